# Optimizing an MI355X kernel written in HIP

```python
import math
import jax, jax.numpy as jnp
from jax import lax
import numpy as np


D_MODEL = 1024
BATCH = 4
SEQ = 8192
DEPTH = 1

HEAD_DIM = 64
SB_HEADS = 8
SB_WIDTH = SB_HEADS * HEAD_DIM
RW_HEADS = 8
RW_WIDTH = RW_HEADS * HEAD_DIM
DECAY_LORA = 64
ICLR_LORA = 64
GATE_LORA = 160
N_BRANCHES = 2
SHIFT_WIDTH = 3 * RW_WIDTH + DECAY_LORA + ICLR_LORA + GATE_LORA
IN_COLS = 3 * SB_WIDTH + SHIFT_WIDTH + N_BRANCHES * D_MODEL
N_GROUPS = 4
EXPERTS_PER_GROUP = 8
N_EXPERTS = N_GROUPS * EXPERTS_PER_GROUP
TOP_K_IN_GROUP = 2
D_EXPERT = 512
Q_BLOCK = 128
NORM_EPS = 1e-6
GN_EPS = 64e-5
L2_EPS = 1e-12

kernel_name = 'hybrid_stickbreak_rwkv7_hmoe_block'


def rmsnorm(x, g):
    xf = x.astype(jnp.float32)
    inv = lax.rsqrt(jnp.mean(xf * xf, axis=-1, keepdims=True) + NORM_EPS)
    return (xf * inv).astype(x.dtype) * g


def stick_breaking_attention(q, k, v):
    seq_len = q.shape[2]
    scale = 1.0 / math.sqrt(q.shape[-1])
    outs = []
    for i in range(seq_len // Q_BLOCK):
        q0 = i * Q_BLOCK
        n_keys = q0 + Q_BLOCK
        qb = q[:, :, q0:n_keys].astype(jnp.float32)
        kb = k[:, :, :n_keys].astype(jnp.float32)
        vb = v[:, :, :n_keys].astype(jnp.float32)
        z = jnp.einsum('bhqd,bhkd->bhqk', qb, kb) * scale
        t_idx = q0 + jnp.arange(Q_BLOCK)[:, None]
        s_idx = jnp.arange(n_keys)[None, :]
        strict = s_idx < t_idx
        log_keep = jnp.where(strict, jax.nn.log_sigmoid(-z), 0.0)
        later = lax.cumsum(log_keep, axis=3, reverse=True) - log_keep
        att = jnp.where(strict, jnp.exp(jax.nn.log_sigmoid(z) + later), 0.0)
        outs.append(jnp.einsum('bhqk,bhkd->bhqd', att, vb).astype(v.dtype))
    return jnp.concatenate(outs, axis=2)


def token_shift(p, mu):
    prev = jnp.pad(p[:, :-1], ((0, 0), (1, 0), (0, 0)))
    return p + mu * (prev - p)


def rwkv7_time_mix(cols, shift_mu, w0, w_decay_up, a0, w_iclr_up, w_gate_up, k_k, k_a, r_k, lnx_w, lnx_b):
    b, s, _ = cols.shape
    xs = token_shift(cols, shift_mu)
    r, k, v, wd, ad, gd = jnp.split(
        xs, [RW_WIDTH, 2 * RW_WIDTH, 3 * RW_WIDTH, 3 * RW_WIDTH + DECAY_LORA,
             3 * RW_WIDTH + DECAY_LORA + ICLR_LORA], axis=-1)
    w = -jax.nn.softplus(-(w0 + jnp.tanh(wd) @ w_decay_up)) - 0.5
    decay = jnp.exp(-jnp.exp(w.astype(jnp.float32)))
    a = jax.nn.sigmoid(a0 + ad @ w_iclr_up)
    g = jax.nn.sigmoid(gd) @ w_gate_up
    kk = k * k_k
    k = k * (1.0 + (a - 1.0) * k_a)

    def heads(t):
        return t.astype(jnp.float32).reshape(b, s, RW_HEADS, HEAD_DIM)

    r_h, k_h, v_h, a_h, kk_h, dec_h = heads(r), heads(k), heads(v), heads(a), heads(kk), heads(decay)
    kk_h = kk_h / jnp.maximum(jnp.sqrt(jnp.sum(kk_h * kk_h, axis=-1, keepdims=True)), L2_EPS)
    vec_a = -kk_h
    vec_b = kk_h * a_h

    def step(state, inp):
        r_t, dec_t, k_t, v_t, a_t, b_t = inp
        sa = jnp.einsum('bhvk,bhk->bhv', state, a_t)
        state = (state * dec_t[:, :, None, :] + sa[..., None] * b_t[:, :, None, :]
                 + v_t[..., None] * k_t[:, :, None, :])
        return state, jnp.einsum('bhvk,bhk->bhv', state, r_t)

    tm = lambda t: jnp.moveaxis(t, 1, 0)
    state0 = jnp.zeros((b, RW_HEADS, HEAD_DIM, HEAD_DIM), jnp.float32)
    _, y = lax.scan(step, state0, (tm(r_h), tm(dec_h), tm(k_h), tm(v_h), tm(vec_a), tm(vec_b)))
    y = jnp.moveaxis(y, 0, 1)
    mean = jnp.mean(y, axis=-1, keepdims=True)
    var = jnp.mean(jnp.square(y - mean), axis=-1, keepdims=True)
    yn = ((y - mean) * lax.rsqrt(var + GN_EPS)).reshape(b, s, RW_WIDTH)
    yn = yn * lnx_w.astype(jnp.float32) + lnx_b.astype(jnp.float32)
    bonus = jnp.sum(r_h * k_h * r_k.astype(jnp.float32), axis=-1, keepdims=True) * v_h
    out = (yn + bonus.reshape(b, s, RW_WIDTH)) * g.astype(jnp.float32)
    return out.astype(cols.dtype)


def hybrid_mixer(h, w_in, gate_bias, shift_mu, w0, w_decay_up, a0, w_iclr_up, w_gate_up,
                 k_k, k_a, r_k, lnx_w, lnx_b, w_o_sb, w_o_rw, w_out):
    b, s, _ = h.shape
    p = h @ w_in
    q, k, v, rw_cols, gate_logits = jnp.split(
        p, [SB_WIDTH, 2 * SB_WIDTH, 3 * SB_WIDTH, 3 * SB_WIDTH + SHIFT_WIDTH], axis=-1)
    to_bhsd = lambda t: t.reshape(b, s, SB_HEADS, HEAD_DIM).transpose(0, 2, 1, 3)
    y_sb = stick_breaking_attention(to_bhsd(q), to_bhsd(k), to_bhsd(v))
    y_sb = y_sb.transpose(0, 2, 1, 3).reshape(b, s, SB_WIDTH)
    y_rw = rwkv7_time_mix(rw_cols, shift_mu, w0, w_decay_up, a0, w_iclr_up, w_gate_up,
                          k_k, k_a, r_k, lnx_w, lnx_b)
    gates = jax.nn.sigmoid(gate_logits + gate_bias)
    g_sb, g_rw = jnp.split(gates, 2, axis=-1)
    merged = g_sb * (y_sb @ w_o_sb) + g_rw * (y_rw @ w_o_rw)
    return merged @ w_out


def hierarchical_moe(h, w_group, w_router, w_up1, w_up3, w_down):
    b, s, d = h.shape
    t = h.reshape(b * s, d)
    n = t.shape[0]
    group_logits = (t @ w_group).astype(jnp.float32)
    group_prob = jax.nn.softmax(group_logits, axis=-1)
    group_sel = jnp.argmax(group_logits, axis=-1)
    group_w = jnp.max(group_prob, axis=-1, keepdims=True)
    expert_logits = (t @ w_router).astype(jnp.float32).reshape(n, N_GROUPS, EXPERTS_PER_GROUP)
    in_group = jnp.einsum('nge,ng->ne', expert_logits, jax.nn.one_hot(group_sel, N_GROUPS, dtype=jnp.float32))
    top_p, top_i = lax.top_k(jax.nn.softmax(in_group, axis=-1), TOP_K_IN_GROUP)
    top_p = top_p / jnp.sum(top_p, axis=-1, keepdims=True)
    expert_ids = group_sel[:, None] * EXPERTS_PER_GROUP + top_i
    combine = jnp.sum(jax.nn.one_hot(expert_ids, N_EXPERTS, dtype=jnp.float32)
                      * (group_w * top_p)[..., None], axis=1).astype(t.dtype)
    y = jnp.zeros_like(t)
    for e in range(N_EXPERTS):
        hid = jax.nn.silu(t @ w_up1[e]) * (t @ w_up3[e])
        y = y + combine[:, e:e + 1] * (hid @ w_down[e])
    return y.reshape(b, s, d)


def setup_inputs(seed: int = 0) -> dict:
    key = jax.random.key(seed)
    ks = jax.random.split(key, 32)
    f32 = jnp.float32
    L = DEPTH

    def nrm(k, shape, scale):
        return jax.random.normal(k, shape, f32) * scale

    return {
        'x': nrm(ks[0], (BATCH, SEQ, D_MODEL), 1.0),
        'c': nrm(ks[1], (BATCH, D_MODEL), 1.0),
        'w_mod': nrm(ks[2], (L, D_MODEL, 6 * D_MODEL), 0.5 * D_MODEL ** -0.5),
        'b_mod': nrm(ks[3], (L, 6 * D_MODEL), 0.01),
        'norm_gains': 1.0 + nrm(ks[4], (L, 4, D_MODEL), 0.02),
        'w_in': nrm(ks[5], (L, D_MODEL, IN_COLS), D_MODEL ** -0.5),
        'gate_bias': nrm(ks[6], (L, N_BRANCHES * D_MODEL), 0.01),
        'shift_mu': jax.random.uniform(ks[7], (L, SHIFT_WIDTH), f32),
        'w0': nrm(ks[8], (L, RW_WIDTH), 0.5),
        'w_decay_up': nrm(ks[9], (L, DECAY_LORA, RW_WIDTH), 0.5 * DECAY_LORA ** -0.5),
        'a0': nrm(ks[10], (L, RW_WIDTH), 0.1),
        'w_iclr_up': nrm(ks[11], (L, ICLR_LORA, RW_WIDTH), ICLR_LORA ** -0.5),
        'w_gate_up': nrm(ks[12], (L, GATE_LORA, RW_WIDTH), GATE_LORA ** -0.5),
        'k_k': 0.85 + nrm(ks[13], (L, RW_WIDTH), 0.05),
        'k_a': 1.0 + nrm(ks[14], (L, RW_WIDTH), 0.05),
        'r_k': nrm(ks[15], (L, RW_HEADS, HEAD_DIM), 0.1),
        'lnx_w': 1.0 + nrm(ks[16], (L, RW_WIDTH), 0.02),
        'lnx_b': nrm(ks[17], (L, RW_WIDTH), 0.01),
        'w_o_sb': nrm(ks[18], (L, SB_WIDTH, D_MODEL), SB_WIDTH ** -0.5),
        'w_o_rw': nrm(ks[19], (L, RW_WIDTH, D_MODEL), RW_WIDTH ** -0.5),
        'w_out': nrm(ks[20], (L, D_MODEL, D_MODEL), D_MODEL ** -0.5),
        'w_group': nrm(ks[21], (L, D_MODEL, N_GROUPS), D_MODEL ** -0.5),
        'w_router': nrm(ks[22], (L, D_MODEL, N_EXPERTS), D_MODEL ** -0.5),
        'w_up1': nrm(ks[23], (L, N_EXPERTS, D_MODEL, D_EXPERT), D_MODEL ** -0.5),
        'w_up3': nrm(ks[24], (L, N_EXPERTS, D_MODEL, D_EXPERT), D_MODEL ** -0.5),
        'w_down': nrm(ks[25], (L, N_EXPERTS, D_EXPERT, D_MODEL), D_EXPERT ** -0.5),
    }


def reference(x, c, w_mod, b_mod, norm_gains, w_in, gate_bias, shift_mu, w0, w_decay_up, a0,
              w_iclr_up, w_gate_up, k_k, k_a, r_k, lnx_w, lnx_b, w_o_sb, w_o_rw, w_out,
              w_group, w_router, w_up1, w_up3, w_down):
    for l in range(DEPTH):
        mod = jax.nn.silu(c) @ w_mod[l] + b_mod[l]
        sh1, sc1, gt1, sh2, sc2, gt2 = [m[:, None, :] for m in jnp.split(mod, 6, axis=-1)]
        h = rmsnorm(x, norm_gains[l, 0]) * (1.0 + sc1) + sh1
        y = hybrid_mixer(h, w_in[l], gate_bias[l], shift_mu[l], w0[l], w_decay_up[l], a0[l],
                         w_iclr_up[l], w_gate_up[l], k_k[l], k_a[l], r_k[l], lnx_w[l], lnx_b[l],
                         w_o_sb[l], w_o_rw[l], w_out[l])
        x = x + gt1 * rmsnorm(y, norm_gains[l, 1])
        h = rmsnorm(x, norm_gains[l, 2]) * (1.0 + sc2) + sh2
        y = hierarchical_moe(h, w_group[l], w_router[l], w_up1[l], w_up3[l], w_down[l])
        x = x + gt2 * rmsnorm(y, norm_gains[l, 3])
    return x
```

```cpp
#include <hip/hip_runtime.h>
#include <cstdio>
#include <cstdint>
__device__ __forceinline__ int opq_tid() { int v = threadIdx.x; asm volatile("" : "+v"(v)); return v; }
#ifndef PHMASK
#define PHMASK 0xffff
#endif
namespace pg8 {
#define PG8_LAS __attribute__((address_space(3)))
typedef unsigned short bf16_t;
typedef short bf16x8 __attribute__((ext_vector_type(8)));
typedef float f32x4 __attribute__((ext_vector_type(4)));
typedef unsigned u32x4 __attribute__((ext_vector_type(4)));
constexpr int BM = 256, BK = 64, HALF = 128, HTB = HALF * BK * 2  , STAGE_BYTES = 8 * HTB, NXCD = 8, WGM = 8;

__host__ __device__ __forceinline__ int lds_byte(int r, int c) { const int st = (r >> 4) * 2 + (c >> 5), rr = r & 15, cc = c & 31, ob = rr * 64 + cc * 2; return st * 1024 + (ob ^ (((ob >> 9) & 1) << 5)); }
__host__ __device__ __forceinline__ void stage_rc(int b, int& R, int& C) { const int st = b / 1024, sb = b % 1024, swz = sb ^ (((sb >> 9) & 1) << 5); R = (st >> 1) * 16 + swz / 64; C = (st & 1) * 32 + (swz % 64) / 2; }
__host__ __device__ __forceinline__ int perm32(int rho) { const int n = rho >> 4, i = rho & 15; return 8 * (i >> 2) + 4 * n + (i & 3); }

struct Unit { int pm, pn; };
struct Gemm { const bf16_t* A; const bf16_t* Bt; int M, N, K; };

struct StaticOrder {
    int nM, nN, nwg, G, c;
    __host__ __device__ void init(int M, int N, int G_, int c_) { nM = M / BM; nN = N / BM; nwg = nM * nN; G = G_; c = c_; }
    __host__ __device__ bool next(int i, Unit& u) const {
        const long L = (long)i * G + c; if (L >= nwg) return false;
        int wgid = (int)L; { const int q = nwg / NXCD, r = nwg % NXCD, xcd = wgid % NXCD, off = wgid / NXCD; wgid = (xcd < r ? xcd * (q + 1) : r * (q + 1) + (xcd - r) * q) + off; }
        const int nig = WGM * nN, gid = wgid / nig, fm = gid * WGM, gsz = (nM - fm) < WGM ? (nM - fm) : WGM;
        u.pm = fm + ((wgid % nig) % gsz); u.pn = (wgid % nig) / gsz; return true;
    }
    __device__ __forceinline__ void a_ready(const Unit&) const {}
    __device__ __forceinline__ void done(const Unit&) const {}
};

template <class Epi, class Sched, bool STAMP = false>
__device__ __forceinline__ void gemm_phase(PG8_LAS unsigned char* lds, const Gemm g, const Sched& S, const Epi& E, unsigned long long* stamps) {
    const int tid = opq_tid(), wid = __builtin_amdgcn_readfirstlane(tid >> 6), lane = tid & 63, wr = wid >> 2, wc = wid & 3, fr = lane & 15, fq = lane >> 4;
    const int K = g.K, nt = K / BK;
    int ts_lo = 0, ts_hi = 0, nts = 0; const unsigned long long rt_entry = STAMP ? (unsigned long long)wall_clock64() : 0ull;
#define PG8_STAMP() do { if (STAMP && wid == 0 && nts < 64) { const unsigned long long _c = (unsigned long long)clock64(); \
        ts_lo = (lane == nts) ? (int)(unsigned)_c : ts_lo; ts_hi = (lane == nts) ? (int)(unsigned)(_c >> 32) : ts_hi; ++nts; } } while (0)
    PG8_STAMP();
    unsigned voffA[2], voffB[2];
#pragma unroll
    for (int i = 0; i < 2; ++i) { int R, C; stage_rc(tid * 16 + i * 8192, R, C); const int Rb = Epi::PERM ? ((R & ~31) + perm32(R & 31)) : R;
        voffA[i] = (unsigned)(R * K + C) * 2u; voffB[i] = (unsigned)(Rb * K + C) * 2u; }
    const size_t kstep = (size_t)(BK * 2);
    const size_t hstep = (size_t)HALF * K * 2;
    const size_t tstep = 2 * hstep;
    const unsigned ldsw = (unsigned)wid * 1024u;
    const int aoff = lds_byte(wr * 64 + fr, fq * 8), boff = lds_byte(wc * 32 + fr, fq * 8);
#define PG8_SA(b, h) (((b) * 2 + (h)) * HTB)
#define PG8_SB(b, h) ((4 + (b) * 2 + (h)) * HTB)
#define PG8_STAGE(bufoff, gbase, voff) do { _Pragma("unroll") for (int _i = 0; _i < 2; ++_i) \
        __builtin_amdgcn_global_load_lds((const unsigned*)((const char*)(gbase) + (voff)[_i]), (PG8_LAS unsigned*)(lds + (bufoff) + ldsw + _i * 8192), 16, 0, 0); } while (0)
#define PG8_LDA(dst, b, h) do { _Pragma("unroll") for (int m = 0; m < 4; ++m) _Pragma("unroll") for (int k = 0; k < 2; ++k) dst[m][k] = *(const PG8_LAS bf16x8*)(lds + PG8_SA(b, h) + aoff + m * 2048 + k * 1024); } while (0)
#define PG8_LDB(dst, b, h) do { _Pragma("unroll") for (int n = 0; n < 2; ++n) _Pragma("unroll") for (int k = 0; k < 2; ++k) dst[n][k] = *(const PG8_LAS bf16x8*)(lds + PG8_SB(b, h) + boff + n * 2048 + k * 1024); } while (0)
#define PG8_MMA(ai, bj, At, Bt) do { __builtin_amdgcn_s_setprio(1); _Pragma("unroll") for (int m = 0; m < 4; ++m) _Pragma("unroll") for (int n = 0; n < 2; ++n) _Pragma("unroll") for (int k = 0; k < 2; ++k) \
        acc[ai][bj][m][n] = __builtin_amdgcn_mfma_f32_16x16x32_bf16(Bt[n][k], At[m][k], acc[ai][bj][m][n], 0, 0, 0); __builtin_amdgcn_s_setprio(0); } while (0)
#define PG8_WAIT_V(n) asm volatile("s_waitcnt vmcnt(" #n ")" ::: "memory")
#define PG8_WAIT_L(n) asm volatile("s_waitcnt lgkmcnt(" #n ")" ::: "memory")
#define PG8_BAR __builtin_amdgcn_s_barrier()
#define PG8_SCHED __builtin_amdgcn_sched_barrier(0)
    Unit cur, nxt; int ui = 0;
    if (!S.next(0, cur)) return;
    f32x4 acc[2][2][4][2];
#pragma unroll
    for (int a = 0; a < 2; ++a)
#pragma unroll
        for (int b = 0; b < 2; ++b)
#pragma unroll
            for (int m = 0; m < 4; ++m)
#pragma unroll
                for (int n = 0; n < 2; ++n) acc[a][b][m][n] = (f32x4){0.f, 0.f, 0.f, 0.f};
    bf16x8 At[4][2], B0[2][2], B1[2][2];
    const char* cA = (const char*)g.A + (size_t)cur.pm * tstep; const char* cB = (const char*)g.Bt + (size_t)cur.pn * tstep;
    S.a_ready(cur);
    PG8_STAGE(PG8_SB(0, 0), cB, voffB); PG8_STAGE(PG8_SA(0, 0), cA, voffA); PG8_STAGE(PG8_SB(0, 1), cB + hstep, voffB); PG8_STAGE(PG8_SA(0, 1), cA + hstep, voffA);
    if (wr == 1) PG8_BAR;
    PG8_WAIT_V(4); PG8_BAR;
    PG8_STAGE(PG8_SB(1, 0), cB + kstep, voffB); PG8_STAGE(PG8_SA(1, 0), cA + kstep, voffA); PG8_STAGE(PG8_SB(1, 1), cB + hstep + kstep, voffB);
    PG8_WAIT_V(6); PG8_BAR;
    PG8_STAMP();
    for (;;) {
        const bool has_next = S.next(ui + 1, nxt);
        const char* nA = has_next ? (const char*)g.A + (size_t)nxt.pm * tstep : cA; const char* nB = has_next ? (const char*)g.Bt + (size_t)nxt.pn * tstep : cB;
        for (int t = 0; t < nt; t += 2) {
            const bool last = (t == nt - 2);
            const char* a1 = cA + (size_t)(t + 1) * kstep;
            const char* a2 = last ? nA : cA + (size_t)(t + 2) * kstep; const char* b2 = last ? nB : cB + (size_t)(t + 2) * kstep;
            const char* a3 = a2 + kstep; const char* b3 = b2 + kstep;
            if (last && has_next) S.a_ready(nxt);
            PG8_LDB(B0, 0, 0); PG8_SCHED; PG8_LDA(At, 0, 0); PG8_STAGE(PG8_SA(1, 1), a1 + hstep, voffA);
            PG8_WAIT_L(8); PG8_BAR; PG8_WAIT_L(0); PG8_MMA(0, 0, At, B0); PG8_BAR; PG8_SCHED;
            PG8_LDB(B1, 0, 1); PG8_STAGE(PG8_SB(0, 0), b2, voffB);
            PG8_BAR; PG8_WAIT_L(0); PG8_MMA(0, 1, At, B1); PG8_BAR;
            PG8_LDA(At, 0, 1); PG8_STAGE(PG8_SA(0, 0), a2, voffA);
            PG8_BAR; PG8_WAIT_L(0); PG8_MMA(1, 0, At, B0); PG8_BAR; PG8_SCHED;
            PG8_STAGE(PG8_SB(0, 1), b2 + hstep, voffB);
            PG8_WAIT_V(6); PG8_BAR; PG8_MMA(1, 1, At, B1); PG8_BAR;
            PG8_LDB(B0, 1, 0); PG8_SCHED; PG8_LDA(At, 1, 0); PG8_STAGE(PG8_SA(0, 1), a2 + hstep, voffA);
            PG8_WAIT_L(8); PG8_BAR; PG8_WAIT_L(0); PG8_MMA(0, 0, At, B0); PG8_BAR; PG8_SCHED;
            PG8_LDB(B1, 1, 1); PG8_STAGE(PG8_SB(1, 0), b3, voffB);
            PG8_BAR; PG8_WAIT_L(0); PG8_MMA(0, 1, At, B1); PG8_BAR;
            PG8_LDA(At, 1, 1); PG8_STAGE(PG8_SA(1, 0), a3, voffA);
            PG8_BAR; PG8_WAIT_L(0); PG8_MMA(1, 0, At, B0); PG8_BAR; PG8_SCHED;
            PG8_STAGE(PG8_SB(1, 1), b3 + hstep, voffB);
            PG8_WAIT_V(6); PG8_BAR; PG8_MMA(1, 1, At, B1); PG8_BAR;
        }
        PG8_STAMP();
        if constexpr (!Epi::AFTER_DRAIN) { E(acc, cur, wr, wc, fr, fq); S.done(cur); }
        PG8_STAMP();
        if (!has_next) break;
#pragma unroll
        for (int a = 0; a < 2; ++a)
#pragma unroll
            for (int b = 0; b < 2; ++b)
#pragma unroll
                for (int m = 0; m < 4; ++m)
#pragma unroll
                    for (int n = 0; n < 2; ++n) acc[a][b][m][n] = (f32x4){0.f, 0.f, 0.f, 0.f};
        cur = nxt; cA = nA; cB = nB; ++ui;
    }
    PG8_WAIT_V(0);
    if (wr == 0) PG8_BAR;
    PG8_BAR;
    if constexpr (Epi::AFTER_DRAIN) { E.fused(acc, cur, wr, wc, fr, fq, lds, wid, lane); S.done(cur); }
    PG8_STAMP();
    if (STAMP && wid == 0) { stamps[lane] = lane < nts ? (((unsigned long long)(unsigned)ts_hi << 32) | (unsigned)ts_lo) : 0ull;
        if (lane == 62) stamps[62] = rt_entry; if (lane == 63) stamps[63] = (unsigned long long)wall_clock64(); }
#undef PG8_STAMP
#undef PG8_SA
#undef PG8_SB
#undef PG8_STAGE
#undef PG8_LDA
#undef PG8_LDB
#undef PG8_MMA
#undef PG8_WAIT_V
#undef PG8_WAIT_L
#undef PG8_BAR
#undef PG8_SCHED
}
}

#define XB_TMO      128
#define XB_XCNT(j)  (256  + 64 * (j))
#define XB_XSUB(j)  (1280 + 64 * (j))
#define XB_XGEN(j)  (2304 + 64 * (j))
#define XB_TOP      3328
#define XB_TOPGEN   3392
#define XCD_BAR_WORDS 3456
#define XB_SPIN_CAP (1u << 18)
#define LAS __attribute__((address_space(3)))

__device__ __forceinline__ unsigned xb_ld(unsigned* p)              { return __hip_atomic_load(p, __ATOMIC_RELAXED, __HIP_MEMORY_SCOPE_AGENT); }
__device__ __forceinline__ unsigned xb_add(unsigned* p, unsigned v) { return __hip_atomic_fetch_add(p, v, __ATOMIC_RELAXED, __HIP_MEMORY_SCOPE_AGENT); }
__device__ __forceinline__ unsigned xb_xcc_id() { return (unsigned)__builtin_amdgcn_s_getreg((3 << 11) | 20) & 0xFu; }
#define XB_SPIN(cond, bar) do { unsigned _sp = 0; while (cond) { __builtin_amdgcn_s_sleep(1); \
    if ((++_sp & 255u) == 0u) { if (xb_ld(&(bar)[XB_TMO])) break; if (_sp > XB_SPIN_CAP) { atomicAdd(&(bar)[XB_TMO], 1u); break; } } } } while (0)

struct XcdBarrier {
    unsigned* bar; unsigned x;
    volatile LAS unsigned* st;
};

__device__ __forceinline__ XcdBarrier xcd_barrier_post(unsigned* bar, volatile LAS unsigned* st) {
    XcdBarrier b; b.bar = bar; b.x = xb_xcc_id(); b.st = st;
    if (threadIdx.x == 0) (void)xb_add(&bar[XB_XCNT(b.x)], 1u);
    return b;
}
__device__ __forceinline__ void xcd_barrier_complete(unsigned* bar, unsigned x, unsigned& nloc, unsigned& nx) {
    const unsigned G = gridDim.x * gridDim.y * gridDim.z;
    unsigned sum, cnt, mine, sp = 0u;
    for (;;) {
        sum = 0u; cnt = 0u; mine = 0u;
#pragma unroll
        for (unsigned j = 0; j < 16; ++j) { const unsigned c = xb_ld(&bar[XB_XCNT(j)]); sum += c; cnt += (c > 0u) ? 1u : 0u; mine = (j == x) ? c : mine; }
        if (sum == G) break;
        __builtin_amdgcn_s_sleep(1);
        if ((++sp & 255u) == 0u) { if (xb_ld(&bar[XB_TMO])) break; if (sp > XB_SPIN_CAP) { atomicAdd(&bar[XB_TMO], 1u); break; } }
    }
    nloc = mine > 0u ? mine : 1u; nx = cnt > 0u ? cnt : 1u;
}

__device__ __forceinline__ void xcd_barrier(const XcdBarrier& b) {
    asm volatile("s_waitcnt vmcnt(0)" ::: "memory");
    __syncthreads();
    if (threadIdx.x == 0) {
        unsigned* bar = b.bar;
        __builtin_amdgcn_s_waitcnt(0);
        unsigned nloc = b.st[0], nx = b.st[1];
        if (nloc == 0u) { xcd_barrier_complete(bar, b.x, nloc, nx); b.st[0] = nloc; b.st[1] = nx; }
        const unsigned old = xb_add(&bar[XB_XSUB(b.x)], 1u);
        const unsigned gen = old / nloc;
        if (old + 1u == (gen + 1u) * nloc) {
            __builtin_amdgcn_fence(__ATOMIC_RELEASE, "agent");
            asm volatile("s_waitcnt vmcnt(0)" ::: "memory");
            const unsigned og = xb_add(&bar[XB_TOP], 1u);
            const unsigned tg = og / nx;
            if (og + 1u == (tg + 1u) * nx) xb_add(&bar[XB_TOPGEN], 1u);
            else XB_SPIN(xb_ld(&bar[XB_TOPGEN]) == tg, bar);
            __builtin_amdgcn_fence(__ATOMIC_ACQUIRE, "agent");
            xb_add(&bar[XB_XGEN(b.x)], 1u);
            asm volatile("s_waitcnt vmcnt(0)" ::: "memory");
        } else {
            XB_SPIN(xb_ld(&bar[XB_XGEN(b.x)]) == gen, bar);
            __builtin_amdgcn_fence(__ATOMIC_ACQUIRE, "agent");
            asm volatile("s_waitcnt vmcnt(0)" ::: "memory");
        }
    }
    __syncthreads();
}


constexpr int NB = 4, SEQ = 8192, D = 1024, NTOK = NB * SEQ;
constexpr int NH = 8, HD = 64, BW = 512;
constexpr int IN_COLS = 5408, NPAD = 5632;
constexpr int LK = 384;
constexpr int NE = 32, DE = 512;
constexpr int CH = 128, NCH = SEQ / CH, NCHUNK = NB * NH * NCH;
constexpr int MAXT = 288;
constexpr float NORM_EPS = 1e-6f, GN_EPS = 64e-5f, L2_EPS = 1e-12f;
constexpr float SB_STOP = -120.0f;

constexpr size_t MiB = 1u << 20;
constexpr size_t WS_CTL = 0, CTL_ZERO_BYTES = 65536;
constexpr size_t WS_MOD = 1 * MiB;
constexpr size_t WS_RTW = WS_MOD + 128 * 1024;
constexpr size_t WS_TOK = WS_RTW + 160 * 1024;
constexpr size_t WS_CNT = WS_TOK + (size_t)NTOK * 16;
constexpr size_t WS_TILE = WS_CNT + 256 * 32 * 4;
constexpr size_t WS_WIN = 2 * MiB;
constexpr size_t WS_WOSB = 13 * MiB, WS_WORW = 14 * MiB, WS_WOUT = 15 * MiB;
constexpr size_t WS_WL = 17 * MiB;
constexpr size_t WS_CW = 19 * MiB;
constexpr size_t WS_QB = 20 * MiB;
constexpr size_t WS_GATE = 52 * MiB;
constexpr size_t WS_GG = 180 * MiB;
constexpr size_t WS_KB = 212 * MiB, WS_VT = 244 * MiB;
constexpr size_t WS_LORA = 276 * MiB;
constexpr size_t WS_ALORA = 308 * MiB;
constexpr size_t WS_E = 356 * MiB, WS_B = 388 * MiB;
constexpr size_t WS_RWRAW = 416 * MiB;
constexpr size_t WS_P = 212 * MiB, WS_QO = 244 * MiB;
constexpr size_t WS_GT = 276 * MiB;
constexpr size_t WS_HT = 292 * MiB;
constexpr size_t WS_SC = 324 * MiB;
constexpr size_t WS_YRW = 356 * MiB;
constexpr size_t WS_WUP = 416 * MiB, WS_WDN = 480 * MiB;
constexpr size_t WS_MRG = 212 * MiB;
constexpr size_t WS_Y1 = 276 * MiB;
constexpr size_t WS_H2 = 52 * MiB;
constexpr size_t WS_HS = 116 * MiB;
constexpr size_t WS_HID = 260 * MiB;
constexpr size_t WS_END = 512 * MiB;
static_assert(WS_TILE + (MAXT + 1) * 4 <= WS_WIN && WS_WIN + (size_t)NPAD * D * 2 <= WS_WOSB && WS_WL + 1536 * LK * 2 <= WS_QB, "fixed region");
static_assert(WS_HS + (size_t)MAXT * 256 * D * 2 <= WS_HID && WS_HID + (size_t)MAXT * 256 * DE * 2 <= WS_WUP, "moe region");
static_assert(WS_ALORA + (size_t)NTOK * LK * 2 <= WS_E && WS_B + (size_t)NTOK * BW * 2 <= WS_RWRAW + 4 * MiB, "rwkv region");

constexpr int LDS_BYTES = 163840;
constexpr int LDS_MISC = LDS_BYTES - 256;
constexpr int NWAVES = 8, NTHR = 512;

typedef unsigned short bf16;
typedef short bf16x8 __attribute__((ext_vector_type(8)));
typedef short s16x4 __attribute__((ext_vector_type(4)));
typedef float f32x4 __attribute__((ext_vector_type(4)));
typedef float f32x16 __attribute__((ext_vector_type(16)));
typedef unsigned u32x4 __attribute__((ext_vector_type(4)));
typedef unsigned u32x2 __attribute__((ext_vector_type(2)));
typedef int i32x4 __attribute__((ext_vector_type(4)));
#define DI __device__ __forceinline__
#define MFMA32(a, b, c) __builtin_amdgcn_mfma_f32_32x32x16_bf16((a), (b), (c), 0, 0, 0)

DI unsigned f2bf(float f) { unsigned u = __builtin_bit_cast(unsigned, f); return (u + 0x7fffu + ((u >> 16) & 1u)) >> 16; }
DI unsigned pk2(float lo, float hi) { return f2bf(lo) | (f2bf(hi) << 16); }
DI float bflo(unsigned u) { return __builtin_bit_cast(float, u << 16); }
DI float bfhi(unsigned u) { return __builtin_bit_cast(float, u & 0xffff0000u); }
DI float bf2f(bf16 h) { return __builtin_bit_cast(float, (unsigned)h << 16); }
DI float fexp(float x) { return __expf(x); }
DI float frcp(float x) { return __builtin_amdgcn_rcpf(x); }
DI float fsigmoid(float x) { return frcp(1.0f + fexp(-x)); }
DI float fsoftplus(float x) { return fmaxf(x, 0.0f) + __logf(1.0f + fexp(-fabsf(x))); }
DI float wave_sum(float v) {
#pragma unroll
    for (int o = 1; o < 64; o <<= 1) v += __shfl_xor(v, o);
    return v;
}
DI int crow(int reg, int hh) { return (reg & 3) + 8 * (reg >> 2) + 4 * hh; }
DI void wave_lds_fence() { __builtin_amdgcn_fence(__ATOMIC_RELEASE, "wavefront"); __builtin_amdgcn_wave_barrier(); __builtin_amdgcn_fence(__ATOMIC_ACQUIRE, "wavefront"); }
DI void unpack8(const u32x4 v, float (&o)[8]) { o[0] = bflo(v.x); o[1] = bfhi(v.x); o[2] = bflo(v.y); o[3] = bfhi(v.y); o[4] = bflo(v.z); o[5] = bfhi(v.z); o[6] = bflo(v.w); o[7] = bfhi(v.w); }
DI u32x4 pack8(const float (&o)[8]) { u32x4 v; v.x = pk2(o[0], o[1]); v.y = pk2(o[2], o[3]); v.z = pk2(o[4], o[5]); v.w = pk2(o[6], o[7]); return v; }
DI bf16x8 pack8v(float a0, float a1, float a2, float a3, float a4, float a5, float a6, float a7) {
    u32x4 v; v.x = pk2(a0, a1); v.y = pk2(a2, a3); v.z = pk2(a4, a5); v.w = pk2(a6, a7); return __builtin_bit_cast(bf16x8, v); }


#if defined(CHECKS)
constexpr int DBG_TOKEN = 77;
#endif

typedef pg8::f32x4 af4;
DI void st8(bf16* p, const af4 v0, const af4 v1) { u32x4 w; w.x = pk2(v0[0], v0[1]); w.y = pk2(v0[2], v0[3]); w.z = pk2(v1[0], v1[1]); w.w = pk2(v1[2], v1[3]); *(u32x4*)p = w; }

struct EpiIn {
    static constexpr bool PERM = true, AFTER_DRAIN = false;
    bf16 *Q, *K, *Vt, *RW, *LO, *GA; const float* gate_bias;
    DI void operator()(const af4 (&acc)[2][2][4][2], const pg8::Unit& u, int wr, int wc, int fr, int fq) const {
        const int pn = u.pn, row0 = u.pm * 256 + wr * 64 + fr;
        if (pn == 4 || pn == 5) {
#pragma unroll
            for (int ai = 0; ai < 2; ++ai)
#pragma unroll
                for (int m = 0; m < 4; ++m) { const int row = row0 + ai * 128 + m * 16, b = row >> 13, s = row & (SEQ - 1);
#pragma unroll
                    for (int bj = 0; bj < 2; ++bj)
#pragma unroll
                        for (int n = 0; n < 2; ++n)
#pragma unroll
                            for (int j = 0; j < 4; ++j) { const int cv = (pn - 4) * 256 + bj * 128 + wc * 32 + 8 * fq + 4 * n + j;
                                Vt[((size_t)(b * BW + cv)) * SEQ + s] = (bf16)f2bf(acc[ai][bj][m][n][j]); } }
        } else if (pn >= 14) {
            const int col0 = (pn - 14) * 256 + wc * 32 + 8 * fq;
            af4 bv[2][2];
#pragma unroll
            for (int bj = 0; bj < 2; ++bj)
#pragma unroll
                for (int n = 0; n < 2; ++n) bv[bj][n] = *(const af4*)(gate_bias + col0 + bj * 128 + 4 * n);
#pragma unroll
            for (int ai = 0; ai < 2; ++ai)
#pragma unroll
                for (int m = 0; m < 4; ++m) { bf16* rowp = GA + (size_t)(row0 + ai * 128 + m * 16) * 2048 + col0;
#pragma unroll
                    for (int bj = 0; bj < 2; ++bj) { af4 v0 = acc[ai][bj][m][0] + bv[bj][0], v1 = acc[ai][bj][m][1] + bv[bj][1];
#pragma unroll
                        for (int j = 0; j < 4; ++j) { v0[j] = fsigmoid(v0[j]); v1[j] = fsigmoid(v1[j]); }
                        st8(rowp + bj * 128, v0, v1); } }
        } else {
            bf16* base; int ld, ct; float sc = 1.0f;
            if (pn < 2) { base = Q; ld = BW; ct = pn; sc = 0.125f; } else if (pn < 4) { base = K; ld = BW; ct = pn - 2; } else if (pn < 12) { base = RW; ld = 1536; ct = pn - 6; } else { base = LO; ld = BW; ct = pn - 12; }
            const int col0 = ct * 256 + wc * 32 + 8 * fq;
#pragma unroll
            for (int ai = 0; ai < 2; ++ai)
#pragma unroll
                for (int m = 0; m < 4; ++m) { bf16* rowp = base + (size_t)(row0 + ai * 128 + m * 16) * ld + col0;
#pragma unroll
                    for (int bj = 0; bj < 2; ++bj) st8(rowp + bj * 128, acc[ai][bj][m][0] * sc, acc[ai][bj][m][1] * sc); }
        }
    }
};

struct EpiLora {
    static constexpr bool PERM = true, AFTER_DRAIN = false;
    bf16 *E, *KS, *B, *GG; const bf16* KK; const float *w0, *a0, *k_a;
    DI void operator()(const af4 (&acc)[2][2][4][2], const pg8::Unit& u, int wr, int wc, int fr_, int fq_) const {
        int fr = fr_, fq = fq_; asm volatile("" : "+v"(fr), "+v"(fq));
        const int pn = u.pn, row0 = u.pm * 256 + wr * 64 + fr, col0 = (pn & 1) * 256 + wc * 32 + 8 * fq;
        if (pn < 2) {
#pragma unroll
            for (int bj = 0; bj < 2; ++bj) { const af4 c0 = *(const af4*)(w0 + col0 + bj * 128), c1 = *(const af4*)(w0 + col0 + bj * 128 + 4);
#pragma unroll
                for (int ai = 0; ai < 2; ++ai)
#pragma unroll
                    for (int m = 0; m < 4; ++m) { af4 v0 = acc[ai][bj][m][0] + c0, v1 = acc[ai][bj][m][1] + c1;
#pragma unroll
                        for (int j = 0; j < 4; ++j) { v0[j] = fexp(-fsoftplus(-v0[j]) - 0.5f); v1[j] = fexp(-fsoftplus(-v1[j]) - 0.5f); }
                        st8(E + (size_t)(row0 + ai * 128 + m * 16) * BW + col0 + bj * 128, v0, v1); __builtin_amdgcn_sched_barrier(0); } }
        } else if (pn < 4) {
#pragma unroll
            for (int bj = 0; bj < 2; ++bj) { const int c = col0 + bj * 128;
                const af4 c0 = *(const af4*)(a0 + c), c1 = *(const af4*)(a0 + c + 4), ka0 = *(const af4*)(k_a + c), ka1 = *(const af4*)(k_a + c + 4);
#pragma unroll
                for (int ai = 0; ai < 2; ++ai)
#pragma unroll
                    for (int m = 0; m < 4; ++m) { const size_t off = (size_t)(row0 + ai * 128 + m * 16) * BW + c;
                        float ks[8], kk[8]; unpack8(*(const u32x4*)(KS + off), ks); unpack8(*(const u32x4*)(KK + off), kk);
                        af4 kp0, kp1, b0, b1;
#pragma unroll
                        for (int j = 0; j < 4; ++j) { const float s0 = fsigmoid(acc[ai][bj][m][0][j] + c0[j]), s1 = fsigmoid(acc[ai][bj][m][1][j] + c1[j]);
                            kp0[j] = ks[j] * (1.0f + (s0 - 1.0f) * ka0[j]); kp1[j] = ks[4 + j] * (1.0f + (s1 - 1.0f) * ka1[j]); b0[j] = kk[j] * s0; b1[j] = kk[4 + j] * s1; }
                        st8(KS + off, kp0, kp1); st8(B + off, b0, b1); __builtin_amdgcn_sched_barrier(0); } }
        } else {
#pragma unroll
            for (int ai = 0; ai < 2; ++ai)
#pragma unroll
                for (int m = 0; m < 4; ++m)
#pragma unroll
                    for (int bj = 0; bj < 2; ++bj) st8(GG + (size_t)(row0 + ai * 128 + m * 16) * BW + col0 + bj * 128, acc[ai][bj][m][0], acc[ai][bj][m][1]);
        }
    }
};

template <bool ADD> struct EpiMerge {
    static constexpr bool PERM = true, AFTER_DRAIN = false;
    const bf16* GA; bf16* MRG; int gofs;
    DI void operator()(const af4 (&acc)[2][2][4][2], const pg8::Unit& u, int wr, int wc, int fr, int fq) const {
        const int row0 = u.pm * 256 + wr * 64 + fr, col0 = u.pn * 256 + wc * 32 + 8 * fq;
#pragma unroll
        for (int ai = 0; ai < 2; ++ai)
#pragma unroll
            for (int m = 0; m < 4; ++m) { const size_t row = (size_t)(row0 + ai * 128 + m * 16);
#pragma unroll
                for (int bj = 0; bj < 2; ++bj) { const int c = col0 + bj * 128;
                    float g[8]; unpack8(*(const u32x4*)(GA + row * 2048 + gofs + c), g);
                    af4 v0, v1;
#pragma unroll
                    for (int j = 0; j < 4; ++j) { v0[j] = g[j] * acc[ai][bj][m][0][j]; v1[j] = g[4 + j] * acc[ai][bj][m][1][j]; }
                    if (ADD) { float o[8]; unpack8(*(const u32x4*)(MRG + row * D + c), o);
#pragma unroll
                        for (int j = 0; j < 4; ++j) { v0[j] += o[j]; v1[j] += o[4 + j]; } }
                    st8(MRG + row * D + c, v0, v1); } }
    }
};

struct EpiPlain {
    static constexpr bool PERM = true, AFTER_DRAIN = false;
    bf16* O; int ld, cmask;
    DI void operator()(const af4 (&acc)[2][2][4][2], const pg8::Unit& u, int wr, int wc, int fr, int fq) const {
        const int row0 = u.pm * 256 + wr * 64 + fr, col0 = (u.pn & cmask) * 256 + wc * 32 + 8 * fq;
#pragma unroll
        for (int ai = 0; ai < 2; ++ai)
#pragma unroll
            for (int m = 0; m < 4; ++m) { bf16* rowp = O + (size_t)(row0 + ai * 128 + m * 16) * ld + col0;
#pragma unroll
                for (int bj = 0; bj < 2; ++bj) st8(rowp + bj * 128, acc[ai][bj][m][0], acc[ai][bj][m][1]); }
    }
};

struct EpiUp {
    static constexpr bool PERM = true, AFTER_DRAIN = false;
    bf16* HID;
    DI void operator()(const af4 (&acc)[2][2][4][2], const pg8::Unit& u, int wr, int wc, int fr, int fq) const {
        const int row0 = u.pm * 256 + wr * 64 + fr, col0 = (u.pn & 3) * 128 + wc * 16 + 4 * fq;
#pragma unroll
        for (int ai = 0; ai < 2; ++ai)
#pragma unroll
            for (int m = 0; m < 4; ++m) { bf16* rowp = HID + (size_t)(row0 + ai * 128 + m * 16) * DE + col0;
#pragma unroll
                for (int bj = 0; bj < 2; ++bj) { float h[4];
#pragma unroll
                    for (int j = 0; j < 4; ++j) { const float u1 = acc[ai][bj][m][0][j]; h[j] = u1 * fsigmoid(u1) * acc[ai][bj][m][1][j]; }
                    u32x2 w; w.x = pk2(h[0], h[1]); w.y = pk2(h[2], h[3]); *(u32x2*)(rowp + bj * 64) = w; } }
    }
};

struct MoeOrder {
    int nunits, G, vc; const int* tile_e;
    DI bool next(int i, pg8::Unit& u) const { const long L = (long)i * G + vc; if (L >= nunits) return false; const int rt = (int)(L >> 2);
        u.pm = rt; u.pn = __builtin_amdgcn_readfirstlane(tile_e[rt]) * 4 + (int)(L & 3); return true; }
    DI void a_ready(const pg8::Unit&) const {}
    DI void done(const pg8::Unit&) const {}
};

struct Args {
    const float *x, *c, *w_mod, *b_mod, *gains, *w_in, *gate_bias, *shift_mu, *w0, *w_decay_up, *a0, *w_iclr_up, *w_gate_up, *k_k, *k_a, *r_k, *lnx_w, *lnx_b,
                *w_o_sb, *w_o_rw, *w_out, *w_group, *w_router, *w_up1, *w_up3, *w_down;
    float* out; unsigned char* ws;
};
struct Frame { LAS unsigned char* lds; int tid, lane, wave, wg, G, gw, NGW; };
#define CAS __attribute__((address_space(4)))
typedef const CAS Args& ARef;

DI void tr_item(const float* W, int ldw, int K, bf16* WT, int k0, int drow0, int scol0, LAS float* scr, int lane) {
    if (scol0 >= 0) {
#pragma unroll 8
        for (int i = 0; i < 32; ++i) { const int kk = 2 * i + (lane >> 5); scr[kk * 33 + (lane & 31)] = W[(size_t)(k0 + kk) * ldw + scol0 + (lane & 31)]; }
    } else {
#pragma unroll 8
        for (int i = 0; i < 32; ++i) { const int kk = 2 * i + (lane >> 5); scr[kk * 33 + (lane & 31)] = 0.0f; }
    }
    wave_lds_fence();
    const int c = lane & 7;
#pragma unroll
    for (int j = 0; j < 4; ++j) { const int n = (lane >> 3) + 8 * j; const LAS float* s = scr + (8 * c) * 33 + n;
        u32x4 o; o.x = pk2(s[0 * 33], s[1 * 33]); o.y = pk2(s[2 * 33], s[3 * 33]); o.z = pk2(s[4 * 33], s[5 * 33]); o.w = pk2(s[6 * 33], s[7 * 33]);
        *(u32x4*)(WT + (size_t)(drow0 + n) * K + k0 + 8 * c) = o; }
    wave_lds_fence();
}
DI void tr_item_up(const float* W1, const float* W3, bf16* WT, int e, int k0, int drow0, LAS float* scr, int lane) {
    const int l31 = lane & 31, sc = (drow0 >> 3) * 4 + (l31 >> 3) * 4 + (l31 & 3);
    const float* W = ((l31 & 4) ? W3 : W1) + (size_t)e * D * DE;
#pragma unroll 8
    for (int i = 0; i < 32; ++i) { const int kk = 2 * i + (lane >> 5); scr[kk * 33 + l31] = W[(size_t)(k0 + kk) * DE + sc]; }
    wave_lds_fence();
    const int c = lane & 7;
#pragma unroll
    for (int j = 0; j < 4; ++j) { const int n = (lane >> 3) + 8 * j; const LAS float* s = scr + (8 * c) * 33 + n;
        u32x4 o; o.x = pk2(s[0 * 33], s[1 * 33]); o.y = pk2(s[2 * 33], s[3 * 33]); o.z = pk2(s[4 * 33], s[5 * 33]); o.w = pk2(s[6 * 33], s[7 * 33]);
        *(u32x4*)(WT + ((size_t)e * 1024 + drow0 + n) * D + k0 + 8 * c) = o; }
    wave_lds_fence();
}

DI void p0_prologue(const Frame& F0, ARef A) {
    Frame F = F0; F.tid = opq_tid(); F.lane = F.tid & 63; F.wave = __builtin_amdgcn_readfirstlane(F.tid >> 6); F.gw = F.wg * NWAVES + F.wave;
    unsigned char* ws = A.ws;
    LAS float* sl = (LAS float*)F.lds;
    LAS float* part = (LAS float*)(F.lds + 16384);
    for (int i = F.tid; i < NB * D; i += NTHR) { const float v = A.c[i]; sl[i] = v * fsigmoid(v); }
    __syncthreads();
    float* mod = (float*)(ws + WS_MOD);
    for (int cg = F.wg; cg < 256; cg += F.G) {
        const int col = F.tid & 31, kg = F.tid >> 5;
        if (col < 24) { float a0 = 0.f, a1 = 0.f, a2 = 0.f, a3 = 0.f;
#pragma unroll 8
            for (int kk = 0; kk < 64; ++kk) { const int k = kg * 64 + kk; const float w = A.w_mod[(size_t)k * 6144 + cg * 24 + col];
                a0 += sl[k] * w; a1 += sl[D + k] * w; a2 += sl[2 * D + k] * w; a3 += sl[3 * D + k] * w; }
            LAS float* p = part + (kg * 24 + col) * 4; p[0] = a0; p[1] = a1; p[2] = a2; p[3] = a3; }
        __syncthreads();
        if (F.tid < 96) { const int c = F.tid >> 2, b = F.tid & 3; float s = 0.f;
#pragma unroll
            for (int kg2 = 0; kg2 < 16; ++kg2) s += part[(kg2 * 24 + c) * 4 + b];
            mod[b * 6144 + cg * 24 + c] = s + A.b_mod[cg * 24 + c]; }
        __syncthreads();
    }
    LAS float* scr = (LAS float*)(F.lds + 32768 + F.wave * 8704);
    constexpr int I_IN = (NPAD / 32) * (D / 64), I_OS = (D / 32) * (BW / 64), I_OUT = (D / 32) * (D / 64);
    for (int it = F.gw; it < I_IN + 2 * I_OS + I_OUT; it += F.NGW) {
        int r = it;
        if (r < I_IN) { const int g = r / (D / 64), kb = r % (D / 64), drow0 = 32 * g;
            const int sc = drow0 < 3360 ? drow0 : (drow0 < 3584 ? -1 : drow0 - 224);
            tr_item(A.w_in, IN_COLS, D, (bf16*)(ws + WS_WIN), 64 * kb, drow0, sc, scr, F.lane); continue; }
        r -= I_IN;
        if (r < I_OS) { const int g = r / (BW / 64), kb = r % (BW / 64); tr_item(A.w_o_sb, D, BW, (bf16*)(ws + WS_WOSB), 64 * kb, 32 * g, 32 * g, scr, F.lane); continue; }
        r -= I_OS;
        if (r < I_OS) { const int g = r / (BW / 64), kb = r % (BW / 64); tr_item(A.w_o_rw, D, BW, (bf16*)(ws + WS_WORW), 64 * kb, 32 * g, 32 * g, scr, F.lane); continue; }
        r -= I_OS;
        { const int g = r / (D / 64), kb = r % (D / 64); tr_item(A.w_out, D, D, (bf16*)(ws + WS_WOUT), 64 * kb, 32 * g, 32 * g, scr, F.lane); }
    }
    const int gt = F.wg * NTHR + F.tid, NGT = F.G * NTHR;
    float* rtw = (float*)(ws + WS_RTW);
    for (int i = gt; i < 36 * D; i += NGT) { const int o = i >> 10, k = i & (D - 1); rtw[i] = o < 4 ? A.w_group[k * 4 + o] : A.w_router[k * NE + (o - 4)]; }
    bf16* wl = (bf16*)(ws + WS_WL);
    for (int i = gt; i < 1536 * LK; i += NGT) { const int n = i / LK, k = i % LK; float v = 0.f;
        if (n < 512) { if (k < 64) v = A.w_decay_up[k * BW + n]; }
        else if (n < 1024) { if (k >= 64 && k < 128) v = A.w_iclr_up[(k - 64) * BW + (n - 512)]; }
        else { if (k >= 128 && k < 288) v = A.w_gate_up[(k - 128) * BW + (n - 1024)]; }
        wl[i] = (bf16)f2bf(v); }
}

DI void p1_h1(const Frame& F0, ARef A, bf16* H1) {
    Frame F = F0; F.tid = opq_tid(); F.lane = F.tid & 63; F.wave = __builtin_amdgcn_readfirstlane(F.tid >> 6); F.gw = F.wg * NWAVES + F.wave;
    const float* mod = (const float*)(A.ws + WS_MOD);
    for (int n = F.gw; n < NTOK; n += F.NGW) {
        const int b = n >> 13;
        const f32x4* xr = (const f32x4*)(A.x + (size_t)n * D) + F.lane;
        f32x4 v[4]; float s = 0.f;
#pragma unroll
        for (int j = 0; j < 4; ++j) { v[j] = xr[64 * j]; s += (v[j][0] * v[j][0] + v[j][1] * v[j][1]) + (v[j][2] * v[j][2] + v[j][3] * v[j][3]); }
        const float inv = rsqrtf(wave_sum(s) * (1.0f / D) + NORM_EPS);
        u32x2* o = (u32x2*)(H1 + (size_t)n * D) + F.lane;
#pragma unroll
        for (int j = 0; j < 4; ++j) { const int k = 4 * F.lane + 256 * j;
            const f32x4 g = *(const f32x4*)(A.gains + k), sh = *(const f32x4*)(mod + b * 6144 + k), sc = *(const f32x4*)(mod + b * 6144 + D + k);
            f32x4 h;
#pragma unroll
            for (int q = 0; q < 4; ++q) h[q] = (v[j][q] * inv) * g[q] * (1.0f + sc[q]) + sh[q];
            u32x2 w; w.x = pk2(h[0], h[1]); w.y = pk2(h[2], h[3]); o[64 * j] = w; }
    }
}

DI void p3_attn(const Frame& F0, const bf16* QB, const bf16* KB, const bf16* VT, bf16* YSB) {
    Frame F = F0; F.tid = opq_tid(); F.lane = F.tid & 63; F.wave = __builtin_amdgcn_readfirstlane(F.tid >> 6); F.gw = F.wg * NWAVES + F.wave;
    const int lane = F.lane, r = lane & 31, hh = lane >> 5;
    bf16x8 tri[2];
#pragma unroll
    for (int s = 0; s < 2; ++s)
#pragma unroll
        for (int e = 0; e < 8; ++e) tri[s][e] = (16 * s + 8 * (e >> 2) + 4 * hh + (e & 3)) > r ? (short)0x3F80 : (short)0;
    for (int u = F.gw; u < NB * NH * (SEQ / 32); u += F.NGW) {
        const int bh = u >> 8, qt = u & 255, b = bh >> 3, h = bh & 7;
        const bf16* qp = QB + (size_t)(b * SEQ + qt * 32 + r) * BW + h * HD + 8 * hh;
        bf16x8 qf[4];
#pragma unroll
        for (int ks = 0; ks < 4; ++ks) qf[ks] = *(const bf16x8*)(qp + 16 * ks);
        f32x16 o0, o1;
#pragma unroll
        for (int i = 0; i < 16; ++i) { o0[i] = 0.f; o1[i] = 0.f; }
        float L = 0.f;
        for (int kt = qt; kt >= 0; --kt) {
            const bf16* kp = KB + (size_t)(b * SEQ + kt * 32 + r) * BW + h * HD + 8 * hh;
            bf16x8 kf[4];
#pragma unroll
            for (int ks = 0; ks < 4; ++ks) kf[ks] = *(const bf16x8*)(kp + 16 * ks);
            const bf16* vp = VT + ((size_t)(bh * HD + r)) * SEQ + kt * 32 + 4 * hh;
            s16x4 vlo[2][2], vhi[2][2];
#pragma unroll
            for (int mb = 0; mb < 2; ++mb)
#pragma unroll
                for (int ks = 0; ks < 2; ++ks) { vlo[mb][ks] = *(const s16x4*)(vp + (size_t)mb * 32 * SEQ + 16 * ks); vhi[mb][ks] = *(const s16x4*)(vp + (size_t)mb * 32 * SEQ + 16 * ks + 8); }
            f32x16 z;
#pragma unroll
            for (int i = 0; i < 16; ++i) z[i] = 0.f;
#pragma unroll
            for (int ks = 0; ks < 4; ++ks) z = MFMA32(kf[ks], qf[ks], z);
            const bool diag = (kt == qt);
            float lk[16], lo[16], tot = 0.f;
#pragma unroll
            for (int i = 0; i < 16; ++i) { const bool valid = !diag || (crow(i, hh) < r);
                const float sp = fsoftplus(z[i]); lk[i] = valid ? -sp : 0.0f; z[i] = valid ? z[i] - sp : -1.0e30f;
                tot += lk[i];
                const float hi = bflo(f2bf(lk[i])); lo[i] = lk[i] - hi; lk[i] = hi; }
            tot += __shfl_xor(tot, 32);
            f32x16 lat;
#pragma unroll
            for (int i = 0; i < 16; ++i) lat[i] = L;
#pragma unroll
            for (int s = 0; s < 2; ++s) {
                lat = MFMA32(tri[s], pack8v(lk[8 * s], lk[8 * s + 1], lk[8 * s + 2], lk[8 * s + 3], lk[8 * s + 4], lk[8 * s + 5], lk[8 * s + 6], lk[8 * s + 7]), lat);
                lat = MFMA32(tri[s], pack8v(lo[8 * s], lo[8 * s + 1], lo[8 * s + 2], lo[8 * s + 3], lo[8 * s + 4], lo[8 * s + 5], lo[8 * s + 6], lo[8 * s + 7]), lat); }
            float at[16];
#pragma unroll
            for (int i = 0; i < 16; ++i) at[i] = fexp(z[i] + lat[i]);
#pragma unroll
            for (int s = 0; s < 2; ++s) { const bf16x8 ab = pack8v(at[8 * s], at[8 * s + 1], at[8 * s + 2], at[8 * s + 3], at[8 * s + 4], at[8 * s + 5], at[8 * s + 6], at[8 * s + 7]);
                bf16x8 va, vb;
#pragma unroll
                for (int e = 0; e < 4; ++e) { va[e] = vlo[0][s][e]; va[4 + e] = vhi[0][s][e]; vb[e] = vlo[1][s][e]; vb[4 + e] = vhi[1][s][e]; }
                o0 = MFMA32(va, ab, o0); o1 = MFMA32(vb, ab, o1); }
            L += tot;
            if (__all(L < SB_STOP)) break;
        }
        bf16* op = YSB + (size_t)(b * SEQ + qt * 32 + r) * BW + h * HD + 4 * hh;
#pragma unroll
        for (int g = 0; g < 4; ++g) { u32x2 w0, w1; w0.x = pk2(o0[4 * g], o0[4 * g + 1]); w0.y = pk2(o0[4 * g + 2], o0[4 * g + 3]); w1.x = pk2(o1[4 * g], o1[4 * g + 1]); w1.y = pk2(o1[4 * g + 2], o1[4 * g + 3]);
            *(u32x2*)(op + 8 * g) = w0; *(u32x2*)(op + 32 + 8 * g) = w1; }
    }
}

DI void p3_prep(const Frame& F0, ARef A, const bf16* RWRAW, const bf16* LORA, bf16* R, bf16* KS, bf16* V, bf16* KK, bf16* ALORA) {
    Frame F = F0; F.tid = opq_tid(); F.lane = F.tid & 63; F.wave = __builtin_amdgcn_readfirstlane(F.tid >> 6); F.gw = F.wg * NWAVES + F.wave;
    const int lane = F.lane;
    for (int n = F.gw; n < NTOK; n += F.NGW) {
        const bool first = (n & (SEQ - 1)) == 0;
        float xs[3][8];
#pragma unroll
        for (int part = 0; part < 3; ++part) { const int col = part * 512 + lane * 8;
            float p[8], q[8]; unpack8(*(const u32x4*)(RWRAW + (size_t)n * 1536 + col), p);
            if (!first) unpack8(*(const u32x4*)(RWRAW + (size_t)(n - 1) * 1536 + col), q); else {
#pragma unroll
                for (int j = 0; j < 8; ++j) q[j] = 0.f; }
            const f32x4 m0 = *(const f32x4*)(A.shift_mu + col), m1 = *(const f32x4*)(A.shift_mu + col + 4);
#pragma unroll
            for (int j = 0; j < 4; ++j) { xs[part][j] = p[j] + m0[j] * (q[j] - p[j]); xs[part][4 + j] = p[4 + j] + m1[j] * (q[4 + j] - p[4 + j]); } }
        const size_t off = (size_t)n * BW + lane * 8;
        *(u32x4*)(R + off) = pack8(xs[0]); *(u32x4*)(KS + off) = pack8(xs[1]); *(u32x4*)(V + off) = pack8(xs[2]);
        float kk[8], ss = 0.f;
        { const f32x4 c0 = *(const f32x4*)(A.k_k + lane * 8), c1 = *(const f32x4*)(A.k_k + lane * 8 + 4);
#pragma unroll
            for (int j = 0; j < 4; ++j) { kk[j] = xs[1][j] * c0[j]; kk[4 + j] = xs[1][4 + j] * c1[j]; }
#pragma unroll
            for (int j = 0; j < 8; ++j) ss += kk[j] * kk[j]; }
        ss += __shfl_xor(ss, 1); ss += __shfl_xor(ss, 2); ss += __shfl_xor(ss, 4);
        const float rn = 1.0f / fmaxf(sqrtf(ss), L2_EPS);
#pragma unroll
        for (int j = 0; j < 8; ++j) kk[j] *= rn;
        *(u32x4*)(KK + off) = pack8(kk);
        if (lane < 48) { float a[8];
            if (lane < 36) { const int col = lane * 8; float p[8], q[8]; unpack8(*(const u32x4*)(LORA + (size_t)n * BW + col), p);
                if (!first) unpack8(*(const u32x4*)(LORA + (size_t)(n - 1) * BW + col), q); else {
#pragma unroll
                    for (int j = 0; j < 8; ++j) q[j] = 0.f; }
                const f32x4 m0 = *(const f32x4*)(A.shift_mu + 1536 + col), m1 = *(const f32x4*)(A.shift_mu + 1536 + col + 4);
#pragma unroll
                for (int j = 0; j < 8; ++j) { const float mu = j < 4 ? m0[j & 3] : m1[j & 3]; const float v = p[j] + mu * (q[j] - p[j]);
                    a[j] = lane < 8 ? (1.0f - 2.0f * frcp(fexp(2.0f * v) + 1.0f)) : (lane < 16 ? v : fsigmoid(v)); }
            } else {
#pragma unroll
                for (int j = 0; j < 8; ++j) a[j] = 0.f; }
            *(u32x4*)(ALORA + (size_t)n * LK + lane * 8) = pack8(a); }
    }
}

DI void p5_scan(const Frame& F0, const bf16* R, const bf16* KP, const bf16* V, const bf16* KK, const bf16* Bv, const bf16* Ev, bf16* P, bf16* QO, bf16* GT, float* HT) {
    Frame F = F0; F.tid = opq_tid(); F.lane = F.tid & 63; F.wave = __builtin_amdgcn_readfirstlane(F.tid >> 6); F.gw = F.wg * NWAVES + F.wave;
    const int lane = F.lane;
    LAS float* sl = (LAS float*)(F.lds + F.wave * 16384);
    for (int cid = F.gw; cid < NCHUNK; cid += F.NGW) {
        const int bh = cid >> 6, c = cid & 63, b = bh >> 3, h = bh & 7;
        const unsigned n0 = (unsigned)b * SEQ + (unsigned)c * CH; const int col0 = h * HD;
        float Gs[64], Hs[64];
        int ln = lane; asm volatile("" : "+v"(ln));
#pragma unroll
        for (int k = 0; k < 64; ++k) { Gs[k] = (k == ln) ? 1.0f : 0.0f; Hs[k] = 0.0f; }
        for (int sb = 0; sb < CH / 8; ++sb) {
            { const int s = lane >> 3, k8 = (lane & 7) * 8; const unsigned off = (n0 + sb * 8 + s) * BW + col0 + k8;
                float t[8]; LAS float* d = sl + s * 320 + k8;
                unpack8(*(const u32x4*)(KK + off), t);
#pragma unroll
                for (int j = 0; j < 8; ++j) d[j] = -t[j];
                unpack8(*(const u32x4*)(Bv + off), t);
#pragma unroll
                for (int j = 0; j < 8; ++j) d[64 + j] = t[j];
                unpack8(*(const u32x4*)(Ev + off), t);
#pragma unroll
                for (int j = 0; j < 8; ++j) d[128 + j] = fexp(-t[j]);
                unpack8(*(const u32x4*)(KP + off), t);
#pragma unroll
                for (int j = 0; j < 8; ++j) d[192 + j] = t[j];
                unpack8(*(const u32x4*)(R + off), t);
#pragma unroll
                for (int j = 0; j < 8; ++j) d[256 + j] = t[j]; }
            wave_lds_fence();
            for (int s = 0; s < 8; ++s) {
                const unsigned n = n0 + sb * 8 + s;
                const float vt = bf2f(V[n * BW + col0 + lane]);
                const LAS f32x4* pa = (const LAS f32x4*)(sl + s * 320);
                float ga0 = 0.f, ga1 = 0.f, ha0 = 0.f, ha1 = 0.f;
#pragma unroll
                for (int k4 = 0; k4 < 16; ++k4) { const f32x4 a4 = pa[k4];
                    ga0 += Gs[4 * k4] * a4[0]; ga1 += Gs[4 * k4 + 1] * a4[1]; ga0 += Gs[4 * k4 + 2] * a4[2]; ga1 += Gs[4 * k4 + 3] * a4[3];
                    ha0 += Hs[4 * k4] * a4[0]; ha1 += Hs[4 * k4 + 1] * a4[1]; ha0 += Hs[4 * k4 + 2] * a4[2]; ha1 += Hs[4 * k4 + 3] * a4[3];
                    if ((k4 & 3) == 3) __builtin_amdgcn_sched_barrier(0); }
                const float ga = ga0 + ga1, ha = ha0 + ha1;
                float p0 = 0.f, p1 = 0.f, q0 = 0.f, q1 = 0.f;
#pragma unroll
                for (int k4 = 0; k4 < 16; ++k4) { const f32x4 b4 = pa[16 + k4], d4 = pa[32 + k4], kv = pa[48 + k4], r4 = pa[64 + k4];
#pragma unroll
                    for (int q = 0; q < 4; ++q) { const int k = 4 * k4 + q;
                        Gs[k] = Gs[k] * d4[q] + ga * b4[q];
                        Hs[k] = Hs[k] * d4[q] + (ha * b4[q] + vt * kv[q]);
                        if (q & 1) { p1 += Gs[k] * r4[q]; q1 += Hs[k] * r4[q]; } else { p0 += Gs[k] * r4[q]; q0 += Hs[k] * r4[q]; } }
                    if (k4 & 1) __builtin_amdgcn_sched_barrier(0); }
                P[n * BW + col0 + lane] = (bf16)f2bf(p0 + p1);
                QO[n * BW + col0 + lane] = (bf16)f2bf(q0 + q1);
            }
            wave_lds_fence();
        }
        bf16* gt = GT + (size_t)cid * 4096; float* ht = HT + (size_t)cid * 4096;
#pragma unroll
        for (int k = 0; k < 64; ++k) { gt[k * 64 + ln] = (bf16)f2bf(Gs[k]); ht[k * 64 + ln] = Hs[k]; }
    }
}

DI void p6_chain(int task, const bf16* GT, const float* HT, float* SC) {
    const int lane = opq_tid() & 63;
    const int bh = task >> 1, nb = task & 1, r = lane & 31, hh = lane >> 5, i = nb * 32 + r;
    f32x16 X[2];
#pragma unroll
    for (int q = 0; q < 16; ++q) { X[0][q] = 0.f; X[1][q] = 0.f; }
    for (int c = 0; c < NCH; ++c) {
        const size_t cid = (size_t)bh * NCH + c;
        float* sc = SC + cid * 4096;
#pragma unroll
        for (int jb = 0; jb < 2; ++jb)
#pragma unroll
            for (int q = 0; q < 16; ++q) sc[(jb * 32 + crow(q, hh)) * 64 + i] = X[jb][q];
        if (c == NCH - 1) break;
        const bf16* gt = GT + cid * 4096; const float* ht = HT + cid * 4096;
        f32x16 Y[2];
#pragma unroll
        for (int kb = 0; kb < 2; ++kb)
#pragma unroll
            for (int q = 0; q < 16; ++q) Y[kb][q] = ht[(kb * 32 + crow(q, hh)) * 64 + i];
        bf16x8 xb[2][2];
#pragma unroll
        for (int jb = 0; jb < 2; ++jb)
#pragma unroll
            for (int s = 0; s < 2; ++s) xb[jb][s] = pack8v(X[jb][8 * s], X[jb][8 * s + 1], X[jb][8 * s + 2], X[jb][8 * s + 3], X[jb][8 * s + 4], X[jb][8 * s + 5], X[jb][8 * s + 6], X[jb][8 * s + 7]);
#pragma unroll
        for (int kb = 0; kb < 2; ++kb)
#pragma unroll
            for (int jb = 0; jb < 2; ++jb)
#pragma unroll
                for (int s = 0; s < 2; ++s) { const bf16* gp = gt + (kb * 32 + r) * 64 + jb * 32 + 16 * s + 4 * hh;
                    const s16x4 lo = *(const s16x4*)gp, hi = *(const s16x4*)(gp + 8); bf16x8 af;
#pragma unroll
                    for (int e = 0; e < 4; ++e) { af[e] = lo[e]; af[4 + e] = hi[e]; }
                    Y[kb] = MFMA32(af, xb[jb][s], Y[kb]); }
        X[0] = Y[0]; X[1] = Y[1];
    }
}

DI void p6_moe_weights(const Frame& F0, ARef A, int wi, int NW) {
    Frame F = F0; F.tid = opq_tid(); F.lane = F.tid & 63; F.wave = __builtin_amdgcn_readfirstlane(F.tid >> 6); F.gw = F.wg * NWAVES + F.wave;
    LAS float* scr = (LAS float*)(F.lds + F.wave * 8704);
    constexpr int I_UP = NE * 32 * 16, I_DN = NE * 32 * 8;
    for (int it = wi; it < I_UP + I_DN; it += NW) {
        if (it < I_UP) { const int e = it >> 9, g = (it >> 4) & 31, kb = it & 15; tr_item_up(A.w_up1, A.w_up3, (bf16*)(A.ws + WS_WUP), e, 64 * kb, 32 * g, scr, F.lane); }
        else { const int r = it - I_UP, e = r >> 8, g = (r >> 3) & 31, kb = r & 7;
            tr_item(A.w_down + (size_t)e * DE * D, D, DE, (bf16*)(A.ws + WS_WDN) + (size_t)e * 1024 * DE, 64 * kb, 32 * g, 32 * g, scr, F.lane); }
    }
}

DI void p7_out(const Frame& F0, ARef A, const float* SC, const bf16* P, const bf16* QO, const bf16* R, const bf16* KP, const bf16* V, const bf16* GG, bf16* YRW) {
    Frame F = F0; F.tid = opq_tid(); F.lane = F.tid & 63; F.wave = __builtin_amdgcn_readfirstlane(F.tid >> 6); F.gw = F.wg * NWAVES + F.wave;
    const int lane = F.lane;
    LAS float* sl = (LAS float*)(F.lds + F.wave * 16384);
    for (int cid = F.gw; cid < NCHUNK; cid += F.NGW) {
        const int bh = cid >> 6, c = cid & 63, b = bh >> 3, h = bh & 7;
        const unsigned n0 = (unsigned)b * SEQ + (unsigned)c * CH; const int col0 = h * HD;
        float S[64];
        { const float* sc = SC + (size_t)cid * 4096;
#pragma unroll
            for (int j = 0; j < 64; ++j) S[j] = sc[j * 64 + lane]; }
        const float lw = A.lnx_w[col0 + lane], lb = A.lnx_b[col0 + lane], rk = A.r_k[col0 + lane];
        for (int sb = 0; sb < CH / 32; ++sb) {
#pragma unroll
            for (int ps = 0; ps < 4; ++ps) { const int s = ps * 8 + (lane >> 3), k8 = (lane & 7) * 8; float t[8];
                unpack8(*(const u32x4*)(P + (n0 + sb * 32 + s) * BW + col0 + k8), t);
#pragma unroll
                for (int j = 0; j < 8; ++j) sl[s * 64 + k8 + j] = t[j]; }
            wave_lds_fence();
            for (int s = 0; s < 32; ++s) {
                const unsigned o = (n0 + sb * 32 + s) * BW + col0 + lane;
                float y0 = bf2f(QO[o]), y1 = 0.f;
                const LAS f32x4* pp = (const LAS f32x4*)(sl + s * 64);
#pragma unroll
                for (int k4 = 0; k4 < 16; ++k4) { const f32x4 p4 = pp[k4]; y0 += S[4 * k4] * p4[0]; y1 += S[4 * k4 + 1] * p4[1]; y0 += S[4 * k4 + 2] * p4[2]; y1 += S[4 * k4 + 3] * p4[3]; }
                const float y = y0 + y1;
                const float mean = wave_sum(y) * (1.0f / 64.0f), dv = y - mean, var = wave_sum(dv * dv) * (1.0f / 64.0f);
                const float yn = dv * rsqrtf(var + GN_EPS) * lw + lb;
                const float vv = bf2f(V[o]);
                const float bonus = wave_sum(bf2f(R[o]) * bf2f(KP[o]) * rk) * vv;
                YRW[o] = (bf16)f2bf((yn + bonus) * bf2f(GG[o]));
            }
            wave_lds_fence();
        }
    }
}

DI void p10_rows(const Frame& F0, ARef A, const bf16* Y1, bf16* H2) {
    Frame F = F0; F.tid = opq_tid(); F.lane = F.tid & 63; F.wave = __builtin_amdgcn_readfirstlane(F.tid >> 6); F.gw = F.wg * NWAVES + F.wave;
    const int lane = F.lane;
    const float* mod = (const float*)(A.ws + WS_MOD);
    LAS float* rw = (LAS float*)F.lds;
    LAS int* hist = (LAS int*)(F.lds + 147456);
    { const f32x4* src = (const f32x4*)(A.ws + WS_RTW); LAS f32x4* dst = (LAS f32x4*)F.lds;
        for (int i = F.tid; i < 36 * D / 4; i += NTHR) dst[i] = src[i]; }
    i32x4* tok = (i32x4*)(A.ws + WS_TOK); int* cnt = (int*)(A.ws + WS_CNT);
    for (int tb = F.wg; tb < NTOK / 128; tb += F.G) {
        if (F.tid < 32) hist[F.tid] = 0;
        __syncthreads();
        for (int tl = F.wave; tl < 128; tl += NWAVES) {
            const int n = tb * 128 + tl, b = n >> 13;
            const f32x4* xr = (const f32x4*)(A.x + (size_t)n * D) + lane; const u32x2* yr = (const u32x2*)(Y1 + (size_t)n * D) + lane;
            f32x4 xv[4], yv[4]; float s = 0.f;
#pragma unroll
            for (int j = 0; j < 4; ++j) { xv[j] = xr[64 * j]; const u32x2 w = yr[64 * j]; yv[j][0] = bflo(w.x); yv[j][1] = bfhi(w.x); yv[j][2] = bflo(w.y); yv[j][3] = bfhi(w.y);
                s += (yv[j][0] * yv[j][0] + yv[j][1] * yv[j][1]) + (yv[j][2] * yv[j][2] + yv[j][3] * yv[j][3]); }
            const float inv1 = rsqrtf(wave_sum(s) * (1.0f / D) + NORM_EPS);
            float s2 = 0.f;
#pragma unroll
            for (int j = 0; j < 4; ++j) { const int k = 4 * lane + 256 * j;
                const f32x4 g1 = *(const f32x4*)(A.gains + D + k), gt = *(const f32x4*)(mod + b * 6144 + 2 * D + k);
#pragma unroll
                for (int q = 0; q < 4; ++q) { xv[j][q] = xv[j][q] + gt[q] * ((yv[j][q] * inv1) * g1[q]); s2 += xv[j][q] * xv[j][q]; }
                *((f32x4*)(A.out + (size_t)n * D) + lane + 64 * j) = xv[j]; }
            const float inv2 = rsqrtf(wave_sum(s2) * (1.0f / D) + NORM_EPS);
            f32x4 hv[4];
#pragma unroll
            for (int j = 0; j < 4; ++j) { const int k = 4 * lane + 256 * j;
                const f32x4 g2 = *(const f32x4*)(A.gains + 2 * D + k), sh = *(const f32x4*)(mod + b * 6144 + 3 * D + k), sc = *(const f32x4*)(mod + b * 6144 + 4 * D + k);
#pragma unroll
                for (int q = 0; q < 4; ++q) hv[j][q] = (xv[j][q] * inv2) * g2[q] * (1.0f + sc[q]) + sh[q];
                u32x2 w; w.x = pk2(hv[j][0], hv[j][1]); w.y = pk2(hv[j][2], hv[j][3]); *((u32x2*)(H2 + (size_t)n * D) + lane + 64 * j) = w; }
            float lg[36];
#pragma unroll
            for (int o = 0; o < 36; ++o) { float a = 0.f;
#pragma unroll
                for (int j = 0; j < 4; ++j) { const f32x4 w = *(const LAS f32x4*)(rw + o * D + 4 * lane + 256 * j); a += (hv[j][0] * w[0] + hv[j][1] * w[1]) + (hv[j][2] * w[2] + hv[j][3] * w[3]); }
                lg[o] = wave_sum(a); if (o & 1) __builtin_amdgcn_sched_barrier(0); }
            int gs = 0; float gm = lg[0];
#pragma unroll
            for (int g = 1; g < 4; ++g) if (lg[g] > gm) { gm = lg[g]; gs = g; }
            float gsum = 0.f;
#pragma unroll
            for (int g = 0; g < 4; ++g) gsum += fexp(lg[g] - gm);
            const float gw = 1.0f / gsum;
            float el[8];
#pragma unroll
            for (int e = 0; e < 8; ++e) el[e] = gs == 0 ? lg[4 + e] : (gs == 1 ? lg[12 + e] : (gs == 2 ? lg[20 + e] : lg[28 + e]));
            int i0 = 0; float m0 = el[0];
#pragma unroll
            for (int e = 1; e < 8; ++e) if (el[e] > m0) { m0 = el[e]; i0 = e; }
            int i1 = -1; float m1 = -3.0e38f;
#pragma unroll
            for (int e = 0; e < 8; ++e) if (e != i0 && el[e] > m1) { m1 = el[e]; i1 = e; }
            const float t = fexp(m1 - m0), p0 = 1.0f / (1.0f + t), p1 = t * p0;
            const int e0 = gs * 8 + i0, e1 = gs * 8 + i1;
#if defined(CHECKS)
            if (lane == 0 && n == DBG_TOKEN) { float* dbg = (float*)(A.ws + WS_CTL + 32768) + 48; dbg[0] = lg[0]; dbg[1] = lg[1]; dbg[2] = lg[2]; dbg[3] = lg[3]; dbg[4] = gsum; dbg[5] = p0; dbg[6] = gw; dbg[7] = t; }
#endif
            if (lane == 0) { i32x4 rec; rec.x = e0 | (e1 << 8); rec.y = 0; rec.z = 0; rec.w = 0; tok[n] = rec;
                float* cwp = (float*)(A.ws + WS_CW) + 2 * n; cwp[0] = gw * p0; cwp[1] = gw * p1;
                atomicAdd((int*)&hist[e0], 1); atomicAdd((int*)&hist[e1], 1); }
        }
        __syncthreads();
        if (F.tid < 32) cnt[tb * 32 + F.tid] = hist[F.tid];
        __syncthreads();
    }
}

DI void p11_rank_gather(const Frame& F0, ARef A, const bf16* H2, bf16* HS) {
    Frame F = F0; F.tid = opq_tid(); F.lane = F.tid & 63; F.wave = __builtin_amdgcn_readfirstlane(F.tid >> 6); F.gw = F.wg * NWAVES + F.wave;
    LAS int* base = (LAS int*)F.lds;
    LAS int* seg = base + 32;
    LAS int* el = base + 96;
    LAS int* pos = base + 352;
    i32x4* tok = (i32x4*)(A.ws + WS_TOK); const int* cnt = (const int*)(A.ws + WS_CNT); int* tile = (int*)(A.ws + WS_TILE);
    for (int tb = F.wg; tb < NTOK / 128; tb += F.G) {
        if (F.tid < 32) { int tot = 0, pre = 0;
            for (int t2 = 0; t2 < NTOK / 128; ++t2) { const int v = cnt[t2 * 32 + F.tid]; tot += v; if (t2 < tb) pre += v; }
            base[F.tid] = pre; seg[F.tid] = (tot + 255) & ~255; }
        if (F.tid >= 64 && F.tid < 64 + 128) { const i32x4 rec = tok[tb * 128 + (F.tid - 64)]; el[2 * (F.tid - 64)] = rec.x & 255; el[2 * (F.tid - 64) + 1] = (rec.x >> 8) & 255; }
        __syncthreads();
        if (F.tid == 0) { int acc = 0; for (int e = 0; e < 32; ++e) { const int sz = seg[e]; seg[e] = acc; acc += sz; } seg[32] = acc; }
        __syncthreads();
        if (F.tid < 32) { int p = seg[F.tid] + base[F.tid];
            for (int q = 0; q < 256; ++q) if (el[q] == F.tid) pos[q] = p++; }
        if (tb == 0 && F.tid >= 64 && F.tid < 64 + 32) { const int e = F.tid - 64;
            for (int t2 = seg[e] >> 8; t2 < (seg[e + 1] >> 8); ++t2) tile[t2] = e;
            if (e == 0) tile[MAXT] = seg[32] >> 8; }
        __syncthreads();
        if (F.tid < 128) { i32x4 rec = tok[tb * 128 + F.tid]; rec.x = pos[2 * F.tid]; rec.y = pos[2 * F.tid + 1]; tok[tb * 128 + F.tid] = rec; }
        for (int q = F.wave; q < 256; q += NWAVES) { const int n = tb * 128 + (q >> 1);
            const u32x4* src = (const u32x4*)(H2 + (size_t)n * D) + F.lane; u32x4* dst = (u32x4*)(HS + (size_t)pos[q] * D) + F.lane;
            dst[0] = src[0]; dst[64] = src[64]; }
        __syncthreads();
    }
}

DI void p14_final(const Frame& F0, ARef A, const bf16* YE) {
    Frame F = F0; F.tid = opq_tid(); F.lane = F.tid & 63; F.wave = __builtin_amdgcn_readfirstlane(F.tid >> 6); F.gw = F.wg * NWAVES + F.wave;
    const int lane = F.lane;
    const float* mod = (const float*)(A.ws + WS_MOD); const i32x4* tok = (const i32x4*)(A.ws + WS_TOK);
    for (int n = F.gw; n < NTOK; n += F.NGW) {
        const int b = n >> 13; const i32x4 rec = tok[n];
        const float c0 = ((const float*)(A.ws + WS_CW))[2 * n], c1 = ((const float*)(A.ws + WS_CW))[2 * n + 1];
        const u32x2* y0 = (const u32x2*)(YE + (size_t)rec.x * D) + lane; const u32x2* y1 = (const u32x2*)(YE + (size_t)rec.y * D) + lane;
        f32x4 yv[4]; float s = 0.f;
#pragma unroll
        for (int j = 0; j < 4; ++j) { const u32x2 a = y0[64 * j], bq = y1[64 * j];
            yv[j][0] = c0 * bflo(a.x) + c1 * bflo(bq.x); yv[j][1] = c0 * bfhi(a.x) + c1 * bfhi(bq.x); yv[j][2] = c0 * bflo(a.y) + c1 * bflo(bq.y); yv[j][3] = c0 * bfhi(a.y) + c1 * bfhi(bq.y);
            s += (yv[j][0] * yv[j][0] + yv[j][1] * yv[j][1]) + (yv[j][2] * yv[j][2] + yv[j][3] * yv[j][3]); }
        const float inv = rsqrtf(wave_sum(s) * (1.0f / D) + NORM_EPS);
#pragma unroll
        for (int j = 0; j < 4; ++j) { const int k = 4 * lane + 256 * j;
            const f32x4 g3 = *(const f32x4*)(A.gains + 3 * D + k), gt = *(const f32x4*)(mod + b * 6144 + 5 * D + k);
            f32x4* op = (f32x4*)(A.out + (size_t)n * D) + lane + 64 * j; f32x4 xv = *op;
#pragma unroll
            for (int q = 0; q < 4; ++q) xv[q] = xv[q] + gt[q] * ((yv[j][q] * inv) * g3[q]);
            *op = xv; }
    }
}

#if defined(CHECKS)
constexpr size_t WS_FLG = WS_CTL + 32768;
DI unsigned* chk_flags(unsigned char* ws) { return (unsigned*)(ws + WS_FLG); }
DI void chk(unsigned char* ws, int id, float got, float want, float rel, float ab) {
    const float d = fabsf(got - want), lim = rel * fmaxf(fabsf(got), fabsf(want)) + ab;
    if (!(d <= lim)) chk_flags(ws)[id] = 1u; }
DI unsigned hsh(unsigned a) { a ^= a >> 16; a *= 0x7feb352du; a ^= a >> 15; a *= 0x846ca68bu; a ^= a >> 16; return a; }
DI float bfr(float v) { return bflo(f2bf(v)); }
DI int scol_of(int n) { return n < 3360 ? n : (n < 3584 ? -1 : n - 224); }

DI void chk_p0(const Frame& F, ARef A) {
    unsigned char* ws = A.ws; const int lane = F.lane;
    const float* mod = (const float*)(ws + WS_MOD);
    for (int s = F.wave; s < 32; s += NWAVES) { const unsigned hh = hsh(1000 + s); const int b = hh & 3, o = (hh >> 2) % 6144; float a = 0.f;
        for (int k = lane; k < D; k += 64) { const float c = A.c[b * D + k]; a += (c / (1.0f + expf(-c))) * A.w_mod[(size_t)k * 6144 + o]; }
        a = wave_sum(a) + A.b_mod[o]; chk(ws, 10, mod[b * 6144 + o], a, 1e-3f, 1e-4f); }
    const bf16* wt = (const bf16*)(ws + WS_WIN);
    for (int s = 0; s < 8; ++s) { const unsigned hh = hsh(2000 + (F.wave * 8 + s) * 64 + lane); const int n = hh % NPAD, k = (hh >> 13) & 1023; const int sc = scol_of(n);
        const float want = sc >= 0 ? bfr(A.w_in[(size_t)k * IN_COLS + sc]) : 0.f; chk(ws, 11, bf2f(wt[(size_t)n * D + k]), want, 0.f, 0.f); }
    { const unsigned hh = hsh(3000 + F.wave * 64 + lane); const int n = hh & 1023, k = (hh >> 10) & 511, k2 = (hh >> 10) & 1023;
        chk(ws, 11, bf2f(((const bf16*)(ws + WS_WOSB))[n * BW + k]), bfr(A.w_o_sb[k * D + n]), 0.f, 0.f);
        chk(ws, 11, bf2f(((const bf16*)(ws + WS_WORW))[n * BW + k]), bfr(A.w_o_rw[k * D + n]), 0.f, 0.f);
        chk(ws, 11, bf2f(((const bf16*)(ws + WS_WOUT))[n * D + k2]), bfr(A.w_out[k2 * D + n]), 0.f, 0.f);
        const int o = hh % 36; chk(ws, 11, ((const float*)(ws + WS_RTW))[o * D + k2], o < 4 ? A.w_group[k2 * 4 + o] : A.w_router[k2 * NE + o - 4], 0.f, 0.f);
        const int nl = hh % 1536, kl = (hh >> 11) % LK; float v = 0.f;
        if (nl < 512) { if (kl < 64) v = A.w_decay_up[kl * BW + nl]; } else if (nl < 1024) { if (kl >= 64 && kl < 128) v = A.w_iclr_up[(kl - 64) * BW + nl - 512]; } else { if (kl >= 128 && kl < 288) v = A.w_gate_up[(kl - 128) * BW + nl - 1024]; }
        chk(ws, 11, bf2f(((const bf16*)(ws + WS_WL))[nl * LK + kl]), bfr(v), 0.f, 0.f); }
}
DI void chk_p1(const Frame& F, ARef A, const bf16* H1) {
    unsigned char* ws = A.ws; const int lane = F.lane; const float* mod = (const float*)(ws + WS_MOD);
    for (int s = F.wave; s < 16; s += NWAVES) { const int n = hsh(4000 + s) % NTOK, b = n >> 13; float ss = 0.f;
        for (int k = lane; k < D; k += 64) { const float v = A.x[(size_t)n * D + k]; ss += v * v; }
        const float inv = 1.0f / sqrtf(wave_sum(ss) / D + NORM_EPS);
        for (int k = lane; k < D; k += 64) { const float want = (A.x[(size_t)n * D + k] * inv) * A.gains[k] * (1.0f + mod[b * 6144 + D + k]) + mod[b * 6144 + k];
            chk(ws, 12, bf2f(H1[(size_t)n * D + k]), want, 0.01f, 0.01f); } }
}
DI float wdot(const bf16* arow, const float* W, int ldw, int col, int K, int lane) { float a = 0.f; for (int k = lane; k < K; k += 64) a += bf2f(arow[k]) * W[(size_t)k * ldw + col]; return wave_sum(a); }
DI void chk_p2(const Frame& F, ARef A, const bf16* H1) {
    unsigned char* ws = A.ws; const int lane = F.lane;
    for (int s = F.wave; s < 96; s += NWAVES) { const unsigned hh = hsh(5000 + s); const int n = hh % NTOK, region = s % 6; int col;
        const unsigned h2 = hsh(hh);
        float got, want; int id = 13 + region;
        if (region == 0) { col = h2 % 512; want = 0.125f * wdot(H1 + (size_t)n * D, A.w_in, IN_COLS, col, D, lane); got = bf2f(((const bf16*)(ws + WS_QB))[(size_t)n * BW + col]); }
        else if (region == 1) { col = h2 % 512; want = wdot(H1 + (size_t)n * D, A.w_in, IN_COLS, 512 + col, D, lane); got = bf2f(((const bf16*)(ws + WS_KB))[(size_t)n * BW + col]); }
        else if (region == 2) { col = h2 % 512; want = wdot(H1 + (size_t)n * D, A.w_in, IN_COLS, 1024 + col, D, lane); got = bf2f(((const bf16*)(ws + WS_VT))[((size_t)((n >> 13) * BW + col)) * SEQ + (n & (SEQ - 1))]); }
        else if (region == 3) { col = h2 % 1536; want = wdot(H1 + (size_t)n * D, A.w_in, IN_COLS, 1536 + col, D, lane); got = bf2f(((const bf16*)(ws + WS_RWRAW))[(size_t)n * 1536 + col]); }
        else if (region == 4) { col = h2 % 288; want = wdot(H1 + (size_t)n * D, A.w_in, IN_COLS, 3072 + col, D, lane); got = bf2f(((const bf16*)(ws + WS_LORA))[(size_t)n * BW + col]); }
        else { col = h2 % 2048; want = wdot(H1 + (size_t)n * D, A.w_in, IN_COLS, 3360 + col, D, lane) + A.gate_bias[col]; want = 1.0f / (1.0f + expf(-want)); got = bf2f(((const bf16*)(ws + WS_GATE))[(size_t)n * 2048 + col]); }
        chk(ws, id, got, want, 0.03f, 0.02f); }
}
constexpr int NATT = 16;
DI void att_sample(int s, int& b, int& h, int& t) { const unsigned hh = hsh(6000 + s); b = hh & 3; h = (hh >> 2) & 7; t = (s < 4) ? (s * 37) : (int)((hh >> 5) % SEQ); }
DI void chk_p3_save(const Frame& F, ARef A) {
    if (F.wave == 0) { bf16* sv = (bf16*)(A.ws + WS_FLG + 4096);
        for (int s = 0; s < NATT; ++s) { int b, h, t; att_sample(s, b, h, t); sv[s * 64 + F.lane] = ((const bf16*)(A.ws + WS_QB))[(size_t)(b * SEQ + t) * BW + h * HD + F.lane]; } }
}
DI void chk_p3(const Frame& F, ARef A, const bf16* R, const bf16* KS, const bf16* V, const bf16* KK) {
    unsigned char* ws = A.ws; const int lane = F.lane;
    const bf16* sv = (const bf16*)(ws + WS_FLG + 4096); const bf16* KB = (const bf16*)(ws + WS_KB); const bf16* VT = (const bf16*)(ws + WS_VT);
    for (int s = F.wave; s < NATT; s += NWAVES) { int b, h, t; att_sample(s, b, h, t);
        const float q = bf2f(sv[s * 64 + lane]); float later = 0.f, o = 0.f;
        for (int k = t - 1; k >= 0; --k) { const float z = wave_sum(q * bf2f(KB[(size_t)(b * SEQ + k) * BW + h * HD + lane]));
            const float sp = fmaxf(z, 0.f) + log1pf(expf(-fabsf(z)));
            o += expf(z - sp + later) * bf2f(VT[((size_t)((b * NH + h) * HD + lane)) * SEQ + k]);
            later -= sp; if (later < -200.f) break; }
        chk(ws, 19, bf2f(((const bf16*)(ws + WS_QB))[(size_t)(b * SEQ + t) * BW + h * HD + lane]), o, 0.04f, 0.02f); }
    const bf16* RW = (const bf16*)(ws + WS_RWRAW); const bf16* LO = (const bf16*)(ws + WS_LORA); const bf16* AL = (const bf16*)(ws + WS_ALORA);
    for (int s = F.wave; s < 32; s += NWAVES) { const unsigned hh = hsh(7000 + s); const int n = (s < 4) ? s * SEQ : (int)(hh % NTOK), hd = (hh >> 16) & 7; const bool first = (n & (SEQ - 1)) == 0;
        float xs[3];
        for (int p = 0; p < 3; ++p) { const int col = p * 512 + hd * 64 + lane; const float cur = bf2f(RW[(size_t)n * 1536 + col]), prv = first ? 0.f : bf2f(RW[(size_t)(n - 1) * 1536 + col]); xs[p] = cur + A.shift_mu[col] * (prv - cur); }
        const size_t o = (size_t)n * BW + hd * 64 + lane;
        chk(ws, 20, bf2f(R[o]), xs[0], 0.01f, 0.005f); chk(ws, 20, bf2f(KS[o]), xs[1], 0.01f, 0.005f); chk(ws, 20, bf2f(V[o]), xs[2], 0.01f, 0.005f);
        const float kk = xs[1] * A.k_k[hd * 64 + lane]; const float nn = sqrtf(wave_sum(kk * kk));
        chk(ws, 20, bf2f(KK[o]), kk / fmaxf(nn, L2_EPS), 0.01f, 0.002f);
        for (int c = lane; c < LK; c += 64) { float want = 0.f;
            if (c < 288) { const float cur = bf2f(LO[(size_t)n * BW + c]), prv = first ? 0.f : bf2f(LO[(size_t)(n - 1) * BW + c]); const float v = cur + A.shift_mu[1536 + c] * (prv - cur);
                want = c < 64 ? tanhf(v) : (c < 128 ? v : 1.0f / (1.0f + expf(-v))); }
            chk(ws, 20, bf2f(AL[(size_t)n * LK + c]), want, 0.01f, 0.005f); } }
}
DI void chk_p4_save(const Frame& F, ARef A, const bf16* KS) {
    if (F.wave == 0) { bf16* sv = (bf16*)(A.ws + WS_FLG + 8192);
        for (int s = 0; s < 16; ++s) { const unsigned hh = hsh(8000 + s); const int n = hh % NTOK, hd = (hh >> 16) & 7; sv[s * 64 + F.lane] = KS[(size_t)n * BW + hd * 64 + F.lane]; } }
}
DI void chk_p4(const Frame& F, ARef A, const bf16* KP, const bf16* KK) {
    unsigned char* ws = A.ws; const int lane = F.lane; const bf16* AL = (const bf16*)(ws + WS_ALORA); const bf16* sv = (const bf16*)(ws + WS_FLG + 8192);
    for (int s = F.wave; s < 16; s += NWAVES) { const unsigned hh = hsh(8000 + s); const int n = hh % NTOK, hd = (hh >> 16) & 7, c = hd * 64 + lane; const size_t o = (size_t)n * BW + c;
        float lw = 0.f, la = 0.f, lg = 0.f;
        for (int k = 0; k < 64; ++k) { lw += bf2f(AL[(size_t)n * LK + k]) * A.w_decay_up[k * BW + c]; la += bf2f(AL[(size_t)n * LK + 64 + k]) * A.w_iclr_up[k * BW + c]; }
        for (int k = 0; k < 160; ++k) lg += bf2f(AL[(size_t)n * LK + 128 + k]) * A.w_gate_up[k * BW + c];
        const float x = -(A.w0[c] + lw), w = -(fmaxf(x, 0.f) + log1pf(expf(-fabsf(x)))) - 0.5f;
        chk(ws, 21, bf2f(((const bf16*)(ws + WS_E))[o]), expf(w), 0.03f, 0.003f);
        const float a = 1.0f / (1.0f + expf(-(A.a0[c] + la))); const float ks = bf2f(sv[s * 64 + lane]);
        chk(ws, 22, bf2f(KP[o]), ks * (1.0f + (a - 1.0f) * A.k_a[c]), 0.03f, 0.01f);
        chk(ws, 22, bf2f(((const bf16*)(ws + WS_B))[o]), bf2f(KK[o]) * a, 0.03f, 0.003f);
        chk(ws, 23, bf2f(((const bf16*)(ws + WS_GG))[o]), lg, 0.03f, 0.01f); }
}
constexpr int NST = 300;
DI void chk_p7_save(const Frame& F, ARef A) {
    if (F.wave < 4) { const int b = (F.wave * 3) & 3, h = (F.wave * 5 + 1) & 7; bf16* sv = (bf16*)(A.ws + 400 * MiB) + F.wave * NST * 64;
        for (int t = 0; t < NST; ++t) sv[t * 64 + F.lane] = ((const bf16*)(A.ws + WS_E))[(size_t)(b * SEQ + t) * BW + h * HD + F.lane]; }
}
DI void chk_p7(const Frame& F, ARef A, const bf16* R, const bf16* KP, const bf16* V, const bf16* KK) {
    unsigned char* ws = A.ws; const int lane = F.lane;
    const bf16* Bv = (const bf16*)(ws + WS_B); const bf16* Esv = (const bf16*)(ws + 400 * MiB) + F.wave * NST * 64; const bf16* GG = (const bf16*)(ws + WS_GG); const bf16* YRW = (const bf16*)(ws + WS_YRW);
    if (F.wave < 4) { const int b = (F.wave * 3) & 3, h = (F.wave * 5 + 1) & 7, col0 = h * HD;
        float S[64];
#pragma unroll
        for (int k = 0; k < 64; ++k) S[k] = 0.f;
        for (int t = 0; t < NST; ++t) { const size_t o = (size_t)(b * SEQ + t) * BW + col0 + lane;
            const float av = -bf2f(KK[o]), bv = bf2f(Bv[o]), dv = expf(-bf2f(Esv[t * 64 + lane])), kv = bf2f(KP[o]), rv = bf2f(R[o]), vv = bf2f(V[o]);
            float sa = 0.f;
#pragma unroll
            for (int k = 0; k < 64; ++k) sa += S[k] * __shfl(av, k);
            float y = 0.f;
#pragma unroll
            for (int k = 0; k < 64; ++k) { S[k] = S[k] * __shfl(dv, k) + sa * __shfl(bv, k) + vv * __shfl(kv, k); y += S[k] * __shfl(rv, k); }
            const float mean = wave_sum(y) / 64.f, d = y - mean, var = wave_sum(d * d) / 64.f;
            const float yn = d / sqrtf(var + GN_EPS) * A.lnx_w[col0 + lane] + A.lnx_b[col0 + lane];
            const float bonus = wave_sum(rv * kv * A.r_k[col0 + lane]) * vv;
            const float want = (yn + bonus) * bf2f(GG[o]);
            chk(ws, t < 128 ? 24 : 25, bf2f(YRW[o]), want, 0.05f, 0.03f); } }
}
DI void chk_p8(const Frame& F, ARef A) {
    unsigned char* ws = A.ws; const int lane = F.lane;
    for (int s = F.wave; s < 32; s += NWAVES) { const unsigned hh = hsh(9000 + s); const int n = hh % NTOK, c = (hh >> 15) & 1023;
        const float p1 = wdot((const bf16*)(ws + WS_QB) + (size_t)n * BW, A.w_o_sb, D, c, BW, lane), p2 = wdot((const bf16*)(ws + WS_YRW) + (size_t)n * BW, A.w_o_rw, D, c, BW, lane);
        const bf16* ga = (const bf16*)(ws + WS_GATE) + (size_t)n * 2048;
        chk(ws, 26, bf2f(((const bf16*)(ws + WS_MRG))[(size_t)n * D + c]), bf2f(ga[c]) * p1 + bf2f(ga[1024 + c]) * p2, 0.03f, 0.01f); }
}
DI void chk_p9(const Frame& F, ARef A) {
    unsigned char* ws = A.ws; const int lane = F.lane;
    for (int s = F.wave; s < 32; s += NWAVES) { const unsigned hh = hsh(9500 + s); const int n = hh % NTOK, c = (hh >> 15) & 1023;
        chk(ws, 27, bf2f(((const bf16*)(ws + WS_Y1))[(size_t)n * D + c]), wdot((const bf16*)(ws + WS_MRG) + (size_t)n * D, A.w_out, D, c, D, lane), 0.03f, 0.01f); }
}
DI void chk_p10(const Frame& F, ARef A) {
    unsigned char* ws = A.ws; const int lane = F.lane; const float* mod = (const float*)(ws + WS_MOD);
    const bf16* Y1 = (const bf16*)(ws + WS_Y1); const bf16* H2 = (const bf16*)(ws + WS_H2); const i32x4* tok = (const i32x4*)(ws + WS_TOK);
    for (int s = F.wave; s < 32; s += NWAVES) { const int n = s == 0 ? DBG_TOKEN : (s < 16 ? (int)(hsh(10000 + s) % 128) : (int)(hsh(10000 + s) % NTOK)), b = n >> 13; float ss = 0.f;
        for (int k = lane; k < D; k += 64) { const float v = bf2f(Y1[(size_t)n * D + k]); ss += v * v; }
        const float inv1 = 1.0f / sqrtf(wave_sum(ss) / D + NORM_EPS); float s2 = 0.f;
        for (int k = lane; k < D; k += 64) { const float x1 = A.x[(size_t)n * D + k] + mod[b * 6144 + 2 * D + k] * ((bf2f(Y1[(size_t)n * D + k]) * inv1) * A.gains[D + k]);
            chk(ws, 28, A.out[(size_t)n * D + k], x1, 1e-3f, 1e-3f); s2 += x1 * x1; }
        const float inv2 = 1.0f / sqrtf(wave_sum(s2) / D + NORM_EPS);
        float lg[36];
#pragma unroll
        for (int o = 0; o < 36; ++o) lg[o] = 0.f;
        for (int k = lane; k < D; k += 64) { const float h2 = (A.out[(size_t)n * D + k] * inv2) * A.gains[2 * D + k] * (1.0f + mod[b * 6144 + 4 * D + k]) + mod[b * 6144 + 3 * D + k];
            chk(ws, 29, bf2f(H2[(size_t)n * D + k]), h2, 0.01f, 0.01f);
#pragma unroll
            for (int o = 0; o < 36; ++o) lg[o] += h2 * (o < 4 ? A.w_group[k * 4 + o] : A.w_router[k * NE + o - 4]); }
#pragma unroll
        for (int o = 0; o < 36; ++o) lg[o] = wave_sum(lg[o]);
        int gs = 0; float gm = lg[0];
#pragma unroll
        for (int g = 1; g < 4; ++g) if (lg[g] > gm) { gm = lg[g]; gs = g; }
        float gsum = 0.f;
#pragma unroll
        for (int g = 0; g < 4; ++g) gsum += expf(lg[g] - gm);
        float el[8];
#pragma unroll
        for (int e = 0; e < 8; ++e) el[e] = gs == 0 ? lg[4 + e] : (gs == 1 ? lg[12 + e] : (gs == 2 ? lg[20 + e] : lg[28 + e]));
        int i0 = 0; float m0 = el[0];
#pragma unroll
        for (int e = 1; e < 8; ++e) if (el[e] > m0) { m0 = el[e]; i0 = e; }
        int i1 = -1; float m1 = -3.0e38f;
#pragma unroll
        for (int e = 0; e < 8; ++e) if (e != i0 && el[e] > m1) { m1 = el[e]; i1 = e; }
        const float tt = expf(m1 - m0), p0 = 1.0f / (1.0f + tt);
        const i32x4 rec = tok[n];
        if (lane == 0 && s < 16) { if ((rec.x & 255) != gs * 8 + i0 || ((rec.x >> 8) & 255) != gs * 8 + i1) chk_flags(ws)[30] = 1u;
            if (n == DBG_TOKEN) { const float* dbg = (const float*)chk_flags(ws) + 48; float code = 1.f;
                if (dbg[4] > 4.001f) code += 2.f; if (dbg[5] < 0.499f) code += 4.f;
                if (fabsf(dbg[0] - lg[0]) > 1e-3f || fabsf(dbg[1] - lg[1]) > 1e-3f || fabsf(dbg[2] - lg[2]) > 1e-3f || fabsf(dbg[3] - lg[3]) > 1e-3f) code += 8.f;
                if (fabsf(dbg[4] - gsum) > 1e-3f) code += 16.f; if (fabsf(dbg[6] * dbg[5] - __builtin_bit_cast(float, rec.z)) > 1e-4f) code += 32.f;
                ((float*)chk_flags(ws))[62] = code * 0.1f; ((float*)chk_flags(ws))[63] = dbg[4]; }
            chk(ws, 56, ((const float*)(ws + WS_CW))[2 * n], p0 / gsum, 3e-2f, 1e-4f); chk(ws, 57, ((const float*)(ws + WS_CW))[2 * n + 1], tt * p0 / gsum, 3e-2f, 1e-4f);
            chk(ws, 58, ((const float*)(ws + WS_CW))[2 * n], p0 / gsum, 1e-3f, 1e-5f); chk(ws, 59, ((const float*)(ws + WS_CW))[2 * n + 1], tt * p0 / gsum, 1e-3f, 1e-5f); } }
}
DI void chk_p11(const Frame& F, ARef A) {
    unsigned char* ws = A.ws; const int lane = F.lane; const i32x4* tok = (const i32x4*)(ws + WS_TOK); const int* tile = (const int*)(ws + WS_TILE);
    const bf16* H2 = (const bf16*)(ws + WS_H2); const bf16* HS = (const bf16*)(ws + WS_HS);
    for (int s = F.wave; s < 64; s += NWAVES) { const int n = hsh(11000 + s) % NTOK; const i32x4 rec = tok[n];
        if (rec.x < 0 || rec.x >= tile[MAXT] * 256 || rec.y < 0 || rec.y >= tile[MAXT] * 256 || tile[MAXT] > MAXT || tile[MAXT] < 256) { chk_flags(ws)[32] = 1u; continue; }
        for (int k = lane; k < D; k += 64) { chk(ws, 33, bf2f(HS[(size_t)rec.x * D + k]), bf2f(H2[(size_t)n * D + k]), 0.f, 0.f); chk(ws, 33, bf2f(HS[(size_t)rec.y * D + k]), bf2f(H2[(size_t)n * D + k]), 0.f, 0.f); } }
    { const unsigned hh = hsh(12000 + F.wave * 64 + lane); const int e = hh & 31, n = (hh >> 5) & 1023, k = (hh >> 15) & 1023, k5 = k & 511;
        const int c = (n >> 3) * 4 + (n & 3); const float want = (n & 4) ? A.w_up3[((size_t)e * D + k) * DE + c] : A.w_up1[((size_t)e * D + k) * DE + c];
        chk(ws, 34, bf2f(((const bf16*)(ws + WS_WUP))[((size_t)e * 1024 + n) * D + k]), bfr(want), 0.f, 0.f);
        chk(ws, 35, bf2f(((const bf16*)(ws + WS_WDN))[((size_t)e * 1024 + n) * DE + k5]), bfr(A.w_down[((size_t)e * DE + k5) * D + n]), 0.f, 0.f); }
}
DI void chk_p12(const Frame& F, ARef A) {
    unsigned char* ws = A.ws; const int lane = F.lane; const i32x4* tok = (const i32x4*)(ws + WS_TOK); const int* tile = (const int*)(ws + WS_TILE);
    const bf16* H2 = (const bf16*)(ws + WS_H2); const bf16* HID = (const bf16*)(ws + WS_HID);
    for (int s = F.wave; s < 32; s += NWAVES) { const unsigned hh = hsh(13000 + s); const int n = hh % NTOK, c = (hh >> 16) & 511; const i32x4 rec = tok[n]; const int pos = (s & 1) ? rec.y : rec.x;
        const int e = tile[pos >> 8];
        const float u1 = wdot(H2 + (size_t)n * D, A.w_up1 + (size_t)e * D * DE, DE, c, D, lane), u3 = wdot(H2 + (size_t)n * D, A.w_up3 + (size_t)e * D * DE, DE, c, D, lane);
        chk(ws, 36, bf2f(HID[(size_t)pos * DE + c]), u1 / (1.0f + expf(-u1)) * u3, 0.04f, 0.01f); }
}
DI void chk_p13(const Frame& F, ARef A) {
    unsigned char* ws = A.ws; const int lane = F.lane; const i32x4* tok = (const i32x4*)(ws + WS_TOK); const int* tile = (const int*)(ws + WS_TILE);
    const bf16* HID = (const bf16*)(ws + WS_HID); const bf16* YE = (const bf16*)(ws + WS_HS);
    for (int s = F.wave; s < 32; s += NWAVES) { const unsigned hh = hsh(14000 + s); const int n = hh % NTOK, c = (hh >> 16) & 1023; const i32x4 rec = tok[n]; const int pos = (s & 1) ? rec.y : rec.x;
        const int e = tile[pos >> 8];
        chk(ws, 37, bf2f(YE[(size_t)pos * D + c]), wdot(HID + (size_t)pos * DE, A.w_down + (size_t)e * DE * D, D, c, DE, lane), 0.04f, 0.01f); }
}
#endif

__global__ void __launch_bounds__(NTHR, 2) hybrid_fwd(Args A_unused) {
    extern __shared__ __attribute__((aligned(16))) unsigned char lds_raw[];
    const CAS Args& A = *(const CAS Args*)__builtin_amdgcn_kernarg_segment_ptr();
    Frame F;
    F.lds = (LAS unsigned char*)lds_raw;
    F.tid = threadIdx.x; F.lane = F.tid & 63; F.wave = __builtin_amdgcn_readfirstlane(F.tid >> 6);
    F.wg = blockIdx.x; F.G = gridDim.x; F.gw = F.wg * NWAVES + F.wave; F.NGW = F.G * NWAVES;
    volatile LAS unsigned* MISC = (volatile LAS unsigned*)(F.lds + LDS_MISC);
    if (F.tid < 64) MISC[F.tid] = 0u;
    __syncthreads();
    const XcdBarrier bar = xcd_barrier_post((unsigned*)(A.ws + WS_CTL), MISC + 8);
    unsigned char* ws = A.ws;
    LAS unsigned char* stage = F.lds;
    bf16* const dob = (bf16*)A.out;
    bf16 *H1 = dob, *R = dob, *KS = dob + (size_t)NTOK * BW, *V = dob + 2 * (size_t)NTOK * BW, *KK = dob + 3 * (size_t)NTOK * BW;

    p0_prologue(F, A);
    xcd_barrier(bar);
#if defined(CHECKS)
    if (F.wg == 0) chk_p0(F, A);
#endif
    p1_h1(F, A, H1);
    xcd_barrier(bar);
#if defined(CHECKS)
    if (F.wg == 0) chk_p1(F, A, H1);
#endif
    {   pg8::Gemm g{H1, (const bf16*)(ws + WS_WIN), NTOK, NPAD, D}; pg8::StaticOrder S; S.init(NTOK, NPAD, F.G, F.wg);
        EpiIn E{(bf16*)(ws + WS_QB), (bf16*)(ws + WS_KB), (bf16*)(ws + WS_VT), (bf16*)(ws + WS_RWRAW), (bf16*)(ws + WS_LORA), (bf16*)(ws + WS_GATE), A.gate_bias};
        pg8::gemm_phase<EpiIn, pg8::StaticOrder>(stage, g, S, E, nullptr); }
    xcd_barrier(bar);
#if defined(CHECKS)
    if (F.wg == 0) { chk_p2(F, A, H1); chk_p3_save(F, A); }
    xcd_barrier(bar);
#endif
    p3_attn(F, (const bf16*)(ws + WS_QB), (const bf16*)(ws + WS_KB), (const bf16*)(ws + WS_VT), (bf16*)(ws + WS_QB));
    p3_prep(F, A, (const bf16*)(ws + WS_RWRAW), (const bf16*)(ws + WS_LORA), R, KS, V, KK, (bf16*)(ws + WS_ALORA));
    xcd_barrier(bar);
#if defined(CHECKS)
    if (F.wg == 0) { chk_p3(F, A, R, KS, V, KK); chk_p4_save(F, A, KS); }
    xcd_barrier(bar);
#endif
    {   pg8::Gemm g{(const bf16*)(ws + WS_ALORA), (const bf16*)(ws + WS_WL), NTOK, 1536, LK}; pg8::StaticOrder S; S.init(NTOK, 1536, F.G, F.wg);
        EpiLora E{(bf16*)(ws + WS_E), KS, (bf16*)(ws + WS_B), (bf16*)(ws + WS_GG), KK, A.w0, A.a0, A.k_a};
        pg8::gemm_phase<EpiLora, pg8::StaticOrder>(stage, g, S, E, nullptr); }
    xcd_barrier(bar);
#if defined(CHECKS)
    if (F.wg == 0) chk_p4(F, A, KS, KK);
#endif
    p5_scan(F, R, KS, V, KK, (const bf16*)(ws + WS_B), (const bf16*)(ws + WS_E), (bf16*)(ws + WS_P), (bf16*)(ws + WS_QO), (bf16*)(ws + WS_GT), (float*)(ws + WS_HT));
    xcd_barrier(bar);
#if defined(CHECKS)
    if (F.wg == 255) chk_p7_save(F, A);
#endif
    {   const int ncw = F.G < 64 ? F.G : 64;
        if (F.wg < ncw && F.wave == 0) { for (int task = F.wg; task < 64; task += ncw) p6_chain(task, (const bf16*)(ws + WS_GT), (const float*)(ws + WS_HT), (float*)(ws + WS_SC)); }
        else { const int wi = F.wg < ncw ? F.wg * 7 + (F.wave - 1) : ncw * 7 + (F.wg - ncw) * 8 + F.wave, NW = ncw * 7 + (F.G - ncw) * 8;
            p6_moe_weights(F, A, wi, NW); } }
    xcd_barrier(bar);
    p7_out(F, A, (const float*)(ws + WS_SC), (const bf16*)(ws + WS_P), (const bf16*)(ws + WS_QO), R, KS, V, (const bf16*)(ws + WS_GG), (bf16*)(ws + WS_YRW));
    xcd_barrier(bar);
#if defined(CHECKS)
    if (F.wg == 0) chk_p7(F, A, R, KS, V, KK);
#endif
    {   pg8::StaticOrder S; S.init(NTOK, D, F.G, F.wg);
        {   pg8::Gemm g{(const bf16*)(ws + WS_QB), (const bf16*)(ws + WS_WOSB), NTOK, D, BW};
            EpiMerge<false> E{(const bf16*)(ws + WS_GATE), (bf16*)(ws + WS_MRG), 0};
            pg8::gemm_phase<EpiMerge<false>, pg8::StaticOrder>(stage, g, S, E, nullptr); }
        {   pg8::Gemm g{(const bf16*)(ws + WS_YRW), (const bf16*)(ws + WS_WORW), NTOK, D, BW};
            EpiMerge<true> E{(const bf16*)(ws + WS_GATE), (bf16*)(ws + WS_MRG), D};
            pg8::gemm_phase<EpiMerge<true>, pg8::StaticOrder>(stage, g, S, E, nullptr); } }
    xcd_barrier(bar);
#if defined(CHECKS)
    if (F.wg == 0) chk_p8(F, A);
#endif
    {   pg8::Gemm g{(const bf16*)(ws + WS_MRG), (const bf16*)(ws + WS_WOUT), NTOK, D, D}; pg8::StaticOrder S; S.init(NTOK, D, F.G, F.wg);
        EpiPlain E{(bf16*)(ws + WS_Y1), D, 0xff};
        pg8::gemm_phase<EpiPlain, pg8::StaticOrder>(stage, g, S, E, nullptr); }
    xcd_barrier(bar);
#if defined(CHECKS)
    if (F.wg == 0) chk_p9(F, A);
#endif
    p10_rows(F, A, (const bf16*)(ws + WS_Y1), (bf16*)(ws + WS_H2));
    xcd_barrier(bar);
#if defined(VARIANT) && VARIANT == 1
    return;
#endif
#if defined(CHECKS)
    if (F.wg == 0) chk_p10(F, A);
#endif
    p11_rank_gather(F, A, (const bf16*)(ws + WS_H2), (bf16*)(ws + WS_HS));
    xcd_barrier(bar);
#if defined(CHECKS)
    if (F.wg == 0) chk_p11(F, A);
#endif
    {   const int* tile = (const int*)(ws + WS_TILE);
        const int nt = __builtin_amdgcn_readfirstlane(tile[MAXT]);
        MoeOrder S; S.nunits = nt * 4; S.G = F.G; S.vc = (F.G % 8 == 0) ? (F.wg % 8) * (F.G / 8) + F.wg / 8 : F.wg; S.tile_e = tile;
        {   pg8::Gemm g{(const bf16*)(ws + WS_HS), (const bf16*)(ws + WS_WUP), MAXT * 256, NE * 1024, D};
            EpiUp E{(bf16*)(ws + WS_HID)};
            pg8::gemm_phase<EpiUp, MoeOrder>(stage, g, S, E, nullptr); }
        xcd_barrier(bar);
#if defined(CHECKS)
        if (F.wg == 0) chk_p12(F, A);
#endif
        {   pg8::Gemm g{(const bf16*)(ws + WS_HID), (const bf16*)(ws + WS_WDN), MAXT * 256, NE * 1024, DE};
            EpiPlain E{(bf16*)(ws + WS_HS), D, 3};
            pg8::gemm_phase<EpiPlain, MoeOrder>(stage, g, S, E, nullptr); } }
    xcd_barrier(bar);
#if defined(CHECKS)
    if (F.wg == 0) chk_p13(F, A);
#endif
    p14_final(F, A, (const bf16*)(ws + WS_HS));
#if defined(CHECKS)
    xcd_barrier(bar);
    if (F.wg == 0 && F.tid == 0) { const unsigned* fl = chk_flags(ws); int id = 0; for (int i = 61; i >= 0; --i) if (fl[i]) id = i;
        if (((const unsigned*)(ws + WS_CTL))[XB_TMO]) id = 60;
        if (id) A.out[0] = 10.0f * (float)id;
#if defined(CHKVAL)
        A.out[0] = 1000.0f * ((const float*)fl)[CHKVAL];
#endif
        }
#endif
}

extern "C" void kernel_launch(void* const* d_in, const int* in_sizes, int n_in, void* d_out, int out_size, void* d_ws, size_t ws_size, hipStream_t stream) {
    static int grid = 0;
    if (grid == 0) {
        if (n_in != 26 || in_sizes[0] != NTOK * D || out_size != NTOK * D || ws_size < WS_END) {
            fprintf(stderr, "kernel_launch: unexpected shapes (n_in %d, in0 %d, out %d, ws %zu); nothing launched\n", n_in, n_in > 0 ? in_sizes[0] : -1, out_size, ws_size); grid = -1; return; }
        int dev = 0, cus = 0, per_cu = 0;
        if (hipGetDevice(&dev) != hipSuccess || hipDeviceGetAttribute(&cus, hipDeviceAttributeMultiprocessorCount, dev) != hipSuccess) { grid = -1; return; }
        if (hipFuncSetAttribute((const void*)hybrid_fwd, hipFuncAttributeMaxDynamicSharedMemorySize, LDS_BYTES) != hipSuccess) { fprintf(stderr, "kernel_launch: hipFuncSetAttribute failed\n"); grid = -1; return; }
        if (hipOccupancyMaxActiveBlocksPerMultiprocessor(&per_cu, (const void*)hybrid_fwd, NTHR, LDS_BYTES) != hipSuccess || per_cu < 1)
            fprintf(stderr, "kernel_launch: note: occupancy query reports %d workgroups per CU\n", per_cu);
        (void)hipGetLastError();
        grid = cus > 256 ? 256 : cus;
    }
    if (grid < 0) return;
    if (hipMemsetAsync((char*)d_ws + WS_CTL, 0, CTL_ZERO_BYTES, stream) != hipSuccess) return;
    Args a{};
    const float** p = (const float**)&a;
    for (int i = 0; i < 26; ++i) p[i] = (const float*)d_in[i];
    a.out = (float*)d_out; a.ws = (unsigned char*)d_ws;
    hipLaunchKernelGGL(hybrid_fwd, dim3(grid), dim3(NTHR), LDS_BYTES, stream, a);
}
```

```cpp
#include <hip/hip_runtime.h>
#include <cstdio>
#include <cstdint>
__device__ __forceinline__ int opq_tid(int wave) { int l; asm volatile("v_mbcnt_lo_u32_b32 %0, -1, 0\n\tv_mbcnt_hi_u32_b32 %0, -1, %0" : "=v"(l)); return wave * 64 + l; }
#ifndef PHMASK
#define PHMASK 0xffff
#endif
namespace pg8 {
#define PG8_LAS __attribute__((address_space(3)))
typedef unsigned short bf16_t;
typedef short bf16x8 __attribute__((ext_vector_type(8)));
typedef float f32x4 __attribute__((ext_vector_type(4)));
typedef unsigned u32x4 __attribute__((ext_vector_type(4)));
constexpr int BM = 256, BK = 64, HALF = 128, HTB = HALF * BK * 2  , STAGE_BYTES = 8 * HTB, NXCD = 8, WGM = 8;

__host__ __device__ __forceinline__ int lds_byte(int r, int c) { const int st = (r >> 4) * 2 + (c >> 5), rr = r & 15, cc = c & 31, ob = rr * 64 + cc * 2; return st * 1024 + (ob ^ (((ob >> 9) & 1) << 5)); }
__host__ __device__ __forceinline__ void stage_rc(int b, int& R, int& C) { const int st = b / 1024, sb = b % 1024, swz = sb ^ (((sb >> 9) & 1) << 5); R = (st >> 1) * 16 + swz / 64; C = (st & 1) * 32 + (swz % 64) / 2; }
__host__ __device__ __forceinline__ int perm32(int rho) { const int n = rho >> 4, i = rho & 15; return 8 * (i >> 2) + 4 * n + (i & 3); }

struct Unit { int pm, pn; };
struct Gemm { const bf16_t* A; const bf16_t* Bt; int M, N, K; };

struct StaticOrder {
    int nM, nN, nwg, G, c;
    __host__ __device__ void init(int M, int N, int G_, int c_) { nM = M / BM; nN = N / BM; nwg = nM * nN; G = G_; c = c_; }
    __host__ __device__ bool next(int i, Unit& u) const {
        const long L = (long)i * G + c; if (L >= nwg) return false;
        int wgid = (int)L; { const int q = nwg / NXCD, r = nwg % NXCD, xcd = wgid % NXCD, off = wgid / NXCD; wgid = (xcd < r ? xcd * (q + 1) : r * (q + 1) + (xcd - r) * q) + off; }
        const int nig = WGM * nN, gid = wgid / nig, fm = gid * WGM, gsz = (nM - fm) < WGM ? (nM - fm) : WGM;
        u.pm = fm + ((wgid % nig) % gsz); u.pn = (wgid % nig) / gsz; return true;
    }
    __device__ __forceinline__ void a_ready(const Unit&) const {}
    __device__ __forceinline__ void done(const Unit&) const {}
};

template <class Epi, class Sched, bool STAMP = false>
__device__ __forceinline__ void gemm_phase(PG8_LAS unsigned char* lds, const Gemm g, const Sched& S, const Epi& E, unsigned long long* stamps, int wave_id) {
    const int tid = opq_tid(wave_id), wid = __builtin_amdgcn_readfirstlane(tid >> 6), lane = tid & 63, wr = wid >> 2, wc = wid & 3, fr = lane & 15, fq = lane >> 4;
    const int K = g.K, nt = K / BK;
    int ts_lo = 0, ts_hi = 0, nts = 0; const unsigned long long rt_entry = STAMP ? (unsigned long long)wall_clock64() : 0ull;
#define PG8_STAMP() do { if (STAMP && wid == 0 && nts < 64) { const unsigned long long _c = (unsigned long long)clock64(); \
        ts_lo = (lane == nts) ? (int)(unsigned)_c : ts_lo; ts_hi = (lane == nts) ? (int)(unsigned)(_c >> 32) : ts_hi; ++nts; } } while (0)
    PG8_STAMP();
    unsigned voffA[2], voffB[2];
#pragma unroll
    for (int i = 0; i < 2; ++i) { int R, C; stage_rc(tid * 16 + i * 8192, R, C); const int Rb = Epi::PERM ? ((R & ~31) + perm32(R & 31)) : R;
        voffA[i] = (unsigned)(R * K + C) * 2u; voffB[i] = (unsigned)(Rb * K + C) * 2u; }
    const size_t kstep = (size_t)(BK * 2);
    const size_t hstep = (size_t)HALF * K * 2;
    const size_t tstep = 2 * hstep;
    const unsigned ldsw = (unsigned)wid * 1024u;
    const int aoff = lds_byte(wr * 64 + fr, fq * 8), boff = lds_byte(wc * 32 + fr, fq * 8);
#define PG8_SA(b, h) (((b) * 2 + (h)) * HTB)
#define PG8_SB(b, h) ((4 + (b) * 2 + (h)) * HTB)
#define PG8_STAGE(bufoff, gbase, voff) do { _Pragma("unroll") for (int _i = 0; _i < 2; ++_i) \
        __builtin_amdgcn_global_load_lds((const unsigned*)((const char*)(gbase) + (voff)[_i]), (PG8_LAS unsigned*)(lds + (bufoff) + ldsw + _i * 8192), 16, 0, 0); } while (0)
#define PG8_LDA(dst, b, h) do { _Pragma("unroll") for (int m = 0; m < 4; ++m) _Pragma("unroll") for (int k = 0; k < 2; ++k) dst[m][k] = *(const PG8_LAS bf16x8*)(lds + PG8_SA(b, h) + aoff + m * 2048 + k * 1024); } while (0)
#define PG8_LDB(dst, b, h) do { _Pragma("unroll") for (int n = 0; n < 2; ++n) _Pragma("unroll") for (int k = 0; k < 2; ++k) dst[n][k] = *(const PG8_LAS bf16x8*)(lds + PG8_SB(b, h) + boff + n * 2048 + k * 1024); } while (0)
#define PG8_MMA(ai, bj, At, Bt) do { __builtin_amdgcn_s_setprio(1); _Pragma("unroll") for (int m = 0; m < 4; ++m) _Pragma("unroll") for (int n = 0; n < 2; ++n) _Pragma("unroll") for (int k = 0; k < 2; ++k) \
        acc[ai][bj][m][n] = __builtin_amdgcn_mfma_f32_16x16x32_bf16(Bt[n][k], At[m][k], acc[ai][bj][m][n], 0, 0, 0); __builtin_amdgcn_s_setprio(0); } while (0)
#define PG8_WAIT_V(n) asm volatile("s_waitcnt vmcnt(" #n ")" ::: "memory")
#define PG8_WAIT_L(n) asm volatile("s_waitcnt lgkmcnt(" #n ")" ::: "memory")
#define PG8_BAR __builtin_amdgcn_s_barrier()
#define PG8_SCHED __builtin_amdgcn_sched_barrier(0)
    Unit cur, nxt; int ui = 0;
    if (!S.next(0, cur)) return;
    f32x4 acc[2][2][4][2];
#pragma unroll
    for (int a = 0; a < 2; ++a)
#pragma unroll
        for (int b = 0; b < 2; ++b)
#pragma unroll
            for (int m = 0; m < 4; ++m)
#pragma unroll
                for (int n = 0; n < 2; ++n) acc[a][b][m][n] = (f32x4){0.f, 0.f, 0.f, 0.f};
    bf16x8 At[4][2], B0[2][2], B1[2][2];
    const char* cA = (const char*)g.A + (size_t)cur.pm * tstep; const char* cB = (const char*)g.Bt + (size_t)cur.pn * tstep;
    S.a_ready(cur);
    PG8_STAGE(PG8_SB(0, 0), cB, voffB); PG8_STAGE(PG8_SA(0, 0), cA, voffA); PG8_STAGE(PG8_SB(0, 1), cB + hstep, voffB); PG8_STAGE(PG8_SA(0, 1), cA + hstep, voffA);
    if (wr == 1) PG8_BAR;
    PG8_WAIT_V(4); PG8_BAR;
    PG8_STAGE(PG8_SB(1, 0), cB + kstep, voffB); PG8_STAGE(PG8_SA(1, 0), cA + kstep, voffA); PG8_STAGE(PG8_SB(1, 1), cB + hstep + kstep, voffB);
    PG8_WAIT_V(6); PG8_BAR;
    PG8_STAMP();
    for (;;) {
        const bool has_next = S.next(ui + 1, nxt);
        const char* nA = has_next ? (const char*)g.A + (size_t)nxt.pm * tstep : cA; const char* nB = has_next ? (const char*)g.Bt + (size_t)nxt.pn * tstep : cB;
        for (int t = 0; t < nt; t += 2) {
            const bool last = (t == nt - 2);
            const char* a1 = cA + (size_t)(t + 1) * kstep;
            const char* a2 = last ? nA : cA + (size_t)(t + 2) * kstep; const char* b2 = last ? nB : cB + (size_t)(t + 2) * kstep;
            const char* a3 = a2 + kstep; const char* b3 = b2 + kstep;
            if (last && has_next) S.a_ready(nxt);
            PG8_LDB(B0, 0, 0); PG8_SCHED; PG8_LDA(At, 0, 0); PG8_STAGE(PG8_SA(1, 1), a1 + hstep, voffA);
            PG8_WAIT_L(8); PG8_BAR; PG8_WAIT_L(0); PG8_MMA(0, 0, At, B0); PG8_BAR; PG8_SCHED;
            PG8_LDB(B1, 0, 1); PG8_STAGE(PG8_SB(0, 0), b2, voffB);
            PG8_BAR; PG8_WAIT_L(0); PG8_MMA(0, 1, At, B1); PG8_BAR;
            PG8_LDA(At, 0, 1); PG8_STAGE(PG8_SA(0, 0), a2, voffA);
            PG8_BAR; PG8_WAIT_L(0); PG8_MMA(1, 0, At, B0); PG8_BAR; PG8_SCHED;
            PG8_STAGE(PG8_SB(0, 1), b2 + hstep, voffB);
            PG8_WAIT_V(6); PG8_BAR; PG8_MMA(1, 1, At, B1); PG8_BAR;
            PG8_LDB(B0, 1, 0); PG8_SCHED; PG8_LDA(At, 1, 0); PG8_STAGE(PG8_SA(0, 1), a2 + hstep, voffA);
            PG8_WAIT_L(8); PG8_BAR; PG8_WAIT_L(0); PG8_MMA(0, 0, At, B0); PG8_BAR; PG8_SCHED;
            PG8_LDB(B1, 1, 1); PG8_STAGE(PG8_SB(1, 0), b3, voffB);
            PG8_BAR; PG8_WAIT_L(0); PG8_MMA(0, 1, At, B1); PG8_BAR;
            PG8_LDA(At, 1, 1); PG8_STAGE(PG8_SA(1, 0), a3, voffA);
            PG8_BAR; PG8_WAIT_L(0); PG8_MMA(1, 0, At, B0); PG8_BAR; PG8_SCHED;
            PG8_STAGE(PG8_SB(1, 1), b3 + hstep, voffB);
            PG8_WAIT_V(6); PG8_BAR; PG8_MMA(1, 1, At, B1); PG8_BAR;
        }
        PG8_STAMP();
        if constexpr (!Epi::AFTER_DRAIN) { E(acc, cur, wr, wc, fr, fq); S.done(cur); }
        PG8_STAMP();
        if (!has_next) break;
#pragma unroll
        for (int a = 0; a < 2; ++a)
#pragma unroll
            for (int b = 0; b < 2; ++b)
#pragma unroll
                for (int m = 0; m < 4; ++m)
#pragma unroll
                    for (int n = 0; n < 2; ++n) acc[a][b][m][n] = (f32x4){0.f, 0.f, 0.f, 0.f};
        cur = nxt; cA = nA; cB = nB; ++ui;
    }
    PG8_WAIT_V(0);
    if (wr == 0) PG8_BAR;
    PG8_BAR;
    if constexpr (Epi::AFTER_DRAIN) { E.fused(acc, cur, wr, wc, fr, fq, lds, wid, lane); S.done(cur); }
    PG8_STAMP();
    if (STAMP && wid == 0) { stamps[lane] = lane < nts ? (((unsigned long long)(unsigned)ts_hi << 32) | (unsigned)ts_lo) : 0ull;
        if (lane == 62) stamps[62] = rt_entry; if (lane == 63) stamps[63] = (unsigned long long)wall_clock64(); }
#undef PG8_STAMP
#undef PG8_SA
#undef PG8_SB
#undef PG8_STAGE
#undef PG8_LDA
#undef PG8_LDB
#undef PG8_MMA
#undef PG8_WAIT_V
#undef PG8_WAIT_L
#undef PG8_BAR
#undef PG8_SCHED
}
}

#define XB_TMO      128
#define XB_XCNT(j)  (256  + 64 * (j))
#define XB_XSUB(j)  (1280 + 64 * (j))
#define XB_XGEN(j)  (2304 + 64 * (j))
#define XB_TOP      3328
#define XB_TOPGEN   3392
#define XCD_BAR_WORDS 3456
#define XB_SPIN_CAP (1u << 18)
#define LAS __attribute__((address_space(3)))

__device__ __forceinline__ unsigned xb_ld(unsigned* p)              { return __hip_atomic_load(p, __ATOMIC_RELAXED, __HIP_MEMORY_SCOPE_AGENT); }
__device__ __forceinline__ unsigned xb_add(unsigned* p, unsigned v) { return __hip_atomic_fetch_add(p, v, __ATOMIC_RELAXED, __HIP_MEMORY_SCOPE_AGENT); }
__device__ __forceinline__ unsigned xb_xcc_id() { return (unsigned)__builtin_amdgcn_s_getreg((3 << 11) | 20) & 0xFu; }
#define XB_SPIN(cond, bar) do { unsigned _sp = 0; while (cond) { __builtin_amdgcn_s_sleep(1); \
    if ((++_sp & 255u) == 0u) { if (xb_ld(&(bar)[XB_TMO])) break; if (_sp > XB_SPIN_CAP) { atomicAdd(&(bar)[XB_TMO], 1u); break; } } } } while (0)

struct XcdBarrier {
    unsigned* bar; unsigned x; int wave;
    volatile LAS unsigned* st;
};

__device__ __forceinline__ bool xb_t0(int wave) { return wave == 0 && __builtin_amdgcn_mbcnt_hi(~0u, __builtin_amdgcn_mbcnt_lo(~0u, 0u)) == 0u; }
__device__ __forceinline__ XcdBarrier xcd_barrier_post(unsigned* bar, volatile LAS unsigned* st, int wave) {
    XcdBarrier b; b.bar = bar; b.x = xb_xcc_id(); b.st = st; b.wave = wave;
    if (xb_t0(wave)) (void)xb_add(&bar[XB_XCNT(b.x)], 1u);
    return b;
}
__device__ __forceinline__ void xcd_barrier_complete(unsigned* bar, unsigned x, unsigned& nloc, unsigned& nx) {
    const unsigned G = gridDim.x * gridDim.y * gridDim.z;
    unsigned sum, cnt, mine, sp = 0u;
    for (;;) {
        sum = 0u; cnt = 0u; mine = 0u;
#pragma unroll
        for (unsigned j = 0; j < 16; ++j) { const unsigned c = xb_ld(&bar[XB_XCNT(j)]); sum += c; cnt += (c > 0u) ? 1u : 0u; mine = (j == x) ? c : mine; }
        if (sum == G) break;
        __builtin_amdgcn_s_sleep(1);
        if ((++sp & 255u) == 0u) { if (xb_ld(&bar[XB_TMO])) break; if (sp > XB_SPIN_CAP) { atomicAdd(&bar[XB_TMO], 1u); break; } }
    }
    nloc = mine > 0u ? mine : 1u; nx = cnt > 0u ? cnt : 1u;
}

__device__ __forceinline__ void xcd_barrier(const XcdBarrier& b) {
    asm volatile("s_waitcnt vmcnt(0)" ::: "memory");
    __syncthreads();
    if (xb_t0(b.wave)) {
        unsigned* bar = b.bar;
        __builtin_amdgcn_s_waitcnt(0);
        unsigned nloc = b.st[0], nx = b.st[1];
        if (nloc == 0u) { xcd_barrier_complete(bar, b.x, nloc, nx); b.st[0] = nloc; b.st[1] = nx; }
        const unsigned old = xb_add(&bar[XB_XSUB(b.x)], 1u);
        const unsigned gen = old / nloc;
        if (old + 1u == (gen + 1u) * nloc) {
            __builtin_amdgcn_fence(__ATOMIC_RELEASE, "agent");
            asm volatile("s_waitcnt vmcnt(0)" ::: "memory");
            const unsigned og = xb_add(&bar[XB_TOP], 1u);
            const unsigned tg = og / nx;
            if (og + 1u == (tg + 1u) * nx) xb_add(&bar[XB_TOPGEN], 1u);
            else XB_SPIN(xb_ld(&bar[XB_TOPGEN]) == tg, bar);
            __builtin_amdgcn_fence(__ATOMIC_ACQUIRE, "agent");
            xb_add(&bar[XB_XGEN(b.x)], 1u);
            asm volatile("s_waitcnt vmcnt(0)" ::: "memory");
        } else {
            XB_SPIN(xb_ld(&bar[XB_XGEN(b.x)]) == gen, bar);
            __builtin_amdgcn_fence(__ATOMIC_ACQUIRE, "agent");
            asm volatile("s_waitcnt vmcnt(0)" ::: "memory");
        }
    }
    __syncthreads();
}


constexpr int NB = 4, SEQ = 8192, D = 1024, NTOK = NB * SEQ;
constexpr int NH = 8, HD = 64, BW = 512;
constexpr int IN_COLS = 5408, NPAD = 5632;
constexpr int LK = 384;
constexpr int NE = 32, DE = 512;
constexpr int CH = 64, NCH = SEQ / CH, NCH_LOG = 7, NCHUNK = NB * NH * NCH;
constexpr int MAXT = 288;
constexpr float NORM_EPS = 1e-6f, GN_EPS = 64e-5f, L2_EPS = 1e-12f;
constexpr float SB_STOP = -120.0f;

constexpr size_t MiB = 1u << 20;
constexpr size_t WS_CTL = 0, CTL_ZERO_BYTES = 65536;
constexpr size_t WS_MOD = 1 * MiB;
constexpr size_t WS_RTW = WS_MOD + 128 * 1024;
constexpr size_t WS_TOK = WS_RTW + 160 * 1024;
constexpr size_t WS_CNT = WS_TOK + (size_t)NTOK * 16;
constexpr size_t WS_TILE = WS_CNT + 256 * 32 * 4;
constexpr size_t WS_WIN = 2 * MiB;
constexpr size_t WS_WOSB = 13 * MiB, WS_WORW = 14 * MiB, WS_WOUT = 15 * MiB;
constexpr size_t WS_WL = 17 * MiB;
constexpr size_t WS_BON = 18 * MiB + 256 * 1024;
constexpr size_t WS_CW = 19 * MiB + 768 * 1024;
constexpr size_t WS_QB = 20 * MiB;
constexpr size_t WS_GATE = 52 * MiB;
constexpr size_t WS_GG = 180 * MiB;
constexpr size_t WS_KB = 212 * MiB, WS_VT = 244 * MiB;
constexpr size_t WS_LORA = 276 * MiB;
constexpr size_t WS_ALORA = 308 * MiB;
constexpr size_t WS_E = 340 * MiB, WS_B = 372 * MiB;
constexpr size_t WS_RWRAW = 416 * MiB;
constexpr size_t WS_P = 212 * MiB, WS_QO = 244 * MiB;
constexpr size_t WS_GT = 276 * MiB;
constexpr size_t WS_HT = 308 * MiB;
constexpr size_t WS_SC = 340 * MiB;
constexpr size_t WS_YRW = 384 * MiB;
constexpr size_t WS_WUP = 416 * MiB, WS_WDN = 480 * MiB;
constexpr size_t WS_MRG = 212 * MiB;
constexpr size_t WS_Y1 = 276 * MiB;
constexpr size_t WS_H2 = 52 * MiB;
constexpr size_t WS_HS = 116 * MiB;
constexpr size_t WS_HID = 260 * MiB;
constexpr size_t WS_END = 512 * MiB;
static_assert(WS_TILE + (MAXT + 1) * 4 <= WS_WIN && WS_WIN + (size_t)NPAD * D * 2 <= WS_WOSB && WS_WL + 1536 * LK * 2 <= WS_QB, "fixed region");
static_assert(WS_HS + (size_t)MAXT * 256 * D * 2 <= WS_HID && WS_HID + (size_t)MAXT * 256 * DE * 2 <= WS_WUP, "moe region");
static_assert(WS_ALORA + (size_t)NTOK * LK * 2 <= WS_E && WS_B + (size_t)NTOK * BW * 2 <= WS_RWRAW, "rwkv region");

constexpr int LDS_BYTES = 163840;
constexpr int LDS_MISC = LDS_BYTES - 256;
constexpr int NWAVES = 8, NTHR = 512;

typedef unsigned short bf16;
typedef short bf16x8 __attribute__((ext_vector_type(8)));
typedef short s16x4 __attribute__((ext_vector_type(4)));
typedef float f32x4 __attribute__((ext_vector_type(4)));
typedef float f32x16 __attribute__((ext_vector_type(16)));
typedef unsigned u32x4 __attribute__((ext_vector_type(4)));
typedef unsigned u32x2 __attribute__((ext_vector_type(2)));
typedef int i32x4 __attribute__((ext_vector_type(4)));
#define DI __device__ __forceinline__
#define GAS __attribute__((address_space(1)))
#define MFMA32(a, b, c) __builtin_amdgcn_mfma_f32_32x32x16_bf16((a), (b), (c), 0, 0, 0)

typedef float f32x2_t __attribute__((ext_vector_type(2))); typedef __bf16 bf16x2_t __attribute__((ext_vector_type(2)));
DI unsigned pk2(float lo, float hi) { f32x2_t v = {lo, hi}; return __builtin_bit_cast(unsigned, __builtin_convertvector(v, bf16x2_t)); }
DI unsigned f2bf(float f) { return pk2(f, 0.0f) & 0xffffu; }
DI float bflo(unsigned u) { return __builtin_bit_cast(float, u << 16); }
DI float bfhi(unsigned u) { return __builtin_bit_cast(float, u & 0xffff0000u); }
DI float bf2f(bf16 h) { return __builtin_bit_cast(float, (unsigned)h << 16); }
DI float fexp(float x) { return __expf(x); }
DI float frcp(float x) { return __builtin_amdgcn_rcpf(x); }
DI float fsigmoid(float x) { return frcp(1.0f + fexp(-x)); }
DI float fsoftplus(float x) { return fmaxf(x, 0.0f) + __logf(1.0f + fexp(-fabsf(x))); }
#define DPP_SHR(v, ctrl) __builtin_bit_cast(float, __builtin_amdgcn_update_dpp(0, __builtin_bit_cast(int, (v)), (ctrl), 0xf, 0xf, true))
DI float wave_sum(float v) {
    v += DPP_SHR(v, 0x111); v += DPP_SHR(v, 0x112); v += DPP_SHR(v, 0x114); v += DPP_SHR(v, 0x118);
    v += __builtin_bit_cast(float, __builtin_amdgcn_update_dpp(0, __builtin_bit_cast(int, v), 0x142, 0xa, 0xf, false));
    v += __builtin_bit_cast(float, __builtin_amdgcn_update_dpp(0, __builtin_bit_cast(int, v), 0x143, 0xc, 0xf, false));
    return __builtin_bit_cast(float, __builtin_amdgcn_readlane(__builtin_bit_cast(int, v), 63));
}
DI float shfl_xor_l(float v, int m, int lane) { return __builtin_bit_cast(float, __builtin_amdgcn_ds_bpermute(4 * (lane ^ m), __builtin_bit_cast(int, v))); }
DI int crow(int reg, int hh) { return (reg & 3) + 8 * (reg >> 2) + 4 * hh; }
DI void wave_lds_fence() { __builtin_amdgcn_fence(__ATOMIC_RELEASE, "wavefront"); __builtin_amdgcn_wave_barrier(); __builtin_amdgcn_fence(__ATOMIC_ACQUIRE, "wavefront"); }
DI void unpack8(const u32x4 v, float (&o)[8]) { o[0] = bflo(v.x); o[1] = bfhi(v.x); o[2] = bflo(v.y); o[3] = bfhi(v.y); o[4] = bflo(v.z); o[5] = bfhi(v.z); o[6] = bflo(v.w); o[7] = bfhi(v.w); }
DI u32x4 pack8(const float (&o)[8]) { u32x4 v; v.x = pk2(o[0], o[1]); v.y = pk2(o[2], o[3]); v.z = pk2(o[4], o[5]); v.w = pk2(o[6], o[7]); return v; }
DI bf16x8 pack8v(float a0, float a1, float a2, float a3, float a4, float a5, float a6, float a7) {
    u32x4 v; v.x = pk2(a0, a1); v.y = pk2(a2, a3); v.z = pk2(a4, a5); v.w = pk2(a6, a7); return __builtin_bit_cast(bf16x8, v); }


#if defined(CHECKS)
constexpr int DBG_TOKEN = 77;
#endif

typedef pg8::f32x4 af4;
DI void st8(bf16* p, const af4 v0, const af4 v1) { u32x4 w; w.x = pk2(v0[0], v0[1]); w.y = pk2(v0[2], v0[3]); w.z = pk2(v1[0], v1[1]); w.w = pk2(v1[2], v1[3]); *(u32x4*)p = w; }

struct EpiIn {
    static constexpr bool PERM = true, AFTER_DRAIN = false;
    bf16 *Q, *K, *Vt, *RW, *LO, *GA; const float* gate_bias;
    DI void operator()(const af4 (&acc)[2][2][4][2], const pg8::Unit& u, int wr, int wc, int fr, int fq) const {
        const int pn = u.pn, row0 = u.pm * 256 + wr * 64 + fr;
        if (pn == 4 || pn == 5) {
#pragma unroll
            for (int ai = 0; ai < 2; ++ai)
#pragma unroll
                for (int m = 0; m < 4; ++m) { const int row = row0 + ai * 128 + m * 16, b = row >> 13, s = row & (SEQ - 1);
#pragma unroll
                    for (int bj = 0; bj < 2; ++bj)
#pragma unroll
                        for (int n = 0; n < 2; ++n)
#pragma unroll
                            for (int j = 0; j < 4; ++j) { const int cv = (pn - 4) * 256 + bj * 128 + wc * 32 + 8 * fq + 4 * n + j;
                                Vt[((size_t)(b * BW + cv)) * SEQ + s] = (bf16)f2bf(acc[ai][bj][m][n][j]); } }
        } else if (pn >= 14) {
            const int col0 = (pn - 14) * 256 + wc * 32 + 8 * fq;
            af4 bv[2][2];
#pragma unroll
            for (int bj = 0; bj < 2; ++bj)
#pragma unroll
                for (int n = 0; n < 2; ++n) bv[bj][n] = *(const af4*)(gate_bias + col0 + bj * 128 + 4 * n);
#pragma unroll
            for (int ai = 0; ai < 2; ++ai)
#pragma unroll
                for (int m = 0; m < 4; ++m) { bf16* rowp = GA + (size_t)(row0 + ai * 128 + m * 16) * 2048 + col0;
#pragma unroll
                    for (int bj = 0; bj < 2; ++bj) { af4 v0 = acc[ai][bj][m][0] + bv[bj][0], v1 = acc[ai][bj][m][1] + bv[bj][1];
#pragma unroll
                        for (int j = 0; j < 4; ++j) { v0[j] = fsigmoid(v0[j]); v1[j] = fsigmoid(v1[j]); }
                        st8(rowp + bj * 128, v0, v1); } }
        } else {
            bf16* base; int ld, ct; float sc = 1.0f;
            if (pn < 2) { base = Q; ld = BW; ct = pn; sc = 0.125f; } else if (pn < 4) { base = K; ld = BW; ct = pn - 2; } else if (pn < 12) { base = RW; ld = 1536; ct = pn - 6; } else { base = LO; ld = BW; ct = pn - 12; }
            const int col0 = ct * 256 + wc * 32 + 8 * fq;
#pragma unroll
            for (int ai = 0; ai < 2; ++ai)
#pragma unroll
                for (int m = 0; m < 4; ++m) { bf16* rowp = base + (size_t)(row0 + ai * 128 + m * 16) * ld + col0;
#pragma unroll
                    for (int bj = 0; bj < 2; ++bj) st8(rowp + bj * 128, acc[ai][bj][m][0] * sc, acc[ai][bj][m][1] * sc); }
        }
    }
};

template <bool ADD> struct EpiMerge {
    static constexpr bool PERM = true, AFTER_DRAIN = false;
    bf16* GA; bf16* MRG; int gofs;
    DI void operator()(const af4 (&acc)[2][2][4][2], const pg8::Unit& u, int wr, int wc, int fr, int fq) const {
        const int row0 = u.pm * 256 + wr * 64 + fr, col0 = u.pn * 256 + wc * 32 + 8 * fq;
#pragma unroll
        for (int ai = 0; ai < 2; ++ai)
#pragma unroll
            for (int m = 0; m < 4; ++m) { const size_t row = (size_t)(row0 + ai * 128 + m * 16);
#pragma unroll
                for (int bj = 0; bj < 2; ++bj) { const int c = col0 + bj * 128;
                    float g[8]; unpack8(*(const u32x4*)(GA + row * 2048 + gofs + c), g);
                    af4 v0, v1;
#pragma unroll
                    for (int j = 0; j < 4; ++j) { v0[j] = g[j] * acc[ai][bj][m][0][j]; v1[j] = g[4 + j] * acc[ai][bj][m][1][j]; }
                    if (ADD) { float o[8]; unpack8(*(const u32x4*)(GA + row * 2048 + c), o);
#pragma unroll
                        for (int j = 0; j < 4; ++j) { v0[j] += o[j]; v1[j] += o[4 + j]; }
                        st8(MRG + row * D + c, v0, v1); }
                    else st8(GA + row * 2048 + c, v0, v1); } }
    }
};

struct EpiPlain {
    static constexpr bool PERM = true, AFTER_DRAIN = false;
    bf16* O; int ld, cmask;
    DI void operator()(const af4 (&acc)[2][2][4][2], const pg8::Unit& u, int wr, int wc, int fr, int fq) const {
        const int row0 = u.pm * 256 + wr * 64 + fr, col0 = (u.pn & cmask) * 256 + wc * 32 + 8 * fq;
#pragma unroll
        for (int ai = 0; ai < 2; ++ai)
#pragma unroll
            for (int m = 0; m < 4; ++m) { bf16* rowp = O + (size_t)(row0 + ai * 128 + m * 16) * ld + col0;
#pragma unroll
                for (int bj = 0; bj < 2; ++bj) st8(rowp + bj * 128, acc[ai][bj][m][0], acc[ai][bj][m][1]); }
    }
};

struct EpiUp {
    static constexpr bool PERM = true, AFTER_DRAIN = false;
    bf16* HID;
    DI void operator()(const af4 (&acc)[2][2][4][2], const pg8::Unit& u, int wr, int wc, int fr, int fq) const {
        const int row0 = u.pm * 256 + wr * 64 + fr, col0 = (u.pn & 3) * 128 + wc * 16 + 4 * fq;
#pragma unroll
        for (int ai = 0; ai < 2; ++ai)
#pragma unroll
            for (int m = 0; m < 4; ++m) { bf16* rowp = HID + (size_t)(row0 + ai * 128 + m * 16) * DE + col0;
#pragma unroll
                for (int bj = 0; bj < 2; ++bj) { float h[4];
#pragma unroll
                    for (int j = 0; j < 4; ++j) { const float u1 = acc[ai][bj][m][0][j]; h[j] = u1 * fsigmoid(u1) * acc[ai][bj][m][1][j]; }
                    u32x2 w; w.x = pk2(h[0], h[1]); w.y = pk2(h[2], h[3]); *(u32x2*)(rowp + bj * 64) = w; } }
    }
};

struct MoeOrder {
    int nunits, G, vc; const int* tile_e;
    DI bool next(int i, pg8::Unit& u) const { const long L = (long)i * G + vc; if (L >= nunits) return false; const int rt = (int)(L >> 2);
        u.pm = rt; u.pn = __builtin_amdgcn_readfirstlane(tile_e[rt]) * 4 + (int)(L & 3); return true; }
    DI void a_ready(const pg8::Unit&) const {}
    DI void done(const pg8::Unit&) const {}
};

struct Args {
    const float *x, *c, *w_mod, *b_mod, *gains, *w_in, *gate_bias, *shift_mu, *w0, *w_decay_up, *a0, *w_iclr_up, *w_gate_up, *k_k, *k_a, *r_k, *lnx_w, *lnx_b,
                *w_o_sb, *w_o_rw, *w_out, *w_group, *w_router, *w_up1, *w_up3, *w_down;
    float* out; unsigned char* ws;
};
struct Frame { LAS unsigned char* lds; int tid, lane, wave, wg, G, gw, NGW; };
#define CAS __attribute__((address_space(4)))
typedef const CAS Args& ARef;

DI void tr_item(const float* W, int ldw, int K, bf16* WT, int k0, int drow0, int scol0, LAS float* scr, int lane) {
    if (scol0 >= 0) {
        float v[32];
        const float* wp = W + (size_t)(k0 + (lane >> 5)) * ldw + scol0 + (lane & 31);
#pragma unroll
        for (int i = 0; i < 32; ++i) v[i] = wp[(size_t)(2 * i) * ldw];
#pragma unroll
        for (int i = 0; i < 32; ++i) scr[(2 * i + (lane >> 5)) * 33 + (lane & 31)] = v[i];
    } else {
#pragma unroll 8
        for (int i = 0; i < 32; ++i) { const int kk = 2 * i + (lane >> 5); scr[kk * 33 + (lane & 31)] = 0.0f; }
    }
    wave_lds_fence();
    const int c = lane & 7;
#pragma unroll
    for (int j = 0; j < 4; ++j) { const int n = (lane >> 3) + 8 * j; const LAS float* s = scr + (8 * c) * 33 + n;
        u32x4 o; o.x = pk2(s[0 * 33], s[1 * 33]); o.y = pk2(s[2 * 33], s[3 * 33]); o.z = pk2(s[4 * 33], s[5 * 33]); o.w = pk2(s[6 * 33], s[7 * 33]);
        *(u32x4*)(WT + (size_t)(drow0 + n) * K + k0 + 8 * c) = o; }
    wave_lds_fence();
}
DI void tr_item_up(const float* W1, const float* W3, bf16* WT, int e, int k0, int drow0, LAS float* scr, int lane) {
    const int l31 = lane & 31, sc = (drow0 >> 3) * 4 + (l31 >> 3) * 4 + (l31 & 3);
    const float* W = ((l31 & 4) ? W3 : W1) + (size_t)e * D * DE;
    { float v[32]; const float* wp = W + (size_t)(k0 + (lane >> 5)) * DE + sc;
#pragma unroll
        for (int i = 0; i < 32; ++i) v[i] = wp[(size_t)(2 * i) * DE];
#pragma unroll
        for (int i = 0; i < 32; ++i) scr[(2 * i + (lane >> 5)) * 33 + l31] = v[i]; }
    wave_lds_fence();
    const int c = lane & 7;
#pragma unroll
    for (int j = 0; j < 4; ++j) { const int n = (lane >> 3) + 8 * j; const LAS float* s = scr + (8 * c) * 33 + n;
        u32x4 o; o.x = pk2(s[0 * 33], s[1 * 33]); o.y = pk2(s[2 * 33], s[3 * 33]); o.z = pk2(s[4 * 33], s[5 * 33]); o.w = pk2(s[6 * 33], s[7 * 33]);
        *(u32x4*)(WT + ((size_t)e * 1024 + drow0 + n) * D + k0 + 8 * c) = o; }
    wave_lds_fence();
}

DI void p0_prologue(const Frame& F0, ARef A) {
    Frame F = F0; F.tid = opq_tid(F0.wave); F.lane = F.tid & 63; F.wave = __builtin_amdgcn_readfirstlane(F.tid >> 6); F.gw = F.wg * NWAVES + F.wave;
    unsigned char* ws = A.ws;
    LAS float* sl = (LAS float*)F.lds;
    LAS float* part = (LAS float*)(F.lds + 16384);
    for (int i = F.tid; i < NB * D; i += NTHR) { const float v = A.c[i]; sl[i] = v * fsigmoid(v); }
    __syncthreads();
    float* mod = (float*)(ws + WS_MOD);
    for (int cg = F.wg; cg < 256; cg += F.G) {
        const int col = F.tid & 31, kg = F.tid >> 5;
        if (col < 24) { float a0 = 0.f, a1 = 0.f, a2 = 0.f, a3 = 0.f;
#pragma unroll 8
            for (int kk = 0; kk < 64; ++kk) { const int k = kg * 64 + kk; const float w = A.w_mod[(size_t)k * 6144 + cg * 24 + col];
                a0 += sl[k] * w; a1 += sl[D + k] * w; a2 += sl[2 * D + k] * w; a3 += sl[3 * D + k] * w; }
            LAS float* p = part + (kg * 24 + col) * 4; p[0] = a0; p[1] = a1; p[2] = a2; p[3] = a3; }
        __syncthreads();
        if (F.tid < 96) { const int c = F.tid >> 2, b = F.tid & 3; float s = 0.f;
#pragma unroll
            for (int kg2 = 0; kg2 < 16; ++kg2) s += part[(kg2 * 24 + c) * 4 + b];
            mod[b * 6144 + cg * 24 + c] = s + A.b_mod[cg * 24 + c]; }
        __syncthreads();
    }
    LAS float* scr = (LAS float*)(F.lds + 32768 + F.wave * 8704);
    constexpr int I_IN = (NPAD / 32) * (D / 64), I_OS = (D / 32) * (BW / 64), I_OUT = (D / 32) * (D / 64);
    for (int it = F.gw; it < I_IN + 2 * I_OS + I_OUT; it += F.NGW) {
        int r = it;
        if (r < I_IN) { const int g = r / (D / 64), kb = r % (D / 64), drow0 = 32 * g;
            const int sc = drow0 < 3360 ? drow0 : (drow0 < 3584 ? -1 : drow0 - 224);
            tr_item(A.w_in, IN_COLS, D, (bf16*)(ws + WS_WIN), 64 * kb, drow0, sc, scr, F.lane); continue; }
        r -= I_IN;
        if (r < I_OS) { const int g = r / (BW / 64), kb = r % (BW / 64); tr_item(A.w_o_sb, D, BW, (bf16*)(ws + WS_WOSB), 64 * kb, 32 * g, 32 * g, scr, F.lane); continue; }
        r -= I_OS;
        if (r < I_OS) { const int g = r / (BW / 64), kb = r % (BW / 64); tr_item(A.w_o_rw, D, BW, (bf16*)(ws + WS_WORW), 64 * kb, 32 * g, 32 * g, scr, F.lane); continue; }
        r -= I_OS;
        { const int g = r / (D / 64), kb = r % (D / 64); tr_item(A.w_out, D, D, (bf16*)(ws + WS_WOUT), 64 * kb, 32 * g, 32 * g, scr, F.lane); }
    }
    const int gt = F.wg * NTHR + F.tid, NGT = F.G * NTHR;
    float* rtw = (float*)(ws + WS_RTW);
    for (int i = gt; i < 36 * D; i += NGT) { const int o = i >> 10, k = i & (D - 1); rtw[i] = o < 4 ? A.w_group[k * 4 + o] : A.w_router[k * NE + (o - 4)]; }
    bf16* wl = (bf16*)(ws + WS_WL);
    for (int i = gt; i < 1536 * LK; i += NGT) { const int n = i / LK, k = i % LK; float v = 0.f;
        if (n < 512) { if (k < 64) v = A.w_decay_up[k * BW + n]; }
        else if (n < 1024) { if (k >= 64 && k < 128) v = A.w_iclr_up[(k - 64) * BW + (n - 512)]; }
        else { if (k >= 128 && k < 288) v = A.w_gate_up[(k - 128) * BW + (n - 1024)]; }
        wl[i] = (bf16)f2bf(v); }
}

DI void p1_h1(const Frame& F0, ARef A, bf16* H1) {
    Frame F = F0; F.tid = opq_tid(F0.wave); F.lane = F.tid & 63; F.wave = __builtin_amdgcn_readfirstlane(F.tid >> 6); F.gw = F.wg * NWAVES + F.wave;
    const float* mod = (const float*)(A.ws + WS_MOD);
    for (int n = F.gw; n < NTOK; n += F.NGW) {
        const int b = n >> 13;
        const f32x4* xr = (const f32x4*)(A.x + (size_t)n * D) + F.lane;
        f32x4 v[4]; float s = 0.f;
#pragma unroll
        for (int j = 0; j < 4; ++j) { v[j] = xr[64 * j]; s += (v[j][0] * v[j][0] + v[j][1] * v[j][1]) + (v[j][2] * v[j][2] + v[j][3] * v[j][3]); }
        const float inv = rsqrtf(wave_sum(s) * (1.0f / D) + NORM_EPS);
        u32x2* o = (u32x2*)(H1 + (size_t)n * D) + F.lane;
#pragma unroll
        for (int j = 0; j < 4; ++j) { const int k = 4 * F.lane + 256 * j;
            const f32x4 g = *(const f32x4*)(A.gains + k), sh = *(const f32x4*)(mod + b * 6144 + k), sc = *(const f32x4*)(mod + b * 6144 + D + k);
            f32x4 h;
#pragma unroll
            for (int q = 0; q < 4; ++q) h[q] = (v[j][q] * inv) * g[q] * (1.0f + sc[q]) + sh[q];
            u32x2 w; w.x = pk2(h[0], h[1]); w.y = pk2(h[2], h[3]); o[64 * j] = w; }
    }
}

DI void p3_attn(const Frame& F0, const bf16* QB, const bf16* KB, const bf16* VT, bf16* YSB) {
    Frame F = F0; F.tid = opq_tid(F0.wave); F.lane = F.tid & 63; F.wave = __builtin_amdgcn_readfirstlane(F.tid >> 6); F.gw = F.wg * NWAVES + F.wave;
    const int lane = F.lane, r = lane & 31, hh = lane >> 5;
    bf16x8 tri[2];
#pragma unroll
    for (int s = 0; s < 2; ++s)
#pragma unroll
        for (int e = 0; e < 8; ++e) tri[s][e] = (16 * s + 8 * (e >> 2) + 4 * hh + (e & 3)) > r ? (short)0x3F80 : (short)0;
    for (int u = F.gw; u < NB * NH * (SEQ / 32); u += F.NGW) {
        const int bh = u >> 8, qt = u & 255, b = bh >> 3, h = bh & 7;
        const bf16* qp = QB + (size_t)(b * SEQ + qt * 32 + r) * BW + h * HD + 8 * hh;
        bf16x8 qf[4];
#pragma unroll
        for (int ks = 0; ks < 4; ++ks) qf[ks] = *(const bf16x8*)(qp + 16 * ks);
        f32x16 o0, o1;
#pragma unroll
        for (int i = 0; i < 16; ++i) { o0[i] = 0.f; o1[i] = 0.f; }
        float L = 0.f;
        bf16x8 kf[4]; s16x4 vlo[2][2], vhi[2][2];
#define ATT_LOAD(KT, KF, VLO, VHI) do { const bf16* kp_ = KB + (size_t)(b * SEQ + (KT) * 32 + r) * BW + h * HD + 8 * hh; \
            _Pragma("unroll") for (int ks = 0; ks < 4; ++ks) KF[ks] = *(const bf16x8*)(kp_ + 16 * ks); \
            const bf16* vp_ = VT + ((size_t)(bh * HD + r)) * SEQ + (KT) * 32 + 4 * hh; \
            _Pragma("unroll") for (int mb = 0; mb < 2; ++mb) _Pragma("unroll") for (int ks = 0; ks < 2; ++ks) { VLO[mb][ks] = *(const s16x4*)(vp_ + (size_t)mb * 32 * SEQ + 16 * ks); VHI[mb][ks] = *(const s16x4*)(vp_ + (size_t)mb * 32 * SEQ + 16 * ks + 8); } } while (0)
        ATT_LOAD(qt, kf, vlo, vhi);
        for (int kt = qt; kt >= 0; --kt) {
            bf16x8 kfn[4]; s16x4 vlon[2][2], vhin[2][2];
            { const int ktn = kt > 0 ? kt - 1 : 0; ATT_LOAD(ktn, kfn, vlon, vhin); }
            f32x16 z;
#pragma unroll
            for (int i = 0; i < 16; ++i) z[i] = 0.f;
#pragma unroll
            for (int ks = 0; ks < 4; ++ks) z = MFMA32(kf[ks], qf[ks], z);
            const bool diag = (kt == qt);
            float lk[16], lo[16], tot = 0.f;
#pragma unroll
            for (int i = 0; i < 16; ++i) { const bool valid = !diag || (crow(i, hh) < r);
                const float sp = fsoftplus(z[i]); lk[i] = valid ? -sp : 0.0f; z[i] = valid ? z[i] - sp : -1.0e30f;
                tot += lk[i];
                const float hi = bflo(f2bf(lk[i])); lo[i] = lk[i] - hi; lk[i] = hi; }
            tot += shfl_xor_l(tot, 32, lane);
            f32x16 lat;
#pragma unroll
            for (int i = 0; i < 16; ++i) lat[i] = L;
#pragma unroll
            for (int s = 0; s < 2; ++s) {
                lat = MFMA32(tri[s], pack8v(lk[8 * s], lk[8 * s + 1], lk[8 * s + 2], lk[8 * s + 3], lk[8 * s + 4], lk[8 * s + 5], lk[8 * s + 6], lk[8 * s + 7]), lat);
                lat = MFMA32(tri[s], pack8v(lo[8 * s], lo[8 * s + 1], lo[8 * s + 2], lo[8 * s + 3], lo[8 * s + 4], lo[8 * s + 5], lo[8 * s + 6], lo[8 * s + 7]), lat); }
            float at[16];
#pragma unroll
            for (int i = 0; i < 16; ++i) at[i] = fexp(z[i] + lat[i]);
#pragma unroll
            for (int s = 0; s < 2; ++s) { const bf16x8 ab = pack8v(at[8 * s], at[8 * s + 1], at[8 * s + 2], at[8 * s + 3], at[8 * s + 4], at[8 * s + 5], at[8 * s + 6], at[8 * s + 7]);
                bf16x8 va, vb;
#pragma unroll
                for (int e = 0; e < 4; ++e) { va[e] = vlo[0][s][e]; va[4 + e] = vhi[0][s][e]; vb[e] = vlo[1][s][e]; vb[4 + e] = vhi[1][s][e]; }
                o0 = MFMA32(va, ab, o0); o1 = MFMA32(vb, ab, o1); }
            L += tot;
            if (__all(L < SB_STOP)) break;
#pragma unroll
            for (int ks = 0; ks < 4; ++ks) kf[ks] = kfn[ks];
#pragma unroll
            for (int mb = 0; mb < 2; ++mb)
#pragma unroll
                for (int ks = 0; ks < 2; ++ks) { vlo[mb][ks] = vlon[mb][ks]; vhi[mb][ks] = vhin[mb][ks]; }
        }
#undef ATT_LOAD
        bf16* op = YSB + (size_t)(b * SEQ + qt * 32 + r) * BW + h * HD + 4 * hh;
#pragma unroll
        for (int g = 0; g < 4; ++g) { u32x2 w0, w1; w0.x = pk2(o0[4 * g], o0[4 * g + 1]); w0.y = pk2(o0[4 * g + 2], o0[4 * g + 3]); w1.x = pk2(o1[4 * g], o1[4 * g + 1]); w1.y = pk2(o1[4 * g + 2], o1[4 * g + 3]);
            *(u32x2*)(op + 8 * g) = w0; *(u32x2*)(op + 32 + 8 * g) = w1; }
    }
}

DI void p3_prep(const Frame& F0, ARef A, const bf16* RWRAW, const bf16* LORA, bf16* R, bf16* KS, bf16* V, bf16* KK, bf16* ALORA) {
    Frame F = F0; F.tid = opq_tid(F0.wave); F.lane = F.tid & 63; F.wave = __builtin_amdgcn_readfirstlane(F.tid >> 6); F.gw = F.wg * NWAVES + F.wave;
    const int lane = F.lane;
    f32x4 mu[3][2], kkc[2], mul[2];
#pragma unroll
    for (int part = 0; part < 3; ++part) { mu[part][0] = *(const f32x4*)(A.shift_mu + part * 512 + lane * 8); mu[part][1] = *(const f32x4*)(A.shift_mu + part * 512 + lane * 8 + 4); }
    kkc[0] = *(const f32x4*)(A.k_k + lane * 8); kkc[1] = *(const f32x4*)(A.k_k + lane * 8 + 4);
    const int lcol = lane < 36 ? lane * 8 : 0;
    mul[0] = *(const f32x4*)(A.shift_mu + 1536 + lcol); mul[1] = *(const f32x4*)(A.shift_mu + 1536 + lcol + 4);
    constexpr int RUN = 16;
    for (int run = F.gw; run < NTOK / RUN; run += F.NGW) {
        const int n0 = run * RUN;
        u32x4 prv[3], prl, cur[3], cul;
        const u32x4 z4 = {0u, 0u, 0u, 0u};
        if ((n0 & (SEQ - 1)) == 0) { prv[0] = z4; prv[1] = z4; prv[2] = z4; prl = z4; }
        else {
#pragma unroll
            for (int part = 0; part < 3; ++part) prv[part] = *(const u32x4*)(RWRAW + (size_t)(n0 - 1) * 1536 + part * 512 + lane * 8);
            prl = *(const u32x4*)(LORA + (size_t)(n0 - 1) * BW + lcol); }
#pragma unroll
        for (int part = 0; part < 3; ++part) cur[part] = *(const u32x4*)(RWRAW + (size_t)n0 * 1536 + part * 512 + lane * 8);
        cul = *(const u32x4*)(LORA + (size_t)n0 * BW + lcol);
        for (int i = 0; i < RUN; ++i) {
            const int n = n0 + i, nn = i + 1 < RUN ? n + 1 : n;
            u32x4 nxt[3], nxl;
#pragma unroll
            for (int part = 0; part < 3; ++part) nxt[part] = *(const u32x4*)(RWRAW + (size_t)nn * 1536 + part * 512 + lane * 8);
            nxl = *(const u32x4*)(LORA + (size_t)nn * BW + lcol);
            float xs[3][8];
#pragma unroll
            for (int part = 0; part < 3; ++part) { float p[8], q[8]; unpack8(cur[part], p); unpack8(prv[part], q);
#pragma unroll
                for (int j = 0; j < 4; ++j) { xs[part][j] = p[j] + mu[part][0][j] * (q[j] - p[j]); xs[part][4 + j] = p[4 + j] + mu[part][1][j] * (q[4 + j] - p[4 + j]); } }
            const size_t off = (size_t)n * BW + lane * 8;
            *(u32x4*)(R + off) = pack8(xs[0]); *(u32x4*)(KS + off) = pack8(xs[1]); *(u32x4*)(V + off) = pack8(xs[2]);
            float kk[8], ss = 0.f;
#pragma unroll
            for (int j = 0; j < 4; ++j) { kk[j] = xs[1][j] * kkc[0][j]; kk[4 + j] = xs[1][4 + j] * kkc[1][j]; }
#pragma unroll
            for (int j = 0; j < 8; ++j) ss += kk[j] * kk[j];
            ss += shfl_xor_l(ss, 1, lane); ss += shfl_xor_l(ss, 2, lane); ss += shfl_xor_l(ss, 4, lane);
            const float rn = 1.0f / fmaxf(sqrtf(ss), L2_EPS);
#pragma unroll
            for (int j = 0; j < 8; ++j) kk[j] *= rn;
            *(u32x4*)(KK + off) = pack8(kk);
            if (lane < 48) { float a[8];
                if (lane < 36) { float p[8], q[8]; unpack8(cul, p); unpack8(prl, q);
#pragma unroll
                    for (int j = 0; j < 8; ++j) { const float m = j < 4 ? mul[0][j & 3] : mul[1][j & 3]; const float v = p[j] + m * (q[j] - p[j]);
                        a[j] = lane < 8 ? (1.0f - 2.0f * frcp(fexp(2.0f * v) + 1.0f)) : (lane < 16 ? v : fsigmoid(v)); }
                } else {
#pragma unroll
                    for (int j = 0; j < 8; ++j) a[j] = 0.f; }
                *(u32x4*)(ALORA + (size_t)n * LK + lane * 8) = pack8(a); }
#pragma unroll
            for (int part = 0; part < 3; ++part) { prv[part] = cur[part]; cur[part] = nxt[part]; }
            prl = cul; cul = nxl;
        }
    }
}

DI void p4_lora(const Frame& F0, ARef A, const bf16* ALORA, const bf16* WL, bf16* E, bf16* KS, bf16* Bo, bf16* GG, const bf16* KK, const bf16* R, float* BON) {
    Frame F = F0; F.tid = opq_tid(F0.wave); F.lane = F.tid & 63; F.wave = __builtin_amdgcn_readfirstlane(F.tid >> 6); F.gw = F.wg * NWAVES + F.wave;
    const int lane = F.lane, r = lane & 31, hh = lane >> 5;
    for (int u = F.gw; u < 2 * (NTOK / 32); u += F.NGW) {
        const int n0 = (u >> 1) * 32, par = u & 1;
        bf16x8 tf[18];
#pragma unroll
        for (int ks = 0; ks < 18; ++ks) tf[ks] = *(const bf16x8*)(ALORA + (size_t)(n0 + r) * LK + 16 * ks + 8 * hh);
        const unsigned orow = (unsigned)(n0 + r) * BW + 4 * hh;
#define LORA_BLOCK(KS0, NKS, CB, BODY) { const int c0_ = 32 * ((CB) & 15); f32x16 acc_; \
            _Pragma("unroll") for (int q = 0; q < 16; ++q) acc_[q] = 0.f; \
            _Pragma("unroll") for (int ks = 0; ks < (NKS); ++ks) acc_ = MFMA32(*(const bf16x8*)(WL + (size_t)(32 * (CB) + r) * LK + 16 * ((KS0) + ks) + 8 * hh), tf[(KS0) + ks], acc_); \
            BODY }
        for (int i = 0; i < 8; ++i) { const int cb = 4 * (i >> 1) + 2 * par + (i & 1);
            LORA_BLOCK(0, 4, cb, {
                _Pragma("unroll") for (int g = 0; g < 4; ++g) { const f32x4 w0v = *(const f32x4*)(A.w0 + c0_ + 8 * g + 4 * hh); float e4[4];
                    _Pragma("unroll") for (int j = 0; j < 4; ++j) { const float v = acc_[4 * g + j] + w0v[j]; e4[j] = fexp(-fsoftplus(-v) - 0.5f); }
                    u32x2 w; w.x = pk2(e4[0], e4[1]); w.y = pk2(e4[2], e4[3]); *(u32x2*)(E + orow + c0_ + 8 * g) = w; } }) }
        float bsum = 0.f;
        for (int i = 0; i < 8; ++i) { const int cb = 16 + 4 * (i >> 1) + 2 * par + (i & 1);
            LORA_BLOCK(4, 4, cb, {
                _Pragma("unroll") for (int g = 0; g < 4; ++g) { const f32x4 a0v = *(const f32x4*)(A.a0 + c0_ + 8 * g + 4 * hh); const f32x4 kav = *(const f32x4*)(A.k_a + c0_ + 8 * g + 4 * hh);
                    const unsigned o = orow + c0_ + 8 * g; const u32x2 kw = *(const u32x2*)(KS + o); const u32x2 qw = *(const u32x2*)(KK + o); const u32x2 rw = *(const u32x2*)(R + o); const f32x4 rkv = *(const f32x4*)(A.r_k + c0_ + 8 * g + 4 * hh);
                    float ksv[4]; float kkv[4]; float kp[4]; float bb[4]; ksv[0] = bflo(kw.x); ksv[1] = bfhi(kw.x); ksv[2] = bflo(kw.y); ksv[3] = bfhi(kw.y); kkv[0] = bflo(qw.x); kkv[1] = bfhi(qw.x); kkv[2] = bflo(qw.y); kkv[3] = bfhi(qw.y);
                    _Pragma("unroll") for (int j = 0; j < 4; ++j) { const float s0 = fsigmoid(acc_[4 * g + j] + a0v[j]); kp[j] = ksv[j] * (1.0f + (s0 - 1.0f) * kav[j]); bb[j] = kkv[j] * s0; }
                    bsum += (bflo(rw.x) * kp[0] * rkv[0] + bfhi(rw.x) * kp[1] * rkv[1]) + (bflo(rw.y) * kp[2] * rkv[2] + bfhi(rw.y) * kp[3] * rkv[3]);
                    u32x2 w1; u32x2 w2; w1.x = pk2(kp[0], kp[1]); w1.y = pk2(kp[2], kp[3]); w2.x = pk2(bb[0], bb[1]); w2.y = pk2(bb[2], bb[3]); *(u32x2*)(KS + o) = w1; *(u32x2*)(Bo + o) = w2; } })
            if (i & 1) { const float tot = bsum + shfl_xor_l(bsum, 32, lane); if (hh == 0) BON[(size_t)(n0 + r) * 8 + 2 * (i >> 1) + par] = tot; bsum = 0.f; } }
        for (int i = 0; i < 8; ++i) { const int cb = 32 + 4 * (i >> 1) + 2 * par + (i & 1);
            LORA_BLOCK(8, 10, cb, {
                _Pragma("unroll") for (int g = 0; g < 4; ++g) { u32x2 w; w.x = pk2(acc_[4 * g], acc_[4 * g + 1]); w.y = pk2(acc_[4 * g + 2], acc_[4 * g + 3]); *(u32x2*)(GG + orow + c0_ + 8 * g) = w; } }) }
#undef LORA_BLOCK
    }
}

DI void p6_chain(int task, int wave, const bf16* GT, const bf16* HT, bf16* SC) {
    const int lane = opq_tid(wave) & 63;
    const int bh = task >> 1, nb = task & 1, r = lane & 31, hh = lane >> 5, i = nb * 32 + r;
    f32x16 X[2];
#pragma unroll
    for (int q = 0; q < 16; ++q) { X[0][q] = 0.f; X[1][q] = 0.f; }
    f32x16 H0[2], H1[2]; bf16x8 G0[8], G1[8];
#define CHAIN_FETCH(cc, HS, GS) do { const bf16* ht_ = HT + ((size_t)bh * NCH + (cc)) * 4096; const bf16* gt_ = GT + ((size_t)bh * NCH + (cc)) * 4096; \
        _Pragma("unroll") for (int kb = 0; kb < 2; ++kb) _Pragma("unroll") for (int g = 0; g < 4; ++g) { const u32x2 w_ = *(const u32x2*)(ht_ + ((((kb * 2 + nb) * 4 + g) * 64) + lane) * 4); \
            HS[kb][4 * g] = bflo(w_.x); HS[kb][4 * g + 1] = bfhi(w_.x); HS[kb][4 * g + 2] = bflo(w_.y); HS[kb][4 * g + 3] = bfhi(w_.y); } \
        _Pragma("unroll") for (int f = 0; f < 8; ++f) GS[f] = *(const bf16x8*)(gt_ + (f * 64 + lane) * 8); } while (0)
#define CHAIN_STORE(cc) do { bf16* sc_ = SC + ((size_t)bh * NCH + (cc)) * 4096; \
        _Pragma("unroll") for (int jb = 0; jb < 2; ++jb) _Pragma("unroll") for (int g = 0; g < 4; ++g) { u32x2 w_; w_.x = pk2(X[jb][4 * g], X[jb][4 * g + 1]); w_.y = pk2(X[jb][4 * g + 2], X[jb][4 * g + 3]); \
            *(u32x2*)(sc_ + ((((jb * 2 + nb) * 4 + g) * 64) + lane) * 4) = w_; } } while (0)
#define CHAIN_STEP(HS, GS) do { bf16x8 xb_[2][2]; \
        _Pragma("unroll") for (int jb = 0; jb < 2; ++jb) _Pragma("unroll") for (int s = 0; s < 2; ++s) \
            xb_[jb][s] = pack8v(X[jb][8 * s], X[jb][8 * s + 1], X[jb][8 * s + 2], X[jb][8 * s + 3], X[jb][8 * s + 4], X[jb][8 * s + 5], X[jb][8 * s + 6], X[jb][8 * s + 7]); \
        X[0] = HS[0]; X[1] = HS[1]; \
        _Pragma("unroll") for (int kb = 0; kb < 2; ++kb) _Pragma("unroll") for (int jb = 0; jb < 2; ++jb) _Pragma("unroll") for (int s = 0; s < 2; ++s) X[kb] = MFMA32(GS[kb * 4 + jb * 2 + s], xb_[jb][s], X[kb]); } while (0)
    CHAIN_FETCH(0, H0, G0); CHAIN_FETCH(1, H1, G1);
    for (int c = 0; c < NCH; c += 2) {
        CHAIN_STORE(c);
        CHAIN_STEP(H0, G0);
        if (c + 2 < NCH - 1) CHAIN_FETCH(c + 2, H0, G0);
        CHAIN_STORE(c + 1);
        if (c + 1 < NCH - 1) { CHAIN_STEP(H1, G1);
            if (c + 3 < NCH - 1) CHAIN_FETCH(c + 3, H1, G1); }
    }
#undef CHAIN_FETCH
#undef CHAIN_STORE
#undef CHAIN_STEP
}

DI void p6_moe_weights(const Frame& F0, ARef A, int wi, int NW) {
    Frame F = F0; F.tid = opq_tid(F0.wave); F.lane = F.tid & 63; F.wave = __builtin_amdgcn_readfirstlane(F.tid >> 6); F.gw = F.wg * NWAVES + F.wave;
    LAS float* scr = (LAS float*)(F.lds + F.wave * 20480);
    constexpr int I_UP = NE * 32 * 16, I_DN = NE * 32 * 8;
    for (int it = wi; it < I_UP + I_DN; it += NW) {
        if (it < I_UP) { const int e = it >> 9, g = (it >> 4) & 31, kb = it & 15; tr_item_up(A.w_up1, A.w_up3, (bf16*)(A.ws + WS_WUP), e, 64 * kb, 32 * g, scr, F.lane); }
        else { const int r = it - I_UP, e = r >> 8, g = (r >> 3) & 31, kb = r & 7;
            tr_item(A.w_down + (size_t)e * DE * D, D, DE, (bf16*)(A.ws + WS_WDN) + (size_t)e * 1024 * DE, 64 * kb, 32 * g, 32 * g, scr, F.lane); }
    }
}

DI float half_bcast_sum(float v, int hh) {
    v += DPP_SHR(v, 0x111); v += DPP_SHR(v, 0x112); v += DPP_SHR(v, 0x114); v += DPP_SHR(v, 0x118);
    v += __builtin_bit_cast(float, __builtin_amdgcn_update_dpp(0, __builtin_bit_cast(int, v), 0x142, 0xa, 0xf, false));
    const float lo = __builtin_bit_cast(float, __builtin_amdgcn_readlane(__builtin_bit_cast(int, v), 31)), hi = __builtin_bit_cast(float, __builtin_amdgcn_readlane(__builtin_bit_cast(int, v), 63));
    return hh ? hi : lo; }
DI void p7_mfma(const Frame& F0, ARef A, const bf16* SC, const bf16* Pn, const bf16* QOn, const bf16* V, const bf16* GG, const float* BON, bf16* YRW) {
    Frame F = F0; F.tid = opq_tid(F0.wave); F.lane = F.tid & 63; F.wave = __builtin_amdgcn_readfirstlane(F.tid >> 6); F.gw = F.wg * NWAVES + F.wave;
    const int lane = F.lane, r = lane & 31, hh = lane >> 5;
    for (int cid = F.gw; cid < NCHUNK; cid += F.NGW) {
        const int bh = cid >> NCH_LOG, c = cid & (NCH - 1), b = bh >> 3, h = bh & 7;
        const unsigned n0 = (unsigned)b * SEQ + (unsigned)c * CH; const int col0 = h * HD;
        const bf16* sc = SC + (size_t)cid * 4096; const bf16* pn = Pn + (size_t)cid * 4096; const bf16* qn = QOn + (size_t)cid * 4096;
        bf16x8 Sf[2][2][2], Pf[2][2][2];
#pragma unroll
        for (int jb = 0; jb < 2; ++jb)
#pragma unroll
            for (int xb = 0; xb < 2; ++xb)
#pragma unroll
                for (int s = 0; s < 2; ++s) { const s16x4 lo = *(const s16x4*)(sc + ((((jb * 2 + xb) * 4 + 2 * s) * 64) + lane) * 4), hi = *(const s16x4*)(sc + ((((jb * 2 + xb) * 4 + 2 * s + 1) * 64) + lane) * 4);
#pragma unroll
                    for (int e = 0; e < 4; ++e) { Sf[jb][xb][s][e] = lo[e]; Sf[jb][xb][s][4 + e] = hi[e]; }
                    Pf[jb][xb][s] = *(const bf16x8*)(pn + ((((jb * 2 + xb) * 2 + s) * 64) + lane) * 8); }
        f32x16 Z[2][2];
#pragma unroll
        for (int tb = 0; tb < 2; ++tb)
#pragma unroll
            for (int nb = 0; nb < 2; ++nb) {
#pragma unroll
                for (int g = 0; g < 4; ++g) { const u32x2 w = *(const u32x2*)(qn + ((((tb * 2 + nb) * 4 + g) * 64) + lane) * 4);
                    Z[tb][nb][4 * g] = bflo(w.x); Z[tb][nb][4 * g + 1] = bfhi(w.x); Z[tb][nb][4 * g + 2] = bflo(w.y); Z[tb][nb][4 * g + 3] = bfhi(w.y); }
#pragma unroll
                for (int jb = 0; jb < 2; ++jb)
#pragma unroll
                    for (int s = 0; s < 2; ++s) Z[tb][nb] = MFMA32(Pf[jb][tb][s], Sf[jb][nb][s], Z[tb][nb]); }
        float lw[2], lb[2];
#pragma unroll
        for (int nb = 0; nb < 2; ++nb) { lw[nb] = A.lnx_w[col0 + 32 * nb + r]; lb[nb] = A.lnx_b[col0 + 32 * nb + r]; }
#pragma unroll
        for (int tb = 0; tb < 2; ++tb)
#pragma unroll
            for (int q = 0; q < 16; ++q) {
                const unsigned tokrow = n0 + 32 * tb + 4 * hh + (q & 3) + 8 * (q >> 2);
                const float mean = half_bcast_sum(Z[tb][0][q] + Z[tb][1][q], hh) * (1.0f / 64.0f);
                const float d0 = Z[tb][0][q] - mean, d1 = Z[tb][1][q] - mean;
                const float rs = rsqrtf(half_bcast_sum(d0 * d0 + d1 * d1, hh) * (1.0f / 64.0f) + GN_EPS);
                const float bon = BON[(size_t)tokrow * 8 + h];
                const unsigned o0 = tokrow * BW + col0 + r;
                YRW[o0] = (bf16)f2bf((d0 * rs * lw[0] + lb[0] + bon * bf2f(V[o0])) * bf2f(GG[o0]));
                YRW[o0 + 32] = (bf16)f2bf((d1 * rs * lw[1] + lb[1] + bon * bf2f(V[o0 + 32])) * bf2f(GG[o0 + 32]));
                if ((q & 3) == 3) __builtin_amdgcn_sched_barrier(0); }
    }
}

DI void p10_rows(const Frame& F0, ARef A, const bf16* Y1, bf16* H2) {
    Frame F = F0; F.tid = opq_tid(F0.wave); F.lane = F.tid & 63; F.wave = __builtin_amdgcn_readfirstlane(F.tid >> 6); F.gw = F.wg * NWAVES + F.wave;
    const int lane = F.lane;
    const float* mod = (const float*)(A.ws + WS_MOD);
    LAS float* rw = (LAS float*)F.lds;
    LAS int* hist = (LAS int*)(F.lds + 147456);
    { const float* src = (const float*)(A.ws + WS_RTW);
        for (int i = F.tid; i < 18 * D; i += NTHR) { const int op = i >> 10, k = i & (D - 1); typedef float f2_t __attribute__((ext_vector_type(2))); f2_t w; w.x = src[(2 * op) * D + k]; w.y = src[(2 * op + 1) * D + k]; *(LAS f2_t*)(rw + 2 * i) = w; } }
    i32x4* tok = (i32x4*)(A.ws + WS_TOK); int* cnt = (int*)(A.ws + WS_CNT);
    for (int tb = F.wg; tb < NTOK / 128; tb += F.G) {
        if (F.tid < 32) hist[F.tid] = 0;
        __syncthreads();
        for (int tl = F.wave; tl < 128; tl += NWAVES) {
            const int n = tb * 128 + tl, b = n >> 13;
            const f32x4* xr = (const f32x4*)(A.x + (size_t)n * D) + lane; const u32x2* yr = (const u32x2*)(Y1 + (size_t)n * D) + lane;
            f32x4 xv[4], yv[4]; float s = 0.f;
#pragma unroll
            for (int j = 0; j < 4; ++j) { xv[j] = xr[64 * j]; const u32x2 w = yr[64 * j]; yv[j][0] = bflo(w.x); yv[j][1] = bfhi(w.x); yv[j][2] = bflo(w.y); yv[j][3] = bfhi(w.y);
                s += (yv[j][0] * yv[j][0] + yv[j][1] * yv[j][1]) + (yv[j][2] * yv[j][2] + yv[j][3] * yv[j][3]); }
            const float inv1 = rsqrtf(wave_sum(s) * (1.0f / D) + NORM_EPS);
            float s2 = 0.f;
#pragma unroll
            for (int j = 0; j < 4; ++j) { const int k = 4 * lane + 256 * j;
                const f32x4 g1 = *(const f32x4*)(A.gains + D + k), gt = *(const f32x4*)(mod + b * 6144 + 2 * D + k);
#pragma unroll
                for (int q = 0; q < 4; ++q) { xv[j][q] = xv[j][q] + gt[q] * ((yv[j][q] * inv1) * g1[q]); s2 += xv[j][q] * xv[j][q]; }
                *((f32x4*)(A.out + (size_t)n * D) + lane + 64 * j) = xv[j]; }
            const float inv2 = rsqrtf(wave_sum(s2) * (1.0f / D) + NORM_EPS);
            f32x4 hv[4];
#pragma unroll
            for (int j = 0; j < 4; ++j) { const int k = 4 * lane + 256 * j;
                const f32x4 g2 = *(const f32x4*)(A.gains + 2 * D + k), sh = *(const f32x4*)(mod + b * 6144 + 3 * D + k), sc = *(const f32x4*)(mod + b * 6144 + 4 * D + k);
#pragma unroll
                for (int q = 0; q < 4; ++q) hv[j][q] = (xv[j][q] * inv2) * g2[q] * (1.0f + sc[q]) + sh[q];
                u32x2 w; w.x = pk2(hv[j][0], hv[j][1]); w.y = pk2(hv[j][2], hv[j][3]); *((u32x2*)(H2 + (size_t)n * D) + lane + 64 * j) = w; }
            float lg[36];
#pragma unroll
            for (int op = 0; op < 18; ++op) { typedef float f2_t __attribute__((ext_vector_type(2))); f2_t a = {0.f, 0.f};
#pragma unroll
                for (int j = 0; j < 4; ++j) { const LAS f32x4* wp = (const LAS f32x4*)(rw + (op * D + 4 * lane + 256 * j) * 2); const f32x4 wA = wp[0], wB = wp[1];
                    a += (f2_t){hv[j][0], hv[j][0]} * (f2_t){wA[0], wA[1]}; a += (f2_t){hv[j][1], hv[j][1]} * (f2_t){wA[2], wA[3]};
                    a += (f2_t){hv[j][2], hv[j][2]} * (f2_t){wB[0], wB[1]}; a += (f2_t){hv[j][3], hv[j][3]} * (f2_t){wB[2], wB[3]}; }
                lg[2 * op] = wave_sum(a.x); lg[2 * op + 1] = wave_sum(a.y); if (op & 1) __builtin_amdgcn_sched_barrier(0); }
            int gs = 0; float gm = lg[0];
#pragma unroll
            for (int g = 1; g < 4; ++g) if (lg[g] > gm) { gm = lg[g]; gs = g; }
            float gsum = 0.f;
#pragma unroll
            for (int g = 0; g < 4; ++g) gsum += fexp(lg[g] - gm);
            const float gw = 1.0f / gsum;
            float el[8];
#pragma unroll
            for (int e = 0; e < 8; ++e) el[e] = gs == 0 ? lg[4 + e] : (gs == 1 ? lg[12 + e] : (gs == 2 ? lg[20 + e] : lg[28 + e]));
            int i0 = 0; float m0 = el[0];
#pragma unroll
            for (int e = 1; e < 8; ++e) if (el[e] > m0) { m0 = el[e]; i0 = e; }
            int i1 = -1; float m1 = -3.0e38f;
#pragma unroll
            for (int e = 0; e < 8; ++e) if (e != i0 && el[e] > m1) { m1 = el[e]; i1 = e; }
            const float t = fexp(m1 - m0), p0 = 1.0f / (1.0f + t), p1 = t * p0;
            const int e0 = gs * 8 + i0, e1 = gs * 8 + i1;
#if defined(CHECKS)
            if (lane == 0 && n == DBG_TOKEN) { float* dbg = (float*)(A.ws + WS_CTL + 32768) + 48; dbg[0] = lg[0]; dbg[1] = lg[1]; dbg[2] = lg[2]; dbg[3] = lg[3]; dbg[4] = gsum; dbg[5] = p0; dbg[6] = gw; dbg[7] = t; }
#endif
            if (lane == 0) { i32x4 rec; rec.x = e0 | (e1 << 8); rec.y = 0; rec.z = 0; rec.w = 0; tok[n] = rec;
                float* cwp = (float*)(A.ws + WS_CW) + 2 * n; cwp[0] = gw * p0; cwp[1] = gw * p1;
                atomicAdd((int*)&hist[e0], 1); atomicAdd((int*)&hist[e1], 1); }
        }
        __syncthreads();
        if (F.tid < 32) cnt[tb * 32 + F.tid] = hist[F.tid];
        __syncthreads();
    }
}

DI void p11_rank_gather(const Frame& F0, ARef A, const bf16* H2, bf16* HS) {
    Frame F = F0; F.tid = opq_tid(F0.wave); F.lane = F.tid & 63; F.wave = __builtin_amdgcn_readfirstlane(F.tid >> 6); F.gw = F.wg * NWAVES + F.wave;
    LAS int* base = (LAS int*)F.lds;
    LAS int* seg = base + 32;
    LAS int* el = base + 96;
    LAS int* pos = base + 352;
    i32x4* tok = (i32x4*)(A.ws + WS_TOK); const int* cnt = (const int*)(A.ws + WS_CNT); int* tile = (int*)(A.ws + WS_TILE);
    for (int tb = F.wg; tb < NTOK / 128; tb += F.G) {
        if (F.tid < 32) { int tot = 0, pre = 0;
            for (int t2 = 0; t2 < NTOK / 128; ++t2) { const int v = cnt[t2 * 32 + F.tid]; tot += v; if (t2 < tb) pre += v; }
            base[F.tid] = pre; seg[F.tid] = (tot + 255) & ~255; }
        if (F.tid >= 64 && F.tid < 64 + 128) { const i32x4 rec = tok[tb * 128 + (F.tid - 64)]; el[2 * (F.tid - 64)] = rec.x & 255; el[2 * (F.tid - 64) + 1] = (rec.x >> 8) & 255; }
        __syncthreads();
        if (F.tid == 0) { int acc = 0; for (int e = 0; e < 32; ++e) { const int sz = seg[e]; seg[e] = acc; acc += sz; } seg[32] = acc; }
        __syncthreads();
        if (F.tid < 32) { int p = seg[F.tid] + base[F.tid];
            for (int q = 0; q < 256; ++q) if (el[q] == F.tid) pos[q] = p++; }
        if (tb == 0 && F.tid >= 64 && F.tid < 64 + 32) { const int e = F.tid - 64;
            for (int t2 = seg[e] >> 8; t2 < (seg[e + 1] >> 8); ++t2) tile[t2] = e;
            if (e == 0) tile[MAXT] = seg[32] >> 8; }
        __syncthreads();
        if (F.tid < 128) { i32x4 rec = tok[tb * 128 + F.tid]; rec.x = pos[2 * F.tid]; rec.y = pos[2 * F.tid + 1]; tok[tb * 128 + F.tid] = rec; }
        for (int q = F.wave; q < 256; q += NWAVES) { const int n = tb * 128 + (q >> 1);
            const u32x4* src = (const u32x4*)(H2 + (size_t)n * D) + F.lane; u32x4* dst = (u32x4*)(HS + (size_t)pos[q] * D) + F.lane;
            dst[0] = src[0]; dst[64] = src[64]; }
        __syncthreads();
    }
}

DI void p14_final(const Frame& F0, ARef A, const bf16* YE) {
    Frame F = F0; F.tid = opq_tid(F0.wave); F.lane = F.tid & 63; F.wave = __builtin_amdgcn_readfirstlane(F.tid >> 6); F.gw = F.wg * NWAVES + F.wave;
    const int lane = F.lane;
    const float* mod = (const float*)(A.ws + WS_MOD); const i32x4* tok = (const i32x4*)(A.ws + WS_TOK);
    for (int n = F.gw; n < NTOK; n += F.NGW) {
        const int b = n >> 13; const i32x4 rec = tok[n];
        const float c0 = ((const float*)(A.ws + WS_CW))[2 * n], c1 = ((const float*)(A.ws + WS_CW))[2 * n + 1];
        const u32x2* y0 = (const u32x2*)(YE + (size_t)rec.x * D) + lane; const u32x2* y1 = (const u32x2*)(YE + (size_t)rec.y * D) + lane;
        f32x4 yv[4]; float s = 0.f;
#pragma unroll
        for (int j = 0; j < 4; ++j) { const u32x2 a = y0[64 * j], bq = y1[64 * j];
            yv[j][0] = c0 * bflo(a.x) + c1 * bflo(bq.x); yv[j][1] = c0 * bfhi(a.x) + c1 * bfhi(bq.x); yv[j][2] = c0 * bflo(a.y) + c1 * bflo(bq.y); yv[j][3] = c0 * bfhi(a.y) + c1 * bfhi(bq.y);
            s += (yv[j][0] * yv[j][0] + yv[j][1] * yv[j][1]) + (yv[j][2] * yv[j][2] + yv[j][3] * yv[j][3]); }
        const float inv = rsqrtf(wave_sum(s) * (1.0f / D) + NORM_EPS);
#pragma unroll
        for (int j = 0; j < 4; ++j) { const int k = 4 * lane + 256 * j;
            const f32x4 g3 = *(const f32x4*)(A.gains + 3 * D + k), gt = *(const f32x4*)(mod + b * 6144 + 5 * D + k);
            f32x4* op = (f32x4*)(A.out + (size_t)n * D) + lane + 64 * j; f32x4 xv = *op;
#pragma unroll
            for (int q = 0; q < 4; ++q) xv[q] = xv[q] + gt[q] * ((yv[j][q] * inv) * g3[q]);
            *op = xv; }
    }
}

DI bf16x8 pk_tile(const f32x16& x, const int s) { return pack8v(x[8 * s], x[8 * s + 1], x[8 * s + 2], x[8 * s + 3], x[8 * s + 4], x[8 * s + 5], x[8 * s + 6], x[8 * s + 7]); }
constexpr int FS = 72;
DI bf16x8 rd_frag(const LAS bf16* buf, int tb, int cb, int s, int r, int hh) {
    const LAS bf16* p = buf + (32 * cb + r) * FS + 32 * tb + 16 * s + 4 * hh;
    const s16x4 lo = *(const LAS s16x4*)p, hi = *(const LAS s16x4*)(p + 8); bf16x8 f;
#pragma unroll
    for (int e = 0; e < 4; ++e) { f[e] = lo[e]; f[4 + e] = hi[e]; }
    return f; }
DI void wr_tile_ft(LAS bf16* buf, const f32x16& x, int tb, int cb, int r, int hh) {
#pragma unroll
    for (int g = 0; g < 4; ++g) { u32x2 w; w.x = pk2(x[4 * g], x[4 * g + 1]); w.y = pk2(x[4 * g + 2], x[4 * g + 3]); *(LAS u32x2*)(buf + (32 * cb + r) * FS + 32 * tb + 8 * g + 4 * hh) = w; } }
DI void wr_l_ft(LAS bf16* buf, const float (&x)[64], int lane) {
#pragma unroll
    for (int t8 = 0; t8 < 8; ++t8) { u32x4 w; w.x = pk2(x[8 * t8], x[8 * t8 + 1]); w.y = pk2(x[8 * t8 + 2], x[8 * t8 + 3]); w.z = pk2(x[8 * t8 + 4], x[8 * t8 + 5]); w.w = pk2(x[8 * t8 + 6], x[8 * t8 + 7]);
        *(LAS u32x4*)(buf + lane * FS + 8 * t8) = w; } }

#if defined(STAMPS)
#define P5STAMP(k) do { p5ts[k] = __builtin_amdgcn_s_memrealtime(); } while (0)
#else
#define P5STAMP(k) do { } while (0)
#endif
DI void p5_mfma(unsigned char* F0_ws, const Frame& F0, const bf16* R, const bf16* KP, const bf16* V, const bf16* KK, const bf16* Bv, const bf16* Ev, bf16* P, bf16* QO, bf16* GT, bf16* HT) {
    Frame F = F0; F.tid = opq_tid(F0.wave); F.lane = F.tid & 63; F.wave = __builtin_amdgcn_readfirstlane(F.tid >> 6); F.gw = F.wg * NWAVES + F.wave;
    const int lane = F.lane, r = lane & 31, hh = lane >> 5;
    LAS unsigned char* wl = F.lds + F.wave * 20480;
    LAS bf16* buf0 = (LAS bf16*)wl; LAS bf16* buf1 = (LAS bf16*)(wl + 9216);
    LAS float* LT = (LAS float*)wl;
    LAS float* LC = (LAS float*)(wl + 18432);
    for (int cid = F.gw; cid < NCHUNK; cid += F.NGW) {
        const int bh = cid >> NCH_LOG, c = cid & (NCH - 1), b = bh >> 3, h = bh & 7;
        const unsigned n0 = (unsigned)b * SEQ + (unsigned)c * CH, col0 = (unsigned)h * HD;
        int ln = lane; asm volatile("" : "+v"(ln));
#if defined(STAMPS)
        unsigned long long p5ts[10];
#endif
        const int rm = ln & 31, hm = ln >> 5;
        const bf16 *R0_ = R, *KP0_ = KP, *V0_ = V, *KK0_ = KK, *Bv0_ = Bv, *Ev0_ = Ev; bf16 *P0_ = P, *QO0_ = QO;
        asm volatile("" : "+s"(R0_), "+s"(KP0_), "+s"(V0_), "+s"(KK0_), "+s"(Bv0_), "+s"(Ev0_), "+s"(P0_), "+s"(QO0_));
        const GAS char *R_ = (const GAS char*)R0_, *KP_ = (const GAS char*)KP0_, *V_ = (const GAS char*)V0_, *KK_ = (const GAS char*)KK0_, *Bv_ = (const GAS char*)Bv0_, *Ev_ = (const GAS char*)Ev0_;
        GAS char *P_ = (GAS char*)P0_, *QO_ = (GAS char*)QO0_;
        const unsigned nb0 = n0 * BW + col0;
        const unsigned vL = (nb0 + (unsigned)ln) * 2u, vT = (nb0 + (unsigned)rm * BW + 4u * hm) * 2u, vC = (nb0 + 4u * hm * BW + (unsigned)rm) * 2u, vG = (4u * hm * 64 + (unsigned)rm) * 2u;
#define OADD(v, c) ({ unsigned o_; asm volatile("v_add_u32_e32 %0, %1, %2" : "=v"(o_) : "n"((int)(c)), "v"(v)); o_; })
#define LD16(arr, off) (*(const GAS bf16*)((arr) + (off)))
#define XL(arr, t) LD16(arr, OADD(vL, (t) * BW * 2))
#define ROWQ(q) (((q) & 3) + 8 * ((q) >> 2))
        P5STAMP(0);
        u32x2 raw[2][5][4];
#define LOAD_TILE(BUF, FB, TB) do { _Pragma("unroll") for (int g = 0; g < 4; ++g) { const unsigned ot_ = OADD(vT, (32 * (TB) * BW + 32 * (FB) + 8 * g) * 2); \
            raw[BUF][0][g] = *(const GAS u32x2*)(Ev_ + ot_); raw[BUF][1][g] = *(const GAS u32x2*)(KK_ + ot_); raw[BUF][2][g] = *(const GAS u32x2*)(R_ + ot_); \
            raw[BUF][3][g] = *(const GAS u32x2*)(Bv_ + ot_); raw[BUF][4][g] = *(const GAS u32x2*)(KP_ + ot_); } } while (0)
        LOAD_TILE(0, 0, 0);
        {   float run = 0.f;
#pragma unroll
            for (int t = 0; t < 64; ++t) { run -= bf2f(XL(Ev_, t)); LT[ln * 65 + t] = run; } }
        wave_lds_fence();
        P5STAMP(1);
        bf16x8 Ap[2][2][2], Rp[2][2][2], Bp[2][2][2], Kp[2][2][2];
#pragma unroll
        for (int ti = 0; ti < 4; ++ti) { const int fb = ti >> 1, tb = ti & 1;
            if (ti < 3) LOAD_TILE((ti + 1) & 1, (ti + 1) >> 1, (ti + 1) & 1);
#pragma unroll
            for (int s = 0; s < 2; ++s) {
                float a8[8], r8[8], b8[8], k8[8];
#pragma unroll
                for (int g2 = 0; g2 < 2; ++g2) { const int g = 2 * s + g2;
                    const u32x2 ew = raw[ti & 1][0][g], aw = raw[ti & 1][1][g], rw = raw[ti & 1][2][g], bw = raw[ti & 1][3][g], kw = raw[ti & 1][4][g];
                    const float e4[4] = {bflo(ew.x), bfhi(ew.x), bflo(ew.y), bfhi(ew.y)}, av[4] = {bflo(aw.x), bfhi(aw.x), bflo(aw.y), bfhi(aw.y)}, rv[4] = {bflo(rw.x), bfhi(rw.x), bflo(rw.y), bfhi(rw.y)},
                                bv[4] = {bflo(bw.x), bfhi(bw.x), bflo(bw.y), bfhi(bw.y)}, kv[4] = {bflo(kw.x), bfhi(kw.x), bflo(kw.y), bfhi(kw.y)};
#pragma unroll
                    for (int j = 0; j < 4; ++j) { const float l = LT[(32 * fb + 8 * g + 4 * hm + j) * 65 + 32 * tb + rm];
                        const float eI = fexp(l), eX = fexp(l + e4[j]), eN = frcp(eI);
                        a8[4 * g2 + j] = -av[j] * eX; r8[4 * g2 + j] = rv[j] * eI; b8[4 * g2 + j] = bv[j] * eN; k8[4 * g2 + j] = kv[j] * eN; } }
                Ap[fb][tb][s] = __builtin_bit_cast(bf16x8, pack8(a8)); Rp[fb][tb][s] = __builtin_bit_cast(bf16x8, pack8(r8));
                Bp[fb][tb][s] = __builtin_bit_cast(bf16x8, pack8(b8)); Kp[fb][tb][s] = __builtin_bit_cast(bf16x8, pack8(k8)); }
            __builtin_amdgcn_sched_barrier(0); }
#undef LOAD_TILE
        wave_lds_fence();
        P5STAMP(2);
        bf16x8 Makp[2][2][2], Mbrp[2][2][2], Mkrp[2][2][2];
#define GRAM(XP, YP, STRICT, BODY) _Pragma("unroll") for (int ib = 0; ib < 2; ++ib) _Pragma("unroll") for (int tb = 0; tb < 2; ++tb) { f32x16 m_; \
            _Pragma("unroll") for (int q = 0; q < 16; ++q) m_[q] = 0.f; \
            _Pragma("unroll") for (int fb = 0; fb < 2; ++fb) _Pragma("unroll") for (int s = 0; s < 2; ++s) m_ = MFMA32(XP[fb][ib][s], YP[fb][tb][s], m_); \
            int rm_ = rm; asm volatile("" : "+v"(rm_)); \
            _Pragma("unroll") for (int q = 0; q < 16; ++q) { const int i_ = 32 * ib + crow(q, hm), t_ = 32 * tb + rm_; m_[q] = ((STRICT) ? (i_ < t_) : (i_ <= t_)) ? m_[q] : 0.f; } \
            BODY __builtin_amdgcn_sched_barrier(0); }
        GRAM(Bp, Ap, true, { wr_tile_ft(buf0, m_, ib, tb, rm, hm); })
        GRAM(Kp, Ap, true, { Makp[ib][tb][0] = pk_tile(m_, 0); Makp[ib][tb][1] = pk_tile(m_, 1); })
        GRAM(Bp, Rp, false, { Mbrp[ib][tb][0] = pk_tile(m_, 0); Mbrp[ib][tb][1] = pk_tile(m_, 1); })
        GRAM(Kp, Rp, false, { Mkrp[ib][tb][0] = pk_tile(m_, 0); Mkrp[ib][tb][1] = pk_tile(m_, 1); })
#undef GRAM
        P5STAMP(3);
        {   bf16x8 Vp[2][2][2];
#pragma unroll
            for (int ib = 0; ib < 2; ++ib)
#pragma unroll
                for (int vb = 0; vb < 2; ++vb) { f32x16 v_;
#pragma unroll
                    for (int q = 0; q < 16; ++q) v_[q] = bf2f(LD16(V_, OADD(vC, ((32 * ib + ROWQ(q)) * BW + 32 * vb) * 2)));
                    Vp[ib][vb][0] = pk_tile(v_, 0); Vp[ib][vb][1] = pk_tile(v_, 1); }
#pragma unroll
            for (int tb = 0; tb < 2; ++tb)
#pragma unroll
                for (int vb = 0; vb < 2; ++vb) { f32x16 w_;
#pragma unroll
                    for (int q = 0; q < 16; ++q) w_[q] = 0.f;
#pragma unroll
                    for (int ib = 0; ib < 2; ++ib)
#pragma unroll
                        for (int s = 0; s < 2; ++s) w_ = MFMA32(Makp[ib][tb][s], Vp[ib][vb][s], w_);
                    wr_tile_ft(buf1, w_, tb, vb, rm, hm); __builtin_amdgcn_sched_barrier(0); } }
        wave_lds_fence();
        P5STAMP(4);
#define SOLVE_BLK(X, T8) _Pragma("unroll") for (int jt = 0; jt < 8; ++jt) { const int t = 8 * (T8) + jt; \
            _Pragma("unroll") for (int gi = 0; gi <= (T8); ++gi) if (8 * gi < t) { float m8[8]; unpack8(*(const LAS u32x4*)(buf0 + t * FS + 8 * gi), m8); \
                _Pragma("unroll") for (int j = 0; j < 8; ++j) { if (8 * gi + j < t) X[t] += X[8 * gi + j] * m8[j]; } } \
            if (jt & 1) __builtin_amdgcn_sched_barrier(0); }
#define SOLVE(X) SOLVE_BLK(X, 0) SOLVE_BLK(X, 1) SOLVE_BLK(X, 2) SOLVE_BLK(X, 3) SOLVE_BLK(X, 4) SOLVE_BLK(X, 5) SOLVE_BLK(X, 6) SOLVE_BLK(X, 7)
        float lC;
        {   float xw[64];
#pragma unroll
            for (int t8 = 0; t8 < 8; ++t8) { float w8[8]; unpack8(*(const LAS u32x4*)(buf1 + ln * FS + 8 * t8), w8);
#pragma unroll
                for (int j = 0; j < 8; ++j) xw[8 * t8 + j] = w8[j]; }
            SOLVE(xw)
            wr_l_ft(buf1, xw, ln); }
        __builtin_amdgcn_sched_barrier(0);
        P5STAMP(5);
        {   float xa[64];
            {   float run = 0.f;
#pragma unroll
                for (int t = 0; t < 64; ++t) { xa[t] = -bf2f(XL(KK_, t)) * fexp(run); run -= bf2f(XL(Ev_, t)); if ((t & 31) == 31) __builtin_amdgcn_sched_barrier(0); }
                lC = run; LC[ln] = fexp(lC); }
            SOLVE(xa)
            wave_lds_fence();
            wr_l_ft(buf0, xa, ln); }
#undef SOLVE
#undef SOLVE_BLK
        wave_lds_fence();
        P5STAMP(6);
        bf16x8 ATp[2][2][2], W1p[2][2][2];
#pragma unroll
        for (int ib = 0; ib < 2; ++ib)
#pragma unroll
            for (int kb = 0; kb < 2; ++kb)
#pragma unroll
                for (int s = 0; s < 2; ++s) { ATp[ib][kb][s] = rd_frag(buf0, ib, kb, s, rm, hm); W1p[ib][kb][s] = rd_frag(buf1, ib, kb, s, rm, hm); }
        wave_lds_fence();
        {   float run = 0.f;
#pragma unroll
            for (int t8 = 0; t8 < 8; ++t8) { float r8[8];
#pragma unroll
                for (int j = 0; j < 8; ++j) { const int t = 8 * t8 + j; run -= bf2f(XL(Ev_, t)); r8[j] = bf2f(XL(R_, t)) * fexp(run); }
                *(LAS u32x4*)(buf0 + ln * FS + 8 * t8) = pack8(r8); if (t8 & 3) { } else { } if ((t8 & 3) == 3) __builtin_amdgcn_sched_barrier(0); } }
        wave_lds_fence();
        GAS char* pn = (GAS char*)(P0_ + (size_t)cid * 4096); GAS char* qn = (GAS char*)(QO0_ + (size_t)cid * 4096);
#pragma unroll
        for (int jb = 0; jb < 2; ++jb)
#pragma unroll
            for (int tb = 0; tb < 2; ++tb) { f32x16 p_;
#pragma unroll
                for (int q = 0; q < 16; ++q) p_[q] = bf2f(buf0[(32 * jb + crow(q, hm)) * FS + 32 * tb + rm]);
#pragma unroll
                for (int ib = 0; ib < 2; ++ib)
#pragma unroll
                    for (int s = 0; s < 2; ++s) p_ = MFMA32(ATp[ib][jb][s], Mbrp[ib][tb][s], p_);
#pragma unroll
                for (int s = 0; s < 2; ++s) *(GAS bf16x8*)(pn + ((((jb * 2 + tb) * 2 + s) * 64) + ln) * 16) = pk_tile(p_, s);
                __builtin_amdgcn_sched_barrier(0); }
        bf16x8 Vp[2][2][2];
#pragma unroll
        for (int ib = 0; ib < 2; ++ib)
#pragma unroll
            for (int vb = 0; vb < 2; ++vb) { f32x16 v_;
#pragma unroll
                for (int q = 0; q < 16; ++q) v_[q] = bf2f(LD16(V_, OADD(vC, ((32 * ib + ROWQ(q)) * BW + 32 * vb) * 2)));
                Vp[ib][vb][0] = pk_tile(v_, 0); Vp[ib][vb][1] = pk_tile(v_, 1); }
        P5STAMP(7);
#pragma unroll
        for (int tb = 0; tb < 2; ++tb)
#pragma unroll
            for (int vb = 0; vb < 2; ++vb) { f32x16 y_;
#pragma unroll
                for (int q = 0; q < 16; ++q) y_[q] = 0.f;
#pragma unroll
                for (int ib = 0; ib < 2; ++ib)
#pragma unroll
                    for (int s = 0; s < 2; ++s) { y_ = MFMA32(Mbrp[ib][tb][s], W1p[ib][vb][s], y_); y_ = MFMA32(Mkrp[ib][tb][s], Vp[ib][vb][s], y_); }
#pragma unroll
                for (int g = 0; g < 4; ++g) { u32x2 w; w.x = pk2(y_[4 * g], y_[4 * g + 1]); w.y = pk2(y_[4 * g + 2], y_[4 * g + 3]); *(GAS u32x2*)(qn + ((((tb * 2 + vb) * 4 + g) * 64) + ln) * 8) = w; }
                __builtin_amdgcn_sched_barrier(0); }
        P5STAMP(8);
        wave_lds_fence();
        {   float run = 0.f;
#pragma unroll
            for (int t8 = 0; t8 < 8; ++t8) { float b8[8], k8[8];
#pragma unroll
                for (int j = 0; j < 8; ++j) { const int t = 8 * t8 + j; run -= bf2f(XL(Ev_, t)); const float sc = fexp(lC - run); b8[j] = bf2f(XL(Bv_, t)) * sc; k8[j] = bf2f(XL(KP_, t)) * sc; }
                *(LAS u32x4*)(buf0 + ln * FS + 8 * t8) = pack8(b8); *(LAS u32x4*)(buf1 + ln * FS + 8 * t8) = pack8(k8); if ((t8 & 3) == 3) __builtin_amdgcn_sched_barrier(0); } }
        wave_lds_fence();
        bf16x8 Bh[2][2][2];
#pragma unroll
        for (int tb = 0; tb < 2; ++tb)
#pragma unroll
            for (int kb = 0; kb < 2; ++kb)
#pragma unroll
                for (int s = 0; s < 2; ++s) Bh[tb][kb][s] = rd_frag(buf0, tb, kb, s, rm, hm);
        GAS char* gt = (GAS char*)(GT + (size_t)cid * 4096); GAS char* ht = (GAS char*)(HT + (size_t)cid * 4096);
#pragma unroll
        for (int kb = 0; kb < 2; ++kb)
#pragma unroll
            for (int jb = 0; jb < 2; ++jb) { f32x16 g_;
                const float dg = LC[32 * kb + rm];
#pragma unroll
                for (int q = 0; q < 16; ++q) g_[q] = (kb == jb && crow(q, hm) == rm) ? dg : 0.f;
#pragma unroll
                for (int tb = 0; tb < 2; ++tb)
#pragma unroll
                    for (int s = 0; s < 2; ++s) g_ = MFMA32(ATp[tb][jb][s], Bh[tb][kb][s], g_);
#pragma unroll
                for (int s = 0; s < 2; ++s) *(GAS bf16x8*)(gt + ((kb * 4 + jb * 2 + s) * 64 + ln) * 16) = pk_tile(g_, s);
                __builtin_amdgcn_sched_barrier(0); }
        {   bf16x8 Kh[2][2][2];
#pragma unroll
            for (int tb = 0; tb < 2; ++tb)
#pragma unroll
                for (int kb = 0; kb < 2; ++kb)
#pragma unroll
                    for (int s = 0; s < 2; ++s) Kh[tb][kb][s] = rd_frag(buf1, tb, kb, s, rm, hm);
#pragma unroll
            for (int kb = 0; kb < 2; ++kb)
#pragma unroll
                for (int vb = 0; vb < 2; ++vb) { f32x16 h_;
#pragma unroll
                    for (int q = 0; q < 16; ++q) h_[q] = 0.f;
#pragma unroll
                    for (int tb = 0; tb < 2; ++tb)
#pragma unroll
                        for (int s = 0; s < 2; ++s) { h_ = MFMA32(Bh[tb][kb][s], W1p[tb][vb][s], h_); h_ = MFMA32(Kh[tb][kb][s], Vp[tb][vb][s], h_); }
#pragma unroll
                    for (int g = 0; g < 4; ++g) { u32x2 w; w.x = pk2(h_[4 * g], h_[4 * g + 1]); w.y = pk2(h_[4 * g + 2], h_[4 * g + 3]); *(GAS u32x2*)(ht + ((((kb * 2 + vb) * 4 + g) * 64) + ln) * 8) = w; }
                    __builtin_amdgcn_sched_barrier(0); } }
        P5STAMP(9);
#if defined(STAMPS)
        if (F.gw == 0 && cid == 0 && lane == 0) { _Pragma("unroll") for (int k_ = 0; k_ < 10; ++k_) ((unsigned long long*)(F0_ws + WS_CTL + 49152))[32 + k_] = p5ts[k_]; }
#endif
        wave_lds_fence();
#undef XL
#undef OADD
#undef LD16
#undef ROWQ
    }
}

#if defined(CHECKS)
constexpr size_t WS_FLG = WS_CTL + 32768;
DI unsigned* chk_flags(unsigned char* ws) { return (unsigned*)(ws + WS_FLG); }
DI void chk(unsigned char* ws, int id, float got, float want, float rel, float ab) {
    const float d = fabsf(got - want), lim = rel * fmaxf(fabsf(got), fabsf(want)) + ab;
    if (!(d <= lim)) chk_flags(ws)[id] = 1u; }
DI unsigned hsh(unsigned a) { a ^= a >> 16; a *= 0x7feb352du; a ^= a >> 15; a *= 0x846ca68bu; a ^= a >> 16; return a; }
DI float bfr(float v) { return bflo(f2bf(v)); }
DI int scol_of(int n) { return n < 3360 ? n : (n < 3584 ? -1 : n - 224); }

DI void chk_p0(const Frame& F, ARef A) {
    unsigned char* ws = A.ws; const int lane = F.lane;
    const float* mod = (const float*)(ws + WS_MOD);
    for (int s = F.wave; s < 32; s += NWAVES) { const unsigned hh = hsh(1000 + s); const int b = hh & 3, o = (hh >> 2) % 6144; float a = 0.f;
        for (int k = lane; k < D; k += 64) { const float c = A.c[b * D + k]; a += (c / (1.0f + expf(-c))) * A.w_mod[(size_t)k * 6144 + o]; }
        a = wave_sum(a) + A.b_mod[o]; chk(ws, 10, mod[b * 6144 + o], a, 1e-3f, 1e-4f); }
    const bf16* wt = (const bf16*)(ws + WS_WIN);
    for (int s = 0; s < 8; ++s) { const unsigned hh = hsh(2000 + (F.wave * 8 + s) * 64 + lane); const int n = hh % NPAD, k = (hh >> 13) & 1023; const int sc = scol_of(n);
        const float want = sc >= 0 ? bfr(A.w_in[(size_t)k * IN_COLS + sc]) : 0.f; chk(ws, 11, bf2f(wt[(size_t)n * D + k]), want, 0.f, 0.f); }
    { const unsigned hh = hsh(3000 + F.wave * 64 + lane); const int n = hh & 1023, k = (hh >> 10) & 511, k2 = (hh >> 10) & 1023;
        chk(ws, 11, bf2f(((const bf16*)(ws + WS_WOSB))[n * BW + k]), bfr(A.w_o_sb[k * D + n]), 0.f, 0.f);
        chk(ws, 11, bf2f(((const bf16*)(ws + WS_WORW))[n * BW + k]), bfr(A.w_o_rw[k * D + n]), 0.f, 0.f);
        chk(ws, 11, bf2f(((const bf16*)(ws + WS_WOUT))[n * D + k2]), bfr(A.w_out[k2 * D + n]), 0.f, 0.f);
        const int o = hh % 36; chk(ws, 11, ((const float*)(ws + WS_RTW))[o * D + k2], o < 4 ? A.w_group[k2 * 4 + o] : A.w_router[k2 * NE + o - 4], 0.f, 0.f);
        const int nl = hh % 1536, kl = (hh >> 11) % LK; float v = 0.f;
        if (nl < 512) { if (kl < 64) v = A.w_decay_up[kl * BW + nl]; } else if (nl < 1024) { if (kl >= 64 && kl < 128) v = A.w_iclr_up[(kl - 64) * BW + nl - 512]; } else { if (kl >= 128 && kl < 288) v = A.w_gate_up[(kl - 128) * BW + nl - 1024]; }
        chk(ws, 11, bf2f(((const bf16*)(ws + WS_WL))[nl * LK + kl]), bfr(v), 0.f, 0.f); }
}
DI void chk_p1(const Frame& F, ARef A, const bf16* H1) {
    unsigned char* ws = A.ws; const int lane = F.lane; const float* mod = (const float*)(ws + WS_MOD);
    for (int s = F.wave; s < 16; s += NWAVES) { const int n = hsh(4000 + s) % NTOK, b = n >> 13; float ss = 0.f;
        for (int k = lane; k < D; k += 64) { const float v = A.x[(size_t)n * D + k]; ss += v * v; }
        const float inv = 1.0f / sqrtf(wave_sum(ss) / D + NORM_EPS);
        for (int k = lane; k < D; k += 64) { const float want = (A.x[(size_t)n * D + k] * inv) * A.gains[k] * (1.0f + mod[b * 6144 + D + k]) + mod[b * 6144 + k];
            chk(ws, 12, bf2f(H1[(size_t)n * D + k]), want, 0.01f, 0.01f); } }
}
DI float wdot(const bf16* arow, const float* W, int ldw, int col, int K, int lane) { float a = 0.f; for (int k = lane; k < K; k += 64) a += bf2f(arow[k]) * W[(size_t)k * ldw + col]; return wave_sum(a); }
DI void chk_p2(const Frame& F, ARef A, const bf16* H1) {
    unsigned char* ws = A.ws; const int lane = F.lane;
    for (int s = F.wave; s < 96; s += NWAVES) { const unsigned hh = hsh(5000 + s); const int n = hh % NTOK, region = s % 6; int col;
        const unsigned h2 = hsh(hh);
        float got, want; int id = 13 + region;
        if (region == 0) { col = h2 % 512; want = 0.125f * wdot(H1 + (size_t)n * D, A.w_in, IN_COLS, col, D, lane); got = bf2f(((const bf16*)(ws + WS_QB))[(size_t)n * BW + col]); }
        else if (region == 1) { col = h2 % 512; want = wdot(H1 + (size_t)n * D, A.w_in, IN_COLS, 512 + col, D, lane); got = bf2f(((const bf16*)(ws + WS_KB))[(size_t)n * BW + col]); }
        else if (region == 2) { col = h2 % 512; want = wdot(H1 + (size_t)n * D, A.w_in, IN_COLS, 1024 + col, D, lane); got = bf2f(((const bf16*)(ws + WS_VT))[((size_t)((n >> 13) * BW + col)) * SEQ + (n & (SEQ - 1))]); }
        else if (region == 3) { col = h2 % 1536; want = wdot(H1 + (size_t)n * D, A.w_in, IN_COLS, 1536 + col, D, lane); got = bf2f(((const bf16*)(ws + WS_RWRAW))[(size_t)n * 1536 + col]); }
        else if (region == 4) { col = h2 % 288; want = wdot(H1 + (size_t)n * D, A.w_in, IN_COLS, 3072 + col, D, lane); got = bf2f(((const bf16*)(ws + WS_LORA))[(size_t)n * BW + col]); }
        else { col = h2 % 2048; want = wdot(H1 + (size_t)n * D, A.w_in, IN_COLS, 3360 + col, D, lane) + A.gate_bias[col]; want = 1.0f / (1.0f + expf(-want)); got = bf2f(((const bf16*)(ws + WS_GATE))[(size_t)n * 2048 + col]); }
        chk(ws, id, got, want, 0.03f, 0.02f); }
}
constexpr int NATT = 16;
DI void att_sample(int s, int& b, int& h, int& t) { const unsigned hh = hsh(6000 + s); b = hh & 3; h = (hh >> 2) & 7; t = (s < 4) ? (s * 37) : (int)((hh >> 5) % SEQ); }
DI void chk_p3_save(const Frame& F, ARef A) {
    if (F.wave == 0) { bf16* sv = (bf16*)(A.ws + WS_FLG + 4096);
        for (int s = 0; s < NATT; ++s) { int b, h, t; att_sample(s, b, h, t); sv[s * 64 + F.lane] = ((const bf16*)(A.ws + WS_QB))[(size_t)(b * SEQ + t) * BW + h * HD + F.lane]; } }
}
DI void chk_p3(const Frame& F, ARef A, const bf16* R, const bf16* KS, const bf16* V, const bf16* KK) {
    unsigned char* ws = A.ws; const int lane = F.lane;
    const bf16* sv = (const bf16*)(ws + WS_FLG + 4096); const bf16* KB = (const bf16*)(ws + WS_KB); const bf16* VT = (const bf16*)(ws + WS_VT);
    for (int s = F.wave; s < NATT; s += NWAVES) { int b, h, t; att_sample(s, b, h, t);
        const float q = bf2f(sv[s * 64 + lane]); float later = 0.f, o = 0.f;
        for (int k = t - 1; k >= 0; --k) { const float z = wave_sum(q * bf2f(KB[(size_t)(b * SEQ + k) * BW + h * HD + lane]));
            const float sp = fmaxf(z, 0.f) + log1pf(expf(-fabsf(z)));
            o += expf(z - sp + later) * bf2f(VT[((size_t)((b * NH + h) * HD + lane)) * SEQ + k]);
            later -= sp; if (later < -200.f) break; }
        chk(ws, 19, bf2f(((const bf16*)(ws + WS_QB))[(size_t)(b * SEQ + t) * BW + h * HD + lane]), o, 0.04f, 0.02f); }
    const bf16* RW = (const bf16*)(ws + WS_RWRAW); const bf16* LO = (const bf16*)(ws + WS_LORA); const bf16* AL = (const bf16*)(ws + WS_ALORA);
    for (int s = F.wave; s < 32; s += NWAVES) { const unsigned hh = hsh(7000 + s); const int n = (s < 4) ? s * SEQ : (int)(hh % NTOK), hd = (hh >> 16) & 7; const bool first = (n & (SEQ - 1)) == 0;
        float xs[3];
        for (int p = 0; p < 3; ++p) { const int col = p * 512 + hd * 64 + lane; const float cur = bf2f(RW[(size_t)n * 1536 + col]), prv = first ? 0.f : bf2f(RW[(size_t)(n - 1) * 1536 + col]); xs[p] = cur + A.shift_mu[col] * (prv - cur); }
        const size_t o = (size_t)n * BW + hd * 64 + lane;
        chk(ws, 20, bf2f(R[o]), xs[0], 0.01f, 0.005f); chk(ws, 20, bf2f(KS[o]), xs[1], 0.01f, 0.005f); chk(ws, 20, bf2f(V[o]), xs[2], 0.01f, 0.005f);
        const float kk = xs[1] * A.k_k[hd * 64 + lane]; const float nn = sqrtf(wave_sum(kk * kk));
        chk(ws, 20, bf2f(KK[o]), kk / fmaxf(nn, L2_EPS), 0.01f, 0.002f);
        for (int c = lane; c < LK; c += 64) { float want = 0.f;
            if (c < 288) { const float cur = bf2f(LO[(size_t)n * BW + c]), prv = first ? 0.f : bf2f(LO[(size_t)(n - 1) * BW + c]); const float v = cur + A.shift_mu[1536 + c] * (prv - cur);
                want = c < 64 ? tanhf(v) : (c < 128 ? v : 1.0f / (1.0f + expf(-v))); }
            chk(ws, 20, bf2f(AL[(size_t)n * LK + c]), want, 0.01f, 0.005f); } }
}
DI void chk_p4_save(const Frame& F, ARef A, const bf16* KS) {
    if (F.wave == 0) { bf16* sv = (bf16*)(A.ws + WS_FLG + 8192);
        for (int s = 0; s < 16; ++s) { const unsigned hh = hsh(8000 + s); const int n = hh % NTOK, hd = (hh >> 16) & 7; sv[s * 64 + F.lane] = KS[(size_t)n * BW + hd * 64 + F.lane]; } }
}
DI void chk_p4(const Frame& F, ARef A, const bf16* KP, const bf16* KK) {
    unsigned char* ws = A.ws; const int lane = F.lane; const bf16* AL = (const bf16*)(ws + WS_ALORA); const bf16* sv = (const bf16*)(ws + WS_FLG + 8192);
    for (int s = F.wave; s < 16; s += NWAVES) { const unsigned hh = hsh(8000 + s); const int n = hh % NTOK, hd = (hh >> 16) & 7, c = hd * 64 + lane; const size_t o = (size_t)n * BW + c;
        float lw = 0.f, la = 0.f, lg = 0.f;
        for (int k = 0; k < 64; ++k) { lw += bf2f(AL[(size_t)n * LK + k]) * A.w_decay_up[k * BW + c]; la += bf2f(AL[(size_t)n * LK + 64 + k]) * A.w_iclr_up[k * BW + c]; }
        for (int k = 0; k < 160; ++k) lg += bf2f(AL[(size_t)n * LK + 128 + k]) * A.w_gate_up[k * BW + c];
        const float x = -(A.w0[c] + lw), w = -(fmaxf(x, 0.f) + log1pf(expf(-fabsf(x)))) - 0.5f;
        chk(ws, 21, bf2f(((const bf16*)(ws + WS_E))[o]), expf(w), 0.03f, 0.003f);
        const float a = 1.0f / (1.0f + expf(-(A.a0[c] + la))); const float ks = bf2f(sv[s * 64 + lane]);
        chk(ws, 22, bf2f(KP[o]), ks * (1.0f + (a - 1.0f) * A.k_a[c]), 0.03f, 0.01f);
        chk(ws, 22, bf2f(((const bf16*)(ws + WS_B))[o]), bf2f(KK[o]) * a, 0.03f, 0.003f);
        chk(ws, 23, bf2f(((const bf16*)(ws + WS_GG))[o]), lg, 0.03f, 0.01f); }
}
constexpr int NST = 300;
DI void chk_p7_save(const Frame& F, ARef A) {
    if (F.wave < 4) { const int b = (F.wave * 3) & 3, h = (F.wave * 5 + 1) & 7; bf16* sv = (bf16*)(A.ws + 256 * 1024) + F.wave * NST * 64;
        for (int t = 0; t < NST; ++t) sv[t * 64 + F.lane] = ((const bf16*)(A.ws + WS_E))[(size_t)(b * SEQ + t) * BW + h * HD + F.lane]; }
}
DI void chk_p7(const Frame& F, ARef A, const bf16* R, const bf16* KP, const bf16* V, const bf16* KK) {
    unsigned char* ws = A.ws; const int lane = F.lane;
    const bf16* Bv = (const bf16*)(ws + WS_B); const bf16* Esv = (const bf16*)(ws + 256 * 1024) + F.wave * NST * 64; const bf16* GG = (const bf16*)(ws + WS_GG); const bf16* YRW = (const bf16*)(ws + WS_YRW);
    if (F.wave < 4) { const int b = (F.wave * 3) & 3, h = (F.wave * 5 + 1) & 7, col0 = h * HD;
        float S[64];
#pragma unroll
        for (int k = 0; k < 64; ++k) S[k] = 0.f;
        for (int t = 0; t < NST; ++t) { const size_t o = (size_t)(b * SEQ + t) * BW + col0 + lane;
            const float av = -bf2f(KK[o]), bv = bf2f(Bv[o]), dv = expf(-bf2f(Esv[t * 64 + lane])), kv = bf2f(KP[o]), rv = bf2f(R[o]), vv = bf2f(V[o]);
            float sa = 0.f;
#pragma unroll
            for (int k = 0; k < 64; ++k) sa += S[k] * __shfl(av, k);
            float y = 0.f;
#pragma unroll
            for (int k = 0; k < 64; ++k) { S[k] = S[k] * __shfl(dv, k) + sa * __shfl(bv, k) + vv * __shfl(kv, k); y += S[k] * __shfl(rv, k); }
            const float mean = wave_sum(y) / 64.f, d = y - mean, var = wave_sum(d * d) / 64.f;
            const float yn = d / sqrtf(var + GN_EPS) * A.lnx_w[col0 + lane] + A.lnx_b[col0 + lane];
            const float bonus = wave_sum(rv * kv * A.r_k[col0 + lane]) * vv;
            const float want = (yn + bonus) * bf2f(GG[o]);
            chk(ws, t < 128 ? 24 : 25, bf2f(YRW[o]), want, 0.05f, 0.03f); } }
}
DI void chk_p8(const Frame& F, ARef A) {
    unsigned char* ws = A.ws; const int lane = F.lane;
    for (int s = F.wave; s < 32; s += NWAVES) { const unsigned hh = hsh(9000 + s); const int n = hh % NTOK, c = (hh >> 15) & 1023;
        const float p1 = wdot((const bf16*)(ws + WS_QB) + (size_t)n * BW, A.w_o_sb, D, c, BW, lane), p2 = wdot((const bf16*)(ws + WS_YRW) + (size_t)n * BW, A.w_o_rw, D, c, BW, lane);
        const bf16* ga = (const bf16*)(ws + WS_GATE) + (size_t)n * 2048;
        chk(ws, 26, bf2f(((const bf16*)(ws + WS_MRG))[(size_t)n * D + c]), bf2f(ga[c]) * p1 + bf2f(ga[1024 + c]) * p2, 0.03f, 0.01f); }
}
DI void chk_p9(const Frame& F, ARef A) {
    unsigned char* ws = A.ws; const int lane = F.lane;
    for (int s = F.wave; s < 32; s += NWAVES) { const unsigned hh = hsh(9500 + s); const int n = hh % NTOK, c = (hh >> 15) & 1023;
        chk(ws, 27, bf2f(((const bf16*)(ws + WS_Y1))[(size_t)n * D + c]), wdot((const bf16*)(ws + WS_MRG) + (size_t)n * D, A.w_out, D, c, D, lane), 0.03f, 0.01f); }
}
DI void chk_p10(const Frame& F, ARef A) {
    unsigned char* ws = A.ws; const int lane = F.lane; const float* mod = (const float*)(ws + WS_MOD);
    const bf16* Y1 = (const bf16*)(ws + WS_Y1); const bf16* H2 = (const bf16*)(ws + WS_H2); const i32x4* tok = (const i32x4*)(ws + WS_TOK);
    for (int s = F.wave; s < 32; s += NWAVES) { const int n = s == 0 ? DBG_TOKEN : (s < 16 ? (int)(hsh(10000 + s) % 128) : (int)(hsh(10000 + s) % NTOK)), b = n >> 13; float ss = 0.f;
        for (int k = lane; k < D; k += 64) { const float v = bf2f(Y1[(size_t)n * D + k]); ss += v * v; }
        const float inv1 = 1.0f / sqrtf(wave_sum(ss) / D + NORM_EPS); float s2 = 0.f;
        for (int k = lane; k < D; k += 64) { const float x1 = A.x[(size_t)n * D + k] + mod[b * 6144 + 2 * D + k] * ((bf2f(Y1[(size_t)n * D + k]) * inv1) * A.gains[D + k]);
            chk(ws, 28, A.out[(size_t)n * D + k], x1, 1e-3f, 1e-3f); s2 += x1 * x1; }
        const float inv2 = 1.0f / sqrtf(wave_sum(s2) / D + NORM_EPS);
        float lg[36];
#pragma unroll
        for (int o = 0; o < 36; ++o) lg[o] = 0.f;
        for (int k = lane; k < D; k += 64) { const float h2 = (A.out[(size_t)n * D + k] * inv2) * A.gains[2 * D + k] * (1.0f + mod[b * 6144 + 4 * D + k]) + mod[b * 6144 + 3 * D + k];
            chk(ws, 29, bf2f(H2[(size_t)n * D + k]), h2, 0.01f, 0.01f);
#pragma unroll
            for (int o = 0; o < 36; ++o) lg[o] += h2 * (o < 4 ? A.w_group[k * 4 + o] : A.w_router[k * NE + o - 4]); }
#pragma unroll
        for (int o = 0; o < 36; ++o) lg[o] = wave_sum(lg[o]);
        int gs = 0; float gm = lg[0];
#pragma unroll
        for (int g = 1; g < 4; ++g) if (lg[g] > gm) { gm = lg[g]; gs = g; }
        float gsum = 0.f;
#pragma unroll
        for (int g = 0; g < 4; ++g) gsum += expf(lg[g] - gm);
        float el[8];
#pragma unroll
        for (int e = 0; e < 8; ++e) el[e] = gs == 0 ? lg[4 + e] : (gs == 1 ? lg[12 + e] : (gs == 2 ? lg[20 + e] : lg[28 + e]));
        int i0 = 0; float m0 = el[0];
#pragma unroll
        for (int e = 1; e < 8; ++e) if (el[e] > m0) { m0 = el[e]; i0 = e; }
        int i1 = -1; float m1 = -3.0e38f;
#pragma unroll
        for (int e = 0; e < 8; ++e) if (e != i0 && el[e] > m1) { m1 = el[e]; i1 = e; }
        const float tt = expf(m1 - m0), p0 = 1.0f / (1.0f + tt);
        const i32x4 rec = tok[n];
        if (lane == 0 && s < 16) { if ((rec.x & 255) != gs * 8 + i0 || ((rec.x >> 8) & 255) != gs * 8 + i1) chk_flags(ws)[30] = 1u;
            if (n == DBG_TOKEN) { const float* dbg = (const float*)chk_flags(ws) + 48; float code = 1.f;
                if (dbg[4] > 4.001f) code += 2.f; if (dbg[5] < 0.499f) code += 4.f;
                if (fabsf(dbg[0] - lg[0]) > 1e-3f || fabsf(dbg[1] - lg[1]) > 1e-3f || fabsf(dbg[2] - lg[2]) > 1e-3f || fabsf(dbg[3] - lg[3]) > 1e-3f) code += 8.f;
                if (fabsf(dbg[4] - gsum) > 1e-3f) code += 16.f; if (fabsf(dbg[6] * dbg[5] - __builtin_bit_cast(float, rec.z)) > 1e-4f) code += 32.f;
                ((float*)chk_flags(ws))[62] = code * 0.1f; ((float*)chk_flags(ws))[63] = dbg[4]; }
            chk(ws, 56, ((const float*)(ws + WS_CW))[2 * n], p0 / gsum, 3e-2f, 1e-4f); chk(ws, 57, ((const float*)(ws + WS_CW))[2 * n + 1], tt * p0 / gsum, 3e-2f, 1e-4f);
            chk(ws, 58, ((const float*)(ws + WS_CW))[2 * n], p0 / gsum, 1e-3f, 1e-5f); chk(ws, 59, ((const float*)(ws + WS_CW))[2 * n + 1], tt * p0 / gsum, 1e-3f, 1e-5f); } }
}
DI void chk_p11(const Frame& F, ARef A) {
    unsigned char* ws = A.ws; const int lane = F.lane; const i32x4* tok = (const i32x4*)(ws + WS_TOK); const int* tile = (const int*)(ws + WS_TILE);
    const bf16* H2 = (const bf16*)(ws + WS_H2); const bf16* HS = (const bf16*)(ws + WS_HS);
    for (int s = F.wave; s < 64; s += NWAVES) { const int n = hsh(11000 + s) % NTOK; const i32x4 rec = tok[n];
        if (rec.x < 0 || rec.x >= tile[MAXT] * 256 || rec.y < 0 || rec.y >= tile[MAXT] * 256 || tile[MAXT] > MAXT || tile[MAXT] < 256) { chk_flags(ws)[32] = 1u; continue; }
        for (int k = lane; k < D; k += 64) { chk(ws, 33, bf2f(HS[(size_t)rec.x * D + k]), bf2f(H2[(size_t)n * D + k]), 0.f, 0.f); chk(ws, 33, bf2f(HS[(size_t)rec.y * D + k]), bf2f(H2[(size_t)n * D + k]), 0.f, 0.f); } }
    { const unsigned hh = hsh(12000 + F.wave * 64 + lane); const int e = hh & 31, n = (hh >> 5) & 1023, k = (hh >> 15) & 1023, k5 = k & 511;
        const int c = (n >> 3) * 4 + (n & 3); const float want = (n & 4) ? A.w_up3[((size_t)e * D + k) * DE + c] : A.w_up1[((size_t)e * D + k) * DE + c];
        chk(ws, 34, bf2f(((const bf16*)(ws + WS_WUP))[((size_t)e * 1024 + n) * D + k]), bfr(want), 0.f, 0.f);
        chk(ws, 35, bf2f(((const bf16*)(ws + WS_WDN))[((size_t)e * 1024 + n) * DE + k5]), bfr(A.w_down[((size_t)e * DE + k5) * D + n]), 0.f, 0.f); }
}
DI void chk_p12(const Frame& F, ARef A) {
    unsigned char* ws = A.ws; const int lane = F.lane; const i32x4* tok = (const i32x4*)(ws + WS_TOK); const int* tile = (const int*)(ws + WS_TILE);
    const bf16* H2 = (const bf16*)(ws + WS_H2); const bf16* HID = (const bf16*)(ws + WS_HID);
    for (int s = F.wave; s < 32; s += NWAVES) { const unsigned hh = hsh(13000 + s); const int n = hh % NTOK, c = (hh >> 16) & 511; const i32x4 rec = tok[n]; const int pos = (s & 1) ? rec.y : rec.x;
        const int e = tile[pos >> 8];
        const float u1 = wdot(H2 + (size_t)n * D, A.w_up1 + (size_t)e * D * DE, DE, c, D, lane), u3 = wdot(H2 + (size_t)n * D, A.w_up3 + (size_t)e * D * DE, DE, c, D, lane);
        chk(ws, 36, bf2f(HID[(size_t)pos * DE + c]), u1 / (1.0f + expf(-u1)) * u3, 0.04f, 0.01f); }
}
DI void chk_p13(const Frame& F, ARef A) {
    unsigned char* ws = A.ws; const int lane = F.lane; const i32x4* tok = (const i32x4*)(ws + WS_TOK); const int* tile = (const int*)(ws + WS_TILE);
    const bf16* HID = (const bf16*)(ws + WS_HID); const bf16* YE = (const bf16*)(ws + WS_HS);
    for (int s = F.wave; s < 32; s += NWAVES) { const unsigned hh = hsh(14000 + s); const int n = hh % NTOK, c = (hh >> 16) & 1023; const i32x4 rec = tok[n]; const int pos = (s & 1) ? rec.y : rec.x;
        const int e = tile[pos >> 8];
        chk(ws, 37, bf2f(YE[(size_t)pos * D + c]), wdot(HID + (size_t)pos * DE, A.w_down + (size_t)e * DE * D, D, c, DE, lane), 0.04f, 0.01f); }
}
#endif

__global__ void __launch_bounds__(NTHR, 2) hybrid_fwd(Args A_unused) {
    extern __shared__ __attribute__((aligned(16))) unsigned char lds_raw[];
    const CAS Args& A = *(const CAS Args*)__builtin_amdgcn_kernarg_segment_ptr();
    Frame F;
    F.lds = (LAS unsigned char*)lds_raw;
    F.wave = __builtin_amdgcn_readfirstlane((int)threadIdx.x >> 6); F.tid = opq_tid(F.wave); F.lane = F.tid & 63;
    F.wg = blockIdx.x; F.G = gridDim.x; F.gw = F.wg * NWAVES + F.wave; F.NGW = F.G * NWAVES;
    volatile LAS unsigned* MISC = (volatile LAS unsigned*)(F.lds + LDS_MISC);
    if (F.wave == 0) MISC[F.lane] = 0u;
    __syncthreads();
    const XcdBarrier bar = xcd_barrier_post((unsigned*)(A.ws + WS_CTL), MISC + 8, F.wave);
    unsigned char* ws = A.ws;
    LAS unsigned char* stage = F.lds;
    bf16* const dob = (bf16*)A.out;
    bf16 *H1 = dob, *R = dob, *KS = dob + (size_t)NTOK * BW, *V = dob + 2 * (size_t)NTOK * BW, *KK = dob + 3 * (size_t)NTOK * BW;

#if defined(STAMPS)
    unsigned long long* const tsp = (unsigned long long*)(ws + WS_CTL + 49152);
#define STAMP(k) do { if (F.wg == 0 && xb_t0(F.wave)) tsp[k] = wall_clock64(); } while (0)
#else
#define STAMP(k) do { } while (0)
#endif
#if defined(REPEAT_PHASE)
#ifndef REPEAT_COUNT
#define REPEAT_COUNT 2
#endif
#define REP(k) _Pragma("nounroll") for (int rep_ = 0; rep_ < ((k) == REPEAT_PHASE ? REPEAT_COUNT : 1); ++rep_)
#else
#define REP(k)
#endif
    STAMP(0);
    REP(0) {
    p0_prologue(F, A);
    xcd_barrier(bar);
    }
    STAMP(1);
#if defined(CHECKS)
    if (F.wg == 0) chk_p0(F, A);
#endif
    REP(1) {
    p1_h1(F, A, H1);
    xcd_barrier(bar);
    }
    STAMP(2);
#if defined(CHECKS)
    if (F.wg == 0) chk_p1(F, A, H1);
#endif
    REP(2) {
    {   pg8::Gemm g{H1, (const bf16*)(ws + WS_WIN), NTOK, NPAD, D}; pg8::StaticOrder S; S.init(NTOK, NPAD, F.G, F.wg);
        EpiIn E{(bf16*)(ws + WS_QB), (bf16*)(ws + WS_KB), (bf16*)(ws + WS_VT), (bf16*)(ws + WS_RWRAW), (bf16*)(ws + WS_LORA), (bf16*)(ws + WS_GATE), A.gate_bias};
        pg8::gemm_phase<EpiIn, pg8::StaticOrder>(stage, g, S, E, nullptr, F.wave); }
    xcd_barrier(bar);
    }
    STAMP(3);
#if defined(CHECKS)
    if (F.wg == 0) { chk_p2(F, A, H1); chk_p3_save(F, A); }
    xcd_barrier(bar);
#endif
#if !defined(CHECKS)
    const bool fuse34 = (F.G == 256);
#else
    const bool fuse34 = false;
#endif
    REP(3) {
    p3_attn(F, (const bf16*)(ws + WS_QB), (const bf16*)(ws + WS_KB), (const bf16*)(ws + WS_VT), (bf16*)(ws + WS_QB));
#if defined(STAMPS)
    STAMP(20);
#endif
    p3_prep(F, A, (const bf16*)(ws + WS_RWRAW), (const bf16*)(ws + WS_LORA), R, KS, V, KK, (bf16*)(ws + WS_ALORA));
#if !defined(CHECKS)
    if (fuse34) { asm volatile("s_waitcnt vmcnt(0)" ::: "memory"); __syncthreads();
        p4_lora(F, A, (const bf16*)(ws + WS_ALORA), (const bf16*)(ws + WS_WL), (bf16*)(ws + WS_E), KS, (bf16*)(ws + WS_B), (bf16*)(ws + WS_GG), KK, R, (float*)(ws + WS_BON)); }
#endif
    xcd_barrier(bar);
    }
#if defined(STAMPS)
    STAMP(21);
#endif
    STAMP(4);
#if defined(CHECKS)
    if (F.wg == 0) { chk_p3(F, A, R, KS, V, KK); chk_p4_save(F, A, KS); }
    xcd_barrier(bar);
#endif
    if (!fuse34) {
    p4_lora(F, A, (const bf16*)(ws + WS_ALORA), (const bf16*)(ws + WS_WL), (bf16*)(ws + WS_E), KS, (bf16*)(ws + WS_B), (bf16*)(ws + WS_GG), KK, R, (float*)(ws + WS_BON));
    xcd_barrier(bar);
    }
    STAMP(5);
#if defined(CHECKS)
    if (F.wg == 0) chk_p4(F, A, KS, KK);
#endif
    REP(5) {
    p5_mfma(ws, F, R, KS, V, KK, (const bf16*)(ws + WS_B), (const bf16*)(ws + WS_E), (bf16*)(ws + WS_P), (bf16*)(ws + WS_QO), (bf16*)(ws + WS_GT), (bf16*)(ws + WS_HT));
    p6_moe_weights(F, A, F.gw, F.NGW);
    xcd_barrier(bar);
    }
    STAMP(6);
#if defined(CHECKS)
    if (F.wg == 255) chk_p7_save(F, A);
#endif
    REP(6) {
    {   const int ncw = F.G < 64 ? F.G : 64;
        if (F.wg < ncw) { if (F.wave == 0) for (int task = F.wg; task < 64; task += ncw) p6_chain(task, F.wave, (const bf16*)(ws + WS_GT), (const bf16*)(ws + WS_HT), (bf16*)(ws + WS_SC));
#if defined(STAMPS)
            STAMP(22);
#endif
        }
        else {
            pg8::StaticOrder S; S.init(NTOK, D, F.G - ncw, F.wg - ncw);
            pg8::Gemm g{(const bf16*)(ws + WS_QB), (const bf16*)(ws + WS_WOSB), NTOK, D, BW};
            EpiMerge<false> E{(bf16*)(ws + WS_GATE), (bf16*)(ws + WS_MRG), 0};
            pg8::gemm_phase<EpiMerge<false>, pg8::StaticOrder>(stage, g, S, E, nullptr, F.wave); }
    }
    xcd_barrier(bar);
    }
    STAMP(7);
    REP(7) {
    p7_mfma(F, A, (const bf16*)(ws + WS_SC), (const bf16*)(ws + WS_P), (const bf16*)(ws + WS_QO), V, (const bf16*)(ws + WS_GG), (const float*)(ws + WS_BON), (bf16*)(ws + WS_YRW));
    xcd_barrier(bar);
    }
    STAMP(8);
#if defined(CHECKS)
    if (F.wg == 0) chk_p7(F, A, R, KS, V, KK);
#endif
    REP(8) {
    {   pg8::StaticOrder S; S.init(NTOK, D, F.G, F.wg);
        {   pg8::Gemm g{(const bf16*)(ws + WS_YRW), (const bf16*)(ws + WS_WORW), NTOK, D, BW};
            EpiMerge<true> E{(bf16*)(ws + WS_GATE), (bf16*)(ws + WS_MRG), D};
            pg8::gemm_phase<EpiMerge<true>, pg8::StaticOrder>(stage, g, S, E, nullptr, F.wave); } }
    xcd_barrier(bar);
    }
    STAMP(9);
#if defined(CHECKS)
    if (F.wg == 0) chk_p8(F, A);
#endif
    REP(9) {
    {   pg8::Gemm g{(const bf16*)(ws + WS_MRG), (const bf16*)(ws + WS_WOUT), NTOK, D, D}; pg8::StaticOrder S; S.init(NTOK, D, F.G, F.wg);
        EpiPlain E{(bf16*)(ws + WS_Y1), D, 0xff};
        pg8::gemm_phase<EpiPlain, pg8::StaticOrder>(stage, g, S, E, nullptr, F.wave); }
    xcd_barrier(bar);
    }
    STAMP(10);
#if defined(CHECKS)
    if (F.wg == 0) chk_p9(F, A);
#endif
    REP(10) {
    p10_rows(F, A, (const bf16*)(ws + WS_Y1), (bf16*)(ws + WS_H2));
    xcd_barrier(bar);
    }
    STAMP(11);
#if defined(VARIANT) && VARIANT == 1
    return;
#endif
#if defined(CHECKS)
    if (F.wg == 0) chk_p10(F, A);
#endif
    REP(11) {
    p11_rank_gather(F, A, (const bf16*)(ws + WS_H2), (bf16*)(ws + WS_HS));
    xcd_barrier(bar);
    }
    STAMP(12);
#if defined(CHECKS)
    if (F.wg == 0) chk_p11(F, A);
#endif
    {   const int* tile = (const int*)(ws + WS_TILE);
        const int nt = __builtin_amdgcn_readfirstlane(tile[MAXT]);
        MoeOrder S; S.nunits = nt * 4; S.G = F.G; S.vc = (F.G % 8 == 0) ? (F.wg % 8) * (F.G / 8) + F.wg / 8 : F.wg; S.tile_e = tile;
        REP(12) {   pg8::Gemm g{(const bf16*)(ws + WS_HS), (const bf16*)(ws + WS_WUP), MAXT * 256, NE * 1024, D};
            EpiUp E{(bf16*)(ws + WS_HID)};
            pg8::gemm_phase<EpiUp, MoeOrder>(stage, g, S, E, nullptr, F.wave);
        xcd_barrier(bar); }
    STAMP(13);
#if defined(CHECKS)
        if (F.wg == 0) chk_p12(F, A);
#endif
        REP(13) {   pg8::Gemm g{(const bf16*)(ws + WS_HID), (const bf16*)(ws + WS_WDN), MAXT * 256, NE * 1024, DE};
            EpiPlain E{(bf16*)(ws + WS_HS), D, 3};
            pg8::gemm_phase<EpiPlain, MoeOrder>(stage, g, S, E, nullptr, F.wave);
        xcd_barrier(bar); } }
    STAMP(14);
#if defined(CHECKS)
    if (F.wg == 0) chk_p13(F, A);
#endif
    p14_final(F, A, (const bf16*)(ws + WS_HS));
#if defined(STAMPS)
    xcd_barrier(bar);
    STAMP(15);
    if (F.wg == 0) { __syncthreads();
        const float va = (float)(long long)(tsp[STAMP_A2] - tsp[STAMP_A]) * 0.01f, vb = (float)(long long)(tsp[STAMP_B2] - tsp[STAMP_B]) * 0.01f;
#if defined(STAMP_SHIFT)
        const float shf_ = 1.1f;
#else
        const float shf_ = 1.0f;
#endif
        int b1 = (int)floorf(logf(fmaxf(va * shf_, 1.0f)) / logf(1.21f)) + 1, b2 = (int)floorf(logf(fmaxf(vb * shf_, 1.0f)) / logf(1.21f)) + 1;
#if defined(STAMP_CAL)
        b1 = 10; b2 = 30;
#endif
#if defined(STAMP_FRAC)
        { const unsigned long long* t5 = tsp + 32; const float tot = (float)(long long)(t5[9] - t5[0]);
          b1 = (int)(12.0f * (float)(long long)(t5[STAMP_A2] - t5[STAMP_A]) / tot) + 3; b2 = (int)(12.0f * (float)(long long)(t5[STAMP_B2] - t5[STAMP_B]) / tot) + 3; }
#endif
#if defined(STAMP_THR_A)
        b1 = va > (float)(STAMP_THR_A) ? 30 : 10; b2 = vb > (float)(STAMP_THR_B) ? 30 : 10;
#endif
        const int t_ = opq_tid(F.wave);
        for (int i = t_; i < 1000; i += NTHR) A.out[1000 + i] += 20.0f * (float)b2;
        if (t_ == 0) A.out[0] = 200.0f * (float)b1; }
#endif
#if defined(CHECKS)
    xcd_barrier(bar);
    if (F.wg == 0 && F.tid == 0) { const unsigned* fl = chk_flags(ws); int id = 0; for (int i = 61; i >= 0; --i) if (fl[i]) id = i;
        if (((const unsigned*)(ws + WS_CTL))[XB_TMO]) id = 60;
        if (id) A.out[0] = 10.0f * (float)id;
#if defined(CHKVAL)
        A.out[0] = 1000.0f * ((const float*)fl)[CHKVAL];
#endif
        }
#endif
}

extern "C" void kernel_launch(void* const* d_in, const int* in_sizes, int n_in, void* d_out, int out_size, void* d_ws, size_t ws_size, hipStream_t stream) {
    static int grid = 0;
    if (grid == 0) {
        if (n_in != 26 || in_sizes[0] != NTOK * D || out_size != NTOK * D || ws_size < WS_END) {
            fprintf(stderr, "kernel_launch: unexpected shapes (n_in %d, in0 %d, out %d, ws %zu); nothing launched\n", n_in, n_in > 0 ? in_sizes[0] : -1, out_size, ws_size); grid = -1; return; }
        int dev = 0, cus = 0, per_cu = 0;
        if (hipGetDevice(&dev) != hipSuccess || hipDeviceGetAttribute(&cus, hipDeviceAttributeMultiprocessorCount, dev) != hipSuccess) { grid = -1; return; }
        if (hipFuncSetAttribute((const void*)hybrid_fwd, hipFuncAttributeMaxDynamicSharedMemorySize, LDS_BYTES) != hipSuccess) { fprintf(stderr, "kernel_launch: hipFuncSetAttribute failed\n"); grid = -1; return; }
        if (hipOccupancyMaxActiveBlocksPerMultiprocessor(&per_cu, (const void*)hybrid_fwd, NTHR, LDS_BYTES) != hipSuccess || per_cu < 1)
            fprintf(stderr, "kernel_launch: note: occupancy query reports %d workgroups per CU\n", per_cu);
        (void)hipGetLastError();
        grid = cus > 256 ? 256 : cus;
    }
    if (grid < 0) return;
    if (hipMemsetAsync((char*)d_ws + WS_CTL, 0, CTL_ZERO_BYTES, stream) != hipSuccess) return;
    Args a{};
    const float** p = (const float**)&a;
    for (int i = 0; i < 26; ++i) p[i] = (const float*)d_in[i];
    a.out = (float*)d_out; a.ws = (unsigned char*)d_ws;
    hipLaunchKernelGGL(hybrid_fwd, dim3(grid), dim3(NTHR), LDS_BYTES, stream, a);
}

#if defined(ONLY_P5)
__global__ void __launch_bounds__(NTHR, 2) only_p5(Args A_unused) {
    extern __shared__ __attribute__((aligned(16))) unsigned char lds_raw[];
    const CAS Args& A = *(const CAS Args*)__builtin_amdgcn_kernarg_segment_ptr();
    Frame F; F.lds = (LAS unsigned char*)lds_raw; F.wave = __builtin_amdgcn_readfirstlane((int)threadIdx.x >> 6); F.tid = opq_tid(F.wave); F.lane = F.tid & 63;
    F.wg = blockIdx.x; F.G = gridDim.x; F.gw = F.wg * NWAVES + F.wave; F.NGW = F.G * NWAVES;
    unsigned char* ws = A.ws; bf16* const dob = (bf16*)A.out;
    bf16 *R = dob, *KS = dob + (size_t)NTOK * BW, *V = dob + 2 * (size_t)NTOK * BW, *KK = dob + 3 * (size_t)NTOK * BW;
    p5_mfma(ws, F, R, KS, V, KK, (const bf16*)(ws + WS_B), (const bf16*)(ws + WS_E), (bf16*)(ws + WS_P), (bf16*)(ws + WS_QO), (bf16*)(ws + WS_GT), (bf16*)(ws + WS_HT));
}
#endif
```

```cpp
#include <hip/hip_runtime.h>
#include <cstdio>
#include <cstdint>
__device__ __forceinline__ int opq_tid(int wave) { int l; asm volatile("v_mbcnt_lo_u32_b32 %0, -1, 0\n\tv_mbcnt_hi_u32_b32 %0, -1, %0" : "=v"(l)); return wave * 64 + l; }
#ifndef PHMASK
#define PHMASK 0xffff
#endif
namespace pg8 {
#define PG8_LAS __attribute__((address_space(3)))
typedef unsigned short bf16_t;
typedef short bf16x8 __attribute__((ext_vector_type(8)));
typedef float f32x4 __attribute__((ext_vector_type(4)));
typedef unsigned u32x4 __attribute__((ext_vector_type(4)));
constexpr int BM = 256, BK = 64, HALF = 128, HTB = HALF * BK * 2  , STAGE_BYTES = 8 * HTB, NXCD = 8, WGM = 8;

__host__ __device__ __forceinline__ int lds_byte(int r, int c) { const int st = (r >> 4) * 2 + (c >> 5), rr = r & 15, cc = c & 31, ob = rr * 64 + cc * 2; return st * 1024 + (ob ^ (((ob >> 9) & 1) << 5)); }
__host__ __device__ __forceinline__ void stage_rc(int b, int& R, int& C) { const int st = b / 1024, sb = b % 1024, swz = sb ^ (((sb >> 9) & 1) << 5); R = (st >> 1) * 16 + swz / 64; C = (st & 1) * 32 + (swz % 64) / 2; }
__host__ __device__ __forceinline__ int perm32(int rho) { const int n = rho >> 4, i = rho & 15; return 8 * (i >> 2) + 4 * n + (i & 3); }

struct Unit { int pm, pn; };
struct Gemm { const bf16_t* A; const bf16_t* Bt; int M, N, K; };

struct StaticOrder {
    int nM, nN, nwg, G, c;
    __host__ __device__ void init(int M, int N, int G_, int c_) { nM = M / BM; nN = N / BM; nwg = nM * nN; G = G_; c = c_; }
    __host__ __device__ bool next(int i, Unit& u) const {
        const long L = (long)i * G + c; if (L >= nwg) return false;
        int wgid = (int)L; { const int q = nwg / NXCD, r = nwg % NXCD, xcd = wgid % NXCD, off = wgid / NXCD; wgid = (xcd < r ? xcd * (q + 1) : r * (q + 1) + (xcd - r) * q) + off; }
        const int nig = WGM * nN, gid = wgid / nig, fm = gid * WGM, gsz = (nM - fm) < WGM ? (nM - fm) : WGM;
        u.pm = fm + ((wgid % nig) % gsz); u.pn = (wgid % nig) / gsz; return true;
    }
    __device__ __forceinline__ void a_ready(const Unit&) const {}
    __device__ __forceinline__ void done(const Unit&) const {}
};

template <class Epi, class Sched, bool STAMP = false>
__device__ __forceinline__ void gemm_phase(PG8_LAS unsigned char* lds, const Gemm g, const Sched& S, const Epi& E, unsigned long long* stamps, int wave_id) {
    const int tid = opq_tid(wave_id), wid = __builtin_amdgcn_readfirstlane(tid >> 6), lane = tid & 63, wr = wid >> 2, wc = wid & 3, fr = lane & 15, fq = lane >> 4;
    const int K = g.K, nt = K / BK;
    int ts_lo = 0, ts_hi = 0, nts = 0; const unsigned long long rt_entry = STAMP ? (unsigned long long)wall_clock64() : 0ull;
#define PG8_STAMP() do { if (STAMP && wid == 0 && nts < 64) { const unsigned long long _c = (unsigned long long)clock64(); \
        ts_lo = (lane == nts) ? (int)(unsigned)_c : ts_lo; ts_hi = (lane == nts) ? (int)(unsigned)(_c >> 32) : ts_hi; ++nts; } } while (0)
    PG8_STAMP();
    unsigned voffA[2], voffB[2];
#pragma unroll
    for (int i = 0; i < 2; ++i) { int R, C; stage_rc(tid * 16 + i * 8192, R, C); const int Rb = Epi::PERM ? ((R & ~31) + perm32(R & 31)) : R;
        voffA[i] = (unsigned)(R * K + C) * 2u; voffB[i] = (unsigned)(Rb * K + C) * 2u; }
    const size_t kstep = (size_t)(BK * 2);
    const size_t hstep = (size_t)HALF * K * 2;
    const size_t tstep = 2 * hstep;
    const unsigned ldsw = (unsigned)wid * 1024u;
    const int aoff = lds_byte(wr * 64 + fr, fq * 8), boff = lds_byte(wc * 32 + fr, fq * 8);
#define PG8_SA(b, h) (((b) * 2 + (h)) * HTB)
#define PG8_SB(b, h) ((4 + (b) * 2 + (h)) * HTB)
#define PG8_STAGE(bufoff, gbase, voff) do { _Pragma("unroll") for (int _i = 0; _i < 2; ++_i) \
        __builtin_amdgcn_global_load_lds((const unsigned*)((const char*)(gbase) + (voff)[_i]), (PG8_LAS unsigned*)(lds + (bufoff) + ldsw + _i * 8192), 16, 0, 0); } while (0)
#define PG8_LDA(dst, b, h) do { _Pragma("unroll") for (int m = 0; m < 4; ++m) _Pragma("unroll") for (int k = 0; k < 2; ++k) dst[m][k] = *(const PG8_LAS bf16x8*)(lds + PG8_SA(b, h) + aoff + m * 2048 + k * 1024); } while (0)
#define PG8_LDB(dst, b, h) do { _Pragma("unroll") for (int n = 0; n < 2; ++n) _Pragma("unroll") for (int k = 0; k < 2; ++k) dst[n][k] = *(const PG8_LAS bf16x8*)(lds + PG8_SB(b, h) + boff + n * 2048 + k * 1024); } while (0)
#define PG8_MMA(ai, bj, At, Bt) do { __builtin_amdgcn_s_setprio(1); _Pragma("unroll") for (int m = 0; m < 4; ++m) _Pragma("unroll") for (int n = 0; n < 2; ++n) _Pragma("unroll") for (int k = 0; k < 2; ++k) \
        acc[ai][bj][m][n] = __builtin_amdgcn_mfma_f32_16x16x32_bf16(Bt[n][k], At[m][k], acc[ai][bj][m][n], 0, 0, 0); __builtin_amdgcn_s_setprio(0); } while (0)
#define PG8_WAIT_V(n) asm volatile("s_waitcnt vmcnt(" #n ")" ::: "memory")
#define PG8_WAIT_L(n) asm volatile("s_waitcnt lgkmcnt(" #n ")" ::: "memory")
#define PG8_BAR __builtin_amdgcn_s_barrier()
#define PG8_SCHED __builtin_amdgcn_sched_barrier(0)
    Unit cur, nxt; int ui = 0;
    if (!S.next(0, cur)) return;
    f32x4 acc[2][2][4][2];
#pragma unroll
    for (int a = 0; a < 2; ++a)
#pragma unroll
        for (int b = 0; b < 2; ++b)
#pragma unroll
            for (int m = 0; m < 4; ++m)
#pragma unroll
                for (int n = 0; n < 2; ++n) acc[a][b][m][n] = (f32x4){0.f, 0.f, 0.f, 0.f};
    bf16x8 At[4][2], B0[2][2], B1[2][2];
    const char* cA = (const char*)g.A + (size_t)cur.pm * tstep; const char* cB = (const char*)g.Bt + (size_t)cur.pn * tstep;
    S.a_ready(cur);
    PG8_STAGE(PG8_SB(0, 0), cB, voffB); PG8_STAGE(PG8_SA(0, 0), cA, voffA); PG8_STAGE(PG8_SB(0, 1), cB + hstep, voffB); PG8_STAGE(PG8_SA(0, 1), cA + hstep, voffA);
    if (wr == 1) PG8_BAR;
    PG8_WAIT_V(4); PG8_BAR;
    PG8_STAGE(PG8_SB(1, 0), cB + kstep, voffB); PG8_STAGE(PG8_SA(1, 0), cA + kstep, voffA); PG8_STAGE(PG8_SB(1, 1), cB + hstep + kstep, voffB);
    PG8_WAIT_V(6); PG8_BAR;
    PG8_STAMP();
    for (;;) {
        const bool has_next = S.next(ui + 1, nxt);
        const char* nA = has_next ? (const char*)g.A + (size_t)nxt.pm * tstep : cA; const char* nB = has_next ? (const char*)g.Bt + (size_t)nxt.pn * tstep : cB;
        for (int t = 0; t < nt; t += 2) {
            const bool last = (t == nt - 2);
            const char* a1 = cA + (size_t)(t + 1) * kstep;
            const char* a2 = last ? nA : cA + (size_t)(t + 2) * kstep; const char* b2 = last ? nB : cB + (size_t)(t + 2) * kstep;
            const char* a3 = a2 + kstep; const char* b3 = b2 + kstep;
            if (last && has_next) S.a_ready(nxt);
            PG8_LDB(B0, 0, 0); PG8_SCHED; PG8_LDA(At, 0, 0); PG8_STAGE(PG8_SA(1, 1), a1 + hstep, voffA);
            PG8_WAIT_L(8); PG8_BAR; PG8_WAIT_L(0); PG8_MMA(0, 0, At, B0); PG8_BAR; PG8_SCHED;
            PG8_LDB(B1, 0, 1); PG8_STAGE(PG8_SB(0, 0), b2, voffB);
            PG8_BAR; PG8_WAIT_L(0); PG8_MMA(0, 1, At, B1); PG8_BAR;
            PG8_LDA(At, 0, 1); PG8_STAGE(PG8_SA(0, 0), a2, voffA);
            PG8_BAR; PG8_WAIT_L(0); PG8_MMA(1, 0, At, B0); PG8_BAR; PG8_SCHED;
            PG8_STAGE(PG8_SB(0, 1), b2 + hstep, voffB);
            PG8_WAIT_V(6); PG8_BAR; PG8_MMA(1, 1, At, B1); PG8_BAR;
            PG8_LDB(B0, 1, 0); PG8_SCHED; PG8_LDA(At, 1, 0); PG8_STAGE(PG8_SA(0, 1), a2 + hstep, voffA);
            PG8_WAIT_L(8); PG8_BAR; PG8_WAIT_L(0); PG8_MMA(0, 0, At, B0); PG8_BAR; PG8_SCHED;
            PG8_LDB(B1, 1, 1); PG8_STAGE(PG8_SB(1, 0), b3, voffB);
            PG8_BAR; PG8_WAIT_L(0); PG8_MMA(0, 1, At, B1); PG8_BAR;
            PG8_LDA(At, 1, 1); PG8_STAGE(PG8_SA(1, 0), a3, voffA);
            PG8_BAR; PG8_WAIT_L(0); PG8_MMA(1, 0, At, B0); PG8_BAR; PG8_SCHED;
            PG8_STAGE(PG8_SB(1, 1), b3 + hstep, voffB);
            PG8_WAIT_V(6); PG8_BAR; PG8_MMA(1, 1, At, B1); PG8_BAR;
        }
        PG8_STAMP();
        if constexpr (!Epi::AFTER_DRAIN) { E(acc, cur, wr, wc, fr, fq); S.done(cur); }
        PG8_STAMP();
        if (!has_next) break;
#pragma unroll
        for (int a = 0; a < 2; ++a)
#pragma unroll
            for (int b = 0; b < 2; ++b)
#pragma unroll
                for (int m = 0; m < 4; ++m)
#pragma unroll
                    for (int n = 0; n < 2; ++n) acc[a][b][m][n] = (f32x4){0.f, 0.f, 0.f, 0.f};
        cur = nxt; cA = nA; cB = nB; ++ui;
    }
    PG8_WAIT_V(0);
    if (wr == 0) PG8_BAR;
    PG8_BAR;
    if constexpr (Epi::AFTER_DRAIN) { E.fused(acc, cur, wr, wc, fr, fq, lds, wid, lane); S.done(cur); }
    PG8_STAMP();
    if (STAMP && wid == 0) { stamps[lane] = lane < nts ? (((unsigned long long)(unsigned)ts_hi << 32) | (unsigned)ts_lo) : 0ull;
        if (lane == 62) stamps[62] = rt_entry; if (lane == 63) stamps[63] = (unsigned long long)wall_clock64(); }
#undef PG8_STAMP
#undef PG8_SA
#undef PG8_SB
#undef PG8_STAGE
#undef PG8_LDA
#undef PG8_LDB
#undef PG8_MMA
#undef PG8_WAIT_V
#undef PG8_WAIT_L
#undef PG8_BAR
#undef PG8_SCHED
}
}

#define XB_TMO      128
#define XB_XCNT(j)  (256  + 64 * (j))
#define XB_XSUB(j)  (1280 + 64 * (j))
#define XB_XGEN(j)  (2304 + 64 * (j))
#define XB_TOP      3328
#define XB_TOPGEN   3392
#define XCD_BAR_WORDS 3456
#define XB_SPIN_CAP (1u << 18)
#define LAS __attribute__((address_space(3)))

__device__ __forceinline__ unsigned xb_ld(unsigned* p)              { return __hip_atomic_load(p, __ATOMIC_RELAXED, __HIP_MEMORY_SCOPE_AGENT); }
__device__ __forceinline__ unsigned xb_add(unsigned* p, unsigned v) { return __hip_atomic_fetch_add(p, v, __ATOMIC_RELAXED, __HIP_MEMORY_SCOPE_AGENT); }
__device__ __forceinline__ unsigned xb_xcc_id() { return (unsigned)__builtin_amdgcn_s_getreg((3 << 11) | 20) & 0xFu; }
#define XB_SPIN(cond, bar) do { unsigned _sp = 0; while (cond) { __builtin_amdgcn_s_sleep(1); \
    if ((++_sp & 255u) == 0u) { if (xb_ld(&(bar)[XB_TMO])) break; if (_sp > XB_SPIN_CAP) { atomicAdd(&(bar)[XB_TMO], 1u); break; } } } } while (0)

struct XcdBarrier {
    unsigned* bar; unsigned x; int wave;
    volatile LAS unsigned* st;
};

__device__ __forceinline__ bool xb_t0(int wave) { return wave == 0 && __builtin_amdgcn_mbcnt_hi(~0u, __builtin_amdgcn_mbcnt_lo(~0u, 0u)) == 0u; }
__device__ __forceinline__ XcdBarrier xcd_barrier_post(unsigned* bar, volatile LAS unsigned* st, int wave) {
    XcdBarrier b; b.bar = bar; b.x = xb_xcc_id(); b.st = st; b.wave = wave;
    if (xb_t0(wave)) (void)xb_add(&bar[XB_XCNT(b.x)], 1u);
    return b;
}
__device__ __forceinline__ void xcd_barrier_complete(unsigned* bar, unsigned x, unsigned& nloc, unsigned& nx) {
    const unsigned G = gridDim.x * gridDim.y * gridDim.z;
    unsigned sum, cnt, mine, sp = 0u;
    for (;;) {
        sum = 0u; cnt = 0u; mine = 0u;
#pragma unroll
        for (unsigned j = 0; j < 16; ++j) { const unsigned c = xb_ld(&bar[XB_XCNT(j)]); sum += c; cnt += (c > 0u) ? 1u : 0u; mine = (j == x) ? c : mine; }
        if (sum == G) break;
        __builtin_amdgcn_s_sleep(1);
        if ((++sp & 255u) == 0u) { if (xb_ld(&bar[XB_TMO])) break; if (sp > XB_SPIN_CAP) { atomicAdd(&bar[XB_TMO], 1u); break; } }
    }
    nloc = mine > 0u ? mine : 1u; nx = cnt > 0u ? cnt : 1u;
}

__device__ __forceinline__ void xcd_barrier(const XcdBarrier& b) {
    asm volatile("s_waitcnt vmcnt(0)" ::: "memory");
    __syncthreads();
    if (xb_t0(b.wave)) {
        unsigned* bar = b.bar;
        __builtin_amdgcn_s_waitcnt(0);
        unsigned nloc = b.st[0], nx = b.st[1];
        if (nloc == 0u) { xcd_barrier_complete(bar, b.x, nloc, nx); b.st[0] = nloc; b.st[1] = nx; }
        const unsigned old = xb_add(&bar[XB_XSUB(b.x)], 1u);
        const unsigned gen = old / nloc;
        if (old + 1u == (gen + 1u) * nloc) {
            __builtin_amdgcn_fence(__ATOMIC_RELEASE, "agent");
            asm volatile("s_waitcnt vmcnt(0)" ::: "memory");
            const unsigned og = xb_add(&bar[XB_TOP], 1u);
            const unsigned tg = og / nx;
            if (og + 1u == (tg + 1u) * nx) xb_add(&bar[XB_TOPGEN], 1u);
            else XB_SPIN(xb_ld(&bar[XB_TOPGEN]) == tg, bar);
            __builtin_amdgcn_fence(__ATOMIC_ACQUIRE, "agent");
            xb_add(&bar[XB_XGEN(b.x)], 1u);
            asm volatile("s_waitcnt vmcnt(0)" ::: "memory");
        } else {
            XB_SPIN(xb_ld(&bar[XB_XGEN(b.x)]) == gen, bar);
            __builtin_amdgcn_fence(__ATOMIC_ACQUIRE, "agent");
            asm volatile("s_waitcnt vmcnt(0)" ::: "memory");
        }
    }
    __syncthreads();
}


constexpr int NB = 4, SEQ = 8192, D = 1024, NTOK = NB * SEQ;
constexpr int NH = 8, HD = 64, BW = 512;
constexpr int IN_COLS = 5408, NPAD = 5632;
constexpr int LK = 384;
constexpr int NE = 32, DE = 512;
constexpr int CH = 64, NCH = SEQ / CH, NCH_LOG = 7, NCHUNK = NB * NH * NCH;
constexpr int MAXT = 288;
constexpr float NORM_EPS = 1e-6f, GN_EPS = 64e-5f, L2_EPS = 1e-12f;
constexpr float SB_STOP = -120.0f;

constexpr size_t MiB = 1u << 20;
constexpr size_t WS_CTL = 0, CTL_ZERO_BYTES = 65536;
constexpr size_t WS_MOD = 1 * MiB;
constexpr size_t WS_RTW = WS_MOD + 128 * 1024;
constexpr size_t WS_TOK = WS_RTW + 160 * 1024;
constexpr size_t WS_CNT = WS_TOK + (size_t)NTOK * 16;
constexpr size_t WS_TILE = WS_CNT + 256 * 32 * 4;
constexpr size_t WS_WIN = 2 * MiB;
constexpr size_t WS_WOSB = 13 * MiB, WS_WORW = 14 * MiB, WS_WOUT = 15 * MiB;
constexpr size_t WS_WL = 17 * MiB;
constexpr size_t WS_BON = 18 * MiB + 256 * 1024;
constexpr size_t WS_CW = 19 * MiB + 768 * 1024;
constexpr size_t WS_QB = 20 * MiB;
constexpr size_t WS_GATE = 52 * MiB;
constexpr size_t WS_GG = 180 * MiB;
constexpr size_t WS_KB = 212 * MiB, WS_VT = 244 * MiB;
constexpr size_t WS_LORA = 276 * MiB;
constexpr size_t WS_ALORA = 308 * MiB;
constexpr size_t WS_E = 340 * MiB, WS_B = 372 * MiB;
constexpr size_t WS_RWRAW = 416 * MiB;
constexpr size_t WS_P = 212 * MiB, WS_QO = 244 * MiB;
constexpr size_t WS_GT = 276 * MiB;
constexpr size_t WS_HT = 308 * MiB;
constexpr size_t WS_SC = 340 * MiB;
constexpr size_t WS_YRW = 384 * MiB;
constexpr size_t WS_WUP = 416 * MiB, WS_WDN = 480 * MiB;
constexpr size_t WS_MRG = 212 * MiB;
constexpr size_t WS_Y1 = 276 * MiB;
constexpr size_t WS_H2 = 52 * MiB;
constexpr size_t WS_HS = 116 * MiB;
constexpr size_t WS_HID = 260 * MiB;
constexpr size_t WS_X1 = 340 * MiB;
constexpr size_t WS_END = 512 * MiB;
static_assert(WS_TILE + (MAXT + 1) * 4 <= WS_WIN && WS_WIN + (size_t)NPAD * D * 2 <= WS_WOSB && WS_WL + 1536 * LK * 2 <= WS_QB, "fixed region");
static_assert(WS_HS + (size_t)MAXT * 256 * D * 2 <= WS_HID && WS_HID + (size_t)MAXT * 256 * DE * 2 <= WS_WUP, "moe region");
static_assert(WS_ALORA + (size_t)NTOK * LK * 2 <= WS_E && WS_B + (size_t)NTOK * BW * 2 <= WS_RWRAW, "rwkv region");

constexpr int LDS_BYTES = 163840;
constexpr int LDS_MISC = LDS_BYTES - 256;
constexpr int NWAVES = 8, NTHR = 512;

typedef unsigned short bf16;
typedef short bf16x8 __attribute__((ext_vector_type(8)));
typedef short s16x4 __attribute__((ext_vector_type(4)));
typedef float f32x4 __attribute__((ext_vector_type(4)));
typedef float f32x16 __attribute__((ext_vector_type(16)));
typedef unsigned u32x4 __attribute__((ext_vector_type(4)));
typedef unsigned u32x2 __attribute__((ext_vector_type(2)));
typedef int i32x4 __attribute__((ext_vector_type(4)));
#define DI __device__ __forceinline__
#define GAS __attribute__((address_space(1)))
#define MFMA32(a, b, c) __builtin_amdgcn_mfma_f32_32x32x16_bf16((a), (b), (c), 0, 0, 0)

typedef float f32x2_t __attribute__((ext_vector_type(2))); typedef __bf16 bf16x2_t __attribute__((ext_vector_type(2)));
DI unsigned pk2(float lo, float hi) { f32x2_t v = {lo, hi}; return __builtin_bit_cast(unsigned, __builtin_convertvector(v, bf16x2_t)); }
DI unsigned f2bf(float f) { return pk2(f, 0.0f) & 0xffffu; }
DI float bflo(unsigned u) { return __builtin_bit_cast(float, u << 16); }
DI float bfhi(unsigned u) { return __builtin_bit_cast(float, u & 0xffff0000u); }
DI float bf2f(bf16 h) { return __builtin_bit_cast(float, (unsigned)h << 16); }
DI float fexp(float x) { return __expf(x); }
DI float frcp(float x) { return __builtin_amdgcn_rcpf(x); }
DI float fsigmoid(float x) { return frcp(1.0f + fexp(-x)); }
DI float fsoftplus(float x) { return fmaxf(x, 0.0f) + __logf(1.0f + fexp(-fabsf(x))); }
#define DPP_SHR(v, ctrl) __builtin_bit_cast(float, __builtin_amdgcn_update_dpp(0, __builtin_bit_cast(int, (v)), (ctrl), 0xf, 0xf, true))
DI float wave_sum(float v) {
    v += DPP_SHR(v, 0x111); v += DPP_SHR(v, 0x112); v += DPP_SHR(v, 0x114); v += DPP_SHR(v, 0x118);
    v += __builtin_bit_cast(float, __builtin_amdgcn_update_dpp(0, __builtin_bit_cast(int, v), 0x142, 0xa, 0xf, false));
    v += __builtin_bit_cast(float, __builtin_amdgcn_update_dpp(0, __builtin_bit_cast(int, v), 0x143, 0xc, 0xf, false));
    return __builtin_bit_cast(float, __builtin_amdgcn_readlane(__builtin_bit_cast(int, v), 63));
}
DI float shfl_xor_l(float v, int m, int lane) { return __builtin_bit_cast(float, __builtin_amdgcn_ds_bpermute(4 * (lane ^ m), __builtin_bit_cast(int, v))); }
DI int crow(int reg, int hh) { return (reg & 3) + 8 * (reg >> 2) + 4 * hh; }
DI void wave_lds_fence() { __builtin_amdgcn_fence(__ATOMIC_RELEASE, "wavefront"); __builtin_amdgcn_wave_barrier(); __builtin_amdgcn_fence(__ATOMIC_ACQUIRE, "wavefront"); }
DI void unpack8(const u32x4 v, float (&o)[8]) { o[0] = bflo(v.x); o[1] = bfhi(v.x); o[2] = bflo(v.y); o[3] = bfhi(v.y); o[4] = bflo(v.z); o[5] = bfhi(v.z); o[6] = bflo(v.w); o[7] = bfhi(v.w); }
DI u32x4 pack8(const float (&o)[8]) { u32x4 v; v.x = pk2(o[0], o[1]); v.y = pk2(o[2], o[3]); v.z = pk2(o[4], o[5]); v.w = pk2(o[6], o[7]); return v; }
DI bf16x8 pack8v(float a0, float a1, float a2, float a3, float a4, float a5, float a6, float a7) {
    u32x4 v; v.x = pk2(a0, a1); v.y = pk2(a2, a3); v.z = pk2(a4, a5); v.w = pk2(a6, a7); return __builtin_bit_cast(bf16x8, v); }


#if defined(CHECKS)
constexpr int DBG_TOKEN = 77;
#endif

typedef pg8::f32x4 af4;
DI void st8(bf16* p, const af4 v0, const af4 v1) { u32x4 w; w.x = pk2(v0[0], v0[1]); w.y = pk2(v0[2], v0[3]); w.z = pk2(v1[0], v1[1]); w.w = pk2(v1[2], v1[3]); *(u32x4*)p = w; }

struct EpiIn {
    static constexpr bool PERM = true, AFTER_DRAIN = false;
    bf16 *Q, *K, *Vt, *RW, *LO, *GA; const float* gate_bias;
    DI void operator()(const af4 (&acc)[2][2][4][2], const pg8::Unit& u, int wr, int wc, int fr, int fq) const {
        const int pn = u.pn, row0 = u.pm * 256 + wr * 64 + fr;
        if (pn == 4 || pn == 5) {
#pragma unroll
            for (int ai = 0; ai < 2; ++ai)
#pragma unroll
                for (int m = 0; m < 4; ++m) { const int row = row0 + ai * 128 + m * 16, b = row >> 13, s = row & (SEQ - 1);
#pragma unroll
                    for (int bj = 0; bj < 2; ++bj)
#pragma unroll
                        for (int n = 0; n < 2; ++n)
#pragma unroll
                            for (int j = 0; j < 4; ++j) { const int cv = (pn - 4) * 256 + bj * 128 + wc * 32 + 8 * fq + 4 * n + j;
                                Vt[((size_t)(b * BW + cv)) * SEQ + s] = (bf16)f2bf(acc[ai][bj][m][n][j]); } }
        } else if (pn >= 14) {
            const int col0 = (pn - 14) * 256 + wc * 32 + 8 * fq;
            af4 bv[2][2];
#pragma unroll
            for (int bj = 0; bj < 2; ++bj)
#pragma unroll
                for (int n = 0; n < 2; ++n) bv[bj][n] = *(const af4*)(gate_bias + col0 + bj * 128 + 4 * n);
#pragma unroll
            for (int ai = 0; ai < 2; ++ai)
#pragma unroll
                for (int m = 0; m < 4; ++m) { bf16* rowp = GA + (size_t)(row0 + ai * 128 + m * 16) * 2048 + col0;
#pragma unroll
                    for (int bj = 0; bj < 2; ++bj) { af4 v0 = acc[ai][bj][m][0] + bv[bj][0], v1 = acc[ai][bj][m][1] + bv[bj][1];
#pragma unroll
                        for (int j = 0; j < 4; ++j) { v0[j] = fsigmoid(v0[j]); v1[j] = fsigmoid(v1[j]); }
                        st8(rowp + bj * 128, v0, v1); } }
        } else {
            bf16* base; int ld, ct; float sc = 1.0f;
            if (pn < 2) { base = Q; ld = BW; ct = pn; sc = 0.125f; } else if (pn < 4) { base = K; ld = BW; ct = pn - 2; } else if (pn < 12) { base = RW; ld = 1536; ct = pn - 6; } else { base = LO; ld = BW; ct = pn - 12; }
            const int col0 = ct * 256 + wc * 32 + 8 * fq;
#pragma unroll
            for (int ai = 0; ai < 2; ++ai)
#pragma unroll
                for (int m = 0; m < 4; ++m) { bf16* rowp = base + (size_t)(row0 + ai * 128 + m * 16) * ld + col0;
#pragma unroll
                    for (int bj = 0; bj < 2; ++bj) st8(rowp + bj * 128, acc[ai][bj][m][0] * sc, acc[ai][bj][m][1] * sc); }
        }
    }
};

template <bool ADD> struct EpiMerge {
    static constexpr bool PERM = true, AFTER_DRAIN = false;
    bf16* GA; bf16* MRG; int gofs;
    DI void operator()(const af4 (&acc)[2][2][4][2], const pg8::Unit& u, int wr, int wc, int fr, int fq) const {
        const int row0 = u.pm * 256 + wr * 64 + fr, col0 = u.pn * 256 + wc * 32 + 8 * fq;
#pragma unroll
        for (int ai = 0; ai < 2; ++ai)
#pragma unroll
            for (int m = 0; m < 4; ++m) { const size_t row = (size_t)(row0 + ai * 128 + m * 16);
#pragma unroll
                for (int bj = 0; bj < 2; ++bj) { const int c = col0 + bj * 128;
                    float g[8]; unpack8(*(const u32x4*)(GA + row * 2048 + gofs + c), g);
                    af4 v0, v1;
#pragma unroll
                    for (int j = 0; j < 4; ++j) { v0[j] = g[j] * acc[ai][bj][m][0][j]; v1[j] = g[4 + j] * acc[ai][bj][m][1][j]; }
                    if (ADD) { float o[8]; unpack8(*(const u32x4*)(GA + row * 2048 + c), o);
#pragma unroll
                        for (int j = 0; j < 4; ++j) { v0[j] += o[j]; v1[j] += o[4 + j]; }
                        st8(MRG + row * D + c, v0, v1); }
                    else st8(GA + row * 2048 + c, v0, v1); } }
    }
};

struct EpiPlain {
    static constexpr bool PERM = true, AFTER_DRAIN = false;
    bf16* O; int ld, cmask;
    DI void operator()(const af4 (&acc)[2][2][4][2], const pg8::Unit& u, int wr, int wc, int fr, int fq) const {
        const int row0 = u.pm * 256 + wr * 64 + fr, col0 = (u.pn & cmask) * 256 + wc * 32 + 8 * fq;
#pragma unroll
        for (int ai = 0; ai < 2; ++ai)
#pragma unroll
            for (int m = 0; m < 4; ++m) { bf16* rowp = O + (size_t)(row0 + ai * 128 + m * 16) * ld + col0;
#pragma unroll
                for (int bj = 0; bj < 2; ++bj) st8(rowp + bj * 128, acc[ai][bj][m][0], acc[ai][bj][m][1]); }
    }
};

struct EpiUp {
    static constexpr bool PERM = true, AFTER_DRAIN = false;
    bf16* HID;
    DI void operator()(const af4 (&acc)[2][2][4][2], const pg8::Unit& u, int wr, int wc, int fr, int fq) const {
        const int row0 = u.pm * 256 + wr * 64 + fr, col0 = (u.pn & 3) * 128 + wc * 16 + 4 * fq;
#pragma unroll
        for (int ai = 0; ai < 2; ++ai)
#pragma unroll
            for (int m = 0; m < 4; ++m) { bf16* rowp = HID + (size_t)(row0 + ai * 128 + m * 16) * DE + col0;
#pragma unroll
                for (int bj = 0; bj < 2; ++bj) { float h[4];
#pragma unroll
                    for (int j = 0; j < 4; ++j) { const float u1 = acc[ai][bj][m][0][j]; h[j] = u1 * fsigmoid(u1) * acc[ai][bj][m][1][j]; }
                    u32x2 w; w.x = pk2(h[0], h[1]); w.y = pk2(h[2], h[3]); *(u32x2*)(rowp + bj * 64) = w; } }
    }
};

struct MoeOrder {
    int nunits, G, vc; const int* tile_e;
    DI bool next(int i, pg8::Unit& u) const { const long L = (long)i * G + vc; if (L >= nunits) return false; const int rt = (int)(L >> 2);
        u.pm = rt; u.pn = __builtin_amdgcn_readfirstlane(tile_e[rt]) * 4 + (int)(L & 3); return true; }
    DI void a_ready(const pg8::Unit&) const {}
    DI void done(const pg8::Unit&) const {}
};

struct Args {
    const float *x, *c, *w_mod, *b_mod, *gains, *w_in, *gate_bias, *shift_mu, *w0, *w_decay_up, *a0, *w_iclr_up, *w_gate_up, *k_k, *k_a, *r_k, *lnx_w, *lnx_b,
                *w_o_sb, *w_o_rw, *w_out, *w_group, *w_router, *w_up1, *w_up3, *w_down;
    float* out; unsigned char* ws;
};
struct Frame { LAS unsigned char* lds; int tid, lane, wave, wg, G, gw, NGW; };
#define CAS __attribute__((address_space(4)))
typedef const CAS Args& ARef;

DI void tr_item(const float* W, int ldw, int K, bf16* WT, int k0, int drow0, int scol0, LAS float* scr, int lane) {
    if (scol0 >= 0) {
        float v[32];
        const float* wp = W + (size_t)(k0 + (lane >> 5)) * ldw + scol0 + (lane & 31);
#pragma unroll
        for (int i = 0; i < 32; ++i) v[i] = wp[(size_t)(2 * i) * ldw];
#pragma unroll
        for (int i = 0; i < 32; ++i) scr[(2 * i + (lane >> 5)) * 33 + (lane & 31)] = v[i];
    } else {
#pragma unroll 8
        for (int i = 0; i < 32; ++i) { const int kk = 2 * i + (lane >> 5); scr[kk * 33 + (lane & 31)] = 0.0f; }
    }
    wave_lds_fence();
    const int c = lane & 7;
#pragma unroll
    for (int j = 0; j < 4; ++j) { const int n = (lane >> 3) + 8 * j; const LAS float* s = scr + (8 * c) * 33 + n;
        u32x4 o; o.x = pk2(s[0 * 33], s[1 * 33]); o.y = pk2(s[2 * 33], s[3 * 33]); o.z = pk2(s[4 * 33], s[5 * 33]); o.w = pk2(s[6 * 33], s[7 * 33]);
        *(u32x4*)(WT + (size_t)(drow0 + n) * K + k0 + 8 * c) = o; }
    wave_lds_fence();
}
DI void tr_item_up(const float* W1, const float* W3, bf16* WT, int e, int k0, int drow0, LAS float* scr, int lane) {
    const int l31 = lane & 31, sc = (drow0 >> 3) * 4 + (l31 >> 3) * 4 + (l31 & 3);
    const float* W = ((l31 & 4) ? W3 : W1) + (size_t)e * D * DE;
    { float v[32]; const float* wp = W + (size_t)(k0 + (lane >> 5)) * DE + sc;
#pragma unroll
        for (int i = 0; i < 32; ++i) v[i] = wp[(size_t)(2 * i) * DE];
#pragma unroll
        for (int i = 0; i < 32; ++i) scr[(2 * i + (lane >> 5)) * 33 + l31] = v[i]; }
    wave_lds_fence();
    const int c = lane & 7;
#pragma unroll
    for (int j = 0; j < 4; ++j) { const int n = (lane >> 3) + 8 * j; const LAS float* s = scr + (8 * c) * 33 + n;
        u32x4 o; o.x = pk2(s[0 * 33], s[1 * 33]); o.y = pk2(s[2 * 33], s[3 * 33]); o.z = pk2(s[4 * 33], s[5 * 33]); o.w = pk2(s[6 * 33], s[7 * 33]);
        *(u32x4*)(WT + ((size_t)e * 1024 + drow0 + n) * D + k0 + 8 * c) = o; }
    wave_lds_fence();
}

DI void p0_prologue(const Frame& F0, ARef A) {
    Frame F = F0; F.tid = opq_tid(F0.wave); F.lane = F.tid & 63; F.wave = __builtin_amdgcn_readfirstlane(F.tid >> 6); F.gw = F.wg * NWAVES + F.wave;
    unsigned char* ws = A.ws;
    LAS float* sl = (LAS float*)F.lds;
    LAS float* part = (LAS float*)(F.lds + 16384);
    for (int i = F.tid; i < NB * D; i += NTHR) { const float v = A.c[i]; sl[i] = v * fsigmoid(v); }
    __syncthreads();
    float* mod = (float*)(ws + WS_MOD);
    for (int cg = F.wg; cg < 256; cg += F.G) {
        const int col = F.tid & 31, kg = F.tid >> 5;
        if (col < 24) { float a0 = 0.f, a1 = 0.f, a2 = 0.f, a3 = 0.f;
#pragma unroll 8
            for (int kk = 0; kk < 64; ++kk) { const int k = kg * 64 + kk; const float w = A.w_mod[(size_t)k * 6144 + cg * 24 + col];
                a0 += sl[k] * w; a1 += sl[D + k] * w; a2 += sl[2 * D + k] * w; a3 += sl[3 * D + k] * w; }
            LAS float* p = part + (kg * 24 + col) * 4; p[0] = a0; p[1] = a1; p[2] = a2; p[3] = a3; }
        __syncthreads();
        if (F.tid < 96) { const int c = F.tid >> 2, b = F.tid & 3; float s = 0.f;
#pragma unroll
            for (int kg2 = 0; kg2 < 16; ++kg2) s += part[(kg2 * 24 + c) * 4 + b];
            mod[b * 6144 + cg * 24 + c] = s + A.b_mod[cg * 24 + c]; }
        __syncthreads();
    }
    LAS float* scr = (LAS float*)(F.lds + 32768 + F.wave * 8704);
    constexpr int I_IN = (NPAD / 32) * (D / 64), I_OS = (D / 32) * (BW / 64), I_OUT = (D / 32) * (D / 64);
    for (int it = F.gw; it < I_IN + 2 * I_OS + I_OUT; it += F.NGW) {
        int r = it;
        if (r < I_IN) { const int g = r / (D / 64), kb = r % (D / 64), drow0 = 32 * g;
            const int sc = drow0 < 3360 ? drow0 : (drow0 < 3584 ? -1 : drow0 - 224);
            tr_item(A.w_in, IN_COLS, D, (bf16*)(ws + WS_WIN), 64 * kb, drow0, sc, scr, F.lane); continue; }
        r -= I_IN;
        if (r < I_OS) { const int g = r / (BW / 64), kb = r % (BW / 64); tr_item(A.w_o_sb, D, BW, (bf16*)(ws + WS_WOSB), 64 * kb, 32 * g, 32 * g, scr, F.lane); continue; }
        r -= I_OS;
        if (r < I_OS) { const int g = r / (BW / 64), kb = r % (BW / 64); tr_item(A.w_o_rw, D, BW, (bf16*)(ws + WS_WORW), 64 * kb, 32 * g, 32 * g, scr, F.lane); continue; }
        r -= I_OS;
        { const int g = r / (D / 64), kb = r % (D / 64); tr_item(A.w_out, D, D, (bf16*)(ws + WS_WOUT), 64 * kb, 32 * g, 32 * g, scr, F.lane); }
    }
    const int gt = F.wg * NTHR + F.tid, NGT = F.G * NTHR;
    float* rtw = (float*)(ws + WS_RTW);
    for (int i = gt; i < 36 * D; i += NGT) { const int o = i >> 10, k = i & (D - 1); rtw[i] = o < 4 ? A.w_group[k * 4 + o] : A.w_router[k * NE + (o - 4)]; }
    bf16* wl = (bf16*)(ws + WS_WL);
    for (int i = gt; i < 1536 * LK; i += NGT) { const int n = i / LK, k = i % LK; float v = 0.f;
        if (n < 512) { if (k < 64) v = A.w_decay_up[k * BW + n]; }
        else if (n < 1024) { if (k >= 64 && k < 128) v = A.w_iclr_up[(k - 64) * BW + (n - 512)]; }
        else { if (k >= 128 && k < 288) v = A.w_gate_up[(k - 128) * BW + (n - 1024)]; }
        wl[i] = (bf16)f2bf(v); }
}

DI void p1_h1(const Frame& F0, ARef A, bf16* H1) {
    Frame F = F0; F.tid = opq_tid(F0.wave); F.lane = F.tid & 63; F.wave = __builtin_amdgcn_readfirstlane(F.tid >> 6); F.gw = F.wg * NWAVES + F.wave;
    const float* mod = (const float*)(A.ws + WS_MOD);
    for (int n = F.gw; n < NTOK; n += F.NGW) {
        const int b = n >> 13;
        const f32x4* xr = (const f32x4*)(A.x + (size_t)n * D) + F.lane;
        f32x4 v[4]; float s = 0.f;
#pragma unroll
        for (int j = 0; j < 4; ++j) { v[j] = xr[64 * j]; s += (v[j][0] * v[j][0] + v[j][1] * v[j][1]) + (v[j][2] * v[j][2] + v[j][3] * v[j][3]); }
        const float inv = rsqrtf(wave_sum(s) * (1.0f / D) + NORM_EPS);
        u32x2* o = (u32x2*)(H1 + (size_t)n * D) + F.lane;
#pragma unroll
        for (int j = 0; j < 4; ++j) { const int k = 4 * F.lane + 256 * j;
            const f32x4 g = *(const f32x4*)(A.gains + k), sh = *(const f32x4*)(mod + b * 6144 + k), sc = *(const f32x4*)(mod + b * 6144 + D + k);
            f32x4 h;
#pragma unroll
            for (int q = 0; q < 4; ++q) h[q] = (v[j][q] * inv) * g[q] * (1.0f + sc[q]) + sh[q];
            u32x2 w; w.x = pk2(h[0], h[1]); w.y = pk2(h[2], h[3]); o[64 * j] = w; }
    }
}

DI void p3_attn(const Frame& F0, const bf16* QB, const bf16* KB, const bf16* VT, bf16* YSB) {
    Frame F = F0; F.tid = opq_tid(F0.wave); F.lane = F.tid & 63; F.wave = __builtin_amdgcn_readfirstlane(F.tid >> 6); F.gw = F.wg * NWAVES + F.wave;
    const int lane = F.lane, r = lane & 31, hh = lane >> 5;
    bf16x8 tri[2];
#pragma unroll
    for (int s = 0; s < 2; ++s)
#pragma unroll
        for (int e = 0; e < 8; ++e) tri[s][e] = (16 * s + 8 * (e >> 2) + 4 * hh + (e & 3)) > r ? (short)0x3F80 : (short)0;
    for (int u = F.gw; u < NB * NH * (SEQ / 32); u += F.NGW) {
        const int bh = u >> 8, qt = u & 255, b = bh >> 3, h = bh & 7;
        const bf16* qp = QB + (size_t)(b * SEQ + qt * 32 + r) * BW + h * HD + 8 * hh;
        bf16x8 qf[4];
#pragma unroll
        for (int ks = 0; ks < 4; ++ks) qf[ks] = *(const bf16x8*)(qp + 16 * ks);
        f32x16 o0, o1;
#pragma unroll
        for (int i = 0; i < 16; ++i) { o0[i] = 0.f; o1[i] = 0.f; }
        float L = 0.f;
        bf16x8 kf[4]; s16x4 vlo[2][2], vhi[2][2];
#define ATT_LOAD(KT, KF, VLO, VHI) do { const bf16* kp_ = KB + (size_t)(b * SEQ + (KT) * 32 + r) * BW + h * HD + 8 * hh; \
            _Pragma("unroll") for (int ks = 0; ks < 4; ++ks) KF[ks] = *(const bf16x8*)(kp_ + 16 * ks); \
            const bf16* vp_ = VT + ((size_t)(bh * HD + r)) * SEQ + (KT) * 32 + 4 * hh; \
            _Pragma("unroll") for (int mb = 0; mb < 2; ++mb) _Pragma("unroll") for (int ks = 0; ks < 2; ++ks) { VLO[mb][ks] = *(const s16x4*)(vp_ + (size_t)mb * 32 * SEQ + 16 * ks); VHI[mb][ks] = *(const s16x4*)(vp_ + (size_t)mb * 32 * SEQ + 16 * ks + 8); } } while (0)
        ATT_LOAD(qt, kf, vlo, vhi);
        for (int kt = qt; kt >= 0; --kt) {
            bf16x8 kfn[4]; s16x4 vlon[2][2], vhin[2][2];
            { const int ktn = kt > 0 ? kt - 1 : 0; ATT_LOAD(ktn, kfn, vlon, vhin); }
            f32x16 z;
#pragma unroll
            for (int i = 0; i < 16; ++i) z[i] = 0.f;
#pragma unroll
            for (int ks = 0; ks < 4; ++ks) z = MFMA32(kf[ks], qf[ks], z);
            const bool diag = (kt == qt);
            float lk[16], lo[16], tot = 0.f;
#pragma unroll
            for (int i = 0; i < 16; ++i) { const bool valid = !diag || (crow(i, hh) < r);
                const float sp = fsoftplus(z[i]); lk[i] = valid ? -sp : 0.0f; z[i] = valid ? z[i] - sp : -1.0e30f;
                tot += lk[i];
                const float hi = bflo(f2bf(lk[i])); lo[i] = lk[i] - hi; lk[i] = hi; }
            tot += shfl_xor_l(tot, 32, lane);
            f32x16 lat;
#pragma unroll
            for (int i = 0; i < 16; ++i) lat[i] = L;
#pragma unroll
            for (int s = 0; s < 2; ++s) {
                lat = MFMA32(tri[s], pack8v(lk[8 * s], lk[8 * s + 1], lk[8 * s + 2], lk[8 * s + 3], lk[8 * s + 4], lk[8 * s + 5], lk[8 * s + 6], lk[8 * s + 7]), lat);
                lat = MFMA32(tri[s], pack8v(lo[8 * s], lo[8 * s + 1], lo[8 * s + 2], lo[8 * s + 3], lo[8 * s + 4], lo[8 * s + 5], lo[8 * s + 6], lo[8 * s + 7]), lat); }
            float at[16];
#pragma unroll
            for (int i = 0; i < 16; ++i) at[i] = fexp(z[i] + lat[i]);
#pragma unroll
            for (int s = 0; s < 2; ++s) { const bf16x8 ab = pack8v(at[8 * s], at[8 * s + 1], at[8 * s + 2], at[8 * s + 3], at[8 * s + 4], at[8 * s + 5], at[8 * s + 6], at[8 * s + 7]);
                bf16x8 va, vb;
#pragma unroll
                for (int e = 0; e < 4; ++e) { va[e] = vlo[0][s][e]; va[4 + e] = vhi[0][s][e]; vb[e] = vlo[1][s][e]; vb[4 + e] = vhi[1][s][e]; }
                o0 = MFMA32(va, ab, o0); o1 = MFMA32(vb, ab, o1); }
            L += tot;
            if (__all(L < SB_STOP)) break;
#pragma unroll
            for (int ks = 0; ks < 4; ++ks) kf[ks] = kfn[ks];
#pragma unroll
            for (int mb = 0; mb < 2; ++mb)
#pragma unroll
                for (int ks = 0; ks < 2; ++ks) { vlo[mb][ks] = vlon[mb][ks]; vhi[mb][ks] = vhin[mb][ks]; }
        }
#undef ATT_LOAD
        bf16* op = YSB + (size_t)(b * SEQ + qt * 32 + r) * BW + h * HD + 4 * hh;
#pragma unroll
        for (int g = 0; g < 4; ++g) { u32x2 w0, w1; w0.x = pk2(o0[4 * g], o0[4 * g + 1]); w0.y = pk2(o0[4 * g + 2], o0[4 * g + 3]); w1.x = pk2(o1[4 * g], o1[4 * g + 1]); w1.y = pk2(o1[4 * g + 2], o1[4 * g + 3]);
            *(u32x2*)(op + 8 * g) = w0; *(u32x2*)(op + 32 + 8 * g) = w1; }
    }
}

DI void p3_prep(const Frame& F0, ARef A, const bf16* RWRAW, const bf16* LORA, bf16* R, bf16* KS, bf16* V, bf16* KK, bf16* ALORA) {
    Frame F = F0; F.tid = opq_tid(F0.wave); F.lane = F.tid & 63; F.wave = __builtin_amdgcn_readfirstlane(F.tid >> 6); F.gw = F.wg * NWAVES + F.wave;
    const int lane = F.lane;
    f32x4 mu[3][2], kkc[2], mul[2];
#pragma unroll
    for (int part = 0; part < 3; ++part) { mu[part][0] = *(const f32x4*)(A.shift_mu + part * 512 + lane * 8); mu[part][1] = *(const f32x4*)(A.shift_mu + part * 512 + lane * 8 + 4); }
    kkc[0] = *(const f32x4*)(A.k_k + lane * 8); kkc[1] = *(const f32x4*)(A.k_k + lane * 8 + 4);
    const int lcol = lane < 36 ? lane * 8 : 0;
    mul[0] = *(const f32x4*)(A.shift_mu + 1536 + lcol); mul[1] = *(const f32x4*)(A.shift_mu + 1536 + lcol + 4);
    constexpr int RUN = 16;
    for (int run = F.gw; run < NTOK / RUN; run += F.NGW) {
        const int n0 = run * RUN;
        u32x4 prv[3], prl, cur[3], cul;
        const u32x4 z4 = {0u, 0u, 0u, 0u};
        if ((n0 & (SEQ - 1)) == 0) { prv[0] = z4; prv[1] = z4; prv[2] = z4; prl = z4; }
        else {
#pragma unroll
            for (int part = 0; part < 3; ++part) prv[part] = *(const u32x4*)(RWRAW + (size_t)(n0 - 1) * 1536 + part * 512 + lane * 8);
            prl = *(const u32x4*)(LORA + (size_t)(n0 - 1) * BW + lcol); }
#pragma unroll
        for (int part = 0; part < 3; ++part) cur[part] = *(const u32x4*)(RWRAW + (size_t)n0 * 1536 + part * 512 + lane * 8);
        cul = *(const u32x4*)(LORA + (size_t)n0 * BW + lcol);
        for (int i = 0; i < RUN; ++i) {
            const int n = n0 + i, nn = i + 1 < RUN ? n + 1 : n;
            u32x4 nxt[3], nxl;
#pragma unroll
            for (int part = 0; part < 3; ++part) nxt[part] = *(const u32x4*)(RWRAW + (size_t)nn * 1536 + part * 512 + lane * 8);
            nxl = *(const u32x4*)(LORA + (size_t)nn * BW + lcol);
            float xs[3][8];
#pragma unroll
            for (int part = 0; part < 3; ++part) { float p[8], q[8]; unpack8(cur[part], p); unpack8(prv[part], q);
#pragma unroll
                for (int j = 0; j < 4; ++j) { xs[part][j] = p[j] + mu[part][0][j] * (q[j] - p[j]); xs[part][4 + j] = p[4 + j] + mu[part][1][j] * (q[4 + j] - p[4 + j]); } }
            const size_t off = (size_t)n * BW + lane * 8;
            *(u32x4*)(R + off) = pack8(xs[0]); *(u32x4*)(KS + off) = pack8(xs[1]); *(u32x4*)(V + off) = pack8(xs[2]);
            float kk[8], ss = 0.f;
#pragma unroll
            for (int j = 0; j < 4; ++j) { kk[j] = xs[1][j] * kkc[0][j]; kk[4 + j] = xs[1][4 + j] * kkc[1][j]; }
#pragma unroll
            for (int j = 0; j < 8; ++j) ss += kk[j] * kk[j];
            ss += shfl_xor_l(ss, 1, lane); ss += shfl_xor_l(ss, 2, lane); ss += shfl_xor_l(ss, 4, lane);
            const float rn = 1.0f / fmaxf(sqrtf(ss), L2_EPS);
#pragma unroll
            for (int j = 0; j < 8; ++j) kk[j] *= rn;
            *(u32x4*)(KK + off) = pack8(kk);
            if (lane < 48) { float a[8];
                if (lane < 36) { float p[8], q[8]; unpack8(cul, p); unpack8(prl, q);
#pragma unroll
                    for (int j = 0; j < 8; ++j) { const float m = j < 4 ? mul[0][j & 3] : mul[1][j & 3]; const float v = p[j] + m * (q[j] - p[j]);
                        a[j] = lane < 8 ? (1.0f - 2.0f * frcp(fexp(2.0f * v) + 1.0f)) : (lane < 16 ? v : fsigmoid(v)); }
                } else {
#pragma unroll
                    for (int j = 0; j < 8; ++j) a[j] = 0.f; }
                *(u32x4*)(ALORA + (size_t)n * LK + lane * 8) = pack8(a); }
#pragma unroll
            for (int part = 0; part < 3; ++part) { prv[part] = cur[part]; cur[part] = nxt[part]; }
            prl = cul; cul = nxl;
        }
    }
}

DI void p4_lora(const Frame& F0, ARef A, const bf16* ALORA, const bf16* WL, bf16* E, bf16* KS, bf16* Bo, bf16* GG, const bf16* KK, const bf16* R, float* BON) {
    Frame F = F0; F.tid = opq_tid(F0.wave); F.lane = F.tid & 63; F.wave = __builtin_amdgcn_readfirstlane(F.tid >> 6); F.gw = F.wg * NWAVES + F.wave;
    const int lane = F.lane, r = lane & 31, hh = lane >> 5;
    for (int u = F.gw; u < 2 * (NTOK / 32); u += F.NGW) {
        const int n0 = (u >> 1) * 32, par = u & 1;
        bf16x8 tf[18];
#pragma unroll
        for (int ks = 0; ks < 18; ++ks) tf[ks] = *(const bf16x8*)(ALORA + (size_t)(n0 + r) * LK + 16 * ks + 8 * hh);
        const unsigned orow = (unsigned)(n0 + r) * BW + 4 * hh;
#define LORA_BLOCK(KS0, NKS, CB, BODY) { const int c0_ = 32 * ((CB) & 15); f32x16 acc_; \
            _Pragma("unroll") for (int q = 0; q < 16; ++q) acc_[q] = 0.f; \
            _Pragma("unroll") for (int ks = 0; ks < (NKS); ++ks) acc_ = MFMA32(*(const bf16x8*)(WL + (size_t)(32 * (CB) + r) * LK + 16 * ((KS0) + ks) + 8 * hh), tf[(KS0) + ks], acc_); \
            BODY }
        for (int i = 0; i < 8; ++i) { const int cb = 4 * (i >> 1) + 2 * par + (i & 1);
            LORA_BLOCK(0, 4, cb, {
                _Pragma("unroll") for (int g = 0; g < 4; ++g) { const f32x4 w0v = *(const f32x4*)(A.w0 + c0_ + 8 * g + 4 * hh); float e4[4];
                    _Pragma("unroll") for (int j = 0; j < 4; ++j) { const float v = acc_[4 * g + j] + w0v[j]; e4[j] = fexp(-fsoftplus(-v) - 0.5f); }
                    u32x2 w; w.x = pk2(e4[0], e4[1]); w.y = pk2(e4[2], e4[3]); *(u32x2*)(E + orow + c0_ + 8 * g) = w; } }) }
        float bsum = 0.f;
        for (int i = 0; i < 8; ++i) { const int cb = 16 + 4 * (i >> 1) + 2 * par + (i & 1);
            LORA_BLOCK(4, 4, cb, {
                _Pragma("unroll") for (int g = 0; g < 4; ++g) { const f32x4 a0v = *(const f32x4*)(A.a0 + c0_ + 8 * g + 4 * hh); const f32x4 kav = *(const f32x4*)(A.k_a + c0_ + 8 * g + 4 * hh);
                    const unsigned o = orow + c0_ + 8 * g; const u32x2 kw = *(const u32x2*)(KS + o); const u32x2 qw = *(const u32x2*)(KK + o); const u32x2 rw = *(const u32x2*)(R + o); const f32x4 rkv = *(const f32x4*)(A.r_k + c0_ + 8 * g + 4 * hh);
                    float ksv[4]; float kkv[4]; float kp[4]; float bb[4]; ksv[0] = bflo(kw.x); ksv[1] = bfhi(kw.x); ksv[2] = bflo(kw.y); ksv[3] = bfhi(kw.y); kkv[0] = bflo(qw.x); kkv[1] = bfhi(qw.x); kkv[2] = bflo(qw.y); kkv[3] = bfhi(qw.y);
                    _Pragma("unroll") for (int j = 0; j < 4; ++j) { const float s0 = fsigmoid(acc_[4 * g + j] + a0v[j]); kp[j] = ksv[j] * (1.0f + (s0 - 1.0f) * kav[j]); bb[j] = kkv[j] * s0; }
                    bsum += (bflo(rw.x) * kp[0] * rkv[0] + bfhi(rw.x) * kp[1] * rkv[1]) + (bflo(rw.y) * kp[2] * rkv[2] + bfhi(rw.y) * kp[3] * rkv[3]);
                    u32x2 w1; u32x2 w2; w1.x = pk2(kp[0], kp[1]); w1.y = pk2(kp[2], kp[3]); w2.x = pk2(bb[0], bb[1]); w2.y = pk2(bb[2], bb[3]); *(u32x2*)(KS + o) = w1; *(u32x2*)(Bo + o) = w2; } })
            if (i & 1) { const float tot = bsum + shfl_xor_l(bsum, 32, lane); if (hh == 0) BON[(size_t)(n0 + r) * 8 + 2 * (i >> 1) + par] = tot; bsum = 0.f; } }
        for (int i = 0; i < 8; ++i) { const int cb = 32 + 4 * (i >> 1) + 2 * par + (i & 1);
            LORA_BLOCK(8, 10, cb, {
                _Pragma("unroll") for (int g = 0; g < 4; ++g) { u32x2 w; w.x = pk2(acc_[4 * g], acc_[4 * g + 1]); w.y = pk2(acc_[4 * g + 2], acc_[4 * g + 3]); *(u32x2*)(GG + orow + c0_ + 8 * g) = w; } }) }
#undef LORA_BLOCK
    }
}

DI void p6_chain(int task, int wave, const bf16* GT, const bf16* HT, bf16* SC) {
    const int lane = opq_tid(wave) & 63;
    const int bh = task >> 1, nb = task & 1, r = lane & 31, hh = lane >> 5, i = nb * 32 + r;
    f32x16 X[2];
#pragma unroll
    for (int q = 0; q < 16; ++q) { X[0][q] = 0.f; X[1][q] = 0.f; }
    f32x16 H0[2], H1[2]; bf16x8 G0[8], G1[8];
#define CHAIN_FETCH(cc, HS, GS) do { const bf16* ht_ = HT + ((size_t)bh * NCH + (cc)) * 4096; const bf16* gt_ = GT + ((size_t)bh * NCH + (cc)) * 4096; \
        _Pragma("unroll") for (int kb = 0; kb < 2; ++kb) _Pragma("unroll") for (int g = 0; g < 4; ++g) { const u32x2 w_ = *(const u32x2*)(ht_ + ((((kb * 2 + nb) * 4 + g) * 64) + lane) * 4); \
            HS[kb][4 * g] = bflo(w_.x); HS[kb][4 * g + 1] = bfhi(w_.x); HS[kb][4 * g + 2] = bflo(w_.y); HS[kb][4 * g + 3] = bfhi(w_.y); } \
        _Pragma("unroll") for (int f = 0; f < 8; ++f) GS[f] = *(const bf16x8*)(gt_ + (f * 64 + lane) * 8); } while (0)
#define CHAIN_STORE(cc) do { bf16* sc_ = SC + ((size_t)bh * NCH + (cc)) * 4096; \
        _Pragma("unroll") for (int jb = 0; jb < 2; ++jb) _Pragma("unroll") for (int g = 0; g < 4; ++g) { u32x2 w_; w_.x = pk2(X[jb][4 * g], X[jb][4 * g + 1]); w_.y = pk2(X[jb][4 * g + 2], X[jb][4 * g + 3]); \
            *(u32x2*)(sc_ + ((((jb * 2 + nb) * 4 + g) * 64) + lane) * 4) = w_; } } while (0)
#define CHAIN_STEP(HS, GS) do { bf16x8 xb_[2][2]; \
        _Pragma("unroll") for (int jb = 0; jb < 2; ++jb) _Pragma("unroll") for (int s = 0; s < 2; ++s) \
            xb_[jb][s] = pack8v(X[jb][8 * s], X[jb][8 * s + 1], X[jb][8 * s + 2], X[jb][8 * s + 3], X[jb][8 * s + 4], X[jb][8 * s + 5], X[jb][8 * s + 6], X[jb][8 * s + 7]); \
        X[0] = HS[0]; X[1] = HS[1]; \
        _Pragma("unroll") for (int kb = 0; kb < 2; ++kb) _Pragma("unroll") for (int jb = 0; jb < 2; ++jb) _Pragma("unroll") for (int s = 0; s < 2; ++s) X[kb] = MFMA32(GS[kb * 4 + jb * 2 + s], xb_[jb][s], X[kb]); } while (0)
    CHAIN_FETCH(0, H0, G0); CHAIN_FETCH(1, H1, G1);
    for (int c = 0; c < NCH; c += 2) {
        CHAIN_STORE(c);
        CHAIN_STEP(H0, G0);
        if (c + 2 < NCH - 1) CHAIN_FETCH(c + 2, H0, G0);
        CHAIN_STORE(c + 1);
        if (c + 1 < NCH - 1) { CHAIN_STEP(H1, G1);
            if (c + 3 < NCH - 1) CHAIN_FETCH(c + 3, H1, G1); }
    }
#undef CHAIN_FETCH
#undef CHAIN_STORE
#undef CHAIN_STEP
}

DI void p6_moe_weights(const Frame& F0, ARef A, int wi, int NW) {
    Frame F = F0; F.tid = opq_tid(F0.wave); F.lane = F.tid & 63; F.wave = __builtin_amdgcn_readfirstlane(F.tid >> 6); F.gw = F.wg * NWAVES + F.wave;
    LAS float* scr = (LAS float*)(F.lds + F.wave * 20480);
    constexpr int I_UP = NE * 32 * 16, I_DN = NE * 32 * 8;
    for (int it = wi; it < I_UP + I_DN; it += NW) {
        if (it < I_UP) { const int e = it >> 9, g = (it >> 4) & 31, kb = it & 15; tr_item_up(A.w_up1, A.w_up3, (bf16*)(A.ws + WS_WUP), e, 64 * kb, 32 * g, scr, F.lane); }
        else { const int r = it - I_UP, e = r >> 8, g = (r >> 3) & 31, kb = r & 7;
            tr_item(A.w_down + (size_t)e * DE * D, D, DE, (bf16*)(A.ws + WS_WDN) + (size_t)e * 1024 * DE, 64 * kb, 32 * g, 32 * g, scr, F.lane); }
    }
}

DI float half_bcast_sum(float v, int hh) {
    v += DPP_SHR(v, 0x111); v += DPP_SHR(v, 0x112); v += DPP_SHR(v, 0x114); v += DPP_SHR(v, 0x118);
    v += __builtin_bit_cast(float, __builtin_amdgcn_update_dpp(0, __builtin_bit_cast(int, v), 0x142, 0xa, 0xf, false));
    const float lo = __builtin_bit_cast(float, __builtin_amdgcn_readlane(__builtin_bit_cast(int, v), 31)), hi = __builtin_bit_cast(float, __builtin_amdgcn_readlane(__builtin_bit_cast(int, v), 63));
    return hh ? hi : lo; }
DI void p7_mfma(const Frame& F0, ARef A, const bf16* SC, const bf16* Pn, const bf16* QOn, const bf16* V, const bf16* GG, const float* BON, bf16* YRW) {
    Frame F = F0; F.tid = opq_tid(F0.wave); F.lane = F.tid & 63; F.wave = __builtin_amdgcn_readfirstlane(F.tid >> 6); F.gw = F.wg * NWAVES + F.wave;
    const int lane = F.lane, r = lane & 31, hh = lane >> 5;
    for (int cid = F.gw; cid < NCHUNK; cid += F.NGW) {
        const int bh = cid >> NCH_LOG, c = cid & (NCH - 1), b = bh >> 3, h = bh & 7;
        const unsigned n0 = (unsigned)b * SEQ + (unsigned)c * CH; const int col0 = h * HD;
        const bf16* sc = SC + (size_t)cid * 4096; const bf16* pn = Pn + (size_t)cid * 4096; const bf16* qn = QOn + (size_t)cid * 4096;
        bf16x8 Sf[2][2][2], Pf[2][2][2];
#pragma unroll
        for (int jb = 0; jb < 2; ++jb)
#pragma unroll
            for (int xb = 0; xb < 2; ++xb)
#pragma unroll
                for (int s = 0; s < 2; ++s) { const s16x4 lo = *(const s16x4*)(sc + ((((jb * 2 + xb) * 4 + 2 * s) * 64) + lane) * 4), hi = *(const s16x4*)(sc + ((((jb * 2 + xb) * 4 + 2 * s + 1) * 64) + lane) * 4);
#pragma unroll
                    for (int e = 0; e < 4; ++e) { Sf[jb][xb][s][e] = lo[e]; Sf[jb][xb][s][4 + e] = hi[e]; }
                    Pf[jb][xb][s] = *(const bf16x8*)(pn + ((((jb * 2 + xb) * 2 + s) * 64) + lane) * 8); }
        f32x16 Z[2][2];
#pragma unroll
        for (int tb = 0; tb < 2; ++tb)
#pragma unroll
            for (int nb = 0; nb < 2; ++nb) {
#pragma unroll
                for (int g = 0; g < 4; ++g) { const u32x2 w = *(const u32x2*)(qn + ((((tb * 2 + nb) * 4 + g) * 64) + lane) * 4);
                    Z[tb][nb][4 * g] = bflo(w.x); Z[tb][nb][4 * g + 1] = bfhi(w.x); Z[tb][nb][4 * g + 2] = bflo(w.y); Z[tb][nb][4 * g + 3] = bfhi(w.y); }
#pragma unroll
                for (int jb = 0; jb < 2; ++jb)
#pragma unroll
                    for (int s = 0; s < 2; ++s) Z[tb][nb] = MFMA32(Pf[jb][tb][s], Sf[jb][nb][s], Z[tb][nb]); }
        float lw[2], lb[2];
#pragma unroll
        for (int nb = 0; nb < 2; ++nb) { lw[nb] = A.lnx_w[col0 + 32 * nb + r]; lb[nb] = A.lnx_b[col0 + 32 * nb + r]; }
#pragma unroll
        for (int tb = 0; tb < 2; ++tb)
#pragma unroll
            for (int q = 0; q < 16; ++q) {
                const unsigned tokrow = n0 + 32 * tb + 4 * hh + (q & 3) + 8 * (q >> 2);
                const float mean = half_bcast_sum(Z[tb][0][q] + Z[tb][1][q], hh) * (1.0f / 64.0f);
                const float d0 = Z[tb][0][q] - mean, d1 = Z[tb][1][q] - mean;
                const float rs = rsqrtf(half_bcast_sum(d0 * d0 + d1 * d1, hh) * (1.0f / 64.0f) + GN_EPS);
                const float bon = BON[(size_t)tokrow * 8 + h];
                const unsigned o0 = tokrow * BW + col0 + r;
                YRW[o0] = (bf16)f2bf((d0 * rs * lw[0] + lb[0] + bon * bf2f(V[o0])) * bf2f(GG[o0]));
                YRW[o0 + 32] = (bf16)f2bf((d1 * rs * lw[1] + lb[1] + bon * bf2f(V[o0 + 32])) * bf2f(GG[o0 + 32]));
                if ((q & 3) == 3) __builtin_amdgcn_sched_barrier(0); }
    }
}

DI void p10_rows(const Frame& F0, ARef A, const bf16* Y1, bf16* H2) {
    Frame F = F0; F.tid = opq_tid(F0.wave); F.lane = F.tid & 63; F.wave = __builtin_amdgcn_readfirstlane(F.tid >> 6); F.gw = F.wg * NWAVES + F.wave;
    const int lane = F.lane;
    const float* mod = (const float*)(A.ws + WS_MOD);
    LAS float* rw = (LAS float*)F.lds;
    LAS int* hist = (LAS int*)(F.lds + 147456);
    { const float* src = (const float*)(A.ws + WS_RTW);
        for (int i = F.tid; i < 18 * D; i += NTHR) { const int op = i >> 10, k = i & (D - 1); typedef float f2_t __attribute__((ext_vector_type(2))); f2_t w; w.x = src[(2 * op) * D + k]; w.y = src[(2 * op + 1) * D + k]; *(LAS f2_t*)(rw + 2 * i) = w; } }
    i32x4* tok = (i32x4*)(A.ws + WS_TOK); int* cnt = (int*)(A.ws + WS_CNT);
    for (int tb = F.wg; tb < NTOK / 128; tb += F.G) {
        if (F.tid < 32) hist[F.tid] = 0;
        __syncthreads();
        for (int tl = F.wave; tl < 128; tl += NWAVES) {
            const int n = tb * 128 + tl, b = n >> 13;
            const f32x4* xr = (const f32x4*)(A.x + (size_t)n * D) + lane; const u32x2* yr = (const u32x2*)(Y1 + (size_t)n * D) + lane;
            f32x4 xv[4], yv[4]; float s = 0.f;
#pragma unroll
            for (int j = 0; j < 4; ++j) { xv[j] = xr[64 * j]; const u32x2 w = yr[64 * j]; yv[j][0] = bflo(w.x); yv[j][1] = bfhi(w.x); yv[j][2] = bflo(w.y); yv[j][3] = bfhi(w.y);
                s += (yv[j][0] * yv[j][0] + yv[j][1] * yv[j][1]) + (yv[j][2] * yv[j][2] + yv[j][3] * yv[j][3]); }
            const float inv1 = rsqrtf(wave_sum(s) * (1.0f / D) + NORM_EPS);
            float s2 = 0.f;
#pragma unroll
            for (int j = 0; j < 4; ++j) { const int k = 4 * lane + 256 * j;
                const f32x4 g1 = *(const f32x4*)(A.gains + D + k), gt = *(const f32x4*)(mod + b * 6144 + 2 * D + k);
#pragma unroll
                for (int q = 0; q < 4; ++q) { xv[j][q] = xv[j][q] + gt[q] * ((yv[j][q] * inv1) * g1[q]); s2 += xv[j][q] * xv[j][q]; }
                u32x2 xw; xw.x = pk2(xv[j][0], xv[j][1]); xw.y = pk2(xv[j][2], xv[j][3]); *((u32x2*)(A.ws + WS_X1 + (size_t)n * D * 2) + lane + 64 * j) = xw; }
            const float inv2 = rsqrtf(wave_sum(s2) * (1.0f / D) + NORM_EPS);
            f32x4 hv[4];
#pragma unroll
            for (int j = 0; j < 4; ++j) { const int k = 4 * lane + 256 * j;
                const f32x4 g2 = *(const f32x4*)(A.gains + 2 * D + k), sh = *(const f32x4*)(mod + b * 6144 + 3 * D + k), sc = *(const f32x4*)(mod + b * 6144 + 4 * D + k);
#pragma unroll
                for (int q = 0; q < 4; ++q) hv[j][q] = (xv[j][q] * inv2) * g2[q] * (1.0f + sc[q]) + sh[q];
                u32x2 w; w.x = pk2(hv[j][0], hv[j][1]); w.y = pk2(hv[j][2], hv[j][3]); *((u32x2*)(H2 + (size_t)n * D) + lane + 64 * j) = w; }
            typedef float f2_t __attribute__((ext_vector_type(2)));
#define P10_PAIR(OUT0, OUT1, WBASE) do { f2_t a = {0.f, 0.f}; \
                _Pragma("unroll") for (int j = 0; j < 4; ++j) { const LAS f32x4* wp = (const LAS f32x4*)((WBASE) + (4 * lane + 256 * j) * 2); const f32x4 wA = wp[0], wB = wp[1]; \
                    a += (f2_t){hv[j][0], hv[j][0]} * (f2_t){wA[0], wA[1]}; a += (f2_t){hv[j][1], hv[j][1]} * (f2_t){wA[2], wA[3]}; \
                    a += (f2_t){hv[j][2], hv[j][2]} * (f2_t){wB[0], wB[1]}; a += (f2_t){hv[j][3], hv[j][3]} * (f2_t){wB[2], wB[3]}; } \
                OUT0 = wave_sum(a.x); OUT1 = wave_sum(a.y); } while (0)
            float lg[4];
            P10_PAIR(lg[0], lg[1], rw); P10_PAIR(lg[2], lg[3], rw + 2 * D);
            int gs = 0; float gm = lg[0];
#pragma unroll
            for (int g = 1; g < 4; ++g) if (lg[g] > gm) { gm = lg[g]; gs = g; }
            gs = __builtin_amdgcn_readfirstlane(gs);
            float gsum = 0.f;
#pragma unroll
            for (int g = 0; g < 4; ++g) gsum += fexp(lg[g] - gm);
            const float gw = 1.0f / gsum;
            float el[8];
            { const LAS float* rwg = rw + (2 + 4 * gs) * (2 * D);
#pragma unroll
              for (int i = 0; i < 4; ++i) P10_PAIR(el[2 * i], el[2 * i + 1], rwg + i * 2 * D); }
#undef P10_PAIR
            int i0 = 0; float m0 = el[0];
#pragma unroll
            for (int e = 1; e < 8; ++e) if (el[e] > m0) { m0 = el[e]; i0 = e; }
            int i1 = -1; float m1 = -3.0e38f;
#pragma unroll
            for (int e = 0; e < 8; ++e) if (e != i0 && el[e] > m1) { m1 = el[e]; i1 = e; }
            const float t = fexp(m1 - m0), p0 = 1.0f / (1.0f + t), p1 = t * p0;
            const int e0 = gs * 8 + i0, e1 = gs * 8 + i1;
#if defined(CHECKS)
            if (lane == 0 && n == DBG_TOKEN) { float* dbg = (float*)(A.ws + WS_CTL + 32768) + 48; dbg[0] = lg[0]; dbg[1] = lg[1]; dbg[2] = lg[2]; dbg[3] = lg[3]; dbg[4] = gsum; dbg[5] = p0; dbg[6] = gw; dbg[7] = t; }
#endif
            if (lane == 0) { i32x4 rec; rec.x = e0 | (e1 << 8); rec.y = 0; rec.z = 0; rec.w = 0; tok[n] = rec;
                float* cwp = (float*)(A.ws + WS_CW) + 2 * n; cwp[0] = gw * p0; cwp[1] = gw * p1;
                atomicAdd((int*)&hist[e0], 1); atomicAdd((int*)&hist[e1], 1); }
        }
        __syncthreads();
        if (F.tid < 32) cnt[tb * 32 + F.tid] = hist[F.tid];
        __syncthreads();
    }
}

DI void p11_rank_gather(const Frame& F0, ARef A, const bf16* H2, bf16* HS) {
    Frame F = F0; F.tid = opq_tid(F0.wave); F.lane = F.tid & 63; F.wave = __builtin_amdgcn_readfirstlane(F.tid >> 6); F.gw = F.wg * NWAVES + F.wave;
    LAS int* base = (LAS int*)F.lds;
    LAS int* seg = base + 32;
    LAS int* el = base + 96;
    LAS int* pos = base + 352;
    i32x4* tok = (i32x4*)(A.ws + WS_TOK); const int* cnt = (const int*)(A.ws + WS_CNT); int* tile = (int*)(A.ws + WS_TILE);
    for (int tb = F.wg; tb < NTOK / 128; tb += F.G) {
        if (F.tid < 32) { int tot = 0, pre = 0;
            for (int t2 = 0; t2 < NTOK / 128; ++t2) { const int v = cnt[t2 * 32 + F.tid]; tot += v; if (t2 < tb) pre += v; }
            base[F.tid] = pre; seg[F.tid] = (tot + 255) & ~255; }
        if (F.tid >= 64 && F.tid < 64 + 128) { const i32x4 rec = tok[tb * 128 + (F.tid - 64)]; el[2 * (F.tid - 64)] = rec.x & 255; el[2 * (F.tid - 64) + 1] = (rec.x >> 8) & 255; }
        __syncthreads();
        if (F.tid == 0) { int acc = 0; for (int e = 0; e < 32; ++e) { const int sz = seg[e]; seg[e] = acc; acc += sz; } seg[32] = acc; }
        __syncthreads();
        if (F.tid < 32) { int p = seg[F.tid] + base[F.tid];
            for (int q = 0; q < 256; ++q) if (el[q] == F.tid) pos[q] = p++; }
        if (tb == 0 && F.tid >= 64 && F.tid < 64 + 32) { const int e = F.tid - 64;
            for (int t2 = seg[e] >> 8; t2 < (seg[e + 1] >> 8); ++t2) tile[t2] = e;
            if (e == 0) tile[MAXT] = seg[32] >> 8; }
        __syncthreads();
        if (F.tid < 128) { i32x4 rec = tok[tb * 128 + F.tid]; rec.x = pos[2 * F.tid]; rec.y = pos[2 * F.tid + 1]; tok[tb * 128 + F.tid] = rec; }
        for (int q = F.wave; q < 256; q += NWAVES) { const int n = tb * 128 + (q >> 1);
            const u32x4* src = (const u32x4*)(H2 + (size_t)n * D) + F.lane; u32x4* dst = (u32x4*)(HS + (size_t)pos[q] * D) + F.lane;
            dst[0] = src[0]; dst[64] = src[64]; }
        __syncthreads();
    }
}

DI void p14_final(const Frame& F0, ARef A, const bf16* YE) {
    Frame F = F0; F.tid = opq_tid(F0.wave); F.lane = F.tid & 63; F.wave = __builtin_amdgcn_readfirstlane(F.tid >> 6); F.gw = F.wg * NWAVES + F.wave;
    const int lane = F.lane;
    const float* mod = (const float*)(A.ws + WS_MOD); const i32x4* tok = (const i32x4*)(A.ws + WS_TOK);
    for (int n = F.gw; n < NTOK; n += F.NGW) {
        const int b = n >> 13; const i32x4 rec = tok[n];
        const float c0 = ((const float*)(A.ws + WS_CW))[2 * n], c1 = ((const float*)(A.ws + WS_CW))[2 * n + 1];
        const u32x2* y0 = (const u32x2*)(YE + (size_t)rec.x * D) + lane; const u32x2* y1 = (const u32x2*)(YE + (size_t)rec.y * D) + lane;
        f32x4 yv[4]; float s = 0.f;
#pragma unroll
        for (int j = 0; j < 4; ++j) { const u32x2 a = y0[64 * j], bq = y1[64 * j];
            yv[j][0] = c0 * bflo(a.x) + c1 * bflo(bq.x); yv[j][1] = c0 * bfhi(a.x) + c1 * bfhi(bq.x); yv[j][2] = c0 * bflo(a.y) + c1 * bflo(bq.y); yv[j][3] = c0 * bfhi(a.y) + c1 * bfhi(bq.y);
            s += (yv[j][0] * yv[j][0] + yv[j][1] * yv[j][1]) + (yv[j][2] * yv[j][2] + yv[j][3] * yv[j][3]); }
        const float inv = rsqrtf(wave_sum(s) * (1.0f / D) + NORM_EPS);
#pragma unroll
        for (int j = 0; j < 4; ++j) { const int k = 4 * lane + 256 * j;
            const f32x4 g3 = *(const f32x4*)(A.gains + 3 * D + k), gt = *(const f32x4*)(mod + b * 6144 + 5 * D + k);
            const u32x2 xw = *((const u32x2*)(A.ws + WS_X1 + (size_t)n * D * 2) + lane + 64 * j); f32x4 xv = {bflo(xw.x), bfhi(xw.x), bflo(xw.y), bfhi(xw.y)};
#pragma unroll
            for (int q = 0; q < 4; ++q) xv[q] = xv[q] + gt[q] * ((yv[j][q] * inv) * g3[q]);
            *((f32x4*)(A.out + (size_t)n * D) + lane + 64 * j) = xv; }
    }
}

DI bf16x8 pk_tile(const f32x16& x, const int s) { return pack8v(x[8 * s], x[8 * s + 1], x[8 * s + 2], x[8 * s + 3], x[8 * s + 4], x[8 * s + 5], x[8 * s + 6], x[8 * s + 7]); }
constexpr int FS = 72;
DI bf16x8 rd_frag(const LAS bf16* buf, int tb, int cb, int s, int r, int hh) {
    const LAS bf16* p = buf + (32 * cb + r) * FS + 32 * tb + 16 * s + 4 * hh;
    const s16x4 lo = *(const LAS s16x4*)p, hi = *(const LAS s16x4*)(p + 8); bf16x8 f;
#pragma unroll
    for (int e = 0; e < 4; ++e) { f[e] = lo[e]; f[4 + e] = hi[e]; }
    return f; }
DI void wr_tile_ft(LAS bf16* buf, const f32x16& x, int tb, int cb, int r, int hh) {
#pragma unroll
    for (int g = 0; g < 4; ++g) { u32x2 w; w.x = pk2(x[4 * g], x[4 * g + 1]); w.y = pk2(x[4 * g + 2], x[4 * g + 3]); *(LAS u32x2*)(buf + (32 * cb + r) * FS + 32 * tb + 8 * g + 4 * hh) = w; } }
DI void wr_l_ft(LAS bf16* buf, const float (&x)[64], int lane) {
#pragma unroll
    for (int t8 = 0; t8 < 8; ++t8) { u32x4 w; w.x = pk2(x[8 * t8], x[8 * t8 + 1]); w.y = pk2(x[8 * t8 + 2], x[8 * t8 + 3]); w.z = pk2(x[8 * t8 + 4], x[8 * t8 + 5]); w.w = pk2(x[8 * t8 + 6], x[8 * t8 + 7]);
        *(LAS u32x4*)(buf + lane * FS + 8 * t8) = w; } }

#if defined(STAMPS)
#define P5STAMP(k) do { p5ts[k] = __builtin_amdgcn_s_memrealtime(); } while (0)
#else
#define P5STAMP(k) do { } while (0)
#endif
DI void p5_mfma(unsigned char* F0_ws, const Frame& F0, const bf16* R, const bf16* KP, const bf16* V, const bf16* KK, const bf16* Bv, const bf16* Ev, bf16* P, bf16* QO, bf16* GT, bf16* HT) {
    Frame F = F0; F.tid = opq_tid(F0.wave); F.lane = F.tid & 63; F.wave = __builtin_amdgcn_readfirstlane(F.tid >> 6); F.gw = F.wg * NWAVES + F.wave;
    const int lane = F.lane, r = lane & 31, hh = lane >> 5;
    LAS unsigned char* wl = F.lds + F.wave * 20480;
    LAS bf16* buf0 = (LAS bf16*)wl; LAS bf16* buf1 = (LAS bf16*)(wl + 9216);
    LAS float* LT = (LAS float*)wl;
    LAS float* LC = (LAS float*)(wl + 18432);
    for (int cid = F.gw; cid < NCHUNK; cid += F.NGW) {
        const int bh = cid >> NCH_LOG, c = cid & (NCH - 1), b = bh >> 3, h = bh & 7;
        const unsigned n0 = (unsigned)b * SEQ + (unsigned)c * CH, col0 = (unsigned)h * HD;
        int ln = lane; asm volatile("" : "+v"(ln));
#if defined(STAMPS)
        unsigned long long p5ts[10];
#endif
        const int rm = ln & 31, hm = ln >> 5;
        const bf16 *R0_ = R, *KP0_ = KP, *V0_ = V, *KK0_ = KK, *Bv0_ = Bv, *Ev0_ = Ev; bf16 *P0_ = P, *QO0_ = QO;
        asm volatile("" : "+s"(R0_), "+s"(KP0_), "+s"(V0_), "+s"(KK0_), "+s"(Bv0_), "+s"(Ev0_), "+s"(P0_), "+s"(QO0_));
        const GAS char *R_ = (const GAS char*)R0_, *KP_ = (const GAS char*)KP0_, *V_ = (const GAS char*)V0_, *KK_ = (const GAS char*)KK0_, *Bv_ = (const GAS char*)Bv0_, *Ev_ = (const GAS char*)Ev0_;
        GAS char *P_ = (GAS char*)P0_, *QO_ = (GAS char*)QO0_;
        const unsigned nb0 = n0 * BW + col0;
        const unsigned vL = (nb0 + (unsigned)ln) * 2u, vT = (nb0 + (unsigned)rm * BW + 4u * hm) * 2u, vC = (nb0 + 4u * hm * BW + (unsigned)rm) * 2u, vG = (4u * hm * 64 + (unsigned)rm) * 2u;
#define OADD(v, c) ({ unsigned o_; asm volatile("v_add_u32_e32 %0, %1, %2" : "=v"(o_) : "n"((int)(c)), "v"(v)); o_; })
#define LD16(arr, off) (*(const GAS bf16*)((arr) + (off)))
#define XL(arr, t) LD16(arr, OADD(vL, (t) * BW * 2))
#define ROWQ(q) (((q) & 3) + 8 * ((q) >> 2))
        P5STAMP(0);
        u32x2 raw[2][5][4];
#define LOAD_TILE(BUF, FB, TB) do { _Pragma("unroll") for (int g = 0; g < 4; ++g) { const unsigned ot_ = OADD(vT, (32 * (TB) * BW + 32 * (FB) + 8 * g) * 2); \
            raw[BUF][0][g] = *(const GAS u32x2*)(Ev_ + ot_); raw[BUF][1][g] = *(const GAS u32x2*)(KK_ + ot_); raw[BUF][2][g] = *(const GAS u32x2*)(R_ + ot_); \
            raw[BUF][3][g] = *(const GAS u32x2*)(Bv_ + ot_); raw[BUF][4][g] = *(const GAS u32x2*)(KP_ + ot_); } } while (0)
        LOAD_TILE(0, 0, 0);
        {   float run = 0.f;
#pragma unroll
            for (int t = 0; t < 64; ++t) { run -= bf2f(XL(Ev_, t)); LT[ln * 65 + t] = run; } }
        wave_lds_fence();
        P5STAMP(1);
        bf16x8 Ap[2][2][2], Rp[2][2][2], Bp[2][2][2], Kp[2][2][2];
#pragma unroll
        for (int ti = 0; ti < 4; ++ti) { const int fb = ti >> 1, tb = ti & 1;
            if (ti < 3) LOAD_TILE((ti + 1) & 1, (ti + 1) >> 1, (ti + 1) & 1);
#pragma unroll
            for (int s = 0; s < 2; ++s) {
                float a8[8], r8[8], b8[8], k8[8];
#pragma unroll
                for (int g2 = 0; g2 < 2; ++g2) { const int g = 2 * s + g2;
                    const u32x2 ew = raw[ti & 1][0][g], aw = raw[ti & 1][1][g], rw = raw[ti & 1][2][g], bw = raw[ti & 1][3][g], kw = raw[ti & 1][4][g];
                    const float e4[4] = {bflo(ew.x), bfhi(ew.x), bflo(ew.y), bfhi(ew.y)}, av[4] = {bflo(aw.x), bfhi(aw.x), bflo(aw.y), bfhi(aw.y)}, rv[4] = {bflo(rw.x), bfhi(rw.x), bflo(rw.y), bfhi(rw.y)},
                                bv[4] = {bflo(bw.x), bfhi(bw.x), bflo(bw.y), bfhi(bw.y)}, kv[4] = {bflo(kw.x), bfhi(kw.x), bflo(kw.y), bfhi(kw.y)};
#pragma unroll
                    for (int j = 0; j < 4; ++j) { const float l = LT[(32 * fb + 8 * g + 4 * hm + j) * 65 + 32 * tb + rm];
                        const float eI = fexp(l), eX = fexp(l + e4[j]), eN = frcp(eI);
                        a8[4 * g2 + j] = -av[j] * eX; r8[4 * g2 + j] = rv[j] * eI; b8[4 * g2 + j] = bv[j] * eN; k8[4 * g2 + j] = kv[j] * eN; } }
                Ap[fb][tb][s] = __builtin_bit_cast(bf16x8, pack8(a8)); Rp[fb][tb][s] = __builtin_bit_cast(bf16x8, pack8(r8));
                Bp[fb][tb][s] = __builtin_bit_cast(bf16x8, pack8(b8)); Kp[fb][tb][s] = __builtin_bit_cast(bf16x8, pack8(k8)); }
            __builtin_amdgcn_sched_barrier(0); }
#undef LOAD_TILE
        wave_lds_fence();
        P5STAMP(2);
        bf16x8 Makp[2][2][2], Mbrp[2][2][2], Mkrp[2][2][2];
#define GRAM(XP, YP, STRICT, BODY) _Pragma("unroll") for (int ib = 0; ib < 2; ++ib) _Pragma("unroll") for (int tb = 0; tb < 2; ++tb) { f32x16 m_; \
            _Pragma("unroll") for (int q = 0; q < 16; ++q) m_[q] = 0.f; \
            _Pragma("unroll") for (int fb = 0; fb < 2; ++fb) _Pragma("unroll") for (int s = 0; s < 2; ++s) m_ = MFMA32(XP[fb][ib][s], YP[fb][tb][s], m_); \
            int rm_ = rm; asm volatile("" : "+v"(rm_)); \
            _Pragma("unroll") for (int q = 0; q < 16; ++q) { const int i_ = 32 * ib + crow(q, hm), t_ = 32 * tb + rm_; m_[q] = ((STRICT) ? (i_ < t_) : (i_ <= t_)) ? m_[q] : 0.f; } \
            BODY __builtin_amdgcn_sched_barrier(0); }
        GRAM(Bp, Ap, true, { wr_tile_ft(buf0, m_, ib, tb, rm, hm); })
        GRAM(Kp, Ap, true, { Makp[ib][tb][0] = pk_tile(m_, 0); Makp[ib][tb][1] = pk_tile(m_, 1); })
        GRAM(Bp, Rp, false, { Mbrp[ib][tb][0] = pk_tile(m_, 0); Mbrp[ib][tb][1] = pk_tile(m_, 1); })
        GRAM(Kp, Rp, false, { Mkrp[ib][tb][0] = pk_tile(m_, 0); Mkrp[ib][tb][1] = pk_tile(m_, 1); })
#undef GRAM
        P5STAMP(3);
        {   bf16x8 Vp[2][2][2];
#pragma unroll
            for (int ib = 0; ib < 2; ++ib)
#pragma unroll
                for (int vb = 0; vb < 2; ++vb) { f32x16 v_;
#pragma unroll
                    for (int q = 0; q < 16; ++q) v_[q] = bf2f(LD16(V_, OADD(vC, ((32 * ib + ROWQ(q)) * BW + 32 * vb) * 2)));
                    Vp[ib][vb][0] = pk_tile(v_, 0); Vp[ib][vb][1] = pk_tile(v_, 1); }
#pragma unroll
            for (int tb = 0; tb < 2; ++tb)
#pragma unroll
                for (int vb = 0; vb < 2; ++vb) { f32x16 w_;
#pragma unroll
                    for (int q = 0; q < 16; ++q) w_[q] = 0.f;
#pragma unroll
                    for (int ib = 0; ib < 2; ++ib)
#pragma unroll
                        for (int s = 0; s < 2; ++s) w_ = MFMA32(Makp[ib][tb][s], Vp[ib][vb][s], w_);
                    wr_tile_ft(buf1, w_, tb, vb, rm, hm); __builtin_amdgcn_sched_barrier(0); } }
        wave_lds_fence();
        P5STAMP(4);
#define SOLVE_BLK(X, T8) _Pragma("unroll") for (int jt = 0; jt < 8; ++jt) { const int t = 8 * (T8) + jt; \
            _Pragma("unroll") for (int gi = 0; gi <= (T8); ++gi) if (8 * gi < t) { float m8[8]; unpack8(*(const LAS u32x4*)(buf0 + t * FS + 8 * gi), m8); \
                _Pragma("unroll") for (int j = 0; j < 8; ++j) { if (8 * gi + j < t) X[t] += X[8 * gi + j] * m8[j]; } } \
            if (jt & 1) __builtin_amdgcn_sched_barrier(0); }
#define SOLVE(X) SOLVE_BLK(X, 0) SOLVE_BLK(X, 1) SOLVE_BLK(X, 2) SOLVE_BLK(X, 3) SOLVE_BLK(X, 4) SOLVE_BLK(X, 5) SOLVE_BLK(X, 6) SOLVE_BLK(X, 7)
        float lC;
        {   float xw[64];
#pragma unroll
            for (int t8 = 0; t8 < 8; ++t8) { float w8[8]; unpack8(*(const LAS u32x4*)(buf1 + ln * FS + 8 * t8), w8);
#pragma unroll
                for (int j = 0; j < 8; ++j) xw[8 * t8 + j] = w8[j]; }
            SOLVE(xw)
            wr_l_ft(buf1, xw, ln); }
        __builtin_amdgcn_sched_barrier(0);
        P5STAMP(5);
        {   float xa[64];
            {   float run = 0.f;
#pragma unroll
                for (int t = 0; t < 64; ++t) { xa[t] = -bf2f(XL(KK_, t)) * fexp(run); run -= bf2f(XL(Ev_, t)); if ((t & 31) == 31) __builtin_amdgcn_sched_barrier(0); }
                lC = run; LC[ln] = fexp(lC); }
            SOLVE(xa)
            wave_lds_fence();
            wr_l_ft(buf0, xa, ln); }
#undef SOLVE
#undef SOLVE_BLK
        wave_lds_fence();
        P5STAMP(6);
        bf16x8 ATp[2][2][2], W1p[2][2][2];
#pragma unroll
        for (int ib = 0; ib < 2; ++ib)
#pragma unroll
            for (int kb = 0; kb < 2; ++kb)
#pragma unroll
                for (int s = 0; s < 2; ++s) { ATp[ib][kb][s] = rd_frag(buf0, ib, kb, s, rm, hm); W1p[ib][kb][s] = rd_frag(buf1, ib, kb, s, rm, hm); }
        wave_lds_fence();
        {   float run = 0.f;
#pragma unroll
            for (int t8 = 0; t8 < 8; ++t8) { float r8[8];
#pragma unroll
                for (int j = 0; j < 8; ++j) { const int t = 8 * t8 + j; run -= bf2f(XL(Ev_, t)); r8[j] = bf2f(XL(R_, t)) * fexp(run); }
                *(LAS u32x4*)(buf0 + ln * FS + 8 * t8) = pack8(r8); if (t8 & 3) { } else { } if ((t8 & 3) == 3) __builtin_amdgcn_sched_barrier(0); } }
        wave_lds_fence();
        GAS char* pn = (GAS char*)(P0_ + (size_t)cid * 4096); GAS char* qn = (GAS char*)(QO0_ + (size_t)cid * 4096);
#pragma unroll
        for (int jb = 0; jb < 2; ++jb)
#pragma unroll
            for (int tb = 0; tb < 2; ++tb) { f32x16 p_;
#pragma unroll
                for (int q = 0; q < 16; ++q) p_[q] = bf2f(buf0[(32 * jb + crow(q, hm)) * FS + 32 * tb + rm]);
#pragma unroll
                for (int ib = 0; ib < 2; ++ib)
#pragma unroll
                    for (int s = 0; s < 2; ++s) p_ = MFMA32(ATp[ib][jb][s], Mbrp[ib][tb][s], p_);
#pragma unroll
                for (int s = 0; s < 2; ++s) *(GAS bf16x8*)(pn + ((((jb * 2 + tb) * 2 + s) * 64) + ln) * 16) = pk_tile(p_, s);
                __builtin_amdgcn_sched_barrier(0); }
        bf16x8 Vp[2][2][2];
#pragma unroll
        for (int ib = 0; ib < 2; ++ib)
#pragma unroll
            for (int vb = 0; vb < 2; ++vb) { f32x16 v_;
#pragma unroll
                for (int q = 0; q < 16; ++q) v_[q] = bf2f(LD16(V_, OADD(vC, ((32 * ib + ROWQ(q)) * BW + 32 * vb) * 2)));
                Vp[ib][vb][0] = pk_tile(v_, 0); Vp[ib][vb][1] = pk_tile(v_, 1); }
        P5STAMP(7);
#pragma unroll
        for (int tb = 0; tb < 2; ++tb)
#pragma unroll
            for (int vb = 0; vb < 2; ++vb) { f32x16 y_;
#pragma unroll
                for (int q = 0; q < 16; ++q) y_[q] = 0.f;
#pragma unroll
                for (int ib = 0; ib < 2; ++ib)
#pragma unroll
                    for (int s = 0; s < 2; ++s) { y_ = MFMA32(Mbrp[ib][tb][s], W1p[ib][vb][s], y_); y_ = MFMA32(Mkrp[ib][tb][s], Vp[ib][vb][s], y_); }
#pragma unroll
                for (int g = 0; g < 4; ++g) { u32x2 w; w.x = pk2(y_[4 * g], y_[4 * g + 1]); w.y = pk2(y_[4 * g + 2], y_[4 * g + 3]); *(GAS u32x2*)(qn + ((((tb * 2 + vb) * 4 + g) * 64) + ln) * 8) = w; }
                __builtin_amdgcn_sched_barrier(0); }
        P5STAMP(8);
        wave_lds_fence();
        {   float run = 0.f;
#pragma unroll
            for (int t8 = 0; t8 < 8; ++t8) { float b8[8], k8[8];
#pragma unroll
                for (int j = 0; j < 8; ++j) { const int t = 8 * t8 + j; run -= bf2f(XL(Ev_, t)); const float sc = fexp(lC - run); b8[j] = bf2f(XL(Bv_, t)) * sc; k8[j] = bf2f(XL(KP_, t)) * sc; }
                *(LAS u32x4*)(buf0 + ln * FS + 8 * t8) = pack8(b8); *(LAS u32x4*)(buf1 + ln * FS + 8 * t8) = pack8(k8); if ((t8 & 3) == 3) __builtin_amdgcn_sched_barrier(0); } }
        wave_lds_fence();
        bf16x8 Bh[2][2][2];
#pragma unroll
        for (int tb = 0; tb < 2; ++tb)
#pragma unroll
            for (int kb = 0; kb < 2; ++kb)
#pragma unroll
                for (int s = 0; s < 2; ++s) Bh[tb][kb][s] = rd_frag(buf0, tb, kb, s, rm, hm);
        GAS char* gt = (GAS char*)(GT + (size_t)cid * 4096); GAS char* ht = (GAS char*)(HT + (size_t)cid * 4096);
#pragma unroll
        for (int kb = 0; kb < 2; ++kb)
#pragma unroll
            for (int jb = 0; jb < 2; ++jb) { f32x16 g_;
                const float dg = LC[32 * kb + rm];
#pragma unroll
                for (int q = 0; q < 16; ++q) g_[q] = (kb == jb && crow(q, hm) == rm) ? dg : 0.f;
#pragma unroll
                for (int tb = 0; tb < 2; ++tb)
#pragma unroll
                    for (int s = 0; s < 2; ++s) g_ = MFMA32(ATp[tb][jb][s], Bh[tb][kb][s], g_);
#pragma unroll
                for (int s = 0; s < 2; ++s) *(GAS bf16x8*)(gt + ((kb * 4 + jb * 2 + s) * 64 + ln) * 16) = pk_tile(g_, s);
                __builtin_amdgcn_sched_barrier(0); }
        {   bf16x8 Kh[2][2][2];
#pragma unroll
            for (int tb = 0; tb < 2; ++tb)
#pragma unroll
                for (int kb = 0; kb < 2; ++kb)
#pragma unroll
                    for (int s = 0; s < 2; ++s) Kh[tb][kb][s] = rd_frag(buf1, tb, kb, s, rm, hm);
#pragma unroll
            for (int kb = 0; kb < 2; ++kb)
#pragma unroll
                for (int vb = 0; vb < 2; ++vb) { f32x16 h_;
#pragma unroll
                    for (int q = 0; q < 16; ++q) h_[q] = 0.f;
#pragma unroll
                    for (int tb = 0; tb < 2; ++tb)
#pragma unroll
                        for (int s = 0; s < 2; ++s) { h_ = MFMA32(Bh[tb][kb][s], W1p[tb][vb][s], h_); h_ = MFMA32(Kh[tb][kb][s], Vp[tb][vb][s], h_); }
#pragma unroll
                    for (int g = 0; g < 4; ++g) { u32x2 w; w.x = pk2(h_[4 * g], h_[4 * g + 1]); w.y = pk2(h_[4 * g + 2], h_[4 * g + 3]); *(GAS u32x2*)(ht + ((((kb * 2 + vb) * 4 + g) * 64) + ln) * 8) = w; }
                    __builtin_amdgcn_sched_barrier(0); } }
        P5STAMP(9);
#if defined(STAMPS)
        if (F.gw == 0 && cid == 0 && lane == 0) { _Pragma("unroll") for (int k_ = 0; k_ < 10; ++k_) ((unsigned long long*)(F0_ws + WS_CTL + 49152))[32 + k_] = p5ts[k_]; }
#endif
        wave_lds_fence();
#undef XL
#undef OADD
#undef LD16
#undef ROWQ
    }
}

#if defined(CHECKS)
constexpr size_t WS_FLG = WS_CTL + 32768;
DI unsigned* chk_flags(unsigned char* ws) { return (unsigned*)(ws + WS_FLG); }
DI void chk(unsigned char* ws, int id, float got, float want, float rel, float ab) {
    const float d = fabsf(got - want), lim = rel * fmaxf(fabsf(got), fabsf(want)) + ab;
    if (!(d <= lim)) chk_flags(ws)[id] = 1u; }
DI unsigned hsh(unsigned a) { a ^= a >> 16; a *= 0x7feb352du; a ^= a >> 15; a *= 0x846ca68bu; a ^= a >> 16; return a; }
DI float bfr(float v) { return bflo(f2bf(v)); }
DI int scol_of(int n) { return n < 3360 ? n : (n < 3584 ? -1 : n - 224); }

DI void chk_p0(const Frame& F, ARef A) {
    unsigned char* ws = A.ws; const int lane = F.lane;
    const float* mod = (const float*)(ws + WS_MOD);
    for (int s = F.wave; s < 32; s += NWAVES) { const unsigned hh = hsh(1000 + s); const int b = hh & 3, o = (hh >> 2) % 6144; float a = 0.f;
        for (int k = lane; k < D; k += 64) { const float c = A.c[b * D + k]; a += (c / (1.0f + expf(-c))) * A.w_mod[(size_t)k * 6144 + o]; }
        a = wave_sum(a) + A.b_mod[o]; chk(ws, 10, mod[b * 6144 + o], a, 1e-3f, 1e-4f); }
    const bf16* wt = (const bf16*)(ws + WS_WIN);
    for (int s = 0; s < 8; ++s) { const unsigned hh = hsh(2000 + (F.wave * 8 + s) * 64 + lane); const int n = hh % NPAD, k = (hh >> 13) & 1023; const int sc = scol_of(n);
        const float want = sc >= 0 ? bfr(A.w_in[(size_t)k * IN_COLS + sc]) : 0.f; chk(ws, 11, bf2f(wt[(size_t)n * D + k]), want, 0.f, 0.f); }
    { const unsigned hh = hsh(3000 + F.wave * 64 + lane); const int n = hh & 1023, k = (hh >> 10) & 511, k2 = (hh >> 10) & 1023;
        chk(ws, 11, bf2f(((const bf16*)(ws + WS_WOSB))[n * BW + k]), bfr(A.w_o_sb[k * D + n]), 0.f, 0.f);
        chk(ws, 11, bf2f(((const bf16*)(ws + WS_WORW))[n * BW + k]), bfr(A.w_o_rw[k * D + n]), 0.f, 0.f);
        chk(ws, 11, bf2f(((const bf16*)(ws + WS_WOUT))[n * D + k2]), bfr(A.w_out[k2 * D + n]), 0.f, 0.f);
        const int o = hh % 36; chk(ws, 11, ((const float*)(ws + WS_RTW))[o * D + k2], o < 4 ? A.w_group[k2 * 4 + o] : A.w_router[k2 * NE + o - 4], 0.f, 0.f);
        const int nl = hh % 1536, kl = (hh >> 11) % LK; float v = 0.f;
        if (nl < 512) { if (kl < 64) v = A.w_decay_up[kl * BW + nl]; } else if (nl < 1024) { if (kl >= 64 && kl < 128) v = A.w_iclr_up[(kl - 64) * BW + nl - 512]; } else { if (kl >= 128 && kl < 288) v = A.w_gate_up[(kl - 128) * BW + nl - 1024]; }
        chk(ws, 11, bf2f(((const bf16*)(ws + WS_WL))[nl * LK + kl]), bfr(v), 0.f, 0.f); }
}
DI void chk_p1(const Frame& F, ARef A, const bf16* H1) {
    unsigned char* ws = A.ws; const int lane = F.lane; const float* mod = (const float*)(ws + WS_MOD);
    for (int s = F.wave; s < 16; s += NWAVES) { const int n = hsh(4000 + s) % NTOK, b = n >> 13; float ss = 0.f;
        for (int k = lane; k < D; k += 64) { const float v = A.x[(size_t)n * D + k]; ss += v * v; }
        const float inv = 1.0f / sqrtf(wave_sum(ss) / D + NORM_EPS);
        for (int k = lane; k < D; k += 64) { const float want = (A.x[(size_t)n * D + k] * inv) * A.gains[k] * (1.0f + mod[b * 6144 + D + k]) + mod[b * 6144 + k];
            chk(ws, 12, bf2f(H1[(size_t)n * D + k]), want, 0.01f, 0.01f); } }
}
DI float wdot(const bf16* arow, const float* W, int ldw, int col, int K, int lane) { float a = 0.f; for (int k = lane; k < K; k += 64) a += bf2f(arow[k]) * W[(size_t)k * ldw + col]; return wave_sum(a); }
DI void chk_p2(const Frame& F, ARef A, const bf16* H1) {
    unsigned char* ws = A.ws; const int lane = F.lane;
    for (int s = F.wave; s < 96; s += NWAVES) { const unsigned hh = hsh(5000 + s); const int n = hh % NTOK, region = s % 6; int col;
        const unsigned h2 = hsh(hh);
        float got, want; int id = 13 + region;
        if (region == 0) { col = h2 % 512; want = 0.125f * wdot(H1 + (size_t)n * D, A.w_in, IN_COLS, col, D, lane); got = bf2f(((const bf16*)(ws + WS_QB))[(size_t)n * BW + col]); }
        else if (region == 1) { col = h2 % 512; want = wdot(H1 + (size_t)n * D, A.w_in, IN_COLS, 512 + col, D, lane); got = bf2f(((const bf16*)(ws + WS_KB))[(size_t)n * BW + col]); }
        else if (region == 2) { col = h2 % 512; want = wdot(H1 + (size_t)n * D, A.w_in, IN_COLS, 1024 + col, D, lane); got = bf2f(((const bf16*)(ws + WS_VT))[((size_t)((n >> 13) * BW + col)) * SEQ + (n & (SEQ - 1))]); }
        else if (region == 3) { col = h2 % 1536; want = wdot(H1 + (size_t)n * D, A.w_in, IN_COLS, 1536 + col, D, lane); got = bf2f(((const bf16*)(ws + WS_RWRAW))[(size_t)n * 1536 + col]); }
        else if (region == 4) { col = h2 % 288; want = wdot(H1 + (size_t)n * D, A.w_in, IN_COLS, 3072 + col, D, lane); got = bf2f(((const bf16*)(ws + WS_LORA))[(size_t)n * BW + col]); }
        else { col = h2 % 2048; want = wdot(H1 + (size_t)n * D, A.w_in, IN_COLS, 3360 + col, D, lane) + A.gate_bias[col]; want = 1.0f / (1.0f + expf(-want)); got = bf2f(((const bf16*)(ws + WS_GATE))[(size_t)n * 2048 + col]); }
        chk(ws, id, got, want, 0.03f, 0.02f); }
}
constexpr int NATT = 16;
DI void att_sample(int s, int& b, int& h, int& t) { const unsigned hh = hsh(6000 + s); b = hh & 3; h = (hh >> 2) & 7; t = (s < 4) ? (s * 37) : (int)((hh >> 5) % SEQ); }
DI void chk_p3_save(const Frame& F, ARef A) {
    if (F.wave == 0) { bf16* sv = (bf16*)(A.ws + WS_FLG + 4096);
        for (int s = 0; s < NATT; ++s) { int b, h, t; att_sample(s, b, h, t); sv[s * 64 + F.lane] = ((const bf16*)(A.ws + WS_QB))[(size_t)(b * SEQ + t) * BW + h * HD + F.lane]; } }
}
DI void chk_p3(const Frame& F, ARef A, const bf16* R, const bf16* KS, const bf16* V, const bf16* KK) {
    unsigned char* ws = A.ws; const int lane = F.lane;
    const bf16* sv = (const bf16*)(ws + WS_FLG + 4096); const bf16* KB = (const bf16*)(ws + WS_KB); const bf16* VT = (const bf16*)(ws + WS_VT);
    for (int s = F.wave; s < NATT; s += NWAVES) { int b, h, t; att_sample(s, b, h, t);
        const float q = bf2f(sv[s * 64 + lane]); float later = 0.f, o = 0.f;
        for (int k = t - 1; k >= 0; --k) { const float z = wave_sum(q * bf2f(KB[(size_t)(b * SEQ + k) * BW + h * HD + lane]));
            const float sp = fmaxf(z, 0.f) + log1pf(expf(-fabsf(z)));
            o += expf(z - sp + later) * bf2f(VT[((size_t)((b * NH + h) * HD + lane)) * SEQ + k]);
            later -= sp; if (later < -200.f) break; }
        chk(ws, 19, bf2f(((const bf16*)(ws + WS_QB))[(size_t)(b * SEQ + t) * BW + h * HD + lane]), o, 0.04f, 0.02f); }
    const bf16* RW = (const bf16*)(ws + WS_RWRAW); const bf16* LO = (const bf16*)(ws + WS_LORA); const bf16* AL = (const bf16*)(ws + WS_ALORA);
    for (int s = F.wave; s < 32; s += NWAVES) { const unsigned hh = hsh(7000 + s); const int n = (s < 4) ? s * SEQ : (int)(hh % NTOK), hd = (hh >> 16) & 7; const bool first = (n & (SEQ - 1)) == 0;
        float xs[3];
        for (int p = 0; p < 3; ++p) { const int col = p * 512 + hd * 64 + lane; const float cur = bf2f(RW[(size_t)n * 1536 + col]), prv = first ? 0.f : bf2f(RW[(size_t)(n - 1) * 1536 + col]); xs[p] = cur + A.shift_mu[col] * (prv - cur); }
        const size_t o = (size_t)n * BW + hd * 64 + lane;
        chk(ws, 20, bf2f(R[o]), xs[0], 0.01f, 0.005f); chk(ws, 20, bf2f(KS[o]), xs[1], 0.01f, 0.005f); chk(ws, 20, bf2f(V[o]), xs[2], 0.01f, 0.005f);
        const float kk = xs[1] * A.k_k[hd * 64 + lane]; const float nn = sqrtf(wave_sum(kk * kk));
        chk(ws, 20, bf2f(KK[o]), kk / fmaxf(nn, L2_EPS), 0.01f, 0.002f);
        for (int c = lane; c < LK; c += 64) { float want = 0.f;
            if (c < 288) { const float cur = bf2f(LO[(size_t)n * BW + c]), prv = first ? 0.f : bf2f(LO[(size_t)(n - 1) * BW + c]); const float v = cur + A.shift_mu[1536 + c] * (prv - cur);
                want = c < 64 ? tanhf(v) : (c < 128 ? v : 1.0f / (1.0f + expf(-v))); }
            chk(ws, 20, bf2f(AL[(size_t)n * LK + c]), want, 0.01f, 0.005f); } }
}
DI void chk_p4_save(const Frame& F, ARef A, const bf16* KS) {
    if (F.wave == 0) { bf16* sv = (bf16*)(A.ws + WS_FLG + 8192);
        for (int s = 0; s < 16; ++s) { const unsigned hh = hsh(8000 + s); const int n = hh % NTOK, hd = (hh >> 16) & 7; sv[s * 64 + F.lane] = KS[(size_t)n * BW + hd * 64 + F.lane]; } }
}
DI void chk_p4(const Frame& F, ARef A, const bf16* KP, const bf16* KK) {
    unsigned char* ws = A.ws; const int lane = F.lane; const bf16* AL = (const bf16*)(ws + WS_ALORA); const bf16* sv = (const bf16*)(ws + WS_FLG + 8192);
    for (int s = F.wave; s < 16; s += NWAVES) { const unsigned hh = hsh(8000 + s); const int n = hh % NTOK, hd = (hh >> 16) & 7, c = hd * 64 + lane; const size_t o = (size_t)n * BW + c;
        float lw = 0.f, la = 0.f, lg = 0.f;
        for (int k = 0; k < 64; ++k) { lw += bf2f(AL[(size_t)n * LK + k]) * A.w_decay_up[k * BW + c]; la += bf2f(AL[(size_t)n * LK + 64 + k]) * A.w_iclr_up[k * BW + c]; }
        for (int k = 0; k < 160; ++k) lg += bf2f(AL[(size_t)n * LK + 128 + k]) * A.w_gate_up[k * BW + c];
        const float x = -(A.w0[c] + lw), w = -(fmaxf(x, 0.f) + log1pf(expf(-fabsf(x)))) - 0.5f;
        chk(ws, 21, bf2f(((const bf16*)(ws + WS_E))[o]), expf(w), 0.03f, 0.003f);
        const float a = 1.0f / (1.0f + expf(-(A.a0[c] + la))); const float ks = bf2f(sv[s * 64 + lane]);
        chk(ws, 22, bf2f(KP[o]), ks * (1.0f + (a - 1.0f) * A.k_a[c]), 0.03f, 0.01f);
        chk(ws, 22, bf2f(((const bf16*)(ws + WS_B))[o]), bf2f(KK[o]) * a, 0.03f, 0.003f);
        chk(ws, 23, bf2f(((const bf16*)(ws + WS_GG))[o]), lg, 0.03f, 0.01f); }
}
constexpr int NST = 300;
DI void chk_p7_save(const Frame& F, ARef A) {
    if (F.wave < 4) { const int b = (F.wave * 3) & 3, h = (F.wave * 5 + 1) & 7; bf16* sv = (bf16*)(A.ws + 256 * 1024) + F.wave * NST * 64;
        for (int t = 0; t < NST; ++t) sv[t * 64 + F.lane] = ((const bf16*)(A.ws + WS_E))[(size_t)(b * SEQ + t) * BW + h * HD + F.lane]; }
}
DI void chk_p7(const Frame& F, ARef A, const bf16* R, const bf16* KP, const bf16* V, const bf16* KK) {
    unsigned char* ws = A.ws; const int lane = F.lane;
    const bf16* Bv = (const bf16*)(ws + WS_B); const bf16* Esv = (const bf16*)(ws + 256 * 1024) + F.wave * NST * 64; const bf16* GG = (const bf16*)(ws + WS_GG); const bf16* YRW = (const bf16*)(ws + WS_YRW);
    if (F.wave < 4) { const int b = (F.wave * 3) & 3, h = (F.wave * 5 + 1) & 7, col0 = h * HD;
        float S[64];
#pragma unroll
        for (int k = 0; k < 64; ++k) S[k] = 0.f;
        for (int t = 0; t < NST; ++t) { const size_t o = (size_t)(b * SEQ + t) * BW + col0 + lane;
            const float av = -bf2f(KK[o]), bv = bf2f(Bv[o]), dv = expf(-bf2f(Esv[t * 64 + lane])), kv = bf2f(KP[o]), rv = bf2f(R[o]), vv = bf2f(V[o]);
            float sa = 0.f;
#pragma unroll
            for (int k = 0; k < 64; ++k) sa += S[k] * __shfl(av, k);
            float y = 0.f;
#pragma unroll
            for (int k = 0; k < 64; ++k) { S[k] = S[k] * __shfl(dv, k) + sa * __shfl(bv, k) + vv * __shfl(kv, k); y += S[k] * __shfl(rv, k); }
            const float mean = wave_sum(y) / 64.f, d = y - mean, var = wave_sum(d * d) / 64.f;
            const float yn = d / sqrtf(var + GN_EPS) * A.lnx_w[col0 + lane] + A.lnx_b[col0 + lane];
            const float bonus = wave_sum(rv * kv * A.r_k[col0 + lane]) * vv;
            const float want = (yn + bonus) * bf2f(GG[o]);
            chk(ws, t < 128 ? 24 : 25, bf2f(YRW[o]), want, 0.05f, 0.03f); } }
}
DI void chk_p8(const Frame& F, ARef A) {
    unsigned char* ws = A.ws; const int lane = F.lane;
    for (int s = F.wave; s < 32; s += NWAVES) { const unsigned hh = hsh(9000 + s); const int n = hh % NTOK, c = (hh >> 15) & 1023;
        const float p1 = wdot((const bf16*)(ws + WS_QB) + (size_t)n * BW, A.w_o_sb, D, c, BW, lane), p2 = wdot((const bf16*)(ws + WS_YRW) + (size_t)n * BW, A.w_o_rw, D, c, BW, lane);
        const bf16* ga = (const bf16*)(ws + WS_GATE) + (size_t)n * 2048;
        chk(ws, 26, bf2f(((const bf16*)(ws + WS_MRG))[(size_t)n * D + c]), bf2f(ga[c]) * p1 + bf2f(ga[1024 + c]) * p2, 0.03f, 0.01f); }
}
DI void chk_p9(const Frame& F, ARef A) {
    unsigned char* ws = A.ws; const int lane = F.lane;
    for (int s = F.wave; s < 32; s += NWAVES) { const unsigned hh = hsh(9500 + s); const int n = hh % NTOK, c = (hh >> 15) & 1023;
        chk(ws, 27, bf2f(((const bf16*)(ws + WS_Y1))[(size_t)n * D + c]), wdot((const bf16*)(ws + WS_MRG) + (size_t)n * D, A.w_out, D, c, D, lane), 0.03f, 0.01f); }
}
DI void chk_p10(const Frame& F, ARef A) {
    unsigned char* ws = A.ws; const int lane = F.lane; const float* mod = (const float*)(ws + WS_MOD);
    const bf16* Y1 = (const bf16*)(ws + WS_Y1); const bf16* H2 = (const bf16*)(ws + WS_H2); const i32x4* tok = (const i32x4*)(ws + WS_TOK);
    for (int s = F.wave; s < 32; s += NWAVES) { const int n = s == 0 ? DBG_TOKEN : (s < 16 ? (int)(hsh(10000 + s) % 128) : (int)(hsh(10000 + s) % NTOK)), b = n >> 13; float ss = 0.f;
        for (int k = lane; k < D; k += 64) { const float v = bf2f(Y1[(size_t)n * D + k]); ss += v * v; }
        const float inv1 = 1.0f / sqrtf(wave_sum(ss) / D + NORM_EPS); float s2 = 0.f;
        for (int k = lane; k < D; k += 64) { const float x1 = A.x[(size_t)n * D + k] + mod[b * 6144 + 2 * D + k] * ((bf2f(Y1[(size_t)n * D + k]) * inv1) * A.gains[D + k]);
            chk(ws, 28, A.out[(size_t)n * D + k], x1, 1e-3f, 1e-3f); s2 += x1 * x1; }
        const float inv2 = 1.0f / sqrtf(wave_sum(s2) / D + NORM_EPS);
        float lg[36];
#pragma unroll
        for (int o = 0; o < 36; ++o) lg[o] = 0.f;
        for (int k = lane; k < D; k += 64) { const float h2 = (A.out[(size_t)n * D + k] * inv2) * A.gains[2 * D + k] * (1.0f + mod[b * 6144 + 4 * D + k]) + mod[b * 6144 + 3 * D + k];
            chk(ws, 29, bf2f(H2[(size_t)n * D + k]), h2, 0.01f, 0.01f);
#pragma unroll
            for (int o = 0; o < 36; ++o) lg[o] += h2 * (o < 4 ? A.w_group[k * 4 + o] : A.w_router[k * NE + o - 4]); }
#pragma unroll
        for (int o = 0; o < 36; ++o) lg[o] = wave_sum(lg[o]);
        int gs = 0; float gm = lg[0];
#pragma unroll
        for (int g = 1; g < 4; ++g) if (lg[g] > gm) { gm = lg[g]; gs = g; }
        float gsum = 0.f;
#pragma unroll
        for (int g = 0; g < 4; ++g) gsum += expf(lg[g] - gm);
        float el[8];
#pragma unroll
        for (int e = 0; e < 8; ++e) el[e] = gs == 0 ? lg[4 + e] : (gs == 1 ? lg[12 + e] : (gs == 2 ? lg[20 + e] : lg[28 + e]));
        int i0 = 0; float m0 = el[0];
#pragma unroll
        for (int e = 1; e < 8; ++e) if (el[e] > m0) { m0 = el[e]; i0 = e; }
        int i1 = -1; float m1 = -3.0e38f;
#pragma unroll
        for (int e = 0; e < 8; ++e) if (e != i0 && el[e] > m1) { m1 = el[e]; i1 = e; }
        const float tt = expf(m1 - m0), p0 = 1.0f / (1.0f + tt);
        const i32x4 rec = tok[n];
        if (lane == 0 && s < 16) { if ((rec.x & 255) != gs * 8 + i0 || ((rec.x >> 8) & 255) != gs * 8 + i1) chk_flags(ws)[30] = 1u;
            if (n == DBG_TOKEN) { const float* dbg = (const float*)chk_flags(ws) + 48; float code = 1.f;
                if (dbg[4] > 4.001f) code += 2.f; if (dbg[5] < 0.499f) code += 4.f;
                if (fabsf(dbg[0] - lg[0]) > 1e-3f || fabsf(dbg[1] - lg[1]) > 1e-3f || fabsf(dbg[2] - lg[2]) > 1e-3f || fabsf(dbg[3] - lg[3]) > 1e-3f) code += 8.f;
                if (fabsf(dbg[4] - gsum) > 1e-3f) code += 16.f; if (fabsf(dbg[6] * dbg[5] - __builtin_bit_cast(float, rec.z)) > 1e-4f) code += 32.f;
                ((float*)chk_flags(ws))[62] = code * 0.1f; ((float*)chk_flags(ws))[63] = dbg[4]; }
            chk(ws, 56, ((const float*)(ws + WS_CW))[2 * n], p0 / gsum, 3e-2f, 1e-4f); chk(ws, 57, ((const float*)(ws + WS_CW))[2 * n + 1], tt * p0 / gsum, 3e-2f, 1e-4f);
            chk(ws, 58, ((const float*)(ws + WS_CW))[2 * n], p0 / gsum, 1e-3f, 1e-5f); chk(ws, 59, ((const float*)(ws + WS_CW))[2 * n + 1], tt * p0 / gsum, 1e-3f, 1e-5f); } }
}
DI void chk_p11(const Frame& F, ARef A) {
    unsigned char* ws = A.ws; const int lane = F.lane; const i32x4* tok = (const i32x4*)(ws + WS_TOK); const int* tile = (const int*)(ws + WS_TILE);
    const bf16* H2 = (const bf16*)(ws + WS_H2); const bf16* HS = (const bf16*)(ws + WS_HS);
    for (int s = F.wave; s < 64; s += NWAVES) { const int n = hsh(11000 + s) % NTOK; const i32x4 rec = tok[n];
        if (rec.x < 0 || rec.x >= tile[MAXT] * 256 || rec.y < 0 || rec.y >= tile[MAXT] * 256 || tile[MAXT] > MAXT || tile[MAXT] < 256) { chk_flags(ws)[32] = 1u; continue; }
        for (int k = lane; k < D; k += 64) { chk(ws, 33, bf2f(HS[(size_t)rec.x * D + k]), bf2f(H2[(size_t)n * D + k]), 0.f, 0.f); chk(ws, 33, bf2f(HS[(size_t)rec.y * D + k]), bf2f(H2[(size_t)n * D + k]), 0.f, 0.f); } }
    { const unsigned hh = hsh(12000 + F.wave * 64 + lane); const int e = hh & 31, n = (hh >> 5) & 1023, k = (hh >> 15) & 1023, k5 = k & 511;
        const int c = (n >> 3) * 4 + (n & 3); const float want = (n & 4) ? A.w_up3[((size_t)e * D + k) * DE + c] : A.w_up1[((size_t)e * D + k) * DE + c];
        chk(ws, 34, bf2f(((const bf16*)(ws + WS_WUP))[((size_t)e * 1024 + n) * D + k]), bfr(want), 0.f, 0.f);
        chk(ws, 35, bf2f(((const bf16*)(ws + WS_WDN))[((size_t)e * 1024 + n) * DE + k5]), bfr(A.w_down[((size_t)e * DE + k5) * D + n]), 0.f, 0.f); }
}
DI void chk_p12(const Frame& F, ARef A) {
    unsigned char* ws = A.ws; const int lane = F.lane; const i32x4* tok = (const i32x4*)(ws + WS_TOK); const int* tile = (const int*)(ws + WS_TILE);
    const bf16* H2 = (const bf16*)(ws + WS_H2); const bf16* HID = (const bf16*)(ws + WS_HID);
    for (int s = F.wave; s < 32; s += NWAVES) { const unsigned hh = hsh(13000 + s); const int n = hh % NTOK, c = (hh >> 16) & 511; const i32x4 rec = tok[n]; const int pos = (s & 1) ? rec.y : rec.x;
        const int e = tile[pos >> 8];
        const float u1 = wdot(H2 + (size_t)n * D, A.w_up1 + (size_t)e * D * DE, DE, c, D, lane), u3 = wdot(H2 + (size_t)n * D, A.w_up3 + (size_t)e * D * DE, DE, c, D, lane);
        chk(ws, 36, bf2f(HID[(size_t)pos * DE + c]), u1 / (1.0f + expf(-u1)) * u3, 0.04f, 0.01f); }
}
DI void chk_p13(const Frame& F, ARef A) {
    unsigned char* ws = A.ws; const int lane = F.lane; const i32x4* tok = (const i32x4*)(ws + WS_TOK); const int* tile = (const int*)(ws + WS_TILE);
    const bf16* HID = (const bf16*)(ws + WS_HID); const bf16* YE = (const bf16*)(ws + WS_HS);
    for (int s = F.wave; s < 32; s += NWAVES) { const unsigned hh = hsh(14000 + s); const int n = hh % NTOK, c = (hh >> 16) & 1023; const i32x4 rec = tok[n]; const int pos = (s & 1) ? rec.y : rec.x;
        const int e = tile[pos >> 8];
        chk(ws, 37, bf2f(YE[(size_t)pos * D + c]), wdot(HID + (size_t)pos * DE, A.w_down + (size_t)e * DE * D, D, c, DE, lane), 0.04f, 0.01f); }
}
#endif

__global__ void __launch_bounds__(NTHR, 2) hybrid_fwd(Args A_unused) {
    extern __shared__ __attribute__((aligned(16))) unsigned char lds_raw[];
    const CAS Args& A = *(const CAS Args*)__builtin_amdgcn_kernarg_segment_ptr();
    Frame F;
    F.lds = (LAS unsigned char*)lds_raw;
    F.wave = __builtin_amdgcn_readfirstlane((int)threadIdx.x >> 6); F.tid = opq_tid(F.wave); F.lane = F.tid & 63;
    F.wg = blockIdx.x; F.G = gridDim.x; F.gw = F.wg * NWAVES + F.wave; F.NGW = F.G * NWAVES;
    volatile LAS unsigned* MISC = (volatile LAS unsigned*)(F.lds + LDS_MISC);
    if (F.wave == 0) MISC[F.lane] = 0u;
    __syncthreads();
    const XcdBarrier bar = xcd_barrier_post((unsigned*)(A.ws + WS_CTL), MISC + 8, F.wave);
    unsigned char* ws = A.ws;
    LAS unsigned char* stage = F.lds;
    bf16* const dob = (bf16*)A.out;
    bf16 *H1 = dob, *R = dob, *KS = dob + (size_t)NTOK * BW, *V = dob + 2 * (size_t)NTOK * BW, *KK = dob + 3 * (size_t)NTOK * BW;

#if defined(STAMPS)
    unsigned long long* const tsp = (unsigned long long*)(ws + WS_CTL + 49152);
#define STAMP(k) do { if (F.wg == 0 && xb_t0(F.wave)) tsp[k] = wall_clock64(); } while (0)
#else
#define STAMP(k) do { } while (0)
#endif
#if defined(REPEAT_PHASE)
#ifndef REPEAT_COUNT
#define REPEAT_COUNT 2
#endif
#define REP(k) _Pragma("nounroll") for (int rep_ = 0; rep_ < ((k) == REPEAT_PHASE ? REPEAT_COUNT : 1); ++rep_)
#else
#define REP(k)
#endif
    STAMP(0);
    REP(0) {
    p0_prologue(F, A);
    xcd_barrier(bar);
    }
    STAMP(1);
#if defined(CHECKS)
    if (F.wg == 0) chk_p0(F, A);
#endif
    REP(1) {
    p1_h1(F, A, H1);
    xcd_barrier(bar);
    }
    STAMP(2);
#if defined(CHECKS)
    if (F.wg == 0) chk_p1(F, A, H1);
#endif
    REP(2) {
    {   pg8::Gemm g{H1, (const bf16*)(ws + WS_WIN), NTOK, NPAD, D}; pg8::StaticOrder S; S.init(NTOK, NPAD, F.G, F.wg);
        EpiIn E{(bf16*)(ws + WS_QB), (bf16*)(ws + WS_KB), (bf16*)(ws + WS_VT), (bf16*)(ws + WS_RWRAW), (bf16*)(ws + WS_LORA), (bf16*)(ws + WS_GATE), A.gate_bias};
        pg8::gemm_phase<EpiIn, pg8::StaticOrder>(stage, g, S, E, nullptr, F.wave); }
    xcd_barrier(bar);
    }
    STAMP(3);
#if defined(CHECKS)
    if (F.wg == 0) { chk_p2(F, A, H1); chk_p3_save(F, A); }
    xcd_barrier(bar);
#endif
#if !defined(CHECKS)
    const bool fuse34 = (F.G == 256);
#else
    const bool fuse34 = false;
#endif
    REP(3) {
    p3_attn(F, (const bf16*)(ws + WS_QB), (const bf16*)(ws + WS_KB), (const bf16*)(ws + WS_VT), (bf16*)(ws + WS_QB));
#if defined(STAMPS)
    STAMP(20);
#endif
    p3_prep(F, A, (const bf16*)(ws + WS_RWRAW), (const bf16*)(ws + WS_LORA), R, KS, V, KK, (bf16*)(ws + WS_ALORA));
#if !defined(CHECKS)
    if (fuse34) { asm volatile("s_waitcnt vmcnt(0)" ::: "memory"); __syncthreads();
        p4_lora(F, A, (const bf16*)(ws + WS_ALORA), (const bf16*)(ws + WS_WL), (bf16*)(ws + WS_E), KS, (bf16*)(ws + WS_B), (bf16*)(ws + WS_GG), KK, R, (float*)(ws + WS_BON)); }
#endif
    xcd_barrier(bar);
    }
#if defined(STAMPS)
    STAMP(21);
#endif
    STAMP(4);
#if defined(CHECKS)
    if (F.wg == 0) { chk_p3(F, A, R, KS, V, KK); chk_p4_save(F, A, KS); }
    xcd_barrier(bar);
#endif
    if (!fuse34) {
    p4_lora(F, A, (const bf16*)(ws + WS_ALORA), (const bf16*)(ws + WS_WL), (bf16*)(ws + WS_E), KS, (bf16*)(ws + WS_B), (bf16*)(ws + WS_GG), KK, R, (float*)(ws + WS_BON));
    xcd_barrier(bar);
    }
    STAMP(5);
#if defined(CHECKS)
    if (F.wg == 0) chk_p4(F, A, KS, KK);
#endif
    REP(5) {
    p5_mfma(ws, F, R, KS, V, KK, (const bf16*)(ws + WS_B), (const bf16*)(ws + WS_E), (bf16*)(ws + WS_P), (bf16*)(ws + WS_QO), (bf16*)(ws + WS_GT), (bf16*)(ws + WS_HT));
    p6_moe_weights(F, A, F.gw, F.NGW);
    xcd_barrier(bar);
    }
    STAMP(6);
#if defined(CHECKS)
    if (F.wg == 255) chk_p7_save(F, A);
#endif
    REP(6) {
    {   const int ncw = F.G < 64 ? F.G : 64;
        if (F.wg < ncw) { if (F.wave == 0) for (int task = F.wg; task < 64; task += ncw) p6_chain(task, F.wave, (const bf16*)(ws + WS_GT), (const bf16*)(ws + WS_HT), (bf16*)(ws + WS_SC));
#if defined(STAMPS)
            STAMP(22);
#endif
        }
        else {
            pg8::StaticOrder S; S.init(NTOK, D, F.G - ncw, F.wg - ncw);
            pg8::Gemm g{(const bf16*)(ws + WS_QB), (const bf16*)(ws + WS_WOSB), NTOK, D, BW};
            EpiMerge<false> E{(bf16*)(ws + WS_GATE), (bf16*)(ws + WS_MRG), 0};
            pg8::gemm_phase<EpiMerge<false>, pg8::StaticOrder>(stage, g, S, E, nullptr, F.wave); }
    }
    xcd_barrier(bar);
    }
    STAMP(7);
    REP(7) {
    p7_mfma(F, A, (const bf16*)(ws + WS_SC), (const bf16*)(ws + WS_P), (const bf16*)(ws + WS_QO), V, (const bf16*)(ws + WS_GG), (const float*)(ws + WS_BON), (bf16*)(ws + WS_YRW));
    xcd_barrier(bar);
    }
    STAMP(8);
#if defined(CHECKS)
    if (F.wg == 0) chk_p7(F, A, R, KS, V, KK);
#endif
    REP(8) {
    {   pg8::StaticOrder S; S.init(NTOK, D, F.G, F.wg);
        {   pg8::Gemm g{(const bf16*)(ws + WS_YRW), (const bf16*)(ws + WS_WORW), NTOK, D, BW};
            EpiMerge<true> E{(bf16*)(ws + WS_GATE), (bf16*)(ws + WS_MRG), D};
            pg8::gemm_phase<EpiMerge<true>, pg8::StaticOrder>(stage, g, S, E, nullptr, F.wave); } }
    xcd_barrier(bar);
    }
    STAMP(9);
#if defined(CHECKS)
    if (F.wg == 0) chk_p8(F, A);
#endif
    REP(9) {
    {   pg8::Gemm g{(const bf16*)(ws + WS_MRG), (const bf16*)(ws + WS_WOUT), NTOK, D, D}; pg8::StaticOrder S; S.init(NTOK, D, F.G, F.wg);
        EpiPlain E{(bf16*)(ws + WS_Y1), D, 0xff};
        pg8::gemm_phase<EpiPlain, pg8::StaticOrder>(stage, g, S, E, nullptr, F.wave); }
    xcd_barrier(bar);
    }
    STAMP(10);
#if defined(CHECKS)
    if (F.wg == 0) chk_p9(F, A);
#endif
    REP(10) {
    p10_rows(F, A, (const bf16*)(ws + WS_Y1), (bf16*)(ws + WS_H2));
    xcd_barrier(bar);
    }
    STAMP(11);
#if defined(CHECKS)
    if (F.wg == 0) chk_p10(F, A);
#endif
    REP(11) {
    p11_rank_gather(F, A, (const bf16*)(ws + WS_H2), (bf16*)(ws + WS_HS));
    xcd_barrier(bar);
    }
    STAMP(12);
#if defined(CHECKS)
    if (F.wg == 0) chk_p11(F, A);
#endif
    {   const int* tile = (const int*)(ws + WS_TILE);
        const int nt = __builtin_amdgcn_readfirstlane(tile[MAXT]);
        MoeOrder S; S.nunits = nt * 4; S.G = F.G; S.vc = (F.G % 8 == 0) ? (F.wg % 8) * (F.G / 8) + F.wg / 8 : F.wg; S.tile_e = tile;
        REP(12) {   pg8::Gemm g{(const bf16*)(ws + WS_HS), (const bf16*)(ws + WS_WUP), MAXT * 256, NE * 1024, D};
            EpiUp E{(bf16*)(ws + WS_HID)};
            pg8::gemm_phase<EpiUp, MoeOrder>(stage, g, S, E, nullptr, F.wave);
        xcd_barrier(bar); }
    STAMP(13);
#if defined(CHECKS)
        if (F.wg == 0) chk_p12(F, A);
#endif
        REP(13) {   pg8::Gemm g{(const bf16*)(ws + WS_HID), (const bf16*)(ws + WS_WDN), MAXT * 256, NE * 1024, DE};
            EpiPlain E{(bf16*)(ws + WS_HS), D, 3};
            pg8::gemm_phase<EpiPlain, MoeOrder>(stage, g, S, E, nullptr, F.wave);
        xcd_barrier(bar); } }
    STAMP(14);
#if defined(CHECKS)
    if (F.wg == 0) chk_p13(F, A);
#endif
    p14_final(F, A, (const bf16*)(ws + WS_HS));
#if defined(STAMPS)
    xcd_barrier(bar);
    STAMP(15);
    if (F.wg == 0) { __syncthreads();
        const float va = (float)(long long)(tsp[STAMP_A2] - tsp[STAMP_A]) * 0.01f, vb = (float)(long long)(tsp[STAMP_B2] - tsp[STAMP_B]) * 0.01f;
#if defined(STAMP_SHIFT)
        const float shf_ = 1.1f;
#else
        const float shf_ = 1.0f;
#endif
        int b1 = (int)floorf(logf(fmaxf(va * shf_, 1.0f)) / logf(1.21f)) + 1, b2 = (int)floorf(logf(fmaxf(vb * shf_, 1.0f)) / logf(1.21f)) + 1;
#if defined(STAMP_CAL)
        b1 = 10; b2 = 30;
#endif
#if defined(STAMP_FRAC)
        { const unsigned long long* t5 = tsp + 32; const float tot = (float)(long long)(t5[9] - t5[0]);
          b1 = (int)(12.0f * (float)(long long)(t5[STAMP_A2] - t5[STAMP_A]) / tot) + 3; b2 = (int)(12.0f * (float)(long long)(t5[STAMP_B2] - t5[STAMP_B]) / tot) + 3; }
#endif
#if defined(STAMP_THR_A)
        b1 = va > (float)(STAMP_THR_A) ? 30 : 10; b2 = vb > (float)(STAMP_THR_B) ? 30 : 10;
#endif
        const int t_ = opq_tid(F.wave);
        for (int i = t_; i < 1000; i += NTHR) A.out[1000 + i] += 20.0f * (float)b2;
        if (t_ == 0) A.out[0] = 200.0f * (float)b1; }
#endif
#if defined(CHECKS)
    xcd_barrier(bar);
    if (F.wg == 0 && F.tid == 0) { const unsigned* fl = chk_flags(ws); int id = 0; for (int i = 61; i >= 0; --i) if (fl[i]) id = i;
        if (((const unsigned*)(ws + WS_CTL))[XB_TMO]) id = 60;
        if (id) A.out[0] = 10.0f * (float)id;
#if defined(CHKVAL)
        A.out[0] = 1000.0f * ((const float*)fl)[CHKVAL];
#endif
        }
#endif
}

extern "C" void kernel_launch(void* const* d_in, const int* in_sizes, int n_in, void* d_out, int out_size, void* d_ws, size_t ws_size, hipStream_t stream) {
    static int grid = 0;
    if (grid == 0) {
        if (n_in != 26 || in_sizes[0] != NTOK * D || out_size != NTOK * D || ws_size < WS_END) {
            fprintf(stderr, "kernel_launch: unexpected shapes (n_in %d, in0 %d, out %d, ws %zu); nothing launched\n", n_in, n_in > 0 ? in_sizes[0] : -1, out_size, ws_size); grid = -1; return; }
        int dev = 0, cus = 0, per_cu = 0;
        if (hipGetDevice(&dev) != hipSuccess || hipDeviceGetAttribute(&cus, hipDeviceAttributeMultiprocessorCount, dev) != hipSuccess) { grid = -1; return; }
        if (hipFuncSetAttribute((const void*)hybrid_fwd, hipFuncAttributeMaxDynamicSharedMemorySize, LDS_BYTES) != hipSuccess) { fprintf(stderr, "kernel_launch: hipFuncSetAttribute failed\n"); grid = -1; return; }
        if (hipOccupancyMaxActiveBlocksPerMultiprocessor(&per_cu, (const void*)hybrid_fwd, NTHR, LDS_BYTES) != hipSuccess || per_cu < 1)
            fprintf(stderr, "kernel_launch: note: occupancy query reports %d workgroups per CU\n", per_cu);
        (void)hipGetLastError();
        grid = cus > 256 ? 256 : cus;
    }
    if (grid < 0) return;
    if (hipMemsetAsync((char*)d_ws + WS_CTL, 0, CTL_ZERO_BYTES, stream) != hipSuccess) return;
    Args a{};
    const float** p = (const float**)&a;
    for (int i = 0; i < 26; ++i) p[i] = (const float*)d_in[i];
    a.out = (float*)d_out; a.ws = (unsigned char*)d_ws;
    hipLaunchKernelGGL(hybrid_fwd, dim3(grid), dim3(NTHR), LDS_BYTES, stream, a);
}

#if defined(ONLY_P5)
__global__ void __launch_bounds__(NTHR, 2) only_p5(Args A_unused) {
    extern __shared__ __attribute__((aligned(16))) unsigned char lds_raw[];
    const CAS Args& A = *(const CAS Args*)__builtin_amdgcn_kernarg_segment_ptr();
    Frame F; F.lds = (LAS unsigned char*)lds_raw; F.wave = __builtin_amdgcn_readfirstlane((int)threadIdx.x >> 6); F.tid = opq_tid(F.wave); F.lane = F.tid & 63;
    F.wg = blockIdx.x; F.G = gridDim.x; F.gw = F.wg * NWAVES + F.wave; F.NGW = F.G * NWAVES;
    unsigned char* ws = A.ws; bf16* const dob = (bf16*)A.out;
    bf16 *R = dob, *KS = dob + (size_t)NTOK * BW, *V = dob + 2 * (size_t)NTOK * BW, *KK = dob + 3 * (size_t)NTOK * BW;
    p5_mfma(ws, F, R, KS, V, KK, (const bf16*)(ws + WS_B), (const bf16*)(ws + WS_E), (bf16*)(ws + WS_P), (bf16*)(ws + WS_QO), (bf16*)(ws + WS_GT), (bf16*)(ws + WS_HT));
}
#endif
```

```cpp
#include <hip/hip_runtime.h>
#include <cstdio>
#include <cstdint>
__device__ __forceinline__ int opq_tid(int wave) { int l; asm volatile("v_mbcnt_lo_u32_b32 %0, -1, 0\n\tv_mbcnt_hi_u32_b32 %0, -1, %0" : "=v"(l)); return wave * 64 + l; }
#ifndef PHMASK
#define PHMASK 0xffff
#endif
namespace pg8 {
#define PG8_LAS __attribute__((address_space(3)))
typedef unsigned short bf16_t;
typedef short bf16x8 __attribute__((ext_vector_type(8)));
typedef float f32x4 __attribute__((ext_vector_type(4)));
typedef unsigned u32x4 __attribute__((ext_vector_type(4)));
constexpr int BM = 256, BK = 64, HALF = 128, HTB = HALF * BK * 2  , STAGE_BYTES = 8 * HTB, NXCD = 8, WGM = 8;

__host__ __device__ __forceinline__ int lds_byte(int r, int c) { const int st = (r >> 4) * 2 + (c >> 5), rr = r & 15, cc = c & 31, ob = rr * 64 + cc * 2; return st * 1024 + (ob ^ (((ob >> 9) & 1) << 5)); }
__host__ __device__ __forceinline__ void stage_rc(int b, int& R, int& C) { const int st = b / 1024, sb = b % 1024, swz = sb ^ (((sb >> 9) & 1) << 5); R = (st >> 1) * 16 + swz / 64; C = (st & 1) * 32 + (swz % 64) / 2; }
__host__ __device__ __forceinline__ int perm32(int rho) { const int n = rho >> 4, i = rho & 15; return 8 * (i >> 2) + 4 * n + (i & 3); }

struct Unit { int pm, pn; };
struct Gemm { const bf16_t* A; const bf16_t* Bt; int M, N, K; };

struct StaticOrder {
    int nM, nN, nwg, G, c;
    __host__ __device__ void init(int M, int N, int G_, int c_) { nM = M / BM; nN = N / BM; nwg = nM * nN; G = G_; c = c_; }
    __host__ __device__ bool next(int i, Unit& u) const {
        const long L = (long)i * G + c; if (L >= nwg) return false;
        int wgid = (int)L; { const int q = nwg / NXCD, r = nwg % NXCD, xcd = wgid % NXCD, off = wgid / NXCD; wgid = (xcd < r ? xcd * (q + 1) : r * (q + 1) + (xcd - r) * q) + off; }
        const int nig = WGM * nN, gid = wgid / nig, fm = gid * WGM, gsz = (nM - fm) < WGM ? (nM - fm) : WGM;
        u.pm = fm + ((wgid % nig) % gsz); u.pn = (wgid % nig) / gsz; return true;
    }
    __device__ __forceinline__ void a_ready(const Unit&) const {}
    __device__ __forceinline__ void done(const Unit&) const {}
};

template <class Epi, class Sched, bool STAMP = false>
__device__ __forceinline__ void gemm_phase(PG8_LAS unsigned char* lds, const Gemm g, const Sched& S, const Epi& E, unsigned long long* stamps, int wave_id) {
    const int tid = opq_tid(wave_id), wid = __builtin_amdgcn_readfirstlane(tid >> 6), lane = tid & 63, wr = wid >> 2, wc = wid & 3, fr = lane & 15, fq = lane >> 4;
    const int K = g.K, nt = K / BK;
    int ts_lo = 0, ts_hi = 0, nts = 0; const unsigned long long rt_entry = STAMP ? (unsigned long long)wall_clock64() : 0ull;
#define PG8_STAMP() do { if (STAMP && wid == 0 && nts < 64) { const unsigned long long _c = (unsigned long long)clock64(); \
        ts_lo = (lane == nts) ? (int)(unsigned)_c : ts_lo; ts_hi = (lane == nts) ? (int)(unsigned)(_c >> 32) : ts_hi; ++nts; } } while (0)
    PG8_STAMP();
    unsigned voffA[2], voffB[2];
#pragma unroll
    for (int i = 0; i < 2; ++i) { int R, C; stage_rc(tid * 16 + i * 8192, R, C); const int Rb = Epi::PERM ? ((R & ~31) + perm32(R & 31)) : R;
        voffA[i] = (unsigned)(R * K + C) * 2u; voffB[i] = (unsigned)(Rb * K + C) * 2u; }
    const size_t kstep = (size_t)(BK * 2);
    const size_t hstep = (size_t)HALF * K * 2;
    const size_t tstep = 2 * hstep;
    const unsigned ldsw = (unsigned)wid * 1024u;
    const int aoff = lds_byte(wr * 64 + fr, fq * 8), boff = lds_byte(wc * 32 + fr, fq * 8);
#define PG8_SA(b, h) (((b) * 2 + (h)) * HTB)
#define PG8_SB(b, h) ((4 + (b) * 2 + (h)) * HTB)
#define PG8_STAGE(bufoff, gbase, voff) do { _Pragma("unroll") for (int _i = 0; _i < 2; ++_i) \
        __builtin_amdgcn_global_load_lds((const unsigned*)((const char*)(gbase) + (voff)[_i]), (PG8_LAS unsigned*)(lds + (bufoff) + ldsw + _i * 8192), 16, 0, 0); } while (0)
#define PG8_LDA(dst, b, h) do { _Pragma("unroll") for (int m = 0; m < 4; ++m) _Pragma("unroll") for (int k = 0; k < 2; ++k) dst[m][k] = *(const PG8_LAS bf16x8*)(lds + PG8_SA(b, h) + aoff + m * 2048 + k * 1024); } while (0)
#define PG8_LDB(dst, b, h) do { _Pragma("unroll") for (int n = 0; n < 2; ++n) _Pragma("unroll") for (int k = 0; k < 2; ++k) dst[n][k] = *(const PG8_LAS bf16x8*)(lds + PG8_SB(b, h) + boff + n * 2048 + k * 1024); } while (0)
#define PG8_MMA(ai, bj, At, Bt) do { __builtin_amdgcn_s_setprio(1); _Pragma("unroll") for (int m = 0; m < 4; ++m) _Pragma("unroll") for (int n = 0; n < 2; ++n) _Pragma("unroll") for (int k = 0; k < 2; ++k) \
        acc[ai][bj][m][n] = __builtin_amdgcn_mfma_f32_16x16x32_bf16(Bt[n][k], At[m][k], acc[ai][bj][m][n], 0, 0, 0); __builtin_amdgcn_s_setprio(0); } while (0)
#define PG8_WAIT_V(n) asm volatile("s_waitcnt vmcnt(" #n ")" ::: "memory")
#define PG8_WAIT_L(n) asm volatile("s_waitcnt lgkmcnt(" #n ")" ::: "memory")
#define PG8_BAR __builtin_amdgcn_s_barrier()
#define PG8_SCHED __builtin_amdgcn_sched_barrier(0)
    Unit cur, nxt; int ui = 0;
    if (!S.next(0, cur)) return;
    f32x4 acc[2][2][4][2];
#pragma unroll
    for (int a = 0; a < 2; ++a)
#pragma unroll
        for (int b = 0; b < 2; ++b)
#pragma unroll
            for (int m = 0; m < 4; ++m)
#pragma unroll
                for (int n = 0; n < 2; ++n) acc[a][b][m][n] = (f32x4){0.f, 0.f, 0.f, 0.f};
    bf16x8 At[4][2], B0[2][2], B1[2][2];
    const char* cA = (const char*)g.A + (size_t)cur.pm * tstep; const char* cB = (const char*)g.Bt + (size_t)cur.pn * tstep;
    S.a_ready(cur);
    PG8_STAGE(PG8_SB(0, 0), cB, voffB); PG8_STAGE(PG8_SA(0, 0), cA, voffA); PG8_STAGE(PG8_SB(0, 1), cB + hstep, voffB); PG8_STAGE(PG8_SA(0, 1), cA + hstep, voffA);
    if (wr == 1) PG8_BAR;
    PG8_WAIT_V(4); PG8_BAR;
    PG8_STAGE(PG8_SB(1, 0), cB + kstep, voffB); PG8_STAGE(PG8_SA(1, 0), cA + kstep, voffA); PG8_STAGE(PG8_SB(1, 1), cB + hstep + kstep, voffB);
    PG8_WAIT_V(6); PG8_BAR;
    PG8_STAMP();
    for (;;) {
        const bool has_next = S.next(ui + 1, nxt);
        const char* nA = has_next ? (const char*)g.A + (size_t)nxt.pm * tstep : cA; const char* nB = has_next ? (const char*)g.Bt + (size_t)nxt.pn * tstep : cB;
        for (int t = 0; t < nt; t += 2) {
            const bool last = (t == nt - 2);
            const char* a1 = cA + (size_t)(t + 1) * kstep;
            const char* a2 = last ? nA : cA + (size_t)(t + 2) * kstep; const char* b2 = last ? nB : cB + (size_t)(t + 2) * kstep;
            const char* a3 = a2 + kstep; const char* b3 = b2 + kstep;
            if (last && has_next) S.a_ready(nxt);
            PG8_LDB(B0, 0, 0); PG8_SCHED; PG8_LDA(At, 0, 0); PG8_STAGE(PG8_SA(1, 1), a1 + hstep, voffA);
            PG8_WAIT_L(8); PG8_BAR; PG8_WAIT_L(0); PG8_MMA(0, 0, At, B0); PG8_BAR; PG8_SCHED;
            PG8_LDB(B1, 0, 1); PG8_STAGE(PG8_SB(0, 0), b2, voffB);
            PG8_BAR; PG8_WAIT_L(0); PG8_MMA(0, 1, At, B1); PG8_BAR;
            PG8_LDA(At, 0, 1); PG8_STAGE(PG8_SA(0, 0), a2, voffA);
            PG8_BAR; PG8_WAIT_L(0); PG8_MMA(1, 0, At, B0); PG8_BAR; PG8_SCHED;
            PG8_STAGE(PG8_SB(0, 1), b2 + hstep, voffB);
            PG8_WAIT_V(6); PG8_BAR; PG8_MMA(1, 1, At, B1); PG8_BAR;
            PG8_LDB(B0, 1, 0); PG8_SCHED; PG8_LDA(At, 1, 0); PG8_STAGE(PG8_SA(0, 1), a2 + hstep, voffA);
            PG8_WAIT_L(8); PG8_BAR; PG8_WAIT_L(0); PG8_MMA(0, 0, At, B0); PG8_BAR; PG8_SCHED;
            PG8_LDB(B1, 1, 1); PG8_STAGE(PG8_SB(1, 0), b3, voffB);
            PG8_BAR; PG8_WAIT_L(0); PG8_MMA(0, 1, At, B1); PG8_BAR;
            PG8_LDA(At, 1, 1); PG8_STAGE(PG8_SA(1, 0), a3, voffA);
            PG8_BAR; PG8_WAIT_L(0); PG8_MMA(1, 0, At, B0); PG8_BAR; PG8_SCHED;
            PG8_STAGE(PG8_SB(1, 1), b3 + hstep, voffB);
            PG8_WAIT_V(6); PG8_BAR; PG8_MMA(1, 1, At, B1); PG8_BAR;
        }
        PG8_STAMP();
        if constexpr (!Epi::AFTER_DRAIN) { E(acc, cur, wr, wc, fr, fq); S.done(cur); }
        PG8_STAMP();
        if (!has_next) break;
#pragma unroll
        for (int a = 0; a < 2; ++a)
#pragma unroll
            for (int b = 0; b < 2; ++b)
#pragma unroll
                for (int m = 0; m < 4; ++m)
#pragma unroll
                    for (int n = 0; n < 2; ++n) acc[a][b][m][n] = (f32x4){0.f, 0.f, 0.f, 0.f};
        cur = nxt; cA = nA; cB = nB; ++ui;
    }
    PG8_WAIT_V(0);
    if (wr == 0) PG8_BAR;
    PG8_BAR;
    if constexpr (Epi::AFTER_DRAIN) { E.fused(acc, cur, wr, wc, fr, fq, lds, wid, lane); S.done(cur); }
    PG8_STAMP();
    if (STAMP && wid == 0) { stamps[lane] = lane < nts ? (((unsigned long long)(unsigned)ts_hi << 32) | (unsigned)ts_lo) : 0ull;
        if (lane == 62) stamps[62] = rt_entry; if (lane == 63) stamps[63] = (unsigned long long)wall_clock64(); }
#undef PG8_STAMP
#undef PG8_SA
#undef PG8_SB
#undef PG8_STAGE
#undef PG8_LDA
#undef PG8_LDB
#undef PG8_MMA
#undef PG8_WAIT_V
#undef PG8_WAIT_L
#undef PG8_BAR
#undef PG8_SCHED
}
}

#define XB_TMO      128
#define XB_XCNT(j)  (256  + 64 * (j))
#define XB_XSUB(j)  (1280 + 64 * (j))
#define XB_XGEN(j)  (2304 + 64 * (j))
#define XB_TOP      3328
#define XB_TOPGEN   3392
#define XCD_BAR_WORDS 3456
#define XB_SPIN_CAP (1u << 18)
#define LAS __attribute__((address_space(3)))

__device__ __forceinline__ unsigned xb_ld(unsigned* p)              { return __hip_atomic_load(p, __ATOMIC_RELAXED, __HIP_MEMORY_SCOPE_AGENT); }
__device__ __forceinline__ unsigned xb_add(unsigned* p, unsigned v) { return __hip_atomic_fetch_add(p, v, __ATOMIC_RELAXED, __HIP_MEMORY_SCOPE_AGENT); }
__device__ __forceinline__ unsigned xb_xcc_id() { return (unsigned)__builtin_amdgcn_s_getreg((3 << 11) | 20) & 0xFu; }
#define XB_SPIN(cond, bar) do { unsigned _sp = 0; while (cond) { __builtin_amdgcn_s_sleep(1); \
    if ((++_sp & 255u) == 0u) { if (xb_ld(&(bar)[XB_TMO])) break; if (_sp > XB_SPIN_CAP) { atomicAdd(&(bar)[XB_TMO], 1u); break; } } } } while (0)

struct XcdBarrier {
    unsigned* bar; unsigned x; int wave;
    volatile LAS unsigned* st;
};

__device__ __forceinline__ bool xb_t0(int wave) { return wave == 0 && __builtin_amdgcn_mbcnt_hi(~0u, __builtin_amdgcn_mbcnt_lo(~0u, 0u)) == 0u; }
__device__ __forceinline__ XcdBarrier xcd_barrier_post(unsigned* bar, volatile LAS unsigned* st, int wave) {
    XcdBarrier b; b.bar = bar; b.x = xb_xcc_id(); b.st = st; b.wave = wave;
    if (xb_t0(wave)) (void)xb_add(&bar[XB_XCNT(b.x)], 1u);
    return b;
}
__device__ __forceinline__ void xcd_barrier_complete(unsigned* bar, unsigned x, unsigned& nloc, unsigned& nx) {
    const unsigned G = gridDim.x * gridDim.y * gridDim.z;
    unsigned sum, cnt, mine, sp = 0u;
    for (;;) {
        sum = 0u; cnt = 0u; mine = 0u;
#pragma unroll
        for (unsigned j = 0; j < 16; ++j) { const unsigned c = xb_ld(&bar[XB_XCNT(j)]); sum += c; cnt += (c > 0u) ? 1u : 0u; mine = (j == x) ? c : mine; }
        if (sum == G) break;
        __builtin_amdgcn_s_sleep(1);
        if ((++sp & 255u) == 0u) { if (xb_ld(&bar[XB_TMO])) break; if (sp > XB_SPIN_CAP) { atomicAdd(&bar[XB_TMO], 1u); break; } }
    }
    nloc = mine > 0u ? mine : 1u; nx = cnt > 0u ? cnt : 1u;
}

__device__ __forceinline__ void xcd_barrier(const XcdBarrier& b) {
    asm volatile("s_waitcnt vmcnt(0)" ::: "memory");
    __syncthreads();
    if (xb_t0(b.wave)) {
        unsigned* bar = b.bar;
        __builtin_amdgcn_s_waitcnt(0);
        unsigned nloc = b.st[0], nx = b.st[1];
        if (nloc == 0u) { xcd_barrier_complete(bar, b.x, nloc, nx); b.st[0] = nloc; b.st[1] = nx; }
        const unsigned old = xb_add(&bar[XB_XSUB(b.x)], 1u);
        const unsigned gen = old / nloc;
        if (old + 1u == (gen + 1u) * nloc) {
            __builtin_amdgcn_fence(__ATOMIC_RELEASE, "agent");
            asm volatile("s_waitcnt vmcnt(0)" ::: "memory");
            const unsigned og = xb_add(&bar[XB_TOP], 1u);
            const unsigned tg = og / nx;
            if (og + 1u == (tg + 1u) * nx) xb_add(&bar[XB_TOPGEN], 1u);
            else XB_SPIN(xb_ld(&bar[XB_TOPGEN]) == tg, bar);
            __builtin_amdgcn_fence(__ATOMIC_ACQUIRE, "agent");
            xb_add(&bar[XB_XGEN(b.x)], 1u);
            asm volatile("s_waitcnt vmcnt(0)" ::: "memory");
        } else {
            XB_SPIN(xb_ld(&bar[XB_XGEN(b.x)]) == gen, bar);
            __builtin_amdgcn_fence(__ATOMIC_ACQUIRE, "agent");
            asm volatile("s_waitcnt vmcnt(0)" ::: "memory");
        }
    }
    __syncthreads();
}


constexpr int NB = 4, SEQ = 8192, D = 1024, NTOK = NB * SEQ;
constexpr int NH = 8, HD = 64, BW = 512;
constexpr int IN_COLS = 5408, NPAD = 5632;
constexpr int LK = 384;
constexpr int NE = 32, DE = 512;
constexpr int CH = 64, NCH = SEQ / CH, NCH_LOG = 7, NCHUNK = NB * NH * NCH;
constexpr int MAXT = 288;
constexpr float NORM_EPS = 1e-6f, GN_EPS = 64e-5f, L2_EPS = 1e-12f;
constexpr float SB_STOP = -120.0f;

constexpr size_t MiB = 1u << 20;
constexpr size_t WS_CTL = 0, CTL_ZERO_BYTES = 65536;
constexpr size_t WS_MOD = 1 * MiB;
constexpr size_t WS_RTW = WS_MOD + 128 * 1024;
constexpr size_t WS_TOK = WS_RTW + 160 * 1024;
constexpr size_t WS_CNT = WS_TOK + (size_t)NTOK * 16;
constexpr size_t WS_TILE = WS_CNT + 256 * 32 * 4;
constexpr size_t WS_WIN = 2 * MiB;
constexpr size_t WS_WOSB = 13 * MiB, WS_WORW = 14 * MiB, WS_WOUT = 15 * MiB;
constexpr size_t WS_WL = 17 * MiB;
constexpr size_t WS_BON = 18 * MiB + 256 * 1024;
constexpr size_t WS_CW = 19 * MiB + 768 * 1024;
constexpr size_t WS_QB = 20 * MiB;
constexpr size_t WS_GATE = 52 * MiB;
constexpr size_t WS_GG = 180 * MiB;
constexpr size_t WS_KB = 212 * MiB, WS_VT = 244 * MiB;
constexpr size_t WS_LORA = 276 * MiB;
constexpr size_t WS_ALORA = 308 * MiB;
constexpr size_t WS_E = 340 * MiB, WS_B = 372 * MiB;
constexpr size_t WS_RWRAW = 416 * MiB;
constexpr size_t WS_P = 212 * MiB, WS_QO = 244 * MiB;
constexpr size_t WS_GT = 276 * MiB;
constexpr size_t WS_HT = 308 * MiB;
constexpr size_t WS_SC = 340 * MiB;
constexpr size_t WS_YRW = 384 * MiB;
constexpr size_t WS_WUP = 416 * MiB, WS_WDN = 480 * MiB;
constexpr size_t WS_MRG = 212 * MiB;
constexpr size_t WS_Y1 = 276 * MiB;
constexpr size_t WS_H2 = 52 * MiB;
constexpr size_t WS_HS = 116 * MiB;
constexpr size_t WS_HID = 260 * MiB;
constexpr size_t WS_X1 = 340 * MiB;
constexpr size_t WS_END = 512 * MiB;
static_assert(WS_TILE + (MAXT + 1) * 4 <= WS_WIN && WS_WIN + (size_t)NPAD * D * 2 <= WS_WOSB && WS_WL + 1536 * LK * 2 <= WS_QB, "fixed region");
static_assert(WS_HS + (size_t)MAXT * 256 * D * 2 <= WS_HID && WS_HID + (size_t)MAXT * 256 * DE * 2 <= WS_WUP, "moe region");
static_assert(WS_ALORA + (size_t)NTOK * LK * 2 <= WS_E && WS_B + (size_t)NTOK * BW * 2 <= WS_RWRAW, "rwkv region");

constexpr int LDS_BYTES = 163840;
constexpr int LDS_MISC = LDS_BYTES - 256;
constexpr int NWAVES = 8, NTHR = 512;

typedef unsigned short bf16;
typedef short bf16x8 __attribute__((ext_vector_type(8)));
typedef short s16x4 __attribute__((ext_vector_type(4)));
typedef float f32x4 __attribute__((ext_vector_type(4)));
typedef float f32x16 __attribute__((ext_vector_type(16)));
typedef unsigned u32x4 __attribute__((ext_vector_type(4)));
typedef unsigned u32x2 __attribute__((ext_vector_type(2)));
typedef int i32x4 __attribute__((ext_vector_type(4)));
#define DI __device__ __forceinline__
#define GAS __attribute__((address_space(1)))
#define MFMA32(a, b, c) __builtin_amdgcn_mfma_f32_32x32x16_bf16((a), (b), (c), 0, 0, 0)

typedef float f32x2_t __attribute__((ext_vector_type(2))); typedef __bf16 bf16x2_t __attribute__((ext_vector_type(2)));
DI unsigned pk2(float lo, float hi) { f32x2_t v = {lo, hi}; return __builtin_bit_cast(unsigned, __builtin_convertvector(v, bf16x2_t)); }
DI unsigned f2bf(float f) { return pk2(f, 0.0f) & 0xffffu; }
DI float bflo(unsigned u) { return __builtin_bit_cast(float, u << 16); }
DI float bfhi(unsigned u) { return __builtin_bit_cast(float, u & 0xffff0000u); }
DI float bf2f(bf16 h) { return __builtin_bit_cast(float, (unsigned)h << 16); }
DI float fexp(float x) { return __expf(x); }
DI float frcp(float x) { return __builtin_amdgcn_rcpf(x); }
DI float fsigmoid(float x) { return frcp(1.0f + fexp(-x)); }
DI float fsoftplus(float x) { return fmaxf(x, 0.0f) + __logf(1.0f + fexp(-fabsf(x))); }
#define DPP_SHR(v, ctrl) __builtin_bit_cast(float, __builtin_amdgcn_update_dpp(0, __builtin_bit_cast(int, (v)), (ctrl), 0xf, 0xf, true))
DI float wave_sum(float v) {
    v += DPP_SHR(v, 0x111); v += DPP_SHR(v, 0x112); v += DPP_SHR(v, 0x114); v += DPP_SHR(v, 0x118);
    v += __builtin_bit_cast(float, __builtin_amdgcn_update_dpp(0, __builtin_bit_cast(int, v), 0x142, 0xa, 0xf, false));
    v += __builtin_bit_cast(float, __builtin_amdgcn_update_dpp(0, __builtin_bit_cast(int, v), 0x143, 0xc, 0xf, false));
    return __builtin_bit_cast(float, __builtin_amdgcn_readlane(__builtin_bit_cast(int, v), 63));
}
DI float shfl_xor_l(float v, int m, int lane) { return __builtin_bit_cast(float, __builtin_amdgcn_ds_bpermute(4 * (lane ^ m), __builtin_bit_cast(int, v))); }
DI int crow(int reg, int hh) { return (reg & 3) + 8 * (reg >> 2) + 4 * hh; }
DI void wave_lds_fence() { __builtin_amdgcn_fence(__ATOMIC_RELEASE, "wavefront"); __builtin_amdgcn_wave_barrier(); __builtin_amdgcn_fence(__ATOMIC_ACQUIRE, "wavefront"); }
DI void unpack8(const u32x4 v, float (&o)[8]) { o[0] = bflo(v.x); o[1] = bfhi(v.x); o[2] = bflo(v.y); o[3] = bfhi(v.y); o[4] = bflo(v.z); o[5] = bfhi(v.z); o[6] = bflo(v.w); o[7] = bfhi(v.w); }
DI u32x4 pack8(const float (&o)[8]) { u32x4 v; v.x = pk2(o[0], o[1]); v.y = pk2(o[2], o[3]); v.z = pk2(o[4], o[5]); v.w = pk2(o[6], o[7]); return v; }
DI bf16x8 pack8v(float a0, float a1, float a2, float a3, float a4, float a5, float a6, float a7) {
    u32x4 v; v.x = pk2(a0, a1); v.y = pk2(a2, a3); v.z = pk2(a4, a5); v.w = pk2(a6, a7); return __builtin_bit_cast(bf16x8, v); }


#if defined(CHECKS)
constexpr int DBG_TOKEN = 77;
#endif

typedef pg8::f32x4 af4;
DI void st8(bf16* p, const af4 v0, const af4 v1) { u32x4 w; w.x = pk2(v0[0], v0[1]); w.y = pk2(v0[2], v0[3]); w.z = pk2(v1[0], v1[1]); w.w = pk2(v1[2], v1[3]); *(u32x4*)p = w; }

struct EpiIn {
    static constexpr bool PERM = true, AFTER_DRAIN = false;
    bf16 *Q, *K, *Vt, *RW, *LO, *GA; const float* gate_bias;
    DI void operator()(const af4 (&acc)[2][2][4][2], const pg8::Unit& u, int wr, int wc, int fr, int fq) const {
        const int pn = u.pn, row0 = u.pm * 256 + wr * 64 + fr;
        if (pn == 4 || pn == 5) {
#pragma unroll
            for (int ai = 0; ai < 2; ++ai)
#pragma unroll
                for (int m = 0; m < 4; ++m) { const int row = row0 + ai * 128 + m * 16, b = row >> 13, s = row & (SEQ - 1);
#pragma unroll
                    for (int bj = 0; bj < 2; ++bj)
#pragma unroll
                        for (int n = 0; n < 2; ++n)
#pragma unroll
                            for (int j = 0; j < 4; ++j) { const int cv = (pn - 4) * 256 + bj * 128 + wc * 32 + 8 * fq + 4 * n + j;
                                Vt[((size_t)(b * BW + cv)) * SEQ + s] = (bf16)f2bf(acc[ai][bj][m][n][j]); } }
        } else if (pn >= 14) {
            const int col0 = (pn - 14) * 256 + wc * 32 + 8 * fq;
            af4 bv[2][2];
#pragma unroll
            for (int bj = 0; bj < 2; ++bj)
#pragma unroll
                for (int n = 0; n < 2; ++n) bv[bj][n] = *(const af4*)(gate_bias + col0 + bj * 128 + 4 * n);
#pragma unroll
            for (int ai = 0; ai < 2; ++ai)
#pragma unroll
                for (int m = 0; m < 4; ++m) { bf16* rowp = GA + (size_t)(row0 + ai * 128 + m * 16) * 2048 + col0;
#pragma unroll
                    for (int bj = 0; bj < 2; ++bj) { af4 v0 = acc[ai][bj][m][0] + bv[bj][0], v1 = acc[ai][bj][m][1] + bv[bj][1];
#pragma unroll
                        for (int j = 0; j < 4; ++j) { v0[j] = fsigmoid(v0[j]); v1[j] = fsigmoid(v1[j]); }
                        st8(rowp + bj * 128, v0, v1); } }
        } else {
            bf16* base; int ld, ct; float sc = 1.0f;
            if (pn < 2) { base = Q; ld = BW; ct = pn; sc = 0.125f; } else if (pn < 4) { base = K; ld = BW; ct = pn - 2; } else if (pn < 12) { base = RW; ld = 1536; ct = pn - 6; } else { base = LO; ld = BW; ct = pn - 12; }
            const int col0 = ct * 256 + wc * 32 + 8 * fq;
#pragma unroll
            for (int ai = 0; ai < 2; ++ai)
#pragma unroll
                for (int m = 0; m < 4; ++m) { bf16* rowp = base + (size_t)(row0 + ai * 128 + m * 16) * ld + col0;
#pragma unroll
                    for (int bj = 0; bj < 2; ++bj) st8(rowp + bj * 128, acc[ai][bj][m][0] * sc, acc[ai][bj][m][1] * sc); }
        }
    }
};

template <bool ADD> struct EpiMerge {
    static constexpr bool PERM = true, AFTER_DRAIN = false;
    bf16* GA; bf16* MRG; int gofs;
    DI void operator()(const af4 (&acc)[2][2][4][2], const pg8::Unit& u, int wr, int wc, int fr, int fq) const {
        const int row0 = u.pm * 256 + wr * 64 + fr, col0 = u.pn * 256 + wc * 32 + 8 * fq;
#pragma unroll
        for (int ai = 0; ai < 2; ++ai)
#pragma unroll
            for (int m = 0; m < 4; ++m) { const size_t row = (size_t)(row0 + ai * 128 + m * 16);
#pragma unroll
                for (int bj = 0; bj < 2; ++bj) { const int c = col0 + bj * 128;
                    float g[8]; unpack8(*(const u32x4*)(GA + row * 2048 + gofs + c), g);
                    af4 v0, v1;
#pragma unroll
                    for (int j = 0; j < 4; ++j) { v0[j] = g[j] * acc[ai][bj][m][0][j]; v1[j] = g[4 + j] * acc[ai][bj][m][1][j]; }
                    if (ADD) { float o[8]; unpack8(*(const u32x4*)(GA + row * 2048 + c), o);
#pragma unroll
                        for (int j = 0; j < 4; ++j) { v0[j] += o[j]; v1[j] += o[4 + j]; }
                        st8(MRG + row * D + c, v0, v1); }
                    else st8(GA + row * 2048 + c, v0, v1); } }
    }
};

struct EpiPlain {
    static constexpr bool PERM = true, AFTER_DRAIN = false;
    bf16* O; int ld, cmask;
    DI void operator()(const af4 (&acc)[2][2][4][2], const pg8::Unit& u, int wr, int wc, int fr, int fq) const {
        const int row0 = u.pm * 256 + wr * 64 + fr, col0 = (u.pn & cmask) * 256 + wc * 32 + 8 * fq;
#pragma unroll
        for (int ai = 0; ai < 2; ++ai)
#pragma unroll
            for (int m = 0; m < 4; ++m) { bf16* rowp = O + (size_t)(row0 + ai * 128 + m * 16) * ld + col0;
#pragma unroll
                for (int bj = 0; bj < 2; ++bj) st8(rowp + bj * 128, acc[ai][bj][m][0], acc[ai][bj][m][1]); }
    }
};

struct EpiUp {
    static constexpr bool PERM = true, AFTER_DRAIN = false;
    bf16* HID;
    DI void operator()(const af4 (&acc)[2][2][4][2], const pg8::Unit& u, int wr, int wc, int fr, int fq) const {
        const int row0 = u.pm * 256 + wr * 64 + fr, col0 = (u.pn & 3) * 128 + wc * 16 + 4 * fq;
#pragma unroll
        for (int ai = 0; ai < 2; ++ai)
#pragma unroll
            for (int m = 0; m < 4; ++m) { bf16* rowp = HID + (size_t)(row0 + ai * 128 + m * 16) * DE + col0;
#pragma unroll
                for (int bj = 0; bj < 2; ++bj) { float h[4];
#pragma unroll
                    for (int j = 0; j < 4; ++j) { const float u1 = acc[ai][bj][m][0][j]; h[j] = u1 * fsigmoid(u1) * acc[ai][bj][m][1][j]; }
                    u32x2 w; w.x = pk2(h[0], h[1]); w.y = pk2(h[2], h[3]); *(u32x2*)(rowp + bj * 64) = w; } }
    }
};

struct MoeOrder {
    int nunits, G, vc; const int* tile_e;
    DI bool next(int i, pg8::Unit& u) const { const long L = (long)i * G + vc; if (L >= nunits) return false; const int rt = (int)(L >> 2);
        u.pm = rt; u.pn = __builtin_amdgcn_readfirstlane(tile_e[rt]) * 4 + (int)(L & 3); return true; }
    DI void a_ready(const pg8::Unit&) const {}
    DI void done(const pg8::Unit&) const {}
};

struct Args {
    const float *x, *c, *w_mod, *b_mod, *gains, *w_in, *gate_bias, *shift_mu, *w0, *w_decay_up, *a0, *w_iclr_up, *w_gate_up, *k_k, *k_a, *r_k, *lnx_w, *lnx_b,
                *w_o_sb, *w_o_rw, *w_out, *w_group, *w_router, *w_up1, *w_up3, *w_down;
    float* out; unsigned char* ws;
};
struct Frame { LAS unsigned char* lds; int tid, lane, wave, wg, G, gw, NGW; };
#define CAS __attribute__((address_space(4)))
typedef const CAS Args& ARef;

DI void tr_item(const float* W, int ldw, int K, bf16* WT, int k0, int drow0, int scol0, LAS float* scr, int lane) {
    if (scol0 >= 0) {
        float v[32];
        const float* wp = W + (size_t)(k0 + (lane >> 5)) * ldw + scol0 + (lane & 31);
#pragma unroll
        for (int i = 0; i < 32; ++i) v[i] = wp[(size_t)(2 * i) * ldw];
#pragma unroll
        for (int i = 0; i < 32; ++i) scr[(2 * i + (lane >> 5)) * 33 + (lane & 31)] = v[i];
    } else {
#pragma unroll 8
        for (int i = 0; i < 32; ++i) { const int kk = 2 * i + (lane >> 5); scr[kk * 33 + (lane & 31)] = 0.0f; }
    }
    wave_lds_fence();
    const int c = lane & 7;
#pragma unroll
    for (int j = 0; j < 4; ++j) { const int n = (lane >> 3) + 8 * j; const LAS float* s = scr + (8 * c) * 33 + n;
        u32x4 o; o.x = pk2(s[0 * 33], s[1 * 33]); o.y = pk2(s[2 * 33], s[3 * 33]); o.z = pk2(s[4 * 33], s[5 * 33]); o.w = pk2(s[6 * 33], s[7 * 33]);
        *(u32x4*)(WT + (size_t)(drow0 + n) * K + k0 + 8 * c) = o; }
    wave_lds_fence();
}
DI void tr_item_up(const float* W1, const float* W3, bf16* WT, int e, int k0, int drow0, LAS float* scr, int lane) {
    const int l31 = lane & 31, sc = (drow0 >> 3) * 4 + (l31 >> 3) * 4 + (l31 & 3);
    const float* W = ((l31 & 4) ? W3 : W1) + (size_t)e * D * DE;
    { float v[32]; const float* wp = W + (size_t)(k0 + (lane >> 5)) * DE + sc;
#pragma unroll
        for (int i = 0; i < 32; ++i) v[i] = wp[(size_t)(2 * i) * DE];
#pragma unroll
        for (int i = 0; i < 32; ++i) scr[(2 * i + (lane >> 5)) * 33 + l31] = v[i]; }
    wave_lds_fence();
    const int c = lane & 7;
#pragma unroll
    for (int j = 0; j < 4; ++j) { const int n = (lane >> 3) + 8 * j; const LAS float* s = scr + (8 * c) * 33 + n;
        u32x4 o; o.x = pk2(s[0 * 33], s[1 * 33]); o.y = pk2(s[2 * 33], s[3 * 33]); o.z = pk2(s[4 * 33], s[5 * 33]); o.w = pk2(s[6 * 33], s[7 * 33]);
        *(u32x4*)(WT + ((size_t)e * 1024 + drow0 + n) * D + k0 + 8 * c) = o; }
    wave_lds_fence();
}

DI void p0_prologue(const Frame& F0, ARef A) {
    Frame F = F0; F.tid = opq_tid(F0.wave); F.lane = F.tid & 63; F.wave = __builtin_amdgcn_readfirstlane(F.tid >> 6); F.gw = F.wg * NWAVES + F.wave;
    unsigned char* ws = A.ws;
    LAS float* sl = (LAS float*)F.lds;
    LAS float* part = (LAS float*)(F.lds + 16384);
    for (int i = F.tid; i < NB * D; i += NTHR) { const float v = A.c[i]; sl[i] = v * fsigmoid(v); }
    __syncthreads();
    float* mod = (float*)(ws + WS_MOD);
    for (int cg = F.wg; cg < 256; cg += F.G) {
        const int col = F.tid & 31, kg = F.tid >> 5;
        if (col < 24) { float a0 = 0.f, a1 = 0.f, a2 = 0.f, a3 = 0.f;
#pragma unroll 8
            for (int kk = 0; kk < 64; ++kk) { const int k = kg * 64 + kk; const float w = A.w_mod[(size_t)k * 6144 + cg * 24 + col];
                a0 += sl[k] * w; a1 += sl[D + k] * w; a2 += sl[2 * D + k] * w; a3 += sl[3 * D + k] * w; }
            LAS float* p = part + (kg * 24 + col) * 4; p[0] = a0; p[1] = a1; p[2] = a2; p[3] = a3; }
        __syncthreads();
        if (F.tid < 96) { const int c = F.tid >> 2, b = F.tid & 3; float s = 0.f;
#pragma unroll
            for (int kg2 = 0; kg2 < 16; ++kg2) s += part[(kg2 * 24 + c) * 4 + b];
            mod[b * 6144 + cg * 24 + c] = s + A.b_mod[cg * 24 + c]; }
        __syncthreads();
    }
    LAS float* scr = (LAS float*)(F.lds + 32768 + F.wave * 8704);
    constexpr int I_IN = (NPAD / 32) * (D / 64), I_OS = (D / 32) * (BW / 64), I_OUT = (D / 32) * (D / 64);
    for (int it = F.gw; it < I_IN + 2 * I_OS + I_OUT; it += F.NGW) {
        int r = it;
        if (r < I_IN) { const int g = r / (D / 64), kb = r % (D / 64), drow0 = 32 * g;
            const int sc = drow0 < 3360 ? drow0 : (drow0 < 3584 ? -1 : drow0 - 224);
            tr_item(A.w_in, IN_COLS, D, (bf16*)(ws + WS_WIN), 64 * kb, drow0, sc, scr, F.lane); continue; }
        r -= I_IN;
        if (r < I_OS) { const int g = r / (BW / 64), kb = r % (BW / 64); tr_item(A.w_o_sb, D, BW, (bf16*)(ws + WS_WOSB), 64 * kb, 32 * g, 32 * g, scr, F.lane); continue; }
        r -= I_OS;
        if (r < I_OS) { const int g = r / (BW / 64), kb = r % (BW / 64); tr_item(A.w_o_rw, D, BW, (bf16*)(ws + WS_WORW), 64 * kb, 32 * g, 32 * g, scr, F.lane); continue; }
        r -= I_OS;
        { const int g = r / (D / 64), kb = r % (D / 64); tr_item(A.w_out, D, D, (bf16*)(ws + WS_WOUT), 64 * kb, 32 * g, 32 * g, scr, F.lane); }
    }
    const int gt = F.wg * NTHR + F.tid, NGT = F.G * NTHR;
    float* rtw = (float*)(ws + WS_RTW);
    for (int i = gt; i < 36 * D; i += NGT) { const int o = i >> 10, k = i & (D - 1); rtw[i] = o < 4 ? A.w_group[k * 4 + o] : A.w_router[k * NE + (o - 4)]; }
    bf16* wl = (bf16*)(ws + WS_WL);
    for (int i = gt; i < 1536 * LK; i += NGT) { const int n = i / LK, k = i % LK; float v = 0.f;
        if (n < 512) { if (k < 64) v = A.w_decay_up[k * BW + n]; }
        else if (n < 1024) { if (k >= 64 && k < 128) v = A.w_iclr_up[(k - 64) * BW + (n - 512)]; }
        else { if (k >= 128 && k < 288) v = A.w_gate_up[(k - 128) * BW + (n - 1024)]; }
        wl[i] = (bf16)f2bf(v); }
}

DI void p1_h1(const Frame& F0, ARef A, bf16* H1) {
    Frame F = F0; F.tid = opq_tid(F0.wave); F.lane = F.tid & 63; F.wave = __builtin_amdgcn_readfirstlane(F.tid >> 6); F.gw = F.wg * NWAVES + F.wave;
    const float* mod = (const float*)(A.ws + WS_MOD);
    for (int n = F.gw; n < NTOK; n += F.NGW) {
        const int b = n >> 13;
        const f32x4* xr = (const f32x4*)(A.x + (size_t)n * D) + F.lane;
        f32x4 v[4]; float s = 0.f;
#pragma unroll
        for (int j = 0; j < 4; ++j) { v[j] = xr[64 * j]; s += (v[j][0] * v[j][0] + v[j][1] * v[j][1]) + (v[j][2] * v[j][2] + v[j][3] * v[j][3]); }
        const float inv = rsqrtf(wave_sum(s) * (1.0f / D) + NORM_EPS);
        u32x2* o = (u32x2*)(H1 + (size_t)n * D) + F.lane;
#pragma unroll
        for (int j = 0; j < 4; ++j) { const int k = 4 * F.lane + 256 * j;
            const f32x4 g = *(const f32x4*)(A.gains + k), sh = *(const f32x4*)(mod + b * 6144 + k), sc = *(const f32x4*)(mod + b * 6144 + D + k);
            f32x4 h;
#pragma unroll
            for (int q = 0; q < 4; ++q) h[q] = (v[j][q] * inv) * g[q] * (1.0f + sc[q]) + sh[q];
            u32x2 w; w.x = pk2(h[0], h[1]); w.y = pk2(h[2], h[3]); o[64 * j] = w; }
    }
}

DI void p3_attn(const Frame& F0, const bf16* QB, const bf16* KB, const bf16* VT, bf16* YSB) {
    Frame F = F0; F.tid = opq_tid(F0.wave); F.lane = F.tid & 63; F.wave = __builtin_amdgcn_readfirstlane(F.tid >> 6); F.gw = F.wg * NWAVES + F.wave;
    const int lane = F.lane, r = lane & 31, hh = lane >> 5;
    bf16x8 tri[2];
#pragma unroll
    for (int s = 0; s < 2; ++s)
#pragma unroll
        for (int e = 0; e < 8; ++e) tri[s][e] = (16 * s + 8 * (e >> 2) + 4 * hh + (e & 3)) > r ? (short)0x3F80 : (short)0;
    for (int u = F.gw; u < NB * NH * (SEQ / 32); u += F.NGW) {
        const int bh = u >> 8, qt = u & 255, b = bh >> 3, h = bh & 7;
        const bf16* qp = QB + (size_t)(b * SEQ + qt * 32 + r) * BW + h * HD + 8 * hh;
        bf16x8 qf[4];
#pragma unroll
        for (int ks = 0; ks < 4; ++ks) qf[ks] = *(const bf16x8*)(qp + 16 * ks);
        f32x16 o0, o1;
#pragma unroll
        for (int i = 0; i < 16; ++i) { o0[i] = 0.f; o1[i] = 0.f; }
        float L = 0.f;
        bf16x8 kf[4]; s16x4 vlo[2][2], vhi[2][2];
#define ATT_LOAD(KT, KF, VLO, VHI) do { const bf16* kp_ = KB + (size_t)(b * SEQ + (KT) * 32 + r) * BW + h * HD + 8 * hh; \
            _Pragma("unroll") for (int ks = 0; ks < 4; ++ks) KF[ks] = *(const bf16x8*)(kp_ + 16 * ks); \
            const bf16* vp_ = VT + ((size_t)(bh * HD + r)) * SEQ + (KT) * 32 + 4 * hh; \
            _Pragma("unroll") for (int mb = 0; mb < 2; ++mb) _Pragma("unroll") for (int ks = 0; ks < 2; ++ks) { VLO[mb][ks] = *(const s16x4*)(vp_ + (size_t)mb * 32 * SEQ + 16 * ks); VHI[mb][ks] = *(const s16x4*)(vp_ + (size_t)mb * 32 * SEQ + 16 * ks + 8); } } while (0)
        ATT_LOAD(qt, kf, vlo, vhi);
        for (int kt = qt; kt >= 0; --kt) {
            bf16x8 kfn[4]; s16x4 vlon[2][2], vhin[2][2];
            { const int ktn = kt > 0 ? kt - 1 : 0; ATT_LOAD(ktn, kfn, vlon, vhin); }
            f32x16 z;
#pragma unroll
            for (int i = 0; i < 16; ++i) z[i] = 0.f;
#pragma unroll
            for (int ks = 0; ks < 4; ++ks) z = MFMA32(kf[ks], qf[ks], z);
            const bool diag = (kt == qt);
            float lk[16], lo[16], tot = 0.f;
#pragma unroll
            for (int i = 0; i < 16; ++i) { const bool valid = !diag || (crow(i, hh) < r);
                const float sp = fsoftplus(z[i]); lk[i] = valid ? -sp : 0.0f; z[i] = valid ? z[i] - sp : -1.0e30f;
                tot += lk[i];
                const float hi = bflo(f2bf(lk[i])); lo[i] = lk[i] - hi; lk[i] = hi; }
            tot += shfl_xor_l(tot, 32, lane);
            f32x16 lat;
#pragma unroll
            for (int i = 0; i < 16; ++i) lat[i] = L;
#pragma unroll
            for (int s = 0; s < 2; ++s) {
                lat = MFMA32(tri[s], pack8v(lk[8 * s], lk[8 * s + 1], lk[8 * s + 2], lk[8 * s + 3], lk[8 * s + 4], lk[8 * s + 5], lk[8 * s + 6], lk[8 * s + 7]), lat);
                lat = MFMA32(tri[s], pack8v(lo[8 * s], lo[8 * s + 1], lo[8 * s + 2], lo[8 * s + 3], lo[8 * s + 4], lo[8 * s + 5], lo[8 * s + 6], lo[8 * s + 7]), lat); }
            float at[16];
#pragma unroll
            for (int i = 0; i < 16; ++i) at[i] = fexp(z[i] + lat[i]);
#pragma unroll
            for (int s = 0; s < 2; ++s) { const bf16x8 ab = pack8v(at[8 * s], at[8 * s + 1], at[8 * s + 2], at[8 * s + 3], at[8 * s + 4], at[8 * s + 5], at[8 * s + 6], at[8 * s + 7]);
                bf16x8 va, vb;
#pragma unroll
                for (int e = 0; e < 4; ++e) { va[e] = vlo[0][s][e]; va[4 + e] = vhi[0][s][e]; vb[e] = vlo[1][s][e]; vb[4 + e] = vhi[1][s][e]; }
                o0 = MFMA32(va, ab, o0); o1 = MFMA32(vb, ab, o1); }
            L += tot;
            if (__all(L < SB_STOP)) break;
#pragma unroll
            for (int ks = 0; ks < 4; ++ks) kf[ks] = kfn[ks];
#pragma unroll
            for (int mb = 0; mb < 2; ++mb)
#pragma unroll
                for (int ks = 0; ks < 2; ++ks) { vlo[mb][ks] = vlon[mb][ks]; vhi[mb][ks] = vhin[mb][ks]; }
        }
#undef ATT_LOAD
        bf16* op = YSB + (size_t)(b * SEQ + qt * 32 + r) * BW + h * HD + 4 * hh;
#pragma unroll
        for (int g = 0; g < 4; ++g) { u32x2 w0, w1; w0.x = pk2(o0[4 * g], o0[4 * g + 1]); w0.y = pk2(o0[4 * g + 2], o0[4 * g + 3]); w1.x = pk2(o1[4 * g], o1[4 * g + 1]); w1.y = pk2(o1[4 * g + 2], o1[4 * g + 3]);
            *(u32x2*)(op + 8 * g) = w0; *(u32x2*)(op + 32 + 8 * g) = w1; }
    }
}

DI void p3_prep(const Frame& F0, ARef A, const bf16* RWRAW, const bf16* LORA, bf16* R, bf16* KS, bf16* V, bf16* KK, bf16* ALORA) {
    Frame F = F0; F.tid = opq_tid(F0.wave); F.lane = F.tid & 63; F.wave = __builtin_amdgcn_readfirstlane(F.tid >> 6); F.gw = F.wg * NWAVES + F.wave;
    const int lane = F.lane;
    f32x4 mu[3][2], kkc[2], mul[2];
#pragma unroll
    for (int part = 0; part < 3; ++part) { mu[part][0] = *(const f32x4*)(A.shift_mu + part * 512 + lane * 8); mu[part][1] = *(const f32x4*)(A.shift_mu + part * 512 + lane * 8 + 4); }
    kkc[0] = *(const f32x4*)(A.k_k + lane * 8); kkc[1] = *(const f32x4*)(A.k_k + lane * 8 + 4);
    const int lcol = lane < 36 ? lane * 8 : 0;
    mul[0] = *(const f32x4*)(A.shift_mu + 1536 + lcol); mul[1] = *(const f32x4*)(A.shift_mu + 1536 + lcol + 4);
    constexpr int RUN = 16;
    for (int run = F.gw; run < NTOK / RUN; run += F.NGW) {
        const int n0 = run * RUN;
        u32x4 prv[3], prl, cur[3], cul;
        const u32x4 z4 = {0u, 0u, 0u, 0u};
        if ((n0 & (SEQ - 1)) == 0) { prv[0] = z4; prv[1] = z4; prv[2] = z4; prl = z4; }
        else {
#pragma unroll
            for (int part = 0; part < 3; ++part) prv[part] = *(const u32x4*)(RWRAW + (size_t)(n0 - 1) * 1536 + part * 512 + lane * 8);
            prl = *(const u32x4*)(LORA + (size_t)(n0 - 1) * BW + lcol); }
#pragma unroll
        for (int part = 0; part < 3; ++part) cur[part] = *(const u32x4*)(RWRAW + (size_t)n0 * 1536 + part * 512 + lane * 8);
        cul = *(const u32x4*)(LORA + (size_t)n0 * BW + lcol);
        for (int i = 0; i < RUN; ++i) {
            const int n = n0 + i, nn = i + 1 < RUN ? n + 1 : n;
            u32x4 nxt[3], nxl;
#pragma unroll
            for (int part = 0; part < 3; ++part) nxt[part] = *(const u32x4*)(RWRAW + (size_t)nn * 1536 + part * 512 + lane * 8);
            nxl = *(const u32x4*)(LORA + (size_t)nn * BW + lcol);
            float xs[3][8];
#pragma unroll
            for (int part = 0; part < 3; ++part) { float p[8], q[8]; unpack8(cur[part], p); unpack8(prv[part], q);
#pragma unroll
                for (int j = 0; j < 4; ++j) { xs[part][j] = p[j] + mu[part][0][j] * (q[j] - p[j]); xs[part][4 + j] = p[4 + j] + mu[part][1][j] * (q[4 + j] - p[4 + j]); } }
            const size_t off = (size_t)n * BW + lane * 8;
            *(u32x4*)(R + off) = pack8(xs[0]); *(u32x4*)(KS + off) = pack8(xs[1]); *(u32x4*)(V + off) = pack8(xs[2]);
            float kk[8], ss = 0.f;
#pragma unroll
            for (int j = 0; j < 4; ++j) { kk[j] = xs[1][j] * kkc[0][j]; kk[4 + j] = xs[1][4 + j] * kkc[1][j]; }
#pragma unroll
            for (int j = 0; j < 8; ++j) ss += kk[j] * kk[j];
            ss += shfl_xor_l(ss, 1, lane); ss += shfl_xor_l(ss, 2, lane); ss += shfl_xor_l(ss, 4, lane);
            const float rn = 1.0f / fmaxf(sqrtf(ss), L2_EPS);
#pragma unroll
            for (int j = 0; j < 8; ++j) kk[j] *= rn;
            *(u32x4*)(KK + off) = pack8(kk);
            if (lane < 48) { float a[8];
                if (lane < 36) { float p[8], q[8]; unpack8(cul, p); unpack8(prl, q);
#pragma unroll
                    for (int j = 0; j < 8; ++j) { const float m = j < 4 ? mul[0][j & 3] : mul[1][j & 3]; const float v = p[j] + m * (q[j] - p[j]);
                        a[j] = lane < 8 ? (1.0f - 2.0f * frcp(fexp(2.0f * v) + 1.0f)) : (lane < 16 ? v : fsigmoid(v)); }
                } else {
#pragma unroll
                    for (int j = 0; j < 8; ++j) a[j] = 0.f; }
                *(u32x4*)(ALORA + (size_t)n * LK + lane * 8) = pack8(a); }
#pragma unroll
            for (int part = 0; part < 3; ++part) { prv[part] = cur[part]; cur[part] = nxt[part]; }
            prl = cul; cul = nxl;
        }
    }
}

DI void p4_lora(const Frame& F0, ARef A, const bf16* ALORA, const bf16* WL, bf16* E, bf16* KS, bf16* Bo, bf16* GG, const bf16* KK, const bf16* R, float* BON) {
    Frame F = F0; F.tid = opq_tid(F0.wave); F.lane = F.tid & 63; F.wave = __builtin_amdgcn_readfirstlane(F.tid >> 6); F.gw = F.wg * NWAVES + F.wave;
    const int lane = F.lane, r = lane & 31, hh = lane >> 5;
    for (int u = F.gw; u < 2 * (NTOK / 32); u += F.NGW) {
        const int n0 = (u >> 1) * 32, par = u & 1;
        bf16x8 tf[18];
#pragma unroll
        for (int ks = 0; ks < 18; ++ks) tf[ks] = *(const bf16x8*)(ALORA + (size_t)(n0 + r) * LK + 16 * ks + 8 * hh);
        const unsigned orow = (unsigned)(n0 + r) * BW + 4 * hh;
#define LORA_BLOCK(KS0, NKS, CB, BODY) { const int c0_ = 32 * ((CB) & 15); f32x16 acc_; \
            _Pragma("unroll") for (int q = 0; q < 16; ++q) acc_[q] = 0.f; \
            _Pragma("unroll") for (int ks = 0; ks < (NKS); ++ks) acc_ = MFMA32(*(const bf16x8*)(WL + (size_t)(32 * (CB) + r) * LK + 16 * ((KS0) + ks) + 8 * hh), tf[(KS0) + ks], acc_); \
            BODY }
        for (int i = 0; i < 8; ++i) { const int cb = 4 * (i >> 1) + 2 * par + (i & 1);
            LORA_BLOCK(0, 4, cb, {
                _Pragma("unroll") for (int g = 0; g < 4; ++g) { const f32x4 w0v = *(const f32x4*)(A.w0 + c0_ + 8 * g + 4 * hh); float e4[4];
                    _Pragma("unroll") for (int j = 0; j < 4; ++j) { const float v = acc_[4 * g + j] + w0v[j]; e4[j] = fexp(-fsoftplus(-v) - 0.5f); }
                    u32x2 w; w.x = pk2(e4[0], e4[1]); w.y = pk2(e4[2], e4[3]); *(u32x2*)(E + orow + c0_ + 8 * g) = w; } }) }
        float bsum = 0.f;
        for (int i = 0; i < 8; ++i) { const int cb = 16 + 4 * (i >> 1) + 2 * par + (i & 1);
            LORA_BLOCK(4, 4, cb, {
                _Pragma("unroll") for (int g = 0; g < 4; ++g) { const f32x4 a0v = *(const f32x4*)(A.a0 + c0_ + 8 * g + 4 * hh); const f32x4 kav = *(const f32x4*)(A.k_a + c0_ + 8 * g + 4 * hh);
                    const unsigned o = orow + c0_ + 8 * g; const u32x2 kw = *(const u32x2*)(KS + o); const u32x2 qw = *(const u32x2*)(KK + o); const u32x2 rw = *(const u32x2*)(R + o); const f32x4 rkv = *(const f32x4*)(A.r_k + c0_ + 8 * g + 4 * hh);
                    float ksv[4]; float kkv[4]; float kp[4]; float bb[4]; ksv[0] = bflo(kw.x); ksv[1] = bfhi(kw.x); ksv[2] = bflo(kw.y); ksv[3] = bfhi(kw.y); kkv[0] = bflo(qw.x); kkv[1] = bfhi(qw.x); kkv[2] = bflo(qw.y); kkv[3] = bfhi(qw.y);
                    _Pragma("unroll") for (int j = 0; j < 4; ++j) { const float s0 = fsigmoid(acc_[4 * g + j] + a0v[j]); kp[j] = ksv[j] * (1.0f + (s0 - 1.0f) * kav[j]); bb[j] = kkv[j] * s0; }
                    bsum += (bflo(rw.x) * kp[0] * rkv[0] + bfhi(rw.x) * kp[1] * rkv[1]) + (bflo(rw.y) * kp[2] * rkv[2] + bfhi(rw.y) * kp[3] * rkv[3]);
                    u32x2 w1; u32x2 w2; w1.x = pk2(kp[0], kp[1]); w1.y = pk2(kp[2], kp[3]); w2.x = pk2(bb[0], bb[1]); w2.y = pk2(bb[2], bb[3]); *(u32x2*)(KS + o) = w1; *(u32x2*)(Bo + o) = w2; } })
            if (i & 1) { const float tot = bsum + shfl_xor_l(bsum, 32, lane); if (hh == 0) BON[(size_t)(n0 + r) * 8 + 2 * (i >> 1) + par] = tot; bsum = 0.f; } }
        for (int i = 0; i < 8; ++i) { const int cb = 32 + 4 * (i >> 1) + 2 * par + (i & 1);
            LORA_BLOCK(8, 10, cb, {
                _Pragma("unroll") for (int g = 0; g < 4; ++g) { u32x2 w; w.x = pk2(acc_[4 * g], acc_[4 * g + 1]); w.y = pk2(acc_[4 * g + 2], acc_[4 * g + 3]); *(u32x2*)(GG + orow + c0_ + 8 * g) = w; } }) }
#undef LORA_BLOCK
    }
}

DI void p6_chain(int task, int wave, LAS unsigned char* ring, const bf16* GT, const bf16* HT, bf16* SC) {
    const int lane = opq_tid(wave) & 63;
    const int bh = task >> 1, nb = task & 1;
    constexpr int RD = 6, SLOT = 12288;
    f32x16 X[2];
#pragma unroll
    for (int q = 0; q < 16; ++q) { X[0][q] = 0.f; X[1][q] = 0.f; }
    const char* gsrc = (const char*)(GT + (size_t)bh * NCH * 4096) + lane * 16;
    const char* hsrc = (const char*)(HT + (size_t)bh * NCH * 4096) + nb * 2048 + lane * 16;
#define CHAIN_DMA(cc) do { LAS unsigned char* sl_ = ring + ((cc) % RD) * SLOT; const char* g_ = gsrc + (size_t)(cc) * 8192; const char* h_ = hsrc + (size_t)(cc) * 8192; \
        _Pragma("unroll") for (int f = 0; f < 8; ++f) __builtin_amdgcn_global_load_lds((const unsigned*)(g_ + f * 1024), (LAS unsigned*)(sl_ + f * 1024), 16, 0, 0); \
        _Pragma("unroll") for (int kb = 0; kb < 2; ++kb) _Pragma("unroll") for (int j = 0; j < 2; ++j) \
            __builtin_amdgcn_global_load_lds((const unsigned*)(h_ + kb * 4096 + j * 1024), (LAS unsigned*)(sl_ + 8192 + (kb * 2 + j) * 1024), 16, 0, 0); } while (0)
#define CHAIN_READ(cc, HS, GS) do { const LAS unsigned char* sl_ = ring + ((cc) % RD) * SLOT; \
        _Pragma("unroll") for (int f = 0; f < 8; ++f) GS[f] = *(const LAS bf16x8*)(sl_ + f * 1024 + lane * 16); \
        _Pragma("unroll") for (int kb = 0; kb < 2; ++kb) _Pragma("unroll") for (int g = 0; g < 4; ++g) { const u32x2 w_ = *(const LAS u32x2*)(sl_ + 8192 + kb * 2048 + (g * 64 + lane) * 8); \
            HS[kb][4 * g] = bflo(w_.x); HS[kb][4 * g + 1] = bfhi(w_.x); HS[kb][4 * g + 2] = bflo(w_.y); HS[kb][4 * g + 3] = bfhi(w_.y); } } while (0)
#define CHAIN_STORE(cc) do { bf16* sc_ = SC + ((size_t)bh * NCH + (cc)) * 4096; \
        _Pragma("unroll") for (int jb = 0; jb < 2; ++jb) _Pragma("unroll") for (int g = 0; g < 4; ++g) { u32x2 w_; w_.x = pk2(X[jb][4 * g], X[jb][4 * g + 1]); w_.y = pk2(X[jb][4 * g + 2], X[jb][4 * g + 3]); \
            *(u32x2*)(sc_ + ((((jb * 2 + nb) * 4 + g) * 64) + lane) * 4) = w_; } } while (0)
#define CHAIN_STEP(HS, GS) do { bf16x8 xb_[2][2]; \
        _Pragma("unroll") for (int jb = 0; jb < 2; ++jb) _Pragma("unroll") for (int s = 0; s < 2; ++s) \
            xb_[jb][s] = pack8v(X[jb][8 * s], X[jb][8 * s + 1], X[jb][8 * s + 2], X[jb][8 * s + 3], X[jb][8 * s + 4], X[jb][8 * s + 5], X[jb][8 * s + 6], X[jb][8 * s + 7]); \
        X[0] = HS[0]; X[1] = HS[1]; \
        _Pragma("unroll") for (int kb = 0; kb < 2; ++kb) _Pragma("unroll") for (int jb = 0; jb < 2; ++jb) _Pragma("unroll") for (int s = 0; s < 2; ++s) X[kb] = MFMA32(GS[kb * 4 + jb * 2 + s], xb_[jb][s], X[kb]); } while (0)
    for (int cc = 0; cc < RD; ++cc) CHAIN_DMA(cc);
    for (int c = 0; c < NCH - 1; ++c) {
        f32x16 Hc[2]; bf16x8 Gc[8];
        if (c + RD <= NCH - 1) asm volatile("s_waitcnt vmcnt(60)" ::: "memory"); else asm volatile("s_waitcnt vmcnt(0)" ::: "memory");
        CHAIN_READ(c, Hc, Gc);
        asm volatile("s_waitcnt lgkmcnt(0)" ::: "memory");
        if (c + RD < NCH - 1) CHAIN_DMA(c + RD);
        CHAIN_STORE(c);
        CHAIN_STEP(Hc, Gc);
    }
    CHAIN_STORE(NCH - 1);
    asm volatile("s_waitcnt vmcnt(0)" ::: "memory");
#undef CHAIN_DMA
#undef CHAIN_READ
#undef CHAIN_STORE
#undef CHAIN_STEP
}

DI void p6_moe_weights(const Frame& F0, ARef A, int wi, int NW) {
    Frame F = F0; F.tid = opq_tid(F0.wave); F.lane = F.tid & 63; F.wave = __builtin_amdgcn_readfirstlane(F.tid >> 6); F.gw = F.wg * NWAVES + F.wave;
    LAS float* scr = (LAS float*)(F.lds + F.wave * 20480);
    constexpr int I_UP = NE * 32 * 16, I_DN = NE * 32 * 8;
    for (int it = wi; it < I_UP + I_DN; it += NW) {
        if (it < I_UP) { const int e = it >> 9, g = (it >> 4) & 31, kb = it & 15; tr_item_up(A.w_up1, A.w_up3, (bf16*)(A.ws + WS_WUP), e, 64 * kb, 32 * g, scr, F.lane); }
        else { const int r = it - I_UP, e = r >> 8, g = (r >> 3) & 31, kb = r & 7;
            tr_item(A.w_down + (size_t)e * DE * D, D, DE, (bf16*)(A.ws + WS_WDN) + (size_t)e * 1024 * DE, 64 * kb, 32 * g, 32 * g, scr, F.lane); }
    }
}

DI float half_bcast_sum(float v, int hh) {
    v += DPP_SHR(v, 0x111); v += DPP_SHR(v, 0x112); v += DPP_SHR(v, 0x114); v += DPP_SHR(v, 0x118);
    v += __builtin_bit_cast(float, __builtin_amdgcn_update_dpp(0, __builtin_bit_cast(int, v), 0x142, 0xa, 0xf, false));
    const float lo = __builtin_bit_cast(float, __builtin_amdgcn_readlane(__builtin_bit_cast(int, v), 31)), hi = __builtin_bit_cast(float, __builtin_amdgcn_readlane(__builtin_bit_cast(int, v), 63));
    return hh ? hi : lo; }
DI void p7_mfma(const Frame& F0, ARef A, const bf16* SC, const bf16* Pn, const bf16* QOn, const bf16* V, const bf16* GG, const float* BON, bf16* YRW) {
    Frame F = F0; F.tid = opq_tid(F0.wave); F.lane = F.tid & 63; F.wave = __builtin_amdgcn_readfirstlane(F.tid >> 6); F.gw = F.wg * NWAVES + F.wave;
    const int lane = F.lane, r = lane & 31, hh = lane >> 5;
    for (int cid = F.gw; cid < NCHUNK; cid += F.NGW) {
        const int bh = cid >> NCH_LOG, c = cid & (NCH - 1), b = bh >> 3, h = bh & 7;
        const unsigned n0 = (unsigned)b * SEQ + (unsigned)c * CH; const int col0 = h * HD;
        const bf16* sc = SC + (size_t)cid * 4096; const bf16* pn = Pn + (size_t)cid * 4096; const bf16* qn = QOn + (size_t)cid * 4096;
        bf16x8 Sf[2][2][2], Pf[2][2][2];
#pragma unroll
        for (int jb = 0; jb < 2; ++jb)
#pragma unroll
            for (int xb = 0; xb < 2; ++xb)
#pragma unroll
                for (int s = 0; s < 2; ++s) { const s16x4 lo = *(const s16x4*)(sc + ((((jb * 2 + xb) * 4 + 2 * s) * 64) + lane) * 4), hi = *(const s16x4*)(sc + ((((jb * 2 + xb) * 4 + 2 * s + 1) * 64) + lane) * 4);
#pragma unroll
                    for (int e = 0; e < 4; ++e) { Sf[jb][xb][s][e] = lo[e]; Sf[jb][xb][s][4 + e] = hi[e]; }
                    Pf[jb][xb][s] = *(const bf16x8*)(pn + ((((jb * 2 + xb) * 2 + s) * 64) + lane) * 8); }
        f32x16 Z[2][2];
#pragma unroll
        for (int tb = 0; tb < 2; ++tb)
#pragma unroll
            for (int nb = 0; nb < 2; ++nb) {
#pragma unroll
                for (int g = 0; g < 4; ++g) { const u32x2 w = *(const u32x2*)(qn + ((((tb * 2 + nb) * 4 + g) * 64) + lane) * 4);
                    Z[tb][nb][4 * g] = bflo(w.x); Z[tb][nb][4 * g + 1] = bfhi(w.x); Z[tb][nb][4 * g + 2] = bflo(w.y); Z[tb][nb][4 * g + 3] = bfhi(w.y); }
#pragma unroll
                for (int jb = 0; jb < 2; ++jb)
#pragma unroll
                    for (int s = 0; s < 2; ++s) Z[tb][nb] = MFMA32(Pf[jb][tb][s], Sf[jb][nb][s], Z[tb][nb]); }
        float lw[2], lb[2];
#pragma unroll
        for (int nb = 0; nb < 2; ++nb) { lw[nb] = A.lnx_w[col0 + 32 * nb + r]; lb[nb] = A.lnx_b[col0 + 32 * nb + r]; }
#pragma unroll
        for (int tb = 0; tb < 2; ++tb)
#pragma unroll
            for (int q = 0; q < 16; ++q) {
                const unsigned tokrow = n0 + 32 * tb + 4 * hh + (q & 3) + 8 * (q >> 2);
                const float mean = half_bcast_sum(Z[tb][0][q] + Z[tb][1][q], hh) * (1.0f / 64.0f);
                const float d0 = Z[tb][0][q] - mean, d1 = Z[tb][1][q] - mean;
                const float rs = rsqrtf(half_bcast_sum(d0 * d0 + d1 * d1, hh) * (1.0f / 64.0f) + GN_EPS);
                const float bon = BON[(size_t)tokrow * 8 + h];
                const unsigned o0 = tokrow * BW + col0 + r;
                YRW[o0] = (bf16)f2bf((d0 * rs * lw[0] + lb[0] + bon * bf2f(V[o0])) * bf2f(GG[o0]));
                YRW[o0 + 32] = (bf16)f2bf((d1 * rs * lw[1] + lb[1] + bon * bf2f(V[o0 + 32])) * bf2f(GG[o0 + 32]));
                if ((q & 3) == 3) __builtin_amdgcn_sched_barrier(0); }
    }
}

DI void p10_rows(const Frame& F0, ARef A, const bf16* Y1, bf16* H2) {
    Frame F = F0; F.tid = opq_tid(F0.wave); F.lane = F.tid & 63; F.wave = __builtin_amdgcn_readfirstlane(F.tid >> 6); F.gw = F.wg * NWAVES + F.wave;
    const int lane = F.lane;
    const float* mod = (const float*)(A.ws + WS_MOD);
    LAS float* rw = (LAS float*)F.lds;
    LAS int* hist = (LAS int*)(F.lds + 147456);
    { const float* src = (const float*)(A.ws + WS_RTW);
        for (int i = F.tid; i < 18 * D; i += NTHR) { const int op = i >> 10, k = i & (D - 1); typedef float f2_t __attribute__((ext_vector_type(2))); f2_t w; w.x = src[(2 * op) * D + k]; w.y = src[(2 * op + 1) * D + k]; *(LAS f2_t*)(rw + 2 * i) = w; } }
    i32x4* tok = (i32x4*)(A.ws + WS_TOK); int* cnt = (int*)(A.ws + WS_CNT);
    for (int tb = F.wg; tb < NTOK / 128; tb += F.G) {
        if (F.tid < 32) hist[F.tid] = 0;
        __syncthreads();
        for (int tl = F.wave; tl < 128; tl += NWAVES) {
            const int n = tb * 128 + tl, b = n >> 13;
            const f32x4* xr = (const f32x4*)(A.x + (size_t)n * D) + lane; const u32x2* yr = (const u32x2*)(Y1 + (size_t)n * D) + lane;
            f32x4 xv[4], yv[4]; float s = 0.f;
#pragma unroll
            for (int j = 0; j < 4; ++j) { xv[j] = xr[64 * j]; const u32x2 w = yr[64 * j]; yv[j][0] = bflo(w.x); yv[j][1] = bfhi(w.x); yv[j][2] = bflo(w.y); yv[j][3] = bfhi(w.y);
                s += (yv[j][0] * yv[j][0] + yv[j][1] * yv[j][1]) + (yv[j][2] * yv[j][2] + yv[j][3] * yv[j][3]); }
            const float inv1 = rsqrtf(wave_sum(s) * (1.0f / D) + NORM_EPS);
            float s2 = 0.f;
#pragma unroll
            for (int j = 0; j < 4; ++j) { const int k = 4 * lane + 256 * j;
                const f32x4 g1 = *(const f32x4*)(A.gains + D + k), gt = *(const f32x4*)(mod + b * 6144 + 2 * D + k);
#pragma unroll
                for (int q = 0; q < 4; ++q) { xv[j][q] = xv[j][q] + gt[q] * ((yv[j][q] * inv1) * g1[q]); s2 += xv[j][q] * xv[j][q]; }
                u32x2 xw; xw.x = pk2(xv[j][0], xv[j][1]); xw.y = pk2(xv[j][2], xv[j][3]); *((u32x2*)(A.ws + WS_X1 + (size_t)n * D * 2) + lane + 64 * j) = xw; }
            const float inv2 = rsqrtf(wave_sum(s2) * (1.0f / D) + NORM_EPS);
            f32x4 hv[4];
#pragma unroll
            for (int j = 0; j < 4; ++j) { const int k = 4 * lane + 256 * j;
                const f32x4 g2 = *(const f32x4*)(A.gains + 2 * D + k), sh = *(const f32x4*)(mod + b * 6144 + 3 * D + k), sc = *(const f32x4*)(mod + b * 6144 + 4 * D + k);
#pragma unroll
                for (int q = 0; q < 4; ++q) hv[j][q] = (xv[j][q] * inv2) * g2[q] * (1.0f + sc[q]) + sh[q];
                u32x2 w; w.x = pk2(hv[j][0], hv[j][1]); w.y = pk2(hv[j][2], hv[j][3]); *((u32x2*)(H2 + (size_t)n * D) + lane + 64 * j) = w; }
            typedef float f2_t __attribute__((ext_vector_type(2)));
#define P10_PAIR(OUT0, OUT1, WBASE) do { f2_t a = {0.f, 0.f}; \
                _Pragma("unroll") for (int j = 0; j < 4; ++j) { const LAS f32x4* wp = (const LAS f32x4*)((WBASE) + (4 * lane + 256 * j) * 2); const f32x4 wA = wp[0], wB = wp[1]; \
                    a += (f2_t){hv[j][0], hv[j][0]} * (f2_t){wA[0], wA[1]}; a += (f2_t){hv[j][1], hv[j][1]} * (f2_t){wA[2], wA[3]}; \
                    a += (f2_t){hv[j][2], hv[j][2]} * (f2_t){wB[0], wB[1]}; a += (f2_t){hv[j][3], hv[j][3]} * (f2_t){wB[2], wB[3]}; } \
                OUT0 = wave_sum(a.x); OUT1 = wave_sum(a.y); } while (0)
            float lg[4];
            P10_PAIR(lg[0], lg[1], rw); P10_PAIR(lg[2], lg[3], rw + 2 * D);
            int gs = 0; float gm = lg[0];
#pragma unroll
            for (int g = 1; g < 4; ++g) if (lg[g] > gm) { gm = lg[g]; gs = g; }
            gs = __builtin_amdgcn_readfirstlane(gs);
            float gsum = 0.f;
#pragma unroll
            for (int g = 0; g < 4; ++g) gsum += fexp(lg[g] - gm);
            const float gw = 1.0f / gsum;
            float el[8];
            { const LAS float* rwg = rw + (2 + 4 * gs) * (2 * D);
#pragma unroll
              for (int i = 0; i < 4; ++i) P10_PAIR(el[2 * i], el[2 * i + 1], rwg + i * 2 * D); }
#undef P10_PAIR
            int i0 = 0; float m0 = el[0];
#pragma unroll
            for (int e = 1; e < 8; ++e) if (el[e] > m0) { m0 = el[e]; i0 = e; }
            int i1 = -1; float m1 = -3.0e38f;
#pragma unroll
            for (int e = 0; e < 8; ++e) if (e != i0 && el[e] > m1) { m1 = el[e]; i1 = e; }
            const float t = fexp(m1 - m0), p0 = 1.0f / (1.0f + t), p1 = t * p0;
            const int e0 = gs * 8 + i0, e1 = gs * 8 + i1;
#if defined(CHECKS)
            if (lane == 0 && n == DBG_TOKEN) { float* dbg = (float*)(A.ws + WS_CTL + 32768) + 48; dbg[0] = lg[0]; dbg[1] = lg[1]; dbg[2] = lg[2]; dbg[3] = lg[3]; dbg[4] = gsum; dbg[5] = p0; dbg[6] = gw; dbg[7] = t; }
#endif
            if (lane == 0) { i32x4 rec; rec.x = e0 | (e1 << 8); rec.y = 0; rec.z = 0; rec.w = 0; tok[n] = rec;
                float* cwp = (float*)(A.ws + WS_CW) + 2 * n; cwp[0] = gw * p0; cwp[1] = gw * p1;
                atomicAdd((int*)&hist[e0], 1); atomicAdd((int*)&hist[e1], 1); }
        }
        __syncthreads();
        if (F.tid < 32) cnt[tb * 32 + F.tid] = hist[F.tid];
        __syncthreads();
    }
}

DI void p11_rank_gather(const Frame& F0, ARef A, const bf16* H2, bf16* HS) {
    Frame F = F0; F.tid = opq_tid(F0.wave); F.lane = F.tid & 63; F.wave = __builtin_amdgcn_readfirstlane(F.tid >> 6); F.gw = F.wg * NWAVES + F.wave;
    LAS int* base = (LAS int*)F.lds;
    LAS int* seg = base + 32;
    LAS int* el = base + 96;
    LAS int* pos = base + 352;
    i32x4* tok = (i32x4*)(A.ws + WS_TOK); const int* cnt = (const int*)(A.ws + WS_CNT); int* tile = (int*)(A.ws + WS_TILE);
    for (int tb = F.wg; tb < NTOK / 128; tb += F.G) {
        if (F.tid < 32) { int tot = 0, pre = 0;
            for (int t2 = 0; t2 < NTOK / 128; ++t2) { const int v = cnt[t2 * 32 + F.tid]; tot += v; if (t2 < tb) pre += v; }
            base[F.tid] = pre; seg[F.tid] = (tot + 255) & ~255; }
        if (F.tid >= 64 && F.tid < 64 + 128) { const i32x4 rec = tok[tb * 128 + (F.tid - 64)]; el[2 * (F.tid - 64)] = rec.x & 255; el[2 * (F.tid - 64) + 1] = (rec.x >> 8) & 255; }
        __syncthreads();
        if (F.tid == 0) { int acc = 0; for (int e = 0; e < 32; ++e) { const int sz = seg[e]; seg[e] = acc; acc += sz; } seg[32] = acc; }
        __syncthreads();
        if (F.tid < 32) { int p = seg[F.tid] + base[F.tid];
            for (int q = 0; q < 256; ++q) if (el[q] == F.tid) pos[q] = p++; }
        if (tb == 0 && F.tid >= 64 && F.tid < 64 + 32) { const int e = F.tid - 64;
            for (int t2 = seg[e] >> 8; t2 < (seg[e + 1] >> 8); ++t2) tile[t2] = e;
            if (e == 0) tile[MAXT] = seg[32] >> 8; }
        __syncthreads();
        if (F.tid < 128) { i32x4 rec = tok[tb * 128 + F.tid]; rec.x = pos[2 * F.tid]; rec.y = pos[2 * F.tid + 1]; tok[tb * 128 + F.tid] = rec; }
        for (int q = F.wave; q < 256; q += NWAVES) { const int n = tb * 128 + (q >> 1);
            const u32x4* src = (const u32x4*)(H2 + (size_t)n * D) + F.lane; u32x4* dst = (u32x4*)(HS + (size_t)pos[q] * D) + F.lane;
            dst[0] = src[0]; dst[64] = src[64]; }
        __syncthreads();
    }
}

DI void p14_final(const Frame& F0, ARef A, const bf16* YE) {
    Frame F = F0; F.tid = opq_tid(F0.wave); F.lane = F.tid & 63; F.wave = __builtin_amdgcn_readfirstlane(F.tid >> 6); F.gw = F.wg * NWAVES + F.wave;
    const int lane = F.lane;
    const float* mod = (const float*)(A.ws + WS_MOD); const i32x4* tok = (const i32x4*)(A.ws + WS_TOK);
    for (int n = F.gw; n < NTOK; n += F.NGW) {
        const int b = n >> 13; const i32x4 rec = tok[n];
        const float c0 = ((const float*)(A.ws + WS_CW))[2 * n], c1 = ((const float*)(A.ws + WS_CW))[2 * n + 1];
        const u32x2* y0 = (const u32x2*)(YE + (size_t)rec.x * D) + lane; const u32x2* y1 = (const u32x2*)(YE + (size_t)rec.y * D) + lane;
        f32x4 yv[4]; float s = 0.f;
#pragma unroll
        for (int j = 0; j < 4; ++j) { const u32x2 a = y0[64 * j], bq = y1[64 * j];
            yv[j][0] = c0 * bflo(a.x) + c1 * bflo(bq.x); yv[j][1] = c0 * bfhi(a.x) + c1 * bfhi(bq.x); yv[j][2] = c0 * bflo(a.y) + c1 * bflo(bq.y); yv[j][3] = c0 * bfhi(a.y) + c1 * bfhi(bq.y);
            s += (yv[j][0] * yv[j][0] + yv[j][1] * yv[j][1]) + (yv[j][2] * yv[j][2] + yv[j][3] * yv[j][3]); }
        const float inv = rsqrtf(wave_sum(s) * (1.0f / D) + NORM_EPS);
#pragma unroll
        for (int j = 0; j < 4; ++j) { const int k = 4 * lane + 256 * j;
            const f32x4 g3 = *(const f32x4*)(A.gains + 3 * D + k), gt = *(const f32x4*)(mod + b * 6144 + 5 * D + k);
            const u32x2 xw = *((const u32x2*)(A.ws + WS_X1 + (size_t)n * D * 2) + lane + 64 * j); f32x4 xv = {bflo(xw.x), bfhi(xw.x), bflo(xw.y), bfhi(xw.y)};
#pragma unroll
            for (int q = 0; q < 4; ++q) xv[q] = xv[q] + gt[q] * ((yv[j][q] * inv) * g3[q]);
            *((f32x4*)(A.out + (size_t)n * D) + lane + 64 * j) = xv; }
    }
}

DI bf16x8 pk_tile(const f32x16& x, const int s) { return pack8v(x[8 * s], x[8 * s + 1], x[8 * s + 2], x[8 * s + 3], x[8 * s + 4], x[8 * s + 5], x[8 * s + 6], x[8 * s + 7]); }
constexpr int FS = 72;
DI bf16x8 rd_frag(const LAS bf16* buf, int tb, int cb, int s, int r, int hh) {
    const LAS bf16* p = buf + (32 * cb + r) * FS + 32 * tb + 16 * s + 4 * hh;
    const s16x4 lo = *(const LAS s16x4*)p, hi = *(const LAS s16x4*)(p + 8); bf16x8 f;
#pragma unroll
    for (int e = 0; e < 4; ++e) { f[e] = lo[e]; f[4 + e] = hi[e]; }
    return f; }
DI void wr_tile_ft(LAS bf16* buf, const f32x16& x, int tb, int cb, int r, int hh) {
#pragma unroll
    for (int g = 0; g < 4; ++g) { u32x2 w; w.x = pk2(x[4 * g], x[4 * g + 1]); w.y = pk2(x[4 * g + 2], x[4 * g + 3]); *(LAS u32x2*)(buf + (32 * cb + r) * FS + 32 * tb + 8 * g + 4 * hh) = w; } }
DI void wr_l_ft(LAS bf16* buf, const float (&x)[64], int lane) {
#pragma unroll
    for (int t8 = 0; t8 < 8; ++t8) { u32x4 w; w.x = pk2(x[8 * t8], x[8 * t8 + 1]); w.y = pk2(x[8 * t8 + 2], x[8 * t8 + 3]); w.z = pk2(x[8 * t8 + 4], x[8 * t8 + 5]); w.w = pk2(x[8 * t8 + 6], x[8 * t8 + 7]);
        *(LAS u32x4*)(buf + lane * FS + 8 * t8) = w; } }

#if defined(STAMPS)
#define P5STAMP(k) do { p5ts[k] = __builtin_amdgcn_s_memrealtime(); } while (0)
#else
#define P5STAMP(k) do { } while (0)
#endif
DI void p5_mfma(unsigned char* F0_ws, const Frame& F0, const bf16* R, const bf16* KP, const bf16* V, const bf16* KK, const bf16* Bv, const bf16* Ev, bf16* P, bf16* QO, bf16* GT, bf16* HT) {
    Frame F = F0; F.tid = opq_tid(F0.wave); F.lane = F.tid & 63; F.wave = __builtin_amdgcn_readfirstlane(F.tid >> 6); F.gw = F.wg * NWAVES + F.wave;
    const int lane = F.lane, r = lane & 31, hh = lane >> 5;
    LAS unsigned char* wl = F.lds + F.wave * 20480;
    LAS bf16* buf0 = (LAS bf16*)wl; LAS bf16* buf1 = (LAS bf16*)(wl + 9216);
    LAS float* LT = (LAS float*)wl;
    LAS float* LC = (LAS float*)(wl + 18432);
    for (int cid = F.gw; cid < NCHUNK; cid += F.NGW) {
        const int bh = cid >> NCH_LOG, c = cid & (NCH - 1), b = bh >> 3, h = bh & 7;
        const unsigned n0 = (unsigned)b * SEQ + (unsigned)c * CH, col0 = (unsigned)h * HD;
        int ln = lane; asm volatile("" : "+v"(ln));
#if defined(STAMPS)
        unsigned long long p5ts[10];
#endif
        const int rm = ln & 31, hm = ln >> 5;
        const bf16 *R0_ = R, *KP0_ = KP, *V0_ = V, *KK0_ = KK, *Bv0_ = Bv, *Ev0_ = Ev; bf16 *P0_ = P, *QO0_ = QO;
        asm volatile("" : "+s"(R0_), "+s"(KP0_), "+s"(V0_), "+s"(KK0_), "+s"(Bv0_), "+s"(Ev0_), "+s"(P0_), "+s"(QO0_));
        const GAS char *R_ = (const GAS char*)R0_, *KP_ = (const GAS char*)KP0_, *V_ = (const GAS char*)V0_, *KK_ = (const GAS char*)KK0_, *Bv_ = (const GAS char*)Bv0_, *Ev_ = (const GAS char*)Ev0_;
        GAS char *P_ = (GAS char*)P0_, *QO_ = (GAS char*)QO0_;
        const unsigned nb0 = n0 * BW + col0;
        const unsigned vL = (nb0 + (unsigned)ln) * 2u, vT = (nb0 + (unsigned)rm * BW + 4u * hm) * 2u, vC = (nb0 + 4u * hm * BW + (unsigned)rm) * 2u, vG = (4u * hm * 64 + (unsigned)rm) * 2u;
#define OADD(v, c) ({ unsigned o_; asm volatile("v_add_u32_e32 %0, %1, %2" : "=v"(o_) : "n"((int)(c)), "v"(v)); o_; })
#define LD16(arr, off) (*(const GAS bf16*)((arr) + (off)))
#define XL(arr, t) LD16(arr, OADD(vL, (t) * BW * 2))
#define ROWQ(q) (((q) & 3) + 8 * ((q) >> 2))
        P5STAMP(0);
        u32x2 raw[2][5][4];
#define LOAD_TILE(BUF, FB, TB) do { _Pragma("unroll") for (int g = 0; g < 4; ++g) { const unsigned ot_ = OADD(vT, (32 * (TB) * BW + 32 * (FB) + 8 * g) * 2); \
            raw[BUF][0][g] = *(const GAS u32x2*)(Ev_ + ot_); raw[BUF][1][g] = *(const GAS u32x2*)(KK_ + ot_); raw[BUF][2][g] = *(const GAS u32x2*)(R_ + ot_); \
            raw[BUF][3][g] = *(const GAS u32x2*)(Bv_ + ot_); raw[BUF][4][g] = *(const GAS u32x2*)(KP_ + ot_); } } while (0)
        LOAD_TILE(0, 0, 0);
        {   float run = 0.f;
#pragma unroll
            for (int t = 0; t < 64; ++t) { run -= bf2f(XL(Ev_, t)); LT[ln * 65 + t] = run; } }
        wave_lds_fence();
        P5STAMP(1);
        bf16x8 Ap[2][2][2], Rp[2][2][2], Bp[2][2][2], Kp[2][2][2];
#pragma unroll
        for (int ti = 0; ti < 4; ++ti) { const int fb = ti >> 1, tb = ti & 1;
            if (ti < 3) LOAD_TILE((ti + 1) & 1, (ti + 1) >> 1, (ti + 1) & 1);
#pragma unroll
            for (int s = 0; s < 2; ++s) {
                float a8[8], r8[8], b8[8], k8[8];
#pragma unroll
                for (int g2 = 0; g2 < 2; ++g2) { const int g = 2 * s + g2;
                    const u32x2 ew = raw[ti & 1][0][g], aw = raw[ti & 1][1][g], rw = raw[ti & 1][2][g], bw = raw[ti & 1][3][g], kw = raw[ti & 1][4][g];
                    const float e4[4] = {bflo(ew.x), bfhi(ew.x), bflo(ew.y), bfhi(ew.y)}, av[4] = {bflo(aw.x), bfhi(aw.x), bflo(aw.y), bfhi(aw.y)}, rv[4] = {bflo(rw.x), bfhi(rw.x), bflo(rw.y), bfhi(rw.y)},
                                bv[4] = {bflo(bw.x), bfhi(bw.x), bflo(bw.y), bfhi(bw.y)}, kv[4] = {bflo(kw.x), bfhi(kw.x), bflo(kw.y), bfhi(kw.y)};
#pragma unroll
                    for (int j = 0; j < 4; ++j) { const float l = LT[(32 * fb + 8 * g + 4 * hm + j) * 65 + 32 * tb + rm];
                        const float eI = fexp(l), eX = fexp(l + e4[j]), eN = frcp(eI);
                        a8[4 * g2 + j] = -av[j] * eX; r8[4 * g2 + j] = rv[j] * eI; b8[4 * g2 + j] = bv[j] * eN; k8[4 * g2 + j] = kv[j] * eN; } }
                Ap[fb][tb][s] = __builtin_bit_cast(bf16x8, pack8(a8)); Rp[fb][tb][s] = __builtin_bit_cast(bf16x8, pack8(r8));
                Bp[fb][tb][s] = __builtin_bit_cast(bf16x8, pack8(b8)); Kp[fb][tb][s] = __builtin_bit_cast(bf16x8, pack8(k8)); }
            __builtin_amdgcn_sched_barrier(0); }
#undef LOAD_TILE
        wave_lds_fence();
        P5STAMP(2);
        bf16x8 Makp[2][2][2], Mbrp[2][2][2], Mkrp[2][2][2];
#define GRAM(XP, YP, STRICT, BODY) _Pragma("unroll") for (int ib = 0; ib < 2; ++ib) _Pragma("unroll") for (int tb = 0; tb < 2; ++tb) { f32x16 m_; \
            _Pragma("unroll") for (int q = 0; q < 16; ++q) m_[q] = 0.f; \
            _Pragma("unroll") for (int fb = 0; fb < 2; ++fb) _Pragma("unroll") for (int s = 0; s < 2; ++s) m_ = MFMA32(XP[fb][ib][s], YP[fb][tb][s], m_); \
            int rm_ = rm; asm volatile("" : "+v"(rm_)); \
            _Pragma("unroll") for (int q = 0; q < 16; ++q) { const int i_ = 32 * ib + crow(q, hm), t_ = 32 * tb + rm_; m_[q] = ((STRICT) ? (i_ < t_) : (i_ <= t_)) ? m_[q] : 0.f; } \
            BODY __builtin_amdgcn_sched_barrier(0); }
        GRAM(Bp, Ap, true, { wr_tile_ft(buf0, m_, ib, tb, rm, hm); })
        GRAM(Kp, Ap, true, { Makp[ib][tb][0] = pk_tile(m_, 0); Makp[ib][tb][1] = pk_tile(m_, 1); })
        GRAM(Bp, Rp, false, { Mbrp[ib][tb][0] = pk_tile(m_, 0); Mbrp[ib][tb][1] = pk_tile(m_, 1); })
        GRAM(Kp, Rp, false, { Mkrp[ib][tb][0] = pk_tile(m_, 0); Mkrp[ib][tb][1] = pk_tile(m_, 1); })
#undef GRAM
        P5STAMP(3);
        {   bf16x8 Vp[2][2][2];
#pragma unroll
            for (int ib = 0; ib < 2; ++ib)
#pragma unroll
                for (int vb = 0; vb < 2; ++vb) { f32x16 v_;
#pragma unroll
                    for (int q = 0; q < 16; ++q) v_[q] = bf2f(LD16(V_, OADD(vC, ((32 * ib + ROWQ(q)) * BW + 32 * vb) * 2)));
                    Vp[ib][vb][0] = pk_tile(v_, 0); Vp[ib][vb][1] = pk_tile(v_, 1); }
#pragma unroll
            for (int tb = 0; tb < 2; ++tb)
#pragma unroll
                for (int vb = 0; vb < 2; ++vb) { f32x16 w_;
#pragma unroll
                    for (int q = 0; q < 16; ++q) w_[q] = 0.f;
#pragma unroll
                    for (int ib = 0; ib < 2; ++ib)
#pragma unroll
                        for (int s = 0; s < 2; ++s) w_ = MFMA32(Makp[ib][tb][s], Vp[ib][vb][s], w_);
                    wr_tile_ft(buf1, w_, tb, vb, rm, hm); __builtin_amdgcn_sched_barrier(0); } }
        wave_lds_fence();
        P5STAMP(4);
#define SOLVE_BLK(X, T8) _Pragma("unroll") for (int jt = 0; jt < 8; ++jt) { const int t = 8 * (T8) + jt; \
            _Pragma("unroll") for (int gi = 0; gi <= (T8); ++gi) if (8 * gi < t) { float m8[8]; unpack8(*(const LAS u32x4*)(buf0 + t * FS + 8 * gi), m8); \
                _Pragma("unroll") for (int j = 0; j < 8; ++j) { if (8 * gi + j < t) X[t] += X[8 * gi + j] * m8[j]; } } \
            if (jt & 1) __builtin_amdgcn_sched_barrier(0); }
#define SOLVE(X) SOLVE_BLK(X, 0) SOLVE_BLK(X, 1) SOLVE_BLK(X, 2) SOLVE_BLK(X, 3) SOLVE_BLK(X, 4) SOLVE_BLK(X, 5) SOLVE_BLK(X, 6) SOLVE_BLK(X, 7)
        float lC;
        {   float xw[64];
#pragma unroll
            for (int t8 = 0; t8 < 8; ++t8) { float w8[8]; unpack8(*(const LAS u32x4*)(buf1 + ln * FS + 8 * t8), w8);
#pragma unroll
                for (int j = 0; j < 8; ++j) xw[8 * t8 + j] = w8[j]; }
            SOLVE(xw)
            wr_l_ft(buf1, xw, ln); }
        __builtin_amdgcn_sched_barrier(0);
        P5STAMP(5);
        {   float xa[64];
            {   float run = 0.f;
#pragma unroll
                for (int t = 0; t < 64; ++t) { xa[t] = -bf2f(XL(KK_, t)) * fexp(run); run -= bf2f(XL(Ev_, t)); if ((t & 31) == 31) __builtin_amdgcn_sched_barrier(0); }
                lC = run; LC[ln] = fexp(lC); }
            SOLVE(xa)
            wave_lds_fence();
            wr_l_ft(buf0, xa, ln); }
#undef SOLVE
#undef SOLVE_BLK
        wave_lds_fence();
        P5STAMP(6);
        bf16x8 ATp[2][2][2], W1p[2][2][2];
#pragma unroll
        for (int ib = 0; ib < 2; ++ib)
#pragma unroll
            for (int kb = 0; kb < 2; ++kb)
#pragma unroll
                for (int s = 0; s < 2; ++s) { ATp[ib][kb][s] = rd_frag(buf0, ib, kb, s, rm, hm); W1p[ib][kb][s] = rd_frag(buf1, ib, kb, s, rm, hm); }
        wave_lds_fence();
        {   float run = 0.f;
#pragma unroll
            for (int t8 = 0; t8 < 8; ++t8) { float r8[8];
#pragma unroll
                for (int j = 0; j < 8; ++j) { const int t = 8 * t8 + j; run -= bf2f(XL(Ev_, t)); r8[j] = bf2f(XL(R_, t)) * fexp(run); }
                *(LAS u32x4*)(buf0 + ln * FS + 8 * t8) = pack8(r8); if (t8 & 3) { } else { } if ((t8 & 3) == 3) __builtin_amdgcn_sched_barrier(0); } }
        wave_lds_fence();
        GAS char* pn = (GAS char*)(P0_ + (size_t)cid * 4096); GAS char* qn = (GAS char*)(QO0_ + (size_t)cid * 4096);
#pragma unroll
        for (int jb = 0; jb < 2; ++jb)
#pragma unroll
            for (int tb = 0; tb < 2; ++tb) { f32x16 p_;
#pragma unroll
                for (int q = 0; q < 16; ++q) p_[q] = bf2f(buf0[(32 * jb + crow(q, hm)) * FS + 32 * tb + rm]);
#pragma unroll
                for (int ib = 0; ib < 2; ++ib)
#pragma unroll
                    for (int s = 0; s < 2; ++s) p_ = MFMA32(ATp[ib][jb][s], Mbrp[ib][tb][s], p_);
#pragma unroll
                for (int s = 0; s < 2; ++s) *(GAS bf16x8*)(pn + ((((jb * 2 + tb) * 2 + s) * 64) + ln) * 16) = pk_tile(p_, s);
                __builtin_amdgcn_sched_barrier(0); }
        bf16x8 Vp[2][2][2];
#pragma unroll
        for (int ib = 0; ib < 2; ++ib)
#pragma unroll
            for (int vb = 0; vb < 2; ++vb) { f32x16 v_;
#pragma unroll
                for (int q = 0; q < 16; ++q) v_[q] = bf2f(LD16(V_, OADD(vC, ((32 * ib + ROWQ(q)) * BW + 32 * vb) * 2)));
                Vp[ib][vb][0] = pk_tile(v_, 0); Vp[ib][vb][1] = pk_tile(v_, 1); }
        P5STAMP(7);
#pragma unroll
        for (int tb = 0; tb < 2; ++tb)
#pragma unroll
            for (int vb = 0; vb < 2; ++vb) { f32x16 y_;
#pragma unroll
                for (int q = 0; q < 16; ++q) y_[q] = 0.f;
#pragma unroll
                for (int ib = 0; ib < 2; ++ib)
#pragma unroll
                    for (int s = 0; s < 2; ++s) { y_ = MFMA32(Mbrp[ib][tb][s], W1p[ib][vb][s], y_); y_ = MFMA32(Mkrp[ib][tb][s], Vp[ib][vb][s], y_); }
#pragma unroll
                for (int g = 0; g < 4; ++g) { u32x2 w; w.x = pk2(y_[4 * g], y_[4 * g + 1]); w.y = pk2(y_[4 * g + 2], y_[4 * g + 3]); *(GAS u32x2*)(qn + ((((tb * 2 + vb) * 4 + g) * 64) + ln) * 8) = w; }
                __builtin_amdgcn_sched_barrier(0); }
        P5STAMP(8);
        wave_lds_fence();
        {   float run = 0.f;
#pragma unroll
            for (int t8 = 0; t8 < 8; ++t8) { float b8[8], k8[8];
#pragma unroll
                for (int j = 0; j < 8; ++j) { const int t = 8 * t8 + j; run -= bf2f(XL(Ev_, t)); const float sc = fexp(lC - run); b8[j] = bf2f(XL(Bv_, t)) * sc; k8[j] = bf2f(XL(KP_, t)) * sc; }
                *(LAS u32x4*)(buf0 + ln * FS + 8 * t8) = pack8(b8); *(LAS u32x4*)(buf1 + ln * FS + 8 * t8) = pack8(k8); if ((t8 & 3) == 3) __builtin_amdgcn_sched_barrier(0); } }
        wave_lds_fence();
        bf16x8 Bh[2][2][2];
#pragma unroll
        for (int tb = 0; tb < 2; ++tb)
#pragma unroll
            for (int kb = 0; kb < 2; ++kb)
#pragma unroll
                for (int s = 0; s < 2; ++s) Bh[tb][kb][s] = rd_frag(buf0, tb, kb, s, rm, hm);
        GAS char* gt = (GAS char*)(GT + (size_t)cid * 4096); GAS char* ht = (GAS char*)(HT + (size_t)cid * 4096);
#pragma unroll
        for (int kb = 0; kb < 2; ++kb)
#pragma unroll
            for (int jb = 0; jb < 2; ++jb) { f32x16 g_;
                const float dg = LC[32 * kb + rm];
#pragma unroll
                for (int q = 0; q < 16; ++q) g_[q] = (kb == jb && crow(q, hm) == rm) ? dg : 0.f;
#pragma unroll
                for (int tb = 0; tb < 2; ++tb)
#pragma unroll
                    for (int s = 0; s < 2; ++s) g_ = MFMA32(ATp[tb][jb][s], Bh[tb][kb][s], g_);
#pragma unroll
                for (int s = 0; s < 2; ++s) *(GAS bf16x8*)(gt + ((kb * 4 + jb * 2 + s) * 64 + ln) * 16) = pk_tile(g_, s);
                __builtin_amdgcn_sched_barrier(0); }
        {   bf16x8 Kh[2][2][2];
#pragma unroll
            for (int tb = 0; tb < 2; ++tb)
#pragma unroll
                for (int kb = 0; kb < 2; ++kb)
#pragma unroll
                    for (int s = 0; s < 2; ++s) Kh[tb][kb][s] = rd_frag(buf1, tb, kb, s, rm, hm);
#pragma unroll
            for (int kb = 0; kb < 2; ++kb)
#pragma unroll
                for (int vb = 0; vb < 2; ++vb) { f32x16 h_;
#pragma unroll
                    for (int q = 0; q < 16; ++q) h_[q] = 0.f;
#pragma unroll
                    for (int tb = 0; tb < 2; ++tb)
#pragma unroll
                        for (int s = 0; s < 2; ++s) { h_ = MFMA32(Bh[tb][kb][s], W1p[tb][vb][s], h_); h_ = MFMA32(Kh[tb][kb][s], Vp[tb][vb][s], h_); }
#pragma unroll
                    for (int g = 0; g < 4; ++g) { u32x2 w; w.x = pk2(h_[4 * g], h_[4 * g + 1]); w.y = pk2(h_[4 * g + 2], h_[4 * g + 3]); *(GAS u32x2*)(ht + ((((kb * 2 + vb) * 4 + g) * 64) + ln) * 8) = w; }
                    __builtin_amdgcn_sched_barrier(0); } }
        P5STAMP(9);
#if defined(STAMPS)
        if (F.gw == 0 && cid == 0 && lane == 0) { _Pragma("unroll") for (int k_ = 0; k_ < 10; ++k_) ((unsigned long long*)(F0_ws + WS_CTL + 49152))[32 + k_] = p5ts[k_]; }
#endif
        wave_lds_fence();
#undef XL
#undef OADD
#undef LD16
#undef ROWQ
    }
}

#if defined(CHECKS)
constexpr size_t WS_FLG = WS_CTL + 32768;
DI unsigned* chk_flags(unsigned char* ws) { return (unsigned*)(ws + WS_FLG); }
DI void chk(unsigned char* ws, int id, float got, float want, float rel, float ab) {
    const float d = fabsf(got - want), lim = rel * fmaxf(fabsf(got), fabsf(want)) + ab;
    if (!(d <= lim)) chk_flags(ws)[id] = 1u; }
DI unsigned hsh(unsigned a) { a ^= a >> 16; a *= 0x7feb352du; a ^= a >> 15; a *= 0x846ca68bu; a ^= a >> 16; return a; }
DI float bfr(float v) { return bflo(f2bf(v)); }
DI int scol_of(int n) { return n < 3360 ? n : (n < 3584 ? -1 : n - 224); }

DI void chk_p0(const Frame& F, ARef A) {
    unsigned char* ws = A.ws; const int lane = F.lane;
    const float* mod = (const float*)(ws + WS_MOD);
    for (int s = F.wave; s < 32; s += NWAVES) { const unsigned hh = hsh(1000 + s); const int b = hh & 3, o = (hh >> 2) % 6144; float a = 0.f;
        for (int k = lane; k < D; k += 64) { const float c = A.c[b * D + k]; a += (c / (1.0f + expf(-c))) * A.w_mod[(size_t)k * 6144 + o]; }
        a = wave_sum(a) + A.b_mod[o]; chk(ws, 10, mod[b * 6144 + o], a, 1e-3f, 1e-4f); }
    const bf16* wt = (const bf16*)(ws + WS_WIN);
    for (int s = 0; s < 8; ++s) { const unsigned hh = hsh(2000 + (F.wave * 8 + s) * 64 + lane); const int n = hh % NPAD, k = (hh >> 13) & 1023; const int sc = scol_of(n);
        const float want = sc >= 0 ? bfr(A.w_in[(size_t)k * IN_COLS + sc]) : 0.f; chk(ws, 11, bf2f(wt[(size_t)n * D + k]), want, 0.f, 0.f); }
    { const unsigned hh = hsh(3000 + F.wave * 64 + lane); const int n = hh & 1023, k = (hh >> 10) & 511, k2 = (hh >> 10) & 1023;
        chk(ws, 11, bf2f(((const bf16*)(ws + WS_WOSB))[n * BW + k]), bfr(A.w_o_sb[k * D + n]), 0.f, 0.f);
        chk(ws, 11, bf2f(((const bf16*)(ws + WS_WORW))[n * BW + k]), bfr(A.w_o_rw[k * D + n]), 0.f, 0.f);
        chk(ws, 11, bf2f(((const bf16*)(ws + WS_WOUT))[n * D + k2]), bfr(A.w_out[k2 * D + n]), 0.f, 0.f);
        const int o = hh % 36; chk(ws, 11, ((const float*)(ws + WS_RTW))[o * D + k2], o < 4 ? A.w_group[k2 * 4 + o] : A.w_router[k2 * NE + o - 4], 0.f, 0.f);
        const int nl = hh % 1536, kl = (hh >> 11) % LK; float v = 0.f;
        if (nl < 512) { if (kl < 64) v = A.w_decay_up[kl * BW + nl]; } else if (nl < 1024) { if (kl >= 64 && kl < 128) v = A.w_iclr_up[(kl - 64) * BW + nl - 512]; } else { if (kl >= 128 && kl < 288) v = A.w_gate_up[(kl - 128) * BW + nl - 1024]; }
        chk(ws, 11, bf2f(((const bf16*)(ws + WS_WL))[nl * LK + kl]), bfr(v), 0.f, 0.f); }
}
DI void chk_p1(const Frame& F, ARef A, const bf16* H1) {
    unsigned char* ws = A.ws; const int lane = F.lane; const float* mod = (const float*)(ws + WS_MOD);
    for (int s = F.wave; s < 16; s += NWAVES) { const int n = hsh(4000 + s) % NTOK, b = n >> 13; float ss = 0.f;
        for (int k = lane; k < D; k += 64) { const float v = A.x[(size_t)n * D + k]; ss += v * v; }
        const float inv = 1.0f / sqrtf(wave_sum(ss) / D + NORM_EPS);
        for (int k = lane; k < D; k += 64) { const float want = (A.x[(size_t)n * D + k] * inv) * A.gains[k] * (1.0f + mod[b * 6144 + D + k]) + mod[b * 6144 + k];
            chk(ws, 12, bf2f(H1[(size_t)n * D + k]), want, 0.01f, 0.01f); } }
}
DI float wdot(const bf16* arow, const float* W, int ldw, int col, int K, int lane) { float a = 0.f; for (int k = lane; k < K; k += 64) a += bf2f(arow[k]) * W[(size_t)k * ldw + col]; return wave_sum(a); }
DI void chk_p2(const Frame& F, ARef A, const bf16* H1) {
    unsigned char* ws = A.ws; const int lane = F.lane;
    for (int s = F.wave; s < 96; s += NWAVES) { const unsigned hh = hsh(5000 + s); const int n = hh % NTOK, region = s % 6; int col;
        const unsigned h2 = hsh(hh);
        float got, want; int id = 13 + region;
        if (region == 0) { col = h2 % 512; want = 0.125f * wdot(H1 + (size_t)n * D, A.w_in, IN_COLS, col, D, lane); got = bf2f(((const bf16*)(ws + WS_QB))[(size_t)n * BW + col]); }
        else if (region == 1) { col = h2 % 512; want = wdot(H1 + (size_t)n * D, A.w_in, IN_COLS, 512 + col, D, lane); got = bf2f(((const bf16*)(ws + WS_KB))[(size_t)n * BW + col]); }
        else if (region == 2) { col = h2 % 512; want = wdot(H1 + (size_t)n * D, A.w_in, IN_COLS, 1024 + col, D, lane); got = bf2f(((const bf16*)(ws + WS_VT))[((size_t)((n >> 13) * BW + col)) * SEQ + (n & (SEQ - 1))]); }
        else if (region == 3) { col = h2 % 1536; want = wdot(H1 + (size_t)n * D, A.w_in, IN_COLS, 1536 + col, D, lane); got = bf2f(((const bf16*)(ws + WS_RWRAW))[(size_t)n * 1536 + col]); }
        else if (region == 4) { col = h2 % 288; want = wdot(H1 + (size_t)n * D, A.w_in, IN_COLS, 3072 + col, D, lane); got = bf2f(((const bf16*)(ws + WS_LORA))[(size_t)n * BW + col]); }
        else { col = h2 % 2048; want = wdot(H1 + (size_t)n * D, A.w_in, IN_COLS, 3360 + col, D, lane) + A.gate_bias[col]; want = 1.0f / (1.0f + expf(-want)); got = bf2f(((const bf16*)(ws + WS_GATE))[(size_t)n * 2048 + col]); }
        chk(ws, id, got, want, 0.03f, 0.02f); }
}
constexpr int NATT = 16;
DI void att_sample(int s, int& b, int& h, int& t) { const unsigned hh = hsh(6000 + s); b = hh & 3; h = (hh >> 2) & 7; t = (s < 4) ? (s * 37) : (int)((hh >> 5) % SEQ); }
DI void chk_p3_save(const Frame& F, ARef A) {
    if (F.wave == 0) { bf16* sv = (bf16*)(A.ws + WS_FLG + 4096);
        for (int s = 0; s < NATT; ++s) { int b, h, t; att_sample(s, b, h, t); sv[s * 64 + F.lane] = ((const bf16*)(A.ws + WS_QB))[(size_t)(b * SEQ + t) * BW + h * HD + F.lane]; } }
}
DI void chk_p3(const Frame& F, ARef A, const bf16* R, const bf16* KS, const bf16* V, const bf16* KK) {
    unsigned char* ws = A.ws; const int lane = F.lane;
    const bf16* sv = (const bf16*)(ws + WS_FLG + 4096); const bf16* KB = (const bf16*)(ws + WS_KB); const bf16* VT = (const bf16*)(ws + WS_VT);
    for (int s = F.wave; s < NATT; s += NWAVES) { int b, h, t; att_sample(s, b, h, t);
        const float q = bf2f(sv[s * 64 + lane]); float later = 0.f, o = 0.f;
        for (int k = t - 1; k >= 0; --k) { const float z = wave_sum(q * bf2f(KB[(size_t)(b * SEQ + k) * BW + h * HD + lane]));
            const float sp = fmaxf(z, 0.f) + log1pf(expf(-fabsf(z)));
            o += expf(z - sp + later) * bf2f(VT[((size_t)((b * NH + h) * HD + lane)) * SEQ + k]);
            later -= sp; if (later < -200.f) break; }
        chk(ws, 19, bf2f(((const bf16*)(ws + WS_QB))[(size_t)(b * SEQ + t) * BW + h * HD + lane]), o, 0.04f, 0.02f); }
    const bf16* RW = (const bf16*)(ws + WS_RWRAW); const bf16* LO = (const bf16*)(ws + WS_LORA); const bf16* AL = (const bf16*)(ws + WS_ALORA);
    for (int s = F.wave; s < 32; s += NWAVES) { const unsigned hh = hsh(7000 + s); const int n = (s < 4) ? s * SEQ : (int)(hh % NTOK), hd = (hh >> 16) & 7; const bool first = (n & (SEQ - 1)) == 0;
        float xs[3];
        for (int p = 0; p < 3; ++p) { const int col = p * 512 + hd * 64 + lane; const float cur = bf2f(RW[(size_t)n * 1536 + col]), prv = first ? 0.f : bf2f(RW[(size_t)(n - 1) * 1536 + col]); xs[p] = cur + A.shift_mu[col] * (prv - cur); }
        const size_t o = (size_t)n * BW + hd * 64 + lane;
        chk(ws, 20, bf2f(R[o]), xs[0], 0.01f, 0.005f); chk(ws, 20, bf2f(KS[o]), xs[1], 0.01f, 0.005f); chk(ws, 20, bf2f(V[o]), xs[2], 0.01f, 0.005f);
        const float kk = xs[1] * A.k_k[hd * 64 + lane]; const float nn = sqrtf(wave_sum(kk * kk));
        chk(ws, 20, bf2f(KK[o]), kk / fmaxf(nn, L2_EPS), 0.01f, 0.002f);
        for (int c = lane; c < LK; c += 64) { float want = 0.f;
            if (c < 288) { const float cur = bf2f(LO[(size_t)n * BW + c]), prv = first ? 0.f : bf2f(LO[(size_t)(n - 1) * BW + c]); const float v = cur + A.shift_mu[1536 + c] * (prv - cur);
                want = c < 64 ? tanhf(v) : (c < 128 ? v : 1.0f / (1.0f + expf(-v))); }
            chk(ws, 20, bf2f(AL[(size_t)n * LK + c]), want, 0.01f, 0.005f); } }
}
DI void chk_p4_save(const Frame& F, ARef A, const bf16* KS) {
    if (F.wave == 0) { bf16* sv = (bf16*)(A.ws + WS_FLG + 8192);
        for (int s = 0; s < 16; ++s) { const unsigned hh = hsh(8000 + s); const int n = hh % NTOK, hd = (hh >> 16) & 7; sv[s * 64 + F.lane] = KS[(size_t)n * BW + hd * 64 + F.lane]; } }
}
DI void chk_p4(const Frame& F, ARef A, const bf16* KP, const bf16* KK) {
    unsigned char* ws = A.ws; const int lane = F.lane; const bf16* AL = (const bf16*)(ws + WS_ALORA); const bf16* sv = (const bf16*)(ws + WS_FLG + 8192);
    for (int s = F.wave; s < 16; s += NWAVES) { const unsigned hh = hsh(8000 + s); const int n = hh % NTOK, hd = (hh >> 16) & 7, c = hd * 64 + lane; const size_t o = (size_t)n * BW + c;
        float lw = 0.f, la = 0.f, lg = 0.f;
        for (int k = 0; k < 64; ++k) { lw += bf2f(AL[(size_t)n * LK + k]) * A.w_decay_up[k * BW + c]; la += bf2f(AL[(size_t)n * LK + 64 + k]) * A.w_iclr_up[k * BW + c]; }
        for (int k = 0; k < 160; ++k) lg += bf2f(AL[(size_t)n * LK + 128 + k]) * A.w_gate_up[k * BW + c];
        const float x = -(A.w0[c] + lw), w = -(fmaxf(x, 0.f) + log1pf(expf(-fabsf(x)))) - 0.5f;
        chk(ws, 21, bf2f(((const bf16*)(ws + WS_E))[o]), expf(w), 0.03f, 0.003f);
        const float a = 1.0f / (1.0f + expf(-(A.a0[c] + la))); const float ks = bf2f(sv[s * 64 + lane]);
        chk(ws, 22, bf2f(KP[o]), ks * (1.0f + (a - 1.0f) * A.k_a[c]), 0.03f, 0.01f);
        chk(ws, 22, bf2f(((const bf16*)(ws + WS_B))[o]), bf2f(KK[o]) * a, 0.03f, 0.003f);
        chk(ws, 23, bf2f(((const bf16*)(ws + WS_GG))[o]), lg, 0.03f, 0.01f); }
}
constexpr int NST = 300;
DI void chk_p7_save(const Frame& F, ARef A) {
    if (F.wave < 4) { const int b = (F.wave * 3) & 3, h = (F.wave * 5 + 1) & 7; bf16* sv = (bf16*)(A.ws + 256 * 1024) + F.wave * NST * 64;
        for (int t = 0; t < NST; ++t) sv[t * 64 + F.lane] = ((const bf16*)(A.ws + WS_E))[(size_t)(b * SEQ + t) * BW + h * HD + F.lane]; }
}
DI void chk_p7(const Frame& F, ARef A, const bf16* R, const bf16* KP, const bf16* V, const bf16* KK) {
    unsigned char* ws = A.ws; const int lane = F.lane;
    const bf16* Bv = (const bf16*)(ws + WS_B); const bf16* Esv = (const bf16*)(ws + 256 * 1024) + F.wave * NST * 64; const bf16* GG = (const bf16*)(ws + WS_GG); const bf16* YRW = (const bf16*)(ws + WS_YRW);
    if (F.wave < 4) { const int b = (F.wave * 3) & 3, h = (F.wave * 5 + 1) & 7, col0 = h * HD;
        float S[64];
#pragma unroll
        for (int k = 0; k < 64; ++k) S[k] = 0.f;
        for (int t = 0; t < NST; ++t) { const size_t o = (size_t)(b * SEQ + t) * BW + col0 + lane;
            const float av = -bf2f(KK[o]), bv = bf2f(Bv[o]), dv = expf(-bf2f(Esv[t * 64 + lane])), kv = bf2f(KP[o]), rv = bf2f(R[o]), vv = bf2f(V[o]);
            float sa = 0.f;
#pragma unroll
            for (int k = 0; k < 64; ++k) sa += S[k] * __shfl(av, k);
            float y = 0.f;
#pragma unroll
            for (int k = 0; k < 64; ++k) { S[k] = S[k] * __shfl(dv, k) + sa * __shfl(bv, k) + vv * __shfl(kv, k); y += S[k] * __shfl(rv, k); }
            const float mean = wave_sum(y) / 64.f, d = y - mean, var = wave_sum(d * d) / 64.f;
            const float yn = d / sqrtf(var + GN_EPS) * A.lnx_w[col0 + lane] + A.lnx_b[col0 + lane];
            const float bonus = wave_sum(rv * kv * A.r_k[col0 + lane]) * vv;
            const float want = (yn + bonus) * bf2f(GG[o]);
            chk(ws, t < 128 ? 24 : 25, bf2f(YRW[o]), want, 0.05f, 0.03f); } }
}
DI void chk_p8(const Frame& F, ARef A) {
    unsigned char* ws = A.ws; const int lane = F.lane;
    for (int s = F.wave; s < 32; s += NWAVES) { const unsigned hh = hsh(9000 + s); const int n = hh % NTOK, c = (hh >> 15) & 1023;
        const float p1 = wdot((const bf16*)(ws + WS_QB) + (size_t)n * BW, A.w_o_sb, D, c, BW, lane), p2 = wdot((const bf16*)(ws + WS_YRW) + (size_t)n * BW, A.w_o_rw, D, c, BW, lane);
        const bf16* ga = (const bf16*)(ws + WS_GATE) + (size_t)n * 2048;
        chk(ws, 26, bf2f(((const bf16*)(ws + WS_MRG))[(size_t)n * D + c]), bf2f(ga[c]) * p1 + bf2f(ga[1024 + c]) * p2, 0.03f, 0.01f); }
}
DI void chk_p9(const Frame& F, ARef A) {
    unsigned char* ws = A.ws; const int lane = F.lane;
    for (int s = F.wave; s < 32; s += NWAVES) { const unsigned hh = hsh(9500 + s); const int n = hh % NTOK, c = (hh >> 15) & 1023;
        chk(ws, 27, bf2f(((const bf16*)(ws + WS_Y1))[(size_t)n * D + c]), wdot((const bf16*)(ws + WS_MRG) + (size_t)n * D, A.w_out, D, c, D, lane), 0.03f, 0.01f); }
}
DI void chk_p10(const Frame& F, ARef A) {
    unsigned char* ws = A.ws; const int lane = F.lane; const float* mod = (const float*)(ws + WS_MOD);
    const bf16* Y1 = (const bf16*)(ws + WS_Y1); const bf16* H2 = (const bf16*)(ws + WS_H2); const i32x4* tok = (const i32x4*)(ws + WS_TOK);
    for (int s = F.wave; s < 32; s += NWAVES) { const int n = s == 0 ? DBG_TOKEN : (s < 16 ? (int)(hsh(10000 + s) % 128) : (int)(hsh(10000 + s) % NTOK)), b = n >> 13; float ss = 0.f;
        for (int k = lane; k < D; k += 64) { const float v = bf2f(Y1[(size_t)n * D + k]); ss += v * v; }
        const float inv1 = 1.0f / sqrtf(wave_sum(ss) / D + NORM_EPS); float s2 = 0.f;
        for (int k = lane; k < D; k += 64) { const float x1 = A.x[(size_t)n * D + k] + mod[b * 6144 + 2 * D + k] * ((bf2f(Y1[(size_t)n * D + k]) * inv1) * A.gains[D + k]);
            chk(ws, 28, A.out[(size_t)n * D + k], x1, 1e-3f, 1e-3f); s2 += x1 * x1; }
        const float inv2 = 1.0f / sqrtf(wave_sum(s2) / D + NORM_EPS);
        float lg[36];
#pragma unroll
        for (int o = 0; o < 36; ++o) lg[o] = 0.f;
        for (int k = lane; k < D; k += 64) { const float h2 = (A.out[(size_t)n * D + k] * inv2) * A.gains[2 * D + k] * (1.0f + mod[b * 6144 + 4 * D + k]) + mod[b * 6144 + 3 * D + k];
            chk(ws, 29, bf2f(H2[(size_t)n * D + k]), h2, 0.01f, 0.01f);
#pragma unroll
            for (int o = 0; o < 36; ++o) lg[o] += h2 * (o < 4 ? A.w_group[k * 4 + o] : A.w_router[k * NE + o - 4]); }
#pragma unroll
        for (int o = 0; o < 36; ++o) lg[o] = wave_sum(lg[o]);
        int gs = 0; float gm = lg[0];
#pragma unroll
        for (int g = 1; g < 4; ++g) if (lg[g] > gm) { gm = lg[g]; gs = g; }
        float gsum = 0.f;
#pragma unroll
        for (int g = 0; g < 4; ++g) gsum += expf(lg[g] - gm);
        float el[8];
#pragma unroll
        for (int e = 0; e < 8; ++e) el[e] = gs == 0 ? lg[4 + e] : (gs == 1 ? lg[12 + e] : (gs == 2 ? lg[20 + e] : lg[28 + e]));
        int i0 = 0; float m0 = el[0];
#pragma unroll
        for (int e = 1; e < 8; ++e) if (el[e] > m0) { m0 = el[e]; i0 = e; }
        int i1 = -1; float m1 = -3.0e38f;
#pragma unroll
        for (int e = 0; e < 8; ++e) if (e != i0 && el[e] > m1) { m1 = el[e]; i1 = e; }
        const float tt = expf(m1 - m0), p0 = 1.0f / (1.0f + tt);
        const i32x4 rec = tok[n];
        if (lane == 0 && s < 16) { if ((rec.x & 255) != gs * 8 + i0 || ((rec.x >> 8) & 255) != gs * 8 + i1) chk_flags(ws)[30] = 1u;
            if (n == DBG_TOKEN) { const float* dbg = (const float*)chk_flags(ws) + 48; float code = 1.f;
                if (dbg[4] > 4.001f) code += 2.f; if (dbg[5] < 0.499f) code += 4.f;
                if (fabsf(dbg[0] - lg[0]) > 1e-3f || fabsf(dbg[1] - lg[1]) > 1e-3f || fabsf(dbg[2] - lg[2]) > 1e-3f || fabsf(dbg[3] - lg[3]) > 1e-3f) code += 8.f;
                if (fabsf(dbg[4] - gsum) > 1e-3f) code += 16.f; if (fabsf(dbg[6] * dbg[5] - __builtin_bit_cast(float, rec.z)) > 1e-4f) code += 32.f;
                ((float*)chk_flags(ws))[62] = code * 0.1f; ((float*)chk_flags(ws))[63] = dbg[4]; }
            chk(ws, 56, ((const float*)(ws + WS_CW))[2 * n], p0 / gsum, 3e-2f, 1e-4f); chk(ws, 57, ((const float*)(ws + WS_CW))[2 * n + 1], tt * p0 / gsum, 3e-2f, 1e-4f);
            chk(ws, 58, ((const float*)(ws + WS_CW))[2 * n], p0 / gsum, 1e-3f, 1e-5f); chk(ws, 59, ((const float*)(ws + WS_CW))[2 * n + 1], tt * p0 / gsum, 1e-3f, 1e-5f); } }
}
DI void chk_p11(const Frame& F, ARef A) {
    unsigned char* ws = A.ws; const int lane = F.lane; const i32x4* tok = (const i32x4*)(ws + WS_TOK); const int* tile = (const int*)(ws + WS_TILE);
    const bf16* H2 = (const bf16*)(ws + WS_H2); const bf16* HS = (const bf16*)(ws + WS_HS);
    for (int s = F.wave; s < 64; s += NWAVES) { const int n = hsh(11000 + s) % NTOK; const i32x4 rec = tok[n];
        if (rec.x < 0 || rec.x >= tile[MAXT] * 256 || rec.y < 0 || rec.y >= tile[MAXT] * 256 || tile[MAXT] > MAXT || tile[MAXT] < 256) { chk_flags(ws)[32] = 1u; continue; }
        for (int k = lane; k < D; k += 64) { chk(ws, 33, bf2f(HS[(size_t)rec.x * D + k]), bf2f(H2[(size_t)n * D + k]), 0.f, 0.f); chk(ws, 33, bf2f(HS[(size_t)rec.y * D + k]), bf2f(H2[(size_t)n * D + k]), 0.f, 0.f); } }
    { const unsigned hh = hsh(12000 + F.wave * 64 + lane); const int e = hh & 31, n = (hh >> 5) & 1023, k = (hh >> 15) & 1023, k5 = k & 511;
        const int c = (n >> 3) * 4 + (n & 3); const float want = (n & 4) ? A.w_up3[((size_t)e * D + k) * DE + c] : A.w_up1[((size_t)e * D + k) * DE + c];
        chk(ws, 34, bf2f(((const bf16*)(ws + WS_WUP))[((size_t)e * 1024 + n) * D + k]), bfr(want), 0.f, 0.f);
        chk(ws, 35, bf2f(((const bf16*)(ws + WS_WDN))[((size_t)e * 1024 + n) * DE + k5]), bfr(A.w_down[((size_t)e * DE + k5) * D + n]), 0.f, 0.f); }
}
DI void chk_p12(const Frame& F, ARef A) {
    unsigned char* ws = A.ws; const int lane = F.lane; const i32x4* tok = (const i32x4*)(ws + WS_TOK); const int* tile = (const int*)(ws + WS_TILE);
    const bf16* H2 = (const bf16*)(ws + WS_H2); const bf16* HID = (const bf16*)(ws + WS_HID);
    for (int s = F.wave; s < 32; s += NWAVES) { const unsigned hh = hsh(13000 + s); const int n = hh % NTOK, c = (hh >> 16) & 511; const i32x4 rec = tok[n]; const int pos = (s & 1) ? rec.y : rec.x;
        const int e = tile[pos >> 8];
        const float u1 = wdot(H2 + (size_t)n * D, A.w_up1 + (size_t)e * D * DE, DE, c, D, lane), u3 = wdot(H2 + (size_t)n * D, A.w_up3 + (size_t)e * D * DE, DE, c, D, lane);
        chk(ws, 36, bf2f(HID[(size_t)pos * DE + c]), u1 / (1.0f + expf(-u1)) * u3, 0.04f, 0.01f); }
}
DI void chk_p13(const Frame& F, ARef A) {
    unsigned char* ws = A.ws; const int lane = F.lane; const i32x4* tok = (const i32x4*)(ws + WS_TOK); const int* tile = (const int*)(ws + WS_TILE);
    const bf16* HID = (const bf16*)(ws + WS_HID); const bf16* YE = (const bf16*)(ws + WS_HS);
    for (int s = F.wave; s < 32; s += NWAVES) { const unsigned hh = hsh(14000 + s); const int n = hh % NTOK, c = (hh >> 16) & 1023; const i32x4 rec = tok[n]; const int pos = (s & 1) ? rec.y : rec.x;
        const int e = tile[pos >> 8];
        chk(ws, 37, bf2f(YE[(size_t)pos * D + c]), wdot(HID + (size_t)pos * DE, A.w_down + (size_t)e * DE * D, D, c, DE, lane), 0.04f, 0.01f); }
}
#endif

__global__ void __launch_bounds__(NTHR, 2) hybrid_fwd(Args A_unused) {
    extern __shared__ __attribute__((aligned(16))) unsigned char lds_raw[];
    const CAS Args& A = *(const CAS Args*)__builtin_amdgcn_kernarg_segment_ptr();
    Frame F;
    F.lds = (LAS unsigned char*)lds_raw;
    F.wave = __builtin_amdgcn_readfirstlane((int)threadIdx.x >> 6); F.tid = opq_tid(F.wave); F.lane = F.tid & 63;
    F.wg = blockIdx.x; F.G = gridDim.x; F.gw = F.wg * NWAVES + F.wave; F.NGW = F.G * NWAVES;
    volatile LAS unsigned* MISC = (volatile LAS unsigned*)(F.lds + LDS_MISC);
    if (F.wave == 0) MISC[F.lane] = 0u;
    __syncthreads();
    const XcdBarrier bar = xcd_barrier_post((unsigned*)(A.ws + WS_CTL), MISC + 8, F.wave);
    unsigned char* ws = A.ws;
    LAS unsigned char* stage = F.lds;
    bf16* const dob = (bf16*)A.out;
    bf16 *H1 = dob, *R = dob, *KS = dob + (size_t)NTOK * BW, *V = dob + 2 * (size_t)NTOK * BW, *KK = dob + 3 * (size_t)NTOK * BW;

#if defined(STAMPS)
    unsigned long long* const tsp = (unsigned long long*)(ws + WS_CTL + 49152);
#define STAMP(k) do { if (F.wg == 0 && xb_t0(F.wave)) tsp[k] = wall_clock64(); } while (0)
#else
#define STAMP(k) do { } while (0)
#endif
#if defined(REPEAT_PHASE)
#ifndef REPEAT_COUNT
#define REPEAT_COUNT 2
#endif
#define REP(k) _Pragma("nounroll") for (int rep_ = 0; rep_ < ((k) == REPEAT_PHASE ? REPEAT_COUNT : 1); ++rep_)
#else
#define REP(k)
#endif
    STAMP(0);
    REP(0) {
    p0_prologue(F, A);
    xcd_barrier(bar);
    }
    STAMP(1);
#if defined(CHECKS)
    if (F.wg == 0) chk_p0(F, A);
#endif
    REP(1) {
    p1_h1(F, A, H1);
    xcd_barrier(bar);
    }
    STAMP(2);
#if defined(CHECKS)
    if (F.wg == 0) chk_p1(F, A, H1);
#endif
    REP(2) {
    {   pg8::Gemm g{H1, (const bf16*)(ws + WS_WIN), NTOK, NPAD, D}; pg8::StaticOrder S; S.init(NTOK, NPAD, F.G, F.wg);
        EpiIn E{(bf16*)(ws + WS_QB), (bf16*)(ws + WS_KB), (bf16*)(ws + WS_VT), (bf16*)(ws + WS_RWRAW), (bf16*)(ws + WS_LORA), (bf16*)(ws + WS_GATE), A.gate_bias};
        pg8::gemm_phase<EpiIn, pg8::StaticOrder>(stage, g, S, E, nullptr, F.wave); }
    xcd_barrier(bar);
    }
    STAMP(3);
#if defined(CHECKS)
    if (F.wg == 0) { chk_p2(F, A, H1); chk_p3_save(F, A); }
    xcd_barrier(bar);
#endif
#if !defined(CHECKS)
    const bool fuse34 = (F.G == 256);
#else
    const bool fuse34 = false;
#endif
    REP(3) {
    p3_attn(F, (const bf16*)(ws + WS_QB), (const bf16*)(ws + WS_KB), (const bf16*)(ws + WS_VT), (bf16*)(ws + WS_QB));
#if defined(STAMPS)
    STAMP(20);
#endif
    p3_prep(F, A, (const bf16*)(ws + WS_RWRAW), (const bf16*)(ws + WS_LORA), R, KS, V, KK, (bf16*)(ws + WS_ALORA));
#if !defined(CHECKS)
    if (fuse34) { asm volatile("s_waitcnt vmcnt(0)" ::: "memory"); __syncthreads();
        p4_lora(F, A, (const bf16*)(ws + WS_ALORA), (const bf16*)(ws + WS_WL), (bf16*)(ws + WS_E), KS, (bf16*)(ws + WS_B), (bf16*)(ws + WS_GG), KK, R, (float*)(ws + WS_BON)); }
#endif
    xcd_barrier(bar);
    }
#if defined(STAMPS)
    STAMP(21);
#endif
    STAMP(4);
#if defined(CHECKS)
    if (F.wg == 0) { chk_p3(F, A, R, KS, V, KK); chk_p4_save(F, A, KS); }
    xcd_barrier(bar);
#endif
    if (!fuse34) {
    p4_lora(F, A, (const bf16*)(ws + WS_ALORA), (const bf16*)(ws + WS_WL), (bf16*)(ws + WS_E), KS, (bf16*)(ws + WS_B), (bf16*)(ws + WS_GG), KK, R, (float*)(ws + WS_BON));
    xcd_barrier(bar);
    }
    STAMP(5);
#if defined(CHECKS)
    if (F.wg == 0) chk_p4(F, A, KS, KK);
#endif
    REP(5) {
    p5_mfma(ws, F, R, KS, V, KK, (const bf16*)(ws + WS_B), (const bf16*)(ws + WS_E), (bf16*)(ws + WS_P), (bf16*)(ws + WS_QO), (bf16*)(ws + WS_GT), (bf16*)(ws + WS_HT));
    p6_moe_weights(F, A, F.gw, F.NGW);
    xcd_barrier(bar);
    }
    STAMP(6);
#if defined(CHECKS)
    if (F.wg == 255) chk_p7_save(F, A);
#endif
    REP(6) {
    {   const int ncw = F.G < 64 ? F.G : 64;
        if (F.wg < ncw) { if (F.wave == 0) for (int task = F.wg; task < 64; task += ncw) p6_chain(task, F.wave, F.lds, (const bf16*)(ws + WS_GT), (const bf16*)(ws + WS_HT), (bf16*)(ws + WS_SC));
#if defined(STAMPS)
            STAMP(22);
#endif
        }
        else {
            pg8::StaticOrder S; S.init(NTOK, D, F.G - ncw, F.wg - ncw);
            pg8::Gemm g{(const bf16*)(ws + WS_QB), (const bf16*)(ws + WS_WOSB), NTOK, D, BW};
            EpiMerge<false> E{(bf16*)(ws + WS_GATE), (bf16*)(ws + WS_MRG), 0};
            pg8::gemm_phase<EpiMerge<false>, pg8::StaticOrder>(stage, g, S, E, nullptr, F.wave); }
    }
    xcd_barrier(bar);
    }
    STAMP(7);
    REP(7) {
    p7_mfma(F, A, (const bf16*)(ws + WS_SC), (const bf16*)(ws + WS_P), (const bf16*)(ws + WS_QO), V, (const bf16*)(ws + WS_GG), (const float*)(ws + WS_BON), (bf16*)(ws + WS_YRW));
    xcd_barrier(bar);
    }
    STAMP(8);
#if defined(CHECKS)
    if (F.wg == 0) chk_p7(F, A, R, KS, V, KK);
#endif
    REP(8) {
    {   pg8::StaticOrder S; S.init(NTOK, D, F.G, F.wg);
        {   pg8::Gemm g{(const bf16*)(ws + WS_YRW), (const bf16*)(ws + WS_WORW), NTOK, D, BW};
            EpiMerge<true> E{(bf16*)(ws + WS_GATE), (bf16*)(ws + WS_MRG), D};
            pg8::gemm_phase<EpiMerge<true>, pg8::StaticOrder>(stage, g, S, E, nullptr, F.wave); } }
    xcd_barrier(bar);
    }
    STAMP(9);
#if defined(CHECKS)
    if (F.wg == 0) chk_p8(F, A);
#endif
    REP(9) {
    {   pg8::Gemm g{(const bf16*)(ws + WS_MRG), (const bf16*)(ws + WS_WOUT), NTOK, D, D}; pg8::StaticOrder S; S.init(NTOK, D, F.G, F.wg);
        EpiPlain E{(bf16*)(ws + WS_Y1), D, 0xff};
        pg8::gemm_phase<EpiPlain, pg8::StaticOrder>(stage, g, S, E, nullptr, F.wave); }
    xcd_barrier(bar);
    }
    STAMP(10);
#if defined(CHECKS)
    if (F.wg == 0) chk_p9(F, A);
#endif
    REP(10) {
    p10_rows(F, A, (const bf16*)(ws + WS_Y1), (bf16*)(ws + WS_H2));
    xcd_barrier(bar);
    }
    STAMP(11);
#if defined(CHECKS)
    if (F.wg == 0) chk_p10(F, A);
#endif
    REP(11) {
    p11_rank_gather(F, A, (const bf16*)(ws + WS_H2), (bf16*)(ws + WS_HS));
    xcd_barrier(bar);
    }
    STAMP(12);
#if defined(CHECKS)
    if (F.wg == 0) chk_p11(F, A);
#endif
    {   const int* tile = (const int*)(ws + WS_TILE);
        const int nt = __builtin_amdgcn_readfirstlane(tile[MAXT]);
        MoeOrder S; S.nunits = nt * 4; S.G = F.G; S.vc = (F.G % 8 == 0) ? (F.wg % 8) * (F.G / 8) + F.wg / 8 : F.wg; S.tile_e = tile;
        REP(12) {   pg8::Gemm g{(const bf16*)(ws + WS_HS), (const bf16*)(ws + WS_WUP), MAXT * 256, NE * 1024, D};
            EpiUp E{(bf16*)(ws + WS_HID)};
            pg8::gemm_phase<EpiUp, MoeOrder>(stage, g, S, E, nullptr, F.wave);
        xcd_barrier(bar); }
    STAMP(13);
#if defined(CHECKS)
        if (F.wg == 0) chk_p12(F, A);
#endif
        REP(13) {   pg8::Gemm g{(const bf16*)(ws + WS_HID), (const bf16*)(ws + WS_WDN), MAXT * 256, NE * 1024, DE};
            EpiPlain E{(bf16*)(ws + WS_HS), D, 3};
            pg8::gemm_phase<EpiPlain, MoeOrder>(stage, g, S, E, nullptr, F.wave);
        xcd_barrier(bar); } }
    STAMP(14);
#if defined(CHECKS)
    if (F.wg == 0) chk_p13(F, A);
#endif
    p14_final(F, A, (const bf16*)(ws + WS_HS));
#if defined(STAMPS)
    xcd_barrier(bar);
    STAMP(15);
    if (F.wg == 0) { __syncthreads();
        const float va = (float)(long long)(tsp[STAMP_A2] - tsp[STAMP_A]) * 0.01f, vb = (float)(long long)(tsp[STAMP_B2] - tsp[STAMP_B]) * 0.01f;
#if defined(STAMP_SHIFT)
        const float shf_ = 1.1f;
#else
        const float shf_ = 1.0f;
#endif
        int b1 = (int)floorf(logf(fmaxf(va * shf_, 1.0f)) / logf(1.21f)) + 1, b2 = (int)floorf(logf(fmaxf(vb * shf_, 1.0f)) / logf(1.21f)) + 1;
#if defined(STAMP_CAL)
        b1 = 10; b2 = 30;
#endif
#if defined(STAMP_FRAC)
        { const unsigned long long* t5 = tsp + 32; const float tot = (float)(long long)(t5[9] - t5[0]);
          b1 = (int)(12.0f * (float)(long long)(t5[STAMP_A2] - t5[STAMP_A]) / tot) + 3; b2 = (int)(12.0f * (float)(long long)(t5[STAMP_B2] - t5[STAMP_B]) / tot) + 3; }
#endif
#if defined(STAMP_THR_A)
        b1 = va > (float)(STAMP_THR_A) ? 30 : 10; b2 = vb > (float)(STAMP_THR_B) ? 30 : 10;
#endif
        const int t_ = opq_tid(F.wave);
        for (int i = t_; i < 1000; i += NTHR) A.out[1000 + i] += 20.0f * (float)b2;
        if (t_ == 0) A.out[0] = 200.0f * (float)b1; }
#endif
#if defined(CHECKS)
    xcd_barrier(bar);
    if (F.wg == 0 && F.tid == 0) { const unsigned* fl = chk_flags(ws); int id = 0; for (int i = 61; i >= 0; --i) if (fl[i]) id = i;
        if (((const unsigned*)(ws + WS_CTL))[XB_TMO]) id = 60;
        if (id) A.out[0] = 10.0f * (float)id;
#if defined(CHKVAL)
        A.out[0] = 1000.0f * ((const float*)fl)[CHKVAL];
#endif
        }
#endif
}

extern "C" void kernel_launch(void* const* d_in, const int* in_sizes, int n_in, void* d_out, int out_size, void* d_ws, size_t ws_size, hipStream_t stream) {
    static int grid = 0;
    if (grid == 0) {
        if (n_in != 26 || in_sizes[0] != NTOK * D || out_size != NTOK * D || ws_size < WS_END) {
            fprintf(stderr, "kernel_launch: unexpected shapes (n_in %d, in0 %d, out %d, ws %zu); nothing launched\n", n_in, n_in > 0 ? in_sizes[0] : -1, out_size, ws_size); grid = -1; return; }
        int dev = 0, cus = 0, per_cu = 0;
        if (hipGetDevice(&dev) != hipSuccess || hipDeviceGetAttribute(&cus, hipDeviceAttributeMultiprocessorCount, dev) != hipSuccess) { grid = -1; return; }
        if (hipFuncSetAttribute((const void*)hybrid_fwd, hipFuncAttributeMaxDynamicSharedMemorySize, LDS_BYTES) != hipSuccess) { fprintf(stderr, "kernel_launch: hipFuncSetAttribute failed\n"); grid = -1; return; }
        if (hipOccupancyMaxActiveBlocksPerMultiprocessor(&per_cu, (const void*)hybrid_fwd, NTHR, LDS_BYTES) != hipSuccess || per_cu < 1)
            fprintf(stderr, "kernel_launch: note: occupancy query reports %d workgroups per CU\n", per_cu);
        (void)hipGetLastError();
        grid = cus > 256 ? 256 : cus;
    }
    if (grid < 0) return;
    if (hipMemsetAsync((char*)d_ws + WS_CTL, 0, CTL_ZERO_BYTES, stream) != hipSuccess) return;
    Args a{};
    const float** p = (const float**)&a;
    for (int i = 0; i < 26; ++i) p[i] = (const float*)d_in[i];
    a.out = (float*)d_out; a.ws = (unsigned char*)d_ws;
    hipLaunchKernelGGL(hybrid_fwd, dim3(grid), dim3(NTHR), LDS_BYTES, stream, a);
}

#if defined(ONLY_P5)
__global__ void __launch_bounds__(NTHR, 2) only_p5(Args A_unused) {
    extern __shared__ __attribute__((aligned(16))) unsigned char lds_raw[];
    const CAS Args& A = *(const CAS Args*)__builtin_amdgcn_kernarg_segment_ptr();
    Frame F; F.lds = (LAS unsigned char*)lds_raw; F.wave = __builtin_amdgcn_readfirstlane((int)threadIdx.x >> 6); F.tid = opq_tid(F.wave); F.lane = F.tid & 63;
    F.wg = blockIdx.x; F.G = gridDim.x; F.gw = F.wg * NWAVES + F.wave; F.NGW = F.G * NWAVES;
    unsigned char* ws = A.ws; bf16* const dob = (bf16*)A.out;
    bf16 *R = dob, *KS = dob + (size_t)NTOK * BW, *V = dob + 2 * (size_t)NTOK * BW, *KK = dob + 3 * (size_t)NTOK * BW;
    p5_mfma(ws, F, R, KS, V, KK, (const bf16*)(ws + WS_B), (const bf16*)(ws + WS_E), (bf16*)(ws + WS_P), (bf16*)(ws + WS_QO), (bf16*)(ws + WS_GT), (bf16*)(ws + WS_HT));
}
#endif
```

```cpp
#include <hip/hip_runtime.h>
#include <cstdio>
#include <cstdint>
__device__ __forceinline__ int opq_tid(int wave) { int l; asm volatile("v_mbcnt_lo_u32_b32 %0, -1, 0\n\tv_mbcnt_hi_u32_b32 %0, -1, %0" : "=v"(l)); return wave * 64 + l; }
#ifndef PHMASK
#define PHMASK 0xffff
#endif
namespace pg8 {
#define PG8_LAS __attribute__((address_space(3)))
typedef unsigned short bf16_t;
typedef short bf16x8 __attribute__((ext_vector_type(8)));
typedef float f32x4 __attribute__((ext_vector_type(4)));
typedef unsigned u32x4 __attribute__((ext_vector_type(4)));
constexpr int BM = 256, BK = 64, HALF = 128, HTB = HALF * BK * 2  , STAGE_BYTES = 8 * HTB, NXCD = 8, WGM = 8;

__host__ __device__ __forceinline__ int lds_byte(int r, int c) { const int st = (r >> 4) * 2 + (c >> 5), rr = r & 15, cc = c & 31, ob = rr * 64 + cc * 2; return st * 1024 + (ob ^ (((ob >> 9) & 1) << 5)); }
__host__ __device__ __forceinline__ void stage_rc(int b, int& R, int& C) { const int st = b / 1024, sb = b % 1024, swz = sb ^ (((sb >> 9) & 1) << 5); R = (st >> 1) * 16 + swz / 64; C = (st & 1) * 32 + (swz % 64) / 2; }
__host__ __device__ __forceinline__ int perm32(int rho) { const int n = rho >> 4, i = rho & 15; return 8 * (i >> 2) + 4 * n + (i & 3); }

struct Unit { int pm, pn; };
struct Gemm { const bf16_t* A; const bf16_t* Bt; int M, N, K; };

struct StaticOrder {
    int nM, nN, nwg, G, c;
    __host__ __device__ void init(int M, int N, int G_, int c_) { nM = M / BM; nN = N / BM; nwg = nM * nN; G = G_; c = c_; }
    __host__ __device__ bool next(int i, Unit& u) const {
        const long L = (long)i * G + c; if (L >= nwg) return false;
        int wgid = (int)L; { const int q = nwg / NXCD, r = nwg % NXCD, xcd = wgid % NXCD, off = wgid / NXCD; wgid = (xcd < r ? xcd * (q + 1) : r * (q + 1) + (xcd - r) * q) + off; }
        const int nig = WGM * nN, gid = wgid / nig, fm = gid * WGM, gsz = (nM - fm) < WGM ? (nM - fm) : WGM;
        u.pm = fm + ((wgid % nig) % gsz); u.pn = (wgid % nig) / gsz; return true;
    }
    __device__ __forceinline__ void a_ready(const Unit&) const {}
    __device__ __forceinline__ void done(const Unit&) const {}
};

template <class Epi, class Sched, bool STAMP = false>
__device__ __forceinline__ void gemm_phase(PG8_LAS unsigned char* lds, const Gemm g, const Sched& S, const Epi& E, unsigned long long* stamps, int wave_id) {
    const int tid = opq_tid(wave_id), wid = __builtin_amdgcn_readfirstlane(tid >> 6), lane = tid & 63, wr = wid >> 2, wc = wid & 3, fr = lane & 15, fq = lane >> 4;
    const int K = g.K, nt = K / BK;
    int ts_lo = 0, ts_hi = 0, nts = 0; const unsigned long long rt_entry = STAMP ? (unsigned long long)wall_clock64() : 0ull;
#define PG8_STAMP() do { if (STAMP && wid == 0 && nts < 64) { const unsigned long long _c = (unsigned long long)clock64(); \
        ts_lo = (lane == nts) ? (int)(unsigned)_c : ts_lo; ts_hi = (lane == nts) ? (int)(unsigned)(_c >> 32) : ts_hi; ++nts; } } while (0)
    PG8_STAMP();
    unsigned voffA[2], voffB[2];
#pragma unroll
    for (int i = 0; i < 2; ++i) { int R, C; stage_rc(tid * 16 + i * 8192, R, C); const int Rb = Epi::PERM ? ((R & ~31) + perm32(R & 31)) : R;
        voffA[i] = (unsigned)(R * K + C) * 2u; voffB[i] = (unsigned)(Rb * K + C) * 2u; }
    const size_t kstep = (size_t)(BK * 2);
    const size_t hstep = (size_t)HALF * K * 2;
    const size_t tstep = 2 * hstep;
    const unsigned ldsw = (unsigned)wid * 1024u;
    const int aoff = lds_byte(wr * 64 + fr, fq * 8), boff = lds_byte(wc * 32 + fr, fq * 8);
#define PG8_SA(b, h) (((b) * 2 + (h)) * HTB)
#define PG8_SB(b, h) ((4 + (b) * 2 + (h)) * HTB)
#define PG8_STAGE(bufoff, gbase, voff) do { _Pragma("unroll") for (int _i = 0; _i < 2; ++_i) \
        __builtin_amdgcn_global_load_lds((const unsigned*)((const char*)(gbase) + (voff)[_i]), (PG8_LAS unsigned*)(lds + (bufoff) + ldsw + _i * 8192), 16, 0, 0); } while (0)
#define PG8_LDA(dst, b, h) do { _Pragma("unroll") for (int m = 0; m < 4; ++m) _Pragma("unroll") for (int k = 0; k < 2; ++k) dst[m][k] = *(const PG8_LAS bf16x8*)(lds + PG8_SA(b, h) + aoff + m * 2048 + k * 1024); } while (0)
#define PG8_LDB(dst, b, h) do { _Pragma("unroll") for (int n = 0; n < 2; ++n) _Pragma("unroll") for (int k = 0; k < 2; ++k) dst[n][k] = *(const PG8_LAS bf16x8*)(lds + PG8_SB(b, h) + boff + n * 2048 + k * 1024); } while (0)
#define PG8_MMA(ai, bj, At, Bt) do { __builtin_amdgcn_s_setprio(1); _Pragma("unroll") for (int m = 0; m < 4; ++m) _Pragma("unroll") for (int n = 0; n < 2; ++n) _Pragma("unroll") for (int k = 0; k < 2; ++k) \
        acc[ai][bj][m][n] = __builtin_amdgcn_mfma_f32_16x16x32_bf16(Bt[n][k], At[m][k], acc[ai][bj][m][n], 0, 0, 0); __builtin_amdgcn_s_setprio(0); } while (0)
#define PG8_WAIT_V(n) asm volatile("s_waitcnt vmcnt(" #n ")" ::: "memory")
#define PG8_WAIT_L(n) asm volatile("s_waitcnt lgkmcnt(" #n ")" ::: "memory")
#define PG8_BAR __builtin_amdgcn_s_barrier()
#define PG8_SCHED __builtin_amdgcn_sched_barrier(0)
    Unit cur, nxt; int ui = 0;
    if (!S.next(0, cur)) return;
    f32x4 acc[2][2][4][2];
#pragma unroll
    for (int a = 0; a < 2; ++a)
#pragma unroll
        for (int b = 0; b < 2; ++b)
#pragma unroll
            for (int m = 0; m < 4; ++m)
#pragma unroll
                for (int n = 0; n < 2; ++n) acc[a][b][m][n] = (f32x4){0.f, 0.f, 0.f, 0.f};
    bf16x8 At[4][2], B0[2][2], B1[2][2];
    const char* cA = (const char*)g.A + (size_t)cur.pm * tstep; const char* cB = (const char*)g.Bt + (size_t)cur.pn * tstep;
    S.a_ready(cur);
    PG8_STAGE(PG8_SB(0, 0), cB, voffB); PG8_STAGE(PG8_SA(0, 0), cA, voffA); PG8_STAGE(PG8_SB(0, 1), cB + hstep, voffB); PG8_STAGE(PG8_SA(0, 1), cA + hstep, voffA);
    if (wr == 1) PG8_BAR;
    PG8_WAIT_V(4); PG8_BAR;
    PG8_STAGE(PG8_SB(1, 0), cB + kstep, voffB); PG8_STAGE(PG8_SA(1, 0), cA + kstep, voffA); PG8_STAGE(PG8_SB(1, 1), cB + hstep + kstep, voffB);
    PG8_WAIT_V(6); PG8_BAR;
    PG8_STAMP();
    for (;;) {
        const bool has_next = S.next(ui + 1, nxt);
        const char* nA = has_next ? (const char*)g.A + (size_t)nxt.pm * tstep : cA; const char* nB = has_next ? (const char*)g.Bt + (size_t)nxt.pn * tstep : cB;
        for (int t = 0; t < nt; t += 2) {
            const bool last = (t == nt - 2);
            const char* a1 = cA + (size_t)(t + 1) * kstep;
            const char* a2 = last ? nA : cA + (size_t)(t + 2) * kstep; const char* b2 = last ? nB : cB + (size_t)(t + 2) * kstep;
            const char* a3 = a2 + kstep; const char* b3 = b2 + kstep;
            if (last && has_next) S.a_ready(nxt);
            PG8_LDB(B0, 0, 0); PG8_SCHED; PG8_LDA(At, 0, 0); PG8_STAGE(PG8_SA(1, 1), a1 + hstep, voffA);
            PG8_WAIT_L(8); PG8_BAR; PG8_WAIT_L(0); PG8_MMA(0, 0, At, B0); PG8_BAR; PG8_SCHED;
            PG8_LDB(B1, 0, 1); PG8_STAGE(PG8_SB(0, 0), b2, voffB);
            PG8_BAR; PG8_WAIT_L(0); PG8_MMA(0, 1, At, B1); PG8_BAR;
            PG8_LDA(At, 0, 1); PG8_STAGE(PG8_SA(0, 0), a2, voffA);
            PG8_BAR; PG8_WAIT_L(0); PG8_MMA(1, 0, At, B0); PG8_BAR; PG8_SCHED;
            PG8_STAGE(PG8_SB(0, 1), b2 + hstep, voffB);
            PG8_WAIT_V(6); PG8_BAR; PG8_MMA(1, 1, At, B1); PG8_BAR;
            PG8_LDB(B0, 1, 0); PG8_SCHED; PG8_LDA(At, 1, 0); PG8_STAGE(PG8_SA(0, 1), a2 + hstep, voffA);
            PG8_WAIT_L(8); PG8_BAR; PG8_WAIT_L(0); PG8_MMA(0, 0, At, B0); PG8_BAR; PG8_SCHED;
            PG8_LDB(B1, 1, 1); PG8_STAGE(PG8_SB(1, 0), b3, voffB);
            PG8_BAR; PG8_WAIT_L(0); PG8_MMA(0, 1, At, B1); PG8_BAR;
            PG8_LDA(At, 1, 1); PG8_STAGE(PG8_SA(1, 0), a3, voffA);
            PG8_BAR; PG8_WAIT_L(0); PG8_MMA(1, 0, At, B0); PG8_BAR; PG8_SCHED;
            PG8_STAGE(PG8_SB(1, 1), b3 + hstep, voffB);
            PG8_WAIT_V(6); PG8_BAR; PG8_MMA(1, 1, At, B1); PG8_BAR;
        }
        PG8_STAMP();
        if constexpr (!Epi::AFTER_DRAIN) { E(acc, cur, wr, wc, fr, fq); S.done(cur); }
        PG8_STAMP();
        if (!has_next) break;
#pragma unroll
        for (int a = 0; a < 2; ++a)
#pragma unroll
            for (int b = 0; b < 2; ++b)
#pragma unroll
                for (int m = 0; m < 4; ++m)
#pragma unroll
                    for (int n = 0; n < 2; ++n) acc[a][b][m][n] = (f32x4){0.f, 0.f, 0.f, 0.f};
        cur = nxt; cA = nA; cB = nB; ++ui;
    }
    PG8_WAIT_V(0);
    if (wr == 0) PG8_BAR;
    PG8_BAR;
    if constexpr (Epi::AFTER_DRAIN) { E.fused(acc, cur, wr, wc, fr, fq, lds, wid, lane); S.done(cur); }
    PG8_STAMP();
    if (STAMP && wid == 0) { stamps[lane] = lane < nts ? (((unsigned long long)(unsigned)ts_hi << 32) | (unsigned)ts_lo) : 0ull;
        if (lane == 62) stamps[62] = rt_entry; if (lane == 63) stamps[63] = (unsigned long long)wall_clock64(); }
#undef PG8_STAMP
#undef PG8_SA
#undef PG8_SB
#undef PG8_STAGE
#undef PG8_LDA
#undef PG8_LDB
#undef PG8_MMA
#undef PG8_WAIT_V
#undef PG8_WAIT_L
#undef PG8_BAR
#undef PG8_SCHED
}
}

#define XB_TMO      128
#define XB_XCNT(j)  (256  + 64 * (j))
#define XB_XSUB(j)  (1280 + 64 * (j))
#define XB_XGEN(j)  (2304 + 64 * (j))
#define XB_TOP      3328
#define XB_TOPGEN   3392
#define XCD_BAR_WORDS 3456
#define XB_SPIN_CAP (1u << 18)
#define LAS __attribute__((address_space(3)))

__device__ __forceinline__ unsigned xb_ld(unsigned* p)              { return __hip_atomic_load(p, __ATOMIC_RELAXED, __HIP_MEMORY_SCOPE_AGENT); }
__device__ __forceinline__ unsigned xb_add(unsigned* p, unsigned v) { return __hip_atomic_fetch_add(p, v, __ATOMIC_RELAXED, __HIP_MEMORY_SCOPE_AGENT); }
__device__ __forceinline__ unsigned xb_xcc_id() { return (unsigned)__builtin_amdgcn_s_getreg((3 << 11) | 20) & 0xFu; }
#define XB_SPIN(cond, bar) do { unsigned _sp = 0; while (cond) { __builtin_amdgcn_s_sleep(1); \
    if ((++_sp & 255u) == 0u) { if (xb_ld(&(bar)[XB_TMO])) break; if (_sp > XB_SPIN_CAP) { atomicAdd(&(bar)[XB_TMO], 1u); break; } } } } while (0)

struct XcdBarrier {
    unsigned* bar; unsigned x; int wave;
    volatile LAS unsigned* st;
};

__device__ __forceinline__ bool xb_t0(int wave) { return wave == 0 && __builtin_amdgcn_mbcnt_hi(~0u, __builtin_amdgcn_mbcnt_lo(~0u, 0u)) == 0u; }
__device__ __forceinline__ XcdBarrier xcd_barrier_post(unsigned* bar, volatile LAS unsigned* st, int wave) {
    XcdBarrier b; b.bar = bar; b.x = xb_xcc_id(); b.st = st; b.wave = wave;
    if (xb_t0(wave)) (void)xb_add(&bar[XB_XCNT(b.x)], 1u);
    return b;
}
__device__ __forceinline__ void xcd_barrier_complete(unsigned* bar, unsigned x, unsigned& nloc, unsigned& nx) {
    const unsigned G = gridDim.x * gridDim.y * gridDim.z;
    unsigned sum, cnt, mine, sp = 0u;
    for (;;) {
        sum = 0u; cnt = 0u; mine = 0u;
#pragma unroll
        for (unsigned j = 0; j < 16; ++j) { const unsigned c = xb_ld(&bar[XB_XCNT(j)]); sum += c; cnt += (c > 0u) ? 1u : 0u; mine = (j == x) ? c : mine; }
        if (sum == G) break;
        __builtin_amdgcn_s_sleep(1);
        if ((++sp & 255u) == 0u) { if (xb_ld(&bar[XB_TMO])) break; if (sp > XB_SPIN_CAP) { atomicAdd(&bar[XB_TMO], 1u); break; } }
    }
    nloc = mine > 0u ? mine : 1u; nx = cnt > 0u ? cnt : 1u;
}

__device__ __forceinline__ void xcd_barrier(const XcdBarrier& b) {
    asm volatile("s_waitcnt vmcnt(0)" ::: "memory");
    __syncthreads();
    if (xb_t0(b.wave)) {
        unsigned* bar = b.bar;
        __builtin_amdgcn_s_waitcnt(0);
        unsigned nloc = b.st[0], nx = b.st[1];
        if (nloc == 0u) { xcd_barrier_complete(bar, b.x, nloc, nx); b.st[0] = nloc; b.st[1] = nx; }
        const unsigned old = xb_add(&bar[XB_XSUB(b.x)], 1u);
        const unsigned gen = old / nloc;
        if (old + 1u == (gen + 1u) * nloc) {
            __builtin_amdgcn_fence(__ATOMIC_RELEASE, "agent");
            asm volatile("s_waitcnt vmcnt(0)" ::: "memory");
            const unsigned og = xb_add(&bar[XB_TOP], 1u);
            const unsigned tg = og / nx;
            if (og + 1u == (tg + 1u) * nx) xb_add(&bar[XB_TOPGEN], 1u);
            else XB_SPIN(xb_ld(&bar[XB_TOPGEN]) == tg, bar);
            __builtin_amdgcn_fence(__ATOMIC_ACQUIRE, "agent");
            xb_add(&bar[XB_XGEN(b.x)], 1u);
            asm volatile("s_waitcnt vmcnt(0)" ::: "memory");
        } else {
            XB_SPIN(xb_ld(&bar[XB_XGEN(b.x)]) == gen, bar);
            __builtin_amdgcn_fence(__ATOMIC_ACQUIRE, "agent");
            asm volatile("s_waitcnt vmcnt(0)" ::: "memory");
        }
    }
    __syncthreads();
}


constexpr int NB = 4, SEQ = 8192, D = 1024, NTOK = NB * SEQ;
constexpr int NH = 8, HD = 64, BW = 512;
constexpr int IN_COLS = 5408, NPAD = 5632;
constexpr int LK = 384;
constexpr int NE = 32, DE = 512;
constexpr int CH = 64, NCH = SEQ / CH, NCH_LOG = 7, NCHUNK = NB * NH * NCH;
constexpr int MAXT = 288;
constexpr float NORM_EPS = 1e-6f, GN_EPS = 64e-5f, L2_EPS = 1e-12f;
constexpr float SB_STOP = -120.0f;

constexpr size_t MiB = 1u << 20;
constexpr size_t WS_CTL = 0, CTL_ZERO_BYTES = 65536;
constexpr size_t WS_MOD = 1 * MiB;
constexpr size_t WS_RTW = WS_MOD + 128 * 1024;
constexpr size_t WS_TOK = WS_RTW + 160 * 1024;
constexpr size_t WS_CNT = WS_TOK + (size_t)NTOK * 16;
constexpr size_t WS_TILE = WS_CNT + 256 * 32 * 4;
constexpr size_t WS_WIN = 2 * MiB;
constexpr size_t WS_WOSB = 13 * MiB, WS_WORW = 14 * MiB, WS_WOUT = 15 * MiB;
constexpr size_t WS_WL = 17 * MiB;
constexpr size_t WS_BON = 18 * MiB + 256 * 1024;
constexpr size_t WS_CW = 19 * MiB + 768 * 1024;
constexpr size_t WS_QB = 20 * MiB;
constexpr size_t WS_GATE = 52 * MiB;
constexpr size_t WS_GG = 180 * MiB;
constexpr size_t WS_KB = 212 * MiB, WS_VT = 244 * MiB;
constexpr size_t WS_LORA = 276 * MiB;
constexpr size_t WS_ALORA = 308 * MiB;
constexpr size_t WS_E = 340 * MiB, WS_B = 372 * MiB;
constexpr size_t WS_RWRAW = 416 * MiB;
constexpr size_t WS_P = 212 * MiB, WS_QO = 244 * MiB;
constexpr size_t WS_GT = 276 * MiB;
constexpr size_t WS_HT = 308 * MiB;
constexpr size_t WS_SC = 340 * MiB;
constexpr size_t WS_YRW = 384 * MiB;
constexpr size_t WS_WUP = 416 * MiB, WS_WDN = 480 * MiB;
constexpr size_t WS_MRG = 212 * MiB;
constexpr size_t WS_Y1 = 276 * MiB;
constexpr size_t WS_H2 = 52 * MiB;
constexpr size_t WS_HS = 116 * MiB;
constexpr size_t WS_HID = 260 * MiB;
constexpr size_t WS_X1 = 340 * MiB;
constexpr size_t WS_END = 512 * MiB;
static_assert(WS_TILE + (MAXT + 1) * 4 <= WS_WIN && WS_WIN + (size_t)NPAD * D * 2 <= WS_WOSB && WS_WL + 1536 * LK * 2 <= WS_QB, "fixed region");
static_assert(WS_HS + (size_t)MAXT * 256 * D * 2 <= WS_HID && WS_HID + (size_t)MAXT * 256 * DE * 2 <= WS_WUP, "moe region");
static_assert(WS_ALORA + (size_t)NTOK * LK * 2 <= WS_E && WS_B + (size_t)NTOK * BW * 2 <= WS_RWRAW, "rwkv region");

constexpr int LDS_BYTES = 163840;
constexpr int LDS_MISC = LDS_BYTES - 256;
constexpr int NWAVES = 8, NTHR = 512;

typedef unsigned short bf16;
typedef short bf16x8 __attribute__((ext_vector_type(8)));
typedef short s16x4 __attribute__((ext_vector_type(4)));
typedef float f32x4 __attribute__((ext_vector_type(4)));
typedef float f32x16 __attribute__((ext_vector_type(16)));
typedef unsigned u32x4 __attribute__((ext_vector_type(4)));
typedef unsigned u32x2 __attribute__((ext_vector_type(2)));
typedef int i32x4 __attribute__((ext_vector_type(4)));
#define DI __device__ __forceinline__
#define GAS __attribute__((address_space(1)))
#define MFMA32(a, b, c) __builtin_amdgcn_mfma_f32_32x32x16_bf16((a), (b), (c), 0, 0, 0)

typedef float f32x2_t __attribute__((ext_vector_type(2))); typedef __bf16 bf16x2_t __attribute__((ext_vector_type(2)));
DI unsigned pk2(float lo, float hi) { f32x2_t v = {lo, hi}; return __builtin_bit_cast(unsigned, __builtin_convertvector(v, bf16x2_t)); }
DI unsigned f2bf(float f) { return pk2(f, 0.0f) & 0xffffu; }
DI float bflo(unsigned u) { return __builtin_bit_cast(float, u << 16); }
DI float bfhi(unsigned u) { return __builtin_bit_cast(float, u & 0xffff0000u); }
DI float bf2f(bf16 h) { return __builtin_bit_cast(float, (unsigned)h << 16); }
DI float fexp(float x) { return __expf(x); }
DI float frcp(float x) { return __builtin_amdgcn_rcpf(x); }
DI float fsigmoid(float x) { return frcp(1.0f + fexp(-x)); }
DI float fsoftplus(float x) { return fmaxf(x, 0.0f) + __logf(1.0f + fexp(-fabsf(x))); }
#define DPP_SHR(v, ctrl) __builtin_bit_cast(float, __builtin_amdgcn_update_dpp(0, __builtin_bit_cast(int, (v)), (ctrl), 0xf, 0xf, true))
DI float wave_sum(float v) {
    v += DPP_SHR(v, 0x111); v += DPP_SHR(v, 0x112); v += DPP_SHR(v, 0x114); v += DPP_SHR(v, 0x118);
    v += __builtin_bit_cast(float, __builtin_amdgcn_update_dpp(0, __builtin_bit_cast(int, v), 0x142, 0xa, 0xf, false));
    v += __builtin_bit_cast(float, __builtin_amdgcn_update_dpp(0, __builtin_bit_cast(int, v), 0x143, 0xc, 0xf, false));
    return __builtin_bit_cast(float, __builtin_amdgcn_readlane(__builtin_bit_cast(int, v), 63));
}
DI float shfl_xor_l(float v, int m, int lane) { return __builtin_bit_cast(float, __builtin_amdgcn_ds_bpermute(4 * (lane ^ m), __builtin_bit_cast(int, v))); }
DI int crow(int reg, int hh) { return (reg & 3) + 8 * (reg >> 2) + 4 * hh; }
DI void wave_lds_fence() { __builtin_amdgcn_fence(__ATOMIC_RELEASE, "wavefront"); __builtin_amdgcn_wave_barrier(); __builtin_amdgcn_fence(__ATOMIC_ACQUIRE, "wavefront"); }
DI void unpack8(const u32x4 v, float (&o)[8]) { o[0] = bflo(v.x); o[1] = bfhi(v.x); o[2] = bflo(v.y); o[3] = bfhi(v.y); o[4] = bflo(v.z); o[5] = bfhi(v.z); o[6] = bflo(v.w); o[7] = bfhi(v.w); }
DI u32x4 pack8(const float (&o)[8]) { u32x4 v; v.x = pk2(o[0], o[1]); v.y = pk2(o[2], o[3]); v.z = pk2(o[4], o[5]); v.w = pk2(o[6], o[7]); return v; }
DI bf16x8 pack8v(float a0, float a1, float a2, float a3, float a4, float a5, float a6, float a7) {
    u32x4 v; v.x = pk2(a0, a1); v.y = pk2(a2, a3); v.z = pk2(a4, a5); v.w = pk2(a6, a7); return __builtin_bit_cast(bf16x8, v); }


#if defined(CHECKS)
constexpr int DBG_TOKEN = 77;
#endif

typedef pg8::f32x4 af4;
DI void st8(bf16* p, const af4 v0, const af4 v1) { u32x4 w; w.x = pk2(v0[0], v0[1]); w.y = pk2(v0[2], v0[3]); w.z = pk2(v1[0], v1[1]); w.w = pk2(v1[2], v1[3]); *(u32x4*)p = w; }

struct EpiIn {
    static constexpr bool PERM = true, AFTER_DRAIN = false;
    bf16 *Q, *K, *Vt, *RW, *LO, *GA; const float* gate_bias;
    DI void operator()(const af4 (&acc)[2][2][4][2], const pg8::Unit& u, int wr, int wc, int fr, int fq) const {
        const int pn = u.pn, row0 = u.pm * 256 + wr * 64 + fr;
        if (pn == 4 || pn == 5) {
#pragma unroll
            for (int ai = 0; ai < 2; ++ai)
#pragma unroll
                for (int m = 0; m < 4; ++m) { const int row = row0 + ai * 128 + m * 16, b = row >> 13, s = row & (SEQ - 1);
#pragma unroll
                    for (int bj = 0; bj < 2; ++bj)
#pragma unroll
                        for (int n = 0; n < 2; ++n)
#pragma unroll
                            for (int j = 0; j < 4; ++j) { const int cv = (pn - 4) * 256 + bj * 128 + wc * 32 + 8 * fq + 4 * n + j;
                                Vt[((size_t)(b * BW + cv)) * SEQ + s] = (bf16)f2bf(acc[ai][bj][m][n][j]); } }
        } else if (pn >= 14) {
            const int col0 = (pn - 14) * 256 + wc * 32 + 8 * fq;
            af4 bv[2][2];
#pragma unroll
            for (int bj = 0; bj < 2; ++bj)
#pragma unroll
                for (int n = 0; n < 2; ++n) bv[bj][n] = *(const af4*)(gate_bias + col0 + bj * 128 + 4 * n);
#pragma unroll
            for (int ai = 0; ai < 2; ++ai)
#pragma unroll
                for (int m = 0; m < 4; ++m) { bf16* rowp = GA + (size_t)(row0 + ai * 128 + m * 16) * 2048 + col0;
#pragma unroll
                    for (int bj = 0; bj < 2; ++bj) { af4 v0 = acc[ai][bj][m][0] + bv[bj][0], v1 = acc[ai][bj][m][1] + bv[bj][1];
#pragma unroll
                        for (int j = 0; j < 4; ++j) { v0[j] = fsigmoid(v0[j]); v1[j] = fsigmoid(v1[j]); }
                        st8(rowp + bj * 128, v0, v1); } }
        } else {
            bf16* base; int ld, ct; float sc = 1.0f;
            if (pn < 2) { base = Q; ld = BW; ct = pn; sc = 0.125f; } else if (pn < 4) { base = K; ld = BW; ct = pn - 2; } else if (pn < 12) { base = RW; ld = 1536; ct = pn - 6; } else { base = LO; ld = BW; ct = pn - 12; }
            const int col0 = ct * 256 + wc * 32 + 8 * fq;
#pragma unroll
            for (int ai = 0; ai < 2; ++ai)
#pragma unroll
                for (int m = 0; m < 4; ++m) { bf16* rowp = base + (size_t)(row0 + ai * 128 + m * 16) * ld + col0;
#pragma unroll
                    for (int bj = 0; bj < 2; ++bj) st8(rowp + bj * 128, acc[ai][bj][m][0] * sc, acc[ai][bj][m][1] * sc); }
        }
    }
};

template <bool ADD> struct EpiMerge {
    static constexpr bool PERM = true, AFTER_DRAIN = false;
    bf16* GA; bf16* MRG; int gofs;
    DI void operator()(const af4 (&acc)[2][2][4][2], const pg8::Unit& u, int wr, int wc, int fr, int fq) const {
        const int row0 = u.pm * 256 + wr * 64 + fr, col0 = u.pn * 256 + wc * 32 + 8 * fq;
#pragma unroll
        for (int ai = 0; ai < 2; ++ai)
#pragma unroll
            for (int m = 0; m < 4; ++m) { const size_t row = (size_t)(row0 + ai * 128 + m * 16);
#pragma unroll
                for (int bj = 0; bj < 2; ++bj) { const int c = col0 + bj * 128;
                    float g[8]; unpack8(*(const u32x4*)(GA + row * 2048 + gofs + c), g);
                    af4 v0, v1;
#pragma unroll
                    for (int j = 0; j < 4; ++j) { v0[j] = g[j] * acc[ai][bj][m][0][j]; v1[j] = g[4 + j] * acc[ai][bj][m][1][j]; }
                    if (ADD) { float o[8]; unpack8(*(const u32x4*)(GA + row * 2048 + c), o);
#pragma unroll
                        for (int j = 0; j < 4; ++j) { v0[j] += o[j]; v1[j] += o[4 + j]; }
                        st8(MRG + row * D + c, v0, v1); }
                    else st8(GA + row * 2048 + c, v0, v1); } }
    }
};

struct EpiPlain {
    static constexpr bool PERM = true, AFTER_DRAIN = false;
    bf16* O; int ld, cmask;
    DI void operator()(const af4 (&acc)[2][2][4][2], const pg8::Unit& u, int wr, int wc, int fr, int fq) const {
        const int row0 = u.pm * 256 + wr * 64 + fr, col0 = (u.pn & cmask) * 256 + wc * 32 + 8 * fq;
#pragma unroll
        for (int ai = 0; ai < 2; ++ai)
#pragma unroll
            for (int m = 0; m < 4; ++m) { bf16* rowp = O + (size_t)(row0 + ai * 128 + m * 16) * ld + col0;
#pragma unroll
                for (int bj = 0; bj < 2; ++bj) st8(rowp + bj * 128, acc[ai][bj][m][0], acc[ai][bj][m][1]); }
    }
};

struct EpiUp {
    static constexpr bool PERM = true, AFTER_DRAIN = false;
    bf16* HID;
    DI void operator()(const af4 (&acc)[2][2][4][2], const pg8::Unit& u, int wr, int wc, int fr, int fq) const {
        const int row0 = u.pm * 256 + wr * 64 + fr, col0 = (u.pn & 3) * 128 + wc * 16 + 4 * fq;
#pragma unroll
        for (int ai = 0; ai < 2; ++ai)
#pragma unroll
            for (int m = 0; m < 4; ++m) { bf16* rowp = HID + (size_t)(row0 + ai * 128 + m * 16) * DE + col0;
#pragma unroll
                for (int bj = 0; bj < 2; ++bj) { float h[4];
#pragma unroll
                    for (int j = 0; j < 4; ++j) { const float u1 = acc[ai][bj][m][0][j]; h[j] = u1 * fsigmoid(u1) * acc[ai][bj][m][1][j]; }
                    __hip_atomic_store((GAS unsigned long long*)(rowp + bj * 64), (unsigned long long)pk2(h[0], h[1]) | ((unsigned long long)pk2(h[2], h[3]) << 32), __ATOMIC_RELAXED, __HIP_MEMORY_SCOPE_AGENT); } }
    }
};

constexpr unsigned MOE_CNT_WORD = 3584, MOE_CNT_STRIDE = 16;
struct MoeUpOrder {
    int nunits, G, vc; const int* tile_e; unsigned* cnt;
    DI bool next(int i, pg8::Unit& u) const { const long L = (long)i * G + vc; if (L >= nunits) return false; const int rt = (int)(L >> 2);
        u.pm = rt; u.pn = __builtin_amdgcn_readfirstlane(tile_e[rt]) * 4 + (int)(L & 3); return true; }
    DI void a_ready(const pg8::Unit&) const {}
    DI void done(const pg8::Unit& u) const { asm volatile("s_waitcnt vmcnt(0)" ::: "memory");
        if (__builtin_amdgcn_mbcnt_hi(~0u, __builtin_amdgcn_mbcnt_lo(~0u, 0u)) == 0u) __hip_atomic_fetch_add(cnt + MOE_CNT_STRIDE * u.pm, 1u, __ATOMIC_RELAXED, __HIP_MEMORY_SCOPE_AGENT); }
};
struct MoeDnOrder {
    int nunits, G, vc, q, rem, wave; const int* tile_e; unsigned* cnt;
    DI bool next(int i, pg8::Unit& u) const { long L;
        if (vc >= rem) { if (i > q) return false; L = (long)i * (G - rem) + (vc - rem); } else L = (long)(q + 1) * (G - rem) + (long)i * rem + vc;
        if (L >= nunits) return false; const int rt = (int)(L >> 2);
        u.pm = rt; u.pn = __builtin_amdgcn_readfirstlane(tile_e[rt]) * 4 + (int)(L & 3); return true; }
    DI void a_ready(const pg8::Unit& u) const {
        if (wave == 0) { unsigned sp = 0;
            while ((unsigned)__builtin_amdgcn_readfirstlane(__hip_atomic_load(cnt + MOE_CNT_STRIDE * u.pm, __ATOMIC_RELAXED, __HIP_MEMORY_SCOPE_AGENT)) < 32u) { __builtin_amdgcn_s_sleep(2); if (++sp > (1u << 22)) break; }
            __builtin_amdgcn_fence(__ATOMIC_ACQUIRE, "agent");
            asm volatile("s_waitcnt vmcnt(0)" ::: "memory"); }
        asm volatile("" ::: "memory"); __builtin_amdgcn_s_barrier(); asm volatile("" ::: "memory"); }
    DI void done(const pg8::Unit&) const {}
};

struct Args {
    const float *x, *c, *w_mod, *b_mod, *gains, *w_in, *gate_bias, *shift_mu, *w0, *w_decay_up, *a0, *w_iclr_up, *w_gate_up, *k_k, *k_a, *r_k, *lnx_w, *lnx_b,
                *w_o_sb, *w_o_rw, *w_out, *w_group, *w_router, *w_up1, *w_up3, *w_down;
    float* out; unsigned char* ws;
};
struct Frame { LAS unsigned char* lds; int tid, lane, wave, wg, G, gw, NGW; };
#define CAS __attribute__((address_space(4)))
typedef const CAS Args& ARef;

DI void tr_item(const float* W, int ldw, int K, bf16* WT, int k0, int drow0, int scol0, LAS float* scr, int lane) {
    if (scol0 >= 0) {
        float v[32];
        const float* wp = W + (size_t)(k0 + (lane >> 5)) * ldw + scol0 + (lane & 31);
#pragma unroll
        for (int i = 0; i < 32; ++i) v[i] = wp[(size_t)(2 * i) * ldw];
#pragma unroll
        for (int i = 0; i < 32; ++i) scr[(2 * i + (lane >> 5)) * 33 + (lane & 31)] = v[i];
    } else {
#pragma unroll 8
        for (int i = 0; i < 32; ++i) { const int kk = 2 * i + (lane >> 5); scr[kk * 33 + (lane & 31)] = 0.0f; }
    }
    wave_lds_fence();
    const int c = lane & 7;
#pragma unroll
    for (int j = 0; j < 4; ++j) { const int n = (lane >> 3) + 8 * j; const LAS float* s = scr + (8 * c) * 33 + n;
        u32x4 o; o.x = pk2(s[0 * 33], s[1 * 33]); o.y = pk2(s[2 * 33], s[3 * 33]); o.z = pk2(s[4 * 33], s[5 * 33]); o.w = pk2(s[6 * 33], s[7 * 33]);
        *(u32x4*)(WT + (size_t)(drow0 + n) * K + k0 + 8 * c) = o; }
    wave_lds_fence();
}
DI void tr_item_up(const float* W1, const float* W3, bf16* WT, int e, int k0, int drow0, LAS float* scr, int lane) {
    const int l31 = lane & 31, sc = (drow0 >> 3) * 4 + (l31 >> 3) * 4 + (l31 & 3);
    const float* W = ((l31 & 4) ? W3 : W1) + (size_t)e * D * DE;
    { float v[32]; const float* wp = W + (size_t)(k0 + (lane >> 5)) * DE + sc;
#pragma unroll
        for (int i = 0; i < 32; ++i) v[i] = wp[(size_t)(2 * i) * DE];
#pragma unroll
        for (int i = 0; i < 32; ++i) scr[(2 * i + (lane >> 5)) * 33 + l31] = v[i]; }
    wave_lds_fence();
    const int c = lane & 7;
#pragma unroll
    for (int j = 0; j < 4; ++j) { const int n = (lane >> 3) + 8 * j; const LAS float* s = scr + (8 * c) * 33 + n;
        u32x4 o; o.x = pk2(s[0 * 33], s[1 * 33]); o.y = pk2(s[2 * 33], s[3 * 33]); o.z = pk2(s[4 * 33], s[5 * 33]); o.w = pk2(s[6 * 33], s[7 * 33]);
        *(u32x4*)(WT + ((size_t)e * 1024 + drow0 + n) * D + k0 + 8 * c) = o; }
    wave_lds_fence();
}

DI void p0_prologue(const Frame& F0, ARef A) {
    Frame F = F0; F.tid = opq_tid(F0.wave); F.lane = F.tid & 63; F.wave = __builtin_amdgcn_readfirstlane(F.tid >> 6); F.gw = F.wg * NWAVES + F.wave;
    unsigned char* ws = A.ws;
    LAS float* sl = (LAS float*)F.lds;
    LAS float* part = (LAS float*)(F.lds + 16384);
    for (int i = F.tid; i < NB * D; i += NTHR) { const float v = A.c[i]; sl[i] = v * fsigmoid(v); }
    __syncthreads();
    float* mod = (float*)(ws + WS_MOD);
    for (int cg = F.wg; cg < 256; cg += F.G) {
        const int col = F.tid & 31, kg = F.tid >> 5;
        if (col < 24) { float a0 = 0.f, a1 = 0.f, a2 = 0.f, a3 = 0.f;
#pragma unroll 8
            for (int kk = 0; kk < 64; ++kk) { const int k = kg * 64 + kk; const float w = A.w_mod[(size_t)k * 6144 + cg * 24 + col];
                a0 += sl[k] * w; a1 += sl[D + k] * w; a2 += sl[2 * D + k] * w; a3 += sl[3 * D + k] * w; }
            LAS float* p = part + (kg * 24 + col) * 4; p[0] = a0; p[1] = a1; p[2] = a2; p[3] = a3; }
        __syncthreads();
        if (F.tid < 96) { const int c = F.tid >> 2, b = F.tid & 3; float s = 0.f;
#pragma unroll
            for (int kg2 = 0; kg2 < 16; ++kg2) s += part[(kg2 * 24 + c) * 4 + b];
            mod[b * 6144 + cg * 24 + c] = s + A.b_mod[cg * 24 + c]; }
        __syncthreads();
    }
    LAS float* scr = (LAS float*)(F.lds + 32768 + F.wave * 8704);
    constexpr int I_IN = (NPAD / 32) * (D / 64), I_OS = (D / 32) * (BW / 64), I_OUT = (D / 32) * (D / 64);
    for (int it = F.gw; it < I_IN + 2 * I_OS + I_OUT; it += F.NGW) {
        int r = it;
        if (r < I_IN) { const int g = r / (D / 64), kb = r % (D / 64), drow0 = 32 * g;
            const int sc = drow0 < 3360 ? drow0 : (drow0 < 3584 ? -1 : drow0 - 224);
            tr_item(A.w_in, IN_COLS, D, (bf16*)(ws + WS_WIN), 64 * kb, drow0, sc, scr, F.lane); continue; }
        r -= I_IN;
        if (r < I_OS) { const int g = r / (BW / 64), kb = r % (BW / 64); tr_item(A.w_o_sb, D, BW, (bf16*)(ws + WS_WOSB), 64 * kb, 32 * g, 32 * g, scr, F.lane); continue; }
        r -= I_OS;
        if (r < I_OS) { const int g = r / (BW / 64), kb = r % (BW / 64); tr_item(A.w_o_rw, D, BW, (bf16*)(ws + WS_WORW), 64 * kb, 32 * g, 32 * g, scr, F.lane); continue; }
        r -= I_OS;
        { const int g = r / (D / 64), kb = r % (D / 64); tr_item(A.w_out, D, D, (bf16*)(ws + WS_WOUT), 64 * kb, 32 * g, 32 * g, scr, F.lane); }
    }
    const int gt = F.wg * NTHR + F.tid, NGT = F.G * NTHR;
    float* rtw = (float*)(ws + WS_RTW);
    for (int i = gt; i < 36 * D; i += NGT) { const int o = i >> 10, k = i & (D - 1); rtw[i] = o < 4 ? A.w_group[k * 4 + o] : A.w_router[k * NE + (o - 4)]; }
    bf16* wl = (bf16*)(ws + WS_WL);
    for (int i = gt; i < 1536 * LK; i += NGT) { const int n = i / LK, k = i % LK; float v = 0.f;
        if (n < 512) { if (k < 64) v = A.w_decay_up[k * BW + n]; }
        else if (n < 1024) { if (k >= 64 && k < 128) v = A.w_iclr_up[(k - 64) * BW + (n - 512)]; }
        else { if (k >= 128 && k < 288) v = A.w_gate_up[(k - 128) * BW + (n - 1024)]; }
        wl[i] = (bf16)f2bf(v); }
}

DI void p1_h1(const Frame& F0, ARef A, bf16* H1) {
    Frame F = F0; F.tid = opq_tid(F0.wave); F.lane = F.tid & 63; F.wave = __builtin_amdgcn_readfirstlane(F.tid >> 6); F.gw = F.wg * NWAVES + F.wave;
    const float* mod = (const float*)(A.ws + WS_MOD);
    for (int n = F.gw; n < NTOK; n += F.NGW) {
        const int b = n >> 13;
        const f32x4* xr = (const f32x4*)(A.x + (size_t)n * D) + F.lane;
        f32x4 v[4]; float s = 0.f;
#pragma unroll
        for (int j = 0; j < 4; ++j) { v[j] = xr[64 * j]; s += (v[j][0] * v[j][0] + v[j][1] * v[j][1]) + (v[j][2] * v[j][2] + v[j][3] * v[j][3]); }
        const float inv = rsqrtf(wave_sum(s) * (1.0f / D) + NORM_EPS);
        u32x2* o = (u32x2*)(H1 + (size_t)n * D) + F.lane;
#pragma unroll
        for (int j = 0; j < 4; ++j) { const int k = 4 * F.lane + 256 * j;
            const f32x4 g = *(const f32x4*)(A.gains + k), sh = *(const f32x4*)(mod + b * 6144 + k), sc = *(const f32x4*)(mod + b * 6144 + D + k);
            f32x4 h;
#pragma unroll
            for (int q = 0; q < 4; ++q) h[q] = (v[j][q] * inv) * g[q] * (1.0f + sc[q]) + sh[q];
            u32x2 w; w.x = pk2(h[0], h[1]); w.y = pk2(h[2], h[3]); o[64 * j] = w; }
    }
}

DI void p3_attn(const Frame& F0, const bf16* QB, const bf16* KB, const bf16* VT, bf16* YSB) {
    Frame F = F0; F.tid = opq_tid(F0.wave); F.lane = F.tid & 63; F.wave = __builtin_amdgcn_readfirstlane(F.tid >> 6); F.gw = F.wg * NWAVES + F.wave;
    const int lane = F.lane, r = lane & 31, hh = lane >> 5;
    bf16x8 tri[2];
#pragma unroll
    for (int s = 0; s < 2; ++s)
#pragma unroll
        for (int e = 0; e < 8; ++e) tri[s][e] = (16 * s + 8 * (e >> 2) + 4 * hh + (e & 3)) > r ? (short)0x3F80 : (short)0;
    for (int u = F.gw; u < NB * NH * (SEQ / 32); u += F.NGW) {
        const int bh = u >> 8, qt = u & 255, b = bh >> 3, h = bh & 7;
        const bf16* qp = QB + (size_t)(b * SEQ + qt * 32 + r) * BW + h * HD + 8 * hh;
        bf16x8 qf[4];
#pragma unroll
        for (int ks = 0; ks < 4; ++ks) qf[ks] = *(const bf16x8*)(qp + 16 * ks);
        f32x16 o0, o1;
#pragma unroll
        for (int i = 0; i < 16; ++i) { o0[i] = 0.f; o1[i] = 0.f; }
        float L = 0.f;
        bf16x8 kf[4]; s16x4 vlo[2][2], vhi[2][2];
#define ATT_LOAD(KT, KF, VLO, VHI) do { const bf16* kp_ = KB + (size_t)(b * SEQ + (KT) * 32 + r) * BW + h * HD + 8 * hh; \
            _Pragma("unroll") for (int ks = 0; ks < 4; ++ks) KF[ks] = *(const bf16x8*)(kp_ + 16 * ks); \
            const bf16* vp_ = VT + ((size_t)(bh * HD + r)) * SEQ + (KT) * 32 + 4 * hh; \
            _Pragma("unroll") for (int mb = 0; mb < 2; ++mb) _Pragma("unroll") for (int ks = 0; ks < 2; ++ks) { VLO[mb][ks] = *(const s16x4*)(vp_ + (size_t)mb * 32 * SEQ + 16 * ks); VHI[mb][ks] = *(const s16x4*)(vp_ + (size_t)mb * 32 * SEQ + 16 * ks + 8); } } while (0)
        ATT_LOAD(qt, kf, vlo, vhi);
        for (int kt = qt; kt >= 0; --kt) {
            bf16x8 kfn[4]; s16x4 vlon[2][2], vhin[2][2];
            { const int ktn = kt > 0 ? kt - 1 : 0; ATT_LOAD(ktn, kfn, vlon, vhin); }
            f32x16 z;
#pragma unroll
            for (int i = 0; i < 16; ++i) z[i] = 0.f;
#pragma unroll
            for (int ks = 0; ks < 4; ++ks) z = MFMA32(kf[ks], qf[ks], z);
            const bool diag = (kt == qt);
            float lk[16], lo[16], tot = 0.f;
#pragma unroll
            for (int i = 0; i < 16; ++i) { const bool valid = !diag || (crow(i, hh) < r);
                const float sp = fsoftplus(z[i]); lk[i] = valid ? -sp : 0.0f; z[i] = valid ? z[i] - sp : -1.0e30f;
                tot += lk[i];
                const float hi = bflo(f2bf(lk[i])); lo[i] = lk[i] - hi; lk[i] = hi; }
            tot += shfl_xor_l(tot, 32, lane);
            f32x16 lat;
#pragma unroll
            for (int i = 0; i < 16; ++i) lat[i] = L;
#pragma unroll
            for (int s = 0; s < 2; ++s) {
                lat = MFMA32(tri[s], pack8v(lk[8 * s], lk[8 * s + 1], lk[8 * s + 2], lk[8 * s + 3], lk[8 * s + 4], lk[8 * s + 5], lk[8 * s + 6], lk[8 * s + 7]), lat);
                lat = MFMA32(tri[s], pack8v(lo[8 * s], lo[8 * s + 1], lo[8 * s + 2], lo[8 * s + 3], lo[8 * s + 4], lo[8 * s + 5], lo[8 * s + 6], lo[8 * s + 7]), lat); }
            float at[16];
#pragma unroll
            for (int i = 0; i < 16; ++i) at[i] = fexp(z[i] + lat[i]);
#pragma unroll
            for (int s = 0; s < 2; ++s) { const bf16x8 ab = pack8v(at[8 * s], at[8 * s + 1], at[8 * s + 2], at[8 * s + 3], at[8 * s + 4], at[8 * s + 5], at[8 * s + 6], at[8 * s + 7]);
                bf16x8 va, vb;
#pragma unroll
                for (int e = 0; e < 4; ++e) { va[e] = vlo[0][s][e]; va[4 + e] = vhi[0][s][e]; vb[e] = vlo[1][s][e]; vb[4 + e] = vhi[1][s][e]; }
                o0 = MFMA32(va, ab, o0); o1 = MFMA32(vb, ab, o1); }
            L += tot;
            if (__all(L < SB_STOP)) break;
#pragma unroll
            for (int ks = 0; ks < 4; ++ks) kf[ks] = kfn[ks];
#pragma unroll
            for (int mb = 0; mb < 2; ++mb)
#pragma unroll
                for (int ks = 0; ks < 2; ++ks) { vlo[mb][ks] = vlon[mb][ks]; vhi[mb][ks] = vhin[mb][ks]; }
        }
#undef ATT_LOAD
        bf16* op = YSB + (size_t)(b * SEQ + qt * 32 + r) * BW + h * HD + 4 * hh;
#pragma unroll
        for (int g = 0; g < 4; ++g) { u32x2 w0, w1; w0.x = pk2(o0[4 * g], o0[4 * g + 1]); w0.y = pk2(o0[4 * g + 2], o0[4 * g + 3]); w1.x = pk2(o1[4 * g], o1[4 * g + 1]); w1.y = pk2(o1[4 * g + 2], o1[4 * g + 3]);
            *(u32x2*)(op + 8 * g) = w0; *(u32x2*)(op + 32 + 8 * g) = w1; }
    }
}

DI void p3_prep(const Frame& F0, ARef A, const bf16* RWRAW, const bf16* LORA, bf16* R, bf16* KS, bf16* V, bf16* KK, bf16* ALORA) {
    Frame F = F0; F.tid = opq_tid(F0.wave); F.lane = F.tid & 63; F.wave = __builtin_amdgcn_readfirstlane(F.tid >> 6); F.gw = F.wg * NWAVES + F.wave;
    const int lane = F.lane;
    f32x4 mu[3][2], kkc[2], mul[2];
#pragma unroll
    for (int part = 0; part < 3; ++part) { mu[part][0] = *(const f32x4*)(A.shift_mu + part * 512 + lane * 8); mu[part][1] = *(const f32x4*)(A.shift_mu + part * 512 + lane * 8 + 4); }
    kkc[0] = *(const f32x4*)(A.k_k + lane * 8); kkc[1] = *(const f32x4*)(A.k_k + lane * 8 + 4);
    const int lcol = lane < 36 ? lane * 8 : 0;
    mul[0] = *(const f32x4*)(A.shift_mu + 1536 + lcol); mul[1] = *(const f32x4*)(A.shift_mu + 1536 + lcol + 4);
    constexpr int RUN = 16;
    for (int run = F.gw; run < NTOK / RUN; run += F.NGW) {
        const int n0 = run * RUN;
        u32x4 prv[3], prl, cur[3], cul;
        const u32x4 z4 = {0u, 0u, 0u, 0u};
        if ((n0 & (SEQ - 1)) == 0) { prv[0] = z4; prv[1] = z4; prv[2] = z4; prl = z4; }
        else {
#pragma unroll
            for (int part = 0; part < 3; ++part) prv[part] = *(const u32x4*)(RWRAW + (size_t)(n0 - 1) * 1536 + part * 512 + lane * 8);
            prl = *(const u32x4*)(LORA + (size_t)(n0 - 1) * BW + lcol); }
#pragma unroll
        for (int part = 0; part < 3; ++part) cur[part] = *(const u32x4*)(RWRAW + (size_t)n0 * 1536 + part * 512 + lane * 8);
        cul = *(const u32x4*)(LORA + (size_t)n0 * BW + lcol);
        for (int i = 0; i < RUN; ++i) {
            const int n = n0 + i, nn = i + 1 < RUN ? n + 1 : n;
            u32x4 nxt[3], nxl;
#pragma unroll
            for (int part = 0; part < 3; ++part) nxt[part] = *(const u32x4*)(RWRAW + (size_t)nn * 1536 + part * 512 + lane * 8);
            nxl = *(const u32x4*)(LORA + (size_t)nn * BW + lcol);
            float xs[3][8];
#pragma unroll
            for (int part = 0; part < 3; ++part) { float p[8], q[8]; unpack8(cur[part], p); unpack8(prv[part], q);
#pragma unroll
                for (int j = 0; j < 4; ++j) { xs[part][j] = p[j] + mu[part][0][j] * (q[j] - p[j]); xs[part][4 + j] = p[4 + j] + mu[part][1][j] * (q[4 + j] - p[4 + j]); } }
            const size_t off = (size_t)n * BW + lane * 8;
            *(u32x4*)(R + off) = pack8(xs[0]); *(u32x4*)(KS + off) = pack8(xs[1]); *(u32x4*)(V + off) = pack8(xs[2]);
            float kk[8], ss = 0.f;
#pragma unroll
            for (int j = 0; j < 4; ++j) { kk[j] = xs[1][j] * kkc[0][j]; kk[4 + j] = xs[1][4 + j] * kkc[1][j]; }
#pragma unroll
            for (int j = 0; j < 8; ++j) ss += kk[j] * kk[j];
            ss += shfl_xor_l(ss, 1, lane); ss += shfl_xor_l(ss, 2, lane); ss += shfl_xor_l(ss, 4, lane);
            const float rn = 1.0f / fmaxf(sqrtf(ss), L2_EPS);
#pragma unroll
            for (int j = 0; j < 8; ++j) kk[j] *= rn;
            *(u32x4*)(KK + off) = pack8(kk);
            if (lane < 48) { float a[8];
                if (lane < 36) { float p[8], q[8]; unpack8(cul, p); unpack8(prl, q);
#pragma unroll
                    for (int j = 0; j < 8; ++j) { const float m = j < 4 ? mul[0][j & 3] : mul[1][j & 3]; const float v = p[j] + m * (q[j] - p[j]);
                        a[j] = lane < 8 ? (1.0f - 2.0f * frcp(fexp(2.0f * v) + 1.0f)) : (lane < 16 ? v : fsigmoid(v)); }
                } else {
#pragma unroll
                    for (int j = 0; j < 8; ++j) a[j] = 0.f; }
                *(u32x4*)(ALORA + (size_t)n * LK + lane * 8) = pack8(a); }
#pragma unroll
            for (int part = 0; part < 3; ++part) { prv[part] = cur[part]; cur[part] = nxt[part]; }
            prl = cul; cul = nxl;
        }
    }
}

DI void p4_lora(const Frame& F0, ARef A, const bf16* ALORA, const bf16* WL, bf16* E, bf16* KS, bf16* Bo, bf16* GG, const bf16* KK, const bf16* R, float* BON) {
    Frame F = F0; F.tid = opq_tid(F0.wave); F.lane = F.tid & 63; F.wave = __builtin_amdgcn_readfirstlane(F.tid >> 6); F.gw = F.wg * NWAVES + F.wave;
    const int lane = F.lane, r = lane & 31, hh = lane >> 5;
    for (int u = F.gw; u < 2 * (NTOK / 32); u += F.NGW) {
        const int n0 = (u >> 1) * 32, par = u & 1;
        bf16x8 tf[18];
#pragma unroll
        for (int ks = 0; ks < 18; ++ks) tf[ks] = *(const bf16x8*)(ALORA + (size_t)(n0 + r) * LK + 16 * ks + 8 * hh);
        const unsigned orow = (unsigned)(n0 + r) * BW + 4 * hh;
#define LORA_BLOCK(KS0, NKS, CB, BODY) { const int c0_ = 32 * ((CB) & 15); f32x16 acc_; \
            _Pragma("unroll") for (int q = 0; q < 16; ++q) acc_[q] = 0.f; \
            _Pragma("unroll") for (int ks = 0; ks < (NKS); ++ks) acc_ = MFMA32(*(const bf16x8*)(WL + (size_t)(32 * (CB) + r) * LK + 16 * ((KS0) + ks) + 8 * hh), tf[(KS0) + ks], acc_); \
            BODY }
        for (int i = 0; i < 8; ++i) { const int cb = 4 * (i >> 1) + 2 * par + (i & 1);
            LORA_BLOCK(0, 4, cb, {
                _Pragma("unroll") for (int g = 0; g < 4; ++g) { const f32x4 w0v = *(const f32x4*)(A.w0 + c0_ + 8 * g + 4 * hh); float e4[4];
                    _Pragma("unroll") for (int j = 0; j < 4; ++j) { const float v = acc_[4 * g + j] + w0v[j]; e4[j] = fexp(-fsoftplus(-v) - 0.5f); }
                    u32x2 w; w.x = pk2(e4[0], e4[1]); w.y = pk2(e4[2], e4[3]); *(u32x2*)(E + orow + c0_ + 8 * g) = w; } }) }
        float bsum = 0.f;
        for (int i = 0; i < 8; ++i) { const int cb = 16 + 4 * (i >> 1) + 2 * par + (i & 1);
            LORA_BLOCK(4, 4, cb, {
                _Pragma("unroll") for (int g = 0; g < 4; ++g) { const f32x4 a0v = *(const f32x4*)(A.a0 + c0_ + 8 * g + 4 * hh); const f32x4 kav = *(const f32x4*)(A.k_a + c0_ + 8 * g + 4 * hh);
                    const unsigned o = orow + c0_ + 8 * g; const u32x2 kw = *(const u32x2*)(KS + o); const u32x2 qw = *(const u32x2*)(KK + o); const u32x2 rw = *(const u32x2*)(R + o); const f32x4 rkv = *(const f32x4*)(A.r_k + c0_ + 8 * g + 4 * hh);
                    float ksv[4]; float kkv[4]; float kp[4]; float bb[4]; ksv[0] = bflo(kw.x); ksv[1] = bfhi(kw.x); ksv[2] = bflo(kw.y); ksv[3] = bfhi(kw.y); kkv[0] = bflo(qw.x); kkv[1] = bfhi(qw.x); kkv[2] = bflo(qw.y); kkv[3] = bfhi(qw.y);
                    _Pragma("unroll") for (int j = 0; j < 4; ++j) { const float s0 = fsigmoid(acc_[4 * g + j] + a0v[j]); kp[j] = ksv[j] * (1.0f + (s0 - 1.0f) * kav[j]); bb[j] = kkv[j] * s0; }
                    bsum += (bflo(rw.x) * kp[0] * rkv[0] + bfhi(rw.x) * kp[1] * rkv[1]) + (bflo(rw.y) * kp[2] * rkv[2] + bfhi(rw.y) * kp[3] * rkv[3]);
                    u32x2 w1; u32x2 w2; w1.x = pk2(kp[0], kp[1]); w1.y = pk2(kp[2], kp[3]); w2.x = pk2(bb[0], bb[1]); w2.y = pk2(bb[2], bb[3]); *(u32x2*)(KS + o) = w1; *(u32x2*)(Bo + o) = w2; } })
            if (i & 1) { const float tot = bsum + shfl_xor_l(bsum, 32, lane); if (hh == 0) BON[(size_t)(n0 + r) * 8 + 2 * (i >> 1) + par] = tot; bsum = 0.f; } }
        for (int i = 0; i < 8; ++i) { const int cb = 32 + 4 * (i >> 1) + 2 * par + (i & 1);
            LORA_BLOCK(8, 10, cb, {
                _Pragma("unroll") for (int g = 0; g < 4; ++g) { u32x2 w; w.x = pk2(acc_[4 * g], acc_[4 * g + 1]); w.y = pk2(acc_[4 * g + 2], acc_[4 * g + 3]); *(u32x2*)(GG + orow + c0_ + 8 * g) = w; } }) }
#undef LORA_BLOCK
    }
}

DI void p6_chain(int task, int wave, LAS unsigned char* ring, const bf16* GT, const bf16* HT, bf16* SC) {
    const int lane = opq_tid(wave) & 63;
    const int bh = task >> 1, nb = task & 1;
    constexpr int RD = 6, SLOT = 12288;
    f32x16 X[2];
#pragma unroll
    for (int q = 0; q < 16; ++q) { X[0][q] = 0.f; X[1][q] = 0.f; }
    const char* gsrc = (const char*)(GT + (size_t)bh * NCH * 4096) + lane * 16;
    const char* hsrc = (const char*)(HT + (size_t)bh * NCH * 4096) + nb * 2048 + lane * 16;
#define CHAIN_DMA(cc) do { LAS unsigned char* sl_ = ring + ((cc) % RD) * SLOT; const char* g_ = gsrc + (size_t)(cc) * 8192; const char* h_ = hsrc + (size_t)(cc) * 8192; \
        _Pragma("unroll") for (int f = 0; f < 8; ++f) __builtin_amdgcn_global_load_lds((const unsigned*)(g_ + f * 1024), (LAS unsigned*)(sl_ + f * 1024), 16, 0, 0); \
        _Pragma("unroll") for (int kb = 0; kb < 2; ++kb) _Pragma("unroll") for (int j = 0; j < 2; ++j) \
            __builtin_amdgcn_global_load_lds((const unsigned*)(h_ + kb * 4096 + j * 1024), (LAS unsigned*)(sl_ + 8192 + (kb * 2 + j) * 1024), 16, 0, 0); } while (0)
#define CHAIN_READ(cc, HS, GS) do { const LAS unsigned char* sl_ = ring + ((cc) % RD) * SLOT; \
        _Pragma("unroll") for (int f = 0; f < 8; ++f) GS[f] = *(const LAS bf16x8*)(sl_ + f * 1024 + lane * 16); \
        _Pragma("unroll") for (int kb = 0; kb < 2; ++kb) _Pragma("unroll") for (int g = 0; g < 4; ++g) { const u32x2 w_ = *(const LAS u32x2*)(sl_ + 8192 + kb * 2048 + (g * 64 + lane) * 8); \
            HS[kb][4 * g] = bflo(w_.x); HS[kb][4 * g + 1] = bfhi(w_.x); HS[kb][4 * g + 2] = bflo(w_.y); HS[kb][4 * g + 3] = bfhi(w_.y); } } while (0)
#define CHAIN_STORE(cc) do { bf16* sc_ = SC + ((size_t)bh * NCH + (cc)) * 4096; \
        _Pragma("unroll") for (int jb = 0; jb < 2; ++jb) _Pragma("unroll") for (int g = 0; g < 4; ++g) { u32x2 w_; w_.x = pk2(X[jb][4 * g], X[jb][4 * g + 1]); w_.y = pk2(X[jb][4 * g + 2], X[jb][4 * g + 3]); \
            *(u32x2*)(sc_ + ((((jb * 2 + nb) * 4 + g) * 64) + lane) * 4) = w_; } } while (0)
#define CHAIN_STEP(HS, GS) do { bf16x8 xb_[2][2]; \
        _Pragma("unroll") for (int jb = 0; jb < 2; ++jb) _Pragma("unroll") for (int s = 0; s < 2; ++s) \
            xb_[jb][s] = pack8v(X[jb][8 * s], X[jb][8 * s + 1], X[jb][8 * s + 2], X[jb][8 * s + 3], X[jb][8 * s + 4], X[jb][8 * s + 5], X[jb][8 * s + 6], X[jb][8 * s + 7]); \
        X[0] = HS[0]; X[1] = HS[1]; \
        _Pragma("unroll") for (int kb = 0; kb < 2; ++kb) _Pragma("unroll") for (int jb = 0; jb < 2; ++jb) _Pragma("unroll") for (int s = 0; s < 2; ++s) X[kb] = MFMA32(GS[kb * 4 + jb * 2 + s], xb_[jb][s], X[kb]); } while (0)
    for (int cc = 0; cc < RD; ++cc) CHAIN_DMA(cc);
    for (int c = 0; c < NCH - 1; ++c) {
        f32x16 Hc[2]; bf16x8 Gc[8];
        if (c + RD <= NCH - 1) asm volatile("s_waitcnt vmcnt(60)" ::: "memory"); else asm volatile("s_waitcnt vmcnt(0)" ::: "memory");
        CHAIN_READ(c, Hc, Gc);
        asm volatile("s_waitcnt lgkmcnt(0)" ::: "memory");
        if (c + RD < NCH - 1) CHAIN_DMA(c + RD);
        CHAIN_STORE(c);
        CHAIN_STEP(Hc, Gc);
    }
    CHAIN_STORE(NCH - 1);
    asm volatile("s_waitcnt vmcnt(0)" ::: "memory");
#undef CHAIN_DMA
#undef CHAIN_READ
#undef CHAIN_STORE
#undef CHAIN_STEP
}

DI void p6_moe_weights(const Frame& F0, ARef A, int wi, int NW) {
    Frame F = F0; F.tid = opq_tid(F0.wave); F.lane = F.tid & 63; F.wave = __builtin_amdgcn_readfirstlane(F.tid >> 6); F.gw = F.wg * NWAVES + F.wave;
    LAS float* scr = (LAS float*)(F.lds + F.wave * 20480);
    constexpr int I_UP = NE * 32 * 16, I_DN = NE * 32 * 8;
    for (int it = wi; it < I_UP + I_DN; it += NW) {
        if (it < I_UP) { const int e = it >> 9, g = (it >> 4) & 31, kb = it & 15; tr_item_up(A.w_up1, A.w_up3, (bf16*)(A.ws + WS_WUP), e, 64 * kb, 32 * g, scr, F.lane); }
        else { const int r = it - I_UP, e = r >> 8, g = (r >> 3) & 31, kb = r & 7;
            tr_item(A.w_down + (size_t)e * DE * D, D, DE, (bf16*)(A.ws + WS_WDN) + (size_t)e * 1024 * DE, 64 * kb, 32 * g, 32 * g, scr, F.lane); }
    }
}

DI float half_bcast_sum(float v, int hh) {
    v += DPP_SHR(v, 0x111); v += DPP_SHR(v, 0x112); v += DPP_SHR(v, 0x114); v += DPP_SHR(v, 0x118);
    v += __builtin_bit_cast(float, __builtin_amdgcn_update_dpp(0, __builtin_bit_cast(int, v), 0x142, 0xa, 0xf, false));
    const float lo = __builtin_bit_cast(float, __builtin_amdgcn_readlane(__builtin_bit_cast(int, v), 31)), hi = __builtin_bit_cast(float, __builtin_amdgcn_readlane(__builtin_bit_cast(int, v), 63));
    return hh ? hi : lo; }
DI void p7_mfma(const Frame& F0, ARef A, const bf16* SC, const bf16* Pn, const bf16* QOn, const bf16* V, const bf16* GG, const float* BON, bf16* YRW) {
    Frame F = F0; F.tid = opq_tid(F0.wave); F.lane = F.tid & 63; F.wave = __builtin_amdgcn_readfirstlane(F.tid >> 6); F.gw = F.wg * NWAVES + F.wave;
    const int lane = F.lane, r = lane & 31, hh = lane >> 5;
    for (int cid = F.gw; cid < NCHUNK; cid += F.NGW) {
        const int bh = cid >> NCH_LOG, c = cid & (NCH - 1), b = bh >> 3, h = bh & 7;
        const unsigned n0 = (unsigned)b * SEQ + (unsigned)c * CH; const int col0 = h * HD;
        const bf16* sc = SC + (size_t)cid * 4096; const bf16* pn = Pn + (size_t)cid * 4096; const bf16* qn = QOn + (size_t)cid * 4096;
        bf16x8 Sf[2][2][2], Pf[2][2][2];
#pragma unroll
        for (int jb = 0; jb < 2; ++jb)
#pragma unroll
            for (int xb = 0; xb < 2; ++xb)
#pragma unroll
                for (int s = 0; s < 2; ++s) { const s16x4 lo = *(const s16x4*)(sc + ((((jb * 2 + xb) * 4 + 2 * s) * 64) + lane) * 4), hi = *(const s16x4*)(sc + ((((jb * 2 + xb) * 4 + 2 * s + 1) * 64) + lane) * 4);
#pragma unroll
                    for (int e = 0; e < 4; ++e) { Sf[jb][xb][s][e] = lo[e]; Sf[jb][xb][s][4 + e] = hi[e]; }
                    Pf[jb][xb][s] = *(const bf16x8*)(pn + ((((jb * 2 + xb) * 2 + s) * 64) + lane) * 8); }
        f32x16 Z[2][2];
#pragma unroll
        for (int tb = 0; tb < 2; ++tb)
#pragma unroll
            for (int nb = 0; nb < 2; ++nb) {
#pragma unroll
                for (int g = 0; g < 4; ++g) { const u32x2 w = *(const u32x2*)(qn + ((((tb * 2 + nb) * 4 + g) * 64) + lane) * 4);
                    Z[tb][nb][4 * g] = bflo(w.x); Z[tb][nb][4 * g + 1] = bfhi(w.x); Z[tb][nb][4 * g + 2] = bflo(w.y); Z[tb][nb][4 * g + 3] = bfhi(w.y); }
#pragma unroll
                for (int jb = 0; jb < 2; ++jb)
#pragma unroll
                    for (int s = 0; s < 2; ++s) Z[tb][nb] = MFMA32(Pf[jb][tb][s], Sf[jb][nb][s], Z[tb][nb]); }
        float lw[2], lb[2];
#pragma unroll
        for (int nb = 0; nb < 2; ++nb) { lw[nb] = A.lnx_w[col0 + 32 * nb + r]; lb[nb] = A.lnx_b[col0 + 32 * nb + r]; }
#pragma unroll
        for (int tb = 0; tb < 2; ++tb)
#pragma unroll
            for (int q = 0; q < 16; ++q) {
                const unsigned tokrow = n0 + 32 * tb + 4 * hh + (q & 3) + 8 * (q >> 2);
                const float mean = half_bcast_sum(Z[tb][0][q] + Z[tb][1][q], hh) * (1.0f / 64.0f);
                const float d0 = Z[tb][0][q] - mean, d1 = Z[tb][1][q] - mean;
                const float rs = rsqrtf(half_bcast_sum(d0 * d0 + d1 * d1, hh) * (1.0f / 64.0f) + GN_EPS);
                const float bon = BON[(size_t)tokrow * 8 + h];
                const unsigned o0 = tokrow * BW + col0 + r;
                YRW[o0] = (bf16)f2bf((d0 * rs * lw[0] + lb[0] + bon * bf2f(V[o0])) * bf2f(GG[o0]));
                YRW[o0 + 32] = (bf16)f2bf((d1 * rs * lw[1] + lb[1] + bon * bf2f(V[o0 + 32])) * bf2f(GG[o0 + 32]));
                if ((q & 3) == 3) __builtin_amdgcn_sched_barrier(0); }
    }
}

DI void p10_rows(const Frame& F0, ARef A, const bf16* Y1, bf16* H2) {
    Frame F = F0; F.tid = opq_tid(F0.wave); F.lane = F.tid & 63; F.wave = __builtin_amdgcn_readfirstlane(F.tid >> 6); F.gw = F.wg * NWAVES + F.wave;
    const int lane = F.lane;
    const float* mod = (const float*)(A.ws + WS_MOD);
    LAS float* rw = (LAS float*)F.lds;
    LAS int* hist = (LAS int*)(F.lds + 147456);
    { const float* src = (const float*)(A.ws + WS_RTW);
        for (int i = F.tid; i < 18 * D; i += NTHR) { const int op = i >> 10, k = i & (D - 1); typedef float f2_t __attribute__((ext_vector_type(2))); f2_t w; w.x = src[(2 * op) * D + k]; w.y = src[(2 * op + 1) * D + k]; *(LAS f2_t*)(rw + 2 * i) = w; } }
    i32x4* tok = (i32x4*)(A.ws + WS_TOK); int* cnt = (int*)(A.ws + WS_CNT);
    for (int tb = F.wg; tb < NTOK / 128; tb += F.G) {
        if (F.tid < 32) hist[F.tid] = 0;
        __syncthreads();
        for (int tl = F.wave; tl < 128; tl += NWAVES) {
            const int n = tb * 128 + tl, b = n >> 13;
            const f32x4* xr = (const f32x4*)(A.x + (size_t)n * D) + lane; const u32x2* yr = (const u32x2*)(Y1 + (size_t)n * D) + lane;
            f32x4 xv[4], yv[4]; float s = 0.f;
#pragma unroll
            for (int j = 0; j < 4; ++j) { xv[j] = xr[64 * j]; const u32x2 w = yr[64 * j]; yv[j][0] = bflo(w.x); yv[j][1] = bfhi(w.x); yv[j][2] = bflo(w.y); yv[j][3] = bfhi(w.y);
                s += (yv[j][0] * yv[j][0] + yv[j][1] * yv[j][1]) + (yv[j][2] * yv[j][2] + yv[j][3] * yv[j][3]); }
            const float inv1 = rsqrtf(wave_sum(s) * (1.0f / D) + NORM_EPS);
            float s2 = 0.f;
#pragma unroll
            for (int j = 0; j < 4; ++j) { const int k = 4 * lane + 256 * j;
                const f32x4 g1 = *(const f32x4*)(A.gains + D + k), gt = *(const f32x4*)(mod + b * 6144 + 2 * D + k);
#pragma unroll
                for (int q = 0; q < 4; ++q) { xv[j][q] = xv[j][q] + gt[q] * ((yv[j][q] * inv1) * g1[q]); s2 += xv[j][q] * xv[j][q]; }
                u32x2 xw; xw.x = pk2(xv[j][0], xv[j][1]); xw.y = pk2(xv[j][2], xv[j][3]); *((u32x2*)(A.ws + WS_X1 + (size_t)n * D * 2) + lane + 64 * j) = xw; }
            const float inv2 = rsqrtf(wave_sum(s2) * (1.0f / D) + NORM_EPS);
            f32x4 hv[4];
#pragma unroll
            for (int j = 0; j < 4; ++j) { const int k = 4 * lane + 256 * j;
                const f32x4 g2 = *(const f32x4*)(A.gains + 2 * D + k), sh = *(const f32x4*)(mod + b * 6144 + 3 * D + k), sc = *(const f32x4*)(mod + b * 6144 + 4 * D + k);
#pragma unroll
                for (int q = 0; q < 4; ++q) hv[j][q] = (xv[j][q] * inv2) * g2[q] * (1.0f + sc[q]) + sh[q];
                u32x2 w; w.x = pk2(hv[j][0], hv[j][1]); w.y = pk2(hv[j][2], hv[j][3]); *((u32x2*)(H2 + (size_t)n * D) + lane + 64 * j) = w; }
            typedef float f2_t __attribute__((ext_vector_type(2)));
#define P10_PAIR(OUT0, OUT1, WBASE) do { f2_t a = {0.f, 0.f}; \
                _Pragma("unroll") for (int j = 0; j < 4; ++j) { const LAS f32x4* wp = (const LAS f32x4*)((WBASE) + (4 * lane + 256 * j) * 2); const f32x4 wA = wp[0], wB = wp[1]; \
                    a += (f2_t){hv[j][0], hv[j][0]} * (f2_t){wA[0], wA[1]}; a += (f2_t){hv[j][1], hv[j][1]} * (f2_t){wA[2], wA[3]}; \
                    a += (f2_t){hv[j][2], hv[j][2]} * (f2_t){wB[0], wB[1]}; a += (f2_t){hv[j][3], hv[j][3]} * (f2_t){wB[2], wB[3]}; } \
                OUT0 = wave_sum(a.x); OUT1 = wave_sum(a.y); } while (0)
            float lg[4];
            P10_PAIR(lg[0], lg[1], rw); P10_PAIR(lg[2], lg[3], rw + 2 * D);
            int gs = 0; float gm = lg[0];
#pragma unroll
            for (int g = 1; g < 4; ++g) if (lg[g] > gm) { gm = lg[g]; gs = g; }
            gs = __builtin_amdgcn_readfirstlane(gs);
            float gsum = 0.f;
#pragma unroll
            for (int g = 0; g < 4; ++g) gsum += fexp(lg[g] - gm);
            const float gw = 1.0f / gsum;
            float el[8];
            { const LAS float* rwg = rw + (2 + 4 * gs) * (2 * D);
#pragma unroll
              for (int i = 0; i < 4; ++i) P10_PAIR(el[2 * i], el[2 * i + 1], rwg + i * 2 * D); }
#undef P10_PAIR
            int i0 = 0; float m0 = el[0];
#pragma unroll
            for (int e = 1; e < 8; ++e) if (el[e] > m0) { m0 = el[e]; i0 = e; }
            int i1 = -1; float m1 = -3.0e38f;
#pragma unroll
            for (int e = 0; e < 8; ++e) if (e != i0 && el[e] > m1) { m1 = el[e]; i1 = e; }
            const float t = fexp(m1 - m0), p0 = 1.0f / (1.0f + t), p1 = t * p0;
            const int e0 = gs * 8 + i0, e1 = gs * 8 + i1;
#if defined(CHECKS)
            if (lane == 0 && n == DBG_TOKEN) { float* dbg = (float*)(A.ws + WS_CTL + 32768) + 48; dbg[0] = lg[0]; dbg[1] = lg[1]; dbg[2] = lg[2]; dbg[3] = lg[3]; dbg[4] = gsum; dbg[5] = p0; dbg[6] = gw; dbg[7] = t; }
#endif
            if (lane == 0) { i32x4 rec; rec.x = e0 | (e1 << 8); rec.y = 0; rec.z = 0; rec.w = 0; tok[n] = rec;
                float* cwp = (float*)(A.ws + WS_CW) + 2 * n; cwp[0] = gw * p0; cwp[1] = gw * p1;
                atomicAdd((int*)&hist[e0], 1); atomicAdd((int*)&hist[e1], 1); }
        }
        __syncthreads();
        if (F.tid < 32) cnt[tb * 32 + F.tid] = hist[F.tid];
        __syncthreads();
    }
}

DI void p11_rank_gather(const Frame& F0, ARef A, const bf16* H2, bf16* HS) {
    Frame F = F0; F.tid = opq_tid(F0.wave); F.lane = F.tid & 63; F.wave = __builtin_amdgcn_readfirstlane(F.tid >> 6); F.gw = F.wg * NWAVES + F.wave;
    LAS int* base = (LAS int*)F.lds;
    LAS int* seg = base + 32;
    LAS int* el = base + 96;
    LAS int* pos = base + 352;
    i32x4* tok = (i32x4*)(A.ws + WS_TOK); const int* cnt = (const int*)(A.ws + WS_CNT); int* tile = (int*)(A.ws + WS_TILE);
    for (int tb = F.wg; tb < NTOK / 128; tb += F.G) {
        if (F.tid < 32) { int tot = 0, pre = 0;
            for (int t2 = 0; t2 < NTOK / 128; ++t2) { const int v = cnt[t2 * 32 + F.tid]; tot += v; if (t2 < tb) pre += v; }
            base[F.tid] = pre; seg[F.tid] = (tot + 255) & ~255; }
        if (F.tid >= 64 && F.tid < 64 + 128) { const i32x4 rec = tok[tb * 128 + (F.tid - 64)]; el[2 * (F.tid - 64)] = rec.x & 255; el[2 * (F.tid - 64) + 1] = (rec.x >> 8) & 255; }
        __syncthreads();
        if (F.tid == 0) { int acc = 0; for (int e = 0; e < 32; ++e) { const int sz = seg[e]; seg[e] = acc; acc += sz; } seg[32] = acc; }
        __syncthreads();
        if (F.tid < 32) { int p = seg[F.tid] + base[F.tid];
            for (int q = 0; q < 256; ++q) if (el[q] == F.tid) pos[q] = p++; }
        if (tb == 0 && F.tid >= 64 && F.tid < 64 + 32) { const int e = F.tid - 64;
            for (int t2 = seg[e] >> 8; t2 < (seg[e + 1] >> 8); ++t2) tile[t2] = e;
            if (e == 0) tile[MAXT] = seg[32] >> 8; }
        __syncthreads();
        if (F.tid < 128) { i32x4 rec = tok[tb * 128 + F.tid]; rec.x = pos[2 * F.tid]; rec.y = pos[2 * F.tid + 1]; tok[tb * 128 + F.tid] = rec; }
        for (int q = F.wave; q < 256; q += NWAVES) { const int n = tb * 128 + (q >> 1);
            const u32x4* src = (const u32x4*)(H2 + (size_t)n * D) + F.lane; u32x4* dst = (u32x4*)(HS + (size_t)pos[q] * D) + F.lane;
            dst[0] = src[0]; dst[64] = src[64]; }
        __syncthreads();
    }
}

DI void p14_final(const Frame& F0, ARef A, const bf16* YE) {
    Frame F = F0; F.tid = opq_tid(F0.wave); F.lane = F.tid & 63; F.wave = __builtin_amdgcn_readfirstlane(F.tid >> 6); F.gw = F.wg * NWAVES + F.wave;
    const int lane = F.lane;
    const float* mod = (const float*)(A.ws + WS_MOD); const i32x4* tok = (const i32x4*)(A.ws + WS_TOK);
    for (int n = F.gw; n < NTOK; n += F.NGW) {
        const int b = n >> 13; const i32x4 rec = tok[n];
        const float c0 = ((const float*)(A.ws + WS_CW))[2 * n], c1 = ((const float*)(A.ws + WS_CW))[2 * n + 1];
        const u32x2* y0 = (const u32x2*)(YE + (size_t)rec.x * D) + lane; const u32x2* y1 = (const u32x2*)(YE + (size_t)rec.y * D) + lane;
        f32x4 yv[4]; float s = 0.f;
#pragma unroll
        for (int j = 0; j < 4; ++j) { const u32x2 a = y0[64 * j], bq = y1[64 * j];
            yv[j][0] = c0 * bflo(a.x) + c1 * bflo(bq.x); yv[j][1] = c0 * bfhi(a.x) + c1 * bfhi(bq.x); yv[j][2] = c0 * bflo(a.y) + c1 * bflo(bq.y); yv[j][3] = c0 * bfhi(a.y) + c1 * bfhi(bq.y);
            s += (yv[j][0] * yv[j][0] + yv[j][1] * yv[j][1]) + (yv[j][2] * yv[j][2] + yv[j][3] * yv[j][3]); }
        const float inv = rsqrtf(wave_sum(s) * (1.0f / D) + NORM_EPS);
#pragma unroll
        for (int j = 0; j < 4; ++j) { const int k = 4 * lane + 256 * j;
            const f32x4 g3 = *(const f32x4*)(A.gains + 3 * D + k), gt = *(const f32x4*)(mod + b * 6144 + 5 * D + k);
            const u32x2 xw = *((const u32x2*)(A.ws + WS_X1 + (size_t)n * D * 2) + lane + 64 * j); f32x4 xv = {bflo(xw.x), bfhi(xw.x), bflo(xw.y), bfhi(xw.y)};
#pragma unroll
            for (int q = 0; q < 4; ++q) xv[q] = xv[q] + gt[q] * ((yv[j][q] * inv) * g3[q]);
            *((f32x4*)(A.out + (size_t)n * D) + lane + 64 * j) = xv; }
    }
}

DI bf16x8 pk_tile(const f32x16& x, const int s) { return pack8v(x[8 * s], x[8 * s + 1], x[8 * s + 2], x[8 * s + 3], x[8 * s + 4], x[8 * s + 5], x[8 * s + 6], x[8 * s + 7]); }
constexpr int FS = 72;
DI bf16x8 rd_frag(const LAS bf16* buf, int tb, int cb, int s, int r, int hh) {
    const LAS bf16* p = buf + (32 * cb + r) * FS + 32 * tb + 16 * s + 4 * hh;
    const s16x4 lo = *(const LAS s16x4*)p, hi = *(const LAS s16x4*)(p + 8); bf16x8 f;
#pragma unroll
    for (int e = 0; e < 4; ++e) { f[e] = lo[e]; f[4 + e] = hi[e]; }
    return f; }
DI void wr_tile_ft(LAS bf16* buf, const f32x16& x, int tb, int cb, int r, int hh) {
#pragma unroll
    for (int g = 0; g < 4; ++g) { u32x2 w; w.x = pk2(x[4 * g], x[4 * g + 1]); w.y = pk2(x[4 * g + 2], x[4 * g + 3]); *(LAS u32x2*)(buf + (32 * cb + r) * FS + 32 * tb + 8 * g + 4 * hh) = w; } }
DI void wr_l_ft(LAS bf16* buf, const float (&x)[64], int lane) {
#pragma unroll
    for (int t8 = 0; t8 < 8; ++t8) { u32x4 w; w.x = pk2(x[8 * t8], x[8 * t8 + 1]); w.y = pk2(x[8 * t8 + 2], x[8 * t8 + 3]); w.z = pk2(x[8 * t8 + 4], x[8 * t8 + 5]); w.w = pk2(x[8 * t8 + 6], x[8 * t8 + 7]);
        *(LAS u32x4*)(buf + lane * FS + 8 * t8) = w; } }

#if defined(STAMPS)
#define P5STAMP(k) do { p5ts[k] = __builtin_amdgcn_s_memrealtime(); } while (0)
#else
#define P5STAMP(k) do { } while (0)
#endif
DI void p5_mfma(unsigned char* F0_ws, const Frame& F0, const bf16* R, const bf16* KP, const bf16* V, const bf16* KK, const bf16* Bv, const bf16* Ev, bf16* P, bf16* QO, bf16* GT, bf16* HT) {
    Frame F = F0; F.tid = opq_tid(F0.wave); F.lane = F.tid & 63; F.wave = __builtin_amdgcn_readfirstlane(F.tid >> 6); F.gw = F.wg * NWAVES + F.wave;
    const int lane = F.lane, r = lane & 31, hh = lane >> 5;
    LAS unsigned char* wl = F.lds + F.wave * 20480;
    LAS bf16* buf0 = (LAS bf16*)wl; LAS bf16* buf1 = (LAS bf16*)(wl + 9216);
    LAS float* LT = (LAS float*)wl;
    LAS float* LC = (LAS float*)(wl + 18432);
    for (int cid = F.gw; cid < NCHUNK; cid += F.NGW) {
        const int bh = cid >> NCH_LOG, c = cid & (NCH - 1), b = bh >> 3, h = bh & 7;
        const unsigned n0 = (unsigned)b * SEQ + (unsigned)c * CH, col0 = (unsigned)h * HD;
        int ln = lane; asm volatile("" : "+v"(ln));
#if defined(STAMPS)
        unsigned long long p5ts[10];
#endif
        const int rm = ln & 31, hm = ln >> 5;
        const bf16 *R0_ = R, *KP0_ = KP, *V0_ = V, *KK0_ = KK, *Bv0_ = Bv, *Ev0_ = Ev; bf16 *P0_ = P, *QO0_ = QO;
        asm volatile("" : "+s"(R0_), "+s"(KP0_), "+s"(V0_), "+s"(KK0_), "+s"(Bv0_), "+s"(Ev0_), "+s"(P0_), "+s"(QO0_));
        const GAS char *R_ = (const GAS char*)R0_, *KP_ = (const GAS char*)KP0_, *V_ = (const GAS char*)V0_, *KK_ = (const GAS char*)KK0_, *Bv_ = (const GAS char*)Bv0_, *Ev_ = (const GAS char*)Ev0_;
        GAS char *P_ = (GAS char*)P0_, *QO_ = (GAS char*)QO0_;
        const unsigned nb0 = n0 * BW + col0;
        const unsigned vL = (nb0 + (unsigned)ln) * 2u, vT = (nb0 + (unsigned)rm * BW + 4u * hm) * 2u, vC = (nb0 + 4u * hm * BW + (unsigned)rm) * 2u, vG = (4u * hm * 64 + (unsigned)rm) * 2u;
#define OADD(v, c) ({ unsigned o_; asm volatile("v_add_u32_e32 %0, %1, %2" : "=v"(o_) : "n"((int)(c)), "v"(v)); o_; })
#define LD16(arr, off) (*(const GAS bf16*)((arr) + (off)))
#define XL(arr, t) LD16(arr, OADD(vL, (t) * BW * 2))
#define ROWQ(q) (((q) & 3) + 8 * ((q) >> 2))
        P5STAMP(0);
        u32x2 raw[2][5][4];
#define LOAD_TILE(BUF, FB, TB) do { _Pragma("unroll") for (int g = 0; g < 4; ++g) { const unsigned ot_ = OADD(vT, (32 * (TB) * BW + 32 * (FB) + 8 * g) * 2); \
            raw[BUF][0][g] = *(const GAS u32x2*)(Ev_ + ot_); raw[BUF][1][g] = *(const GAS u32x2*)(KK_ + ot_); raw[BUF][2][g] = *(const GAS u32x2*)(R_ + ot_); \
            raw[BUF][3][g] = *(const GAS u32x2*)(Bv_ + ot_); raw[BUF][4][g] = *(const GAS u32x2*)(KP_ + ot_); } } while (0)
        LOAD_TILE(0, 0, 0);
        {   float run = 0.f;
#pragma unroll
            for (int t = 0; t < 64; ++t) { run -= bf2f(XL(Ev_, t)); LT[ln * 65 + t] = run; } }
        wave_lds_fence();
        P5STAMP(1);
        bf16x8 Ap[2][2][2], Rp[2][2][2], Bp[2][2][2], Kp[2][2][2];
#pragma unroll
        for (int ti = 0; ti < 4; ++ti) { const int fb = ti >> 1, tb = ti & 1;
            if (ti < 3) LOAD_TILE((ti + 1) & 1, (ti + 1) >> 1, (ti + 1) & 1);
#pragma unroll
            for (int s = 0; s < 2; ++s) {
                float a8[8], r8[8], b8[8], k8[8];
#pragma unroll
                for (int g2 = 0; g2 < 2; ++g2) { const int g = 2 * s + g2;
                    const u32x2 ew = raw[ti & 1][0][g], aw = raw[ti & 1][1][g], rw = raw[ti & 1][2][g], bw = raw[ti & 1][3][g], kw = raw[ti & 1][4][g];
                    const float e4[4] = {bflo(ew.x), bfhi(ew.x), bflo(ew.y), bfhi(ew.y)}, av[4] = {bflo(aw.x), bfhi(aw.x), bflo(aw.y), bfhi(aw.y)}, rv[4] = {bflo(rw.x), bfhi(rw.x), bflo(rw.y), bfhi(rw.y)},
                                bv[4] = {bflo(bw.x), bfhi(bw.x), bflo(bw.y), bfhi(bw.y)}, kv[4] = {bflo(kw.x), bfhi(kw.x), bflo(kw.y), bfhi(kw.y)};
#pragma unroll
                    for (int j = 0; j < 4; ++j) { const float l = LT[(32 * fb + 8 * g + 4 * hm + j) * 65 + 32 * tb + rm];
                        const float eI = fexp(l), eX = fexp(l + e4[j]), eN = frcp(eI);
                        a8[4 * g2 + j] = -av[j] * eX; r8[4 * g2 + j] = rv[j] * eI; b8[4 * g2 + j] = bv[j] * eN; k8[4 * g2 + j] = kv[j] * eN; } }
                Ap[fb][tb][s] = __builtin_bit_cast(bf16x8, pack8(a8)); Rp[fb][tb][s] = __builtin_bit_cast(bf16x8, pack8(r8));
                Bp[fb][tb][s] = __builtin_bit_cast(bf16x8, pack8(b8)); Kp[fb][tb][s] = __builtin_bit_cast(bf16x8, pack8(k8)); }
            __builtin_amdgcn_sched_barrier(0); }
#undef LOAD_TILE
        wave_lds_fence();
        P5STAMP(2);
        bf16x8 Makp[2][2][2], Mbrp[2][2][2], Mkrp[2][2][2];
#define GRAM(XP, YP, STRICT, BODY) _Pragma("unroll") for (int ib = 0; ib < 2; ++ib) _Pragma("unroll") for (int tb = 0; tb < 2; ++tb) { f32x16 m_; \
            _Pragma("unroll") for (int q = 0; q < 16; ++q) m_[q] = 0.f; \
            _Pragma("unroll") for (int fb = 0; fb < 2; ++fb) _Pragma("unroll") for (int s = 0; s < 2; ++s) m_ = MFMA32(XP[fb][ib][s], YP[fb][tb][s], m_); \
            int rm_ = rm; asm volatile("" : "+v"(rm_)); \
            _Pragma("unroll") for (int q = 0; q < 16; ++q) { const int i_ = 32 * ib + crow(q, hm), t_ = 32 * tb + rm_; m_[q] = ((STRICT) ? (i_ < t_) : (i_ <= t_)) ? m_[q] : 0.f; } \
            BODY __builtin_amdgcn_sched_barrier(0); }
        GRAM(Bp, Ap, true, { wr_tile_ft(buf0, m_, ib, tb, rm, hm); })
        GRAM(Kp, Ap, true, { Makp[ib][tb][0] = pk_tile(m_, 0); Makp[ib][tb][1] = pk_tile(m_, 1); })
        GRAM(Bp, Rp, false, { Mbrp[ib][tb][0] = pk_tile(m_, 0); Mbrp[ib][tb][1] = pk_tile(m_, 1); })
        GRAM(Kp, Rp, false, { Mkrp[ib][tb][0] = pk_tile(m_, 0); Mkrp[ib][tb][1] = pk_tile(m_, 1); })
#undef GRAM
        P5STAMP(3);
        {   bf16x8 Vp[2][2][2];
#pragma unroll
            for (int ib = 0; ib < 2; ++ib)
#pragma unroll
                for (int vb = 0; vb < 2; ++vb) { f32x16 v_;
#pragma unroll
                    for (int q = 0; q < 16; ++q) v_[q] = bf2f(LD16(V_, OADD(vC, ((32 * ib + ROWQ(q)) * BW + 32 * vb) * 2)));
                    Vp[ib][vb][0] = pk_tile(v_, 0); Vp[ib][vb][1] = pk_tile(v_, 1); }
#pragma unroll
            for (int tb = 0; tb < 2; ++tb)
#pragma unroll
                for (int vb = 0; vb < 2; ++vb) { f32x16 w_;
#pragma unroll
                    for (int q = 0; q < 16; ++q) w_[q] = 0.f;
#pragma unroll
                    for (int ib = 0; ib < 2; ++ib)
#pragma unroll
                        for (int s = 0; s < 2; ++s) w_ = MFMA32(Makp[ib][tb][s], Vp[ib][vb][s], w_);
                    wr_tile_ft(buf1, w_, tb, vb, rm, hm); __builtin_amdgcn_sched_barrier(0); } }
        wave_lds_fence();
        P5STAMP(4);
#define SOLVE_BLK(X, T8) _Pragma("unroll") for (int jt = 0; jt < 8; ++jt) { const int t = 8 * (T8) + jt; \
            _Pragma("unroll") for (int gi = 0; gi <= (T8); ++gi) if (8 * gi < t) { float m8[8]; unpack8(*(const LAS u32x4*)(buf0 + t * FS + 8 * gi), m8); \
                _Pragma("unroll") for (int j = 0; j < 8; ++j) { if (8 * gi + j < t) X[t] += X[8 * gi + j] * m8[j]; } } \
            if (jt & 1) __builtin_amdgcn_sched_barrier(0); }
#define SOLVE(X) SOLVE_BLK(X, 0) SOLVE_BLK(X, 1) SOLVE_BLK(X, 2) SOLVE_BLK(X, 3) SOLVE_BLK(X, 4) SOLVE_BLK(X, 5) SOLVE_BLK(X, 6) SOLVE_BLK(X, 7)
        float lC;
        {   float xw[64];
#pragma unroll
            for (int t8 = 0; t8 < 8; ++t8) { float w8[8]; unpack8(*(const LAS u32x4*)(buf1 + ln * FS + 8 * t8), w8);
#pragma unroll
                for (int j = 0; j < 8; ++j) xw[8 * t8 + j] = w8[j]; }
            SOLVE(xw)
            wr_l_ft(buf1, xw, ln); }
        __builtin_amdgcn_sched_barrier(0);
        P5STAMP(5);
        {   float xa[64];
            {   float run = 0.f;
#pragma unroll
                for (int t = 0; t < 64; ++t) { xa[t] = -bf2f(XL(KK_, t)) * fexp(run); run -= bf2f(XL(Ev_, t)); if ((t & 31) == 31) __builtin_amdgcn_sched_barrier(0); }
                lC = run; LC[ln] = fexp(lC); }
            SOLVE(xa)
            wave_lds_fence();
            wr_l_ft(buf0, xa, ln); }
#undef SOLVE
#undef SOLVE_BLK
        wave_lds_fence();
        P5STAMP(6);
        bf16x8 ATp[2][2][2], W1p[2][2][2];
#pragma unroll
        for (int ib = 0; ib < 2; ++ib)
#pragma unroll
            for (int kb = 0; kb < 2; ++kb)
#pragma unroll
                for (int s = 0; s < 2; ++s) { ATp[ib][kb][s] = rd_frag(buf0, ib, kb, s, rm, hm); W1p[ib][kb][s] = rd_frag(buf1, ib, kb, s, rm, hm); }
        wave_lds_fence();
        {   float run = 0.f;
#pragma unroll
            for (int t8 = 0; t8 < 8; ++t8) { float r8[8];
#pragma unroll
                for (int j = 0; j < 8; ++j) { const int t = 8 * t8 + j; run -= bf2f(XL(Ev_, t)); r8[j] = bf2f(XL(R_, t)) * fexp(run); }
                *(LAS u32x4*)(buf0 + ln * FS + 8 * t8) = pack8(r8); if (t8 & 3) { } else { } if ((t8 & 3) == 3) __builtin_amdgcn_sched_barrier(0); } }
        wave_lds_fence();
        GAS char* pn = (GAS char*)(P0_ + (size_t)cid * 4096); GAS char* qn = (GAS char*)(QO0_ + (size_t)cid * 4096);
#pragma unroll
        for (int jb = 0; jb < 2; ++jb)
#pragma unroll
            for (int tb = 0; tb < 2; ++tb) { f32x16 p_;
#pragma unroll
                for (int q = 0; q < 16; ++q) p_[q] = bf2f(buf0[(32 * jb + crow(q, hm)) * FS + 32 * tb + rm]);
#pragma unroll
                for (int ib = 0; ib < 2; ++ib)
#pragma unroll
                    for (int s = 0; s < 2; ++s) p_ = MFMA32(ATp[ib][jb][s], Mbrp[ib][tb][s], p_);
#pragma unroll
                for (int s = 0; s < 2; ++s) *(GAS bf16x8*)(pn + ((((jb * 2 + tb) * 2 + s) * 64) + ln) * 16) = pk_tile(p_, s);
                __builtin_amdgcn_sched_barrier(0); }
        bf16x8 Vp[2][2][2];
#pragma unroll
        for (int ib = 0; ib < 2; ++ib)
#pragma unroll
            for (int vb = 0; vb < 2; ++vb) { f32x16 v_;
#pragma unroll
                for (int q = 0; q < 16; ++q) v_[q] = bf2f(LD16(V_, OADD(vC, ((32 * ib + ROWQ(q)) * BW + 32 * vb) * 2)));
                Vp[ib][vb][0] = pk_tile(v_, 0); Vp[ib][vb][1] = pk_tile(v_, 1); }
        P5STAMP(7);
#pragma unroll
        for (int tb = 0; tb < 2; ++tb)
#pragma unroll
            for (int vb = 0; vb < 2; ++vb) { f32x16 y_;
#pragma unroll
                for (int q = 0; q < 16; ++q) y_[q] = 0.f;
#pragma unroll
                for (int ib = 0; ib < 2; ++ib)
#pragma unroll
                    for (int s = 0; s < 2; ++s) { y_ = MFMA32(Mbrp[ib][tb][s], W1p[ib][vb][s], y_); y_ = MFMA32(Mkrp[ib][tb][s], Vp[ib][vb][s], y_); }
#pragma unroll
                for (int g = 0; g < 4; ++g) { u32x2 w; w.x = pk2(y_[4 * g], y_[4 * g + 1]); w.y = pk2(y_[4 * g + 2], y_[4 * g + 3]); *(GAS u32x2*)(qn + ((((tb * 2 + vb) * 4 + g) * 64) + ln) * 8) = w; }
                __builtin_amdgcn_sched_barrier(0); }
        P5STAMP(8);
        wave_lds_fence();
        {   float run = 0.f;
#pragma unroll
            for (int t8 = 0; t8 < 8; ++t8) { float b8[8], k8[8];
#pragma unroll
                for (int j = 0; j < 8; ++j) { const int t = 8 * t8 + j; run -= bf2f(XL(Ev_, t)); const float sc = fexp(lC - run); b8[j] = bf2f(XL(Bv_, t)) * sc; k8[j] = bf2f(XL(KP_, t)) * sc; }
                *(LAS u32x4*)(buf0 + ln * FS + 8 * t8) = pack8(b8); *(LAS u32x4*)(buf1 + ln * FS + 8 * t8) = pack8(k8); if ((t8 & 3) == 3) __builtin_amdgcn_sched_barrier(0); } }
        wave_lds_fence();
        bf16x8 Bh[2][2][2];
#pragma unroll
        for (int tb = 0; tb < 2; ++tb)
#pragma unroll
            for (int kb = 0; kb < 2; ++kb)
#pragma unroll
                for (int s = 0; s < 2; ++s) Bh[tb][kb][s] = rd_frag(buf0, tb, kb, s, rm, hm);
        GAS char* gt = (GAS char*)(GT + (size_t)cid * 4096); GAS char* ht = (GAS char*)(HT + (size_t)cid * 4096);
#pragma unroll
        for (int kb = 0; kb < 2; ++kb)
#pragma unroll
            for (int jb = 0; jb < 2; ++jb) { f32x16 g_;
                const float dg = LC[32 * kb + rm];
#pragma unroll
                for (int q = 0; q < 16; ++q) g_[q] = (kb == jb && crow(q, hm) == rm) ? dg : 0.f;
#pragma unroll
                for (int tb = 0; tb < 2; ++tb)
#pragma unroll
                    for (int s = 0; s < 2; ++s) g_ = MFMA32(ATp[tb][jb][s], Bh[tb][kb][s], g_);
#pragma unroll
                for (int s = 0; s < 2; ++s) *(GAS bf16x8*)(gt + ((kb * 4 + jb * 2 + s) * 64 + ln) * 16) = pk_tile(g_, s);
                __builtin_amdgcn_sched_barrier(0); }
        {   bf16x8 Kh[2][2][2];
#pragma unroll
            for (int tb = 0; tb < 2; ++tb)
#pragma unroll
                for (int kb = 0; kb < 2; ++kb)
#pragma unroll
                    for (int s = 0; s < 2; ++s) Kh[tb][kb][s] = rd_frag(buf1, tb, kb, s, rm, hm);
#pragma unroll
            for (int kb = 0; kb < 2; ++kb)
#pragma unroll
                for (int vb = 0; vb < 2; ++vb) { f32x16 h_;
#pragma unroll
                    for (int q = 0; q < 16; ++q) h_[q] = 0.f;
#pragma unroll
                    for (int tb = 0; tb < 2; ++tb)
#pragma unroll
                        for (int s = 0; s < 2; ++s) { h_ = MFMA32(Bh[tb][kb][s], W1p[tb][vb][s], h_); h_ = MFMA32(Kh[tb][kb][s], Vp[tb][vb][s], h_); }
#pragma unroll
                    for (int g = 0; g < 4; ++g) { u32x2 w; w.x = pk2(h_[4 * g], h_[4 * g + 1]); w.y = pk2(h_[4 * g + 2], h_[4 * g + 3]); *(GAS u32x2*)(ht + ((((kb * 2 + vb) * 4 + g) * 64) + ln) * 8) = w; }
                    __builtin_amdgcn_sched_barrier(0); } }
        P5STAMP(9);
#if defined(STAMPS)
        if (F.gw == 0 && cid == 0 && lane == 0) { _Pragma("unroll") for (int k_ = 0; k_ < 10; ++k_) ((unsigned long long*)(F0_ws + WS_CTL + 49152))[32 + k_] = p5ts[k_]; }
#endif
        wave_lds_fence();
#undef XL
#undef OADD
#undef LD16
#undef ROWQ
    }
}

#if defined(CHECKS)
constexpr size_t WS_FLG = WS_CTL + 32768;
DI unsigned* chk_flags(unsigned char* ws) { return (unsigned*)(ws + WS_FLG); }
DI void chk(unsigned char* ws, int id, float got, float want, float rel, float ab) {
    const float d = fabsf(got - want), lim = rel * fmaxf(fabsf(got), fabsf(want)) + ab;
    if (!(d <= lim)) chk_flags(ws)[id] = 1u; }
DI unsigned hsh(unsigned a) { a ^= a >> 16; a *= 0x7feb352du; a ^= a >> 15; a *= 0x846ca68bu; a ^= a >> 16; return a; }
DI float bfr(float v) { return bflo(f2bf(v)); }
DI int scol_of(int n) { return n < 3360 ? n : (n < 3584 ? -1 : n - 224); }

DI void chk_p0(const Frame& F, ARef A) {
    unsigned char* ws = A.ws; const int lane = F.lane;
    const float* mod = (const float*)(ws + WS_MOD);
    for (int s = F.wave; s < 32; s += NWAVES) { const unsigned hh = hsh(1000 + s); const int b = hh & 3, o = (hh >> 2) % 6144; float a = 0.f;
        for (int k = lane; k < D; k += 64) { const float c = A.c[b * D + k]; a += (c / (1.0f + expf(-c))) * A.w_mod[(size_t)k * 6144 + o]; }
        a = wave_sum(a) + A.b_mod[o]; chk(ws, 10, mod[b * 6144 + o], a, 1e-3f, 1e-4f); }
    const bf16* wt = (const bf16*)(ws + WS_WIN);
    for (int s = 0; s < 8; ++s) { const unsigned hh = hsh(2000 + (F.wave * 8 + s) * 64 + lane); const int n = hh % NPAD, k = (hh >> 13) & 1023; const int sc = scol_of(n);
        const float want = sc >= 0 ? bfr(A.w_in[(size_t)k * IN_COLS + sc]) : 0.f; chk(ws, 11, bf2f(wt[(size_t)n * D + k]), want, 0.f, 0.f); }
    { const unsigned hh = hsh(3000 + F.wave * 64 + lane); const int n = hh & 1023, k = (hh >> 10) & 511, k2 = (hh >> 10) & 1023;
        chk(ws, 11, bf2f(((const bf16*)(ws + WS_WOSB))[n * BW + k]), bfr(A.w_o_sb[k * D + n]), 0.f, 0.f);
        chk(ws, 11, bf2f(((const bf16*)(ws + WS_WORW))[n * BW + k]), bfr(A.w_o_rw[k * D + n]), 0.f, 0.f);
        chk(ws, 11, bf2f(((const bf16*)(ws + WS_WOUT))[n * D + k2]), bfr(A.w_out[k2 * D + n]), 0.f, 0.f);
        const int o = hh % 36; chk(ws, 11, ((const float*)(ws + WS_RTW))[o * D + k2], o < 4 ? A.w_group[k2 * 4 + o] : A.w_router[k2 * NE + o - 4], 0.f, 0.f);
        const int nl = hh % 1536, kl = (hh >> 11) % LK; float v = 0.f;
        if (nl < 512) { if (kl < 64) v = A.w_decay_up[kl * BW + nl]; } else if (nl < 1024) { if (kl >= 64 && kl < 128) v = A.w_iclr_up[(kl - 64) * BW + nl - 512]; } else { if (kl >= 128 && kl < 288) v = A.w_gate_up[(kl - 128) * BW + nl - 1024]; }
        chk(ws, 11, bf2f(((const bf16*)(ws + WS_WL))[nl * LK + kl]), bfr(v), 0.f, 0.f); }
}
DI void chk_p1(const Frame& F, ARef A, const bf16* H1) {
    unsigned char* ws = A.ws; const int lane = F.lane; const float* mod = (const float*)(ws + WS_MOD);
    for (int s = F.wave; s < 16; s += NWAVES) { const int n = hsh(4000 + s) % NTOK, b = n >> 13; float ss = 0.f;
        for (int k = lane; k < D; k += 64) { const float v = A.x[(size_t)n * D + k]; ss += v * v; }
        const float inv = 1.0f / sqrtf(wave_sum(ss) / D + NORM_EPS);
        for (int k = lane; k < D; k += 64) { const float want = (A.x[(size_t)n * D + k] * inv) * A.gains[k] * (1.0f + mod[b * 6144 + D + k]) + mod[b * 6144 + k];
            chk(ws, 12, bf2f(H1[(size_t)n * D + k]), want, 0.01f, 0.01f); } }
}
DI float wdot(const bf16* arow, const float* W, int ldw, int col, int K, int lane) { float a = 0.f; for (int k = lane; k < K; k += 64) a += bf2f(arow[k]) * W[(size_t)k * ldw + col]; return wave_sum(a); }
DI void chk_p2(const Frame& F, ARef A, const bf16* H1) {
    unsigned char* ws = A.ws; const int lane = F.lane;
    for (int s = F.wave; s < 96; s += NWAVES) { const unsigned hh = hsh(5000 + s); const int n = hh % NTOK, region = s % 6; int col;
        const unsigned h2 = hsh(hh);
        float got, want; int id = 13 + region;
        if (region == 0) { col = h2 % 512; want = 0.125f * wdot(H1 + (size_t)n * D, A.w_in, IN_COLS, col, D, lane); got = bf2f(((const bf16*)(ws + WS_QB))[(size_t)n * BW + col]); }
        else if (region == 1) { col = h2 % 512; want = wdot(H1 + (size_t)n * D, A.w_in, IN_COLS, 512 + col, D, lane); got = bf2f(((const bf16*)(ws + WS_KB))[(size_t)n * BW + col]); }
        else if (region == 2) { col = h2 % 512; want = wdot(H1 + (size_t)n * D, A.w_in, IN_COLS, 1024 + col, D, lane); got = bf2f(((const bf16*)(ws + WS_VT))[((size_t)((n >> 13) * BW + col)) * SEQ + (n & (SEQ - 1))]); }
        else if (region == 3) { col = h2 % 1536; want = wdot(H1 + (size_t)n * D, A.w_in, IN_COLS, 1536 + col, D, lane); got = bf2f(((const bf16*)(ws + WS_RWRAW))[(size_t)n * 1536 + col]); }
        else if (region == 4) { col = h2 % 288; want = wdot(H1 + (size_t)n * D, A.w_in, IN_COLS, 3072 + col, D, lane); got = bf2f(((const bf16*)(ws + WS_LORA))[(size_t)n * BW + col]); }
        else { col = h2 % 2048; want = wdot(H1 + (size_t)n * D, A.w_in, IN_COLS, 3360 + col, D, lane) + A.gate_bias[col]; want = 1.0f / (1.0f + expf(-want)); got = bf2f(((const bf16*)(ws + WS_GATE))[(size_t)n * 2048 + col]); }
        chk(ws, id, got, want, 0.03f, 0.02f); }
}
constexpr int NATT = 16;
DI void att_sample(int s, int& b, int& h, int& t) { const unsigned hh = hsh(6000 + s); b = hh & 3; h = (hh >> 2) & 7; t = (s < 4) ? (s * 37) : (int)((hh >> 5) % SEQ); }
DI void chk_p3_save(const Frame& F, ARef A) {
    if (F.wave == 0) { bf16* sv = (bf16*)(A.ws + WS_FLG + 4096);
        for (int s = 0; s < NATT; ++s) { int b, h, t; att_sample(s, b, h, t); sv[s * 64 + F.lane] = ((const bf16*)(A.ws + WS_QB))[(size_t)(b * SEQ + t) * BW + h * HD + F.lane]; } }
}
DI void chk_p3(const Frame& F, ARef A, const bf16* R, const bf16* KS, const bf16* V, const bf16* KK) {
    unsigned char* ws = A.ws; const int lane = F.lane;
    const bf16* sv = (const bf16*)(ws + WS_FLG + 4096); const bf16* KB = (const bf16*)(ws + WS_KB); const bf16* VT = (const bf16*)(ws + WS_VT);
    for (int s = F.wave; s < NATT; s += NWAVES) { int b, h, t; att_sample(s, b, h, t);
        const float q = bf2f(sv[s * 64 + lane]); float later = 0.f, o = 0.f;
        for (int k = t - 1; k >= 0; --k) { const float z = wave_sum(q * bf2f(KB[(size_t)(b * SEQ + k) * BW + h * HD + lane]));
            const float sp = fmaxf(z, 0.f) + log1pf(expf(-fabsf(z)));
            o += expf(z - sp + later) * bf2f(VT[((size_t)((b * NH + h) * HD + lane)) * SEQ + k]);
            later -= sp; if (later < -200.f) break; }
        chk(ws, 19, bf2f(((const bf16*)(ws + WS_QB))[(size_t)(b * SEQ + t) * BW + h * HD + lane]), o, 0.04f, 0.02f); }
    const bf16* RW = (const bf16*)(ws + WS_RWRAW); const bf16* LO = (const bf16*)(ws + WS_LORA); const bf16* AL = (const bf16*)(ws + WS_ALORA);
    for (int s = F.wave; s < 32; s += NWAVES) { const unsigned hh = hsh(7000 + s); const int n = (s < 4) ? s * SEQ : (int)(hh % NTOK), hd = (hh >> 16) & 7; const bool first = (n & (SEQ - 1)) == 0;
        float xs[3];
        for (int p = 0; p < 3; ++p) { const int col = p * 512 + hd * 64 + lane; const float cur = bf2f(RW[(size_t)n * 1536 + col]), prv = first ? 0.f : bf2f(RW[(size_t)(n - 1) * 1536 + col]); xs[p] = cur + A.shift_mu[col] * (prv - cur); }
        const size_t o = (size_t)n * BW + hd * 64 + lane;
        chk(ws, 20, bf2f(R[o]), xs[0], 0.01f, 0.005f); chk(ws, 20, bf2f(KS[o]), xs[1], 0.01f, 0.005f); chk(ws, 20, bf2f(V[o]), xs[2], 0.01f, 0.005f);
        const float kk = xs[1] * A.k_k[hd * 64 + lane]; const float nn = sqrtf(wave_sum(kk * kk));
        chk(ws, 20, bf2f(KK[o]), kk / fmaxf(nn, L2_EPS), 0.01f, 0.002f);
        for (int c = lane; c < LK; c += 64) { float want = 0.f;
            if (c < 288) { const float cur = bf2f(LO[(size_t)n * BW + c]), prv = first ? 0.f : bf2f(LO[(size_t)(n - 1) * BW + c]); const float v = cur + A.shift_mu[1536 + c] * (prv - cur);
                want = c < 64 ? tanhf(v) : (c < 128 ? v : 1.0f / (1.0f + expf(-v))); }
            chk(ws, 20, bf2f(AL[(size_t)n * LK + c]), want, 0.01f, 0.005f); } }
}
DI void chk_p4_save(const Frame& F, ARef A, const bf16* KS) {
    if (F.wave == 0) { bf16* sv = (bf16*)(A.ws + WS_FLG + 8192);
        for (int s = 0; s < 16; ++s) { const unsigned hh = hsh(8000 + s); const int n = hh % NTOK, hd = (hh >> 16) & 7; sv[s * 64 + F.lane] = KS[(size_t)n * BW + hd * 64 + F.lane]; } }
}
DI void chk_p4(const Frame& F, ARef A, const bf16* KP, const bf16* KK) {
    unsigned char* ws = A.ws; const int lane = F.lane; const bf16* AL = (const bf16*)(ws + WS_ALORA); const bf16* sv = (const bf16*)(ws + WS_FLG + 8192);
    for (int s = F.wave; s < 16; s += NWAVES) { const unsigned hh = hsh(8000 + s); const int n = hh % NTOK, hd = (hh >> 16) & 7, c = hd * 64 + lane; const size_t o = (size_t)n * BW + c;
        float lw = 0.f, la = 0.f, lg = 0.f;
        for (int k = 0; k < 64; ++k) { lw += bf2f(AL[(size_t)n * LK + k]) * A.w_decay_up[k * BW + c]; la += bf2f(AL[(size_t)n * LK + 64 + k]) * A.w_iclr_up[k * BW + c]; }
        for (int k = 0; k < 160; ++k) lg += bf2f(AL[(size_t)n * LK + 128 + k]) * A.w_gate_up[k * BW + c];
        const float x = -(A.w0[c] + lw), w = -(fmaxf(x, 0.f) + log1pf(expf(-fabsf(x)))) - 0.5f;
        chk(ws, 21, bf2f(((const bf16*)(ws + WS_E))[o]), expf(w), 0.03f, 0.003f);
        const float a = 1.0f / (1.0f + expf(-(A.a0[c] + la))); const float ks = bf2f(sv[s * 64 + lane]);
        chk(ws, 22, bf2f(KP[o]), ks * (1.0f + (a - 1.0f) * A.k_a[c]), 0.03f, 0.01f);
        chk(ws, 22, bf2f(((const bf16*)(ws + WS_B))[o]), bf2f(KK[o]) * a, 0.03f, 0.003f);
        chk(ws, 23, bf2f(((const bf16*)(ws + WS_GG))[o]), lg, 0.03f, 0.01f); }
}
constexpr int NST = 300;
DI void chk_p7_save(const Frame& F, ARef A) {
    if (F.wave < 4) { const int b = (F.wave * 3) & 3, h = (F.wave * 5 + 1) & 7; bf16* sv = (bf16*)(A.ws + 256 * 1024) + F.wave * NST * 64;
        for (int t = 0; t < NST; ++t) sv[t * 64 + F.lane] = ((const bf16*)(A.ws + WS_E))[(size_t)(b * SEQ + t) * BW + h * HD + F.lane]; }
}
DI void chk_p7(const Frame& F, ARef A, const bf16* R, const bf16* KP, const bf16* V, const bf16* KK) {
    unsigned char* ws = A.ws; const int lane = F.lane;
    const bf16* Bv = (const bf16*)(ws + WS_B); const bf16* Esv = (const bf16*)(ws + 256 * 1024) + F.wave * NST * 64; const bf16* GG = (const bf16*)(ws + WS_GG); const bf16* YRW = (const bf16*)(ws + WS_YRW);
    if (F.wave < 4) { const int b = (F.wave * 3) & 3, h = (F.wave * 5 + 1) & 7, col0 = h * HD;
        float S[64];
#pragma unroll
        for (int k = 0; k < 64; ++k) S[k] = 0.f;
        for (int t = 0; t < NST; ++t) { const size_t o = (size_t)(b * SEQ + t) * BW + col0 + lane;
            const float av = -bf2f(KK[o]), bv = bf2f(Bv[o]), dv = expf(-bf2f(Esv[t * 64 + lane])), kv = bf2f(KP[o]), rv = bf2f(R[o]), vv = bf2f(V[o]);
            float sa = 0.f;
#pragma unroll
            for (int k = 0; k < 64; ++k) sa += S[k] * __shfl(av, k);
            float y = 0.f;
#pragma unroll
            for (int k = 0; k < 64; ++k) { S[k] = S[k] * __shfl(dv, k) + sa * __shfl(bv, k) + vv * __shfl(kv, k); y += S[k] * __shfl(rv, k); }
            const float mean = wave_sum(y) / 64.f, d = y - mean, var = wave_sum(d * d) / 64.f;
            const float yn = d / sqrtf(var + GN_EPS) * A.lnx_w[col0 + lane] + A.lnx_b[col0 + lane];
            const float bonus = wave_sum(rv * kv * A.r_k[col0 + lane]) * vv;
            const float want = (yn + bonus) * bf2f(GG[o]);
            chk(ws, t < 128 ? 24 : 25, bf2f(YRW[o]), want, 0.05f, 0.03f); } }
}
DI void chk_p8(const Frame& F, ARef A) {
    unsigned char* ws = A.ws; const int lane = F.lane;
    for (int s = F.wave; s < 32; s += NWAVES) { const unsigned hh = hsh(9000 + s); const int n = hh % NTOK, c = (hh >> 15) & 1023;
        const float p1 = wdot((const bf16*)(ws + WS_QB) + (size_t)n * BW, A.w_o_sb, D, c, BW, lane), p2 = wdot((const bf16*)(ws + WS_YRW) + (size_t)n * BW, A.w_o_rw, D, c, BW, lane);
        const bf16* ga = (const bf16*)(ws + WS_GATE) + (size_t)n * 2048;
        chk(ws, 26, bf2f(((const bf16*)(ws + WS_MRG))[(size_t)n * D + c]), bf2f(ga[c]) * p1 + bf2f(ga[1024 + c]) * p2, 0.03f, 0.01f); }
}
DI void chk_p9(const Frame& F, ARef A) {
    unsigned char* ws = A.ws; const int lane = F.lane;
    for (int s = F.wave; s < 32; s += NWAVES) { const unsigned hh = hsh(9500 + s); const int n = hh % NTOK, c = (hh >> 15) & 1023;
        chk(ws, 27, bf2f(((const bf16*)(ws + WS_Y1))[(size_t)n * D + c]), wdot((const bf16*)(ws + WS_MRG) + (size_t)n * D, A.w_out, D, c, D, lane), 0.03f, 0.01f); }
}
DI void chk_p10(const Frame& F, ARef A) {
    unsigned char* ws = A.ws; const int lane = F.lane; const float* mod = (const float*)(ws + WS_MOD);
    const bf16* Y1 = (const bf16*)(ws + WS_Y1); const bf16* H2 = (const bf16*)(ws + WS_H2); const i32x4* tok = (const i32x4*)(ws + WS_TOK);
    for (int s = F.wave; s < 32; s += NWAVES) { const int n = s == 0 ? DBG_TOKEN : (s < 16 ? (int)(hsh(10000 + s) % 128) : (int)(hsh(10000 + s) % NTOK)), b = n >> 13; float ss = 0.f;
        for (int k = lane; k < D; k += 64) { const float v = bf2f(Y1[(size_t)n * D + k]); ss += v * v; }
        const float inv1 = 1.0f / sqrtf(wave_sum(ss) / D + NORM_EPS); float s2 = 0.f;
        for (int k = lane; k < D; k += 64) { const float x1 = A.x[(size_t)n * D + k] + mod[b * 6144 + 2 * D + k] * ((bf2f(Y1[(size_t)n * D + k]) * inv1) * A.gains[D + k]);
            chk(ws, 28, A.out[(size_t)n * D + k], x1, 1e-3f, 1e-3f); s2 += x1 * x1; }
        const float inv2 = 1.0f / sqrtf(wave_sum(s2) / D + NORM_EPS);
        float lg[36];
#pragma unroll
        for (int o = 0; o < 36; ++o) lg[o] = 0.f;
        for (int k = lane; k < D; k += 64) { const float h2 = (A.out[(size_t)n * D + k] * inv2) * A.gains[2 * D + k] * (1.0f + mod[b * 6144 + 4 * D + k]) + mod[b * 6144 + 3 * D + k];
            chk(ws, 29, bf2f(H2[(size_t)n * D + k]), h2, 0.01f, 0.01f);
#pragma unroll
            for (int o = 0; o < 36; ++o) lg[o] += h2 * (o < 4 ? A.w_group[k * 4 + o] : A.w_router[k * NE + o - 4]); }
#pragma unroll
        for (int o = 0; o < 36; ++o) lg[o] = wave_sum(lg[o]);
        int gs = 0; float gm = lg[0];
#pragma unroll
        for (int g = 1; g < 4; ++g) if (lg[g] > gm) { gm = lg[g]; gs = g; }
        float gsum = 0.f;
#pragma unroll
        for (int g = 0; g < 4; ++g) gsum += expf(lg[g] - gm);
        float el[8];
#pragma unroll
        for (int e = 0; e < 8; ++e) el[e] = gs == 0 ? lg[4 + e] : (gs == 1 ? lg[12 + e] : (gs == 2 ? lg[20 + e] : lg[28 + e]));
        int i0 = 0; float m0 = el[0];
#pragma unroll
        for (int e = 1; e < 8; ++e) if (el[e] > m0) { m0 = el[e]; i0 = e; }
        int i1 = -1; float m1 = -3.0e38f;
#pragma unroll
        for (int e = 0; e < 8; ++e) if (e != i0 && el[e] > m1) { m1 = el[e]; i1 = e; }
        const float tt = expf(m1 - m0), p0 = 1.0f / (1.0f + tt);
        const i32x4 rec = tok[n];
        if (lane == 0 && s < 16) { if ((rec.x & 255) != gs * 8 + i0 || ((rec.x >> 8) & 255) != gs * 8 + i1) chk_flags(ws)[30] = 1u;
            if (n == DBG_TOKEN) { const float* dbg = (const float*)chk_flags(ws) + 48; float code = 1.f;
                if (dbg[4] > 4.001f) code += 2.f; if (dbg[5] < 0.499f) code += 4.f;
                if (fabsf(dbg[0] - lg[0]) > 1e-3f || fabsf(dbg[1] - lg[1]) > 1e-3f || fabsf(dbg[2] - lg[2]) > 1e-3f || fabsf(dbg[3] - lg[3]) > 1e-3f) code += 8.f;
                if (fabsf(dbg[4] - gsum) > 1e-3f) code += 16.f; if (fabsf(dbg[6] * dbg[5] - __builtin_bit_cast(float, rec.z)) > 1e-4f) code += 32.f;
                ((float*)chk_flags(ws))[62] = code * 0.1f; ((float*)chk_flags(ws))[63] = dbg[4]; }
            chk(ws, 56, ((const float*)(ws + WS_CW))[2 * n], p0 / gsum, 3e-2f, 1e-4f); chk(ws, 57, ((const float*)(ws + WS_CW))[2 * n + 1], tt * p0 / gsum, 3e-2f, 1e-4f);
            chk(ws, 58, ((const float*)(ws + WS_CW))[2 * n], p0 / gsum, 1e-3f, 1e-5f); chk(ws, 59, ((const float*)(ws + WS_CW))[2 * n + 1], tt * p0 / gsum, 1e-3f, 1e-5f); } }
}
DI void chk_p11(const Frame& F, ARef A) {
    unsigned char* ws = A.ws; const int lane = F.lane; const i32x4* tok = (const i32x4*)(ws + WS_TOK); const int* tile = (const int*)(ws + WS_TILE);
    const bf16* H2 = (const bf16*)(ws + WS_H2); const bf16* HS = (const bf16*)(ws + WS_HS);
    for (int s = F.wave; s < 64; s += NWAVES) { const int n = hsh(11000 + s) % NTOK; const i32x4 rec = tok[n];
        if (rec.x < 0 || rec.x >= tile[MAXT] * 256 || rec.y < 0 || rec.y >= tile[MAXT] * 256 || tile[MAXT] > MAXT || tile[MAXT] < 256) { chk_flags(ws)[32] = 1u; continue; }
        for (int k = lane; k < D; k += 64) { chk(ws, 33, bf2f(HS[(size_t)rec.x * D + k]), bf2f(H2[(size_t)n * D + k]), 0.f, 0.f); chk(ws, 33, bf2f(HS[(size_t)rec.y * D + k]), bf2f(H2[(size_t)n * D + k]), 0.f, 0.f); } }
    { const unsigned hh = hsh(12000 + F.wave * 64 + lane); const int e = hh & 31, n = (hh >> 5) & 1023, k = (hh >> 15) & 1023, k5 = k & 511;
        const int c = (n >> 3) * 4 + (n & 3); const float want = (n & 4) ? A.w_up3[((size_t)e * D + k) * DE + c] : A.w_up1[((size_t)e * D + k) * DE + c];
        chk(ws, 34, bf2f(((const bf16*)(ws + WS_WUP))[((size_t)e * 1024 + n) * D + k]), bfr(want), 0.f, 0.f);
        chk(ws, 35, bf2f(((const bf16*)(ws + WS_WDN))[((size_t)e * 1024 + n) * DE + k5]), bfr(A.w_down[((size_t)e * DE + k5) * D + n]), 0.f, 0.f); }
}
DI void chk_p12(const Frame& F, ARef A) {
    unsigned char* ws = A.ws; const int lane = F.lane; const i32x4* tok = (const i32x4*)(ws + WS_TOK); const int* tile = (const int*)(ws + WS_TILE);
    const bf16* H2 = (const bf16*)(ws + WS_H2); const bf16* HID = (const bf16*)(ws + WS_HID);
    for (int s = F.wave; s < 32; s += NWAVES) { const unsigned hh = hsh(13000 + s); const int n = hh % NTOK, c = (hh >> 16) & 511; const i32x4 rec = tok[n]; const int pos = (s & 1) ? rec.y : rec.x;
        const int e = tile[pos >> 8];
        const float u1 = wdot(H2 + (size_t)n * D, A.w_up1 + (size_t)e * D * DE, DE, c, D, lane), u3 = wdot(H2 + (size_t)n * D, A.w_up3 + (size_t)e * D * DE, DE, c, D, lane);
        chk(ws, 36, bf2f(HID[(size_t)pos * DE + c]), u1 / (1.0f + expf(-u1)) * u3, 0.04f, 0.01f); }
}
DI void chk_p13(const Frame& F, ARef A) {
    unsigned char* ws = A.ws; const int lane = F.lane; const i32x4* tok = (const i32x4*)(ws + WS_TOK); const int* tile = (const int*)(ws + WS_TILE);
    const bf16* HID = (const bf16*)(ws + WS_HID); const bf16* YE = (const bf16*)(ws + WS_HS);
    for (int s = F.wave; s < 32; s += NWAVES) { const unsigned hh = hsh(14000 + s); const int n = hh % NTOK, c = (hh >> 16) & 1023; const i32x4 rec = tok[n]; const int pos = (s & 1) ? rec.y : rec.x;
        const int e = tile[pos >> 8];
        chk(ws, 37, bf2f(YE[(size_t)pos * D + c]), wdot(HID + (size_t)pos * DE, A.w_down + (size_t)e * DE * D, D, c, DE, lane), 0.04f, 0.01f); }
}
#endif

__global__ void __launch_bounds__(NTHR, 2) hybrid_fwd(Args A_unused) {
    extern __shared__ __attribute__((aligned(16))) unsigned char lds_raw[];
    const CAS Args& A = *(const CAS Args*)__builtin_amdgcn_kernarg_segment_ptr();
    Frame F;
    F.lds = (LAS unsigned char*)lds_raw;
    F.wave = __builtin_amdgcn_readfirstlane((int)threadIdx.x >> 6); F.tid = opq_tid(F.wave); F.lane = F.tid & 63;
    F.wg = blockIdx.x; F.G = gridDim.x; F.gw = F.wg * NWAVES + F.wave; F.NGW = F.G * NWAVES;
    volatile LAS unsigned* MISC = (volatile LAS unsigned*)(F.lds + LDS_MISC);
    if (F.wave == 0) MISC[F.lane] = 0u;
    __syncthreads();
    const XcdBarrier bar = xcd_barrier_post((unsigned*)(A.ws + WS_CTL), MISC + 8, F.wave);
    unsigned char* ws = A.ws;
    LAS unsigned char* stage = F.lds;
    bf16* const dob = (bf16*)A.out;
    bf16 *H1 = dob, *R = dob, *KS = dob + (size_t)NTOK * BW, *V = dob + 2 * (size_t)NTOK * BW, *KK = dob + 3 * (size_t)NTOK * BW;

#if defined(STAMPS)
    unsigned long long* const tsp = (unsigned long long*)(ws + WS_CTL + 49152);
#define STAMP(k) do { if (F.wg == 0 && xb_t0(F.wave)) tsp[k] = wall_clock64(); } while (0)
#else
#define STAMP(k) do { } while (0)
#endif
#if defined(REPEAT_PHASE)
#ifndef REPEAT_COUNT
#define REPEAT_COUNT 2
#endif
#define REP(k) _Pragma("nounroll") for (int rep_ = 0; rep_ < ((k) == REPEAT_PHASE ? REPEAT_COUNT : 1); ++rep_)
#else
#define REP(k)
#endif
    STAMP(0);
    REP(0) {
    p0_prologue(F, A);
    xcd_barrier(bar);
    }
    STAMP(1);
#if defined(CHECKS)
    if (F.wg == 0) chk_p0(F, A);
#endif
    REP(1) {
    p1_h1(F, A, H1);
    xcd_barrier(bar);
    }
    STAMP(2);
#if defined(CHECKS)
    if (F.wg == 0) chk_p1(F, A, H1);
#endif
    REP(2) {
    {   pg8::Gemm g{H1, (const bf16*)(ws + WS_WIN), NTOK, NPAD, D}; pg8::StaticOrder S; S.init(NTOK, NPAD, F.G, F.wg);
        EpiIn E{(bf16*)(ws + WS_QB), (bf16*)(ws + WS_KB), (bf16*)(ws + WS_VT), (bf16*)(ws + WS_RWRAW), (bf16*)(ws + WS_LORA), (bf16*)(ws + WS_GATE), A.gate_bias};
        pg8::gemm_phase<EpiIn, pg8::StaticOrder>(stage, g, S, E, nullptr, F.wave); }
    xcd_barrier(bar);
    }
    STAMP(3);
#if defined(CHECKS)
    if (F.wg == 0) { chk_p2(F, A, H1); chk_p3_save(F, A); }
    xcd_barrier(bar);
#endif
#if !defined(CHECKS)
    const bool fuse34 = (F.G == 256);
#else
    const bool fuse34 = false;
#endif
    REP(3) {
    p3_attn(F, (const bf16*)(ws + WS_QB), (const bf16*)(ws + WS_KB), (const bf16*)(ws + WS_VT), (bf16*)(ws + WS_QB));
#if defined(STAMPS)
    STAMP(20);
#endif
    p3_prep(F, A, (const bf16*)(ws + WS_RWRAW), (const bf16*)(ws + WS_LORA), R, KS, V, KK, (bf16*)(ws + WS_ALORA));
#if !defined(CHECKS)
    if (fuse34) { asm volatile("s_waitcnt vmcnt(0)" ::: "memory"); __syncthreads();
        p4_lora(F, A, (const bf16*)(ws + WS_ALORA), (const bf16*)(ws + WS_WL), (bf16*)(ws + WS_E), KS, (bf16*)(ws + WS_B), (bf16*)(ws + WS_GG), KK, R, (float*)(ws + WS_BON)); }
#endif
    xcd_barrier(bar);
    }
#if defined(STAMPS)
    STAMP(21);
#endif
    STAMP(4);
#if defined(CHECKS)
    if (F.wg == 0) { chk_p3(F, A, R, KS, V, KK); chk_p4_save(F, A, KS); }
    xcd_barrier(bar);
#endif
    if (!fuse34) {
    p4_lora(F, A, (const bf16*)(ws + WS_ALORA), (const bf16*)(ws + WS_WL), (bf16*)(ws + WS_E), KS, (bf16*)(ws + WS_B), (bf16*)(ws + WS_GG), KK, R, (float*)(ws + WS_BON));
    xcd_barrier(bar);
    }
    STAMP(5);
#if defined(CHECKS)
    if (F.wg == 0) chk_p4(F, A, KS, KK);
#endif
    REP(5) {
    p5_mfma(ws, F, R, KS, V, KK, (const bf16*)(ws + WS_B), (const bf16*)(ws + WS_E), (bf16*)(ws + WS_P), (bf16*)(ws + WS_QO), (bf16*)(ws + WS_GT), (bf16*)(ws + WS_HT));
    p6_moe_weights(F, A, F.gw, F.NGW);
    xcd_barrier(bar);
    }
    STAMP(6);
#if defined(CHECKS)
    if (F.wg == 255) chk_p7_save(F, A);
#endif
    REP(6) {
    {   const int ncw = F.G < 64 ? F.G : 64;
        if (F.wg < ncw) { if (F.wave == 0) for (int task = F.wg; task < 64; task += ncw) p6_chain(task, F.wave, F.lds, (const bf16*)(ws + WS_GT), (const bf16*)(ws + WS_HT), (bf16*)(ws + WS_SC));
#if defined(STAMPS)
            STAMP(22);
#endif
        }
        else {
            pg8::StaticOrder S; S.init(NTOK, D, F.G - ncw, F.wg - ncw);
            pg8::Gemm g{(const bf16*)(ws + WS_QB), (const bf16*)(ws + WS_WOSB), NTOK, D, BW};
            EpiMerge<false> E{(bf16*)(ws + WS_GATE), (bf16*)(ws + WS_MRG), 0};
            pg8::gemm_phase<EpiMerge<false>, pg8::StaticOrder>(stage, g, S, E, nullptr, F.wave); }
    }
    xcd_barrier(bar);
    }
    STAMP(7);
    REP(7) {
    p7_mfma(F, A, (const bf16*)(ws + WS_SC), (const bf16*)(ws + WS_P), (const bf16*)(ws + WS_QO), V, (const bf16*)(ws + WS_GG), (const float*)(ws + WS_BON), (bf16*)(ws + WS_YRW));
    xcd_barrier(bar);
    }
    STAMP(8);
#if defined(CHECKS)
    if (F.wg == 0) chk_p7(F, A, R, KS, V, KK);
#endif
    REP(8) {
    {   pg8::StaticOrder S; S.init(NTOK, D, F.G, F.wg);
        {   pg8::Gemm g{(const bf16*)(ws + WS_YRW), (const bf16*)(ws + WS_WORW), NTOK, D, BW};
            EpiMerge<true> E{(bf16*)(ws + WS_GATE), (bf16*)(ws + WS_MRG), D};
            pg8::gemm_phase<EpiMerge<true>, pg8::StaticOrder>(stage, g, S, E, nullptr, F.wave); } }
    xcd_barrier(bar);
    }
    STAMP(9);
#if defined(CHECKS)
    if (F.wg == 0) chk_p8(F, A);
#endif
    REP(9) {
    {   pg8::Gemm g{(const bf16*)(ws + WS_MRG), (const bf16*)(ws + WS_WOUT), NTOK, D, D}; pg8::StaticOrder S; S.init(NTOK, D, F.G, F.wg);
        EpiPlain E{(bf16*)(ws + WS_Y1), D, 0xff};
        pg8::gemm_phase<EpiPlain, pg8::StaticOrder>(stage, g, S, E, nullptr, F.wave); }
    xcd_barrier(bar);
    }
    STAMP(10);
#if defined(CHECKS)
    if (F.wg == 0) chk_p9(F, A);
#endif
    REP(10) {
    p10_rows(F, A, (const bf16*)(ws + WS_Y1), (bf16*)(ws + WS_H2));
    xcd_barrier(bar);
    }
    STAMP(11);
#if defined(CHECKS)
    if (F.wg == 0) chk_p10(F, A);
#endif
    REP(11) {
    p11_rank_gather(F, A, (const bf16*)(ws + WS_H2), (bf16*)(ws + WS_HS));
    xcd_barrier(bar);
    }
    STAMP(12);
#if defined(CHECKS)
    if (F.wg == 0) chk_p11(F, A);
#endif
    {   const int* tile = (const int*)(ws + WS_TILE);
        const int nt = __builtin_amdgcn_readfirstlane(tile[MAXT]);
        const int vc = (F.G % 8 == 0) ? (F.wg % 8) * (F.G / 8) + F.wg / 8 : F.wg;
        unsigned* tcnt = (unsigned*)(ws + WS_CTL) + MOE_CNT_WORD;
        REP(12) {   pg8::Gemm g{(const bf16*)(ws + WS_HS), (const bf16*)(ws + WS_WUP), MAXT * 256, NE * 1024, D};
            MoeUpOrder S; S.nunits = nt * 4; S.G = F.G; S.vc = vc; S.tile_e = tile; S.cnt = tcnt;
            EpiUp E{(bf16*)(ws + WS_HID)};
            pg8::gemm_phase<EpiUp, MoeUpOrder>(stage, g, S, E, nullptr, F.wave); }
        __syncthreads();
    STAMP(13);
        REP(13) {   pg8::Gemm g{(const bf16*)(ws + WS_HID), (const bf16*)(ws + WS_WDN), MAXT * 256, NE * 1024, DE};
            MoeDnOrder S; S.nunits = nt * 4; S.G = F.G; S.vc = vc; S.q = (nt * 4) / F.G; S.rem = nt * 4 - S.q * F.G; S.wave = F.wave; S.tile_e = tile; S.cnt = tcnt;
            EpiPlain E{(bf16*)(ws + WS_HS), D, 3};
            pg8::gemm_phase<EpiPlain, MoeDnOrder>(stage, g, S, E, nullptr, F.wave);
        xcd_barrier(bar); } }
    STAMP(14);
#if defined(CHECKS)
    if (F.wg == 0) chk_p13(F, A);
#endif
    p14_final(F, A, (const bf16*)(ws + WS_HS));
#if defined(STAMPS)
    xcd_barrier(bar);
    STAMP(15);
    if (F.wg == 0) { __syncthreads();
        const float va = (float)(long long)(tsp[STAMP_A2] - tsp[STAMP_A]) * 0.01f, vb = (float)(long long)(tsp[STAMP_B2] - tsp[STAMP_B]) * 0.01f;
#if defined(STAMP_SHIFT)
        const float shf_ = 1.1f;
#else
        const float shf_ = 1.0f;
#endif
        int b1 = (int)floorf(logf(fmaxf(va * shf_, 1.0f)) / logf(1.21f)) + 1, b2 = (int)floorf(logf(fmaxf(vb * shf_, 1.0f)) / logf(1.21f)) + 1;
#if defined(STAMP_CAL)
        b1 = 10; b2 = 30;
#endif
#if defined(STAMP_FRAC)
        { const unsigned long long* t5 = tsp + 32; const float tot = (float)(long long)(t5[9] - t5[0]);
          b1 = (int)(12.0f * (float)(long long)(t5[STAMP_A2] - t5[STAMP_A]) / tot) + 3; b2 = (int)(12.0f * (float)(long long)(t5[STAMP_B2] - t5[STAMP_B]) / tot) + 3; }
#endif
#if defined(STAMP_THR_A)
        b1 = va > (float)(STAMP_THR_A) ? 30 : 10; b2 = vb > (float)(STAMP_THR_B) ? 30 : 10;
#endif
        const int t_ = opq_tid(F.wave);
        for (int i = t_; i < 1000; i += NTHR) A.out[1000 + i] += 20.0f * (float)b2;
        if (t_ == 0) A.out[0] = 200.0f * (float)b1; }
#endif
#if defined(CHECKS)
    xcd_barrier(bar);
    if (F.wg == 0 && F.tid == 0) { const unsigned* fl = chk_flags(ws); int id = 0; for (int i = 61; i >= 0; --i) if (fl[i]) id = i;
        if (((const unsigned*)(ws + WS_CTL))[XB_TMO]) id = 60;
        if (id) A.out[0] = 10.0f * (float)id;
#if defined(CHKVAL)
        A.out[0] = 1000.0f * ((const float*)fl)[CHKVAL];
#endif
        }
#endif
}

extern "C" void kernel_launch(void* const* d_in, const int* in_sizes, int n_in, void* d_out, int out_size, void* d_ws, size_t ws_size, hipStream_t stream) {
    static int grid = 0;
    if (grid == 0) {
        if (n_in != 26 || in_sizes[0] != NTOK * D || out_size != NTOK * D || ws_size < WS_END) {
            fprintf(stderr, "kernel_launch: unexpected shapes (n_in %d, in0 %d, out %d, ws %zu); nothing launched\n", n_in, n_in > 0 ? in_sizes[0] : -1, out_size, ws_size); grid = -1; return; }
        int dev = 0, cus = 0, per_cu = 0;
        if (hipGetDevice(&dev) != hipSuccess || hipDeviceGetAttribute(&cus, hipDeviceAttributeMultiprocessorCount, dev) != hipSuccess) { grid = -1; return; }
        if (hipFuncSetAttribute((const void*)hybrid_fwd, hipFuncAttributeMaxDynamicSharedMemorySize, LDS_BYTES) != hipSuccess) { fprintf(stderr, "kernel_launch: hipFuncSetAttribute failed\n"); grid = -1; return; }
        if (hipOccupancyMaxActiveBlocksPerMultiprocessor(&per_cu, (const void*)hybrid_fwd, NTHR, LDS_BYTES) != hipSuccess || per_cu < 1)
            fprintf(stderr, "kernel_launch: note: occupancy query reports %d workgroups per CU\n", per_cu);
        (void)hipGetLastError();
        grid = cus > 256 ? 256 : cus;
    }
    if (grid < 0) return;
    if (hipMemsetAsync((char*)d_ws + WS_CTL, 0, CTL_ZERO_BYTES, stream) != hipSuccess) return;
    Args a{};
    const float** p = (const float**)&a;
    for (int i = 0; i < 26; ++i) p[i] = (const float*)d_in[i];
    a.out = (float*)d_out; a.ws = (unsigned char*)d_ws;
    hipLaunchKernelGGL(hybrid_fwd, dim3(grid), dim3(NTHR), LDS_BYTES, stream, a);
}

#if defined(ONLY_P5)
__global__ void __launch_bounds__(NTHR, 2) only_p5(Args A_unused) {
    extern __shared__ __attribute__((aligned(16))) unsigned char lds_raw[];
    const CAS Args& A = *(const CAS Args*)__builtin_amdgcn_kernarg_segment_ptr();
    Frame F; F.lds = (LAS unsigned char*)lds_raw; F.wave = __builtin_amdgcn_readfirstlane((int)threadIdx.x >> 6); F.tid = opq_tid(F.wave); F.lane = F.tid & 63;
    F.wg = blockIdx.x; F.G = gridDim.x; F.gw = F.wg * NWAVES + F.wave; F.NGW = F.G * NWAVES;
    unsigned char* ws = A.ws; bf16* const dob = (bf16*)A.out;
    bf16 *R = dob, *KS = dob + (size_t)NTOK * BW, *V = dob + 2 * (size_t)NTOK * BW, *KK = dob + 3 * (size_t)NTOK * BW;
    p5_mfma(ws, F, R, KS, V, KK, (const bf16*)(ws + WS_B), (const bf16*)(ws + WS_E), (bf16*)(ws + WS_P), (bf16*)(ws + WS_QO), (bf16*)(ws + WS_GT), (bf16*)(ws + WS_HT));
}
#endif
```

```cpp
#include <hip/hip_runtime.h>
#include <cstdio>
#include <cstdint>
__device__ __forceinline__ int opq_tid(int wave) { int l; asm volatile("v_mbcnt_lo_u32_b32 %0, -1, 0\n\tv_mbcnt_hi_u32_b32 %0, -1, %0" : "=v"(l)); return wave * 64 + l; }
#ifndef PHMASK
#define PHMASK 0xffff
#endif
namespace pg8 {
#define PG8_LAS __attribute__((address_space(3)))
typedef unsigned short bf16_t;
typedef short bf16x8 __attribute__((ext_vector_type(8)));
typedef float f32x4 __attribute__((ext_vector_type(4)));
typedef unsigned u32x4 __attribute__((ext_vector_type(4)));
constexpr int BM = 256, BK = 64, HALF = 128, HTB = HALF * BK * 2  , STAGE_BYTES = 8 * HTB, NXCD = 8, WGM = 8;

__host__ __device__ __forceinline__ int lds_byte(int r, int c) { const int st = (r >> 4) * 2 + (c >> 5), rr = r & 15, cc = c & 31, ob = rr * 64 + cc * 2; return st * 1024 + (ob ^ (((ob >> 9) & 1) << 5)); }
__host__ __device__ __forceinline__ void stage_rc(int b, int& R, int& C) { const int st = b / 1024, sb = b % 1024, swz = sb ^ (((sb >> 9) & 1) << 5); R = (st >> 1) * 16 + swz / 64; C = (st & 1) * 32 + (swz % 64) / 2; }
__host__ __device__ __forceinline__ int perm32(int rho) { const int n = rho >> 4, i = rho & 15; return 8 * (i >> 2) + 4 * n + (i & 3); }

struct Unit { int pm, pn; };
struct Gemm { const bf16_t* A; const bf16_t* Bt; int M, N, K; };

struct StaticOrder {
    int nM, nN, nwg, G, c;
    __host__ __device__ void init(int M, int N, int G_, int c_) { nM = M / BM; nN = N / BM; nwg = nM * nN; G = G_; c = c_; }
    __host__ __device__ bool next(int i, Unit& u) const {
        const long L = (long)i * G + c; if (L >= nwg) return false;
        int wgid = (int)L; { const int q = nwg / NXCD, r = nwg % NXCD, xcd = wgid % NXCD, off = wgid / NXCD; wgid = (xcd < r ? xcd * (q + 1) : r * (q + 1) + (xcd - r) * q) + off; }
        const int nig = WGM * nN, gid = wgid / nig, fm = gid * WGM, gsz = (nM - fm) < WGM ? (nM - fm) : WGM;
        u.pm = fm + ((wgid % nig) % gsz); u.pn = (wgid % nig) / gsz; return true;
    }
    __device__ __forceinline__ void a_ready(const Unit&) const {}
    __device__ __forceinline__ void done(const Unit&) const {}
};

template <class Epi, class Sched, bool STAMP = false>
__device__ __forceinline__ void gemm_phase(PG8_LAS unsigned char* lds, const Gemm g, const Sched& S, const Epi& E, unsigned long long* stamps, int wave_id) {
    const int tid = opq_tid(wave_id), wid = __builtin_amdgcn_readfirstlane(tid >> 6), lane = tid & 63, wr = wid >> 2, wc = wid & 3, fr = lane & 15, fq = lane >> 4;
    const int K = g.K, nt = K / BK;
    int ts_lo = 0, ts_hi = 0, nts = 0; const unsigned long long rt_entry = STAMP ? (unsigned long long)wall_clock64() : 0ull;
#define PG8_STAMP() do { if (STAMP && wid == 0 && nts < 64) { const unsigned long long _c = (unsigned long long)clock64(); \
        ts_lo = (lane == nts) ? (int)(unsigned)_c : ts_lo; ts_hi = (lane == nts) ? (int)(unsigned)(_c >> 32) : ts_hi; ++nts; } } while (0)
    PG8_STAMP();
    unsigned voffA[2], voffB[2];
#pragma unroll
    for (int i = 0; i < 2; ++i) { int R, C; stage_rc(tid * 16 + i * 8192, R, C); const int Rb = Epi::PERM ? ((R & ~31) + perm32(R & 31)) : R;
        voffA[i] = (unsigned)(R * K + C) * 2u; voffB[i] = (unsigned)(Rb * K + C) * 2u; }
    const size_t kstep = (size_t)(BK * 2);
    const size_t hstep = (size_t)HALF * K * 2;
    const size_t tstep = 2 * hstep;
    const unsigned ldsw = (unsigned)wid * 1024u;
    const int aoff = lds_byte(wr * 64 + fr, fq * 8), boff = lds_byte(wc * 32 + fr, fq * 8);
#define PG8_SA(b, h) (((b) * 2 + (h)) * HTB)
#define PG8_SB(b, h) ((4 + (b) * 2 + (h)) * HTB)
#define PG8_STAGE(bufoff, gbase, voff) do { _Pragma("unroll") for (int _i = 0; _i < 2; ++_i) \
        __builtin_amdgcn_global_load_lds((const unsigned*)((const char*)(gbase) + (voff)[_i]), (PG8_LAS unsigned*)(lds + (bufoff) + ldsw + _i * 8192), 16, 0, 0); } while (0)
#define PG8_LDA(dst, b, h) do { _Pragma("unroll") for (int m = 0; m < 4; ++m) _Pragma("unroll") for (int k = 0; k < 2; ++k) dst[m][k] = *(const PG8_LAS bf16x8*)(lds + PG8_SA(b, h) + aoff + m * 2048 + k * 1024); } while (0)
#define PG8_LDB(dst, b, h) do { _Pragma("unroll") for (int n = 0; n < 2; ++n) _Pragma("unroll") for (int k = 0; k < 2; ++k) dst[n][k] = *(const PG8_LAS bf16x8*)(lds + PG8_SB(b, h) + boff + n * 2048 + k * 1024); } while (0)
#define PG8_MMA(ai, bj, At, Bt) do { __builtin_amdgcn_s_setprio(1); _Pragma("unroll") for (int m = 0; m < 4; ++m) _Pragma("unroll") for (int n = 0; n < 2; ++n) _Pragma("unroll") for (int k = 0; k < 2; ++k) \
        acc[ai][bj][m][n] = __builtin_amdgcn_mfma_f32_16x16x32_bf16(Bt[n][k], At[m][k], acc[ai][bj][m][n], 0, 0, 0); __builtin_amdgcn_s_setprio(0); } while (0)
#define PG8_WAIT_V(n) asm volatile("s_waitcnt vmcnt(" #n ")" ::: "memory")
#define PG8_WAIT_L(n) asm volatile("s_waitcnt lgkmcnt(" #n ")" ::: "memory")
#define PG8_BAR __builtin_amdgcn_s_barrier()
#define PG8_SCHED __builtin_amdgcn_sched_barrier(0)
    Unit cur, nxt; int ui = 0;
    if (!S.next(0, cur)) return;
    f32x4 acc[2][2][4][2];
#pragma unroll
    for (int a = 0; a < 2; ++a)
#pragma unroll
        for (int b = 0; b < 2; ++b)
#pragma unroll
            for (int m = 0; m < 4; ++m)
#pragma unroll
                for (int n = 0; n < 2; ++n) acc[a][b][m][n] = (f32x4){0.f, 0.f, 0.f, 0.f};
    bf16x8 At[4][2], B0[2][2], B1[2][2];
    const char* cA = (const char*)g.A + (size_t)cur.pm * tstep; const char* cB = (const char*)g.Bt + (size_t)cur.pn * tstep;
    S.a_ready(cur);
    PG8_STAGE(PG8_SB(0, 0), cB, voffB); PG8_STAGE(PG8_SA(0, 0), cA, voffA); PG8_STAGE(PG8_SB(0, 1), cB + hstep, voffB); PG8_STAGE(PG8_SA(0, 1), cA + hstep, voffA);
    if (wr == 1) PG8_BAR;
    PG8_WAIT_V(4); PG8_BAR;
    PG8_STAGE(PG8_SB(1, 0), cB + kstep, voffB); PG8_STAGE(PG8_SA(1, 0), cA + kstep, voffA); PG8_STAGE(PG8_SB(1, 1), cB + hstep + kstep, voffB);
    PG8_WAIT_V(6); PG8_BAR;
    PG8_STAMP();
    for (;;) {
        const bool has_next = S.next(ui + 1, nxt);
        const char* nA = has_next ? (const char*)g.A + (size_t)nxt.pm * tstep : cA; const char* nB = has_next ? (const char*)g.Bt + (size_t)nxt.pn * tstep : cB;
        for (int t = 0; t < nt; t += 2) {
            const bool last = (t == nt - 2);
            const char* a1 = cA + (size_t)(t + 1) * kstep;
            const char* a2 = last ? nA : cA + (size_t)(t + 2) * kstep; const char* b2 = last ? nB : cB + (size_t)(t + 2) * kstep;
            const char* a3 = a2 + kstep; const char* b3 = b2 + kstep;
            if (last && has_next) S.a_ready(nxt);
            PG8_LDB(B0, 0, 0); PG8_SCHED; PG8_LDA(At, 0, 0); PG8_STAGE(PG8_SA(1, 1), a1 + hstep, voffA);
            PG8_WAIT_L(8); PG8_BAR; PG8_WAIT_L(0); PG8_MMA(0, 0, At, B0); PG8_BAR; PG8_SCHED;
            PG8_LDB(B1, 0, 1); PG8_STAGE(PG8_SB(0, 0), b2, voffB);
            PG8_BAR; PG8_WAIT_L(0); PG8_MMA(0, 1, At, B1); PG8_BAR;
            PG8_LDA(At, 0, 1); PG8_STAGE(PG8_SA(0, 0), a2, voffA);
            PG8_BAR; PG8_WAIT_L(0); PG8_MMA(1, 0, At, B0); PG8_BAR; PG8_SCHED;
            PG8_STAGE(PG8_SB(0, 1), b2 + hstep, voffB);
            PG8_WAIT_V(6); PG8_BAR; PG8_MMA(1, 1, At, B1); PG8_BAR;
            PG8_LDB(B0, 1, 0); PG8_SCHED; PG8_LDA(At, 1, 0); PG8_STAGE(PG8_SA(0, 1), a2 + hstep, voffA);
            PG8_WAIT_L(8); PG8_BAR; PG8_WAIT_L(0); PG8_MMA(0, 0, At, B0); PG8_BAR; PG8_SCHED;
            PG8_LDB(B1, 1, 1); PG8_STAGE(PG8_SB(1, 0), b3, voffB);
            PG8_BAR; PG8_WAIT_L(0); PG8_MMA(0, 1, At, B1); PG8_BAR;
            PG8_LDA(At, 1, 1); PG8_STAGE(PG8_SA(1, 0), a3, voffA);
            PG8_BAR; PG8_WAIT_L(0); PG8_MMA(1, 0, At, B0); PG8_BAR; PG8_SCHED;
            PG8_STAGE(PG8_SB(1, 1), b3 + hstep, voffB);
            PG8_WAIT_V(6); PG8_BAR; PG8_MMA(1, 1, At, B1); PG8_BAR;
        }
        PG8_STAMP();
        if constexpr (!Epi::AFTER_DRAIN) { E(acc, cur, wr, wc, fr, fq); S.done(cur); }
        PG8_STAMP();
        if (!has_next) break;
#pragma unroll
        for (int a = 0; a < 2; ++a)
#pragma unroll
            for (int b = 0; b < 2; ++b)
#pragma unroll
                for (int m = 0; m < 4; ++m)
#pragma unroll
                    for (int n = 0; n < 2; ++n) acc[a][b][m][n] = (f32x4){0.f, 0.f, 0.f, 0.f};
        cur = nxt; cA = nA; cB = nB; ++ui;
    }
    PG8_WAIT_V(0);
    if (wr == 0) PG8_BAR;
    PG8_BAR;
    if constexpr (Epi::AFTER_DRAIN) { E.fused(acc, cur, wr, wc, fr, fq, lds, wid, lane); S.done(cur); }
    PG8_STAMP();
    if (STAMP && wid == 0) { stamps[lane] = lane < nts ? (((unsigned long long)(unsigned)ts_hi << 32) | (unsigned)ts_lo) : 0ull;
        if (lane == 62) stamps[62] = rt_entry; if (lane == 63) stamps[63] = (unsigned long long)wall_clock64(); }
#undef PG8_STAMP
#undef PG8_SA
#undef PG8_SB
#undef PG8_STAGE
#undef PG8_LDA
#undef PG8_LDB
#undef PG8_MMA
#undef PG8_WAIT_V
#undef PG8_WAIT_L
#undef PG8_BAR
#undef PG8_SCHED
}
}

#define XB_TMO      128
#define XB_XCNT(j)  (256  + 64 * (j))
#define XB_XSUB(j)  (1280 + 64 * (j))
#define XB_XGEN(j)  (2304 + 64 * (j))
#define XB_TOP      3328
#define XB_TOPGEN   3392
#define XCD_BAR_WORDS 3456
#define XB_SPIN_CAP (1u << 18)
#define LAS __attribute__((address_space(3)))

__device__ __forceinline__ unsigned xb_ld(unsigned* p)              { return __hip_atomic_load(p, __ATOMIC_RELAXED, __HIP_MEMORY_SCOPE_AGENT); }
__device__ __forceinline__ unsigned xb_add(unsigned* p, unsigned v) { return __hip_atomic_fetch_add(p, v, __ATOMIC_RELAXED, __HIP_MEMORY_SCOPE_AGENT); }
__device__ __forceinline__ unsigned xb_xcc_id() { return (unsigned)__builtin_amdgcn_s_getreg((3 << 11) | 20) & 0xFu; }
#define XB_SPIN(cond, bar) do { unsigned _sp = 0; while (cond) { __builtin_amdgcn_s_sleep(1); \
    if ((++_sp & 255u) == 0u) { if (xb_ld(&(bar)[XB_TMO])) break; if (_sp > XB_SPIN_CAP) { atomicAdd(&(bar)[XB_TMO], 1u); break; } } } } while (0)

struct XcdBarrier {
    unsigned* bar; unsigned x; int wave;
    volatile LAS unsigned* st;
};

__device__ __forceinline__ bool xb_t0(int wave) { return wave == 0 && __builtin_amdgcn_mbcnt_hi(~0u, __builtin_amdgcn_mbcnt_lo(~0u, 0u)) == 0u; }
__device__ __forceinline__ XcdBarrier xcd_barrier_post(unsigned* bar, volatile LAS unsigned* st, int wave) {
    XcdBarrier b; b.bar = bar; b.x = xb_xcc_id(); b.st = st; b.wave = wave;
    if (xb_t0(wave)) (void)xb_add(&bar[XB_XCNT(b.x)], 1u);
    return b;
}
__device__ __forceinline__ void xcd_barrier_complete(unsigned* bar, unsigned x, unsigned& nloc, unsigned& nx) {
    const unsigned G = gridDim.x * gridDim.y * gridDim.z;
    unsigned sum, cnt, mine, sp = 0u;
    for (;;) {
        sum = 0u; cnt = 0u; mine = 0u;
#pragma unroll
        for (unsigned j = 0; j < 16; ++j) { const unsigned c = xb_ld(&bar[XB_XCNT(j)]); sum += c; cnt += (c > 0u) ? 1u : 0u; mine = (j == x) ? c : mine; }
        if (sum == G) break;
        __builtin_amdgcn_s_sleep(1);
        if ((++sp & 255u) == 0u) { if (xb_ld(&bar[XB_TMO])) break; if (sp > XB_SPIN_CAP) { atomicAdd(&bar[XB_TMO], 1u); break; } }
    }
    nloc = mine > 0u ? mine : 1u; nx = cnt > 0u ? cnt : 1u;
}

__device__ __forceinline__ void xcd_barrier(const XcdBarrier& b) {
    asm volatile("s_waitcnt vmcnt(0)" ::: "memory");
    __syncthreads();
    if (xb_t0(b.wave)) {
        unsigned* bar = b.bar;
        __builtin_amdgcn_s_waitcnt(0);
        unsigned nloc = b.st[0], nx = b.st[1];
        if (nloc == 0u) { xcd_barrier_complete(bar, b.x, nloc, nx); b.st[0] = nloc; b.st[1] = nx; }
        const unsigned old = xb_add(&bar[XB_XSUB(b.x)], 1u);
        const unsigned gen = old / nloc;
        if (old + 1u == (gen + 1u) * nloc) {
            __builtin_amdgcn_fence(__ATOMIC_RELEASE, "agent");
            asm volatile("s_waitcnt vmcnt(0)" ::: "memory");
            const unsigned og = xb_add(&bar[XB_TOP], 1u);
            const unsigned tg = og / nx;
            if (og + 1u == (tg + 1u) * nx) xb_add(&bar[XB_TOPGEN], 1u);
            else XB_SPIN(xb_ld(&bar[XB_TOPGEN]) == tg, bar);
            __builtin_amdgcn_fence(__ATOMIC_ACQUIRE, "agent");
            xb_add(&bar[XB_XGEN(b.x)], 1u);
            asm volatile("s_waitcnt vmcnt(0)" ::: "memory");
        } else {
            XB_SPIN(xb_ld(&bar[XB_XGEN(b.x)]) == gen, bar);
            __builtin_amdgcn_fence(__ATOMIC_ACQUIRE, "agent");
            asm volatile("s_waitcnt vmcnt(0)" ::: "memory");
        }
    }
    __syncthreads();
}


constexpr int NB = 4, SEQ = 8192, D = 1024, NTOK = NB * SEQ;
constexpr int NH = 8, HD = 64, BW = 512;
constexpr int IN_COLS = 5408, NPAD = 5632;
constexpr int LK = 384;
constexpr int NE = 32, DE = 512;
constexpr int CH = 64, NCH = SEQ / CH, NCH_LOG = 7, NCHUNK = NB * NH * NCH;
constexpr int MAXT = 288;
constexpr float NORM_EPS = 1e-6f, GN_EPS = 64e-5f, L2_EPS = 1e-12f;
constexpr float SB_STOP = -120.0f;

constexpr size_t MiB = 1u << 20;
constexpr size_t WS_CTL = 0, CTL_ZERO_BYTES = 65536;
constexpr size_t WS_MOD = 1 * MiB;
constexpr size_t WS_RTW = WS_MOD + 128 * 1024;
constexpr size_t WS_TOK = WS_RTW + 160 * 1024;
constexpr size_t WS_CNT = WS_TOK + (size_t)NTOK * 16;
constexpr size_t WS_TILE = WS_CNT + 256 * 32 * 4;
constexpr size_t WS_WIN = 2 * MiB;
constexpr size_t WS_WOSB = 13 * MiB, WS_WORW = 14 * MiB, WS_WOUT = 15 * MiB;
constexpr size_t WS_WL = 17 * MiB;
constexpr size_t WS_BON = 18 * MiB + 256 * 1024;
constexpr size_t WS_CW = 19 * MiB + 768 * 1024;
constexpr size_t WS_QB = 20 * MiB;
constexpr size_t WS_GATE = 52 * MiB;
constexpr size_t WS_GG = 180 * MiB;
constexpr size_t WS_KB = 212 * MiB, WS_VT = 244 * MiB;
constexpr size_t WS_LORA = 276 * MiB;
constexpr size_t WS_ALORA = 308 * MiB;
constexpr size_t WS_E = 340 * MiB, WS_B = 372 * MiB;
constexpr size_t WS_RWRAW = 416 * MiB;
constexpr size_t WS_P = 212 * MiB, WS_QO = 244 * MiB;
constexpr size_t WS_GT = 276 * MiB;
constexpr size_t WS_HT = 308 * MiB;
constexpr size_t WS_SC = 340 * MiB;
constexpr size_t WS_YRW = 384 * MiB;
constexpr size_t WS_WUP = 416 * MiB, WS_WDN = 480 * MiB;
constexpr size_t WS_MRG = 212 * MiB;
constexpr size_t WS_Y1 = 276 * MiB;
constexpr size_t WS_H2 = 52 * MiB;
constexpr size_t WS_HS = 116 * MiB;
constexpr size_t WS_HID = 260 * MiB;
constexpr size_t WS_X1 = 340 * MiB;
constexpr size_t WS_END = 512 * MiB;
static_assert(WS_TILE + (MAXT + 1) * 4 <= WS_WIN && WS_WIN + (size_t)NPAD * D * 2 <= WS_WOSB && WS_WL + 1536 * LK * 2 <= WS_QB, "fixed region");
static_assert(WS_HS + (size_t)MAXT * 256 * D * 2 <= WS_HID && WS_HID + (size_t)MAXT * 256 * DE * 2 <= WS_WUP, "moe region");
static_assert(WS_ALORA + (size_t)NTOK * LK * 2 <= WS_E && WS_B + (size_t)NTOK * BW * 2 <= WS_RWRAW, "rwkv region");

constexpr int LDS_BYTES = 163840;
constexpr int LDS_MISC = LDS_BYTES - 256;
constexpr int NWAVES = 8, NTHR = 512;

typedef unsigned short bf16;
typedef short bf16x8 __attribute__((ext_vector_type(8)));
typedef short s16x4 __attribute__((ext_vector_type(4)));
typedef float f32x4 __attribute__((ext_vector_type(4)));
typedef float f32x16 __attribute__((ext_vector_type(16)));
typedef unsigned u32x4 __attribute__((ext_vector_type(4)));
typedef unsigned u32x2 __attribute__((ext_vector_type(2)));
typedef int i32x4 __attribute__((ext_vector_type(4)));
#define DI __device__ __forceinline__
#define GAS __attribute__((address_space(1)))
#define MFMA32(a, b, c) __builtin_amdgcn_mfma_f32_32x32x16_bf16((a), (b), (c), 0, 0, 0)

typedef float f32x2_t __attribute__((ext_vector_type(2))); typedef __bf16 bf16x2_t __attribute__((ext_vector_type(2)));
DI unsigned pk2(float lo, float hi) { f32x2_t v = {lo, hi}; return __builtin_bit_cast(unsigned, __builtin_convertvector(v, bf16x2_t)); }
DI unsigned f2bf(float f) { return pk2(f, 0.0f) & 0xffffu; }
DI float bflo(unsigned u) { return __builtin_bit_cast(float, u << 16); }
DI float bfhi(unsigned u) { return __builtin_bit_cast(float, u & 0xffff0000u); }
DI float bf2f(bf16 h) { return __builtin_bit_cast(float, (unsigned)h << 16); }
DI float fexp(float x) { return __expf(x); }
DI float frcp(float x) { return __builtin_amdgcn_rcpf(x); }
DI float fsigmoid(float x) { return frcp(1.0f + fexp(-x)); }
DI float fsoftplus(float x) { return fmaxf(x, 0.0f) + __logf(1.0f + fexp(-fabsf(x))); }
#define DPP_SHR(v, ctrl) __builtin_bit_cast(float, __builtin_amdgcn_update_dpp(0, __builtin_bit_cast(int, (v)), (ctrl), 0xf, 0xf, true))
DI float wave_sum(float v) {
    v += DPP_SHR(v, 0x111); v += DPP_SHR(v, 0x112); v += DPP_SHR(v, 0x114); v += DPP_SHR(v, 0x118);
    v += __builtin_bit_cast(float, __builtin_amdgcn_update_dpp(0, __builtin_bit_cast(int, v), 0x142, 0xa, 0xf, false));
    v += __builtin_bit_cast(float, __builtin_amdgcn_update_dpp(0, __builtin_bit_cast(int, v), 0x143, 0xc, 0xf, false));
    return __builtin_bit_cast(float, __builtin_amdgcn_readlane(__builtin_bit_cast(int, v), 63));
}
DI float shfl_xor_l(float v, int m, int lane) { return __builtin_bit_cast(float, __builtin_amdgcn_ds_bpermute(4 * (lane ^ m), __builtin_bit_cast(int, v))); }
DI int crow(int reg, int hh) { return (reg & 3) + 8 * (reg >> 2) + 4 * hh; }
DI void wave_lds_fence() { __builtin_amdgcn_fence(__ATOMIC_RELEASE, "wavefront"); __builtin_amdgcn_wave_barrier(); __builtin_amdgcn_fence(__ATOMIC_ACQUIRE, "wavefront"); }
DI void unpack8(const u32x4 v, float (&o)[8]) { o[0] = bflo(v.x); o[1] = bfhi(v.x); o[2] = bflo(v.y); o[3] = bfhi(v.y); o[4] = bflo(v.z); o[5] = bfhi(v.z); o[6] = bflo(v.w); o[7] = bfhi(v.w); }
DI u32x4 pack8(const float (&o)[8]) { u32x4 v; v.x = pk2(o[0], o[1]); v.y = pk2(o[2], o[3]); v.z = pk2(o[4], o[5]); v.w = pk2(o[6], o[7]); return v; }
DI bf16x8 pack8v(float a0, float a1, float a2, float a3, float a4, float a5, float a6, float a7) {
    u32x4 v; v.x = pk2(a0, a1); v.y = pk2(a2, a3); v.z = pk2(a4, a5); v.w = pk2(a6, a7); return __builtin_bit_cast(bf16x8, v); }


#if defined(CHECKS)
constexpr int DBG_TOKEN = 77;
#endif

typedef pg8::f32x4 af4;
DI void st8(bf16* p, const af4 v0, const af4 v1) { u32x4 w; w.x = pk2(v0[0], v0[1]); w.y = pk2(v0[2], v0[3]); w.z = pk2(v1[0], v1[1]); w.w = pk2(v1[2], v1[3]); *(u32x4*)p = w; }

struct EpiIn {
    static constexpr bool PERM = true, AFTER_DRAIN = false;
    bf16 *Q, *K, *Vt, *RW, *LO, *GA; const float* gate_bias;
    DI void operator()(const af4 (&acc)[2][2][4][2], const pg8::Unit& u, int wr, int wc, int fr, int fq) const {
        const int pn = u.pn, row0 = u.pm * 256 + wr * 64 + fr;
        if (pn == 4 || pn == 5) {
#pragma unroll
            for (int ai = 0; ai < 2; ++ai)
#pragma unroll
                for (int m = 0; m < 4; ++m) { const int row = row0 + ai * 128 + m * 16, b = row >> 13, s = row & (SEQ - 1);
#pragma unroll
                    for (int bj = 0; bj < 2; ++bj)
#pragma unroll
                        for (int n = 0; n < 2; ++n)
#pragma unroll
                            for (int j = 0; j < 4; ++j) { const int cv = (pn - 4) * 256 + bj * 128 + wc * 32 + 8 * fq + 4 * n + j;
                                Vt[((size_t)(b * BW + cv)) * SEQ + s] = (bf16)f2bf(acc[ai][bj][m][n][j]); } }
        } else if (pn >= 14) {
            const int col0 = (pn - 14) * 256 + wc * 32 + 8 * fq;
            af4 bv[2][2];
#pragma unroll
            for (int bj = 0; bj < 2; ++bj)
#pragma unroll
                for (int n = 0; n < 2; ++n) bv[bj][n] = *(const af4*)(gate_bias + col0 + bj * 128 + 4 * n);
#pragma unroll
            for (int ai = 0; ai < 2; ++ai)
#pragma unroll
                for (int m = 0; m < 4; ++m) { bf16* rowp = GA + (size_t)(row0 + ai * 128 + m * 16) * 2048 + col0;
#pragma unroll
                    for (int bj = 0; bj < 2; ++bj) { af4 v0 = acc[ai][bj][m][0] + bv[bj][0], v1 = acc[ai][bj][m][1] + bv[bj][1];
#pragma unroll
                        for (int j = 0; j < 4; ++j) { v0[j] = fsigmoid(v0[j]); v1[j] = fsigmoid(v1[j]); }
                        st8(rowp + bj * 128, v0, v1); } }
        } else {
            bf16* base; int ld, ct; float sc = 1.0f;
            if (pn < 2) { base = Q; ld = BW; ct = pn; sc = 0.125f; } else if (pn < 4) { base = K; ld = BW; ct = pn - 2; } else if (pn < 12) { base = RW; ld = 1536; ct = pn - 6; } else { base = LO; ld = BW; ct = pn - 12; }
            const int col0 = ct * 256 + wc * 32 + 8 * fq;
#pragma unroll
            for (int ai = 0; ai < 2; ++ai)
#pragma unroll
                for (int m = 0; m < 4; ++m) { bf16* rowp = base + (size_t)(row0 + ai * 128 + m * 16) * ld + col0;
#pragma unroll
                    for (int bj = 0; bj < 2; ++bj) st8(rowp + bj * 128, acc[ai][bj][m][0] * sc, acc[ai][bj][m][1] * sc); }
        }
    }
};

template <bool ADD> struct EpiMerge {
    static constexpr bool PERM = true, AFTER_DRAIN = false;
    bf16* GA; bf16* MRG; int gofs;
    DI void operator()(const af4 (&acc)[2][2][4][2], const pg8::Unit& u, int wr, int wc, int fr, int fq) const {
        const int row0 = u.pm * 256 + wr * 64 + fr, col0 = u.pn * 256 + wc * 32 + 8 * fq;
#pragma unroll
        for (int ai = 0; ai < 2; ++ai)
#pragma unroll
            for (int m = 0; m < 4; ++m) { const size_t row = (size_t)(row0 + ai * 128 + m * 16);
#pragma unroll
                for (int bj = 0; bj < 2; ++bj) { const int c = col0 + bj * 128;
                    float g[8]; unpack8(*(const u32x4*)(GA + row * 2048 + gofs + c), g);
                    af4 v0, v1;
#pragma unroll
                    for (int j = 0; j < 4; ++j) { v0[j] = g[j] * acc[ai][bj][m][0][j]; v1[j] = g[4 + j] * acc[ai][bj][m][1][j]; }
                    if (ADD) { float o[8]; unpack8(*(const u32x4*)(GA + row * 2048 + c), o);
#pragma unroll
                        for (int j = 0; j < 4; ++j) { v0[j] += o[j]; v1[j] += o[4 + j]; }
                        st8(MRG + row * D + c, v0, v1); }
                    else st8(GA + row * 2048 + c, v0, v1); } }
    }
};

struct EpiPlain {
    static constexpr bool PERM = true, AFTER_DRAIN = false;
    bf16* O; int ld, cmask;
    DI void operator()(const af4 (&acc)[2][2][4][2], const pg8::Unit& u, int wr, int wc, int fr, int fq) const {
        const int row0 = u.pm * 256 + wr * 64 + fr, col0 = (u.pn & cmask) * 256 + wc * 32 + 8 * fq;
#pragma unroll
        for (int ai = 0; ai < 2; ++ai)
#pragma unroll
            for (int m = 0; m < 4; ++m) { bf16* rowp = O + (size_t)(row0 + ai * 128 + m * 16) * ld + col0;
#pragma unroll
                for (int bj = 0; bj < 2; ++bj) st8(rowp + bj * 128, acc[ai][bj][m][0], acc[ai][bj][m][1]); }
    }
};

struct EpiUp {
    static constexpr bool PERM = true, AFTER_DRAIN = false;
    bf16* HID;
    DI void operator()(const af4 (&acc)[2][2][4][2], const pg8::Unit& u, int wr, int wc, int fr, int fq) const {
        const int row0 = u.pm * 256 + wr * 64 + fr, col0 = (u.pn & 3) * 128 + wc * 16 + 4 * fq;
#pragma unroll
        for (int ai = 0; ai < 2; ++ai)
#pragma unroll
            for (int m = 0; m < 4; ++m) { bf16* rowp = HID + (size_t)(row0 + ai * 128 + m * 16) * DE + col0;
#pragma unroll
                for (int bj = 0; bj < 2; ++bj) { float h[4];
#pragma unroll
                    for (int j = 0; j < 4; ++j) { const float u1 = acc[ai][bj][m][0][j]; h[j] = u1 * fsigmoid(u1) * acc[ai][bj][m][1][j]; }
                    __hip_atomic_store((GAS unsigned long long*)(rowp + bj * 64), (unsigned long long)pk2(h[0], h[1]) | ((unsigned long long)pk2(h[2], h[3]) << 32), __ATOMIC_RELAXED, __HIP_MEMORY_SCOPE_AGENT); } }
    }
};

constexpr unsigned MOE_CNT_WORD = 3584, MOE_CNT_STRIDE = 16;
struct MoeUpOrder {
    int nunits, G, vc; const int* tile_e; unsigned* cnt;
    DI bool next(int i, pg8::Unit& u) const { const long L = (long)i * G + vc; if (L >= nunits) return false; const int rt = (int)(L >> 2);
        u.pm = rt; u.pn = __builtin_amdgcn_readfirstlane(tile_e[rt]) * 4 + (int)(L & 3); return true; }
    DI void a_ready(const pg8::Unit&) const {}
    DI void done(const pg8::Unit& u) const { asm volatile("s_waitcnt vmcnt(0)" ::: "memory");
        if (__builtin_amdgcn_mbcnt_hi(~0u, __builtin_amdgcn_mbcnt_lo(~0u, 0u)) == 0u) __hip_atomic_fetch_add(cnt + MOE_CNT_STRIDE * u.pm, 1u, __ATOMIC_RELAXED, __HIP_MEMORY_SCOPE_AGENT); }
};
struct MoeDnOrder {
    int nunits, G, vc, q, rem, wave; const int* tile_e; unsigned* cnt;
    DI bool next(int i, pg8::Unit& u) const { long L;
        if (vc >= rem) { if (i > q) return false; L = (long)i * (G - rem) + (vc - rem); } else L = (long)(q + 1) * (G - rem) + (long)i * rem + vc;
        if (L >= nunits) return false; const int rt = (int)(L >> 2);
        u.pm = rt; u.pn = __builtin_amdgcn_readfirstlane(tile_e[rt]) * 4 + (int)(L & 3); return true; }
    DI void a_ready(const pg8::Unit& u) const {
        if (wave == 0) { unsigned sp = 0;
            while ((unsigned)__builtin_amdgcn_readfirstlane(__hip_atomic_load(cnt + MOE_CNT_STRIDE * u.pm, __ATOMIC_RELAXED, __HIP_MEMORY_SCOPE_AGENT)) < 32u) { __builtin_amdgcn_s_sleep(2); if (++sp > (1u << 22)) break; }
            __builtin_amdgcn_fence(__ATOMIC_ACQUIRE, "agent");
            asm volatile("s_waitcnt vmcnt(0)" ::: "memory"); }
        asm volatile("" ::: "memory"); __builtin_amdgcn_s_barrier(); asm volatile("" ::: "memory"); }
    DI void done(const pg8::Unit&) const {}
};

struct Args {
    const float *x, *c, *w_mod, *b_mod, *gains, *w_in, *gate_bias, *shift_mu, *w0, *w_decay_up, *a0, *w_iclr_up, *w_gate_up, *k_k, *k_a, *r_k, *lnx_w, *lnx_b,
                *w_o_sb, *w_o_rw, *w_out, *w_group, *w_router, *w_up1, *w_up3, *w_down;
    float* out; unsigned char* ws;
};
struct Frame { LAS unsigned char* lds; int tid, lane, wave, wg, G, gw, NGW; };
#define CAS __attribute__((address_space(4)))
typedef const CAS Args& ARef;

DI void tr_item(const float* W, int ldw, int K, bf16* WT, int k0, int drow0, int scol0, LAS float* scr, int lane) {
    if (scol0 >= 0) {
        float v[32];
        const float* wp = W + (size_t)(k0 + (lane >> 5)) * ldw + scol0 + (lane & 31);
#pragma unroll
        for (int i = 0; i < 32; ++i) v[i] = wp[(size_t)(2 * i) * ldw];
#pragma unroll
        for (int i = 0; i < 32; ++i) scr[(2 * i + (lane >> 5)) * 33 + (lane & 31)] = v[i];
    } else {
#pragma unroll 8
        for (int i = 0; i < 32; ++i) { const int kk = 2 * i + (lane >> 5); scr[kk * 33 + (lane & 31)] = 0.0f; }
    }
    wave_lds_fence();
    const int c = lane & 7;
#pragma unroll
    for (int j = 0; j < 4; ++j) { const int n = (lane >> 3) + 8 * j; const LAS float* s = scr + (8 * c) * 33 + n;
        u32x4 o; o.x = pk2(s[0 * 33], s[1 * 33]); o.y = pk2(s[2 * 33], s[3 * 33]); o.z = pk2(s[4 * 33], s[5 * 33]); o.w = pk2(s[6 * 33], s[7 * 33]);
        *(u32x4*)(WT + (size_t)(drow0 + n) * K + k0 + 8 * c) = o; }
    wave_lds_fence();
}
DI void tr_item_up(const float* W1, const float* W3, bf16* WT, int e, int k0, int drow0, LAS float* scr, int lane) {
    const int l31 = lane & 31, sc = (drow0 >> 3) * 4 + (l31 >> 3) * 4 + (l31 & 3);
    const float* W = ((l31 & 4) ? W3 : W1) + (size_t)e * D * DE;
    { float v[32]; const float* wp = W + (size_t)(k0 + (lane >> 5)) * DE + sc;
#pragma unroll
        for (int i = 0; i < 32; ++i) v[i] = wp[(size_t)(2 * i) * DE];
#pragma unroll
        for (int i = 0; i < 32; ++i) scr[(2 * i + (lane >> 5)) * 33 + l31] = v[i]; }
    wave_lds_fence();
    const int c = lane & 7;
#pragma unroll
    for (int j = 0; j < 4; ++j) { const int n = (lane >> 3) + 8 * j; const LAS float* s = scr + (8 * c) * 33 + n;
        u32x4 o; o.x = pk2(s[0 * 33], s[1 * 33]); o.y = pk2(s[2 * 33], s[3 * 33]); o.z = pk2(s[4 * 33], s[5 * 33]); o.w = pk2(s[6 * 33], s[7 * 33]);
        *(u32x4*)(WT + ((size_t)e * 1024 + drow0 + n) * D + k0 + 8 * c) = o; }
    wave_lds_fence();
}

DI void p0_prologue(const Frame& F0, ARef A) {
    Frame F = F0; F.tid = opq_tid(F0.wave); F.lane = F.tid & 63; F.wave = __builtin_amdgcn_readfirstlane(F.tid >> 6); F.gw = F.wg * NWAVES + F.wave;
    unsigned char* ws = A.ws;
    LAS float* sl = (LAS float*)F.lds;
    LAS float* part = (LAS float*)(F.lds + 16384);
    for (int i = F.tid; i < NB * D; i += NTHR) { const float v = A.c[i]; sl[i] = v * fsigmoid(v); }
    __syncthreads();
    float* mod = (float*)(ws + WS_MOD);
    for (int cg = F.wg; cg < 256; cg += F.G) {
        const int col = F.tid & 31, kg = F.tid >> 5;
        if (col < 24) { float a0 = 0.f, a1 = 0.f, a2 = 0.f, a3 = 0.f;
#pragma unroll 8
            for (int kk = 0; kk < 64; ++kk) { const int k = kg * 64 + kk; const float w = A.w_mod[(size_t)k * 6144 + cg * 24 + col];
                a0 += sl[k] * w; a1 += sl[D + k] * w; a2 += sl[2 * D + k] * w; a3 += sl[3 * D + k] * w; }
            LAS float* p = part + (kg * 24 + col) * 4; p[0] = a0; p[1] = a1; p[2] = a2; p[3] = a3; }
        __syncthreads();
        if (F.tid < 96) { const int c = F.tid >> 2, b = F.tid & 3; float s = 0.f;
#pragma unroll
            for (int kg2 = 0; kg2 < 16; ++kg2) s += part[(kg2 * 24 + c) * 4 + b];
            mod[b * 6144 + cg * 24 + c] = s + A.b_mod[cg * 24 + c]; }
        __syncthreads();
    }
    LAS float* scr = (LAS float*)(F.lds + 32768 + F.wave * 8704);
    constexpr int I_IN = (NPAD / 32) * (D / 64), I_OS = (D / 32) * (BW / 64), I_OUT = (D / 32) * (D / 64);
    for (int it = F.gw; it < I_IN + 2 * I_OS + I_OUT; it += F.NGW) {
        int r = it;
        if (r < I_IN) { const int g = r / (D / 64), kb = r % (D / 64), drow0 = 32 * g;
            const int sc = drow0 < 3360 ? drow0 : (drow0 < 3584 ? -1 : drow0 - 224);
            tr_item(A.w_in, IN_COLS, D, (bf16*)(ws + WS_WIN), 64 * kb, drow0, sc, scr, F.lane); continue; }
        r -= I_IN;
        if (r < I_OS) { const int g = r / (BW / 64), kb = r % (BW / 64); tr_item(A.w_o_sb, D, BW, (bf16*)(ws + WS_WOSB), 64 * kb, 32 * g, 32 * g, scr, F.lane); continue; }
        r -= I_OS;
        if (r < I_OS) { const int g = r / (BW / 64), kb = r % (BW / 64); tr_item(A.w_o_rw, D, BW, (bf16*)(ws + WS_WORW), 64 * kb, 32 * g, 32 * g, scr, F.lane); continue; }
        r -= I_OS;
        { const int g = r / (D / 64), kb = r % (D / 64); tr_item(A.w_out, D, D, (bf16*)(ws + WS_WOUT), 64 * kb, 32 * g, 32 * g, scr, F.lane); }
    }
    const int gt = F.wg * NTHR + F.tid, NGT = F.G * NTHR;
    float* rtw = (float*)(ws + WS_RTW);
    for (int i = gt; i < 36 * D; i += NGT) { const int o = i >> 10, k = i & (D - 1); rtw[i] = o < 4 ? A.w_group[k * 4 + o] : A.w_router[k * NE + (o - 4)]; }
    bf16* wl = (bf16*)(ws + WS_WL);
    for (int i = gt; i < 1536 * LK; i += NGT) { const int n = i / LK, k = i % LK; float v = 0.f;
        if (n < 512) { if (k < 64) v = A.w_decay_up[k * BW + n]; }
        else if (n < 1024) { if (k >= 64 && k < 128) v = A.w_iclr_up[(k - 64) * BW + (n - 512)]; }
        else { if (k >= 128 && k < 288) v = A.w_gate_up[(k - 128) * BW + (n - 1024)]; }
        wl[i] = (bf16)f2bf(v); }
}

DI void p1_h1(const Frame& F0, ARef A, bf16* H1) {
    Frame F = F0; F.tid = opq_tid(F0.wave); F.lane = F.tid & 63; F.wave = __builtin_amdgcn_readfirstlane(F.tid >> 6); F.gw = F.wg * NWAVES + F.wave;
    const float* mod = (const float*)(A.ws + WS_MOD);
    for (int n = F.gw; n < NTOK; n += F.NGW) {
        const int b = n >> 13;
        const f32x4* xr = (const f32x4*)(A.x + (size_t)n * D) + F.lane;
        f32x4 v[4]; float s = 0.f;
#pragma unroll
        for (int j = 0; j < 4; ++j) { v[j] = xr[64 * j]; s += (v[j][0] * v[j][0] + v[j][1] * v[j][1]) + (v[j][2] * v[j][2] + v[j][3] * v[j][3]); }
        const float inv = rsqrtf(wave_sum(s) * (1.0f / D) + NORM_EPS);
        u32x2* o = (u32x2*)(H1 + (size_t)n * D) + F.lane;
#pragma unroll
        for (int j = 0; j < 4; ++j) { const int k = 4 * F.lane + 256 * j;
            const f32x4 g = *(const f32x4*)(A.gains + k), sh = *(const f32x4*)(mod + b * 6144 + k), sc = *(const f32x4*)(mod + b * 6144 + D + k);
            f32x4 h;
#pragma unroll
            for (int q = 0; q < 4; ++q) h[q] = (v[j][q] * inv) * g[q] * (1.0f + sc[q]) + sh[q];
            u32x2 w; w.x = pk2(h[0], h[1]); w.y = pk2(h[2], h[3]); o[64 * j] = w; }
    }
}

DI void p3_attn(const Frame& F0, const bf16* QB, const bf16* KB, const bf16* VT, bf16* YSB) {
    Frame F = F0; F.tid = opq_tid(F0.wave); F.lane = F.tid & 63; F.wave = __builtin_amdgcn_readfirstlane(F.tid >> 6); F.gw = F.wg * NWAVES + F.wave;
    const int lane = F.lane, r = lane & 31, hh = lane >> 5;
    bf16x8 tri[2];
#pragma unroll
    for (int s = 0; s < 2; ++s)
#pragma unroll
        for (int e = 0; e < 8; ++e) tri[s][e] = (16 * s + 8 * (e >> 2) + 4 * hh + (e & 3)) > r ? (short)0x3F80 : (short)0;
    for (int u = F.gw; u < NB * NH * (SEQ / 32); u += F.NGW) {
        const int bh = u >> 8, qt = u & 255, b = bh >> 3, h = bh & 7;
        const bf16* qp = QB + (size_t)(b * SEQ + qt * 32 + r) * BW + h * HD + 8 * hh;
        bf16x8 qf[4];
#pragma unroll
        for (int ks = 0; ks < 4; ++ks) qf[ks] = *(const bf16x8*)(qp + 16 * ks);
        f32x16 o0, o1;
#pragma unroll
        for (int i = 0; i < 16; ++i) { o0[i] = 0.f; o1[i] = 0.f; }
        float L = 0.f;
        bf16x8 kf[4]; s16x4 vlo[2][2], vhi[2][2];
#define ATT_LOAD(KT, KF, VLO, VHI) do { const bf16* kp_ = KB + (size_t)(b * SEQ + (KT) * 32 + r) * BW + h * HD + 8 * hh; \
            _Pragma("unroll") for (int ks = 0; ks < 4; ++ks) KF[ks] = *(const bf16x8*)(kp_ + 16 * ks); \
            const bf16* vp_ = VT + ((size_t)(bh * HD + r)) * SEQ + (KT) * 32 + 4 * hh; \
            _Pragma("unroll") for (int mb = 0; mb < 2; ++mb) _Pragma("unroll") for (int ks = 0; ks < 2; ++ks) { VLO[mb][ks] = *(const s16x4*)(vp_ + (size_t)mb * 32 * SEQ + 16 * ks); VHI[mb][ks] = *(const s16x4*)(vp_ + (size_t)mb * 32 * SEQ + 16 * ks + 8); } } while (0)
        ATT_LOAD(qt, kf, vlo, vhi);
        for (int kt = qt; kt >= 0; --kt) {
            bf16x8 kfn[4]; s16x4 vlon[2][2], vhin[2][2];
            { const int ktn = kt > 0 ? kt - 1 : 0; ATT_LOAD(ktn, kfn, vlon, vhin); }
            f32x16 z;
#pragma unroll
            for (int i = 0; i < 16; ++i) z[i] = 0.f;
#pragma unroll
            for (int ks = 0; ks < 4; ++ks) z = MFMA32(kf[ks], qf[ks], z);
            const bool diag = (kt == qt);
            float lk[16], lo[16], tot = 0.f;
#pragma unroll
            for (int i = 0; i < 16; ++i) { const bool valid = !diag || (crow(i, hh) < r);
                const float sp = fsoftplus(z[i]); lk[i] = valid ? -sp : 0.0f; z[i] = valid ? z[i] - sp : -1.0e30f;
                tot += lk[i];
                const float hi = bflo(f2bf(lk[i])); lo[i] = lk[i] - hi; lk[i] = hi; }
            tot += shfl_xor_l(tot, 32, lane);
            f32x16 lat;
#pragma unroll
            for (int i = 0; i < 16; ++i) lat[i] = L;
#pragma unroll
            for (int s = 0; s < 2; ++s) {
                lat = MFMA32(tri[s], pack8v(lk[8 * s], lk[8 * s + 1], lk[8 * s + 2], lk[8 * s + 3], lk[8 * s + 4], lk[8 * s + 5], lk[8 * s + 6], lk[8 * s + 7]), lat);
                lat = MFMA32(tri[s], pack8v(lo[8 * s], lo[8 * s + 1], lo[8 * s + 2], lo[8 * s + 3], lo[8 * s + 4], lo[8 * s + 5], lo[8 * s + 6], lo[8 * s + 7]), lat); }
            float at[16];
#pragma unroll
            for (int i = 0; i < 16; ++i) at[i] = fexp(z[i] + lat[i]);
#pragma unroll
            for (int s = 0; s < 2; ++s) { const bf16x8 ab = pack8v(at[8 * s], at[8 * s + 1], at[8 * s + 2], at[8 * s + 3], at[8 * s + 4], at[8 * s + 5], at[8 * s + 6], at[8 * s + 7]);
                bf16x8 va, vb;
#pragma unroll
                for (int e = 0; e < 4; ++e) { va[e] = vlo[0][s][e]; va[4 + e] = vhi[0][s][e]; vb[e] = vlo[1][s][e]; vb[4 + e] = vhi[1][s][e]; }
                o0 = MFMA32(va, ab, o0); o1 = MFMA32(vb, ab, o1); }
            L += tot;
            if (__all(L < SB_STOP)) break;
#pragma unroll
            for (int ks = 0; ks < 4; ++ks) kf[ks] = kfn[ks];
#pragma unroll
            for (int mb = 0; mb < 2; ++mb)
#pragma unroll
                for (int ks = 0; ks < 2; ++ks) { vlo[mb][ks] = vlon[mb][ks]; vhi[mb][ks] = vhin[mb][ks]; }
        }
#undef ATT_LOAD
        bf16* op = YSB + (size_t)(b * SEQ + qt * 32 + r) * BW + h * HD + 4 * hh;
#pragma unroll
        for (int g = 0; g < 4; ++g) { u32x2 w0, w1; w0.x = pk2(o0[4 * g], o0[4 * g + 1]); w0.y = pk2(o0[4 * g + 2], o0[4 * g + 3]); w1.x = pk2(o1[4 * g], o1[4 * g + 1]); w1.y = pk2(o1[4 * g + 2], o1[4 * g + 3]);
            *(u32x2*)(op + 8 * g) = w0; *(u32x2*)(op + 32 + 8 * g) = w1; }
    }
}

DI void p3_prep(const Frame& F0, ARef A, const bf16* RWRAW, const bf16* LORA, bf16* R, bf16* KS, bf16* V, bf16* KK, bf16* ALORA) {
    Frame F = F0; F.tid = opq_tid(F0.wave); F.lane = F.tid & 63; F.wave = __builtin_amdgcn_readfirstlane(F.tid >> 6); F.gw = F.wg * NWAVES + F.wave;
    const int lane = F.lane;
    f32x4 mu[3][2], kkc[2], mul[2];
#pragma unroll
    for (int part = 0; part < 3; ++part) { mu[part][0] = *(const f32x4*)(A.shift_mu + part * 512 + lane * 8); mu[part][1] = *(const f32x4*)(A.shift_mu + part * 512 + lane * 8 + 4); }
    kkc[0] = *(const f32x4*)(A.k_k + lane * 8); kkc[1] = *(const f32x4*)(A.k_k + lane * 8 + 4);
    const int lcol = lane < 36 ? lane * 8 : 0;
    mul[0] = *(const f32x4*)(A.shift_mu + 1536 + lcol); mul[1] = *(const f32x4*)(A.shift_mu + 1536 + lcol + 4);
    constexpr int RUN = 16;
    for (int run = F.gw; run < NTOK / RUN; run += F.NGW) {
        const int n0 = run * RUN;
        u32x4 prv[3], prl, cur[3], cul;
        const u32x4 z4 = {0u, 0u, 0u, 0u};
        if ((n0 & (SEQ - 1)) == 0) { prv[0] = z4; prv[1] = z4; prv[2] = z4; prl = z4; }
        else {
#pragma unroll
            for (int part = 0; part < 3; ++part) prv[part] = *(const u32x4*)(RWRAW + (size_t)(n0 - 1) * 1536 + part * 512 + lane * 8);
            prl = *(const u32x4*)(LORA + (size_t)(n0 - 1) * BW + lcol); }
#pragma unroll
        for (int part = 0; part < 3; ++part) cur[part] = *(const u32x4*)(RWRAW + (size_t)n0 * 1536 + part * 512 + lane * 8);
        cul = *(const u32x4*)(LORA + (size_t)n0 * BW + lcol);
        for (int i = 0; i < RUN; ++i) {
            const int n = n0 + i, nn = i + 1 < RUN ? n + 1 : n;
            u32x4 nxt[3], nxl;
#pragma unroll
            for (int part = 0; part < 3; ++part) nxt[part] = *(const u32x4*)(RWRAW + (size_t)nn * 1536 + part * 512 + lane * 8);
            nxl = *(const u32x4*)(LORA + (size_t)nn * BW + lcol);
            float xs[3][8];
#pragma unroll
            for (int part = 0; part < 3; ++part) { float p[8], q[8]; unpack8(cur[part], p); unpack8(prv[part], q);
#pragma unroll
                for (int j = 0; j < 4; ++j) { xs[part][j] = p[j] + mu[part][0][j] * (q[j] - p[j]); xs[part][4 + j] = p[4 + j] + mu[part][1][j] * (q[4 + j] - p[4 + j]); } }
            const size_t off = (size_t)n * BW + lane * 8;
            *(u32x4*)(R + off) = pack8(xs[0]); *(u32x4*)(KS + off) = pack8(xs[1]); *(u32x4*)(V + off) = pack8(xs[2]);
            float kk[8], ss = 0.f;
#pragma unroll
            for (int j = 0; j < 4; ++j) { kk[j] = xs[1][j] * kkc[0][j]; kk[4 + j] = xs[1][4 + j] * kkc[1][j]; }
#pragma unroll
            for (int j = 0; j < 8; ++j) ss += kk[j] * kk[j];
            ss += shfl_xor_l(ss, 1, lane); ss += shfl_xor_l(ss, 2, lane); ss += shfl_xor_l(ss, 4, lane);
            const float rn = 1.0f / fmaxf(sqrtf(ss), L2_EPS);
#pragma unroll
            for (int j = 0; j < 8; ++j) kk[j] *= rn;
            *(u32x4*)(KK + off) = pack8(kk);
            if (lane < 48) { float a[8];
                if (lane < 36) { float p[8], q[8]; unpack8(cul, p); unpack8(prl, q);
#pragma unroll
                    for (int j = 0; j < 8; ++j) { const float m = j < 4 ? mul[0][j & 3] : mul[1][j & 3]; const float v = p[j] + m * (q[j] - p[j]);
                        a[j] = lane < 8 ? (1.0f - 2.0f * frcp(fexp(2.0f * v) + 1.0f)) : (lane < 16 ? v : fsigmoid(v)); }
                } else {
#pragma unroll
                    for (int j = 0; j < 8; ++j) a[j] = 0.f; }
                *(u32x4*)(ALORA + (size_t)n * LK + lane * 8) = pack8(a); }
#pragma unroll
            for (int part = 0; part < 3; ++part) { prv[part] = cur[part]; cur[part] = nxt[part]; }
            prl = cul; cul = nxl;
        }
    }
}

DI void p4_lora(const Frame& F0, ARef A, const bf16* ALORA, const bf16* WL, bf16* E, bf16* KS, bf16* Bo, bf16* GG, const bf16* KK, const bf16* R, float* BON) {
    Frame F = F0; F.tid = opq_tid(F0.wave); F.lane = F.tid & 63; F.wave = __builtin_amdgcn_readfirstlane(F.tid >> 6); F.gw = F.wg * NWAVES + F.wave;
    const int lane = F.lane, r = lane & 31, hh = lane >> 5;
    for (int u = F.gw; u < 2 * (NTOK / 32); u += F.NGW) {
        const int n0 = (u >> 1) * 32, par = u & 1;
        bf16x8 tf[18];
#pragma unroll
        for (int ks = 0; ks < 18; ++ks) tf[ks] = *(const bf16x8*)(ALORA + (size_t)(n0 + r) * LK + 16 * ks + 8 * hh);
        const unsigned orow = (unsigned)(n0 + r) * BW + 4 * hh;
#define LORA_BLOCK(KS0, NKS, CB, BODY) { const int c0_ = 32 * ((CB) & 15); f32x16 acc_; \
            _Pragma("unroll") for (int q = 0; q < 16; ++q) acc_[q] = 0.f; \
            _Pragma("unroll") for (int ks = 0; ks < (NKS); ++ks) acc_ = MFMA32(*(const bf16x8*)(WL + (size_t)(32 * (CB) + r) * LK + 16 * ((KS0) + ks) + 8 * hh), tf[(KS0) + ks], acc_); \
            BODY }
        for (int i = 0; i < 8; ++i) { const int cb = 4 * (i >> 1) + 2 * par + (i & 1);
            LORA_BLOCK(0, 4, cb, {
                _Pragma("unroll") for (int g = 0; g < 4; ++g) { const f32x4 w0v = *(const f32x4*)(A.w0 + c0_ + 8 * g + 4 * hh); float e4[4];
                    _Pragma("unroll") for (int j = 0; j < 4; ++j) { const float v = acc_[4 * g + j] + w0v[j]; e4[j] = fexp(-fsoftplus(-v) - 0.5f); }
                    u32x2 w; w.x = pk2(e4[0], e4[1]); w.y = pk2(e4[2], e4[3]); *(u32x2*)(E + orow + c0_ + 8 * g) = w; } }) }
        float bsum = 0.f;
        for (int i = 0; i < 8; ++i) { const int cb = 16 + 4 * (i >> 1) + 2 * par + (i & 1);
            LORA_BLOCK(4, 4, cb, {
                _Pragma("unroll") for (int g = 0; g < 4; ++g) { const f32x4 a0v = *(const f32x4*)(A.a0 + c0_ + 8 * g + 4 * hh); const f32x4 kav = *(const f32x4*)(A.k_a + c0_ + 8 * g + 4 * hh);
                    const unsigned o = orow + c0_ + 8 * g; const u32x2 kw = *(const u32x2*)(KS + o); const u32x2 qw = *(const u32x2*)(KK + o); const u32x2 rw = *(const u32x2*)(R + o); const f32x4 rkv = *(const f32x4*)(A.r_k + c0_ + 8 * g + 4 * hh);
                    float ksv[4]; float kkv[4]; float kp[4]; float bb[4]; ksv[0] = bflo(kw.x); ksv[1] = bfhi(kw.x); ksv[2] = bflo(kw.y); ksv[3] = bfhi(kw.y); kkv[0] = bflo(qw.x); kkv[1] = bfhi(qw.x); kkv[2] = bflo(qw.y); kkv[3] = bfhi(qw.y);
                    _Pragma("unroll") for (int j = 0; j < 4; ++j) { const float s0 = fsigmoid(acc_[4 * g + j] + a0v[j]); kp[j] = ksv[j] * (1.0f + (s0 - 1.0f) * kav[j]); bb[j] = kkv[j] * s0; }
                    bsum += (bflo(rw.x) * kp[0] * rkv[0] + bfhi(rw.x) * kp[1] * rkv[1]) + (bflo(rw.y) * kp[2] * rkv[2] + bfhi(rw.y) * kp[3] * rkv[3]);
                    u32x2 w1; u32x2 w2; w1.x = pk2(kp[0], kp[1]); w1.y = pk2(kp[2], kp[3]); w2.x = pk2(bb[0], bb[1]); w2.y = pk2(bb[2], bb[3]); *(u32x2*)(KS + o) = w1; *(u32x2*)(Bo + o) = w2; } })
            if (i & 1) { const float tot = bsum + shfl_xor_l(bsum, 32, lane); if (hh == 0) BON[(size_t)(n0 + r) * 8 + 2 * (i >> 1) + par] = tot; bsum = 0.f; } }
        for (int i = 0; i < 8; ++i) { const int cb = 32 + 4 * (i >> 1) + 2 * par + (i & 1);
            LORA_BLOCK(8, 10, cb, {
                _Pragma("unroll") for (int g = 0; g < 4; ++g) { u32x2 w; w.x = pk2(acc_[4 * g], acc_[4 * g + 1]); w.y = pk2(acc_[4 * g + 2], acc_[4 * g + 3]); *(u32x2*)(GG + orow + c0_ + 8 * g) = w; } }) }
#undef LORA_BLOCK
    }
}

DI void p6_chain(int task, int wave, LAS unsigned char* ring, const bf16* GT, const bf16* HT, bf16* SC) {
    const int lane = opq_tid(wave) & 63;
    const int bh = task >> 1, nb = task & 1;
    constexpr int RD = 6, SLOT = 12288;
    f32x16 X[2];
#pragma unroll
    for (int q = 0; q < 16; ++q) { X[0][q] = 0.f; X[1][q] = 0.f; }
    const char* gsrc = (const char*)(GT + (size_t)bh * NCH * 4096) + lane * 16;
    const char* hsrc = (const char*)(HT + (size_t)bh * NCH * 4096) + nb * 2048 + lane * 16;
#define CHAIN_DMA(cc) do { LAS unsigned char* sl_ = ring + ((cc) % RD) * SLOT; const char* g_ = gsrc + (size_t)(cc) * 8192; const char* h_ = hsrc + (size_t)(cc) * 8192; \
        _Pragma("unroll") for (int f = 0; f < 8; ++f) __builtin_amdgcn_global_load_lds((const unsigned*)(g_ + f * 1024), (LAS unsigned*)(sl_ + f * 1024), 16, 0, 0); \
        _Pragma("unroll") for (int kb = 0; kb < 2; ++kb) _Pragma("unroll") for (int j = 0; j < 2; ++j) \
            __builtin_amdgcn_global_load_lds((const unsigned*)(h_ + kb * 4096 + j * 1024), (LAS unsigned*)(sl_ + 8192 + (kb * 2 + j) * 1024), 16, 0, 0); } while (0)
#define CHAIN_READ(cc, HS, GS) do { const LAS unsigned char* sl_ = ring + ((cc) % RD) * SLOT; \
        _Pragma("unroll") for (int f = 0; f < 8; ++f) GS[f] = *(const LAS bf16x8*)(sl_ + f * 1024 + lane * 16); \
        _Pragma("unroll") for (int kb = 0; kb < 2; ++kb) _Pragma("unroll") for (int g = 0; g < 4; ++g) { const u32x2 w_ = *(const LAS u32x2*)(sl_ + 8192 + kb * 2048 + (g * 64 + lane) * 8); \
            HS[kb][4 * g] = bflo(w_.x); HS[kb][4 * g + 1] = bfhi(w_.x); HS[kb][4 * g + 2] = bflo(w_.y); HS[kb][4 * g + 3] = bfhi(w_.y); } } while (0)
#define CHAIN_STORE(cc) do { bf16* sc_ = SC + ((size_t)bh * NCH + (cc)) * 4096; \
        _Pragma("unroll") for (int jb = 0; jb < 2; ++jb) _Pragma("unroll") for (int g = 0; g < 4; ++g) { u32x2 w_; w_.x = pk2(X[jb][4 * g], X[jb][4 * g + 1]); w_.y = pk2(X[jb][4 * g + 2], X[jb][4 * g + 3]); \
            *(u32x2*)(sc_ + ((((jb * 2 + nb) * 4 + g) * 64) + lane) * 4) = w_; } } while (0)
#define CHAIN_STEP(HS, GS) do { bf16x8 xb_[2][2]; \
        _Pragma("unroll") for (int jb = 0; jb < 2; ++jb) _Pragma("unroll") for (int s = 0; s < 2; ++s) \
            xb_[jb][s] = pack8v(X[jb][8 * s], X[jb][8 * s + 1], X[jb][8 * s + 2], X[jb][8 * s + 3], X[jb][8 * s + 4], X[jb][8 * s + 5], X[jb][8 * s + 6], X[jb][8 * s + 7]); \
        X[0] = HS[0]; X[1] = HS[1]; \
        _Pragma("unroll") for (int kb = 0; kb < 2; ++kb) _Pragma("unroll") for (int jb = 0; jb < 2; ++jb) _Pragma("unroll") for (int s = 0; s < 2; ++s) X[kb] = MFMA32(GS[kb * 4 + jb * 2 + s], xb_[jb][s], X[kb]); } while (0)
    for (int cc = 0; cc < RD; ++cc) CHAIN_DMA(cc);
    for (int c = 0; c < NCH - 1; ++c) {
        f32x16 Hc[2]; bf16x8 Gc[8];
        if (c + RD <= NCH - 1) asm volatile("s_waitcnt vmcnt(60)" ::: "memory"); else asm volatile("s_waitcnt vmcnt(0)" ::: "memory");
        CHAIN_READ(c, Hc, Gc);
        asm volatile("s_waitcnt lgkmcnt(0)" ::: "memory");
        if (c + RD < NCH - 1) CHAIN_DMA(c + RD);
        CHAIN_STORE(c);
        CHAIN_STEP(Hc, Gc);
    }
    CHAIN_STORE(NCH - 1);
    asm volatile("s_waitcnt vmcnt(0)" ::: "memory");
#undef CHAIN_DMA
#undef CHAIN_READ
#undef CHAIN_STORE
#undef CHAIN_STEP
}

DI void p6_moe_weights(const Frame& F0, ARef A, int wi, int NW) {
    Frame F = F0; F.tid = opq_tid(F0.wave); F.lane = F.tid & 63; F.wave = __builtin_amdgcn_readfirstlane(F.tid >> 6); F.gw = F.wg * NWAVES + F.wave;
    LAS float* scr = (LAS float*)(F.lds + F.wave * 20480);
    constexpr int I_UP = NE * 32 * 16, I_DN = NE * 32 * 8;
    for (int it = wi; it < I_UP + I_DN; it += NW) {
        if (it < I_UP) { const int e = it >> 9, g = (it >> 4) & 31, kb = it & 15; tr_item_up(A.w_up1, A.w_up3, (bf16*)(A.ws + WS_WUP), e, 64 * kb, 32 * g, scr, F.lane); }
        else { const int r = it - I_UP, e = r >> 8, g = (r >> 3) & 31, kb = r & 7;
            tr_item(A.w_down + (size_t)e * DE * D, D, DE, (bf16*)(A.ws + WS_WDN) + (size_t)e * 1024 * DE, 64 * kb, 32 * g, 32 * g, scr, F.lane); }
    }
}

DI float half_bcast_sum(float v, int hh) {
    v += DPP_SHR(v, 0x111); v += DPP_SHR(v, 0x112); v += DPP_SHR(v, 0x114); v += DPP_SHR(v, 0x118);
    v += __builtin_bit_cast(float, __builtin_amdgcn_update_dpp(0, __builtin_bit_cast(int, v), 0x142, 0xa, 0xf, false));
    const float lo = __builtin_bit_cast(float, __builtin_amdgcn_readlane(__builtin_bit_cast(int, v), 31)), hi = __builtin_bit_cast(float, __builtin_amdgcn_readlane(__builtin_bit_cast(int, v), 63));
    return hh ? hi : lo; }
DI void p7_mfma(const Frame& F0, ARef A, const bf16* SC, const bf16* Pn, const bf16* QOn, const bf16* V, const bf16* GG, const float* BON, bf16* YRW) {
    Frame F = F0; F.tid = opq_tid(F0.wave); F.lane = F.tid & 63; F.wave = __builtin_amdgcn_readfirstlane(F.tid >> 6); F.gw = F.wg * NWAVES + F.wave;
    const int lane = F.lane, r = lane & 31, hh = lane >> 5;
    for (int cid = F.gw; cid < NCHUNK; cid += F.NGW) {
        const int bh = cid >> NCH_LOG, c = cid & (NCH - 1), b = bh >> 3, h = bh & 7;
        const unsigned n0 = (unsigned)b * SEQ + (unsigned)c * CH; const int col0 = h * HD;
        const bf16* sc = SC + (size_t)cid * 4096; const bf16* pn = Pn + (size_t)cid * 4096; const bf16* qn = QOn + (size_t)cid * 4096;
        bf16x8 Sf[2][2][2], Pf[2][2][2];
#pragma unroll
        for (int jb = 0; jb < 2; ++jb)
#pragma unroll
            for (int xb = 0; xb < 2; ++xb)
#pragma unroll
                for (int s = 0; s < 2; ++s) { const s16x4 lo = *(const s16x4*)(sc + ((((jb * 2 + xb) * 4 + 2 * s) * 64) + lane) * 4), hi = *(const s16x4*)(sc + ((((jb * 2 + xb) * 4 + 2 * s + 1) * 64) + lane) * 4);
#pragma unroll
                    for (int e = 0; e < 4; ++e) { Sf[jb][xb][s][e] = lo[e]; Sf[jb][xb][s][4 + e] = hi[e]; }
                    Pf[jb][xb][s] = *(const bf16x8*)(pn + ((((jb * 2 + xb) * 2 + s) * 64) + lane) * 8); }
        f32x16 Z[2][2];
#pragma unroll
        for (int tb = 0; tb < 2; ++tb)
#pragma unroll
            for (int nb = 0; nb < 2; ++nb) {
#pragma unroll
                for (int g = 0; g < 4; ++g) { const u32x2 w = *(const u32x2*)(qn + ((((tb * 2 + nb) * 4 + g) * 64) + lane) * 4);
                    Z[tb][nb][4 * g] = bflo(w.x); Z[tb][nb][4 * g + 1] = bfhi(w.x); Z[tb][nb][4 * g + 2] = bflo(w.y); Z[tb][nb][4 * g + 3] = bfhi(w.y); }
#pragma unroll
                for (int jb = 0; jb < 2; ++jb)
#pragma unroll
                    for (int s = 0; s < 2; ++s) Z[tb][nb] = MFMA32(Pf[jb][tb][s], Sf[jb][nb][s], Z[tb][nb]); }
        float lw[2], lb[2];
#pragma unroll
        for (int nb = 0; nb < 2; ++nb) { lw[nb] = A.lnx_w[col0 + 32 * nb + r]; lb[nb] = A.lnx_b[col0 + 32 * nb + r]; }
#pragma unroll
        for (int tb = 0; tb < 2; ++tb)
#pragma unroll
            for (int q = 0; q < 16; ++q) {
                const unsigned tokrow = n0 + 32 * tb + 4 * hh + (q & 3) + 8 * (q >> 2);
                const float mean = half_bcast_sum(Z[tb][0][q] + Z[tb][1][q], hh) * (1.0f / 64.0f);
                const float d0 = Z[tb][0][q] - mean, d1 = Z[tb][1][q] - mean;
                const float rs = rsqrtf(half_bcast_sum(d0 * d0 + d1 * d1, hh) * (1.0f / 64.0f) + GN_EPS);
                const float bon = BON[(size_t)tokrow * 8 + h];
                const unsigned o0 = tokrow * BW + col0 + r;
                YRW[o0] = (bf16)f2bf((d0 * rs * lw[0] + lb[0] + bon * bf2f(V[o0])) * bf2f(GG[o0]));
                YRW[o0 + 32] = (bf16)f2bf((d1 * rs * lw[1] + lb[1] + bon * bf2f(V[o0 + 32])) * bf2f(GG[o0 + 32]));
                if ((q & 3) == 3) __builtin_amdgcn_sched_barrier(0); }
    }
}

DI void p10_rows(const Frame& F0, ARef A, const bf16* Y1, bf16* H2) {
    Frame F = F0; F.tid = opq_tid(F0.wave); F.lane = F.tid & 63; F.wave = __builtin_amdgcn_readfirstlane(F.tid >> 6); F.gw = F.wg * NWAVES + F.wave;
    const int lane = F.lane;
    const float* mod = (const float*)(A.ws + WS_MOD);
    LAS float* rw = (LAS float*)F.lds;
    LAS int* hist = (LAS int*)(F.lds + 147456);
    { const float* src = (const float*)(A.ws + WS_RTW);
        for (int i = F.tid; i < 18 * D; i += NTHR) { const int op = i >> 10, k = i & (D - 1); typedef float f2_t __attribute__((ext_vector_type(2))); f2_t w; w.x = src[(2 * op) * D + k]; w.y = src[(2 * op + 1) * D + k]; *(LAS f2_t*)(rw + 2 * i) = w; } }
    i32x4* tok = (i32x4*)(A.ws + WS_TOK); int* cnt = (int*)(A.ws + WS_CNT);
    for (int tb = F.wg; tb < NTOK / 128; tb += F.G) {
        if (F.tid < 32) hist[F.tid] = 0;
        __syncthreads();
        for (int tl = F.wave; tl < 128; tl += NWAVES) {
            const int n = tb * 128 + tl, b = n >> 13;
            const f32x4* xr = (const f32x4*)(A.x + (size_t)n * D) + lane; const u32x2* yr = (const u32x2*)(Y1 + (size_t)n * D) + lane;
            f32x4 xv[4], yv[4]; float s = 0.f;
#pragma unroll
            for (int j = 0; j < 4; ++j) { xv[j] = xr[64 * j]; const u32x2 w = yr[64 * j]; yv[j][0] = bflo(w.x); yv[j][1] = bfhi(w.x); yv[j][2] = bflo(w.y); yv[j][3] = bfhi(w.y);
                s += (yv[j][0] * yv[j][0] + yv[j][1] * yv[j][1]) + (yv[j][2] * yv[j][2] + yv[j][3] * yv[j][3]); }
            const float inv1 = rsqrtf(wave_sum(s) * (1.0f / D) + NORM_EPS);
            float s2 = 0.f;
#pragma unroll
            for (int j = 0; j < 4; ++j) { const int k = 4 * lane + 256 * j;
                const f32x4 g1 = *(const f32x4*)(A.gains + D + k), gt = *(const f32x4*)(mod + b * 6144 + 2 * D + k);
#pragma unroll
                for (int q = 0; q < 4; ++q) { xv[j][q] = xv[j][q] + gt[q] * ((yv[j][q] * inv1) * g1[q]); s2 += xv[j][q] * xv[j][q]; }
                u32x2 xw; xw.x = pk2(xv[j][0], xv[j][1]); xw.y = pk2(xv[j][2], xv[j][3]); *((u32x2*)(A.ws + WS_X1 + (size_t)n * D * 2) + lane + 64 * j) = xw; }
            const float inv2 = rsqrtf(wave_sum(s2) * (1.0f / D) + NORM_EPS);
            f32x4 hv[4];
#pragma unroll
            for (int j = 0; j < 4; ++j) { const int k = 4 * lane + 256 * j;
                const f32x4 g2 = *(const f32x4*)(A.gains + 2 * D + k), sh = *(const f32x4*)(mod + b * 6144 + 3 * D + k), sc = *(const f32x4*)(mod + b * 6144 + 4 * D + k);
#pragma unroll
                for (int q = 0; q < 4; ++q) hv[j][q] = (xv[j][q] * inv2) * g2[q] * (1.0f + sc[q]) + sh[q];
                u32x2 w; w.x = pk2(hv[j][0], hv[j][1]); w.y = pk2(hv[j][2], hv[j][3]); *((u32x2*)(H2 + (size_t)n * D) + lane + 64 * j) = w; }
            typedef float f2_t __attribute__((ext_vector_type(2)));
#define P10_PAIR(OUT0, OUT1, WBASE) do { f2_t a = {0.f, 0.f}; \
                _Pragma("unroll") for (int j = 0; j < 4; ++j) { const LAS f32x4* wp = (const LAS f32x4*)((WBASE) + (4 * lane + 256 * j) * 2); const f32x4 wA = wp[0], wB = wp[1]; \
                    a += (f2_t){hv[j][0], hv[j][0]} * (f2_t){wA[0], wA[1]}; a += (f2_t){hv[j][1], hv[j][1]} * (f2_t){wA[2], wA[3]}; \
                    a += (f2_t){hv[j][2], hv[j][2]} * (f2_t){wB[0], wB[1]}; a += (f2_t){hv[j][3], hv[j][3]} * (f2_t){wB[2], wB[3]}; } \
                OUT0 = wave_sum(a.x); OUT1 = wave_sum(a.y); } while (0)
            float lg[4];
            P10_PAIR(lg[0], lg[1], rw); P10_PAIR(lg[2], lg[3], rw + 2 * D);
            int gs = 0; float gm = lg[0];
#pragma unroll
            for (int g = 1; g < 4; ++g) if (lg[g] > gm) { gm = lg[g]; gs = g; }
            gs = __builtin_amdgcn_readfirstlane(gs);
            float gsum = 0.f;
#pragma unroll
            for (int g = 0; g < 4; ++g) gsum += fexp(lg[g] - gm);
            const float gw = 1.0f / gsum;
            float el[8];
            { const LAS float* rwg = rw + (2 + 4 * gs) * (2 * D);
#pragma unroll
              for (int i = 0; i < 4; ++i) P10_PAIR(el[2 * i], el[2 * i + 1], rwg + i * 2 * D); }
#undef P10_PAIR
            int i0 = 0; float m0 = el[0];
#pragma unroll
            for (int e = 1; e < 8; ++e) if (el[e] > m0) { m0 = el[e]; i0 = e; }
            int i1 = -1; float m1 = -3.0e38f;
#pragma unroll
            for (int e = 0; e < 8; ++e) if (e != i0 && el[e] > m1) { m1 = el[e]; i1 = e; }
            const float t = fexp(m1 - m0), p0 = 1.0f / (1.0f + t), p1 = t * p0;
            const int e0 = gs * 8 + i0, e1 = gs * 8 + i1;
#if defined(CHECKS)
            if (lane == 0 && n == DBG_TOKEN) { float* dbg = (float*)(A.ws + WS_CTL + 32768) + 48; dbg[0] = lg[0]; dbg[1] = lg[1]; dbg[2] = lg[2]; dbg[3] = lg[3]; dbg[4] = gsum; dbg[5] = p0; dbg[6] = gw; dbg[7] = t; }
#endif
            if (lane == 0) { i32x4 rec; rec.x = e0 | (e1 << 8); rec.y = 0; rec.z = 0; rec.w = 0; tok[n] = rec;
                float* cwp = (float*)(A.ws + WS_CW) + 2 * n; cwp[0] = gw * p0; cwp[1] = gw * p1;
                atomicAdd((int*)&hist[e0], 1); atomicAdd((int*)&hist[e1], 1); }
        }
        __syncthreads();
        if (F.tid < 32) cnt[tb * 32 + F.tid] = hist[F.tid];
        __syncthreads();
    }
}

DI void p11_rank_gather(const Frame& F0, ARef A, const bf16* H2, bf16* HS) {
    Frame F = F0; F.tid = opq_tid(F0.wave); F.lane = F.tid & 63; F.wave = __builtin_amdgcn_readfirstlane(F.tid >> 6); F.gw = F.wg * NWAVES + F.wave;
    LAS int* base = (LAS int*)F.lds;
    LAS int* seg = base + 32;
    LAS int* el = base + 96;
    LAS int* pos = base + 352;
    i32x4* tok = (i32x4*)(A.ws + WS_TOK); const int* cnt = (const int*)(A.ws + WS_CNT); int* tile = (int*)(A.ws + WS_TILE);
    for (int tb = F.wg; tb < NTOK / 128; tb += F.G) {
        if (F.tid < 32) { int tot = 0, pre = 0;
            for (int t2 = 0; t2 < NTOK / 128; ++t2) { const int v = cnt[t2 * 32 + F.tid]; tot += v; if (t2 < tb) pre += v; }
            base[F.tid] = pre; seg[F.tid] = (tot + 255) & ~255; }
        if (F.tid >= 64 && F.tid < 64 + 128) { const i32x4 rec = tok[tb * 128 + (F.tid - 64)]; el[2 * (F.tid - 64)] = rec.x & 255; el[2 * (F.tid - 64) + 1] = (rec.x >> 8) & 255; }
        __syncthreads();
        if (F.tid == 0) { int acc = 0; for (int e = 0; e < 32; ++e) { const int sz = seg[e]; seg[e] = acc; acc += sz; } seg[32] = acc; }
        __syncthreads();
        if (F.tid < 32) { int p = seg[F.tid] + base[F.tid];
            for (int q = 0; q < 256; ++q) if (el[q] == F.tid) pos[q] = p++; }
        if (tb == 0 && F.tid >= 64 && F.tid < 64 + 32) { const int e = F.tid - 64;
            for (int t2 = seg[e] >> 8; t2 < (seg[e + 1] >> 8); ++t2) tile[t2] = e;
            if (e == 0) tile[MAXT] = seg[32] >> 8; }
        __syncthreads();
        if (F.tid < 128) { i32x4 rec = tok[tb * 128 + F.tid]; rec.x = pos[2 * F.tid]; rec.y = pos[2 * F.tid + 1]; tok[tb * 128 + F.tid] = rec; }
        for (int q = F.wave; q < 256; q += NWAVES) { const int n = tb * 128 + (q >> 1);
            const u32x4* src = (const u32x4*)(H2 + (size_t)n * D) + F.lane; u32x4* dst = (u32x4*)(HS + (size_t)pos[q] * D) + F.lane;
            dst[0] = src[0]; dst[64] = src[64]; }
        __syncthreads();
    }
}

DI void p14_final(const Frame& F0, ARef A, const bf16* YE) {
    Frame F = F0; F.tid = opq_tid(F0.wave); F.lane = F.tid & 63; F.wave = __builtin_amdgcn_readfirstlane(F.tid >> 6); F.gw = F.wg * NWAVES + F.wave;
    const int lane = F.lane;
    const float* mod = (const float*)(A.ws + WS_MOD); const i32x4* tok = (const i32x4*)(A.ws + WS_TOK);
    for (int n = F.gw; n < NTOK; n += F.NGW) {
        const int b = n >> 13; const i32x4 rec = tok[n];
        const float c0 = ((const float*)(A.ws + WS_CW))[2 * n], c1 = ((const float*)(A.ws + WS_CW))[2 * n + 1];
        const u32x2* y0 = (const u32x2*)(YE + (size_t)rec.x * D) + lane; const u32x2* y1 = (const u32x2*)(YE + (size_t)rec.y * D) + lane;
        f32x4 yv[4]; float s = 0.f;
#pragma unroll
        for (int j = 0; j < 4; ++j) { const u32x2 a = y0[64 * j], bq = y1[64 * j];
            yv[j][0] = c0 * bflo(a.x) + c1 * bflo(bq.x); yv[j][1] = c0 * bfhi(a.x) + c1 * bfhi(bq.x); yv[j][2] = c0 * bflo(a.y) + c1 * bflo(bq.y); yv[j][3] = c0 * bfhi(a.y) + c1 * bfhi(bq.y);
            s += (yv[j][0] * yv[j][0] + yv[j][1] * yv[j][1]) + (yv[j][2] * yv[j][2] + yv[j][3] * yv[j][3]); }
        const float inv = rsqrtf(wave_sum(s) * (1.0f / D) + NORM_EPS);
#pragma unroll
        for (int j = 0; j < 4; ++j) { const int k = 4 * lane + 256 * j;
            const f32x4 g3 = *(const f32x4*)(A.gains + 3 * D + k), gt = *(const f32x4*)(mod + b * 6144 + 5 * D + k);
            const u32x2 xw = *((const u32x2*)(A.ws + WS_X1 + (size_t)n * D * 2) + lane + 64 * j); f32x4 xv = {bflo(xw.x), bfhi(xw.x), bflo(xw.y), bfhi(xw.y)};
#pragma unroll
            for (int q = 0; q < 4; ++q) xv[q] = xv[q] + gt[q] * ((yv[j][q] * inv) * g3[q]);
            *((f32x4*)(A.out + (size_t)n * D) + lane + 64 * j) = xv; }
    }
}

DI bf16x8 pk_tile(const f32x16& x, const int s) { return pack8v(x[8 * s], x[8 * s + 1], x[8 * s + 2], x[8 * s + 3], x[8 * s + 4], x[8 * s + 5], x[8 * s + 6], x[8 * s + 7]); }
constexpr int FS = 72;
DI bf16x8 rd_frag(const LAS bf16* buf, int tb, int cb, int s, int r, int hh) {
    const LAS bf16* p = buf + (32 * cb + r) * FS + 32 * tb + 16 * s + 4 * hh;
    const s16x4 lo = *(const LAS s16x4*)p, hi = *(const LAS s16x4*)(p + 8); bf16x8 f;
#pragma unroll
    for (int e = 0; e < 4; ++e) { f[e] = lo[e]; f[4 + e] = hi[e]; }
    return f; }
DI void wr_tile_ft(LAS bf16* buf, const f32x16& x, int tb, int cb, int r, int hh) {
#pragma unroll
    for (int g = 0; g < 4; ++g) { u32x2 w; w.x = pk2(x[4 * g], x[4 * g + 1]); w.y = pk2(x[4 * g + 2], x[4 * g + 3]); *(LAS u32x2*)(buf + (32 * cb + r) * FS + 32 * tb + 8 * g + 4 * hh) = w; } }
DI void wr_l_ft(LAS bf16* buf, const float (&x)[64], int lane) {
#pragma unroll
    for (int t8 = 0; t8 < 8; ++t8) { u32x4 w; w.x = pk2(x[8 * t8], x[8 * t8 + 1]); w.y = pk2(x[8 * t8 + 2], x[8 * t8 + 3]); w.z = pk2(x[8 * t8 + 4], x[8 * t8 + 5]); w.w = pk2(x[8 * t8 + 6], x[8 * t8 + 7]);
        *(LAS u32x4*)(buf + lane * FS + 8 * t8) = w; } }

#if defined(STAMPS)
#define P5STAMP(k) do { p5ts[k] = __builtin_amdgcn_s_memrealtime(); } while (0)
#else
#define P5STAMP(k) do { } while (0)
#endif
DI void p5_mfma(unsigned char* F0_ws, const Frame& F0, const bf16* R, const bf16* KP, const bf16* V, const bf16* KK, const bf16* Bv, const bf16* Ev, bf16* P, bf16* QO, bf16* GT, bf16* HT) {
    Frame F = F0; F.tid = opq_tid(F0.wave); F.lane = F.tid & 63; F.wave = __builtin_amdgcn_readfirstlane(F.tid >> 6); F.gw = F.wg * NWAVES + F.wave;
    const int lane = F.lane, r = lane & 31, hh = lane >> 5;
    LAS unsigned char* wl = F.lds + F.wave * 20480;
    LAS bf16* buf0 = (LAS bf16*)wl; LAS bf16* buf1 = (LAS bf16*)(wl + 9216);
    LAS float* LT = (LAS float*)wl;
    LAS float* LC = (LAS float*)(wl + 18432);
    for (int cid = F.gw; cid < NCHUNK; cid += F.NGW) {
        const int bh = cid >> NCH_LOG, c = cid & (NCH - 1), b = bh >> 3, h = bh & 7;
        const unsigned n0 = (unsigned)b * SEQ + (unsigned)c * CH, col0 = (unsigned)h * HD;
        int ln = lane; asm volatile("" : "+v"(ln));
#if defined(STAMPS)
        unsigned long long p5ts[10];
#endif
        const int rm = ln & 31, hm = ln >> 5;
        const bf16 *R0_ = R, *KP0_ = KP, *V0_ = V, *KK0_ = KK, *Bv0_ = Bv, *Ev0_ = Ev; bf16 *P0_ = P, *QO0_ = QO;
        asm volatile("" : "+s"(R0_), "+s"(KP0_), "+s"(V0_), "+s"(KK0_), "+s"(Bv0_), "+s"(Ev0_), "+s"(P0_), "+s"(QO0_));
        const GAS char *R_ = (const GAS char*)R0_, *KP_ = (const GAS char*)KP0_, *V_ = (const GAS char*)V0_, *KK_ = (const GAS char*)KK0_, *Bv_ = (const GAS char*)Bv0_, *Ev_ = (const GAS char*)Ev0_;
        GAS char *P_ = (GAS char*)P0_, *QO_ = (GAS char*)QO0_;
        const unsigned nb0 = n0 * BW + col0;
        const unsigned vL = (nb0 + (unsigned)ln) * 2u, vT = (nb0 + (unsigned)rm * BW + 4u * hm) * 2u, vC = (nb0 + 4u * hm * BW + (unsigned)rm) * 2u, vG = (4u * hm * 64 + (unsigned)rm) * 2u;
#define OADD(v, c) ({ unsigned o_; asm volatile("v_add_u32_e32 %0, %1, %2" : "=v"(o_) : "n"((int)(c)), "v"(v)); o_; })
#define LD16(arr, off) (*(const GAS bf16*)((arr) + (off)))
#define XL(arr, t) LD16(arr, OADD(vL, (t) * BW * 2))
#define ROWQ(q) (((q) & 3) + 8 * ((q) >> 2))
        P5STAMP(0);
        u32x2 raw[2][5][4];
#define LOAD_TILE(BUF, FB, TB) do { _Pragma("unroll") for (int g = 0; g < 4; ++g) { const unsigned ot_ = OADD(vT, (32 * (TB) * BW + 32 * (FB) + 8 * g) * 2); \
            raw[BUF][0][g] = *(const GAS u32x2*)(Ev_ + ot_); raw[BUF][1][g] = *(const GAS u32x2*)(KK_ + ot_); raw[BUF][2][g] = *(const GAS u32x2*)(R_ + ot_); \
            raw[BUF][3][g] = *(const GAS u32x2*)(Bv_ + ot_); raw[BUF][4][g] = *(const GAS u32x2*)(KP_ + ot_); } } while (0)
        LOAD_TILE(0, 0, 0);
        {   float run = 0.f;
#pragma unroll
            for (int t = 0; t < 64; ++t) { run -= bf2f(XL(Ev_, t)); LT[ln * 65 + t] = run; } }
        wave_lds_fence();
        P5STAMP(1);
        bf16x8 Ap[2][2][2], Rp[2][2][2], Bp[2][2][2], Kp[2][2][2];
#pragma unroll
        for (int ti = 0; ti < 4; ++ti) { const int fb = ti >> 1, tb = ti & 1;
            if (ti < 3) LOAD_TILE((ti + 1) & 1, (ti + 1) >> 1, (ti + 1) & 1);
#pragma unroll
            for (int s = 0; s < 2; ++s) {
                float a8[8], r8[8], b8[8], k8[8];
#pragma unroll
                for (int g2 = 0; g2 < 2; ++g2) { const int g = 2 * s + g2;
                    const u32x2 ew = raw[ti & 1][0][g], aw = raw[ti & 1][1][g], rw = raw[ti & 1][2][g], bw = raw[ti & 1][3][g], kw = raw[ti & 1][4][g];
                    const float e4[4] = {bflo(ew.x), bfhi(ew.x), bflo(ew.y), bfhi(ew.y)}, av[4] = {bflo(aw.x), bfhi(aw.x), bflo(aw.y), bfhi(aw.y)}, rv[4] = {bflo(rw.x), bfhi(rw.x), bflo(rw.y), bfhi(rw.y)},
                                bv[4] = {bflo(bw.x), bfhi(bw.x), bflo(bw.y), bfhi(bw.y)}, kv[4] = {bflo(kw.x), bfhi(kw.x), bflo(kw.y), bfhi(kw.y)};
#pragma unroll
                    for (int j = 0; j < 4; ++j) { const float l = LT[(32 * fb + 8 * g + 4 * hm + j) * 65 + 32 * tb + rm];
                        const float eI = fexp(l), eX = fexp(l + e4[j]), eN = frcp(eI);
                        a8[4 * g2 + j] = -av[j] * eX; r8[4 * g2 + j] = rv[j] * eI; b8[4 * g2 + j] = bv[j] * eN; k8[4 * g2 + j] = kv[j] * eN; } }
                Ap[fb][tb][s] = __builtin_bit_cast(bf16x8, pack8(a8)); Rp[fb][tb][s] = __builtin_bit_cast(bf16x8, pack8(r8));
                Bp[fb][tb][s] = __builtin_bit_cast(bf16x8, pack8(b8)); Kp[fb][tb][s] = __builtin_bit_cast(bf16x8, pack8(k8)); }
            __builtin_amdgcn_sched_barrier(0); }
#undef LOAD_TILE
        wave_lds_fence();
        P5STAMP(2);
        bf16x8 Makp[2][2][2], Mbrp[2][2][2], Mkrp[2][2][2];
#define GRAM_TILE(m_, XP, YP, ib, tb) do { _Pragma("unroll") for (int q = 0; q < 16; ++q) m_[q] = 0.f; \
            _Pragma("unroll") for (int fb = 0; fb < 2; ++fb) _Pragma("unroll") for (int s = 0; s < 2; ++s) m_ = MFMA32(XP[fb][ib][s], YP[fb][tb][s], m_); } while (0)
#define GRAM(XP, YP, STRICT, BODY) _Pragma("unroll") for (int ib = 0; ib < 2; ++ib) _Pragma("unroll") for (int tb = 0; tb < 2; ++tb) if (!(ib == 1 && tb == 0)) { f32x16 m_; \
            GRAM_TILE(m_, XP, YP, ib, tb); \
            int rm_ = rm; asm volatile("" : "+v"(rm_)); \
            _Pragma("unroll") for (int q = 0; q < 16; ++q) { const int i_ = 32 * ib + crow(q, hm), t_ = 32 * tb + rm_; m_[q] = ((STRICT) ? (i_ < t_) : (i_ <= t_)) ? m_[q] : 0.f; } \
            BODY __builtin_amdgcn_sched_barrier(0); }
        GRAM(Kp, Ap, true, { Makp[ib][tb][0] = pk_tile(m_, 0); Makp[ib][tb][1] = pk_tile(m_, 1); })
        GRAM(Bp, Rp, false, { Mbrp[ib][tb][0] = pk_tile(m_, 0); Mbrp[ib][tb][1] = pk_tile(m_, 1); })
        GRAM(Kp, Rp, false, { Mkrp[ib][tb][0] = pk_tile(m_, 0); Mkrp[ib][tb][1] = pk_tile(m_, 1); })
#undef GRAM
        P5STAMP(3);
        bf16x8 Tp[2][2][2];
        {   bf16x8 AP[2][2], BP[2][2], AU01[2]; f32x16 CT[2], CTT0;
#pragma unroll
            for (int b = 0; b < 2; ++b) { f32x16 m_; int rm_ = rm; asm volatile("" : "+v"(rm_));
                GRAM_TILE(m_, Bp, Ap, b, b);
#pragma unroll
                for (int q = 0; q < 16; ++q) m_[q] = crow(q, hm) < rm_ ? m_[q] : 0.f;
                BP[b][0] = pk_tile(m_, 0); BP[b][1] = pk_tile(m_, 1);
#pragma unroll
                for (int q = 0; q < 16; ++q) CT[b][q] = m_[q] + (crow(q, hm) == rm_ ? 1.0f : 0.f);
                GRAM_TILE(m_, Ap, Bp, b, b);
#pragma unroll
                for (int q = 0; q < 16; ++q) m_[q] = rm_ < crow(q, hm) ? m_[q] : 0.f;
                AP[b][0] = pk_tile(m_, 0); AP[b][1] = pk_tile(m_, 1);
                if (b == 0) {
#pragma unroll
                    for (int q = 0; q < 16; ++q) CTT0[q] = m_[q] + (crow(q, hm) == rm_ ? 1.0f : 0.f); }
                __builtin_amdgcn_sched_barrier(0); }
            {   f32x16 m_; GRAM_TILE(m_, Ap, Bp, 1, 0);
                AU01[0] = pk_tile(m_, 0); AU01[1] = pk_tile(m_, 1); }
            __builtin_amdgcn_sched_barrier(0);
#pragma unroll
            for (int b = 1; b >= 0; --b) {
#pragma unroll
                for (int it = 0; it < 4; ++it) { f32x16 pn_, pt_;
#pragma unroll
                    for (int q = 0; q < 16; ++q) { pn_[q] = 0.f; pt_[q] = 0.f; }
#pragma unroll
                    for (int s = 0; s < 2; ++s) { pn_ = MFMA32(AP[b][s], BP[b][s], pn_); pt_ = MFMA32(BP[b][s], AP[b][s], pt_); }
                    const bf16x8 bt0 = pk_tile(CT[b], 0), bt1 = pk_tile(CT[b], 1);
                    AP[b][0] = pk_tile(pt_, 0); AP[b][1] = pk_tile(pt_, 1); BP[b][0] = pk_tile(pn_, 0); BP[b][1] = pk_tile(pn_, 1);
                    CT[b] = MFMA32(AP[b][0], bt0, CT[b]); CT[b] = MFMA32(AP[b][1], bt1, CT[b]);
                    if (b == 0) { CTT0 = MFMA32(bt0, AP[b][0], CTT0); CTT0 = MFMA32(bt1, AP[b][1], CTT0); }
                    __builtin_amdgcn_sched_barrier(0); }
                Tp[b][b][0] = pk_tile(CT[b], 0); Tp[b][b][1] = pk_tile(CT[b], 1); }
            {   f32x16 x_;
#pragma unroll
                for (int q = 0; q < 16; ++q) x_[q] = 0.f;
                x_ = MFMA32(AU01[0], Tp[1][1][0], x_); x_ = MFMA32(AU01[1], Tp[1][1][1], x_);
                const bf16x8 bx0 = pk_tile(x_, 0), bx1 = pk_tile(x_, 1), at0 = pk_tile(CTT0, 0), at1 = pk_tile(CTT0, 1);
#pragma unroll
                for (int q = 0; q < 16; ++q) x_[q] = 0.f;
                x_ = MFMA32(at0, bx0, x_); x_ = MFMA32(at1, bx1, x_);
                Tp[1][0][0] = pk_tile(x_, 0); Tp[1][0][1] = pk_tile(x_, 1); }
            __builtin_amdgcn_sched_barrier(0); }
#undef GRAM_TILE
        P5STAMP(4);
        bf16x8 W1p[2][2][2];
        {   bf16x8 Vp[2][2][2];
#pragma unroll
            for (int ib = 0; ib < 2; ++ib)
#pragma unroll
                for (int vb = 0; vb < 2; ++vb) { f32x16 v_;
#pragma unroll
                    for (int q = 0; q < 16; ++q) v_[q] = bf2f(LD16(V_, OADD(vC, ((32 * ib + ROWQ(q)) * BW + 32 * vb) * 2)));
                    Vp[ib][vb][0] = pk_tile(v_, 0); Vp[ib][vb][1] = pk_tile(v_, 1); }
#pragma unroll
            for (int vb = 0; vb < 2; ++vb) { bf16x8 W0p[2][2];
#pragma unroll
                for (int tb = 0; tb < 2; ++tb) { f32x16 w_;
#pragma unroll
                    for (int q = 0; q < 16; ++q) w_[q] = 0.f;
#pragma unroll
                    for (int ib = 0; ib <= tb; ++ib)
#pragma unroll
                        for (int s = 0; s < 2; ++s) w_ = MFMA32(Makp[ib][tb][s], Vp[ib][vb][s], w_);
                    W0p[tb][0] = pk_tile(w_, 0); W0p[tb][1] = pk_tile(w_, 1); }
#pragma unroll
                for (int tb = 0; tb < 2; ++tb) { f32x16 w_;
#pragma unroll
                    for (int q = 0; q < 16; ++q) w_[q] = 0.f;
#pragma unroll
                    for (int ib = 0; ib <= tb; ++ib)
#pragma unroll
                        for (int s = 0; s < 2; ++s) w_ = MFMA32(Tp[tb][ib][s], W0p[ib][s], w_);
                    W1p[tb][vb][0] = pk_tile(w_, 0); W1p[tb][vb][1] = pk_tile(w_, 1); }
                __builtin_amdgcn_sched_barrier(0); } }
        P5STAMP(5);
        float lC;
        bf16x8 ATp[2][2][2];
        {   {   float xa[64];
                float run = 0.f;
#pragma unroll
                for (int t = 0; t < 64; ++t) { xa[t] = -bf2f(XL(KK_, t)) * fexp(run); run -= bf2f(XL(Ev_, t)); if ((t & 31) == 31) __builtin_amdgcn_sched_barrier(0); }
                lC = run; LC[ln] = fexp(lC);
                wr_l_ft(buf0, xa, ln); }
            wave_lds_fence();
#pragma unroll
            for (int kb = 0; kb < 2; ++kb) { bf16x8 A0p[2][2];
#pragma unroll
                for (int ib = 0; ib < 2; ++ib)
#pragma unroll
                    for (int s = 0; s < 2; ++s) A0p[ib][s] = rd_frag(buf0, ib, kb, s, rm, hm);
#pragma unroll
                for (int tb = 0; tb < 2; ++tb) { f32x16 a_;
#pragma unroll
                    for (int q = 0; q < 16; ++q) a_[q] = 0.f;
#pragma unroll
                    for (int ib = 0; ib <= tb; ++ib)
#pragma unroll
                        for (int s = 0; s < 2; ++s) a_ = MFMA32(Tp[tb][ib][s], A0p[ib][s], a_);
                    ATp[tb][kb][0] = pk_tile(a_, 0); ATp[tb][kb][1] = pk_tile(a_, 1); }
                __builtin_amdgcn_sched_barrier(0); } }
        wave_lds_fence();
        P5STAMP(6);
        {   float run = 0.f;
#pragma unroll
            for (int t8 = 0; t8 < 8; ++t8) { float r8[8];
#pragma unroll
                for (int j = 0; j < 8; ++j) { const int t = 8 * t8 + j; run -= bf2f(XL(Ev_, t)); r8[j] = bf2f(XL(R_, t)) * fexp(run); }
                *(LAS u32x4*)(buf0 + ln * FS + 8 * t8) = pack8(r8); if (t8 & 3) { } else { } if ((t8 & 3) == 3) __builtin_amdgcn_sched_barrier(0); } }
        wave_lds_fence();
        GAS char* pn = (GAS char*)(P0_ + (size_t)cid * 4096); GAS char* qn = (GAS char*)(QO0_ + (size_t)cid * 4096);
#pragma unroll
        for (int jb = 0; jb < 2; ++jb)
#pragma unroll
            for (int tb = 0; tb < 2; ++tb) { f32x16 p_;
#pragma unroll
                for (int q = 0; q < 16; ++q) p_[q] = bf2f(buf0[(32 * jb + crow(q, hm)) * FS + 32 * tb + rm]);
#pragma unroll
                for (int ib = 0; ib <= tb; ++ib)
#pragma unroll
                    for (int s = 0; s < 2; ++s) p_ = MFMA32(ATp[ib][jb][s], Mbrp[ib][tb][s], p_);
#pragma unroll
                for (int s = 0; s < 2; ++s) *(GAS bf16x8*)(pn + ((((jb * 2 + tb) * 2 + s) * 64) + ln) * 16) = pk_tile(p_, s);
                __builtin_amdgcn_sched_barrier(0); }
        bf16x8 Vp[2][2][2];
#pragma unroll
        for (int ib = 0; ib < 2; ++ib)
#pragma unroll
            for (int vb = 0; vb < 2; ++vb) { f32x16 v_;
#pragma unroll
                for (int q = 0; q < 16; ++q) v_[q] = bf2f(LD16(V_, OADD(vC, ((32 * ib + ROWQ(q)) * BW + 32 * vb) * 2)));
                Vp[ib][vb][0] = pk_tile(v_, 0); Vp[ib][vb][1] = pk_tile(v_, 1); }
        P5STAMP(7);
#pragma unroll
        for (int tb = 0; tb < 2; ++tb)
#pragma unroll
            for (int vb = 0; vb < 2; ++vb) { f32x16 y_;
#pragma unroll
                for (int q = 0; q < 16; ++q) y_[q] = 0.f;
#pragma unroll
                for (int ib = 0; ib <= tb; ++ib)
#pragma unroll
                    for (int s = 0; s < 2; ++s) { y_ = MFMA32(Mbrp[ib][tb][s], W1p[ib][vb][s], y_); y_ = MFMA32(Mkrp[ib][tb][s], Vp[ib][vb][s], y_); }
#pragma unroll
                for (int g = 0; g < 4; ++g) { u32x2 w; w.x = pk2(y_[4 * g], y_[4 * g + 1]); w.y = pk2(y_[4 * g + 2], y_[4 * g + 3]); *(GAS u32x2*)(qn + ((((tb * 2 + vb) * 4 + g) * 64) + ln) * 8) = w; }
                __builtin_amdgcn_sched_barrier(0); }
        P5STAMP(8);
        wave_lds_fence();
        {   float run = 0.f;
#pragma unroll
            for (int t8 = 0; t8 < 8; ++t8) { float b8[8], k8[8];
#pragma unroll
                for (int j = 0; j < 8; ++j) { const int t = 8 * t8 + j; run -= bf2f(XL(Ev_, t)); const float sc = fexp(lC - run); b8[j] = bf2f(XL(Bv_, t)) * sc; k8[j] = bf2f(XL(KP_, t)) * sc; }
                *(LAS u32x4*)(buf0 + ln * FS + 8 * t8) = pack8(b8); *(LAS u32x4*)(buf1 + ln * FS + 8 * t8) = pack8(k8); if ((t8 & 3) == 3) __builtin_amdgcn_sched_barrier(0); } }
        wave_lds_fence();
        bf16x8 Bh[2][2][2];
#pragma unroll
        for (int tb = 0; tb < 2; ++tb)
#pragma unroll
            for (int kb = 0; kb < 2; ++kb)
#pragma unroll
                for (int s = 0; s < 2; ++s) Bh[tb][kb][s] = rd_frag(buf0, tb, kb, s, rm, hm);
        GAS char* gt = (GAS char*)(GT + (size_t)cid * 4096); GAS char* ht = (GAS char*)(HT + (size_t)cid * 4096);
#pragma unroll
        for (int kb = 0; kb < 2; ++kb)
#pragma unroll
            for (int jb = 0; jb < 2; ++jb) { f32x16 g_;
                const float dg = LC[32 * kb + rm];
#pragma unroll
                for (int q = 0; q < 16; ++q) g_[q] = (kb == jb && crow(q, hm) == rm) ? dg : 0.f;
#pragma unroll
                for (int tb = 0; tb < 2; ++tb)
#pragma unroll
                    for (int s = 0; s < 2; ++s) g_ = MFMA32(ATp[tb][jb][s], Bh[tb][kb][s], g_);
#pragma unroll
                for (int s = 0; s < 2; ++s) *(GAS bf16x8*)(gt + ((kb * 4 + jb * 2 + s) * 64 + ln) * 16) = pk_tile(g_, s);
                __builtin_amdgcn_sched_barrier(0); }
        {   bf16x8 Kh[2][2][2];
#pragma unroll
            for (int tb = 0; tb < 2; ++tb)
#pragma unroll
                for (int kb = 0; kb < 2; ++kb)
#pragma unroll
                    for (int s = 0; s < 2; ++s) Kh[tb][kb][s] = rd_frag(buf1, tb, kb, s, rm, hm);
#pragma unroll
            for (int kb = 0; kb < 2; ++kb)
#pragma unroll
                for (int vb = 0; vb < 2; ++vb) { f32x16 h_;
#pragma unroll
                    for (int q = 0; q < 16; ++q) h_[q] = 0.f;
#pragma unroll
                    for (int tb = 0; tb < 2; ++tb)
#pragma unroll
                        for (int s = 0; s < 2; ++s) { h_ = MFMA32(Bh[tb][kb][s], W1p[tb][vb][s], h_); h_ = MFMA32(Kh[tb][kb][s], Vp[tb][vb][s], h_); }
#pragma unroll
                    for (int g = 0; g < 4; ++g) { u32x2 w; w.x = pk2(h_[4 * g], h_[4 * g + 1]); w.y = pk2(h_[4 * g + 2], h_[4 * g + 3]); *(GAS u32x2*)(ht + ((((kb * 2 + vb) * 4 + g) * 64) + ln) * 8) = w; }
                    __builtin_amdgcn_sched_barrier(0); } }
        P5STAMP(9);
#if defined(STAMPS)
        if (F.gw == 0 && cid == 0 && lane == 0) { _Pragma("unroll") for (int k_ = 0; k_ < 10; ++k_) ((unsigned long long*)(F0_ws + WS_CTL + 49152))[32 + k_] = p5ts[k_]; }
#endif
        wave_lds_fence();
#undef XL
#undef OADD
#undef LD16
#undef ROWQ
    }
}

#if defined(CHECKS)
constexpr size_t WS_FLG = WS_CTL + 32768;
DI unsigned* chk_flags(unsigned char* ws) { return (unsigned*)(ws + WS_FLG); }
DI void chk(unsigned char* ws, int id, float got, float want, float rel, float ab) {
    const float d = fabsf(got - want), lim = rel * fmaxf(fabsf(got), fabsf(want)) + ab;
    if (!(d <= lim)) chk_flags(ws)[id] = 1u; }
DI unsigned hsh(unsigned a) { a ^= a >> 16; a *= 0x7feb352du; a ^= a >> 15; a *= 0x846ca68bu; a ^= a >> 16; return a; }
DI float bfr(float v) { return bflo(f2bf(v)); }
DI int scol_of(int n) { return n < 3360 ? n : (n < 3584 ? -1 : n - 224); }

DI void chk_p0(const Frame& F, ARef A) {
    unsigned char* ws = A.ws; const int lane = F.lane;
    const float* mod = (const float*)(ws + WS_MOD);
    for (int s = F.wave; s < 32; s += NWAVES) { const unsigned hh = hsh(1000 + s); const int b = hh & 3, o = (hh >> 2) % 6144; float a = 0.f;
        for (int k = lane; k < D; k += 64) { const float c = A.c[b * D + k]; a += (c / (1.0f + expf(-c))) * A.w_mod[(size_t)k * 6144 + o]; }
        a = wave_sum(a) + A.b_mod[o]; chk(ws, 10, mod[b * 6144 + o], a, 1e-3f, 1e-4f); }
    const bf16* wt = (const bf16*)(ws + WS_WIN);
    for (int s = 0; s < 8; ++s) { const unsigned hh = hsh(2000 + (F.wave * 8 + s) * 64 + lane); const int n = hh % NPAD, k = (hh >> 13) & 1023; const int sc = scol_of(n);
        const float want = sc >= 0 ? bfr(A.w_in[(size_t)k * IN_COLS + sc]) : 0.f; chk(ws, 11, bf2f(wt[(size_t)n * D + k]), want, 0.f, 0.f); }
    { const unsigned hh = hsh(3000 + F.wave * 64 + lane); const int n = hh & 1023, k = (hh >> 10) & 511, k2 = (hh >> 10) & 1023;
        chk(ws, 11, bf2f(((const bf16*)(ws + WS_WOSB))[n * BW + k]), bfr(A.w_o_sb[k * D + n]), 0.f, 0.f);
        chk(ws, 11, bf2f(((const bf16*)(ws + WS_WORW))[n * BW + k]), bfr(A.w_o_rw[k * D + n]), 0.f, 0.f);
        chk(ws, 11, bf2f(((const bf16*)(ws + WS_WOUT))[n * D + k2]), bfr(A.w_out[k2 * D + n]), 0.f, 0.f);
        const int o = hh % 36; chk(ws, 11, ((const float*)(ws + WS_RTW))[o * D + k2], o < 4 ? A.w_group[k2 * 4 + o] : A.w_router[k2 * NE + o - 4], 0.f, 0.f);
        const int nl = hh % 1536, kl = (hh >> 11) % LK; float v = 0.f;
        if (nl < 512) { if (kl < 64) v = A.w_decay_up[kl * BW + nl]; } else if (nl < 1024) { if (kl >= 64 && kl < 128) v = A.w_iclr_up[(kl - 64) * BW + nl - 512]; } else { if (kl >= 128 && kl < 288) v = A.w_gate_up[(kl - 128) * BW + nl - 1024]; }
        chk(ws, 11, bf2f(((const bf16*)(ws + WS_WL))[nl * LK + kl]), bfr(v), 0.f, 0.f); }
}
DI void chk_p1(const Frame& F, ARef A, const bf16* H1) {
    unsigned char* ws = A.ws; const int lane = F.lane; const float* mod = (const float*)(ws + WS_MOD);
    for (int s = F.wave; s < 16; s += NWAVES) { const int n = hsh(4000 + s) % NTOK, b = n >> 13; float ss = 0.f;
        for (int k = lane; k < D; k += 64) { const float v = A.x[(size_t)n * D + k]; ss += v * v; }
        const float inv = 1.0f / sqrtf(wave_sum(ss) / D + NORM_EPS);
        for (int k = lane; k < D; k += 64) { const float want = (A.x[(size_t)n * D + k] * inv) * A.gains[k] * (1.0f + mod[b * 6144 + D + k]) + mod[b * 6144 + k];
            chk(ws, 12, bf2f(H1[(size_t)n * D + k]), want, 0.01f, 0.01f); } }
}
DI float wdot(const bf16* arow, const float* W, int ldw, int col, int K, int lane) { float a = 0.f; for (int k = lane; k < K; k += 64) a += bf2f(arow[k]) * W[(size_t)k * ldw + col]; return wave_sum(a); }
DI void chk_p2(const Frame& F, ARef A, const bf16* H1) {
    unsigned char* ws = A.ws; const int lane = F.lane;
    for (int s = F.wave; s < 96; s += NWAVES) { const unsigned hh = hsh(5000 + s); const int n = hh % NTOK, region = s % 6; int col;
        const unsigned h2 = hsh(hh);
        float got, want; int id = 13 + region;
        if (region == 0) { col = h2 % 512; want = 0.125f * wdot(H1 + (size_t)n * D, A.w_in, IN_COLS, col, D, lane); got = bf2f(((const bf16*)(ws + WS_QB))[(size_t)n * BW + col]); }
        else if (region == 1) { col = h2 % 512; want = wdot(H1 + (size_t)n * D, A.w_in, IN_COLS, 512 + col, D, lane); got = bf2f(((const bf16*)(ws + WS_KB))[(size_t)n * BW + col]); }
        else if (region == 2) { col = h2 % 512; want = wdot(H1 + (size_t)n * D, A.w_in, IN_COLS, 1024 + col, D, lane); got = bf2f(((const bf16*)(ws + WS_VT))[((size_t)((n >> 13) * BW + col)) * SEQ + (n & (SEQ - 1))]); }
        else if (region == 3) { col = h2 % 1536; want = wdot(H1 + (size_t)n * D, A.w_in, IN_COLS, 1536 + col, D, lane); got = bf2f(((const bf16*)(ws + WS_RWRAW))[(size_t)n * 1536 + col]); }
        else if (region == 4) { col = h2 % 288; want = wdot(H1 + (size_t)n * D, A.w_in, IN_COLS, 3072 + col, D, lane); got = bf2f(((const bf16*)(ws + WS_LORA))[(size_t)n * BW + col]); }
        else { col = h2 % 2048; want = wdot(H1 + (size_t)n * D, A.w_in, IN_COLS, 3360 + col, D, lane) + A.gate_bias[col]; want = 1.0f / (1.0f + expf(-want)); got = bf2f(((const bf16*)(ws + WS_GATE))[(size_t)n * 2048 + col]); }
        chk(ws, id, got, want, 0.03f, 0.02f); }
}
constexpr int NATT = 16;
DI void att_sample(int s, int& b, int& h, int& t) { const unsigned hh = hsh(6000 + s); b = hh & 3; h = (hh >> 2) & 7; t = (s < 4) ? (s * 37) : (int)((hh >> 5) % SEQ); }
DI void chk_p3_save(const Frame& F, ARef A) {
    if (F.wave == 0) { bf16* sv = (bf16*)(A.ws + WS_FLG + 4096);
        for (int s = 0; s < NATT; ++s) { int b, h, t; att_sample(s, b, h, t); sv[s * 64 + F.lane] = ((const bf16*)(A.ws + WS_QB))[(size_t)(b * SEQ + t) * BW + h * HD + F.lane]; } }
}
DI void chk_p3(const Frame& F, ARef A, const bf16* R, const bf16* KS, const bf16* V, const bf16* KK) {
    unsigned char* ws = A.ws; const int lane = F.lane;
    const bf16* sv = (const bf16*)(ws + WS_FLG + 4096); const bf16* KB = (const bf16*)(ws + WS_KB); const bf16* VT = (const bf16*)(ws + WS_VT);
    for (int s = F.wave; s < NATT; s += NWAVES) { int b, h, t; att_sample(s, b, h, t);
        const float q = bf2f(sv[s * 64 + lane]); float later = 0.f, o = 0.f;
        for (int k = t - 1; k >= 0; --k) { const float z = wave_sum(q * bf2f(KB[(size_t)(b * SEQ + k) * BW + h * HD + lane]));
            const float sp = fmaxf(z, 0.f) + log1pf(expf(-fabsf(z)));
            o += expf(z - sp + later) * bf2f(VT[((size_t)((b * NH + h) * HD + lane)) * SEQ + k]);
            later -= sp; if (later < -200.f) break; }
        chk(ws, 19, bf2f(((const bf16*)(ws + WS_QB))[(size_t)(b * SEQ + t) * BW + h * HD + lane]), o, 0.04f, 0.02f); }
    const bf16* RW = (const bf16*)(ws + WS_RWRAW); const bf16* LO = (const bf16*)(ws + WS_LORA); const bf16* AL = (const bf16*)(ws + WS_ALORA);
    for (int s = F.wave; s < 32; s += NWAVES) { const unsigned hh = hsh(7000 + s); const int n = (s < 4) ? s * SEQ : (int)(hh % NTOK), hd = (hh >> 16) & 7; const bool first = (n & (SEQ - 1)) == 0;
        float xs[3];
        for (int p = 0; p < 3; ++p) { const int col = p * 512 + hd * 64 + lane; const float cur = bf2f(RW[(size_t)n * 1536 + col]), prv = first ? 0.f : bf2f(RW[(size_t)(n - 1) * 1536 + col]); xs[p] = cur + A.shift_mu[col] * (prv - cur); }
        const size_t o = (size_t)n * BW + hd * 64 + lane;
        chk(ws, 20, bf2f(R[o]), xs[0], 0.01f, 0.005f); chk(ws, 20, bf2f(KS[o]), xs[1], 0.01f, 0.005f); chk(ws, 20, bf2f(V[o]), xs[2], 0.01f, 0.005f);
        const float kk = xs[1] * A.k_k[hd * 64 + lane]; const float nn = sqrtf(wave_sum(kk * kk));
        chk(ws, 20, bf2f(KK[o]), kk / fmaxf(nn, L2_EPS), 0.01f, 0.002f);
        for (int c = lane; c < LK; c += 64) { float want = 0.f;
            if (c < 288) { const float cur = bf2f(LO[(size_t)n * BW + c]), prv = first ? 0.f : bf2f(LO[(size_t)(n - 1) * BW + c]); const float v = cur + A.shift_mu[1536 + c] * (prv - cur);
                want = c < 64 ? tanhf(v) : (c < 128 ? v : 1.0f / (1.0f + expf(-v))); }
            chk(ws, 20, bf2f(AL[(size_t)n * LK + c]), want, 0.01f, 0.005f); } }
}
DI void chk_p4_save(const Frame& F, ARef A, const bf16* KS) {
    if (F.wave == 0) { bf16* sv = (bf16*)(A.ws + WS_FLG + 8192);
        for (int s = 0; s < 16; ++s) { const unsigned hh = hsh(8000 + s); const int n = hh % NTOK, hd = (hh >> 16) & 7; sv[s * 64 + F.lane] = KS[(size_t)n * BW + hd * 64 + F.lane]; } }
}
DI void chk_p4(const Frame& F, ARef A, const bf16* KP, const bf16* KK) {
    unsigned char* ws = A.ws; const int lane = F.lane; const bf16* AL = (const bf16*)(ws + WS_ALORA); const bf16* sv = (const bf16*)(ws + WS_FLG + 8192);
    for (int s = F.wave; s < 16; s += NWAVES) { const unsigned hh = hsh(8000 + s); const int n = hh % NTOK, hd = (hh >> 16) & 7, c = hd * 64 + lane; const size_t o = (size_t)n * BW + c;
        float lw = 0.f, la = 0.f, lg = 0.f;
        for (int k = 0; k < 64; ++k) { lw += bf2f(AL[(size_t)n * LK + k]) * A.w_decay_up[k * BW + c]; la += bf2f(AL[(size_t)n * LK + 64 + k]) * A.w_iclr_up[k * BW + c]; }
        for (int k = 0; k < 160; ++k) lg += bf2f(AL[(size_t)n * LK + 128 + k]) * A.w_gate_up[k * BW + c];
        const float x = -(A.w0[c] + lw), w = -(fmaxf(x, 0.f) + log1pf(expf(-fabsf(x)))) - 0.5f;
        chk(ws, 21, bf2f(((const bf16*)(ws + WS_E))[o]), expf(w), 0.03f, 0.003f);
        const float a = 1.0f / (1.0f + expf(-(A.a0[c] + la))); const float ks = bf2f(sv[s * 64 + lane]);
        chk(ws, 22, bf2f(KP[o]), ks * (1.0f + (a - 1.0f) * A.k_a[c]), 0.03f, 0.01f);
        chk(ws, 22, bf2f(((const bf16*)(ws + WS_B))[o]), bf2f(KK[o]) * a, 0.03f, 0.003f);
        chk(ws, 23, bf2f(((const bf16*)(ws + WS_GG))[o]), lg, 0.03f, 0.01f); }
}
constexpr int NST = 300;
DI void chk_p7_save(const Frame& F, ARef A) {
    if (F.wave < 4) { const int b = (F.wave * 3) & 3, h = (F.wave * 5 + 1) & 7; bf16* sv = (bf16*)(A.ws + 256 * 1024) + F.wave * NST * 64;
        for (int t = 0; t < NST; ++t) sv[t * 64 + F.lane] = ((const bf16*)(A.ws + WS_E))[(size_t)(b * SEQ + t) * BW + h * HD + F.lane]; }
}
DI void chk_p7(const Frame& F, ARef A, const bf16* R, const bf16* KP, const bf16* V, const bf16* KK) {
    unsigned char* ws = A.ws; const int lane = F.lane;
    const bf16* Bv = (const bf16*)(ws + WS_B); const bf16* Esv = (const bf16*)(ws + 256 * 1024) + F.wave * NST * 64; const bf16* GG = (const bf16*)(ws + WS_GG); const bf16* YRW = (const bf16*)(ws + WS_YRW);
    if (F.wave < 4) { const int b = (F.wave * 3) & 3, h = (F.wave * 5 + 1) & 7, col0 = h * HD;
        float S[64];
#pragma unroll
        for (int k = 0; k < 64; ++k) S[k] = 0.f;
        for (int t = 0; t < NST; ++t) { const size_t o = (size_t)(b * SEQ + t) * BW + col0 + lane;
            const float av = -bf2f(KK[o]), bv = bf2f(Bv[o]), dv = expf(-bf2f(Esv[t * 64 + lane])), kv = bf2f(KP[o]), rv = bf2f(R[o]), vv = bf2f(V[o]);
            float sa = 0.f;
#pragma unroll
            for (int k = 0; k < 64; ++k) sa += S[k] * __shfl(av, k);
            float y = 0.f;
#pragma unroll
            for (int k = 0; k < 64; ++k) { S[k] = S[k] * __shfl(dv, k) + sa * __shfl(bv, k) + vv * __shfl(kv, k); y += S[k] * __shfl(rv, k); }
            const float mean = wave_sum(y) / 64.f, d = y - mean, var = wave_sum(d * d) / 64.f;
            const float yn = d / sqrtf(var + GN_EPS) * A.lnx_w[col0 + lane] + A.lnx_b[col0 + lane];
            const float bonus = wave_sum(rv * kv * A.r_k[col0 + lane]) * vv;
            const float want = (yn + bonus) * bf2f(GG[o]);
            chk(ws, t < 128 ? 24 : 25, bf2f(YRW[o]), want, 0.05f, 0.03f); } }
}
DI void chk_p8(const Frame& F, ARef A) {
    unsigned char* ws = A.ws; const int lane = F.lane;
    for (int s = F.wave; s < 32; s += NWAVES) { const unsigned hh = hsh(9000 + s); const int n = hh % NTOK, c = (hh >> 15) & 1023;
        const float p1 = wdot((const bf16*)(ws + WS_QB) + (size_t)n * BW, A.w_o_sb, D, c, BW, lane), p2 = wdot((const bf16*)(ws + WS_YRW) + (size_t)n * BW, A.w_o_rw, D, c, BW, lane);
        const bf16* ga = (const bf16*)(ws + WS_GATE) + (size_t)n * 2048;
        chk(ws, 26, bf2f(((const bf16*)(ws + WS_MRG))[(size_t)n * D + c]), bf2f(ga[c]) * p1 + bf2f(ga[1024 + c]) * p2, 0.03f, 0.01f); }
}
DI void chk_p9(const Frame& F, ARef A) {
    unsigned char* ws = A.ws; const int lane = F.lane;
    for (int s = F.wave; s < 32; s += NWAVES) { const unsigned hh = hsh(9500 + s); const int n = hh % NTOK, c = (hh >> 15) & 1023;
        chk(ws, 27, bf2f(((const bf16*)(ws + WS_Y1))[(size_t)n * D + c]), wdot((const bf16*)(ws + WS_MRG) + (size_t)n * D, A.w_out, D, c, D, lane), 0.03f, 0.01f); }
}
DI void chk_p10(const Frame& F, ARef A) {
    unsigned char* ws = A.ws; const int lane = F.lane; const float* mod = (const float*)(ws + WS_MOD);
    const bf16* Y1 = (const bf16*)(ws + WS_Y1); const bf16* H2 = (const bf16*)(ws + WS_H2); const i32x4* tok = (const i32x4*)(ws + WS_TOK);
    for (int s = F.wave; s < 32; s += NWAVES) { const int n = s == 0 ? DBG_TOKEN : (s < 16 ? (int)(hsh(10000 + s) % 128) : (int)(hsh(10000 + s) % NTOK)), b = n >> 13; float ss = 0.f;
        for (int k = lane; k < D; k += 64) { const float v = bf2f(Y1[(size_t)n * D + k]); ss += v * v; }
        const float inv1 = 1.0f / sqrtf(wave_sum(ss) / D + NORM_EPS); float s2 = 0.f;
        for (int k = lane; k < D; k += 64) { const float x1 = A.x[(size_t)n * D + k] + mod[b * 6144 + 2 * D + k] * ((bf2f(Y1[(size_t)n * D + k]) * inv1) * A.gains[D + k]);
            chk(ws, 28, A.out[(size_t)n * D + k], x1, 1e-3f, 1e-3f); s2 += x1 * x1; }
        const float inv2 = 1.0f / sqrtf(wave_sum(s2) / D + NORM_EPS);
        float lg[36];
#pragma unroll
        for (int o = 0; o < 36; ++o) lg[o] = 0.f;
        for (int k = lane; k < D; k += 64) { const float h2 = (A.out[(size_t)n * D + k] * inv2) * A.gains[2 * D + k] * (1.0f + mod[b * 6144 + 4 * D + k]) + mod[b * 6144 + 3 * D + k];
            chk(ws, 29, bf2f(H2[(size_t)n * D + k]), h2, 0.01f, 0.01f);
#pragma unroll
            for (int o = 0; o < 36; ++o) lg[o] += h2 * (o < 4 ? A.w_group[k * 4 + o] : A.w_router[k * NE + o - 4]); }
#pragma unroll
        for (int o = 0; o < 36; ++o) lg[o] = wave_sum(lg[o]);
        int gs = 0; float gm = lg[0];
#pragma unroll
        for (int g = 1; g < 4; ++g) if (lg[g] > gm) { gm = lg[g]; gs = g; }
        float gsum = 0.f;
#pragma unroll
        for (int g = 0; g < 4; ++g) gsum += expf(lg[g] - gm);
        float el[8];
#pragma unroll
        for (int e = 0; e < 8; ++e) el[e] = gs == 0 ? lg[4 + e] : (gs == 1 ? lg[12 + e] : (gs == 2 ? lg[20 + e] : lg[28 + e]));
        int i0 = 0; float m0 = el[0];
#pragma unroll
        for (int e = 1; e < 8; ++e) if (el[e] > m0) { m0 = el[e]; i0 = e; }
        int i1 = -1; float m1 = -3.0e38f;
#pragma unroll
        for (int e = 0; e < 8; ++e) if (e != i0 && el[e] > m1) { m1 = el[e]; i1 = e; }
        const float tt = expf(m1 - m0), p0 = 1.0f / (1.0f + tt);
        const i32x4 rec = tok[n];
        if (lane == 0 && s < 16) { if ((rec.x & 255) != gs * 8 + i0 || ((rec.x >> 8) & 255) != gs * 8 + i1) chk_flags(ws)[30] = 1u;
            if (n == DBG_TOKEN) { const float* dbg = (const float*)chk_flags(ws) + 48; float code = 1.f;
                if (dbg[4] > 4.001f) code += 2.f; if (dbg[5] < 0.499f) code += 4.f;
                if (fabsf(dbg[0] - lg[0]) > 1e-3f || fabsf(dbg[1] - lg[1]) > 1e-3f || fabsf(dbg[2] - lg[2]) > 1e-3f || fabsf(dbg[3] - lg[3]) > 1e-3f) code += 8.f;
                if (fabsf(dbg[4] - gsum) > 1e-3f) code += 16.f; if (fabsf(dbg[6] * dbg[5] - __builtin_bit_cast(float, rec.z)) > 1e-4f) code += 32.f;
                ((float*)chk_flags(ws))[62] = code * 0.1f; ((float*)chk_flags(ws))[63] = dbg[4]; }
            chk(ws, 56, ((const float*)(ws + WS_CW))[2 * n], p0 / gsum, 3e-2f, 1e-4f); chk(ws, 57, ((const float*)(ws + WS_CW))[2 * n + 1], tt * p0 / gsum, 3e-2f, 1e-4f);
            chk(ws, 58, ((const float*)(ws + WS_CW))[2 * n], p0 / gsum, 1e-3f, 1e-5f); chk(ws, 59, ((const float*)(ws + WS_CW))[2 * n + 1], tt * p0 / gsum, 1e-3f, 1e-5f); } }
}
DI void chk_p11(const Frame& F, ARef A) {
    unsigned char* ws = A.ws; const int lane = F.lane; const i32x4* tok = (const i32x4*)(ws + WS_TOK); const int* tile = (const int*)(ws + WS_TILE);
    const bf16* H2 = (const bf16*)(ws + WS_H2); const bf16* HS = (const bf16*)(ws + WS_HS);
    for (int s = F.wave; s < 64; s += NWAVES) { const int n = hsh(11000 + s) % NTOK; const i32x4 rec = tok[n];
        if (rec.x < 0 || rec.x >= tile[MAXT] * 256 || rec.y < 0 || rec.y >= tile[MAXT] * 256 || tile[MAXT] > MAXT || tile[MAXT] < 256) { chk_flags(ws)[32] = 1u; continue; }
        for (int k = lane; k < D; k += 64) { chk(ws, 33, bf2f(HS[(size_t)rec.x * D + k]), bf2f(H2[(size_t)n * D + k]), 0.f, 0.f); chk(ws, 33, bf2f(HS[(size_t)rec.y * D + k]), bf2f(H2[(size_t)n * D + k]), 0.f, 0.f); } }
    { const unsigned hh = hsh(12000 + F.wave * 64 + lane); const int e = hh & 31, n = (hh >> 5) & 1023, k = (hh >> 15) & 1023, k5 = k & 511;
        const int c = (n >> 3) * 4 + (n & 3); const float want = (n & 4) ? A.w_up3[((size_t)e * D + k) * DE + c] : A.w_up1[((size_t)e * D + k) * DE + c];
        chk(ws, 34, bf2f(((const bf16*)(ws + WS_WUP))[((size_t)e * 1024 + n) * D + k]), bfr(want), 0.f, 0.f);
        chk(ws, 35, bf2f(((const bf16*)(ws + WS_WDN))[((size_t)e * 1024 + n) * DE + k5]), bfr(A.w_down[((size_t)e * DE + k5) * D + n]), 0.f, 0.f); }
}
DI void chk_p12(const Frame& F, ARef A) {
    unsigned char* ws = A.ws; const int lane = F.lane; const i32x4* tok = (const i32x4*)(ws + WS_TOK); const int* tile = (const int*)(ws + WS_TILE);
    const bf16* H2 = (const bf16*)(ws + WS_H2); const bf16* HID = (const bf16*)(ws + WS_HID);
    for (int s = F.wave; s < 32; s += NWAVES) { const unsigned hh = hsh(13000 + s); const int n = hh % NTOK, c = (hh >> 16) & 511; const i32x4 rec = tok[n]; const int pos = (s & 1) ? rec.y : rec.x;
        const int e = tile[pos >> 8];
        const float u1 = wdot(H2 + (size_t)n * D, A.w_up1 + (size_t)e * D * DE, DE, c, D, lane), u3 = wdot(H2 + (size_t)n * D, A.w_up3 + (size_t)e * D * DE, DE, c, D, lane);
        chk(ws, 36, bf2f(HID[(size_t)pos * DE + c]), u1 / (1.0f + expf(-u1)) * u3, 0.04f, 0.01f); }
}
DI void chk_p13(const Frame& F, ARef A) {
    unsigned char* ws = A.ws; const int lane = F.lane; const i32x4* tok = (const i32x4*)(ws + WS_TOK); const int* tile = (const int*)(ws + WS_TILE);
    const bf16* HID = (const bf16*)(ws + WS_HID); const bf16* YE = (const bf16*)(ws + WS_HS);
    for (int s = F.wave; s < 32; s += NWAVES) { const unsigned hh = hsh(14000 + s); const int n = hh % NTOK, c = (hh >> 16) & 1023; const i32x4 rec = tok[n]; const int pos = (s & 1) ? rec.y : rec.x;
        const int e = tile[pos >> 8];
        chk(ws, 37, bf2f(YE[(size_t)pos * D + c]), wdot(HID + (size_t)pos * DE, A.w_down + (size_t)e * DE * D, D, c, DE, lane), 0.04f, 0.01f); }
}
#endif

__global__ void __launch_bounds__(NTHR, 2) hybrid_fwd(Args A_unused) {
    extern __shared__ __attribute__((aligned(16))) unsigned char lds_raw[];
    const CAS Args& A = *(const CAS Args*)__builtin_amdgcn_kernarg_segment_ptr();
    Frame F;
    F.lds = (LAS unsigned char*)lds_raw;
    F.wave = __builtin_amdgcn_readfirstlane((int)threadIdx.x >> 6); F.tid = opq_tid(F.wave); F.lane = F.tid & 63;
    F.wg = blockIdx.x; F.G = gridDim.x; F.gw = F.wg * NWAVES + F.wave; F.NGW = F.G * NWAVES;
    volatile LAS unsigned* MISC = (volatile LAS unsigned*)(F.lds + LDS_MISC);
    if (F.wave == 0) MISC[F.lane] = 0u;
    __syncthreads();
    const XcdBarrier bar = xcd_barrier_post((unsigned*)(A.ws + WS_CTL), MISC + 8, F.wave);
    unsigned char* ws = A.ws;
    LAS unsigned char* stage = F.lds;
    bf16* const dob = (bf16*)A.out;
    bf16 *H1 = dob, *R = dob, *KS = dob + (size_t)NTOK * BW, *V = dob + 2 * (size_t)NTOK * BW, *KK = dob + 3 * (size_t)NTOK * BW;

#if defined(STAMPS)
    unsigned long long* const tsp = (unsigned long long*)(ws + WS_CTL + 49152);
#define STAMP(k) do { if (F.wg == 0 && xb_t0(F.wave)) tsp[k] = wall_clock64(); } while (0)
#else
#define STAMP(k) do { } while (0)
#endif
#if defined(REPEAT_PHASE)
#ifndef REPEAT_COUNT
#define REPEAT_COUNT 2
#endif
#define REP(k) _Pragma("nounroll") for (int rep_ = 0; rep_ < ((k) == REPEAT_PHASE ? REPEAT_COUNT : 1); ++rep_)
#else
#define REP(k)
#endif
    STAMP(0);
    REP(0) {
    p0_prologue(F, A);
    xcd_barrier(bar);
    }
    STAMP(1);
#if defined(CHECKS)
    if (F.wg == 0) chk_p0(F, A);
#endif
    REP(1) {
    p1_h1(F, A, H1);
    xcd_barrier(bar);
    }
    STAMP(2);
#if defined(CHECKS)
    if (F.wg == 0) chk_p1(F, A, H1);
#endif
    REP(2) {
    {   pg8::Gemm g{H1, (const bf16*)(ws + WS_WIN), NTOK, NPAD, D}; pg8::StaticOrder S; S.init(NTOK, NPAD, F.G, F.wg);
        EpiIn E{(bf16*)(ws + WS_QB), (bf16*)(ws + WS_KB), (bf16*)(ws + WS_VT), (bf16*)(ws + WS_RWRAW), (bf16*)(ws + WS_LORA), (bf16*)(ws + WS_GATE), A.gate_bias};
        pg8::gemm_phase<EpiIn, pg8::StaticOrder>(stage, g, S, E, nullptr, F.wave); }
    xcd_barrier(bar);
    }
    STAMP(3);
#if defined(CHECKS)
    if (F.wg == 0) { chk_p2(F, A, H1); chk_p3_save(F, A); }
    xcd_barrier(bar);
#endif
#if !defined(CHECKS)
    const bool fuse34 = (F.G == 256);
#else
    const bool fuse34 = false;
#endif
    REP(3) {
    p3_attn(F, (const bf16*)(ws + WS_QB), (const bf16*)(ws + WS_KB), (const bf16*)(ws + WS_VT), (bf16*)(ws + WS_QB));
#if defined(STAMPS)
    STAMP(20);
#endif
    p3_prep(F, A, (const bf16*)(ws + WS_RWRAW), (const bf16*)(ws + WS_LORA), R, KS, V, KK, (bf16*)(ws + WS_ALORA));
#if !defined(CHECKS)
    if (fuse34) { asm volatile("s_waitcnt vmcnt(0)" ::: "memory"); __syncthreads();
        p4_lora(F, A, (const bf16*)(ws + WS_ALORA), (const bf16*)(ws + WS_WL), (bf16*)(ws + WS_E), KS, (bf16*)(ws + WS_B), (bf16*)(ws + WS_GG), KK, R, (float*)(ws + WS_BON)); }
#endif
    xcd_barrier(bar);
    }
#if defined(STAMPS)
    STAMP(21);
#endif
    STAMP(4);
#if defined(CHECKS)
    if (F.wg == 0) { chk_p3(F, A, R, KS, V, KK); chk_p4_save(F, A, KS); }
    xcd_barrier(bar);
#endif
    if (!fuse34) {
    p4_lora(F, A, (const bf16*)(ws + WS_ALORA), (const bf16*)(ws + WS_WL), (bf16*)(ws + WS_E), KS, (bf16*)(ws + WS_B), (bf16*)(ws + WS_GG), KK, R, (float*)(ws + WS_BON));
    xcd_barrier(bar);
    }
    STAMP(5);
#if defined(CHECKS)
    if (F.wg == 0) chk_p4(F, A, KS, KK);
#endif
    REP(5) {
    p5_mfma(ws, F, R, KS, V, KK, (const bf16*)(ws + WS_B), (const bf16*)(ws + WS_E), (bf16*)(ws + WS_P), (bf16*)(ws + WS_QO), (bf16*)(ws + WS_GT), (bf16*)(ws + WS_HT));
    p6_moe_weights(F, A, F.gw, F.NGW);
    xcd_barrier(bar);
    }
    STAMP(6);
#if defined(CHECKS)
    if (F.wg == 255) chk_p7_save(F, A);
#endif
    REP(6) {
    {   const int ncw = F.G < 64 ? F.G : 64;
        if (F.wg < ncw) { if (F.wave == 0) for (int task = F.wg; task < 64; task += ncw) p6_chain(task, F.wave, F.lds, (const bf16*)(ws + WS_GT), (const bf16*)(ws + WS_HT), (bf16*)(ws + WS_SC));
#if defined(STAMPS)
            STAMP(22);
#endif
        }
        else {
            pg8::StaticOrder S; S.init(NTOK, D, F.G - ncw, F.wg - ncw);
            pg8::Gemm g{(const bf16*)(ws + WS_QB), (const bf16*)(ws + WS_WOSB), NTOK, D, BW};
            EpiMerge<false> E{(bf16*)(ws + WS_GATE), (bf16*)(ws + WS_MRG), 0};
            pg8::gemm_phase<EpiMerge<false>, pg8::StaticOrder>(stage, g, S, E, nullptr, F.wave); }
    }
    xcd_barrier(bar);
    }
    STAMP(7);
    REP(7) {
    p7_mfma(F, A, (const bf16*)(ws + WS_SC), (const bf16*)(ws + WS_P), (const bf16*)(ws + WS_QO), V, (const bf16*)(ws + WS_GG), (const float*)(ws + WS_BON), (bf16*)(ws + WS_YRW));
    xcd_barrier(bar);
    }
    STAMP(8);
#if defined(CHECKS)
    if (F.wg == 0) chk_p7(F, A, R, KS, V, KK);
#endif
    REP(8) {
    {   pg8::StaticOrder S; S.init(NTOK, D, F.G, F.wg);
        {   pg8::Gemm g{(const bf16*)(ws + WS_YRW), (const bf16*)(ws + WS_WORW), NTOK, D, BW};
            EpiMerge<true> E{(bf16*)(ws + WS_GATE), (bf16*)(ws + WS_MRG), D};
            pg8::gemm_phase<EpiMerge<true>, pg8::StaticOrder>(stage, g, S, E, nullptr, F.wave); } }
    xcd_barrier(bar);
    }
    STAMP(9);
#if defined(CHECKS)
    if (F.wg == 0) chk_p8(F, A);
#endif
    REP(9) {
    {   pg8::Gemm g{(const bf16*)(ws + WS_MRG), (const bf16*)(ws + WS_WOUT), NTOK, D, D}; pg8::StaticOrder S; S.init(NTOK, D, F.G, F.wg);
        EpiPlain E{(bf16*)(ws + WS_Y1), D, 0xff};
        pg8::gemm_phase<EpiPlain, pg8::StaticOrder>(stage, g, S, E, nullptr, F.wave); }
    xcd_barrier(bar);
    }
    STAMP(10);
#if defined(CHECKS)
    if (F.wg == 0) chk_p9(F, A);
#endif
    REP(10) {
    p10_rows(F, A, (const bf16*)(ws + WS_Y1), (bf16*)(ws + WS_H2));
    xcd_barrier(bar);
    }
    STAMP(11);
#if defined(CHECKS)
    if (F.wg == 0) chk_p10(F, A);
#endif
    REP(11) {
    p11_rank_gather(F, A, (const bf16*)(ws + WS_H2), (bf16*)(ws + WS_HS));
    xcd_barrier(bar);
    }
    STAMP(12);
#if defined(CHECKS)
    if (F.wg == 0) chk_p11(F, A);
#endif
    {   const int* tile = (const int*)(ws + WS_TILE);
        const int nt = __builtin_amdgcn_readfirstlane(tile[MAXT]);
        const int vc = (F.G % 8 == 0) ? (F.wg % 8) * (F.G / 8) + F.wg / 8 : F.wg;
        unsigned* tcnt = (unsigned*)(ws + WS_CTL) + MOE_CNT_WORD;
        REP(12) {   pg8::Gemm g{(const bf16*)(ws + WS_HS), (const bf16*)(ws + WS_WUP), MAXT * 256, NE * 1024, D};
            MoeUpOrder S; S.nunits = nt * 4; S.G = F.G; S.vc = vc; S.tile_e = tile; S.cnt = tcnt;
            EpiUp E{(bf16*)(ws + WS_HID)};
            pg8::gemm_phase<EpiUp, MoeUpOrder>(stage, g, S, E, nullptr, F.wave); }
        __syncthreads();
    STAMP(13);
        REP(13) {   pg8::Gemm g{(const bf16*)(ws + WS_HID), (const bf16*)(ws + WS_WDN), MAXT * 256, NE * 1024, DE};
            MoeDnOrder S; S.nunits = nt * 4; S.G = F.G; S.vc = vc; S.q = (nt * 4) / F.G; S.rem = nt * 4 - S.q * F.G; S.wave = F.wave; S.tile_e = tile; S.cnt = tcnt;
            EpiPlain E{(bf16*)(ws + WS_HS), D, 3};
            pg8::gemm_phase<EpiPlain, MoeDnOrder>(stage, g, S, E, nullptr, F.wave);
        xcd_barrier(bar); } }
    STAMP(14);
#if defined(CHECKS)
    if (F.wg == 0) chk_p13(F, A);
#endif
    p14_final(F, A, (const bf16*)(ws + WS_HS));
#if defined(STAMPS)
    xcd_barrier(bar);
    STAMP(15);
    if (F.wg == 0) { __syncthreads();
        const float va = (float)(long long)(tsp[STAMP_A2] - tsp[STAMP_A]) * 0.01f, vb = (float)(long long)(tsp[STAMP_B2] - tsp[STAMP_B]) * 0.01f;
#if defined(STAMP_SHIFT)
        const float shf_ = 1.1f;
#else
        const float shf_ = 1.0f;
#endif
        int b1 = (int)floorf(logf(fmaxf(va * shf_, 1.0f)) / logf(1.21f)) + 1, b2 = (int)floorf(logf(fmaxf(vb * shf_, 1.0f)) / logf(1.21f)) + 1;
#if defined(STAMP_CAL)
        b1 = 10; b2 = 30;
#endif
#if defined(STAMP_FRAC)
        { const unsigned long long* t5 = tsp + 32; const float tot = (float)(long long)(t5[9] - t5[0]);
          b1 = (int)(12.0f * (float)(long long)(t5[STAMP_A2] - t5[STAMP_A]) / tot) + 3; b2 = (int)(12.0f * (float)(long long)(t5[STAMP_B2] - t5[STAMP_B]) / tot) + 3; }
#endif
#if defined(STAMP_THR_A)
        b1 = va > (float)(STAMP_THR_A) ? 30 : 10; b2 = vb > (float)(STAMP_THR_B) ? 30 : 10;
#endif
        const int t_ = opq_tid(F.wave);
        for (int i = t_; i < 1000; i += NTHR) A.out[1000 + i] += 20.0f * (float)b2;
        if (t_ == 0) A.out[0] = 200.0f * (float)b1; }
#endif
#if defined(CHECKS)
    xcd_barrier(bar);
    if (F.wg == 0 && F.tid == 0) { const unsigned* fl = chk_flags(ws); int id = 0; for (int i = 61; i >= 0; --i) if (fl[i]) id = i;
        if (((const unsigned*)(ws + WS_CTL))[XB_TMO]) id = 60;
        if (id) A.out[0] = 10.0f * (float)id;
#if defined(CHKVAL)
        A.out[0] = 1000.0f * ((const float*)fl)[CHKVAL];
#endif
        }
#endif
}

extern "C" void kernel_launch(void* const* d_in, const int* in_sizes, int n_in, void* d_out, int out_size, void* d_ws, size_t ws_size, hipStream_t stream) {
    static int grid = 0;
    if (grid == 0) {
        if (n_in != 26 || in_sizes[0] != NTOK * D || out_size != NTOK * D || ws_size < WS_END) {
            fprintf(stderr, "kernel_launch: unexpected shapes (n_in %d, in0 %d, out %d, ws %zu); nothing launched\n", n_in, n_in > 0 ? in_sizes[0] : -1, out_size, ws_size); grid = -1; return; }
        int dev = 0, cus = 0, per_cu = 0;
        if (hipGetDevice(&dev) != hipSuccess || hipDeviceGetAttribute(&cus, hipDeviceAttributeMultiprocessorCount, dev) != hipSuccess) { grid = -1; return; }
        if (hipFuncSetAttribute((const void*)hybrid_fwd, hipFuncAttributeMaxDynamicSharedMemorySize, LDS_BYTES) != hipSuccess) { fprintf(stderr, "kernel_launch: hipFuncSetAttribute failed\n"); grid = -1; return; }
        if (hipOccupancyMaxActiveBlocksPerMultiprocessor(&per_cu, (const void*)hybrid_fwd, NTHR, LDS_BYTES) != hipSuccess || per_cu < 1)
            fprintf(stderr, "kernel_launch: note: occupancy query reports %d workgroups per CU\n", per_cu);
        (void)hipGetLastError();
        grid = cus > 256 ? 256 : cus;
    }
    if (grid < 0) return;
    if (hipMemsetAsync((char*)d_ws + WS_CTL, 0, CTL_ZERO_BYTES, stream) != hipSuccess) return;
    Args a{};
    const float** p = (const float**)&a;
    for (int i = 0; i < 26; ++i) p[i] = (const float*)d_in[i];
    a.out = (float*)d_out; a.ws = (unsigned char*)d_ws;
    hipLaunchKernelGGL(hybrid_fwd, dim3(grid), dim3(NTHR), LDS_BYTES, stream, a);
}

#if defined(ONLY_P5)
__global__ void __launch_bounds__(NTHR, 2) only_p5(Args A_unused) {
    extern __shared__ __attribute__((aligned(16))) unsigned char lds_raw[];
    const CAS Args& A = *(const CAS Args*)__builtin_amdgcn_kernarg_segment_ptr();
    Frame F; F.lds = (LAS unsigned char*)lds_raw; F.wave = __builtin_amdgcn_readfirstlane((int)threadIdx.x >> 6); F.tid = opq_tid(F.wave); F.lane = F.tid & 63;
    F.wg = blockIdx.x; F.G = gridDim.x; F.gw = F.wg * NWAVES + F.wave; F.NGW = F.G * NWAVES;
    unsigned char* ws = A.ws; bf16* const dob = (bf16*)A.out;
    bf16 *R = dob, *KS = dob + (size_t)NTOK * BW, *V = dob + 2 * (size_t)NTOK * BW, *KK = dob + 3 * (size_t)NTOK * BW;
    p5_mfma(ws, F, R, KS, V, KK, (const bf16*)(ws + WS_B), (const bf16*)(ws + WS_E), (bf16*)(ws + WS_P), (bf16*)(ws + WS_QO), (bf16*)(ws + WS_GT), (bf16*)(ws + WS_HT));
}
#endif
```

```cpp
#include <hip/hip_runtime.h>
#include <cstdio>
#include <cstdint>
__device__ __forceinline__ int opq_tid(int wave) { int l; asm volatile("v_mbcnt_lo_u32_b32 %0, -1, 0\n\tv_mbcnt_hi_u32_b32 %0, -1, %0" : "=v"(l)); return wave * 64 + l; }
#ifndef PHMASK
#define PHMASK 0xffff
#endif
namespace pg8 {
#define PG8_LAS __attribute__((address_space(3)))
typedef unsigned short bf16_t;
typedef short bf16x8 __attribute__((ext_vector_type(8)));
typedef float f32x4 __attribute__((ext_vector_type(4)));
typedef unsigned u32x4 __attribute__((ext_vector_type(4)));
constexpr int BM = 256, BK = 64, HALF = 128, HTB = HALF * BK * 2  , STAGE_BYTES = 8 * HTB, NXCD = 8, WGM = 8;

__host__ __device__ __forceinline__ int lds_byte(int r, int c) { const int st = (r >> 4) * 2 + (c >> 5), rr = r & 15, cc = c & 31, ob = rr * 64 + cc * 2; return st * 1024 + (ob ^ (((ob >> 9) & 1) << 5)); }
__host__ __device__ __forceinline__ void stage_rc(int b, int& R, int& C) { const int st = b / 1024, sb = b % 1024, swz = sb ^ (((sb >> 9) & 1) << 5); R = (st >> 1) * 16 + swz / 64; C = (st & 1) * 32 + (swz % 64) / 2; }
__host__ __device__ __forceinline__ int perm32(int rho) { const int n = rho >> 4, i = rho & 15; return 8 * (i >> 2) + 4 * n + (i & 3); }

struct Unit { int pm, pn; };
struct Gemm { const bf16_t* A; const bf16_t* Bt; int M, N, K; };

struct StaticOrder {
    int nM, nN, nwg, G, c;
    __host__ __device__ void init(int M, int N, int G_, int c_) { nM = M / BM; nN = N / BM; nwg = nM * nN; G = G_; c = c_; }
    __host__ __device__ bool next(int i, Unit& u) const {
        const long L = (long)i * G + c; if (L >= nwg) return false;
        int wgid = (int)L; { const int q = nwg / NXCD, r = nwg % NXCD, xcd = wgid % NXCD, off = wgid / NXCD; wgid = (xcd < r ? xcd * (q + 1) : r * (q + 1) + (xcd - r) * q) + off; }
        const int nig = WGM * nN, gid = wgid / nig, fm = gid * WGM, gsz = (nM - fm) < WGM ? (nM - fm) : WGM;
        u.pm = fm + ((wgid % nig) % gsz); u.pn = (wgid % nig) / gsz; return true;
    }
    __device__ __forceinline__ void a_ready(const Unit&) const {}
    __device__ __forceinline__ void done(const Unit&) const {}
};

template <class Epi, class Sched, bool STAMP = false>
__device__ __forceinline__ void gemm_phase(PG8_LAS unsigned char* lds, const Gemm g, const Sched& S, const Epi& E, unsigned long long* stamps, int wave_id) {
    const int tid = opq_tid(wave_id), wid = __builtin_amdgcn_readfirstlane(tid >> 6), lane = tid & 63, wr = wid >> 2, wc = wid & 3, fr = lane & 15, fq = lane >> 4;
    const int K = g.K, nt = K / BK;
    int ts_lo = 0, ts_hi = 0, nts = 0; const unsigned long long rt_entry = STAMP ? (unsigned long long)wall_clock64() : 0ull;
#define PG8_STAMP() do { if (STAMP && wid == 0 && nts < 64) { const unsigned long long _c = (unsigned long long)clock64(); \
        ts_lo = (lane == nts) ? (int)(unsigned)_c : ts_lo; ts_hi = (lane == nts) ? (int)(unsigned)(_c >> 32) : ts_hi; ++nts; } } while (0)
    PG8_STAMP();
    unsigned voffA[2], voffB[2];
#pragma unroll
    for (int i = 0; i < 2; ++i) { int R, C; stage_rc(tid * 16 + i * 8192, R, C); const int Rb = Epi::PERM ? ((R & ~31) + perm32(R & 31)) : R;
        voffA[i] = (unsigned)(R * K + C) * 2u; voffB[i] = (unsigned)(Rb * K + C) * 2u; }
    const size_t kstep = (size_t)(BK * 2);
    const size_t hstep = (size_t)HALF * K * 2;
    const size_t tstep = 2 * hstep;
    const unsigned ldsw = (unsigned)wid * 1024u;
    const int aoff = lds_byte(wr * 64 + fr, fq * 8), boff = lds_byte(wc * 32 + fr, fq * 8);
#define PG8_SA(b, h) (((b) * 2 + (h)) * HTB)
#define PG8_SB(b, h) ((4 + (b) * 2 + (h)) * HTB)
#define PG8_STAGE(bufoff, gbase, voff) do { _Pragma("unroll") for (int _i = 0; _i < 2; ++_i) \
        __builtin_amdgcn_global_load_lds((const unsigned*)((const char*)(gbase) + (voff)[_i]), (PG8_LAS unsigned*)(lds + (bufoff) + ldsw + _i * 8192), 16, 0, 0); } while (0)
#define PG8_LDA(dst, b, h) do { _Pragma("unroll") for (int m = 0; m < 4; ++m) _Pragma("unroll") for (int k = 0; k < 2; ++k) dst[m][k] = *(const PG8_LAS bf16x8*)(lds + PG8_SA(b, h) + aoff + m * 2048 + k * 1024); } while (0)
#define PG8_LDB(dst, b, h) do { _Pragma("unroll") for (int n = 0; n < 2; ++n) _Pragma("unroll") for (int k = 0; k < 2; ++k) dst[n][k] = *(const PG8_LAS bf16x8*)(lds + PG8_SB(b, h) + boff + n * 2048 + k * 1024); } while (0)
#define PG8_MMA(ai, bj, At, Bt) do { __builtin_amdgcn_s_setprio(1); _Pragma("unroll") for (int m = 0; m < 4; ++m) _Pragma("unroll") for (int n = 0; n < 2; ++n) _Pragma("unroll") for (int k = 0; k < 2; ++k) \
        acc[ai][bj][m][n] = __builtin_amdgcn_mfma_f32_16x16x32_bf16(Bt[n][k], At[m][k], acc[ai][bj][m][n], 0, 0, 0); __builtin_amdgcn_s_setprio(0); } while (0)
#define PG8_WAIT_V(n) asm volatile("s_waitcnt vmcnt(" #n ")" ::: "memory")
#define PG8_WAIT_L(n) asm volatile("s_waitcnt lgkmcnt(" #n ")" ::: "memory")
#define PG8_BAR __builtin_amdgcn_s_barrier()
#define PG8_SCHED __builtin_amdgcn_sched_barrier(0)
    Unit cur, nxt; int ui = 0;
    if (!S.next(0, cur)) return;
    f32x4 acc[2][2][4][2];
#pragma unroll
    for (int a = 0; a < 2; ++a)
#pragma unroll
        for (int b = 0; b < 2; ++b)
#pragma unroll
            for (int m = 0; m < 4; ++m)
#pragma unroll
                for (int n = 0; n < 2; ++n) acc[a][b][m][n] = (f32x4){0.f, 0.f, 0.f, 0.f};
    bf16x8 At[4][2], B0[2][2], B1[2][2];
    const char* cA = (const char*)g.A + (size_t)cur.pm * tstep; const char* cB = (const char*)g.Bt + (size_t)cur.pn * tstep;
    S.a_ready(cur);
    PG8_STAGE(PG8_SB(0, 0), cB, voffB); PG8_STAGE(PG8_SA(0, 0), cA, voffA); PG8_STAGE(PG8_SB(0, 1), cB + hstep, voffB); PG8_STAGE(PG8_SA(0, 1), cA + hstep, voffA);
    if (wr == 1) PG8_BAR;
    PG8_WAIT_V(4); PG8_BAR;
    PG8_STAGE(PG8_SB(1, 0), cB + kstep, voffB); PG8_STAGE(PG8_SA(1, 0), cA + kstep, voffA); PG8_STAGE(PG8_SB(1, 1), cB + hstep + kstep, voffB);
    PG8_WAIT_V(6); PG8_BAR;
    PG8_STAMP();
    for (;;) {
        const bool has_next = S.next(ui + 1, nxt);
        const char* nA = has_next ? (const char*)g.A + (size_t)nxt.pm * tstep : cA; const char* nB = has_next ? (const char*)g.Bt + (size_t)nxt.pn * tstep : cB;
        for (int t = 0; t < nt; t += 2) {
            const bool last = (t == nt - 2);
            const char* a1 = cA + (size_t)(t + 1) * kstep;
            const char* a2 = last ? nA : cA + (size_t)(t + 2) * kstep; const char* b2 = last ? nB : cB + (size_t)(t + 2) * kstep;
            const char* a3 = a2 + kstep; const char* b3 = b2 + kstep;
            if (last && has_next) S.a_ready(nxt);
            PG8_LDB(B0, 0, 0); PG8_SCHED; PG8_LDA(At, 0, 0); PG8_STAGE(PG8_SA(1, 1), a1 + hstep, voffA);
            PG8_WAIT_L(8); PG8_BAR; PG8_WAIT_L(0); PG8_MMA(0, 0, At, B0); PG8_BAR; PG8_SCHED;
            PG8_LDB(B1, 0, 1); PG8_STAGE(PG8_SB(0, 0), b2, voffB);
            PG8_BAR; PG8_WAIT_L(0); PG8_MMA(0, 1, At, B1); PG8_BAR;
            PG8_LDA(At, 0, 1); PG8_STAGE(PG8_SA(0, 0), a2, voffA);
            PG8_BAR; PG8_WAIT_L(0); PG8_MMA(1, 0, At, B0); PG8_BAR; PG8_SCHED;
            PG8_STAGE(PG8_SB(0, 1), b2 + hstep, voffB);
            PG8_WAIT_V(6); PG8_BAR; PG8_MMA(1, 1, At, B1); PG8_BAR;
            PG8_LDB(B0, 1, 0); PG8_SCHED; PG8_LDA(At, 1, 0); PG8_STAGE(PG8_SA(0, 1), a2 + hstep, voffA);
            PG8_WAIT_L(8); PG8_BAR; PG8_WAIT_L(0); PG8_MMA(0, 0, At, B0); PG8_BAR; PG8_SCHED;
            PG8_LDB(B1, 1, 1); PG8_STAGE(PG8_SB(1, 0), b3, voffB);
            PG8_BAR; PG8_WAIT_L(0); PG8_MMA(0, 1, At, B1); PG8_BAR;
            PG8_LDA(At, 1, 1); PG8_STAGE(PG8_SA(1, 0), a3, voffA);
            PG8_BAR; PG8_WAIT_L(0); PG8_MMA(1, 0, At, B0); PG8_BAR; PG8_SCHED;
            PG8_STAGE(PG8_SB(1, 1), b3 + hstep, voffB);
            PG8_WAIT_V(6); PG8_BAR; PG8_MMA(1, 1, At, B1); PG8_BAR;
        }
        PG8_STAMP();
        if constexpr (!Epi::AFTER_DRAIN) { E(acc, cur, wr, wc, fr, fq); S.done(cur); }
        PG8_STAMP();
        if (!has_next) break;
#pragma unroll
        for (int a = 0; a < 2; ++a)
#pragma unroll
            for (int b = 0; b < 2; ++b)
#pragma unroll
                for (int m = 0; m < 4; ++m)
#pragma unroll
                    for (int n = 0; n < 2; ++n) acc[a][b][m][n] = (f32x4){0.f, 0.f, 0.f, 0.f};
        cur = nxt; cA = nA; cB = nB; ++ui;
    }
    PG8_WAIT_V(0);
    if (wr == 0) PG8_BAR;
    PG8_BAR;
    if constexpr (Epi::AFTER_DRAIN) { E.fused(acc, cur, wr, wc, fr, fq, lds, wid, lane); S.done(cur); }
    PG8_STAMP();
    if (STAMP && wid == 0) { stamps[lane] = lane < nts ? (((unsigned long long)(unsigned)ts_hi << 32) | (unsigned)ts_lo) : 0ull;
        if (lane == 62) stamps[62] = rt_entry; if (lane == 63) stamps[63] = (unsigned long long)wall_clock64(); }
#undef PG8_STAMP
#undef PG8_SA
#undef PG8_SB
#undef PG8_STAGE
#undef PG8_LDA
#undef PG8_LDB
#undef PG8_MMA
#undef PG8_WAIT_V
#undef PG8_WAIT_L
#undef PG8_BAR
#undef PG8_SCHED
}
}

#define XB_TMO      128
#define XB_XCNT(j)  (256  + 64 * (j))
#define XB_XSUB(j)  (1280 + 64 * (j))
#define XB_XGEN(j)  (2304 + 64 * (j))
#define XB_TOP      3328
#define XB_TOPGEN   3392
#define XCD_BAR_WORDS 3456
#define XB_SPIN_CAP (1u << 18)
#define LAS __attribute__((address_space(3)))

__device__ __forceinline__ unsigned xb_ld(unsigned* p)              { return __hip_atomic_load(p, __ATOMIC_RELAXED, __HIP_MEMORY_SCOPE_AGENT); }
__device__ __forceinline__ unsigned xb_add(unsigned* p, unsigned v) { return __hip_atomic_fetch_add(p, v, __ATOMIC_RELAXED, __HIP_MEMORY_SCOPE_AGENT); }
__device__ __forceinline__ unsigned xb_xcc_id() { return (unsigned)__builtin_amdgcn_s_getreg((3 << 11) | 20) & 0xFu; }
#define XB_SPIN(cond, bar) do { unsigned _sp = 0; while (cond) { __builtin_amdgcn_s_sleep(1); \
    if ((++_sp & 255u) == 0u) { if (xb_ld(&(bar)[XB_TMO])) break; if (_sp > XB_SPIN_CAP) { atomicAdd(&(bar)[XB_TMO], 1u); break; } } } } while (0)

struct XcdBarrier {
    unsigned* bar; unsigned x; int wave;
    volatile LAS unsigned* st;
};

__device__ __forceinline__ bool xb_t0(int wave) { return wave == 0 && __builtin_amdgcn_mbcnt_hi(~0u, __builtin_amdgcn_mbcnt_lo(~0u, 0u)) == 0u; }
__device__ __forceinline__ XcdBarrier xcd_barrier_post(unsigned* bar, volatile LAS unsigned* st, int wave) {
    XcdBarrier b; b.bar = bar; b.x = xb_xcc_id(); b.st = st; b.wave = wave;
    if (xb_t0(wave)) (void)xb_add(&bar[XB_XCNT(b.x)], 1u);
    return b;
}
__device__ __forceinline__ void xcd_barrier_complete(unsigned* bar, unsigned x, unsigned& nloc, unsigned& nx) {
    const unsigned G = gridDim.x * gridDim.y * gridDim.z;
    unsigned sum, cnt, mine, sp = 0u;
    for (;;) {
        sum = 0u; cnt = 0u; mine = 0u;
#pragma unroll
        for (unsigned j = 0; j < 16; ++j) { const unsigned c = xb_ld(&bar[XB_XCNT(j)]); sum += c; cnt += (c > 0u) ? 1u : 0u; mine = (j == x) ? c : mine; }
        if (sum == G) break;
        __builtin_amdgcn_s_sleep(1);
        if ((++sp & 255u) == 0u) { if (xb_ld(&bar[XB_TMO])) break; if (sp > XB_SPIN_CAP) { atomicAdd(&bar[XB_TMO], 1u); break; } }
    }
    nloc = mine > 0u ? mine : 1u; nx = cnt > 0u ? cnt : 1u;
}

__device__ __forceinline__ void xcd_barrier(const XcdBarrier& b) {
    asm volatile("s_waitcnt vmcnt(0)" ::: "memory");
    __syncthreads();
    if (xb_t0(b.wave)) {
        unsigned* bar = b.bar;
        __builtin_amdgcn_s_waitcnt(0);
        unsigned nloc = b.st[0], nx = b.st[1];
        if (nloc == 0u) { xcd_barrier_complete(bar, b.x, nloc, nx); b.st[0] = nloc; b.st[1] = nx; }
        const unsigned old = xb_add(&bar[XB_XSUB(b.x)], 1u);
        const unsigned gen = old / nloc;
        if (old + 1u == (gen + 1u) * nloc) {
            __builtin_amdgcn_fence(__ATOMIC_RELEASE, "agent");
            asm volatile("s_waitcnt vmcnt(0)" ::: "memory");
            const unsigned og = xb_add(&bar[XB_TOP], 1u);
            const unsigned tg = og / nx;
            if (og + 1u == (tg + 1u) * nx) xb_add(&bar[XB_TOPGEN], 1u);
            else XB_SPIN(xb_ld(&bar[XB_TOPGEN]) == tg, bar);
            __builtin_amdgcn_fence(__ATOMIC_ACQUIRE, "agent");
            xb_add(&bar[XB_XGEN(b.x)], 1u);
            asm volatile("s_waitcnt vmcnt(0)" ::: "memory");
        } else {
            XB_SPIN(xb_ld(&bar[XB_XGEN(b.x)]) == gen, bar);
            __builtin_amdgcn_fence(__ATOMIC_ACQUIRE, "agent");
            asm volatile("s_waitcnt vmcnt(0)" ::: "memory");
        }
    }
    __syncthreads();
}


constexpr int NB = 4, SEQ = 8192, D = 1024, NTOK = NB * SEQ;
constexpr int NH = 8, HD = 64, BW = 512;
constexpr int IN_COLS = 5408, NPAD = 5632;
constexpr int LK = 384;
constexpr int NE = 32, DE = 512;
constexpr int CH = 64, NCH = SEQ / CH, NCH_LOG = 7, NCHUNK = NB * NH * NCH;
constexpr int MAXT = 288;
constexpr float NORM_EPS = 1e-6f, GN_EPS = 64e-5f, L2_EPS = 1e-12f;
constexpr float SB_STOP = -120.0f;

constexpr size_t MiB = 1u << 20;
constexpr size_t WS_CTL = 0, CTL_ZERO_BYTES = 65536;
constexpr size_t WS_MOD = 1 * MiB;
constexpr size_t WS_RTW = WS_MOD + 128 * 1024;
constexpr size_t WS_TOK = WS_RTW + 160 * 1024;
constexpr size_t WS_CNT = WS_TOK + (size_t)NTOK * 16;
constexpr size_t WS_TILE = WS_CNT + 256 * 32 * 4;
constexpr size_t WS_WIN = 2 * MiB;
constexpr size_t WS_WOSB = 13 * MiB, WS_WORW = 14 * MiB, WS_WOUT = 15 * MiB;
constexpr size_t WS_WL = 17 * MiB;
constexpr size_t WS_BON = 18 * MiB + 256 * 1024;
constexpr size_t WS_CW = 19 * MiB + 768 * 1024;
constexpr size_t WS_QB = 20 * MiB;
constexpr size_t WS_GATE = 52 * MiB;
constexpr size_t WS_GG = 180 * MiB;
constexpr size_t WS_KB = 212 * MiB, WS_VT = 244 * MiB;
constexpr size_t WS_LORA = 276 * MiB;
constexpr size_t WS_ALORA = 308 * MiB;
constexpr size_t WS_E = 340 * MiB, WS_B = 372 * MiB;
constexpr size_t WS_RWRAW = 416 * MiB;
constexpr size_t WS_P = 212 * MiB, WS_QO = 244 * MiB;
constexpr size_t WS_GT = 276 * MiB;
constexpr size_t WS_HT = 308 * MiB;
constexpr size_t WS_SC = 340 * MiB;
constexpr size_t WS_YRW = 384 * MiB;
constexpr size_t WS_WUP = 416 * MiB, WS_WDN = 480 * MiB;
constexpr size_t WS_MRG = 212 * MiB;
constexpr size_t WS_Y1 = 276 * MiB;
constexpr size_t WS_H2 = 52 * MiB;
constexpr size_t WS_HS = 116 * MiB;
constexpr size_t WS_HID = 260 * MiB;
constexpr size_t WS_X1 = 340 * MiB;
constexpr size_t WS_END = 512 * MiB;
static_assert(WS_TILE + (MAXT + 1) * 4 <= WS_WIN && WS_WIN + (size_t)NPAD * D * 2 <= WS_WOSB && WS_WL + 1536 * LK * 2 <= WS_QB, "fixed region");
static_assert(WS_HS + (size_t)MAXT * 256 * D * 2 <= WS_HID && WS_HID + (size_t)MAXT * 256 * DE * 2 <= WS_WUP, "moe region");
static_assert(WS_ALORA + (size_t)NTOK * LK * 2 <= WS_E && WS_B + (size_t)NTOK * BW * 2 <= WS_RWRAW, "rwkv region");

constexpr int LDS_BYTES = 163840;
constexpr int LDS_MISC = LDS_BYTES - 256;
constexpr int NWAVES = 8, NTHR = 512;

typedef unsigned short bf16;
typedef short bf16x8 __attribute__((ext_vector_type(8)));
typedef short s16x4 __attribute__((ext_vector_type(4)));
typedef float f32x4 __attribute__((ext_vector_type(4)));
typedef float f32x16 __attribute__((ext_vector_type(16)));
typedef unsigned u32x4 __attribute__((ext_vector_type(4)));
typedef unsigned u32x2 __attribute__((ext_vector_type(2)));
typedef int i32x4 __attribute__((ext_vector_type(4)));
#define DI __device__ __forceinline__
#define GAS __attribute__((address_space(1)))
#define MFMA32(a, b, c) __builtin_amdgcn_mfma_f32_32x32x16_bf16((a), (b), (c), 0, 0, 0)

typedef float f32x2_t __attribute__((ext_vector_type(2))); typedef __bf16 bf16x2_t __attribute__((ext_vector_type(2)));
DI unsigned pk2(float lo, float hi) { f32x2_t v = {lo, hi}; return __builtin_bit_cast(unsigned, __builtin_convertvector(v, bf16x2_t)); }
DI unsigned f2bf(float f) { return pk2(f, 0.0f) & 0xffffu; }
DI float bflo(unsigned u) { return __builtin_bit_cast(float, u << 16); }
DI float bfhi(unsigned u) { return __builtin_bit_cast(float, u & 0xffff0000u); }
DI float bf2f(bf16 h) { return __builtin_bit_cast(float, (unsigned)h << 16); }
DI float fexp(float x) { return __expf(x); }
DI float frcp(float x) { return __builtin_amdgcn_rcpf(x); }
DI float fsigmoid(float x) { return frcp(1.0f + fexp(-x)); }
DI float fsoftplus(float x) { return fmaxf(x, 0.0f) + __logf(1.0f + fexp(-fabsf(x))); }
#define DPP_SHR(v, ctrl) __builtin_bit_cast(float, __builtin_amdgcn_update_dpp(0, __builtin_bit_cast(int, (v)), (ctrl), 0xf, 0xf, true))
DI float wave_sum(float v) {
    v += DPP_SHR(v, 0x111); v += DPP_SHR(v, 0x112); v += DPP_SHR(v, 0x114); v += DPP_SHR(v, 0x118);
    v += __builtin_bit_cast(float, __builtin_amdgcn_update_dpp(0, __builtin_bit_cast(int, v), 0x142, 0xa, 0xf, false));
    v += __builtin_bit_cast(float, __builtin_amdgcn_update_dpp(0, __builtin_bit_cast(int, v), 0x143, 0xc, 0xf, false));
    return __builtin_bit_cast(float, __builtin_amdgcn_readlane(__builtin_bit_cast(int, v), 63));
}
DI float shfl_xor_l(float v, int m, int lane) { return __builtin_bit_cast(float, __builtin_amdgcn_ds_bpermute(4 * (lane ^ m), __builtin_bit_cast(int, v))); }
DI int crow(int reg, int hh) { return (reg & 3) + 8 * (reg >> 2) + 4 * hh; }
DI void wave_lds_fence() { __builtin_amdgcn_fence(__ATOMIC_RELEASE, "wavefront"); __builtin_amdgcn_wave_barrier(); __builtin_amdgcn_fence(__ATOMIC_ACQUIRE, "wavefront"); }
DI void unpack8(const u32x4 v, float (&o)[8]) { o[0] = bflo(v.x); o[1] = bfhi(v.x); o[2] = bflo(v.y); o[3] = bfhi(v.y); o[4] = bflo(v.z); o[5] = bfhi(v.z); o[6] = bflo(v.w); o[7] = bfhi(v.w); }
DI u32x4 pack8(const float (&o)[8]) { u32x4 v; v.x = pk2(o[0], o[1]); v.y = pk2(o[2], o[3]); v.z = pk2(o[4], o[5]); v.w = pk2(o[6], o[7]); return v; }
DI bf16x8 pack8v(float a0, float a1, float a2, float a3, float a4, float a5, float a6, float a7) {
    u32x4 v; v.x = pk2(a0, a1); v.y = pk2(a2, a3); v.z = pk2(a4, a5); v.w = pk2(a6, a7); return __builtin_bit_cast(bf16x8, v); }


#if defined(CHECKS)
constexpr int DBG_TOKEN = 77;
#endif

typedef pg8::f32x4 af4;
DI void st8(bf16* p, const af4 v0, const af4 v1) { u32x4 w; w.x = pk2(v0[0], v0[1]); w.y = pk2(v0[2], v0[3]); w.z = pk2(v1[0], v1[1]); w.w = pk2(v1[2], v1[3]); *(u32x4*)p = w; }

struct EpiIn {
    static constexpr bool PERM = true, AFTER_DRAIN = false;
    bf16 *Q, *K, *Vt, *RW, *LO, *GA; const float* gate_bias;
    DI void operator()(const af4 (&acc)[2][2][4][2], const pg8::Unit& u, int wr, int wc, int fr, int fq) const {
        const int pn = u.pn, row0 = u.pm * 256 + wr * 64 + fr;
        if (pn == 4 || pn == 5) {
#pragma unroll
            for (int ai = 0; ai < 2; ++ai)
#pragma unroll
                for (int m = 0; m < 4; ++m) { const int row = row0 + ai * 128 + m * 16, b = row >> 13, s = row & (SEQ - 1);
#pragma unroll
                    for (int bj = 0; bj < 2; ++bj)
#pragma unroll
                        for (int n = 0; n < 2; ++n)
#pragma unroll
                            for (int j = 0; j < 4; ++j) { const int cv = (pn - 4) * 256 + bj * 128 + wc * 32 + 8 * fq + 4 * n + j;
                                Vt[((size_t)(b * BW + cv)) * SEQ + s] = (bf16)f2bf(acc[ai][bj][m][n][j]); } }
        } else if (pn >= 14) {
            const int col0 = (pn - 14) * 256 + wc * 32 + 8 * fq;
            af4 bv[2][2];
#pragma unroll
            for (int bj = 0; bj < 2; ++bj)
#pragma unroll
                for (int n = 0; n < 2; ++n) bv[bj][n] = *(const af4*)(gate_bias + col0 + bj * 128 + 4 * n);
#pragma unroll
            for (int ai = 0; ai < 2; ++ai)
#pragma unroll
                for (int m = 0; m < 4; ++m) { bf16* rowp = GA + (size_t)(row0 + ai * 128 + m * 16) * 2048 + col0;
#pragma unroll
                    for (int bj = 0; bj < 2; ++bj) { af4 v0 = acc[ai][bj][m][0] + bv[bj][0], v1 = acc[ai][bj][m][1] + bv[bj][1];
#pragma unroll
                        for (int j = 0; j < 4; ++j) { v0[j] = fsigmoid(v0[j]); v1[j] = fsigmoid(v1[j]); }
                        st8(rowp + bj * 128, v0, v1); } }
        } else {
            bf16* base; int ld, ct; float sc = 1.0f;
            if (pn < 2) { base = Q; ld = BW; ct = pn; sc = 0.125f; } else if (pn < 4) { base = K; ld = BW; ct = pn - 2; } else if (pn < 12) { base = RW; ld = 1536; ct = pn - 6; } else { base = LO; ld = BW; ct = pn - 12; }
            const int col0 = ct * 256 + wc * 32 + 8 * fq;
#pragma unroll
            for (int ai = 0; ai < 2; ++ai)
#pragma unroll
                for (int m = 0; m < 4; ++m) { bf16* rowp = base + (size_t)(row0 + ai * 128 + m * 16) * ld + col0;
#pragma unroll
                    for (int bj = 0; bj < 2; ++bj) st8(rowp + bj * 128, acc[ai][bj][m][0] * sc, acc[ai][bj][m][1] * sc); }
        }
    }
};

template <bool ADD> struct EpiMerge {
    static constexpr bool PERM = true, AFTER_DRAIN = false;
    bf16* GA; bf16* MRG; int gofs;
    DI void operator()(const af4 (&acc)[2][2][4][2], const pg8::Unit& u, int wr, int wc, int fr, int fq) const {
        const int row0 = u.pm * 256 + wr * 64 + fr, col0 = u.pn * 256 + wc * 32 + 8 * fq;
#pragma unroll
        for (int ai = 0; ai < 2; ++ai)
#pragma unroll
            for (int m = 0; m < 4; ++m) { const size_t row = (size_t)(row0 + ai * 128 + m * 16);
#pragma unroll
                for (int bj = 0; bj < 2; ++bj) { const int c = col0 + bj * 128;
                    float g[8]; unpack8(*(const u32x4*)(GA + row * 2048 + gofs + c), g);
                    af4 v0, v1;
#pragma unroll
                    for (int j = 0; j < 4; ++j) { v0[j] = g[j] * acc[ai][bj][m][0][j]; v1[j] = g[4 + j] * acc[ai][bj][m][1][j]; }
                    if (ADD) { float o[8]; unpack8(*(const u32x4*)(GA + row * 2048 + c), o);
#pragma unroll
                        for (int j = 0; j < 4; ++j) { v0[j] += o[j]; v1[j] += o[4 + j]; }
                        st8(MRG + row * D + c, v0, v1); }
                    else st8(GA + row * 2048 + c, v0, v1); } }
    }
};

struct EpiPlain {
    static constexpr bool PERM = true, AFTER_DRAIN = false;
    bf16* O; int ld, cmask;
    DI void operator()(const af4 (&acc)[2][2][4][2], const pg8::Unit& u, int wr, int wc, int fr, int fq) const {
        const int row0 = u.pm * 256 + wr * 64 + fr, col0 = (u.pn & cmask) * 256 + wc * 32 + 8 * fq;
#pragma unroll
        for (int ai = 0; ai < 2; ++ai)
#pragma unroll
            for (int m = 0; m < 4; ++m) { bf16* rowp = O + (size_t)(row0 + ai * 128 + m * 16) * ld + col0;
#pragma unroll
                for (int bj = 0; bj < 2; ++bj) st8(rowp + bj * 128, acc[ai][bj][m][0], acc[ai][bj][m][1]); }
    }
};

struct EpiUp {
    static constexpr bool PERM = true, AFTER_DRAIN = false;
    bf16* HID;
    DI void operator()(const af4 (&acc)[2][2][4][2], const pg8::Unit& u, int wr, int wc, int fr, int fq) const {
        const int row0 = u.pm * 256 + wr * 64 + fr, col0 = (u.pn & 3) * 128 + wc * 16 + 4 * fq;
#pragma unroll
        for (int ai = 0; ai < 2; ++ai)
#pragma unroll
            for (int m = 0; m < 4; ++m) { bf16* rowp = HID + (size_t)(row0 + ai * 128 + m * 16) * DE + col0;
#pragma unroll
                for (int bj = 0; bj < 2; ++bj) { float h[4];
#pragma unroll
                    for (int j = 0; j < 4; ++j) { const float u1 = acc[ai][bj][m][0][j]; h[j] = u1 * fsigmoid(u1) * acc[ai][bj][m][1][j]; }
                    __hip_atomic_store((GAS unsigned long long*)(rowp + bj * 64), (unsigned long long)pk2(h[0], h[1]) | ((unsigned long long)pk2(h[2], h[3]) << 32), __ATOMIC_RELAXED, __HIP_MEMORY_SCOPE_AGENT); } }
    }
};

constexpr unsigned MOE_CNT_WORD = 3584, MOE_CNT_STRIDE = 16;
struct MoeUpOrder {
    int nunits, G, vc; const int* tile_e; unsigned* cnt;
    DI bool next(int i, pg8::Unit& u) const { const long L = (long)i * G + vc; if (L >= nunits) return false; const int rt = (int)(L >> 2);
        u.pm = rt; u.pn = __builtin_amdgcn_readfirstlane(tile_e[rt]) * 4 + (int)(L & 3); return true; }
    DI void a_ready(const pg8::Unit&) const {}
    DI void done(const pg8::Unit& u) const { asm volatile("s_waitcnt vmcnt(0)" ::: "memory");
        if (__builtin_amdgcn_mbcnt_hi(~0u, __builtin_amdgcn_mbcnt_lo(~0u, 0u)) == 0u) __hip_atomic_fetch_add(cnt + MOE_CNT_STRIDE * u.pm, 1u, __ATOMIC_RELAXED, __HIP_MEMORY_SCOPE_AGENT); }
};
struct MoeDnOrder {
    int nunits, G, vc, q, rem, wave; const int* tile_e; unsigned* cnt;
    DI bool next(int i, pg8::Unit& u) const { long L;
        if (vc >= rem) { if (i > q) return false; L = (long)i * (G - rem) + (vc - rem); } else L = (long)(q + 1) * (G - rem) + (long)i * rem + vc;
        if (L >= nunits) return false; const int rt = (int)(L >> 2);
        u.pm = rt; u.pn = __builtin_amdgcn_readfirstlane(tile_e[rt]) * 4 + (int)(L & 3); return true; }
    DI void a_ready(const pg8::Unit& u) const {
        if (wave == 0) { unsigned sp = 0;
            while ((unsigned)__builtin_amdgcn_readfirstlane(__hip_atomic_load(cnt + MOE_CNT_STRIDE * u.pm, __ATOMIC_RELAXED, __HIP_MEMORY_SCOPE_AGENT)) < 32u) { __builtin_amdgcn_s_sleep(2); if (++sp > (1u << 22)) break; }
            __builtin_amdgcn_fence(__ATOMIC_ACQUIRE, "agent");
            asm volatile("s_waitcnt vmcnt(0)" ::: "memory"); }
        asm volatile("" ::: "memory"); __builtin_amdgcn_s_barrier(); asm volatile("" ::: "memory"); }
    DI void done(const pg8::Unit&) const {}
};

struct Args {
    const float *x, *c, *w_mod, *b_mod, *gains, *w_in, *gate_bias, *shift_mu, *w0, *w_decay_up, *a0, *w_iclr_up, *w_gate_up, *k_k, *k_a, *r_k, *lnx_w, *lnx_b,
                *w_o_sb, *w_o_rw, *w_out, *w_group, *w_router, *w_up1, *w_up3, *w_down;
    float* out; unsigned char* ws;
};
struct Frame { LAS unsigned char* lds; int tid, lane, wave, wg, G, gw, NGW; };
#define CAS __attribute__((address_space(4)))
typedef const CAS Args& ARef;

DI void tr_item(const float* W, int ldw, int K, bf16* WT, int k0, int drow0, int scol0, LAS float* scr, int lane) {
    if (scol0 >= 0) {
        float v[32];
        const float* wp = W + (size_t)(k0 + (lane >> 5)) * ldw + scol0 + (lane & 31);
#pragma unroll
        for (int i = 0; i < 32; ++i) v[i] = wp[(size_t)(2 * i) * ldw];
#pragma unroll
        for (int i = 0; i < 32; ++i) scr[(2 * i + (lane >> 5)) * 33 + (lane & 31)] = v[i];
    } else {
#pragma unroll 8
        for (int i = 0; i < 32; ++i) { const int kk = 2 * i + (lane >> 5); scr[kk * 33 + (lane & 31)] = 0.0f; }
    }
    wave_lds_fence();
    const int c = lane & 7;
#pragma unroll
    for (int j = 0; j < 4; ++j) { const int n = (lane >> 3) + 8 * j; const LAS float* s = scr + (8 * c) * 33 + n;
        u32x4 o; o.x = pk2(s[0 * 33], s[1 * 33]); o.y = pk2(s[2 * 33], s[3 * 33]); o.z = pk2(s[4 * 33], s[5 * 33]); o.w = pk2(s[6 * 33], s[7 * 33]);
        *(u32x4*)(WT + (size_t)(drow0 + n) * K + k0 + 8 * c) = o; }
    wave_lds_fence();
}
DI void tr_item_up(const float* W1, const float* W3, bf16* WT, int e, int k0, int drow0, LAS float* scr, int lane) {
    const int l31 = lane & 31, sc = (drow0 >> 3) * 4 + (l31 >> 3) * 4 + (l31 & 3);
    const float* W = ((l31 & 4) ? W3 : W1) + (size_t)e * D * DE;
    { float v[32]; const float* wp = W + (size_t)(k0 + (lane >> 5)) * DE + sc;
#pragma unroll
        for (int i = 0; i < 32; ++i) v[i] = wp[(size_t)(2 * i) * DE];
#pragma unroll
        for (int i = 0; i < 32; ++i) scr[(2 * i + (lane >> 5)) * 33 + l31] = v[i]; }
    wave_lds_fence();
    const int c = lane & 7;
#pragma unroll
    for (int j = 0; j < 4; ++j) { const int n = (lane >> 3) + 8 * j; const LAS float* s = scr + (8 * c) * 33 + n;
        u32x4 o; o.x = pk2(s[0 * 33], s[1 * 33]); o.y = pk2(s[2 * 33], s[3 * 33]); o.z = pk2(s[4 * 33], s[5 * 33]); o.w = pk2(s[6 * 33], s[7 * 33]);
        *(u32x4*)(WT + ((size_t)e * 1024 + drow0 + n) * D + k0 + 8 * c) = o; }
    wave_lds_fence();
}

DI void p0_prologue(const Frame& F0, ARef A) {
    Frame F = F0; F.tid = opq_tid(F0.wave); F.lane = F.tid & 63; F.wave = __builtin_amdgcn_readfirstlane(F.tid >> 6); F.gw = F.wg * NWAVES + F.wave;
    unsigned char* ws = A.ws;
    LAS float* sl = (LAS float*)F.lds;
    LAS float* part = (LAS float*)(F.lds + 16384);
    for (int i = F.tid; i < NB * D; i += NTHR) { const float v = A.c[i]; sl[i] = v * fsigmoid(v); }
    __syncthreads();
    float* mod = (float*)(ws + WS_MOD);
    for (int cg = F.wg; cg < 256; cg += F.G) {
        const int col = F.tid & 31, kg = F.tid >> 5;
        if (col < 24) { float a0 = 0.f, a1 = 0.f, a2 = 0.f, a3 = 0.f;
#pragma unroll 8
            for (int kk = 0; kk < 64; ++kk) { const int k = kg * 64 + kk; const float w = A.w_mod[(size_t)k * 6144 + cg * 24 + col];
                a0 += sl[k] * w; a1 += sl[D + k] * w; a2 += sl[2 * D + k] * w; a3 += sl[3 * D + k] * w; }
            LAS float* p = part + (kg * 24 + col) * 4; p[0] = a0; p[1] = a1; p[2] = a2; p[3] = a3; }
        __syncthreads();
        if (F.tid < 96) { const int c = F.tid >> 2, b = F.tid & 3; float s = 0.f;
#pragma unroll
            for (int kg2 = 0; kg2 < 16; ++kg2) s += part[(kg2 * 24 + c) * 4 + b];
            mod[b * 6144 + cg * 24 + c] = s + A.b_mod[cg * 24 + c]; }
        __syncthreads();
    }
    LAS float* scr = (LAS float*)(F.lds + 32768 + F.wave * 8704);
    constexpr int I_IN = (NPAD / 32) * (D / 64), I_OS = (D / 32) * (BW / 64), I_OUT = (D / 32) * (D / 64);
    for (int it = F.gw; it < I_IN + 2 * I_OS + I_OUT; it += F.NGW) {
        int r = it;
        if (r < I_IN) { const int g = r / (D / 64), kb = r % (D / 64), drow0 = 32 * g;
            const int sc = drow0 < 3360 ? drow0 : (drow0 < 3584 ? -1 : drow0 - 224);
            tr_item(A.w_in, IN_COLS, D, (bf16*)(ws + WS_WIN), 64 * kb, drow0, sc, scr, F.lane); continue; }
        r -= I_IN;
        if (r < I_OS) { const int g = r / (BW / 64), kb = r % (BW / 64); tr_item(A.w_o_sb, D, BW, (bf16*)(ws + WS_WOSB), 64 * kb, 32 * g, 32 * g, scr, F.lane); continue; }
        r -= I_OS;
        if (r < I_OS) { const int g = r / (BW / 64), kb = r % (BW / 64); tr_item(A.w_o_rw, D, BW, (bf16*)(ws + WS_WORW), 64 * kb, 32 * g, 32 * g, scr, F.lane); continue; }
        r -= I_OS;
        { const int g = r / (D / 64), kb = r % (D / 64); tr_item(A.w_out, D, D, (bf16*)(ws + WS_WOUT), 64 * kb, 32 * g, 32 * g, scr, F.lane); }
    }
    const int gt = F.wg * NTHR + F.tid, NGT = F.G * NTHR;
    float* rtw = (float*)(ws + WS_RTW);
    for (int i = gt; i < 36 * D; i += NGT) { const int o = i >> 10, k = i & (D - 1); rtw[i] = o < 4 ? A.w_group[k * 4 + o] : A.w_router[k * NE + (o - 4)]; }
    bf16* wl = (bf16*)(ws + WS_WL);
    for (int i = gt; i < 1536 * LK; i += NGT) { const int n = i / LK, k = i % LK; float v = 0.f;
        if (n < 512) { if (k < 64) v = A.w_decay_up[k * BW + n]; }
        else if (n < 1024) { if (k >= 64 && k < 128) v = A.w_iclr_up[(k - 64) * BW + (n - 512)]; }
        else { if (k >= 128 && k < 288) v = A.w_gate_up[(k - 128) * BW + (n - 1024)]; }
        wl[i] = (bf16)f2bf(v); }
}

DI void p1_h1(const Frame& F0, ARef A, bf16* H1) {
    Frame F = F0; F.tid = opq_tid(F0.wave); F.lane = F.tid & 63; F.wave = __builtin_amdgcn_readfirstlane(F.tid >> 6); F.gw = F.wg * NWAVES + F.wave;
    const float* mod = (const float*)(A.ws + WS_MOD);
    for (int n = F.gw; n < NTOK; n += F.NGW) {
        const int b = n >> 13;
        const f32x4* xr = (const f32x4*)(A.x + (size_t)n * D) + F.lane;
        f32x4 v[4]; float s = 0.f;
#pragma unroll
        for (int j = 0; j < 4; ++j) { v[j] = xr[64 * j]; s += (v[j][0] * v[j][0] + v[j][1] * v[j][1]) + (v[j][2] * v[j][2] + v[j][3] * v[j][3]); }
        const float inv = rsqrtf(wave_sum(s) * (1.0f / D) + NORM_EPS);
        u32x2* o = (u32x2*)(H1 + (size_t)n * D) + F.lane;
#pragma unroll
        for (int j = 0; j < 4; ++j) { const int k = 4 * F.lane + 256 * j;
            const f32x4 g = *(const f32x4*)(A.gains + k), sh = *(const f32x4*)(mod + b * 6144 + k), sc = *(const f32x4*)(mod + b * 6144 + D + k);
            f32x4 h;
#pragma unroll
            for (int q = 0; q < 4; ++q) h[q] = (v[j][q] * inv) * g[q] * (1.0f + sc[q]) + sh[q];
            u32x2 w; w.x = pk2(h[0], h[1]); w.y = pk2(h[2], h[3]); o[64 * j] = w; }
    }
}

DI void p3_attn(const Frame& F0, const bf16* QB, const bf16* KB, const bf16* VT, bf16* YSB) {
    Frame F = F0; F.tid = opq_tid(F0.wave); F.lane = F.tid & 63; F.wave = __builtin_amdgcn_readfirstlane(F.tid >> 6); F.gw = F.wg * NWAVES + F.wave;
    const int lane = F.lane, r = lane & 31, hh = lane >> 5;
    bf16x8 tri[2];
#pragma unroll
    for (int s = 0; s < 2; ++s)
#pragma unroll
        for (int e = 0; e < 8; ++e) tri[s][e] = (16 * s + 8 * (e >> 2) + 4 * hh + (e & 3)) > r ? (short)0x3F80 : (short)0;
    for (int u = F.gw; u < NB * NH * (SEQ / 32); u += F.NGW) {
        const int bh = u >> 8, qt = u & 255, b = bh >> 3, h = bh & 7;
        const bf16* qp = QB + (size_t)(b * SEQ + qt * 32 + r) * BW + h * HD + 8 * hh;
        bf16x8 qf[4];
#pragma unroll
        for (int ks = 0; ks < 4; ++ks) qf[ks] = *(const bf16x8*)(qp + 16 * ks);
        f32x16 o0, o1;
#pragma unroll
        for (int i = 0; i < 16; ++i) { o0[i] = 0.f; o1[i] = 0.f; }
        float L = 0.f;
        bf16x8 kf[4]; s16x4 vlo[2][2], vhi[2][2];
#define ATT_LOAD(KT, KF, VLO, VHI) do { const bf16* kp_ = KB + (size_t)(b * SEQ + (KT) * 32 + r) * BW + h * HD + 8 * hh; \
            _Pragma("unroll") for (int ks = 0; ks < 4; ++ks) KF[ks] = *(const bf16x8*)(kp_ + 16 * ks); \
            const bf16* vp_ = VT + ((size_t)(bh * HD + r)) * SEQ + (KT) * 32 + 4 * hh; \
            _Pragma("unroll") for (int mb = 0; mb < 2; ++mb) _Pragma("unroll") for (int ks = 0; ks < 2; ++ks) { VLO[mb][ks] = *(const s16x4*)(vp_ + (size_t)mb * 32 * SEQ + 16 * ks); VHI[mb][ks] = *(const s16x4*)(vp_ + (size_t)mb * 32 * SEQ + 16 * ks + 8); } } while (0)
        ATT_LOAD(qt, kf, vlo, vhi);
        for (int kt = qt; kt >= 0; --kt) {
            bf16x8 kfn[4]; s16x4 vlon[2][2], vhin[2][2];
            { const int ktn = kt > 0 ? kt - 1 : 0; ATT_LOAD(ktn, kfn, vlon, vhin); }
            f32x16 z;
#pragma unroll
            for (int i = 0; i < 16; ++i) z[i] = 0.f;
#pragma unroll
            for (int ks = 0; ks < 4; ++ks) z = MFMA32(kf[ks], qf[ks], z);
            const bool diag = (kt == qt);
            float lk[16], lo[16], tot = 0.f;
#pragma unroll
            for (int i = 0; i < 16; ++i) { const bool valid = !diag || (crow(i, hh) < r);
                const float sp = fsoftplus(z[i]); lk[i] = valid ? -sp : 0.0f; z[i] = valid ? z[i] - sp : -1.0e30f;
                tot += lk[i];
                const float hi = bflo(f2bf(lk[i])); lo[i] = lk[i] - hi; lk[i] = hi; }
            tot += shfl_xor_l(tot, 32, lane);
            f32x16 lat;
#pragma unroll
            for (int i = 0; i < 16; ++i) lat[i] = L;
#pragma unroll
            for (int s = 0; s < 2; ++s) {
                lat = MFMA32(tri[s], pack8v(lk[8 * s], lk[8 * s + 1], lk[8 * s + 2], lk[8 * s + 3], lk[8 * s + 4], lk[8 * s + 5], lk[8 * s + 6], lk[8 * s + 7]), lat);
                lat = MFMA32(tri[s], pack8v(lo[8 * s], lo[8 * s + 1], lo[8 * s + 2], lo[8 * s + 3], lo[8 * s + 4], lo[8 * s + 5], lo[8 * s + 6], lo[8 * s + 7]), lat); }
            float at[16];
#pragma unroll
            for (int i = 0; i < 16; ++i) at[i] = fexp(z[i] + lat[i]);
#pragma unroll
            for (int s = 0; s < 2; ++s) { const bf16x8 ab = pack8v(at[8 * s], at[8 * s + 1], at[8 * s + 2], at[8 * s + 3], at[8 * s + 4], at[8 * s + 5], at[8 * s + 6], at[8 * s + 7]);
                bf16x8 va, vb;
#pragma unroll
                for (int e = 0; e < 4; ++e) { va[e] = vlo[0][s][e]; va[4 + e] = vhi[0][s][e]; vb[e] = vlo[1][s][e]; vb[4 + e] = vhi[1][s][e]; }
                o0 = MFMA32(va, ab, o0); o1 = MFMA32(vb, ab, o1); }
            L += tot;
            if (__all(L < SB_STOP)) break;
#pragma unroll
            for (int ks = 0; ks < 4; ++ks) kf[ks] = kfn[ks];
#pragma unroll
            for (int mb = 0; mb < 2; ++mb)
#pragma unroll
                for (int ks = 0; ks < 2; ++ks) { vlo[mb][ks] = vlon[mb][ks]; vhi[mb][ks] = vhin[mb][ks]; }
        }
#undef ATT_LOAD
        bf16* op = YSB + (size_t)(b * SEQ + qt * 32 + r) * BW + h * HD + 4 * hh;
#pragma unroll
        for (int g = 0; g < 4; ++g) { u32x2 w0, w1; w0.x = pk2(o0[4 * g], o0[4 * g + 1]); w0.y = pk2(o0[4 * g + 2], o0[4 * g + 3]); w1.x = pk2(o1[4 * g], o1[4 * g + 1]); w1.y = pk2(o1[4 * g + 2], o1[4 * g + 3]);
            *(u32x2*)(op + 8 * g) = w0; *(u32x2*)(op + 32 + 8 * g) = w1; }
    }
}

DI void p3_prep(const Frame& F0, ARef A, const bf16* RWRAW, const bf16* LORA, bf16* R, bf16* KS, bf16* V, bf16* KK, bf16* ALORA) {
    Frame F = F0; F.tid = opq_tid(F0.wave); F.lane = F.tid & 63; F.wave = __builtin_amdgcn_readfirstlane(F.tid >> 6); F.gw = F.wg * NWAVES + F.wave;
    const int lane = F.lane;
    f32x4 mu[3][2], kkc[2], mul[2];
#pragma unroll
    for (int part = 0; part < 3; ++part) { mu[part][0] = *(const f32x4*)(A.shift_mu + part * 512 + lane * 8); mu[part][1] = *(const f32x4*)(A.shift_mu + part * 512 + lane * 8 + 4); }
    kkc[0] = *(const f32x4*)(A.k_k + lane * 8); kkc[1] = *(const f32x4*)(A.k_k + lane * 8 + 4);
    const int lcol = lane < 36 ? lane * 8 : 0;
    mul[0] = *(const f32x4*)(A.shift_mu + 1536 + lcol); mul[1] = *(const f32x4*)(A.shift_mu + 1536 + lcol + 4);
    constexpr int RUN = 16;
    for (int run = F.gw; run < NTOK / RUN; run += F.NGW) {
        const int n0 = run * RUN;
        u32x4 prv[3], prl, cur[3], cul;
        const u32x4 z4 = {0u, 0u, 0u, 0u};
        if ((n0 & (SEQ - 1)) == 0) { prv[0] = z4; prv[1] = z4; prv[2] = z4; prl = z4; }
        else {
#pragma unroll
            for (int part = 0; part < 3; ++part) prv[part] = *(const u32x4*)(RWRAW + (size_t)(n0 - 1) * 1536 + part * 512 + lane * 8);
            prl = *(const u32x4*)(LORA + (size_t)(n0 - 1) * BW + lcol); }
#pragma unroll
        for (int part = 0; part < 3; ++part) cur[part] = *(const u32x4*)(RWRAW + (size_t)n0 * 1536 + part * 512 + lane * 8);
        cul = *(const u32x4*)(LORA + (size_t)n0 * BW + lcol);
        for (int i = 0; i < RUN; ++i) {
            const int n = n0 + i, nn = i + 1 < RUN ? n + 1 : n;
            u32x4 nxt[3], nxl;
#pragma unroll
            for (int part = 0; part < 3; ++part) nxt[part] = *(const u32x4*)(RWRAW + (size_t)nn * 1536 + part * 512 + lane * 8);
            nxl = *(const u32x4*)(LORA + (size_t)nn * BW + lcol);
            float xs[3][8];
#pragma unroll
            for (int part = 0; part < 3; ++part) { float p[8], q[8]; unpack8(cur[part], p); unpack8(prv[part], q);
#pragma unroll
                for (int j = 0; j < 4; ++j) { xs[part][j] = p[j] + mu[part][0][j] * (q[j] - p[j]); xs[part][4 + j] = p[4 + j] + mu[part][1][j] * (q[4 + j] - p[4 + j]); } }
            const size_t off = (size_t)n * BW + lane * 8;
            *(u32x4*)(R + off) = pack8(xs[0]); *(u32x4*)(KS + off) = pack8(xs[1]); *(u32x4*)(V + off) = pack8(xs[2]);
            float kk[8], ss = 0.f;
#pragma unroll
            for (int j = 0; j < 4; ++j) { kk[j] = xs[1][j] * kkc[0][j]; kk[4 + j] = xs[1][4 + j] * kkc[1][j]; }
#pragma unroll
            for (int j = 0; j < 8; ++j) ss += kk[j] * kk[j];
            ss += shfl_xor_l(ss, 1, lane); ss += shfl_xor_l(ss, 2, lane); ss += shfl_xor_l(ss, 4, lane);
            const float rn = 1.0f / fmaxf(sqrtf(ss), L2_EPS);
#pragma unroll
            for (int j = 0; j < 8; ++j) kk[j] *= rn;
            *(u32x4*)(KK + off) = pack8(kk);
            if (lane < 48) { float a[8];
                if (lane < 36) { float p[8], q[8]; unpack8(cul, p); unpack8(prl, q);
#pragma unroll
                    for (int j = 0; j < 8; ++j) { const float m = j < 4 ? mul[0][j & 3] : mul[1][j & 3]; const float v = p[j] + m * (q[j] - p[j]);
                        a[j] = lane < 8 ? (1.0f - 2.0f * frcp(fexp(2.0f * v) + 1.0f)) : (lane < 16 ? v : fsigmoid(v)); }
                } else {
#pragma unroll
                    for (int j = 0; j < 8; ++j) a[j] = 0.f; }
                *(u32x4*)(ALORA + (size_t)n * LK + lane * 8) = pack8(a); }
#pragma unroll
            for (int part = 0; part < 3; ++part) { prv[part] = cur[part]; cur[part] = nxt[part]; }
            prl = cul; cul = nxl;
        }
    }
}

DI void p4_lora(const Frame& F0, ARef A, const bf16* ALORA, const bf16* WL, bf16* E, bf16* KS, bf16* Bo, bf16* GG, const bf16* KK, const bf16* R, float* BON) {
    Frame F = F0; F.tid = opq_tid(F0.wave); F.lane = F.tid & 63; F.wave = __builtin_amdgcn_readfirstlane(F.tid >> 6); F.gw = F.wg * NWAVES + F.wave;
    const int lane = F.lane, r = lane & 31, hh = lane >> 5;
    for (int u = F.gw; u < 2 * (NTOK / 32); u += F.NGW) {
        const int n0 = (u >> 1) * 32, par = u & 1;
        bf16x8 tf[18];
#pragma unroll
        for (int ks = 0; ks < 18; ++ks) tf[ks] = *(const bf16x8*)(ALORA + (size_t)(n0 + r) * LK + 16 * ks + 8 * hh);
        const unsigned orow = (unsigned)(n0 + r) * BW + 4 * hh;
#define LORA_BLOCK(KS0, NKS, CB, BODY) { const int c0_ = 32 * ((CB) & 15); f32x16 acc_; \
            _Pragma("unroll") for (int q = 0; q < 16; ++q) acc_[q] = 0.f; \
            _Pragma("unroll") for (int ks = 0; ks < (NKS); ++ks) acc_ = MFMA32(*(const bf16x8*)(WL + (size_t)(32 * (CB) + r) * LK + 16 * ((KS0) + ks) + 8 * hh), tf[(KS0) + ks], acc_); \
            BODY }
        for (int i = 0; i < 8; ++i) { const int cb = 4 * (i >> 1) + 2 * par + (i & 1);
            LORA_BLOCK(0, 4, cb, {
                _Pragma("unroll") for (int g = 0; g < 4; ++g) { const f32x4 w0v = *(const f32x4*)(A.w0 + c0_ + 8 * g + 4 * hh); float e4[4];
                    _Pragma("unroll") for (int j = 0; j < 4; ++j) { const float v = acc_[4 * g + j] + w0v[j]; e4[j] = fexp(-fsoftplus(-v) - 0.5f); }
                    u32x2 w; w.x = pk2(e4[0], e4[1]); w.y = pk2(e4[2], e4[3]); *(u32x2*)(E + orow + c0_ + 8 * g) = w; } }) }
        float bsum = 0.f;
        for (int i = 0; i < 8; ++i) { const int cb = 16 + 4 * (i >> 1) + 2 * par + (i & 1);
            LORA_BLOCK(4, 4, cb, {
                _Pragma("unroll") for (int g = 0; g < 4; ++g) { const f32x4 a0v = *(const f32x4*)(A.a0 + c0_ + 8 * g + 4 * hh); const f32x4 kav = *(const f32x4*)(A.k_a + c0_ + 8 * g + 4 * hh);
                    const unsigned o = orow + c0_ + 8 * g; const u32x2 kw = *(const u32x2*)(KS + o); const u32x2 qw = *(const u32x2*)(KK + o); const u32x2 rw = *(const u32x2*)(R + o); const f32x4 rkv = *(const f32x4*)(A.r_k + c0_ + 8 * g + 4 * hh);
                    float ksv[4]; float kkv[4]; float kp[4]; float bb[4]; ksv[0] = bflo(kw.x); ksv[1] = bfhi(kw.x); ksv[2] = bflo(kw.y); ksv[3] = bfhi(kw.y); kkv[0] = bflo(qw.x); kkv[1] = bfhi(qw.x); kkv[2] = bflo(qw.y); kkv[3] = bfhi(qw.y);
                    _Pragma("unroll") for (int j = 0; j < 4; ++j) { const float s0 = fsigmoid(acc_[4 * g + j] + a0v[j]); kp[j] = ksv[j] * (1.0f + (s0 - 1.0f) * kav[j]); bb[j] = kkv[j] * s0; }
                    bsum += (bflo(rw.x) * kp[0] * rkv[0] + bfhi(rw.x) * kp[1] * rkv[1]) + (bflo(rw.y) * kp[2] * rkv[2] + bfhi(rw.y) * kp[3] * rkv[3]);
                    u32x2 w1; u32x2 w2; w1.x = pk2(kp[0], kp[1]); w1.y = pk2(kp[2], kp[3]); w2.x = pk2(bb[0], bb[1]); w2.y = pk2(bb[2], bb[3]); *(u32x2*)(KS + o) = w1; *(u32x2*)(Bo + o) = w2; } })
            if (i & 1) { const float tot = bsum + shfl_xor_l(bsum, 32, lane); if (hh == 0) BON[(size_t)(n0 + r) * 8 + 2 * (i >> 1) + par] = tot; bsum = 0.f; } }
        for (int i = 0; i < 8; ++i) { const int cb = 32 + 4 * (i >> 1) + 2 * par + (i & 1);
            LORA_BLOCK(8, 10, cb, {
                _Pragma("unroll") for (int g = 0; g < 4; ++g) { u32x2 w; w.x = pk2(acc_[4 * g], acc_[4 * g + 1]); w.y = pk2(acc_[4 * g + 2], acc_[4 * g + 3]); *(u32x2*)(GG + orow + c0_ + 8 * g) = w; } }) }
#undef LORA_BLOCK
    }
}

DI void p6_chain(int task, int wave, LAS unsigned char* ring, const bf16* GT, const bf16* HT, bf16* SC) {
    const int lane = opq_tid(wave) & 63;
    const int bh = task >> 1, nb = task & 1;
    constexpr int RD = 6, SLOT = 12288;
    f32x16 X[2];
#pragma unroll
    for (int q = 0; q < 16; ++q) { X[0][q] = 0.f; X[1][q] = 0.f; }
    const char* gsrc = (const char*)(GT + (size_t)bh * NCH * 4096) + lane * 16;
    const char* hsrc = (const char*)(HT + (size_t)bh * NCH * 4096) + nb * 2048 + lane * 16;
#define CHAIN_DMA(cc) do { LAS unsigned char* sl_ = ring + ((cc) % RD) * SLOT; const char* g_ = gsrc + (size_t)(cc) * 8192; const char* h_ = hsrc + (size_t)(cc) * 8192; \
        _Pragma("unroll") for (int f = 0; f < 8; ++f) __builtin_amdgcn_global_load_lds((const unsigned*)(g_ + f * 1024), (LAS unsigned*)(sl_ + f * 1024), 16, 0, 0); \
        _Pragma("unroll") for (int kb = 0; kb < 2; ++kb) _Pragma("unroll") for (int j = 0; j < 2; ++j) \
            __builtin_amdgcn_global_load_lds((const unsigned*)(h_ + kb * 4096 + j * 1024), (LAS unsigned*)(sl_ + 8192 + (kb * 2 + j) * 1024), 16, 0, 0); } while (0)
#define CHAIN_READ(cc, HS, GS) do { const LAS unsigned char* sl_ = ring + ((cc) % RD) * SLOT; \
        _Pragma("unroll") for (int f = 0; f < 8; ++f) GS[f] = *(const LAS bf16x8*)(sl_ + f * 1024 + lane * 16); \
        _Pragma("unroll") for (int kb = 0; kb < 2; ++kb) _Pragma("unroll") for (int g = 0; g < 4; ++g) { const u32x2 w_ = *(const LAS u32x2*)(sl_ + 8192 + kb * 2048 + (g * 64 + lane) * 8); \
            HS[kb][4 * g] = bflo(w_.x); HS[kb][4 * g + 1] = bfhi(w_.x); HS[kb][4 * g + 2] = bflo(w_.y); HS[kb][4 * g + 3] = bfhi(w_.y); } } while (0)
#define CHAIN_STORE(cc) do { bf16* sc_ = SC + ((size_t)bh * NCH + (cc)) * 4096; \
        _Pragma("unroll") for (int jb = 0; jb < 2; ++jb) _Pragma("unroll") for (int g = 0; g < 4; ++g) { u32x2 w_; w_.x = pk2(X[jb][4 * g], X[jb][4 * g + 1]); w_.y = pk2(X[jb][4 * g + 2], X[jb][4 * g + 3]); \
            *(u32x2*)(sc_ + ((((jb * 2 + nb) * 4 + g) * 64) + lane) * 4) = w_; } } while (0)
#define CHAIN_STEP(HS, GS) do { bf16x8 xb_[2][2]; \
        _Pragma("unroll") for (int jb = 0; jb < 2; ++jb) _Pragma("unroll") for (int s = 0; s < 2; ++s) \
            xb_[jb][s] = pack8v(X[jb][8 * s], X[jb][8 * s + 1], X[jb][8 * s + 2], X[jb][8 * s + 3], X[jb][8 * s + 4], X[jb][8 * s + 5], X[jb][8 * s + 6], X[jb][8 * s + 7]); \
        X[0] = HS[0]; X[1] = HS[1]; \
        _Pragma("unroll") for (int kb = 0; kb < 2; ++kb) _Pragma("unroll") for (int jb = 0; jb < 2; ++jb) _Pragma("unroll") for (int s = 0; s < 2; ++s) X[kb] = MFMA32(GS[kb * 4 + jb * 2 + s], xb_[jb][s], X[kb]); } while (0)
    for (int cc = 0; cc < RD; ++cc) CHAIN_DMA(cc);
    for (int c = 0; c < NCH - 1; ++c) {
        f32x16 Hc[2]; bf16x8 Gc[8];
        if (c + RD <= NCH - 1) asm volatile("s_waitcnt vmcnt(60)" ::: "memory"); else asm volatile("s_waitcnt vmcnt(0)" ::: "memory");
        CHAIN_READ(c, Hc, Gc);
        asm volatile("s_waitcnt lgkmcnt(0)" ::: "memory");
        if (c + RD < NCH - 1) CHAIN_DMA(c + RD);
        CHAIN_STORE(c);
        CHAIN_STEP(Hc, Gc);
    }
    CHAIN_STORE(NCH - 1);
    asm volatile("s_waitcnt vmcnt(0)" ::: "memory");
#undef CHAIN_DMA
#undef CHAIN_READ
#undef CHAIN_STORE
#undef CHAIN_STEP
}

DI void p6_moe_weights(const Frame& F0, ARef A, int wi, int NW) {
    Frame F = F0; F.tid = opq_tid(F0.wave); F.lane = F.tid & 63; F.wave = __builtin_amdgcn_readfirstlane(F.tid >> 6); F.gw = F.wg * NWAVES + F.wave;
    LAS float* scr = (LAS float*)(F.lds + F.wave * 20480);
    constexpr int I_UP = NE * 32 * 16, I_DN = NE * 32 * 8;
    for (int it = wi; it < I_UP + I_DN; it += NW) {
        if (it < I_UP) { const int e = it >> 9, g = (it >> 4) & 31, kb = it & 15; tr_item_up(A.w_up1, A.w_up3, (bf16*)(A.ws + WS_WUP), e, 64 * kb, 32 * g, scr, F.lane); }
        else { const int r = it - I_UP, e = r >> 8, g = (r >> 3) & 31, kb = r & 7;
            tr_item(A.w_down + (size_t)e * DE * D, D, DE, (bf16*)(A.ws + WS_WDN) + (size_t)e * 1024 * DE, 64 * kb, 32 * g, 32 * g, scr, F.lane); }
    }
}

DI float half_bcast_sum(float v, int hh) {
    v += DPP_SHR(v, 0x111); v += DPP_SHR(v, 0x112); v += DPP_SHR(v, 0x114); v += DPP_SHR(v, 0x118);
    v += __builtin_bit_cast(float, __builtin_amdgcn_update_dpp(0, __builtin_bit_cast(int, v), 0x142, 0xa, 0xf, false));
    const float lo = __builtin_bit_cast(float, __builtin_amdgcn_readlane(__builtin_bit_cast(int, v), 31)), hi = __builtin_bit_cast(float, __builtin_amdgcn_readlane(__builtin_bit_cast(int, v), 63));
    return hh ? hi : lo; }
DI void p7_mfma(const Frame& F0, ARef A, const bf16* SC, const bf16* Pn, const bf16* QOn, const bf16* V, const bf16* GG, const float* BON, bf16* YRW) {
    Frame F = F0; F.tid = opq_tid(F0.wave); F.lane = F.tid & 63; F.wave = __builtin_amdgcn_readfirstlane(F.tid >> 6); F.gw = F.wg * NWAVES + F.wave;
    const int lane = F.lane, r = lane & 31, hh = lane >> 5;
    for (int cid = F.gw; cid < NCHUNK; cid += F.NGW) {
        const int bh = cid >> NCH_LOG, c = cid & (NCH - 1), b = bh >> 3, h = bh & 7;
        const unsigned n0 = (unsigned)b * SEQ + (unsigned)c * CH; const int col0 = h * HD;
        const bf16* sc = SC + (size_t)cid * 4096; const bf16* pn = Pn + (size_t)cid * 4096; const bf16* qn = QOn + (size_t)cid * 4096;
        bf16x8 Sf[2][2][2], Pf[2][2][2];
#pragma unroll
        for (int jb = 0; jb < 2; ++jb)
#pragma unroll
            for (int xb = 0; xb < 2; ++xb)
#pragma unroll
                for (int s = 0; s < 2; ++s) { const s16x4 lo = *(const s16x4*)(sc + ((((jb * 2 + xb) * 4 + 2 * s) * 64) + lane) * 4), hi = *(const s16x4*)(sc + ((((jb * 2 + xb) * 4 + 2 * s + 1) * 64) + lane) * 4);
#pragma unroll
                    for (int e = 0; e < 4; ++e) { Sf[jb][xb][s][e] = lo[e]; Sf[jb][xb][s][4 + e] = hi[e]; }
                    Pf[jb][xb][s] = *(const bf16x8*)(pn + ((((jb * 2 + xb) * 2 + s) * 64) + lane) * 8); }
        f32x16 Z[2][2];
#pragma unroll
        for (int tb = 0; tb < 2; ++tb)
#pragma unroll
            for (int nb = 0; nb < 2; ++nb) {
#pragma unroll
                for (int g = 0; g < 4; ++g) { const u32x2 w = *(const u32x2*)(qn + ((((tb * 2 + nb) * 4 + g) * 64) + lane) * 4);
                    Z[tb][nb][4 * g] = bflo(w.x); Z[tb][nb][4 * g + 1] = bfhi(w.x); Z[tb][nb][4 * g + 2] = bflo(w.y); Z[tb][nb][4 * g + 3] = bfhi(w.y); }
#pragma unroll
                for (int jb = 0; jb < 2; ++jb)
#pragma unroll
                    for (int s = 0; s < 2; ++s) Z[tb][nb] = MFMA32(Pf[jb][tb][s], Sf[jb][nb][s], Z[tb][nb]); }
        float lw[2], lb[2];
#pragma unroll
        for (int nb = 0; nb < 2; ++nb) { lw[nb] = A.lnx_w[col0 + 32 * nb + r]; lb[nb] = A.lnx_b[col0 + 32 * nb + r]; }
#pragma unroll
        for (int tb = 0; tb < 2; ++tb)
#pragma unroll
            for (int q = 0; q < 16; ++q) {
                const unsigned tokrow = n0 + 32 * tb + 4 * hh + (q & 3) + 8 * (q >> 2);
                const float mean = half_bcast_sum(Z[tb][0][q] + Z[tb][1][q], hh) * (1.0f / 64.0f);
                const float d0 = Z[tb][0][q] - mean, d1 = Z[tb][1][q] - mean;
                const float rs = rsqrtf(half_bcast_sum(d0 * d0 + d1 * d1, hh) * (1.0f / 64.0f) + GN_EPS);
                const float bon = BON[(size_t)tokrow * 8 + h];
                const unsigned o0 = tokrow * BW + col0 + r;
                YRW[o0] = (bf16)f2bf((d0 * rs * lw[0] + lb[0] + bon * bf2f(V[o0])) * bf2f(GG[o0]));
                YRW[o0 + 32] = (bf16)f2bf((d1 * rs * lw[1] + lb[1] + bon * bf2f(V[o0 + 32])) * bf2f(GG[o0 + 32]));
                if ((q & 3) == 3) __builtin_amdgcn_sched_barrier(0); }
    }
}

DI void p10_rows(const Frame& F0, ARef A, const bf16* Y1, bf16* H2) {
    Frame F = F0; F.tid = opq_tid(F0.wave); F.lane = F.tid & 63; F.wave = __builtin_amdgcn_readfirstlane(F.tid >> 6); F.gw = F.wg * NWAVES + F.wave;
    const int lane = F.lane;
    const float* mod = (const float*)(A.ws + WS_MOD);
    LAS float* rw = (LAS float*)F.lds;
    LAS int* hist = (LAS int*)(F.lds + 147456);
    { const float* src = (const float*)(A.ws + WS_RTW);
        for (int i = F.tid; i < 18 * D; i += NTHR) { const int op = i >> 10, k = i & (D - 1); typedef float f2_t __attribute__((ext_vector_type(2))); f2_t w; w.x = src[(2 * op) * D + k]; w.y = src[(2 * op + 1) * D + k]; *(LAS f2_t*)(rw + 2 * i) = w; } }
    i32x4* tok = (i32x4*)(A.ws + WS_TOK); int* cnt = (int*)(A.ws + WS_CNT);
    for (int tb = F.wg; tb < NTOK / 128; tb += F.G) {
        if (F.tid < 32) hist[F.tid] = 0;
        __syncthreads();
        for (int tl = F.wave; tl < 128; tl += NWAVES) {
            const int n = tb * 128 + tl, b = n >> 13;
            const f32x4* xr = (const f32x4*)(A.x + (size_t)n * D) + lane; const u32x2* yr = (const u32x2*)(Y1 + (size_t)n * D) + lane;
            f32x4 xv[4], yv[4]; float s = 0.f;
#pragma unroll
            for (int j = 0; j < 4; ++j) { xv[j] = xr[64 * j]; const u32x2 w = yr[64 * j]; yv[j][0] = bflo(w.x); yv[j][1] = bfhi(w.x); yv[j][2] = bflo(w.y); yv[j][3] = bfhi(w.y);
                s += (yv[j][0] * yv[j][0] + yv[j][1] * yv[j][1]) + (yv[j][2] * yv[j][2] + yv[j][3] * yv[j][3]); }
            const float inv1 = rsqrtf(wave_sum(s) * (1.0f / D) + NORM_EPS);
            float s2 = 0.f;
#pragma unroll
            for (int j = 0; j < 4; ++j) { const int k = 4 * lane + 256 * j;
                const f32x4 g1 = *(const f32x4*)(A.gains + D + k), gt = *(const f32x4*)(mod + b * 6144 + 2 * D + k);
#pragma unroll
                for (int q = 0; q < 4; ++q) { xv[j][q] = xv[j][q] + gt[q] * ((yv[j][q] * inv1) * g1[q]); s2 += xv[j][q] * xv[j][q]; }
                u32x2 xw; xw.x = pk2(xv[j][0], xv[j][1]); xw.y = pk2(xv[j][2], xv[j][3]); *((u32x2*)(A.ws + WS_X1 + (size_t)n * D * 2) + lane + 64 * j) = xw; }
            const float inv2 = rsqrtf(wave_sum(s2) * (1.0f / D) + NORM_EPS);
            f32x4 hv[4];
#pragma unroll
            for (int j = 0; j < 4; ++j) { const int k = 4 * lane + 256 * j;
                const f32x4 g2 = *(const f32x4*)(A.gains + 2 * D + k), sh = *(const f32x4*)(mod + b * 6144 + 3 * D + k), sc = *(const f32x4*)(mod + b * 6144 + 4 * D + k);
#pragma unroll
                for (int q = 0; q < 4; ++q) hv[j][q] = (xv[j][q] * inv2) * g2[q] * (1.0f + sc[q]) + sh[q];
                u32x2 w; w.x = pk2(hv[j][0], hv[j][1]); w.y = pk2(hv[j][2], hv[j][3]); *((u32x2*)(H2 + (size_t)n * D) + lane + 64 * j) = w; }
            typedef float f2_t __attribute__((ext_vector_type(2)));
#define P10_PAIR(OUT0, OUT1, WBASE) do { f2_t a = {0.f, 0.f}; \
                _Pragma("unroll") for (int j = 0; j < 4; ++j) { const LAS f32x4* wp = (const LAS f32x4*)((WBASE) + (4 * lane + 256 * j) * 2); const f32x4 wA = wp[0], wB = wp[1]; \
                    a += (f2_t){hv[j][0], hv[j][0]} * (f2_t){wA[0], wA[1]}; a += (f2_t){hv[j][1], hv[j][1]} * (f2_t){wA[2], wA[3]}; \
                    a += (f2_t){hv[j][2], hv[j][2]} * (f2_t){wB[0], wB[1]}; a += (f2_t){hv[j][3], hv[j][3]} * (f2_t){wB[2], wB[3]}; } \
                OUT0 = wave_sum(a.x); OUT1 = wave_sum(a.y); } while (0)
            float lg[4];
            P10_PAIR(lg[0], lg[1], rw); P10_PAIR(lg[2], lg[3], rw + 2 * D);
            int gs = 0; float gm = lg[0];
#pragma unroll
            for (int g = 1; g < 4; ++g) if (lg[g] > gm) { gm = lg[g]; gs = g; }
            gs = __builtin_amdgcn_readfirstlane(gs);
            float gsum = 0.f;
#pragma unroll
            for (int g = 0; g < 4; ++g) gsum += fexp(lg[g] - gm);
            const float gw = 1.0f / gsum;
            float el[8];
            { const LAS float* rwg = rw + (2 + 4 * gs) * (2 * D);
#pragma unroll
              for (int i = 0; i < 4; ++i) P10_PAIR(el[2 * i], el[2 * i + 1], rwg + i * 2 * D); }
#undef P10_PAIR
            int i0 = 0; float m0 = el[0];
#pragma unroll
            for (int e = 1; e < 8; ++e) if (el[e] > m0) { m0 = el[e]; i0 = e; }
            int i1 = -1; float m1 = -3.0e38f;
#pragma unroll
            for (int e = 0; e < 8; ++e) if (e != i0 && el[e] > m1) { m1 = el[e]; i1 = e; }
            const float t = fexp(m1 - m0), p0 = 1.0f / (1.0f + t), p1 = t * p0;
            const int e0 = gs * 8 + i0, e1 = gs * 8 + i1;
#if defined(CHECKS)
            if (lane == 0 && n == DBG_TOKEN) { float* dbg = (float*)(A.ws + WS_CTL + 32768) + 48; dbg[0] = lg[0]; dbg[1] = lg[1]; dbg[2] = lg[2]; dbg[3] = lg[3]; dbg[4] = gsum; dbg[5] = p0; dbg[6] = gw; dbg[7] = t; }
#endif
            if (lane == 0) { i32x4 rec; rec.x = e0 | (e1 << 8); rec.y = 0; rec.z = 0; rec.w = 0; tok[n] = rec;
                float* cwp = (float*)(A.ws + WS_CW) + 2 * n; cwp[0] = gw * p0; cwp[1] = gw * p1;
                atomicAdd((int*)&hist[e0], 1); atomicAdd((int*)&hist[e1], 1); }
        }
        __syncthreads();
        if (F.tid < 32) cnt[tb * 32 + F.tid] = hist[F.tid];
        __syncthreads();
    }
}

DI void p11_rank_gather(const Frame& F0, ARef A, const bf16* H2, bf16* HS) {
    Frame F = F0; F.tid = opq_tid(F0.wave); F.lane = F.tid & 63; F.wave = __builtin_amdgcn_readfirstlane(F.tid >> 6); F.gw = F.wg * NWAVES + F.wave;
    LAS int* base = (LAS int*)F.lds;
    LAS int* seg = base + 32;
    LAS int* el = base + 96;
    LAS int* pos = base + 352;
    i32x4* tok = (i32x4*)(A.ws + WS_TOK); const int* cnt = (const int*)(A.ws + WS_CNT); int* tile = (int*)(A.ws + WS_TILE);
    for (int tb = F.wg; tb < NTOK / 128; tb += F.G) {
        if (F.tid < 32) { int tot = 0, pre = 0;
            for (int t2 = 0; t2 < NTOK / 128; ++t2) { const int v = cnt[t2 * 32 + F.tid]; tot += v; if (t2 < tb) pre += v; }
            base[F.tid] = pre; seg[F.tid] = (tot + 255) & ~255; }
        if (F.tid >= 64 && F.tid < 64 + 128) { const i32x4 rec = tok[tb * 128 + (F.tid - 64)]; el[2 * (F.tid - 64)] = rec.x & 255; el[2 * (F.tid - 64) + 1] = (rec.x >> 8) & 255; }
        __syncthreads();
        if (F.tid == 0) { int acc = 0; for (int e = 0; e < 32; ++e) { const int sz = seg[e]; seg[e] = acc; acc += sz; } seg[32] = acc; }
        __syncthreads();
        if (F.tid < 32) { int p = seg[F.tid] + base[F.tid];
            for (int q = 0; q < 256; ++q) if (el[q] == F.tid) pos[q] = p++; }
        if (tb == 0 && F.tid >= 64 && F.tid < 64 + 32) { const int e = F.tid - 64;
            for (int t2 = seg[e] >> 8; t2 < (seg[e + 1] >> 8); ++t2) tile[t2] = e;
            if (e == 0) tile[MAXT] = seg[32] >> 8; }
        __syncthreads();
        if (F.tid < 128) { i32x4 rec = tok[tb * 128 + F.tid]; rec.x = pos[2 * F.tid]; rec.y = pos[2 * F.tid + 1]; tok[tb * 128 + F.tid] = rec; }
        for (int q = F.wave; q < 256; q += NWAVES) { const int n = tb * 128 + (q >> 1);
            const u32x4* src = (const u32x4*)(H2 + (size_t)n * D) + F.lane; u32x4* dst = (u32x4*)(HS + (size_t)pos[q] * D) + F.lane;
            dst[0] = src[0]; dst[64] = src[64]; }
        __syncthreads();
    }
}

DI void p14_final(const Frame& F0, ARef A, const bf16* YE) {
    Frame F = F0; F.tid = opq_tid(F0.wave); F.lane = F.tid & 63; F.wave = __builtin_amdgcn_readfirstlane(F.tid >> 6); F.gw = F.wg * NWAVES + F.wave;
    const int lane = F.lane;
    const float* mod = (const float*)(A.ws + WS_MOD); const i32x4* tok = (const i32x4*)(A.ws + WS_TOK);
    for (int n = F.gw; n < NTOK; n += F.NGW) {
        const int b = n >> 13; const i32x4 rec = tok[n];
        const float c0 = ((const float*)(A.ws + WS_CW))[2 * n], c1 = ((const float*)(A.ws + WS_CW))[2 * n + 1];
        const u32x2* y0 = (const u32x2*)(YE + (size_t)rec.x * D) + lane; const u32x2* y1 = (const u32x2*)(YE + (size_t)rec.y * D) + lane;
        f32x4 yv[4]; float s = 0.f;
#pragma unroll
        for (int j = 0; j < 4; ++j) { const u32x2 a = y0[64 * j], bq = y1[64 * j];
            yv[j][0] = c0 * bflo(a.x) + c1 * bflo(bq.x); yv[j][1] = c0 * bfhi(a.x) + c1 * bfhi(bq.x); yv[j][2] = c0 * bflo(a.y) + c1 * bflo(bq.y); yv[j][3] = c0 * bfhi(a.y) + c1 * bfhi(bq.y);
            s += (yv[j][0] * yv[j][0] + yv[j][1] * yv[j][1]) + (yv[j][2] * yv[j][2] + yv[j][3] * yv[j][3]); }
        const float inv = rsqrtf(wave_sum(s) * (1.0f / D) + NORM_EPS);
#pragma unroll
        for (int j = 0; j < 4; ++j) { const int k = 4 * lane + 256 * j;
            const f32x4 g3 = *(const f32x4*)(A.gains + 3 * D + k), gt = *(const f32x4*)(mod + b * 6144 + 5 * D + k);
            const u32x2 xw = *((const u32x2*)(A.ws + WS_X1 + (size_t)n * D * 2) + lane + 64 * j); f32x4 xv = {bflo(xw.x), bfhi(xw.x), bflo(xw.y), bfhi(xw.y)};
#pragma unroll
            for (int q = 0; q < 4; ++q) xv[q] = xv[q] + gt[q] * ((yv[j][q] * inv) * g3[q]);
            *((f32x4*)(A.out + (size_t)n * D) + lane + 64 * j) = xv; }
    }
}

DI bf16x8 pk_tile(const f32x16& x, const int s) { return pack8v(x[8 * s], x[8 * s + 1], x[8 * s + 2], x[8 * s + 3], x[8 * s + 4], x[8 * s + 5], x[8 * s + 6], x[8 * s + 7]); }
constexpr int FS = 72;
DI bf16x8 rd_frag(const LAS bf16* buf, int tb, int cb, int s, int r, int hh) {
    const LAS bf16* p = buf + (32 * cb + r) * FS + 32 * tb + 16 * s + 4 * hh;
    const s16x4 lo = *(const LAS s16x4*)p, hi = *(const LAS s16x4*)(p + 8); bf16x8 f;
#pragma unroll
    for (int e = 0; e < 4; ++e) { f[e] = lo[e]; f[4 + e] = hi[e]; }
    return f; }
DI void wr_tile_ft(LAS bf16* buf, const f32x16& x, int tb, int cb, int r, int hh) {
#pragma unroll
    for (int g = 0; g < 4; ++g) { u32x2 w; w.x = pk2(x[4 * g], x[4 * g + 1]); w.y = pk2(x[4 * g + 2], x[4 * g + 3]); *(LAS u32x2*)(buf + (32 * cb + r) * FS + 32 * tb + 8 * g + 4 * hh) = w; } }
DI void wr_l_ft(LAS bf16* buf, const float (&x)[64], int lane) {
#pragma unroll
    for (int t8 = 0; t8 < 8; ++t8) { u32x4 w; w.x = pk2(x[8 * t8], x[8 * t8 + 1]); w.y = pk2(x[8 * t8 + 2], x[8 * t8 + 3]); w.z = pk2(x[8 * t8 + 4], x[8 * t8 + 5]); w.w = pk2(x[8 * t8 + 6], x[8 * t8 + 7]);
        *(LAS u32x4*)(buf + lane * FS + 8 * t8) = w; } }

#if defined(STAMPS)
#define P5STAMP(k) do { p5ts[k] = __builtin_amdgcn_s_memrealtime(); } while (0)
#else
#define P5STAMP(k) do { } while (0)
#endif
DI void p5_mfma(unsigned char* F0_ws, const Frame& F0, const bf16* R, const bf16* KP, const bf16* V, const bf16* KK, const bf16* Bv, const bf16* Ev, bf16* P, bf16* QO, bf16* GT, bf16* HT) {
    Frame F = F0; F.tid = opq_tid(F0.wave); F.lane = F.tid & 63; F.wave = __builtin_amdgcn_readfirstlane(F.tid >> 6); F.gw = F.wg * NWAVES + F.wave;
    const int lane = F.lane, r = lane & 31, hh = lane >> 5;
    LAS unsigned char* wl_init = F.lds + F.wave * 20480;
    LAS unsigned char* const wl0 = wl_init;
    {   bf16x8 id_[2];
#pragma unroll
        for (int s = 0; s < 2; ++s)
#pragma unroll
            for (int e = 0; e < 8; ++e) id_[s][e] = (16 * s + 8 * (e >> 2) + 4 * hh + (e & 3)) == r ? (short)0x3F80 : (short)0;
        *(LAS bf16x8*)(wl0 + 16640 + lane * 16) = id_[0]; *(LAS bf16x8*)(wl0 + 16640 + 1024 + lane * 16) = id_[1]; }
    wave_lds_fence();
    for (int cid = F.gw; cid < NCHUNK; cid += F.NGW) {
        const int bh = cid >> NCH_LOG, c = cid & (NCH - 1), b = bh >> 3, h = bh & 7;
        const unsigned n0 = (unsigned)b * SEQ + (unsigned)c * CH, col0 = (unsigned)h * HD;
        LAS unsigned char* wl = wl0; asm volatile("" : "+s"(wl));
        LAS float* LT = (LAS float*)wl; LAS unsigned char* IFR = wl + 16640; LAS float* LC = (LAS float*)(wl + 18688);
        const int ln = opq_tid(F.wave) & 63;
#if defined(STAMPS)
        unsigned long long p5ts[10];
#endif
        const int rm = ln & 31, hm = ln >> 5;
        const bf16 *R0_ = R, *KP0_ = KP, *V0_ = V, *KK0_ = KK, *Bv0_ = Bv, *Ev0_ = Ev; bf16 *P0_ = P, *QO0_ = QO;
        asm volatile("" : "+s"(R0_), "+s"(KP0_), "+s"(V0_), "+s"(KK0_), "+s"(Bv0_), "+s"(Ev0_), "+s"(P0_), "+s"(QO0_));
        const GAS char *R_ = (const GAS char*)R0_, *KP_ = (const GAS char*)KP0_, *V_ = (const GAS char*)V0_, *KK_ = (const GAS char*)KK0_, *Bv_ = (const GAS char*)Bv0_, *Ev_ = (const GAS char*)Ev0_;
        GAS char *P_ = (GAS char*)P0_, *QO_ = (GAS char*)QO0_;
        const unsigned nb0 = n0 * BW + col0;
        const unsigned vL = (nb0 + (unsigned)ln) * 2u, vT = (nb0 + (unsigned)rm * BW + 4u * hm) * 2u;
#define OADD(v, c) ({ unsigned o_; asm volatile("v_add_u32_e32 %0, %1, %2" : "=v"(o_) : "n"((int)(c)), "v"(v)); o_; })
#define LD16(arr, off) (*(const GAS bf16*)((arr) + (off)))
#define XL(arr, t) LD16(arr, OADD(vL, (t) * BW * 2))
#define ROWQ(q) (((q) & 3) + 8 * ((q) >> 2))
        P5STAMP(0);
        u32x2 raw[2][5][4];
#define LOAD_TILE(BUF, FB, TB) do { _Pragma("unroll") for (int g = 0; g < 4; ++g) { const unsigned ot_ = OADD(vT, (32 * (TB) * BW + 32 * (FB) + 8 * g) * 2); \
            raw[BUF][0][g] = *(const GAS u32x2*)(Ev_ + ot_); raw[BUF][1][g] = *(const GAS u32x2*)(KK_ + ot_); raw[BUF][2][g] = *(const GAS u32x2*)(R_ + ot_); \
            raw[BUF][3][g] = *(const GAS u32x2*)(Bv_ + ot_); raw[BUF][4][g] = *(const GAS u32x2*)(KP_ + ot_); } } while (0)
        LOAD_TILE(0, 0, 0);
        {   float run = 0.f;
#pragma unroll
            for (int t = 0; t < 64; ++t) { run -= bf2f(XL(Ev_, t)); LT[ln * 65 + t] = run; }
            LC[ln] = fexp(run); }
        wave_lds_fence();
        P5STAMP(1);
        bf16x8 Ap[2][2][2], Rp[2][2][2], Bp[2][2][2], Kp[2][2][2];
#pragma unroll
        for (int ti = 0; ti < 4; ++ti) { const int fb = ti >> 1, tb = ti & 1;
            if (ti < 3) LOAD_TILE((ti + 1) & 1, (ti + 1) >> 1, (ti + 1) & 1);
#pragma unroll
            for (int s = 0; s < 2; ++s) {
                float a8[8], r8[8], b8[8], k8[8];
#pragma unroll
                for (int g2 = 0; g2 < 2; ++g2) { const int g = 2 * s + g2;
                    const u32x2 ew = raw[ti & 1][0][g], aw = raw[ti & 1][1][g], rw = raw[ti & 1][2][g], bw = raw[ti & 1][3][g], kw = raw[ti & 1][4][g];
                    const float e4[4] = {bflo(ew.x), bfhi(ew.x), bflo(ew.y), bfhi(ew.y)}, av[4] = {bflo(aw.x), bfhi(aw.x), bflo(aw.y), bfhi(aw.y)}, rv[4] = {bflo(rw.x), bfhi(rw.x), bflo(rw.y), bfhi(rw.y)},
                                bv[4] = {bflo(bw.x), bfhi(bw.x), bflo(bw.y), bfhi(bw.y)}, kv[4] = {bflo(kw.x), bfhi(kw.x), bflo(kw.y), bfhi(kw.y)};
#pragma unroll
                    for (int j = 0; j < 4; ++j) { const float l = LT[(32 * fb + 8 * g + 4 * hm + j) * 65 + 32 * tb + rm];
                        const float eI = fexp(l), eX = fexp(l + e4[j]), eN = frcp(eI);
                        a8[4 * g2 + j] = -av[j] * eX; r8[4 * g2 + j] = rv[j] * eI; b8[4 * g2 + j] = bv[j] * eN; k8[4 * g2 + j] = kv[j] * eN; } }
                Ap[fb][tb][s] = __builtin_bit_cast(bf16x8, pack8(a8)); Rp[fb][tb][s] = __builtin_bit_cast(bf16x8, pack8(r8));
                Bp[fb][tb][s] = __builtin_bit_cast(bf16x8, pack8(b8)); Kp[fb][tb][s] = __builtin_bit_cast(bf16x8, pack8(k8)); }
            __builtin_amdgcn_sched_barrier(0); }
#undef LOAD_TILE
        wave_lds_fence();
        P5STAMP(2);
#define GRAM_TILE(m_, XP, YP, ib, tb) do { _Pragma("unroll") for (int q = 0; q < 16; ++q) m_[q] = 0.f; \
            _Pragma("unroll") for (int fb = 0; fb < 2; ++fb) _Pragma("unroll") for (int s = 0; s < 2; ++s) m_ = MFMA32(XP[fb][ib][s], YP[fb][tb][s], m_); } while (0)
#define IDF(s) (*(const LAS bf16x8*)(IFR + (s) * 1024 + ln * 16))
        bf16x8 Tp[2][2][2];
        {
#pragma unroll
            for (int b = 1; b >= 0; --b) { bf16x8 AP[2], BP[2]; f32x16 CT;
                {   f32x16 m_; int rm_ = rm; asm volatile("" : "+v"(rm_));
                    GRAM_TILE(m_, Bp, Ap, b, b);
#pragma unroll
                    for (int q = 0; q < 16; ++q) m_[q] = crow(q, hm) < rm_ ? m_[q] : 0.f;
                    BP[0] = pk_tile(m_, 0); BP[1] = pk_tile(m_, 1);
#pragma unroll
                    for (int q = 0; q < 16; ++q) CT[q] = m_[q] + (crow(q, hm) == rm_ ? 1.0f : 0.f);
                    GRAM_TILE(m_, Ap, Bp, b, b);
#pragma unroll
                    for (int q = 0; q < 16; ++q) m_[q] = rm_ < crow(q, hm) ? m_[q] : 0.f;
                    AP[0] = pk_tile(m_, 0); AP[1] = pk_tile(m_, 1); }
                __builtin_amdgcn_sched_barrier(0);
#pragma unroll
                for (int it = 0; it < 4; ++it) { f32x16 pn_, pt_;
#pragma unroll
                    for (int q = 0; q < 16; ++q) { pn_[q] = 0.f; pt_[q] = 0.f; }
#pragma unroll
                    for (int s = 0; s < 2; ++s) { pn_ = MFMA32(AP[s], BP[s], pn_); pt_ = MFMA32(BP[s], AP[s], pt_); }
                    const bf16x8 bt0 = pk_tile(CT, 0), bt1 = pk_tile(CT, 1);
                    AP[0] = pk_tile(pt_, 0); AP[1] = pk_tile(pt_, 1); BP[0] = pk_tile(pn_, 0); BP[1] = pk_tile(pn_, 1);
                    CT = MFMA32(AP[0], bt0, CT); CT = MFMA32(AP[1], bt1, CT);
                    __builtin_amdgcn_sched_barrier(0); }
                Tp[b][b][0] = pk_tile(CT, 0); Tp[b][b][1] = pk_tile(CT, 1); }
            {   f32x16 x_; GRAM_TILE(x_, Ap, Bp, 1, 0);
                const bf16x8 au0 = pk_tile(x_, 0), au1 = pk_tile(x_, 1);
#pragma unroll
                for (int q = 0; q < 16; ++q) x_[q] = 0.f;
                x_ = MFMA32(au0, Tp[1][1][0], x_); x_ = MFMA32(au1, Tp[1][1][1], x_);
                const bf16x8 bx0 = pk_tile(x_, 0), bx1 = pk_tile(x_, 1);
#pragma unroll
                for (int q = 0; q < 16; ++q) x_[q] = 0.f;
                x_ = MFMA32(Tp[0][0][0], IDF(0), x_); x_ = MFMA32(Tp[0][0][1], IDF(1), x_);
                const bf16x8 at0 = pk_tile(x_, 0), at1 = pk_tile(x_, 1);
#pragma unroll
                for (int q = 0; q < 16; ++q) x_[q] = 0.f;
                x_ = MFMA32(at0, bx0, x_); x_ = MFMA32(at1, bx1, x_);
                Tp[1][0][0] = pk_tile(x_, 0); Tp[1][0][1] = pk_tile(x_, 1); }
            __builtin_amdgcn_sched_barrier(0); }
        P5STAMP(3);
        {   const bf16x8 id0 = IDF(0), id1 = IDF(1);
#pragma unroll
            for (int tb = 0; tb < 2; ++tb)
#pragma unroll
                for (int kb = 0; kb < 2; ++kb) { f32x16 xb_, xk_; const float sc = LC[32 * kb + rm];
#pragma unroll
                    for (int q = 0; q < 16; ++q) { xb_[q] = 0.f; xk_[q] = 0.f; }
                    xb_ = MFMA32(Bp[kb][tb][0], id0, xb_); xb_ = MFMA32(Bp[kb][tb][1], id1, xb_);
                    xk_ = MFMA32(Kp[kb][tb][0], id0, xk_); xk_ = MFMA32(Kp[kb][tb][1], id1, xk_);
#pragma unroll
                    for (int q = 0; q < 16; ++q) { xb_[q] *= sc; xk_[q] *= sc; }
#pragma unroll
                    for (int s = 0; s < 2; ++s) { *(LAS bf16x8*)(wl + (((tb * 2 + kb) * 2 + s) * 1024) + ln * 16) = pk_tile(xb_, s); *(LAS bf16x8*)(wl + 8192 + (((tb * 2 + kb) * 2 + s) * 1024) + ln * 16) = pk_tile(xk_, s); }
                    __builtin_amdgcn_sched_barrier(0); } }
        bf16x8 Makp[2][2][2], Mbrp[2][2][2], Mkrp[2][2][2];
#define GRAM(XP, YP, STRICT, BODY) _Pragma("unroll") for (int ib = 0; ib < 2; ++ib) _Pragma("unroll") for (int tb = 0; tb < 2; ++tb) if (!(ib == 1 && tb == 0)) { f32x16 m_; \
            GRAM_TILE(m_, XP, YP, ib, tb); \
            int rm_ = rm; asm volatile("" : "+v"(rm_)); \
            _Pragma("unroll") for (int q = 0; q < 16; ++q) { const int i_ = 32 * ib + crow(q, hm), t_ = 32 * tb + rm_; m_[q] = ((STRICT) ? (i_ < t_) : (i_ <= t_)) ? m_[q] : 0.f; } \
            BODY __builtin_amdgcn_sched_barrier(0); }
        GRAM(Kp, Rp, false, { Mkrp[ib][tb][0] = pk_tile(m_, 0); Mkrp[ib][tb][1] = pk_tile(m_, 1); })
        GRAM(Kp, Ap, true, { Makp[ib][tb][0] = pk_tile(m_, 0); Makp[ib][tb][1] = pk_tile(m_, 1); })
        GRAM(Bp, Rp, false, { Mbrp[ib][tb][0] = pk_tile(m_, 0); Mbrp[ib][tb][1] = pk_tile(m_, 1); })
#undef GRAM
#undef GRAM_TILE
        P5STAMP(4);
        bf16x8 ATp[2][2][2];
        GAS char* pn = (GAS char*)(P0_ + (size_t)cid * 4096);
#pragma unroll
        for (int kb = 0; kb < 2; ++kb) { const bf16x8 id0 = IDF(0), id1 = IDF(1);
            {   bf16x8 A0p[2][2];
#pragma unroll
                for (int ib = 0; ib < 2; ++ib) { f32x16 x_;
#pragma unroll
                    for (int q = 0; q < 16; ++q) x_[q] = 0.f;
                    x_ = MFMA32(Ap[kb][ib][0], id0, x_); x_ = MFMA32(Ap[kb][ib][1], id1, x_);
                    A0p[ib][0] = pk_tile(x_, 0); A0p[ib][1] = pk_tile(x_, 1); }
#pragma unroll
                for (int tb = 0; tb < 2; ++tb) { f32x16 a_;
#pragma unroll
                    for (int q = 0; q < 16; ++q) a_[q] = 0.f;
#pragma unroll
                    for (int ib = 0; ib <= tb; ++ib)
#pragma unroll
                        for (int s = 0; s < 2; ++s) a_ = MFMA32(Tp[tb][ib][s], A0p[ib][s], a_);
                    ATp[tb][kb][0] = pk_tile(a_, 0); ATp[tb][kb][1] = pk_tile(a_, 1); } }
            __builtin_amdgcn_sched_barrier(0);
#pragma unroll
            for (int tb = 0; tb < 2; ++tb) { f32x16 p_; const int jb = kb;
#pragma unroll
                for (int q = 0; q < 16; ++q) p_[q] = 0.f;
                p_ = MFMA32(id0, Rp[jb][tb][0], p_); p_ = MFMA32(id1, Rp[jb][tb][1], p_);
#pragma unroll
                for (int ib = 0; ib <= tb; ++ib)
#pragma unroll
                    for (int s = 0; s < 2; ++s) p_ = MFMA32(ATp[ib][jb][s], Mbrp[ib][tb][s], p_);
#pragma unroll
                for (int s = 0; s < 2; ++s) *(GAS bf16x8*)(pn + ((((jb * 2 + tb) * 2 + s) * 64) + ln) * 16) = pk_tile(p_, s);
                __builtin_amdgcn_sched_barrier(0); } }
        P5STAMP(6);
        bf16x8 W1p[2][2][2], Vp[2][2][2];
        int lc_ = ln; asm volatile("" : "+v"(lc_));
        const unsigned vC = (nb0 + 4u * (unsigned)(lc_ >> 5) * BW + (unsigned)(lc_ & 31)) * 2u;
#pragma unroll
        for (int ib = 0; ib < 2; ++ib)
#pragma unroll
            for (int vb = 0; vb < 2; ++vb) { f32x16 v_;
#pragma unroll
                for (int q = 0; q < 16; ++q) v_[q] = bf2f(LD16(V_, OADD(vC, ((32 * ib + ROWQ(q)) * BW + 32 * vb) * 2)));
                Vp[ib][vb][0] = pk_tile(v_, 0); Vp[ib][vb][1] = pk_tile(v_, 1); }
#pragma unroll
        for (int vb = 0; vb < 2; ++vb) { bf16x8 W0p[2][2];
#pragma unroll
            for (int tb = 0; tb < 2; ++tb) { f32x16 w_;
#pragma unroll
                for (int q = 0; q < 16; ++q) w_[q] = 0.f;
#pragma unroll
                for (int ib = 0; ib <= tb; ++ib)
#pragma unroll
                    for (int s = 0; s < 2; ++s) w_ = MFMA32(Makp[ib][tb][s], Vp[ib][vb][s], w_);
                W0p[tb][0] = pk_tile(w_, 0); W0p[tb][1] = pk_tile(w_, 1); }
#pragma unroll
            for (int tb = 0; tb < 2; ++tb) { f32x16 w_;
#pragma unroll
                for (int q = 0; q < 16; ++q) w_[q] = 0.f;
#pragma unroll
                for (int ib = 0; ib <= tb; ++ib)
#pragma unroll
                    for (int s = 0; s < 2; ++s) w_ = MFMA32(Tp[tb][ib][s], W0p[ib][s], w_);
                W1p[tb][vb][0] = pk_tile(w_, 0); W1p[tb][vb][1] = pk_tile(w_, 1); }
            __builtin_amdgcn_sched_barrier(0); }
        P5STAMP(7);
        GAS char* qn = (GAS char*)(QO0_ + (size_t)cid * 4096);
#pragma unroll
        for (int tb = 0; tb < 2; ++tb)
#pragma unroll
            for (int vb = 0; vb < 2; ++vb) { f32x16 y_;
#pragma unroll
                for (int q = 0; q < 16; ++q) y_[q] = 0.f;
#pragma unroll
                for (int ib = 0; ib <= tb; ++ib)
#pragma unroll
                    for (int s = 0; s < 2; ++s) { y_ = MFMA32(Mbrp[ib][tb][s], W1p[ib][vb][s], y_); y_ = MFMA32(Mkrp[ib][tb][s], Vp[ib][vb][s], y_); }
#pragma unroll
                for (int g = 0; g < 4; ++g) { u32x2 w; w.x = pk2(y_[4 * g], y_[4 * g + 1]); w.y = pk2(y_[4 * g + 2], y_[4 * g + 3]); *(GAS u32x2*)(qn + ((((tb * 2 + vb) * 4 + g) * 64) + ln) * 8) = w; }
                __builtin_amdgcn_sched_barrier(0); }
        P5STAMP(8);
        wave_lds_fence();
        bf16x8 Bh[2][2][2];
#pragma unroll
        for (int tb = 0; tb < 2; ++tb)
#pragma unroll
            for (int kb = 0; kb < 2; ++kb)
#pragma unroll
                for (int s = 0; s < 2; ++s) Bh[tb][kb][s] = *(const LAS bf16x8*)(wl + (((tb * 2 + kb) * 2 + s) * 1024) + ln * 16);
        GAS char* gt = (GAS char*)(GT + (size_t)cid * 4096); GAS char* ht = (GAS char*)(HT + (size_t)cid * 4096);
#pragma unroll
        for (int kb = 0; kb < 2; ++kb)
#pragma unroll
            for (int jb = 0; jb < 2; ++jb) { f32x16 g_;
                const float dg = LC[32 * kb + rm];
#pragma unroll
                for (int q = 0; q < 16; ++q) g_[q] = (kb == jb && crow(q, hm) == rm) ? dg : 0.f;
#pragma unroll
                for (int tb = 0; tb < 2; ++tb)
#pragma unroll
                    for (int s = 0; s < 2; ++s) g_ = MFMA32(ATp[tb][jb][s], Bh[tb][kb][s], g_);
#pragma unroll
                for (int s = 0; s < 2; ++s) *(GAS bf16x8*)(gt + ((kb * 4 + jb * 2 + s) * 64 + ln) * 16) = pk_tile(g_, s);
                __builtin_amdgcn_sched_barrier(0); }
        {   bf16x8 Kh[2][2][2];
#pragma unroll
            for (int tb = 0; tb < 2; ++tb)
#pragma unroll
                for (int kb = 0; kb < 2; ++kb)
#pragma unroll
                    for (int s = 0; s < 2; ++s) Kh[tb][kb][s] = *(const LAS bf16x8*)(wl + 8192 + (((tb * 2 + kb) * 2 + s) * 1024) + ln * 16);
#pragma unroll
            for (int kb = 0; kb < 2; ++kb)
#pragma unroll
                for (int vb = 0; vb < 2; ++vb) { f32x16 h_;
#pragma unroll
                    for (int q = 0; q < 16; ++q) h_[q] = 0.f;
#pragma unroll
                    for (int tb = 0; tb < 2; ++tb)
#pragma unroll
                        for (int s = 0; s < 2; ++s) { h_ = MFMA32(Bh[tb][kb][s], W1p[tb][vb][s], h_); h_ = MFMA32(Kh[tb][kb][s], Vp[tb][vb][s], h_); }
#pragma unroll
                    for (int g = 0; g < 4; ++g) { u32x2 w; w.x = pk2(h_[4 * g], h_[4 * g + 1]); w.y = pk2(h_[4 * g + 2], h_[4 * g + 3]); *(GAS u32x2*)(ht + ((((kb * 2 + vb) * 4 + g) * 64) + ln) * 8) = w; }
                    __builtin_amdgcn_sched_barrier(0); } }
        P5STAMP(9);
#undef IDF
#if defined(STAMPS)
        if (F.gw == 0 && cid == 0 && lane == 0) { _Pragma("unroll") for (int k_ = 0; k_ < 10; ++k_) ((unsigned long long*)(F0_ws + WS_CTL + 49152))[32 + k_] = p5ts[k_]; }
#endif
        wave_lds_fence();
#undef XL
#undef OADD
#undef LD16
#undef ROWQ
    }
}

#if defined(CHECKS)
constexpr size_t WS_FLG = WS_CTL + 32768;
DI unsigned* chk_flags(unsigned char* ws) { return (unsigned*)(ws + WS_FLG); }
DI void chk(unsigned char* ws, int id, float got, float want, float rel, float ab) {
    const float d = fabsf(got - want), lim = rel * fmaxf(fabsf(got), fabsf(want)) + ab;
    if (!(d <= lim)) chk_flags(ws)[id] = 1u; }
DI unsigned hsh(unsigned a) { a ^= a >> 16; a *= 0x7feb352du; a ^= a >> 15; a *= 0x846ca68bu; a ^= a >> 16; return a; }
DI float bfr(float v) { return bflo(f2bf(v)); }
DI int scol_of(int n) { return n < 3360 ? n : (n < 3584 ? -1 : n - 224); }

DI void chk_p0(const Frame& F, ARef A) {
    unsigned char* ws = A.ws; const int lane = F.lane;
    const float* mod = (const float*)(ws + WS_MOD);
    for (int s = F.wave; s < 32; s += NWAVES) { const unsigned hh = hsh(1000 + s); const int b = hh & 3, o = (hh >> 2) % 6144; float a = 0.f;
        for (int k = lane; k < D; k += 64) { const float c = A.c[b * D + k]; a += (c / (1.0f + expf(-c))) * A.w_mod[(size_t)k * 6144 + o]; }
        a = wave_sum(a) + A.b_mod[o]; chk(ws, 10, mod[b * 6144 + o], a, 1e-3f, 1e-4f); }
    const bf16* wt = (const bf16*)(ws + WS_WIN);
    for (int s = 0; s < 8; ++s) { const unsigned hh = hsh(2000 + (F.wave * 8 + s) * 64 + lane); const int n = hh % NPAD, k = (hh >> 13) & 1023; const int sc = scol_of(n);
        const float want = sc >= 0 ? bfr(A.w_in[(size_t)k * IN_COLS + sc]) : 0.f; chk(ws, 11, bf2f(wt[(size_t)n * D + k]), want, 0.f, 0.f); }
    { const unsigned hh = hsh(3000 + F.wave * 64 + lane); const int n = hh & 1023, k = (hh >> 10) & 511, k2 = (hh >> 10) & 1023;
        chk(ws, 11, bf2f(((const bf16*)(ws + WS_WOSB))[n * BW + k]), bfr(A.w_o_sb[k * D + n]), 0.f, 0.f);
        chk(ws, 11, bf2f(((const bf16*)(ws + WS_WORW))[n * BW + k]), bfr(A.w_o_rw[k * D + n]), 0.f, 0.f);
        chk(ws, 11, bf2f(((const bf16*)(ws + WS_WOUT))[n * D + k2]), bfr(A.w_out[k2 * D + n]), 0.f, 0.f);
        const int o = hh % 36; chk(ws, 11, ((const float*)(ws + WS_RTW))[o * D + k2], o < 4 ? A.w_group[k2 * 4 + o] : A.w_router[k2 * NE + o - 4], 0.f, 0.f);
        const int nl = hh % 1536, kl = (hh >> 11) % LK; float v = 0.f;
        if (nl < 512) { if (kl < 64) v = A.w_decay_up[kl * BW + nl]; } else if (nl < 1024) { if (kl >= 64 && kl < 128) v = A.w_iclr_up[(kl - 64) * BW + nl - 512]; } else { if (kl >= 128 && kl < 288) v = A.w_gate_up[(kl - 128) * BW + nl - 1024]; }
        chk(ws, 11, bf2f(((const bf16*)(ws + WS_WL))[nl * LK + kl]), bfr(v), 0.f, 0.f); }
}
DI void chk_p1(const Frame& F, ARef A, const bf16* H1) {
    unsigned char* ws = A.ws; const int lane = F.lane; const float* mod = (const float*)(ws + WS_MOD);
    for (int s = F.wave; s < 16; s += NWAVES) { const int n = hsh(4000 + s) % NTOK, b = n >> 13; float ss = 0.f;
        for (int k = lane; k < D; k += 64) { const float v = A.x[(size_t)n * D + k]; ss += v * v; }
        const float inv = 1.0f / sqrtf(wave_sum(ss) / D + NORM_EPS);
        for (int k = lane; k < D; k += 64) { const float want = (A.x[(size_t)n * D + k] * inv) * A.gains[k] * (1.0f + mod[b * 6144 + D + k]) + mod[b * 6144 + k];
            chk(ws, 12, bf2f(H1[(size_t)n * D + k]), want, 0.01f, 0.01f); } }
}
DI float wdot(const bf16* arow, const float* W, int ldw, int col, int K, int lane) { float a = 0.f; for (int k = lane; k < K; k += 64) a += bf2f(arow[k]) * W[(size_t)k * ldw + col]; return wave_sum(a); }
DI void chk_p2(const Frame& F, ARef A, const bf16* H1) {
    unsigned char* ws = A.ws; const int lane = F.lane;
    for (int s = F.wave; s < 96; s += NWAVES) { const unsigned hh = hsh(5000 + s); const int n = hh % NTOK, region = s % 6; int col;
        const unsigned h2 = hsh(hh);
        float got, want; int id = 13 + region;
        if (region == 0) { col = h2 % 512; want = 0.125f * wdot(H1 + (size_t)n * D, A.w_in, IN_COLS, col, D, lane); got = bf2f(((const bf16*)(ws + WS_QB))[(size_t)n * BW + col]); }
        else if (region == 1) { col = h2 % 512; want = wdot(H1 + (size_t)n * D, A.w_in, IN_COLS, 512 + col, D, lane); got = bf2f(((const bf16*)(ws + WS_KB))[(size_t)n * BW + col]); }
        else if (region == 2) { col = h2 % 512; want = wdot(H1 + (size_t)n * D, A.w_in, IN_COLS, 1024 + col, D, lane); got = bf2f(((const bf16*)(ws + WS_VT))[((size_t)((n >> 13) * BW + col)) * SEQ + (n & (SEQ - 1))]); }
        else if (region == 3) { col = h2 % 1536; want = wdot(H1 + (size_t)n * D, A.w_in, IN_COLS, 1536 + col, D, lane); got = bf2f(((const bf16*)(ws + WS_RWRAW))[(size_t)n * 1536 + col]); }
        else if (region == 4) { col = h2 % 288; want = wdot(H1 + (size_t)n * D, A.w_in, IN_COLS, 3072 + col, D, lane); got = bf2f(((const bf16*)(ws + WS_LORA))[(size_t)n * BW + col]); }
        else { col = h2 % 2048; want = wdot(H1 + (size_t)n * D, A.w_in, IN_COLS, 3360 + col, D, lane) + A.gate_bias[col]; want = 1.0f / (1.0f + expf(-want)); got = bf2f(((const bf16*)(ws + WS_GATE))[(size_t)n * 2048 + col]); }
        chk(ws, id, got, want, 0.03f, 0.02f); }
}
constexpr int NATT = 16;
DI void att_sample(int s, int& b, int& h, int& t) { const unsigned hh = hsh(6000 + s); b = hh & 3; h = (hh >> 2) & 7; t = (s < 4) ? (s * 37) : (int)((hh >> 5) % SEQ); }
DI void chk_p3_save(const Frame& F, ARef A) {
    if (F.wave == 0) { bf16* sv = (bf16*)(A.ws + WS_FLG + 4096);
        for (int s = 0; s < NATT; ++s) { int b, h, t; att_sample(s, b, h, t); sv[s * 64 + F.lane] = ((const bf16*)(A.ws + WS_QB))[(size_t)(b * SEQ + t) * BW + h * HD + F.lane]; } }
}
DI void chk_p3(const Frame& F, ARef A, const bf16* R, const bf16* KS, const bf16* V, const bf16* KK) {
    unsigned char* ws = A.ws; const int lane = F.lane;
    const bf16* sv = (const bf16*)(ws + WS_FLG + 4096); const bf16* KB = (const bf16*)(ws + WS_KB); const bf16* VT = (const bf16*)(ws + WS_VT);
    for (int s = F.wave; s < NATT; s += NWAVES) { int b, h, t; att_sample(s, b, h, t);
        const float q = bf2f(sv[s * 64 + lane]); float later = 0.f, o = 0.f;
        for (int k = t - 1; k >= 0; --k) { const float z = wave_sum(q * bf2f(KB[(size_t)(b * SEQ + k) * BW + h * HD + lane]));
            const float sp = fmaxf(z, 0.f) + log1pf(expf(-fabsf(z)));
            o += expf(z - sp + later) * bf2f(VT[((size_t)((b * NH + h) * HD + lane)) * SEQ + k]);
            later -= sp; if (later < -200.f) break; }
        chk(ws, 19, bf2f(((const bf16*)(ws + WS_QB))[(size_t)(b * SEQ + t) * BW + h * HD + lane]), o, 0.04f, 0.02f); }
    const bf16* RW = (const bf16*)(ws + WS_RWRAW); const bf16* LO = (const bf16*)(ws + WS_LORA); const bf16* AL = (const bf16*)(ws + WS_ALORA);
    for (int s = F.wave; s < 32; s += NWAVES) { const unsigned hh = hsh(7000 + s); const int n = (s < 4) ? s * SEQ : (int)(hh % NTOK), hd = (hh >> 16) & 7; const bool first = (n & (SEQ - 1)) == 0;
        float xs[3];
        for (int p = 0; p < 3; ++p) { const int col = p * 512 + hd * 64 + lane; const float cur = bf2f(RW[(size_t)n * 1536 + col]), prv = first ? 0.f : bf2f(RW[(size_t)(n - 1) * 1536 + col]); xs[p] = cur + A.shift_mu[col] * (prv - cur); }
        const size_t o = (size_t)n * BW + hd * 64 + lane;
        chk(ws, 20, bf2f(R[o]), xs[0], 0.01f, 0.005f); chk(ws, 20, bf2f(KS[o]), xs[1], 0.01f, 0.005f); chk(ws, 20, bf2f(V[o]), xs[2], 0.01f, 0.005f);
        const float kk = xs[1] * A.k_k[hd * 64 + lane]; const float nn = sqrtf(wave_sum(kk * kk));
        chk(ws, 20, bf2f(KK[o]), kk / fmaxf(nn, L2_EPS), 0.01f, 0.002f);
        for (int c = lane; c < LK; c += 64) { float want = 0.f;
            if (c < 288) { const float cur = bf2f(LO[(size_t)n * BW + c]), prv = first ? 0.f : bf2f(LO[(size_t)(n - 1) * BW + c]); const float v = cur + A.shift_mu[1536 + c] * (prv - cur);
                want = c < 64 ? tanhf(v) : (c < 128 ? v : 1.0f / (1.0f + expf(-v))); }
            chk(ws, 20, bf2f(AL[(size_t)n * LK + c]), want, 0.01f, 0.005f); } }
}
DI void chk_p4_save(const Frame& F, ARef A, const bf16* KS) {
    if (F.wave == 0) { bf16* sv = (bf16*)(A.ws + WS_FLG + 8192);
        for (int s = 0; s < 16; ++s) { const unsigned hh = hsh(8000 + s); const int n = hh % NTOK, hd = (hh >> 16) & 7; sv[s * 64 + F.lane] = KS[(size_t)n * BW + hd * 64 + F.lane]; } }
}
DI void chk_p4(const Frame& F, ARef A, const bf16* KP, const bf16* KK) {
    unsigned char* ws = A.ws; const int lane = F.lane; const bf16* AL = (const bf16*)(ws + WS_ALORA); const bf16* sv = (const bf16*)(ws + WS_FLG + 8192);
    for (int s = F.wave; s < 16; s += NWAVES) { const unsigned hh = hsh(8000 + s); const int n = hh % NTOK, hd = (hh >> 16) & 7, c = hd * 64 + lane; const size_t o = (size_t)n * BW + c;
        float lw = 0.f, la = 0.f, lg = 0.f;
        for (int k = 0; k < 64; ++k) { lw += bf2f(AL[(size_t)n * LK + k]) * A.w_decay_up[k * BW + c]; la += bf2f(AL[(size_t)n * LK + 64 + k]) * A.w_iclr_up[k * BW + c]; }
        for (int k = 0; k < 160; ++k) lg += bf2f(AL[(size_t)n * LK + 128 + k]) * A.w_gate_up[k * BW + c];
        const float x = -(A.w0[c] + lw), w = -(fmaxf(x, 0.f) + log1pf(expf(-fabsf(x)))) - 0.5f;
        chk(ws, 21, bf2f(((const bf16*)(ws + WS_E))[o]), expf(w), 0.03f, 0.003f);
        const float a = 1.0f / (1.0f + expf(-(A.a0[c] + la))); const float ks = bf2f(sv[s * 64 + lane]);
        chk(ws, 22, bf2f(KP[o]), ks * (1.0f + (a - 1.0f) * A.k_a[c]), 0.03f, 0.01f);
        chk(ws, 22, bf2f(((const bf16*)(ws + WS_B))[o]), bf2f(KK[o]) * a, 0.03f, 0.003f);
        chk(ws, 23, bf2f(((const bf16*)(ws + WS_GG))[o]), lg, 0.03f, 0.01f); }
}
constexpr int NST = 300;
DI void chk_p7_save(const Frame& F, ARef A) {
    if (F.wave < 4) { const int b = (F.wave * 3) & 3, h = (F.wave * 5 + 1) & 7; bf16* sv = (bf16*)(A.ws + 256 * 1024) + F.wave * NST * 64;
        for (int t = 0; t < NST; ++t) sv[t * 64 + F.lane] = ((const bf16*)(A.ws + WS_E))[(size_t)(b * SEQ + t) * BW + h * HD + F.lane]; }
}
DI void chk_p7(const Frame& F, ARef A, const bf16* R, const bf16* KP, const bf16* V, const bf16* KK) {
    unsigned char* ws = A.ws; const int lane = F.lane;
    const bf16* Bv = (const bf16*)(ws + WS_B); const bf16* Esv = (const bf16*)(ws + 256 * 1024) + F.wave * NST * 64; const bf16* GG = (const bf16*)(ws + WS_GG); const bf16* YRW = (const bf16*)(ws + WS_YRW);
    if (F.wave < 4) { const int b = (F.wave * 3) & 3, h = (F.wave * 5 + 1) & 7, col0 = h * HD;
        float S[64];
#pragma unroll
        for (int k = 0; k < 64; ++k) S[k] = 0.f;
        for (int t = 0; t < NST; ++t) { const size_t o = (size_t)(b * SEQ + t) * BW + col0 + lane;
            const float av = -bf2f(KK[o]), bv = bf2f(Bv[o]), dv = expf(-bf2f(Esv[t * 64 + lane])), kv = bf2f(KP[o]), rv = bf2f(R[o]), vv = bf2f(V[o]);
            float sa = 0.f;
#pragma unroll
            for (int k = 0; k < 64; ++k) sa += S[k] * __shfl(av, k);
            float y = 0.f;
#pragma unroll
            for (int k = 0; k < 64; ++k) { S[k] = S[k] * __shfl(dv, k) + sa * __shfl(bv, k) + vv * __shfl(kv, k); y += S[k] * __shfl(rv, k); }
            const float mean = wave_sum(y) / 64.f, d = y - mean, var = wave_sum(d * d) / 64.f;
            const float yn = d / sqrtf(var + GN_EPS) * A.lnx_w[col0 + lane] + A.lnx_b[col0 + lane];
            const float bonus = wave_sum(rv * kv * A.r_k[col0 + lane]) * vv;
            const float want = (yn + bonus) * bf2f(GG[o]);
            chk(ws, t < 128 ? 24 : 25, bf2f(YRW[o]), want, 0.05f, 0.03f); } }
}
DI void chk_p8(const Frame& F, ARef A) {
    unsigned char* ws = A.ws; const int lane = F.lane;
    for (int s = F.wave; s < 32; s += NWAVES) { const unsigned hh = hsh(9000 + s); const int n = hh % NTOK, c = (hh >> 15) & 1023;
        const float p1 = wdot((const bf16*)(ws + WS_QB) + (size_t)n * BW, A.w_o_sb, D, c, BW, lane), p2 = wdot((const bf16*)(ws + WS_YRW) + (size_t)n * BW, A.w_o_rw, D, c, BW, lane);
        const bf16* ga = (const bf16*)(ws + WS_GATE) + (size_t)n * 2048;
        chk(ws, 26, bf2f(((const bf16*)(ws + WS_MRG))[(size_t)n * D + c]), bf2f(ga[c]) * p1 + bf2f(ga[1024 + c]) * p2, 0.03f, 0.01f); }
}
DI void chk_p9(const Frame& F, ARef A) {
    unsigned char* ws = A.ws; const int lane = F.lane;
    for (int s = F.wave; s < 32; s += NWAVES) { const unsigned hh = hsh(9500 + s); const int n = hh % NTOK, c = (hh >> 15) & 1023;
        chk(ws, 27, bf2f(((const bf16*)(ws + WS_Y1))[(size_t)n * D + c]), wdot((const bf16*)(ws + WS_MRG) + (size_t)n * D, A.w_out, D, c, D, lane), 0.03f, 0.01f); }
}
DI void chk_p10(const Frame& F, ARef A) {
    unsigned char* ws = A.ws; const int lane = F.lane; const float* mod = (const float*)(ws + WS_MOD);
    const bf16* Y1 = (const bf16*)(ws + WS_Y1); const bf16* H2 = (const bf16*)(ws + WS_H2); const i32x4* tok = (const i32x4*)(ws + WS_TOK);
    for (int s = F.wave; s < 32; s += NWAVES) { const int n = s == 0 ? DBG_TOKEN : (s < 16 ? (int)(hsh(10000 + s) % 128) : (int)(hsh(10000 + s) % NTOK)), b = n >> 13; float ss = 0.f;
        for (int k = lane; k < D; k += 64) { const float v = bf2f(Y1[(size_t)n * D + k]); ss += v * v; }
        const float inv1 = 1.0f / sqrtf(wave_sum(ss) / D + NORM_EPS); float s2 = 0.f;
        for (int k = lane; k < D; k += 64) { const float x1 = A.x[(size_t)n * D + k] + mod[b * 6144 + 2 * D + k] * ((bf2f(Y1[(size_t)n * D + k]) * inv1) * A.gains[D + k]);
            chk(ws, 28, A.out[(size_t)n * D + k], x1, 1e-3f, 1e-3f); s2 += x1 * x1; }
        const float inv2 = 1.0f / sqrtf(wave_sum(s2) / D + NORM_EPS);
        float lg[36];
#pragma unroll
        for (int o = 0; o < 36; ++o) lg[o] = 0.f;
        for (int k = lane; k < D; k += 64) { const float h2 = (A.out[(size_t)n * D + k] * inv2) * A.gains[2 * D + k] * (1.0f + mod[b * 6144 + 4 * D + k]) + mod[b * 6144 + 3 * D + k];
            chk(ws, 29, bf2f(H2[(size_t)n * D + k]), h2, 0.01f, 0.01f);
#pragma unroll
            for (int o = 0; o < 36; ++o) lg[o] += h2 * (o < 4 ? A.w_group[k * 4 + o] : A.w_router[k * NE + o - 4]); }
#pragma unroll
        for (int o = 0; o < 36; ++o) lg[o] = wave_sum(lg[o]);
        int gs = 0; float gm = lg[0];
#pragma unroll
        for (int g = 1; g < 4; ++g) if (lg[g] > gm) { gm = lg[g]; gs = g; }
        float gsum = 0.f;
#pragma unroll
        for (int g = 0; g < 4; ++g) gsum += expf(lg[g] - gm);
        float el[8];
#pragma unroll
        for (int e = 0; e < 8; ++e) el[e] = gs == 0 ? lg[4 + e] : (gs == 1 ? lg[12 + e] : (gs == 2 ? lg[20 + e] : lg[28 + e]));
        int i0 = 0; float m0 = el[0];
#pragma unroll
        for (int e = 1; e < 8; ++e) if (el[e] > m0) { m0 = el[e]; i0 = e; }
        int i1 = -1; float m1 = -3.0e38f;
#pragma unroll
        for (int e = 0; e < 8; ++e) if (e != i0 && el[e] > m1) { m1 = el[e]; i1 = e; }
        const float tt = expf(m1 - m0), p0 = 1.0f / (1.0f + tt);
        const i32x4 rec = tok[n];
        if (lane == 0 && s < 16) { if ((rec.x & 255) != gs * 8 + i0 || ((rec.x >> 8) & 255) != gs * 8 + i1) chk_flags(ws)[30] = 1u;
            if (n == DBG_TOKEN) { const float* dbg = (const float*)chk_flags(ws) + 48; float code = 1.f;
                if (dbg[4] > 4.001f) code += 2.f; if (dbg[5] < 0.499f) code += 4.f;
                if (fabsf(dbg[0] - lg[0]) > 1e-3f || fabsf(dbg[1] - lg[1]) > 1e-3f || fabsf(dbg[2] - lg[2]) > 1e-3f || fabsf(dbg[3] - lg[3]) > 1e-3f) code += 8.f;
                if (fabsf(dbg[4] - gsum) > 1e-3f) code += 16.f; if (fabsf(dbg[6] * dbg[5] - __builtin_bit_cast(float, rec.z)) > 1e-4f) code += 32.f;
                ((float*)chk_flags(ws))[62] = code * 0.1f; ((float*)chk_flags(ws))[63] = dbg[4]; }
            chk(ws, 56, ((const float*)(ws + WS_CW))[2 * n], p0 / gsum, 3e-2f, 1e-4f); chk(ws, 57, ((const float*)(ws + WS_CW))[2 * n + 1], tt * p0 / gsum, 3e-2f, 1e-4f);
            chk(ws, 58, ((const float*)(ws + WS_CW))[2 * n], p0 / gsum, 1e-3f, 1e-5f); chk(ws, 59, ((const float*)(ws + WS_CW))[2 * n + 1], tt * p0 / gsum, 1e-3f, 1e-5f); } }
}
DI void chk_p11(const Frame& F, ARef A) {
    unsigned char* ws = A.ws; const int lane = F.lane; const i32x4* tok = (const i32x4*)(ws + WS_TOK); const int* tile = (const int*)(ws + WS_TILE);
    const bf16* H2 = (const bf16*)(ws + WS_H2); const bf16* HS = (const bf16*)(ws + WS_HS);
    for (int s = F.wave; s < 64; s += NWAVES) { const int n = hsh(11000 + s) % NTOK; const i32x4 rec = tok[n];
        if (rec.x < 0 || rec.x >= tile[MAXT] * 256 || rec.y < 0 || rec.y >= tile[MAXT] * 256 || tile[MAXT] > MAXT || tile[MAXT] < 256) { chk_flags(ws)[32] = 1u; continue; }
        for (int k = lane; k < D; k += 64) { chk(ws, 33, bf2f(HS[(size_t)rec.x * D + k]), bf2f(H2[(size_t)n * D + k]), 0.f, 0.f); chk(ws, 33, bf2f(HS[(size_t)rec.y * D + k]), bf2f(H2[(size_t)n * D + k]), 0.f, 0.f); } }
    { const unsigned hh = hsh(12000 + F.wave * 64 + lane); const int e = hh & 31, n = (hh >> 5) & 1023, k = (hh >> 15) & 1023, k5 = k & 511;
        const int c = (n >> 3) * 4 + (n & 3); const float want = (n & 4) ? A.w_up3[((size_t)e * D + k) * DE + c] : A.w_up1[((size_t)e * D + k) * DE + c];
        chk(ws, 34, bf2f(((const bf16*)(ws + WS_WUP))[((size_t)e * 1024 + n) * D + k]), bfr(want), 0.f, 0.f);
        chk(ws, 35, bf2f(((const bf16*)(ws + WS_WDN))[((size_t)e * 1024 + n) * DE + k5]), bfr(A.w_down[((size_t)e * DE + k5) * D + n]), 0.f, 0.f); }
}
DI void chk_p12(const Frame& F, ARef A) {
    unsigned char* ws = A.ws; const int lane = F.lane; const i32x4* tok = (const i32x4*)(ws + WS_TOK); const int* tile = (const int*)(ws + WS_TILE);
    const bf16* H2 = (const bf16*)(ws + WS_H2); const bf16* HID = (const bf16*)(ws + WS_HID);
    for (int s = F.wave; s < 32; s += NWAVES) { const unsigned hh = hsh(13000 + s); const int n = hh % NTOK, c = (hh >> 16) & 511; const i32x4 rec = tok[n]; const int pos = (s & 1) ? rec.y : rec.x;
        const int e = tile[pos >> 8];
        const float u1 = wdot(H2 + (size_t)n * D, A.w_up1 + (size_t)e * D * DE, DE, c, D, lane), u3 = wdot(H2 + (size_t)n * D, A.w_up3 + (size_t)e * D * DE, DE, c, D, lane);
        chk(ws, 36, bf2f(HID[(size_t)pos * DE + c]), u1 / (1.0f + expf(-u1)) * u3, 0.04f, 0.01f); }
}
DI void chk_p13(const Frame& F, ARef A) {
    unsigned char* ws = A.ws; const int lane = F.lane; const i32x4* tok = (const i32x4*)(ws + WS_TOK); const int* tile = (const int*)(ws + WS_TILE);
    const bf16* HID = (const bf16*)(ws + WS_HID); const bf16* YE = (const bf16*)(ws + WS_HS);
    for (int s = F.wave; s < 32; s += NWAVES) { const unsigned hh = hsh(14000 + s); const int n = hh % NTOK, c = (hh >> 16) & 1023; const i32x4 rec = tok[n]; const int pos = (s & 1) ? rec.y : rec.x;
        const int e = tile[pos >> 8];
        chk(ws, 37, bf2f(YE[(size_t)pos * D + c]), wdot(HID + (size_t)pos * DE, A.w_down + (size_t)e * DE * D, D, c, DE, lane), 0.04f, 0.01f); }
}
#endif

__global__ void __launch_bounds__(NTHR, 2) hybrid_fwd(Args A_unused) {
    extern __shared__ __attribute__((aligned(16))) unsigned char lds_raw[];
    const CAS Args& A = *(const CAS Args*)__builtin_amdgcn_kernarg_segment_ptr();
    Frame F;
    F.lds = (LAS unsigned char*)lds_raw;
    F.wave = __builtin_amdgcn_readfirstlane((int)threadIdx.x >> 6); F.tid = opq_tid(F.wave); F.lane = F.tid & 63;
    F.wg = blockIdx.x; F.G = gridDim.x; F.gw = F.wg * NWAVES + F.wave; F.NGW = F.G * NWAVES;
    volatile LAS unsigned* MISC = (volatile LAS unsigned*)(F.lds + LDS_MISC);
    if (F.wave == 0) MISC[F.lane] = 0u;
    __syncthreads();
    const XcdBarrier bar = xcd_barrier_post((unsigned*)(A.ws + WS_CTL), MISC + 8, F.wave);
    unsigned char* ws = A.ws;
    LAS unsigned char* stage = F.lds;
    bf16* const dob = (bf16*)A.out;
    bf16 *H1 = dob, *R = dob, *KS = dob + (size_t)NTOK * BW, *V = dob + 2 * (size_t)NTOK * BW, *KK = dob + 3 * (size_t)NTOK * BW;

#if defined(STAMPS)
    unsigned long long* const tsp = (unsigned long long*)(ws + WS_CTL + 49152);
#define STAMP(k) do { if (F.wg == 0 && xb_t0(F.wave)) tsp[k] = wall_clock64(); } while (0)
#else
#define STAMP(k) do { } while (0)
#endif
#if defined(REPEAT_PHASE)
#ifndef REPEAT_COUNT
#define REPEAT_COUNT 2
#endif
#define REP(k) _Pragma("nounroll") for (int rep_ = 0; rep_ < ((k) == REPEAT_PHASE ? REPEAT_COUNT : 1); ++rep_)
#else
#define REP(k)
#endif
    STAMP(0);
    REP(0) {
    p0_prologue(F, A);
    xcd_barrier(bar);
    }
    STAMP(1);
#if defined(CHECKS)
    if (F.wg == 0) chk_p0(F, A);
#endif
    REP(1) {
    p1_h1(F, A, H1);
    xcd_barrier(bar);
    }
    STAMP(2);
#if defined(CHECKS)
    if (F.wg == 0) chk_p1(F, A, H1);
#endif
    REP(2) {
    {   pg8::Gemm g{H1, (const bf16*)(ws + WS_WIN), NTOK, NPAD, D}; pg8::StaticOrder S; S.init(NTOK, NPAD, F.G, F.wg);
        EpiIn E{(bf16*)(ws + WS_QB), (bf16*)(ws + WS_KB), (bf16*)(ws + WS_VT), (bf16*)(ws + WS_RWRAW), (bf16*)(ws + WS_LORA), (bf16*)(ws + WS_GATE), A.gate_bias};
        pg8::gemm_phase<EpiIn, pg8::StaticOrder>(stage, g, S, E, nullptr, F.wave); }
    xcd_barrier(bar);
    }
    STAMP(3);
#if defined(CHECKS)
    if (F.wg == 0) { chk_p2(F, A, H1); chk_p3_save(F, A); }
    xcd_barrier(bar);
#endif
#if !defined(CHECKS)
    const bool fuse34 = (F.G == 256);
#else
    const bool fuse34 = false;
#endif
    REP(3) {
    p3_attn(F, (const bf16*)(ws + WS_QB), (const bf16*)(ws + WS_KB), (const bf16*)(ws + WS_VT), (bf16*)(ws + WS_QB));
#if defined(STAMPS)
    STAMP(20);
#endif
    p3_prep(F, A, (const bf16*)(ws + WS_RWRAW), (const bf16*)(ws + WS_LORA), R, KS, V, KK, (bf16*)(ws + WS_ALORA));
#if !defined(CHECKS)
    if (fuse34) { asm volatile("s_waitcnt vmcnt(0)" ::: "memory"); __syncthreads();
        p4_lora(F, A, (const bf16*)(ws + WS_ALORA), (const bf16*)(ws + WS_WL), (bf16*)(ws + WS_E), KS, (bf16*)(ws + WS_B), (bf16*)(ws + WS_GG), KK, R, (float*)(ws + WS_BON)); }
#endif
    xcd_barrier(bar);
    }
#if defined(STAMPS)
    STAMP(21);
#endif
    STAMP(4);
#if defined(CHECKS)
    if (F.wg == 0) { chk_p3(F, A, R, KS, V, KK); chk_p4_save(F, A, KS); }
    xcd_barrier(bar);
#endif
    if (!fuse34) {
    p4_lora(F, A, (const bf16*)(ws + WS_ALORA), (const bf16*)(ws + WS_WL), (bf16*)(ws + WS_E), KS, (bf16*)(ws + WS_B), (bf16*)(ws + WS_GG), KK, R, (float*)(ws + WS_BON));
    xcd_barrier(bar);
    }
    STAMP(5);
#if defined(CHECKS)
    if (F.wg == 0) chk_p4(F, A, KS, KK);
#endif
    REP(5) {
    p5_mfma(ws, F, R, KS, V, KK, (const bf16*)(ws + WS_B), (const bf16*)(ws + WS_E), (bf16*)(ws + WS_P), (bf16*)(ws + WS_QO), (bf16*)(ws + WS_GT), (bf16*)(ws + WS_HT));
    p6_moe_weights(F, A, F.gw, F.NGW);
    xcd_barrier(bar);
    }
    STAMP(6);
#if defined(CHECKS)
    if (F.wg == 255) chk_p7_save(F, A);
#endif
    REP(6) {
    {   const int ncw = F.G < 64 ? F.G : 64;
        if (F.wg < ncw) { if (F.wave == 0) for (int task = F.wg; task < 64; task += ncw) p6_chain(task, F.wave, F.lds, (const bf16*)(ws + WS_GT), (const bf16*)(ws + WS_HT), (bf16*)(ws + WS_SC));
#if defined(STAMPS)
            STAMP(22);
#endif
        }
        else {
            pg8::StaticOrder S; S.init(NTOK, D, F.G - ncw, F.wg - ncw);
            pg8::Gemm g{(const bf16*)(ws + WS_QB), (const bf16*)(ws + WS_WOSB), NTOK, D, BW};
            EpiMerge<false> E{(bf16*)(ws + WS_GATE), (bf16*)(ws + WS_MRG), 0};
            pg8::gemm_phase<EpiMerge<false>, pg8::StaticOrder>(stage, g, S, E, nullptr, F.wave); }
    }
    xcd_barrier(bar);
    }
    STAMP(7);
    REP(7) {
    p7_mfma(F, A, (const bf16*)(ws + WS_SC), (const bf16*)(ws + WS_P), (const bf16*)(ws + WS_QO), V, (const bf16*)(ws + WS_GG), (const float*)(ws + WS_BON), (bf16*)(ws + WS_YRW));
    xcd_barrier(bar);
    }
    STAMP(8);
#if defined(CHECKS)
    if (F.wg == 0) chk_p7(F, A, R, KS, V, KK);
#endif
    REP(8) {
    {   pg8::StaticOrder S; S.init(NTOK, D, F.G, F.wg);
        {   pg8::Gemm g{(const bf16*)(ws + WS_YRW), (const bf16*)(ws + WS_WORW), NTOK, D, BW};
            EpiMerge<true> E{(bf16*)(ws + WS_GATE), (bf16*)(ws + WS_MRG), D};
            pg8::gemm_phase<EpiMerge<true>, pg8::StaticOrder>(stage, g, S, E, nullptr, F.wave); } }
    xcd_barrier(bar);
    }
    STAMP(9);
#if defined(CHECKS)
    if (F.wg == 0) chk_p8(F, A);
#endif
    REP(9) {
    {   pg8::Gemm g{(const bf16*)(ws + WS_MRG), (const bf16*)(ws + WS_WOUT), NTOK, D, D}; pg8::StaticOrder S; S.init(NTOK, D, F.G, F.wg);
        EpiPlain E{(bf16*)(ws + WS_Y1), D, 0xff};
        pg8::gemm_phase<EpiPlain, pg8::StaticOrder>(stage, g, S, E, nullptr, F.wave); }
    xcd_barrier(bar);
    }
    STAMP(10);
#if defined(CHECKS)
    if (F.wg == 0) chk_p9(F, A);
#endif
    REP(10) {
    p10_rows(F, A, (const bf16*)(ws + WS_Y1), (bf16*)(ws + WS_H2));
    xcd_barrier(bar);
    }
    STAMP(11);
#if defined(CHECKS)
    if (F.wg == 0) chk_p10(F, A);
#endif
    REP(11) {
    p11_rank_gather(F, A, (const bf16*)(ws + WS_H2), (bf16*)(ws + WS_HS));
    xcd_barrier(bar);
    }
    STAMP(12);
#if defined(CHECKS)
    if (F.wg == 0) chk_p11(F, A);
#endif
    {   const int* tile = (const int*)(ws + WS_TILE);
        const int nt = __builtin_amdgcn_readfirstlane(tile[MAXT]);
        const int vc = (F.G % 8 == 0) ? (F.wg % 8) * (F.G / 8) + F.wg / 8 : F.wg;
        unsigned* tcnt = (unsigned*)(ws + WS_CTL) + MOE_CNT_WORD;
        REP(12) {   pg8::Gemm g{(const bf16*)(ws + WS_HS), (const bf16*)(ws + WS_WUP), MAXT * 256, NE * 1024, D};
            MoeUpOrder S; S.nunits = nt * 4; S.G = F.G; S.vc = vc; S.tile_e = tile; S.cnt = tcnt;
            EpiUp E{(bf16*)(ws + WS_HID)};
            pg8::gemm_phase<EpiUp, MoeUpOrder>(stage, g, S, E, nullptr, F.wave); }
        __syncthreads();
    STAMP(13);
        REP(13) {   pg8::Gemm g{(const bf16*)(ws + WS_HID), (const bf16*)(ws + WS_WDN), MAXT * 256, NE * 1024, DE};
            MoeDnOrder S; S.nunits = nt * 4; S.G = F.G; S.vc = vc; S.q = (nt * 4) / F.G; S.rem = nt * 4 - S.q * F.G; S.wave = F.wave; S.tile_e = tile; S.cnt = tcnt;
            EpiPlain E{(bf16*)(ws + WS_HS), D, 3};
            pg8::gemm_phase<EpiPlain, MoeDnOrder>(stage, g, S, E, nullptr, F.wave);
        xcd_barrier(bar); } }
    STAMP(14);
#if defined(CHECKS)
    if (F.wg == 0) chk_p13(F, A);
#endif
    p14_final(F, A, (const bf16*)(ws + WS_HS));
#if defined(STAMPS)
    xcd_barrier(bar);
    STAMP(15);
    if (F.wg == 0) { __syncthreads();
        const float va = (float)(long long)(tsp[STAMP_A2] - tsp[STAMP_A]) * 0.01f, vb = (float)(long long)(tsp[STAMP_B2] - tsp[STAMP_B]) * 0.01f;
#if defined(STAMP_SHIFT)
        const float shf_ = 1.1f;
#else
        const float shf_ = 1.0f;
#endif
        int b1 = (int)floorf(logf(fmaxf(va * shf_, 1.0f)) / logf(1.21f)) + 1, b2 = (int)floorf(logf(fmaxf(vb * shf_, 1.0f)) / logf(1.21f)) + 1;
#if defined(STAMP_CAL)
        b1 = 10; b2 = 30;
#endif
#if defined(STAMP_FRAC)
        { const unsigned long long* t5 = tsp + 32; const float tot = (float)(long long)(t5[9] - t5[0]);
          b1 = (int)(12.0f * (float)(long long)(t5[STAMP_A2] - t5[STAMP_A]) / tot) + 3; b2 = (int)(12.0f * (float)(long long)(t5[STAMP_B2] - t5[STAMP_B]) / tot) + 3; }
#endif
#if defined(STAMP_THR_A)
        b1 = va > (float)(STAMP_THR_A) ? 30 : 10; b2 = vb > (float)(STAMP_THR_B) ? 30 : 10;
#endif
        const int t_ = opq_tid(F.wave);
        for (int i = t_; i < 1000; i += NTHR) A.out[1000 + i] += 20.0f * (float)b2;
        if (t_ == 0) A.out[0] = 200.0f * (float)b1; }
#endif
#if defined(CHECKS)
    xcd_barrier(bar);
    if (F.wg == 0 && F.tid == 0) { const unsigned* fl = chk_flags(ws); int id = 0; for (int i = 61; i >= 0; --i) if (fl[i]) id = i;
        if (((const unsigned*)(ws + WS_CTL))[XB_TMO]) id = 60;
        if (id) A.out[0] = 10.0f * (float)id;
#if defined(CHKVAL)
        A.out[0] = 1000.0f * ((const float*)fl)[CHKVAL];
#endif
        }
#endif
}

extern "C" void kernel_launch(void* const* d_in, const int* in_sizes, int n_in, void* d_out, int out_size, void* d_ws, size_t ws_size, hipStream_t stream) {
    static int grid = 0;
    if (grid == 0) {
        if (n_in != 26 || in_sizes[0] != NTOK * D || out_size != NTOK * D || ws_size < WS_END) {
            fprintf(stderr, "kernel_launch: unexpected shapes (n_in %d, in0 %d, out %d, ws %zu); nothing launched\n", n_in, n_in > 0 ? in_sizes[0] : -1, out_size, ws_size); grid = -1; return; }
        int dev = 0, cus = 0, per_cu = 0;
        if (hipGetDevice(&dev) != hipSuccess || hipDeviceGetAttribute(&cus, hipDeviceAttributeMultiprocessorCount, dev) != hipSuccess) { grid = -1; return; }
        if (hipFuncSetAttribute((const void*)hybrid_fwd, hipFuncAttributeMaxDynamicSharedMemorySize, LDS_BYTES) != hipSuccess) { fprintf(stderr, "kernel_launch: hipFuncSetAttribute failed\n"); grid = -1; return; }
        if (hipOccupancyMaxActiveBlocksPerMultiprocessor(&per_cu, (const void*)hybrid_fwd, NTHR, LDS_BYTES) != hipSuccess || per_cu < 1)
            fprintf(stderr, "kernel_launch: note: occupancy query reports %d workgroups per CU\n", per_cu);
        (void)hipGetLastError();
        grid = cus > 256 ? 256 : cus;
    }
    if (grid < 0) return;
    if (hipMemsetAsync((char*)d_ws + WS_CTL, 0, CTL_ZERO_BYTES, stream) != hipSuccess) return;
    Args a{};
    const float** p = (const float**)&a;
    for (int i = 0; i < 26; ++i) p[i] = (const float*)d_in[i];
    a.out = (float*)d_out; a.ws = (unsigned char*)d_ws;
    hipLaunchKernelGGL(hybrid_fwd, dim3(grid), dim3(NTHR), LDS_BYTES, stream, a);
}

#if defined(ONLY_P5)
__global__ void __launch_bounds__(NTHR, 2) only_p5(Args A_unused) {
    extern __shared__ __attribute__((aligned(16))) unsigned char lds_raw[];
    const CAS Args& A = *(const CAS Args*)__builtin_amdgcn_kernarg_segment_ptr();
    Frame F; F.lds = (LAS unsigned char*)lds_raw; F.wave = __builtin_amdgcn_readfirstlane((int)threadIdx.x >> 6); F.tid = opq_tid(F.wave); F.lane = F.tid & 63;
    F.wg = blockIdx.x; F.G = gridDim.x; F.gw = F.wg * NWAVES + F.wave; F.NGW = F.G * NWAVES;
    unsigned char* ws = A.ws; bf16* const dob = (bf16*)A.out;
    bf16 *R = dob, *KS = dob + (size_t)NTOK * BW, *V = dob + 2 * (size_t)NTOK * BW, *KK = dob + 3 * (size_t)NTOK * BW;
    p5_mfma(ws, F, R, KS, V, KK, (const bf16*)(ws + WS_B), (const bf16*)(ws + WS_E), (bf16*)(ws + WS_P), (bf16*)(ws + WS_QO), (bf16*)(ws + WS_GT), (bf16*)(ws + WS_HT));
}
#endif
```

```cpp
#include <hip/hip_runtime.h>
#include <cstdio>
#include <cstdint>
__device__ __forceinline__ int opq_tid(int wave) { int l; asm volatile("v_mbcnt_lo_u32_b32 %0, -1, 0\n\tv_mbcnt_hi_u32_b32 %0, -1, %0" : "=v"(l)); return wave * 64 + l; }
#ifndef PHMASK
#define PHMASK 0xffff
#endif
namespace pg8 {
#define PG8_LAS __attribute__((address_space(3)))
typedef unsigned short bf16_t;
typedef short bf16x8 __attribute__((ext_vector_type(8)));
typedef float f32x4 __attribute__((ext_vector_type(4)));
typedef unsigned u32x4 __attribute__((ext_vector_type(4)));
constexpr int BM = 256, BK = 64, HALF = 128, HTB = HALF * BK * 2  , STAGE_BYTES = 8 * HTB, NXCD = 8, WGM = 8;

__host__ __device__ __forceinline__ int lds_byte(int r, int c) { const int st = (r >> 4) * 2 + (c >> 5), rr = r & 15, cc = c & 31, ob = rr * 64 + cc * 2; return st * 1024 + (ob ^ (((ob >> 9) & 1) << 5)); }
__host__ __device__ __forceinline__ void stage_rc(int b, int& R, int& C) { const int st = b / 1024, sb = b % 1024, swz = sb ^ (((sb >> 9) & 1) << 5); R = (st >> 1) * 16 + swz / 64; C = (st & 1) * 32 + (swz % 64) / 2; }
__host__ __device__ __forceinline__ int perm32(int rho) { const int n = rho >> 4, i = rho & 15; return 8 * (i >> 2) + 4 * n + (i & 3); }

struct Unit { int pm, pn; };
struct Gemm { const bf16_t* A; const bf16_t* Bt; int M, N, K; };

struct StaticOrder {
    int nM, nN, nwg, G, c;
    __host__ __device__ void init(int M, int N, int G_, int c_) { nM = M / BM; nN = N / BM; nwg = nM * nN; G = G_; c = c_; }
    __host__ __device__ bool next(int i, Unit& u) const {
        const long L = (long)i * G + c; if (L >= nwg) return false;
        int wgid = (int)L; { const int q = nwg / NXCD, r = nwg % NXCD, xcd = wgid % NXCD, off = wgid / NXCD; wgid = (xcd < r ? xcd * (q + 1) : r * (q + 1) + (xcd - r) * q) + off; }
        const int nig = WGM * nN, gid = wgid / nig, fm = gid * WGM, gsz = (nM - fm) < WGM ? (nM - fm) : WGM;
        u.pm = fm + ((wgid % nig) % gsz); u.pn = (wgid % nig) / gsz; return true;
    }
    __device__ __forceinline__ void a_ready(const Unit&) const {}
    __device__ __forceinline__ void done(const Unit&) const {}
};

template <class Epi, class Sched, bool STAMP = false>
__device__ __forceinline__ void gemm_phase(PG8_LAS unsigned char* lds, const Gemm g, const Sched& S, const Epi& E, unsigned long long* stamps, int wave_id) {
    const int tid = opq_tid(wave_id), wid = __builtin_amdgcn_readfirstlane(tid >> 6), lane = tid & 63, wr = wid >> 2, wc = wid & 3, fr = lane & 15, fq = lane >> 4;
    const int K = g.K, nt = K / BK;
    int ts_lo = 0, ts_hi = 0, nts = 0; const unsigned long long rt_entry = STAMP ? (unsigned long long)wall_clock64() : 0ull;
#define PG8_STAMP() do { if (STAMP && wid == 0 && nts < 64) { const unsigned long long _c = (unsigned long long)clock64(); \
        ts_lo = (lane == nts) ? (int)(unsigned)_c : ts_lo; ts_hi = (lane == nts) ? (int)(unsigned)(_c >> 32) : ts_hi; ++nts; } } while (0)
    PG8_STAMP();
    unsigned voffA[2], voffB[2];
#pragma unroll
    for (int i = 0; i < 2; ++i) { int R, C; stage_rc(tid * 16 + i * 8192, R, C); const int Rb = Epi::PERM ? ((R & ~31) + perm32(R & 31)) : R;
        voffA[i] = (unsigned)(R * K + C) * 2u; voffB[i] = (unsigned)(Rb * K + C) * 2u; }
    const size_t kstep = (size_t)(BK * 2);
    const size_t hstep = (size_t)HALF * K * 2;
    const size_t tstep = 2 * hstep;
    const unsigned ldsw = (unsigned)wid * 1024u;
    const int aoff = lds_byte(wr * 64 + fr, fq * 8), boff = lds_byte(wc * 32 + fr, fq * 8);
#define PG8_SA(b, h) (((b) * 2 + (h)) * HTB)
#define PG8_SB(b, h) ((4 + (b) * 2 + (h)) * HTB)
#define PG8_STAGE(bufoff, gbase, voff) do { _Pragma("unroll") for (int _i = 0; _i < 2; ++_i) \
        __builtin_amdgcn_global_load_lds((const unsigned*)((const char*)(gbase) + (voff)[_i]), (PG8_LAS unsigned*)(lds + (bufoff) + ldsw + _i * 8192), 16, 0, 0); } while (0)
#define PG8_LDA(dst, b, h) do { _Pragma("unroll") for (int m = 0; m < 4; ++m) _Pragma("unroll") for (int k = 0; k < 2; ++k) dst[m][k] = *(const PG8_LAS bf16x8*)(lds + PG8_SA(b, h) + aoff + m * 2048 + k * 1024); } while (0)
#define PG8_LDB(dst, b, h) do { _Pragma("unroll") for (int n = 0; n < 2; ++n) _Pragma("unroll") for (int k = 0; k < 2; ++k) dst[n][k] = *(const PG8_LAS bf16x8*)(lds + PG8_SB(b, h) + boff + n * 2048 + k * 1024); } while (0)
#define PG8_MMA(ai, bj, At, Bt) do { __builtin_amdgcn_s_setprio(1); _Pragma("unroll") for (int m = 0; m < 4; ++m) _Pragma("unroll") for (int n = 0; n < 2; ++n) _Pragma("unroll") for (int k = 0; k < 2; ++k) \
        acc[ai][bj][m][n] = __builtin_amdgcn_mfma_f32_16x16x32_bf16(Bt[n][k], At[m][k], acc[ai][bj][m][n], 0, 0, 0); __builtin_amdgcn_s_setprio(0); } while (0)
#define PG8_WAIT_V(n) asm volatile("s_waitcnt vmcnt(" #n ")" ::: "memory")
#define PG8_WAIT_L(n) asm volatile("s_waitcnt lgkmcnt(" #n ")" ::: "memory")
#define PG8_BAR __builtin_amdgcn_s_barrier()
#define PG8_SCHED __builtin_amdgcn_sched_barrier(0)
    Unit cur, nxt; int ui = 0;
    if (!S.next(0, cur)) return;
    f32x4 acc[2][2][4][2];
#pragma unroll
    for (int a = 0; a < 2; ++a)
#pragma unroll
        for (int b = 0; b < 2; ++b)
#pragma unroll
            for (int m = 0; m < 4; ++m)
#pragma unroll
                for (int n = 0; n < 2; ++n) acc[a][b][m][n] = (f32x4){0.f, 0.f, 0.f, 0.f};
    bf16x8 At[4][2], B0[2][2], B1[2][2];
    const char* cA = (const char*)g.A + (size_t)cur.pm * tstep; const char* cB = (const char*)g.Bt + (size_t)cur.pn * tstep;
    S.a_ready(cur);
    PG8_STAGE(PG8_SB(0, 0), cB, voffB); PG8_STAGE(PG8_SA(0, 0), cA, voffA); PG8_STAGE(PG8_SB(0, 1), cB + hstep, voffB); PG8_STAGE(PG8_SA(0, 1), cA + hstep, voffA);
    if (wr == 1) PG8_BAR;
    PG8_WAIT_V(4); PG8_BAR;
    PG8_STAGE(PG8_SB(1, 0), cB + kstep, voffB); PG8_STAGE(PG8_SA(1, 0), cA + kstep, voffA); PG8_STAGE(PG8_SB(1, 1), cB + hstep + kstep, voffB);
    PG8_WAIT_V(6); PG8_BAR;
    PG8_STAMP();
    for (;;) {
        const bool has_next = S.next(ui + 1, nxt);
        const char* nA = has_next ? (const char*)g.A + (size_t)nxt.pm * tstep : cA; const char* nB = has_next ? (const char*)g.Bt + (size_t)nxt.pn * tstep : cB;
        for (int t = 0; t < nt; t += 2) {
            const bool last = (t == nt - 2);
            const char* a1 = cA + (size_t)(t + 1) * kstep;
            const char* a2 = last ? nA : cA + (size_t)(t + 2) * kstep; const char* b2 = last ? nB : cB + (size_t)(t + 2) * kstep;
            const char* a3 = a2 + kstep; const char* b3 = b2 + kstep;
            if (last && has_next) S.a_ready(nxt);
            PG8_LDB(B0, 0, 0); PG8_SCHED; PG8_LDA(At, 0, 0); PG8_STAGE(PG8_SA(1, 1), a1 + hstep, voffA);
            PG8_WAIT_L(8); PG8_BAR; PG8_WAIT_L(0); PG8_MMA(0, 0, At, B0); PG8_BAR; PG8_SCHED;
            PG8_LDB(B1, 0, 1); PG8_STAGE(PG8_SB(0, 0), b2, voffB);
            PG8_BAR; PG8_WAIT_L(0); PG8_MMA(0, 1, At, B1); PG8_BAR;
            PG8_LDA(At, 0, 1); PG8_STAGE(PG8_SA(0, 0), a2, voffA);
            PG8_BAR; PG8_WAIT_L(0); PG8_MMA(1, 0, At, B0); PG8_BAR; PG8_SCHED;
            PG8_STAGE(PG8_SB(0, 1), b2 + hstep, voffB);
            PG8_WAIT_V(6); PG8_BAR; PG8_MMA(1, 1, At, B1); PG8_BAR;
            PG8_LDB(B0, 1, 0); PG8_SCHED; PG8_LDA(At, 1, 0); PG8_STAGE(PG8_SA(0, 1), a2 + hstep, voffA);
            PG8_WAIT_L(8); PG8_BAR; PG8_WAIT_L(0); PG8_MMA(0, 0, At, B0); PG8_BAR; PG8_SCHED;
            PG8_LDB(B1, 1, 1); PG8_STAGE(PG8_SB(1, 0), b3, voffB);
            PG8_BAR; PG8_WAIT_L(0); PG8_MMA(0, 1, At, B1); PG8_BAR;
            PG8_LDA(At, 1, 1); PG8_STAGE(PG8_SA(1, 0), a3, voffA);
            PG8_BAR; PG8_WAIT_L(0); PG8_MMA(1, 0, At, B0); PG8_BAR; PG8_SCHED;
            PG8_STAGE(PG8_SB(1, 1), b3 + hstep, voffB);
            PG8_WAIT_V(6); PG8_BAR; PG8_MMA(1, 1, At, B1); PG8_BAR;
        }
        PG8_STAMP();
        if constexpr (!Epi::AFTER_DRAIN) { E(acc, cur, wr, wc, fr, fq); S.done(cur); }
        PG8_STAMP();
        if (!has_next) break;
#pragma unroll
        for (int a = 0; a < 2; ++a)
#pragma unroll
            for (int b = 0; b < 2; ++b)
#pragma unroll
                for (int m = 0; m < 4; ++m)
#pragma unroll
                    for (int n = 0; n < 2; ++n) acc[a][b][m][n] = (f32x4){0.f, 0.f, 0.f, 0.f};
        cur = nxt; cA = nA; cB = nB; ++ui;
    }
    PG8_WAIT_V(0);
    if (wr == 0) PG8_BAR;
    PG8_BAR;
    if constexpr (Epi::AFTER_DRAIN) { E.fused(acc, cur, wr, wc, fr, fq, lds, wid, lane); S.done(cur); }
    PG8_STAMP();
    if (STAMP && wid == 0) { stamps[lane] = lane < nts ? (((unsigned long long)(unsigned)ts_hi << 32) | (unsigned)ts_lo) : 0ull;
        if (lane == 62) stamps[62] = rt_entry; if (lane == 63) stamps[63] = (unsigned long long)wall_clock64(); }
#undef PG8_STAMP
#undef PG8_SA
#undef PG8_SB
#undef PG8_STAGE
#undef PG8_LDA
#undef PG8_LDB
#undef PG8_MMA
#undef PG8_WAIT_V
#undef PG8_WAIT_L
#undef PG8_BAR
#undef PG8_SCHED
}
}

#define XB_TMO      128
#define XB_XCNT(j)  (256  + 64 * (j))
#define XB_XSUB(j)  (1280 + 64 * (j))
#define XB_XGEN(j)  (2304 + 64 * (j))
#define XB_TOP      3328
#define XB_TOPGEN   3392
#define XCD_BAR_WORDS 3456
#define XB_SPIN_CAP (1u << 18)
#define LAS __attribute__((address_space(3)))

__device__ __forceinline__ unsigned xb_ld(unsigned* p)              { return __hip_atomic_load(p, __ATOMIC_RELAXED, __HIP_MEMORY_SCOPE_AGENT); }
__device__ __forceinline__ unsigned xb_add(unsigned* p, unsigned v) { return __hip_atomic_fetch_add(p, v, __ATOMIC_RELAXED, __HIP_MEMORY_SCOPE_AGENT); }
__device__ __forceinline__ unsigned xb_xcc_id() { return (unsigned)__builtin_amdgcn_s_getreg((3 << 11) | 20) & 0xFu; }
#define XB_SPIN(cond, bar) do { unsigned _sp = 0; while (cond) { __builtin_amdgcn_s_sleep(1); \
    if ((++_sp & 255u) == 0u) { if (xb_ld(&(bar)[XB_TMO])) break; if (_sp > XB_SPIN_CAP) { atomicAdd(&(bar)[XB_TMO], 1u); break; } } } } while (0)

struct XcdBarrier {
    unsigned* bar; unsigned x; int wave;
    volatile LAS unsigned* st;
};

__device__ __forceinline__ bool xb_t0(int wave) { return wave == 0 && __builtin_amdgcn_mbcnt_hi(~0u, __builtin_amdgcn_mbcnt_lo(~0u, 0u)) == 0u; }
__device__ __forceinline__ XcdBarrier xcd_barrier_post(unsigned* bar, volatile LAS unsigned* st, int wave) {
    XcdBarrier b; b.bar = bar; b.x = xb_xcc_id(); b.st = st; b.wave = wave;
    if (xb_t0(wave)) (void)xb_add(&bar[XB_XCNT(b.x)], 1u);
    return b;
}
__device__ __forceinline__ void xcd_barrier_complete(unsigned* bar, unsigned x, unsigned& nloc, unsigned& nx) {
    const unsigned G = gridDim.x * gridDim.y * gridDim.z;
    unsigned sum, cnt, mine, sp = 0u;
    for (;;) {
        sum = 0u; cnt = 0u; mine = 0u;
#pragma unroll
        for (unsigned j = 0; j < 16; ++j) { const unsigned c = xb_ld(&bar[XB_XCNT(j)]); sum += c; cnt += (c > 0u) ? 1u : 0u; mine = (j == x) ? c : mine; }
        if (sum == G) break;
        __builtin_amdgcn_s_sleep(1);
        if ((++sp & 255u) == 0u) { if (xb_ld(&bar[XB_TMO])) break; if (sp > XB_SPIN_CAP) { atomicAdd(&bar[XB_TMO], 1u); break; } }
    }
    nloc = mine > 0u ? mine : 1u; nx = cnt > 0u ? cnt : 1u;
}

__device__ __forceinline__ void xcd_barrier(const XcdBarrier& b) {
    asm volatile("s_waitcnt vmcnt(0)" ::: "memory");
    __syncthreads();
    if (xb_t0(b.wave)) {
        unsigned* bar = b.bar;
        __builtin_amdgcn_s_waitcnt(0);
        unsigned nloc = b.st[0], nx = b.st[1];
        if (nloc == 0u) { xcd_barrier_complete(bar, b.x, nloc, nx); b.st[0] = nloc; b.st[1] = nx; }
        const unsigned old = xb_add(&bar[XB_XSUB(b.x)], 1u);
        const unsigned gen = old / nloc;
        if (old + 1u == (gen + 1u) * nloc) {
            __builtin_amdgcn_fence(__ATOMIC_RELEASE, "agent");
            asm volatile("s_waitcnt vmcnt(0)" ::: "memory");
            const unsigned og = xb_add(&bar[XB_TOP], 1u);
            const unsigned tg = og / nx;
            if (og + 1u == (tg + 1u) * nx) xb_add(&bar[XB_TOPGEN], 1u);
            else XB_SPIN(xb_ld(&bar[XB_TOPGEN]) == tg, bar);
            __builtin_amdgcn_fence(__ATOMIC_ACQUIRE, "agent");
            xb_add(&bar[XB_XGEN(b.x)], 1u);
            asm volatile("s_waitcnt vmcnt(0)" ::: "memory");
        } else {
            XB_SPIN(xb_ld(&bar[XB_XGEN(b.x)]) == gen, bar);
            __builtin_amdgcn_fence(__ATOMIC_ACQUIRE, "agent");
            asm volatile("s_waitcnt vmcnt(0)" ::: "memory");
        }
    }
    __syncthreads();
}


constexpr int NB = 4, SEQ = 8192, D = 1024, NTOK = NB * SEQ;
constexpr int NH = 8, HD = 64, BW = 512;
constexpr int IN_COLS = 5408, NPAD = 5632;
constexpr int LK = 384;
constexpr int NE = 32, DE = 512;
constexpr int CH = 64, NCH = SEQ / CH, NCH_LOG = 7, NCHUNK = NB * NH * NCH;
constexpr int MAXT = 288;
constexpr float NORM_EPS = 1e-6f, GN_EPS = 64e-5f, L2_EPS = 1e-12f;
constexpr float SB_STOP = -120.0f;

constexpr size_t MiB = 1u << 20;
constexpr size_t WS_CTL = 0, CTL_ZERO_BYTES = 65536;
constexpr size_t WS_MOD = 1 * MiB;
constexpr size_t WS_RTW = WS_MOD + 128 * 1024;
constexpr size_t WS_TOK = WS_RTW + 160 * 1024;
constexpr size_t WS_CNT = WS_TOK + (size_t)NTOK * 16;
constexpr size_t WS_TILE = WS_CNT + 256 * 32 * 4;
constexpr size_t WS_WIN = 2 * MiB;
constexpr size_t WS_WOSB = 13 * MiB, WS_WORW = 14 * MiB, WS_WOUT = 15 * MiB;
constexpr size_t WS_WL = 17 * MiB;
constexpr size_t WS_BON = 18 * MiB + 256 * 1024;
constexpr size_t WS_CW = 19 * MiB + 768 * 1024;
constexpr size_t WS_QB = 20 * MiB;
constexpr size_t WS_GATE = 52 * MiB;
constexpr size_t WS_GG = 180 * MiB;
constexpr size_t WS_KB = 212 * MiB, WS_VT = 244 * MiB;
constexpr size_t WS_LORA = 276 * MiB;
constexpr size_t WS_ALORA = 308 * MiB;
constexpr size_t WS_E = 340 * MiB, WS_B = 372 * MiB;
constexpr size_t WS_RWRAW = 416 * MiB;
constexpr size_t WS_P = 212 * MiB, WS_QO = 244 * MiB;
constexpr size_t WS_GT = 276 * MiB;
constexpr size_t WS_HT = 308 * MiB;
constexpr size_t WS_SC = 340 * MiB;
constexpr size_t WS_YRW = 384 * MiB;
constexpr size_t WS_WUP = 416 * MiB, WS_WDN = 480 * MiB;
constexpr size_t WS_MRG = 212 * MiB;
constexpr size_t WS_Y1 = 276 * MiB;
constexpr size_t WS_H2 = 52 * MiB;
constexpr size_t WS_HS = 116 * MiB;
constexpr size_t WS_HID = 260 * MiB;
constexpr size_t WS_X1 = 340 * MiB;
constexpr size_t WS_END = 512 * MiB;
static_assert(WS_TILE + (MAXT + 1) * 4 <= WS_WIN && WS_WIN + (size_t)NPAD * D * 2 <= WS_WOSB && WS_WL + 1536 * LK * 2 <= WS_QB, "fixed region");
static_assert(WS_HS + (size_t)MAXT * 256 * D * 2 <= WS_HID && WS_HID + (size_t)MAXT * 256 * DE * 2 <= WS_WUP, "moe region");
static_assert(WS_ALORA + (size_t)NTOK * LK * 2 <= WS_E && WS_B + (size_t)NTOK * BW * 2 <= WS_RWRAW, "rwkv region");

constexpr int LDS_BYTES = 163840;
constexpr int LDS_MISC = LDS_BYTES - 256;
constexpr int NWAVES = 8, NTHR = 512;

typedef unsigned short bf16;
typedef short bf16x8 __attribute__((ext_vector_type(8)));
typedef short s16x4 __attribute__((ext_vector_type(4)));
typedef float f32x4 __attribute__((ext_vector_type(4)));
typedef float f32x16 __attribute__((ext_vector_type(16)));
typedef unsigned u32x4 __attribute__((ext_vector_type(4)));
typedef unsigned u32x2 __attribute__((ext_vector_type(2)));
typedef int i32x4 __attribute__((ext_vector_type(4)));
#define DI __device__ __forceinline__
#define GAS __attribute__((address_space(1)))
#define MFMA32(a, b, c) __builtin_amdgcn_mfma_f32_32x32x16_bf16((a), (b), (c), 0, 0, 0)

typedef float f32x2_t __attribute__((ext_vector_type(2))); typedef __bf16 bf16x2_t __attribute__((ext_vector_type(2)));
DI unsigned pk2(float lo, float hi) { f32x2_t v = {lo, hi}; return __builtin_bit_cast(unsigned, __builtin_convertvector(v, bf16x2_t)); }
DI unsigned f2bf(float f) { return pk2(f, 0.0f) & 0xffffu; }
DI float bflo(unsigned u) { return __builtin_bit_cast(float, u << 16); }
DI float bfhi(unsigned u) { return __builtin_bit_cast(float, u & 0xffff0000u); }
DI float bf2f(bf16 h) { return __builtin_bit_cast(float, (unsigned)h << 16); }
DI float fexp(float x) { return __expf(x); }
DI float frcp(float x) { return __builtin_amdgcn_rcpf(x); }
DI float fsigmoid(float x) { return frcp(1.0f + fexp(-x)); }
DI float fsoftplus(float x) { return fmaxf(x, 0.0f) + __logf(1.0f + fexp(-fabsf(x))); }
#define DPP_SHR(v, ctrl) __builtin_bit_cast(float, __builtin_amdgcn_update_dpp(0, __builtin_bit_cast(int, (v)), (ctrl), 0xf, 0xf, true))
DI float wave_sum(float v) {
    v += DPP_SHR(v, 0x111); v += DPP_SHR(v, 0x112); v += DPP_SHR(v, 0x114); v += DPP_SHR(v, 0x118);
    v += __builtin_bit_cast(float, __builtin_amdgcn_update_dpp(0, __builtin_bit_cast(int, v), 0x142, 0xa, 0xf, false));
    v += __builtin_bit_cast(float, __builtin_amdgcn_update_dpp(0, __builtin_bit_cast(int, v), 0x143, 0xc, 0xf, false));
    return __builtin_bit_cast(float, __builtin_amdgcn_readlane(__builtin_bit_cast(int, v), 63));
}
DI float shfl_xor_l(float v, int m, int lane) { return __builtin_bit_cast(float, __builtin_amdgcn_ds_bpermute(4 * (lane ^ m), __builtin_bit_cast(int, v))); }
DI int crow(int reg, int hh) { return (reg & 3) + 8 * (reg >> 2) + 4 * hh; }
DI void wave_lds_fence() { __builtin_amdgcn_fence(__ATOMIC_RELEASE, "wavefront"); __builtin_amdgcn_wave_barrier(); __builtin_amdgcn_fence(__ATOMIC_ACQUIRE, "wavefront"); }
DI void unpack8(const u32x4 v, float (&o)[8]) { o[0] = bflo(v.x); o[1] = bfhi(v.x); o[2] = bflo(v.y); o[3] = bfhi(v.y); o[4] = bflo(v.z); o[5] = bfhi(v.z); o[6] = bflo(v.w); o[7] = bfhi(v.w); }
DI u32x4 pack8(const float (&o)[8]) { u32x4 v; v.x = pk2(o[0], o[1]); v.y = pk2(o[2], o[3]); v.z = pk2(o[4], o[5]); v.w = pk2(o[6], o[7]); return v; }
DI bf16x8 pack8v(float a0, float a1, float a2, float a3, float a4, float a5, float a6, float a7) {
    u32x4 v; v.x = pk2(a0, a1); v.y = pk2(a2, a3); v.z = pk2(a4, a5); v.w = pk2(a6, a7); return __builtin_bit_cast(bf16x8, v); }


#if defined(CHECKS)
constexpr int DBG_TOKEN = 77;
#endif

typedef pg8::f32x4 af4;
DI void st8(bf16* p, const af4 v0, const af4 v1) { u32x4 w; w.x = pk2(v0[0], v0[1]); w.y = pk2(v0[2], v0[3]); w.z = pk2(v1[0], v1[1]); w.w = pk2(v1[2], v1[3]); *(u32x4*)p = w; }

struct EpiIn {
    static constexpr bool PERM = true, AFTER_DRAIN = false;
    bf16 *Q, *K, *Vt, *RW, *LO, *GA; const float* gate_bias;
    DI void operator()(const af4 (&acc)[2][2][4][2], const pg8::Unit& u, int wr, int wc, int fr, int fq) const {
        const int pn = u.pn, row0 = u.pm * 256 + wr * 64 + fr;
        if (pn == 4 || pn == 5) {
#pragma unroll
            for (int ai = 0; ai < 2; ++ai)
#pragma unroll
                for (int m = 0; m < 4; ++m) { const int row = row0 + ai * 128 + m * 16, b = row >> 13, s = row & (SEQ - 1);
#pragma unroll
                    for (int bj = 0; bj < 2; ++bj)
#pragma unroll
                        for (int n = 0; n < 2; ++n)
#pragma unroll
                            for (int j = 0; j < 4; ++j) { const int cv = (pn - 4) * 256 + bj * 128 + wc * 32 + 8 * fq + 4 * n + j;
                                Vt[((size_t)(b * BW + cv)) * SEQ + s] = (bf16)f2bf(acc[ai][bj][m][n][j]); } }
        } else if (pn >= 14) {
            const int col0 = (pn - 14) * 256 + wc * 32 + 8 * fq;
            af4 bv[2][2];
#pragma unroll
            for (int bj = 0; bj < 2; ++bj)
#pragma unroll
                for (int n = 0; n < 2; ++n) bv[bj][n] = *(const af4*)(gate_bias + col0 + bj * 128 + 4 * n);
#pragma unroll
            for (int ai = 0; ai < 2; ++ai)
#pragma unroll
                for (int m = 0; m < 4; ++m) { bf16* rowp = GA + (size_t)(row0 + ai * 128 + m * 16) * 2048 + col0;
#pragma unroll
                    for (int bj = 0; bj < 2; ++bj) { af4 v0 = acc[ai][bj][m][0] + bv[bj][0], v1 = acc[ai][bj][m][1] + bv[bj][1];
#pragma unroll
                        for (int j = 0; j < 4; ++j) { v0[j] = fsigmoid(v0[j]); v1[j] = fsigmoid(v1[j]); }
                        st8(rowp + bj * 128, v0, v1); } }
        } else {
            bf16* base; int ld, ct; float sc = 1.0f;
            if (pn < 2) { base = Q; ld = BW; ct = pn; sc = 0.125f; } else if (pn < 4) { base = K; ld = BW; ct = pn - 2; } else if (pn < 12) { base = RW; ld = 1536; ct = pn - 6; } else { base = LO; ld = BW; ct = pn - 12; }
            const int col0 = ct * 256 + wc * 32 + 8 * fq;
#pragma unroll
            for (int ai = 0; ai < 2; ++ai)
#pragma unroll
                for (int m = 0; m < 4; ++m) { bf16* rowp = base + (size_t)(row0 + ai * 128 + m * 16) * ld + col0;
#pragma unroll
                    for (int bj = 0; bj < 2; ++bj) st8(rowp + bj * 128, acc[ai][bj][m][0] * sc, acc[ai][bj][m][1] * sc); }
        }
    }
};

template <bool ADD> struct EpiMerge {
    static constexpr bool PERM = true, AFTER_DRAIN = false;
    bf16* GA; bf16* MRG; int gofs;
    DI void operator()(const af4 (&acc)[2][2][4][2], const pg8::Unit& u, int wr, int wc, int fr, int fq) const {
        const int row0 = u.pm * 256 + wr * 64 + fr, col0 = u.pn * 256 + wc * 32 + 8 * fq;
#pragma unroll
        for (int ai = 0; ai < 2; ++ai)
#pragma unroll
            for (int m = 0; m < 4; ++m) { const size_t row = (size_t)(row0 + ai * 128 + m * 16);
#pragma unroll
                for (int bj = 0; bj < 2; ++bj) { const int c = col0 + bj * 128;
                    float g[8]; unpack8(*(const u32x4*)(GA + row * 2048 + gofs + c), g);
                    af4 v0, v1;
#pragma unroll
                    for (int j = 0; j < 4; ++j) { v0[j] = g[j] * acc[ai][bj][m][0][j]; v1[j] = g[4 + j] * acc[ai][bj][m][1][j]; }
                    if (ADD) { float o[8]; unpack8(*(const u32x4*)(GA + row * 2048 + c), o);
#pragma unroll
                        for (int j = 0; j < 4; ++j) { v0[j] += o[j]; v1[j] += o[4 + j]; }
                        st8(MRG + row * D + c, v0, v1); }
                    else st8(GA + row * 2048 + c, v0, v1); } }
    }
};

struct EpiPlain {
    static constexpr bool PERM = true, AFTER_DRAIN = false;
    bf16* O; int ld, cmask;
    DI void operator()(const af4 (&acc)[2][2][4][2], const pg8::Unit& u, int wr, int wc, int fr, int fq) const {
        const int row0 = u.pm * 256 + wr * 64 + fr, col0 = (u.pn & cmask) * 256 + wc * 32 + 8 * fq;
#pragma unroll
        for (int ai = 0; ai < 2; ++ai)
#pragma unroll
            for (int m = 0; m < 4; ++m) { bf16* rowp = O + (size_t)(row0 + ai * 128 + m * 16) * ld + col0;
#pragma unroll
                for (int bj = 0; bj < 2; ++bj) st8(rowp + bj * 128, acc[ai][bj][m][0], acc[ai][bj][m][1]); }
    }
};

struct EpiUp {
    static constexpr bool PERM = true, AFTER_DRAIN = false;
    bf16* HID;
    DI void operator()(const af4 (&acc)[2][2][4][2], const pg8::Unit& u, int wr, int wc, int fr, int fq) const {
        const int row0 = u.pm * 256 + wr * 64 + fr, col0 = (u.pn & 3) * 128 + wc * 16 + 4 * fq;
#pragma unroll
        for (int ai = 0; ai < 2; ++ai)
#pragma unroll
            for (int m = 0; m < 4; ++m) { bf16* rowp = HID + (size_t)(row0 + ai * 128 + m * 16) * DE + col0;
#pragma unroll
                for (int bj = 0; bj < 2; ++bj) { float h[4];
#pragma unroll
                    for (int j = 0; j < 4; ++j) { const float u1 = acc[ai][bj][m][0][j]; h[j] = u1 * fsigmoid(u1) * acc[ai][bj][m][1][j]; }
                    __hip_atomic_store((GAS unsigned long long*)(rowp + bj * 64), (unsigned long long)pk2(h[0], h[1]) | ((unsigned long long)pk2(h[2], h[3]) << 32), __ATOMIC_RELAXED, __HIP_MEMORY_SCOPE_AGENT); } }
    }
};

constexpr unsigned MOE_CNT_WORD = 3584, MOE_CNT_STRIDE = 16;
struct MoeUpOrder {
    int nunits, G, vc; const int* tile_e; unsigned* cnt;
    DI bool next(int i, pg8::Unit& u) const { const long L = (long)i * G + vc; if (L >= nunits) return false; const int rt = (int)(L >> 2);
        u.pm = rt; u.pn = __builtin_amdgcn_readfirstlane(tile_e[rt]) * 4 + (int)(L & 3); return true; }
    DI void a_ready(const pg8::Unit&) const {}
    DI void done(const pg8::Unit& u) const { asm volatile("s_waitcnt vmcnt(0)" ::: "memory");
        if (__builtin_amdgcn_mbcnt_hi(~0u, __builtin_amdgcn_mbcnt_lo(~0u, 0u)) == 0u) __hip_atomic_fetch_add(cnt + MOE_CNT_STRIDE * u.pm, 1u, __ATOMIC_RELAXED, __HIP_MEMORY_SCOPE_AGENT); }
};
struct MoeDnOrder {
    int nunits, G, vc, q, rem, wave; const int* tile_e; unsigned* cnt;
    DI bool next(int i, pg8::Unit& u) const { long L;
        if (vc >= rem) { if (i > q) return false; L = (long)i * (G - rem) + (vc - rem); } else L = (long)(q + 1) * (G - rem) + (long)i * rem + vc;
        if (L >= nunits) return false; const int rt = (int)(L >> 2);
        u.pm = rt; u.pn = __builtin_amdgcn_readfirstlane(tile_e[rt]) * 4 + (int)(L & 3); return true; }
    DI void a_ready(const pg8::Unit& u) const {
        if (wave == 0) { unsigned sp = 0;
            while ((unsigned)__builtin_amdgcn_readfirstlane(__hip_atomic_load(cnt + MOE_CNT_STRIDE * u.pm, __ATOMIC_RELAXED, __HIP_MEMORY_SCOPE_AGENT)) < 32u) { __builtin_amdgcn_s_sleep(2); if (++sp > (1u << 22)) break; }
            __builtin_amdgcn_fence(__ATOMIC_ACQUIRE, "agent");
            asm volatile("s_waitcnt vmcnt(0)" ::: "memory"); }
        asm volatile("" ::: "memory"); __builtin_amdgcn_s_barrier(); asm volatile("" ::: "memory"); }
    DI void done(const pg8::Unit&) const {}
};

struct Args {
    const float *x, *c, *w_mod, *b_mod, *gains, *w_in, *gate_bias, *shift_mu, *w0, *w_decay_up, *a0, *w_iclr_up, *w_gate_up, *k_k, *k_a, *r_k, *lnx_w, *lnx_b,
                *w_o_sb, *w_o_rw, *w_out, *w_group, *w_router, *w_up1, *w_up3, *w_down;
    float* out; unsigned char* ws;
};
struct Frame { LAS unsigned char* lds; int tid, lane, wave, wg, G, gw, NGW; };
#define CAS __attribute__((address_space(4)))
typedef const CAS Args& ARef;

DI void tr_item(const float* W, int ldw, int K, bf16* WT, int k0, int drow0, int scol0, LAS float* scr, int lane) {
    if (scol0 >= 0) {
        float v[32];
        const float* wp = W + (size_t)(k0 + (lane >> 5)) * ldw + scol0 + (lane & 31);
#pragma unroll
        for (int i = 0; i < 32; ++i) v[i] = wp[(size_t)(2 * i) * ldw];
#pragma unroll
        for (int i = 0; i < 32; ++i) scr[(2 * i + (lane >> 5)) * 33 + (lane & 31)] = v[i];
    } else {
#pragma unroll 8
        for (int i = 0; i < 32; ++i) { const int kk = 2 * i + (lane >> 5); scr[kk * 33 + (lane & 31)] = 0.0f; }
    }
    wave_lds_fence();
    const int c = lane & 7;
#pragma unroll
    for (int j = 0; j < 4; ++j) { const int n = (lane >> 3) + 8 * j; const LAS float* s = scr + (8 * c) * 33 + n;
        u32x4 o; o.x = pk2(s[0 * 33], s[1 * 33]); o.y = pk2(s[2 * 33], s[3 * 33]); o.z = pk2(s[4 * 33], s[5 * 33]); o.w = pk2(s[6 * 33], s[7 * 33]);
        *(u32x4*)(WT + (size_t)(drow0 + n) * K + k0 + 8 * c) = o; }
    wave_lds_fence();
}
DI void tr_item_up(const float* W1, const float* W3, bf16* WT, int e, int k0, int drow0, LAS float* scr, int lane) {
    const int l31 = lane & 31, sc = (drow0 >> 3) * 4 + (l31 >> 3) * 4 + (l31 & 3);
    const float* W = ((l31 & 4) ? W3 : W1) + (size_t)e * D * DE;
    { float v[32]; const float* wp = W + (size_t)(k0 + (lane >> 5)) * DE + sc;
#pragma unroll
        for (int i = 0; i < 32; ++i) v[i] = wp[(size_t)(2 * i) * DE];
#pragma unroll
        for (int i = 0; i < 32; ++i) scr[(2 * i + (lane >> 5)) * 33 + l31] = v[i]; }
    wave_lds_fence();
    const int c = lane & 7;
#pragma unroll
    for (int j = 0; j < 4; ++j) { const int n = (lane >> 3) + 8 * j; const LAS float* s = scr + (8 * c) * 33 + n;
        u32x4 o; o.x = pk2(s[0 * 33], s[1 * 33]); o.y = pk2(s[2 * 33], s[3 * 33]); o.z = pk2(s[4 * 33], s[5 * 33]); o.w = pk2(s[6 * 33], s[7 * 33]);
        *(u32x4*)(WT + ((size_t)e * 1024 + drow0 + n) * D + k0 + 8 * c) = o; }
    wave_lds_fence();
}

DI void p0_prologue(const Frame& F0, ARef A) {
    Frame F = F0; F.tid = opq_tid(F0.wave); F.lane = F.tid & 63; F.wave = __builtin_amdgcn_readfirstlane(F.tid >> 6); F.gw = F.wg * NWAVES + F.wave;
    unsigned char* ws = A.ws;
    LAS float* sl = (LAS float*)F.lds;
    LAS float* part = (LAS float*)(F.lds + 16384);
    for (int i = F.tid; i < NB * D; i += NTHR) { const float v = A.c[i]; sl[i] = v * fsigmoid(v); }
    __syncthreads();
    float* mod = (float*)(ws + WS_MOD);
    for (int cg = F.wg; cg < 256; cg += F.G) {
        const int col = F.tid & 31, kg = F.tid >> 5;
        if (col < 24) { float a0 = 0.f, a1 = 0.f, a2 = 0.f, a3 = 0.f;
#pragma unroll 8
            for (int kk = 0; kk < 64; ++kk) { const int k = kg * 64 + kk; const float w = A.w_mod[(size_t)k * 6144 + cg * 24 + col];
                a0 += sl[k] * w; a1 += sl[D + k] * w; a2 += sl[2 * D + k] * w; a3 += sl[3 * D + k] * w; }
            LAS float* p = part + (kg * 24 + col) * 4; p[0] = a0; p[1] = a1; p[2] = a2; p[3] = a3; }
        __syncthreads();
        if (F.tid < 96) { const int c = F.tid >> 2, b = F.tid & 3; float s = 0.f;
#pragma unroll
            for (int kg2 = 0; kg2 < 16; ++kg2) s += part[(kg2 * 24 + c) * 4 + b];
            mod[b * 6144 + cg * 24 + c] = s + A.b_mod[cg * 24 + c]; }
        __syncthreads();
    }
    LAS float* scr = (LAS float*)(F.lds + 32768 + F.wave * 8704);
    constexpr int I_IN = (NPAD / 32) * (D / 64), I_OS = (D / 32) * (BW / 64), I_OUT = (D / 32) * (D / 64);
    for (int it = F.gw; it < I_IN + 2 * I_OS + I_OUT; it += F.NGW) {
        int r = it;
        if (r < I_IN) { const int g = r / (D / 64), kb = r % (D / 64), drow0 = 32 * g;
            const int sc = drow0 < 3360 ? drow0 : (drow0 < 3584 ? -1 : drow0 - 224);
            tr_item(A.w_in, IN_COLS, D, (bf16*)(ws + WS_WIN), 64 * kb, drow0, sc, scr, F.lane); continue; }
        r -= I_IN;
        if (r < I_OS) { const int g = r / (BW / 64), kb = r % (BW / 64); tr_item(A.w_o_sb, D, BW, (bf16*)(ws + WS_WOSB), 64 * kb, 32 * g, 32 * g, scr, F.lane); continue; }
        r -= I_OS;
        if (r < I_OS) { const int g = r / (BW / 64), kb = r % (BW / 64); tr_item(A.w_o_rw, D, BW, (bf16*)(ws + WS_WORW), 64 * kb, 32 * g, 32 * g, scr, F.lane); continue; }
        r -= I_OS;
        { const int g = r / (D / 64), kb = r % (D / 64); tr_item(A.w_out, D, D, (bf16*)(ws + WS_WOUT), 64 * kb, 32 * g, 32 * g, scr, F.lane); }
    }
    const int gt = F.wg * NTHR + F.tid, NGT = F.G * NTHR;
    float* rtw = (float*)(ws + WS_RTW);
    for (int i = gt; i < 36 * D; i += NGT) { const int o = i >> 10, k = i & (D - 1); rtw[i] = o < 4 ? A.w_group[k * 4 + o] : A.w_router[k * NE + (o - 4)]; }
    bf16* wl = (bf16*)(ws + WS_WL);
    for (int i = gt; i < 1536 * LK; i += NGT) { const int n = i / LK, k = i % LK; float v = 0.f;
        if (n < 512) { if (k < 64) v = A.w_decay_up[k * BW + n]; }
        else if (n < 1024) { if (k >= 64 && k < 128) v = A.w_iclr_up[(k - 64) * BW + (n - 512)]; }
        else { if (k >= 128 && k < 288) v = A.w_gate_up[(k - 128) * BW + (n - 1024)]; }
        wl[i] = (bf16)f2bf(v); }
}

DI void p1_h1(const Frame& F0, ARef A, bf16* H1) {
    Frame F = F0; F.tid = opq_tid(F0.wave); F.lane = F.tid & 63; F.wave = __builtin_amdgcn_readfirstlane(F.tid >> 6); F.gw = F.wg * NWAVES + F.wave;
    const float* mod = (const float*)(A.ws + WS_MOD);
    for (int n = F.gw; n < NTOK; n += F.NGW) {
        const int b = n >> 13;
        const f32x4* xr = (const f32x4*)(A.x + (size_t)n * D) + F.lane;
        f32x4 v[4]; float s = 0.f;
#pragma unroll
        for (int j = 0; j < 4; ++j) { v[j] = xr[64 * j]; s += (v[j][0] * v[j][0] + v[j][1] * v[j][1]) + (v[j][2] * v[j][2] + v[j][3] * v[j][3]); }
        const float inv = rsqrtf(wave_sum(s) * (1.0f / D) + NORM_EPS);
        u32x2* o = (u32x2*)(H1 + (size_t)n * D) + F.lane;
#pragma unroll
        for (int j = 0; j < 4; ++j) { const int k = 4 * F.lane + 256 * j;
            const f32x4 g = *(const f32x4*)(A.gains + k), sh = *(const f32x4*)(mod + b * 6144 + k), sc = *(const f32x4*)(mod + b * 6144 + D + k);
            f32x4 h;
#pragma unroll
            for (int q = 0; q < 4; ++q) h[q] = (v[j][q] * inv) * g[q] * (1.0f + sc[q]) + sh[q];
            u32x2 w; w.x = pk2(h[0], h[1]); w.y = pk2(h[2], h[3]); o[64 * j] = w; }
    }
}

DI void p3_attn(const Frame& F0, const bf16* QB, const bf16* KB, const bf16* VT, bf16* YSB) {
    Frame F = F0; F.tid = opq_tid(F0.wave); F.lane = F.tid & 63; F.wave = __builtin_amdgcn_readfirstlane(F.tid >> 6); F.gw = F.wg * NWAVES + F.wave;
    const int lane = F.lane, r = lane & 31, hh = lane >> 5;
    bf16x8 tri[2];
#pragma unroll
    for (int s = 0; s < 2; ++s)
#pragma unroll
        for (int e = 0; e < 8; ++e) tri[s][e] = (16 * s + 8 * (e >> 2) + 4 * hh + (e & 3)) > r ? (short)0x3F80 : (short)0;
    for (int u = F.gw; u < NB * NH * (SEQ / 32); u += F.NGW) {
        const int bh = u >> 8, qt = u & 255, b = bh >> 3, h = bh & 7;
        const bf16* qp = QB + (size_t)(b * SEQ + qt * 32 + r) * BW + h * HD + 8 * hh;
        bf16x8 qf[4];
#pragma unroll
        for (int ks = 0; ks < 4; ++ks) qf[ks] = *(const bf16x8*)(qp + 16 * ks);
        f32x16 o0, o1;
#pragma unroll
        for (int i = 0; i < 16; ++i) { o0[i] = 0.f; o1[i] = 0.f; }
        float L = 0.f;
        bf16x8 kf[4]; s16x4 vlo[2][2], vhi[2][2];
#define ATT_LOAD(KT, KF, VLO, VHI) do { const bf16* kp_ = KB + (size_t)(b * SEQ + (KT) * 32 + r) * BW + h * HD + 8 * hh; \
            _Pragma("unroll") for (int ks = 0; ks < 4; ++ks) KF[ks] = *(const bf16x8*)(kp_ + 16 * ks); \
            const bf16* vp_ = VT + ((size_t)(bh * HD + r)) * SEQ + (KT) * 32 + 4 * hh; \
            _Pragma("unroll") for (int mb = 0; mb < 2; ++mb) _Pragma("unroll") for (int ks = 0; ks < 2; ++ks) { VLO[mb][ks] = *(const s16x4*)(vp_ + (size_t)mb * 32 * SEQ + 16 * ks); VHI[mb][ks] = *(const s16x4*)(vp_ + (size_t)mb * 32 * SEQ + 16 * ks + 8); } } while (0)
        ATT_LOAD(qt, kf, vlo, vhi);
        for (int kt = qt; kt >= 0; --kt) {
            bf16x8 kfn[4]; s16x4 vlon[2][2], vhin[2][2];
            { const int ktn = kt > 0 ? kt - 1 : 0; ATT_LOAD(ktn, kfn, vlon, vhin); }
            f32x16 z;
#pragma unroll
            for (int i = 0; i < 16; ++i) z[i] = 0.f;
#pragma unroll
            for (int ks = 0; ks < 4; ++ks) z = MFMA32(kf[ks], qf[ks], z);
            const bool diag = (kt == qt);
            float lk[16], lo[16], tot = 0.f;
#pragma unroll
            for (int i = 0; i < 16; ++i) { const bool valid = !diag || (crow(i, hh) < r);
                const float sp = fsoftplus(z[i]); lk[i] = valid ? -sp : 0.0f; z[i] = valid ? z[i] - sp : -1.0e30f;
                tot += lk[i];
                const float hi = bflo(f2bf(lk[i])); lo[i] = lk[i] - hi; lk[i] = hi; }
            tot += shfl_xor_l(tot, 32, lane);
            f32x16 lat;
#pragma unroll
            for (int i = 0; i < 16; ++i) lat[i] = L;
#pragma unroll
            for (int s = 0; s < 2; ++s) {
                lat = MFMA32(tri[s], pack8v(lk[8 * s], lk[8 * s + 1], lk[8 * s + 2], lk[8 * s + 3], lk[8 * s + 4], lk[8 * s + 5], lk[8 * s + 6], lk[8 * s + 7]), lat);
                lat = MFMA32(tri[s], pack8v(lo[8 * s], lo[8 * s + 1], lo[8 * s + 2], lo[8 * s + 3], lo[8 * s + 4], lo[8 * s + 5], lo[8 * s + 6], lo[8 * s + 7]), lat); }
            float at[16];
#pragma unroll
            for (int i = 0; i < 16; ++i) at[i] = fexp(z[i] + lat[i]);
#pragma unroll
            for (int s = 0; s < 2; ++s) { const bf16x8 ab = pack8v(at[8 * s], at[8 * s + 1], at[8 * s + 2], at[8 * s + 3], at[8 * s + 4], at[8 * s + 5], at[8 * s + 6], at[8 * s + 7]);
                bf16x8 va, vb;
#pragma unroll
                for (int e = 0; e < 4; ++e) { va[e] = vlo[0][s][e]; va[4 + e] = vhi[0][s][e]; vb[e] = vlo[1][s][e]; vb[4 + e] = vhi[1][s][e]; }
                o0 = MFMA32(va, ab, o0); o1 = MFMA32(vb, ab, o1); }
            L += tot;
            if (__all(L < SB_STOP)) break;
#pragma unroll
            for (int ks = 0; ks < 4; ++ks) kf[ks] = kfn[ks];
#pragma unroll
            for (int mb = 0; mb < 2; ++mb)
#pragma unroll
                for (int ks = 0; ks < 2; ++ks) { vlo[mb][ks] = vlon[mb][ks]; vhi[mb][ks] = vhin[mb][ks]; }
        }
#undef ATT_LOAD
        bf16* op = YSB + (size_t)(b * SEQ + qt * 32 + r) * BW + h * HD + 4 * hh;
#pragma unroll
        for (int g = 0; g < 4; ++g) { u32x2 w0, w1; w0.x = pk2(o0[4 * g], o0[4 * g + 1]); w0.y = pk2(o0[4 * g + 2], o0[4 * g + 3]); w1.x = pk2(o1[4 * g], o1[4 * g + 1]); w1.y = pk2(o1[4 * g + 2], o1[4 * g + 3]);
            *(u32x2*)(op + 8 * g) = w0; *(u32x2*)(op + 32 + 8 * g) = w1; }
    }
}

DI void p3_prep(const Frame& F0, ARef A, const bf16* RWRAW, const bf16* LORA, bf16* R, bf16* KS, bf16* V, bf16* KK, bf16* ALORA) {
    Frame F = F0; F.tid = opq_tid(F0.wave); F.lane = F.tid & 63; F.wave = __builtin_amdgcn_readfirstlane(F.tid >> 6); F.gw = F.wg * NWAVES + F.wave;
    const int lane = F.lane;
    f32x4 mu[3][2], kkc[2], mul[2];
#pragma unroll
    for (int part = 0; part < 3; ++part) { mu[part][0] = *(const f32x4*)(A.shift_mu + part * 512 + lane * 8); mu[part][1] = *(const f32x4*)(A.shift_mu + part * 512 + lane * 8 + 4); }
    kkc[0] = *(const f32x4*)(A.k_k + lane * 8); kkc[1] = *(const f32x4*)(A.k_k + lane * 8 + 4);
    const int lcol = lane < 36 ? lane * 8 : 0;
    mul[0] = *(const f32x4*)(A.shift_mu + 1536 + lcol); mul[1] = *(const f32x4*)(A.shift_mu + 1536 + lcol + 4);
    constexpr int RUN = 16;
    for (int run = F.gw; run < NTOK / RUN; run += F.NGW) {
        const int n0 = run * RUN;
        u32x4 prv[3], prl, cur[3], cul;
        const u32x4 z4 = {0u, 0u, 0u, 0u};
        if ((n0 & (SEQ - 1)) == 0) { prv[0] = z4; prv[1] = z4; prv[2] = z4; prl = z4; }
        else {
#pragma unroll
            for (int part = 0; part < 3; ++part) prv[part] = *(const u32x4*)(RWRAW + (size_t)(n0 - 1) * 1536 + part * 512 + lane * 8);
            prl = *(const u32x4*)(LORA + (size_t)(n0 - 1) * BW + lcol); }
#pragma unroll
        for (int part = 0; part < 3; ++part) cur[part] = *(const u32x4*)(RWRAW + (size_t)n0 * 1536 + part * 512 + lane * 8);
        cul = *(const u32x4*)(LORA + (size_t)n0 * BW + lcol);
        for (int i = 0; i < RUN; ++i) {
            const int n = n0 + i, nn = i + 1 < RUN ? n + 1 : n;
            u32x4 nxt[3], nxl;
#pragma unroll
            for (int part = 0; part < 3; ++part) nxt[part] = *(const u32x4*)(RWRAW + (size_t)nn * 1536 + part * 512 + lane * 8);
            nxl = *(const u32x4*)(LORA + (size_t)nn * BW + lcol);
            float xs[3][8];
#pragma unroll
            for (int part = 0; part < 3; ++part) { float p[8], q[8]; unpack8(cur[part], p); unpack8(prv[part], q);
#pragma unroll
                for (int j = 0; j < 4; ++j) { xs[part][j] = p[j] + mu[part][0][j] * (q[j] - p[j]); xs[part][4 + j] = p[4 + j] + mu[part][1][j] * (q[4 + j] - p[4 + j]); } }
            const size_t off = (size_t)n * BW + lane * 8;
            *(u32x4*)(R + off) = pack8(xs[0]); *(u32x4*)(KS + off) = pack8(xs[1]); *(u32x4*)(V + off) = pack8(xs[2]);
            float kk[8], ss = 0.f;
#pragma unroll
            for (int j = 0; j < 4; ++j) { kk[j] = xs[1][j] * kkc[0][j]; kk[4 + j] = xs[1][4 + j] * kkc[1][j]; }
#pragma unroll
            for (int j = 0; j < 8; ++j) ss += kk[j] * kk[j];
            ss += shfl_xor_l(ss, 1, lane); ss += shfl_xor_l(ss, 2, lane); ss += shfl_xor_l(ss, 4, lane);
            const float rn = 1.0f / fmaxf(sqrtf(ss), L2_EPS);
#pragma unroll
            for (int j = 0; j < 8; ++j) kk[j] *= rn;
            *(u32x4*)(KK + off) = pack8(kk);
            if (lane < 48) { float a[8];
                if (lane < 36) { float p[8], q[8]; unpack8(cul, p); unpack8(prl, q);
#pragma unroll
                    for (int j = 0; j < 8; ++j) { const float m = j < 4 ? mul[0][j & 3] : mul[1][j & 3]; const float v = p[j] + m * (q[j] - p[j]);
                        a[j] = lane < 8 ? (1.0f - 2.0f * frcp(fexp(2.0f * v) + 1.0f)) : (lane < 16 ? v : fsigmoid(v)); }
                } else {
#pragma unroll
                    for (int j = 0; j < 8; ++j) a[j] = 0.f; }
                *(u32x4*)(ALORA + (size_t)n * LK + lane * 8) = pack8(a); }
#pragma unroll
            for (int part = 0; part < 3; ++part) { prv[part] = cur[part]; cur[part] = nxt[part]; }
            prl = cul; cul = nxl;
        }
    }
}

DI void p4_lora(const Frame& F0, ARef A, const bf16* ALORA, const bf16* WL, bf16* E, bf16* KS, bf16* Bo, bf16* GG, const bf16* KK, const bf16* R, float* BON) {
    Frame F = F0; F.tid = opq_tid(F0.wave); F.lane = F.tid & 63; F.wave = __builtin_amdgcn_readfirstlane(F.tid >> 6); F.gw = F.wg * NWAVES + F.wave;
    const int lane = F.lane, r = lane & 31, hh = lane >> 5;
    for (int u = F.gw; u < 2 * (NTOK / 32); u += F.NGW) {
        const int n0 = (u >> 1) * 32, par = u & 1;
        bf16x8 tf[18];
#pragma unroll
        for (int ks = 0; ks < 18; ++ks) tf[ks] = *(const bf16x8*)(ALORA + (size_t)(n0 + r) * LK + 16 * ks + 8 * hh);
        const unsigned orow = (unsigned)(n0 + r) * BW + 4 * hh;
#define LORA_BLOCK(KS0, NKS, CB, BODY) { const int c0_ = 32 * ((CB) & 15); f32x16 acc_; \
            _Pragma("unroll") for (int q = 0; q < 16; ++q) acc_[q] = 0.f; \
            _Pragma("unroll") for (int ks = 0; ks < (NKS); ++ks) acc_ = MFMA32(*(const bf16x8*)(WL + (size_t)(32 * (CB) + r) * LK + 16 * ((KS0) + ks) + 8 * hh), tf[(KS0) + ks], acc_); \
            BODY }
        for (int i = 0; i < 8; ++i) { const int cb = 4 * (i >> 1) + 2 * par + (i & 1);
            LORA_BLOCK(0, 4, cb, {
                _Pragma("unroll") for (int g = 0; g < 4; ++g) { const f32x4 w0v = *(const f32x4*)(A.w0 + c0_ + 8 * g + 4 * hh); float e4[4];
                    _Pragma("unroll") for (int j = 0; j < 4; ++j) { const float v = acc_[4 * g + j] + w0v[j]; e4[j] = fexp(-fsoftplus(-v) - 0.5f); }
                    u32x2 w; w.x = pk2(e4[0], e4[1]); w.y = pk2(e4[2], e4[3]); *(u32x2*)(E + orow + c0_ + 8 * g) = w; } }) }
        float bsum = 0.f;
        for (int i = 0; i < 8; ++i) { const int cb = 16 + 4 * (i >> 1) + 2 * par + (i & 1);
            LORA_BLOCK(4, 4, cb, {
                _Pragma("unroll") for (int g = 0; g < 4; ++g) { const f32x4 a0v = *(const f32x4*)(A.a0 + c0_ + 8 * g + 4 * hh); const f32x4 kav = *(const f32x4*)(A.k_a + c0_ + 8 * g + 4 * hh);
                    const unsigned o = orow + c0_ + 8 * g; const u32x2 kw = *(const u32x2*)(KS + o); const u32x2 qw = *(const u32x2*)(KK + o); const u32x2 rw = *(const u32x2*)(R + o); const f32x4 rkv = *(const f32x4*)(A.r_k + c0_ + 8 * g + 4 * hh);
                    float ksv[4]; float kkv[4]; float kp[4]; float bb[4]; ksv[0] = bflo(kw.x); ksv[1] = bfhi(kw.x); ksv[2] = bflo(kw.y); ksv[3] = bfhi(kw.y); kkv[0] = bflo(qw.x); kkv[1] = bfhi(qw.x); kkv[2] = bflo(qw.y); kkv[3] = bfhi(qw.y);
                    _Pragma("unroll") for (int j = 0; j < 4; ++j) { const float s0 = fsigmoid(acc_[4 * g + j] + a0v[j]); kp[j] = ksv[j] * (1.0f + (s0 - 1.0f) * kav[j]); bb[j] = kkv[j] * s0; }
                    bsum += (bflo(rw.x) * kp[0] * rkv[0] + bfhi(rw.x) * kp[1] * rkv[1]) + (bflo(rw.y) * kp[2] * rkv[2] + bfhi(rw.y) * kp[3] * rkv[3]);
                    u32x2 w1; u32x2 w2; w1.x = pk2(kp[0], kp[1]); w1.y = pk2(kp[2], kp[3]); w2.x = pk2(bb[0], bb[1]); w2.y = pk2(bb[2], bb[3]); *(u32x2*)(KS + o) = w1; *(u32x2*)(Bo + o) = w2; } })
            if (i & 1) { const float tot = bsum + shfl_xor_l(bsum, 32, lane); if (hh == 0) BON[(size_t)(n0 + r) * 8 + 2 * (i >> 1) + par] = tot; bsum = 0.f; } }
        for (int i = 0; i < 8; ++i) { const int cb = 32 + 4 * (i >> 1) + 2 * par + (i & 1);
            LORA_BLOCK(8, 10, cb, {
                _Pragma("unroll") for (int g = 0; g < 4; ++g) { u32x2 w; w.x = pk2(acc_[4 * g], acc_[4 * g + 1]); w.y = pk2(acc_[4 * g + 2], acc_[4 * g + 3]); *(u32x2*)(GG + orow + c0_ + 8 * g) = w; } }) }
#undef LORA_BLOCK
    }
}

DI void p6_chain(int task, int wave, LAS unsigned char* ring, const bf16* GT, const bf16* HT, bf16* SC) {
    const int lane = opq_tid(wave) & 63;
    const int bh = task >> 1, nb = task & 1;
    constexpr int RD = 6, SLOT = 12288;
    f32x16 X[2];
#pragma unroll
    for (int q = 0; q < 16; ++q) { X[0][q] = 0.f; X[1][q] = 0.f; }
    const char* gsrc = (const char*)(GT + (size_t)bh * NCH * 4096) + lane * 16;
    const char* hsrc = (const char*)(HT + (size_t)bh * NCH * 4096) + nb * 2048 + lane * 16;
#define CHAIN_DMA(cc) do { LAS unsigned char* sl_ = ring + ((cc) % RD) * SLOT; const char* g_ = gsrc + (size_t)(cc) * 8192; const char* h_ = hsrc + (size_t)(cc) * 8192; \
        _Pragma("unroll") for (int f = 0; f < 8; ++f) __builtin_amdgcn_global_load_lds((const unsigned*)(g_ + f * 1024), (LAS unsigned*)(sl_ + f * 1024), 16, 0, 0); \
        _Pragma("unroll") for (int kb = 0; kb < 2; ++kb) _Pragma("unroll") for (int j = 0; j < 2; ++j) \
            __builtin_amdgcn_global_load_lds((const unsigned*)(h_ + kb * 4096 + j * 1024), (LAS unsigned*)(sl_ + 8192 + (kb * 2 + j) * 1024), 16, 0, 0); } while (0)
#define CHAIN_READ(cc, HS, GS) do { const LAS unsigned char* sl_ = ring + ((cc) % RD) * SLOT; \
        _Pragma("unroll") for (int f = 0; f < 8; ++f) GS[f] = *(const LAS bf16x8*)(sl_ + f * 1024 + lane * 16); \
        _Pragma("unroll") for (int kb = 0; kb < 2; ++kb) _Pragma("unroll") for (int g = 0; g < 4; ++g) { const u32x2 w_ = *(const LAS u32x2*)(sl_ + 8192 + kb * 2048 + (g * 64 + lane) * 8); \
            HS[kb][4 * g] = bflo(w_.x); HS[kb][4 * g + 1] = bfhi(w_.x); HS[kb][4 * g + 2] = bflo(w_.y); HS[kb][4 * g + 3] = bfhi(w_.y); } } while (0)
#define CHAIN_STORE(cc) do { bf16* sc_ = SC + ((size_t)bh * NCH + (cc)) * 4096; \
        _Pragma("unroll") for (int jb = 0; jb < 2; ++jb) _Pragma("unroll") for (int g = 0; g < 4; ++g) { u32x2 w_; w_.x = pk2(X[jb][4 * g], X[jb][4 * g + 1]); w_.y = pk2(X[jb][4 * g + 2], X[jb][4 * g + 3]); \
            *(u32x2*)(sc_ + ((((jb * 2 + nb) * 4 + g) * 64) + lane) * 4) = w_; } } while (0)
#define CHAIN_STEP(HS, GS) do { bf16x8 xb_[2][2]; \
        _Pragma("unroll") for (int jb = 0; jb < 2; ++jb) _Pragma("unroll") for (int s = 0; s < 2; ++s) \
            xb_[jb][s] = pack8v(X[jb][8 * s], X[jb][8 * s + 1], X[jb][8 * s + 2], X[jb][8 * s + 3], X[jb][8 * s + 4], X[jb][8 * s + 5], X[jb][8 * s + 6], X[jb][8 * s + 7]); \
        X[0] = HS[0]; X[1] = HS[1]; \
        _Pragma("unroll") for (int kb = 0; kb < 2; ++kb) _Pragma("unroll") for (int jb = 0; jb < 2; ++jb) _Pragma("unroll") for (int s = 0; s < 2; ++s) X[kb] = MFMA32(GS[kb * 4 + jb * 2 + s], xb_[jb][s], X[kb]); } while (0)
    for (int cc = 0; cc < RD; ++cc) CHAIN_DMA(cc);
    for (int c = 0; c < NCH - 1; ++c) {
        f32x16 Hc[2]; bf16x8 Gc[8];
        if (c + RD <= NCH - 1) asm volatile("s_waitcnt vmcnt(60)" ::: "memory"); else asm volatile("s_waitcnt vmcnt(0)" ::: "memory");
        CHAIN_READ(c, Hc, Gc);
        asm volatile("s_waitcnt lgkmcnt(0)" ::: "memory");
        if (c + RD < NCH - 1) CHAIN_DMA(c + RD);
        CHAIN_STORE(c);
        CHAIN_STEP(Hc, Gc);
    }
    CHAIN_STORE(NCH - 1);
    asm volatile("s_waitcnt vmcnt(0)" ::: "memory");
#undef CHAIN_DMA
#undef CHAIN_READ
#undef CHAIN_STORE
#undef CHAIN_STEP
}

DI void p6_moe_weights(const Frame& F0, ARef A, int wi, int NW) {
    Frame F = F0; F.tid = opq_tid(F0.wave); F.lane = F.tid & 63; F.wave = __builtin_amdgcn_readfirstlane(F.tid >> 6); F.gw = F.wg * NWAVES + F.wave;
    LAS float* scr = (LAS float*)(F.lds + F.wave * 20480);
    constexpr int I_UP = NE * 32 * 16, I_DN = NE * 32 * 8;
    for (int it = wi; it < I_UP + I_DN; it += NW) {
        if (it < I_UP) { const int e = it >> 9, g = (it >> 4) & 31, kb = it & 15; tr_item_up(A.w_up1, A.w_up3, (bf16*)(A.ws + WS_WUP), e, 64 * kb, 32 * g, scr, F.lane); }
        else { const int r = it - I_UP, e = r >> 8, g = (r >> 3) & 31, kb = r & 7;
            tr_item(A.w_down + (size_t)e * DE * D, D, DE, (bf16*)(A.ws + WS_WDN) + (size_t)e * 1024 * DE, 64 * kb, 32 * g, 32 * g, scr, F.lane); }
    }
}

DI float half_bcast_sum(float v, int hh) {
    v += DPP_SHR(v, 0x111); v += DPP_SHR(v, 0x112); v += DPP_SHR(v, 0x114); v += DPP_SHR(v, 0x118);
    v += __builtin_bit_cast(float, __builtin_amdgcn_update_dpp(0, __builtin_bit_cast(int, v), 0x142, 0xa, 0xf, false));
    const float lo = __builtin_bit_cast(float, __builtin_amdgcn_readlane(__builtin_bit_cast(int, v), 31)), hi = __builtin_bit_cast(float, __builtin_amdgcn_readlane(__builtin_bit_cast(int, v), 63));
    return hh ? hi : lo; }
DI void p7_mfma(const Frame& F0, ARef A, const bf16* SC, const bf16* Pn, const bf16* QOn, const bf16* V, const bf16* GG, const float* BON, bf16* YRW) {
    Frame F = F0; F.tid = opq_tid(F0.wave); F.lane = F.tid & 63; F.wave = __builtin_amdgcn_readfirstlane(F.tid >> 6); F.gw = F.wg * NWAVES + F.wave;
    const int lane = F.lane, r = lane & 31, hh = lane >> 5;
    for (int cid = F.gw; cid < NCHUNK; cid += F.NGW) {
        const int bh = cid >> NCH_LOG, c = cid & (NCH - 1), b = bh >> 3, h = bh & 7;
        const unsigned n0 = (unsigned)b * SEQ + (unsigned)c * CH; const int col0 = h * HD;
        const bf16* sc = SC + (size_t)cid * 4096; const bf16* pn = Pn + (size_t)cid * 4096; const bf16* qn = QOn + (size_t)cid * 4096;
        bf16x8 Sf[2][2][2], Pf[2][2][2];
#pragma unroll
        for (int jb = 0; jb < 2; ++jb)
#pragma unroll
            for (int xb = 0; xb < 2; ++xb)
#pragma unroll
                for (int s = 0; s < 2; ++s) { const s16x4 lo = *(const s16x4*)(sc + ((((jb * 2 + xb) * 4 + 2 * s) * 64) + lane) * 4), hi = *(const s16x4*)(sc + ((((jb * 2 + xb) * 4 + 2 * s + 1) * 64) + lane) * 4);
#pragma unroll
                    for (int e = 0; e < 4; ++e) { Sf[jb][xb][s][e] = lo[e]; Sf[jb][xb][s][4 + e] = hi[e]; }
                    Pf[jb][xb][s] = *(const bf16x8*)(pn + ((((jb * 2 + xb) * 2 + s) * 64) + lane) * 8); }
        f32x16 Z[2][2];
#pragma unroll
        for (int tb = 0; tb < 2; ++tb)
#pragma unroll
            for (int nb = 0; nb < 2; ++nb) {
#pragma unroll
                for (int g = 0; g < 4; ++g) { const u32x2 w = *(const u32x2*)(qn + ((((tb * 2 + nb) * 4 + g) * 64) + lane) * 4);
                    Z[tb][nb][4 * g] = bflo(w.x); Z[tb][nb][4 * g + 1] = bfhi(w.x); Z[tb][nb][4 * g + 2] = bflo(w.y); Z[tb][nb][4 * g + 3] = bfhi(w.y); }
#pragma unroll
                for (int jb = 0; jb < 2; ++jb)
#pragma unroll
                    for (int s = 0; s < 2; ++s) Z[tb][nb] = MFMA32(Pf[jb][tb][s], Sf[jb][nb][s], Z[tb][nb]); }
        float lw[2], lb[2];
#pragma unroll
        for (int nb = 0; nb < 2; ++nb) { lw[nb] = A.lnx_w[col0 + 32 * nb + r]; lb[nb] = A.lnx_b[col0 + 32 * nb + r]; }
#pragma unroll
        for (int tb = 0; tb < 2; ++tb)
#pragma unroll
            for (int q = 0; q < 16; ++q) {
                const unsigned tokrow = n0 + 32 * tb + 4 * hh + (q & 3) + 8 * (q >> 2);
                const float mean = half_bcast_sum(Z[tb][0][q] + Z[tb][1][q], hh) * (1.0f / 64.0f);
                const float d0 = Z[tb][0][q] - mean, d1 = Z[tb][1][q] - mean;
                const float rs = rsqrtf(half_bcast_sum(d0 * d0 + d1 * d1, hh) * (1.0f / 64.0f) + GN_EPS);
                const float bon = BON[(size_t)tokrow * 8 + h];
                const unsigned o0 = tokrow * BW + col0 + r;
                YRW[o0] = (bf16)f2bf((d0 * rs * lw[0] + lb[0] + bon * bf2f(V[o0])) * bf2f(GG[o0]));
                YRW[o0 + 32] = (bf16)f2bf((d1 * rs * lw[1] + lb[1] + bon * bf2f(V[o0 + 32])) * bf2f(GG[o0 + 32]));
                if ((q & 3) == 3) __builtin_amdgcn_sched_barrier(0); }
    }
}

DI void p10_rows(const Frame& F0, ARef A, const bf16* Y1, bf16* H2) {
    Frame F = F0; F.tid = opq_tid(F0.wave); F.lane = F.tid & 63; F.wave = __builtin_amdgcn_readfirstlane(F.tid >> 6); F.gw = F.wg * NWAVES + F.wave;
    const int lane = F.lane;
    const float* mod = (const float*)(A.ws + WS_MOD);
    LAS float* rw = (LAS float*)F.lds;
    LAS int* hist = (LAS int*)(F.lds + 147456);
    { const float* src = (const float*)(A.ws + WS_RTW);
        for (int i = F.tid; i < 18 * D; i += NTHR) { const int op = i >> 10, k = i & (D - 1); typedef float f2_t __attribute__((ext_vector_type(2))); f2_t w; w.x = src[(2 * op) * D + k]; w.y = src[(2 * op + 1) * D + k]; *(LAS f2_t*)(rw + 2 * i) = w; } }
    i32x4* tok = (i32x4*)(A.ws + WS_TOK); int* cnt = (int*)(A.ws + WS_CNT);
    for (int tb = F.wg; tb < NTOK / 128; tb += F.G) {
        if (F.tid < 32) hist[F.tid] = 0;
        __syncthreads();
        for (int tl = F.wave; tl < 128; tl += NWAVES) {
            const int n = tb * 128 + tl, b = n >> 13;
            const f32x4* xr = (const f32x4*)(A.x + (size_t)n * D) + lane; const u32x2* yr = (const u32x2*)(Y1 + (size_t)n * D) + lane;
            f32x4 xv[4], yv[4]; float s = 0.f;
#pragma unroll
            for (int j = 0; j < 4; ++j) { xv[j] = xr[64 * j]; const u32x2 w = yr[64 * j]; yv[j][0] = bflo(w.x); yv[j][1] = bfhi(w.x); yv[j][2] = bflo(w.y); yv[j][3] = bfhi(w.y);
                s += (yv[j][0] * yv[j][0] + yv[j][1] * yv[j][1]) + (yv[j][2] * yv[j][2] + yv[j][3] * yv[j][3]); }
            const float inv1 = rsqrtf(wave_sum(s) * (1.0f / D) + NORM_EPS);
            float s2 = 0.f;
#pragma unroll
            for (int j = 0; j < 4; ++j) { const int k = 4 * lane + 256 * j;
                const f32x4 g1 = *(const f32x4*)(A.gains + D + k), gt = *(const f32x4*)(mod + b * 6144 + 2 * D + k);
#pragma unroll
                for (int q = 0; q < 4; ++q) { xv[j][q] = xv[j][q] + gt[q] * ((yv[j][q] * inv1) * g1[q]); s2 += xv[j][q] * xv[j][q]; }
                u32x2 xw; xw.x = pk2(xv[j][0], xv[j][1]); xw.y = pk2(xv[j][2], xv[j][3]); *((u32x2*)(A.ws + WS_X1 + (size_t)n * D * 2) + lane + 64 * j) = xw; }
            const float inv2 = rsqrtf(wave_sum(s2) * (1.0f / D) + NORM_EPS);
            f32x4 hv[4];
#pragma unroll
            for (int j = 0; j < 4; ++j) { const int k = 4 * lane + 256 * j;
                const f32x4 g2 = *(const f32x4*)(A.gains + 2 * D + k), sh = *(const f32x4*)(mod + b * 6144 + 3 * D + k), sc = *(const f32x4*)(mod + b * 6144 + 4 * D + k);
#pragma unroll
                for (int q = 0; q < 4; ++q) hv[j][q] = (xv[j][q] * inv2) * g2[q] * (1.0f + sc[q]) + sh[q];
                u32x2 w; w.x = pk2(hv[j][0], hv[j][1]); w.y = pk2(hv[j][2], hv[j][3]); *((u32x2*)(H2 + (size_t)n * D) + lane + 64 * j) = w; }
            typedef float f2_t __attribute__((ext_vector_type(2)));
#define P10_PAIR(OUT0, OUT1, WBASE) do { f2_t a = {0.f, 0.f}; \
                _Pragma("unroll") for (int j = 0; j < 4; ++j) { const LAS f32x4* wp = (const LAS f32x4*)((WBASE) + (4 * lane + 256 * j) * 2); const f32x4 wA = wp[0], wB = wp[1]; \
                    a += (f2_t){hv[j][0], hv[j][0]} * (f2_t){wA[0], wA[1]}; a += (f2_t){hv[j][1], hv[j][1]} * (f2_t){wA[2], wA[3]}; \
                    a += (f2_t){hv[j][2], hv[j][2]} * (f2_t){wB[0], wB[1]}; a += (f2_t){hv[j][3], hv[j][3]} * (f2_t){wB[2], wB[3]}; } \
                OUT0 = wave_sum(a.x); OUT1 = wave_sum(a.y); } while (0)
            float lg[4];
            P10_PAIR(lg[0], lg[1], rw); P10_PAIR(lg[2], lg[3], rw + 2 * D);
            int gs = 0; float gm = lg[0];
#pragma unroll
            for (int g = 1; g < 4; ++g) if (lg[g] > gm) { gm = lg[g]; gs = g; }
            gs = __builtin_amdgcn_readfirstlane(gs);
            float gsum = 0.f;
#pragma unroll
            for (int g = 0; g < 4; ++g) gsum += fexp(lg[g] - gm);
            const float gw = 1.0f / gsum;
            float el[8];
            { const LAS float* rwg = rw + (2 + 4 * gs) * (2 * D);
#pragma unroll
              for (int i = 0; i < 4; ++i) P10_PAIR(el[2 * i], el[2 * i + 1], rwg + i * 2 * D); }
#undef P10_PAIR
            int i0 = 0; float m0 = el[0];
#pragma unroll
            for (int e = 1; e < 8; ++e) if (el[e] > m0) { m0 = el[e]; i0 = e; }
            int i1 = -1; float m1 = -3.0e38f;
#pragma unroll
            for (int e = 0; e < 8; ++e) if (e != i0 && el[e] > m1) { m1 = el[e]; i1 = e; }
            const float t = fexp(m1 - m0), p0 = 1.0f / (1.0f + t), p1 = t * p0;
            const int e0 = gs * 8 + i0, e1 = gs * 8 + i1;
#if defined(CHECKS)
            if (lane == 0 && n == DBG_TOKEN) { float* dbg = (float*)(A.ws + WS_CTL + 32768) + 48; dbg[0] = lg[0]; dbg[1] = lg[1]; dbg[2] = lg[2]; dbg[3] = lg[3]; dbg[4] = gsum; dbg[5] = p0; dbg[6] = gw; dbg[7] = t; }
#endif
            if (lane == 0) { i32x4 rec; rec.x = e0 | (e1 << 8); rec.y = 0; rec.z = 0; rec.w = 0; tok[n] = rec;
                float* cwp = (float*)(A.ws + WS_CW) + 2 * n; cwp[0] = gw * p0; cwp[1] = gw * p1;
                atomicAdd((int*)&hist[e0], 1); atomicAdd((int*)&hist[e1], 1); }
        }
        __syncthreads();
        if (F.tid < 32) cnt[tb * 32 + F.tid] = hist[F.tid];
        __syncthreads();
    }
}

DI void p11_rank_gather(const Frame& F0, ARef A, const bf16* H2, bf16* HS) {
    Frame F = F0; F.tid = opq_tid(F0.wave); F.lane = F.tid & 63; F.wave = __builtin_amdgcn_readfirstlane(F.tid >> 6); F.gw = F.wg * NWAVES + F.wave;
    LAS int* base = (LAS int*)F.lds;
    LAS int* seg = base + 32;
    LAS int* el = base + 96;
    LAS int* pos = base + 352;
    i32x4* tok = (i32x4*)(A.ws + WS_TOK); const int* cnt = (const int*)(A.ws + WS_CNT); int* tile = (int*)(A.ws + WS_TILE);
    for (int tb = F.wg; tb < NTOK / 128; tb += F.G) {
        if (F.tid < 32) { int tot = 0, pre = 0;
            for (int t2 = 0; t2 < NTOK / 128; ++t2) { const int v = cnt[t2 * 32 + F.tid]; tot += v; if (t2 < tb) pre += v; }
            base[F.tid] = pre; seg[F.tid] = (tot + 255) & ~255; }
        if (F.tid >= 64 && F.tid < 64 + 128) { const i32x4 rec = tok[tb * 128 + (F.tid - 64)]; el[2 * (F.tid - 64)] = rec.x & 255; el[2 * (F.tid - 64) + 1] = (rec.x >> 8) & 255; }
        __syncthreads();
        if (F.tid == 0) { int acc = 0; for (int e = 0; e < 32; ++e) { const int sz = seg[e]; seg[e] = acc; acc += sz; } seg[32] = acc; }
        __syncthreads();
        if (F.tid < 32) { int p = seg[F.tid] + base[F.tid];
            for (int q = 0; q < 256; ++q) if (el[q] == F.tid) pos[q] = p++; }
        if (tb == 0 && F.tid >= 64 && F.tid < 64 + 32) { const int e = F.tid - 64;
            for (int t2 = seg[e] >> 8; t2 < (seg[e + 1] >> 8); ++t2) tile[t2] = e;
            if (e == 0) tile[MAXT] = seg[32] >> 8; }
        __syncthreads();
        if (F.tid < 128) { i32x4 rec = tok[tb * 128 + F.tid]; rec.x = pos[2 * F.tid]; rec.y = pos[2 * F.tid + 1]; tok[tb * 128 + F.tid] = rec; }
        for (int q = F.wave; q < 256; q += NWAVES) { const int n = tb * 128 + (q >> 1);
            const u32x4* src = (const u32x4*)(H2 + (size_t)n * D) + F.lane; u32x4* dst = (u32x4*)(HS + (size_t)pos[q] * D) + F.lane;
            dst[0] = src[0]; dst[64] = src[64]; }
        __syncthreads();
    }
}

DI void p14_final(const Frame& F0, ARef A, const bf16* YE) {
    Frame F = F0; F.tid = opq_tid(F0.wave); F.lane = F.tid & 63; F.wave = __builtin_amdgcn_readfirstlane(F.tid >> 6); F.gw = F.wg * NWAVES + F.wave;
    const int lane = F.lane;
    const float* mod = (const float*)(A.ws + WS_MOD); const i32x4* tok = (const i32x4*)(A.ws + WS_TOK);
    for (int n = F.gw; n < NTOK; n += F.NGW) {
        const int b = n >> 13; const i32x4 rec = tok[n];
        const float c0 = ((const float*)(A.ws + WS_CW))[2 * n], c1 = ((const float*)(A.ws + WS_CW))[2 * n + 1];
        const u32x2* y0 = (const u32x2*)(YE + (size_t)rec.x * D) + lane; const u32x2* y1 = (const u32x2*)(YE + (size_t)rec.y * D) + lane;
        f32x4 yv[4]; float s = 0.f;
#pragma unroll
        for (int j = 0; j < 4; ++j) { const u32x2 a = y0[64 * j], bq = y1[64 * j];
            yv[j][0] = c0 * bflo(a.x) + c1 * bflo(bq.x); yv[j][1] = c0 * bfhi(a.x) + c1 * bfhi(bq.x); yv[j][2] = c0 * bflo(a.y) + c1 * bflo(bq.y); yv[j][3] = c0 * bfhi(a.y) + c1 * bfhi(bq.y);
            s += (yv[j][0] * yv[j][0] + yv[j][1] * yv[j][1]) + (yv[j][2] * yv[j][2] + yv[j][3] * yv[j][3]); }
        const float inv = rsqrtf(wave_sum(s) * (1.0f / D) + NORM_EPS);
#pragma unroll
        for (int j = 0; j < 4; ++j) { const int k = 4 * lane + 256 * j;
            const f32x4 g3 = *(const f32x4*)(A.gains + 3 * D + k), gt = *(const f32x4*)(mod + b * 6144 + 5 * D + k);
            const u32x2 xw = *((const u32x2*)(A.ws + WS_X1 + (size_t)n * D * 2) + lane + 64 * j); f32x4 xv = {bflo(xw.x), bfhi(xw.x), bflo(xw.y), bfhi(xw.y)};
#pragma unroll
            for (int q = 0; q < 4; ++q) xv[q] = xv[q] + gt[q] * ((yv[j][q] * inv) * g3[q]);
            *((f32x4*)(A.out + (size_t)n * D) + lane + 64 * j) = xv; }
    }
}

DI bf16x8 pk_tile(const f32x16& x, const int s) { return pack8v(x[8 * s], x[8 * s + 1], x[8 * s + 2], x[8 * s + 3], x[8 * s + 4], x[8 * s + 5], x[8 * s + 6], x[8 * s + 7]); }
constexpr int FS = 72;
DI bf16x8 rd_frag(const LAS bf16* buf, int tb, int cb, int s, int r, int hh) {
    const LAS bf16* p = buf + (32 * cb + r) * FS + 32 * tb + 16 * s + 4 * hh;
    const s16x4 lo = *(const LAS s16x4*)p, hi = *(const LAS s16x4*)(p + 8); bf16x8 f;
#pragma unroll
    for (int e = 0; e < 4; ++e) { f[e] = lo[e]; f[4 + e] = hi[e]; }
    return f; }
DI void wr_tile_ft(LAS bf16* buf, const f32x16& x, int tb, int cb, int r, int hh) {
#pragma unroll
    for (int g = 0; g < 4; ++g) { u32x2 w; w.x = pk2(x[4 * g], x[4 * g + 1]); w.y = pk2(x[4 * g + 2], x[4 * g + 3]); *(LAS u32x2*)(buf + (32 * cb + r) * FS + 32 * tb + 8 * g + 4 * hh) = w; } }
DI void wr_l_ft(LAS bf16* buf, const float (&x)[64], int lane) {
#pragma unroll
    for (int t8 = 0; t8 < 8; ++t8) { u32x4 w; w.x = pk2(x[8 * t8], x[8 * t8 + 1]); w.y = pk2(x[8 * t8 + 2], x[8 * t8 + 3]); w.z = pk2(x[8 * t8 + 4], x[8 * t8 + 5]); w.w = pk2(x[8 * t8 + 6], x[8 * t8 + 7]);
        *(LAS u32x4*)(buf + lane * FS + 8 * t8) = w; } }

#if defined(STAMPS)
#define P5STAMP(k) do { p5ts[k] = __builtin_amdgcn_s_memrealtime(); } while (0)
#else
#define P5STAMP(k) do { } while (0)
#endif
DI void p5_mfma(unsigned char* F0_ws, const Frame& F0, const bf16* R, const bf16* KP, const bf16* V, const bf16* KK, const bf16* Bv, const bf16* Ev, bf16* P, bf16* QO, bf16* GT, bf16* HT) {
    Frame F = F0; F.tid = opq_tid(F0.wave); F.lane = F.tid & 63; F.wave = __builtin_amdgcn_readfirstlane(F.tid >> 6); F.gw = F.wg * NWAVES + F.wave;
    const int lane = F.lane, r = lane & 31, hh = lane >> 5;
    LAS unsigned char* wl_init = F.lds + F.wave * 20480;
    LAS unsigned char* const wl0 = wl_init;
    {   bf16x8 id_[2];
#pragma unroll
        for (int s = 0; s < 2; ++s)
#pragma unroll
            for (int e = 0; e < 8; ++e) id_[s][e] = (16 * s + 8 * (e >> 2) + 4 * hh + (e & 3)) == r ? (short)0x3F80 : (short)0;
        *(LAS bf16x8*)(wl0 + 16640 + lane * 16) = id_[0]; *(LAS bf16x8*)(wl0 + 16640 + 1024 + lane * 16) = id_[1]; }
    wave_lds_fence();
    for (int cid = F.gw; cid < NCHUNK; cid += F.NGW) {
        const int bh = cid >> NCH_LOG, c = cid & (NCH - 1), b = bh >> 3, h = bh & 7;
        const unsigned n0 = (unsigned)b * SEQ + (unsigned)c * CH, col0 = (unsigned)h * HD;
        LAS unsigned char* wl = wl0; asm volatile("" : "+s"(wl));
        LAS unsigned char* IFR = wl + 16640;
        const int ln = opq_tid(F.wave) & 63;
#if defined(STAMPS)
        unsigned long long p5ts[10];
#endif
        const int rm = ln & 31, hm = ln >> 5;
        const bf16 *R0_ = R, *KP0_ = KP, *V0_ = V, *KK0_ = KK, *Bv0_ = Bv, *Ev0_ = Ev; bf16 *P0_ = P, *QO0_ = QO;
        asm volatile("" : "+s"(R0_), "+s"(KP0_), "+s"(V0_), "+s"(KK0_), "+s"(Bv0_), "+s"(Ev0_), "+s"(P0_), "+s"(QO0_));
        const GAS char *R_ = (const GAS char*)R0_, *KP_ = (const GAS char*)KP0_, *V_ = (const GAS char*)V0_, *KK_ = (const GAS char*)KK0_, *Bv_ = (const GAS char*)Bv0_, *Ev_ = (const GAS char*)Ev0_;
        GAS char *P_ = (GAS char*)P0_, *QO_ = (GAS char*)QO0_;
        const unsigned nb0 = n0 * BW + col0;
        const unsigned vL = (nb0 + (unsigned)ln) * 2u, vT = (nb0 + (unsigned)rm * BW + 4u * hm) * 2u;
#define OADD(v, c) ({ unsigned o_; asm volatile("v_add_u32_e32 %0, %1, %2" : "=v"(o_) : "n"((int)(c)), "v"(v)); o_; })
#define LD16(arr, off) (*(const GAS bf16*)((arr) + (off)))
#define XL(arr, t) LD16(arr, OADD(vL, (t) * BW * 2))
#define ROWQ(q) (((q) & 3) + 8 * ((q) >> 2))
        P5STAMP(0);
        bf16x8 Ep[2][2][2]; u32x2 raw[2][4][4];
#pragma unroll
        for (int fb = 0; fb < 2; ++fb)
#pragma unroll
            for (int tb = 0; tb < 2; ++tb)
#pragma unroll
                for (int s = 0; s < 2; ++s) { const u32x2 lo_ = *(const GAS u32x2*)(Ev_ + OADD(vT, (32 * tb * BW + 32 * fb + 16 * s) * 2)), hi_ = *(const GAS u32x2*)(Ev_ + OADD(vT, (32 * tb * BW + 32 * fb + 16 * s + 8) * 2));
                    u32x4 w_; w_.x = lo_.x; w_.y = lo_.y; w_.z = hi_.x; w_.w = hi_.y; Ep[fb][tb][s] = __builtin_bit_cast(bf16x8, w_); }
#define LOAD_TILE(BUF, FB, TB) do { _Pragma("unroll") for (int g = 0; g < 4; ++g) { const unsigned ot_ = OADD(vT, (32 * (TB) * BW + 32 * (FB) + 8 * g) * 2); \
            raw[BUF][0][g] = *(const GAS u32x2*)(KK_ + ot_); raw[BUF][1][g] = *(const GAS u32x2*)(R_ + ot_); \
            raw[BUF][2][g] = *(const GAS u32x2*)(Bv_ + ot_); raw[BUF][3][g] = *(const GAS u32x2*)(KP_ + ot_); } } while (0)
        LOAD_TILE(0, 0, 0);
#define IDF(s) (*(const LAS bf16x8*)(IFR + (s) * 1024 + ln * 16))
        bf16x8 ETp[2][2][2], tri[2], ones;
        float sc_[2];
        {   const bf16x8 id0 = IDF(0), id1 = IDF(1);
            {   unsigned o2_ = 0x3F803F80u; asm volatile("" : "+v"(o2_)); u32x4 o4_; o4_.x = o2_; o4_.y = o2_; o4_.z = o2_; o4_.w = o2_; ones = __builtin_bit_cast(bf16x8, o4_); }
#pragma unroll
            for (int e = 0; e < 8; ++e) {
#pragma unroll
                for (int s = 0; s < 2; ++s) tri[s][e] = (16 * s + 8 * (e >> 2) + 4 * hm + (e & 3)) <= rm ? (short)0x3F80 : (short)0; }
#pragma unroll
            for (int kb = 0; kb < 2; ++kb)
#pragma unroll
                for (int fb = 0; fb < 2; ++fb) { f32x16 x_;
#pragma unroll
                    for (int q = 0; q < 16; ++q) x_[q] = 0.f;
                    x_ = MFMA32(Ep[fb][kb][0], id0, x_); x_ = MFMA32(Ep[fb][kb][1], id1, x_);
                    ETp[kb][fb][0] = pk_tile(x_, 0); ETp[kb][fb][1] = pk_tile(x_, 1); }
#pragma unroll
            for (int fb = 0; fb < 2; ++fb) { f32x16 t_;
#pragma unroll
                for (int q = 0; q < 16; ++q) t_[q] = 0.f;
#pragma unroll
                for (int kb = 0; kb < 2; ++kb)
#pragma unroll
                    for (int s = 0; s < 2; ++s) t_ = MFMA32(ones, ETp[kb][fb][s], t_);
                sc_[fb] = fexp(-t_[0]); }
            __builtin_amdgcn_sched_barrier(0); }
        P5STAMP(1);
        bf16x8 Ap[2][2][2], Rp[2][2][2], Bp[2][2][2], Kp[2][2][2];
#pragma unroll
        for (int ti = 0; ti < 4; ++ti) { const int fb = ti >> 1, tb = ti & 1;
            if (ti < 3) LOAD_TILE((ti + 1) & 1, (ti + 1) >> 1, (ti + 1) & 1);
            f32x16 Lt;
#pragma unroll
            for (int q = 0; q < 16; ++q) Lt[q] = 0.f;
#pragma unroll
            for (int kb = 0; kb <= tb; ++kb)
#pragma unroll
                for (int s = 0; s < 2; ++s) Lt = MFMA32(ETp[kb][fb][s], kb < tb ? ones : tri[s], Lt);
#pragma unroll
            for (int s = 0; s < 2; ++s) {
                float a8[8], r8[8], b8[8], k8[8], e8[8]; unpack8(__builtin_bit_cast(u32x4, Ep[fb][tb][s]), e8);
#pragma unroll
                for (int g2 = 0; g2 < 2; ++g2) { const int g = 2 * s + g2;
                    const u32x2 aw = raw[ti & 1][0][g], rw = raw[ti & 1][1][g], bw = raw[ti & 1][2][g], kw = raw[ti & 1][3][g];
                    const float av[4] = {bflo(aw.x), bfhi(aw.x), bflo(aw.y), bfhi(aw.y)}, rv[4] = {bflo(rw.x), bfhi(rw.x), bflo(rw.y), bfhi(rw.y)},
                                bv[4] = {bflo(bw.x), bfhi(bw.x), bflo(bw.y), bfhi(bw.y)}, kv[4] = {bflo(kw.x), bfhi(kw.x), bflo(kw.y), bfhi(kw.y)};
#pragma unroll
                    for (int j = 0; j < 4; ++j) { const float l = -Lt[4 * g + j];
                        const float eI = fexp(l), eX = fexp(l + e8[4 * g2 + j]), eN = frcp(eI);
                        a8[4 * g2 + j] = -av[j] * eX; r8[4 * g2 + j] = rv[j] * eI; b8[4 * g2 + j] = bv[j] * eN; k8[4 * g2 + j] = kv[j] * eN; } }
                Ap[fb][tb][s] = __builtin_bit_cast(bf16x8, pack8(a8)); Rp[fb][tb][s] = __builtin_bit_cast(bf16x8, pack8(r8));
                Bp[fb][tb][s] = __builtin_bit_cast(bf16x8, pack8(b8)); Kp[fb][tb][s] = __builtin_bit_cast(bf16x8, pack8(k8)); }
            __builtin_amdgcn_sched_barrier(0); }
#undef LOAD_TILE
        P5STAMP(2);
#define GRAM_TILE(m_, XP, YP, ib, tb) do { _Pragma("unroll") for (int q = 0; q < 16; ++q) m_[q] = 0.f; \
            _Pragma("unroll") for (int fb = 0; fb < 2; ++fb) _Pragma("unroll") for (int s = 0; s < 2; ++s) m_ = MFMA32(XP[fb][ib][s], YP[fb][tb][s], m_); } while (0)
        bf16x8 Tp[2][2][2];
        {
#pragma unroll
            for (int b = 1; b >= 0; --b) { bf16x8 AP[2], BP[2]; f32x16 CT;
                {   f32x16 m_; int rm_ = rm; asm volatile("" : "+v"(rm_));
                    GRAM_TILE(m_, Bp, Ap, b, b);
#pragma unroll
                    for (int q = 0; q < 16; ++q) m_[q] = crow(q, hm) < rm_ ? m_[q] : 0.f;
                    BP[0] = pk_tile(m_, 0); BP[1] = pk_tile(m_, 1);
#pragma unroll
                    for (int q = 0; q < 16; ++q) CT[q] = m_[q] + (crow(q, hm) == rm_ ? 1.0f : 0.f);
                    GRAM_TILE(m_, Ap, Bp, b, b);
#pragma unroll
                    for (int q = 0; q < 16; ++q) m_[q] = rm_ < crow(q, hm) ? m_[q] : 0.f;
                    AP[0] = pk_tile(m_, 0); AP[1] = pk_tile(m_, 1); }
                __builtin_amdgcn_sched_barrier(0);
#pragma unroll
                for (int it = 0; it < 4; ++it) { f32x16 pn_, pt_;
#pragma unroll
                    for (int q = 0; q < 16; ++q) { pn_[q] = 0.f; pt_[q] = 0.f; }
#pragma unroll
                    for (int s = 0; s < 2; ++s) { pn_ = MFMA32(AP[s], BP[s], pn_); pt_ = MFMA32(BP[s], AP[s], pt_); }
                    const bf16x8 bt0 = pk_tile(CT, 0), bt1 = pk_tile(CT, 1);
                    AP[0] = pk_tile(pt_, 0); AP[1] = pk_tile(pt_, 1); BP[0] = pk_tile(pn_, 0); BP[1] = pk_tile(pn_, 1);
                    CT = MFMA32(AP[0], bt0, CT); CT = MFMA32(AP[1], bt1, CT);
                    __builtin_amdgcn_sched_barrier(0); }
                Tp[b][b][0] = pk_tile(CT, 0); Tp[b][b][1] = pk_tile(CT, 1); }
            {   f32x16 x_; GRAM_TILE(x_, Ap, Bp, 1, 0);
                const bf16x8 au0 = pk_tile(x_, 0), au1 = pk_tile(x_, 1);
#pragma unroll
                for (int q = 0; q < 16; ++q) x_[q] = 0.f;
                x_ = MFMA32(au0, Tp[1][1][0], x_); x_ = MFMA32(au1, Tp[1][1][1], x_);
                const bf16x8 bx0 = pk_tile(x_, 0), bx1 = pk_tile(x_, 1);
#pragma unroll
                for (int q = 0; q < 16; ++q) x_[q] = 0.f;
                x_ = MFMA32(Tp[0][0][0], IDF(0), x_); x_ = MFMA32(Tp[0][0][1], IDF(1), x_);
                const bf16x8 at0 = pk_tile(x_, 0), at1 = pk_tile(x_, 1);
#pragma unroll
                for (int q = 0; q < 16; ++q) x_[q] = 0.f;
                x_ = MFMA32(at0, bx0, x_); x_ = MFMA32(at1, bx1, x_);
                Tp[1][0][0] = pk_tile(x_, 0); Tp[1][0][1] = pk_tile(x_, 1); }
            __builtin_amdgcn_sched_barrier(0); }
        P5STAMP(3);
        {   const bf16x8 id0 = IDF(0), id1 = IDF(1);
#pragma unroll
            for (int tb = 0; tb < 2; ++tb)
#pragma unroll
                for (int kb = 0; kb < 2; ++kb) { f32x16 xb_, xk_; const float sc = sc_[kb];
#pragma unroll
                    for (int q = 0; q < 16; ++q) { xb_[q] = 0.f; xk_[q] = 0.f; }
                    xb_ = MFMA32(Bp[kb][tb][0], id0, xb_); xb_ = MFMA32(Bp[kb][tb][1], id1, xb_);
                    xk_ = MFMA32(Kp[kb][tb][0], id0, xk_); xk_ = MFMA32(Kp[kb][tb][1], id1, xk_);
#pragma unroll
                    for (int q = 0; q < 16; ++q) { xb_[q] *= sc; xk_[q] *= sc; }
#pragma unroll
                    for (int s = 0; s < 2; ++s) { *(LAS bf16x8*)(wl + (((tb * 2 + kb) * 2 + s) * 1024) + ln * 16) = pk_tile(xb_, s); *(LAS bf16x8*)(wl + 8192 + (((tb * 2 + kb) * 2 + s) * 1024) + ln * 16) = pk_tile(xk_, s); }
                    __builtin_amdgcn_sched_barrier(0); } }
        bf16x8 Makp[2][2][2], Mbrp[2][2][2], Mkrp[2][2][2];
#define GRAM(XP, YP, STRICT, BODY) _Pragma("unroll") for (int ib = 0; ib < 2; ++ib) _Pragma("unroll") for (int tb = 0; tb < 2; ++tb) if (!(ib == 1 && tb == 0)) { f32x16 m_; \
            GRAM_TILE(m_, XP, YP, ib, tb); \
            int rm_ = rm; asm volatile("" : "+v"(rm_)); \
            _Pragma("unroll") for (int q = 0; q < 16; ++q) { const int i_ = 32 * ib + crow(q, hm), t_ = 32 * tb + rm_; m_[q] = ((STRICT) ? (i_ < t_) : (i_ <= t_)) ? m_[q] : 0.f; } \
            BODY __builtin_amdgcn_sched_barrier(0); }
        GRAM(Kp, Rp, false, { Mkrp[ib][tb][0] = pk_tile(m_, 0); Mkrp[ib][tb][1] = pk_tile(m_, 1); })
        GRAM(Kp, Ap, true, { Makp[ib][tb][0] = pk_tile(m_, 0); Makp[ib][tb][1] = pk_tile(m_, 1); })
        GRAM(Bp, Rp, false, { Mbrp[ib][tb][0] = pk_tile(m_, 0); Mbrp[ib][tb][1] = pk_tile(m_, 1); })
#undef GRAM
#undef GRAM_TILE
        P5STAMP(4);
#define IDF2(s) (*(const LAS bf16x8*)(IFR + (s) * 1024 + ln2 * 16))
        bf16x8 ATp[2][2][2];
        const int ln2 = opq_tid(F.wave) & 63;
        GAS char* pn = (GAS char*)(P0_ + (size_t)cid * 4096);
#pragma unroll
        for (int kb = 0; kb < 2; ++kb) { const bf16x8 id0 = IDF2(0), id1 = IDF2(1);
            {   bf16x8 A0p[2][2];
#pragma unroll
                for (int ib = 0; ib < 2; ++ib) { f32x16 x_;
#pragma unroll
                    for (int q = 0; q < 16; ++q) x_[q] = 0.f;
                    x_ = MFMA32(Ap[kb][ib][0], id0, x_); x_ = MFMA32(Ap[kb][ib][1], id1, x_);
                    A0p[ib][0] = pk_tile(x_, 0); A0p[ib][1] = pk_tile(x_, 1); }
#pragma unroll
                for (int tb = 0; tb < 2; ++tb) { f32x16 a_;
#pragma unroll
                    for (int q = 0; q < 16; ++q) a_[q] = 0.f;
#pragma unroll
                    for (int ib = 0; ib <= tb; ++ib)
#pragma unroll
                        for (int s = 0; s < 2; ++s) a_ = MFMA32(Tp[tb][ib][s], A0p[ib][s], a_);
                    ATp[tb][kb][0] = pk_tile(a_, 0); ATp[tb][kb][1] = pk_tile(a_, 1); } }
            __builtin_amdgcn_sched_barrier(0);
#pragma unroll
            for (int tb = 0; tb < 2; ++tb) { f32x16 p_; const int jb = kb;
#pragma unroll
                for (int q = 0; q < 16; ++q) p_[q] = 0.f;
                p_ = MFMA32(id0, Rp[jb][tb][0], p_); p_ = MFMA32(id1, Rp[jb][tb][1], p_);
#pragma unroll
                for (int ib = 0; ib <= tb; ++ib)
#pragma unroll
                    for (int s = 0; s < 2; ++s) p_ = MFMA32(ATp[ib][jb][s], Mbrp[ib][tb][s], p_);
#pragma unroll
                for (int s = 0; s < 2; ++s) *(GAS bf16x8*)(pn + ((((jb * 2 + tb) * 2 + s) * 64) + ln2) * 16) = pk_tile(p_, s);
                __builtin_amdgcn_sched_barrier(0); } }
        P5STAMP(6);
        bf16x8 W1p[2][2][2], Vp[2][2][2];
        const int lc_ = ln2;
        const unsigned vC = (nb0 + 4u * (unsigned)(lc_ >> 5) * BW + (unsigned)(lc_ & 31)) * 2u;
#pragma unroll
        for (int ib = 0; ib < 2; ++ib)
#pragma unroll
            for (int vb = 0; vb < 2; ++vb) { f32x16 v_;
#pragma unroll
                for (int q = 0; q < 16; ++q) v_[q] = bf2f(LD16(V_, OADD(vC, ((32 * ib + ROWQ(q)) * BW + 32 * vb) * 2)));
                Vp[ib][vb][0] = pk_tile(v_, 0); Vp[ib][vb][1] = pk_tile(v_, 1); }
#pragma unroll
        for (int vb = 0; vb < 2; ++vb) { bf16x8 W0p[2][2];
#pragma unroll
            for (int tb = 0; tb < 2; ++tb) { f32x16 w_;
#pragma unroll
                for (int q = 0; q < 16; ++q) w_[q] = 0.f;
#pragma unroll
                for (int ib = 0; ib <= tb; ++ib)
#pragma unroll
                    for (int s = 0; s < 2; ++s) w_ = MFMA32(Makp[ib][tb][s], Vp[ib][vb][s], w_);
                W0p[tb][0] = pk_tile(w_, 0); W0p[tb][1] = pk_tile(w_, 1); }
#pragma unroll
            for (int tb = 0; tb < 2; ++tb) { f32x16 w_;
#pragma unroll
                for (int q = 0; q < 16; ++q) w_[q] = 0.f;
#pragma unroll
                for (int ib = 0; ib <= tb; ++ib)
#pragma unroll
                    for (int s = 0; s < 2; ++s) w_ = MFMA32(Tp[tb][ib][s], W0p[ib][s], w_);
                W1p[tb][vb][0] = pk_tile(w_, 0); W1p[tb][vb][1] = pk_tile(w_, 1); }
            __builtin_amdgcn_sched_barrier(0); }
        P5STAMP(7);
        GAS char* qn = (GAS char*)(QO0_ + (size_t)cid * 4096);
#pragma unroll
        for (int tb = 0; tb < 2; ++tb)
#pragma unroll
            for (int vb = 0; vb < 2; ++vb) { f32x16 y_;
#pragma unroll
                for (int q = 0; q < 16; ++q) y_[q] = 0.f;
#pragma unroll
                for (int ib = 0; ib <= tb; ++ib)
#pragma unroll
                    for (int s = 0; s < 2; ++s) { y_ = MFMA32(Mbrp[ib][tb][s], W1p[ib][vb][s], y_); y_ = MFMA32(Mkrp[ib][tb][s], Vp[ib][vb][s], y_); }
#pragma unroll
                for (int g = 0; g < 4; ++g) { u32x2 w; w.x = pk2(y_[4 * g], y_[4 * g + 1]); w.y = pk2(y_[4 * g + 2], y_[4 * g + 3]); *(GAS u32x2*)(qn + ((((tb * 2 + vb) * 4 + g) * 64) + ln2) * 8) = w; }
                __builtin_amdgcn_sched_barrier(0); }
        P5STAMP(8);
        wave_lds_fence();
        bf16x8 Bh[2][2][2];
#pragma unroll
        for (int tb = 0; tb < 2; ++tb)
#pragma unroll
            for (int kb = 0; kb < 2; ++kb)
#pragma unroll
                for (int s = 0; s < 2; ++s) Bh[tb][kb][s] = *(const LAS bf16x8*)(wl + (((tb * 2 + kb) * 2 + s) * 1024) + ln2 * 16);
        GAS char* gt = (GAS char*)(GT + (size_t)cid * 4096); GAS char* ht = (GAS char*)(HT + (size_t)cid * 4096);
#pragma unroll
        for (int kb = 0; kb < 2; ++kb)
#pragma unroll
            for (int jb = 0; jb < 2; ++jb) { f32x16 g_;
                const float dg = sc_[kb];
#pragma unroll
                for (int q = 0; q < 16; ++q) g_[q] = (kb == jb && crow(q, hm) == rm) ? dg : 0.f;
#pragma unroll
                for (int tb = 0; tb < 2; ++tb)
#pragma unroll
                    for (int s = 0; s < 2; ++s) g_ = MFMA32(ATp[tb][jb][s], Bh[tb][kb][s], g_);
#pragma unroll
                for (int s = 0; s < 2; ++s) *(GAS bf16x8*)(gt + ((kb * 4 + jb * 2 + s) * 64 + ln2) * 16) = pk_tile(g_, s);
                __builtin_amdgcn_sched_barrier(0); }
        {   bf16x8 Kh[2][2][2];
#pragma unroll
            for (int tb = 0; tb < 2; ++tb)
#pragma unroll
                for (int kb = 0; kb < 2; ++kb)
#pragma unroll
                    for (int s = 0; s < 2; ++s) Kh[tb][kb][s] = *(const LAS bf16x8*)(wl + 8192 + (((tb * 2 + kb) * 2 + s) * 1024) + ln2 * 16);
#pragma unroll
            for (int kb = 0; kb < 2; ++kb)
#pragma unroll
                for (int vb = 0; vb < 2; ++vb) { f32x16 h_;
#pragma unroll
                    for (int q = 0; q < 16; ++q) h_[q] = 0.f;
#pragma unroll
                    for (int tb = 0; tb < 2; ++tb)
#pragma unroll
                        for (int s = 0; s < 2; ++s) { h_ = MFMA32(Bh[tb][kb][s], W1p[tb][vb][s], h_); h_ = MFMA32(Kh[tb][kb][s], Vp[tb][vb][s], h_); }
#pragma unroll
                    for (int g = 0; g < 4; ++g) { u32x2 w; w.x = pk2(h_[4 * g], h_[4 * g + 1]); w.y = pk2(h_[4 * g + 2], h_[4 * g + 3]); *(GAS u32x2*)(ht + ((((kb * 2 + vb) * 4 + g) * 64) + ln2) * 8) = w; }
                    __builtin_amdgcn_sched_barrier(0); } }
        P5STAMP(9);
#undef IDF
#undef IDF2
#if defined(STAMPS)
        if (F.gw == 0 && cid == 0 && lane == 0) { _Pragma("unroll") for (int k_ = 0; k_ < 10; ++k_) ((unsigned long long*)(F0_ws + WS_CTL + 49152))[32 + k_] = p5ts[k_]; }
#endif
        wave_lds_fence();
#undef XL
#undef OADD
#undef LD16
#undef ROWQ
    }
}

#if defined(CHECKS)
constexpr size_t WS_FLG = WS_CTL + 32768;
DI unsigned* chk_flags(unsigned char* ws) { return (unsigned*)(ws + WS_FLG); }
DI void chk(unsigned char* ws, int id, float got, float want, float rel, float ab) {
    const float d = fabsf(got - want), lim = rel * fmaxf(fabsf(got), fabsf(want)) + ab;
    if (!(d <= lim)) chk_flags(ws)[id] = 1u; }
DI unsigned hsh(unsigned a) { a ^= a >> 16; a *= 0x7feb352du; a ^= a >> 15; a *= 0x846ca68bu; a ^= a >> 16; return a; }
DI float bfr(float v) { return bflo(f2bf(v)); }
DI int scol_of(int n) { return n < 3360 ? n : (n < 3584 ? -1 : n - 224); }

DI void chk_p0(const Frame& F, ARef A) {
    unsigned char* ws = A.ws; const int lane = F.lane;
    const float* mod = (const float*)(ws + WS_MOD);
    for (int s = F.wave; s < 32; s += NWAVES) { const unsigned hh = hsh(1000 + s); const int b = hh & 3, o = (hh >> 2) % 6144; float a = 0.f;
        for (int k = lane; k < D; k += 64) { const float c = A.c[b * D + k]; a += (c / (1.0f + expf(-c))) * A.w_mod[(size_t)k * 6144 + o]; }
        a = wave_sum(a) + A.b_mod[o]; chk(ws, 10, mod[b * 6144 + o], a, 1e-3f, 1e-4f); }
    const bf16* wt = (const bf16*)(ws + WS_WIN);
    for (int s = 0; s < 8; ++s) { const unsigned hh = hsh(2000 + (F.wave * 8 + s) * 64 + lane); const int n = hh % NPAD, k = (hh >> 13) & 1023; const int sc = scol_of(n);
        const float want = sc >= 0 ? bfr(A.w_in[(size_t)k * IN_COLS + sc]) : 0.f; chk(ws, 11, bf2f(wt[(size_t)n * D + k]), want, 0.f, 0.f); }
    { const unsigned hh = hsh(3000 + F.wave * 64 + lane); const int n = hh & 1023, k = (hh >> 10) & 511, k2 = (hh >> 10) & 1023;
        chk(ws, 11, bf2f(((const bf16*)(ws + WS_WOSB))[n * BW + k]), bfr(A.w_o_sb[k * D + n]), 0.f, 0.f);
        chk(ws, 11, bf2f(((const bf16*)(ws + WS_WORW))[n * BW + k]), bfr(A.w_o_rw[k * D + n]), 0.f, 0.f);
        chk(ws, 11, bf2f(((const bf16*)(ws + WS_WOUT))[n * D + k2]), bfr(A.w_out[k2 * D + n]), 0.f, 0.f);
        const int o = hh % 36; chk(ws, 11, ((const float*)(ws + WS_RTW))[o * D + k2], o < 4 ? A.w_group[k2 * 4 + o] : A.w_router[k2 * NE + o - 4], 0.f, 0.f);
        const int nl = hh % 1536, kl = (hh >> 11) % LK; float v = 0.f;
        if (nl < 512) { if (kl < 64) v = A.w_decay_up[kl * BW + nl]; } else if (nl < 1024) { if (kl >= 64 && kl < 128) v = A.w_iclr_up[(kl - 64) * BW + nl - 512]; } else { if (kl >= 128 && kl < 288) v = A.w_gate_up[(kl - 128) * BW + nl - 1024]; }
        chk(ws, 11, bf2f(((const bf16*)(ws + WS_WL))[nl * LK + kl]), bfr(v), 0.f, 0.f); }
}
DI void chk_p1(const Frame& F, ARef A, const bf16* H1) {
    unsigned char* ws = A.ws; const int lane = F.lane; const float* mod = (const float*)(ws + WS_MOD);
    for (int s = F.wave; s < 16; s += NWAVES) { const int n = hsh(4000 + s) % NTOK, b = n >> 13; float ss = 0.f;
        for (int k = lane; k < D; k += 64) { const float v = A.x[(size_t)n * D + k]; ss += v * v; }
        const float inv = 1.0f / sqrtf(wave_sum(ss) / D + NORM_EPS);
        for (int k = lane; k < D; k += 64) { const float want = (A.x[(size_t)n * D + k] * inv) * A.gains[k] * (1.0f + mod[b * 6144 + D + k]) + mod[b * 6144 + k];
            chk(ws, 12, bf2f(H1[(size_t)n * D + k]), want, 0.01f, 0.01f); } }
}
DI float wdot(const bf16* arow, const float* W, int ldw, int col, int K, int lane) { float a = 0.f; for (int k = lane; k < K; k += 64) a += bf2f(arow[k]) * W[(size_t)k * ldw + col]; return wave_sum(a); }
DI void chk_p2(const Frame& F, ARef A, const bf16* H1) {
    unsigned char* ws = A.ws; const int lane = F.lane;
    for (int s = F.wave; s < 96; s += NWAVES) { const unsigned hh = hsh(5000 + s); const int n = hh % NTOK, region = s % 6; int col;
        const unsigned h2 = hsh(hh);
        float got, want; int id = 13 + region;
        if (region == 0) { col = h2 % 512; want = 0.125f * wdot(H1 + (size_t)n * D, A.w_in, IN_COLS, col, D, lane); got = bf2f(((const bf16*)(ws + WS_QB))[(size_t)n * BW + col]); }
        else if (region == 1) { col = h2 % 512; want = wdot(H1 + (size_t)n * D, A.w_in, IN_COLS, 512 + col, D, lane); got = bf2f(((const bf16*)(ws + WS_KB))[(size_t)n * BW + col]); }
        else if (region == 2) { col = h2 % 512; want = wdot(H1 + (size_t)n * D, A.w_in, IN_COLS, 1024 + col, D, lane); got = bf2f(((const bf16*)(ws + WS_VT))[((size_t)((n >> 13) * BW + col)) * SEQ + (n & (SEQ - 1))]); }
        else if (region == 3) { col = h2 % 1536; want = wdot(H1 + (size_t)n * D, A.w_in, IN_COLS, 1536 + col, D, lane); got = bf2f(((const bf16*)(ws + WS_RWRAW))[(size_t)n * 1536 + col]); }
        else if (region == 4) { col = h2 % 288; want = wdot(H1 + (size_t)n * D, A.w_in, IN_COLS, 3072 + col, D, lane); got = bf2f(((const bf16*)(ws + WS_LORA))[(size_t)n * BW + col]); }
        else { col = h2 % 2048; want = wdot(H1 + (size_t)n * D, A.w_in, IN_COLS, 3360 + col, D, lane) + A.gate_bias[col]; want = 1.0f / (1.0f + expf(-want)); got = bf2f(((const bf16*)(ws + WS_GATE))[(size_t)n * 2048 + col]); }
        chk(ws, id, got, want, 0.03f, 0.02f); }
}
constexpr int NATT = 16;
DI void att_sample(int s, int& b, int& h, int& t) { const unsigned hh = hsh(6000 + s); b = hh & 3; h = (hh >> 2) & 7; t = (s < 4) ? (s * 37) : (int)((hh >> 5) % SEQ); }
DI void chk_p3_save(const Frame& F, ARef A) {
    if (F.wave == 0) { bf16* sv = (bf16*)(A.ws + WS_FLG + 4096);
        for (int s = 0; s < NATT; ++s) { int b, h, t; att_sample(s, b, h, t); sv[s * 64 + F.lane] = ((const bf16*)(A.ws + WS_QB))[(size_t)(b * SEQ + t) * BW + h * HD + F.lane]; } }
}
DI void chk_p3(const Frame& F, ARef A, const bf16* R, const bf16* KS, const bf16* V, const bf16* KK) {
    unsigned char* ws = A.ws; const int lane = F.lane;
    const bf16* sv = (const bf16*)(ws + WS_FLG + 4096); const bf16* KB = (const bf16*)(ws + WS_KB); const bf16* VT = (const bf16*)(ws + WS_VT);
    for (int s = F.wave; s < NATT; s += NWAVES) { int b, h, t; att_sample(s, b, h, t);
        const float q = bf2f(sv[s * 64 + lane]); float later = 0.f, o = 0.f;
        for (int k = t - 1; k >= 0; --k) { const float z = wave_sum(q * bf2f(KB[(size_t)(b * SEQ + k) * BW + h * HD + lane]));
            const float sp = fmaxf(z, 0.f) + log1pf(expf(-fabsf(z)));
            o += expf(z - sp + later) * bf2f(VT[((size_t)((b * NH + h) * HD + lane)) * SEQ + k]);
            later -= sp; if (later < -200.f) break; }
        chk(ws, 19, bf2f(((const bf16*)(ws + WS_QB))[(size_t)(b * SEQ + t) * BW + h * HD + lane]), o, 0.04f, 0.02f); }
    const bf16* RW = (const bf16*)(ws + WS_RWRAW); const bf16* LO = (const bf16*)(ws + WS_LORA); const bf16* AL = (const bf16*)(ws + WS_ALORA);
    for (int s = F.wave; s < 32; s += NWAVES) { const unsigned hh = hsh(7000 + s); const int n = (s < 4) ? s * SEQ : (int)(hh % NTOK), hd = (hh >> 16) & 7; const bool first = (n & (SEQ - 1)) == 0;
        float xs[3];
        for (int p = 0; p < 3; ++p) { const int col = p * 512 + hd * 64 + lane; const float cur = bf2f(RW[(size_t)n * 1536 + col]), prv = first ? 0.f : bf2f(RW[(size_t)(n - 1) * 1536 + col]); xs[p] = cur + A.shift_mu[col] * (prv - cur); }
        const size_t o = (size_t)n * BW + hd * 64 + lane;
        chk(ws, 20, bf2f(R[o]), xs[0], 0.01f, 0.005f); chk(ws, 20, bf2f(KS[o]), xs[1], 0.01f, 0.005f); chk(ws, 20, bf2f(V[o]), xs[2], 0.01f, 0.005f);
        const float kk = xs[1] * A.k_k[hd * 64 + lane]; const float nn = sqrtf(wave_sum(kk * kk));
        chk(ws, 20, bf2f(KK[o]), kk / fmaxf(nn, L2_EPS), 0.01f, 0.002f);
        for (int c = lane; c < LK; c += 64) { float want = 0.f;
            if (c < 288) { const float cur = bf2f(LO[(size_t)n * BW + c]), prv = first ? 0.f : bf2f(LO[(size_t)(n - 1) * BW + c]); const float v = cur + A.shift_mu[1536 + c] * (prv - cur);
                want = c < 64 ? tanhf(v) : (c < 128 ? v : 1.0f / (1.0f + expf(-v))); }
            chk(ws, 20, bf2f(AL[(size_t)n * LK + c]), want, 0.01f, 0.005f); } }
}
DI void chk_p4_save(const Frame& F, ARef A, const bf16* KS) {
    if (F.wave == 0) { bf16* sv = (bf16*)(A.ws + WS_FLG + 8192);
        for (int s = 0; s < 16; ++s) { const unsigned hh = hsh(8000 + s); const int n = hh % NTOK, hd = (hh >> 16) & 7; sv[s * 64 + F.lane] = KS[(size_t)n * BW + hd * 64 + F.lane]; } }
}
DI void chk_p4(const Frame& F, ARef A, const bf16* KP, const bf16* KK) {
    unsigned char* ws = A.ws; const int lane = F.lane; const bf16* AL = (const bf16*)(ws + WS_ALORA); const bf16* sv = (const bf16*)(ws + WS_FLG + 8192);
    for (int s = F.wave; s < 16; s += NWAVES) { const unsigned hh = hsh(8000 + s); const int n = hh % NTOK, hd = (hh >> 16) & 7, c = hd * 64 + lane; const size_t o = (size_t)n * BW + c;
        float lw = 0.f, la = 0.f, lg = 0.f;
        for (int k = 0; k < 64; ++k) { lw += bf2f(AL[(size_t)n * LK + k]) * A.w_decay_up[k * BW + c]; la += bf2f(AL[(size_t)n * LK + 64 + k]) * A.w_iclr_up[k * BW + c]; }
        for (int k = 0; k < 160; ++k) lg += bf2f(AL[(size_t)n * LK + 128 + k]) * A.w_gate_up[k * BW + c];
        const float x = -(A.w0[c] + lw), w = -(fmaxf(x, 0.f) + log1pf(expf(-fabsf(x)))) - 0.5f;
        chk(ws, 21, bf2f(((const bf16*)(ws + WS_E))[o]), expf(w), 0.03f, 0.003f);
        const float a = 1.0f / (1.0f + expf(-(A.a0[c] + la))); const float ks = bf2f(sv[s * 64 + lane]);
        chk(ws, 22, bf2f(KP[o]), ks * (1.0f + (a - 1.0f) * A.k_a[c]), 0.03f, 0.01f);
        chk(ws, 22, bf2f(((const bf16*)(ws + WS_B))[o]), bf2f(KK[o]) * a, 0.03f, 0.003f);
        chk(ws, 23, bf2f(((const bf16*)(ws + WS_GG))[o]), lg, 0.03f, 0.01f); }
}
constexpr int NST = 300;
DI void chk_p7_save(const Frame& F, ARef A) {
    if (F.wave < 4) { const int b = (F.wave * 3) & 3, h = (F.wave * 5 + 1) & 7; bf16* sv = (bf16*)(A.ws + 256 * 1024) + F.wave * NST * 64;
        for (int t = 0; t < NST; ++t) sv[t * 64 + F.lane] = ((const bf16*)(A.ws + WS_E))[(size_t)(b * SEQ + t) * BW + h * HD + F.lane]; }
}
DI void chk_p7(const Frame& F, ARef A, const bf16* R, const bf16* KP, const bf16* V, const bf16* KK) {
    unsigned char* ws = A.ws; const int lane = F.lane;
    const bf16* Bv = (const bf16*)(ws + WS_B); const bf16* Esv = (const bf16*)(ws + 256 * 1024) + F.wave * NST * 64; const bf16* GG = (const bf16*)(ws + WS_GG); const bf16* YRW = (const bf16*)(ws + WS_YRW);
    if (F.wave < 4) { const int b = (F.wave * 3) & 3, h = (F.wave * 5 + 1) & 7, col0 = h * HD;
        float S[64];
#pragma unroll
        for (int k = 0; k < 64; ++k) S[k] = 0.f;
        for (int t = 0; t < NST; ++t) { const size_t o = (size_t)(b * SEQ + t) * BW + col0 + lane;
            const float av = -bf2f(KK[o]), bv = bf2f(Bv[o]), dv = expf(-bf2f(Esv[t * 64 + lane])), kv = bf2f(KP[o]), rv = bf2f(R[o]), vv = bf2f(V[o]);
            float sa = 0.f;
#pragma unroll
            for (int k = 0; k < 64; ++k) sa += S[k] * __shfl(av, k);
            float y = 0.f;
#pragma unroll
            for (int k = 0; k < 64; ++k) { S[k] = S[k] * __shfl(dv, k) + sa * __shfl(bv, k) + vv * __shfl(kv, k); y += S[k] * __shfl(rv, k); }
            const float mean = wave_sum(y) / 64.f, d = y - mean, var = wave_sum(d * d) / 64.f;
            const float yn = d / sqrtf(var + GN_EPS) * A.lnx_w[col0 + lane] + A.lnx_b[col0 + lane];
            const float bonus = wave_sum(rv * kv * A.r_k[col0 + lane]) * vv;
            const float want = (yn + bonus) * bf2f(GG[o]);
            chk(ws, t < 128 ? 24 : 25, bf2f(YRW[o]), want, 0.05f, 0.03f); } }
}
DI void chk_p8(const Frame& F, ARef A) {
    unsigned char* ws = A.ws; const int lane = F.lane;
    for (int s = F.wave; s < 32; s += NWAVES) { const unsigned hh = hsh(9000 + s); const int n = hh % NTOK, c = (hh >> 15) & 1023;
        const float p1 = wdot((const bf16*)(ws + WS_QB) + (size_t)n * BW, A.w_o_sb, D, c, BW, lane), p2 = wdot((const bf16*)(ws + WS_YRW) + (size_t)n * BW, A.w_o_rw, D, c, BW, lane);
        const bf16* ga = (const bf16*)(ws + WS_GATE) + (size_t)n * 2048;
        chk(ws, 26, bf2f(((const bf16*)(ws + WS_MRG))[(size_t)n * D + c]), bf2f(ga[c]) * p1 + bf2f(ga[1024 + c]) * p2, 0.03f, 0.01f); }
}
DI void chk_p9(const Frame& F, ARef A) {
    unsigned char* ws = A.ws; const int lane = F.lane;
    for (int s = F.wave; s < 32; s += NWAVES) { const unsigned hh = hsh(9500 + s); const int n = hh % NTOK, c = (hh >> 15) & 1023;
        chk(ws, 27, bf2f(((const bf16*)(ws + WS_Y1))[(size_t)n * D + c]), wdot((const bf16*)(ws + WS_MRG) + (size_t)n * D, A.w_out, D, c, D, lane), 0.03f, 0.01f); }
}
DI void chk_p10(const Frame& F, ARef A) {
    unsigned char* ws = A.ws; const int lane = F.lane; const float* mod = (const float*)(ws + WS_MOD);
    const bf16* Y1 = (const bf16*)(ws + WS_Y1); const bf16* H2 = (const bf16*)(ws + WS_H2); const i32x4* tok = (const i32x4*)(ws + WS_TOK);
    for (int s = F.wave; s < 32; s += NWAVES) { const int n = s == 0 ? DBG_TOKEN : (s < 16 ? (int)(hsh(10000 + s) % 128) : (int)(hsh(10000 + s) % NTOK)), b = n >> 13; float ss = 0.f;
        for (int k = lane; k < D; k += 64) { const float v = bf2f(Y1[(size_t)n * D + k]); ss += v * v; }
        const float inv1 = 1.0f / sqrtf(wave_sum(ss) / D + NORM_EPS); float s2 = 0.f;
        for (int k = lane; k < D; k += 64) { const float x1 = A.x[(size_t)n * D + k] + mod[b * 6144 + 2 * D + k] * ((bf2f(Y1[(size_t)n * D + k]) * inv1) * A.gains[D + k]);
            chk(ws, 28, A.out[(size_t)n * D + k], x1, 1e-3f, 1e-3f); s2 += x1 * x1; }
        const float inv2 = 1.0f / sqrtf(wave_sum(s2) / D + NORM_EPS);
        float lg[36];
#pragma unroll
        for (int o = 0; o < 36; ++o) lg[o] = 0.f;
        for (int k = lane; k < D; k += 64) { const float h2 = (A.out[(size_t)n * D + k] * inv2) * A.gains[2 * D + k] * (1.0f + mod[b * 6144 + 4 * D + k]) + mod[b * 6144 + 3 * D + k];
            chk(ws, 29, bf2f(H2[(size_t)n * D + k]), h2, 0.01f, 0.01f);
#pragma unroll
            for (int o = 0; o < 36; ++o) lg[o] += h2 * (o < 4 ? A.w_group[k * 4 + o] : A.w_router[k * NE + o - 4]); }
#pragma unroll
        for (int o = 0; o < 36; ++o) lg[o] = wave_sum(lg[o]);
        int gs = 0; float gm = lg[0];
#pragma unroll
        for (int g = 1; g < 4; ++g) if (lg[g] > gm) { gm = lg[g]; gs = g; }
        float gsum = 0.f;
#pragma unroll
        for (int g = 0; g < 4; ++g) gsum += expf(lg[g] - gm);
        float el[8];
#pragma unroll
        for (int e = 0; e < 8; ++e) el[e] = gs == 0 ? lg[4 + e] : (gs == 1 ? lg[12 + e] : (gs == 2 ? lg[20 + e] : lg[28 + e]));
        int i0 = 0; float m0 = el[0];
#pragma unroll
        for (int e = 1; e < 8; ++e) if (el[e] > m0) { m0 = el[e]; i0 = e; }
        int i1 = -1; float m1 = -3.0e38f;
#pragma unroll
        for (int e = 0; e < 8; ++e) if (e != i0 && el[e] > m1) { m1 = el[e]; i1 = e; }
        const float tt = expf(m1 - m0), p0 = 1.0f / (1.0f + tt);
        const i32x4 rec = tok[n];
        if (lane == 0 && s < 16) { if ((rec.x & 255) != gs * 8 + i0 || ((rec.x >> 8) & 255) != gs * 8 + i1) chk_flags(ws)[30] = 1u;
            if (n == DBG_TOKEN) { const float* dbg = (const float*)chk_flags(ws) + 48; float code = 1.f;
                if (dbg[4] > 4.001f) code += 2.f; if (dbg[5] < 0.499f) code += 4.f;
                if (fabsf(dbg[0] - lg[0]) > 1e-3f || fabsf(dbg[1] - lg[1]) > 1e-3f || fabsf(dbg[2] - lg[2]) > 1e-3f || fabsf(dbg[3] - lg[3]) > 1e-3f) code += 8.f;
                if (fabsf(dbg[4] - gsum) > 1e-3f) code += 16.f; if (fabsf(dbg[6] * dbg[5] - __builtin_bit_cast(float, rec.z)) > 1e-4f) code += 32.f;
                ((float*)chk_flags(ws))[62] = code * 0.1f; ((float*)chk_flags(ws))[63] = dbg[4]; }
            chk(ws, 56, ((const float*)(ws + WS_CW))[2 * n], p0 / gsum, 3e-2f, 1e-4f); chk(ws, 57, ((const float*)(ws + WS_CW))[2 * n + 1], tt * p0 / gsum, 3e-2f, 1e-4f);
            chk(ws, 58, ((const float*)(ws + WS_CW))[2 * n], p0 / gsum, 1e-3f, 1e-5f); chk(ws, 59, ((const float*)(ws + WS_CW))[2 * n + 1], tt * p0 / gsum, 1e-3f, 1e-5f); } }
}
DI void chk_p11(const Frame& F, ARef A) {
    unsigned char* ws = A.ws; const int lane = F.lane; const i32x4* tok = (const i32x4*)(ws + WS_TOK); const int* tile = (const int*)(ws + WS_TILE);
    const bf16* H2 = (const bf16*)(ws + WS_H2); const bf16* HS = (const bf16*)(ws + WS_HS);
    for (int s = F.wave; s < 64; s += NWAVES) { const int n = hsh(11000 + s) % NTOK; const i32x4 rec = tok[n];
        if (rec.x < 0 || rec.x >= tile[MAXT] * 256 || rec.y < 0 || rec.y >= tile[MAXT] * 256 || tile[MAXT] > MAXT || tile[MAXT] < 256) { chk_flags(ws)[32] = 1u; continue; }
        for (int k = lane; k < D; k += 64) { chk(ws, 33, bf2f(HS[(size_t)rec.x * D + k]), bf2f(H2[(size_t)n * D + k]), 0.f, 0.f); chk(ws, 33, bf2f(HS[(size_t)rec.y * D + k]), bf2f(H2[(size_t)n * D + k]), 0.f, 0.f); } }
    { const unsigned hh = hsh(12000 + F.wave * 64 + lane); const int e = hh & 31, n = (hh >> 5) & 1023, k = (hh >> 15) & 1023, k5 = k & 511;
        const int c = (n >> 3) * 4 + (n & 3); const float want = (n & 4) ? A.w_up3[((size_t)e * D + k) * DE + c] : A.w_up1[((size_t)e * D + k) * DE + c];
        chk(ws, 34, bf2f(((const bf16*)(ws + WS_WUP))[((size_t)e * 1024 + n) * D + k]), bfr(want), 0.f, 0.f);
        chk(ws, 35, bf2f(((const bf16*)(ws + WS_WDN))[((size_t)e * 1024 + n) * DE + k5]), bfr(A.w_down[((size_t)e * DE + k5) * D + n]), 0.f, 0.f); }
}
DI void chk_p12(const Frame& F, ARef A) {
    unsigned char* ws = A.ws; const int lane = F.lane; const i32x4* tok = (const i32x4*)(ws + WS_TOK); const int* tile = (const int*)(ws + WS_TILE);
    const bf16* H2 = (const bf16*)(ws + WS_H2); const bf16* HID = (const bf16*)(ws + WS_HID);
    for (int s = F.wave; s < 32; s += NWAVES) { const unsigned hh = hsh(13000 + s); const int n = hh % NTOK, c = (hh >> 16) & 511; const i32x4 rec = tok[n]; const int pos = (s & 1) ? rec.y : rec.x;
        const int e = tile[pos >> 8];
        const float u1 = wdot(H2 + (size_t)n * D, A.w_up1 + (size_t)e * D * DE, DE, c, D, lane), u3 = wdot(H2 + (size_t)n * D, A.w_up3 + (size_t)e * D * DE, DE, c, D, lane);
        chk(ws, 36, bf2f(HID[(size_t)pos * DE + c]), u1 / (1.0f + expf(-u1)) * u3, 0.04f, 0.01f); }
}
DI void chk_p13(const Frame& F, ARef A) {
    unsigned char* ws = A.ws; const int lane = F.lane; const i32x4* tok = (const i32x4*)(ws + WS_TOK); const int* tile = (const int*)(ws + WS_TILE);
    const bf16* HID = (const bf16*)(ws + WS_HID); const bf16* YE = (const bf16*)(ws + WS_HS);
    for (int s = F.wave; s < 32; s += NWAVES) { const unsigned hh = hsh(14000 + s); const int n = hh % NTOK, c = (hh >> 16) & 1023; const i32x4 rec = tok[n]; const int pos = (s & 1) ? rec.y : rec.x;
        const int e = tile[pos >> 8];
        chk(ws, 37, bf2f(YE[(size_t)pos * D + c]), wdot(HID + (size_t)pos * DE, A.w_down + (size_t)e * DE * D, D, c, DE, lane), 0.04f, 0.01f); }
}
#endif

__global__ void __launch_bounds__(NTHR, 2) hybrid_fwd(Args A_unused) {
    extern __shared__ __attribute__((aligned(16))) unsigned char lds_raw[];
    const CAS Args& A = *(const CAS Args*)__builtin_amdgcn_kernarg_segment_ptr();
    Frame F;
    F.lds = (LAS unsigned char*)lds_raw;
    F.wave = __builtin_amdgcn_readfirstlane((int)threadIdx.x >> 6); F.tid = opq_tid(F.wave); F.lane = F.tid & 63;
    F.wg = blockIdx.x; F.G = gridDim.x; F.gw = F.wg * NWAVES + F.wave; F.NGW = F.G * NWAVES;
    volatile LAS unsigned* MISC = (volatile LAS unsigned*)(F.lds + LDS_MISC);
    if (F.wave == 0) MISC[F.lane] = 0u;
    __syncthreads();
    const XcdBarrier bar = xcd_barrier_post((unsigned*)(A.ws + WS_CTL), MISC + 8, F.wave);
    unsigned char* ws = A.ws;
    LAS unsigned char* stage = F.lds;
    bf16* const dob = (bf16*)A.out;
    bf16 *H1 = dob, *R = dob, *KS = dob + (size_t)NTOK * BW, *V = dob + 2 * (size_t)NTOK * BW, *KK = dob + 3 * (size_t)NTOK * BW;

#if defined(STAMPS)
    unsigned long long* const tsp = (unsigned long long*)(ws + WS_CTL + 49152);
#define STAMP(k) do { if (F.wg == 0 && xb_t0(F.wave)) tsp[k] = wall_clock64(); } while (0)
#else
#define STAMP(k) do { } while (0)
#endif
#if defined(REPEAT_PHASE)
#ifndef REPEAT_COUNT
#define REPEAT_COUNT 2
#endif
#define REP(k) _Pragma("nounroll") for (int rep_ = 0; rep_ < ((k) == REPEAT_PHASE ? REPEAT_COUNT : 1); ++rep_)
#else
#define REP(k)
#endif
    STAMP(0);
    REP(0) {
    p0_prologue(F, A);
    xcd_barrier(bar);
    }
    STAMP(1);
#if defined(CHECKS)
    if (F.wg == 0) chk_p0(F, A);
#endif
    REP(1) {
    p1_h1(F, A, H1);
    xcd_barrier(bar);
    }
    STAMP(2);
#if defined(CHECKS)
    if (F.wg == 0) chk_p1(F, A, H1);
#endif
    REP(2) {
    {   pg8::Gemm g{H1, (const bf16*)(ws + WS_WIN), NTOK, NPAD, D}; pg8::StaticOrder S; S.init(NTOK, NPAD, F.G, F.wg);
        EpiIn E{(bf16*)(ws + WS_QB), (bf16*)(ws + WS_KB), (bf16*)(ws + WS_VT), (bf16*)(ws + WS_RWRAW), (bf16*)(ws + WS_LORA), (bf16*)(ws + WS_GATE), A.gate_bias};
        pg8::gemm_phase<EpiIn, pg8::StaticOrder>(stage, g, S, E, nullptr, F.wave); }
    xcd_barrier(bar);
    }
    STAMP(3);
#if defined(CHECKS)
    if (F.wg == 0) { chk_p2(F, A, H1); chk_p3_save(F, A); }
    xcd_barrier(bar);
#endif
#if !defined(CHECKS)
    const bool fuse34 = (F.G == 256);
#else
    const bool fuse34 = false;
#endif
    REP(3) {
    p3_attn(F, (const bf16*)(ws + WS_QB), (const bf16*)(ws + WS_KB), (const bf16*)(ws + WS_VT), (bf16*)(ws + WS_QB));
#if defined(STAMPS)
    STAMP(20);
#endif
    p3_prep(F, A, (const bf16*)(ws + WS_RWRAW), (const bf16*)(ws + WS_LORA), R, KS, V, KK, (bf16*)(ws + WS_ALORA));
#if !defined(CHECKS)
    if (fuse34) { asm volatile("s_waitcnt vmcnt(0)" ::: "memory"); __syncthreads();
        p4_lora(F, A, (const bf16*)(ws + WS_ALORA), (const bf16*)(ws + WS_WL), (bf16*)(ws + WS_E), KS, (bf16*)(ws + WS_B), (bf16*)(ws + WS_GG), KK, R, (float*)(ws + WS_BON)); }
#endif
    xcd_barrier(bar);
    }
#if defined(STAMPS)
    STAMP(21);
#endif
    STAMP(4);
#if defined(CHECKS)
    if (F.wg == 0) { chk_p3(F, A, R, KS, V, KK); chk_p4_save(F, A, KS); }
    xcd_barrier(bar);
#endif
    if (!fuse34) {
    p4_lora(F, A, (const bf16*)(ws + WS_ALORA), (const bf16*)(ws + WS_WL), (bf16*)(ws + WS_E), KS, (bf16*)(ws + WS_B), (bf16*)(ws + WS_GG), KK, R, (float*)(ws + WS_BON));
    xcd_barrier(bar);
    }
    STAMP(5);
#if defined(CHECKS)
    if (F.wg == 0) chk_p4(F, A, KS, KK);
#endif
    REP(5) {
    p5_mfma(ws, F, R, KS, V, KK, (const bf16*)(ws + WS_B), (const bf16*)(ws + WS_E), (bf16*)(ws + WS_P), (bf16*)(ws + WS_QO), (bf16*)(ws + WS_GT), (bf16*)(ws + WS_HT));
    p6_moe_weights(F, A, F.gw, F.NGW);
    xcd_barrier(bar);
    }
    STAMP(6);
#if defined(CHECKS)
    if (F.wg == 255) chk_p7_save(F, A);
#endif
    REP(6) {
    {   const int ncw = F.G < 64 ? F.G : 64;
        if (F.wg < ncw) { if (F.wave == 0) for (int task = F.wg; task < 64; task += ncw) p6_chain(task, F.wave, F.lds, (const bf16*)(ws + WS_GT), (const bf16*)(ws + WS_HT), (bf16*)(ws + WS_SC));
#if defined(STAMPS)
            STAMP(22);
#endif
        }
        else {
            pg8::StaticOrder S; S.init(NTOK, D, F.G - ncw, F.wg - ncw);
            pg8::Gemm g{(const bf16*)(ws + WS_QB), (const bf16*)(ws + WS_WOSB), NTOK, D, BW};
            EpiMerge<false> E{(bf16*)(ws + WS_GATE), (bf16*)(ws + WS_MRG), 0};
            pg8::gemm_phase<EpiMerge<false>, pg8::StaticOrder>(stage, g, S, E, nullptr, F.wave); }
    }
    xcd_barrier(bar);
    }
    STAMP(7);
    REP(7) {
    p7_mfma(F, A, (const bf16*)(ws + WS_SC), (const bf16*)(ws + WS_P), (const bf16*)(ws + WS_QO), V, (const bf16*)(ws + WS_GG), (const float*)(ws + WS_BON), (bf16*)(ws + WS_YRW));
    xcd_barrier(bar);
    }
    STAMP(8);
#if defined(CHECKS)
    if (F.wg == 0) chk_p7(F, A, R, KS, V, KK);
#endif
    REP(8) {
    {   pg8::StaticOrder S; S.init(NTOK, D, F.G, F.wg);
        {   pg8::Gemm g{(const bf16*)(ws + WS_YRW), (const bf16*)(ws + WS_WORW), NTOK, D, BW};
            EpiMerge<true> E{(bf16*)(ws + WS_GATE), (bf16*)(ws + WS_MRG), D};
            pg8::gemm_phase<EpiMerge<true>, pg8::StaticOrder>(stage, g, S, E, nullptr, F.wave); } }
    xcd_barrier(bar);
    }
    STAMP(9);
#if defined(CHECKS)
    if (F.wg == 0) chk_p8(F, A);
#endif
    REP(9) {
    {   pg8::Gemm g{(const bf16*)(ws + WS_MRG), (const bf16*)(ws + WS_WOUT), NTOK, D, D}; pg8::StaticOrder S; S.init(NTOK, D, F.G, F.wg);
        EpiPlain E{(bf16*)(ws + WS_Y1), D, 0xff};
        pg8::gemm_phase<EpiPlain, pg8::StaticOrder>(stage, g, S, E, nullptr, F.wave); }
    xcd_barrier(bar);
    }
    STAMP(10);
#if defined(CHECKS)
    if (F.wg == 0) chk_p9(F, A);
#endif
    REP(10) {
    p10_rows(F, A, (const bf16*)(ws + WS_Y1), (bf16*)(ws + WS_H2));
    xcd_barrier(bar);
    }
    STAMP(11);
#if defined(CHECKS)
    if (F.wg == 0) chk_p10(F, A);
#endif
    REP(11) {
    p11_rank_gather(F, A, (const bf16*)(ws + WS_H2), (bf16*)(ws + WS_HS));
    xcd_barrier(bar);
    }
    STAMP(12);
#if defined(CHECKS)
    if (F.wg == 0) chk_p11(F, A);
#endif
    {   const int* tile = (const int*)(ws + WS_TILE);
        const int nt = __builtin_amdgcn_readfirstlane(tile[MAXT]);
        const int vc = (F.G % 8 == 0) ? (F.wg % 8) * (F.G / 8) + F.wg / 8 : F.wg;
        unsigned* tcnt = (unsigned*)(ws + WS_CTL) + MOE_CNT_WORD;
        REP(12) {   pg8::Gemm g{(const bf16*)(ws + WS_HS), (const bf16*)(ws + WS_WUP), MAXT * 256, NE * 1024, D};
            MoeUpOrder S; S.nunits = nt * 4; S.G = F.G; S.vc = vc; S.tile_e = tile; S.cnt = tcnt;
            EpiUp E{(bf16*)(ws + WS_HID)};
            pg8::gemm_phase<EpiUp, MoeUpOrder>(stage, g, S, E, nullptr, F.wave); }
        __syncthreads();
    STAMP(13);
        REP(13) {   pg8::Gemm g{(const bf16*)(ws + WS_HID), (const bf16*)(ws + WS_WDN), MAXT * 256, NE * 1024, DE};
            MoeDnOrder S; S.nunits = nt * 4; S.G = F.G; S.vc = vc; S.q = (nt * 4) / F.G; S.rem = nt * 4 - S.q * F.G; S.wave = F.wave; S.tile_e = tile; S.cnt = tcnt;
            EpiPlain E{(bf16*)(ws + WS_HS), D, 3};
            pg8::gemm_phase<EpiPlain, MoeDnOrder>(stage, g, S, E, nullptr, F.wave);
        xcd_barrier(bar); } }
    STAMP(14);
#if defined(CHECKS)
    if (F.wg == 0) chk_p13(F, A);
#endif
    p14_final(F, A, (const bf16*)(ws + WS_HS));
#if defined(STAMPS)
    xcd_barrier(bar);
    STAMP(15);
    if (F.wg == 0) { __syncthreads();
        const float va = (float)(long long)(tsp[STAMP_A2] - tsp[STAMP_A]) * 0.01f, vb = (float)(long long)(tsp[STAMP_B2] - tsp[STAMP_B]) * 0.01f;
#if defined(STAMP_SHIFT)
        const float shf_ = 1.1f;
#else
        const float shf_ = 1.0f;
#endif
        int b1 = (int)floorf(logf(fmaxf(va * shf_, 1.0f)) / logf(1.21f)) + 1, b2 = (int)floorf(logf(fmaxf(vb * shf_, 1.0f)) / logf(1.21f)) + 1;
#if defined(STAMP_CAL)
        b1 = 10; b2 = 30;
#endif
#if defined(STAMP_FRAC)
        { const unsigned long long* t5 = tsp + 32; const float tot = (float)(long long)(t5[9] - t5[0]);
          b1 = (int)(12.0f * (float)(long long)(t5[STAMP_A2] - t5[STAMP_A]) / tot) + 3; b2 = (int)(12.0f * (float)(long long)(t5[STAMP_B2] - t5[STAMP_B]) / tot) + 3; }
#endif
#if defined(STAMP_THR_A)
        b1 = va > (float)(STAMP_THR_A) ? 30 : 10; b2 = vb > (float)(STAMP_THR_B) ? 30 : 10;
#endif
        const int t_ = opq_tid(F.wave);
        for (int i = t_; i < 1000; i += NTHR) A.out[1000 + i] += 20.0f * (float)b2;
        if (t_ == 0) A.out[0] = 200.0f * (float)b1; }
#endif
#if defined(CHECKS)
    xcd_barrier(bar);
    if (F.wg == 0 && F.tid == 0) { const unsigned* fl = chk_flags(ws); int id = 0; for (int i = 61; i >= 0; --i) if (fl[i]) id = i;
        if (((const unsigned*)(ws + WS_CTL))[XB_TMO]) id = 60;
        if (id) A.out[0] = 10.0f * (float)id;
#if defined(CHKVAL)
        A.out[0] = 1000.0f * ((const float*)fl)[CHKVAL];
#endif
        }
#endif
}

extern "C" void kernel_launch(void* const* d_in, const int* in_sizes, int n_in, void* d_out, int out_size, void* d_ws, size_t ws_size, hipStream_t stream) {
    static int grid = 0;
    if (grid == 0) {
        if (n_in != 26 || in_sizes[0] != NTOK * D || out_size != NTOK * D || ws_size < WS_END) {
            fprintf(stderr, "kernel_launch: unexpected shapes (n_in %d, in0 %d, out %d, ws %zu); nothing launched\n", n_in, n_in > 0 ? in_sizes[0] : -1, out_size, ws_size); grid = -1; return; }
        int dev = 0, cus = 0, per_cu = 0;
        if (hipGetDevice(&dev) != hipSuccess || hipDeviceGetAttribute(&cus, hipDeviceAttributeMultiprocessorCount, dev) != hipSuccess) { grid = -1; return; }
        if (hipFuncSetAttribute((const void*)hybrid_fwd, hipFuncAttributeMaxDynamicSharedMemorySize, LDS_BYTES) != hipSuccess) { fprintf(stderr, "kernel_launch: hipFuncSetAttribute failed\n"); grid = -1; return; }
        if (hipOccupancyMaxActiveBlocksPerMultiprocessor(&per_cu, (const void*)hybrid_fwd, NTHR, LDS_BYTES) != hipSuccess || per_cu < 1)
            fprintf(stderr, "kernel_launch: note: occupancy query reports %d workgroups per CU\n", per_cu);
        (void)hipGetLastError();
        grid = cus > 256 ? 256 : cus;
    }
    if (grid < 0) return;
    if (hipMemsetAsync((char*)d_ws + WS_CTL, 0, CTL_ZERO_BYTES, stream) != hipSuccess) return;
    Args a{};
    const float** p = (const float**)&a;
    for (int i = 0; i < 26; ++i) p[i] = (const float*)d_in[i];
    a.out = (float*)d_out; a.ws = (unsigned char*)d_ws;
    hipLaunchKernelGGL(hybrid_fwd, dim3(grid), dim3(NTHR), LDS_BYTES, stream, a);
}

#if defined(ONLY_P5)
__global__ void __launch_bounds__(NTHR, 2) only_p5(Args A_unused) {
    extern __shared__ __attribute__((aligned(16))) unsigned char lds_raw[];
    const CAS Args& A = *(const CAS Args*)__builtin_amdgcn_kernarg_segment_ptr();
    Frame F; F.lds = (LAS unsigned char*)lds_raw; F.wave = __builtin_amdgcn_readfirstlane((int)threadIdx.x >> 6); F.tid = opq_tid(F.wave); F.lane = F.tid & 63;
    F.wg = blockIdx.x; F.G = gridDim.x; F.gw = F.wg * NWAVES + F.wave; F.NGW = F.G * NWAVES;
    unsigned char* ws = A.ws; bf16* const dob = (bf16*)A.out;
    bf16 *R = dob, *KS = dob + (size_t)NTOK * BW, *V = dob + 2 * (size_t)NTOK * BW, *KK = dob + 3 * (size_t)NTOK * BW;
    p5_mfma(ws, F, R, KS, V, KK, (const bf16*)(ws + WS_B), (const bf16*)(ws + WS_E), (bf16*)(ws + WS_P), (bf16*)(ws + WS_QO), (bf16*)(ws + WS_GT), (bf16*)(ws + WS_HT));
}
#endif
```

```cpp
#include <hip/hip_runtime.h>
#include <cstdio>
#include <cstdint>
__device__ __forceinline__ int opq_tid(int wave) { int l; asm volatile("v_mbcnt_lo_u32_b32 %0, -1, 0\n\tv_mbcnt_hi_u32_b32 %0, -1, %0" : "=v"(l)); return wave * 64 + l; }
#ifndef PHMASK
#define PHMASK 0xffff
#endif
namespace pg8 {
#define PG8_LAS __attribute__((address_space(3)))
typedef unsigned short bf16_t;
typedef short bf16x8 __attribute__((ext_vector_type(8)));
typedef float f32x4 __attribute__((ext_vector_type(4)));
typedef unsigned u32x4 __attribute__((ext_vector_type(4)));
constexpr int BM = 256, BK = 64, HALF = 128, HTB = HALF * BK * 2  , STAGE_BYTES = 8 * HTB, NXCD = 8, WGM = 8;

__host__ __device__ __forceinline__ int lds_byte(int r, int c) { const int st = (r >> 4) * 2 + (c >> 5), rr = r & 15, cc = c & 31, ob = rr * 64 + cc * 2; return st * 1024 + (ob ^ (((ob >> 9) & 1) << 5)); }
__host__ __device__ __forceinline__ void stage_rc(int b, int& R, int& C) { const int st = b / 1024, sb = b % 1024, swz = sb ^ (((sb >> 9) & 1) << 5); R = (st >> 1) * 16 + swz / 64; C = (st & 1) * 32 + (swz % 64) / 2; }
__host__ __device__ __forceinline__ int perm32(int rho) { const int n = rho >> 4, i = rho & 15; return 8 * (i >> 2) + 4 * n + (i & 3); }

struct Unit { int pm, pn; };
struct Gemm { const bf16_t* A; const bf16_t* Bt; int M, N, K; };

struct StaticOrder {
    int nM, nN, nwg, G, c;
    __host__ __device__ void init(int M, int N, int G_, int c_) { nM = M / BM; nN = N / BM; nwg = nM * nN; G = G_; c = c_; }
    __host__ __device__ bool next(int i, Unit& u) const {
        const long L = (long)i * G + c; if (L >= nwg) return false;
        int wgid = (int)L; { const int q = nwg / NXCD, r = nwg % NXCD, xcd = wgid % NXCD, off = wgid / NXCD; wgid = (xcd < r ? xcd * (q + 1) : r * (q + 1) + (xcd - r) * q) + off; }
        const int nig = WGM * nN, gid = wgid / nig, fm = gid * WGM, gsz = (nM - fm) < WGM ? (nM - fm) : WGM;
        u.pm = fm + ((wgid % nig) % gsz); u.pn = (wgid % nig) / gsz; return true;
    }
    __device__ __forceinline__ void a_ready(const Unit&) const {}
    __device__ __forceinline__ void done(const Unit&) const {}
};

template <class Epi, class Sched, bool STAMP = false>
__device__ __forceinline__ void gemm_phase(PG8_LAS unsigned char* lds, const Gemm g, const Sched& S, const Epi& E, unsigned long long* stamps, int wave_id) {
    const int tid = opq_tid(wave_id), wid = __builtin_amdgcn_readfirstlane(tid >> 6), lane = tid & 63, wr = wid >> 2, wc = wid & 3, fr = lane & 15, fq = lane >> 4;
    const int K = g.K, nt = K / BK;
    int ts_lo = 0, ts_hi = 0, nts = 0; const unsigned long long rt_entry = STAMP ? (unsigned long long)wall_clock64() : 0ull;
#define PG8_STAMP() do { if (STAMP && wid == 0 && nts < 64) { const unsigned long long _c = (unsigned long long)clock64(); \
        ts_lo = (lane == nts) ? (int)(unsigned)_c : ts_lo; ts_hi = (lane == nts) ? (int)(unsigned)(_c >> 32) : ts_hi; ++nts; } } while (0)
    PG8_STAMP();
    unsigned voffA[2], voffB[2];
#pragma unroll
    for (int i = 0; i < 2; ++i) { int R, C; stage_rc(tid * 16 + i * 8192, R, C); const int Rb = Epi::PERM ? ((R & ~31) + perm32(R & 31)) : R;
        voffA[i] = (unsigned)(R * K + C) * 2u; voffB[i] = (unsigned)(Rb * K + C) * 2u; }
    const size_t kstep = (size_t)(BK * 2);
    const size_t hstep = (size_t)HALF * K * 2;
    const size_t tstep = 2 * hstep;
    const unsigned ldsw = (unsigned)wid * 1024u;
    const int aoff = lds_byte(wr * 64 + fr, fq * 8), boff = lds_byte(wc * 32 + fr, fq * 8);
#define PG8_SA(b, h) (((b) * 2 + (h)) * HTB)
#define PG8_SB(b, h) ((4 + (b) * 2 + (h)) * HTB)
#define PG8_STAGE(bufoff, gbase, voff) do { _Pragma("unroll") for (int _i = 0; _i < 2; ++_i) \
        __builtin_amdgcn_global_load_lds((const unsigned*)((const char*)(gbase) + (voff)[_i]), (PG8_LAS unsigned*)(lds + (bufoff) + ldsw + _i * 8192), 16, 0, 0); } while (0)
#define PG8_LDA(dst, b, h) do { _Pragma("unroll") for (int m = 0; m < 4; ++m) _Pragma("unroll") for (int k = 0; k < 2; ++k) dst[m][k] = *(const PG8_LAS bf16x8*)(lds + PG8_SA(b, h) + aoff + m * 2048 + k * 1024); } while (0)
#define PG8_LDB(dst, b, h) do { _Pragma("unroll") for (int n = 0; n < 2; ++n) _Pragma("unroll") for (int k = 0; k < 2; ++k) dst[n][k] = *(const PG8_LAS bf16x8*)(lds + PG8_SB(b, h) + boff + n * 2048 + k * 1024); } while (0)
#define PG8_MMA(ai, bj, At, Bt) do { __builtin_amdgcn_s_setprio(1); _Pragma("unroll") for (int m = 0; m < 4; ++m) _Pragma("unroll") for (int n = 0; n < 2; ++n) _Pragma("unroll") for (int k = 0; k < 2; ++k) \
        acc[ai][bj][m][n] = __builtin_amdgcn_mfma_f32_16x16x32_bf16(Bt[n][k], At[m][k], acc[ai][bj][m][n], 0, 0, 0); __builtin_amdgcn_s_setprio(0); } while (0)
#define PG8_WAIT_V(n) asm volatile("s_waitcnt vmcnt(" #n ")" ::: "memory")
#define PG8_WAIT_L(n) asm volatile("s_waitcnt lgkmcnt(" #n ")" ::: "memory")
#define PG8_BAR __builtin_amdgcn_s_barrier()
#define PG8_SCHED __builtin_amdgcn_sched_barrier(0)
    Unit cur, nxt; int ui = 0;
    if (!S.next(0, cur)) return;
    f32x4 acc[2][2][4][2];
#pragma unroll
    for (int a = 0; a < 2; ++a)
#pragma unroll
        for (int b = 0; b < 2; ++b)
#pragma unroll
            for (int m = 0; m < 4; ++m)
#pragma unroll
                for (int n = 0; n < 2; ++n) acc[a][b][m][n] = (f32x4){0.f, 0.f, 0.f, 0.f};
    bf16x8 At[4][2], B0[2][2], B1[2][2];
    const char* cA = (const char*)g.A + (size_t)cur.pm * tstep; const char* cB = (const char*)g.Bt + (size_t)cur.pn * tstep;
    S.a_ready(cur);
    PG8_STAGE(PG8_SB(0, 0), cB, voffB); PG8_STAGE(PG8_SA(0, 0), cA, voffA); PG8_STAGE(PG8_SB(0, 1), cB + hstep, voffB); PG8_STAGE(PG8_SA(0, 1), cA + hstep, voffA);
    if (wr == 1) PG8_BAR;
    PG8_WAIT_V(4); PG8_BAR;
    PG8_STAGE(PG8_SB(1, 0), cB + kstep, voffB); PG8_STAGE(PG8_SA(1, 0), cA + kstep, voffA); PG8_STAGE(PG8_SB(1, 1), cB + hstep + kstep, voffB);
    PG8_WAIT_V(6); PG8_BAR;
    PG8_STAMP();
    for (;;) {
        const bool has_next = S.next(ui + 1, nxt);
        const char* nA = has_next ? (const char*)g.A + (size_t)nxt.pm * tstep : cA; const char* nB = has_next ? (const char*)g.Bt + (size_t)nxt.pn * tstep : cB;
        for (int t = 0; t < nt; t += 2) {
            const bool last = (t == nt - 2);
            const char* a1 = cA + (size_t)(t + 1) * kstep;
            const char* a2 = last ? nA : cA + (size_t)(t + 2) * kstep; const char* b2 = last ? nB : cB + (size_t)(t + 2) * kstep;
            const char* a3 = a2 + kstep; const char* b3 = b2 + kstep;
            if (last && has_next) S.a_ready(nxt);
            PG8_LDB(B0, 0, 0); PG8_SCHED; PG8_LDA(At, 0, 0); PG8_STAGE(PG8_SA(1, 1), a1 + hstep, voffA);
            PG8_WAIT_L(8); PG8_BAR; PG8_WAIT_L(0); PG8_MMA(0, 0, At, B0); PG8_BAR; PG8_SCHED;
            PG8_LDB(B1, 0, 1); PG8_STAGE(PG8_SB(0, 0), b2, voffB);
            PG8_BAR; PG8_WAIT_L(0); PG8_MMA(0, 1, At, B1); PG8_BAR;
            PG8_LDA(At, 0, 1); PG8_STAGE(PG8_SA(0, 0), a2, voffA);
            PG8_BAR; PG8_WAIT_L(0); PG8_MMA(1, 0, At, B0); PG8_BAR; PG8_SCHED;
            PG8_STAGE(PG8_SB(0, 1), b2 + hstep, voffB);
            PG8_WAIT_V(6); PG8_BAR; PG8_MMA(1, 1, At, B1); PG8_BAR;
            PG8_LDB(B0, 1, 0); PG8_SCHED; PG8_LDA(At, 1, 0); PG8_STAGE(PG8_SA(0, 1), a2 + hstep, voffA);
            PG8_WAIT_L(8); PG8_BAR; PG8_WAIT_L(0); PG8_MMA(0, 0, At, B0); PG8_BAR; PG8_SCHED;
            PG8_LDB(B1, 1, 1); PG8_STAGE(PG8_SB(1, 0), b3, voffB);
            PG8_BAR; PG8_WAIT_L(0); PG8_MMA(0, 1, At, B1); PG8_BAR;
            PG8_LDA(At, 1, 1); PG8_STAGE(PG8_SA(1, 0), a3, voffA);
            PG8_BAR; PG8_WAIT_L(0); PG8_MMA(1, 0, At, B0); PG8_BAR; PG8_SCHED;
            PG8_STAGE(PG8_SB(1, 1), b3 + hstep, voffB);
            PG8_WAIT_V(6); PG8_BAR; PG8_MMA(1, 1, At, B1); PG8_BAR;
        }
        PG8_STAMP();
        if constexpr (!Epi::AFTER_DRAIN) { E(acc, cur, wr, wc, fr, fq); S.done(cur); }
        PG8_STAMP();
        if (!has_next) break;
#pragma unroll
        for (int a = 0; a < 2; ++a)
#pragma unroll
            for (int b = 0; b < 2; ++b)
#pragma unroll
                for (int m = 0; m < 4; ++m)
#pragma unroll
                    for (int n = 0; n < 2; ++n) acc[a][b][m][n] = (f32x4){0.f, 0.f, 0.f, 0.f};
        cur = nxt; cA = nA; cB = nB; ++ui;
    }
    PG8_WAIT_V(0);
    if (wr == 0) PG8_BAR;
    PG8_BAR;
    if constexpr (Epi::AFTER_DRAIN) { E.fused(acc, cur, wr, wc, fr, fq, lds, wid, lane); S.done(cur); }
    PG8_STAMP();
    if (STAMP && wid == 0) { stamps[lane] = lane < nts ? (((unsigned long long)(unsigned)ts_hi << 32) | (unsigned)ts_lo) : 0ull;
        if (lane == 62) stamps[62] = rt_entry; if (lane == 63) stamps[63] = (unsigned long long)wall_clock64(); }
#undef PG8_STAMP
#undef PG8_SA
#undef PG8_SB
#undef PG8_STAGE
#undef PG8_LDA
#undef PG8_LDB
#undef PG8_MMA
#undef PG8_WAIT_V
#undef PG8_WAIT_L
#undef PG8_BAR
#undef PG8_SCHED
}
}

#define XB_TMO      128
#define XB_XCNT(j)  (256  + 64 * (j))
#define XB_XSUB(j)  (1280 + 64 * (j))
#define XB_XGEN(j)  (2304 + 64 * (j))
#define XB_TOP      3328
#define XB_TOPGEN   3392
#define XCD_BAR_WORDS 3456
#define XB_SPIN_CAP (1u << 18)
#define LAS __attribute__((address_space(3)))

__device__ __forceinline__ unsigned xb_ld(unsigned* p)              { return __hip_atomic_load(p, __ATOMIC_RELAXED, __HIP_MEMORY_SCOPE_AGENT); }
__device__ __forceinline__ unsigned xb_add(unsigned* p, unsigned v) { return __hip_atomic_fetch_add(p, v, __ATOMIC_RELAXED, __HIP_MEMORY_SCOPE_AGENT); }
__device__ __forceinline__ unsigned xb_xcc_id() { return (unsigned)__builtin_amdgcn_s_getreg((3 << 11) | 20) & 0xFu; }
#define XB_SPIN(cond, bar) do { unsigned _sp = 0; while (cond) { __builtin_amdgcn_s_sleep(1); \
    if ((++_sp & 255u) == 0u) { if (xb_ld(&(bar)[XB_TMO])) break; if (_sp > XB_SPIN_CAP) { atomicAdd(&(bar)[XB_TMO], 1u); break; } } } } while (0)

struct XcdBarrier {
    unsigned* bar; unsigned x; int wave;
    volatile LAS unsigned* st;
};

__device__ __forceinline__ bool xb_t0(int wave) { return wave == 0 && __builtin_amdgcn_mbcnt_hi(~0u, __builtin_amdgcn_mbcnt_lo(~0u, 0u)) == 0u; }
__device__ __forceinline__ XcdBarrier xcd_barrier_post(unsigned* bar, volatile LAS unsigned* st, int wave) {
    XcdBarrier b; b.bar = bar; b.x = xb_xcc_id(); b.st = st; b.wave = wave;
    if (xb_t0(wave)) (void)xb_add(&bar[XB_XCNT(b.x)], 1u);
    return b;
}
__device__ __forceinline__ void xcd_barrier_complete(unsigned* bar, unsigned x, unsigned& nloc, unsigned& nx) {
    const unsigned G = gridDim.x * gridDim.y * gridDim.z;
    unsigned sum, cnt, mine, sp = 0u;
    for (;;) {
        sum = 0u; cnt = 0u; mine = 0u;
#pragma unroll
        for (unsigned j = 0; j < 16; ++j) { const unsigned c = xb_ld(&bar[XB_XCNT(j)]); sum += c; cnt += (c > 0u) ? 1u : 0u; mine = (j == x) ? c : mine; }
        if (sum == G) break;
        __builtin_amdgcn_s_sleep(1);
        if ((++sp & 255u) == 0u) { if (xb_ld(&bar[XB_TMO])) break; if (sp > XB_SPIN_CAP) { atomicAdd(&bar[XB_TMO], 1u); break; } }
    }
    nloc = mine > 0u ? mine : 1u; nx = cnt > 0u ? cnt : 1u;
}

__device__ __forceinline__ void xcd_barrier(const XcdBarrier& b) {
    asm volatile("s_waitcnt vmcnt(0)" ::: "memory");
    __syncthreads();
    if (xb_t0(b.wave)) {
        unsigned* bar = b.bar;
        __builtin_amdgcn_s_waitcnt(0);
        unsigned nloc = b.st[0], nx = b.st[1];
        if (nloc == 0u) { xcd_barrier_complete(bar, b.x, nloc, nx); b.st[0] = nloc; b.st[1] = nx; }
        const unsigned old = xb_add(&bar[XB_XSUB(b.x)], 1u);
        const unsigned gen = old / nloc;
        if (old + 1u == (gen + 1u) * nloc) {
            __builtin_amdgcn_fence(__ATOMIC_RELEASE, "agent");
            asm volatile("s_waitcnt vmcnt(0)" ::: "memory");
            const unsigned og = xb_add(&bar[XB_TOP], 1u);
            const unsigned tg = og / nx;
            if (og + 1u == (tg + 1u) * nx) xb_add(&bar[XB_TOPGEN], 1u);
            else XB_SPIN(xb_ld(&bar[XB_TOPGEN]) == tg, bar);
            __builtin_amdgcn_fence(__ATOMIC_ACQUIRE, "agent");
            xb_add(&bar[XB_XGEN(b.x)], 1u);
            asm volatile("s_waitcnt vmcnt(0)" ::: "memory");
        } else {
            XB_SPIN(xb_ld(&bar[XB_XGEN(b.x)]) == gen, bar);
            __builtin_amdgcn_fence(__ATOMIC_ACQUIRE, "agent");
            asm volatile("s_waitcnt vmcnt(0)" ::: "memory");
        }
    }
    __syncthreads();
}


constexpr int NB = 4, SEQ = 8192, D = 1024, NTOK = NB * SEQ;
constexpr int NH = 8, HD = 64, BW = 512;
constexpr int IN_COLS = 5408, NPAD = 5632;
constexpr int LK = 384;
constexpr int NE = 32, DE = 512;
constexpr int CH = 64, NCH = SEQ / CH, NCH_LOG = 7, NCHUNK = NB * NH * NCH;
constexpr int MAXT = 288;
constexpr float NORM_EPS = 1e-6f, GN_EPS = 64e-5f, L2_EPS = 1e-12f;
constexpr float SB_STOP = -120.0f;

constexpr size_t MiB = 1u << 20;
constexpr size_t WS_CTL = 0, CTL_ZERO_BYTES = 65536;
constexpr size_t WS_MOD = 1 * MiB;
constexpr size_t WS_RTW = WS_MOD + 128 * 1024;
constexpr size_t WS_TOK = WS_RTW + 160 * 1024;
constexpr size_t WS_CNT = WS_TOK + (size_t)NTOK * 16;
constexpr size_t WS_TILE = WS_CNT + 256 * 32 * 4;
constexpr size_t WS_WIN = 2 * MiB;
constexpr size_t WS_WOSB = 13 * MiB, WS_WORW = 14 * MiB, WS_WOUT = 15 * MiB;
constexpr size_t WS_WL = 17 * MiB;
constexpr size_t WS_BON = 18 * MiB + 256 * 1024;
constexpr size_t WS_CW = 19 * MiB + 768 * 1024;
constexpr size_t WS_QB = 20 * MiB;
constexpr size_t WS_GATE = 52 * MiB;
constexpr size_t WS_GG = 180 * MiB;
constexpr size_t WS_KB = 212 * MiB, WS_VT = 244 * MiB;
constexpr size_t WS_LORA = 276 * MiB;
constexpr size_t WS_ALORA = 308 * MiB;
constexpr size_t WS_E = 340 * MiB, WS_B = 372 * MiB;
constexpr size_t WS_RWRAW = 416 * MiB;
constexpr size_t WS_P = 212 * MiB, WS_QO = 244 * MiB;
constexpr size_t WS_GT = 276 * MiB;
constexpr size_t WS_HT = 308 * MiB;
constexpr size_t WS_SC = 340 * MiB;
constexpr size_t WS_YRW = 384 * MiB;
constexpr size_t WS_WUP = 416 * MiB, WS_WDN = 480 * MiB;
constexpr size_t WS_MRG = 212 * MiB;
constexpr size_t WS_Y1 = 276 * MiB;
constexpr size_t WS_H2 = 52 * MiB;
constexpr size_t WS_HS = 116 * MiB;
constexpr size_t WS_HID = 260 * MiB;
constexpr size_t WS_X1 = 340 * MiB;
constexpr size_t WS_END = 512 * MiB;
static_assert(WS_TILE + (MAXT + 1) * 4 <= WS_WIN && WS_WIN + (size_t)NPAD * D * 2 <= WS_WOSB && WS_WL + 1536 * LK * 2 <= WS_QB, "fixed region");
static_assert(WS_HS + (size_t)MAXT * 256 * D * 2 <= WS_HID && WS_HID + (size_t)MAXT * 256 * DE * 2 <= WS_WUP, "moe region");
static_assert(WS_ALORA + (size_t)NTOK * LK * 2 <= WS_E && WS_B + (size_t)NTOK * BW * 2 <= WS_RWRAW, "rwkv region");

constexpr int LDS_BYTES = 163840;
constexpr int LDS_MISC = LDS_BYTES - 256;
constexpr int NWAVES = 8, NTHR = 512;

typedef unsigned short bf16;
typedef short bf16x8 __attribute__((ext_vector_type(8)));
typedef short s16x4 __attribute__((ext_vector_type(4)));
typedef float f32x4 __attribute__((ext_vector_type(4)));
typedef float f32x16 __attribute__((ext_vector_type(16)));
typedef unsigned u32x4 __attribute__((ext_vector_type(4)));
typedef unsigned u32x2 __attribute__((ext_vector_type(2)));
typedef int i32x4 __attribute__((ext_vector_type(4)));
#define DI __device__ __forceinline__
#define GAS __attribute__((address_space(1)))
#define MFMA32(a, b, c) __builtin_amdgcn_mfma_f32_32x32x16_bf16((a), (b), (c), 0, 0, 0)

typedef float f32x2_t __attribute__((ext_vector_type(2))); typedef __bf16 bf16x2_t __attribute__((ext_vector_type(2)));
DI unsigned pk2(float lo, float hi) { f32x2_t v = {lo, hi}; return __builtin_bit_cast(unsigned, __builtin_convertvector(v, bf16x2_t)); }
DI unsigned f2bf(float f) { return pk2(f, 0.0f) & 0xffffu; }
DI float bflo(unsigned u) { return __builtin_bit_cast(float, u << 16); }
DI float bfhi(unsigned u) { return __builtin_bit_cast(float, u & 0xffff0000u); }
DI float bf2f(bf16 h) { return __builtin_bit_cast(float, (unsigned)h << 16); }
DI float fexp(float x) { return __expf(x); }
DI float frcp(float x) { return __builtin_amdgcn_rcpf(x); }
DI float fsigmoid(float x) { return frcp(1.0f + fexp(-x)); }
DI float fsoftplus(float x) { return fmaxf(x, 0.0f) + __logf(1.0f + fexp(-fabsf(x))); }
#define DPP_SHR(v, ctrl) __builtin_bit_cast(float, __builtin_amdgcn_update_dpp(0, __builtin_bit_cast(int, (v)), (ctrl), 0xf, 0xf, true))
DI float wave_sum(float v) {
    v += DPP_SHR(v, 0x111); v += DPP_SHR(v, 0x112); v += DPP_SHR(v, 0x114); v += DPP_SHR(v, 0x118);
    v += __builtin_bit_cast(float, __builtin_amdgcn_update_dpp(0, __builtin_bit_cast(int, v), 0x142, 0xa, 0xf, false));
    v += __builtin_bit_cast(float, __builtin_amdgcn_update_dpp(0, __builtin_bit_cast(int, v), 0x143, 0xc, 0xf, false));
    return __builtin_bit_cast(float, __builtin_amdgcn_readlane(__builtin_bit_cast(int, v), 63));
}
DI float shfl_xor_l(float v, int m, int lane) { return __builtin_bit_cast(float, __builtin_amdgcn_ds_bpermute(4 * (lane ^ m), __builtin_bit_cast(int, v))); }
DI int crow(int reg, int hh) { return (reg & 3) + 8 * (reg >> 2) + 4 * hh; }
DI void wave_lds_fence() { __builtin_amdgcn_fence(__ATOMIC_RELEASE, "wavefront"); __builtin_amdgcn_wave_barrier(); __builtin_amdgcn_fence(__ATOMIC_ACQUIRE, "wavefront"); }
DI void unpack8(const u32x4 v, float (&o)[8]) { o[0] = bflo(v.x); o[1] = bfhi(v.x); o[2] = bflo(v.y); o[3] = bfhi(v.y); o[4] = bflo(v.z); o[5] = bfhi(v.z); o[6] = bflo(v.w); o[7] = bfhi(v.w); }
DI u32x4 pack8(const float (&o)[8]) { u32x4 v; v.x = pk2(o[0], o[1]); v.y = pk2(o[2], o[3]); v.z = pk2(o[4], o[5]); v.w = pk2(o[6], o[7]); return v; }
DI bf16x8 pack8v(float a0, float a1, float a2, float a3, float a4, float a5, float a6, float a7) {
    u32x4 v; v.x = pk2(a0, a1); v.y = pk2(a2, a3); v.z = pk2(a4, a5); v.w = pk2(a6, a7); return __builtin_bit_cast(bf16x8, v); }


#if defined(CHECKS)
constexpr int DBG_TOKEN = 77;
#endif

typedef pg8::f32x4 af4;
DI void st8(bf16* p, const af4 v0, const af4 v1) { u32x4 w; w.x = pk2(v0[0], v0[1]); w.y = pk2(v0[2], v0[3]); w.z = pk2(v1[0], v1[1]); w.w = pk2(v1[2], v1[3]); *(u32x4*)p = w; }

struct EpiIn {
    static constexpr bool PERM = true, AFTER_DRAIN = false;
    bf16 *Q, *K, *Vt, *RW, *LO, *GA; const float* gate_bias;
    DI void operator()(const af4 (&acc)[2][2][4][2], const pg8::Unit& u, int wr, int wc, int fr, int fq) const {
        const int pn = u.pn, row0 = u.pm * 256 + wr * 64 + fr;
        if (pn == 4 || pn == 5) {
#pragma unroll
            for (int ai = 0; ai < 2; ++ai)
#pragma unroll
                for (int m = 0; m < 4; ++m) { const int row = row0 + ai * 128 + m * 16, b = row >> 13, s = row & (SEQ - 1);
#pragma unroll
                    for (int bj = 0; bj < 2; ++bj)
#pragma unroll
                        for (int n = 0; n < 2; ++n)
#pragma unroll
                            for (int j = 0; j < 4; ++j) { const int cv = (pn - 4) * 256 + bj * 128 + wc * 32 + 8 * fq + 4 * n + j;
                                Vt[((size_t)(b * BW + cv)) * SEQ + s] = (bf16)f2bf(acc[ai][bj][m][n][j]); } }
        } else if (pn >= 14) {
            const int col0 = (pn - 14) * 256 + wc * 32 + 8 * fq;
            af4 bv[2][2];
#pragma unroll
            for (int bj = 0; bj < 2; ++bj)
#pragma unroll
                for (int n = 0; n < 2; ++n) bv[bj][n] = *(const af4*)(gate_bias + col0 + bj * 128 + 4 * n);
#pragma unroll
            for (int ai = 0; ai < 2; ++ai)
#pragma unroll
                for (int m = 0; m < 4; ++m) { bf16* rowp = GA + (size_t)(row0 + ai * 128 + m * 16) * 2048 + col0;
#pragma unroll
                    for (int bj = 0; bj < 2; ++bj) { af4 v0 = acc[ai][bj][m][0] + bv[bj][0], v1 = acc[ai][bj][m][1] + bv[bj][1];
#pragma unroll
                        for (int j = 0; j < 4; ++j) { v0[j] = fsigmoid(v0[j]); v1[j] = fsigmoid(v1[j]); }
                        st8(rowp + bj * 128, v0, v1); } }
        } else {
            bf16* base; int ld, ct; float sc = 1.0f;
            if (pn < 2) { base = Q; ld = BW; ct = pn; sc = 0.125f; } else if (pn < 4) { base = K; ld = BW; ct = pn - 2; } else if (pn < 12) { base = RW; ld = 1536; ct = pn - 6; } else { base = LO; ld = BW; ct = pn - 12; }
            const int col0 = ct * 256 + wc * 32 + 8 * fq;
#pragma unroll
            for (int ai = 0; ai < 2; ++ai)
#pragma unroll
                for (int m = 0; m < 4; ++m) { bf16* rowp = base + (size_t)(row0 + ai * 128 + m * 16) * ld + col0;
#pragma unroll
                    for (int bj = 0; bj < 2; ++bj) st8(rowp + bj * 128, acc[ai][bj][m][0] * sc, acc[ai][bj][m][1] * sc); }
        }
    }
};

template <bool ADD> struct EpiMerge {
    static constexpr bool PERM = true, AFTER_DRAIN = false;
    bf16* GA; bf16* MRG; int gofs;
    DI void operator()(const af4 (&acc)[2][2][4][2], const pg8::Unit& u, int wr, int wc, int fr, int fq) const {
        const int row0 = u.pm * 256 + wr * 64 + fr, col0 = u.pn * 256 + wc * 32 + 8 * fq;
#pragma unroll
        for (int ai = 0; ai < 2; ++ai)
#pragma unroll
            for (int m = 0; m < 4; ++m) { const size_t row = (size_t)(row0 + ai * 128 + m * 16);
#pragma unroll
                for (int bj = 0; bj < 2; ++bj) { const int c = col0 + bj * 128;
                    float g[8]; unpack8(*(const u32x4*)(GA + row * 2048 + gofs + c), g);
                    af4 v0, v1;
#pragma unroll
                    for (int j = 0; j < 4; ++j) { v0[j] = g[j] * acc[ai][bj][m][0][j]; v1[j] = g[4 + j] * acc[ai][bj][m][1][j]; }
                    if (ADD) { float o[8]; unpack8(*(const u32x4*)(GA + row * 2048 + c), o);
#pragma unroll
                        for (int j = 0; j < 4; ++j) { v0[j] += o[j]; v1[j] += o[4 + j]; }
                        st8(MRG + row * D + c, v0, v1); }
                    else st8(GA + row * 2048 + c, v0, v1); } }
    }
};

struct EpiPlain {
    static constexpr bool PERM = true, AFTER_DRAIN = false;
    bf16* O; int ld, cmask;
    DI void operator()(const af4 (&acc)[2][2][4][2], const pg8::Unit& u, int wr, int wc, int fr, int fq) const {
        const int row0 = u.pm * 256 + wr * 64 + fr, col0 = (u.pn & cmask) * 256 + wc * 32 + 8 * fq;
#pragma unroll
        for (int ai = 0; ai < 2; ++ai)
#pragma unroll
            for (int m = 0; m < 4; ++m) { bf16* rowp = O + (size_t)(row0 + ai * 128 + m * 16) * ld + col0;
#pragma unroll
                for (int bj = 0; bj < 2; ++bj) st8(rowp + bj * 128, acc[ai][bj][m][0], acc[ai][bj][m][1]); }
    }
};

struct EpiUp {
    static constexpr bool PERM = true, AFTER_DRAIN = false;
    bf16* HID;
    DI void operator()(const af4 (&acc)[2][2][4][2], const pg8::Unit& u, int wr, int wc, int fr, int fq) const {
        const int row0 = u.pm * 256 + wr * 64 + fr, col0 = (u.pn & 3) * 128 + wc * 16 + 4 * fq;
#pragma unroll
        for (int ai = 0; ai < 2; ++ai)
#pragma unroll
            for (int m = 0; m < 4; ++m) { bf16* rowp = HID + (size_t)(row0 + ai * 128 + m * 16) * DE + col0;
#pragma unroll
                for (int bj = 0; bj < 2; ++bj) { float h[4];
#pragma unroll
                    for (int j = 0; j < 4; ++j) { const float u1 = acc[ai][bj][m][0][j]; h[j] = u1 * fsigmoid(u1) * acc[ai][bj][m][1][j]; }
                    __hip_atomic_store((GAS unsigned long long*)(rowp + bj * 64), (unsigned long long)pk2(h[0], h[1]) | ((unsigned long long)pk2(h[2], h[3]) << 32), __ATOMIC_RELAXED, __HIP_MEMORY_SCOPE_AGENT); } }
    }
};

constexpr unsigned MOE_CNT_WORD = 3584, MOE_CNT_STRIDE = 16;
struct MoeUpOrder {
    int nunits, G, vc; const int* tile_e; unsigned* cnt;
    DI bool next(int i, pg8::Unit& u) const { const long L = (long)i * G + vc; if (L >= nunits) return false; const int rt = (int)(L >> 2);
        u.pm = rt; u.pn = __builtin_amdgcn_readfirstlane(tile_e[rt]) * 4 + (int)(L & 3); return true; }
    DI void a_ready(const pg8::Unit&) const {}
    DI void done(const pg8::Unit& u) const { asm volatile("s_waitcnt vmcnt(0)" ::: "memory");
        if (__builtin_amdgcn_mbcnt_hi(~0u, __builtin_amdgcn_mbcnt_lo(~0u, 0u)) == 0u) __hip_atomic_fetch_add(cnt + MOE_CNT_STRIDE * u.pm, 1u, __ATOMIC_RELAXED, __HIP_MEMORY_SCOPE_AGENT); }
};
struct MoeDnOrder {
    int nunits, G, vc, q, rem, wave; const int* tile_e; unsigned* cnt;
    DI bool next(int i, pg8::Unit& u) const { long L;
        if (vc >= rem) { if (i > q) return false; L = (long)i * (G - rem) + (vc - rem); } else L = (long)(q + 1) * (G - rem) + (long)i * rem + vc;
        if (L >= nunits) return false; const int rt = (int)(L >> 2);
        u.pm = rt; u.pn = __builtin_amdgcn_readfirstlane(tile_e[rt]) * 4 + (int)(L & 3); return true; }
    DI void a_ready(const pg8::Unit& u) const {
        if (wave == 0) { unsigned sp = 0;
            while ((unsigned)__builtin_amdgcn_readfirstlane(__hip_atomic_load(cnt + MOE_CNT_STRIDE * u.pm, __ATOMIC_RELAXED, __HIP_MEMORY_SCOPE_AGENT)) < 32u) { __builtin_amdgcn_s_sleep(2); if (++sp > (1u << 22)) break; }
            __builtin_amdgcn_fence(__ATOMIC_ACQUIRE, "agent");
            asm volatile("s_waitcnt vmcnt(0)" ::: "memory"); }
        asm volatile("" ::: "memory"); __builtin_amdgcn_s_barrier(); asm volatile("" ::: "memory"); }
    DI void done(const pg8::Unit&) const {}
};

struct Args {
    const float *x, *c, *w_mod, *b_mod, *gains, *w_in, *gate_bias, *shift_mu, *w0, *w_decay_up, *a0, *w_iclr_up, *w_gate_up, *k_k, *k_a, *r_k, *lnx_w, *lnx_b,
                *w_o_sb, *w_o_rw, *w_out, *w_group, *w_router, *w_up1, *w_up3, *w_down;
    float* out; unsigned char* ws;
};
struct Frame { LAS unsigned char* lds; int tid, lane, wave, wg, G, gw, NGW; };
#define CAS __attribute__((address_space(4)))
typedef const CAS Args& ARef;

DI void tr_item(const float* W, int ldw, int K, bf16* WT, int k0, int drow0, int scol0, LAS float* scr, int lane) {
    if (scol0 >= 0) {
        float v[32];
        const float* wp = W + (size_t)(k0 + (lane >> 5)) * ldw + scol0 + (lane & 31);
#pragma unroll
        for (int i = 0; i < 32; ++i) v[i] = wp[(size_t)(2 * i) * ldw];
#pragma unroll
        for (int i = 0; i < 32; ++i) scr[(2 * i + (lane >> 5)) * 33 + (lane & 31)] = v[i];
    } else {
#pragma unroll 8
        for (int i = 0; i < 32; ++i) { const int kk = 2 * i + (lane >> 5); scr[kk * 33 + (lane & 31)] = 0.0f; }
    }
    wave_lds_fence();
    const int c = lane & 7;
#pragma unroll
    for (int j = 0; j < 4; ++j) { const int n = (lane >> 3) + 8 * j; const LAS float* s = scr + (8 * c) * 33 + n;
        u32x4 o; o.x = pk2(s[0 * 33], s[1 * 33]); o.y = pk2(s[2 * 33], s[3 * 33]); o.z = pk2(s[4 * 33], s[5 * 33]); o.w = pk2(s[6 * 33], s[7 * 33]);
        *(u32x4*)(WT + (size_t)(drow0 + n) * K + k0 + 8 * c) = o; }
    wave_lds_fence();
}
DI void tr_item_up(const float* W1, const float* W3, bf16* WT, int e, int k0, int drow0, LAS float* scr, int lane) {
    const int l31 = lane & 31, sc = (drow0 >> 3) * 4 + (l31 >> 3) * 4 + (l31 & 3);
    const float* W = ((l31 & 4) ? W3 : W1) + (size_t)e * D * DE;
    { float v[32]; const float* wp = W + (size_t)(k0 + (lane >> 5)) * DE + sc;
#pragma unroll
        for (int i = 0; i < 32; ++i) v[i] = wp[(size_t)(2 * i) * DE];
#pragma unroll
        for (int i = 0; i < 32; ++i) scr[(2 * i + (lane >> 5)) * 33 + l31] = v[i]; }
    wave_lds_fence();
    const int c = lane & 7;
#pragma unroll
    for (int j = 0; j < 4; ++j) { const int n = (lane >> 3) + 8 * j; const LAS float* s = scr + (8 * c) * 33 + n;
        u32x4 o; o.x = pk2(s[0 * 33], s[1 * 33]); o.y = pk2(s[2 * 33], s[3 * 33]); o.z = pk2(s[4 * 33], s[5 * 33]); o.w = pk2(s[6 * 33], s[7 * 33]);
        *(u32x4*)(WT + ((size_t)e * 1024 + drow0 + n) * D + k0 + 8 * c) = o; }
    wave_lds_fence();
}

DI void p0_prologue(const Frame& F0, ARef A) {
    Frame F = F0; F.tid = opq_tid(F0.wave); F.lane = F.tid & 63; F.wave = __builtin_amdgcn_readfirstlane(F.tid >> 6); F.gw = F.wg * NWAVES + F.wave;
    unsigned char* ws = A.ws;
    LAS float* sl = (LAS float*)F.lds;
    LAS float* part = (LAS float*)(F.lds + 16384);
    for (int i = F.tid; i < NB * D; i += NTHR) { const float v = A.c[i]; sl[i] = v * fsigmoid(v); }
    __syncthreads();
    float* mod = (float*)(ws + WS_MOD);
    for (int cg = F.wg; cg < 256; cg += F.G) {
        const int col = F.tid & 31, kg = F.tid >> 5;
        if (col < 24) { float a0 = 0.f, a1 = 0.f, a2 = 0.f, a3 = 0.f;
#pragma unroll 8
            for (int kk = 0; kk < 64; ++kk) { const int k = kg * 64 + kk; const float w = A.w_mod[(size_t)k * 6144 + cg * 24 + col];
                a0 += sl[k] * w; a1 += sl[D + k] * w; a2 += sl[2 * D + k] * w; a3 += sl[3 * D + k] * w; }
            LAS float* p = part + (kg * 24 + col) * 4; p[0] = a0; p[1] = a1; p[2] = a2; p[3] = a3; }
        __syncthreads();
        if (F.tid < 96) { const int c = F.tid >> 2, b = F.tid & 3; float s = 0.f;
#pragma unroll
            for (int kg2 = 0; kg2 < 16; ++kg2) s += part[(kg2 * 24 + c) * 4 + b];
            mod[b * 6144 + cg * 24 + c] = s + A.b_mod[cg * 24 + c]; }
        __syncthreads();
    }
    LAS float* scr = (LAS float*)(F.lds + 32768 + F.wave * 8704);
    constexpr int I_IN = (NPAD / 32) * (D / 64), I_OS = (D / 32) * (BW / 64), I_OUT = (D / 32) * (D / 64);
    for (int it = F.gw; it < I_IN + 2 * I_OS + I_OUT; it += F.NGW) {
        int r = it;
        if (r < I_IN) { const int g = r / (D / 64), kb = r % (D / 64), drow0 = 32 * g;
            const int sc = drow0 < 3360 ? drow0 : (drow0 < 3584 ? -1 : drow0 - 224);
            tr_item(A.w_in, IN_COLS, D, (bf16*)(ws + WS_WIN), 64 * kb, drow0, sc, scr, F.lane); continue; }
        r -= I_IN;
        if (r < I_OS) { const int g = r / (BW / 64), kb = r % (BW / 64); tr_item(A.w_o_sb, D, BW, (bf16*)(ws + WS_WOSB), 64 * kb, 32 * g, 32 * g, scr, F.lane); continue; }
        r -= I_OS;
        if (r < I_OS) { const int g = r / (BW / 64), kb = r % (BW / 64); tr_item(A.w_o_rw, D, BW, (bf16*)(ws + WS_WORW), 64 * kb, 32 * g, 32 * g, scr, F.lane); continue; }
        r -= I_OS;
        { const int g = r / (D / 64), kb = r % (D / 64); tr_item(A.w_out, D, D, (bf16*)(ws + WS_WOUT), 64 * kb, 32 * g, 32 * g, scr, F.lane); }
    }
    const int gt = F.wg * NTHR + F.tid, NGT = F.G * NTHR;
    float* rtw = (float*)(ws + WS_RTW);
    for (int i = gt; i < 36 * D; i += NGT) { const int o = i >> 10, k = i & (D - 1); rtw[i] = o < 4 ? A.w_group[k * 4 + o] : A.w_router[k * NE + (o - 4)]; }
    bf16* wl = (bf16*)(ws + WS_WL);
    for (int i = gt; i < 1536 * LK; i += NGT) { const int n = i / LK, k = i % LK; float v = 0.f;
        if (n < 512) { if (k < 64) v = A.w_decay_up[k * BW + n]; }
        else if (n < 1024) { if (k >= 64 && k < 128) v = A.w_iclr_up[(k - 64) * BW + (n - 512)]; }
        else { if (k >= 128 && k < 288) v = A.w_gate_up[(k - 128) * BW + (n - 1024)]; }
        wl[i] = (bf16)f2bf(v); }
}

DI void p1_h1(const Frame& F0, ARef A, bf16* H1) {
    Frame F = F0; F.tid = opq_tid(F0.wave); F.lane = F.tid & 63; F.wave = __builtin_amdgcn_readfirstlane(F.tid >> 6); F.gw = F.wg * NWAVES + F.wave;
    const float* mod = (const float*)(A.ws + WS_MOD);
    for (int n = F.gw; n < NTOK; n += F.NGW) {
        const int b = n >> 13;
        const f32x4* xr = (const f32x4*)(A.x + (size_t)n * D) + F.lane;
        f32x4 v[4]; float s = 0.f;
#pragma unroll
        for (int j = 0; j < 4; ++j) { v[j] = xr[64 * j]; s += (v[j][0] * v[j][0] + v[j][1] * v[j][1]) + (v[j][2] * v[j][2] + v[j][3] * v[j][3]); }
        const float inv = rsqrtf(wave_sum(s) * (1.0f / D) + NORM_EPS);
        u32x2* o = (u32x2*)(H1 + (size_t)n * D) + F.lane;
#pragma unroll
        for (int j = 0; j < 4; ++j) { const int k = 4 * F.lane + 256 * j;
            const f32x4 g = *(const f32x4*)(A.gains + k), sh = *(const f32x4*)(mod + b * 6144 + k), sc = *(const f32x4*)(mod + b * 6144 + D + k);
            f32x4 h;
#pragma unroll
            for (int q = 0; q < 4; ++q) h[q] = (v[j][q] * inv) * g[q] * (1.0f + sc[q]) + sh[q];
            u32x2 w; w.x = pk2(h[0], h[1]); w.y = pk2(h[2], h[3]); o[64 * j] = w; }
    }
}

DI void p3_attn(const Frame& F0, const bf16* QB, const bf16* KB, const bf16* VT, bf16* YSB) {
    Frame F = F0; F.tid = opq_tid(F0.wave); F.lane = F.tid & 63; F.wave = __builtin_amdgcn_readfirstlane(F.tid >> 6); F.gw = F.wg * NWAVES + F.wave;
    const int lane = F.lane, r = lane & 31, hh = lane >> 5;
    bf16x8 tri[2];
#pragma unroll
    for (int s = 0; s < 2; ++s)
#pragma unroll
        for (int e = 0; e < 8; ++e) tri[s][e] = (16 * s + 8 * (e >> 2) + 4 * hh + (e & 3)) > r ? (short)0x3F80 : (short)0;
    for (int u = F.gw; u < NB * NH * (SEQ / 32); u += F.NGW) {
        const int bh = u >> 8, qt = u & 255, b = bh >> 3, h = bh & 7;
        const bf16* qp = QB + (size_t)(b * SEQ + qt * 32 + r) * BW + h * HD + 8 * hh;
        bf16x8 qf[4];
#pragma unroll
        for (int ks = 0; ks < 4; ++ks) qf[ks] = *(const bf16x8*)(qp + 16 * ks);
        f32x16 o0, o1;
#pragma unroll
        for (int i = 0; i < 16; ++i) { o0[i] = 0.f; o1[i] = 0.f; }
        float L = 0.f;
        bf16x8 kf[4]; s16x4 vlo[2][2], vhi[2][2];
#define ATT_LOAD(KT, KF, VLO, VHI) do { const bf16* kp_ = KB + (size_t)(b * SEQ + (KT) * 32 + r) * BW + h * HD + 8 * hh; \
            _Pragma("unroll") for (int ks = 0; ks < 4; ++ks) KF[ks] = *(const bf16x8*)(kp_ + 16 * ks); \
            const bf16* vp_ = VT + ((size_t)(bh * HD + r)) * SEQ + (KT) * 32 + 4 * hh; \
            _Pragma("unroll") for (int mb = 0; mb < 2; ++mb) _Pragma("unroll") for (int ks = 0; ks < 2; ++ks) { VLO[mb][ks] = *(const s16x4*)(vp_ + (size_t)mb * 32 * SEQ + 16 * ks); VHI[mb][ks] = *(const s16x4*)(vp_ + (size_t)mb * 32 * SEQ + 16 * ks + 8); } } while (0)
        ATT_LOAD(qt, kf, vlo, vhi);
        for (int kt = qt; kt >= 0; --kt) {
            bf16x8 kfn[4]; s16x4 vlon[2][2], vhin[2][2];
            { const int ktn = kt > 0 ? kt - 1 : 0; ATT_LOAD(ktn, kfn, vlon, vhin); }
            f32x16 z;
#pragma unroll
            for (int i = 0; i < 16; ++i) z[i] = 0.f;
#pragma unroll
            for (int ks = 0; ks < 4; ++ks) z = MFMA32(kf[ks], qf[ks], z);
            const bool diag = (kt == qt);
            float lk[16], lo[16], tot = 0.f;
#pragma unroll
            for (int i = 0; i < 16; ++i) { const bool valid = !diag || (crow(i, hh) < r);
                const float sp = fsoftplus(z[i]); lk[i] = valid ? -sp : 0.0f; z[i] = valid ? z[i] - sp : -1.0e30f;
                tot += lk[i];
                const float hi = bflo(f2bf(lk[i])); lo[i] = lk[i] - hi; lk[i] = hi; }
            tot += shfl_xor_l(tot, 32, lane);
            f32x16 lat;
#pragma unroll
            for (int i = 0; i < 16; ++i) lat[i] = L;
#pragma unroll
            for (int s = 0; s < 2; ++s) {
                lat = MFMA32(tri[s], pack8v(lk[8 * s], lk[8 * s + 1], lk[8 * s + 2], lk[8 * s + 3], lk[8 * s + 4], lk[8 * s + 5], lk[8 * s + 6], lk[8 * s + 7]), lat);
                lat = MFMA32(tri[s], pack8v(lo[8 * s], lo[8 * s + 1], lo[8 * s + 2], lo[8 * s + 3], lo[8 * s + 4], lo[8 * s + 5], lo[8 * s + 6], lo[8 * s + 7]), lat); }
            float at[16];
#pragma unroll
            for (int i = 0; i < 16; ++i) at[i] = fexp(z[i] + lat[i]);
#pragma unroll
            for (int s = 0; s < 2; ++s) { const bf16x8 ab = pack8v(at[8 * s], at[8 * s + 1], at[8 * s + 2], at[8 * s + 3], at[8 * s + 4], at[8 * s + 5], at[8 * s + 6], at[8 * s + 7]);
                bf16x8 va, vb;
#pragma unroll
                for (int e = 0; e < 4; ++e) { va[e] = vlo[0][s][e]; va[4 + e] = vhi[0][s][e]; vb[e] = vlo[1][s][e]; vb[4 + e] = vhi[1][s][e]; }
                o0 = MFMA32(va, ab, o0); o1 = MFMA32(vb, ab, o1); }
            L += tot;
            if (__all(L < SB_STOP)) break;
#pragma unroll
            for (int ks = 0; ks < 4; ++ks) kf[ks] = kfn[ks];
#pragma unroll
            for (int mb = 0; mb < 2; ++mb)
#pragma unroll
                for (int ks = 0; ks < 2; ++ks) { vlo[mb][ks] = vlon[mb][ks]; vhi[mb][ks] = vhin[mb][ks]; }
        }
#undef ATT_LOAD
        bf16* op = YSB + (size_t)(b * SEQ + qt * 32 + r) * BW + h * HD + 4 * hh;
#pragma unroll
        for (int g = 0; g < 4; ++g) { u32x2 w0, w1; w0.x = pk2(o0[4 * g], o0[4 * g + 1]); w0.y = pk2(o0[4 * g + 2], o0[4 * g + 3]); w1.x = pk2(o1[4 * g], o1[4 * g + 1]); w1.y = pk2(o1[4 * g + 2], o1[4 * g + 3]);
            *(u32x2*)(op + 8 * g) = w0; *(u32x2*)(op + 32 + 8 * g) = w1; }
    }
}

DI void p3_prep(const Frame& F0, ARef A, const bf16* RWRAW, const bf16* LORA, bf16* R, bf16* KS, bf16* V, bf16* KK, bf16* ALORA) {
    Frame F = F0; F.tid = opq_tid(F0.wave); F.lane = F.tid & 63; F.wave = __builtin_amdgcn_readfirstlane(F.tid >> 6); F.gw = F.wg * NWAVES + F.wave;
    const int lane = F.lane;
    f32x4 mu[3][2], kkc[2], mul[2];
#pragma unroll
    for (int part = 0; part < 3; ++part) { mu[part][0] = *(const f32x4*)(A.shift_mu + part * 512 + lane * 8); mu[part][1] = *(const f32x4*)(A.shift_mu + part * 512 + lane * 8 + 4); }
    kkc[0] = *(const f32x4*)(A.k_k + lane * 8); kkc[1] = *(const f32x4*)(A.k_k + lane * 8 + 4);
    const int lcol = lane < 36 ? lane * 8 : 0;
    mul[0] = *(const f32x4*)(A.shift_mu + 1536 + lcol); mul[1] = *(const f32x4*)(A.shift_mu + 1536 + lcol + 4);
    constexpr int RUN = 16;
    for (int run = F.gw; run < NTOK / RUN; run += F.NGW) {
        const int n0 = run * RUN;
        u32x4 prv[3], prl, cur[3], cul;
        const u32x4 z4 = {0u, 0u, 0u, 0u};
        if ((n0 & (SEQ - 1)) == 0) { prv[0] = z4; prv[1] = z4; prv[2] = z4; prl = z4; }
        else {
#pragma unroll
            for (int part = 0; part < 3; ++part) prv[part] = *(const u32x4*)(RWRAW + (size_t)(n0 - 1) * 1536 + part * 512 + lane * 8);
            prl = *(const u32x4*)(LORA + (size_t)(n0 - 1) * BW + lcol); }
#pragma unroll
        for (int part = 0; part < 3; ++part) cur[part] = *(const u32x4*)(RWRAW + (size_t)n0 * 1536 + part * 512 + lane * 8);
        cul = *(const u32x4*)(LORA + (size_t)n0 * BW + lcol);
        for (int i = 0; i < RUN; ++i) {
            const int n = n0 + i, nn = i + 1 < RUN ? n + 1 : n;
            u32x4 nxt[3], nxl;
#pragma unroll
            for (int part = 0; part < 3; ++part) nxt[part] = *(const u32x4*)(RWRAW + (size_t)nn * 1536 + part * 512 + lane * 8);
            nxl = *(const u32x4*)(LORA + (size_t)nn * BW + lcol);
            float xs[3][8];
#pragma unroll
            for (int part = 0; part < 3; ++part) { float p[8], q[8]; unpack8(cur[part], p); unpack8(prv[part], q);
#pragma unroll
                for (int j = 0; j < 4; ++j) { xs[part][j] = p[j] + mu[part][0][j] * (q[j] - p[j]); xs[part][4 + j] = p[4 + j] + mu[part][1][j] * (q[4 + j] - p[4 + j]); } }
            const size_t off = (size_t)n * BW + lane * 8;
            *(u32x4*)(R + off) = pack8(xs[0]); *(u32x4*)(KS + off) = pack8(xs[1]); *(u32x4*)(V + off) = pack8(xs[2]);
            float kk[8], ss = 0.f;
#pragma unroll
            for (int j = 0; j < 4; ++j) { kk[j] = xs[1][j] * kkc[0][j]; kk[4 + j] = xs[1][4 + j] * kkc[1][j]; }
#pragma unroll
            for (int j = 0; j < 8; ++j) ss += kk[j] * kk[j];
            ss += shfl_xor_l(ss, 1, lane); ss += shfl_xor_l(ss, 2, lane); ss += shfl_xor_l(ss, 4, lane);
            const float rn = 1.0f / fmaxf(sqrtf(ss), L2_EPS);
#pragma unroll
            for (int j = 0; j < 8; ++j) kk[j] *= rn;
            *(u32x4*)(KK + off) = pack8(kk);
            if (lane < 48) { float a[8];
                if (lane < 36) { float p[8], q[8]; unpack8(cul, p); unpack8(prl, q);
#pragma unroll
                    for (int j = 0; j < 8; ++j) { const float m = j < 4 ? mul[0][j & 3] : mul[1][j & 3]; const float v = p[j] + m * (q[j] - p[j]);
                        a[j] = lane < 8 ? (1.0f - 2.0f * frcp(fexp(2.0f * v) + 1.0f)) : (lane < 16 ? v : fsigmoid(v)); }
                } else {
#pragma unroll
                    for (int j = 0; j < 8; ++j) a[j] = 0.f; }
                *(u32x4*)(ALORA + (size_t)n * LK + lane * 8) = pack8(a); }
#pragma unroll
            for (int part = 0; part < 3; ++part) { prv[part] = cur[part]; cur[part] = nxt[part]; }
            prl = cul; cul = nxl;
        }
    }
}

DI void p4_lora(const Frame& F0, ARef A, const bf16* ALORA, const bf16* WL, bf16* E, bf16* KS, bf16* Bo, bf16* GG, const bf16* KK, const bf16* R, float* BON) {
    Frame F = F0; F.tid = opq_tid(F0.wave); F.lane = F.tid & 63; F.wave = __builtin_amdgcn_readfirstlane(F.tid >> 6); F.gw = F.wg * NWAVES + F.wave;
    const int lane = F.lane, r = lane & 31, hh = lane >> 5;
    for (int u = F.gw; u < 2 * (NTOK / 32); u += F.NGW) {
        const int n0 = (u >> 1) * 32, par = u & 1;
        bf16x8 tf[18];
#pragma unroll
        for (int ks = 0; ks < 18; ++ks) tf[ks] = *(const bf16x8*)(ALORA + (size_t)(n0 + r) * LK + 16 * ks + 8 * hh);
        const unsigned orow = (unsigned)(n0 + r) * BW + 4 * hh;
#define LORA_BLOCK(KS0, NKS, CB, BODY) { const int c0_ = 32 * ((CB) & 15); f32x16 acc_; \
            _Pragma("unroll") for (int q = 0; q < 16; ++q) acc_[q] = 0.f; \
            _Pragma("unroll") for (int ks = 0; ks < (NKS); ++ks) acc_ = MFMA32(*(const bf16x8*)(WL + (size_t)(32 * (CB) + r) * LK + 16 * ((KS0) + ks) + 8 * hh), tf[(KS0) + ks], acc_); \
            BODY }
        for (int i = 0; i < 8; ++i) { const int cb = 4 * (i >> 1) + 2 * par + (i & 1);
            LORA_BLOCK(0, 4, cb, {
                _Pragma("unroll") for (int g = 0; g < 4; ++g) { const f32x4 w0v = *(const f32x4*)(A.w0 + c0_ + 8 * g + 4 * hh); float e4[4];
                    _Pragma("unroll") for (int j = 0; j < 4; ++j) { const float v = acc_[4 * g + j] + w0v[j]; e4[j] = fexp(-fsoftplus(-v) - 0.5f); }
                    u32x2 w; w.x = pk2(e4[0], e4[1]); w.y = pk2(e4[2], e4[3]); *(u32x2*)(E + orow + c0_ + 8 * g) = w; } }) }
        float bsum = 0.f;
        for (int i = 0; i < 8; ++i) { const int cb = 16 + 4 * (i >> 1) + 2 * par + (i & 1);
            LORA_BLOCK(4, 4, cb, {
                _Pragma("unroll") for (int g = 0; g < 4; ++g) { const f32x4 a0v = *(const f32x4*)(A.a0 + c0_ + 8 * g + 4 * hh); const f32x4 kav = *(const f32x4*)(A.k_a + c0_ + 8 * g + 4 * hh);
                    const unsigned o = orow + c0_ + 8 * g; const u32x2 kw = *(const u32x2*)(KS + o); const u32x2 qw = *(const u32x2*)(KK + o); const u32x2 rw = *(const u32x2*)(R + o); const f32x4 rkv = *(const f32x4*)(A.r_k + c0_ + 8 * g + 4 * hh);
                    float ksv[4]; float kkv[4]; float kp[4]; float bb[4]; ksv[0] = bflo(kw.x); ksv[1] = bfhi(kw.x); ksv[2] = bflo(kw.y); ksv[3] = bfhi(kw.y); kkv[0] = bflo(qw.x); kkv[1] = bfhi(qw.x); kkv[2] = bflo(qw.y); kkv[3] = bfhi(qw.y);
                    _Pragma("unroll") for (int j = 0; j < 4; ++j) { const float s0 = fsigmoid(acc_[4 * g + j] + a0v[j]); kp[j] = ksv[j] * (1.0f + (s0 - 1.0f) * kav[j]); bb[j] = kkv[j] * s0; }
                    bsum += (bflo(rw.x) * kp[0] * rkv[0] + bfhi(rw.x) * kp[1] * rkv[1]) + (bflo(rw.y) * kp[2] * rkv[2] + bfhi(rw.y) * kp[3] * rkv[3]);
                    u32x2 w1; u32x2 w2; w1.x = pk2(kp[0], kp[1]); w1.y = pk2(kp[2], kp[3]); w2.x = pk2(bb[0], bb[1]); w2.y = pk2(bb[2], bb[3]); *(u32x2*)(KS + o) = w1; *(u32x2*)(Bo + o) = w2; } })
            if (i & 1) { const float tot = bsum + shfl_xor_l(bsum, 32, lane); if (hh == 0) BON[(size_t)(n0 + r) * 8 + 2 * (i >> 1) + par] = tot; bsum = 0.f; } }
        for (int i = 0; i < 8; ++i) { const int cb = 32 + 4 * (i >> 1) + 2 * par + (i & 1);
            LORA_BLOCK(8, 10, cb, {
                _Pragma("unroll") for (int g = 0; g < 4; ++g) { u32x2 w; w.x = pk2(acc_[4 * g], acc_[4 * g + 1]); w.y = pk2(acc_[4 * g + 2], acc_[4 * g + 3]); *(u32x2*)(GG + orow + c0_ + 8 * g) = w; } }) }
#undef LORA_BLOCK
    }
}

DI void p6_chain(int task, int wave, LAS unsigned char* ring, const bf16* GT, const bf16* HT, bf16* SC) {
    const int lane = opq_tid(wave) & 63;
    const int bh = task >> 1, nb = task & 1;
    constexpr int RD = 6, SLOT = 12288;
    f32x16 X[2];
#pragma unroll
    for (int q = 0; q < 16; ++q) { X[0][q] = 0.f; X[1][q] = 0.f; }
    const char* gsrc = (const char*)(GT + (size_t)bh * NCH * 4096) + lane * 16;
    const char* hsrc = (const char*)(HT + (size_t)bh * NCH * 4096) + nb * 2048 + lane * 16;
#define CHAIN_DMA(cc) do { LAS unsigned char* sl_ = ring + ((cc) % RD) * SLOT; const char* g_ = gsrc + (size_t)(cc) * 8192; const char* h_ = hsrc + (size_t)(cc) * 8192; \
        _Pragma("unroll") for (int f = 0; f < 8; ++f) __builtin_amdgcn_global_load_lds((const unsigned*)(g_ + f * 1024), (LAS unsigned*)(sl_ + f * 1024), 16, 0, 0); \
        _Pragma("unroll") for (int kb = 0; kb < 2; ++kb) _Pragma("unroll") for (int j = 0; j < 2; ++j) \
            __builtin_amdgcn_global_load_lds((const unsigned*)(h_ + kb * 4096 + j * 1024), (LAS unsigned*)(sl_ + 8192 + (kb * 2 + j) * 1024), 16, 0, 0); } while (0)
#define CHAIN_READ(cc, HS, GS) do { const LAS unsigned char* sl_ = ring + ((cc) % RD) * SLOT; \
        _Pragma("unroll") for (int f = 0; f < 8; ++f) GS[f] = *(const LAS bf16x8*)(sl_ + f * 1024 + lane * 16); \
        _Pragma("unroll") for (int kb = 0; kb < 2; ++kb) _Pragma("unroll") for (int g = 0; g < 4; ++g) { const u32x2 w_ = *(const LAS u32x2*)(sl_ + 8192 + kb * 2048 + (g * 64 + lane) * 8); \
            HS[kb][4 * g] = bflo(w_.x); HS[kb][4 * g + 1] = bfhi(w_.x); HS[kb][4 * g + 2] = bflo(w_.y); HS[kb][4 * g + 3] = bfhi(w_.y); } } while (0)
#define CHAIN_STORE(cc) do { bf16* sc_ = SC + ((size_t)bh * NCH + (cc)) * 4096; \
        _Pragma("unroll") for (int jb = 0; jb < 2; ++jb) _Pragma("unroll") for (int g = 0; g < 4; ++g) { u32x2 w_; w_.x = pk2(X[jb][4 * g], X[jb][4 * g + 1]); w_.y = pk2(X[jb][4 * g + 2], X[jb][4 * g + 3]); \
            *(u32x2*)(sc_ + ((((jb * 2 + nb) * 4 + g) * 64) + lane) * 4) = w_; } } while (0)
#define CHAIN_STEP(HS, GS) do { bf16x8 xb_[2][2]; \
        _Pragma("unroll") for (int jb = 0; jb < 2; ++jb) _Pragma("unroll") for (int s = 0; s < 2; ++s) \
            xb_[jb][s] = pack8v(X[jb][8 * s], X[jb][8 * s + 1], X[jb][8 * s + 2], X[jb][8 * s + 3], X[jb][8 * s + 4], X[jb][8 * s + 5], X[jb][8 * s + 6], X[jb][8 * s + 7]); \
        X[0] = HS[0]; X[1] = HS[1]; \
        _Pragma("unroll") for (int kb = 0; kb < 2; ++kb) _Pragma("unroll") for (int jb = 0; jb < 2; ++jb) _Pragma("unroll") for (int s = 0; s < 2; ++s) X[kb] = MFMA32(GS[kb * 4 + jb * 2 + s], xb_[jb][s], X[kb]); } while (0)
    for (int cc = 0; cc < RD; ++cc) CHAIN_DMA(cc);
    for (int c = 0; c < NCH - 1; ++c) {
        f32x16 Hc[2]; bf16x8 Gc[8];
        if (c + RD <= NCH - 1) asm volatile("s_waitcnt vmcnt(60)" ::: "memory"); else asm volatile("s_waitcnt vmcnt(0)" ::: "memory");
        CHAIN_READ(c, Hc, Gc);
        asm volatile("s_waitcnt lgkmcnt(0)" ::: "memory");
        if (c + RD < NCH - 1) CHAIN_DMA(c + RD);
        CHAIN_STORE(c);
        CHAIN_STEP(Hc, Gc);
    }
    CHAIN_STORE(NCH - 1);
    asm volatile("s_waitcnt vmcnt(0)" ::: "memory");
#undef CHAIN_DMA
#undef CHAIN_READ
#undef CHAIN_STORE
#undef CHAIN_STEP
}

DI void p6_moe_weights(const Frame& F0, ARef A, int wi, int NW) {
    Frame F = F0; F.tid = opq_tid(F0.wave); F.lane = F.tid & 63; F.wave = __builtin_amdgcn_readfirstlane(F.tid >> 6); F.gw = F.wg * NWAVES + F.wave;
    LAS float* scr = (LAS float*)(F.lds + F.wave * 20480);
    constexpr int I_UP = NE * 32 * 16, I_DN = NE * 32 * 8;
    for (int it = wi; it < I_UP + I_DN; it += NW) {
        if (it < I_UP) { const int e = it >> 9, g = (it >> 4) & 31, kb = it & 15; tr_item_up(A.w_up1, A.w_up3, (bf16*)(A.ws + WS_WUP), e, 64 * kb, 32 * g, scr, F.lane); }
        else { const int r = it - I_UP, e = r >> 8, g = (r >> 3) & 31, kb = r & 7;
            tr_item(A.w_down + (size_t)e * DE * D, D, DE, (bf16*)(A.ws + WS_WDN) + (size_t)e * 1024 * DE, 64 * kb, 32 * g, 32 * g, scr, F.lane); }
    }
}

DI float half_bcast_sum(float v, int hh) {
    v += DPP_SHR(v, 0x111); v += DPP_SHR(v, 0x112); v += DPP_SHR(v, 0x114); v += DPP_SHR(v, 0x118);
    v += __builtin_bit_cast(float, __builtin_amdgcn_update_dpp(0, __builtin_bit_cast(int, v), 0x142, 0xa, 0xf, false));
    const float lo = __builtin_bit_cast(float, __builtin_amdgcn_readlane(__builtin_bit_cast(int, v), 31)), hi = __builtin_bit_cast(float, __builtin_amdgcn_readlane(__builtin_bit_cast(int, v), 63));
    return hh ? hi : lo; }
DI void p7_mfma(const Frame& F0, ARef A, const bf16* SC, const bf16* Pn, const bf16* QOn, const bf16* V, const bf16* GG, const float* BON, bf16* YRW) {
    Frame F = F0; F.tid = opq_tid(F0.wave); F.lane = F.tid & 63; F.wave = __builtin_amdgcn_readfirstlane(F.tid >> 6); F.gw = F.wg * NWAVES + F.wave;
    const int lane = F.lane, r = lane & 31, hh = lane >> 5;
    for (int cid = F.gw; cid < NCHUNK; cid += F.NGW) {
        const int bh = cid >> NCH_LOG, c = cid & (NCH - 1), b = bh >> 3, h = bh & 7;
        const unsigned n0 = (unsigned)b * SEQ + (unsigned)c * CH; const int col0 = h * HD;
        const bf16* sc = SC + (size_t)cid * 4096; const bf16* pn = Pn + (size_t)cid * 4096; const bf16* qn = QOn + (size_t)cid * 4096;
        bf16x8 Sf[2][2][2], Pf[2][2][2];
#pragma unroll
        for (int jb = 0; jb < 2; ++jb)
#pragma unroll
            for (int xb = 0; xb < 2; ++xb)
#pragma unroll
                for (int s = 0; s < 2; ++s) { const s16x4 lo = *(const s16x4*)(sc + ((((jb * 2 + xb) * 4 + 2 * s) * 64) + lane) * 4), hi = *(const s16x4*)(sc + ((((jb * 2 + xb) * 4 + 2 * s + 1) * 64) + lane) * 4);
#pragma unroll
                    for (int e = 0; e < 4; ++e) { Sf[jb][xb][s][e] = lo[e]; Sf[jb][xb][s][4 + e] = hi[e]; }
                    Pf[jb][xb][s] = *(const bf16x8*)(pn + ((((jb * 2 + xb) * 2 + s) * 64) + lane) * 8); }
        f32x16 Z[2][2];
#pragma unroll
        for (int tb = 0; tb < 2; ++tb)
#pragma unroll
            for (int nb = 0; nb < 2; ++nb) {
#pragma unroll
                for (int g = 0; g < 4; ++g) { const u32x2 w = *(const u32x2*)(qn + ((((tb * 2 + nb) * 4 + g) * 64) + lane) * 4);
                    Z[tb][nb][4 * g] = bflo(w.x); Z[tb][nb][4 * g + 1] = bfhi(w.x); Z[tb][nb][4 * g + 2] = bflo(w.y); Z[tb][nb][4 * g + 3] = bfhi(w.y); }
#pragma unroll
                for (int jb = 0; jb < 2; ++jb)
#pragma unroll
                    for (int s = 0; s < 2; ++s) Z[tb][nb] = MFMA32(Pf[jb][tb][s], Sf[jb][nb][s], Z[tb][nb]); }
        typedef float f2_t __attribute__((ext_vector_type(2)));
        const f2_t lw = *(const f2_t*)(A.lnx_w + col0 + 2 * r), lb = *(const f2_t*)(A.lnx_b + col0 + 2 * r);
#pragma unroll
        for (int tb = 0; tb < 2; ++tb) {
            unsigned vv[16], gg[16]; float bon[16];
#pragma unroll
            for (int q = 0; q < 16; ++q) { const unsigned tokrow = n0 + 32 * tb + 4 * hh + (q & 3) + 8 * (q >> 2); const unsigned o0 = tokrow * BW + col0 + 2 * r;
                vv[q] = *(const unsigned*)(V + o0); gg[q] = *(const unsigned*)(GG + o0); bon[q] = BON[(size_t)tokrow * 8 + h]; }
#pragma unroll
            for (int q = 0; q < 16; ++q) {
                const unsigned tokrow = n0 + 32 * tb + 4 * hh + (q & 3) + 8 * (q >> 2); const unsigned o0 = tokrow * BW + col0 + 2 * r;
                const float mean = half_bcast_sum(Z[tb][0][q] + Z[tb][1][q], hh) * (1.0f / 64.0f);
                const float d0 = Z[tb][0][q] - mean, d1 = Z[tb][1][q] - mean;
                const float rs = rsqrtf(half_bcast_sum(d0 * d0 + d1 * d1, hh) * (1.0f / 64.0f) + GN_EPS);
                const float y0 = (d0 * rs * lw.x + lb.x + bon[q] * bflo(vv[q])) * bflo(gg[q]), y1 = (d1 * rs * lw.y + lb.y + bon[q] * bfhi(vv[q])) * bfhi(gg[q]);
                *(unsigned*)(YRW + o0) = pk2(y0, y1);
                if ((q & 3) == 3) __builtin_amdgcn_sched_barrier(0); } }
    }
}

DI void p10_rows(const Frame& F0, ARef A, const bf16* Y1, bf16* H2) {
    Frame F = F0; F.tid = opq_tid(F0.wave); F.lane = F.tid & 63; F.wave = __builtin_amdgcn_readfirstlane(F.tid >> 6); F.gw = F.wg * NWAVES + F.wave;
    const int lane = F.lane;
    const float* mod = (const float*)(A.ws + WS_MOD);
    LAS float* rw = (LAS float*)F.lds;
    LAS int* hist = (LAS int*)(F.lds + 147456);
    { const float* src = (const float*)(A.ws + WS_RTW);
        for (int i = F.tid; i < 18 * D; i += NTHR) { const int op = i >> 10, k = i & (D - 1); typedef float f2_t __attribute__((ext_vector_type(2))); f2_t w; w.x = src[(2 * op) * D + k]; w.y = src[(2 * op + 1) * D + k]; *(LAS f2_t*)(rw + 2 * i) = w; } }
    i32x4* tok = (i32x4*)(A.ws + WS_TOK); int* cnt = (int*)(A.ws + WS_CNT);
    for (int tb = F.wg; tb < NTOK / 128; tb += F.G) {
        if (F.tid < 32) hist[F.tid] = 0;
        __syncthreads();
        for (int tl = F.wave; tl < 128; tl += NWAVES) {
            const int n = tb * 128 + tl, b = n >> 13;
            const f32x4* xr = (const f32x4*)(A.x + (size_t)n * D) + lane; const u32x2* yr = (const u32x2*)(Y1 + (size_t)n * D) + lane;
            f32x4 xv[4], yv[4]; float s = 0.f;
#pragma unroll
            for (int j = 0; j < 4; ++j) { xv[j] = xr[64 * j]; const u32x2 w = yr[64 * j]; yv[j][0] = bflo(w.x); yv[j][1] = bfhi(w.x); yv[j][2] = bflo(w.y); yv[j][3] = bfhi(w.y);
                s += (yv[j][0] * yv[j][0] + yv[j][1] * yv[j][1]) + (yv[j][2] * yv[j][2] + yv[j][3] * yv[j][3]); }
            const float inv1 = rsqrtf(wave_sum(s) * (1.0f / D) + NORM_EPS);
            float s2 = 0.f;
#pragma unroll
            for (int j = 0; j < 4; ++j) { const int k = 4 * lane + 256 * j;
                const f32x4 g1 = *(const f32x4*)(A.gains + D + k), gt = *(const f32x4*)(mod + b * 6144 + 2 * D + k);
#pragma unroll
                for (int q = 0; q < 4; ++q) { xv[j][q] = xv[j][q] + gt[q] * ((yv[j][q] * inv1) * g1[q]); s2 += xv[j][q] * xv[j][q]; }
                u32x2 xw; xw.x = pk2(xv[j][0], xv[j][1]); xw.y = pk2(xv[j][2], xv[j][3]); *((u32x2*)(A.ws + WS_X1 + (size_t)n * D * 2) + lane + 64 * j) = xw; }
            const float inv2 = rsqrtf(wave_sum(s2) * (1.0f / D) + NORM_EPS);
            f32x4 hv[4];
#pragma unroll
            for (int j = 0; j < 4; ++j) { const int k = 4 * lane + 256 * j;
                const f32x4 g2 = *(const f32x4*)(A.gains + 2 * D + k), sh = *(const f32x4*)(mod + b * 6144 + 3 * D + k), sc = *(const f32x4*)(mod + b * 6144 + 4 * D + k);
#pragma unroll
                for (int q = 0; q < 4; ++q) hv[j][q] = (xv[j][q] * inv2) * g2[q] * (1.0f + sc[q]) + sh[q];
                u32x2 w; w.x = pk2(hv[j][0], hv[j][1]); w.y = pk2(hv[j][2], hv[j][3]); *((u32x2*)(H2 + (size_t)n * D) + lane + 64 * j) = w; }
            typedef float f2_t __attribute__((ext_vector_type(2)));
#define P10_PAIR(OUT0, OUT1, WBASE) do { f2_t a = {0.f, 0.f}; \
                _Pragma("unroll") for (int j = 0; j < 4; ++j) { const LAS f32x4* wp = (const LAS f32x4*)((WBASE) + (4 * lane + 256 * j) * 2); const f32x4 wA = wp[0], wB = wp[1]; \
                    a += (f2_t){hv[j][0], hv[j][0]} * (f2_t){wA[0], wA[1]}; a += (f2_t){hv[j][1], hv[j][1]} * (f2_t){wA[2], wA[3]}; \
                    a += (f2_t){hv[j][2], hv[j][2]} * (f2_t){wB[0], wB[1]}; a += (f2_t){hv[j][3], hv[j][3]} * (f2_t){wB[2], wB[3]}; } \
                OUT0 = wave_sum(a.x); OUT1 = wave_sum(a.y); } while (0)
            float lg[4];
            P10_PAIR(lg[0], lg[1], rw); P10_PAIR(lg[2], lg[3], rw + 2 * D);
            int gs = 0; float gm = lg[0];
#pragma unroll
            for (int g = 1; g < 4; ++g) if (lg[g] > gm) { gm = lg[g]; gs = g; }
            gs = __builtin_amdgcn_readfirstlane(gs);
            float gsum = 0.f;
#pragma unroll
            for (int g = 0; g < 4; ++g) gsum += fexp(lg[g] - gm);
            const float gw = 1.0f / gsum;
            float el[8];
            { const LAS float* rwg = rw + (2 + 4 * gs) * (2 * D);
#pragma unroll
              for (int i = 0; i < 4; ++i) P10_PAIR(el[2 * i], el[2 * i + 1], rwg + i * 2 * D); }
#undef P10_PAIR
            int i0 = 0; float m0 = el[0];
#pragma unroll
            for (int e = 1; e < 8; ++e) if (el[e] > m0) { m0 = el[e]; i0 = e; }
            int i1 = -1; float m1 = -3.0e38f;
#pragma unroll
            for (int e = 0; e < 8; ++e) if (e != i0 && el[e] > m1) { m1 = el[e]; i1 = e; }
            const float t = fexp(m1 - m0), p0 = 1.0f / (1.0f + t), p1 = t * p0;
            const int e0 = gs * 8 + i0, e1 = gs * 8 + i1;
#if defined(CHECKS)
            if (lane == 0 && n == DBG_TOKEN) { float* dbg = (float*)(A.ws + WS_CTL + 32768) + 48; dbg[0] = lg[0]; dbg[1] = lg[1]; dbg[2] = lg[2]; dbg[3] = lg[3]; dbg[4] = gsum; dbg[5] = p0; dbg[6] = gw; dbg[7] = t; }
#endif
            if (lane == 0) { i32x4 rec; rec.x = e0 | (e1 << 8); rec.y = 0; rec.z = 0; rec.w = 0; tok[n] = rec;
                float* cwp = (float*)(A.ws + WS_CW) + 2 * n; cwp[0] = gw * p0; cwp[1] = gw * p1;
                atomicAdd((int*)&hist[e0], 1); atomicAdd((int*)&hist[e1], 1); }
        }
        __syncthreads();
        if (F.tid < 32) cnt[tb * 32 + F.tid] = hist[F.tid];
        __syncthreads();
    }
}

DI void p11_rank_gather(const Frame& F0, ARef A, const bf16* H2, bf16* HS) {
    Frame F = F0; F.tid = opq_tid(F0.wave); F.lane = F.tid & 63; F.wave = __builtin_amdgcn_readfirstlane(F.tid >> 6); F.gw = F.wg * NWAVES + F.wave;
    LAS int* base = (LAS int*)F.lds;
    LAS int* seg = base + 32;
    LAS int* el = base + 96;
    LAS int* pos = base + 352;
    i32x4* tok = (i32x4*)(A.ws + WS_TOK); const int* cnt = (const int*)(A.ws + WS_CNT); int* tile = (int*)(A.ws + WS_TILE);
    for (int tb = F.wg; tb < NTOK / 128; tb += F.G) {
        if (F.tid < 32) { int tot = 0, pre = 0;
            for (int t2 = 0; t2 < NTOK / 128; ++t2) { const int v = cnt[t2 * 32 + F.tid]; tot += v; if (t2 < tb) pre += v; }
            base[F.tid] = pre; seg[F.tid] = (tot + 255) & ~255; }
        if (F.tid >= 64 && F.tid < 64 + 128) { const i32x4 rec = tok[tb * 128 + (F.tid - 64)]; el[2 * (F.tid - 64)] = rec.x & 255; el[2 * (F.tid - 64) + 1] = (rec.x >> 8) & 255; }
        __syncthreads();
        if (F.tid == 0) { int acc = 0; for (int e = 0; e < 32; ++e) { const int sz = seg[e]; seg[e] = acc; acc += sz; } seg[32] = acc; }
        __syncthreads();
        if (F.tid < 32) { int p = seg[F.tid] + base[F.tid];
            for (int q = 0; q < 256; ++q) if (el[q] == F.tid) pos[q] = p++; }
        if (tb == 0 && F.tid >= 64 && F.tid < 64 + 32) { const int e = F.tid - 64;
            for (int t2 = seg[e] >> 8; t2 < (seg[e + 1] >> 8); ++t2) tile[t2] = e;
            if (e == 0) tile[MAXT] = seg[32] >> 8; }
        __syncthreads();
        if (F.tid < 128) { i32x4 rec = tok[tb * 128 + F.tid]; rec.x = pos[2 * F.tid]; rec.y = pos[2 * F.tid + 1]; tok[tb * 128 + F.tid] = rec; }
        for (int q = F.wave; q < 256; q += NWAVES) { const int n = tb * 128 + (q >> 1);
            const u32x4* src = (const u32x4*)(H2 + (size_t)n * D) + F.lane; u32x4* dst = (u32x4*)(HS + (size_t)pos[q] * D) + F.lane;
            dst[0] = src[0]; dst[64] = src[64]; }
        __syncthreads();
    }
}

DI void p14_final(const Frame& F0, ARef A, const bf16* YE) {
    Frame F = F0; F.tid = opq_tid(F0.wave); F.lane = F.tid & 63; F.wave = __builtin_amdgcn_readfirstlane(F.tid >> 6); F.gw = F.wg * NWAVES + F.wave;
    const int lane = F.lane;
    const float* mod = (const float*)(A.ws + WS_MOD); const i32x4* tok = (const i32x4*)(A.ws + WS_TOK);
    for (int n = F.gw; n < NTOK; n += F.NGW) {
        const int b = n >> 13; const i32x4 rec = tok[n];
        const float c0 = ((const float*)(A.ws + WS_CW))[2 * n], c1 = ((const float*)(A.ws + WS_CW))[2 * n + 1];
        const u32x2* y0 = (const u32x2*)(YE + (size_t)rec.x * D) + lane; const u32x2* y1 = (const u32x2*)(YE + (size_t)rec.y * D) + lane;
        f32x4 yv[4]; float s = 0.f;
#pragma unroll
        for (int j = 0; j < 4; ++j) { const u32x2 a = y0[64 * j], bq = y1[64 * j];
            yv[j][0] = c0 * bflo(a.x) + c1 * bflo(bq.x); yv[j][1] = c0 * bfhi(a.x) + c1 * bfhi(bq.x); yv[j][2] = c0 * bflo(a.y) + c1 * bflo(bq.y); yv[j][3] = c0 * bfhi(a.y) + c1 * bfhi(bq.y);
            s += (yv[j][0] * yv[j][0] + yv[j][1] * yv[j][1]) + (yv[j][2] * yv[j][2] + yv[j][3] * yv[j][3]); }
        const float inv = rsqrtf(wave_sum(s) * (1.0f / D) + NORM_EPS);
#pragma unroll
        for (int j = 0; j < 4; ++j) { const int k = 4 * lane + 256 * j;
            const f32x4 g3 = *(const f32x4*)(A.gains + 3 * D + k), gt = *(const f32x4*)(mod + b * 6144 + 5 * D + k);
            const u32x2 xw = *((const u32x2*)(A.ws + WS_X1 + (size_t)n * D * 2) + lane + 64 * j); f32x4 xv = {bflo(xw.x), bfhi(xw.x), bflo(xw.y), bfhi(xw.y)};
#pragma unroll
            for (int q = 0; q < 4; ++q) xv[q] = xv[q] + gt[q] * ((yv[j][q] * inv) * g3[q]);
            *((f32x4*)(A.out + (size_t)n * D) + lane + 64 * j) = xv; }
    }
}

DI bf16x8 pk_tile(const f32x16& x, const int s) { return pack8v(x[8 * s], x[8 * s + 1], x[8 * s + 2], x[8 * s + 3], x[8 * s + 4], x[8 * s + 5], x[8 * s + 6], x[8 * s + 7]); }
constexpr int FS = 72;
DI bf16x8 rd_frag(const LAS bf16* buf, int tb, int cb, int s, int r, int hh) {
    const LAS bf16* p = buf + (32 * cb + r) * FS + 32 * tb + 16 * s + 4 * hh;
    const s16x4 lo = *(const LAS s16x4*)p, hi = *(const LAS s16x4*)(p + 8); bf16x8 f;
#pragma unroll
    for (int e = 0; e < 4; ++e) { f[e] = lo[e]; f[4 + e] = hi[e]; }
    return f; }
DI void wr_tile_ft(LAS bf16* buf, const f32x16& x, int tb, int cb, int r, int hh) {
#pragma unroll
    for (int g = 0; g < 4; ++g) { u32x2 w; w.x = pk2(x[4 * g], x[4 * g + 1]); w.y = pk2(x[4 * g + 2], x[4 * g + 3]); *(LAS u32x2*)(buf + (32 * cb + r) * FS + 32 * tb + 8 * g + 4 * hh) = w; } }
DI void wr_l_ft(LAS bf16* buf, const float (&x)[64], int lane) {
#pragma unroll
    for (int t8 = 0; t8 < 8; ++t8) { u32x4 w; w.x = pk2(x[8 * t8], x[8 * t8 + 1]); w.y = pk2(x[8 * t8 + 2], x[8 * t8 + 3]); w.z = pk2(x[8 * t8 + 4], x[8 * t8 + 5]); w.w = pk2(x[8 * t8 + 6], x[8 * t8 + 7]);
        *(LAS u32x4*)(buf + lane * FS + 8 * t8) = w; } }

#if defined(STAMPS)
#define P5STAMP(k) do { p5ts[k] = __builtin_amdgcn_s_memrealtime(); } while (0)
#else
#define P5STAMP(k) do { } while (0)
#endif
DI void p5_mfma(unsigned char* F0_ws, const Frame& F0, const bf16* R, const bf16* KP, const bf16* V, const bf16* KK, const bf16* Bv, const bf16* Ev, bf16* P, bf16* QO, bf16* GT, bf16* HT) {
    Frame F = F0; F.tid = opq_tid(F0.wave); F.lane = F.tid & 63; F.wave = __builtin_amdgcn_readfirstlane(F.tid >> 6); F.gw = F.wg * NWAVES + F.wave;
    const int lane = F.lane, r = lane & 31, hh = lane >> 5;
    LAS unsigned char* wl_init = F.lds + F.wave * 20480;
    LAS unsigned char* const wl0 = wl_init;
    {   bf16x8 id_[2];
#pragma unroll
        for (int s = 0; s < 2; ++s)
#pragma unroll
            for (int e = 0; e < 8; ++e) id_[s][e] = (16 * s + 8 * (e >> 2) + 4 * hh + (e & 3)) == r ? (short)0x3F80 : (short)0;
        *(LAS bf16x8*)(wl0 + 16640 + lane * 16) = id_[0]; *(LAS bf16x8*)(wl0 + 16640 + 1024 + lane * 16) = id_[1]; }
    wave_lds_fence();
    for (int cid = F.gw; cid < NCHUNK; cid += F.NGW) {
        const int bh = cid >> NCH_LOG, c = cid & (NCH - 1), b = bh >> 3, h = bh & 7;
        const unsigned n0 = (unsigned)b * SEQ + (unsigned)c * CH, col0 = (unsigned)h * HD;
        LAS unsigned char* wl = wl0; asm volatile("" : "+s"(wl));
        LAS unsigned char* IFR = wl + 16640;
        const int ln = opq_tid(F.wave) & 63;
#if defined(STAMPS)
        unsigned long long p5ts[10];
#endif
        const int rm = ln & 31, hm = ln >> 5;
        const bf16 *R0_ = R, *KP0_ = KP, *V0_ = V, *KK0_ = KK, *Bv0_ = Bv, *Ev0_ = Ev; bf16 *P0_ = P, *QO0_ = QO;
        asm volatile("" : "+s"(R0_), "+s"(KP0_), "+s"(V0_), "+s"(KK0_), "+s"(Bv0_), "+s"(Ev0_), "+s"(P0_), "+s"(QO0_));
        const GAS char *R_ = (const GAS char*)R0_, *KP_ = (const GAS char*)KP0_, *V_ = (const GAS char*)V0_, *KK_ = (const GAS char*)KK0_, *Bv_ = (const GAS char*)Bv0_, *Ev_ = (const GAS char*)Ev0_;
        GAS char *P_ = (GAS char*)P0_, *QO_ = (GAS char*)QO0_;
        const unsigned nb0 = n0 * BW + col0;
        const unsigned vL = (nb0 + (unsigned)ln) * 2u, vT = (nb0 + (unsigned)rm * BW + 4u * hm) * 2u;
#define OADD(v, c) ({ unsigned o_; asm volatile("v_add_u32_e32 %0, %1, %2" : "=v"(o_) : "n"((int)(c)), "v"(v)); o_; })
#define LD16(arr, off) (*(const GAS bf16*)((arr) + (off)))
#define XL(arr, t) LD16(arr, OADD(vL, (t) * BW * 2))
#define ROWQ(q) (((q) & 3) + 8 * ((q) >> 2))
        P5STAMP(0);
        bf16x8 Ep[2][2][2]; u32x2 raw[2][4][4];
#pragma unroll
        for (int fb = 0; fb < 2; ++fb)
#pragma unroll
            for (int tb = 0; tb < 2; ++tb)
#pragma unroll
                for (int s = 0; s < 2; ++s) { const u32x2 lo_ = *(const GAS u32x2*)(Ev_ + OADD(vT, (32 * tb * BW + 32 * fb + 16 * s) * 2)), hi_ = *(const GAS u32x2*)(Ev_ + OADD(vT, (32 * tb * BW + 32 * fb + 16 * s + 8) * 2));
                    u32x4 w_; w_.x = lo_.x; w_.y = lo_.y; w_.z = hi_.x; w_.w = hi_.y; Ep[fb][tb][s] = __builtin_bit_cast(bf16x8, w_); }
#define LOAD_TILE(BUF, FB, TB) do { _Pragma("unroll") for (int g = 0; g < 4; ++g) { const unsigned ot_ = OADD(vT, (32 * (TB) * BW + 32 * (FB) + 8 * g) * 2); \
            raw[BUF][0][g] = *(const GAS u32x2*)(KK_ + ot_); raw[BUF][1][g] = *(const GAS u32x2*)(R_ + ot_); \
            raw[BUF][2][g] = *(const GAS u32x2*)(Bv_ + ot_); raw[BUF][3][g] = *(const GAS u32x2*)(KP_ + ot_); } } while (0)
        LOAD_TILE(0, 0, 0);
#define IDF(s) (*(const LAS bf16x8*)(IFR + (s) * 1024 + ln * 16))
        bf16x8 ETp[2][2][2], tri[2], ones;
        float sc_[2];
        {   const bf16x8 id0 = IDF(0), id1 = IDF(1);
            {   unsigned o2_ = 0x3F803F80u; asm volatile("" : "+v"(o2_)); u32x4 o4_; o4_.x = o2_; o4_.y = o2_; o4_.z = o2_; o4_.w = o2_; ones = __builtin_bit_cast(bf16x8, o4_); }
#pragma unroll
            for (int e = 0; e < 8; ++e) {
#pragma unroll
                for (int s = 0; s < 2; ++s) tri[s][e] = (16 * s + 8 * (e >> 2) + 4 * hm + (e & 3)) <= rm ? (short)0x3F80 : (short)0; }
#pragma unroll
            for (int kb = 0; kb < 2; ++kb)
#pragma unroll
                for (int fb = 0; fb < 2; ++fb) { f32x16 x_;
#pragma unroll
                    for (int q = 0; q < 16; ++q) x_[q] = 0.f;
                    x_ = MFMA32(Ep[fb][kb][0], id0, x_); x_ = MFMA32(Ep[fb][kb][1], id1, x_);
                    ETp[kb][fb][0] = pk_tile(x_, 0); ETp[kb][fb][1] = pk_tile(x_, 1); }
#pragma unroll
            for (int fb = 0; fb < 2; ++fb) { f32x16 t_;
#pragma unroll
                for (int q = 0; q < 16; ++q) t_[q] = 0.f;
#pragma unroll
                for (int kb = 0; kb < 2; ++kb)
#pragma unroll
                    for (int s = 0; s < 2; ++s) t_ = MFMA32(ones, ETp[kb][fb][s], t_);
                sc_[fb] = fexp(-t_[0]); }
            __builtin_amdgcn_sched_barrier(0); }
        P5STAMP(1);
        bf16x8 Ap[2][2][2], Rp[2][2][2], Bp[2][2][2], Kp[2][2][2];
#pragma unroll
        for (int ti = 0; ti < 4; ++ti) { const int fb = ti >> 1, tb = ti & 1;
            if (ti < 3) LOAD_TILE((ti + 1) & 1, (ti + 1) >> 1, (ti + 1) & 1);
            f32x16 Lt;
#pragma unroll
            for (int q = 0; q < 16; ++q) Lt[q] = 0.f;
#pragma unroll
            for (int kb = 0; kb <= tb; ++kb)
#pragma unroll
                for (int s = 0; s < 2; ++s) Lt = MFMA32(ETp[kb][fb][s], kb < tb ? ones : tri[s], Lt);
#pragma unroll
            for (int s = 0; s < 2; ++s) {
                float a8[8], r8[8], b8[8], k8[8], e8[8]; unpack8(__builtin_bit_cast(u32x4, Ep[fb][tb][s]), e8);
#pragma unroll
                for (int g2 = 0; g2 < 2; ++g2) { const int g = 2 * s + g2;
                    const u32x2 aw = raw[ti & 1][0][g], rw = raw[ti & 1][1][g], bw = raw[ti & 1][2][g], kw = raw[ti & 1][3][g];
                    const float av[4] = {bflo(aw.x), bfhi(aw.x), bflo(aw.y), bfhi(aw.y)}, rv[4] = {bflo(rw.x), bfhi(rw.x), bflo(rw.y), bfhi(rw.y)},
                                bv[4] = {bflo(bw.x), bfhi(bw.x), bflo(bw.y), bfhi(bw.y)}, kv[4] = {bflo(kw.x), bfhi(kw.x), bflo(kw.y), bfhi(kw.y)};
#pragma unroll
                    for (int j = 0; j < 4; ++j) { const float l = -Lt[4 * g + j];
                        const float eI = fexp(l), eX = fexp(l + e8[4 * g2 + j]), eN = frcp(eI);
                        a8[4 * g2 + j] = -av[j] * eX; r8[4 * g2 + j] = rv[j] * eI; b8[4 * g2 + j] = bv[j] * eN; k8[4 * g2 + j] = kv[j] * eN; } }
                Ap[fb][tb][s] = __builtin_bit_cast(bf16x8, pack8(a8)); Rp[fb][tb][s] = __builtin_bit_cast(bf16x8, pack8(r8));
                Bp[fb][tb][s] = __builtin_bit_cast(bf16x8, pack8(b8)); Kp[fb][tb][s] = __builtin_bit_cast(bf16x8, pack8(k8)); }
            __builtin_amdgcn_sched_barrier(0); }
#undef LOAD_TILE
        P5STAMP(2);
#define GRAM_TILE(m_, XP, YP, ib, tb) do { _Pragma("unroll") for (int q = 0; q < 16; ++q) m_[q] = 0.f; \
            _Pragma("unroll") for (int fb = 0; fb < 2; ++fb) _Pragma("unroll") for (int s = 0; s < 2; ++s) m_ = MFMA32(XP[fb][ib][s], YP[fb][tb][s], m_); } while (0)
        bf16x8 Tp[2][2][2];
        {
#pragma unroll
            for (int b = 1; b >= 0; --b) { bf16x8 AP[2], BP[2]; f32x16 CT;
                {   f32x16 m_; int rm_ = rm; asm volatile("" : "+v"(rm_));
                    GRAM_TILE(m_, Bp, Ap, b, b);
#pragma unroll
                    for (int q = 0; q < 16; ++q) m_[q] = crow(q, hm) < rm_ ? m_[q] : 0.f;
                    BP[0] = pk_tile(m_, 0); BP[1] = pk_tile(m_, 1);
#pragma unroll
                    for (int q = 0; q < 16; ++q) CT[q] = m_[q] + (crow(q, hm) == rm_ ? 1.0f : 0.f);
                    GRAM_TILE(m_, Ap, Bp, b, b);
#pragma unroll
                    for (int q = 0; q < 16; ++q) m_[q] = rm_ < crow(q, hm) ? m_[q] : 0.f;
                    AP[0] = pk_tile(m_, 0); AP[1] = pk_tile(m_, 1); }
                __builtin_amdgcn_sched_barrier(0);
#pragma unroll
                for (int it = 0; it < 4; ++it) { f32x16 pn_, pt_;
#pragma unroll
                    for (int q = 0; q < 16; ++q) { pn_[q] = 0.f; pt_[q] = 0.f; }
#pragma unroll
                    for (int s = 0; s < 2; ++s) { pn_ = MFMA32(AP[s], BP[s], pn_); pt_ = MFMA32(BP[s], AP[s], pt_); }
                    const bf16x8 bt0 = pk_tile(CT, 0), bt1 = pk_tile(CT, 1);
                    AP[0] = pk_tile(pt_, 0); AP[1] = pk_tile(pt_, 1); BP[0] = pk_tile(pn_, 0); BP[1] = pk_tile(pn_, 1);
                    CT = MFMA32(AP[0], bt0, CT); CT = MFMA32(AP[1], bt1, CT);
                    __builtin_amdgcn_sched_barrier(0); }
                Tp[b][b][0] = pk_tile(CT, 0); Tp[b][b][1] = pk_tile(CT, 1); }
            {   f32x16 x_; GRAM_TILE(x_, Ap, Bp, 1, 0);
                const bf16x8 au0 = pk_tile(x_, 0), au1 = pk_tile(x_, 1);
#pragma unroll
                for (int q = 0; q < 16; ++q) x_[q] = 0.f;
                x_ = MFMA32(au0, Tp[1][1][0], x_); x_ = MFMA32(au1, Tp[1][1][1], x_);
                const bf16x8 bx0 = pk_tile(x_, 0), bx1 = pk_tile(x_, 1);
#pragma unroll
                for (int q = 0; q < 16; ++q) x_[q] = 0.f;
                x_ = MFMA32(Tp[0][0][0], IDF(0), x_); x_ = MFMA32(Tp[0][0][1], IDF(1), x_);
                const bf16x8 at0 = pk_tile(x_, 0), at1 = pk_tile(x_, 1);
#pragma unroll
                for (int q = 0; q < 16; ++q) x_[q] = 0.f;
                x_ = MFMA32(at0, bx0, x_); x_ = MFMA32(at1, bx1, x_);
                Tp[1][0][0] = pk_tile(x_, 0); Tp[1][0][1] = pk_tile(x_, 1); }
            __builtin_amdgcn_sched_barrier(0); }
        P5STAMP(3);
        {   const bf16x8 id0 = IDF(0), id1 = IDF(1);
#pragma unroll
            for (int tb = 0; tb < 2; ++tb)
#pragma unroll
                for (int kb = 0; kb < 2; ++kb) { f32x16 xb_, xk_; const float sc = sc_[kb];
#pragma unroll
                    for (int q = 0; q < 16; ++q) { xb_[q] = 0.f; xk_[q] = 0.f; }
                    xb_ = MFMA32(Bp[kb][tb][0], id0, xb_); xb_ = MFMA32(Bp[kb][tb][1], id1, xb_);
                    xk_ = MFMA32(Kp[kb][tb][0], id0, xk_); xk_ = MFMA32(Kp[kb][tb][1], id1, xk_);
#pragma unroll
                    for (int q = 0; q < 16; ++q) { xb_[q] *= sc; xk_[q] *= sc; }
#pragma unroll
                    for (int s = 0; s < 2; ++s) { *(LAS bf16x8*)(wl + (((tb * 2 + kb) * 2 + s) * 1024) + ln * 16) = pk_tile(xb_, s); *(LAS bf16x8*)(wl + 8192 + (((tb * 2 + kb) * 2 + s) * 1024) + ln * 16) = pk_tile(xk_, s); }
                    __builtin_amdgcn_sched_barrier(0); } }
        bf16x8 Makp[2][2][2], Mbrp[2][2][2], Mkrp[2][2][2];
#define GRAM(XP, YP, STRICT, BODY) _Pragma("unroll") for (int ib = 0; ib < 2; ++ib) _Pragma("unroll") for (int tb = 0; tb < 2; ++tb) if (!(ib == 1 && tb == 0)) { f32x16 m_; \
            GRAM_TILE(m_, XP, YP, ib, tb); \
            int rm_ = rm; asm volatile("" : "+v"(rm_)); \
            _Pragma("unroll") for (int q = 0; q < 16; ++q) { const int i_ = 32 * ib + crow(q, hm), t_ = 32 * tb + rm_; m_[q] = ((STRICT) ? (i_ < t_) : (i_ <= t_)) ? m_[q] : 0.f; } \
            BODY __builtin_amdgcn_sched_barrier(0); }
        GRAM(Kp, Rp, false, { Mkrp[ib][tb][0] = pk_tile(m_, 0); Mkrp[ib][tb][1] = pk_tile(m_, 1); })
        GRAM(Kp, Ap, true, { Makp[ib][tb][0] = pk_tile(m_, 0); Makp[ib][tb][1] = pk_tile(m_, 1); })
        GRAM(Bp, Rp, false, { Mbrp[ib][tb][0] = pk_tile(m_, 0); Mbrp[ib][tb][1] = pk_tile(m_, 1); })
#undef GRAM
#undef GRAM_TILE
        P5STAMP(4);
#define IDF2(s) (*(const LAS bf16x8*)(IFR + (s) * 1024 + ln2 * 16))
        bf16x8 ATp[2][2][2];
        const int ln2 = opq_tid(F.wave) & 63;
        GAS char* pn = (GAS char*)(P0_ + (size_t)cid * 4096);
#pragma unroll
        for (int kb = 0; kb < 2; ++kb) { const bf16x8 id0 = IDF2(0), id1 = IDF2(1);
            {   bf16x8 A0p[2][2];
#pragma unroll
                for (int ib = 0; ib < 2; ++ib) { f32x16 x_;
#pragma unroll
                    for (int q = 0; q < 16; ++q) x_[q] = 0.f;
                    x_ = MFMA32(Ap[kb][ib][0], id0, x_); x_ = MFMA32(Ap[kb][ib][1], id1, x_);
                    A0p[ib][0] = pk_tile(x_, 0); A0p[ib][1] = pk_tile(x_, 1); }
#pragma unroll
                for (int tb = 0; tb < 2; ++tb) { f32x16 a_;
#pragma unroll
                    for (int q = 0; q < 16; ++q) a_[q] = 0.f;
#pragma unroll
                    for (int ib = 0; ib <= tb; ++ib)
#pragma unroll
                        for (int s = 0; s < 2; ++s) a_ = MFMA32(Tp[tb][ib][s], A0p[ib][s], a_);
                    ATp[tb][kb][0] = pk_tile(a_, 0); ATp[tb][kb][1] = pk_tile(a_, 1); } }
            __builtin_amdgcn_sched_barrier(0);
#pragma unroll
            for (int tb = 0; tb < 2; ++tb) { f32x16 p_; const int jb = kb;
#pragma unroll
                for (int q = 0; q < 16; ++q) p_[q] = 0.f;
                p_ = MFMA32(id0, Rp[jb][tb][0], p_); p_ = MFMA32(id1, Rp[jb][tb][1], p_);
#pragma unroll
                for (int ib = 0; ib <= tb; ++ib)
#pragma unroll
                    for (int s = 0; s < 2; ++s) p_ = MFMA32(ATp[ib][jb][s], Mbrp[ib][tb][s], p_);
#pragma unroll
                for (int s = 0; s < 2; ++s) *(GAS bf16x8*)(pn + ((((jb * 2 + tb) * 2 + s) * 64) + ln2) * 16) = pk_tile(p_, s);
                __builtin_amdgcn_sched_barrier(0); } }
        P5STAMP(6);
        bf16x8 W1p[2][2][2], Vp[2][2][2];
        const int lc_ = ln2;
        const unsigned vC = (nb0 + 4u * (unsigned)(lc_ >> 5) * BW + 2u * (unsigned)(lc_ & 31)) * 2u;
#pragma unroll
        for (int ib = 0; ib < 2; ++ib) { f32x16 v0_, v1_;
#pragma unroll
            for (int q = 0; q < 16; ++q) { const unsigned w_ = *(const GAS unsigned*)(V_ + OADD(vC, ((32 * ib + ROWQ(q)) * BW) * 2)); v0_[q] = bflo(w_); v1_[q] = bfhi(w_); }
            Vp[ib][0][0] = pk_tile(v0_, 0); Vp[ib][0][1] = pk_tile(v0_, 1); Vp[ib][1][0] = pk_tile(v1_, 0); Vp[ib][1][1] = pk_tile(v1_, 1); }
#pragma unroll
        for (int vb = 0; vb < 2; ++vb) { bf16x8 W0p[2][2];
#pragma unroll
            for (int tb = 0; tb < 2; ++tb) { f32x16 w_;
#pragma unroll
                for (int q = 0; q < 16; ++q) w_[q] = 0.f;
#pragma unroll
                for (int ib = 0; ib <= tb; ++ib)
#pragma unroll
                    for (int s = 0; s < 2; ++s) w_ = MFMA32(Makp[ib][tb][s], Vp[ib][vb][s], w_);
                W0p[tb][0] = pk_tile(w_, 0); W0p[tb][1] = pk_tile(w_, 1); }
#pragma unroll
            for (int tb = 0; tb < 2; ++tb) { f32x16 w_;
#pragma unroll
                for (int q = 0; q < 16; ++q) w_[q] = 0.f;
#pragma unroll
                for (int ib = 0; ib <= tb; ++ib)
#pragma unroll
                    for (int s = 0; s < 2; ++s) w_ = MFMA32(Tp[tb][ib][s], W0p[ib][s], w_);
                W1p[tb][vb][0] = pk_tile(w_, 0); W1p[tb][vb][1] = pk_tile(w_, 1); }
            __builtin_amdgcn_sched_barrier(0); }
        P5STAMP(7);
        GAS char* qn = (GAS char*)(QO0_ + (size_t)cid * 4096);
#pragma unroll
        for (int tb = 0; tb < 2; ++tb)
#pragma unroll
            for (int vb = 0; vb < 2; ++vb) { f32x16 y_;
#pragma unroll
                for (int q = 0; q < 16; ++q) y_[q] = 0.f;
#pragma unroll
                for (int ib = 0; ib <= tb; ++ib)
#pragma unroll
                    for (int s = 0; s < 2; ++s) { y_ = MFMA32(Mbrp[ib][tb][s], W1p[ib][vb][s], y_); y_ = MFMA32(Mkrp[ib][tb][s], Vp[ib][vb][s], y_); }
#pragma unroll
                for (int g = 0; g < 4; ++g) { u32x2 w; w.x = pk2(y_[4 * g], y_[4 * g + 1]); w.y = pk2(y_[4 * g + 2], y_[4 * g + 3]); *(GAS u32x2*)(qn + ((((tb * 2 + vb) * 4 + g) * 64) + ln2) * 8) = w; }
                __builtin_amdgcn_sched_barrier(0); }
        P5STAMP(8);
        wave_lds_fence();
        bf16x8 Bh[2][2][2];
#pragma unroll
        for (int tb = 0; tb < 2; ++tb)
#pragma unroll
            for (int kb = 0; kb < 2; ++kb)
#pragma unroll
                for (int s = 0; s < 2; ++s) Bh[tb][kb][s] = *(const LAS bf16x8*)(wl + (((tb * 2 + kb) * 2 + s) * 1024) + ln2 * 16);
        GAS char* gt = (GAS char*)(GT + (size_t)cid * 4096); GAS char* ht = (GAS char*)(HT + (size_t)cid * 4096);
#pragma unroll
        for (int kb = 0; kb < 2; ++kb)
#pragma unroll
            for (int jb = 0; jb < 2; ++jb) { f32x16 g_;
                const float dg = sc_[kb];
#pragma unroll
                for (int q = 0; q < 16; ++q) g_[q] = (kb == jb && crow(q, hm) == rm) ? dg : 0.f;
#pragma unroll
                for (int tb = 0; tb < 2; ++tb)
#pragma unroll
                    for (int s = 0; s < 2; ++s) g_ = MFMA32(ATp[tb][jb][s], Bh[tb][kb][s], g_);
#pragma unroll
                for (int s = 0; s < 2; ++s) *(GAS bf16x8*)(gt + ((kb * 4 + jb * 2 + s) * 64 + ln2) * 16) = pk_tile(g_, s);
                __builtin_amdgcn_sched_barrier(0); }
        {   bf16x8 Kh[2][2][2];
#pragma unroll
            for (int tb = 0; tb < 2; ++tb)
#pragma unroll
                for (int kb = 0; kb < 2; ++kb)
#pragma unroll
                    for (int s = 0; s < 2; ++s) Kh[tb][kb][s] = *(const LAS bf16x8*)(wl + 8192 + (((tb * 2 + kb) * 2 + s) * 1024) + ln2 * 16);
#pragma unroll
            for (int kb = 0; kb < 2; ++kb)
#pragma unroll
                for (int vb = 0; vb < 2; ++vb) { f32x16 h_;
#pragma unroll
                    for (int q = 0; q < 16; ++q) h_[q] = 0.f;
#pragma unroll
                    for (int tb = 0; tb < 2; ++tb)
#pragma unroll
                        for (int s = 0; s < 2; ++s) { h_ = MFMA32(Bh[tb][kb][s], W1p[tb][vb][s], h_); h_ = MFMA32(Kh[tb][kb][s], Vp[tb][vb][s], h_); }
#pragma unroll
                    for (int g = 0; g < 4; ++g) { u32x2 w; w.x = pk2(h_[4 * g], h_[4 * g + 1]); w.y = pk2(h_[4 * g + 2], h_[4 * g + 3]); *(GAS u32x2*)(ht + ((((kb * 2 + vb) * 4 + g) * 64) + ln2) * 8) = w; }
                    __builtin_amdgcn_sched_barrier(0); } }
        P5STAMP(9);
#undef IDF
#undef IDF2
#if defined(STAMPS)
        if (F.gw == 0 && cid == 0 && lane == 0) { _Pragma("unroll") for (int k_ = 0; k_ < 10; ++k_) ((unsigned long long*)(F0_ws + WS_CTL + 49152))[32 + k_] = p5ts[k_]; }
#endif
        wave_lds_fence();
#undef XL
#undef OADD
#undef LD16
#undef ROWQ
    }
}

#if defined(CHECKS)
constexpr size_t WS_FLG = WS_CTL + 32768;
DI unsigned* chk_flags(unsigned char* ws) { return (unsigned*)(ws + WS_FLG); }
DI void chk(unsigned char* ws, int id, float got, float want, float rel, float ab) {
    const float d = fabsf(got - want), lim = rel * fmaxf(fabsf(got), fabsf(want)) + ab;
    if (!(d <= lim)) chk_flags(ws)[id] = 1u; }
DI unsigned hsh(unsigned a) { a ^= a >> 16; a *= 0x7feb352du; a ^= a >> 15; a *= 0x846ca68bu; a ^= a >> 16; return a; }
DI float bfr(float v) { return bflo(f2bf(v)); }
DI int scol_of(int n) { return n < 3360 ? n : (n < 3584 ? -1 : n - 224); }

DI void chk_p0(const Frame& F, ARef A) {
    unsigned char* ws = A.ws; const int lane = F.lane;
    const float* mod = (const float*)(ws + WS_MOD);
    for (int s = F.wave; s < 32; s += NWAVES) { const unsigned hh = hsh(1000 + s); const int b = hh & 3, o = (hh >> 2) % 6144; float a = 0.f;
        for (int k = lane; k < D; k += 64) { const float c = A.c[b * D + k]; a += (c / (1.0f + expf(-c))) * A.w_mod[(size_t)k * 6144 + o]; }
        a = wave_sum(a) + A.b_mod[o]; chk(ws, 10, mod[b * 6144 + o], a, 1e-3f, 1e-4f); }
    const bf16* wt = (const bf16*)(ws + WS_WIN);
    for (int s = 0; s < 8; ++s) { const unsigned hh = hsh(2000 + (F.wave * 8 + s) * 64 + lane); const int n = hh % NPAD, k = (hh >> 13) & 1023; const int sc = scol_of(n);
        const float want = sc >= 0 ? bfr(A.w_in[(size_t)k * IN_COLS + sc]) : 0.f; chk(ws, 11, bf2f(wt[(size_t)n * D + k]), want, 0.f, 0.f); }
    { const unsigned hh = hsh(3000 + F.wave * 64 + lane); const int n = hh & 1023, k = (hh >> 10) & 511, k2 = (hh >> 10) & 1023;
        chk(ws, 11, bf2f(((const bf16*)(ws + WS_WOSB))[n * BW + k]), bfr(A.w_o_sb[k * D + n]), 0.f, 0.f);
        chk(ws, 11, bf2f(((const bf16*)(ws + WS_WORW))[n * BW + k]), bfr(A.w_o_rw[k * D + n]), 0.f, 0.f);
        chk(ws, 11, bf2f(((const bf16*)(ws + WS_WOUT))[n * D + k2]), bfr(A.w_out[k2 * D + n]), 0.f, 0.f);
        const int o = hh % 36; chk(ws, 11, ((const float*)(ws + WS_RTW))[o * D + k2], o < 4 ? A.w_group[k2 * 4 + o] : A.w_router[k2 * NE + o - 4], 0.f, 0.f);
        const int nl = hh % 1536, kl = (hh >> 11) % LK; float v = 0.f;
        if (nl < 512) { if (kl < 64) v = A.w_decay_up[kl * BW + nl]; } else if (nl < 1024) { if (kl >= 64 && kl < 128) v = A.w_iclr_up[(kl - 64) * BW + nl - 512]; } else { if (kl >= 128 && kl < 288) v = A.w_gate_up[(kl - 128) * BW + nl - 1024]; }
        chk(ws, 11, bf2f(((const bf16*)(ws + WS_WL))[nl * LK + kl]), bfr(v), 0.f, 0.f); }
}
DI void chk_p1(const Frame& F, ARef A, const bf16* H1) {
    unsigned char* ws = A.ws; const int lane = F.lane; const float* mod = (const float*)(ws + WS_MOD);
    for (int s = F.wave; s < 16; s += NWAVES) { const int n = hsh(4000 + s) % NTOK, b = n >> 13; float ss = 0.f;
        for (int k = lane; k < D; k += 64) { const float v = A.x[(size_t)n * D + k]; ss += v * v; }
        const float inv = 1.0f / sqrtf(wave_sum(ss) / D + NORM_EPS);
        for (int k = lane; k < D; k += 64) { const float want = (A.x[(size_t)n * D + k] * inv) * A.gains[k] * (1.0f + mod[b * 6144 + D + k]) + mod[b * 6144 + k];
            chk(ws, 12, bf2f(H1[(size_t)n * D + k]), want, 0.01f, 0.01f); } }
}
DI float wdot(const bf16* arow, const float* W, int ldw, int col, int K, int lane) { float a = 0.f; for (int k = lane; k < K; k += 64) a += bf2f(arow[k]) * W[(size_t)k * ldw + col]; return wave_sum(a); }
DI void chk_p2(const Frame& F, ARef A, const bf16* H1) {
    unsigned char* ws = A.ws; const int lane = F.lane;
    for (int s = F.wave; s < 96; s += NWAVES) { const unsigned hh = hsh(5000 + s); const int n = hh % NTOK, region = s % 6; int col;
        const unsigned h2 = hsh(hh);
        float got, want; int id = 13 + region;
        if (region == 0) { col = h2 % 512; want = 0.125f * wdot(H1 + (size_t)n * D, A.w_in, IN_COLS, col, D, lane); got = bf2f(((const bf16*)(ws + WS_QB))[(size_t)n * BW + col]); }
        else if (region == 1) { col = h2 % 512; want = wdot(H1 + (size_t)n * D, A.w_in, IN_COLS, 512 + col, D, lane); got = bf2f(((const bf16*)(ws + WS_KB))[(size_t)n * BW + col]); }
        else if (region == 2) { col = h2 % 512; want = wdot(H1 + (size_t)n * D, A.w_in, IN_COLS, 1024 + col, D, lane); got = bf2f(((const bf16*)(ws + WS_VT))[((size_t)((n >> 13) * BW + col)) * SEQ + (n & (SEQ - 1))]); }
        else if (region == 3) { col = h2 % 1536; want = wdot(H1 + (size_t)n * D, A.w_in, IN_COLS, 1536 + col, D, lane); got = bf2f(((const bf16*)(ws + WS_RWRAW))[(size_t)n * 1536 + col]); }
        else if (region == 4) { col = h2 % 288; want = wdot(H1 + (size_t)n * D, A.w_in, IN_COLS, 3072 + col, D, lane); got = bf2f(((const bf16*)(ws + WS_LORA))[(size_t)n * BW + col]); }
        else { col = h2 % 2048; want = wdot(H1 + (size_t)n * D, A.w_in, IN_COLS, 3360 + col, D, lane) + A.gate_bias[col]; want = 1.0f / (1.0f + expf(-want)); got = bf2f(((const bf16*)(ws + WS_GATE))[(size_t)n * 2048 + col]); }
        chk(ws, id, got, want, 0.03f, 0.02f); }
}
constexpr int NATT = 16;
DI void att_sample(int s, int& b, int& h, int& t) { const unsigned hh = hsh(6000 + s); b = hh & 3; h = (hh >> 2) & 7; t = (s < 4) ? (s * 37) : (int)((hh >> 5) % SEQ); }
DI void chk_p3_save(const Frame& F, ARef A) {
    if (F.wave == 0) { bf16* sv = (bf16*)(A.ws + WS_FLG + 4096);
        for (int s = 0; s < NATT; ++s) { int b, h, t; att_sample(s, b, h, t); sv[s * 64 + F.lane] = ((const bf16*)(A.ws + WS_QB))[(size_t)(b * SEQ + t) * BW + h * HD + F.lane]; } }
}
DI void chk_p3(const Frame& F, ARef A, const bf16* R, const bf16* KS, const bf16* V, const bf16* KK) {
    unsigned char* ws = A.ws; const int lane = F.lane;
    const bf16* sv = (const bf16*)(ws + WS_FLG + 4096); const bf16* KB = (const bf16*)(ws + WS_KB); const bf16* VT = (const bf16*)(ws + WS_VT);
    for (int s = F.wave; s < NATT; s += NWAVES) { int b, h, t; att_sample(s, b, h, t);
        const float q = bf2f(sv[s * 64 + lane]); float later = 0.f, o = 0.f;
        for (int k = t - 1; k >= 0; --k) { const float z = wave_sum(q * bf2f(KB[(size_t)(b * SEQ + k) * BW + h * HD + lane]));
            const float sp = fmaxf(z, 0.f) + log1pf(expf(-fabsf(z)));
            o += expf(z - sp + later) * bf2f(VT[((size_t)((b * NH + h) * HD + lane)) * SEQ + k]);
            later -= sp; if (later < -200.f) break; }
        chk(ws, 19, bf2f(((const bf16*)(ws + WS_QB))[(size_t)(b * SEQ + t) * BW + h * HD + lane]), o, 0.04f, 0.02f); }
    const bf16* RW = (const bf16*)(ws + WS_RWRAW); const bf16* LO = (const bf16*)(ws + WS_LORA); const bf16* AL = (const bf16*)(ws + WS_ALORA);
    for (int s = F.wave; s < 32; s += NWAVES) { const unsigned hh = hsh(7000 + s); const int n = (s < 4) ? s * SEQ : (int)(hh % NTOK), hd = (hh >> 16) & 7; const bool first = (n & (SEQ - 1)) == 0;
        float xs[3];
        for (int p = 0; p < 3; ++p) { const int col = p * 512 + hd * 64 + lane; const float cur = bf2f(RW[(size_t)n * 1536 + col]), prv = first ? 0.f : bf2f(RW[(size_t)(n - 1) * 1536 + col]); xs[p] = cur + A.shift_mu[col] * (prv - cur); }
        const size_t o = (size_t)n * BW + hd * 64 + lane;
        chk(ws, 20, bf2f(R[o]), xs[0], 0.01f, 0.005f); chk(ws, 20, bf2f(KS[o]), xs[1], 0.01f, 0.005f); chk(ws, 20, bf2f(V[o]), xs[2], 0.01f, 0.005f);
        const float kk = xs[1] * A.k_k[hd * 64 + lane]; const float nn = sqrtf(wave_sum(kk * kk));
        chk(ws, 20, bf2f(KK[o]), kk / fmaxf(nn, L2_EPS), 0.01f, 0.002f);
        for (int c = lane; c < LK; c += 64) { float want = 0.f;
            if (c < 288) { const float cur = bf2f(LO[(size_t)n * BW + c]), prv = first ? 0.f : bf2f(LO[(size_t)(n - 1) * BW + c]); const float v = cur + A.shift_mu[1536 + c] * (prv - cur);
                want = c < 64 ? tanhf(v) : (c < 128 ? v : 1.0f / (1.0f + expf(-v))); }
            chk(ws, 20, bf2f(AL[(size_t)n * LK + c]), want, 0.01f, 0.005f); } }
}
DI void chk_p4_save(const Frame& F, ARef A, const bf16* KS) {
    if (F.wave == 0) { bf16* sv = (bf16*)(A.ws + WS_FLG + 8192);
        for (int s = 0; s < 16; ++s) { const unsigned hh = hsh(8000 + s); const int n = hh % NTOK, hd = (hh >> 16) & 7; sv[s * 64 + F.lane] = KS[(size_t)n * BW + hd * 64 + F.lane]; } }
}
DI void chk_p4(const Frame& F, ARef A, const bf16* KP, const bf16* KK) {
    unsigned char* ws = A.ws; const int lane = F.lane; const bf16* AL = (const bf16*)(ws + WS_ALORA); const bf16* sv = (const bf16*)(ws + WS_FLG + 8192);
    for (int s = F.wave; s < 16; s += NWAVES) { const unsigned hh = hsh(8000 + s); const int n = hh % NTOK, hd = (hh >> 16) & 7, c = hd * 64 + lane; const size_t o = (size_t)n * BW + c;
        float lw = 0.f, la = 0.f, lg = 0.f;
        for (int k = 0; k < 64; ++k) { lw += bf2f(AL[(size_t)n * LK + k]) * A.w_decay_up[k * BW + c]; la += bf2f(AL[(size_t)n * LK + 64 + k]) * A.w_iclr_up[k * BW + c]; }
        for (int k = 0; k < 160; ++k) lg += bf2f(AL[(size_t)n * LK + 128 + k]) * A.w_gate_up[k * BW + c];
        const float x = -(A.w0[c] + lw), w = -(fmaxf(x, 0.f) + log1pf(expf(-fabsf(x)))) - 0.5f;
        chk(ws, 21, bf2f(((const bf16*)(ws + WS_E))[o]), expf(w), 0.03f, 0.003f);
        const float a = 1.0f / (1.0f + expf(-(A.a0[c] + la))); const float ks = bf2f(sv[s * 64 + lane]);
        chk(ws, 22, bf2f(KP[o]), ks * (1.0f + (a - 1.0f) * A.k_a[c]), 0.03f, 0.01f);
        chk(ws, 22, bf2f(((const bf16*)(ws + WS_B))[o]), bf2f(KK[o]) * a, 0.03f, 0.003f);
        chk(ws, 23, bf2f(((const bf16*)(ws + WS_GG))[o]), lg, 0.03f, 0.01f); }
}
constexpr int NST = 300;
DI void chk_p7_save(const Frame& F, ARef A) {
    if (F.wave < 4) { const int b = (F.wave * 3) & 3, h = (F.wave * 5 + 1) & 7; bf16* sv = (bf16*)(A.ws + 256 * 1024) + F.wave * NST * 64;
        for (int t = 0; t < NST; ++t) sv[t * 64 + F.lane] = ((const bf16*)(A.ws + WS_E))[(size_t)(b * SEQ + t) * BW + h * HD + F.lane]; }
}
DI void chk_p7(const Frame& F, ARef A, const bf16* R, const bf16* KP, const bf16* V, const bf16* KK) {
    unsigned char* ws = A.ws; const int lane = F.lane;
    const bf16* Bv = (const bf16*)(ws + WS_B); const bf16* Esv = (const bf16*)(ws + 256 * 1024) + F.wave * NST * 64; const bf16* GG = (const bf16*)(ws + WS_GG); const bf16* YRW = (const bf16*)(ws + WS_YRW);
    if (F.wave < 4) { const int b = (F.wave * 3) & 3, h = (F.wave * 5 + 1) & 7, col0 = h * HD;
        float S[64];
#pragma unroll
        for (int k = 0; k < 64; ++k) S[k] = 0.f;
        for (int t = 0; t < NST; ++t) { const size_t o = (size_t)(b * SEQ + t) * BW + col0 + lane;
            const float av = -bf2f(KK[o]), bv = bf2f(Bv[o]), dv = expf(-bf2f(Esv[t * 64 + lane])), kv = bf2f(KP[o]), rv = bf2f(R[o]), vv = bf2f(V[o]);
            float sa = 0.f;
#pragma unroll
            for (int k = 0; k < 64; ++k) sa += S[k] * __shfl(av, k);
            float y = 0.f;
#pragma unroll
            for (int k = 0; k < 64; ++k) { S[k] = S[k] * __shfl(dv, k) + sa * __shfl(bv, k) + vv * __shfl(kv, k); y += S[k] * __shfl(rv, k); }
            const float mean = wave_sum(y) / 64.f, d = y - mean, var = wave_sum(d * d) / 64.f;
            const float yn = d / sqrtf(var + GN_EPS) * A.lnx_w[col0 + lane] + A.lnx_b[col0 + lane];
            const float bonus = wave_sum(rv * kv * A.r_k[col0 + lane]) * vv;
            const float want = (yn + bonus) * bf2f(GG[o]);
            chk(ws, t < 128 ? 24 : 25, bf2f(YRW[o]), want, 0.05f, 0.03f); } }
}
DI void chk_p8(const Frame& F, ARef A) {
    unsigned char* ws = A.ws; const int lane = F.lane;
    for (int s = F.wave; s < 32; s += NWAVES) { const unsigned hh = hsh(9000 + s); const int n = hh % NTOK, c = (hh >> 15) & 1023;
        const float p1 = wdot((const bf16*)(ws + WS_QB) + (size_t)n * BW, A.w_o_sb, D, c, BW, lane), p2 = wdot((const bf16*)(ws + WS_YRW) + (size_t)n * BW, A.w_o_rw, D, c, BW, lane);
        const bf16* ga = (const bf16*)(ws + WS_GATE) + (size_t)n * 2048;
        chk(ws, 26, bf2f(((const bf16*)(ws + WS_MRG))[(size_t)n * D + c]), bf2f(ga[c]) * p1 + bf2f(ga[1024 + c]) * p2, 0.03f, 0.01f); }
}
DI void chk_p9(const Frame& F, ARef A) {
    unsigned char* ws = A.ws; const int lane = F.lane;
    for (int s = F.wave; s < 32; s += NWAVES) { const unsigned hh = hsh(9500 + s); const int n = hh % NTOK, c = (hh >> 15) & 1023;
        chk(ws, 27, bf2f(((const bf16*)(ws + WS_Y1))[(size_t)n * D + c]), wdot((const bf16*)(ws + WS_MRG) + (size_t)n * D, A.w_out, D, c, D, lane), 0.03f, 0.01f); }
}
DI void chk_p10(const Frame& F, ARef A) {
    unsigned char* ws = A.ws; const int lane = F.lane; const float* mod = (const float*)(ws + WS_MOD);
    const bf16* Y1 = (const bf16*)(ws + WS_Y1); const bf16* H2 = (const bf16*)(ws + WS_H2); const i32x4* tok = (const i32x4*)(ws + WS_TOK);
    for (int s = F.wave; s < 32; s += NWAVES) { const int n = s == 0 ? DBG_TOKEN : (s < 16 ? (int)(hsh(10000 + s) % 128) : (int)(hsh(10000 + s) % NTOK)), b = n >> 13; float ss = 0.f;
        for (int k = lane; k < D; k += 64) { const float v = bf2f(Y1[(size_t)n * D + k]); ss += v * v; }
        const float inv1 = 1.0f / sqrtf(wave_sum(ss) / D + NORM_EPS); float s2 = 0.f;
        for (int k = lane; k < D; k += 64) { const float x1 = A.x[(size_t)n * D + k] + mod[b * 6144 + 2 * D + k] * ((bf2f(Y1[(size_t)n * D + k]) * inv1) * A.gains[D + k]);
            chk(ws, 28, A.out[(size_t)n * D + k], x1, 1e-3f, 1e-3f); s2 += x1 * x1; }
        const float inv2 = 1.0f / sqrtf(wave_sum(s2) / D + NORM_EPS);
        float lg[36];
#pragma unroll
        for (int o = 0; o < 36; ++o) lg[o] = 0.f;
        for (int k = lane; k < D; k += 64) { const float h2 = (A.out[(size_t)n * D + k] * inv2) * A.gains[2 * D + k] * (1.0f + mod[b * 6144 + 4 * D + k]) + mod[b * 6144 + 3 * D + k];
            chk(ws, 29, bf2f(H2[(size_t)n * D + k]), h2, 0.01f, 0.01f);
#pragma unroll
            for (int o = 0; o < 36; ++o) lg[o] += h2 * (o < 4 ? A.w_group[k * 4 + o] : A.w_router[k * NE + o - 4]); }
#pragma unroll
        for (int o = 0; o < 36; ++o) lg[o] = wave_sum(lg[o]);
        int gs = 0; float gm = lg[0];
#pragma unroll
        for (int g = 1; g < 4; ++g) if (lg[g] > gm) { gm = lg[g]; gs = g; }
        float gsum = 0.f;
#pragma unroll
        for (int g = 0; g < 4; ++g) gsum += expf(lg[g] - gm);
        float el[8];
#pragma unroll
        for (int e = 0; e < 8; ++e) el[e] = gs == 0 ? lg[4 + e] : (gs == 1 ? lg[12 + e] : (gs == 2 ? lg[20 + e] : lg[28 + e]));
        int i0 = 0; float m0 = el[0];
#pragma unroll
        for (int e = 1; e < 8; ++e) if (el[e] > m0) { m0 = el[e]; i0 = e; }
        int i1 = -1; float m1 = -3.0e38f;
#pragma unroll
        for (int e = 0; e < 8; ++e) if (e != i0 && el[e] > m1) { m1 = el[e]; i1 = e; }
        const float tt = expf(m1 - m0), p0 = 1.0f / (1.0f + tt);
        const i32x4 rec = tok[n];
        if (lane == 0 && s < 16) { if ((rec.x & 255) != gs * 8 + i0 || ((rec.x >> 8) & 255) != gs * 8 + i1) chk_flags(ws)[30] = 1u;
            if (n == DBG_TOKEN) { const float* dbg = (const float*)chk_flags(ws) + 48; float code = 1.f;
                if (dbg[4] > 4.001f) code += 2.f; if (dbg[5] < 0.499f) code += 4.f;
                if (fabsf(dbg[0] - lg[0]) > 1e-3f || fabsf(dbg[1] - lg[1]) > 1e-3f || fabsf(dbg[2] - lg[2]) > 1e-3f || fabsf(dbg[3] - lg[3]) > 1e-3f) code += 8.f;
                if (fabsf(dbg[4] - gsum) > 1e-3f) code += 16.f; if (fabsf(dbg[6] * dbg[5] - __builtin_bit_cast(float, rec.z)) > 1e-4f) code += 32.f;
                ((float*)chk_flags(ws))[62] = code * 0.1f; ((float*)chk_flags(ws))[63] = dbg[4]; }
            chk(ws, 56, ((const float*)(ws + WS_CW))[2 * n], p0 / gsum, 3e-2f, 1e-4f); chk(ws, 57, ((const float*)(ws + WS_CW))[2 * n + 1], tt * p0 / gsum, 3e-2f, 1e-4f);
            chk(ws, 58, ((const float*)(ws + WS_CW))[2 * n], p0 / gsum, 1e-3f, 1e-5f); chk(ws, 59, ((const float*)(ws + WS_CW))[2 * n + 1], tt * p0 / gsum, 1e-3f, 1e-5f); } }
}
DI void chk_p11(const Frame& F, ARef A) {
    unsigned char* ws = A.ws; const int lane = F.lane; const i32x4* tok = (const i32x4*)(ws + WS_TOK); const int* tile = (const int*)(ws + WS_TILE);
    const bf16* H2 = (const bf16*)(ws + WS_H2); const bf16* HS = (const bf16*)(ws + WS_HS);
    for (int s = F.wave; s < 64; s += NWAVES) { const int n = hsh(11000 + s) % NTOK; const i32x4 rec = tok[n];
        if (rec.x < 0 || rec.x >= tile[MAXT] * 256 || rec.y < 0 || rec.y >= tile[MAXT] * 256 || tile[MAXT] > MAXT || tile[MAXT] < 256) { chk_flags(ws)[32] = 1u; continue; }
        for (int k = lane; k < D; k += 64) { chk(ws, 33, bf2f(HS[(size_t)rec.x * D + k]), bf2f(H2[(size_t)n * D + k]), 0.f, 0.f); chk(ws, 33, bf2f(HS[(size_t)rec.y * D + k]), bf2f(H2[(size_t)n * D + k]), 0.f, 0.f); } }
    { const unsigned hh = hsh(12000 + F.wave * 64 + lane); const int e = hh & 31, n = (hh >> 5) & 1023, k = (hh >> 15) & 1023, k5 = k & 511;
        const int c = (n >> 3) * 4 + (n & 3); const float want = (n & 4) ? A.w_up3[((size_t)e * D + k) * DE + c] : A.w_up1[((size_t)e * D + k) * DE + c];
        chk(ws, 34, bf2f(((const bf16*)(ws + WS_WUP))[((size_t)e * 1024 + n) * D + k]), bfr(want), 0.f, 0.f);
        chk(ws, 35, bf2f(((const bf16*)(ws + WS_WDN))[((size_t)e * 1024 + n) * DE + k5]), bfr(A.w_down[((size_t)e * DE + k5) * D + n]), 0.f, 0.f); }
}
DI void chk_p12(const Frame& F, ARef A) {
    unsigned char* ws = A.ws; const int lane = F.lane; const i32x4* tok = (const i32x4*)(ws + WS_TOK); const int* tile = (const int*)(ws + WS_TILE);
    const bf16* H2 = (const bf16*)(ws + WS_H2); const bf16* HID = (const bf16*)(ws + WS_HID);
    for (int s = F.wave; s < 32; s += NWAVES) { const unsigned hh = hsh(13000 + s); const int n = hh % NTOK, c = (hh >> 16) & 511; const i32x4 rec = tok[n]; const int pos = (s & 1) ? rec.y : rec.x;
        const int e = tile[pos >> 8];
        const float u1 = wdot(H2 + (size_t)n * D, A.w_up1 + (size_t)e * D * DE, DE, c, D, lane), u3 = wdot(H2 + (size_t)n * D, A.w_up3 + (size_t)e * D * DE, DE, c, D, lane);
        chk(ws, 36, bf2f(HID[(size_t)pos * DE + c]), u1 / (1.0f + expf(-u1)) * u3, 0.04f, 0.01f); }
}
DI void chk_p13(const Frame& F, ARef A) {
    unsigned char* ws = A.ws; const int lane = F.lane; const i32x4* tok = (const i32x4*)(ws + WS_TOK); const int* tile = (const int*)(ws + WS_TILE);
    const bf16* HID = (const bf16*)(ws + WS_HID); const bf16* YE = (const bf16*)(ws + WS_HS);
    for (int s = F.wave; s < 32; s += NWAVES) { const unsigned hh = hsh(14000 + s); const int n = hh % NTOK, c = (hh >> 16) & 1023; const i32x4 rec = tok[n]; const int pos = (s & 1) ? rec.y : rec.x;
        const int e = tile[pos >> 8];
        chk(ws, 37, bf2f(YE[(size_t)pos * D + c]), wdot(HID + (size_t)pos * DE, A.w_down + (size_t)e * DE * D, D, c, DE, lane), 0.04f, 0.01f); }
}
#endif

__global__ void __launch_bounds__(NTHR, 2) hybrid_fwd(Args A_unused) {
    extern __shared__ __attribute__((aligned(16))) unsigned char lds_raw[];
    const CAS Args& A = *(const CAS Args*)__builtin_amdgcn_kernarg_segment_ptr();
    Frame F;
    F.lds = (LAS unsigned char*)lds_raw;
    F.wave = __builtin_amdgcn_readfirstlane((int)threadIdx.x >> 6); F.tid = opq_tid(F.wave); F.lane = F.tid & 63;
    F.wg = blockIdx.x; F.G = gridDim.x; F.gw = F.wg * NWAVES + F.wave; F.NGW = F.G * NWAVES;
    volatile LAS unsigned* MISC = (volatile LAS unsigned*)(F.lds + LDS_MISC);
    if (F.wave == 0) MISC[F.lane] = 0u;
    __syncthreads();
    const XcdBarrier bar = xcd_barrier_post((unsigned*)(A.ws + WS_CTL), MISC + 8, F.wave);
    unsigned char* ws = A.ws;
    LAS unsigned char* stage = F.lds;
    bf16* const dob = (bf16*)A.out;
    bf16 *H1 = dob, *R = dob, *KS = dob + (size_t)NTOK * BW, *V = dob + 2 * (size_t)NTOK * BW, *KK = dob + 3 * (size_t)NTOK * BW;

#if defined(STAMPS)
    unsigned long long* const tsp = (unsigned long long*)(ws + WS_CTL + 49152);
#define STAMP(k) do { if (F.wg == 0 && xb_t0(F.wave)) tsp[k] = wall_clock64(); } while (0)
#else
#define STAMP(k) do { } while (0)
#endif
#if defined(REPEAT_PHASE)
#ifndef REPEAT_COUNT
#define REPEAT_COUNT 2
#endif
#define REP(k) _Pragma("nounroll") for (int rep_ = 0; rep_ < ((k) == REPEAT_PHASE ? REPEAT_COUNT : 1); ++rep_)
#else
#define REP(k)
#endif
    STAMP(0);
    REP(0) {
    p0_prologue(F, A);
    xcd_barrier(bar);
    }
    STAMP(1);
#if defined(CHECKS)
    if (F.wg == 0) chk_p0(F, A);
#endif
    REP(1) {
    p1_h1(F, A, H1);
    xcd_barrier(bar);
    }
    STAMP(2);
#if defined(CHECKS)
    if (F.wg == 0) chk_p1(F, A, H1);
#endif
    REP(2) {
    {   pg8::Gemm g{H1, (const bf16*)(ws + WS_WIN), NTOK, NPAD, D}; pg8::StaticOrder S; S.init(NTOK, NPAD, F.G, F.wg);
        EpiIn E{(bf16*)(ws + WS_QB), (bf16*)(ws + WS_KB), (bf16*)(ws + WS_VT), (bf16*)(ws + WS_RWRAW), (bf16*)(ws + WS_LORA), (bf16*)(ws + WS_GATE), A.gate_bias};
        pg8::gemm_phase<EpiIn, pg8::StaticOrder>(stage, g, S, E, nullptr, F.wave); }
    xcd_barrier(bar);
    }
    STAMP(3);
#if defined(CHECKS)
    if (F.wg == 0) { chk_p2(F, A, H1); chk_p3_save(F, A); }
    xcd_barrier(bar);
#endif
#if !defined(CHECKS)
    const bool fuse34 = (F.G == 256);
#else
    const bool fuse34 = false;
#endif
    REP(3) {
    p3_attn(F, (const bf16*)(ws + WS_QB), (const bf16*)(ws + WS_KB), (const bf16*)(ws + WS_VT), (bf16*)(ws + WS_QB));
#if defined(STAMPS)
    STAMP(20);
#endif
    p3_prep(F, A, (const bf16*)(ws + WS_RWRAW), (const bf16*)(ws + WS_LORA), R, KS, V, KK, (bf16*)(ws + WS_ALORA));
#if !defined(CHECKS)
    if (fuse34) { asm volatile("s_waitcnt vmcnt(0)" ::: "memory"); __syncthreads();
        p4_lora(F, A, (const bf16*)(ws + WS_ALORA), (const bf16*)(ws + WS_WL), (bf16*)(ws + WS_E), KS, (bf16*)(ws + WS_B), (bf16*)(ws + WS_GG), KK, R, (float*)(ws + WS_BON)); }
#endif
    xcd_barrier(bar);
    }
#if defined(STAMPS)
    STAMP(21);
#endif
    STAMP(4);
#if defined(CHECKS)
    if (F.wg == 0) { chk_p3(F, A, R, KS, V, KK); chk_p4_save(F, A, KS); }
    xcd_barrier(bar);
#endif
    if (!fuse34) {
    p4_lora(F, A, (const bf16*)(ws + WS_ALORA), (const bf16*)(ws + WS_WL), (bf16*)(ws + WS_E), KS, (bf16*)(ws + WS_B), (bf16*)(ws + WS_GG), KK, R, (float*)(ws + WS_BON));
    xcd_barrier(bar);
    }
    STAMP(5);
#if defined(CHECKS)
    if (F.wg == 0) chk_p4(F, A, KS, KK);
#endif
    REP(5) {
    p5_mfma(ws, F, R, KS, V, KK, (const bf16*)(ws + WS_B), (const bf16*)(ws + WS_E), (bf16*)(ws + WS_P), (bf16*)(ws + WS_QO), (bf16*)(ws + WS_GT), (bf16*)(ws + WS_HT));
    p6_moe_weights(F, A, F.gw, F.NGW);
    xcd_barrier(bar);
    }
    STAMP(6);
#if defined(CHECKS)
    if (F.wg == 255) chk_p7_save(F, A);
#endif
    REP(6) {
    {   const int ncw = F.G < 64 ? F.G : 64;
        if (F.wg < ncw) { if (F.wave == 0) for (int task = F.wg; task < 64; task += ncw) p6_chain(task, F.wave, F.lds, (const bf16*)(ws + WS_GT), (const bf16*)(ws + WS_HT), (bf16*)(ws + WS_SC));
#if defined(STAMPS)
            STAMP(22);
#endif
        }
        else {
            pg8::StaticOrder S; S.init(NTOK, D, F.G - ncw, F.wg - ncw);
            pg8::Gemm g{(const bf16*)(ws + WS_QB), (const bf16*)(ws + WS_WOSB), NTOK, D, BW};
            EpiMerge<false> E{(bf16*)(ws + WS_GATE), (bf16*)(ws + WS_MRG), 0};
            pg8::gemm_phase<EpiMerge<false>, pg8::StaticOrder>(stage, g, S, E, nullptr, F.wave); }
    }
    xcd_barrier(bar);
    }
    STAMP(7);
    REP(7) {
    p7_mfma(F, A, (const bf16*)(ws + WS_SC), (const bf16*)(ws + WS_P), (const bf16*)(ws + WS_QO), V, (const bf16*)(ws + WS_GG), (const float*)(ws + WS_BON), (bf16*)(ws + WS_YRW));
    xcd_barrier(bar);
    }
    STAMP(8);
#if defined(CHECKS)
    if (F.wg == 0) chk_p7(F, A, R, KS, V, KK);
#endif
    REP(8) {
    {   pg8::StaticOrder S; S.init(NTOK, D, F.G, F.wg);
        {   pg8::Gemm g{(const bf16*)(ws + WS_YRW), (const bf16*)(ws + WS_WORW), NTOK, D, BW};
            EpiMerge<true> E{(bf16*)(ws + WS_GATE), (bf16*)(ws + WS_MRG), D};
            pg8::gemm_phase<EpiMerge<true>, pg8::StaticOrder>(stage, g, S, E, nullptr, F.wave); } }
    xcd_barrier(bar);
    }
    STAMP(9);
#if defined(CHECKS)
    if (F.wg == 0) chk_p8(F, A);
#endif
    REP(9) {
    {   pg8::Gemm g{(const bf16*)(ws + WS_MRG), (const bf16*)(ws + WS_WOUT), NTOK, D, D}; pg8::StaticOrder S; S.init(NTOK, D, F.G, F.wg);
        EpiPlain E{(bf16*)(ws + WS_Y1), D, 0xff};
        pg8::gemm_phase<EpiPlain, pg8::StaticOrder>(stage, g, S, E, nullptr, F.wave); }
    xcd_barrier(bar);
    }
    STAMP(10);
#if defined(CHECKS)
    if (F.wg == 0) chk_p9(F, A);
#endif
    REP(10) {
    p10_rows(F, A, (const bf16*)(ws + WS_Y1), (bf16*)(ws + WS_H2));
    xcd_barrier(bar);
    }
    STAMP(11);
#if defined(CHECKS)
    if (F.wg == 0) chk_p10(F, A);
#endif
    REP(11) {
    p11_rank_gather(F, A, (const bf16*)(ws + WS_H2), (bf16*)(ws + WS_HS));
    xcd_barrier(bar);
    }
    STAMP(12);
#if defined(CHECKS)
    if (F.wg == 0) chk_p11(F, A);
#endif
    {   const int* tile = (const int*)(ws + WS_TILE);
        const int nt = __builtin_amdgcn_readfirstlane(tile[MAXT]);
        const int vc = (F.G % 8 == 0) ? (F.wg % 8) * (F.G / 8) + F.wg / 8 : F.wg;
        unsigned* tcnt = (unsigned*)(ws + WS_CTL) + MOE_CNT_WORD;
        REP(12) {   pg8::Gemm g{(const bf16*)(ws + WS_HS), (const bf16*)(ws + WS_WUP), MAXT * 256, NE * 1024, D};
            MoeUpOrder S; S.nunits = nt * 4; S.G = F.G; S.vc = vc; S.tile_e = tile; S.cnt = tcnt;
            EpiUp E{(bf16*)(ws + WS_HID)};
            pg8::gemm_phase<EpiUp, MoeUpOrder>(stage, g, S, E, nullptr, F.wave); }
        __syncthreads();
    STAMP(13);
        REP(13) {   pg8::Gemm g{(const bf16*)(ws + WS_HID), (const bf16*)(ws + WS_WDN), MAXT * 256, NE * 1024, DE};
            MoeDnOrder S; S.nunits = nt * 4; S.G = F.G; S.vc = vc; S.q = (nt * 4) / F.G; S.rem = nt * 4 - S.q * F.G; S.wave = F.wave; S.tile_e = tile; S.cnt = tcnt;
            EpiPlain E{(bf16*)(ws + WS_HS), D, 3};
            pg8::gemm_phase<EpiPlain, MoeDnOrder>(stage, g, S, E, nullptr, F.wave);
        xcd_barrier(bar); } }
    STAMP(14);
#if defined(CHECKS)
    if (F.wg == 0) chk_p13(F, A);
#endif
    p14_final(F, A, (const bf16*)(ws + WS_HS));
#if defined(STAMPS)
    xcd_barrier(bar);
    STAMP(15);
    if (F.wg == 0) { __syncthreads();
        const float va = (float)(long long)(tsp[STAMP_A2] - tsp[STAMP_A]) * 0.01f, vb = (float)(long long)(tsp[STAMP_B2] - tsp[STAMP_B]) * 0.01f;
#if defined(STAMP_SHIFT)
        const float shf_ = 1.1f;
#else
        const float shf_ = 1.0f;
#endif
        int b1 = (int)floorf(logf(fmaxf(va * shf_, 1.0f)) / logf(1.21f)) + 1, b2 = (int)floorf(logf(fmaxf(vb * shf_, 1.0f)) / logf(1.21f)) + 1;
#if defined(STAMP_CAL)
        b1 = 10; b2 = 30;
#endif
#if defined(STAMP_FRAC)
        { const unsigned long long* t5 = tsp + 32; const float tot = (float)(long long)(t5[9] - t5[0]);
          b1 = (int)(12.0f * (float)(long long)(t5[STAMP_A2] - t5[STAMP_A]) / tot) + 3; b2 = (int)(12.0f * (float)(long long)(t5[STAMP_B2] - t5[STAMP_B]) / tot) + 3; }
#endif
#if defined(STAMP_THR_A)
        b1 = va > (float)(STAMP_THR_A) ? 30 : 10; b2 = vb > (float)(STAMP_THR_B) ? 30 : 10;
#endif
        const int t_ = opq_tid(F.wave);
        for (int i = t_; i < 1000; i += NTHR) A.out[1000 + i] += 20.0f * (float)b2;
        if (t_ == 0) A.out[0] = 200.0f * (float)b1; }
#endif
#if defined(CHECKS)
    xcd_barrier(bar);
    if (F.wg == 0 && F.tid == 0) { const unsigned* fl = chk_flags(ws); int id = 0; for (int i = 61; i >= 0; --i) if (fl[i]) id = i;
        if (((const unsigned*)(ws + WS_CTL))[XB_TMO]) id = 60;
        if (id) A.out[0] = 10.0f * (float)id;
#if defined(CHKVAL)
        A.out[0] = 1000.0f * ((const float*)fl)[CHKVAL];
#endif
        }
#endif
}

extern "C" void kernel_launch(void* const* d_in, const int* in_sizes, int n_in, void* d_out, int out_size, void* d_ws, size_t ws_size, hipStream_t stream) {
    static int grid = 0;
    if (grid == 0) {
        if (n_in != 26 || in_sizes[0] != NTOK * D || out_size != NTOK * D || ws_size < WS_END) {
            fprintf(stderr, "kernel_launch: unexpected shapes (n_in %d, in0 %d, out %d, ws %zu); nothing launched\n", n_in, n_in > 0 ? in_sizes[0] : -1, out_size, ws_size); grid = -1; return; }
        int dev = 0, cus = 0, per_cu = 0;
        if (hipGetDevice(&dev) != hipSuccess || hipDeviceGetAttribute(&cus, hipDeviceAttributeMultiprocessorCount, dev) != hipSuccess) { grid = -1; return; }
        if (hipFuncSetAttribute((const void*)hybrid_fwd, hipFuncAttributeMaxDynamicSharedMemorySize, LDS_BYTES) != hipSuccess) { fprintf(stderr, "kernel_launch: hipFuncSetAttribute failed\n"); grid = -1; return; }
        if (hipOccupancyMaxActiveBlocksPerMultiprocessor(&per_cu, (const void*)hybrid_fwd, NTHR, LDS_BYTES) != hipSuccess || per_cu < 1)
            fprintf(stderr, "kernel_launch: note: occupancy query reports %d workgroups per CU\n", per_cu);
        (void)hipGetLastError();
        grid = cus > 256 ? 256 : cus;
    }
    if (grid < 0) return;
    if (hipMemsetAsync((char*)d_ws + WS_CTL, 0, CTL_ZERO_BYTES, stream) != hipSuccess) return;
    Args a{};
    const float** p = (const float**)&a;
    for (int i = 0; i < 26; ++i) p[i] = (const float*)d_in[i];
    a.out = (float*)d_out; a.ws = (unsigned char*)d_ws;
    hipLaunchKernelGGL(hybrid_fwd, dim3(grid), dim3(NTHR), LDS_BYTES, stream, a);
}

#if defined(ONLY_P5)
__global__ void __launch_bounds__(NTHR, 2) only_p5(Args A_unused) {
    extern __shared__ __attribute__((aligned(16))) unsigned char lds_raw[];
    const CAS Args& A = *(const CAS Args*)__builtin_amdgcn_kernarg_segment_ptr();
    Frame F; F.lds = (LAS unsigned char*)lds_raw; F.wave = __builtin_amdgcn_readfirstlane((int)threadIdx.x >> 6); F.tid = opq_tid(F.wave); F.lane = F.tid & 63;
    F.wg = blockIdx.x; F.G = gridDim.x; F.gw = F.wg * NWAVES + F.wave; F.NGW = F.G * NWAVES;
    unsigned char* ws = A.ws; bf16* const dob = (bf16*)A.out;
    bf16 *R = dob, *KS = dob + (size_t)NTOK * BW, *V = dob + 2 * (size_t)NTOK * BW, *KK = dob + 3 * (size_t)NTOK * BW;
    p5_mfma(ws, F, R, KS, V, KK, (const bf16*)(ws + WS_B), (const bf16*)(ws + WS_E), (bf16*)(ws + WS_P), (bf16*)(ws + WS_QO), (bf16*)(ws + WS_GT), (bf16*)(ws + WS_HT));
}
#endif
```

```cpp
#include <hip/hip_runtime.h>
#include <cstdio>
#include <cstdint>
__device__ __forceinline__ int opq_tid(int wave) { int l; asm volatile("v_mbcnt_lo_u32_b32 %0, -1, 0\n\tv_mbcnt_hi_u32_b32 %0, -1, %0" : "=v"(l)); return wave * 64 + l; }
#ifndef PHMASK
#define PHMASK 0xffff
#endif
namespace pg8 {
#define PG8_LAS __attribute__((address_space(3)))
typedef unsigned short bf16_t;
typedef short bf16x8 __attribute__((ext_vector_type(8)));
typedef float f32x4 __attribute__((ext_vector_type(4)));
typedef unsigned u32x4 __attribute__((ext_vector_type(4)));
constexpr int BM = 256, BK = 64, HALF = 128, HTB = HALF * BK * 2  , STAGE_BYTES = 8 * HTB, NXCD = 8, WGM = 8;

__host__ __device__ __forceinline__ int lds_byte(int r, int c) { const int st = (r >> 4) * 2 + (c >> 5), rr = r & 15, cc = c & 31, ob = rr * 64 + cc * 2; return st * 1024 + (ob ^ (((ob >> 9) & 1) << 5)); }
__host__ __device__ __forceinline__ void stage_rc(int b, int& R, int& C) { const int st = b / 1024, sb = b % 1024, swz = sb ^ (((sb >> 9) & 1) << 5); R = (st >> 1) * 16 + swz / 64; C = (st & 1) * 32 + (swz % 64) / 2; }
__host__ __device__ __forceinline__ int perm32(int rho) { const int n = rho >> 4, i = rho & 15; return 8 * (i >> 2) + 4 * n + (i & 3); }

struct Unit { int pm, pn; };
struct Gemm { const bf16_t* A; const bf16_t* Bt; int M, N, K; };

struct StaticOrder {
    int nM, nN, nwg, G, c;
    __host__ __device__ void init(int M, int N, int G_, int c_) { nM = M / BM; nN = N / BM; nwg = nM * nN; G = G_; c = c_; }
    __host__ __device__ bool next(int i, Unit& u) const {
        const long L = (long)i * G + c; if (L >= nwg) return false;
        int wgid = (int)L; { const int q = nwg / NXCD, r = nwg % NXCD, xcd = wgid % NXCD, off = wgid / NXCD; wgid = (xcd < r ? xcd * (q + 1) : r * (q + 1) + (xcd - r) * q) + off; }
        const int nig = WGM * nN, gid = wgid / nig, fm = gid * WGM, gsz = (nM - fm) < WGM ? (nM - fm) : WGM;
        u.pm = fm + ((wgid % nig) % gsz); u.pn = (wgid % nig) / gsz; return true;
    }
    __device__ __forceinline__ void a_ready(const Unit&) const {}
    __device__ __forceinline__ void done(const Unit&) const {}
};

template <class Epi, class Sched, bool STAMP = false>
__device__ __forceinline__ void gemm_phase(PG8_LAS unsigned char* lds, const Gemm g, const Sched& S, const Epi& E, unsigned long long* stamps, int wave_id) {
    const int tid = opq_tid(wave_id), wid = __builtin_amdgcn_readfirstlane(tid >> 6), lane = tid & 63, wr = wid >> 2, wc = wid & 3, fr = lane & 15, fq = lane >> 4;
    const int K = g.K, nt = K / BK;
    int ts_lo = 0, ts_hi = 0, nts = 0; const unsigned long long rt_entry = STAMP ? (unsigned long long)wall_clock64() : 0ull;
#define PG8_STAMP() do { if (STAMP && wid == 0 && nts < 64) { const unsigned long long _c = (unsigned long long)clock64(); \
        ts_lo = (lane == nts) ? (int)(unsigned)_c : ts_lo; ts_hi = (lane == nts) ? (int)(unsigned)(_c >> 32) : ts_hi; ++nts; } } while (0)
    PG8_STAMP();
    unsigned voffA[2], voffB[2];
#pragma unroll
    for (int i = 0; i < 2; ++i) { int R, C; stage_rc(tid * 16 + i * 8192, R, C); const int Rb = Epi::PERM ? ((R & ~31) + perm32(R & 31)) : R;
        voffA[i] = (unsigned)(R * K + C) * 2u; voffB[i] = (unsigned)(Rb * K + C) * 2u; }
    const size_t kstep = (size_t)(BK * 2);
    const size_t hstep = (size_t)HALF * K * 2;
    const size_t tstep = 2 * hstep;
    const unsigned ldsw = (unsigned)wid * 1024u;
    const int aoff = lds_byte(wr * 64 + fr, fq * 8), boff = lds_byte(wc * 32 + fr, fq * 8);
#define PG8_SA(b, h) (((b) * 2 + (h)) * HTB)
#define PG8_SB(b, h) ((4 + (b) * 2 + (h)) * HTB)
#define PG8_STAGE(bufoff, gbase, voff) do { _Pragma("unroll") for (int _i = 0; _i < 2; ++_i) \
        __builtin_amdgcn_global_load_lds((const unsigned*)((const char*)(gbase) + (voff)[_i]), (PG8_LAS unsigned*)(lds + (bufoff) + ldsw + _i * 8192), 16, 0, 0); } while (0)
#define PG8_LDA(dst, b, h) do { _Pragma("unroll") for (int m = 0; m < 4; ++m) _Pragma("unroll") for (int k = 0; k < 2; ++k) dst[m][k] = *(const PG8_LAS bf16x8*)(lds + PG8_SA(b, h) + aoff + m * 2048 + k * 1024); } while (0)
#define PG8_LDB(dst, b, h) do { _Pragma("unroll") for (int n = 0; n < 2; ++n) _Pragma("unroll") for (int k = 0; k < 2; ++k) dst[n][k] = *(const PG8_LAS bf16x8*)(lds + PG8_SB(b, h) + boff + n * 2048 + k * 1024); } while (0)
#define PG8_MMA(ai, bj, At, Bt) do { __builtin_amdgcn_s_setprio(1); _Pragma("unroll") for (int m = 0; m < 4; ++m) _Pragma("unroll") for (int n = 0; n < 2; ++n) _Pragma("unroll") for (int k = 0; k < 2; ++k) \
        acc[ai][bj][m][n] = __builtin_amdgcn_mfma_f32_16x16x32_bf16(Bt[n][k], At[m][k], acc[ai][bj][m][n], 0, 0, 0); __builtin_amdgcn_s_setprio(0); } while (0)
#define PG8_WAIT_V(n) asm volatile("s_waitcnt vmcnt(" #n ")" ::: "memory")
#define PG8_WAIT_L(n) asm volatile("s_waitcnt lgkmcnt(" #n ")" ::: "memory")
#define PG8_BAR __builtin_amdgcn_s_barrier()
#define PG8_SCHED __builtin_amdgcn_sched_barrier(0)
    Unit cur, nxt; int ui = 0;
    if (!S.next(0, cur)) return;
    f32x4 acc[2][2][4][2];
#pragma unroll
    for (int a = 0; a < 2; ++a)
#pragma unroll
        for (int b = 0; b < 2; ++b)
#pragma unroll
            for (int m = 0; m < 4; ++m)
#pragma unroll
                for (int n = 0; n < 2; ++n) acc[a][b][m][n] = (f32x4){0.f, 0.f, 0.f, 0.f};
    bf16x8 At[4][2], B0[2][2], B1[2][2];
    const char* cA = (const char*)g.A + (size_t)cur.pm * tstep; const char* cB = (const char*)g.Bt + (size_t)cur.pn * tstep;
    S.a_ready(cur);
    PG8_STAGE(PG8_SB(0, 0), cB, voffB); PG8_STAGE(PG8_SA(0, 0), cA, voffA); PG8_STAGE(PG8_SB(0, 1), cB + hstep, voffB); PG8_STAGE(PG8_SA(0, 1), cA + hstep, voffA);
    if (wr == 1) PG8_BAR;
    PG8_WAIT_V(4); PG8_BAR;
    PG8_STAGE(PG8_SB(1, 0), cB + kstep, voffB); PG8_STAGE(PG8_SA(1, 0), cA + kstep, voffA); PG8_STAGE(PG8_SB(1, 1), cB + hstep + kstep, voffB);
    PG8_WAIT_V(6); PG8_BAR;
    PG8_STAMP();
    for (;;) {
        const bool has_next = S.next(ui + 1, nxt);
        const char* nA = has_next ? (const char*)g.A + (size_t)nxt.pm * tstep : cA; const char* nB = has_next ? (const char*)g.Bt + (size_t)nxt.pn * tstep : cB;
        for (int t = 0; t < nt; t += 2) {
            const bool last = (t == nt - 2);
            const char* a1 = cA + (size_t)(t + 1) * kstep;
            const char* a2 = last ? nA : cA + (size_t)(t + 2) * kstep; const char* b2 = last ? nB : cB + (size_t)(t + 2) * kstep;
            const char* a3 = a2 + kstep; const char* b3 = b2 + kstep;
            if (last && has_next) S.a_ready(nxt);
            PG8_LDB(B0, 0, 0); PG8_SCHED; PG8_LDA(At, 0, 0); PG8_STAGE(PG8_SA(1, 1), a1 + hstep, voffA);
            PG8_WAIT_L(8); PG8_BAR; PG8_WAIT_L(0); PG8_MMA(0, 0, At, B0); PG8_BAR; PG8_SCHED;
            PG8_LDB(B1, 0, 1); PG8_STAGE(PG8_SB(0, 0), b2, voffB);
            PG8_BAR; PG8_WAIT_L(0); PG8_MMA(0, 1, At, B1); PG8_BAR;
            PG8_LDA(At, 0, 1); PG8_STAGE(PG8_SA(0, 0), a2, voffA);
            PG8_BAR; PG8_WAIT_L(0); PG8_MMA(1, 0, At, B0); PG8_BAR; PG8_SCHED;
            PG8_STAGE(PG8_SB(0, 1), b2 + hstep, voffB);
            PG8_WAIT_V(6); PG8_BAR; PG8_MMA(1, 1, At, B1); PG8_BAR;
            PG8_LDB(B0, 1, 0); PG8_SCHED; PG8_LDA(At, 1, 0); PG8_STAGE(PG8_SA(0, 1), a2 + hstep, voffA);
            PG8_WAIT_L(8); PG8_BAR; PG8_WAIT_L(0); PG8_MMA(0, 0, At, B0); PG8_BAR; PG8_SCHED;
            PG8_LDB(B1, 1, 1); PG8_STAGE(PG8_SB(1, 0), b3, voffB);
            PG8_BAR; PG8_WAIT_L(0); PG8_MMA(0, 1, At, B1); PG8_BAR;
            PG8_LDA(At, 1, 1); PG8_STAGE(PG8_SA(1, 0), a3, voffA);
            PG8_BAR; PG8_WAIT_L(0); PG8_MMA(1, 0, At, B0); PG8_BAR; PG8_SCHED;
            PG8_STAGE(PG8_SB(1, 1), b3 + hstep, voffB);
            PG8_WAIT_V(6); PG8_BAR; PG8_MMA(1, 1, At, B1); PG8_BAR;
        }
        PG8_STAMP();
        if constexpr (!Epi::AFTER_DRAIN) { E(acc, cur, wr, wc, fr, fq); S.done(cur); }
        PG8_STAMP();
        if (!has_next) break;
#pragma unroll
        for (int a = 0; a < 2; ++a)
#pragma unroll
            for (int b = 0; b < 2; ++b)
#pragma unroll
                for (int m = 0; m < 4; ++m)
#pragma unroll
                    for (int n = 0; n < 2; ++n) acc[a][b][m][n] = (f32x4){0.f, 0.f, 0.f, 0.f};
        cur = nxt; cA = nA; cB = nB; ++ui;
    }
    PG8_WAIT_V(0);
    if (wr == 0) PG8_BAR;
    PG8_BAR;
    if constexpr (Epi::AFTER_DRAIN) { E.fused(acc, cur, wr, wc, fr, fq, lds, wid, lane); S.done(cur); }
    PG8_STAMP();
    if (STAMP && wid == 0) { stamps[lane] = lane < nts ? (((unsigned long long)(unsigned)ts_hi << 32) | (unsigned)ts_lo) : 0ull;
        if (lane == 62) stamps[62] = rt_entry; if (lane == 63) stamps[63] = (unsigned long long)wall_clock64(); }
#undef PG8_STAMP
#undef PG8_SA
#undef PG8_SB
#undef PG8_STAGE
#undef PG8_LDA
#undef PG8_LDB
#undef PG8_MMA
#undef PG8_WAIT_V
#undef PG8_WAIT_L
#undef PG8_BAR
#undef PG8_SCHED
}
}

#define XB_TMO      128
#define XB_XCNT(j)  (256  + 64 * (j))
#define XB_XSUB(j)  (1280 + 64 * (j))
#define XB_XGEN(j)  (2304 + 64 * (j))
#define XB_TOP      3328
#define XB_TOPGEN   3392
#define XCD_BAR_WORDS 3456
#define XB_SPIN_CAP (1u << 18)
#define LAS __attribute__((address_space(3)))

__device__ __forceinline__ unsigned xb_ld(unsigned* p)              { return __hip_atomic_load(p, __ATOMIC_RELAXED, __HIP_MEMORY_SCOPE_AGENT); }
__device__ __forceinline__ unsigned xb_add(unsigned* p, unsigned v) { return __hip_atomic_fetch_add(p, v, __ATOMIC_RELAXED, __HIP_MEMORY_SCOPE_AGENT); }
__device__ __forceinline__ unsigned xb_xcc_id() { return (unsigned)__builtin_amdgcn_s_getreg((3 << 11) | 20) & 0xFu; }
#define XB_SPIN(cond, bar) do { unsigned _sp = 0; while (cond) { __builtin_amdgcn_s_sleep(1); \
    if ((++_sp & 255u) == 0u) { if (xb_ld(&(bar)[XB_TMO])) break; if (_sp > XB_SPIN_CAP) { atomicAdd(&(bar)[XB_TMO], 1u); break; } } } } while (0)

struct XcdBarrier {
    unsigned* bar; unsigned x; int wave;
    volatile LAS unsigned* st;
};

__device__ __forceinline__ bool xb_t0(int wave) { return wave == 0 && __builtin_amdgcn_mbcnt_hi(~0u, __builtin_amdgcn_mbcnt_lo(~0u, 0u)) == 0u; }
__device__ __forceinline__ XcdBarrier xcd_barrier_post(unsigned* bar, volatile LAS unsigned* st, int wave) {
    XcdBarrier b; b.bar = bar; b.x = xb_xcc_id(); b.st = st; b.wave = wave;
    if (xb_t0(wave)) (void)xb_add(&bar[XB_XCNT(b.x)], 1u);
    return b;
}
__device__ __forceinline__ void xcd_barrier_complete(unsigned* bar, unsigned x, unsigned& nloc, unsigned& nx) {
    const unsigned G = gridDim.x * gridDim.y * gridDim.z;
    unsigned sum, cnt, mine, sp = 0u;
    for (;;) {
        sum = 0u; cnt = 0u; mine = 0u;
#pragma unroll
        for (unsigned j = 0; j < 16; ++j) { const unsigned c = xb_ld(&bar[XB_XCNT(j)]); sum += c; cnt += (c > 0u) ? 1u : 0u; mine = (j == x) ? c : mine; }
        if (sum == G) break;
        __builtin_amdgcn_s_sleep(1);
        if ((++sp & 255u) == 0u) { if (xb_ld(&bar[XB_TMO])) break; if (sp > XB_SPIN_CAP) { atomicAdd(&bar[XB_TMO], 1u); break; } }
    }
    nloc = mine > 0u ? mine : 1u; nx = cnt > 0u ? cnt : 1u;
}

__device__ __forceinline__ void xcd_barrier(const XcdBarrier& b) {
    asm volatile("s_waitcnt vmcnt(0)" ::: "memory");
    __syncthreads();
    if (xb_t0(b.wave)) {
        unsigned* bar = b.bar;
        __builtin_amdgcn_s_waitcnt(0);
        unsigned nloc = b.st[0], nx = b.st[1];
        if (nloc == 0u) { xcd_barrier_complete(bar, b.x, nloc, nx); b.st[0] = nloc; b.st[1] = nx; }
        const unsigned old = xb_add(&bar[XB_XSUB(b.x)], 1u);
        const unsigned gen = old / nloc;
        if (old + 1u == (gen + 1u) * nloc) {
            __builtin_amdgcn_fence(__ATOMIC_RELEASE, "agent");
            asm volatile("s_waitcnt vmcnt(0)" ::: "memory");
            const unsigned og = xb_add(&bar[XB_TOP], 1u);
            const unsigned tg = og / nx;
            if (og + 1u == (tg + 1u) * nx) xb_add(&bar[XB_TOPGEN], 1u);
            else XB_SPIN(xb_ld(&bar[XB_TOPGEN]) == tg, bar);
            __builtin_amdgcn_fence(__ATOMIC_ACQUIRE, "agent");
            xb_add(&bar[XB_XGEN(b.x)], 1u);
            asm volatile("s_waitcnt vmcnt(0)" ::: "memory");
        } else {
            XB_SPIN(xb_ld(&bar[XB_XGEN(b.x)]) == gen, bar);
            __builtin_amdgcn_fence(__ATOMIC_ACQUIRE, "agent");
            asm volatile("s_waitcnt vmcnt(0)" ::: "memory");
        }
    }
    __syncthreads();
}


constexpr int NB = 4, SEQ = 8192, D = 1024, NTOK = NB * SEQ;
constexpr int NH = 8, HD = 64, BW = 512;
constexpr int IN_COLS = 5408, NPAD = 5632;
constexpr int LK = 384;
constexpr int NE = 32, DE = 512;
constexpr int CH = 64, NCH = SEQ / CH, NCH_LOG = 7, NCHUNK = NB * NH * NCH;
constexpr int MAXT = 288;
constexpr float NORM_EPS = 1e-6f, GN_EPS = 64e-5f, L2_EPS = 1e-12f;
constexpr float SB_STOP = -120.0f;

constexpr size_t MiB = 1u << 20;
constexpr size_t WS_CTL = 0, CTL_ZERO_BYTES = 65536;
constexpr size_t WS_MOD = 1 * MiB;
constexpr size_t WS_RTW = WS_MOD + 128 * 1024;
constexpr size_t WS_TOK = WS_RTW + 160 * 1024;
constexpr size_t WS_CNT = WS_TOK + (size_t)NTOK * 16;
constexpr size_t WS_TILE = WS_CNT + 256 * 32 * 4;
constexpr size_t WS_WIN = 2 * MiB;
constexpr size_t WS_WOSB = 13 * MiB, WS_WORW = 14 * MiB, WS_WOUT = 15 * MiB;
constexpr size_t WS_WL = 17 * MiB;
constexpr size_t WS_BON = 18 * MiB + 256 * 1024;
constexpr size_t WS_CW = 19 * MiB + 768 * 1024;
constexpr size_t WS_QB = 20 * MiB;
constexpr size_t WS_GATE = 52 * MiB;
constexpr size_t WS_GG = 180 * MiB;
constexpr size_t WS_KB = 212 * MiB, WS_VT = 244 * MiB;
constexpr size_t WS_LORA = 276 * MiB;
constexpr size_t WS_ALORA = 308 * MiB;
constexpr size_t WS_E = 340 * MiB, WS_B = 372 * MiB;
constexpr size_t WS_RWRAW = 416 * MiB;
constexpr size_t WS_P = 212 * MiB, WS_QO = 244 * MiB;
constexpr size_t WS_GT = 276 * MiB;
constexpr size_t WS_HT = 308 * MiB;
constexpr size_t WS_SC = 340 * MiB;
constexpr size_t WS_YRW = 384 * MiB;
constexpr size_t WS_WUP = 416 * MiB, WS_WDN = 480 * MiB;
constexpr size_t WS_MRG = 212 * MiB;
constexpr size_t WS_Y1 = 276 * MiB;
constexpr size_t WS_H2 = 52 * MiB;
constexpr size_t WS_HS = 116 * MiB;
constexpr size_t WS_HID = 260 * MiB;
constexpr size_t WS_X1 = 340 * MiB;
constexpr size_t WS_END = 512 * MiB;
static_assert(WS_TILE + (MAXT + 1) * 4 <= WS_WIN && WS_WIN + (size_t)NPAD * D * 2 <= WS_WOSB && WS_WL + 1536 * LK * 2 <= WS_QB, "fixed region");
static_assert(WS_HS + (size_t)MAXT * 256 * D * 2 <= WS_HID && WS_HID + (size_t)MAXT * 256 * DE * 2 <= WS_WUP, "moe region");
static_assert(WS_ALORA + (size_t)NTOK * LK * 2 <= WS_E && WS_B + (size_t)NTOK * BW * 2 <= WS_RWRAW, "rwkv region");

constexpr int LDS_BYTES = 163840;
constexpr int LDS_MISC = LDS_BYTES - 256;
constexpr int NWAVES = 8, NTHR = 512;

typedef unsigned short bf16;
typedef short bf16x8 __attribute__((ext_vector_type(8)));
typedef short s16x4 __attribute__((ext_vector_type(4)));
typedef float f32x4 __attribute__((ext_vector_type(4)));
typedef float f32x16 __attribute__((ext_vector_type(16)));
typedef unsigned u32x4 __attribute__((ext_vector_type(4)));
typedef unsigned u32x2 __attribute__((ext_vector_type(2)));
typedef int i32x4 __attribute__((ext_vector_type(4)));
#define DI __device__ __forceinline__
#define GAS __attribute__((address_space(1)))
#define MFMA32(a, b, c) __builtin_amdgcn_mfma_f32_32x32x16_bf16((a), (b), (c), 0, 0, 0)

typedef float f32x2_t __attribute__((ext_vector_type(2))); typedef __bf16 bf16x2_t __attribute__((ext_vector_type(2)));
DI unsigned pk2(float lo, float hi) { f32x2_t v = {lo, hi}; return __builtin_bit_cast(unsigned, __builtin_convertvector(v, bf16x2_t)); }
DI unsigned f2bf(float f) { return pk2(f, 0.0f) & 0xffffu; }
DI float bflo(unsigned u) { return __builtin_bit_cast(float, u << 16); }
DI float bfhi(unsigned u) { return __builtin_bit_cast(float, u & 0xffff0000u); }
DI float bf2f(bf16 h) { return __builtin_bit_cast(float, (unsigned)h << 16); }
DI float fexp(float x) { return __expf(x); }
DI float frcp(float x) { return __builtin_amdgcn_rcpf(x); }
DI float fsigmoid(float x) { return frcp(1.0f + fexp(-x)); }
DI float fsoftplus(float x) { return fmaxf(x, 0.0f) + __logf(1.0f + fexp(-fabsf(x))); }
#define DPP_SHR(v, ctrl) __builtin_bit_cast(float, __builtin_amdgcn_update_dpp(0, __builtin_bit_cast(int, (v)), (ctrl), 0xf, 0xf, true))
DI float wave_sum(float v) {
    v += DPP_SHR(v, 0x111); v += DPP_SHR(v, 0x112); v += DPP_SHR(v, 0x114); v += DPP_SHR(v, 0x118);
    v += __builtin_bit_cast(float, __builtin_amdgcn_update_dpp(0, __builtin_bit_cast(int, v), 0x142, 0xa, 0xf, false));
    v += __builtin_bit_cast(float, __builtin_amdgcn_update_dpp(0, __builtin_bit_cast(int, v), 0x143, 0xc, 0xf, false));
    return __builtin_bit_cast(float, __builtin_amdgcn_readlane(__builtin_bit_cast(int, v), 63));
}
DI float shfl_xor_l(float v, int m, int lane) { return __builtin_bit_cast(float, __builtin_amdgcn_ds_bpermute(4 * (lane ^ m), __builtin_bit_cast(int, v))); }
DI int crow(int reg, int hh) { return (reg & 3) + 8 * (reg >> 2) + 4 * hh; }
DI void wave_lds_fence() { __builtin_amdgcn_fence(__ATOMIC_RELEASE, "wavefront"); __builtin_amdgcn_wave_barrier(); __builtin_amdgcn_fence(__ATOMIC_ACQUIRE, "wavefront"); }
DI void unpack8(const u32x4 v, float (&o)[8]) { o[0] = bflo(v.x); o[1] = bfhi(v.x); o[2] = bflo(v.y); o[3] = bfhi(v.y); o[4] = bflo(v.z); o[5] = bfhi(v.z); o[6] = bflo(v.w); o[7] = bfhi(v.w); }
DI u32x4 pack8(const float (&o)[8]) { u32x4 v; v.x = pk2(o[0], o[1]); v.y = pk2(o[2], o[3]); v.z = pk2(o[4], o[5]); v.w = pk2(o[6], o[7]); return v; }
DI bf16x8 pack8v(float a0, float a1, float a2, float a3, float a4, float a5, float a6, float a7) {
    u32x4 v; v.x = pk2(a0, a1); v.y = pk2(a2, a3); v.z = pk2(a4, a5); v.w = pk2(a6, a7); return __builtin_bit_cast(bf16x8, v); }


#if defined(CHECKS)
constexpr int DBG_TOKEN = 77;
#endif

typedef pg8::f32x4 af4;
DI void st8(bf16* p, const af4 v0, const af4 v1) { u32x4 w; w.x = pk2(v0[0], v0[1]); w.y = pk2(v0[2], v0[3]); w.z = pk2(v1[0], v1[1]); w.w = pk2(v1[2], v1[3]); *(u32x4*)p = w; }

struct EpiIn {
    static constexpr bool PERM = true, AFTER_DRAIN = false;
    bf16 *Q, *K, *Vt, *RW, *LO, *GA; const float* gate_bias;
    DI void operator()(const af4 (&acc)[2][2][4][2], const pg8::Unit& u, int wr, int wc, int fr, int fq) const {
        const int pn = u.pn, row0 = u.pm * 256 + wr * 64 + fr;
        if (pn == 4 || pn == 5) {
#pragma unroll
            for (int ai = 0; ai < 2; ++ai)
#pragma unroll
                for (int m = 0; m < 4; ++m) { const int row = row0 + ai * 128 + m * 16, b = row >> 13, s = row & (SEQ - 1);
#pragma unroll
                    for (int bj = 0; bj < 2; ++bj)
#pragma unroll
                        for (int n = 0; n < 2; ++n)
#pragma unroll
                            for (int j = 0; j < 4; ++j) { const int cv = (pn - 4) * 256 + bj * 128 + wc * 32 + 8 * fq + 4 * n + j;
                                Vt[((size_t)(b * BW + cv)) * SEQ + s] = (bf16)f2bf(acc[ai][bj][m][n][j]); } }
        } else if (pn >= 14) {
            const int col0 = (pn - 14) * 256 + wc * 32 + 8 * fq;
            af4 bv[2][2];
#pragma unroll
            for (int bj = 0; bj < 2; ++bj)
#pragma unroll
                for (int n = 0; n < 2; ++n) bv[bj][n] = *(const af4*)(gate_bias + col0 + bj * 128 + 4 * n);
#pragma unroll
            for (int ai = 0; ai < 2; ++ai)
#pragma unroll
                for (int m = 0; m < 4; ++m) { bf16* rowp = GA + (size_t)(row0 + ai * 128 + m * 16) * 2048 + col0;
#pragma unroll
                    for (int bj = 0; bj < 2; ++bj) { af4 v0 = acc[ai][bj][m][0] + bv[bj][0], v1 = acc[ai][bj][m][1] + bv[bj][1];
#pragma unroll
                        for (int j = 0; j < 4; ++j) { v0[j] = fsigmoid(v0[j]); v1[j] = fsigmoid(v1[j]); }
                        st8(rowp + bj * 128, v0, v1); } }
        } else {
            bf16* base; int ld, ct; float sc = 1.0f;
            if (pn < 2) { base = Q; ld = BW; ct = pn; sc = 0.125f; } else if (pn < 4) { base = K; ld = BW; ct = pn - 2; } else if (pn < 12) { base = RW; ld = 1536; ct = pn - 6; } else { base = LO; ld = BW; ct = pn - 12; }
            const int col0 = ct * 256 + wc * 32 + 8 * fq;
#pragma unroll
            for (int ai = 0; ai < 2; ++ai)
#pragma unroll
                for (int m = 0; m < 4; ++m) { bf16* rowp = base + (size_t)(row0 + ai * 128 + m * 16) * ld + col0;
#pragma unroll
                    for (int bj = 0; bj < 2; ++bj) st8(rowp + bj * 128, acc[ai][bj][m][0] * sc, acc[ai][bj][m][1] * sc); }
        }
    }
};

template <bool ADD> struct EpiMerge {
    static constexpr bool PERM = true, AFTER_DRAIN = false;
    bf16* GA; bf16* MRG; int gofs;
    DI void operator()(const af4 (&acc)[2][2][4][2], const pg8::Unit& u, int wr, int wc, int fr, int fq) const {
        const int row0 = u.pm * 256 + wr * 64 + fr, col0 = u.pn * 256 + wc * 32 + 8 * fq;
#pragma unroll
        for (int ai = 0; ai < 2; ++ai)
#pragma unroll
            for (int m = 0; m < 4; ++m) { const size_t row = (size_t)(row0 + ai * 128 + m * 16);
#pragma unroll
                for (int bj = 0; bj < 2; ++bj) { const int c = col0 + bj * 128;
                    float g[8]; unpack8(*(const u32x4*)(GA + row * 2048 + gofs + c), g);
                    af4 v0, v1;
#pragma unroll
                    for (int j = 0; j < 4; ++j) { v0[j] = g[j] * acc[ai][bj][m][0][j]; v1[j] = g[4 + j] * acc[ai][bj][m][1][j]; }
                    if (ADD) { float o[8]; unpack8(*(const u32x4*)(GA + row * 2048 + c), o);
#pragma unroll
                        for (int j = 0; j < 4; ++j) { v0[j] += o[j]; v1[j] += o[4 + j]; }
                        st8(MRG + row * D + c, v0, v1); }
                    else st8(GA + row * 2048 + c, v0, v1); } }
    }
};

struct EpiPlain {
    static constexpr bool PERM = true, AFTER_DRAIN = false;
    bf16* O; int ld, cmask;
    DI void operator()(const af4 (&acc)[2][2][4][2], const pg8::Unit& u, int wr, int wc, int fr, int fq) const {
        const int row0 = u.pm * 256 + wr * 64 + fr, col0 = (u.pn & cmask) * 256 + wc * 32 + 8 * fq;
#pragma unroll
        for (int ai = 0; ai < 2; ++ai)
#pragma unroll
            for (int m = 0; m < 4; ++m) { bf16* rowp = O + (size_t)(row0 + ai * 128 + m * 16) * ld + col0;
#pragma unroll
                for (int bj = 0; bj < 2; ++bj) st8(rowp + bj * 128, acc[ai][bj][m][0], acc[ai][bj][m][1]); }
    }
};

struct EpiUp {
    static constexpr bool PERM = true, AFTER_DRAIN = false;
    bf16* HID;
    DI void operator()(const af4 (&acc)[2][2][4][2], const pg8::Unit& u, int wr, int wc, int fr, int fq) const {
        const int row0 = u.pm * 256 + wr * 64 + fr, col0 = (u.pn & 3) * 128 + wc * 16 + 4 * fq;
#pragma unroll
        for (int ai = 0; ai < 2; ++ai)
#pragma unroll
            for (int m = 0; m < 4; ++m) { bf16* rowp = HID + (size_t)(row0 + ai * 128 + m * 16) * DE + col0;
#pragma unroll
                for (int bj = 0; bj < 2; ++bj) { float h[4];
#pragma unroll
                    for (int j = 0; j < 4; ++j) { const float u1 = acc[ai][bj][m][0][j]; h[j] = u1 * fsigmoid(u1) * acc[ai][bj][m][1][j]; }
                    __hip_atomic_store((GAS unsigned long long*)(rowp + bj * 64), (unsigned long long)pk2(h[0], h[1]) | ((unsigned long long)pk2(h[2], h[3]) << 32), __ATOMIC_RELAXED, __HIP_MEMORY_SCOPE_AGENT); } }
    }
};

constexpr unsigned MOE_CNT_WORD = 3584, MOE_CNT_STRIDE = 16;
struct MoeUpOrder {
    int nunits, G, vc; const int* tile_e; unsigned* cnt;
    DI bool next(int i, pg8::Unit& u) const { const long L = (long)i * G + vc; if (L >= nunits) return false; const int rt = (int)(L >> 2);
        u.pm = rt; u.pn = __builtin_amdgcn_readfirstlane(tile_e[rt]) * 4 + (int)(L & 3); return true; }
    DI void a_ready(const pg8::Unit&) const {}
    DI void done(const pg8::Unit& u) const { asm volatile("s_waitcnt vmcnt(0)" ::: "memory");
        if (__builtin_amdgcn_mbcnt_hi(~0u, __builtin_amdgcn_mbcnt_lo(~0u, 0u)) == 0u) __hip_atomic_fetch_add(cnt + MOE_CNT_STRIDE * u.pm, 1u, __ATOMIC_RELAXED, __HIP_MEMORY_SCOPE_AGENT); }
};
struct MoeDnOrder {
    int nunits, G, vc, q, rem, wave; const int* tile_e; unsigned* cnt;
    DI bool next(int i, pg8::Unit& u) const { long L;
        if (vc >= rem) { if (i > q) return false; L = (long)i * (G - rem) + (vc - rem); } else L = (long)(q + 1) * (G - rem) + (long)i * rem + vc;
        if (L >= nunits) return false; const int rt = (int)(L >> 2);
        u.pm = rt; u.pn = __builtin_amdgcn_readfirstlane(tile_e[rt]) * 4 + (int)(L & 3); return true; }
    DI void a_ready(const pg8::Unit& u) const {
        if (wave == 0) { unsigned sp = 0;
            while ((unsigned)__builtin_amdgcn_readfirstlane(__hip_atomic_load(cnt + MOE_CNT_STRIDE * u.pm, __ATOMIC_RELAXED, __HIP_MEMORY_SCOPE_AGENT)) < 32u) { __builtin_amdgcn_s_sleep(2); if (++sp > (1u << 22)) break; }
            __builtin_amdgcn_fence(__ATOMIC_ACQUIRE, "agent");
            asm volatile("s_waitcnt vmcnt(0)" ::: "memory"); }
        asm volatile("" ::: "memory"); __builtin_amdgcn_s_barrier(); asm volatile("" ::: "memory"); }
    DI void done(const pg8::Unit&) const {}
};

struct Args {
    const float *x, *c, *w_mod, *b_mod, *gains, *w_in, *gate_bias, *shift_mu, *w0, *w_decay_up, *a0, *w_iclr_up, *w_gate_up, *k_k, *k_a, *r_k, *lnx_w, *lnx_b,
                *w_o_sb, *w_o_rw, *w_out, *w_group, *w_router, *w_up1, *w_up3, *w_down;
    float* out; unsigned char* ws;
};
struct Frame { LAS unsigned char* lds; int tid, lane, wave, wg, G, gw, NGW; };
#define CAS __attribute__((address_space(4)))
#if defined(TIMEPHASE)
#ifndef TIMEPHASE_END
#define TIMEPHASE_END (TIMEPHASE + 1)
#endif
DI void tp_stamp(LAS unsigned char* lds, int wave, int k) {
    if (k == TIMEPHASE || k == TIMEPHASE_END) { volatile LAS unsigned long long* tp_ = (volatile LAS unsigned long long*)(lds + LDS_MISC + 64);
        if (xb_t0(wave)) { const unsigned long long now_ = __builtin_amdgcn_s_memrealtime();
            if (k == TIMEPHASE) *tp_ = now_; else { const unsigned long long until_ = now_ + (now_ - *tp_); while (__builtin_amdgcn_s_memrealtime() < until_) __builtin_amdgcn_s_sleep(8); } }
        if (k == TIMEPHASE_END) __syncthreads(); } }
#define TPS(F, k) tp_stamp((F).lds, (F).wave, (k))
#else
#define TPS(F, k) do { } while (0)
#endif
typedef const CAS Args& ARef;

DI void tr_item(const float* W, int ldw, int K, bf16* WT, int k0, int drow0, int scol0, LAS float* scr, int lane) {
    if (scol0 >= 0) {
        float v[32];
        const float* wp = W + (size_t)(k0 + (lane >> 5)) * ldw + scol0 + (lane & 31);
#pragma unroll
        for (int i = 0; i < 32; ++i) v[i] = wp[(size_t)(2 * i) * ldw];
#pragma unroll
        for (int i = 0; i < 32; ++i) scr[(2 * i + (lane >> 5)) * 33 + (lane & 31)] = v[i];
    } else {
#pragma unroll 8
        for (int i = 0; i < 32; ++i) { const int kk = 2 * i + (lane >> 5); scr[kk * 33 + (lane & 31)] = 0.0f; }
    }
    wave_lds_fence();
    const int c = lane & 7;
#pragma unroll
    for (int j = 0; j < 4; ++j) { const int n = (lane >> 3) + 8 * j; const LAS float* s = scr + (8 * c) * 33 + n;
        u32x4 o; o.x = pk2(s[0 * 33], s[1 * 33]); o.y = pk2(s[2 * 33], s[3 * 33]); o.z = pk2(s[4 * 33], s[5 * 33]); o.w = pk2(s[6 * 33], s[7 * 33]);
        *(u32x4*)(WT + (size_t)(drow0 + n) * K + k0 + 8 * c) = o; }
    wave_lds_fence();
}
DI void tr_item_up(const float* W1, const float* W3, bf16* WT, int e, int k0, int drow0, LAS float* scr, int lane) {
    const int l31 = lane & 31, sc = (drow0 >> 3) * 4 + (l31 >> 3) * 4 + (l31 & 3);
    const float* W = ((l31 & 4) ? W3 : W1) + (size_t)e * D * DE;
    { float v[32]; const float* wp = W + (size_t)(k0 + (lane >> 5)) * DE + sc;
#pragma unroll
        for (int i = 0; i < 32; ++i) v[i] = wp[(size_t)(2 * i) * DE];
#pragma unroll
        for (int i = 0; i < 32; ++i) scr[(2 * i + (lane >> 5)) * 33 + l31] = v[i]; }
    wave_lds_fence();
    const int c = lane & 7;
#pragma unroll
    for (int j = 0; j < 4; ++j) { const int n = (lane >> 3) + 8 * j; const LAS float* s = scr + (8 * c) * 33 + n;
        u32x4 o; o.x = pk2(s[0 * 33], s[1 * 33]); o.y = pk2(s[2 * 33], s[3 * 33]); o.z = pk2(s[4 * 33], s[5 * 33]); o.w = pk2(s[6 * 33], s[7 * 33]);
        *(u32x4*)(WT + ((size_t)e * 1024 + drow0 + n) * D + k0 + 8 * c) = o; }
    wave_lds_fence();
}

DI void p0_prologue(const Frame& F0, ARef A) {
    Frame F = F0; F.tid = opq_tid(F0.wave); F.lane = F.tid & 63; F.wave = __builtin_amdgcn_readfirstlane(F.tid >> 6); F.gw = F.wg * NWAVES + F.wave;
    unsigned char* ws = A.ws;
    LAS float* sl = (LAS float*)F.lds;
    LAS float* part = (LAS float*)(F.lds + 16384);
    for (int i = F.tid; i < NB * D; i += NTHR) { const float v = A.c[i]; sl[i] = v * fsigmoid(v); }
    __syncthreads();
    float* mod = (float*)(ws + WS_MOD);
    for (int cg = F.wg; cg < 256; cg += F.G) {
        const int col = F.tid & 31, kg = F.tid >> 5;
        if (col < 24) { float a0 = 0.f, a1 = 0.f, a2 = 0.f, a3 = 0.f;
#pragma unroll 8
            for (int kk = 0; kk < 64; ++kk) { const int k = kg * 64 + kk; const float w = A.w_mod[(size_t)k * 6144 + cg * 24 + col];
                a0 += sl[k] * w; a1 += sl[D + k] * w; a2 += sl[2 * D + k] * w; a3 += sl[3 * D + k] * w; }
            LAS float* p = part + (kg * 24 + col) * 4; p[0] = a0; p[1] = a1; p[2] = a2; p[3] = a3; }
        __syncthreads();
        if (F.tid < 96) { const int c = F.tid >> 2, b = F.tid & 3; float s = 0.f;
#pragma unroll
            for (int kg2 = 0; kg2 < 16; ++kg2) s += part[(kg2 * 24 + c) * 4 + b];
            mod[b * 6144 + cg * 24 + c] = s + A.b_mod[cg * 24 + c]; }
        __syncthreads();
    }
    LAS float* scr = (LAS float*)(F.lds + 32768 + F.wave * 8704);
    constexpr int I_IN = (NPAD / 32) * (D / 64), I_OS = (D / 32) * (BW / 64), I_OUT = (D / 32) * (D / 64);
    for (int it = F.gw; it < I_IN + 2 * I_OS + I_OUT; it += F.NGW) {
        int r = it;
        if (r < I_IN) { const int g = r / (D / 64), kb = r % (D / 64), drow0 = 32 * g;
            const int sc = drow0 < 3360 ? drow0 : (drow0 < 3584 ? -1 : drow0 - 224);
            tr_item(A.w_in, IN_COLS, D, (bf16*)(ws + WS_WIN), 64 * kb, drow0, sc, scr, F.lane); continue; }
        r -= I_IN;
        if (r < I_OS) { const int g = r / (BW / 64), kb = r % (BW / 64); tr_item(A.w_o_sb, D, BW, (bf16*)(ws + WS_WOSB), 64 * kb, 32 * g, 32 * g, scr, F.lane); continue; }
        r -= I_OS;
        if (r < I_OS) { const int g = r / (BW / 64), kb = r % (BW / 64); tr_item(A.w_o_rw, D, BW, (bf16*)(ws + WS_WORW), 64 * kb, 32 * g, 32 * g, scr, F.lane); continue; }
        r -= I_OS;
        { const int g = r / (D / 64), kb = r % (D / 64); tr_item(A.w_out, D, D, (bf16*)(ws + WS_WOUT), 64 * kb, 32 * g, 32 * g, scr, F.lane); }
    }
    const int gt = F.wg * NTHR + F.tid, NGT = F.G * NTHR;
    float* rtw = (float*)(ws + WS_RTW);
    for (int i = gt; i < 36 * D; i += NGT) { const int o = i >> 10, k = i & (D - 1); rtw[i] = o < 4 ? A.w_group[k * 4 + o] : A.w_router[k * NE + (o - 4)]; }
    bf16* wl = (bf16*)(ws + WS_WL);
    for (int i = gt; i < 1536 * LK; i += NGT) { const int n = i / LK, k = i % LK; float v = 0.f;
        if (n < 512) { if (k < 64) v = A.w_decay_up[k * BW + n]; }
        else if (n < 1024) { if (k >= 64 && k < 128) v = A.w_iclr_up[(k - 64) * BW + (n - 512)]; }
        else { if (k >= 128 && k < 288) v = A.w_gate_up[(k - 128) * BW + (n - 1024)]; }
        wl[i] = (bf16)f2bf(v); }
}

DI void p1_h1(const Frame& F0, ARef A, bf16* H1) {
    Frame F = F0; F.tid = opq_tid(F0.wave); F.lane = F.tid & 63; F.wave = __builtin_amdgcn_readfirstlane(F.tid >> 6); F.gw = F.wg * NWAVES + F.wave;
    const float* mod = (const float*)(A.ws + WS_MOD);
    for (int n = F.gw; n < NTOK; n += F.NGW) {
        const int b = n >> 13;
        const f32x4* xr = (const f32x4*)(A.x + (size_t)n * D) + F.lane;
        f32x4 v[4]; float s = 0.f;
#pragma unroll
        for (int j = 0; j < 4; ++j) { v[j] = xr[64 * j]; s += (v[j][0] * v[j][0] + v[j][1] * v[j][1]) + (v[j][2] * v[j][2] + v[j][3] * v[j][3]); }
        const float inv = rsqrtf(wave_sum(s) * (1.0f / D) + NORM_EPS);
        u32x2* o = (u32x2*)(H1 + (size_t)n * D) + F.lane;
#pragma unroll
        for (int j = 0; j < 4; ++j) { const int k = 4 * F.lane + 256 * j;
            const f32x4 g = *(const f32x4*)(A.gains + k), sh = *(const f32x4*)(mod + b * 6144 + k), sc = *(const f32x4*)(mod + b * 6144 + D + k);
            f32x4 h;
#pragma unroll
            for (int q = 0; q < 4; ++q) h[q] = (v[j][q] * inv) * g[q] * (1.0f + sc[q]) + sh[q];
            u32x2 w; w.x = pk2(h[0], h[1]); w.y = pk2(h[2], h[3]); o[64 * j] = w; }
    }
}

DI void p3_attn(const Frame& F0, const bf16* QB, const bf16* KB, const bf16* VT, bf16* YSB) {
    Frame F = F0; F.tid = opq_tid(F0.wave); F.lane = F.tid & 63; F.wave = __builtin_amdgcn_readfirstlane(F.tid >> 6); F.gw = F.wg * NWAVES + F.wave;
    const int lane = F.lane, r = lane & 31, hh = lane >> 5;
    bf16x8 tri[2];
#pragma unroll
    for (int s = 0; s < 2; ++s)
#pragma unroll
        for (int e = 0; e < 8; ++e) tri[s][e] = (16 * s + 8 * (e >> 2) + 4 * hh + (e & 3)) > r ? (short)0x3F80 : (short)0;
    for (int u = F.gw; u < NB * NH * (SEQ / 32); u += F.NGW) {
        const int qt = u & 255, b = u >> 11, h = ((u >> 8) + 2 * b) & 7, bh = b * 8 + h;
        const bf16* qp = QB + (size_t)(b * SEQ + qt * 32 + r) * BW + h * HD + 8 * hh;
        bf16x8 qf[4];
#pragma unroll
        for (int ks = 0; ks < 4; ++ks) qf[ks] = *(const bf16x8*)(qp + 16 * ks);
        f32x16 o0, o1;
#pragma unroll
        for (int i = 0; i < 16; ++i) { o0[i] = 0.f; o1[i] = 0.f; }
        float L = 0.f;
        bf16x8 kf[4]; s16x4 vlo[2][2], vhi[2][2];
#define ATT_LOAD(KT, KF, VLO, VHI) do { const bf16* kp_ = KB + (size_t)(b * SEQ + (KT) * 32 + r) * BW + h * HD + 8 * hh; \
            _Pragma("unroll") for (int ks = 0; ks < 4; ++ks) KF[ks] = *(const bf16x8*)(kp_ + 16 * ks); \
            const bf16* vp_ = VT + ((size_t)(bh * HD + r)) * SEQ + (KT) * 32 + 4 * hh; \
            _Pragma("unroll") for (int mb = 0; mb < 2; ++mb) _Pragma("unroll") for (int ks = 0; ks < 2; ++ks) { VLO[mb][ks] = *(const s16x4*)(vp_ + (size_t)mb * 32 * SEQ + 16 * ks); VHI[mb][ks] = *(const s16x4*)(vp_ + (size_t)mb * 32 * SEQ + 16 * ks + 8); } } while (0)
        ATT_LOAD(qt, kf, vlo, vhi);
        for (int kt = qt; kt >= 0; --kt) {
            bf16x8 kfn[4]; s16x4 vlon[2][2], vhin[2][2];
            { const int ktn = kt > 0 ? kt - 1 : 0; ATT_LOAD(ktn, kfn, vlon, vhin); }
            f32x16 z;
#pragma unroll
            for (int i = 0; i < 16; ++i) z[i] = 0.f;
#pragma unroll
            for (int ks = 0; ks < 4; ++ks) z = MFMA32(kf[ks], qf[ks], z);
            const bool diag = (kt == qt);
            float lk[16], lo[16], tot = 0.f;
#pragma unroll
            for (int i = 0; i < 16; ++i) { const bool valid = !diag || (crow(i, hh) < r);
                const float sp = fsoftplus(z[i]); lk[i] = valid ? -sp : 0.0f; z[i] = valid ? z[i] - sp : -1.0e30f;
                tot += lk[i];
                const float hi = bflo(f2bf(lk[i])); lo[i] = lk[i] - hi; lk[i] = hi; }
            tot += shfl_xor_l(tot, 32, lane);
            f32x16 lat;
#pragma unroll
            for (int i = 0; i < 16; ++i) lat[i] = L;
#pragma unroll
            for (int s = 0; s < 2; ++s) {
                lat = MFMA32(tri[s], pack8v(lk[8 * s], lk[8 * s + 1], lk[8 * s + 2], lk[8 * s + 3], lk[8 * s + 4], lk[8 * s + 5], lk[8 * s + 6], lk[8 * s + 7]), lat);
                lat = MFMA32(tri[s], pack8v(lo[8 * s], lo[8 * s + 1], lo[8 * s + 2], lo[8 * s + 3], lo[8 * s + 4], lo[8 * s + 5], lo[8 * s + 6], lo[8 * s + 7]), lat); }
            float at[16];
#pragma unroll
            for (int i = 0; i < 16; ++i) at[i] = fexp(z[i] + lat[i]);
#pragma unroll
            for (int s = 0; s < 2; ++s) { const bf16x8 ab = pack8v(at[8 * s], at[8 * s + 1], at[8 * s + 2], at[8 * s + 3], at[8 * s + 4], at[8 * s + 5], at[8 * s + 6], at[8 * s + 7]);
                bf16x8 va, vb;
#pragma unroll
                for (int e = 0; e < 4; ++e) { va[e] = vlo[0][s][e]; va[4 + e] = vhi[0][s][e]; vb[e] = vlo[1][s][e]; vb[4 + e] = vhi[1][s][e]; }
                o0 = MFMA32(va, ab, o0); o1 = MFMA32(vb, ab, o1); }
            L += tot;
            if (__all(L < SB_STOP)) break;
#pragma unroll
            for (int ks = 0; ks < 4; ++ks) kf[ks] = kfn[ks];
#pragma unroll
            for (int mb = 0; mb < 2; ++mb)
#pragma unroll
                for (int ks = 0; ks < 2; ++ks) { vlo[mb][ks] = vlon[mb][ks]; vhi[mb][ks] = vhin[mb][ks]; }
        }
#undef ATT_LOAD
        bf16* op = YSB + (size_t)(b * SEQ + qt * 32 + r) * BW + h * HD + 4 * hh;
#pragma unroll
        for (int g = 0; g < 4; ++g) { u32x2 w0, w1; w0.x = pk2(o0[4 * g], o0[4 * g + 1]); w0.y = pk2(o0[4 * g + 2], o0[4 * g + 3]); w1.x = pk2(o1[4 * g], o1[4 * g + 1]); w1.y = pk2(o1[4 * g + 2], o1[4 * g + 3]);
            *(u32x2*)(op + 8 * g) = w0; *(u32x2*)(op + 32 + 8 * g) = w1; }
    }
}

DI void p3_prep(const Frame& F0, ARef A, const bf16* RWRAW, const bf16* LORA, bf16* R, bf16* KS, bf16* V, bf16* KK, bf16* ALORA) {
    Frame F = F0; F.tid = opq_tid(F0.wave); F.lane = F.tid & 63; F.wave = __builtin_amdgcn_readfirstlane(F.tid >> 6); F.gw = F.wg * NWAVES + F.wave;
    const int lane = F.lane;
    f32x4 mu[3][2], kkc[2], mul[2];
#pragma unroll
    for (int part = 0; part < 3; ++part) { mu[part][0] = *(const f32x4*)(A.shift_mu + part * 512 + lane * 8); mu[part][1] = *(const f32x4*)(A.shift_mu + part * 512 + lane * 8 + 4); }
    kkc[0] = *(const f32x4*)(A.k_k + lane * 8); kkc[1] = *(const f32x4*)(A.k_k + lane * 8 + 4);
    const int lcol = lane < 36 ? lane * 8 : 0;
    mul[0] = *(const f32x4*)(A.shift_mu + 1536 + lcol); mul[1] = *(const f32x4*)(A.shift_mu + 1536 + lcol + 4);
    constexpr int RUN = 16;
    for (int run = F.gw; run < NTOK / RUN; run += F.NGW) {
        const int n0 = run * RUN;
        u32x4 prv[3], prl, cur[3], cul;
        const u32x4 z4 = {0u, 0u, 0u, 0u};
        if ((n0 & (SEQ - 1)) == 0) { prv[0] = z4; prv[1] = z4; prv[2] = z4; prl = z4; }
        else {
#pragma unroll
            for (int part = 0; part < 3; ++part) prv[part] = *(const u32x4*)(RWRAW + (size_t)(n0 - 1) * 1536 + part * 512 + lane * 8);
            prl = *(const u32x4*)(LORA + (size_t)(n0 - 1) * BW + lcol); }
#pragma unroll
        for (int part = 0; part < 3; ++part) cur[part] = *(const u32x4*)(RWRAW + (size_t)n0 * 1536 + part * 512 + lane * 8);
        cul = *(const u32x4*)(LORA + (size_t)n0 * BW + lcol);
        for (int i = 0; i < RUN; ++i) {
            const int n = n0 + i, nn = i + 1 < RUN ? n + 1 : n;
            u32x4 nxt[3], nxl;
#pragma unroll
            for (int part = 0; part < 3; ++part) nxt[part] = *(const u32x4*)(RWRAW + (size_t)nn * 1536 + part * 512 + lane * 8);
            nxl = *(const u32x4*)(LORA + (size_t)nn * BW + lcol);
            float xs[3][8];
#pragma unroll
            for (int part = 0; part < 3; ++part) { float p[8], q[8]; unpack8(cur[part], p); unpack8(prv[part], q);
#pragma unroll
                for (int j = 0; j < 4; ++j) { xs[part][j] = p[j] + mu[part][0][j] * (q[j] - p[j]); xs[part][4 + j] = p[4 + j] + mu[part][1][j] * (q[4 + j] - p[4 + j]); } }
            const size_t off = (size_t)n * BW + lane * 8;
            *(u32x4*)(R + off) = pack8(xs[0]); *(u32x4*)(KS + off) = pack8(xs[1]); *(u32x4*)(V + off) = pack8(xs[2]);
            float kk[8], ss = 0.f;
#pragma unroll
            for (int j = 0; j < 4; ++j) { kk[j] = xs[1][j] * kkc[0][j]; kk[4 + j] = xs[1][4 + j] * kkc[1][j]; }
#pragma unroll
            for (int j = 0; j < 8; ++j) ss += kk[j] * kk[j];
            ss += shfl_xor_l(ss, 1, lane); ss += shfl_xor_l(ss, 2, lane); ss += shfl_xor_l(ss, 4, lane);
            const float rn = 1.0f / fmaxf(sqrtf(ss), L2_EPS);
#pragma unroll
            for (int j = 0; j < 8; ++j) kk[j] *= rn;
            *(u32x4*)(KK + off) = pack8(kk);
            if (lane < 48) { float a[8];
                if (lane < 36) { float p[8], q[8]; unpack8(cul, p); unpack8(prl, q);
#pragma unroll
                    for (int j = 0; j < 8; ++j) { const float m = j < 4 ? mul[0][j & 3] : mul[1][j & 3]; const float v = p[j] + m * (q[j] - p[j]);
                        a[j] = lane < 8 ? (1.0f - 2.0f * frcp(fexp(2.0f * v) + 1.0f)) : (lane < 16 ? v : fsigmoid(v)); }
                } else {
#pragma unroll
                    for (int j = 0; j < 8; ++j) a[j] = 0.f; }
                *(u32x4*)(ALORA + (size_t)n * LK + lane * 8) = pack8(a); }
#pragma unroll
            for (int part = 0; part < 3; ++part) { prv[part] = cur[part]; cur[part] = nxt[part]; }
            prl = cul; cul = nxl;
        }
    }
}

DI void p4_lora(const Frame& F0, ARef A, const bf16* ALORA, const bf16* WL, bf16* E, bf16* KS, bf16* Bo, bf16* GG, const bf16* KK, const bf16* R, float* BON) {
    Frame F = F0; F.tid = opq_tid(F0.wave); F.lane = F.tid & 63; F.wave = __builtin_amdgcn_readfirstlane(F.tid >> 6); F.gw = F.wg * NWAVES + F.wave;
    const int lane = F.lane, r = lane & 31, hh = lane >> 5;
    for (int u = F.gw; u < 2 * (NTOK / 32); u += F.NGW) {
        const int n0 = (u >> 1) * 32, par = u & 1;
        bf16x8 tf[18];
#pragma unroll
        for (int ks = 0; ks < 18; ++ks) tf[ks] = *(const bf16x8*)(ALORA + (size_t)(n0 + r) * LK + 16 * ks + 8 * hh);
        TPS(F, 40);
        const unsigned orow = (unsigned)(n0 + r) * BW + 4 * hh;
#define LORA_W(dst, KS0, NKS, CB) do { _Pragma("unroll") for (int ks = 0; ks < (NKS); ++ks) dst[ks] = *(const bf16x8*)(WL + (size_t)(32 * (CB) + r) * LK + 16 * ((KS0) + ks) + 8 * hh); } while (0)
#define LORA_MM(W, KS0, NKS) f32x16 acc_; do { _Pragma("unroll") for (int q = 0; q < 16; ++q) acc_[q] = 0.f; \
            _Pragma("unroll") for (int ks = 0; ks < (NKS); ++ks) acc_ = MFMA32(W[ks], tf[(KS0) + ks], acc_); } while (0)
#define LORA_CB(base, i) ((base) + 4 * ((i) >> 1) + 2 * par + ((i) & 1))
        {   bf16x8 wc[4], wn[4]; LORA_W(wc, 0, 4, LORA_CB(0, 0));
#pragma nounroll
            for (int i = 0; i < 8; ++i) { const int cb = LORA_CB(0, i), c0_ = 32 * (cb & 15); { const int in_ = i < 7 ? i + 1 : 7; LORA_W(wn, 0, 4, LORA_CB(0, in_)); }
                f32x4 w0v[4];
#pragma unroll
                for (int g = 0; g < 4; ++g) w0v[g] = *(const f32x4*)(A.w0 + c0_ + 8 * g + 4 * hh);
                LORA_MM(wc, 0, 4);
#pragma unroll
                for (int g = 0; g < 4; ++g) { float e4[4];
#pragma unroll
                    for (int j = 0; j < 4; ++j) { const float v = acc_[4 * g + j] + w0v[g][j]; e4[j] = fexp(-fsoftplus(-v) - 0.5f); }
                    u32x2 w; w.x = pk2(e4[0], e4[1]); w.y = pk2(e4[2], e4[3]); *(u32x2*)(E + orow + c0_ + 8 * g) = w; }
#pragma unroll
                for (int ks = 0; ks < 4; ++ks) wc[ks] = wn[ks]; } }
        TPS(F, 41);
        {   float bsum = 0.f; bf16x8 wc[4], wn[4]; LORA_W(wc, 4, 4, LORA_CB(16, 0));
#pragma nounroll
            for (int i = 0; i < 8; ++i) { const int cb = LORA_CB(16, i), c0_ = 32 * (cb & 15); { const int in_ = i < 7 ? i + 1 : 7; LORA_W(wn, 4, 4, LORA_CB(16, in_)); }
                f32x4 a0v[4], kav[4], rkv[4]; u32x2 kw[4], qw[4], rw[4];
#pragma unroll
                for (int g = 0; g < 4; ++g) { const unsigned o = orow + c0_ + 8 * g; kw[g] = *(const u32x2*)(KS + o); qw[g] = *(const u32x2*)(KK + o); rw[g] = *(const u32x2*)(R + o);
                    a0v[g] = *(const f32x4*)(A.a0 + c0_ + 8 * g + 4 * hh); kav[g] = *(const f32x4*)(A.k_a + c0_ + 8 * g + 4 * hh); rkv[g] = *(const f32x4*)(A.r_k + c0_ + 8 * g + 4 * hh); }
                LORA_MM(wc, 4, 4);
#pragma unroll
                for (int g = 0; g < 4; ++g) { const unsigned o = orow + c0_ + 8 * g;
                    float ksv[4], kkv[4], kp[4], bb[4]; ksv[0] = bflo(kw[g].x); ksv[1] = bfhi(kw[g].x); ksv[2] = bflo(kw[g].y); ksv[3] = bfhi(kw[g].y); kkv[0] = bflo(qw[g].x); kkv[1] = bfhi(qw[g].x); kkv[2] = bflo(qw[g].y); kkv[3] = bfhi(qw[g].y);
#pragma unroll
                    for (int j = 0; j < 4; ++j) { const float s0 = fsigmoid(acc_[4 * g + j] + a0v[g][j]); kp[j] = ksv[j] * (1.0f + (s0 - 1.0f) * kav[g][j]); bb[j] = kkv[j] * s0; }
                    bsum += (bflo(rw[g].x) * kp[0] * rkv[g][0] + bfhi(rw[g].x) * kp[1] * rkv[g][1]) + (bflo(rw[g].y) * kp[2] * rkv[g][2] + bfhi(rw[g].y) * kp[3] * rkv[g][3]);
                    u32x2 w1, w2; w1.x = pk2(kp[0], kp[1]); w1.y = pk2(kp[2], kp[3]); w2.x = pk2(bb[0], bb[1]); w2.y = pk2(bb[2], bb[3]); *(u32x2*)(KS + o) = w1; *(u32x2*)(Bo + o) = w2; }
                if (i & 1) { const float tot = bsum + shfl_xor_l(bsum, 32, lane); if (hh == 0) BON[(size_t)(n0 + r) * 8 + 2 * (i >> 1) + par] = tot; bsum = 0.f; }
#pragma unroll
                for (int ks = 0; ks < 4; ++ks) wc[ks] = wn[ks]; } }
        TPS(F, 42);
        {   bf16x8 wc[10], wn[10]; LORA_W(wc, 8, 10, LORA_CB(32, 0));
#pragma nounroll
            for (int i = 0; i < 8; ++i) { const int cb = LORA_CB(32, i), c0_ = 32 * (cb & 15); { const int in_ = i < 7 ? i + 1 : 7; LORA_W(wn, 8, 10, LORA_CB(32, in_)); }
                LORA_MM(wc, 8, 10);
#pragma unroll
                for (int g = 0; g < 4; ++g) { u32x2 w; w.x = pk2(acc_[4 * g], acc_[4 * g + 1]); w.y = pk2(acc_[4 * g + 2], acc_[4 * g + 3]); *(u32x2*)(GG + orow + c0_ + 8 * g) = w; }
#pragma unroll
                for (int ks = 0; ks < 10; ++ks) wc[ks] = wn[ks]; } }
        TPS(F, 43);
#undef LORA_W
#undef LORA_MM
#undef LORA_CB
    }
}

DI void p6_chain(int task, int wave, LAS unsigned char* ring, const bf16* GT, const bf16* HT, bf16* SC) {
    const int lane = opq_tid(wave) & 63;
    const int bh = task >> 1, nb = task & 1;
    constexpr int RD = 6, SLOT = 12288;
    f32x16 X[2];
#pragma unroll
    for (int q = 0; q < 16; ++q) { X[0][q] = 0.f; X[1][q] = 0.f; }
    const char* gsrc = (const char*)(GT + (size_t)bh * NCH * 4096) + lane * 16;
    const char* hsrc = (const char*)(HT + (size_t)bh * NCH * 4096) + nb * 2048 + lane * 16;
#define CHAIN_DMA(cc) do { LAS unsigned char* sl_ = ring + ((cc) % RD) * SLOT; const char* g_ = gsrc + (size_t)(cc) * 8192; const char* h_ = hsrc + (size_t)(cc) * 8192; \
        _Pragma("unroll") for (int f = 0; f < 8; ++f) __builtin_amdgcn_global_load_lds((const unsigned*)(g_ + f * 1024), (LAS unsigned*)(sl_ + f * 1024), 16, 0, 0); \
        _Pragma("unroll") for (int kb = 0; kb < 2; ++kb) _Pragma("unroll") for (int j = 0; j < 2; ++j) \
            __builtin_amdgcn_global_load_lds((const unsigned*)(h_ + kb * 4096 + j * 1024), (LAS unsigned*)(sl_ + 8192 + (kb * 2 + j) * 1024), 16, 0, 0); } while (0)
#define CHAIN_READ(cc, HS, GS) do { const LAS unsigned char* sl_ = ring + ((cc) % RD) * SLOT; \
        _Pragma("unroll") for (int f = 0; f < 8; ++f) GS[f] = *(const LAS bf16x8*)(sl_ + f * 1024 + lane * 16); \
        _Pragma("unroll") for (int kb = 0; kb < 2; ++kb) _Pragma("unroll") for (int g = 0; g < 4; ++g) { const u32x2 w_ = *(const LAS u32x2*)(sl_ + 8192 + kb * 2048 + (g * 64 + lane) * 8); \
            HS[kb][4 * g] = bflo(w_.x); HS[kb][4 * g + 1] = bfhi(w_.x); HS[kb][4 * g + 2] = bflo(w_.y); HS[kb][4 * g + 3] = bfhi(w_.y); } } while (0)
#define CHAIN_STORE(cc) do { bf16* sc_ = SC + ((size_t)bh * NCH + (cc)) * 4096; \
        _Pragma("unroll") for (int jb = 0; jb < 2; ++jb) _Pragma("unroll") for (int g = 0; g < 4; ++g) { u32x2 w_; w_.x = pk2(X[jb][4 * g], X[jb][4 * g + 1]); w_.y = pk2(X[jb][4 * g + 2], X[jb][4 * g + 3]); \
            *(u32x2*)(sc_ + ((((jb * 2 + nb) * 4 + g) * 64) + lane) * 4) = w_; } } while (0)
#define CHAIN_STEP(HS, GS) do { bf16x8 xb_[2][2]; \
        _Pragma("unroll") for (int jb = 0; jb < 2; ++jb) _Pragma("unroll") for (int s = 0; s < 2; ++s) \
            xb_[jb][s] = pack8v(X[jb][8 * s], X[jb][8 * s + 1], X[jb][8 * s + 2], X[jb][8 * s + 3], X[jb][8 * s + 4], X[jb][8 * s + 5], X[jb][8 * s + 6], X[jb][8 * s + 7]); \
        X[0] = HS[0]; X[1] = HS[1]; \
        _Pragma("unroll") for (int kb = 0; kb < 2; ++kb) _Pragma("unroll") for (int jb = 0; jb < 2; ++jb) _Pragma("unroll") for (int s = 0; s < 2; ++s) X[kb] = MFMA32(GS[kb * 4 + jb * 2 + s], xb_[jb][s], X[kb]); } while (0)
    for (int cc = 0; cc < RD; ++cc) CHAIN_DMA(cc);
    for (int c = 0; c < NCH - 1; ++c) {
        f32x16 Hc[2]; bf16x8 Gc[8];
        if (c + RD <= NCH - 1) asm volatile("s_waitcnt vmcnt(60)" ::: "memory"); else asm volatile("s_waitcnt vmcnt(0)" ::: "memory");
        CHAIN_READ(c, Hc, Gc);
        asm volatile("s_waitcnt lgkmcnt(0)" ::: "memory");
        if (c + RD < NCH - 1) CHAIN_DMA(c + RD);
        CHAIN_STORE(c);
        CHAIN_STEP(Hc, Gc);
    }
    CHAIN_STORE(NCH - 1);
    asm volatile("s_waitcnt vmcnt(0)" ::: "memory");
#undef CHAIN_DMA
#undef CHAIN_READ
#undef CHAIN_STORE
#undef CHAIN_STEP
}

DI void p6_moe_weights(const Frame& F0, ARef A, int wi, int NW) {
    Frame F = F0; F.tid = opq_tid(F0.wave); F.lane = F.tid & 63; F.wave = __builtin_amdgcn_readfirstlane(F.tid >> 6); F.gw = F.wg * NWAVES + F.wave;
    LAS float* scr = (LAS float*)(F.lds + F.wave * 20480);
    constexpr int I_UP = NE * 32 * 16, I_DN = NE * 32 * 8;
    for (int it = wi; it < I_UP + I_DN; it += NW) {
        if (it < I_UP) { const int e = it >> 9, g = (it >> 4) & 31, kb = it & 15; tr_item_up(A.w_up1, A.w_up3, (bf16*)(A.ws + WS_WUP), e, 64 * kb, 32 * g, scr, F.lane); }
        else { const int r = it - I_UP, e = r >> 8, g = (r >> 3) & 31, kb = r & 7;
            tr_item(A.w_down + (size_t)e * DE * D, D, DE, (bf16*)(A.ws + WS_WDN) + (size_t)e * 1024 * DE, 64 * kb, 32 * g, 32 * g, scr, F.lane); }
    }
}

DI float half_bcast_sum(float v, int hh) {
    v += DPP_SHR(v, 0x111); v += DPP_SHR(v, 0x112); v += DPP_SHR(v, 0x114); v += DPP_SHR(v, 0x118);
    v += __builtin_bit_cast(float, __builtin_amdgcn_update_dpp(0, __builtin_bit_cast(int, v), 0x142, 0xa, 0xf, false));
    const float lo = __builtin_bit_cast(float, __builtin_amdgcn_readlane(__builtin_bit_cast(int, v), 31)), hi = __builtin_bit_cast(float, __builtin_amdgcn_readlane(__builtin_bit_cast(int, v), 63));
    return hh ? hi : lo; }
DI void p7_mfma(const Frame& F0, ARef A, const bf16* SC, const bf16* Pn, const bf16* QOn, const bf16* V, const bf16* GG, const float* BON, bf16* YRW) {
    Frame F = F0; F.tid = opq_tid(F0.wave); F.lane = F.tid & 63; F.wave = __builtin_amdgcn_readfirstlane(F.tid >> 6); F.gw = F.wg * NWAVES + F.wave;
    const int lane = F.lane, r = lane & 31, hh = lane >> 5;
    for (int cid = F.gw; cid < NCHUNK; cid += F.NGW) {
        const int bh = cid >> NCH_LOG, c = cid & (NCH - 1), b = bh >> 3, h = bh & 7;
        const unsigned n0 = (unsigned)b * SEQ + (unsigned)c * CH; const int col0 = h * HD;
        const bf16* sc = SC + (size_t)cid * 4096; const bf16* pn = Pn + (size_t)cid * 4096; const bf16* qn = QOn + (size_t)cid * 4096;
        bf16x8 Sf[2][2][2], Pf[2][2][2];
#pragma unroll
        for (int jb = 0; jb < 2; ++jb)
#pragma unroll
            for (int xb = 0; xb < 2; ++xb)
#pragma unroll
                for (int s = 0; s < 2; ++s) { const s16x4 lo = *(const s16x4*)(sc + ((((jb * 2 + xb) * 4 + 2 * s) * 64) + lane) * 4), hi = *(const s16x4*)(sc + ((((jb * 2 + xb) * 4 + 2 * s + 1) * 64) + lane) * 4);
#pragma unroll
                    for (int e = 0; e < 4; ++e) { Sf[jb][xb][s][e] = lo[e]; Sf[jb][xb][s][4 + e] = hi[e]; }
                    Pf[jb][xb][s] = *(const bf16x8*)(pn + ((((jb * 2 + xb) * 2 + s) * 64) + lane) * 8); }
        f32x16 Z[2][2];
#pragma unroll
        for (int tb = 0; tb < 2; ++tb)
#pragma unroll
            for (int nb = 0; nb < 2; ++nb) {
#pragma unroll
                for (int g = 0; g < 4; ++g) { const u32x2 w = *(const u32x2*)(qn + ((((tb * 2 + nb) * 4 + g) * 64) + lane) * 4);
                    Z[tb][nb][4 * g] = bflo(w.x); Z[tb][nb][4 * g + 1] = bfhi(w.x); Z[tb][nb][4 * g + 2] = bflo(w.y); Z[tb][nb][4 * g + 3] = bfhi(w.y); }
#pragma unroll
                for (int jb = 0; jb < 2; ++jb)
#pragma unroll
                    for (int s = 0; s < 2; ++s) Z[tb][nb] = MFMA32(Pf[jb][tb][s], Sf[jb][nb][s], Z[tb][nb]); }
        typedef float f2_t __attribute__((ext_vector_type(2)));
        const f2_t lw = *(const f2_t*)(A.lnx_w + col0 + 2 * r), lb = *(const f2_t*)(A.lnx_b + col0 + 2 * r);
#pragma unroll
        for (int tb = 0; tb < 2; ++tb) {
            unsigned vv[16], gg[16]; float bon[16];
#pragma unroll
            for (int q = 0; q < 16; ++q) { const unsigned tokrow = n0 + 32 * tb + 4 * hh + (q & 3) + 8 * (q >> 2); const unsigned o0 = tokrow * BW + col0 + 2 * r;
                vv[q] = *(const unsigned*)(V + o0); gg[q] = *(const unsigned*)(GG + o0); bon[q] = BON[(size_t)tokrow * 8 + h]; }
#pragma unroll
            for (int q = 0; q < 16; ++q) {
                const unsigned tokrow = n0 + 32 * tb + 4 * hh + (q & 3) + 8 * (q >> 2); const unsigned o0 = tokrow * BW + col0 + 2 * r;
                const float mean = half_bcast_sum(Z[tb][0][q] + Z[tb][1][q], hh) * (1.0f / 64.0f);
                const float d0 = Z[tb][0][q] - mean, d1 = Z[tb][1][q] - mean;
                const float rs = rsqrtf(half_bcast_sum(d0 * d0 + d1 * d1, hh) * (1.0f / 64.0f) + GN_EPS);
                const float y0 = (d0 * rs * lw.x + lb.x + bon[q] * bflo(vv[q])) * bflo(gg[q]), y1 = (d1 * rs * lw.y + lb.y + bon[q] * bfhi(vv[q])) * bfhi(gg[q]);
                *(unsigned*)(YRW + o0) = pk2(y0, y1);
                if ((q & 3) == 3) __builtin_amdgcn_sched_barrier(0); } }
    }
}

DI void p10_rows(const Frame& F0, ARef A, const bf16* Y1, bf16* H2) {
    Frame F = F0; F.tid = opq_tid(F0.wave); F.lane = F.tid & 63; F.wave = __builtin_amdgcn_readfirstlane(F.tid >> 6); F.gw = F.wg * NWAVES + F.wave;
    const int lane = F.lane;
    const float* mod = (const float*)(A.ws + WS_MOD);
    LAS float* rw = (LAS float*)F.lds;
    LAS int* hist = (LAS int*)(F.lds + 147456);
    { const float* src = (const float*)(A.ws + WS_RTW);
        for (int i = F.tid; i < 18 * D; i += NTHR) { const int op = i >> 10, k = i & (D - 1); typedef float f2_t __attribute__((ext_vector_type(2))); f2_t w; w.x = src[(2 * op) * D + k]; w.y = src[(2 * op + 1) * D + k]; *(LAS f2_t*)(rw + 2 * i) = w; } }
    i32x4* tok = (i32x4*)(A.ws + WS_TOK); int* cnt = (int*)(A.ws + WS_CNT);
    for (int tb = F.wg; tb < NTOK / 128; tb += F.G) {
        if (F.tid < 32) hist[F.tid] = 0;
        __syncthreads();
        for (int tl = F.wave; tl < 128; tl += NWAVES) {
            const int n = tb * 128 + tl, b = n >> 13;
            const f32x4* xr = (const f32x4*)(A.x + (size_t)n * D) + lane; const u32x2* yr = (const u32x2*)(Y1 + (size_t)n * D) + lane;
            f32x4 xv[4], yv[4]; float s = 0.f;
#pragma unroll
            for (int j = 0; j < 4; ++j) { xv[j] = xr[64 * j]; const u32x2 w = yr[64 * j]; yv[j][0] = bflo(w.x); yv[j][1] = bfhi(w.x); yv[j][2] = bflo(w.y); yv[j][3] = bfhi(w.y);
                s += (yv[j][0] * yv[j][0] + yv[j][1] * yv[j][1]) + (yv[j][2] * yv[j][2] + yv[j][3] * yv[j][3]); }
            const float inv1 = rsqrtf(wave_sum(s) * (1.0f / D) + NORM_EPS);
            float s2 = 0.f;
#pragma unroll
            for (int j = 0; j < 4; ++j) { const int k = 4 * lane + 256 * j;
                const f32x4 g1 = *(const f32x4*)(A.gains + D + k), gt = *(const f32x4*)(mod + b * 6144 + 2 * D + k);
#pragma unroll
                for (int q = 0; q < 4; ++q) { xv[j][q] = xv[j][q] + gt[q] * ((yv[j][q] * inv1) * g1[q]); s2 += xv[j][q] * xv[j][q]; }
                u32x2 xw; xw.x = pk2(xv[j][0], xv[j][1]); xw.y = pk2(xv[j][2], xv[j][3]); *((u32x2*)(A.ws + WS_X1 + (size_t)n * D * 2) + lane + 64 * j) = xw; }
            const float inv2 = rsqrtf(wave_sum(s2) * (1.0f / D) + NORM_EPS);
            f32x4 hv[4];
#pragma unroll
            for (int j = 0; j < 4; ++j) { const int k = 4 * lane + 256 * j;
                const f32x4 g2 = *(const f32x4*)(A.gains + 2 * D + k), sh = *(const f32x4*)(mod + b * 6144 + 3 * D + k), sc = *(const f32x4*)(mod + b * 6144 + 4 * D + k);
#pragma unroll
                for (int q = 0; q < 4; ++q) hv[j][q] = (xv[j][q] * inv2) * g2[q] * (1.0f + sc[q]) + sh[q];
                u32x2 w; w.x = pk2(hv[j][0], hv[j][1]); w.y = pk2(hv[j][2], hv[j][3]); *((u32x2*)(H2 + (size_t)n * D) + lane + 64 * j) = w; }
            typedef float f2_t __attribute__((ext_vector_type(2)));
#define P10_PAIR(OUT0, OUT1, WBASE) do { f2_t a = {0.f, 0.f}; \
                _Pragma("unroll") for (int j = 0; j < 4; ++j) { const LAS f32x4* wp = (const LAS f32x4*)((WBASE) + (4 * lane + 256 * j) * 2); const f32x4 wA = wp[0], wB = wp[1]; \
                    a += (f2_t){hv[j][0], hv[j][0]} * (f2_t){wA[0], wA[1]}; a += (f2_t){hv[j][1], hv[j][1]} * (f2_t){wA[2], wA[3]}; \
                    a += (f2_t){hv[j][2], hv[j][2]} * (f2_t){wB[0], wB[1]}; a += (f2_t){hv[j][3], hv[j][3]} * (f2_t){wB[2], wB[3]}; } \
                OUT0 = wave_sum(a.x); OUT1 = wave_sum(a.y); } while (0)
            float lg[4];
            P10_PAIR(lg[0], lg[1], rw); P10_PAIR(lg[2], lg[3], rw + 2 * D);
            int gs = 0; float gm = lg[0];
#pragma unroll
            for (int g = 1; g < 4; ++g) if (lg[g] > gm) { gm = lg[g]; gs = g; }
            gs = __builtin_amdgcn_readfirstlane(gs);
            float gsum = 0.f;
#pragma unroll
            for (int g = 0; g < 4; ++g) gsum += fexp(lg[g] - gm);
            const float gw = 1.0f / gsum;
            float el[8];
            { const LAS float* rwg = rw + (2 + 4 * gs) * (2 * D);
#pragma unroll
              for (int i = 0; i < 4; ++i) P10_PAIR(el[2 * i], el[2 * i + 1], rwg + i * 2 * D); }
#undef P10_PAIR
            int i0 = 0; float m0 = el[0];
#pragma unroll
            for (int e = 1; e < 8; ++e) if (el[e] > m0) { m0 = el[e]; i0 = e; }
            int i1 = -1; float m1 = -3.0e38f;
#pragma unroll
            for (int e = 0; e < 8; ++e) if (e != i0 && el[e] > m1) { m1 = el[e]; i1 = e; }
            const float t = fexp(m1 - m0), p0 = 1.0f / (1.0f + t), p1 = t * p0;
            const int e0 = gs * 8 + i0, e1 = gs * 8 + i1;
#if defined(CHECKS)
            if (lane == 0 && n == DBG_TOKEN) { float* dbg = (float*)(A.ws + WS_CTL + 32768) + 48; dbg[0] = lg[0]; dbg[1] = lg[1]; dbg[2] = lg[2]; dbg[3] = lg[3]; dbg[4] = gsum; dbg[5] = p0; dbg[6] = gw; dbg[7] = t; }
#endif
            if (lane == 0) { i32x4 rec; rec.x = e0 | (e1 << 8); rec.y = 0; rec.z = 0; rec.w = 0; tok[n] = rec;
                float* cwp = (float*)(A.ws + WS_CW) + 2 * n; cwp[0] = gw * p0; cwp[1] = gw * p1;
                atomicAdd((int*)&hist[e0], 1); atomicAdd((int*)&hist[e1], 1); }
        }
        __syncthreads();
        if (F.tid < 32) cnt[tb * 32 + F.tid] = hist[F.tid];
        __syncthreads();
    }
}

DI void p11_rank_gather(const Frame& F0, ARef A, const bf16* H2, bf16* HS) {
    Frame F = F0; F.tid = opq_tid(F0.wave); F.lane = F.tid & 63; F.wave = __builtin_amdgcn_readfirstlane(F.tid >> 6); F.gw = F.wg * NWAVES + F.wave;
    LAS int* base = (LAS int*)F.lds;
    LAS int* seg = base + 32;
    LAS int* el = base + 96;
    LAS int* pos = base + 352;
    i32x4* tok = (i32x4*)(A.ws + WS_TOK); const int* cnt = (const int*)(A.ws + WS_CNT); int* tile = (int*)(A.ws + WS_TILE);
    for (int tb = F.wg; tb < NTOK / 128; tb += F.G) {
        if (F.tid < 32) { int tot = 0, pre = 0;
            for (int t2 = 0; t2 < NTOK / 128; ++t2) { const int v = cnt[t2 * 32 + F.tid]; tot += v; if (t2 < tb) pre += v; }
            base[F.tid] = pre; seg[F.tid] = (tot + 255) & ~255; }
        if (F.tid >= 64 && F.tid < 64 + 128) { const i32x4 rec = tok[tb * 128 + (F.tid - 64)]; el[2 * (F.tid - 64)] = rec.x & 255; el[2 * (F.tid - 64) + 1] = (rec.x >> 8) & 255; }
        __syncthreads();
        if (F.tid == 0) { int acc = 0; for (int e = 0; e < 32; ++e) { const int sz = seg[e]; seg[e] = acc; acc += sz; } seg[32] = acc; }
        __syncthreads();
        if (F.tid < 32) { int p = seg[F.tid] + base[F.tid];
            for (int q = 0; q < 256; ++q) if (el[q] == F.tid) pos[q] = p++; }
        if (tb == 0 && F.tid >= 64 && F.tid < 64 + 32) { const int e = F.tid - 64;
            for (int t2 = seg[e] >> 8; t2 < (seg[e + 1] >> 8); ++t2) tile[t2] = e;
            if (e == 0) tile[MAXT] = seg[32] >> 8; }
        __syncthreads();
        if (F.tid < 128) { i32x4 rec = tok[tb * 128 + F.tid]; rec.x = pos[2 * F.tid]; rec.y = pos[2 * F.tid + 1]; tok[tb * 128 + F.tid] = rec; }
        for (int q = F.wave; q < 256; q += NWAVES) { const int n = tb * 128 + (q >> 1);
            const u32x4* src = (const u32x4*)(H2 + (size_t)n * D) + F.lane; u32x4* dst = (u32x4*)(HS + (size_t)pos[q] * D) + F.lane;
            dst[0] = src[0]; dst[64] = src[64]; }
        __syncthreads();
    }
}

DI void p14_final(const Frame& F0, ARef A, const bf16* YE) {
    Frame F = F0; F.tid = opq_tid(F0.wave); F.lane = F.tid & 63; F.wave = __builtin_amdgcn_readfirstlane(F.tid >> 6); F.gw = F.wg * NWAVES + F.wave;
    const int lane = F.lane;
    const float* mod = (const float*)(A.ws + WS_MOD); const i32x4* tok = (const i32x4*)(A.ws + WS_TOK);
    for (int n = F.gw; n < NTOK; n += F.NGW) {
        const int b = n >> 13; const i32x4 rec = tok[n];
        const float c0 = ((const float*)(A.ws + WS_CW))[2 * n], c1 = ((const float*)(A.ws + WS_CW))[2 * n + 1];
        const u32x2* y0 = (const u32x2*)(YE + (size_t)rec.x * D) + lane; const u32x2* y1 = (const u32x2*)(YE + (size_t)rec.y * D) + lane;
        f32x4 yv[4]; float s = 0.f;
#pragma unroll
        for (int j = 0; j < 4; ++j) { const u32x2 a = y0[64 * j], bq = y1[64 * j];
            yv[j][0] = c0 * bflo(a.x) + c1 * bflo(bq.x); yv[j][1] = c0 * bfhi(a.x) + c1 * bfhi(bq.x); yv[j][2] = c0 * bflo(a.y) + c1 * bflo(bq.y); yv[j][3] = c0 * bfhi(a.y) + c1 * bfhi(bq.y);
            s += (yv[j][0] * yv[j][0] + yv[j][1] * yv[j][1]) + (yv[j][2] * yv[j][2] + yv[j][3] * yv[j][3]); }
        const float inv = rsqrtf(wave_sum(s) * (1.0f / D) + NORM_EPS);
#pragma unroll
        for (int j = 0; j < 4; ++j) { const int k = 4 * lane + 256 * j;
            const f32x4 g3 = *(const f32x4*)(A.gains + 3 * D + k), gt = *(const f32x4*)(mod + b * 6144 + 5 * D + k);
            const u32x2 xw = *((const u32x2*)(A.ws + WS_X1 + (size_t)n * D * 2) + lane + 64 * j); f32x4 xv = {bflo(xw.x), bfhi(xw.x), bflo(xw.y), bfhi(xw.y)};
#pragma unroll
            for (int q = 0; q < 4; ++q) xv[q] = xv[q] + gt[q] * ((yv[j][q] * inv) * g3[q]);
            *((f32x4*)(A.out + (size_t)n * D) + lane + 64 * j) = xv; }
    }
}

DI bf16x8 pk_tile(const f32x16& x, const int s) { return pack8v(x[8 * s], x[8 * s + 1], x[8 * s + 2], x[8 * s + 3], x[8 * s + 4], x[8 * s + 5], x[8 * s + 6], x[8 * s + 7]); }
constexpr int FS = 72;
DI bf16x8 rd_frag(const LAS bf16* buf, int tb, int cb, int s, int r, int hh) {
    const LAS bf16* p = buf + (32 * cb + r) * FS + 32 * tb + 16 * s + 4 * hh;
    const s16x4 lo = *(const LAS s16x4*)p, hi = *(const LAS s16x4*)(p + 8); bf16x8 f;
#pragma unroll
    for (int e = 0; e < 4; ++e) { f[e] = lo[e]; f[4 + e] = hi[e]; }
    return f; }
DI void wr_tile_ft(LAS bf16* buf, const f32x16& x, int tb, int cb, int r, int hh) {
#pragma unroll
    for (int g = 0; g < 4; ++g) { u32x2 w; w.x = pk2(x[4 * g], x[4 * g + 1]); w.y = pk2(x[4 * g + 2], x[4 * g + 3]); *(LAS u32x2*)(buf + (32 * cb + r) * FS + 32 * tb + 8 * g + 4 * hh) = w; } }
DI void wr_l_ft(LAS bf16* buf, const float (&x)[64], int lane) {
#pragma unroll
    for (int t8 = 0; t8 < 8; ++t8) { u32x4 w; w.x = pk2(x[8 * t8], x[8 * t8 + 1]); w.y = pk2(x[8 * t8 + 2], x[8 * t8 + 3]); w.z = pk2(x[8 * t8 + 4], x[8 * t8 + 5]); w.w = pk2(x[8 * t8 + 6], x[8 * t8 + 7]);
        *(LAS u32x4*)(buf + lane * FS + 8 * t8) = w; } }

#if defined(STAMPS)
#define P5STAMP(k) do { p5ts[k] = __builtin_amdgcn_s_memrealtime(); } while (0)
#else
#define P5STAMP(k) do { } while (0)
#endif
DI void p5_mfma(unsigned char* F0_ws, const Frame& F0, const bf16* R, const bf16* KP, const bf16* V, const bf16* KK, const bf16* Bv, const bf16* Ev, bf16* P, bf16* QO, bf16* GT, bf16* HT) {
    Frame F = F0; F.tid = opq_tid(F0.wave); F.lane = F.tid & 63; F.wave = __builtin_amdgcn_readfirstlane(F.tid >> 6); F.gw = F.wg * NWAVES + F.wave;
    const int lane = F.lane, r = lane & 31, hh = lane >> 5;
    LAS unsigned char* wl_init = F.lds + F.wave * 20480;
    LAS unsigned char* const wl0 = wl_init;
    {   bf16x8 id_[2];
#pragma unroll
        for (int s = 0; s < 2; ++s)
#pragma unroll
            for (int e = 0; e < 8; ++e) id_[s][e] = (16 * s + 8 * (e >> 2) + 4 * hh + (e & 3)) == r ? (short)0x3F80 : (short)0;
        *(LAS bf16x8*)(wl0 + 16640 + lane * 16) = id_[0]; *(LAS bf16x8*)(wl0 + 16640 + 1024 + lane * 16) = id_[1]; }
    wave_lds_fence();
    for (int cid = F.gw; cid < NCHUNK; cid += F.NGW) {
        const int bh = cid >> NCH_LOG, c = cid & (NCH - 1), b = bh >> 3, h = bh & 7;
        const unsigned n0 = (unsigned)b * SEQ + (unsigned)c * CH, col0 = (unsigned)h * HD;
        LAS unsigned char* wl = wl0; asm volatile("" : "+s"(wl));
        LAS unsigned char* IFR = wl + 16640;
        const int ln = opq_tid(F.wave) & 63;
#if defined(STAMPS)
        unsigned long long p5ts[10];
#endif
        const int rm = ln & 31, hm = ln >> 5;
        const bf16 *R0_ = R, *KP0_ = KP, *V0_ = V, *KK0_ = KK, *Bv0_ = Bv, *Ev0_ = Ev; bf16 *P0_ = P, *QO0_ = QO;
        asm volatile("" : "+s"(R0_), "+s"(KP0_), "+s"(V0_), "+s"(KK0_), "+s"(Bv0_), "+s"(Ev0_), "+s"(P0_), "+s"(QO0_));
        const GAS char *R_ = (const GAS char*)R0_, *KP_ = (const GAS char*)KP0_, *V_ = (const GAS char*)V0_, *KK_ = (const GAS char*)KK0_, *Bv_ = (const GAS char*)Bv0_, *Ev_ = (const GAS char*)Ev0_;
        GAS char *P_ = (GAS char*)P0_, *QO_ = (GAS char*)QO0_;
        const unsigned nb0 = n0 * BW + col0;
        const unsigned vL = (nb0 + (unsigned)ln) * 2u, vT = (nb0 + (unsigned)rm * BW + 4u * hm) * 2u;
#define OADD(v, c) ({ unsigned o_; asm volatile("v_add_u32_e32 %0, %1, %2" : "=v"(o_) : "n"((int)(c)), "v"(v)); o_; })
#define LD16(arr, off) (*(const GAS bf16*)((arr) + (off)))
#define XL(arr, t) LD16(arr, OADD(vL, (t) * BW * 2))
#define ROWQ(q) (((q) & 3) + 8 * ((q) >> 2))
        P5STAMP(0);
        bf16x8 Ep[2][2][2]; u32x2 raw[2][4][4];
#pragma unroll
        for (int fb = 0; fb < 2; ++fb)
#pragma unroll
            for (int tb = 0; tb < 2; ++tb)
#pragma unroll
                for (int s = 0; s < 2; ++s) { const u32x2 lo_ = *(const GAS u32x2*)(Ev_ + OADD(vT, (32 * tb * BW + 32 * fb + 16 * s) * 2)), hi_ = *(const GAS u32x2*)(Ev_ + OADD(vT, (32 * tb * BW + 32 * fb + 16 * s + 8) * 2));
                    u32x4 w_; w_.x = lo_.x; w_.y = lo_.y; w_.z = hi_.x; w_.w = hi_.y; Ep[fb][tb][s] = __builtin_bit_cast(bf16x8, w_); }
#define LOAD_TILE(BUF, FB, TB) do { _Pragma("unroll") for (int g = 0; g < 4; ++g) { const unsigned ot_ = OADD(vT, (32 * (TB) * BW + 32 * (FB) + 8 * g) * 2); \
            raw[BUF][0][g] = *(const GAS u32x2*)(KK_ + ot_); raw[BUF][1][g] = *(const GAS u32x2*)(R_ + ot_); \
            raw[BUF][2][g] = *(const GAS u32x2*)(Bv_ + ot_); raw[BUF][3][g] = *(const GAS u32x2*)(KP_ + ot_); } } while (0)
        LOAD_TILE(0, 0, 0);
#define IDF(s) (*(const LAS bf16x8*)(IFR + (s) * 1024 + ln * 16))
        bf16x8 ETp[2][2][2], tri[2], ones;
        float sc_[2];
        {   const bf16x8 id0 = IDF(0), id1 = IDF(1);
            {   unsigned o2_ = 0x3F803F80u; asm volatile("" : "+v"(o2_)); u32x4 o4_; o4_.x = o2_; o4_.y = o2_; o4_.z = o2_; o4_.w = o2_; ones = __builtin_bit_cast(bf16x8, o4_); }
#pragma unroll
            for (int e = 0; e < 8; ++e) {
#pragma unroll
                for (int s = 0; s < 2; ++s) tri[s][e] = (16 * s + 8 * (e >> 2) + 4 * hm + (e & 3)) <= rm ? (short)0x3F80 : (short)0; }
#pragma unroll
            for (int kb = 0; kb < 2; ++kb)
#pragma unroll
                for (int fb = 0; fb < 2; ++fb) { f32x16 x_;
#pragma unroll
                    for (int q = 0; q < 16; ++q) x_[q] = 0.f;
                    x_ = MFMA32(Ep[fb][kb][0], id0, x_); x_ = MFMA32(Ep[fb][kb][1], id1, x_);
                    ETp[kb][fb][0] = pk_tile(x_, 0); ETp[kb][fb][1] = pk_tile(x_, 1); }
#pragma unroll
            for (int fb = 0; fb < 2; ++fb) { f32x16 t_;
#pragma unroll
                for (int q = 0; q < 16; ++q) t_[q] = 0.f;
#pragma unroll
                for (int kb = 0; kb < 2; ++kb)
#pragma unroll
                    for (int s = 0; s < 2; ++s) t_ = MFMA32(ones, ETp[kb][fb][s], t_);
                sc_[fb] = fexp(-t_[0]); }
            __builtin_amdgcn_sched_barrier(0); }
        P5STAMP(1);
        bf16x8 Ap[2][2][2], Rp[2][2][2], Bp[2][2][2], Kp[2][2][2];
#pragma unroll
        for (int ti = 0; ti < 4; ++ti) { const int fb = ti >> 1, tb = ti & 1;
            if (ti < 3) LOAD_TILE((ti + 1) & 1, (ti + 1) >> 1, (ti + 1) & 1);
            f32x16 Lt;
#pragma unroll
            for (int q = 0; q < 16; ++q) Lt[q] = 0.f;
#pragma unroll
            for (int kb = 0; kb <= tb; ++kb)
#pragma unroll
                for (int s = 0; s < 2; ++s) Lt = MFMA32(ETp[kb][fb][s], kb < tb ? ones : tri[s], Lt);
#pragma unroll
            for (int s = 0; s < 2; ++s) {
                float a8[8], r8[8], b8[8], k8[8], e8[8]; unpack8(__builtin_bit_cast(u32x4, Ep[fb][tb][s]), e8);
#pragma unroll
                for (int g2 = 0; g2 < 2; ++g2) { const int g = 2 * s + g2;
                    const u32x2 aw = raw[ti & 1][0][g], rw = raw[ti & 1][1][g], bw = raw[ti & 1][2][g], kw = raw[ti & 1][3][g];
                    const float av[4] = {bflo(aw.x), bfhi(aw.x), bflo(aw.y), bfhi(aw.y)}, rv[4] = {bflo(rw.x), bfhi(rw.x), bflo(rw.y), bfhi(rw.y)},
                                bv[4] = {bflo(bw.x), bfhi(bw.x), bflo(bw.y), bfhi(bw.y)}, kv[4] = {bflo(kw.x), bfhi(kw.x), bflo(kw.y), bfhi(kw.y)};
#pragma unroll
                    for (int j = 0; j < 4; ++j) { const float l = -Lt[4 * g + j];
                        const float eI = fexp(l), eX = fexp(l + e8[4 * g2 + j]), eN = frcp(eI);
                        a8[4 * g2 + j] = -av[j] * eX; r8[4 * g2 + j] = rv[j] * eI; b8[4 * g2 + j] = bv[j] * eN; k8[4 * g2 + j] = kv[j] * eN; } }
                Ap[fb][tb][s] = __builtin_bit_cast(bf16x8, pack8(a8)); Rp[fb][tb][s] = __builtin_bit_cast(bf16x8, pack8(r8));
                Bp[fb][tb][s] = __builtin_bit_cast(bf16x8, pack8(b8)); Kp[fb][tb][s] = __builtin_bit_cast(bf16x8, pack8(k8)); }
            __builtin_amdgcn_sched_barrier(0); }
#undef LOAD_TILE
        P5STAMP(2);
#define GRAM_TILE(m_, XP, YP, ib, tb) do { _Pragma("unroll") for (int q = 0; q < 16; ++q) m_[q] = 0.f; \
            _Pragma("unroll") for (int fb = 0; fb < 2; ++fb) _Pragma("unroll") for (int s = 0; s < 2; ++s) m_ = MFMA32(XP[fb][ib][s], YP[fb][tb][s], m_); } while (0)
        bf16x8 Tp[2][2][2];
        {
#pragma unroll
            for (int b = 1; b >= 0; --b) { bf16x8 AP[2], BP[2]; f32x16 CT;
                {   f32x16 m_; int rm_ = rm; asm volatile("" : "+v"(rm_));
                    GRAM_TILE(m_, Bp, Ap, b, b);
#pragma unroll
                    for (int q = 0; q < 16; ++q) m_[q] = crow(q, hm) < rm_ ? m_[q] : 0.f;
                    BP[0] = pk_tile(m_, 0); BP[1] = pk_tile(m_, 1);
#pragma unroll
                    for (int q = 0; q < 16; ++q) CT[q] = m_[q] + (crow(q, hm) == rm_ ? 1.0f : 0.f);
                    GRAM_TILE(m_, Ap, Bp, b, b);
#pragma unroll
                    for (int q = 0; q < 16; ++q) m_[q] = rm_ < crow(q, hm) ? m_[q] : 0.f;
                    AP[0] = pk_tile(m_, 0); AP[1] = pk_tile(m_, 1); }
                __builtin_amdgcn_sched_barrier(0);
#pragma unroll
                for (int it = 0; it < 4; ++it) { f32x16 pn_, pt_;
#pragma unroll
                    for (int q = 0; q < 16; ++q) { pn_[q] = 0.f; pt_[q] = 0.f; }
#pragma unroll
                    for (int s = 0; s < 2; ++s) { pn_ = MFMA32(AP[s], BP[s], pn_); pt_ = MFMA32(BP[s], AP[s], pt_); }
                    const bf16x8 bt0 = pk_tile(CT, 0), bt1 = pk_tile(CT, 1);
                    AP[0] = pk_tile(pt_, 0); AP[1] = pk_tile(pt_, 1); BP[0] = pk_tile(pn_, 0); BP[1] = pk_tile(pn_, 1);
                    CT = MFMA32(AP[0], bt0, CT); CT = MFMA32(AP[1], bt1, CT);
                    __builtin_amdgcn_sched_barrier(0); }
                Tp[b][b][0] = pk_tile(CT, 0); Tp[b][b][1] = pk_tile(CT, 1); }
            {   f32x16 x_; GRAM_TILE(x_, Ap, Bp, 1, 0);
                const bf16x8 au0 = pk_tile(x_, 0), au1 = pk_tile(x_, 1);
#pragma unroll
                for (int q = 0; q < 16; ++q) x_[q] = 0.f;
                x_ = MFMA32(au0, Tp[1][1][0], x_); x_ = MFMA32(au1, Tp[1][1][1], x_);
                const bf16x8 bx0 = pk_tile(x_, 0), bx1 = pk_tile(x_, 1);
#pragma unroll
                for (int q = 0; q < 16; ++q) x_[q] = 0.f;
                x_ = MFMA32(Tp[0][0][0], IDF(0), x_); x_ = MFMA32(Tp[0][0][1], IDF(1), x_);
                const bf16x8 at0 = pk_tile(x_, 0), at1 = pk_tile(x_, 1);
#pragma unroll
                for (int q = 0; q < 16; ++q) x_[q] = 0.f;
                x_ = MFMA32(at0, bx0, x_); x_ = MFMA32(at1, bx1, x_);
                Tp[1][0][0] = pk_tile(x_, 0); Tp[1][0][1] = pk_tile(x_, 1); }
            __builtin_amdgcn_sched_barrier(0); }
        P5STAMP(3);
        {   const bf16x8 id0 = IDF(0), id1 = IDF(1);
#pragma unroll
            for (int tb = 0; tb < 2; ++tb)
#pragma unroll
                for (int kb = 0; kb < 2; ++kb) { f32x16 xb_, xk_; const float sc = sc_[kb];
#pragma unroll
                    for (int q = 0; q < 16; ++q) { xb_[q] = 0.f; xk_[q] = 0.f; }
                    xb_ = MFMA32(Bp[kb][tb][0], id0, xb_); xb_ = MFMA32(Bp[kb][tb][1], id1, xb_);
                    xk_ = MFMA32(Kp[kb][tb][0], id0, xk_); xk_ = MFMA32(Kp[kb][tb][1], id1, xk_);
#pragma unroll
                    for (int q = 0; q < 16; ++q) { xb_[q] *= sc; xk_[q] *= sc; }
#pragma unroll
                    for (int s = 0; s < 2; ++s) { *(LAS bf16x8*)(wl + (((tb * 2 + kb) * 2 + s) * 1024) + ln * 16) = pk_tile(xb_, s); *(LAS bf16x8*)(wl + 8192 + (((tb * 2 + kb) * 2 + s) * 1024) + ln * 16) = pk_tile(xk_, s); }
                    __builtin_amdgcn_sched_barrier(0); } }
        bf16x8 Makp[2][2][2], Mbrp[2][2][2], Mkrp[2][2][2];
#define GRAM(XP, YP, STRICT, BODY) _Pragma("unroll") for (int ib = 0; ib < 2; ++ib) _Pragma("unroll") for (int tb = 0; tb < 2; ++tb) if (!(ib == 1 && tb == 0)) { f32x16 m_; \
            GRAM_TILE(m_, XP, YP, ib, tb); \
            int rm_ = rm; asm volatile("" : "+v"(rm_)); \
            _Pragma("unroll") for (int q = 0; q < 16; ++q) { const int i_ = 32 * ib + crow(q, hm), t_ = 32 * tb + rm_; m_[q] = ((STRICT) ? (i_ < t_) : (i_ <= t_)) ? m_[q] : 0.f; } \
            BODY __builtin_amdgcn_sched_barrier(0); }
        GRAM(Kp, Rp, false, { Mkrp[ib][tb][0] = pk_tile(m_, 0); Mkrp[ib][tb][1] = pk_tile(m_, 1); })
        GRAM(Kp, Ap, true, { Makp[ib][tb][0] = pk_tile(m_, 0); Makp[ib][tb][1] = pk_tile(m_, 1); })
        GRAM(Bp, Rp, false, { Mbrp[ib][tb][0] = pk_tile(m_, 0); Mbrp[ib][tb][1] = pk_tile(m_, 1); })
#undef GRAM
#undef GRAM_TILE
        P5STAMP(4);
#define IDF2(s) (*(const LAS bf16x8*)(IFR + (s) * 1024 + ln2 * 16))
        bf16x8 ATp[2][2][2];
        const int ln2 = opq_tid(F.wave) & 63;
        GAS char* pn = (GAS char*)(P0_ + (size_t)cid * 4096);
#pragma unroll
        for (int kb = 0; kb < 2; ++kb) { const bf16x8 id0 = IDF2(0), id1 = IDF2(1);
            {   bf16x8 A0p[2][2];
#pragma unroll
                for (int ib = 0; ib < 2; ++ib) { f32x16 x_;
#pragma unroll
                    for (int q = 0; q < 16; ++q) x_[q] = 0.f;
                    x_ = MFMA32(Ap[kb][ib][0], id0, x_); x_ = MFMA32(Ap[kb][ib][1], id1, x_);
                    A0p[ib][0] = pk_tile(x_, 0); A0p[ib][1] = pk_tile(x_, 1); }
#pragma unroll
                for (int tb = 0; tb < 2; ++tb) { f32x16 a_;
#pragma unroll
                    for (int q = 0; q < 16; ++q) a_[q] = 0.f;
#pragma unroll
                    for (int ib = 0; ib <= tb; ++ib)
#pragma unroll
                        for (int s = 0; s < 2; ++s) a_ = MFMA32(Tp[tb][ib][s], A0p[ib][s], a_);
                    ATp[tb][kb][0] = pk_tile(a_, 0); ATp[tb][kb][1] = pk_tile(a_, 1); } }
            __builtin_amdgcn_sched_barrier(0);
#pragma unroll
            for (int tb = 0; tb < 2; ++tb) { f32x16 p_; const int jb = kb;
#pragma unroll
                for (int q = 0; q < 16; ++q) p_[q] = 0.f;
                p_ = MFMA32(id0, Rp[jb][tb][0], p_); p_ = MFMA32(id1, Rp[jb][tb][1], p_);
#pragma unroll
                for (int ib = 0; ib <= tb; ++ib)
#pragma unroll
                    for (int s = 0; s < 2; ++s) p_ = MFMA32(ATp[ib][jb][s], Mbrp[ib][tb][s], p_);
#pragma unroll
                for (int s = 0; s < 2; ++s) *(GAS bf16x8*)(pn + ((((jb * 2 + tb) * 2 + s) * 64) + ln2) * 16) = pk_tile(p_, s);
                __builtin_amdgcn_sched_barrier(0); } }
        P5STAMP(6);
        bf16x8 W1p[2][2][2], Vp[2][2][2];
        const int lc_ = ln2;
        const unsigned vC = (nb0 + 4u * (unsigned)(lc_ >> 5) * BW + 2u * (unsigned)(lc_ & 31)) * 2u;
#pragma unroll
        for (int ib = 0; ib < 2; ++ib) { f32x16 v0_, v1_;
#pragma unroll
            for (int q = 0; q < 16; ++q) { const unsigned w_ = *(const GAS unsigned*)(V_ + OADD(vC, ((32 * ib + ROWQ(q)) * BW) * 2)); v0_[q] = bflo(w_); v1_[q] = bfhi(w_); }
            Vp[ib][0][0] = pk_tile(v0_, 0); Vp[ib][0][1] = pk_tile(v0_, 1); Vp[ib][1][0] = pk_tile(v1_, 0); Vp[ib][1][1] = pk_tile(v1_, 1); }
#pragma unroll
        for (int vb = 0; vb < 2; ++vb) { bf16x8 W0p[2][2];
#pragma unroll
            for (int tb = 0; tb < 2; ++tb) { f32x16 w_;
#pragma unroll
                for (int q = 0; q < 16; ++q) w_[q] = 0.f;
#pragma unroll
                for (int ib = 0; ib <= tb; ++ib)
#pragma unroll
                    for (int s = 0; s < 2; ++s) w_ = MFMA32(Makp[ib][tb][s], Vp[ib][vb][s], w_);
                W0p[tb][0] = pk_tile(w_, 0); W0p[tb][1] = pk_tile(w_, 1); }
#pragma unroll
            for (int tb = 0; tb < 2; ++tb) { f32x16 w_;
#pragma unroll
                for (int q = 0; q < 16; ++q) w_[q] = 0.f;
#pragma unroll
                for (int ib = 0; ib <= tb; ++ib)
#pragma unroll
                    for (int s = 0; s < 2; ++s) w_ = MFMA32(Tp[tb][ib][s], W0p[ib][s], w_);
                W1p[tb][vb][0] = pk_tile(w_, 0); W1p[tb][vb][1] = pk_tile(w_, 1); }
            __builtin_amdgcn_sched_barrier(0); }
        P5STAMP(7);
        GAS char* qn = (GAS char*)(QO0_ + (size_t)cid * 4096);
#pragma unroll
        for (int tb = 0; tb < 2; ++tb)
#pragma unroll
            for (int vb = 0; vb < 2; ++vb) { f32x16 y_;
#pragma unroll
                for (int q = 0; q < 16; ++q) y_[q] = 0.f;
#pragma unroll
                for (int ib = 0; ib <= tb; ++ib)
#pragma unroll
                    for (int s = 0; s < 2; ++s) { y_ = MFMA32(Mbrp[ib][tb][s], W1p[ib][vb][s], y_); y_ = MFMA32(Mkrp[ib][tb][s], Vp[ib][vb][s], y_); }
#pragma unroll
                for (int g = 0; g < 4; ++g) { u32x2 w; w.x = pk2(y_[4 * g], y_[4 * g + 1]); w.y = pk2(y_[4 * g + 2], y_[4 * g + 3]); *(GAS u32x2*)(qn + ((((tb * 2 + vb) * 4 + g) * 64) + ln2) * 8) = w; }
                __builtin_amdgcn_sched_barrier(0); }
        P5STAMP(8);
        wave_lds_fence();
        bf16x8 Bh[2][2][2];
#pragma unroll
        for (int tb = 0; tb < 2; ++tb)
#pragma unroll
            for (int kb = 0; kb < 2; ++kb)
#pragma unroll
                for (int s = 0; s < 2; ++s) Bh[tb][kb][s] = *(const LAS bf16x8*)(wl + (((tb * 2 + kb) * 2 + s) * 1024) + ln2 * 16);
        GAS char* gt = (GAS char*)(GT + (size_t)cid * 4096); GAS char* ht = (GAS char*)(HT + (size_t)cid * 4096);
#pragma unroll
        for (int kb = 0; kb < 2; ++kb)
#pragma unroll
            for (int jb = 0; jb < 2; ++jb) { f32x16 g_;
                const float dg = sc_[kb];
#pragma unroll
                for (int q = 0; q < 16; ++q) g_[q] = (kb == jb && crow(q, hm) == rm) ? dg : 0.f;
#pragma unroll
                for (int tb = 0; tb < 2; ++tb)
#pragma unroll
                    for (int s = 0; s < 2; ++s) g_ = MFMA32(ATp[tb][jb][s], Bh[tb][kb][s], g_);
#pragma unroll
                for (int s = 0; s < 2; ++s) *(GAS bf16x8*)(gt + ((kb * 4 + jb * 2 + s) * 64 + ln2) * 16) = pk_tile(g_, s);
                __builtin_amdgcn_sched_barrier(0); }
        {   bf16x8 Kh[2][2][2];
#pragma unroll
            for (int tb = 0; tb < 2; ++tb)
#pragma unroll
                for (int kb = 0; kb < 2; ++kb)
#pragma unroll
                    for (int s = 0; s < 2; ++s) Kh[tb][kb][s] = *(const LAS bf16x8*)(wl + 8192 + (((tb * 2 + kb) * 2 + s) * 1024) + ln2 * 16);
#pragma unroll
            for (int kb = 0; kb < 2; ++kb)
#pragma unroll
                for (int vb = 0; vb < 2; ++vb) { f32x16 h_;
#pragma unroll
                    for (int q = 0; q < 16; ++q) h_[q] = 0.f;
#pragma unroll
                    for (int tb = 0; tb < 2; ++tb)
#pragma unroll
                        for (int s = 0; s < 2; ++s) { h_ = MFMA32(Bh[tb][kb][s], W1p[tb][vb][s], h_); h_ = MFMA32(Kh[tb][kb][s], Vp[tb][vb][s], h_); }
#pragma unroll
                    for (int g = 0; g < 4; ++g) { u32x2 w; w.x = pk2(h_[4 * g], h_[4 * g + 1]); w.y = pk2(h_[4 * g + 2], h_[4 * g + 3]); *(GAS u32x2*)(ht + ((((kb * 2 + vb) * 4 + g) * 64) + ln2) * 8) = w; }
                    __builtin_amdgcn_sched_barrier(0); } }
        P5STAMP(9);
#undef IDF
#undef IDF2
#if defined(STAMPS)
        if (F.gw == 0 && cid == 0 && lane == 0) { _Pragma("unroll") for (int k_ = 0; k_ < 10; ++k_) ((unsigned long long*)(F0_ws + WS_CTL + 49152))[32 + k_] = p5ts[k_]; }
#endif
        wave_lds_fence();
#undef XL
#undef OADD
#undef LD16
#undef ROWQ
    }
}

#if defined(CHECKS)
constexpr size_t WS_FLG = WS_CTL + 32768;
DI unsigned* chk_flags(unsigned char* ws) { return (unsigned*)(ws + WS_FLG); }
DI void chk(unsigned char* ws, int id, float got, float want, float rel, float ab) {
    const float d = fabsf(got - want), lim = rel * fmaxf(fabsf(got), fabsf(want)) + ab;
    if (!(d <= lim)) chk_flags(ws)[id] = 1u; }
DI unsigned hsh(unsigned a) { a ^= a >> 16; a *= 0x7feb352du; a ^= a >> 15; a *= 0x846ca68bu; a ^= a >> 16; return a; }
DI float bfr(float v) { return bflo(f2bf(v)); }
DI int scol_of(int n) { return n < 3360 ? n : (n < 3584 ? -1 : n - 224); }

DI void chk_p0(const Frame& F, ARef A) {
    unsigned char* ws = A.ws; const int lane = F.lane;
    const float* mod = (const float*)(ws + WS_MOD);
    for (int s = F.wave; s < 32; s += NWAVES) { const unsigned hh = hsh(1000 + s); const int b = hh & 3, o = (hh >> 2) % 6144; float a = 0.f;
        for (int k = lane; k < D; k += 64) { const float c = A.c[b * D + k]; a += (c / (1.0f + expf(-c))) * A.w_mod[(size_t)k * 6144 + o]; }
        a = wave_sum(a) + A.b_mod[o]; chk(ws, 10, mod[b * 6144 + o], a, 1e-3f, 1e-4f); }
    const bf16* wt = (const bf16*)(ws + WS_WIN);
    for (int s = 0; s < 8; ++s) { const unsigned hh = hsh(2000 + (F.wave * 8 + s) * 64 + lane); const int n = hh % NPAD, k = (hh >> 13) & 1023; const int sc = scol_of(n);
        const float want = sc >= 0 ? bfr(A.w_in[(size_t)k * IN_COLS + sc]) : 0.f; chk(ws, 11, bf2f(wt[(size_t)n * D + k]), want, 0.f, 0.f); }
    { const unsigned hh = hsh(3000 + F.wave * 64 + lane); const int n = hh & 1023, k = (hh >> 10) & 511, k2 = (hh >> 10) & 1023;
        chk(ws, 11, bf2f(((const bf16*)(ws + WS_WOSB))[n * BW + k]), bfr(A.w_o_sb[k * D + n]), 0.f, 0.f);
        chk(ws, 11, bf2f(((const bf16*)(ws + WS_WORW))[n * BW + k]), bfr(A.w_o_rw[k * D + n]), 0.f, 0.f);
        chk(ws, 11, bf2f(((const bf16*)(ws + WS_WOUT))[n * D + k2]), bfr(A.w_out[k2 * D + n]), 0.f, 0.f);
        const int o = hh % 36; chk(ws, 11, ((const float*)(ws + WS_RTW))[o * D + k2], o < 4 ? A.w_group[k2 * 4 + o] : A.w_router[k2 * NE + o - 4], 0.f, 0.f);
        const int nl = hh % 1536, kl = (hh >> 11) % LK; float v = 0.f;
        if (nl < 512) { if (kl < 64) v = A.w_decay_up[kl * BW + nl]; } else if (nl < 1024) { if (kl >= 64 && kl < 128) v = A.w_iclr_up[(kl - 64) * BW + nl - 512]; } else { if (kl >= 128 && kl < 288) v = A.w_gate_up[(kl - 128) * BW + nl - 1024]; }
        chk(ws, 11, bf2f(((const bf16*)(ws + WS_WL))[nl * LK + kl]), bfr(v), 0.f, 0.f); }
}
DI void chk_p1(const Frame& F, ARef A, const bf16* H1) {
    unsigned char* ws = A.ws; const int lane = F.lane; const float* mod = (const float*)(ws + WS_MOD);
    for (int s = F.wave; s < 16; s += NWAVES) { const int n = hsh(4000 + s) % NTOK, b = n >> 13; float ss = 0.f;
        for (int k = lane; k < D; k += 64) { const float v = A.x[(size_t)n * D + k]; ss += v * v; }
        const float inv = 1.0f / sqrtf(wave_sum(ss) / D + NORM_EPS);
        for (int k = lane; k < D; k += 64) { const float want = (A.x[(size_t)n * D + k] * inv) * A.gains[k] * (1.0f + mod[b * 6144 + D + k]) + mod[b * 6144 + k];
            chk(ws, 12, bf2f(H1[(size_t)n * D + k]), want, 0.01f, 0.01f); } }
}
DI float wdot(const bf16* arow, const float* W, int ldw, int col, int K, int lane) { float a = 0.f; for (int k = lane; k < K; k += 64) a += bf2f(arow[k]) * W[(size_t)k * ldw + col]; return wave_sum(a); }
DI void chk_p2(const Frame& F, ARef A, const bf16* H1) {
    unsigned char* ws = A.ws; const int lane = F.lane;
    for (int s = F.wave; s < 96; s += NWAVES) { const unsigned hh = hsh(5000 + s); const int n = hh % NTOK, region = s % 6; int col;
        const unsigned h2 = hsh(hh);
        float got, want; int id = 13 + region;
        if (region == 0) { col = h2 % 512; want = 0.125f * wdot(H1 + (size_t)n * D, A.w_in, IN_COLS, col, D, lane); got = bf2f(((const bf16*)(ws + WS_QB))[(size_t)n * BW + col]); }
        else if (region == 1) { col = h2 % 512; want = wdot(H1 + (size_t)n * D, A.w_in, IN_COLS, 512 + col, D, lane); got = bf2f(((const bf16*)(ws + WS_KB))[(size_t)n * BW + col]); }
        else if (region == 2) { col = h2 % 512; want = wdot(H1 + (size_t)n * D, A.w_in, IN_COLS, 1024 + col, D, lane); got = bf2f(((const bf16*)(ws + WS_VT))[((size_t)((n >> 13) * BW + col)) * SEQ + (n & (SEQ - 1))]); }
        else if (region == 3) { col = h2 % 1536; want = wdot(H1 + (size_t)n * D, A.w_in, IN_COLS, 1536 + col, D, lane); got = bf2f(((const bf16*)(ws + WS_RWRAW))[(size_t)n * 1536 + col]); }
        else if (region == 4) { col = h2 % 288; want = wdot(H1 + (size_t)n * D, A.w_in, IN_COLS, 3072 + col, D, lane); got = bf2f(((const bf16*)(ws + WS_LORA))[(size_t)n * BW + col]); }
        else { col = h2 % 2048; want = wdot(H1 + (size_t)n * D, A.w_in, IN_COLS, 3360 + col, D, lane) + A.gate_bias[col]; want = 1.0f / (1.0f + expf(-want)); got = bf2f(((const bf16*)(ws + WS_GATE))[(size_t)n * 2048 + col]); }
        chk(ws, id, got, want, 0.03f, 0.02f); }
}
constexpr int NATT = 16;
DI void att_sample(int s, int& b, int& h, int& t) { const unsigned hh = hsh(6000 + s); b = hh & 3; h = (hh >> 2) & 7; t = (s < 4) ? (s * 37) : (int)((hh >> 5) % SEQ); }
DI void chk_p3_save(const Frame& F, ARef A) {
    if (F.wave == 0) { bf16* sv = (bf16*)(A.ws + WS_FLG + 4096);
        for (int s = 0; s < NATT; ++s) { int b, h, t; att_sample(s, b, h, t); sv[s * 64 + F.lane] = ((const bf16*)(A.ws + WS_QB))[(size_t)(b * SEQ + t) * BW + h * HD + F.lane]; } }
}
DI void chk_p3(const Frame& F, ARef A, const bf16* R, const bf16* KS, const bf16* V, const bf16* KK) {
    unsigned char* ws = A.ws; const int lane = F.lane;
    const bf16* sv = (const bf16*)(ws + WS_FLG + 4096); const bf16* KB = (const bf16*)(ws + WS_KB); const bf16* VT = (const bf16*)(ws + WS_VT);
    for (int s = F.wave; s < NATT; s += NWAVES) { int b, h, t; att_sample(s, b, h, t);
        const float q = bf2f(sv[s * 64 + lane]); float later = 0.f, o = 0.f;
        for (int k = t - 1; k >= 0; --k) { const float z = wave_sum(q * bf2f(KB[(size_t)(b * SEQ + k) * BW + h * HD + lane]));
            const float sp = fmaxf(z, 0.f) + log1pf(expf(-fabsf(z)));
            o += expf(z - sp + later) * bf2f(VT[((size_t)((b * NH + h) * HD + lane)) * SEQ + k]);
            later -= sp; if (later < -200.f) break; }
        chk(ws, 19, bf2f(((const bf16*)(ws + WS_QB))[(size_t)(b * SEQ + t) * BW + h * HD + lane]), o, 0.04f, 0.02f); }
    const bf16* RW = (const bf16*)(ws + WS_RWRAW); const bf16* LO = (const bf16*)(ws + WS_LORA); const bf16* AL = (const bf16*)(ws + WS_ALORA);
    for (int s = F.wave; s < 32; s += NWAVES) { const unsigned hh = hsh(7000 + s); const int n = (s < 4) ? s * SEQ : (int)(hh % NTOK), hd = (hh >> 16) & 7; const bool first = (n & (SEQ - 1)) == 0;
        float xs[3];
        for (int p = 0; p < 3; ++p) { const int col = p * 512 + hd * 64 + lane; const float cur = bf2f(RW[(size_t)n * 1536 + col]), prv = first ? 0.f : bf2f(RW[(size_t)(n - 1) * 1536 + col]); xs[p] = cur + A.shift_mu[col] * (prv - cur); }
        const size_t o = (size_t)n * BW + hd * 64 + lane;
        chk(ws, 20, bf2f(R[o]), xs[0], 0.01f, 0.005f); chk(ws, 20, bf2f(KS[o]), xs[1], 0.01f, 0.005f); chk(ws, 20, bf2f(V[o]), xs[2], 0.01f, 0.005f);
        const float kk = xs[1] * A.k_k[hd * 64 + lane]; const float nn = sqrtf(wave_sum(kk * kk));
        chk(ws, 20, bf2f(KK[o]), kk / fmaxf(nn, L2_EPS), 0.01f, 0.002f);
        for (int c = lane; c < LK; c += 64) { float want = 0.f;
            if (c < 288) { const float cur = bf2f(LO[(size_t)n * BW + c]), prv = first ? 0.f : bf2f(LO[(size_t)(n - 1) * BW + c]); const float v = cur + A.shift_mu[1536 + c] * (prv - cur);
                want = c < 64 ? tanhf(v) : (c < 128 ? v : 1.0f / (1.0f + expf(-v))); }
            chk(ws, 20, bf2f(AL[(size_t)n * LK + c]), want, 0.01f, 0.005f); } }
}
DI void chk_p4_save(const Frame& F, ARef A, const bf16* KS) {
    if (F.wave == 0) { bf16* sv = (bf16*)(A.ws + WS_FLG + 8192);
        for (int s = 0; s < 16; ++s) { const unsigned hh = hsh(8000 + s); const int n = hh % NTOK, hd = (hh >> 16) & 7; sv[s * 64 + F.lane] = KS[(size_t)n * BW + hd * 64 + F.lane]; } }
}
DI void chk_p4(const Frame& F, ARef A, const bf16* KP, const bf16* KK) {
    unsigned char* ws = A.ws; const int lane = F.lane; const bf16* AL = (const bf16*)(ws + WS_ALORA); const bf16* sv = (const bf16*)(ws + WS_FLG + 8192);
    for (int s = F.wave; s < 16; s += NWAVES) { const unsigned hh = hsh(8000 + s); const int n = hh % NTOK, hd = (hh >> 16) & 7, c = hd * 64 + lane; const size_t o = (size_t)n * BW + c;
        float lw = 0.f, la = 0.f, lg = 0.f;
        for (int k = 0; k < 64; ++k) { lw += bf2f(AL[(size_t)n * LK + k]) * A.w_decay_up[k * BW + c]; la += bf2f(AL[(size_t)n * LK + 64 + k]) * A.w_iclr_up[k * BW + c]; }
        for (int k = 0; k < 160; ++k) lg += bf2f(AL[(size_t)n * LK + 128 + k]) * A.w_gate_up[k * BW + c];
        const float x = -(A.w0[c] + lw), w = -(fmaxf(x, 0.f) + log1pf(expf(-fabsf(x)))) - 0.5f;
        chk(ws, 21, bf2f(((const bf16*)(ws + WS_E))[o]), expf(w), 0.03f, 0.003f);
        const float a = 1.0f / (1.0f + expf(-(A.a0[c] + la))); const float ks = bf2f(sv[s * 64 + lane]);
        chk(ws, 22, bf2f(KP[o]), ks * (1.0f + (a - 1.0f) * A.k_a[c]), 0.03f, 0.01f);
        chk(ws, 22, bf2f(((const bf16*)(ws + WS_B))[o]), bf2f(KK[o]) * a, 0.03f, 0.003f);
        chk(ws, 23, bf2f(((const bf16*)(ws + WS_GG))[o]), lg, 0.03f, 0.01f); }
}
constexpr int NST = 300;
DI void chk_p7_save(const Frame& F, ARef A) {
    if (F.wave < 4) { const int b = (F.wave * 3) & 3, h = (F.wave * 5 + 1) & 7; bf16* sv = (bf16*)(A.ws + 256 * 1024) + F.wave * NST * 64;
        for (int t = 0; t < NST; ++t) sv[t * 64 + F.lane] = ((const bf16*)(A.ws + WS_E))[(size_t)(b * SEQ + t) * BW + h * HD + F.lane]; }
}
DI void chk_p7(const Frame& F, ARef A, const bf16* R, const bf16* KP, const bf16* V, const bf16* KK) {
    unsigned char* ws = A.ws; const int lane = F.lane;
    const bf16* Bv = (const bf16*)(ws + WS_B); const bf16* Esv = (const bf16*)(ws + 256 * 1024) + F.wave * NST * 64; const bf16* GG = (const bf16*)(ws + WS_GG); const bf16* YRW = (const bf16*)(ws + WS_YRW);
    if (F.wave < 4) { const int b = (F.wave * 3) & 3, h = (F.wave * 5 + 1) & 7, col0 = h * HD;
        float S[64];
#pragma unroll
        for (int k = 0; k < 64; ++k) S[k] = 0.f;
        for (int t = 0; t < NST; ++t) { const size_t o = (size_t)(b * SEQ + t) * BW + col0 + lane;
            const float av = -bf2f(KK[o]), bv = bf2f(Bv[o]), dv = expf(-bf2f(Esv[t * 64 + lane])), kv = bf2f(KP[o]), rv = bf2f(R[o]), vv = bf2f(V[o]);
            float sa = 0.f;
#pragma unroll
            for (int k = 0; k < 64; ++k) sa += S[k] * __shfl(av, k);
            float y = 0.f;
#pragma unroll
            for (int k = 0; k < 64; ++k) { S[k] = S[k] * __shfl(dv, k) + sa * __shfl(bv, k) + vv * __shfl(kv, k); y += S[k] * __shfl(rv, k); }
            const float mean = wave_sum(y) / 64.f, d = y - mean, var = wave_sum(d * d) / 64.f;
            const float yn = d / sqrtf(var + GN_EPS) * A.lnx_w[col0 + lane] + A.lnx_b[col0 + lane];
            const float bonus = wave_sum(rv * kv * A.r_k[col0 + lane]) * vv;
            const float want = (yn + bonus) * bf2f(GG[o]);
            chk(ws, t < 128 ? 24 : 25, bf2f(YRW[o]), want, 0.05f, 0.03f); } }
}
DI void chk_p8(const Frame& F, ARef A) {
    unsigned char* ws = A.ws; const int lane = F.lane;
    for (int s = F.wave; s < 32; s += NWAVES) { const unsigned hh = hsh(9000 + s); const int n = hh % NTOK, c = (hh >> 15) & 1023;
        const float p1 = wdot((const bf16*)(ws + WS_QB) + (size_t)n * BW, A.w_o_sb, D, c, BW, lane), p2 = wdot((const bf16*)(ws + WS_YRW) + (size_t)n * BW, A.w_o_rw, D, c, BW, lane);
        const bf16* ga = (const bf16*)(ws + WS_GATE) + (size_t)n * 2048;
        chk(ws, 26, bf2f(((const bf16*)(ws + WS_MRG))[(size_t)n * D + c]), bf2f(ga[c]) * p1 + bf2f(ga[1024 + c]) * p2, 0.03f, 0.01f); }
}
DI void chk_p9(const Frame& F, ARef A) {
    unsigned char* ws = A.ws; const int lane = F.lane;
    for (int s = F.wave; s < 32; s += NWAVES) { const unsigned hh = hsh(9500 + s); const int n = hh % NTOK, c = (hh >> 15) & 1023;
        chk(ws, 27, bf2f(((const bf16*)(ws + WS_Y1))[(size_t)n * D + c]), wdot((const bf16*)(ws + WS_MRG) + (size_t)n * D, A.w_out, D, c, D, lane), 0.03f, 0.01f); }
}
DI void chk_p10(const Frame& F, ARef A) {
    unsigned char* ws = A.ws; const int lane = F.lane; const float* mod = (const float*)(ws + WS_MOD);
    const bf16* Y1 = (const bf16*)(ws + WS_Y1); const bf16* H2 = (const bf16*)(ws + WS_H2); const i32x4* tok = (const i32x4*)(ws + WS_TOK);
    for (int s = F.wave; s < 32; s += NWAVES) { const int n = s == 0 ? DBG_TOKEN : (s < 16 ? (int)(hsh(10000 + s) % 128) : (int)(hsh(10000 + s) % NTOK)), b = n >> 13; float ss = 0.f;
        for (int k = lane; k < D; k += 64) { const float v = bf2f(Y1[(size_t)n * D + k]); ss += v * v; }
        const float inv1 = 1.0f / sqrtf(wave_sum(ss) / D + NORM_EPS); float s2 = 0.f;
        for (int k = lane; k < D; k += 64) { const float x1 = A.x[(size_t)n * D + k] + mod[b * 6144 + 2 * D + k] * ((bf2f(Y1[(size_t)n * D + k]) * inv1) * A.gains[D + k]);
            chk(ws, 28, A.out[(size_t)n * D + k], x1, 1e-3f, 1e-3f); s2 += x1 * x1; }
        const float inv2 = 1.0f / sqrtf(wave_sum(s2) / D + NORM_EPS);
        float lg[36];
#pragma unroll
        for (int o = 0; o < 36; ++o) lg[o] = 0.f;
        for (int k = lane; k < D; k += 64) { const float h2 = (A.out[(size_t)n * D + k] * inv2) * A.gains[2 * D + k] * (1.0f + mod[b * 6144 + 4 * D + k]) + mod[b * 6144 + 3 * D + k];
            chk(ws, 29, bf2f(H2[(size_t)n * D + k]), h2, 0.01f, 0.01f);
#pragma unroll
            for (int o = 0; o < 36; ++o) lg[o] += h2 * (o < 4 ? A.w_group[k * 4 + o] : A.w_router[k * NE + o - 4]); }
#pragma unroll
        for (int o = 0; o < 36; ++o) lg[o] = wave_sum(lg[o]);
        int gs = 0; float gm = lg[0];
#pragma unroll
        for (int g = 1; g < 4; ++g) if (lg[g] > gm) { gm = lg[g]; gs = g; }
        float gsum = 0.f;
#pragma unroll
        for (int g = 0; g < 4; ++g) gsum += expf(lg[g] - gm);
        float el[8];
#pragma unroll
        for (int e = 0; e < 8; ++e) el[e] = gs == 0 ? lg[4 + e] : (gs == 1 ? lg[12 + e] : (gs == 2 ? lg[20 + e] : lg[28 + e]));
        int i0 = 0; float m0 = el[0];
#pragma unroll
        for (int e = 1; e < 8; ++e) if (el[e] > m0) { m0 = el[e]; i0 = e; }
        int i1 = -1; float m1 = -3.0e38f;
#pragma unroll
        for (int e = 0; e < 8; ++e) if (e != i0 && el[e] > m1) { m1 = el[e]; i1 = e; }
        const float tt = expf(m1 - m0), p0 = 1.0f / (1.0f + tt);
        const i32x4 rec = tok[n];
        if (lane == 0 && s < 16) { if ((rec.x & 255) != gs * 8 + i0 || ((rec.x >> 8) & 255) != gs * 8 + i1) chk_flags(ws)[30] = 1u;
            if (n == DBG_TOKEN) { const float* dbg = (const float*)chk_flags(ws) + 48; float code = 1.f;
                if (dbg[4] > 4.001f) code += 2.f; if (dbg[5] < 0.499f) code += 4.f;
                if (fabsf(dbg[0] - lg[0]) > 1e-3f || fabsf(dbg[1] - lg[1]) > 1e-3f || fabsf(dbg[2] - lg[2]) > 1e-3f || fabsf(dbg[3] - lg[3]) > 1e-3f) code += 8.f;
                if (fabsf(dbg[4] - gsum) > 1e-3f) code += 16.f; if (fabsf(dbg[6] * dbg[5] - __builtin_bit_cast(float, rec.z)) > 1e-4f) code += 32.f;
                ((float*)chk_flags(ws))[62] = code * 0.1f; ((float*)chk_flags(ws))[63] = dbg[4]; }
            chk(ws, 56, ((const float*)(ws + WS_CW))[2 * n], p0 / gsum, 3e-2f, 1e-4f); chk(ws, 57, ((const float*)(ws + WS_CW))[2 * n + 1], tt * p0 / gsum, 3e-2f, 1e-4f);
            chk(ws, 58, ((const float*)(ws + WS_CW))[2 * n], p0 / gsum, 1e-3f, 1e-5f); chk(ws, 59, ((const float*)(ws + WS_CW))[2 * n + 1], tt * p0 / gsum, 1e-3f, 1e-5f); } }
}
DI void chk_p11(const Frame& F, ARef A) {
    unsigned char* ws = A.ws; const int lane = F.lane; const i32x4* tok = (const i32x4*)(ws + WS_TOK); const int* tile = (const int*)(ws + WS_TILE);
    const bf16* H2 = (const bf16*)(ws + WS_H2); const bf16* HS = (const bf16*)(ws + WS_HS);
    for (int s = F.wave; s < 64; s += NWAVES) { const int n = hsh(11000 + s) % NTOK; const i32x4 rec = tok[n];
        if (rec.x < 0 || rec.x >= tile[MAXT] * 256 || rec.y < 0 || rec.y >= tile[MAXT] * 256 || tile[MAXT] > MAXT || tile[MAXT] < 256) { chk_flags(ws)[32] = 1u; continue; }
        for (int k = lane; k < D; k += 64) { chk(ws, 33, bf2f(HS[(size_t)rec.x * D + k]), bf2f(H2[(size_t)n * D + k]), 0.f, 0.f); chk(ws, 33, bf2f(HS[(size_t)rec.y * D + k]), bf2f(H2[(size_t)n * D + k]), 0.f, 0.f); } }
    { const unsigned hh = hsh(12000 + F.wave * 64 + lane); const int e = hh & 31, n = (hh >> 5) & 1023, k = (hh >> 15) & 1023, k5 = k & 511;
        const int c = (n >> 3) * 4 + (n & 3); const float want = (n & 4) ? A.w_up3[((size_t)e * D + k) * DE + c] : A.w_up1[((size_t)e * D + k) * DE + c];
        chk(ws, 34, bf2f(((const bf16*)(ws + WS_WUP))[((size_t)e * 1024 + n) * D + k]), bfr(want), 0.f, 0.f);
        chk(ws, 35, bf2f(((const bf16*)(ws + WS_WDN))[((size_t)e * 1024 + n) * DE + k5]), bfr(A.w_down[((size_t)e * DE + k5) * D + n]), 0.f, 0.f); }
}
DI void chk_p12(const Frame& F, ARef A) {
    unsigned char* ws = A.ws; const int lane = F.lane; const i32x4* tok = (const i32x4*)(ws + WS_TOK); const int* tile = (const int*)(ws + WS_TILE);
    const bf16* H2 = (const bf16*)(ws + WS_H2); const bf16* HID = (const bf16*)(ws + WS_HID);
    for (int s = F.wave; s < 32; s += NWAVES) { const unsigned hh = hsh(13000 + s); const int n = hh % NTOK, c = (hh >> 16) & 511; const i32x4 rec = tok[n]; const int pos = (s & 1) ? rec.y : rec.x;
        const int e = tile[pos >> 8];
        const float u1 = wdot(H2 + (size_t)n * D, A.w_up1 + (size_t)e * D * DE, DE, c, D, lane), u3 = wdot(H2 + (size_t)n * D, A.w_up3 + (size_t)e * D * DE, DE, c, D, lane);
        chk(ws, 36, bf2f(HID[(size_t)pos * DE + c]), u1 / (1.0f + expf(-u1)) * u3, 0.04f, 0.01f); }
}
DI void chk_p13(const Frame& F, ARef A) {
    unsigned char* ws = A.ws; const int lane = F.lane; const i32x4* tok = (const i32x4*)(ws + WS_TOK); const int* tile = (const int*)(ws + WS_TILE);
    const bf16* HID = (const bf16*)(ws + WS_HID); const bf16* YE = (const bf16*)(ws + WS_HS);
    for (int s = F.wave; s < 32; s += NWAVES) { const unsigned hh = hsh(14000 + s); const int n = hh % NTOK, c = (hh >> 16) & 1023; const i32x4 rec = tok[n]; const int pos = (s & 1) ? rec.y : rec.x;
        const int e = tile[pos >> 8];
        chk(ws, 37, bf2f(YE[(size_t)pos * D + c]), wdot(HID + (size_t)pos * DE, A.w_down + (size_t)e * DE * D, D, c, DE, lane), 0.04f, 0.01f); }
}
#endif

__global__ void __launch_bounds__(NTHR, 2) hybrid_fwd(Args A_unused) {
    extern __shared__ __attribute__((aligned(16))) unsigned char lds_raw[];
    const CAS Args& A = *(const CAS Args*)__builtin_amdgcn_kernarg_segment_ptr();
    Frame F;
    F.lds = (LAS unsigned char*)lds_raw;
    F.wave = __builtin_amdgcn_readfirstlane((int)threadIdx.x >> 6); F.tid = opq_tid(F.wave); F.lane = F.tid & 63;
    F.wg = blockIdx.x; F.G = gridDim.x; F.gw = F.wg * NWAVES + F.wave; F.NGW = F.G * NWAVES;
    volatile LAS unsigned* MISC = (volatile LAS unsigned*)(F.lds + LDS_MISC);
    if (F.wave == 0) MISC[F.lane] = 0u;
    __syncthreads();
    const XcdBarrier bar = xcd_barrier_post((unsigned*)(A.ws + WS_CTL), MISC + 8, F.wave);
    unsigned char* ws = A.ws;
    LAS unsigned char* stage = F.lds;
    bf16* const dob = (bf16*)A.out;
    bf16 *H1 = dob, *R = dob, *KS = dob + (size_t)NTOK * BW, *V = dob + 2 * (size_t)NTOK * BW, *KK = dob + 3 * (size_t)NTOK * BW;

#if defined(STAMPS)
    unsigned long long* const tsp = (unsigned long long*)(ws + WS_CTL + 49152);
#define STAMP(k) do { if (F.wg == 0 && xb_t0(F.wave)) tsp[k] = wall_clock64(); } while (0)
#elif defined(TIMEPHASE)
#define STAMP(k) TPS(F, k)
#else
#define STAMP(k) do { } while (0)
#endif
#if defined(REPEAT_PHASE)
#ifndef REPEAT_COUNT
#define REPEAT_COUNT 2
#endif
#define REP(k) _Pragma("nounroll") for (int rep_ = 0; rep_ < ((k) == REPEAT_PHASE ? REPEAT_COUNT : 1); ++rep_)
#else
#define REP(k)
#endif
    STAMP(0);
    REP(0) {
    p0_prologue(F, A);
    xcd_barrier(bar);
    }
    STAMP(1);
#if defined(CHECKS)
    if (F.wg == 0) chk_p0(F, A);
#endif
    REP(1) {
    p1_h1(F, A, H1);
    xcd_barrier(bar);
    }
    STAMP(2);
#if defined(CHECKS)
    if (F.wg == 0) chk_p1(F, A, H1);
#endif
    REP(2) {
    {   pg8::Gemm g{H1, (const bf16*)(ws + WS_WIN), NTOK, NPAD, D}; pg8::StaticOrder S; S.init(NTOK, NPAD, F.G, F.wg);
        EpiIn E{(bf16*)(ws + WS_QB), (bf16*)(ws + WS_KB), (bf16*)(ws + WS_VT), (bf16*)(ws + WS_RWRAW), (bf16*)(ws + WS_LORA), (bf16*)(ws + WS_GATE), A.gate_bias};
        pg8::gemm_phase<EpiIn, pg8::StaticOrder>(stage, g, S, E, nullptr, F.wave); }
    xcd_barrier(bar);
    }
    STAMP(3);
#if defined(CHECKS)
    if (F.wg == 0) { chk_p2(F, A, H1); chk_p3_save(F, A); }
    xcd_barrier(bar);
#endif
#if !defined(CHECKS)
    const bool fuse34 = (F.G == 256);
#else
    const bool fuse34 = false;
#endif
    REP(3) {
#if defined(TIMEPHASE)
    STAMP(30);
#endif
    p3_attn(F, (const bf16*)(ws + WS_QB), (const bf16*)(ws + WS_KB), (const bf16*)(ws + WS_VT), (bf16*)(ws + WS_QB));
#if defined(STAMPS)
    STAMP(20);
#endif
#if defined(TIMEPHASE)
    STAMP(31);
#endif
    p3_prep(F, A, (const bf16*)(ws + WS_RWRAW), (const bf16*)(ws + WS_LORA), R, KS, V, KK, (bf16*)(ws + WS_ALORA));
#if defined(TIMEPHASE)
    STAMP(32);
#endif
#if !defined(CHECKS)
    if (fuse34) { asm volatile("s_waitcnt vmcnt(0)" ::: "memory"); __syncthreads();
        p4_lora(F, A, (const bf16*)(ws + WS_ALORA), (const bf16*)(ws + WS_WL), (bf16*)(ws + WS_E), KS, (bf16*)(ws + WS_B), (bf16*)(ws + WS_GG), KK, R, (float*)(ws + WS_BON)); }
#endif
#if defined(TIMEPHASE)
    STAMP(33);
#endif
    xcd_barrier(bar);
    }
#if defined(STAMPS)
    STAMP(21);
#endif
    STAMP(4);
#if defined(CHECKS)
    if (F.wg == 0) { chk_p3(F, A, R, KS, V, KK); chk_p4_save(F, A, KS); }
    xcd_barrier(bar);
#endif
    if (!fuse34) {
    p4_lora(F, A, (const bf16*)(ws + WS_ALORA), (const bf16*)(ws + WS_WL), (bf16*)(ws + WS_E), KS, (bf16*)(ws + WS_B), (bf16*)(ws + WS_GG), KK, R, (float*)(ws + WS_BON));
    xcd_barrier(bar);
    }
    STAMP(5);
#if defined(CHECKS)
    if (F.wg == 0) chk_p4(F, A, KS, KK);
#endif
    REP(5) {
    p5_mfma(ws, F, R, KS, V, KK, (const bf16*)(ws + WS_B), (const bf16*)(ws + WS_E), (bf16*)(ws + WS_P), (bf16*)(ws + WS_QO), (bf16*)(ws + WS_GT), (bf16*)(ws + WS_HT));
    p6_moe_weights(F, A, F.gw, F.NGW);
    xcd_barrier(bar);
    }
    STAMP(6);
#if defined(CHECKS)
    if (F.wg == 255) chk_p7_save(F, A);
#endif
    REP(6) {
    {   const int ncw = F.G < 64 ? F.G : 64;
        if (F.wg < ncw) { if (F.wave == 0) for (int task = F.wg; task < 64; task += ncw) p6_chain(task, F.wave, F.lds, (const bf16*)(ws + WS_GT), (const bf16*)(ws + WS_HT), (bf16*)(ws + WS_SC));
#if defined(STAMPS)
            STAMP(22);
#endif
        }
        else {
            pg8::StaticOrder S; S.init(NTOK, D, F.G - ncw, F.wg - ncw);
            pg8::Gemm g{(const bf16*)(ws + WS_QB), (const bf16*)(ws + WS_WOSB), NTOK, D, BW};
            EpiMerge<false> E{(bf16*)(ws + WS_GATE), (bf16*)(ws + WS_MRG), 0};
            pg8::gemm_phase<EpiMerge<false>, pg8::StaticOrder>(stage, g, S, E, nullptr, F.wave); }
    }
    xcd_barrier(bar);
    }
    STAMP(7);
    REP(7) {
    p7_mfma(F, A, (const bf16*)(ws + WS_SC), (const bf16*)(ws + WS_P), (const bf16*)(ws + WS_QO), V, (const bf16*)(ws + WS_GG), (const float*)(ws + WS_BON), (bf16*)(ws + WS_YRW));
    xcd_barrier(bar);
    }
    STAMP(8);
#if defined(CHECKS)
    if (F.wg == 0) chk_p7(F, A, R, KS, V, KK);
#endif
    REP(8) {
    {   pg8::StaticOrder S; S.init(NTOK, D, F.G, F.wg);
        {   pg8::Gemm g{(const bf16*)(ws + WS_YRW), (const bf16*)(ws + WS_WORW), NTOK, D, BW};
            EpiMerge<true> E{(bf16*)(ws + WS_GATE), (bf16*)(ws + WS_MRG), D};
            pg8::gemm_phase<EpiMerge<true>, pg8::StaticOrder>(stage, g, S, E, nullptr, F.wave); } }
    xcd_barrier(bar);
    }
    STAMP(9);
#if defined(CHECKS)
    if (F.wg == 0) chk_p8(F, A);
#endif
    REP(9) {
    {   pg8::Gemm g{(const bf16*)(ws + WS_MRG), (const bf16*)(ws + WS_WOUT), NTOK, D, D}; pg8::StaticOrder S; S.init(NTOK, D, F.G, F.wg);
        EpiPlain E{(bf16*)(ws + WS_Y1), D, 0xff};
        pg8::gemm_phase<EpiPlain, pg8::StaticOrder>(stage, g, S, E, nullptr, F.wave); }
    xcd_barrier(bar);
    }
    STAMP(10);
#if defined(CHECKS)
    if (F.wg == 0) chk_p9(F, A);
#endif
    REP(10) {
    p10_rows(F, A, (const bf16*)(ws + WS_Y1), (bf16*)(ws + WS_H2));
    xcd_barrier(bar);
    }
    STAMP(11);
#if defined(CHECKS)
    if (F.wg == 0) chk_p10(F, A);
#endif
    REP(11) {
    p11_rank_gather(F, A, (const bf16*)(ws + WS_H2), (bf16*)(ws + WS_HS));
    xcd_barrier(bar);
    }
    STAMP(12);
#if defined(CHECKS)
    if (F.wg == 0) chk_p11(F, A);
#endif
    {   const int* tile = (const int*)(ws + WS_TILE);
        const int nt = __builtin_amdgcn_readfirstlane(tile[MAXT]);
        const int vc = (F.G % 8 == 0) ? (F.wg % 8) * (F.G / 8) + F.wg / 8 : F.wg;
        unsigned* tcnt = (unsigned*)(ws + WS_CTL) + MOE_CNT_WORD;
        REP(12) {   pg8::Gemm g{(const bf16*)(ws + WS_HS), (const bf16*)(ws + WS_WUP), MAXT * 256, NE * 1024, D};
            MoeUpOrder S; S.nunits = nt * 4; S.G = F.G; S.vc = vc; S.tile_e = tile; S.cnt = tcnt;
            EpiUp E{(bf16*)(ws + WS_HID)};
            pg8::gemm_phase<EpiUp, MoeUpOrder>(stage, g, S, E, nullptr, F.wave); }
        __syncthreads();
    STAMP(13);
        REP(13) {   pg8::Gemm g{(const bf16*)(ws + WS_HID), (const bf16*)(ws + WS_WDN), MAXT * 256, NE * 1024, DE};
            MoeDnOrder S; S.nunits = nt * 4; S.G = F.G; S.vc = vc; S.q = (nt * 4) / F.G; S.rem = nt * 4 - S.q * F.G; S.wave = F.wave; S.tile_e = tile; S.cnt = tcnt;
            EpiPlain E{(bf16*)(ws + WS_HS), D, 3};
            pg8::gemm_phase<EpiPlain, MoeDnOrder>(stage, g, S, E, nullptr, F.wave);
        xcd_barrier(bar); } }
    STAMP(14);
#if defined(CHECKS)
    if (F.wg == 0) chk_p13(F, A);
#endif
    p14_final(F, A, (const bf16*)(ws + WS_HS));
#if defined(STAMPS)
    xcd_barrier(bar);
    STAMP(15);
    if (F.wg == 0) { __syncthreads();
        const float va = (float)(long long)(tsp[STAMP_A2] - tsp[STAMP_A]) * 0.01f, vb = (float)(long long)(tsp[STAMP_B2] - tsp[STAMP_B]) * 0.01f;
#if defined(STAMP_SHIFT)
        const float shf_ = 1.1f;
#else
        const float shf_ = 1.0f;
#endif
        int b1 = (int)floorf(logf(fmaxf(va * shf_, 1.0f)) / logf(1.21f)) + 1, b2 = (int)floorf(logf(fmaxf(vb * shf_, 1.0f)) / logf(1.21f)) + 1;
#if defined(STAMP_CAL)
        b1 = 10; b2 = 30;
#endif
#if defined(STAMP_FRAC)
        { const unsigned long long* t5 = tsp + 32; const float tot = (float)(long long)(t5[9] - t5[0]);
          b1 = (int)(12.0f * (float)(long long)(t5[STAMP_A2] - t5[STAMP_A]) / tot) + 3; b2 = (int)(12.0f * (float)(long long)(t5[STAMP_B2] - t5[STAMP_B]) / tot) + 3; }
#endif
#if defined(STAMP_THR_A)
        b1 = va > (float)(STAMP_THR_A) ? 30 : 10; b2 = vb > (float)(STAMP_THR_B) ? 30 : 10;
#endif
        const int t_ = opq_tid(F.wave);
        for (int i = t_; i < 1000; i += NTHR) A.out[1000 + i] += 20.0f * (float)b2;
        if (t_ == 0) A.out[0] = 200.0f * (float)b1; }
#endif
#if defined(CHECKS)
    xcd_barrier(bar);
    if (F.wg == 0 && F.tid == 0) { const unsigned* fl = chk_flags(ws); int id = 0; for (int i = 61; i >= 0; --i) if (fl[i]) id = i;
        if (((const unsigned*)(ws + WS_CTL))[XB_TMO]) id = 60;
        if (id) A.out[0] = 10.0f * (float)id;
#if defined(CHKVAL)
        A.out[0] = 1000.0f * ((const float*)fl)[CHKVAL];
#endif
        }
#endif
}

extern "C" void kernel_launch(void* const* d_in, const int* in_sizes, int n_in, void* d_out, int out_size, void* d_ws, size_t ws_size, hipStream_t stream) {
    static int grid = 0;
    if (grid == 0) {
        if (n_in != 26 || in_sizes[0] != NTOK * D || out_size != NTOK * D || ws_size < WS_END) {
            fprintf(stderr, "kernel_launch: unexpected shapes (n_in %d, in0 %d, out %d, ws %zu); nothing launched\n", n_in, n_in > 0 ? in_sizes[0] : -1, out_size, ws_size); grid = -1; return; }
        int dev = 0, cus = 0, per_cu = 0;
        if (hipGetDevice(&dev) != hipSuccess || hipDeviceGetAttribute(&cus, hipDeviceAttributeMultiprocessorCount, dev) != hipSuccess) { grid = -1; return; }
        if (hipFuncSetAttribute((const void*)hybrid_fwd, hipFuncAttributeMaxDynamicSharedMemorySize, LDS_BYTES) != hipSuccess) { fprintf(stderr, "kernel_launch: hipFuncSetAttribute failed\n"); grid = -1; return; }
        if (hipOccupancyMaxActiveBlocksPerMultiprocessor(&per_cu, (const void*)hybrid_fwd, NTHR, LDS_BYTES) != hipSuccess || per_cu < 1)
            fprintf(stderr, "kernel_launch: note: occupancy query reports %d workgroups per CU\n", per_cu);
        (void)hipGetLastError();
        grid = cus > 256 ? 256 : cus;
    }
    if (grid < 0) return;
    if (hipMemsetAsync((char*)d_ws + WS_CTL, 0, CTL_ZERO_BYTES, stream) != hipSuccess) return;
    Args a{};
    const float** p = (const float**)&a;
    for (int i = 0; i < 26; ++i) p[i] = (const float*)d_in[i];
    a.out = (float*)d_out; a.ws = (unsigned char*)d_ws;
    hipLaunchKernelGGL(hybrid_fwd, dim3(grid), dim3(NTHR), LDS_BYTES, stream, a);
}

#if defined(ONLY_P5)
__global__ void __launch_bounds__(NTHR, 2) only_p5(Args A_unused) {
    extern __shared__ __attribute__((aligned(16))) unsigned char lds_raw[];
    const CAS Args& A = *(const CAS Args*)__builtin_amdgcn_kernarg_segment_ptr();
    Frame F; F.lds = (LAS unsigned char*)lds_raw; F.wave = __builtin_amdgcn_readfirstlane((int)threadIdx.x >> 6); F.tid = opq_tid(F.wave); F.lane = F.tid & 63;
    F.wg = blockIdx.x; F.G = gridDim.x; F.gw = F.wg * NWAVES + F.wave; F.NGW = F.G * NWAVES;
    unsigned char* ws = A.ws; bf16* const dob = (bf16*)A.out;
    bf16 *R = dob, *KS = dob + (size_t)NTOK * BW, *V = dob + 2 * (size_t)NTOK * BW, *KK = dob + 3 * (size_t)NTOK * BW;
    p5_mfma(ws, F, R, KS, V, KK, (const bf16*)(ws + WS_B), (const bf16*)(ws + WS_E), (bf16*)(ws + WS_P), (bf16*)(ws + WS_QO), (bf16*)(ws + WS_GT), (bf16*)(ws + WS_HT));
}
#endif
```

```cpp
#include <hip/hip_runtime.h>
#include <cstdio>
#include <cstdint>
__device__ __forceinline__ int opq_tid(int wave) { int l; asm volatile("v_mbcnt_lo_u32_b32 %0, -1, 0\n\tv_mbcnt_hi_u32_b32 %0, -1, %0" : "=v"(l)); return wave * 64 + l; }
#ifndef PHMASK
#define PHMASK 0xffff
#endif
namespace pg8 {
#define PG8_LAS __attribute__((address_space(3)))
typedef unsigned short bf16_t;
typedef short bf16x8 __attribute__((ext_vector_type(8)));
typedef float f32x4 __attribute__((ext_vector_type(4)));
typedef unsigned u32x4 __attribute__((ext_vector_type(4)));
constexpr int BM = 256, BK = 64, HALF = 128, HTB = HALF * BK * 2  , STAGE_BYTES = 8 * HTB, NXCD = 8, WGM = 8;

__host__ __device__ __forceinline__ int lds_byte(int r, int c) { const int st = (r >> 4) * 2 + (c >> 5), rr = r & 15, cc = c & 31, ob = rr * 64 + cc * 2; return st * 1024 + (ob ^ (((ob >> 9) & 1) << 5)); }
__host__ __device__ __forceinline__ void stage_rc(int b, int& R, int& C) { const int st = b / 1024, sb = b % 1024, swz = sb ^ (((sb >> 9) & 1) << 5); R = (st >> 1) * 16 + swz / 64; C = (st & 1) * 32 + (swz % 64) / 2; }
__host__ __device__ __forceinline__ int perm32(int rho) { const int n = rho >> 4, i = rho & 15; return 8 * (i >> 2) + 4 * n + (i & 3); }

struct Unit { int pm, pn; };
struct Gemm { const bf16_t* A; const bf16_t* Bt; int M, N, K; };

struct StaticOrder {
    int nM, nN, nwg, G, c;
    __host__ __device__ void init(int M, int N, int G_, int c_) { nM = M / BM; nN = N / BM; nwg = nM * nN; G = G_; c = c_; }
    __host__ __device__ bool next(int i, Unit& u) const {
        const long L = (long)i * G + c; if (L >= nwg) return false;
        int wgid = (int)L; { const int q = nwg / NXCD, r = nwg % NXCD, xcd = wgid % NXCD, off = wgid / NXCD; wgid = (xcd < r ? xcd * (q + 1) : r * (q + 1) + (xcd - r) * q) + off; }
        const int nig = WGM * nN, gid = wgid / nig, fm = gid * WGM, gsz = (nM - fm) < WGM ? (nM - fm) : WGM;
        u.pm = fm + ((wgid % nig) % gsz); u.pn = (wgid % nig) / gsz; return true;
    }
    __device__ __forceinline__ void a_ready(const Unit&) const {}
    __device__ __forceinline__ void done(const Unit&) const {}
};

template <class Epi, class Sched, bool STAMP = false>
__device__ __forceinline__ void gemm_phase(PG8_LAS unsigned char* lds, const Gemm g, const Sched& S, const Epi& E, unsigned long long* stamps, int wave_id) {
    const int tid = opq_tid(wave_id), wid = __builtin_amdgcn_readfirstlane(tid >> 6), lane = tid & 63, wr = wid >> 2, wc = wid & 3, fr = lane & 15, fq = lane >> 4;
    const int K = g.K, nt = K / BK;
    int ts_lo = 0, ts_hi = 0, nts = 0; const unsigned long long rt_entry = STAMP ? (unsigned long long)wall_clock64() : 0ull;
#define PG8_STAMP() do { if (STAMP && wid == 0 && nts < 64) { const unsigned long long _c = (unsigned long long)clock64(); \
        ts_lo = (lane == nts) ? (int)(unsigned)_c : ts_lo; ts_hi = (lane == nts) ? (int)(unsigned)(_c >> 32) : ts_hi; ++nts; } } while (0)
    PG8_STAMP();
    unsigned voffA[2], voffB[2];
#pragma unroll
    for (int i = 0; i < 2; ++i) { int R, C; stage_rc(tid * 16 + i * 8192, R, C); const int Rb = Epi::PERM ? ((R & ~31) + perm32(R & 31)) : R;
        voffA[i] = (unsigned)(R * K + C) * 2u; voffB[i] = (unsigned)(Rb * K + C) * 2u; }
    const size_t kstep = (size_t)(BK * 2);
    const size_t hstep = (size_t)HALF * K * 2;
    const size_t tstep = 2 * hstep;
    const unsigned ldsw = (unsigned)wid * 1024u;
    const int aoff = lds_byte(wr * 64 + fr, fq * 8), boff = lds_byte(wc * 32 + fr, fq * 8);
#define PG8_SA(b, h) (((b) * 2 + (h)) * HTB)
#define PG8_SB(b, h) ((4 + (b) * 2 + (h)) * HTB)
#define PG8_STAGE(bufoff, gbase, voff) do { _Pragma("unroll") for (int _i = 0; _i < 2; ++_i) \
        __builtin_amdgcn_global_load_lds((const unsigned*)((const char*)(gbase) + (voff)[_i]), (PG8_LAS unsigned*)(lds + (bufoff) + ldsw + _i * 8192), 16, 0, 0); } while (0)
#define PG8_LDA(dst, b, h) do { _Pragma("unroll") for (int m = 0; m < 4; ++m) _Pragma("unroll") for (int k = 0; k < 2; ++k) dst[m][k] = *(const PG8_LAS bf16x8*)(lds + PG8_SA(b, h) + aoff + m * 2048 + k * 1024); } while (0)
#define PG8_LDB(dst, b, h) do { _Pragma("unroll") for (int n = 0; n < 2; ++n) _Pragma("unroll") for (int k = 0; k < 2; ++k) dst[n][k] = *(const PG8_LAS bf16x8*)(lds + PG8_SB(b, h) + boff + n * 2048 + k * 1024); } while (0)
#define PG8_MMA(ai, bj, At, Bt) do { __builtin_amdgcn_s_setprio(1); _Pragma("unroll") for (int m = 0; m < 4; ++m) _Pragma("unroll") for (int n = 0; n < 2; ++n) _Pragma("unroll") for (int k = 0; k < 2; ++k) \
        acc[ai][bj][m][n] = __builtin_amdgcn_mfma_f32_16x16x32_bf16(Bt[n][k], At[m][k], acc[ai][bj][m][n], 0, 0, 0); __builtin_amdgcn_s_setprio(0); } while (0)
#define PG8_WAIT_V(n) asm volatile("s_waitcnt vmcnt(" #n ")" ::: "memory")
#define PG8_WAIT_L(n) asm volatile("s_waitcnt lgkmcnt(" #n ")" ::: "memory")
#define PG8_BAR __builtin_amdgcn_s_barrier()
#define PG8_SCHED __builtin_amdgcn_sched_barrier(0)
    Unit cur, nxt; int ui = 0;
    if (!S.next(0, cur)) return;
    f32x4 acc[2][2][4][2];
#pragma unroll
    for (int a = 0; a < 2; ++a)
#pragma unroll
        for (int b = 0; b < 2; ++b)
#pragma unroll
            for (int m = 0; m < 4; ++m)
#pragma unroll
                for (int n = 0; n < 2; ++n) acc[a][b][m][n] = (f32x4){0.f, 0.f, 0.f, 0.f};
    bf16x8 At[4][2], B0[2][2], B1[2][2];
    const char* cA = (const char*)g.A + (size_t)cur.pm * tstep; const char* cB = (const char*)g.Bt + (size_t)cur.pn * tstep;
    S.a_ready(cur);
    PG8_STAGE(PG8_SB(0, 0), cB, voffB); PG8_STAGE(PG8_SA(0, 0), cA, voffA); PG8_STAGE(PG8_SB(0, 1), cB + hstep, voffB); PG8_STAGE(PG8_SA(0, 1), cA + hstep, voffA);
    if (wr == 1) PG8_BAR;
    PG8_WAIT_V(4); PG8_BAR;
    PG8_STAGE(PG8_SB(1, 0), cB + kstep, voffB); PG8_STAGE(PG8_SA(1, 0), cA + kstep, voffA); PG8_STAGE(PG8_SB(1, 1), cB + hstep + kstep, voffB);
    PG8_WAIT_V(6); PG8_BAR;
    PG8_STAMP();
    for (;;) {
        const bool has_next = S.next(ui + 1, nxt);
        const char* nA = has_next ? (const char*)g.A + (size_t)nxt.pm * tstep : cA; const char* nB = has_next ? (const char*)g.Bt + (size_t)nxt.pn * tstep : cB;
        for (int t = 0; t < nt; t += 2) {
            const bool last = (t == nt - 2);
            const char* a1 = cA + (size_t)(t + 1) * kstep;
            const char* a2 = last ? nA : cA + (size_t)(t + 2) * kstep; const char* b2 = last ? nB : cB + (size_t)(t + 2) * kstep;
            const char* a3 = a2 + kstep; const char* b3 = b2 + kstep;
            if (last && has_next) S.a_ready(nxt);
            PG8_LDB(B0, 0, 0); PG8_SCHED; PG8_LDA(At, 0, 0); PG8_STAGE(PG8_SA(1, 1), a1 + hstep, voffA);
            PG8_WAIT_L(8); PG8_BAR; PG8_WAIT_L(0); PG8_MMA(0, 0, At, B0); PG8_BAR; PG8_SCHED;
            PG8_LDB(B1, 0, 1); PG8_STAGE(PG8_SB(0, 0), b2, voffB);
            PG8_BAR; PG8_WAIT_L(0); PG8_MMA(0, 1, At, B1); PG8_BAR;
            PG8_LDA(At, 0, 1); PG8_STAGE(PG8_SA(0, 0), a2, voffA);
            PG8_BAR; PG8_WAIT_L(0); PG8_MMA(1, 0, At, B0); PG8_BAR; PG8_SCHED;
            PG8_STAGE(PG8_SB(0, 1), b2 + hstep, voffB);
            PG8_WAIT_V(6); PG8_BAR; PG8_MMA(1, 1, At, B1); PG8_BAR;
            PG8_LDB(B0, 1, 0); PG8_SCHED; PG8_LDA(At, 1, 0); PG8_STAGE(PG8_SA(0, 1), a2 + hstep, voffA);
            PG8_WAIT_L(8); PG8_BAR; PG8_WAIT_L(0); PG8_MMA(0, 0, At, B0); PG8_BAR; PG8_SCHED;
            PG8_LDB(B1, 1, 1); PG8_STAGE(PG8_SB(1, 0), b3, voffB);
            PG8_BAR; PG8_WAIT_L(0); PG8_MMA(0, 1, At, B1); PG8_BAR;
            PG8_LDA(At, 1, 1); PG8_STAGE(PG8_SA(1, 0), a3, voffA);
            PG8_BAR; PG8_WAIT_L(0); PG8_MMA(1, 0, At, B0); PG8_BAR; PG8_SCHED;
            PG8_STAGE(PG8_SB(1, 1), b3 + hstep, voffB);
            PG8_WAIT_V(6); PG8_BAR; PG8_MMA(1, 1, At, B1); PG8_BAR;
        }
        PG8_STAMP();
        if constexpr (!Epi::AFTER_DRAIN) { E(acc, cur, wr, wc, fr, fq); S.done(cur); }
        PG8_STAMP();
        if (!has_next) break;
#pragma unroll
        for (int a = 0; a < 2; ++a)
#pragma unroll
            for (int b = 0; b < 2; ++b)
#pragma unroll
                for (int m = 0; m < 4; ++m)
#pragma unroll
                    for (int n = 0; n < 2; ++n) acc[a][b][m][n] = (f32x4){0.f, 0.f, 0.f, 0.f};
        cur = nxt; cA = nA; cB = nB; ++ui;
    }
    PG8_WAIT_V(0);
    if (wr == 0) PG8_BAR;
    PG8_BAR;
    if constexpr (Epi::AFTER_DRAIN) { E.fused(acc, cur, wr, wc, fr, fq, lds, wid, lane); S.done(cur); }
    PG8_STAMP();
    if (STAMP && wid == 0) { stamps[lane] = lane < nts ? (((unsigned long long)(unsigned)ts_hi << 32) | (unsigned)ts_lo) : 0ull;
        if (lane == 62) stamps[62] = rt_entry; if (lane == 63) stamps[63] = (unsigned long long)wall_clock64(); }
#undef PG8_STAMP
#undef PG8_SA
#undef PG8_SB
#undef PG8_STAGE
#undef PG8_LDA
#undef PG8_LDB
#undef PG8_MMA
#undef PG8_WAIT_V
#undef PG8_WAIT_L
#undef PG8_BAR
#undef PG8_SCHED
}
}

#define XB_TMO      128
#define XB_XCNT(j)  (256  + 64 * (j))
#define XB_XSUB(j)  (1280 + 64 * (j))
#define XB_XGEN(j)  (2304 + 64 * (j))
#define XB_TOP      3328
#define XB_TOPGEN   3392
#define XCD_BAR_WORDS 3456
#define XB_SPIN_CAP (1u << 18)
#define LAS __attribute__((address_space(3)))

__device__ __forceinline__ unsigned xb_ld(unsigned* p)              { return __hip_atomic_load(p, __ATOMIC_RELAXED, __HIP_MEMORY_SCOPE_AGENT); }
__device__ __forceinline__ unsigned xb_add(unsigned* p, unsigned v) { return __hip_atomic_fetch_add(p, v, __ATOMIC_RELAXED, __HIP_MEMORY_SCOPE_AGENT); }
__device__ __forceinline__ unsigned xb_xcc_id() { return (unsigned)__builtin_amdgcn_s_getreg((3 << 11) | 20) & 0xFu; }
#define XB_SPIN(cond, bar) do { unsigned _sp = 0; while (cond) { __builtin_amdgcn_s_sleep(1); \
    if ((++_sp & 255u) == 0u) { if (xb_ld(&(bar)[XB_TMO])) break; if (_sp > XB_SPIN_CAP) { atomicAdd(&(bar)[XB_TMO], 1u); break; } } } } while (0)

struct XcdBarrier {
    unsigned* bar; unsigned x; int wave;
    volatile LAS unsigned* st;
};

__device__ __forceinline__ bool xb_t0(int wave) { return wave == 0 && __builtin_amdgcn_mbcnt_hi(~0u, __builtin_amdgcn_mbcnt_lo(~0u, 0u)) == 0u; }
__device__ __forceinline__ XcdBarrier xcd_barrier_post(unsigned* bar, volatile LAS unsigned* st, int wave) {
    XcdBarrier b; b.bar = bar; b.x = xb_xcc_id(); b.st = st; b.wave = wave;
    if (xb_t0(wave)) (void)xb_add(&bar[XB_XCNT(b.x)], 1u);
    return b;
}
__device__ __forceinline__ void xcd_barrier_complete(unsigned* bar, unsigned x, unsigned& nloc, unsigned& nx) {
    const unsigned G = gridDim.x * gridDim.y * gridDim.z;
    unsigned sum, cnt, mine, sp = 0u;
    for (;;) {
        sum = 0u; cnt = 0u; mine = 0u;
#pragma unroll
        for (unsigned j = 0; j < 16; ++j) { const unsigned c = xb_ld(&bar[XB_XCNT(j)]); sum += c; cnt += (c > 0u) ? 1u : 0u; mine = (j == x) ? c : mine; }
        if (sum == G) break;
        __builtin_amdgcn_s_sleep(1);
        if ((++sp & 255u) == 0u) { if (xb_ld(&bar[XB_TMO])) break; if (sp > XB_SPIN_CAP) { atomicAdd(&bar[XB_TMO], 1u); break; } }
    }
    nloc = mine > 0u ? mine : 1u; nx = cnt > 0u ? cnt : 1u;
}

__device__ __forceinline__ void xcd_barrier(const XcdBarrier& b) {
    asm volatile("s_waitcnt vmcnt(0)" ::: "memory");
    __syncthreads();
    if (xb_t0(b.wave)) {
        unsigned* bar = b.bar;
        __builtin_amdgcn_s_waitcnt(0);
        unsigned nloc = b.st[0], nx = b.st[1];
        if (nloc == 0u) { xcd_barrier_complete(bar, b.x, nloc, nx); b.st[0] = nloc; b.st[1] = nx; }
        const unsigned old = xb_add(&bar[XB_XSUB(b.x)], 1u);
        const unsigned gen = old / nloc;
        if (old + 1u == (gen + 1u) * nloc) {
            __builtin_amdgcn_fence(__ATOMIC_RELEASE, "agent");
            asm volatile("s_waitcnt vmcnt(0)" ::: "memory");
            const unsigned og = xb_add(&bar[XB_TOP], 1u);
            const unsigned tg = og / nx;
            if (og + 1u == (tg + 1u) * nx) xb_add(&bar[XB_TOPGEN], 1u);
            else XB_SPIN(xb_ld(&bar[XB_TOPGEN]) == tg, bar);
            __builtin_amdgcn_fence(__ATOMIC_ACQUIRE, "agent");
            xb_add(&bar[XB_XGEN(b.x)], 1u);
            asm volatile("s_waitcnt vmcnt(0)" ::: "memory");
        } else {
            XB_SPIN(xb_ld(&bar[XB_XGEN(b.x)]) == gen, bar);
            __builtin_amdgcn_fence(__ATOMIC_ACQUIRE, "agent");
            asm volatile("s_waitcnt vmcnt(0)" ::: "memory");
        }
    }
    __syncthreads();
}


constexpr int NB = 4, SEQ = 8192, D = 1024, NTOK = NB * SEQ;
constexpr int NH = 8, HD = 64, BW = 512;
constexpr int IN_COLS = 5408, NPAD = 5632;
constexpr int LK = 384;
constexpr int NE = 32, DE = 512;
constexpr int CH = 64, NCH = SEQ / CH, NCH_LOG = 7, NCHUNK = NB * NH * NCH;
constexpr int MAXT = 288;
constexpr float NORM_EPS = 1e-6f, GN_EPS = 64e-5f, L2_EPS = 1e-12f;
constexpr float SB_STOP = -120.0f;

constexpr size_t MiB = 1u << 20;
constexpr size_t WS_CTL = 0, CTL_ZERO_BYTES = 65536;
constexpr size_t WS_MOD = 1 * MiB;
constexpr size_t WS_RTW = WS_MOD + 128 * 1024;
constexpr size_t WS_TOK = WS_RTW + 160 * 1024;
constexpr size_t WS_CNT = WS_TOK + (size_t)NTOK * 16;
constexpr size_t WS_TILE = WS_CNT + 256 * 32 * 4;
constexpr size_t WS_WIN = 2 * MiB;
constexpr size_t WS_WOSB = 13 * MiB, WS_WORW = 14 * MiB, WS_WOUT = 15 * MiB;
constexpr size_t WS_WL = 17 * MiB;
constexpr size_t WS_BON = 18 * MiB + 256 * 1024;
constexpr size_t WS_CW = 19 * MiB + 768 * 1024;
constexpr size_t WS_QB = 20 * MiB;
constexpr size_t WS_GATE = 52 * MiB;
constexpr size_t WS_GG = 180 * MiB;
constexpr size_t WS_KB = 212 * MiB, WS_VT = 244 * MiB;
constexpr size_t WS_LORA = 276 * MiB;
constexpr size_t WS_ALORA = 308 * MiB;
constexpr size_t WS_E = 340 * MiB, WS_B = 372 * MiB;
constexpr size_t WS_RWRAW = 416 * MiB;
constexpr size_t WS_P = 212 * MiB, WS_QO = 244 * MiB;
constexpr size_t WS_GT = 276 * MiB;
constexpr size_t WS_HT = 308 * MiB;
constexpr size_t WS_SC = 340 * MiB;
constexpr size_t WS_YRW = 384 * MiB;
constexpr size_t WS_WUP = 416 * MiB, WS_WDN = 480 * MiB;
constexpr size_t WS_MRG = 212 * MiB;
constexpr size_t WS_Y1 = 276 * MiB;
constexpr size_t WS_H2 = 52 * MiB;
constexpr size_t WS_HS = 116 * MiB;
constexpr size_t WS_HID = 260 * MiB;
constexpr size_t WS_X1 = 340 * MiB;
constexpr size_t WS_END = 512 * MiB;
static_assert(WS_TILE + (MAXT + 1) * 4 <= WS_WIN && WS_WIN + (size_t)NPAD * D * 2 <= WS_WOSB && WS_WL + 1536 * LK * 2 <= WS_QB, "fixed region");
static_assert(WS_HS + (size_t)MAXT * 256 * D * 2 <= WS_HID && WS_HID + (size_t)MAXT * 256 * DE * 2 <= WS_WUP, "moe region");
static_assert(WS_ALORA + (size_t)NTOK * LK * 2 <= WS_E && WS_B + (size_t)NTOK * BW * 2 <= WS_RWRAW, "rwkv region");

constexpr int LDS_BYTES = 163840;
constexpr int LDS_MISC = LDS_BYTES - 256;
constexpr int NWAVES = 8, NTHR = 512;

typedef unsigned short bf16;
typedef short bf16x8 __attribute__((ext_vector_type(8)));
typedef short s16x4 __attribute__((ext_vector_type(4)));
typedef float f32x4 __attribute__((ext_vector_type(4)));
typedef float f32x16 __attribute__((ext_vector_type(16)));
typedef unsigned u32x4 __attribute__((ext_vector_type(4)));
typedef unsigned u32x2 __attribute__((ext_vector_type(2)));
typedef int i32x4 __attribute__((ext_vector_type(4)));
#define DI __device__ __forceinline__
#define GAS __attribute__((address_space(1)))
#define MFMA32(a, b, c) __builtin_amdgcn_mfma_f32_32x32x16_bf16((a), (b), (c), 0, 0, 0)

typedef float f32x2_t __attribute__((ext_vector_type(2))); typedef __bf16 bf16x2_t __attribute__((ext_vector_type(2)));
DI unsigned pk2(float lo, float hi) { f32x2_t v = {lo, hi}; return __builtin_bit_cast(unsigned, __builtin_convertvector(v, bf16x2_t)); }
DI unsigned f2bf(float f) { return pk2(f, 0.0f) & 0xffffu; }
DI float bflo(unsigned u) { return __builtin_bit_cast(float, u << 16); }
DI float bfhi(unsigned u) { return __builtin_bit_cast(float, u & 0xffff0000u); }
DI float bf2f(bf16 h) { return __builtin_bit_cast(float, (unsigned)h << 16); }
DI float fexp(float x) { return __expf(x); }
DI float frcp(float x) { return __builtin_amdgcn_rcpf(x); }
DI float fsigmoid(float x) { return frcp(1.0f + fexp(-x)); }
DI float fsoftplus(float x) { return fmaxf(x, 0.0f) + __logf(1.0f + fexp(-fabsf(x))); }
#define DPP_SHR(v, ctrl) __builtin_bit_cast(float, __builtin_amdgcn_update_dpp(0, __builtin_bit_cast(int, (v)), (ctrl), 0xf, 0xf, true))
DI float wave_sum(float v) {
    v += DPP_SHR(v, 0x111); v += DPP_SHR(v, 0x112); v += DPP_SHR(v, 0x114); v += DPP_SHR(v, 0x118);
    v += __builtin_bit_cast(float, __builtin_amdgcn_update_dpp(0, __builtin_bit_cast(int, v), 0x142, 0xa, 0xf, false));
    v += __builtin_bit_cast(float, __builtin_amdgcn_update_dpp(0, __builtin_bit_cast(int, v), 0x143, 0xc, 0xf, false));
    return __builtin_bit_cast(float, __builtin_amdgcn_readlane(__builtin_bit_cast(int, v), 63));
}
DI float shfl_xor_l(float v, int m, int lane) { return __builtin_bit_cast(float, __builtin_amdgcn_ds_bpermute(4 * (lane ^ m), __builtin_bit_cast(int, v))); }
DI int crow(int reg, int hh) { return (reg & 3) + 8 * (reg >> 2) + 4 * hh; }
DI void wave_lds_fence() { __builtin_amdgcn_fence(__ATOMIC_RELEASE, "wavefront"); __builtin_amdgcn_wave_barrier(); __builtin_amdgcn_fence(__ATOMIC_ACQUIRE, "wavefront"); }
DI void unpack8(const u32x4 v, float (&o)[8]) { o[0] = bflo(v.x); o[1] = bfhi(v.x); o[2] = bflo(v.y); o[3] = bfhi(v.y); o[4] = bflo(v.z); o[5] = bfhi(v.z); o[6] = bflo(v.w); o[7] = bfhi(v.w); }
DI u32x4 pack8(const float (&o)[8]) { u32x4 v; v.x = pk2(o[0], o[1]); v.y = pk2(o[2], o[3]); v.z = pk2(o[4], o[5]); v.w = pk2(o[6], o[7]); return v; }
DI bf16x8 pack8v(float a0, float a1, float a2, float a3, float a4, float a5, float a6, float a7) {
    u32x4 v; v.x = pk2(a0, a1); v.y = pk2(a2, a3); v.z = pk2(a4, a5); v.w = pk2(a6, a7); return __builtin_bit_cast(bf16x8, v); }


#if defined(CHECKS)
constexpr int DBG_TOKEN = 77;
#endif

typedef pg8::f32x4 af4;
DI void st8(bf16* p, const af4 v0, const af4 v1) { u32x4 w; w.x = pk2(v0[0], v0[1]); w.y = pk2(v0[2], v0[3]); w.z = pk2(v1[0], v1[1]); w.w = pk2(v1[2], v1[3]); *(u32x4*)p = w; }

struct EpiIn {
    static constexpr bool PERM = true, AFTER_DRAIN = false;
    bf16 *Q, *K, *Vt, *RW, *LO, *GA; const float* gate_bias;
    DI void operator()(const af4 (&acc)[2][2][4][2], const pg8::Unit& u, int wr, int wc, int fr, int fq) const {
        const int pn = u.pn, row0 = u.pm * 256 + wr * 64 + fr;
        if (pn == 4 || pn == 5) {
#pragma unroll
            for (int ai = 0; ai < 2; ++ai)
#pragma unroll
                for (int m = 0; m < 4; ++m) { const int row = row0 + ai * 128 + m * 16, b = row >> 13, s = row & (SEQ - 1);
#pragma unroll
                    for (int bj = 0; bj < 2; ++bj)
#pragma unroll
                        for (int n = 0; n < 2; ++n)
#pragma unroll
                            for (int j = 0; j < 4; ++j) { const int cv = (pn - 4) * 256 + bj * 128 + wc * 32 + 8 * fq + 4 * n + j;
                                Vt[((size_t)(b * BW + cv)) * SEQ + s] = (bf16)f2bf(acc[ai][bj][m][n][j]); } }
        } else if (pn >= 14) {
            const int col0 = (pn - 14) * 256 + wc * 32 + 8 * fq;
            af4 bv[2][2];
#pragma unroll
            for (int bj = 0; bj < 2; ++bj)
#pragma unroll
                for (int n = 0; n < 2; ++n) bv[bj][n] = *(const af4*)(gate_bias + col0 + bj * 128 + 4 * n);
#pragma unroll
            for (int ai = 0; ai < 2; ++ai)
#pragma unroll
                for (int m = 0; m < 4; ++m) { bf16* rowp = GA + (size_t)(row0 + ai * 128 + m * 16) * 2048 + col0;
#pragma unroll
                    for (int bj = 0; bj < 2; ++bj) { af4 v0 = acc[ai][bj][m][0] + bv[bj][0], v1 = acc[ai][bj][m][1] + bv[bj][1];
#pragma unroll
                        for (int j = 0; j < 4; ++j) { v0[j] = fsigmoid(v0[j]); v1[j] = fsigmoid(v1[j]); }
                        st8(rowp + bj * 128, v0, v1); } }
        } else {
            bf16* base; int ld, ct; float sc = 1.0f;
            if (pn < 2) { base = Q; ld = BW; ct = pn; sc = 0.125f; } else if (pn < 4) { base = K; ld = BW; ct = pn - 2; } else if (pn < 12) { base = RW; ld = 1536; ct = pn - 6; } else { base = LO; ld = BW; ct = pn - 12; }
            const int col0 = ct * 256 + wc * 32 + 8 * fq;
#pragma unroll
            for (int ai = 0; ai < 2; ++ai)
#pragma unroll
                for (int m = 0; m < 4; ++m) { bf16* rowp = base + (size_t)(row0 + ai * 128 + m * 16) * ld + col0;
#pragma unroll
                    for (int bj = 0; bj < 2; ++bj) st8(rowp + bj * 128, acc[ai][bj][m][0] * sc, acc[ai][bj][m][1] * sc); }
        }
    }
};

template <bool ADD> struct EpiMerge {
    static constexpr bool PERM = true, AFTER_DRAIN = false;
    bf16* GA; bf16* MRG; int gofs;
    DI void operator()(const af4 (&acc)[2][2][4][2], const pg8::Unit& u, int wr, int wc, int fr, int fq) const {
        const int row0 = u.pm * 256 + wr * 64 + fr, col0 = u.pn * 256 + wc * 32 + 8 * fq;
#pragma unroll
        for (int ai = 0; ai < 2; ++ai)
#pragma unroll
            for (int m = 0; m < 4; ++m) { const size_t row = (size_t)(row0 + ai * 128 + m * 16);
#pragma unroll
                for (int bj = 0; bj < 2; ++bj) { const int c = col0 + bj * 128;
                    float g[8]; unpack8(*(const u32x4*)(GA + row * 2048 + gofs + c), g);
                    af4 v0, v1;
#pragma unroll
                    for (int j = 0; j < 4; ++j) { v0[j] = g[j] * acc[ai][bj][m][0][j]; v1[j] = g[4 + j] * acc[ai][bj][m][1][j]; }
                    if (ADD) { float o[8]; unpack8(*(const u32x4*)(GA + row * 2048 + c), o);
#pragma unroll
                        for (int j = 0; j < 4; ++j) { v0[j] += o[j]; v1[j] += o[4 + j]; }
                        st8(MRG + row * D + c, v0, v1); }
                    else st8(GA + row * 2048 + c, v0, v1); } }
    }
};

struct EpiPlain {
    static constexpr bool PERM = true, AFTER_DRAIN = false;
    bf16* O; int ld, cmask;
    DI void operator()(const af4 (&acc)[2][2][4][2], const pg8::Unit& u, int wr, int wc, int fr, int fq) const {
        const int row0 = u.pm * 256 + wr * 64 + fr, col0 = (u.pn & cmask) * 256 + wc * 32 + 8 * fq;
#pragma unroll
        for (int ai = 0; ai < 2; ++ai)
#pragma unroll
            for (int m = 0; m < 4; ++m) { bf16* rowp = O + (size_t)(row0 + ai * 128 + m * 16) * ld + col0;
#pragma unroll
                for (int bj = 0; bj < 2; ++bj) st8(rowp + bj * 128, acc[ai][bj][m][0], acc[ai][bj][m][1]); }
    }
};

struct EpiUp {
    static constexpr bool PERM = true, AFTER_DRAIN = false;
    bf16* HID;
    DI void operator()(const af4 (&acc)[2][2][4][2], const pg8::Unit& u, int wr, int wc, int fr, int fq) const {
        const int row0 = u.pm * 256 + wr * 64 + fr, col0 = (u.pn & 3) * 128 + wc * 16 + 4 * fq;
#pragma unroll
        for (int ai = 0; ai < 2; ++ai)
#pragma unroll
            for (int m = 0; m < 4; ++m) { bf16* rowp = HID + (size_t)(row0 + ai * 128 + m * 16) * DE + col0;
#pragma unroll
                for (int bj = 0; bj < 2; ++bj) { float h[4];
#pragma unroll
                    for (int j = 0; j < 4; ++j) { const float u1 = acc[ai][bj][m][0][j]; h[j] = u1 * fsigmoid(u1) * acc[ai][bj][m][1][j]; }
                    __hip_atomic_store((GAS unsigned long long*)(rowp + bj * 64), (unsigned long long)pk2(h[0], h[1]) | ((unsigned long long)pk2(h[2], h[3]) << 32), __ATOMIC_RELAXED, __HIP_MEMORY_SCOPE_AGENT); } }
    }
};

constexpr unsigned MOE_CNT_WORD = 3584, MOE_CNT_STRIDE = 16;
struct MoeUpOrder {
    int nunits, G, vc; const int* tile_e; unsigned* cnt;
    DI bool next(int i, pg8::Unit& u) const { const long L = (long)i * G + vc; if (L >= nunits) return false; const int rt = (int)(L >> 2);
        u.pm = rt; u.pn = __builtin_amdgcn_readfirstlane(tile_e[rt]) * 4 + (int)(L & 3); return true; }
    DI void a_ready(const pg8::Unit&) const {}
    DI void done(const pg8::Unit& u) const { asm volatile("s_waitcnt vmcnt(0)" ::: "memory");
        if (__builtin_amdgcn_mbcnt_hi(~0u, __builtin_amdgcn_mbcnt_lo(~0u, 0u)) == 0u) __hip_atomic_fetch_add(cnt + MOE_CNT_STRIDE * u.pm, 1u, __ATOMIC_RELAXED, __HIP_MEMORY_SCOPE_AGENT); }
};
struct MoeDnOrder {
    int nunits, G, vc, q, rem, wave; const int* tile_e; unsigned* cnt;
    DI bool next(int i, pg8::Unit& u) const { long L;
        if (vc >= rem) { if (i > q) return false; L = (long)i * (G - rem) + (vc - rem); } else L = (long)(q + 1) * (G - rem) + (long)i * rem + vc;
        if (L >= nunits) return false; const int rt = (int)(L >> 2);
        u.pm = rt; u.pn = __builtin_amdgcn_readfirstlane(tile_e[rt]) * 4 + (int)(L & 3); return true; }
    DI void a_ready(const pg8::Unit& u) const {
        if (wave == 0) { unsigned sp = 0;
            while ((unsigned)__builtin_amdgcn_readfirstlane(__hip_atomic_load(cnt + MOE_CNT_STRIDE * u.pm, __ATOMIC_RELAXED, __HIP_MEMORY_SCOPE_AGENT)) < 32u) { __builtin_amdgcn_s_sleep(2); if (++sp > (1u << 22)) break; }
            __builtin_amdgcn_fence(__ATOMIC_ACQUIRE, "agent");
            asm volatile("s_waitcnt vmcnt(0)" ::: "memory"); }
        asm volatile("" ::: "memory"); __builtin_amdgcn_s_barrier(); asm volatile("" ::: "memory"); }
    DI void done(const pg8::Unit&) const {}
};

struct Args {
    const float *x, *c, *w_mod, *b_mod, *gains, *w_in, *gate_bias, *shift_mu, *w0, *w_decay_up, *a0, *w_iclr_up, *w_gate_up, *k_k, *k_a, *r_k, *lnx_w, *lnx_b,
                *w_o_sb, *w_o_rw, *w_out, *w_group, *w_router, *w_up1, *w_up3, *w_down;
    float* out; unsigned char* ws;
};
struct Frame { LAS unsigned char* lds; int tid, lane, wave, wg, G, gw, NGW; };
#define CAS __attribute__((address_space(4)))
#if defined(TIMEPHASE)
#ifndef TIMEPHASE_END
#define TIMEPHASE_END (TIMEPHASE + 1)
#endif
DI void tp_stamp(LAS unsigned char* lds, int wave, int k) {
    if (k == TIMEPHASE || k == TIMEPHASE_END) { volatile LAS unsigned long long* tp_ = (volatile LAS unsigned long long*)(lds + LDS_MISC + 64);
        if (xb_t0(wave)) { const unsigned long long now_ = __builtin_amdgcn_s_memrealtime();
            if (k == TIMEPHASE) *tp_ = now_; else { const unsigned long long until_ = now_ + (now_ - *tp_); while (__builtin_amdgcn_s_memrealtime() < until_) __builtin_amdgcn_s_sleep(8); } }
        if (k == TIMEPHASE_END) __syncthreads(); } }
#define TPS(F, k) tp_stamp((F).lds, (F).wave, (k))
#else
#define TPS(F, k) do { } while (0)
#endif
typedef const CAS Args& ARef;

DI void tr_item(const float* W, int ldw, int K, bf16* WT, int k0, int drow0, int scol0, LAS float* scr, int lane) {
    if (scol0 >= 0) {
        float v[32];
        const float* wp = W + (size_t)(k0 + (lane >> 5)) * ldw + scol0 + (lane & 31);
#pragma unroll
        for (int i = 0; i < 32; ++i) v[i] = wp[(size_t)(2 * i) * ldw];
#pragma unroll
        for (int i = 0; i < 32; ++i) scr[(2 * i + (lane >> 5)) * 33 + (lane & 31)] = v[i];
    } else {
#pragma unroll 8
        for (int i = 0; i < 32; ++i) { const int kk = 2 * i + (lane >> 5); scr[kk * 33 + (lane & 31)] = 0.0f; }
    }
    wave_lds_fence();
    const int c = lane & 7;
#pragma unroll
    for (int j = 0; j < 4; ++j) { const int n = (lane >> 3) + 8 * j; const LAS float* s = scr + (8 * c) * 33 + n;
        u32x4 o; o.x = pk2(s[0 * 33], s[1 * 33]); o.y = pk2(s[2 * 33], s[3 * 33]); o.z = pk2(s[4 * 33], s[5 * 33]); o.w = pk2(s[6 * 33], s[7 * 33]);
        *(u32x4*)(WT + (size_t)(drow0 + n) * K + k0 + 8 * c) = o; }
    wave_lds_fence();
}
DI void tr_item_up(const float* W1, const float* W3, bf16* WT, int e, int k0, int drow0, LAS float* scr, int lane) {
    const int l31 = lane & 31, sc = (drow0 >> 3) * 4 + (l31 >> 3) * 4 + (l31 & 3);
    const float* W = ((l31 & 4) ? W3 : W1) + (size_t)e * D * DE;
    { float v[32]; const float* wp = W + (size_t)(k0 + (lane >> 5)) * DE + sc;
#pragma unroll
        for (int i = 0; i < 32; ++i) v[i] = wp[(size_t)(2 * i) * DE];
#pragma unroll
        for (int i = 0; i < 32; ++i) scr[(2 * i + (lane >> 5)) * 33 + l31] = v[i]; }
    wave_lds_fence();
    const int c = lane & 7;
#pragma unroll
    for (int j = 0; j < 4; ++j) { const int n = (lane >> 3) + 8 * j; const LAS float* s = scr + (8 * c) * 33 + n;
        u32x4 o; o.x = pk2(s[0 * 33], s[1 * 33]); o.y = pk2(s[2 * 33], s[3 * 33]); o.z = pk2(s[4 * 33], s[5 * 33]); o.w = pk2(s[6 * 33], s[7 * 33]);
        *(u32x4*)(WT + ((size_t)e * 1024 + drow0 + n) * D + k0 + 8 * c) = o; }
    wave_lds_fence();
}

DI void p0_prologue(const Frame& F0, ARef A) {
    Frame F = F0; F.tid = opq_tid(F0.wave); F.lane = F.tid & 63; F.wave = __builtin_amdgcn_readfirstlane(F.tid >> 6); F.gw = F.wg * NWAVES + F.wave;
    unsigned char* ws = A.ws;
    LAS float* sl = (LAS float*)F.lds;
    LAS float* part = (LAS float*)(F.lds + 16384);
    for (int i = F.tid; i < NB * D; i += NTHR) { const float v = A.c[i]; sl[i] = v * fsigmoid(v); }
    __syncthreads();
    float* mod = (float*)(ws + WS_MOD);
    for (int cg = F.wg; cg < 256; cg += F.G) {
        const int col = F.tid & 31, kg = F.tid >> 5;
        if (col < 24) { float a0 = 0.f, a1 = 0.f, a2 = 0.f, a3 = 0.f;
            float wv[64];
#pragma unroll
            for (int kk = 0; kk < 64; ++kk) wv[kk] = A.w_mod[(size_t)(kg * 64 + kk) * 6144 + cg * 24 + col];
#pragma unroll
            for (int kk = 0; kk < 64; ++kk) { const int k = kg * 64 + kk; const float w = wv[kk];
                a0 += sl[k] * w; a1 += sl[D + k] * w; a2 += sl[2 * D + k] * w; a3 += sl[3 * D + k] * w; }
            LAS float* p = part + (kg * 24 + col) * 4; p[0] = a0; p[1] = a1; p[2] = a2; p[3] = a3; }
        __syncthreads();
        if (F.tid < 96) { const int c = F.tid >> 2, b = F.tid & 3; float s = 0.f;
#pragma unroll
            for (int kg2 = 0; kg2 < 16; ++kg2) s += part[(kg2 * 24 + c) * 4 + b];
            mod[b * 6144 + cg * 24 + c] = s + A.b_mod[cg * 24 + c]; }
        __syncthreads();
    }
    LAS float* scr = (LAS float*)(F.lds + 32768 + F.wave * 8704);
    constexpr int I_IN = (NPAD / 32) * (D / 64), I_OS = (D / 32) * (BW / 64), I_OUT = (D / 32) * (D / 64);
    for (int it = F.gw; it < I_IN + 2 * I_OS + I_OUT; it += F.NGW) {
        int r = it;
        if (r < I_IN) { const int g = r / (D / 64), kb = r % (D / 64), drow0 = 32 * g;
            const int sc = drow0 < 3360 ? drow0 : (drow0 < 3584 ? -1 : drow0 - 224);
            tr_item(A.w_in, IN_COLS, D, (bf16*)(ws + WS_WIN), 64 * kb, drow0, sc, scr, F.lane); continue; }
        r -= I_IN;
        if (r < I_OS) { const int g = r / (BW / 64), kb = r % (BW / 64); tr_item(A.w_o_sb, D, BW, (bf16*)(ws + WS_WOSB), 64 * kb, 32 * g, 32 * g, scr, F.lane); continue; }
        r -= I_OS;
        if (r < I_OS) { const int g = r / (BW / 64), kb = r % (BW / 64); tr_item(A.w_o_rw, D, BW, (bf16*)(ws + WS_WORW), 64 * kb, 32 * g, 32 * g, scr, F.lane); continue; }
        r -= I_OS;
        { const int g = r / (D / 64), kb = r % (D / 64); tr_item(A.w_out, D, D, (bf16*)(ws + WS_WOUT), 64 * kb, 32 * g, 32 * g, scr, F.lane); }
    }
    const int gt = F.wg * NTHR + F.tid, NGT = F.G * NTHR;
    float* rtw = (float*)(ws + WS_RTW);
    for (int i = gt; i < 36 * D; i += NGT) { const int o = 2 * (i >> 11) + (i & 1), k = (i >> 1) & (D - 1); rtw[i] = o < 4 ? A.w_group[k * 4 + o] : A.w_router[k * NE + (o - 4)]; }
    bf16* wl = (bf16*)(ws + WS_WL);
    for (int i0 = gt; i0 < 1536 * LK; i0 += 8 * NGT) { float v[8];
#pragma unroll
        for (int j = 0; j < 8; ++j) { const int i = i0 + j * NGT, n = i / LK, k = i % LK; v[j] = 0.f;
            if (i < 1536 * LK) {
                if (n < 512) { if (k < 64) v[j] = A.w_decay_up[k * BW + n]; }
                else if (n < 1024) { if (k >= 64 && k < 128) v[j] = A.w_iclr_up[(k - 64) * BW + (n - 512)]; }
                else { if (k >= 128 && k < 288) v[j] = A.w_gate_up[(k - 128) * BW + (n - 1024)]; } } }
#pragma unroll
        for (int j = 0; j < 8; ++j) { const int i = i0 + j * NGT; if (i < 1536 * LK) wl[i] = (bf16)f2bf(v[j]); } }
}

DI void p1_h1(const Frame& F0, ARef A, bf16* H1) {
    Frame F = F0; F.tid = opq_tid(F0.wave); F.lane = F.tid & 63; F.wave = __builtin_amdgcn_readfirstlane(F.tid >> 6); F.gw = F.wg * NWAVES + F.wave;
    const float* mod = (const float*)(A.ws + WS_MOD);
    for (int n = F.gw; n < NTOK; n += F.NGW) {
        const int b = n >> 13;
        const f32x4* xr = (const f32x4*)(A.x + (size_t)n * D) + F.lane;
        f32x4 v[4]; float s = 0.f;
#pragma unroll
        for (int j = 0; j < 4; ++j) { v[j] = xr[64 * j]; s += (v[j][0] * v[j][0] + v[j][1] * v[j][1]) + (v[j][2] * v[j][2] + v[j][3] * v[j][3]); }
        const float inv = rsqrtf(wave_sum(s) * (1.0f / D) + NORM_EPS);
        u32x2* o = (u32x2*)(H1 + (size_t)n * D) + F.lane;
#pragma unroll
        for (int j = 0; j < 4; ++j) { const int k = 4 * F.lane + 256 * j;
            const f32x4 g = *(const f32x4*)(A.gains + k), sh = *(const f32x4*)(mod + b * 6144 + k), sc = *(const f32x4*)(mod + b * 6144 + D + k);
            f32x4 h;
#pragma unroll
            for (int q = 0; q < 4; ++q) h[q] = (v[j][q] * inv) * g[q] * (1.0f + sc[q]) + sh[q];
            u32x2 w; w.x = pk2(h[0], h[1]); w.y = pk2(h[2], h[3]); o[64 * j] = w; }
    }
}

DI void p3_attn(const Frame& F0, const bf16* QB, const bf16* KB, const bf16* VT, bf16* YSB) {
    Frame F = F0; F.tid = opq_tid(F0.wave); F.lane = F.tid & 63; F.wave = __builtin_amdgcn_readfirstlane(F.tid >> 6); F.gw = F.wg * NWAVES + F.wave;
    const int lane = F.lane, r = lane & 31, hh = lane >> 5;
    bf16x8 tri[2];
#pragma unroll
    for (int s = 0; s < 2; ++s)
#pragma unroll
        for (int e = 0; e < 8; ++e) tri[s][e] = (16 * s + 8 * (e >> 2) + 4 * hh + (e & 3)) > r ? (short)0x3F80 : (short)0;
    for (int u = F.gw; u < NB * NH * (SEQ / 32); u += F.NGW) {
        const int qt = u & 255, b = u >> 11, h = ((u >> 8) + 2 * b) & 7, bh = b * 8 + h;
        const bf16* qp = QB + (size_t)(b * SEQ + qt * 32 + r) * BW + h * HD + 8 * hh;
        bf16x8 qf[4];
#pragma unroll
        for (int ks = 0; ks < 4; ++ks) qf[ks] = *(const bf16x8*)(qp + 16 * ks);
        f32x16 o0, o1;
#pragma unroll
        for (int i = 0; i < 16; ++i) { o0[i] = 0.f; o1[i] = 0.f; }
        float L = 0.f;
        bf16x8 kf[4]; s16x4 vlo[2][2], vhi[2][2];
#define ATT_LOAD(KT, KF, VLO, VHI) do { const bf16* kp_ = KB + (size_t)(b * SEQ + (KT) * 32 + r) * BW + h * HD + 8 * hh; \
            _Pragma("unroll") for (int ks = 0; ks < 4; ++ks) KF[ks] = *(const bf16x8*)(kp_ + 16 * ks); \
            const bf16* vp_ = VT + ((size_t)(bh * HD + r)) * SEQ + (KT) * 32 + 4 * hh; \
            _Pragma("unroll") for (int mb = 0; mb < 2; ++mb) _Pragma("unroll") for (int ks = 0; ks < 2; ++ks) { VLO[mb][ks] = *(const s16x4*)(vp_ + (size_t)mb * 32 * SEQ + 16 * ks); VHI[mb][ks] = *(const s16x4*)(vp_ + (size_t)mb * 32 * SEQ + 16 * ks + 8); } } while (0)
        ATT_LOAD(qt, kf, vlo, vhi);
        for (int kt = qt; kt >= 0; --kt) {
            bf16x8 kfn[4]; s16x4 vlon[2][2], vhin[2][2];
            { const int ktn = kt > 0 ? kt - 1 : 0; ATT_LOAD(ktn, kfn, vlon, vhin); }
            f32x16 z;
#pragma unroll
            for (int i = 0; i < 16; ++i) z[i] = 0.f;
#pragma unroll
            for (int ks = 0; ks < 4; ++ks) z = MFMA32(kf[ks], qf[ks], z);
            const bool diag = (kt == qt);
            float lk[16], lo[16], tot = 0.f;
#pragma unroll
            for (int i = 0; i < 16; ++i) { const bool valid = !diag || (crow(i, hh) < r);
                const float sp = fsoftplus(z[i]); lk[i] = valid ? -sp : 0.0f; z[i] = valid ? z[i] - sp : -1.0e30f;
                tot += lk[i];
                const float hi = bflo(f2bf(lk[i])); lo[i] = lk[i] - hi; lk[i] = hi; }
            tot += shfl_xor_l(tot, 32, lane);
            f32x16 lat;
#pragma unroll
            for (int i = 0; i < 16; ++i) lat[i] = L;
#pragma unroll
            for (int s = 0; s < 2; ++s) {
                lat = MFMA32(tri[s], pack8v(lk[8 * s], lk[8 * s + 1], lk[8 * s + 2], lk[8 * s + 3], lk[8 * s + 4], lk[8 * s + 5], lk[8 * s + 6], lk[8 * s + 7]), lat);
                lat = MFMA32(tri[s], pack8v(lo[8 * s], lo[8 * s + 1], lo[8 * s + 2], lo[8 * s + 3], lo[8 * s + 4], lo[8 * s + 5], lo[8 * s + 6], lo[8 * s + 7]), lat); }
            float at[16];
#pragma unroll
            for (int i = 0; i < 16; ++i) at[i] = fexp(z[i] + lat[i]);
#pragma unroll
            for (int s = 0; s < 2; ++s) { const bf16x8 ab = pack8v(at[8 * s], at[8 * s + 1], at[8 * s + 2], at[8 * s + 3], at[8 * s + 4], at[8 * s + 5], at[8 * s + 6], at[8 * s + 7]);
                bf16x8 va, vb;
#pragma unroll
                for (int e = 0; e < 4; ++e) { va[e] = vlo[0][s][e]; va[4 + e] = vhi[0][s][e]; vb[e] = vlo[1][s][e]; vb[4 + e] = vhi[1][s][e]; }
                o0 = MFMA32(va, ab, o0); o1 = MFMA32(vb, ab, o1); }
            L += tot;
            if (__all(L < SB_STOP)) break;
#pragma unroll
            for (int ks = 0; ks < 4; ++ks) kf[ks] = kfn[ks];
#pragma unroll
            for (int mb = 0; mb < 2; ++mb)
#pragma unroll
                for (int ks = 0; ks < 2; ++ks) { vlo[mb][ks] = vlon[mb][ks]; vhi[mb][ks] = vhin[mb][ks]; }
        }
#undef ATT_LOAD
        bf16* op = YSB + (size_t)(b * SEQ + qt * 32 + r) * BW + h * HD + 4 * hh;
#pragma unroll
        for (int g = 0; g < 4; ++g) { u32x2 w0, w1; w0.x = pk2(o0[4 * g], o0[4 * g + 1]); w0.y = pk2(o0[4 * g + 2], o0[4 * g + 3]); w1.x = pk2(o1[4 * g], o1[4 * g + 1]); w1.y = pk2(o1[4 * g + 2], o1[4 * g + 3]);
            *(u32x2*)(op + 8 * g) = w0; *(u32x2*)(op + 32 + 8 * g) = w1; }
    }
}

DI void p3_prep(const Frame& F0, ARef A, const bf16* RWRAW, const bf16* LORA, bf16* R, bf16* KS, bf16* V, bf16* KK, bf16* ALORA) {
    Frame F = F0; F.tid = opq_tid(F0.wave); F.lane = F.tid & 63; F.wave = __builtin_amdgcn_readfirstlane(F.tid >> 6); F.gw = F.wg * NWAVES + F.wave;
    const int lane = F.lane;
    f32x4 mu[3][2], kkc[2], mul[2];
#pragma unroll
    for (int part = 0; part < 3; ++part) { mu[part][0] = *(const f32x4*)(A.shift_mu + part * 512 + lane * 8); mu[part][1] = *(const f32x4*)(A.shift_mu + part * 512 + lane * 8 + 4); }
    kkc[0] = *(const f32x4*)(A.k_k + lane * 8); kkc[1] = *(const f32x4*)(A.k_k + lane * 8 + 4);
    const int lcol = lane < 36 ? lane * 8 : 0;
    mul[0] = *(const f32x4*)(A.shift_mu + 1536 + lcol); mul[1] = *(const f32x4*)(A.shift_mu + 1536 + lcol + 4);
    constexpr int RUN = 16;
    for (int run = F.gw; run < NTOK / RUN; run += F.NGW) {
        const int n0 = run * RUN;
        u32x4 prv[3], prl, cur[3], cul;
        const u32x4 z4 = {0u, 0u, 0u, 0u};
        if ((n0 & (SEQ - 1)) == 0) { prv[0] = z4; prv[1] = z4; prv[2] = z4; prl = z4; }
        else {
#pragma unroll
            for (int part = 0; part < 3; ++part) prv[part] = *(const u32x4*)(RWRAW + (size_t)(n0 - 1) * 1536 + part * 512 + lane * 8);
            prl = *(const u32x4*)(LORA + (size_t)(n0 - 1) * BW + lcol); }
#pragma unroll
        for (int part = 0; part < 3; ++part) cur[part] = *(const u32x4*)(RWRAW + (size_t)n0 * 1536 + part * 512 + lane * 8);
        cul = *(const u32x4*)(LORA + (size_t)n0 * BW + lcol);
        for (int i = 0; i < RUN; ++i) {
            const int n = n0 + i, nn = i + 1 < RUN ? n + 1 : n;
            u32x4 nxt[3], nxl;
#pragma unroll
            for (int part = 0; part < 3; ++part) nxt[part] = *(const u32x4*)(RWRAW + (size_t)nn * 1536 + part * 512 + lane * 8);
            nxl = *(const u32x4*)(LORA + (size_t)nn * BW + lcol);
            float xs[3][8];
#pragma unroll
            for (int part = 0; part < 3; ++part) { float p[8], q[8]; unpack8(cur[part], p); unpack8(prv[part], q);
#pragma unroll
                for (int j = 0; j < 4; ++j) { xs[part][j] = p[j] + mu[part][0][j] * (q[j] - p[j]); xs[part][4 + j] = p[4 + j] + mu[part][1][j] * (q[4 + j] - p[4 + j]); } }
            const size_t off = (size_t)n * BW + lane * 8;
            *(u32x4*)(R + off) = pack8(xs[0]); *(u32x4*)(KS + off) = pack8(xs[1]); *(u32x4*)(V + off) = pack8(xs[2]);
            float kk[8], ss = 0.f;
#pragma unroll
            for (int j = 0; j < 4; ++j) { kk[j] = xs[1][j] * kkc[0][j]; kk[4 + j] = xs[1][4 + j] * kkc[1][j]; }
#pragma unroll
            for (int j = 0; j < 8; ++j) ss += kk[j] * kk[j];
            ss += shfl_xor_l(ss, 1, lane); ss += shfl_xor_l(ss, 2, lane); ss += shfl_xor_l(ss, 4, lane);
            const float rn = 1.0f / fmaxf(sqrtf(ss), L2_EPS);
#pragma unroll
            for (int j = 0; j < 8; ++j) kk[j] *= rn;
            *(u32x4*)(KK + off) = pack8(kk);
            if (lane < 48) { float a[8];
                if (lane < 36) { float p[8], q[8]; unpack8(cul, p); unpack8(prl, q);
#pragma unroll
                    for (int j = 0; j < 8; ++j) { const float m = j < 4 ? mul[0][j & 3] : mul[1][j & 3]; const float v = p[j] + m * (q[j] - p[j]);
                        a[j] = lane < 8 ? (1.0f - 2.0f * frcp(fexp(2.0f * v) + 1.0f)) : (lane < 16 ? v : fsigmoid(v)); }
                } else {
#pragma unroll
                    for (int j = 0; j < 8; ++j) a[j] = 0.f; }
                *(u32x4*)(ALORA + (size_t)n * LK + lane * 8) = pack8(a); }
#pragma unroll
            for (int part = 0; part < 3; ++part) { prv[part] = cur[part]; cur[part] = nxt[part]; }
            prl = cul; cul = nxl;
        }
    }
}

DI void p4_lora(const Frame& F0, ARef A, const bf16* ALORA, const bf16* WL, bf16* E, bf16* KS, bf16* Bo, bf16* GG, const bf16* KK, const bf16* R, float* BON) {
    Frame F = F0; F.tid = opq_tid(F0.wave); F.lane = F.tid & 63; F.wave = __builtin_amdgcn_readfirstlane(F.tid >> 6); F.gw = F.wg * NWAVES + F.wave;
    const int lane = F.lane, r = lane & 31, hh = lane >> 5;
    for (int u = F.gw; u < 2 * (NTOK / 32); u += F.NGW) {
        const int n0 = (u >> 1) * 32, par = u & 1;
        bf16x8 tf[18];
#pragma unroll
        for (int ks = 0; ks < 18; ++ks) tf[ks] = *(const bf16x8*)(ALORA + (size_t)(n0 + r) * LK + 16 * ks + 8 * hh);
        TPS(F, 40);
        const unsigned orow = (unsigned)(n0 + r) * BW + 4 * hh;
#define LORA_W(dst, KS0, NKS, CB) do { _Pragma("unroll") for (int ks = 0; ks < (NKS); ++ks) dst[ks] = *(const bf16x8*)(WL + (size_t)(32 * (CB) + r) * LK + 16 * ((KS0) + ks) + 8 * hh); } while (0)
#define LORA_MM(W, KS0, NKS) f32x16 acc_; do { _Pragma("unroll") for (int q = 0; q < 16; ++q) acc_[q] = 0.f; \
            _Pragma("unroll") for (int ks = 0; ks < (NKS); ++ks) acc_ = MFMA32(W[ks], tf[(KS0) + ks], acc_); } while (0)
#define LORA_CB(base, i) ((base) + 4 * ((i) >> 1) + 2 * par + ((i) & 1))
        {   bf16x8 wc[4], wn[4]; LORA_W(wc, 0, 4, LORA_CB(0, 0));
#pragma nounroll
            for (int i = 0; i < 8; ++i) { const int cb = LORA_CB(0, i), c0_ = 32 * (cb & 15); { const int in_ = i < 7 ? i + 1 : 7; LORA_W(wn, 0, 4, LORA_CB(0, in_)); }
                f32x4 w0v[4];
#pragma unroll
                for (int g = 0; g < 4; ++g) w0v[g] = *(const f32x4*)(A.w0 + c0_ + 8 * g + 4 * hh);
                LORA_MM(wc, 0, 4);
#pragma unroll
                for (int g = 0; g < 4; ++g) { float e4[4];
#pragma unroll
                    for (int j = 0; j < 4; ++j) { const float v = acc_[4 * g + j] + w0v[g][j]; e4[j] = fexp(-fsoftplus(-v) - 0.5f); }
                    u32x2 w; w.x = pk2(e4[0], e4[1]); w.y = pk2(e4[2], e4[3]); *(u32x2*)(E + orow + c0_ + 8 * g) = w; }
#pragma unroll
                for (int ks = 0; ks < 4; ++ks) wc[ks] = wn[ks]; } }
        TPS(F, 41);
        {   float bsum = 0.f; bf16x8 wc[4], wn[4]; LORA_W(wc, 4, 4, LORA_CB(16, 0));
#pragma nounroll
            for (int i = 0; i < 8; ++i) { const int cb = LORA_CB(16, i), c0_ = 32 * (cb & 15); { const int in_ = i < 7 ? i + 1 : 7; LORA_W(wn, 4, 4, LORA_CB(16, in_)); }
                f32x4 a0v[4], kav[4], rkv[4]; u32x2 kw[4], qw[4], rw[4];
#pragma unroll
                for (int g = 0; g < 4; ++g) { const unsigned o = orow + c0_ + 8 * g; kw[g] = *(const u32x2*)(KS + o); qw[g] = *(const u32x2*)(KK + o); rw[g] = *(const u32x2*)(R + o);
                    a0v[g] = *(const f32x4*)(A.a0 + c0_ + 8 * g + 4 * hh); kav[g] = *(const f32x4*)(A.k_a + c0_ + 8 * g + 4 * hh); rkv[g] = *(const f32x4*)(A.r_k + c0_ + 8 * g + 4 * hh); }
                LORA_MM(wc, 4, 4);
#pragma unroll
                for (int g = 0; g < 4; ++g) { const unsigned o = orow + c0_ + 8 * g;
                    float ksv[4], kkv[4], kp[4], bb[4]; ksv[0] = bflo(kw[g].x); ksv[1] = bfhi(kw[g].x); ksv[2] = bflo(kw[g].y); ksv[3] = bfhi(kw[g].y); kkv[0] = bflo(qw[g].x); kkv[1] = bfhi(qw[g].x); kkv[2] = bflo(qw[g].y); kkv[3] = bfhi(qw[g].y);
#pragma unroll
                    for (int j = 0; j < 4; ++j) { const float s0 = fsigmoid(acc_[4 * g + j] + a0v[g][j]); kp[j] = ksv[j] * (1.0f + (s0 - 1.0f) * kav[g][j]); bb[j] = kkv[j] * s0; }
                    bsum += (bflo(rw[g].x) * kp[0] * rkv[g][0] + bfhi(rw[g].x) * kp[1] * rkv[g][1]) + (bflo(rw[g].y) * kp[2] * rkv[g][2] + bfhi(rw[g].y) * kp[3] * rkv[g][3]);
                    u32x2 w1, w2; w1.x = pk2(kp[0], kp[1]); w1.y = pk2(kp[2], kp[3]); w2.x = pk2(bb[0], bb[1]); w2.y = pk2(bb[2], bb[3]); *(u32x2*)(KS + o) = w1; *(u32x2*)(Bo + o) = w2; }
                if (i & 1) { const float tot = bsum + shfl_xor_l(bsum, 32, lane); if (hh == 0) BON[(size_t)(n0 + r) * 8 + 2 * (i >> 1) + par] = tot; bsum = 0.f; }
#pragma unroll
                for (int ks = 0; ks < 4; ++ks) wc[ks] = wn[ks]; } }
        TPS(F, 42);
        {   bf16x8 wc[10], wn[10]; LORA_W(wc, 8, 10, LORA_CB(32, 0));
#pragma nounroll
            for (int i = 0; i < 8; ++i) { const int cb = LORA_CB(32, i), c0_ = 32 * (cb & 15); { const int in_ = i < 7 ? i + 1 : 7; LORA_W(wn, 8, 10, LORA_CB(32, in_)); }
                LORA_MM(wc, 8, 10);
#pragma unroll
                for (int g = 0; g < 4; ++g) { u32x2 w; w.x = pk2(acc_[4 * g], acc_[4 * g + 1]); w.y = pk2(acc_[4 * g + 2], acc_[4 * g + 3]); *(u32x2*)(GG + orow + c0_ + 8 * g) = w; }
#pragma unroll
                for (int ks = 0; ks < 10; ++ks) wc[ks] = wn[ks]; } }
        TPS(F, 43);
#undef LORA_W
#undef LORA_MM
#undef LORA_CB
    }
}

DI void p6_chain(int task, int wave, LAS unsigned char* ring, const bf16* GT, const bf16* HT, bf16* SC) {
    const int lane = opq_tid(wave) & 63;
    const int bh = task >> 1, nb = task & 1;
    constexpr int RD = 6, SLOT = 12288;
    f32x16 X[2];
#pragma unroll
    for (int q = 0; q < 16; ++q) { X[0][q] = 0.f; X[1][q] = 0.f; }
    const char* gsrc = (const char*)(GT + (size_t)bh * NCH * 4096) + lane * 16;
    const char* hsrc = (const char*)(HT + (size_t)bh * NCH * 4096) + nb * 2048 + lane * 16;
#define CHAIN_DMA(cc) do { LAS unsigned char* sl_ = ring + ((cc) % RD) * SLOT; const char* g_ = gsrc + (size_t)(cc) * 8192; const char* h_ = hsrc + (size_t)(cc) * 8192; \
        _Pragma("unroll") for (int f = 0; f < 8; ++f) __builtin_amdgcn_global_load_lds((const unsigned*)(g_ + f * 1024), (LAS unsigned*)(sl_ + f * 1024), 16, 0, 0); \
        _Pragma("unroll") for (int kb = 0; kb < 2; ++kb) _Pragma("unroll") for (int j = 0; j < 2; ++j) \
            __builtin_amdgcn_global_load_lds((const unsigned*)(h_ + kb * 4096 + j * 1024), (LAS unsigned*)(sl_ + 8192 + (kb * 2 + j) * 1024), 16, 0, 0); } while (0)
#define CHAIN_READ(cc, HS, GS) do { const LAS unsigned char* sl_ = ring + ((cc) % RD) * SLOT; \
        _Pragma("unroll") for (int f = 0; f < 8; ++f) GS[f] = *(const LAS bf16x8*)(sl_ + f * 1024 + lane * 16); \
        _Pragma("unroll") for (int kb = 0; kb < 2; ++kb) _Pragma("unroll") for (int g = 0; g < 4; ++g) { const u32x2 w_ = *(const LAS u32x2*)(sl_ + 8192 + kb * 2048 + (g * 64 + lane) * 8); \
            HS[kb][4 * g] = bflo(w_.x); HS[kb][4 * g + 1] = bfhi(w_.x); HS[kb][4 * g + 2] = bflo(w_.y); HS[kb][4 * g + 3] = bfhi(w_.y); } } while (0)
#define CHAIN_STORE(cc) do { bf16* sc_ = SC + ((size_t)bh * NCH + (cc)) * 4096; \
        _Pragma("unroll") for (int jb = 0; jb < 2; ++jb) _Pragma("unroll") for (int g = 0; g < 4; ++g) { u32x2 w_; w_.x = pk2(X[jb][4 * g], X[jb][4 * g + 1]); w_.y = pk2(X[jb][4 * g + 2], X[jb][4 * g + 3]); \
            *(u32x2*)(sc_ + ((((jb * 2 + nb) * 4 + g) * 64) + lane) * 4) = w_; } } while (0)
#define CHAIN_STEP(HS, GS) do { bf16x8 xb_[2][2]; \
        _Pragma("unroll") for (int jb = 0; jb < 2; ++jb) _Pragma("unroll") for (int s = 0; s < 2; ++s) \
            xb_[jb][s] = pack8v(X[jb][8 * s], X[jb][8 * s + 1], X[jb][8 * s + 2], X[jb][8 * s + 3], X[jb][8 * s + 4], X[jb][8 * s + 5], X[jb][8 * s + 6], X[jb][8 * s + 7]); \
        X[0] = HS[0]; X[1] = HS[1]; \
        _Pragma("unroll") for (int kb = 0; kb < 2; ++kb) _Pragma("unroll") for (int jb = 0; jb < 2; ++jb) _Pragma("unroll") for (int s = 0; s < 2; ++s) X[kb] = MFMA32(GS[kb * 4 + jb * 2 + s], xb_[jb][s], X[kb]); } while (0)
    for (int cc = 0; cc < RD; ++cc) CHAIN_DMA(cc);
    for (int c = 0; c < NCH - 1; ++c) {
        f32x16 Hc[2]; bf16x8 Gc[8];
        if (c + RD <= NCH - 1) asm volatile("s_waitcnt vmcnt(60)" ::: "memory"); else asm volatile("s_waitcnt vmcnt(0)" ::: "memory");
        CHAIN_READ(c, Hc, Gc);
        asm volatile("s_waitcnt lgkmcnt(0)" ::: "memory");
        if (c + RD < NCH - 1) CHAIN_DMA(c + RD);
        CHAIN_STORE(c);
        CHAIN_STEP(Hc, Gc);
    }
    CHAIN_STORE(NCH - 1);
    asm volatile("s_waitcnt vmcnt(0)" ::: "memory");
#undef CHAIN_DMA
#undef CHAIN_READ
#undef CHAIN_STORE
#undef CHAIN_STEP
}

DI void p6_moe_weights(const Frame& F0, ARef A, int wi, int NW) {
    Frame F = F0; F.tid = opq_tid(F0.wave); F.lane = F.tid & 63; F.wave = __builtin_amdgcn_readfirstlane(F.tid >> 6); F.gw = F.wg * NWAVES + F.wave;
    LAS float* scr = (LAS float*)(F.lds + F.wave * 20480);
    constexpr int I_UP = NE * 32 * 16, I_DN = NE * 32 * 8;
    for (int it = wi; it < I_UP + I_DN; it += NW) {
        if (it < I_UP) { const int e = it >> 9, g = (it >> 4) & 31, kb = it & 15; tr_item_up(A.w_up1, A.w_up3, (bf16*)(A.ws + WS_WUP), e, 64 * kb, 32 * g, scr, F.lane); }
        else { const int r = it - I_UP, e = r >> 8, g = (r >> 3) & 31, kb = r & 7;
            tr_item(A.w_down + (size_t)e * DE * D, D, DE, (bf16*)(A.ws + WS_WDN) + (size_t)e * 1024 * DE, 64 * kb, 32 * g, 32 * g, scr, F.lane); }
    }
}

DI float half_bcast_sum(float v, int hh) {
    v += DPP_SHR(v, 0x111); v += DPP_SHR(v, 0x112); v += DPP_SHR(v, 0x114); v += DPP_SHR(v, 0x118);
    v += __builtin_bit_cast(float, __builtin_amdgcn_update_dpp(0, __builtin_bit_cast(int, v), 0x142, 0xa, 0xf, false));
    const float lo = __builtin_bit_cast(float, __builtin_amdgcn_readlane(__builtin_bit_cast(int, v), 31)), hi = __builtin_bit_cast(float, __builtin_amdgcn_readlane(__builtin_bit_cast(int, v), 63));
    return hh ? hi : lo; }
DI void p7_mfma(const Frame& F0, ARef A, const bf16* SC, const bf16* Pn, const bf16* QOn, const bf16* V, const bf16* GG, const float* BON, bf16* YRW) {
    Frame F = F0; F.tid = opq_tid(F0.wave); F.lane = F.tid & 63; F.wave = __builtin_amdgcn_readfirstlane(F.tid >> 6); F.gw = F.wg * NWAVES + F.wave;
    const int lane = F.lane, r = lane & 31, hh = lane >> 5;
    for (int cid = F.gw; cid < NCHUNK; cid += F.NGW) {
        const int bh = cid >> NCH_LOG, c = cid & (NCH - 1), b = bh >> 3, h = bh & 7;
        const unsigned n0 = (unsigned)b * SEQ + (unsigned)c * CH; const int col0 = h * HD;
        const bf16* sc = SC + (size_t)cid * 4096; const bf16* pn = Pn + (size_t)cid * 4096; const bf16* qn = QOn + (size_t)cid * 4096;
        bf16x8 Sf[2][2][2], Pf[2][2][2];
#pragma unroll
        for (int jb = 0; jb < 2; ++jb)
#pragma unroll
            for (int xb = 0; xb < 2; ++xb)
#pragma unroll
                for (int s = 0; s < 2; ++s) { const s16x4 lo = *(const s16x4*)(sc + ((((jb * 2 + xb) * 4 + 2 * s) * 64) + lane) * 4), hi = *(const s16x4*)(sc + ((((jb * 2 + xb) * 4 + 2 * s + 1) * 64) + lane) * 4);
#pragma unroll
                    for (int e = 0; e < 4; ++e) { Sf[jb][xb][s][e] = lo[e]; Sf[jb][xb][s][4 + e] = hi[e]; }
                    Pf[jb][xb][s] = *(const bf16x8*)(pn + ((((jb * 2 + xb) * 2 + s) * 64) + lane) * 8); }
        f32x16 Z[2][2];
#pragma unroll
        for (int tb = 0; tb < 2; ++tb)
#pragma unroll
            for (int nb = 0; nb < 2; ++nb) {
#pragma unroll
                for (int g = 0; g < 4; ++g) { const u32x2 w = *(const u32x2*)(qn + ((((tb * 2 + nb) * 4 + g) * 64) + lane) * 4);
                    Z[tb][nb][4 * g] = bflo(w.x); Z[tb][nb][4 * g + 1] = bfhi(w.x); Z[tb][nb][4 * g + 2] = bflo(w.y); Z[tb][nb][4 * g + 3] = bfhi(w.y); }
#pragma unroll
                for (int jb = 0; jb < 2; ++jb)
#pragma unroll
                    for (int s = 0; s < 2; ++s) Z[tb][nb] = MFMA32(Pf[jb][tb][s], Sf[jb][nb][s], Z[tb][nb]); }
        typedef float f2_t __attribute__((ext_vector_type(2)));
        const f2_t lw = *(const f2_t*)(A.lnx_w + col0 + 2 * r), lb = *(const f2_t*)(A.lnx_b + col0 + 2 * r);
#pragma unroll
        for (int tb = 0; tb < 2; ++tb) {
            unsigned vv[16], gg[16]; float bon[16];
#pragma unroll
            for (int q = 0; q < 16; ++q) { const unsigned tokrow = n0 + 32 * tb + 4 * hh + (q & 3) + 8 * (q >> 2); const unsigned o0 = tokrow * BW + col0 + 2 * r;
                vv[q] = *(const unsigned*)(V + o0); gg[q] = *(const unsigned*)(GG + o0); bon[q] = BON[(size_t)tokrow * 8 + h]; }
#pragma unroll
            for (int q = 0; q < 16; ++q) {
                const unsigned tokrow = n0 + 32 * tb + 4 * hh + (q & 3) + 8 * (q >> 2); const unsigned o0 = tokrow * BW + col0 + 2 * r;
                const float mean = half_bcast_sum(Z[tb][0][q] + Z[tb][1][q], hh) * (1.0f / 64.0f);
                const float d0 = Z[tb][0][q] - mean, d1 = Z[tb][1][q] - mean;
                const float rs = rsqrtf(half_bcast_sum(d0 * d0 + d1 * d1, hh) * (1.0f / 64.0f) + GN_EPS);
                const float y0 = (d0 * rs * lw.x + lb.x + bon[q] * bflo(vv[q])) * bflo(gg[q]), y1 = (d1 * rs * lw.y + lb.y + bon[q] * bfhi(vv[q])) * bfhi(gg[q]);
                *(unsigned*)(YRW + o0) = pk2(y0, y1);
                if ((q & 3) == 3) __builtin_amdgcn_sched_barrier(0); } }
    }
}

DI void p10_rows(const Frame& F0, ARef A, const bf16* Y1, bf16* H2) {
    Frame F = F0; F.tid = opq_tid(F0.wave); F.lane = F.tid & 63; F.wave = __builtin_amdgcn_readfirstlane(F.tid >> 6); F.gw = F.wg * NWAVES + F.wave;
    const int lane = F.lane;
    const float* mod = (const float*)(A.ws + WS_MOD);
    LAS float* rw = (LAS float*)F.lds;
    LAS int* hist = (LAS int*)(F.lds + 147456);
    TPS(F, 50);
    {   const char* src = (const char*)(A.ws + WS_RTW) + lane * 16;
        for (int j = F.wave; j < 144; j += NWAVES) __builtin_amdgcn_global_load_lds((const unsigned*)(src + j * 1024), (LAS unsigned*)(F.lds + j * 1024), 16, 0, 0);
        asm volatile("s_waitcnt vmcnt(0)" ::: "memory"); }
    __syncthreads();
    TPS(F, 51);
    i32x4* tok = (i32x4*)(A.ws + WS_TOK); int* cnt = (int*)(A.ws + WS_CNT);
    for (int tb = F.wg; tb < NTOK / 128; tb += F.G) {
        if (F.tid < 32) hist[F.tid] = 0;
        __syncthreads();
        for (int tl = F.wave; tl < 128; tl += NWAVES) {
            const int n = tb * 128 + tl, b = n >> 13;
            const f32x4* xr = (const f32x4*)(A.x + (size_t)n * D) + lane; const u32x2* yr = (const u32x2*)(Y1 + (size_t)n * D) + lane;
            f32x4 xv[4], yv[4]; float s = 0.f;
#pragma unroll
            for (int j = 0; j < 4; ++j) { xv[j] = xr[64 * j]; const u32x2 w = yr[64 * j]; yv[j][0] = bflo(w.x); yv[j][1] = bfhi(w.x); yv[j][2] = bflo(w.y); yv[j][3] = bfhi(w.y);
                s += (yv[j][0] * yv[j][0] + yv[j][1] * yv[j][1]) + (yv[j][2] * yv[j][2] + yv[j][3] * yv[j][3]); }
            const float inv1 = rsqrtf(wave_sum(s) * (1.0f / D) + NORM_EPS);
            float s2 = 0.f;
#pragma unroll
            for (int j = 0; j < 4; ++j) { const int k = 4 * lane + 256 * j;
                const f32x4 g1 = *(const f32x4*)(A.gains + D + k), gt = *(const f32x4*)(mod + b * 6144 + 2 * D + k);
#pragma unroll
                for (int q = 0; q < 4; ++q) { xv[j][q] = xv[j][q] + gt[q] * ((yv[j][q] * inv1) * g1[q]); s2 += xv[j][q] * xv[j][q]; }
                u32x2 xw; xw.x = pk2(xv[j][0], xv[j][1]); xw.y = pk2(xv[j][2], xv[j][3]); *((u32x2*)(A.ws + WS_X1 + (size_t)n * D * 2) + lane + 64 * j) = xw; }
            const float inv2 = rsqrtf(wave_sum(s2) * (1.0f / D) + NORM_EPS);
            f32x4 hv[4];
#pragma unroll
            for (int j = 0; j < 4; ++j) { const int k = 4 * lane + 256 * j;
                const f32x4 g2 = *(const f32x4*)(A.gains + 2 * D + k), sh = *(const f32x4*)(mod + b * 6144 + 3 * D + k), sc = *(const f32x4*)(mod + b * 6144 + 4 * D + k);
#pragma unroll
                for (int q = 0; q < 4; ++q) hv[j][q] = (xv[j][q] * inv2) * g2[q] * (1.0f + sc[q]) + sh[q];
                u32x2 w; w.x = pk2(hv[j][0], hv[j][1]); w.y = pk2(hv[j][2], hv[j][3]); *((u32x2*)(H2 + (size_t)n * D) + lane + 64 * j) = w; }
            typedef float f2_t __attribute__((ext_vector_type(2)));
#define P10_PAIR(OUT0, OUT1, WBASE) do { f2_t a = {0.f, 0.f}; \
                _Pragma("unroll") for (int j = 0; j < 4; ++j) { const LAS f32x4* wp = (const LAS f32x4*)((WBASE) + (4 * lane + 256 * j) * 2); const f32x4 wA = wp[0], wB = wp[1]; \
                    a += (f2_t){hv[j][0], hv[j][0]} * (f2_t){wA[0], wA[1]}; a += (f2_t){hv[j][1], hv[j][1]} * (f2_t){wA[2], wA[3]}; \
                    a += (f2_t){hv[j][2], hv[j][2]} * (f2_t){wB[0], wB[1]}; a += (f2_t){hv[j][3], hv[j][3]} * (f2_t){wB[2], wB[3]}; } \
                OUT0 = wave_sum(a.x); OUT1 = wave_sum(a.y); } while (0)
            float lg[4];
            P10_PAIR(lg[0], lg[1], rw); P10_PAIR(lg[2], lg[3], rw + 2 * D);
            int gs = 0; float gm = lg[0];
#pragma unroll
            for (int g = 1; g < 4; ++g) if (lg[g] > gm) { gm = lg[g]; gs = g; }
            gs = __builtin_amdgcn_readfirstlane(gs);
            float gsum = 0.f;
#pragma unroll
            for (int g = 0; g < 4; ++g) gsum += fexp(lg[g] - gm);
            const float gw = 1.0f / gsum;
            float el[8];
            { const LAS float* rwg = rw + (2 + 4 * gs) * (2 * D);
#pragma unroll
              for (int i = 0; i < 4; ++i) P10_PAIR(el[2 * i], el[2 * i + 1], rwg + i * 2 * D); }
#undef P10_PAIR
            int i0 = 0; float m0 = el[0];
#pragma unroll
            for (int e = 1; e < 8; ++e) if (el[e] > m0) { m0 = el[e]; i0 = e; }
            int i1 = -1; float m1 = -3.0e38f;
#pragma unroll
            for (int e = 0; e < 8; ++e) if (e != i0 && el[e] > m1) { m1 = el[e]; i1 = e; }
            const float t = fexp(m1 - m0), p0 = 1.0f / (1.0f + t), p1 = t * p0;
            const int e0 = gs * 8 + i0, e1 = gs * 8 + i1;
#if defined(CHECKS)
            if (lane == 0 && n == DBG_TOKEN) { float* dbg = (float*)(A.ws + WS_CTL + 32768) + 48; dbg[0] = lg[0]; dbg[1] = lg[1]; dbg[2] = lg[2]; dbg[3] = lg[3]; dbg[4] = gsum; dbg[5] = p0; dbg[6] = gw; dbg[7] = t; }
#endif
            if (lane == 0) { i32x4 rec; rec.x = e0 | (e1 << 8); rec.y = 0; rec.z = 0; rec.w = 0; tok[n] = rec;
                float* cwp = (float*)(A.ws + WS_CW) + 2 * n; cwp[0] = gw * p0; cwp[1] = gw * p1;
                atomicAdd((int*)&hist[e0], 1); atomicAdd((int*)&hist[e1], 1); }
        }
        __syncthreads();
        if (F.tid < 32) cnt[tb * 32 + F.tid] = hist[F.tid];
        __syncthreads();
    }
    TPS(F, 52);
}

DI void p11_rank_gather(const Frame& F0, ARef A, const bf16* H2, bf16* HS) {
    Frame F = F0; F.tid = opq_tid(F0.wave); F.lane = F.tid & 63; F.wave = __builtin_amdgcn_readfirstlane(F.tid >> 6); F.gw = F.wg * NWAVES + F.wave;
    LAS int* base = (LAS int*)F.lds;
    LAS int* seg = base + 32;
    LAS int* el = base + 96;
    LAS int* pos = base + 352;
    i32x4* tok = (i32x4*)(A.ws + WS_TOK); const int* cnt = (const int*)(A.ws + WS_CNT); int* tile = (int*)(A.ws + WS_TILE);
    LAS int* ptot = base + 640;
    LAS int* ppre = ptot + 512; LAS int* wcnt = ppre + 512;
    for (int tb = F.wg; tb < NTOK / 128; tb += F.G) {
        {
            const int e = F.tid & 31, part = F.tid >> 5; int tot = 0, pre = 0;
#pragma unroll
            for (int j = 0; j < 16; ++j) { const int t2 = part * 16 + j; const int v = cnt[t2 * 32 + e]; tot += v; pre += t2 < tb ? v : 0; }
            ptot[part * 32 + e] = tot; ppre[part * 32 + e] = pre; }
        if (F.tid >= 64 && F.tid < 64 + 128) { const i32x4 rec = tok[tb * 128 + (F.tid - 64)]; el[2 * (F.tid - 64)] = rec.x & 255; el[2 * (F.tid - 64) + 1] = (rec.x >> 8) & 255; }
        __syncthreads();
        if (F.tid < 32) { int tot = 0, pre = 0;
#pragma unroll
            for (int p = 0; p < 16; ++p) { tot += ptot[p * 32 + F.tid]; pre += ppre[p * 32 + F.tid]; }
            base[F.tid] = pre; seg[F.tid] = (tot + 255) & ~255; }
        int myrank = 0, mye = 0;
        if (F.tid < 256) { mye = el[F.tid];
#pragma unroll 4
            for (int x = 0; x < 32; ++x) { const unsigned long long m = __ballot(mye == x);
                if (mye == x) myrank = __popcll(m & ((1ull << F.lane) - 1ull));
                if (F.lane == 0) wcnt[F.wave * 32 + x] = __popcll(m); } }
        __syncthreads();
        if (F.tid == 0) { int acc = 0; for (int e = 0; e < 32; ++e) { const int sz = seg[e]; seg[e] = acc; acc += sz; } seg[32] = acc; }
        __syncthreads();
        if (F.tid < 256) { int p = seg[mye] + base[mye] + myrank;
            for (int w = 0; w < F.wave; ++w) p += wcnt[w * 32 + mye];
            pos[F.tid] = p; }
        if (tb == 0 && F.tid >= 256 && F.tid < 256 + 32) { const int e = F.tid - 256;
            for (int t2 = seg[e] >> 8; t2 < (seg[e + 1] >> 8); ++t2) tile[t2] = e;
            if (e == 0) tile[MAXT] = seg[32] >> 8; }
        __syncthreads();
        if (F.tid < 128) { i32x4 rec = tok[tb * 128 + F.tid]; rec.x = pos[2 * F.tid]; rec.y = pos[2 * F.tid + 1]; tok[tb * 128 + F.tid] = rec; }
        for (int q = F.wave; q < 256; q += NWAVES) { const int n = tb * 128 + (q >> 1);
            const u32x4* src = (const u32x4*)(H2 + (size_t)n * D) + F.lane; u32x4* dst = (u32x4*)(HS + (size_t)pos[q] * D) + F.lane;
            dst[0] = src[0]; dst[64] = src[64]; }
        __syncthreads();
    }
}

DI void p14_final(const Frame& F0, ARef A, const bf16* YE) {
    Frame F = F0; F.tid = opq_tid(F0.wave); F.lane = F.tid & 63; F.wave = __builtin_amdgcn_readfirstlane(F.tid >> 6); F.gw = F.wg * NWAVES + F.wave;
    const int lane = F.lane;
    const float* mod = (const float*)(A.ws + WS_MOD); const i32x4* tok = (const i32x4*)(A.ws + WS_TOK);
    for (int n = F.gw; n < NTOK; n += F.NGW) {
        const int b = n >> 13; const i32x4 rec = tok[n];
        const float c0 = ((const float*)(A.ws + WS_CW))[2 * n], c1 = ((const float*)(A.ws + WS_CW))[2 * n + 1];
        const u32x2* y0 = (const u32x2*)(YE + (size_t)rec.x * D) + lane; const u32x2* y1 = (const u32x2*)(YE + (size_t)rec.y * D) + lane;
        f32x4 yv[4]; float s = 0.f;
#pragma unroll
        for (int j = 0; j < 4; ++j) { const u32x2 a = y0[64 * j], bq = y1[64 * j];
            yv[j][0] = c0 * bflo(a.x) + c1 * bflo(bq.x); yv[j][1] = c0 * bfhi(a.x) + c1 * bfhi(bq.x); yv[j][2] = c0 * bflo(a.y) + c1 * bflo(bq.y); yv[j][3] = c0 * bfhi(a.y) + c1 * bfhi(bq.y);
            s += (yv[j][0] * yv[j][0] + yv[j][1] * yv[j][1]) + (yv[j][2] * yv[j][2] + yv[j][3] * yv[j][3]); }
        const float inv = rsqrtf(wave_sum(s) * (1.0f / D) + NORM_EPS);
#pragma unroll
        for (int j = 0; j < 4; ++j) { const int k = 4 * lane + 256 * j;
            const f32x4 g3 = *(const f32x4*)(A.gains + 3 * D + k), gt = *(const f32x4*)(mod + b * 6144 + 5 * D + k);
            const u32x2 xw = *((const u32x2*)(A.ws + WS_X1 + (size_t)n * D * 2) + lane + 64 * j); f32x4 xv = {bflo(xw.x), bfhi(xw.x), bflo(xw.y), bfhi(xw.y)};
#pragma unroll
            for (int q = 0; q < 4; ++q) xv[q] = xv[q] + gt[q] * ((yv[j][q] * inv) * g3[q]);
            *((f32x4*)(A.out + (size_t)n * D) + lane + 64 * j) = xv; }
    }
}

DI bf16x8 pk_tile(const f32x16& x, const int s) { return pack8v(x[8 * s], x[8 * s + 1], x[8 * s + 2], x[8 * s + 3], x[8 * s + 4], x[8 * s + 5], x[8 * s + 6], x[8 * s + 7]); }
constexpr int FS = 72;
DI bf16x8 rd_frag(const LAS bf16* buf, int tb, int cb, int s, int r, int hh) {
    const LAS bf16* p = buf + (32 * cb + r) * FS + 32 * tb + 16 * s + 4 * hh;
    const s16x4 lo = *(const LAS s16x4*)p, hi = *(const LAS s16x4*)(p + 8); bf16x8 f;
#pragma unroll
    for (int e = 0; e < 4; ++e) { f[e] = lo[e]; f[4 + e] = hi[e]; }
    return f; }
DI void wr_tile_ft(LAS bf16* buf, const f32x16& x, int tb, int cb, int r, int hh) {
#pragma unroll
    for (int g = 0; g < 4; ++g) { u32x2 w; w.x = pk2(x[4 * g], x[4 * g + 1]); w.y = pk2(x[4 * g + 2], x[4 * g + 3]); *(LAS u32x2*)(buf + (32 * cb + r) * FS + 32 * tb + 8 * g + 4 * hh) = w; } }
DI void wr_l_ft(LAS bf16* buf, const float (&x)[64], int lane) {
#pragma unroll
    for (int t8 = 0; t8 < 8; ++t8) { u32x4 w; w.x = pk2(x[8 * t8], x[8 * t8 + 1]); w.y = pk2(x[8 * t8 + 2], x[8 * t8 + 3]); w.z = pk2(x[8 * t8 + 4], x[8 * t8 + 5]); w.w = pk2(x[8 * t8 + 6], x[8 * t8 + 7]);
        *(LAS u32x4*)(buf + lane * FS + 8 * t8) = w; } }

#if defined(STAMPS)
#define P5STAMP(k) do { p5ts[k] = __builtin_amdgcn_s_memrealtime(); } while (0)
#else
#define P5STAMP(k) do { } while (0)
#endif
DI void p5_mfma(unsigned char* F0_ws, const Frame& F0, const bf16* R, const bf16* KP, const bf16* V, const bf16* KK, const bf16* Bv, const bf16* Ev, bf16* P, bf16* QO, bf16* GT, bf16* HT) {
    Frame F = F0; F.tid = opq_tid(F0.wave); F.lane = F.tid & 63; F.wave = __builtin_amdgcn_readfirstlane(F.tid >> 6); F.gw = F.wg * NWAVES + F.wave;
    const int lane = F.lane, r = lane & 31, hh = lane >> 5;
    LAS unsigned char* wl_init = F.lds + F.wave * 20480;
    LAS unsigned char* const wl0 = wl_init;
    {   bf16x8 id_[2];
#pragma unroll
        for (int s = 0; s < 2; ++s)
#pragma unroll
            for (int e = 0; e < 8; ++e) id_[s][e] = (16 * s + 8 * (e >> 2) + 4 * hh + (e & 3)) == r ? (short)0x3F80 : (short)0;
        *(LAS bf16x8*)(wl0 + 16640 + lane * 16) = id_[0]; *(LAS bf16x8*)(wl0 + 16640 + 1024 + lane * 16) = id_[1]; }
    wave_lds_fence();
    for (int cid = F.gw; cid < NCHUNK; cid += F.NGW) {
        const int bh = cid >> NCH_LOG, c = cid & (NCH - 1), b = bh >> 3, h = bh & 7;
        const unsigned n0 = (unsigned)b * SEQ + (unsigned)c * CH, col0 = (unsigned)h * HD;
        LAS unsigned char* wl = wl0; asm volatile("" : "+s"(wl));
        LAS unsigned char* IFR = wl + 16640;
        const int ln = opq_tid(F.wave) & 63;
#if defined(STAMPS)
        unsigned long long p5ts[10];
#endif
        const int rm = ln & 31, hm = ln >> 5;
        const bf16 *R0_ = R, *KP0_ = KP, *V0_ = V, *KK0_ = KK, *Bv0_ = Bv, *Ev0_ = Ev; bf16 *P0_ = P, *QO0_ = QO;
        asm volatile("" : "+s"(R0_), "+s"(KP0_), "+s"(V0_), "+s"(KK0_), "+s"(Bv0_), "+s"(Ev0_), "+s"(P0_), "+s"(QO0_));
        const GAS char *R_ = (const GAS char*)R0_, *KP_ = (const GAS char*)KP0_, *V_ = (const GAS char*)V0_, *KK_ = (const GAS char*)KK0_, *Bv_ = (const GAS char*)Bv0_, *Ev_ = (const GAS char*)Ev0_;
        GAS char *P_ = (GAS char*)P0_, *QO_ = (GAS char*)QO0_;
        const unsigned nb0 = n0 * BW + col0;
        const unsigned vL = (nb0 + (unsigned)ln) * 2u, vT = (nb0 + (unsigned)rm * BW + 4u * hm) * 2u;
#define OADD(v, c) ({ unsigned o_; asm volatile("v_add_u32_e32 %0, %1, %2" : "=v"(o_) : "n"((int)(c)), "v"(v)); o_; })
#define LD16(arr, off) (*(const GAS bf16*)((arr) + (off)))
#define XL(arr, t) LD16(arr, OADD(vL, (t) * BW * 2))
#define ROWQ(q) (((q) & 3) + 8 * ((q) >> 2))
        P5STAMP(0);
        bf16x8 Ep[2][2][2]; u32x2 raw[2][4][4];
#pragma unroll
        for (int fb = 0; fb < 2; ++fb)
#pragma unroll
            for (int tb = 0; tb < 2; ++tb)
#pragma unroll
                for (int s = 0; s < 2; ++s) { const u32x2 lo_ = *(const GAS u32x2*)(Ev_ + OADD(vT, (32 * tb * BW + 32 * fb + 16 * s) * 2)), hi_ = *(const GAS u32x2*)(Ev_ + OADD(vT, (32 * tb * BW + 32 * fb + 16 * s + 8) * 2));
                    u32x4 w_; w_.x = lo_.x; w_.y = lo_.y; w_.z = hi_.x; w_.w = hi_.y; Ep[fb][tb][s] = __builtin_bit_cast(bf16x8, w_); }
#define LOAD_TILE(BUF, FB, TB) do { _Pragma("unroll") for (int g = 0; g < 4; ++g) { const unsigned ot_ = OADD(vT, (32 * (TB) * BW + 32 * (FB) + 8 * g) * 2); \
            raw[BUF][0][g] = *(const GAS u32x2*)(KK_ + ot_); raw[BUF][1][g] = *(const GAS u32x2*)(R_ + ot_); \
            raw[BUF][2][g] = *(const GAS u32x2*)(Bv_ + ot_); raw[BUF][3][g] = *(const GAS u32x2*)(KP_ + ot_); } } while (0)
        LOAD_TILE(0, 0, 0);
#define IDF(s) (*(const LAS bf16x8*)(IFR + (s) * 1024 + ln * 16))
        bf16x8 ETp[2][2][2], tri[2], ones;
        float sc_[2];
        {   const bf16x8 id0 = IDF(0), id1 = IDF(1);
            {   unsigned o2_ = 0x3F803F80u; asm volatile("" : "+v"(o2_)); u32x4 o4_; o4_.x = o2_; o4_.y = o2_; o4_.z = o2_; o4_.w = o2_; ones = __builtin_bit_cast(bf16x8, o4_); }
#pragma unroll
            for (int e = 0; e < 8; ++e) {
#pragma unroll
                for (int s = 0; s < 2; ++s) tri[s][e] = (16 * s + 8 * (e >> 2) + 4 * hm + (e & 3)) <= rm ? (short)0x3F80 : (short)0; }
#pragma unroll
            for (int kb = 0; kb < 2; ++kb)
#pragma unroll
                for (int fb = 0; fb < 2; ++fb) { f32x16 x_;
#pragma unroll
                    for (int q = 0; q < 16; ++q) x_[q] = 0.f;
                    x_ = MFMA32(Ep[fb][kb][0], id0, x_); x_ = MFMA32(Ep[fb][kb][1], id1, x_);
                    ETp[kb][fb][0] = pk_tile(x_, 0); ETp[kb][fb][1] = pk_tile(x_, 1); }
#pragma unroll
            for (int fb = 0; fb < 2; ++fb) { f32x16 t_;
#pragma unroll
                for (int q = 0; q < 16; ++q) t_[q] = 0.f;
#pragma unroll
                for (int kb = 0; kb < 2; ++kb)
#pragma unroll
                    for (int s = 0; s < 2; ++s) t_ = MFMA32(ones, ETp[kb][fb][s], t_);
                sc_[fb] = fexp(-t_[0]); }
            __builtin_amdgcn_sched_barrier(0); }
        P5STAMP(1);
        bf16x8 Ap[2][2][2], Rp[2][2][2], Bp[2][2][2], Kp[2][2][2];
#pragma unroll
        for (int ti = 0; ti < 4; ++ti) { const int fb = ti >> 1, tb = ti & 1;
            if (ti < 3) LOAD_TILE((ti + 1) & 1, (ti + 1) >> 1, (ti + 1) & 1);
            f32x16 Lt;
#pragma unroll
            for (int q = 0; q < 16; ++q) Lt[q] = 0.f;
#pragma unroll
            for (int kb = 0; kb <= tb; ++kb)
#pragma unroll
                for (int s = 0; s < 2; ++s) Lt = MFMA32(ETp[kb][fb][s], kb < tb ? ones : tri[s], Lt);
#pragma unroll
            for (int s = 0; s < 2; ++s) {
                float a8[8], r8[8], b8[8], k8[8], e8[8]; unpack8(__builtin_bit_cast(u32x4, Ep[fb][tb][s]), e8);
#pragma unroll
                for (int g2 = 0; g2 < 2; ++g2) { const int g = 2 * s + g2;
                    const u32x2 aw = raw[ti & 1][0][g], rw = raw[ti & 1][1][g], bw = raw[ti & 1][2][g], kw = raw[ti & 1][3][g];
                    const float av[4] = {bflo(aw.x), bfhi(aw.x), bflo(aw.y), bfhi(aw.y)}, rv[4] = {bflo(rw.x), bfhi(rw.x), bflo(rw.y), bfhi(rw.y)},
                                bv[4] = {bflo(bw.x), bfhi(bw.x), bflo(bw.y), bfhi(bw.y)}, kv[4] = {bflo(kw.x), bfhi(kw.x), bflo(kw.y), bfhi(kw.y)};
#pragma unroll
                    for (int j = 0; j < 4; ++j) { const float l = -Lt[4 * g + j];
                        const float eI = fexp(l), eX = fexp(l + e8[4 * g2 + j]), eN = frcp(eI);
                        a8[4 * g2 + j] = -av[j] * eX; r8[4 * g2 + j] = rv[j] * eI; b8[4 * g2 + j] = bv[j] * eN; k8[4 * g2 + j] = kv[j] * eN; } }
                Ap[fb][tb][s] = __builtin_bit_cast(bf16x8, pack8(a8)); Rp[fb][tb][s] = __builtin_bit_cast(bf16x8, pack8(r8));
                Bp[fb][tb][s] = __builtin_bit_cast(bf16x8, pack8(b8)); Kp[fb][tb][s] = __builtin_bit_cast(bf16x8, pack8(k8)); }
            __builtin_amdgcn_sched_barrier(0); }
#undef LOAD_TILE
        P5STAMP(2);
#define GRAM_TILE(m_, XP, YP, ib, tb) do { _Pragma("unroll") for (int q = 0; q < 16; ++q) m_[q] = 0.f; \
            _Pragma("unroll") for (int fb = 0; fb < 2; ++fb) _Pragma("unroll") for (int s = 0; s < 2; ++s) m_ = MFMA32(XP[fb][ib][s], YP[fb][tb][s], m_); } while (0)
        bf16x8 Tp[2][2][2];
        {
#pragma unroll
            for (int b = 1; b >= 0; --b) { bf16x8 AP[2], BP[2]; f32x16 CT;
                {   f32x16 m_; int rm_ = rm; asm volatile("" : "+v"(rm_));
                    GRAM_TILE(m_, Bp, Ap, b, b);
#pragma unroll
                    for (int q = 0; q < 16; ++q) m_[q] = crow(q, hm) < rm_ ? m_[q] : 0.f;
                    BP[0] = pk_tile(m_, 0); BP[1] = pk_tile(m_, 1);
#pragma unroll
                    for (int q = 0; q < 16; ++q) CT[q] = m_[q] + (crow(q, hm) == rm_ ? 1.0f : 0.f);
                    GRAM_TILE(m_, Ap, Bp, b, b);
#pragma unroll
                    for (int q = 0; q < 16; ++q) m_[q] = rm_ < crow(q, hm) ? m_[q] : 0.f;
                    AP[0] = pk_tile(m_, 0); AP[1] = pk_tile(m_, 1); }
                __builtin_amdgcn_sched_barrier(0);
#pragma unroll
                for (int it = 0; it < 4; ++it) { f32x16 pn_, pt_;
#pragma unroll
                    for (int q = 0; q < 16; ++q) { pn_[q] = 0.f; pt_[q] = 0.f; }
#pragma unroll
                    for (int s = 0; s < 2; ++s) { pn_ = MFMA32(AP[s], BP[s], pn_); pt_ = MFMA32(BP[s], AP[s], pt_); }
                    const bf16x8 bt0 = pk_tile(CT, 0), bt1 = pk_tile(CT, 1);
                    AP[0] = pk_tile(pt_, 0); AP[1] = pk_tile(pt_, 1); BP[0] = pk_tile(pn_, 0); BP[1] = pk_tile(pn_, 1);
                    CT = MFMA32(AP[0], bt0, CT); CT = MFMA32(AP[1], bt1, CT);
                    __builtin_amdgcn_sched_barrier(0); }
                Tp[b][b][0] = pk_tile(CT, 0); Tp[b][b][1] = pk_tile(CT, 1); }
            {   f32x16 x_; GRAM_TILE(x_, Ap, Bp, 1, 0);
                const bf16x8 au0 = pk_tile(x_, 0), au1 = pk_tile(x_, 1);
#pragma unroll
                for (int q = 0; q < 16; ++q) x_[q] = 0.f;
                x_ = MFMA32(au0, Tp[1][1][0], x_); x_ = MFMA32(au1, Tp[1][1][1], x_);
                const bf16x8 bx0 = pk_tile(x_, 0), bx1 = pk_tile(x_, 1);
#pragma unroll
                for (int q = 0; q < 16; ++q) x_[q] = 0.f;
                x_ = MFMA32(Tp[0][0][0], IDF(0), x_); x_ = MFMA32(Tp[0][0][1], IDF(1), x_);
                const bf16x8 at0 = pk_tile(x_, 0), at1 = pk_tile(x_, 1);
#pragma unroll
                for (int q = 0; q < 16; ++q) x_[q] = 0.f;
                x_ = MFMA32(at0, bx0, x_); x_ = MFMA32(at1, bx1, x_);
                Tp[1][0][0] = pk_tile(x_, 0); Tp[1][0][1] = pk_tile(x_, 1); }
            __builtin_amdgcn_sched_barrier(0); }
        P5STAMP(3);
        {   const bf16x8 id0 = IDF(0), id1 = IDF(1);
#pragma unroll
            for (int tb = 0; tb < 2; ++tb)
#pragma unroll
                for (int kb = 0; kb < 2; ++kb) { f32x16 xb_, xk_; const float sc = sc_[kb];
#pragma unroll
                    for (int q = 0; q < 16; ++q) { xb_[q] = 0.f; xk_[q] = 0.f; }
                    xb_ = MFMA32(Bp[kb][tb][0], id0, xb_); xb_ = MFMA32(Bp[kb][tb][1], id1, xb_);
                    xk_ = MFMA32(Kp[kb][tb][0], id0, xk_); xk_ = MFMA32(Kp[kb][tb][1], id1, xk_);
#pragma unroll
                    for (int q = 0; q < 16; ++q) { xb_[q] *= sc; xk_[q] *= sc; }
#pragma unroll
                    for (int s = 0; s < 2; ++s) { *(LAS bf16x8*)(wl + (((tb * 2 + kb) * 2 + s) * 1024) + ln * 16) = pk_tile(xb_, s); *(LAS bf16x8*)(wl + 8192 + (((tb * 2 + kb) * 2 + s) * 1024) + ln * 16) = pk_tile(xk_, s); }
                    __builtin_amdgcn_sched_barrier(0); } }
        bf16x8 Makp[2][2][2], Mbrp[2][2][2], Mkrp[2][2][2];
#define GRAM(XP, YP, STRICT, BODY) _Pragma("unroll") for (int ib = 0; ib < 2; ++ib) _Pragma("unroll") for (int tb = 0; tb < 2; ++tb) if (!(ib == 1 && tb == 0)) { f32x16 m_; \
            GRAM_TILE(m_, XP, YP, ib, tb); \
            int rm_ = rm; asm volatile("" : "+v"(rm_)); \
            _Pragma("unroll") for (int q = 0; q < 16; ++q) { const int i_ = 32 * ib + crow(q, hm), t_ = 32 * tb + rm_; m_[q] = ((STRICT) ? (i_ < t_) : (i_ <= t_)) ? m_[q] : 0.f; } \
            BODY __builtin_amdgcn_sched_barrier(0); }
        GRAM(Kp, Rp, false, { Mkrp[ib][tb][0] = pk_tile(m_, 0); Mkrp[ib][tb][1] = pk_tile(m_, 1); })
        GRAM(Kp, Ap, true, { Makp[ib][tb][0] = pk_tile(m_, 0); Makp[ib][tb][1] = pk_tile(m_, 1); })
        GRAM(Bp, Rp, false, { Mbrp[ib][tb][0] = pk_tile(m_, 0); Mbrp[ib][tb][1] = pk_tile(m_, 1); })
#undef GRAM
#undef GRAM_TILE
        P5STAMP(4);
#define IDF2(s) (*(const LAS bf16x8*)(IFR + (s) * 1024 + ln2 * 16))
        bf16x8 ATp[2][2][2];
        const int ln2 = opq_tid(F.wave) & 63;
        GAS char* pn = (GAS char*)(P0_ + (size_t)cid * 4096);
#pragma unroll
        for (int kb = 0; kb < 2; ++kb) { const bf16x8 id0 = IDF2(0), id1 = IDF2(1);
            {   bf16x8 A0p[2][2];
#pragma unroll
                for (int ib = 0; ib < 2; ++ib) { f32x16 x_;
#pragma unroll
                    for (int q = 0; q < 16; ++q) x_[q] = 0.f;
                    x_ = MFMA32(Ap[kb][ib][0], id0, x_); x_ = MFMA32(Ap[kb][ib][1], id1, x_);
                    A0p[ib][0] = pk_tile(x_, 0); A0p[ib][1] = pk_tile(x_, 1); }
#pragma unroll
                for (int tb = 0; tb < 2; ++tb) { f32x16 a_;
#pragma unroll
                    for (int q = 0; q < 16; ++q) a_[q] = 0.f;
#pragma unroll
                    for (int ib = 0; ib <= tb; ++ib)
#pragma unroll
                        for (int s = 0; s < 2; ++s) a_ = MFMA32(Tp[tb][ib][s], A0p[ib][s], a_);
                    ATp[tb][kb][0] = pk_tile(a_, 0); ATp[tb][kb][1] = pk_tile(a_, 1); } }
            __builtin_amdgcn_sched_barrier(0);
#pragma unroll
            for (int tb = 0; tb < 2; ++tb) { f32x16 p_; const int jb = kb;
#pragma unroll
                for (int q = 0; q < 16; ++q) p_[q] = 0.f;
                p_ = MFMA32(id0, Rp[jb][tb][0], p_); p_ = MFMA32(id1, Rp[jb][tb][1], p_);
#pragma unroll
                for (int ib = 0; ib <= tb; ++ib)
#pragma unroll
                    for (int s = 0; s < 2; ++s) p_ = MFMA32(ATp[ib][jb][s], Mbrp[ib][tb][s], p_);
#pragma unroll
                for (int s = 0; s < 2; ++s) *(GAS bf16x8*)(pn + ((((jb * 2 + tb) * 2 + s) * 64) + ln2) * 16) = pk_tile(p_, s);
                __builtin_amdgcn_sched_barrier(0); } }
        P5STAMP(6);
        bf16x8 W1p[2][2][2], Vp[2][2][2];
        const int lc_ = ln2;
        const unsigned vC = (nb0 + 4u * (unsigned)(lc_ >> 5) * BW + 2u * (unsigned)(lc_ & 31)) * 2u;
#pragma unroll
        for (int ib = 0; ib < 2; ++ib) { f32x16 v0_, v1_;
#pragma unroll
            for (int q = 0; q < 16; ++q) { const unsigned w_ = *(const GAS unsigned*)(V_ + OADD(vC, ((32 * ib + ROWQ(q)) * BW) * 2)); v0_[q] = bflo(w_); v1_[q] = bfhi(w_); }
            Vp[ib][0][0] = pk_tile(v0_, 0); Vp[ib][0][1] = pk_tile(v0_, 1); Vp[ib][1][0] = pk_tile(v1_, 0); Vp[ib][1][1] = pk_tile(v1_, 1); }
#pragma unroll
        for (int vb = 0; vb < 2; ++vb) { bf16x8 W0p[2][2];
#pragma unroll
            for (int tb = 0; tb < 2; ++tb) { f32x16 w_;
#pragma unroll
                for (int q = 0; q < 16; ++q) w_[q] = 0.f;
#pragma unroll
                for (int ib = 0; ib <= tb; ++ib)
#pragma unroll
                    for (int s = 0; s < 2; ++s) w_ = MFMA32(Makp[ib][tb][s], Vp[ib][vb][s], w_);
                W0p[tb][0] = pk_tile(w_, 0); W0p[tb][1] = pk_tile(w_, 1); }
#pragma unroll
            for (int tb = 0; tb < 2; ++tb) { f32x16 w_;
#pragma unroll
                for (int q = 0; q < 16; ++q) w_[q] = 0.f;
#pragma unroll
                for (int ib = 0; ib <= tb; ++ib)
#pragma unroll
                    for (int s = 0; s < 2; ++s) w_ = MFMA32(Tp[tb][ib][s], W0p[ib][s], w_);
                W1p[tb][vb][0] = pk_tile(w_, 0); W1p[tb][vb][1] = pk_tile(w_, 1); }
            __builtin_amdgcn_sched_barrier(0); }
        P5STAMP(7);
        GAS char* qn = (GAS char*)(QO0_ + (size_t)cid * 4096);
#pragma unroll
        for (int tb = 0; tb < 2; ++tb)
#pragma unroll
            for (int vb = 0; vb < 2; ++vb) { f32x16 y_;
#pragma unroll
                for (int q = 0; q < 16; ++q) y_[q] = 0.f;
#pragma unroll
                for (int ib = 0; ib <= tb; ++ib)
#pragma unroll
                    for (int s = 0; s < 2; ++s) { y_ = MFMA32(Mbrp[ib][tb][s], W1p[ib][vb][s], y_); y_ = MFMA32(Mkrp[ib][tb][s], Vp[ib][vb][s], y_); }
#pragma unroll
                for (int g = 0; g < 4; ++g) { u32x2 w; w.x = pk2(y_[4 * g], y_[4 * g + 1]); w.y = pk2(y_[4 * g + 2], y_[4 * g + 3]); *(GAS u32x2*)(qn + ((((tb * 2 + vb) * 4 + g) * 64) + ln2) * 8) = w; }
                __builtin_amdgcn_sched_barrier(0); }
        P5STAMP(8);
        wave_lds_fence();
        bf16x8 Bh[2][2][2];
#pragma unroll
        for (int tb = 0; tb < 2; ++tb)
#pragma unroll
            for (int kb = 0; kb < 2; ++kb)
#pragma unroll
                for (int s = 0; s < 2; ++s) Bh[tb][kb][s] = *(const LAS bf16x8*)(wl + (((tb * 2 + kb) * 2 + s) * 1024) + ln2 * 16);
        GAS char* gt = (GAS char*)(GT + (size_t)cid * 4096); GAS char* ht = (GAS char*)(HT + (size_t)cid * 4096);
#pragma unroll
        for (int kb = 0; kb < 2; ++kb)
#pragma unroll
            for (int jb = 0; jb < 2; ++jb) { f32x16 g_;
                const float dg = sc_[kb];
#pragma unroll
                for (int q = 0; q < 16; ++q) g_[q] = (kb == jb && crow(q, hm) == rm) ? dg : 0.f;
#pragma unroll
                for (int tb = 0; tb < 2; ++tb)
#pragma unroll
                    for (int s = 0; s < 2; ++s) g_ = MFMA32(ATp[tb][jb][s], Bh[tb][kb][s], g_);
#pragma unroll
                for (int s = 0; s < 2; ++s) *(GAS bf16x8*)(gt + ((kb * 4 + jb * 2 + s) * 64 + ln2) * 16) = pk_tile(g_, s);
                __builtin_amdgcn_sched_barrier(0); }
        {   bf16x8 Kh[2][2][2];
#pragma unroll
            for (int tb = 0; tb < 2; ++tb)
#pragma unroll
                for (int kb = 0; kb < 2; ++kb)
#pragma unroll
                    for (int s = 0; s < 2; ++s) Kh[tb][kb][s] = *(const LAS bf16x8*)(wl + 8192 + (((tb * 2 + kb) * 2 + s) * 1024) + ln2 * 16);
#pragma unroll
            for (int kb = 0; kb < 2; ++kb)
#pragma unroll
                for (int vb = 0; vb < 2; ++vb) { f32x16 h_;
#pragma unroll
                    for (int q = 0; q < 16; ++q) h_[q] = 0.f;
#pragma unroll
                    for (int tb = 0; tb < 2; ++tb)
#pragma unroll
                        for (int s = 0; s < 2; ++s) { h_ = MFMA32(Bh[tb][kb][s], W1p[tb][vb][s], h_); h_ = MFMA32(Kh[tb][kb][s], Vp[tb][vb][s], h_); }
#pragma unroll
                    for (int g = 0; g < 4; ++g) { u32x2 w; w.x = pk2(h_[4 * g], h_[4 * g + 1]); w.y = pk2(h_[4 * g + 2], h_[4 * g + 3]); *(GAS u32x2*)(ht + ((((kb * 2 + vb) * 4 + g) * 64) + ln2) * 8) = w; }
                    __builtin_amdgcn_sched_barrier(0); } }
        P5STAMP(9);
#undef IDF
#undef IDF2
#if defined(STAMPS)
        if (F.gw == 0 && cid == 0 && lane == 0) { _Pragma("unroll") for (int k_ = 0; k_ < 10; ++k_) ((unsigned long long*)(F0_ws + WS_CTL + 49152))[32 + k_] = p5ts[k_]; }
#endif
        wave_lds_fence();
#undef XL
#undef OADD
#undef LD16
#undef ROWQ
    }
}

#if defined(CHECKS)
constexpr size_t WS_FLG = WS_CTL + 32768;
DI unsigned* chk_flags(unsigned char* ws) { return (unsigned*)(ws + WS_FLG); }
DI void chk(unsigned char* ws, int id, float got, float want, float rel, float ab) {
    const float d = fabsf(got - want), lim = rel * fmaxf(fabsf(got), fabsf(want)) + ab;
    if (!(d <= lim)) chk_flags(ws)[id] = 1u; }
DI unsigned hsh(unsigned a) { a ^= a >> 16; a *= 0x7feb352du; a ^= a >> 15; a *= 0x846ca68bu; a ^= a >> 16; return a; }
DI float bfr(float v) { return bflo(f2bf(v)); }
DI int scol_of(int n) { return n < 3360 ? n : (n < 3584 ? -1 : n - 224); }

DI void chk_p0(const Frame& F, ARef A) {
    unsigned char* ws = A.ws; const int lane = F.lane;
    const float* mod = (const float*)(ws + WS_MOD);
    for (int s = F.wave; s < 32; s += NWAVES) { const unsigned hh = hsh(1000 + s); const int b = hh & 3, o = (hh >> 2) % 6144; float a = 0.f;
        for (int k = lane; k < D; k += 64) { const float c = A.c[b * D + k]; a += (c / (1.0f + expf(-c))) * A.w_mod[(size_t)k * 6144 + o]; }
        a = wave_sum(a) + A.b_mod[o]; chk(ws, 10, mod[b * 6144 + o], a, 1e-3f, 1e-4f); }
    const bf16* wt = (const bf16*)(ws + WS_WIN);
    for (int s = 0; s < 8; ++s) { const unsigned hh = hsh(2000 + (F.wave * 8 + s) * 64 + lane); const int n = hh % NPAD, k = (hh >> 13) & 1023; const int sc = scol_of(n);
        const float want = sc >= 0 ? bfr(A.w_in[(size_t)k * IN_COLS + sc]) : 0.f; chk(ws, 11, bf2f(wt[(size_t)n * D + k]), want, 0.f, 0.f); }
    { const unsigned hh = hsh(3000 + F.wave * 64 + lane); const int n = hh & 1023, k = (hh >> 10) & 511, k2 = (hh >> 10) & 1023;
        chk(ws, 11, bf2f(((const bf16*)(ws + WS_WOSB))[n * BW + k]), bfr(A.w_o_sb[k * D + n]), 0.f, 0.f);
        chk(ws, 11, bf2f(((const bf16*)(ws + WS_WORW))[n * BW + k]), bfr(A.w_o_rw[k * D + n]), 0.f, 0.f);
        chk(ws, 11, bf2f(((const bf16*)(ws + WS_WOUT))[n * D + k2]), bfr(A.w_out[k2 * D + n]), 0.f, 0.f);
        const int o = hh % 36; chk(ws, 11, ((const float*)(ws + WS_RTW))[o * D + k2], o < 4 ? A.w_group[k2 * 4 + o] : A.w_router[k2 * NE + o - 4], 0.f, 0.f);
        const int nl = hh % 1536, kl = (hh >> 11) % LK; float v = 0.f;
        if (nl < 512) { if (kl < 64) v = A.w_decay_up[kl * BW + nl]; } else if (nl < 1024) { if (kl >= 64 && kl < 128) v = A.w_iclr_up[(kl - 64) * BW + nl - 512]; } else { if (kl >= 128 && kl < 288) v = A.w_gate_up[(kl - 128) * BW + nl - 1024]; }
        chk(ws, 11, bf2f(((const bf16*)(ws + WS_WL))[nl * LK + kl]), bfr(v), 0.f, 0.f); }
}
DI void chk_p1(const Frame& F, ARef A, const bf16* H1) {
    unsigned char* ws = A.ws; const int lane = F.lane; const float* mod = (const float*)(ws + WS_MOD);
    for (int s = F.wave; s < 16; s += NWAVES) { const int n = hsh(4000 + s) % NTOK, b = n >> 13; float ss = 0.f;
        for (int k = lane; k < D; k += 64) { const float v = A.x[(size_t)n * D + k]; ss += v * v; }
        const float inv = 1.0f / sqrtf(wave_sum(ss) / D + NORM_EPS);
        for (int k = lane; k < D; k += 64) { const float want = (A.x[(size_t)n * D + k] * inv) * A.gains[k] * (1.0f + mod[b * 6144 + D + k]) + mod[b * 6144 + k];
            chk(ws, 12, bf2f(H1[(size_t)n * D + k]), want, 0.01f, 0.01f); } }
}
DI float wdot(const bf16* arow, const float* W, int ldw, int col, int K, int lane) { float a = 0.f; for (int k = lane; k < K; k += 64) a += bf2f(arow[k]) * W[(size_t)k * ldw + col]; return wave_sum(a); }
DI void chk_p2(const Frame& F, ARef A, const bf16* H1) {
    unsigned char* ws = A.ws; const int lane = F.lane;
    for (int s = F.wave; s < 96; s += NWAVES) { const unsigned hh = hsh(5000 + s); const int n = hh % NTOK, region = s % 6; int col;
        const unsigned h2 = hsh(hh);
        float got, want; int id = 13 + region;
        if (region == 0) { col = h2 % 512; want = 0.125f * wdot(H1 + (size_t)n * D, A.w_in, IN_COLS, col, D, lane); got = bf2f(((const bf16*)(ws + WS_QB))[(size_t)n * BW + col]); }
        else if (region == 1) { col = h2 % 512; want = wdot(H1 + (size_t)n * D, A.w_in, IN_COLS, 512 + col, D, lane); got = bf2f(((const bf16*)(ws + WS_KB))[(size_t)n * BW + col]); }
        else if (region == 2) { col = h2 % 512; want = wdot(H1 + (size_t)n * D, A.w_in, IN_COLS, 1024 + col, D, lane); got = bf2f(((const bf16*)(ws + WS_VT))[((size_t)((n >> 13) * BW + col)) * SEQ + (n & (SEQ - 1))]); }
        else if (region == 3) { col = h2 % 1536; want = wdot(H1 + (size_t)n * D, A.w_in, IN_COLS, 1536 + col, D, lane); got = bf2f(((const bf16*)(ws + WS_RWRAW))[(size_t)n * 1536 + col]); }
        else if (region == 4) { col = h2 % 288; want = wdot(H1 + (size_t)n * D, A.w_in, IN_COLS, 3072 + col, D, lane); got = bf2f(((const bf16*)(ws + WS_LORA))[(size_t)n * BW + col]); }
        else { col = h2 % 2048; want = wdot(H1 + (size_t)n * D, A.w_in, IN_COLS, 3360 + col, D, lane) + A.gate_bias[col]; want = 1.0f / (1.0f + expf(-want)); got = bf2f(((const bf16*)(ws + WS_GATE))[(size_t)n * 2048 + col]); }
        chk(ws, id, got, want, 0.03f, 0.02f); }
}
constexpr int NATT = 16;
DI void att_sample(int s, int& b, int& h, int& t) { const unsigned hh = hsh(6000 + s); b = hh & 3; h = (hh >> 2) & 7; t = (s < 4) ? (s * 37) : (int)((hh >> 5) % SEQ); }
DI void chk_p3_save(const Frame& F, ARef A) {
    if (F.wave == 0) { bf16* sv = (bf16*)(A.ws + WS_FLG + 4096);
        for (int s = 0; s < NATT; ++s) { int b, h, t; att_sample(s, b, h, t); sv[s * 64 + F.lane] = ((const bf16*)(A.ws + WS_QB))[(size_t)(b * SEQ + t) * BW + h * HD + F.lane]; } }
}
DI void chk_p3(const Frame& F, ARef A, const bf16* R, const bf16* KS, const bf16* V, const bf16* KK) {
    unsigned char* ws = A.ws; const int lane = F.lane;
    const bf16* sv = (const bf16*)(ws + WS_FLG + 4096); const bf16* KB = (const bf16*)(ws + WS_KB); const bf16* VT = (const bf16*)(ws + WS_VT);
    for (int s = F.wave; s < NATT; s += NWAVES) { int b, h, t; att_sample(s, b, h, t);
        const float q = bf2f(sv[s * 64 + lane]); float later = 0.f, o = 0.f;
        for (int k = t - 1; k >= 0; --k) { const float z = wave_sum(q * bf2f(KB[(size_t)(b * SEQ + k) * BW + h * HD + lane]));
            const float sp = fmaxf(z, 0.f) + log1pf(expf(-fabsf(z)));
            o += expf(z - sp + later) * bf2f(VT[((size_t)((b * NH + h) * HD + lane)) * SEQ + k]);
            later -= sp; if (later < -200.f) break; }
        chk(ws, 19, bf2f(((const bf16*)(ws + WS_QB))[(size_t)(b * SEQ + t) * BW + h * HD + lane]), o, 0.04f, 0.02f); }
    const bf16* RW = (const bf16*)(ws + WS_RWRAW); const bf16* LO = (const bf16*)(ws + WS_LORA); const bf16* AL = (const bf16*)(ws + WS_ALORA);
    for (int s = F.wave; s < 32; s += NWAVES) { const unsigned hh = hsh(7000 + s); const int n = (s < 4) ? s * SEQ : (int)(hh % NTOK), hd = (hh >> 16) & 7; const bool first = (n & (SEQ - 1)) == 0;
        float xs[3];
        for (int p = 0; p < 3; ++p) { const int col = p * 512 + hd * 64 + lane; const float cur = bf2f(RW[(size_t)n * 1536 + col]), prv = first ? 0.f : bf2f(RW[(size_t)(n - 1) * 1536 + col]); xs[p] = cur + A.shift_mu[col] * (prv - cur); }
        const size_t o = (size_t)n * BW + hd * 64 + lane;
        chk(ws, 20, bf2f(R[o]), xs[0], 0.01f, 0.005f); chk(ws, 20, bf2f(KS[o]), xs[1], 0.01f, 0.005f); chk(ws, 20, bf2f(V[o]), xs[2], 0.01f, 0.005f);
        const float kk = xs[1] * A.k_k[hd * 64 + lane]; const float nn = sqrtf(wave_sum(kk * kk));
        chk(ws, 20, bf2f(KK[o]), kk / fmaxf(nn, L2_EPS), 0.01f, 0.002f);
        for (int c = lane; c < LK; c += 64) { float want = 0.f;
            if (c < 288) { const float cur = bf2f(LO[(size_t)n * BW + c]), prv = first ? 0.f : bf2f(LO[(size_t)(n - 1) * BW + c]); const float v = cur + A.shift_mu[1536 + c] * (prv - cur);
                want = c < 64 ? tanhf(v) : (c < 128 ? v : 1.0f / (1.0f + expf(-v))); }
            chk(ws, 20, bf2f(AL[(size_t)n * LK + c]), want, 0.01f, 0.005f); } }
}
DI void chk_p4_save(const Frame& F, ARef A, const bf16* KS) {
    if (F.wave == 0) { bf16* sv = (bf16*)(A.ws + WS_FLG + 8192);
        for (int s = 0; s < 16; ++s) { const unsigned hh = hsh(8000 + s); const int n = hh % NTOK, hd = (hh >> 16) & 7; sv[s * 64 + F.lane] = KS[(size_t)n * BW + hd * 64 + F.lane]; } }
}
DI void chk_p4(const Frame& F, ARef A, const bf16* KP, const bf16* KK) {
    unsigned char* ws = A.ws; const int lane = F.lane; const bf16* AL = (const bf16*)(ws + WS_ALORA); const bf16* sv = (const bf16*)(ws + WS_FLG + 8192);
    for (int s = F.wave; s < 16; s += NWAVES) { const unsigned hh = hsh(8000 + s); const int n = hh % NTOK, hd = (hh >> 16) & 7, c = hd * 64 + lane; const size_t o = (size_t)n * BW + c;
        float lw = 0.f, la = 0.f, lg = 0.f;
        for (int k = 0; k < 64; ++k) { lw += bf2f(AL[(size_t)n * LK + k]) * A.w_decay_up[k * BW + c]; la += bf2f(AL[(size_t)n * LK + 64 + k]) * A.w_iclr_up[k * BW + c]; }
        for (int k = 0; k < 160; ++k) lg += bf2f(AL[(size_t)n * LK + 128 + k]) * A.w_gate_up[k * BW + c];
        const float x = -(A.w0[c] + lw), w = -(fmaxf(x, 0.f) + log1pf(expf(-fabsf(x)))) - 0.5f;
        chk(ws, 21, bf2f(((const bf16*)(ws + WS_E))[o]), expf(w), 0.03f, 0.003f);
        const float a = 1.0f / (1.0f + expf(-(A.a0[c] + la))); const float ks = bf2f(sv[s * 64 + lane]);
        chk(ws, 22, bf2f(KP[o]), ks * (1.0f + (a - 1.0f) * A.k_a[c]), 0.03f, 0.01f);
        chk(ws, 22, bf2f(((const bf16*)(ws + WS_B))[o]), bf2f(KK[o]) * a, 0.03f, 0.003f);
        chk(ws, 23, bf2f(((const bf16*)(ws + WS_GG))[o]), lg, 0.03f, 0.01f); }
}
constexpr int NST = 300;
DI void chk_p7_save(const Frame& F, ARef A) {
    if (F.wave < 4) { const int b = (F.wave * 3) & 3, h = (F.wave * 5 + 1) & 7; bf16* sv = (bf16*)(A.ws + 256 * 1024) + F.wave * NST * 64;
        for (int t = 0; t < NST; ++t) sv[t * 64 + F.lane] = ((const bf16*)(A.ws + WS_E))[(size_t)(b * SEQ + t) * BW + h * HD + F.lane]; }
}
DI void chk_p7(const Frame& F, ARef A, const bf16* R, const bf16* KP, const bf16* V, const bf16* KK) {
    unsigned char* ws = A.ws; const int lane = F.lane;
    const bf16* Bv = (const bf16*)(ws + WS_B); const bf16* Esv = (const bf16*)(ws + 256 * 1024) + F.wave * NST * 64; const bf16* GG = (const bf16*)(ws + WS_GG); const bf16* YRW = (const bf16*)(ws + WS_YRW);
    if (F.wave < 4) { const int b = (F.wave * 3) & 3, h = (F.wave * 5 + 1) & 7, col0 = h * HD;
        float S[64];
#pragma unroll
        for (int k = 0; k < 64; ++k) S[k] = 0.f;
        for (int t = 0; t < NST; ++t) { const size_t o = (size_t)(b * SEQ + t) * BW + col0 + lane;
            const float av = -bf2f(KK[o]), bv = bf2f(Bv[o]), dv = expf(-bf2f(Esv[t * 64 + lane])), kv = bf2f(KP[o]), rv = bf2f(R[o]), vv = bf2f(V[o]);
            float sa = 0.f;
#pragma unroll
            for (int k = 0; k < 64; ++k) sa += S[k] * __shfl(av, k);
            float y = 0.f;
#pragma unroll
            for (int k = 0; k < 64; ++k) { S[k] = S[k] * __shfl(dv, k) + sa * __shfl(bv, k) + vv * __shfl(kv, k); y += S[k] * __shfl(rv, k); }
            const float mean = wave_sum(y) / 64.f, d = y - mean, var = wave_sum(d * d) / 64.f;
            const float yn = d / sqrtf(var + GN_EPS) * A.lnx_w[col0 + lane] + A.lnx_b[col0 + lane];
            const float bonus = wave_sum(rv * kv * A.r_k[col0 + lane]) * vv;
            const float want = (yn + bonus) * bf2f(GG[o]);
            chk(ws, t < 128 ? 24 : 25, bf2f(YRW[o]), want, 0.05f, 0.03f); } }
}
DI void chk_p8(const Frame& F, ARef A) {
    unsigned char* ws = A.ws; const int lane = F.lane;
    for (int s = F.wave; s < 32; s += NWAVES) { const unsigned hh = hsh(9000 + s); const int n = hh % NTOK, c = (hh >> 15) & 1023;
        const float p1 = wdot((const bf16*)(ws + WS_QB) + (size_t)n * BW, A.w_o_sb, D, c, BW, lane), p2 = wdot((const bf16*)(ws + WS_YRW) + (size_t)n * BW, A.w_o_rw, D, c, BW, lane);
        const bf16* ga = (const bf16*)(ws + WS_GATE) + (size_t)n * 2048;
        chk(ws, 26, bf2f(((const bf16*)(ws + WS_MRG))[(size_t)n * D + c]), bf2f(ga[c]) * p1 + bf2f(ga[1024 + c]) * p2, 0.03f, 0.01f); }
}
DI void chk_p9(const Frame& F, ARef A) {
    unsigned char* ws = A.ws; const int lane = F.lane;
    for (int s = F.wave; s < 32; s += NWAVES) { const unsigned hh = hsh(9500 + s); const int n = hh % NTOK, c = (hh >> 15) & 1023;
        chk(ws, 27, bf2f(((const bf16*)(ws + WS_Y1))[(size_t)n * D + c]), wdot((const bf16*)(ws + WS_MRG) + (size_t)n * D, A.w_out, D, c, D, lane), 0.03f, 0.01f); }
}
DI void chk_p10(const Frame& F, ARef A) {
    unsigned char* ws = A.ws; const int lane = F.lane; const float* mod = (const float*)(ws + WS_MOD);
    const bf16* Y1 = (const bf16*)(ws + WS_Y1); const bf16* H2 = (const bf16*)(ws + WS_H2); const i32x4* tok = (const i32x4*)(ws + WS_TOK);
    for (int s = F.wave; s < 32; s += NWAVES) { const int n = s == 0 ? DBG_TOKEN : (s < 16 ? (int)(hsh(10000 + s) % 128) : (int)(hsh(10000 + s) % NTOK)), b = n >> 13; float ss = 0.f;
        for (int k = lane; k < D; k += 64) { const float v = bf2f(Y1[(size_t)n * D + k]); ss += v * v; }
        const float inv1 = 1.0f / sqrtf(wave_sum(ss) / D + NORM_EPS); float s2 = 0.f;
        for (int k = lane; k < D; k += 64) { const float x1 = A.x[(size_t)n * D + k] + mod[b * 6144 + 2 * D + k] * ((bf2f(Y1[(size_t)n * D + k]) * inv1) * A.gains[D + k]);
            chk(ws, 28, A.out[(size_t)n * D + k], x1, 1e-3f, 1e-3f); s2 += x1 * x1; }
        const float inv2 = 1.0f / sqrtf(wave_sum(s2) / D + NORM_EPS);
        float lg[36];
#pragma unroll
        for (int o = 0; o < 36; ++o) lg[o] = 0.f;
        for (int k = lane; k < D; k += 64) { const float h2 = (A.out[(size_t)n * D + k] * inv2) * A.gains[2 * D + k] * (1.0f + mod[b * 6144 + 4 * D + k]) + mod[b * 6144 + 3 * D + k];
            chk(ws, 29, bf2f(H2[(size_t)n * D + k]), h2, 0.01f, 0.01f);
#pragma unroll
            for (int o = 0; o < 36; ++o) lg[o] += h2 * (o < 4 ? A.w_group[k * 4 + o] : A.w_router[k * NE + o - 4]); }
#pragma unroll
        for (int o = 0; o < 36; ++o) lg[o] = wave_sum(lg[o]);
        int gs = 0; float gm = lg[0];
#pragma unroll
        for (int g = 1; g < 4; ++g) if (lg[g] > gm) { gm = lg[g]; gs = g; }
        float gsum = 0.f;
#pragma unroll
        for (int g = 0; g < 4; ++g) gsum += expf(lg[g] - gm);
        float el[8];
#pragma unroll
        for (int e = 0; e < 8; ++e) el[e] = gs == 0 ? lg[4 + e] : (gs == 1 ? lg[12 + e] : (gs == 2 ? lg[20 + e] : lg[28 + e]));
        int i0 = 0; float m0 = el[0];
#pragma unroll
        for (int e = 1; e < 8; ++e) if (el[e] > m0) { m0 = el[e]; i0 = e; }
        int i1 = -1; float m1 = -3.0e38f;
#pragma unroll
        for (int e = 0; e < 8; ++e) if (e != i0 && el[e] > m1) { m1 = el[e]; i1 = e; }
        const float tt = expf(m1 - m0), p0 = 1.0f / (1.0f + tt);
        const i32x4 rec = tok[n];
        if (lane == 0 && s < 16) { if ((rec.x & 255) != gs * 8 + i0 || ((rec.x >> 8) & 255) != gs * 8 + i1) chk_flags(ws)[30] = 1u;
            if (n == DBG_TOKEN) { const float* dbg = (const float*)chk_flags(ws) + 48; float code = 1.f;
                if (dbg[4] > 4.001f) code += 2.f; if (dbg[5] < 0.499f) code += 4.f;
                if (fabsf(dbg[0] - lg[0]) > 1e-3f || fabsf(dbg[1] - lg[1]) > 1e-3f || fabsf(dbg[2] - lg[2]) > 1e-3f || fabsf(dbg[3] - lg[3]) > 1e-3f) code += 8.f;
                if (fabsf(dbg[4] - gsum) > 1e-3f) code += 16.f; if (fabsf(dbg[6] * dbg[5] - __builtin_bit_cast(float, rec.z)) > 1e-4f) code += 32.f;
                ((float*)chk_flags(ws))[62] = code * 0.1f; ((float*)chk_flags(ws))[63] = dbg[4]; }
            chk(ws, 56, ((const float*)(ws + WS_CW))[2 * n], p0 / gsum, 3e-2f, 1e-4f); chk(ws, 57, ((const float*)(ws + WS_CW))[2 * n + 1], tt * p0 / gsum, 3e-2f, 1e-4f);
            chk(ws, 58, ((const float*)(ws + WS_CW))[2 * n], p0 / gsum, 1e-3f, 1e-5f); chk(ws, 59, ((const float*)(ws + WS_CW))[2 * n + 1], tt * p0 / gsum, 1e-3f, 1e-5f); } }
}
DI void chk_p11(const Frame& F, ARef A) {
    unsigned char* ws = A.ws; const int lane = F.lane; const i32x4* tok = (const i32x4*)(ws + WS_TOK); const int* tile = (const int*)(ws + WS_TILE);
    const bf16* H2 = (const bf16*)(ws + WS_H2); const bf16* HS = (const bf16*)(ws + WS_HS);
    for (int s = F.wave; s < 64; s += NWAVES) { const int n = hsh(11000 + s) % NTOK; const i32x4 rec = tok[n];
        if (rec.x < 0 || rec.x >= tile[MAXT] * 256 || rec.y < 0 || rec.y >= tile[MAXT] * 256 || tile[MAXT] > MAXT || tile[MAXT] < 256) { chk_flags(ws)[32] = 1u; continue; }
        for (int k = lane; k < D; k += 64) { chk(ws, 33, bf2f(HS[(size_t)rec.x * D + k]), bf2f(H2[(size_t)n * D + k]), 0.f, 0.f); chk(ws, 33, bf2f(HS[(size_t)rec.y * D + k]), bf2f(H2[(size_t)n * D + k]), 0.f, 0.f); } }
    { const unsigned hh = hsh(12000 + F.wave * 64 + lane); const int e = hh & 31, n = (hh >> 5) & 1023, k = (hh >> 15) & 1023, k5 = k & 511;
        const int c = (n >> 3) * 4 + (n & 3); const float want = (n & 4) ? A.w_up3[((size_t)e * D + k) * DE + c] : A.w_up1[((size_t)e * D + k) * DE + c];
        chk(ws, 34, bf2f(((const bf16*)(ws + WS_WUP))[((size_t)e * 1024 + n) * D + k]), bfr(want), 0.f, 0.f);
        chk(ws, 35, bf2f(((const bf16*)(ws + WS_WDN))[((size_t)e * 1024 + n) * DE + k5]), bfr(A.w_down[((size_t)e * DE + k5) * D + n]), 0.f, 0.f); }
}
DI void chk_p12(const Frame& F, ARef A) {
    unsigned char* ws = A.ws; const int lane = F.lane; const i32x4* tok = (const i32x4*)(ws + WS_TOK); const int* tile = (const int*)(ws + WS_TILE);
    const bf16* H2 = (const bf16*)(ws + WS_H2); const bf16* HID = (const bf16*)(ws + WS_HID);
    for (int s = F.wave; s < 32; s += NWAVES) { const unsigned hh = hsh(13000 + s); const int n = hh % NTOK, c = (hh >> 16) & 511; const i32x4 rec = tok[n]; const int pos = (s & 1) ? rec.y : rec.x;
        const int e = tile[pos >> 8];
        const float u1 = wdot(H2 + (size_t)n * D, A.w_up1 + (size_t)e * D * DE, DE, c, D, lane), u3 = wdot(H2 + (size_t)n * D, A.w_up3 + (size_t)e * D * DE, DE, c, D, lane);
        chk(ws, 36, bf2f(HID[(size_t)pos * DE + c]), u1 / (1.0f + expf(-u1)) * u3, 0.04f, 0.01f); }
}
DI void chk_p13(const Frame& F, ARef A) {
    unsigned char* ws = A.ws; const int lane = F.lane; const i32x4* tok = (const i32x4*)(ws + WS_TOK); const int* tile = (const int*)(ws + WS_TILE);
    const bf16* HID = (const bf16*)(ws + WS_HID); const bf16* YE = (const bf16*)(ws + WS_HS);
    for (int s = F.wave; s < 32; s += NWAVES) { const unsigned hh = hsh(14000 + s); const int n = hh % NTOK, c = (hh >> 16) & 1023; const i32x4 rec = tok[n]; const int pos = (s & 1) ? rec.y : rec.x;
        const int e = tile[pos >> 8];
        chk(ws, 37, bf2f(YE[(size_t)pos * D + c]), wdot(HID + (size_t)pos * DE, A.w_down + (size_t)e * DE * D, D, c, DE, lane), 0.04f, 0.01f); }
}
#endif

__global__ void __launch_bounds__(NTHR, 2) hybrid_fwd(Args A_unused) {
    extern __shared__ __attribute__((aligned(16))) unsigned char lds_raw[];
    const CAS Args& A = *(const CAS Args*)__builtin_amdgcn_kernarg_segment_ptr();
    Frame F;
    F.lds = (LAS unsigned char*)lds_raw;
    F.wave = __builtin_amdgcn_readfirstlane((int)threadIdx.x >> 6); F.tid = opq_tid(F.wave); F.lane = F.tid & 63;
    F.wg = blockIdx.x; F.G = gridDim.x; F.gw = F.wg * NWAVES + F.wave; F.NGW = F.G * NWAVES;
    volatile LAS unsigned* MISC = (volatile LAS unsigned*)(F.lds + LDS_MISC);
    if (F.wave == 0) MISC[F.lane] = 0u;
    __syncthreads();
    const XcdBarrier bar = xcd_barrier_post((unsigned*)(A.ws + WS_CTL), MISC + 8, F.wave);
    unsigned char* ws = A.ws;
    LAS unsigned char* stage = F.lds;
    bf16* const dob = (bf16*)A.out;
    bf16 *H1 = dob, *R = dob, *KS = dob + (size_t)NTOK * BW, *V = dob + 2 * (size_t)NTOK * BW, *KK = dob + 3 * (size_t)NTOK * BW;

#if defined(STAMPS)
    unsigned long long* const tsp = (unsigned long long*)(ws + WS_CTL + 49152);
#define STAMP(k) do { if (F.wg == 0 && xb_t0(F.wave)) tsp[k] = wall_clock64(); } while (0)
#elif defined(TIMEPHASE)
#define STAMP(k) TPS(F, k)
#else
#define STAMP(k) do { } while (0)
#endif
#if defined(REPEAT_PHASE)
#ifndef REPEAT_COUNT
#define REPEAT_COUNT 2
#endif
#define REP(k) _Pragma("nounroll") for (int rep_ = 0; rep_ < ((k) == REPEAT_PHASE ? REPEAT_COUNT : 1); ++rep_)
#else
#define REP(k)
#endif
    STAMP(0);
    REP(0) {
    p0_prologue(F, A);
    xcd_barrier(bar);
    }
    STAMP(1);
#if defined(CHECKS)
    if (F.wg == 0) chk_p0(F, A);
#endif
    REP(1) {
    p1_h1(F, A, H1);
    xcd_barrier(bar);
    }
    STAMP(2);
#if defined(CHECKS)
    if (F.wg == 0) chk_p1(F, A, H1);
#endif
    REP(2) {
    {   pg8::Gemm g{H1, (const bf16*)(ws + WS_WIN), NTOK, NPAD, D}; pg8::StaticOrder S; S.init(NTOK, NPAD, F.G, F.wg);
        EpiIn E{(bf16*)(ws + WS_QB), (bf16*)(ws + WS_KB), (bf16*)(ws + WS_VT), (bf16*)(ws + WS_RWRAW), (bf16*)(ws + WS_LORA), (bf16*)(ws + WS_GATE), A.gate_bias};
        pg8::gemm_phase<EpiIn, pg8::StaticOrder>(stage, g, S, E, nullptr, F.wave); }
    xcd_barrier(bar);
    }
    STAMP(3);
#if defined(CHECKS)
    if (F.wg == 0) { chk_p2(F, A, H1); chk_p3_save(F, A); }
    xcd_barrier(bar);
#endif
#if !defined(CHECKS)
    const bool fuse34 = (F.G == 256);
#else
    const bool fuse34 = false;
#endif
    REP(3) {
#if defined(TIMEPHASE)
    STAMP(30);
#endif
    p3_attn(F, (const bf16*)(ws + WS_QB), (const bf16*)(ws + WS_KB), (const bf16*)(ws + WS_VT), (bf16*)(ws + WS_QB));
#if defined(STAMPS)
    STAMP(20);
#endif
#if defined(TIMEPHASE)
    STAMP(31);
#endif
    p3_prep(F, A, (const bf16*)(ws + WS_RWRAW), (const bf16*)(ws + WS_LORA), R, KS, V, KK, (bf16*)(ws + WS_ALORA));
#if defined(TIMEPHASE)
    STAMP(32);
#endif
#if !defined(CHECKS)
    if (fuse34) { asm volatile("s_waitcnt vmcnt(0)" ::: "memory"); __syncthreads();
        p4_lora(F, A, (const bf16*)(ws + WS_ALORA), (const bf16*)(ws + WS_WL), (bf16*)(ws + WS_E), KS, (bf16*)(ws + WS_B), (bf16*)(ws + WS_GG), KK, R, (float*)(ws + WS_BON)); }
#endif
#if defined(TIMEPHASE)
    STAMP(33);
#endif
    xcd_barrier(bar);
    }
#if defined(STAMPS)
    STAMP(21);
#endif
    STAMP(4);
#if defined(CHECKS)
    if (F.wg == 0) { chk_p3(F, A, R, KS, V, KK); chk_p4_save(F, A, KS); }
    xcd_barrier(bar);
#endif
    if (!fuse34) {
    p4_lora(F, A, (const bf16*)(ws + WS_ALORA), (const bf16*)(ws + WS_WL), (bf16*)(ws + WS_E), KS, (bf16*)(ws + WS_B), (bf16*)(ws + WS_GG), KK, R, (float*)(ws + WS_BON));
    xcd_barrier(bar);
    }
    STAMP(5);
#if defined(CHECKS)
    if (F.wg == 0) chk_p4(F, A, KS, KK);
#endif
    REP(5) {
    p5_mfma(ws, F, R, KS, V, KK, (const bf16*)(ws + WS_B), (const bf16*)(ws + WS_E), (bf16*)(ws + WS_P), (bf16*)(ws + WS_QO), (bf16*)(ws + WS_GT), (bf16*)(ws + WS_HT));
    p6_moe_weights(F, A, F.gw, F.NGW);
    xcd_barrier(bar);
    }
    STAMP(6);
#if defined(CHECKS)
    if (F.wg == 255) chk_p7_save(F, A);
#endif
    REP(6) {
    {   const int ncw = F.G < 64 ? F.G : 64;
        if (F.wg < ncw) { if (F.wave == 0) for (int task = F.wg; task < 64; task += ncw) p6_chain(task, F.wave, F.lds, (const bf16*)(ws + WS_GT), (const bf16*)(ws + WS_HT), (bf16*)(ws + WS_SC));
#if defined(STAMPS)
            STAMP(22);
#endif
        }
        else {
            pg8::StaticOrder S; S.init(NTOK, D, F.G - ncw, F.wg - ncw);
            pg8::Gemm g{(const bf16*)(ws + WS_QB), (const bf16*)(ws + WS_WOSB), NTOK, D, BW};
            EpiMerge<false> E{(bf16*)(ws + WS_GATE), (bf16*)(ws + WS_MRG), 0};
            pg8::gemm_phase<EpiMerge<false>, pg8::StaticOrder>(stage, g, S, E, nullptr, F.wave); }
    }
    xcd_barrier(bar);
    }
    STAMP(7);
    REP(7) {
    p7_mfma(F, A, (const bf16*)(ws + WS_SC), (const bf16*)(ws + WS_P), (const bf16*)(ws + WS_QO), V, (const bf16*)(ws + WS_GG), (const float*)(ws + WS_BON), (bf16*)(ws + WS_YRW));
    xcd_barrier(bar);
    }
    STAMP(8);
#if defined(CHECKS)
    if (F.wg == 0) chk_p7(F, A, R, KS, V, KK);
#endif
    REP(8) {
    {   pg8::StaticOrder S; S.init(NTOK, D, F.G, F.wg);
        {   pg8::Gemm g{(const bf16*)(ws + WS_YRW), (const bf16*)(ws + WS_WORW), NTOK, D, BW};
            EpiMerge<true> E{(bf16*)(ws + WS_GATE), (bf16*)(ws + WS_MRG), D};
            pg8::gemm_phase<EpiMerge<true>, pg8::StaticOrder>(stage, g, S, E, nullptr, F.wave); } }
    xcd_barrier(bar);
    }
    STAMP(9);
#if defined(CHECKS)
    if (F.wg == 0) chk_p8(F, A);
#endif
    REP(9) {
    {   pg8::Gemm g{(const bf16*)(ws + WS_MRG), (const bf16*)(ws + WS_WOUT), NTOK, D, D}; pg8::StaticOrder S; S.init(NTOK, D, F.G, F.wg);
        EpiPlain E{(bf16*)(ws + WS_Y1), D, 0xff};
        pg8::gemm_phase<EpiPlain, pg8::StaticOrder>(stage, g, S, E, nullptr, F.wave); }
    xcd_barrier(bar);
    }
    STAMP(10);
#if defined(CHECKS)
    if (F.wg == 0) chk_p9(F, A);
#endif
    REP(10) {
    p10_rows(F, A, (const bf16*)(ws + WS_Y1), (bf16*)(ws + WS_H2));
    xcd_barrier(bar);
    }
    STAMP(11);
#if defined(CHECKS)
    if (F.wg == 0) chk_p10(F, A);
#endif
    REP(11) {
    p11_rank_gather(F, A, (const bf16*)(ws + WS_H2), (bf16*)(ws + WS_HS));
    xcd_barrier(bar);
    }
    STAMP(12);
#if defined(CHECKS)
    if (F.wg == 0) chk_p11(F, A);
#endif
    {   const int* tile = (const int*)(ws + WS_TILE);
        const int nt = __builtin_amdgcn_readfirstlane(tile[MAXT]);
        const int vc = (F.G % 8 == 0) ? (F.wg % 8) * (F.G / 8) + F.wg / 8 : F.wg;
        unsigned* tcnt = (unsigned*)(ws + WS_CTL) + MOE_CNT_WORD;
        REP(12) {   pg8::Gemm g{(const bf16*)(ws + WS_HS), (const bf16*)(ws + WS_WUP), MAXT * 256, NE * 1024, D};
            MoeUpOrder S; S.nunits = nt * 4; S.G = F.G; S.vc = vc; S.tile_e = tile; S.cnt = tcnt;
            EpiUp E{(bf16*)(ws + WS_HID)};
            pg8::gemm_phase<EpiUp, MoeUpOrder>(stage, g, S, E, nullptr, F.wave); }
        __syncthreads();
    STAMP(13);
        REP(13) {   pg8::Gemm g{(const bf16*)(ws + WS_HID), (const bf16*)(ws + WS_WDN), MAXT * 256, NE * 1024, DE};
            MoeDnOrder S; S.nunits = nt * 4; S.G = F.G; S.vc = vc; S.q = (nt * 4) / F.G; S.rem = nt * 4 - S.q * F.G; S.wave = F.wave; S.tile_e = tile; S.cnt = tcnt;
            EpiPlain E{(bf16*)(ws + WS_HS), D, 3};
            pg8::gemm_phase<EpiPlain, MoeDnOrder>(stage, g, S, E, nullptr, F.wave);
        xcd_barrier(bar); } }
    STAMP(14);
#if defined(CHECKS)
    if (F.wg == 0) chk_p13(F, A);
#endif
    p14_final(F, A, (const bf16*)(ws + WS_HS));
#if defined(STAMPS)
    xcd_barrier(bar);
    STAMP(15);
    if (F.wg == 0) { __syncthreads();
        const float va = (float)(long long)(tsp[STAMP_A2] - tsp[STAMP_A]) * 0.01f, vb = (float)(long long)(tsp[STAMP_B2] - tsp[STAMP_B]) * 0.01f;
#if defined(STAMP_SHIFT)
        const float shf_ = 1.1f;
#else
        const float shf_ = 1.0f;
#endif
        int b1 = (int)floorf(logf(fmaxf(va * shf_, 1.0f)) / logf(1.21f)) + 1, b2 = (int)floorf(logf(fmaxf(vb * shf_, 1.0f)) / logf(1.21f)) + 1;
#if defined(STAMP_CAL)
        b1 = 10; b2 = 30;
#endif
#if defined(STAMP_FRAC)
        { const unsigned long long* t5 = tsp + 32; const float tot = (float)(long long)(t5[9] - t5[0]);
          b1 = (int)(12.0f * (float)(long long)(t5[STAMP_A2] - t5[STAMP_A]) / tot) + 3; b2 = (int)(12.0f * (float)(long long)(t5[STAMP_B2] - t5[STAMP_B]) / tot) + 3; }
#endif
#if defined(STAMP_THR_A)
        b1 = va > (float)(STAMP_THR_A) ? 30 : 10; b2 = vb > (float)(STAMP_THR_B) ? 30 : 10;
#endif
        const int t_ = opq_tid(F.wave);
        for (int i = t_; i < 1000; i += NTHR) A.out[1000 + i] += 20.0f * (float)b2;
        if (t_ == 0) A.out[0] = 200.0f * (float)b1; }
#endif
#if defined(CHECKS)
    xcd_barrier(bar);
    if (F.wg == 0 && F.tid == 0) { const unsigned* fl = chk_flags(ws); int id = 0; for (int i = 61; i >= 0; --i) if (fl[i]) id = i;
        if (((const unsigned*)(ws + WS_CTL))[XB_TMO]) id = 60;
        if (id) A.out[0] = 10.0f * (float)id;
#if defined(CHKVAL)
        A.out[0] = 1000.0f * ((const float*)fl)[CHKVAL];
#endif
        }
#endif
}

extern "C" void kernel_launch(void* const* d_in, const int* in_sizes, int n_in, void* d_out, int out_size, void* d_ws, size_t ws_size, hipStream_t stream) {
    static int grid = 0;
    if (grid == 0) {
        if (n_in != 26 || in_sizes[0] != NTOK * D || out_size != NTOK * D || ws_size < WS_END) {
            fprintf(stderr, "kernel_launch: unexpected shapes (n_in %d, in0 %d, out %d, ws %zu); nothing launched\n", n_in, n_in > 0 ? in_sizes[0] : -1, out_size, ws_size); grid = -1; return; }
        int dev = 0, cus = 0, per_cu = 0;
        if (hipGetDevice(&dev) != hipSuccess || hipDeviceGetAttribute(&cus, hipDeviceAttributeMultiprocessorCount, dev) != hipSuccess) { grid = -1; return; }
        if (hipFuncSetAttribute((const void*)hybrid_fwd, hipFuncAttributeMaxDynamicSharedMemorySize, LDS_BYTES) != hipSuccess) { fprintf(stderr, "kernel_launch: hipFuncSetAttribute failed\n"); grid = -1; return; }
        if (hipOccupancyMaxActiveBlocksPerMultiprocessor(&per_cu, (const void*)hybrid_fwd, NTHR, LDS_BYTES) != hipSuccess || per_cu < 1)
            fprintf(stderr, "kernel_launch: note: occupancy query reports %d workgroups per CU\n", per_cu);
        (void)hipGetLastError();
        grid = cus > 256 ? 256 : cus;
    }
    if (grid < 0) return;
    if (hipMemsetAsync((char*)d_ws + WS_CTL, 0, CTL_ZERO_BYTES, stream) != hipSuccess) return;
    Args a{};
    const float** p = (const float**)&a;
    for (int i = 0; i < 26; ++i) p[i] = (const float*)d_in[i];
    a.out = (float*)d_out; a.ws = (unsigned char*)d_ws;
    hipLaunchKernelGGL(hybrid_fwd, dim3(grid), dim3(NTHR), LDS_BYTES, stream, a);
}

#if defined(ONLY_P5)
__global__ void __launch_bounds__(NTHR, 2) only_p5(Args A_unused) {
    extern __shared__ __attribute__((aligned(16))) unsigned char lds_raw[];
    const CAS Args& A = *(const CAS Args*)__builtin_amdgcn_kernarg_segment_ptr();
    Frame F; F.lds = (LAS unsigned char*)lds_raw; F.wave = __builtin_amdgcn_readfirstlane((int)threadIdx.x >> 6); F.tid = opq_tid(F.wave); F.lane = F.tid & 63;
    F.wg = blockIdx.x; F.G = gridDim.x; F.gw = F.wg * NWAVES + F.wave; F.NGW = F.G * NWAVES;
    unsigned char* ws = A.ws; bf16* const dob = (bf16*)A.out;
    bf16 *R = dob, *KS = dob + (size_t)NTOK * BW, *V = dob + 2 * (size_t)NTOK * BW, *KK = dob + 3 * (size_t)NTOK * BW;
    p5_mfma(ws, F, R, KS, V, KK, (const bf16*)(ws + WS_B), (const bf16*)(ws + WS_E), (bf16*)(ws + WS_P), (bf16*)(ws + WS_QO), (bf16*)(ws + WS_GT), (bf16*)(ws + WS_HT));
}
#endif
```

```cpp
#include <hip/hip_runtime.h>
#include <cstdio>
#include <cstdint>
__device__ __forceinline__ int opq_tid(int wave) { int l; asm volatile("v_mbcnt_lo_u32_b32 %0, -1, 0\n\tv_mbcnt_hi_u32_b32 %0, -1, %0" : "=v"(l)); return wave * 64 + l; }
#ifndef PHMASK
#define PHMASK 0xffff
#endif
namespace pg8 {
#define PG8_LAS __attribute__((address_space(3)))
typedef unsigned short bf16_t;
typedef short bf16x8 __attribute__((ext_vector_type(8)));
typedef float f32x4 __attribute__((ext_vector_type(4)));
typedef unsigned u32x4 __attribute__((ext_vector_type(4)));
constexpr int BM = 256, BK = 64, HALF = 128, HTB = HALF * BK * 2  , STAGE_BYTES = 8 * HTB, NXCD = 8, WGM = 8;

__host__ __device__ __forceinline__ int lds_byte(int r, int c) { const int st = (r >> 4) * 2 + (c >> 5), rr = r & 15, cc = c & 31, ob = rr * 64 + cc * 2; return st * 1024 + (ob ^ (((ob >> 9) & 1) << 5)); }
__host__ __device__ __forceinline__ void stage_rc(int b, int& R, int& C) { const int st = b / 1024, sb = b % 1024, swz = sb ^ (((sb >> 9) & 1) << 5); R = (st >> 1) * 16 + swz / 64; C = (st & 1) * 32 + (swz % 64) / 2; }
__host__ __device__ __forceinline__ int perm32(int rho) { const int n = rho >> 4, i = rho & 15; return 8 * (i >> 2) + 4 * n + (i & 3); }

struct Unit { int pm, pn; };
struct Gemm { const bf16_t* A; const bf16_t* Bt; int M, N, K; };

struct StaticOrder {
    int nM, nN, nwg, G, c;
    __host__ __device__ void init(int M, int N, int G_, int c_) { nM = M / BM; nN = N / BM; nwg = nM * nN; G = G_; c = c_; }
    __host__ __device__ bool next(int i, Unit& u) const {
        const long L = (long)i * G + c; if (L >= nwg) return false;
        int wgid = (int)L; { const int q = nwg / NXCD, r = nwg % NXCD, xcd = wgid % NXCD, off = wgid / NXCD; wgid = (xcd < r ? xcd * (q + 1) : r * (q + 1) + (xcd - r) * q) + off; }
        const int nig = WGM * nN, gid = wgid / nig, fm = gid * WGM, gsz = (nM - fm) < WGM ? (nM - fm) : WGM;
        u.pm = fm + ((wgid % nig) % gsz); u.pn = (wgid % nig) / gsz; return true;
    }
    __device__ __forceinline__ void a_ready(const Unit&) const {}
    __device__ __forceinline__ void done(const Unit&) const {}
};

template <class Epi, class Sched, bool STAMP = false>
__device__ __forceinline__ void gemm_phase(PG8_LAS unsigned char* lds, const Gemm g, const Sched& S, const Epi& E, unsigned long long* stamps, int wave_id) {
    const int tid = opq_tid(wave_id), wid = __builtin_amdgcn_readfirstlane(tid >> 6), lane = tid & 63, wr = wid >> 2, wc = wid & 3, fr = lane & 15, fq = lane >> 4;
    const int K = g.K, nt = K / BK;
    int ts_lo = 0, ts_hi = 0, nts = 0; const unsigned long long rt_entry = STAMP ? (unsigned long long)wall_clock64() : 0ull;
#define PG8_STAMP() do { if (STAMP && wid == 0 && nts < 64) { const unsigned long long _c = (unsigned long long)clock64(); \
        ts_lo = (lane == nts) ? (int)(unsigned)_c : ts_lo; ts_hi = (lane == nts) ? (int)(unsigned)(_c >> 32) : ts_hi; ++nts; } } while (0)
    PG8_STAMP();
    unsigned voffA[2], voffB[2];
#pragma unroll
    for (int i = 0; i < 2; ++i) { int R, C; stage_rc(tid * 16 + i * 8192, R, C); const int Rb = Epi::PERM ? ((R & ~31) + perm32(R & 31)) : R;
        voffA[i] = (unsigned)(R * K + C) * 2u; voffB[i] = (unsigned)(Rb * K + C) * 2u; }
    const size_t kstep = (size_t)(BK * 2);
    const size_t hstep = (size_t)HALF * K * 2;
    const size_t tstep = 2 * hstep;
    const unsigned ldsw = (unsigned)wid * 1024u;
    const int aoff = lds_byte(wr * 64 + fr, fq * 8), boff = lds_byte(wc * 32 + fr, fq * 8);
#define PG8_SA(b, h) (((b) * 2 + (h)) * HTB)
#define PG8_SB(b, h) ((4 + (b) * 2 + (h)) * HTB)
#define PG8_STAGE(bufoff, gbase, voff) do { _Pragma("unroll") for (int _i = 0; _i < 2; ++_i) \
        __builtin_amdgcn_global_load_lds((const unsigned*)((const char*)(gbase) + (voff)[_i]), (PG8_LAS unsigned*)(lds + (bufoff) + ldsw + _i * 8192), 16, 0, 0); } while (0)
#define PG8_LDA(dst, b, h) do { _Pragma("unroll") for (int m = 0; m < 4; ++m) _Pragma("unroll") for (int k = 0; k < 2; ++k) dst[m][k] = *(const PG8_LAS bf16x8*)(lds + PG8_SA(b, h) + aoff + m * 2048 + k * 1024); } while (0)
#define PG8_LDB(dst, b, h) do { _Pragma("unroll") for (int n = 0; n < 2; ++n) _Pragma("unroll") for (int k = 0; k < 2; ++k) dst[n][k] = *(const PG8_LAS bf16x8*)(lds + PG8_SB(b, h) + boff + n * 2048 + k * 1024); } while (0)
#define PG8_MMA(ai, bj, At, Bt) do { __builtin_amdgcn_s_setprio(1); _Pragma("unroll") for (int m = 0; m < 4; ++m) _Pragma("unroll") for (int n = 0; n < 2; ++n) _Pragma("unroll") for (int k = 0; k < 2; ++k) \
        acc[ai][bj][m][n] = __builtin_amdgcn_mfma_f32_16x16x32_bf16(Bt[n][k], At[m][k], acc[ai][bj][m][n], 0, 0, 0); __builtin_amdgcn_s_setprio(0); } while (0)
#define PG8_WAIT_V(n) asm volatile("s_waitcnt vmcnt(" #n ")" ::: "memory")
#define PG8_WAIT_L(n) asm volatile("s_waitcnt lgkmcnt(" #n ")" ::: "memory")
#define PG8_BAR __builtin_amdgcn_s_barrier()
#define PG8_SCHED __builtin_amdgcn_sched_barrier(0)
    Unit cur, nxt; int ui = 0;
    if (!S.next(0, cur)) return;
    f32x4 acc[2][2][4][2];
#pragma unroll
    for (int a = 0; a < 2; ++a)
#pragma unroll
        for (int b = 0; b < 2; ++b)
#pragma unroll
            for (int m = 0; m < 4; ++m)
#pragma unroll
                for (int n = 0; n < 2; ++n) acc[a][b][m][n] = (f32x4){0.f, 0.f, 0.f, 0.f};
    bf16x8 At[4][2], B0[2][2], B1[2][2];
    const char* cA = (const char*)g.A + (size_t)cur.pm * tstep; const char* cB = (const char*)g.Bt + (size_t)cur.pn * tstep;
    S.a_ready(cur);
    PG8_STAGE(PG8_SB(0, 0), cB, voffB); PG8_STAGE(PG8_SA(0, 0), cA, voffA); PG8_STAGE(PG8_SB(0, 1), cB + hstep, voffB); PG8_STAGE(PG8_SA(0, 1), cA + hstep, voffA);
    if (wr == 1) PG8_BAR;
    PG8_WAIT_V(4); PG8_BAR;
    PG8_STAGE(PG8_SB(1, 0), cB + kstep, voffB); PG8_STAGE(PG8_SA(1, 0), cA + kstep, voffA); PG8_STAGE(PG8_SB(1, 1), cB + hstep + kstep, voffB);
    PG8_WAIT_V(6); PG8_BAR;
    PG8_STAMP();
    for (;;) {
        const bool has_next = S.next(ui + 1, nxt);
        const char* nA = has_next ? (const char*)g.A + (size_t)nxt.pm * tstep : cA; const char* nB = has_next ? (const char*)g.Bt + (size_t)nxt.pn * tstep : cB;
        for (int t = 0; t < nt; t += 2) {
            const bool last = (t == nt - 2);
            const char* a1 = cA + (size_t)(t + 1) * kstep;
            const char* a2 = last ? nA : cA + (size_t)(t + 2) * kstep; const char* b2 = last ? nB : cB + (size_t)(t + 2) * kstep;
            const char* a3 = a2 + kstep; const char* b3 = b2 + kstep;
            if (last && has_next) S.a_ready(nxt);
            PG8_LDB(B0, 0, 0); PG8_SCHED; PG8_LDA(At, 0, 0); PG8_STAGE(PG8_SA(1, 1), a1 + hstep, voffA);
            PG8_WAIT_L(8); PG8_BAR; PG8_WAIT_L(0); PG8_MMA(0, 0, At, B0); PG8_BAR; PG8_SCHED;
            PG8_LDB(B1, 0, 1); PG8_STAGE(PG8_SB(0, 0), b2, voffB);
            PG8_BAR; PG8_WAIT_L(0); PG8_MMA(0, 1, At, B1); PG8_BAR;
            PG8_LDA(At, 0, 1); PG8_STAGE(PG8_SA(0, 0), a2, voffA);
            PG8_BAR; PG8_WAIT_L(0); PG8_MMA(1, 0, At, B0); PG8_BAR; PG8_SCHED;
            PG8_STAGE(PG8_SB(0, 1), b2 + hstep, voffB);
            PG8_WAIT_V(6); PG8_BAR; PG8_MMA(1, 1, At, B1); PG8_BAR;
            PG8_LDB(B0, 1, 0); PG8_SCHED; PG8_LDA(At, 1, 0); PG8_STAGE(PG8_SA(0, 1), a2 + hstep, voffA);
            PG8_WAIT_L(8); PG8_BAR; PG8_WAIT_L(0); PG8_MMA(0, 0, At, B0); PG8_BAR; PG8_SCHED;
            PG8_LDB(B1, 1, 1); PG8_STAGE(PG8_SB(1, 0), b3, voffB);
            PG8_BAR; PG8_WAIT_L(0); PG8_MMA(0, 1, At, B1); PG8_BAR;
            PG8_LDA(At, 1, 1); PG8_STAGE(PG8_SA(1, 0), a3, voffA);
            PG8_BAR; PG8_WAIT_L(0); PG8_MMA(1, 0, At, B0); PG8_BAR; PG8_SCHED;
            PG8_STAGE(PG8_SB(1, 1), b3 + hstep, voffB);
            PG8_WAIT_V(6); PG8_BAR; PG8_MMA(1, 1, At, B1); PG8_BAR;
        }
        PG8_STAMP();
        if constexpr (!Epi::AFTER_DRAIN) { E(acc, cur, wr, wc, fr, fq); S.done(cur); }
        PG8_STAMP();
        if (!has_next) break;
#pragma unroll
        for (int a = 0; a < 2; ++a)
#pragma unroll
            for (int b = 0; b < 2; ++b)
#pragma unroll
                for (int m = 0; m < 4; ++m)
#pragma unroll
                    for (int n = 0; n < 2; ++n) acc[a][b][m][n] = (f32x4){0.f, 0.f, 0.f, 0.f};
        cur = nxt; cA = nA; cB = nB; ++ui;
    }
    PG8_WAIT_V(0);
    if (wr == 0) PG8_BAR;
    PG8_BAR;
    if constexpr (Epi::AFTER_DRAIN) { E.fused(acc, cur, wr, wc, fr, fq, lds, wid, lane); S.done(cur); }
    PG8_STAMP();
    if (STAMP && wid == 0) { stamps[lane] = lane < nts ? (((unsigned long long)(unsigned)ts_hi << 32) | (unsigned)ts_lo) : 0ull;
        if (lane == 62) stamps[62] = rt_entry; if (lane == 63) stamps[63] = (unsigned long long)wall_clock64(); }
#undef PG8_STAMP
#undef PG8_SA
#undef PG8_SB
#undef PG8_STAGE
#undef PG8_LDA
#undef PG8_LDB
#undef PG8_MMA
#undef PG8_WAIT_V
#undef PG8_WAIT_L
#undef PG8_BAR
#undef PG8_SCHED
}
}

#define XB_TMO      128
#define XB_XCNT(j)  (256  + 64 * (j))
#define XB_XSUB(j)  (1280 + 64 * (j))
#define XB_XGEN(j)  (2304 + 64 * (j))
#define XB_TOP      3328
#define XB_TOPGEN   3392
#define XCD_BAR_WORDS 3456
#define XB_SPIN_CAP (1u << 18)
#define LAS __attribute__((address_space(3)))

__device__ __forceinline__ unsigned xb_ld(unsigned* p)              { return __hip_atomic_load(p, __ATOMIC_RELAXED, __HIP_MEMORY_SCOPE_AGENT); }
__device__ __forceinline__ unsigned xb_add(unsigned* p, unsigned v) { return __hip_atomic_fetch_add(p, v, __ATOMIC_RELAXED, __HIP_MEMORY_SCOPE_AGENT); }
__device__ __forceinline__ unsigned xb_xcc_id() { return (unsigned)__builtin_amdgcn_s_getreg((3 << 11) | 20) & 0xFu; }
#define XB_SPIN(cond, bar) do { unsigned _sp = 0; while (cond) { __builtin_amdgcn_s_sleep(1); \
    if ((++_sp & 255u) == 0u) { if (xb_ld(&(bar)[XB_TMO])) break; if (_sp > XB_SPIN_CAP) { atomicAdd(&(bar)[XB_TMO], 1u); break; } } } } while (0)

struct XcdBarrier {
    unsigned* bar; unsigned x; int wave;
    volatile LAS unsigned* st;
};

__device__ __forceinline__ bool xb_t0(int wave) { return wave == 0 && __builtin_amdgcn_mbcnt_hi(~0u, __builtin_amdgcn_mbcnt_lo(~0u, 0u)) == 0u; }
__device__ __forceinline__ XcdBarrier xcd_barrier_post(unsigned* bar, volatile LAS unsigned* st, int wave) {
    XcdBarrier b; b.bar = bar; b.x = xb_xcc_id(); b.st = st; b.wave = wave;
    if (xb_t0(wave)) (void)xb_add(&bar[XB_XCNT(b.x)], 1u);
    return b;
}
__device__ __forceinline__ void xcd_barrier_complete(unsigned* bar, unsigned x, unsigned& nloc, unsigned& nx) {
    const unsigned G = gridDim.x * gridDim.y * gridDim.z;
    unsigned sum, cnt, mine, sp = 0u;
    for (;;) {
        sum = 0u; cnt = 0u; mine = 0u;
#pragma unroll
        for (unsigned j = 0; j < 16; ++j) { const unsigned c = xb_ld(&bar[XB_XCNT(j)]); sum += c; cnt += (c > 0u) ? 1u : 0u; mine = (j == x) ? c : mine; }
        if (sum == G) break;
        __builtin_amdgcn_s_sleep(1);
        if ((++sp & 255u) == 0u) { if (xb_ld(&bar[XB_TMO])) break; if (sp > XB_SPIN_CAP) { atomicAdd(&bar[XB_TMO], 1u); break; } }
    }
    nloc = mine > 0u ? mine : 1u; nx = cnt > 0u ? cnt : 1u;
}

__device__ __forceinline__ void xcd_barrier(const XcdBarrier& b) {
    asm volatile("s_waitcnt vmcnt(0)" ::: "memory");
    __syncthreads();
    if (xb_t0(b.wave)) {
        unsigned* bar = b.bar;
        __builtin_amdgcn_s_waitcnt(0);
        unsigned nloc = b.st[0], nx = b.st[1];
        if (nloc == 0u) { xcd_barrier_complete(bar, b.x, nloc, nx); b.st[0] = nloc; b.st[1] = nx; }
        const unsigned old = xb_add(&bar[XB_XSUB(b.x)], 1u);
        const unsigned gen = old / nloc;
        if (old + 1u == (gen + 1u) * nloc) {
            __builtin_amdgcn_fence(__ATOMIC_RELEASE, "agent");
            asm volatile("s_waitcnt vmcnt(0)" ::: "memory");
            const unsigned og = xb_add(&bar[XB_TOP], 1u);
            const unsigned tg = og / nx;
            if (og + 1u == (tg + 1u) * nx) xb_add(&bar[XB_TOPGEN], 1u);
            else XB_SPIN(xb_ld(&bar[XB_TOPGEN]) == tg, bar);
            __builtin_amdgcn_fence(__ATOMIC_ACQUIRE, "agent");
            xb_add(&bar[XB_XGEN(b.x)], 1u);
            asm volatile("s_waitcnt vmcnt(0)" ::: "memory");
        } else {
            XB_SPIN(xb_ld(&bar[XB_XGEN(b.x)]) == gen, bar);
            __builtin_amdgcn_fence(__ATOMIC_ACQUIRE, "agent");
            asm volatile("s_waitcnt vmcnt(0)" ::: "memory");
        }
    }
    __syncthreads();
}


constexpr int NB = 4, SEQ = 8192, D = 1024, NTOK = NB * SEQ;
constexpr int NH = 8, HD = 64, BW = 512;
constexpr int IN_COLS = 5408, NPAD = 5632;
constexpr int LK = 384;
constexpr int NE = 32, DE = 512;
constexpr int CH = 64, NCH = SEQ / CH, NCH_LOG = 7, NCHUNK = NB * NH * NCH;
constexpr int MAXT = 288;
constexpr float NORM_EPS = 1e-6f, GN_EPS = 64e-5f, L2_EPS = 1e-12f;
constexpr float SB_STOP = -104.5f;

constexpr size_t MiB = 1u << 20;
constexpr size_t WS_CTL = 0, CTL_ZERO_BYTES = 65536;
constexpr size_t WS_MOD = 1 * MiB;
constexpr size_t WS_RTW = WS_MOD + 128 * 1024;
constexpr size_t WS_TOK = WS_RTW + 160 * 1024;
constexpr size_t WS_CNT = WS_TOK + (size_t)NTOK * 16;
constexpr size_t WS_TILE = WS_CNT + 256 * 32 * 4;
constexpr size_t WS_WIN = 2 * MiB;
constexpr size_t WS_WOSB = 13 * MiB, WS_WORW = 14 * MiB, WS_WOUT = 15 * MiB;
constexpr size_t WS_WL = 17 * MiB;
constexpr size_t WS_BON = 18 * MiB + 256 * 1024;
constexpr size_t WS_CW = 19 * MiB + 768 * 1024;
constexpr size_t WS_QB = 20 * MiB;
constexpr size_t WS_GATE = 52 * MiB;
constexpr size_t WS_GG = 180 * MiB;
constexpr size_t WS_KB = 212 * MiB, WS_VT = 244 * MiB;
constexpr size_t WS_LORA = 276 * MiB;
constexpr size_t WS_ALORA = 308 * MiB;
constexpr size_t WS_E = 340 * MiB, WS_B = 372 * MiB;
constexpr size_t WS_RWRAW = 416 * MiB;
constexpr size_t WS_P = 212 * MiB, WS_QO = 244 * MiB;
constexpr size_t WS_GT = 276 * MiB;
constexpr size_t WS_HT = 308 * MiB;
constexpr size_t WS_SC = 340 * MiB;
constexpr size_t WS_YRW = 384 * MiB;
constexpr size_t WS_WUP = 416 * MiB, WS_WDN = 480 * MiB;
constexpr size_t WS_MRG = 212 * MiB;
constexpr size_t WS_Y1 = 276 * MiB;
constexpr size_t WS_H2 = 52 * MiB;
constexpr size_t WS_HS = 116 * MiB;
constexpr size_t WS_HID = 260 * MiB;
constexpr size_t WS_X1 = 340 * MiB;
constexpr size_t WS_END = 512 * MiB;
static_assert(WS_TILE + (MAXT + 1) * 4 <= WS_WIN && WS_WIN + (size_t)NPAD * D * 2 <= WS_WOSB && WS_WL + 1536 * LK * 2 <= WS_QB, "fixed region");
static_assert(WS_HS + (size_t)MAXT * 256 * D * 2 <= WS_HID && WS_HID + (size_t)MAXT * 256 * DE * 2 <= WS_WUP, "moe region");
static_assert(WS_ALORA + (size_t)NTOK * LK * 2 <= WS_E && WS_B + (size_t)NTOK * BW * 2 <= WS_RWRAW, "rwkv region");

constexpr int LDS_BYTES = 163840;
constexpr int LDS_MISC = LDS_BYTES - 256;
constexpr int NWAVES = 8, NTHR = 512;

typedef unsigned short bf16;
typedef short bf16x8 __attribute__((ext_vector_type(8)));
typedef short s16x4 __attribute__((ext_vector_type(4)));
typedef float f32x4 __attribute__((ext_vector_type(4)));
typedef float f32x16 __attribute__((ext_vector_type(16)));
typedef unsigned u32x4 __attribute__((ext_vector_type(4)));
typedef unsigned u32x2 __attribute__((ext_vector_type(2)));
typedef int i32x4 __attribute__((ext_vector_type(4)));
#define DI __device__ __forceinline__
#define GAS __attribute__((address_space(1)))
#define MFMA32(a, b, c) __builtin_amdgcn_mfma_f32_32x32x16_bf16((a), (b), (c), 0, 0, 0)

typedef float f32x2_t __attribute__((ext_vector_type(2))); typedef __bf16 bf16x2_t __attribute__((ext_vector_type(2)));
DI unsigned pk2(float lo, float hi) { f32x2_t v = {lo, hi}; return __builtin_bit_cast(unsigned, __builtin_convertvector(v, bf16x2_t)); }
DI unsigned f2bf(float f) { return pk2(f, 0.0f) & 0xffffu; }
DI float bflo(unsigned u) { return __builtin_bit_cast(float, u << 16); }
DI float bfhi(unsigned u) { return __builtin_bit_cast(float, u & 0xffff0000u); }
DI float bf2f(bf16 h) { return __builtin_bit_cast(float, (unsigned)h << 16); }
DI float fexp(float x) { return __expf(x); }
DI float frcp(float x) { return __builtin_amdgcn_rcpf(x); }
DI float fsigmoid(float x) { return frcp(1.0f + fexp(-x)); }
DI float fsoftplus(float x) { return fmaxf(x, 0.0f) + __logf(1.0f + fexp(-fabsf(x))); }
#define DPP_SHR(v, ctrl) __builtin_bit_cast(float, __builtin_amdgcn_update_dpp(0, __builtin_bit_cast(int, (v)), (ctrl), 0xf, 0xf, true))
DI float wave_sum(float v) {
    v += DPP_SHR(v, 0x111); v += DPP_SHR(v, 0x112); v += DPP_SHR(v, 0x114); v += DPP_SHR(v, 0x118);
    v += __builtin_bit_cast(float, __builtin_amdgcn_update_dpp(0, __builtin_bit_cast(int, v), 0x142, 0xa, 0xf, false));
    v += __builtin_bit_cast(float, __builtin_amdgcn_update_dpp(0, __builtin_bit_cast(int, v), 0x143, 0xc, 0xf, false));
    return __builtin_bit_cast(float, __builtin_amdgcn_readlane(__builtin_bit_cast(int, v), 63));
}
DI float shfl_xor_l(float v, int m, int lane) { return __builtin_bit_cast(float, __builtin_amdgcn_ds_bpermute(4 * (lane ^ m), __builtin_bit_cast(int, v))); }
DI int crow(int reg, int hh) { return (reg & 3) + 8 * (reg >> 2) + 4 * hh; }
DI void wave_lds_fence() { __builtin_amdgcn_fence(__ATOMIC_RELEASE, "wavefront"); __builtin_amdgcn_wave_barrier(); __builtin_amdgcn_fence(__ATOMIC_ACQUIRE, "wavefront"); }
DI void unpack8(const u32x4 v, float (&o)[8]) { o[0] = bflo(v.x); o[1] = bfhi(v.x); o[2] = bflo(v.y); o[3] = bfhi(v.y); o[4] = bflo(v.z); o[5] = bfhi(v.z); o[6] = bflo(v.w); o[7] = bfhi(v.w); }
DI u32x4 pack8(const float (&o)[8]) { u32x4 v; v.x = pk2(o[0], o[1]); v.y = pk2(o[2], o[3]); v.z = pk2(o[4], o[5]); v.w = pk2(o[6], o[7]); return v; }
DI bf16x8 pack8v(float a0, float a1, float a2, float a3, float a4, float a5, float a6, float a7) {
    u32x4 v; v.x = pk2(a0, a1); v.y = pk2(a2, a3); v.z = pk2(a4, a5); v.w = pk2(a6, a7); return __builtin_bit_cast(bf16x8, v); }


#if defined(CHECKS)
constexpr int DBG_TOKEN = 77;
#endif

typedef pg8::f32x4 af4;
DI void st8(bf16* p, const af4 v0, const af4 v1) { u32x4 w; w.x = pk2(v0[0], v0[1]); w.y = pk2(v0[2], v0[3]); w.z = pk2(v1[0], v1[1]); w.w = pk2(v1[2], v1[3]); *(u32x4*)p = w; }

struct EpiIn {
    static constexpr bool PERM = true, AFTER_DRAIN = false;
    bf16 *Q, *K, *Vt, *RW, *LO, *GA; const float* gate_bias;
    DI void operator()(const af4 (&acc)[2][2][4][2], const pg8::Unit& u, int wr, int wc, int fr, int fq) const {
        const int pn = u.pn, row0 = u.pm * 256 + wr * 64 + fr;
        if (pn == 4 || pn == 5) {
#pragma unroll
            for (int ai = 0; ai < 2; ++ai)
#pragma unroll
                for (int m = 0; m < 4; ++m) { const int row = row0 + ai * 128 + m * 16, b = row >> 13, s = row & (SEQ - 1);
#pragma unroll
                    for (int bj = 0; bj < 2; ++bj)
#pragma unroll
                        for (int n = 0; n < 2; ++n)
#pragma unroll
                            for (int j = 0; j < 4; ++j) { const int cv = (pn - 4) * 256 + bj * 128 + wc * 32 + 8 * fq + 4 * n + j;
                                Vt[((size_t)(b * BW + cv)) * SEQ + s] = (bf16)f2bf(acc[ai][bj][m][n][j]); } }
        } else if (pn >= 14) {
            const int col0 = (pn - 14) * 256 + wc * 32 + 8 * fq;
            af4 bv[2][2];
#pragma unroll
            for (int bj = 0; bj < 2; ++bj)
#pragma unroll
                for (int n = 0; n < 2; ++n) bv[bj][n] = *(const af4*)(gate_bias + col0 + bj * 128 + 4 * n);
#pragma unroll
            for (int ai = 0; ai < 2; ++ai)
#pragma unroll
                for (int m = 0; m < 4; ++m) { bf16* rowp = GA + (size_t)(row0 + ai * 128 + m * 16) * 2048 + col0;
#pragma unroll
                    for (int bj = 0; bj < 2; ++bj) { af4 v0 = acc[ai][bj][m][0] + bv[bj][0], v1 = acc[ai][bj][m][1] + bv[bj][1];
#pragma unroll
                        for (int j = 0; j < 4; ++j) { v0[j] = fsigmoid(v0[j]); v1[j] = fsigmoid(v1[j]); }
                        st8(rowp + bj * 128, v0, v1); } }
        } else {
            bf16* base; int ld, ct; float sc = 1.0f;
            if (pn < 2) { base = Q; ld = BW; ct = pn; sc = 0.125f; } else if (pn < 4) { base = K; ld = BW; ct = pn - 2; } else if (pn < 12) { base = RW; ld = 1536; ct = pn - 6; } else { base = LO; ld = BW; ct = pn - 12; }
            const int col0 = ct * 256 + wc * 32 + 8 * fq;
#pragma unroll
            for (int ai = 0; ai < 2; ++ai)
#pragma unroll
                for (int m = 0; m < 4; ++m) { bf16* rowp = base + (size_t)(row0 + ai * 128 + m * 16) * ld + col0;
#pragma unroll
                    for (int bj = 0; bj < 2; ++bj) st8(rowp + bj * 128, acc[ai][bj][m][0] * sc, acc[ai][bj][m][1] * sc); }
        }
    }
};

template <bool ADD> struct EpiMerge {
    static constexpr bool PERM = true, AFTER_DRAIN = false;
    bf16* GA; bf16* MRG; int gofs;
    DI void operator()(const af4 (&acc)[2][2][4][2], const pg8::Unit& u, int wr, int wc, int fr, int fq) const {
        const int row0 = u.pm * 256 + wr * 64 + fr, col0 = u.pn * 256 + wc * 32 + 8 * fq;
#pragma unroll
        for (int ai = 0; ai < 2; ++ai)
#pragma unroll
            for (int m = 0; m < 4; ++m) { const size_t row = (size_t)(row0 + ai * 128 + m * 16);
#pragma unroll
                for (int bj = 0; bj < 2; ++bj) { const int c = col0 + bj * 128;
                    float g[8]; unpack8(*(const u32x4*)(GA + row * 2048 + gofs + c), g);
                    af4 v0, v1;
#pragma unroll
                    for (int j = 0; j < 4; ++j) { v0[j] = g[j] * acc[ai][bj][m][0][j]; v1[j] = g[4 + j] * acc[ai][bj][m][1][j]; }
                    if (ADD) { float o[8]; unpack8(*(const u32x4*)(GA + row * 2048 + c), o);
#pragma unroll
                        for (int j = 0; j < 4; ++j) { v0[j] += o[j]; v1[j] += o[4 + j]; }
                        st8(MRG + row * D + c, v0, v1); }
                    else st8(GA + row * 2048 + c, v0, v1); } }
    }
};

struct EpiPlain {
    static constexpr bool PERM = true, AFTER_DRAIN = false;
    bf16* O; int ld, cmask;
    DI void operator()(const af4 (&acc)[2][2][4][2], const pg8::Unit& u, int wr, int wc, int fr, int fq) const {
        const int row0 = u.pm * 256 + wr * 64 + fr, col0 = (u.pn & cmask) * 256 + wc * 32 + 8 * fq;
#pragma unroll
        for (int ai = 0; ai < 2; ++ai)
#pragma unroll
            for (int m = 0; m < 4; ++m) { bf16* rowp = O + (size_t)(row0 + ai * 128 + m * 16) * ld + col0;
#pragma unroll
                for (int bj = 0; bj < 2; ++bj) st8(rowp + bj * 128, acc[ai][bj][m][0], acc[ai][bj][m][1]); }
    }
};

struct EpiUp {
    static constexpr bool PERM = true, AFTER_DRAIN = false;
    bf16* HID;
    DI void operator()(const af4 (&acc)[2][2][4][2], const pg8::Unit& u, int wr, int wc, int fr, int fq) const {
        const int row0 = u.pm * 256 + wr * 64 + fr, col0 = (u.pn & 3) * 128 + wc * 16 + 4 * fq;
#pragma unroll
        for (int ai = 0; ai < 2; ++ai)
#pragma unroll
            for (int m = 0; m < 4; ++m) { bf16* rowp = HID + (size_t)(row0 + ai * 128 + m * 16) * DE + col0;
#pragma unroll
                for (int bj = 0; bj < 2; ++bj) { float h[4];
#pragma unroll
                    for (int j = 0; j < 4; ++j) { const float u1 = acc[ai][bj][m][0][j]; h[j] = u1 * fsigmoid(u1) * acc[ai][bj][m][1][j]; }
                    __hip_atomic_store((GAS unsigned long long*)(rowp + bj * 64), (unsigned long long)pk2(h[0], h[1]) | ((unsigned long long)pk2(h[2], h[3]) << 32), __ATOMIC_RELAXED, __HIP_MEMORY_SCOPE_AGENT); } }
    }
};

constexpr unsigned MOE_CNT_WORD = 3584, MOE_CNT_STRIDE = 16;
struct MoeUpOrder {
    int nunits, G, vc; const int* tile_e; unsigned* cnt;
    DI bool next(int i, pg8::Unit& u) const { const long L = (long)i * G + vc; if (L >= nunits) return false; const int rt = (int)(L >> 2);
        u.pm = rt; u.pn = __builtin_amdgcn_readfirstlane(tile_e[rt]) * 4 + (int)(L & 3); return true; }
    DI void a_ready(const pg8::Unit&) const {}
    DI void done(const pg8::Unit& u) const { asm volatile("s_waitcnt vmcnt(0)" ::: "memory");
        if (__builtin_amdgcn_mbcnt_hi(~0u, __builtin_amdgcn_mbcnt_lo(~0u, 0u)) == 0u) __hip_atomic_fetch_add(cnt + MOE_CNT_STRIDE * u.pm, 1u, __ATOMIC_RELAXED, __HIP_MEMORY_SCOPE_AGENT); }
};
struct MoeDnOrder {
    int nunits, G, vc, q, rem, wave; const int* tile_e; unsigned* cnt;
    DI bool next(int i, pg8::Unit& u) const { long L;
        if (vc >= rem) { if (i > q) return false; L = (long)i * (G - rem) + (vc - rem); } else L = (long)(q + 1) * (G - rem) + (long)i * rem + vc;
        if (L >= nunits) return false; const int rt = (int)(L >> 2);
        u.pm = rt; u.pn = __builtin_amdgcn_readfirstlane(tile_e[rt]) * 4 + (int)(L & 3); return true; }
    DI void a_ready(const pg8::Unit& u) const {
        if (wave == 0) { unsigned sp = 0;
            while ((unsigned)__builtin_amdgcn_readfirstlane(__hip_atomic_load(cnt + MOE_CNT_STRIDE * u.pm, __ATOMIC_RELAXED, __HIP_MEMORY_SCOPE_AGENT)) < 32u) { __builtin_amdgcn_s_sleep(2); if (++sp > (1u << 22)) break; }
            __builtin_amdgcn_fence(__ATOMIC_ACQUIRE, "agent");
            asm volatile("s_waitcnt vmcnt(0)" ::: "memory"); }
        asm volatile("" ::: "memory"); __builtin_amdgcn_s_barrier(); asm volatile("" ::: "memory"); }
    DI void done(const pg8::Unit&) const {}
};

struct Args {
    const float *x, *c, *w_mod, *b_mod, *gains, *w_in, *gate_bias, *shift_mu, *w0, *w_decay_up, *a0, *w_iclr_up, *w_gate_up, *k_k, *k_a, *r_k, *lnx_w, *lnx_b,
                *w_o_sb, *w_o_rw, *w_out, *w_group, *w_router, *w_up1, *w_up3, *w_down;
    float* out; unsigned char* ws;
};
struct Frame { LAS unsigned char* lds; int tid, lane, wave, wg, G, gw, NGW; };
#define CAS __attribute__((address_space(4)))
#if defined(TIMEPHASE)
#ifndef TIMEPHASE_END
#define TIMEPHASE_END (TIMEPHASE + 1)
#endif
DI void tp_stamp(LAS unsigned char* lds, int wave, int k) {
    if (k == TIMEPHASE || k == TIMEPHASE_END) { volatile LAS unsigned long long* tp_ = (volatile LAS unsigned long long*)(lds + LDS_MISC + 64);
        if (xb_t0(wave)) { const unsigned long long now_ = __builtin_amdgcn_s_memrealtime();
            if (k == TIMEPHASE) *tp_ = now_; else { const unsigned long long until_ = now_ + (now_ - *tp_); while (__builtin_amdgcn_s_memrealtime() < until_) __builtin_amdgcn_s_sleep(8); } }
        if (k == TIMEPHASE_END) __syncthreads(); } }
#define TPS(F, k) tp_stamp((F).lds, (F).wave, (k))
#else
#define TPS(F, k) do { } while (0)
#endif
typedef const CAS Args& ARef;

DI void tr_item(const float* W, int ldw, int K, bf16* WT, int k0, int drow0, int scol0, LAS float* scr, int lane) {
    if (scol0 >= 0) {
        float v[32];
        const float* wp = W + (size_t)(k0 + (lane >> 5)) * ldw + scol0 + (lane & 31);
#pragma unroll
        for (int i = 0; i < 32; ++i) v[i] = wp[(size_t)(2 * i) * ldw];
#pragma unroll
        for (int i = 0; i < 32; ++i) scr[(2 * i + (lane >> 5)) * 33 + (lane & 31)] = v[i];
    } else {
#pragma unroll 8
        for (int i = 0; i < 32; ++i) { const int kk = 2 * i + (lane >> 5); scr[kk * 33 + (lane & 31)] = 0.0f; }
    }
    wave_lds_fence();
    const int c = lane & 7;
#pragma unroll
    for (int j = 0; j < 4; ++j) { const int n = (lane >> 3) + 8 * j; const LAS float* s = scr + (8 * c) * 33 + n;
        u32x4 o; o.x = pk2(s[0 * 33], s[1 * 33]); o.y = pk2(s[2 * 33], s[3 * 33]); o.z = pk2(s[4 * 33], s[5 * 33]); o.w = pk2(s[6 * 33], s[7 * 33]);
        *(u32x4*)(WT + (size_t)(drow0 + n) * K + k0 + 8 * c) = o; }
    wave_lds_fence();
}
DI void tr_item_up(const float* W1, const float* W3, bf16* WT, int e, int k0, int drow0, LAS float* scr, int lane) {
    const int l31 = lane & 31, sc = (drow0 >> 3) * 4 + (l31 >> 3) * 4 + (l31 & 3);
    const float* W = ((l31 & 4) ? W3 : W1) + (size_t)e * D * DE;
    { float v[32]; const float* wp = W + (size_t)(k0 + (lane >> 5)) * DE + sc;
#pragma unroll
        for (int i = 0; i < 32; ++i) v[i] = wp[(size_t)(2 * i) * DE];
#pragma unroll
        for (int i = 0; i < 32; ++i) scr[(2 * i + (lane >> 5)) * 33 + l31] = v[i]; }
    wave_lds_fence();
    const int c = lane & 7;
#pragma unroll
    for (int j = 0; j < 4; ++j) { const int n = (lane >> 3) + 8 * j; const LAS float* s = scr + (8 * c) * 33 + n;
        u32x4 o; o.x = pk2(s[0 * 33], s[1 * 33]); o.y = pk2(s[2 * 33], s[3 * 33]); o.z = pk2(s[4 * 33], s[5 * 33]); o.w = pk2(s[6 * 33], s[7 * 33]);
        *(u32x4*)(WT + ((size_t)e * 1024 + drow0 + n) * D + k0 + 8 * c) = o; }
    wave_lds_fence();
}

DI void p0_prologue(const Frame& F0, ARef A) {
    Frame F = F0; F.tid = opq_tid(F0.wave); F.lane = F.tid & 63; F.wave = __builtin_amdgcn_readfirstlane(F.tid >> 6); F.gw = F.wg * NWAVES + F.wave;
    unsigned char* ws = A.ws;
    TPS(F, 60);
    LAS float* sl = (LAS float*)F.lds;
    LAS float* part = (LAS float*)(F.lds + 16384);
    for (int i = F.tid; i < NB * D; i += NTHR) { const float v = A.c[i]; sl[i] = v * fsigmoid(v); }
    __syncthreads();
    float* mod = (float*)(ws + WS_MOD);
    for (int cg = F.wg; cg < 256; cg += F.G) {
        const int col = F.tid & 31, kg = F.tid >> 5;
        if (col < 24) { float a0 = 0.f, a1 = 0.f, a2 = 0.f, a3 = 0.f;
            float wv[64];
#pragma unroll
            for (int kk = 0; kk < 64; ++kk) wv[kk] = A.w_mod[(size_t)(kg * 64 + kk) * 6144 + cg * 24 + col];
#pragma unroll
            for (int kk = 0; kk < 64; ++kk) { const int k = kg * 64 + kk; const float w = wv[kk];
                a0 += sl[k] * w; a1 += sl[D + k] * w; a2 += sl[2 * D + k] * w; a3 += sl[3 * D + k] * w; }
            LAS float* p = part + (kg * 24 + col) * 4; p[0] = a0; p[1] = a1; p[2] = a2; p[3] = a3; }
        __syncthreads();
        if (F.tid < 96) { const int c = F.tid >> 2, b = F.tid & 3; float s = 0.f;
#pragma unroll
            for (int kg2 = 0; kg2 < 16; ++kg2) s += part[(kg2 * 24 + c) * 4 + b];
            mod[b * 6144 + cg * 24 + c] = s + A.b_mod[cg * 24 + c]; }
        __syncthreads();
    }
    TPS(F, 61);
    LAS float* scr = (LAS float*)(F.lds + 32768 + F.wave * 8704);
    constexpr int I_IN = (NPAD / 32) * (D / 64), I_OS = (D / 32) * (BW / 64), I_OUT = (D / 32) * (D / 64);
    for (int it = F.gw; it < I_IN + 2 * I_OS + I_OUT; it += F.NGW) {
        int r = it;
        if (r < I_IN) { const int g = r / (D / 64), kb = r % (D / 64), drow0 = 32 * g;
            const int sc = drow0 < 3360 ? drow0 : (drow0 < 3584 ? -1 : drow0 - 224);
            tr_item(A.w_in, IN_COLS, D, (bf16*)(ws + WS_WIN), 64 * kb, drow0, sc, scr, F.lane); continue; }
        r -= I_IN;
        if (r < I_OS) { const int g = r / (BW / 64), kb = r % (BW / 64); tr_item(A.w_o_sb, D, BW, (bf16*)(ws + WS_WOSB), 64 * kb, 32 * g, 32 * g, scr, F.lane); continue; }
        r -= I_OS;
        if (r < I_OS) { const int g = r / (BW / 64), kb = r % (BW / 64); tr_item(A.w_o_rw, D, BW, (bf16*)(ws + WS_WORW), 64 * kb, 32 * g, 32 * g, scr, F.lane); continue; }
        r -= I_OS;
        { const int g = r / (D / 64), kb = r % (D / 64); tr_item(A.w_out, D, D, (bf16*)(ws + WS_WOUT), 64 * kb, 32 * g, 32 * g, scr, F.lane); }
    }
    TPS(F, 62);
    const int gt = F.wg * NTHR + F.tid, NGT = F.G * NTHR;
    float* rtw = (float*)(ws + WS_RTW);
    for (int i = gt; i < 36 * D; i += NGT) { const int o = 2 * (i >> 11) + (i & 1), k = (i >> 1) & (D - 1); rtw[i] = o < 4 ? A.w_group[k * 4 + o] : A.w_router[k * NE + (o - 4)]; }
    TPS(F, 64);
    bf16* wl = (bf16*)(ws + WS_WL);
    for (int i0 = gt; i0 < 1536 * LK; i0 += 8 * NGT) { float v[8];
#pragma unroll
        for (int j = 0; j < 8; ++j) { const int i = i0 + j * NGT, n = i / LK, k = i % LK; v[j] = 0.f;
            if (i < 1536 * LK) {
                if (n < 512) { if (k < 64) v[j] = A.w_decay_up[k * BW + n]; }
                else if (n < 1024) { if (k >= 64 && k < 128) v[j] = A.w_iclr_up[(k - 64) * BW + (n - 512)]; }
                else { if (k >= 128 && k < 288) v[j] = A.w_gate_up[(k - 128) * BW + (n - 1024)]; } } }
#pragma unroll
        for (int j = 0; j < 8; ++j) { const int i = i0 + j * NGT; if (i < 1536 * LK) wl[i] = (bf16)f2bf(v[j]); } }
    TPS(F, 63);
}

DI void p1_h1(const Frame& F0, ARef A, bf16* H1) {
    Frame F = F0; F.tid = opq_tid(F0.wave); F.lane = F.tid & 63; F.wave = __builtin_amdgcn_readfirstlane(F.tid >> 6); F.gw = F.wg * NWAVES + F.wave;
    const float* mod = (const float*)(A.ws + WS_MOD);
    for (int n = F.gw; n < NTOK; n += F.NGW) {
        const int b = n >> 13;
        const f32x4* xr = (const f32x4*)(A.x + (size_t)n * D) + F.lane;
        f32x4 v[4]; float s = 0.f;
#pragma unroll
        for (int j = 0; j < 4; ++j) { v[j] = xr[64 * j]; s += (v[j][0] * v[j][0] + v[j][1] * v[j][1]) + (v[j][2] * v[j][2] + v[j][3] * v[j][3]); }
        const float inv = rsqrtf(wave_sum(s) * (1.0f / D) + NORM_EPS);
        u32x2* o = (u32x2*)(H1 + (size_t)n * D) + F.lane;
#pragma unroll
        for (int j = 0; j < 4; ++j) { const int k = 4 * F.lane + 256 * j;
            const f32x4 g = *(const f32x4*)(A.gains + k), sh = *(const f32x4*)(mod + b * 6144 + k), sc = *(const f32x4*)(mod + b * 6144 + D + k);
            f32x4 h;
#pragma unroll
            for (int q = 0; q < 4; ++q) h[q] = (v[j][q] * inv) * g[q] * (1.0f + sc[q]) + sh[q];
            u32x2 w; w.x = pk2(h[0], h[1]); w.y = pk2(h[2], h[3]); o[64 * j] = w; }
    }
}

DI void p3_attn(const Frame& F0, const bf16* QB, const bf16* KB, const bf16* VT, bf16* YSB) {
    Frame F = F0; F.tid = opq_tid(F0.wave); F.lane = F.tid & 63; F.wave = __builtin_amdgcn_readfirstlane(F.tid >> 6); F.gw = F.wg * NWAVES + F.wave;
    const int lane = F.lane, r = lane & 31, hh = lane >> 5;
    bf16x8 tri[2];
#pragma unroll
    for (int s = 0; s < 2; ++s)
#pragma unroll
        for (int e = 0; e < 8; ++e) tri[s][e] = (16 * s + 8 * (e >> 2) + 4 * hh + (e & 3)) > r ? (short)0x3F80 : (short)0;
    for (int u = F.gw; u < NB * NH * (SEQ / 32); u += F.NGW) {
        int qt, b, h;
        if (F.G == 256) { b = u >> 11; h = ((F.wg & 7) + 2 * b) & 7; qt = (F.wg >> 3) * 8 + F.wave; }
        else { qt = u & 255; b = u >> 11; h = ((u >> 8) + 2 * b) & 7; }
        const int bh = b * 8 + h;
        const bf16* qp = QB + (size_t)(b * SEQ + qt * 32 + r) * BW + h * HD + 8 * hh;
        bf16x8 qf[4];
#pragma unroll
        for (int ks = 0; ks < 4; ++ks) qf[ks] = *(const bf16x8*)(qp + 16 * ks);
        f32x16 o0, o1;
#pragma unroll
        for (int i = 0; i < 16; ++i) { o0[i] = 0.f; o1[i] = 0.f; }
        float L = 0.f;
        bf16x8 kf[4]; s16x4 vlo[2][2], vhi[2][2];
#define ATT_LOAD(KT, KF, VLO, VHI) do { const bf16* kp_ = KB + (size_t)(b * SEQ + (KT) * 32 + r) * BW + h * HD + 8 * hh; \
            _Pragma("unroll") for (int ks = 0; ks < 4; ++ks) KF[ks] = *(const bf16x8*)(kp_ + 16 * ks); \
            const bf16* vp_ = VT + ((size_t)(bh * HD + r)) * SEQ + (KT) * 32 + 4 * hh; \
            _Pragma("unroll") for (int mb = 0; mb < 2; ++mb) _Pragma("unroll") for (int ks = 0; ks < 2; ++ks) { VLO[mb][ks] = *(const s16x4*)(vp_ + (size_t)mb * 32 * SEQ + 16 * ks); VHI[mb][ks] = *(const s16x4*)(vp_ + (size_t)mb * 32 * SEQ + 16 * ks + 8); } } while (0)
        ATT_LOAD(qt, kf, vlo, vhi);
        for (int kt = qt; kt >= 0; --kt) {
            bf16x8 kfn[4]; s16x4 vlon[2][2], vhin[2][2];
            { const int ktn = kt > 0 ? kt - 1 : 0; ATT_LOAD(ktn, kfn, vlon, vhin); }
            f32x16 z;
#pragma unroll
            for (int i = 0; i < 16; ++i) z[i] = 0.f;
#pragma unroll
            for (int ks = 0; ks < 4; ++ks) z = MFMA32(kf[ks], qf[ks], z);
            const bool diag = (kt == qt);
            float lk[16], lo[16], tot = 0.f;
#pragma unroll
            for (int i = 0; i < 16; ++i) { const bool valid = !diag || (crow(i, hh) < r);
                const float sp = fsoftplus(z[i]); lk[i] = valid ? -sp : 0.0f; z[i] = valid ? z[i] - sp : -1.0e30f;
                tot += lk[i];
                const float hi = bflo(f2bf(lk[i])); lo[i] = lk[i] - hi; lk[i] = hi; }
            tot += shfl_xor_l(tot, 32, lane);
            f32x16 lat;
#pragma unroll
            for (int i = 0; i < 16; ++i) lat[i] = L;
#pragma unroll
            for (int s = 0; s < 2; ++s) {
                lat = MFMA32(tri[s], pack8v(lk[8 * s], lk[8 * s + 1], lk[8 * s + 2], lk[8 * s + 3], lk[8 * s + 4], lk[8 * s + 5], lk[8 * s + 6], lk[8 * s + 7]), lat);
                lat = MFMA32(tri[s], pack8v(lo[8 * s], lo[8 * s + 1], lo[8 * s + 2], lo[8 * s + 3], lo[8 * s + 4], lo[8 * s + 5], lo[8 * s + 6], lo[8 * s + 7]), lat); }
            float at[16];
#pragma unroll
            for (int i = 0; i < 16; ++i) at[i] = fexp(z[i] + lat[i]);
#pragma unroll
            for (int s = 0; s < 2; ++s) { const bf16x8 ab = pack8v(at[8 * s], at[8 * s + 1], at[8 * s + 2], at[8 * s + 3], at[8 * s + 4], at[8 * s + 5], at[8 * s + 6], at[8 * s + 7]);
                bf16x8 va, vb;
#pragma unroll
                for (int e = 0; e < 4; ++e) { va[e] = vlo[0][s][e]; va[4 + e] = vhi[0][s][e]; vb[e] = vlo[1][s][e]; vb[4 + e] = vhi[1][s][e]; }
                o0 = MFMA32(va, ab, o0); o1 = MFMA32(vb, ab, o1); }
            L += tot;
            if (__all(L < SB_STOP)) break;
#pragma unroll
            for (int ks = 0; ks < 4; ++ks) kf[ks] = kfn[ks];
#pragma unroll
            for (int mb = 0; mb < 2; ++mb)
#pragma unroll
                for (int ks = 0; ks < 2; ++ks) { vlo[mb][ks] = vlon[mb][ks]; vhi[mb][ks] = vhin[mb][ks]; }
        }
#undef ATT_LOAD
        bf16* op = YSB + (size_t)(b * SEQ + qt * 32 + r) * BW + h * HD + 4 * hh;
#pragma unroll
        for (int g = 0; g < 4; ++g) { u32x2 w0, w1; w0.x = pk2(o0[4 * g], o0[4 * g + 1]); w0.y = pk2(o0[4 * g + 2], o0[4 * g + 3]); w1.x = pk2(o1[4 * g], o1[4 * g + 1]); w1.y = pk2(o1[4 * g + 2], o1[4 * g + 3]);
            *(u32x2*)(op + 8 * g) = w0; *(u32x2*)(op + 32 + 8 * g) = w1; }
    }
}

DI void p3_prep(const Frame& F0, ARef A, const bf16* RWRAW, const bf16* LORA, bf16* R, bf16* KS, bf16* V, bf16* KK, bf16* ALORA) {
    Frame F = F0; F.tid = opq_tid(F0.wave); F.lane = F.tid & 63; F.wave = __builtin_amdgcn_readfirstlane(F.tid >> 6); F.gw = F.wg * NWAVES + F.wave;
    const int lane = F.lane;
    f32x4 mu[3][2], kkc[2], mul[2];
#pragma unroll
    for (int part = 0; part < 3; ++part) { mu[part][0] = *(const f32x4*)(A.shift_mu + part * 512 + lane * 8); mu[part][1] = *(const f32x4*)(A.shift_mu + part * 512 + lane * 8 + 4); }
    kkc[0] = *(const f32x4*)(A.k_k + lane * 8); kkc[1] = *(const f32x4*)(A.k_k + lane * 8 + 4);
    const int lcol = lane < 36 ? lane * 8 : 0;
    mul[0] = *(const f32x4*)(A.shift_mu + 1536 + lcol); mul[1] = *(const f32x4*)(A.shift_mu + 1536 + lcol + 4);
    constexpr int RUN = 16;
    for (int run = F.gw; run < NTOK / RUN; run += F.NGW) {
        const int n0 = run * RUN;
        u32x4 prv[3], prl, cur[3], cul;
        const u32x4 z4 = {0u, 0u, 0u, 0u};
        if ((n0 & (SEQ - 1)) == 0) { prv[0] = z4; prv[1] = z4; prv[2] = z4; prl = z4; }
        else {
#pragma unroll
            for (int part = 0; part < 3; ++part) prv[part] = *(const u32x4*)(RWRAW + (size_t)(n0 - 1) * 1536 + part * 512 + lane * 8);
            prl = *(const u32x4*)(LORA + (size_t)(n0 - 1) * BW + lcol); }
#pragma unroll
        for (int part = 0; part < 3; ++part) cur[part] = *(const u32x4*)(RWRAW + (size_t)n0 * 1536 + part * 512 + lane * 8);
        cul = *(const u32x4*)(LORA + (size_t)n0 * BW + lcol);
        for (int i = 0; i < RUN; ++i) {
            const int n = n0 + i, nn = i + 1 < RUN ? n + 1 : n;
            u32x4 nxt[3], nxl;
#pragma unroll
            for (int part = 0; part < 3; ++part) nxt[part] = *(const u32x4*)(RWRAW + (size_t)nn * 1536 + part * 512 + lane * 8);
            nxl = *(const u32x4*)(LORA + (size_t)nn * BW + lcol);
            float xs[3][8];
#pragma unroll
            for (int part = 0; part < 3; ++part) { float p[8], q[8]; unpack8(cur[part], p); unpack8(prv[part], q);
#pragma unroll
                for (int j = 0; j < 4; ++j) { xs[part][j] = p[j] + mu[part][0][j] * (q[j] - p[j]); xs[part][4 + j] = p[4 + j] + mu[part][1][j] * (q[4 + j] - p[4 + j]); } }
            const size_t off = (size_t)n * BW + lane * 8;
            *(u32x4*)(R + off) = pack8(xs[0]); *(u32x4*)(KS + off) = pack8(xs[1]); *(u32x4*)(V + off) = pack8(xs[2]);
            float kk[8], ss = 0.f;
#pragma unroll
            for (int j = 0; j < 4; ++j) { kk[j] = xs[1][j] * kkc[0][j]; kk[4 + j] = xs[1][4 + j] * kkc[1][j]; }
#pragma unroll
            for (int j = 0; j < 8; ++j) ss += kk[j] * kk[j];
            ss += shfl_xor_l(ss, 1, lane); ss += shfl_xor_l(ss, 2, lane); ss += shfl_xor_l(ss, 4, lane);
            const float rn = 1.0f / fmaxf(sqrtf(ss), L2_EPS);
#pragma unroll
            for (int j = 0; j < 8; ++j) kk[j] *= rn;
            *(u32x4*)(KK + off) = pack8(kk);
            if (lane < 48) { float a[8];
                if (lane < 36) { float p[8], q[8]; unpack8(cul, p); unpack8(prl, q);
#pragma unroll
                    for (int j = 0; j < 8; ++j) { const float m = j < 4 ? mul[0][j & 3] : mul[1][j & 3]; const float v = p[j] + m * (q[j] - p[j]);
                        a[j] = lane < 8 ? (1.0f - 2.0f * frcp(fexp(2.0f * v) + 1.0f)) : (lane < 16 ? v : fsigmoid(v)); }
                } else {
#pragma unroll
                    for (int j = 0; j < 8; ++j) a[j] = 0.f; }
                *(u32x4*)(ALORA + (size_t)n * LK + lane * 8) = pack8(a); }
#pragma unroll
            for (int part = 0; part < 3; ++part) { prv[part] = cur[part]; cur[part] = nxt[part]; }
            prl = cul; cul = nxl;
        }
    }
}

DI void p4_lora(const Frame& F0, ARef A, const bf16* ALORA, const bf16* WL, bf16* E, bf16* KS, bf16* Bo, bf16* GG, const bf16* KK, const bf16* R, float* BON) {
    Frame F = F0; F.tid = opq_tid(F0.wave); F.lane = F.tid & 63; F.wave = __builtin_amdgcn_readfirstlane(F.tid >> 6); F.gw = F.wg * NWAVES + F.wave;
    const int lane = F.lane, r = lane & 31, hh = lane >> 5;
    for (int u = F.gw; u < 2 * (NTOK / 32); u += F.NGW) {
        const int n0 = (u >> 1) * 32, par = u & 1;
        bf16x8 tf[18];
#pragma unroll
        for (int ks = 0; ks < 18; ++ks) tf[ks] = *(const bf16x8*)(ALORA + (size_t)(n0 + r) * LK + 16 * ks + 8 * hh);
        TPS(F, 40);
        const unsigned orow = (unsigned)(n0 + r) * BW + 4 * hh;
#define LORA_W(dst, KS0, NKS, CB) do { _Pragma("unroll") for (int ks = 0; ks < (NKS); ++ks) dst[ks] = *(const bf16x8*)(WL + (size_t)(32 * (CB) + r) * LK + 16 * ((KS0) + ks) + 8 * hh); } while (0)
#define LORA_MM(W, KS0, NKS) f32x16 acc_; do { _Pragma("unroll") for (int q = 0; q < 16; ++q) acc_[q] = 0.f; \
            _Pragma("unroll") for (int ks = 0; ks < (NKS); ++ks) acc_ = MFMA32(W[ks], tf[(KS0) + ks], acc_); } while (0)
#define LORA_CB(base, i) ((base) + 4 * ((i) >> 1) + 2 * par + ((i) & 1))
        {   bf16x8 wc[4], wn[4]; LORA_W(wc, 0, 4, LORA_CB(0, 0));
#pragma nounroll
            for (int i = 0; i < 8; ++i) { const int cb = LORA_CB(0, i), c0_ = 32 * (cb & 15); { const int in_ = i < 7 ? i + 1 : 7; LORA_W(wn, 0, 4, LORA_CB(0, in_)); }
                f32x4 w0v[4];
#pragma unroll
                for (int g = 0; g < 4; ++g) w0v[g] = *(const f32x4*)(A.w0 + c0_ + 8 * g + 4 * hh);
                LORA_MM(wc, 0, 4);
#pragma unroll
                for (int g = 0; g < 4; ++g) { float e4[4];
#pragma unroll
                    for (int j = 0; j < 4; ++j) { const float v = acc_[4 * g + j] + w0v[g][j]; e4[j] = fexp(-fsoftplus(-v) - 0.5f); }
                    u32x2 w; w.x = pk2(e4[0], e4[1]); w.y = pk2(e4[2], e4[3]); *(u32x2*)(E + orow + c0_ + 8 * g) = w; }
#pragma unroll
                for (int ks = 0; ks < 4; ++ks) wc[ks] = wn[ks]; } }
        TPS(F, 41);
        {   float bsum = 0.f; bf16x8 wc[4], wn[4]; LORA_W(wc, 4, 4, LORA_CB(16, 0));
#pragma nounroll
            for (int i = 0; i < 8; ++i) { const int cb = LORA_CB(16, i), c0_ = 32 * (cb & 15); { const int in_ = i < 7 ? i + 1 : 7; LORA_W(wn, 4, 4, LORA_CB(16, in_)); }
                f32x4 a0v[4], kav[4], rkv[4]; u32x2 kw[4], qw[4], rw[4];
#pragma unroll
                for (int g = 0; g < 4; ++g) { const unsigned o = orow + c0_ + 8 * g; kw[g] = *(const u32x2*)(KS + o); qw[g] = *(const u32x2*)(KK + o); rw[g] = *(const u32x2*)(R + o);
                    a0v[g] = *(const f32x4*)(A.a0 + c0_ + 8 * g + 4 * hh); kav[g] = *(const f32x4*)(A.k_a + c0_ + 8 * g + 4 * hh); rkv[g] = *(const f32x4*)(A.r_k + c0_ + 8 * g + 4 * hh); }
                LORA_MM(wc, 4, 4);
#pragma unroll
                for (int g = 0; g < 4; ++g) { const unsigned o = orow + c0_ + 8 * g;
                    float ksv[4], kkv[4], kp[4], bb[4]; ksv[0] = bflo(kw[g].x); ksv[1] = bfhi(kw[g].x); ksv[2] = bflo(kw[g].y); ksv[3] = bfhi(kw[g].y); kkv[0] = bflo(qw[g].x); kkv[1] = bfhi(qw[g].x); kkv[2] = bflo(qw[g].y); kkv[3] = bfhi(qw[g].y);
#pragma unroll
                    for (int j = 0; j < 4; ++j) { const float s0 = fsigmoid(acc_[4 * g + j] + a0v[g][j]); kp[j] = ksv[j] * (1.0f + (s0 - 1.0f) * kav[g][j]); bb[j] = kkv[j] * s0; }
                    bsum += (bflo(rw[g].x) * kp[0] * rkv[g][0] + bfhi(rw[g].x) * kp[1] * rkv[g][1]) + (bflo(rw[g].y) * kp[2] * rkv[g][2] + bfhi(rw[g].y) * kp[3] * rkv[g][3]);
                    u32x2 w1, w2; w1.x = pk2(kp[0], kp[1]); w1.y = pk2(kp[2], kp[3]); w2.x = pk2(bb[0], bb[1]); w2.y = pk2(bb[2], bb[3]); *(u32x2*)(KS + o) = w1; *(u32x2*)(Bo + o) = w2; }
                if (i & 1) { const float tot = bsum + shfl_xor_l(bsum, 32, lane); if (hh == 0) BON[(size_t)(n0 + r) * 8 + 2 * (i >> 1) + par] = tot; bsum = 0.f; }
#pragma unroll
                for (int ks = 0; ks < 4; ++ks) wc[ks] = wn[ks]; } }
        TPS(F, 42);
        {   bf16x8 wc[10], wn[10]; LORA_W(wc, 8, 10, LORA_CB(32, 0));
#pragma nounroll
            for (int i = 0; i < 8; ++i) { const int cb = LORA_CB(32, i), c0_ = 32 * (cb & 15); { const int in_ = i < 7 ? i + 1 : 7; LORA_W(wn, 8, 10, LORA_CB(32, in_)); }
                LORA_MM(wc, 8, 10);
#pragma unroll
                for (int g = 0; g < 4; ++g) { u32x2 w; w.x = pk2(acc_[4 * g], acc_[4 * g + 1]); w.y = pk2(acc_[4 * g + 2], acc_[4 * g + 3]); *(u32x2*)(GG + orow + c0_ + 8 * g) = w; }
#pragma unroll
                for (int ks = 0; ks < 10; ++ks) wc[ks] = wn[ks]; } }
        TPS(F, 43);
#undef LORA_W
#undef LORA_MM
#undef LORA_CB
    }
}

DI void p6_chain(int task, int wave, LAS unsigned char* ring, const bf16* GT, const bf16* HT, bf16* SC) {
    const int lane = opq_tid(wave) & 63;
    const int bh = task >> 1, nb = task & 1;
    constexpr int RD = 6, SLOT = 12288;
    f32x16 X[2];
#pragma unroll
    for (int q = 0; q < 16; ++q) { X[0][q] = 0.f; X[1][q] = 0.f; }
    const char* gsrc = (const char*)(GT + (size_t)bh * NCH * 4096) + lane * 16;
    const char* hsrc = (const char*)(HT + (size_t)bh * NCH * 4096) + nb * 2048 + lane * 16;
#define CHAIN_DMA(cc) do { LAS unsigned char* sl_ = ring + ((cc) % RD) * SLOT; const char* g_ = gsrc + (size_t)(cc) * 8192; const char* h_ = hsrc + (size_t)(cc) * 8192; \
        _Pragma("unroll") for (int f = 0; f < 8; ++f) __builtin_amdgcn_global_load_lds((const unsigned*)(g_ + f * 1024), (LAS unsigned*)(sl_ + f * 1024), 16, 0, 0); \
        _Pragma("unroll") for (int kb = 0; kb < 2; ++kb) _Pragma("unroll") for (int j = 0; j < 2; ++j) \
            __builtin_amdgcn_global_load_lds((const unsigned*)(h_ + kb * 4096 + j * 1024), (LAS unsigned*)(sl_ + 8192 + (kb * 2 + j) * 1024), 16, 0, 0); } while (0)
#define CHAIN_READ(cc, HS, GS) do { const LAS unsigned char* sl_ = ring + ((cc) % RD) * SLOT; \
        _Pragma("unroll") for (int f = 0; f < 8; ++f) GS[f] = *(const LAS bf16x8*)(sl_ + f * 1024 + lane * 16); \
        _Pragma("unroll") for (int kb = 0; kb < 2; ++kb) _Pragma("unroll") for (int g = 0; g < 4; ++g) { const u32x2 w_ = *(const LAS u32x2*)(sl_ + 8192 + kb * 2048 + (g * 64 + lane) * 8); \
            HS[kb][4 * g] = bflo(w_.x); HS[kb][4 * g + 1] = bfhi(w_.x); HS[kb][4 * g + 2] = bflo(w_.y); HS[kb][4 * g + 3] = bfhi(w_.y); } } while (0)
#define CHAIN_STORE(cc) do { bf16* sc_ = SC + ((size_t)bh * NCH + (cc)) * 4096; \
        _Pragma("unroll") for (int jb = 0; jb < 2; ++jb) _Pragma("unroll") for (int g = 0; g < 4; ++g) { u32x2 w_; w_.x = pk2(X[jb][4 * g], X[jb][4 * g + 1]); w_.y = pk2(X[jb][4 * g + 2], X[jb][4 * g + 3]); \
            *(u32x2*)(sc_ + ((((jb * 2 + nb) * 4 + g) * 64) + lane) * 4) = w_; } } while (0)
#define CHAIN_STEP(HS, GS) do { bf16x8 xb_[2][2]; \
        _Pragma("unroll") for (int jb = 0; jb < 2; ++jb) _Pragma("unroll") for (int s = 0; s < 2; ++s) \
            xb_[jb][s] = pack8v(X[jb][8 * s], X[jb][8 * s + 1], X[jb][8 * s + 2], X[jb][8 * s + 3], X[jb][8 * s + 4], X[jb][8 * s + 5], X[jb][8 * s + 6], X[jb][8 * s + 7]); \
        X[0] = HS[0]; X[1] = HS[1]; \
        _Pragma("unroll") for (int kb = 0; kb < 2; ++kb) _Pragma("unroll") for (int jb = 0; jb < 2; ++jb) _Pragma("unroll") for (int s = 0; s < 2; ++s) X[kb] = MFMA32(GS[kb * 4 + jb * 2 + s], xb_[jb][s], X[kb]); } while (0)
    for (int cc = 0; cc < RD; ++cc) CHAIN_DMA(cc);
    for (int c = 0; c < NCH - 1; ++c) {
        f32x16 Hc[2]; bf16x8 Gc[8];
        if (c + RD <= NCH - 1) asm volatile("s_waitcnt vmcnt(60)" ::: "memory"); else asm volatile("s_waitcnt vmcnt(0)" ::: "memory");
        CHAIN_READ(c, Hc, Gc);
        asm volatile("s_waitcnt lgkmcnt(0)" ::: "memory");
        if (c + RD < NCH - 1) CHAIN_DMA(c + RD);
        CHAIN_STORE(c);
        CHAIN_STEP(Hc, Gc);
    }
    CHAIN_STORE(NCH - 1);
    asm volatile("s_waitcnt vmcnt(0)" ::: "memory");
#undef CHAIN_DMA
#undef CHAIN_READ
#undef CHAIN_STORE
#undef CHAIN_STEP
}

DI void p6_moe_weights(const Frame& F0, ARef A, int wi, int NW) {
    Frame F = F0; F.tid = opq_tid(F0.wave); F.lane = F.tid & 63; F.wave = __builtin_amdgcn_readfirstlane(F.tid >> 6); F.gw = F.wg * NWAVES + F.wave;
    LAS float* scr = (LAS float*)(F.lds + F.wave * 20480);
    constexpr int I_UP = NE * 32 * 16, I_DN = NE * 32 * 8;
    for (int it = wi; it < I_UP + I_DN; it += NW) {
        if (it < I_UP) { const int e = it >> 9, g = (it >> 4) & 31, kb = it & 15; tr_item_up(A.w_up1, A.w_up3, (bf16*)(A.ws + WS_WUP), e, 64 * kb, 32 * g, scr, F.lane); }
        else { const int r = it - I_UP, e = r >> 8, g = (r >> 3) & 31, kb = r & 7;
            tr_item(A.w_down + (size_t)e * DE * D, D, DE, (bf16*)(A.ws + WS_WDN) + (size_t)e * 1024 * DE, 64 * kb, 32 * g, 32 * g, scr, F.lane); }
    }
}

DI float half_bcast_sum(float v, int hh) {
    v += DPP_SHR(v, 0x111); v += DPP_SHR(v, 0x112); v += DPP_SHR(v, 0x114); v += DPP_SHR(v, 0x118);
    v += __builtin_bit_cast(float, __builtin_amdgcn_update_dpp(0, __builtin_bit_cast(int, v), 0x142, 0xa, 0xf, false));
    const float lo = __builtin_bit_cast(float, __builtin_amdgcn_readlane(__builtin_bit_cast(int, v), 31)), hi = __builtin_bit_cast(float, __builtin_amdgcn_readlane(__builtin_bit_cast(int, v), 63));
    return hh ? hi : lo; }
DI void p7_mfma(const Frame& F0, ARef A, const bf16* SC, const bf16* Pn, const bf16* QOn, const bf16* V, const bf16* GG, const float* BON, bf16* YRW) {
    Frame F = F0; F.tid = opq_tid(F0.wave); F.lane = F.tid & 63; F.wave = __builtin_amdgcn_readfirstlane(F.tid >> 6); F.gw = F.wg * NWAVES + F.wave;
    const int lane = F.lane, r = lane & 31, hh = lane >> 5;
    for (int cid = F.gw; cid < NCHUNK; cid += F.NGW) {
        const int bh = cid >> NCH_LOG, c = cid & (NCH - 1), b = bh >> 3, h = bh & 7;
        const unsigned n0 = (unsigned)b * SEQ + (unsigned)c * CH; const int col0 = h * HD;
        const bf16* sc = SC + (size_t)cid * 4096; const bf16* pn = Pn + (size_t)cid * 4096; const bf16* qn = QOn + (size_t)cid * 4096;
        bf16x8 Sf[2][2][2], Pf[2][2][2];
#pragma unroll
        for (int jb = 0; jb < 2; ++jb)
#pragma unroll
            for (int xb = 0; xb < 2; ++xb)
#pragma unroll
                for (int s = 0; s < 2; ++s) { const s16x4 lo = *(const s16x4*)(sc + ((((jb * 2 + xb) * 4 + 2 * s) * 64) + lane) * 4), hi = *(const s16x4*)(sc + ((((jb * 2 + xb) * 4 + 2 * s + 1) * 64) + lane) * 4);
#pragma unroll
                    for (int e = 0; e < 4; ++e) { Sf[jb][xb][s][e] = lo[e]; Sf[jb][xb][s][4 + e] = hi[e]; }
                    Pf[jb][xb][s] = *(const bf16x8*)(pn + ((((jb * 2 + xb) * 2 + s) * 64) + lane) * 8); }
        f32x16 Z[2][2];
#pragma unroll
        for (int tb = 0; tb < 2; ++tb)
#pragma unroll
            for (int nb = 0; nb < 2; ++nb) {
#pragma unroll
                for (int g = 0; g < 4; ++g) { const u32x2 w = *(const u32x2*)(qn + ((((tb * 2 + nb) * 4 + g) * 64) + lane) * 4);
                    Z[tb][nb][4 * g] = bflo(w.x); Z[tb][nb][4 * g + 1] = bfhi(w.x); Z[tb][nb][4 * g + 2] = bflo(w.y); Z[tb][nb][4 * g + 3] = bfhi(w.y); }
#pragma unroll
                for (int jb = 0; jb < 2; ++jb)
#pragma unroll
                    for (int s = 0; s < 2; ++s) Z[tb][nb] = MFMA32(Pf[jb][tb][s], Sf[jb][nb][s], Z[tb][nb]); }
        typedef float f2_t __attribute__((ext_vector_type(2)));
        const f2_t lw = *(const f2_t*)(A.lnx_w + col0 + 2 * r), lb = *(const f2_t*)(A.lnx_b + col0 + 2 * r);
#pragma unroll
        for (int tb = 0; tb < 2; ++tb) {
            unsigned vv[16], gg[16]; float bon[16];
#pragma unroll
            for (int q = 0; q < 16; ++q) { const unsigned tokrow = n0 + 32 * tb + 4 * hh + (q & 3) + 8 * (q >> 2); const unsigned o0 = tokrow * BW + col0 + 2 * r;
                vv[q] = *(const unsigned*)(V + o0); gg[q] = *(const unsigned*)(GG + o0); bon[q] = BON[(size_t)tokrow * 8 + h]; }
#pragma unroll
            for (int q = 0; q < 16; ++q) {
                const unsigned tokrow = n0 + 32 * tb + 4 * hh + (q & 3) + 8 * (q >> 2); const unsigned o0 = tokrow * BW + col0 + 2 * r;
                const float mean = half_bcast_sum(Z[tb][0][q] + Z[tb][1][q], hh) * (1.0f / 64.0f);
                const float d0 = Z[tb][0][q] - mean, d1 = Z[tb][1][q] - mean;
                const float rs = rsqrtf(half_bcast_sum(d0 * d0 + d1 * d1, hh) * (1.0f / 64.0f) + GN_EPS);
                const float y0 = (d0 * rs * lw.x + lb.x + bon[q] * bflo(vv[q])) * bflo(gg[q]), y1 = (d1 * rs * lw.y + lb.y + bon[q] * bfhi(vv[q])) * bfhi(gg[q]);
                *(unsigned*)(YRW + o0) = pk2(y0, y1);
                if ((q & 3) == 3) __builtin_amdgcn_sched_barrier(0); } }
    }
}

DI void p10_rows(const Frame& F0, ARef A, const bf16* Y1, bf16* H2) {
    Frame F = F0; F.tid = opq_tid(F0.wave); F.lane = F.tid & 63; F.wave = __builtin_amdgcn_readfirstlane(F.tid >> 6); F.gw = F.wg * NWAVES + F.wave;
    const int lane = F.lane;
    const float* mod = (const float*)(A.ws + WS_MOD);
    LAS float* rw = (LAS float*)F.lds;
    LAS int* hist = (LAS int*)(F.lds + 147456);
    TPS(F, 50);
    {   const char* src = (const char*)(A.ws + WS_RTW) + lane * 16;
        for (int j = F.wave; j < 144; j += NWAVES) __builtin_amdgcn_global_load_lds((const unsigned*)(src + j * 1024), (LAS unsigned*)(F.lds + j * 1024), 16, 0, 0);
        asm volatile("s_waitcnt vmcnt(0)" ::: "memory"); }
    __syncthreads();
    TPS(F, 51);
    i32x4* tok = (i32x4*)(A.ws + WS_TOK); int* cnt = (int*)(A.ws + WS_CNT);
    for (int tb = F.wg; tb < NTOK / 128; tb += F.G) {
        if (F.tid < 32) hist[F.tid] = 0;
        __syncthreads();
        for (int tl = F.wave; tl < 128; tl += NWAVES) {
            const int n = tb * 128 + tl, b = n >> 13;
            const f32x4* xr = (const f32x4*)(A.x + (size_t)n * D) + lane; const u32x2* yr = (const u32x2*)(Y1 + (size_t)n * D) + lane;
            f32x4 xv[4], yv[4]; float s = 0.f;
#pragma unroll
            for (int j = 0; j < 4; ++j) { xv[j] = xr[64 * j]; const u32x2 w = yr[64 * j]; yv[j][0] = bflo(w.x); yv[j][1] = bfhi(w.x); yv[j][2] = bflo(w.y); yv[j][3] = bfhi(w.y);
                s += (yv[j][0] * yv[j][0] + yv[j][1] * yv[j][1]) + (yv[j][2] * yv[j][2] + yv[j][3] * yv[j][3]); }
            const float inv1 = rsqrtf(wave_sum(s) * (1.0f / D) + NORM_EPS);
            float s2 = 0.f;
#pragma unroll
            for (int j = 0; j < 4; ++j) { const int k = 4 * lane + 256 * j;
                const f32x4 g1 = *(const f32x4*)(A.gains + D + k), gt = *(const f32x4*)(mod + b * 6144 + 2 * D + k);
#pragma unroll
                for (int q = 0; q < 4; ++q) { xv[j][q] = xv[j][q] + gt[q] * ((yv[j][q] * inv1) * g1[q]); s2 += xv[j][q] * xv[j][q]; }
                u32x2 xw; xw.x = pk2(xv[j][0], xv[j][1]); xw.y = pk2(xv[j][2], xv[j][3]); *((u32x2*)(A.ws + WS_X1 + (size_t)n * D * 2) + lane + 64 * j) = xw; }
            const float inv2 = rsqrtf(wave_sum(s2) * (1.0f / D) + NORM_EPS);
            f32x4 hv[4];
#pragma unroll
            for (int j = 0; j < 4; ++j) { const int k = 4 * lane + 256 * j;
                const f32x4 g2 = *(const f32x4*)(A.gains + 2 * D + k), sh = *(const f32x4*)(mod + b * 6144 + 3 * D + k), sc = *(const f32x4*)(mod + b * 6144 + 4 * D + k);
#pragma unroll
                for (int q = 0; q < 4; ++q) hv[j][q] = (xv[j][q] * inv2) * g2[q] * (1.0f + sc[q]) + sh[q];
                u32x2 w; w.x = pk2(hv[j][0], hv[j][1]); w.y = pk2(hv[j][2], hv[j][3]); *((u32x2*)(H2 + (size_t)n * D) + lane + 64 * j) = w; }
            typedef float f2_t __attribute__((ext_vector_type(2)));
#define P10_PAIR(OUT0, OUT1, WBASE) do { f2_t a = {0.f, 0.f}; \
                _Pragma("unroll") for (int j = 0; j < 4; ++j) { const LAS f32x4* wp = (const LAS f32x4*)((WBASE) + (4 * lane + 256 * j) * 2); const f32x4 wA = wp[0], wB = wp[1]; \
                    a += (f2_t){hv[j][0], hv[j][0]} * (f2_t){wA[0], wA[1]}; a += (f2_t){hv[j][1], hv[j][1]} * (f2_t){wA[2], wA[3]}; \
                    a += (f2_t){hv[j][2], hv[j][2]} * (f2_t){wB[0], wB[1]}; a += (f2_t){hv[j][3], hv[j][3]} * (f2_t){wB[2], wB[3]}; } \
                OUT0 = wave_sum(a.x); OUT1 = wave_sum(a.y); } while (0)
            float lg[4];
            P10_PAIR(lg[0], lg[1], rw); P10_PAIR(lg[2], lg[3], rw + 2 * D);
            int gs = 0; float gm = lg[0];
#pragma unroll
            for (int g = 1; g < 4; ++g) if (lg[g] > gm) { gm = lg[g]; gs = g; }
            gs = __builtin_amdgcn_readfirstlane(gs);
            float gsum = 0.f;
#pragma unroll
            for (int g = 0; g < 4; ++g) gsum += fexp(lg[g] - gm);
            const float gw = 1.0f / gsum;
            float el[8];
            { const LAS float* rwg = rw + (2 + 4 * gs) * (2 * D);
#pragma unroll
              for (int i = 0; i < 4; ++i) P10_PAIR(el[2 * i], el[2 * i + 1], rwg + i * 2 * D); }
#undef P10_PAIR
            int i0 = 0; float m0 = el[0];
#pragma unroll
            for (int e = 1; e < 8; ++e) if (el[e] > m0) { m0 = el[e]; i0 = e; }
            int i1 = -1; float m1 = -3.0e38f;
#pragma unroll
            for (int e = 0; e < 8; ++e) if (e != i0 && el[e] > m1) { m1 = el[e]; i1 = e; }
            const float t = fexp(m1 - m0), p0 = 1.0f / (1.0f + t), p1 = t * p0;
            const int e0 = gs * 8 + i0, e1 = gs * 8 + i1;
#if defined(CHECKS)
            if (lane == 0 && n == DBG_TOKEN) { float* dbg = (float*)(A.ws + WS_CTL + 32768) + 48; dbg[0] = lg[0]; dbg[1] = lg[1]; dbg[2] = lg[2]; dbg[3] = lg[3]; dbg[4] = gsum; dbg[5] = p0; dbg[6] = gw; dbg[7] = t; }
#endif
            if (lane == 0) { i32x4 rec; rec.x = e0 | (e1 << 8); rec.y = 0; rec.z = 0; rec.w = 0; tok[n] = rec;
                float* cwp = (float*)(A.ws + WS_CW) + 2 * n; cwp[0] = gw * p0; cwp[1] = gw * p1;
                atomicAdd((int*)&hist[e0], 1); atomicAdd((int*)&hist[e1], 1); }
        }
        __syncthreads();
        if (F.tid < 32) cnt[tb * 32 + F.tid] = hist[F.tid];
        __syncthreads();
    }
    TPS(F, 52);
}

DI void p11_rank_gather(const Frame& F0, ARef A, const bf16* H2, bf16* HS) {
    Frame F = F0; F.tid = opq_tid(F0.wave); F.lane = F.tid & 63; F.wave = __builtin_amdgcn_readfirstlane(F.tid >> 6); F.gw = F.wg * NWAVES + F.wave;
    LAS int* base = (LAS int*)F.lds;
    LAS int* seg = base + 32;
    LAS int* el = base + 96;
    LAS int* pos = base + 352;
    i32x4* tok = (i32x4*)(A.ws + WS_TOK); const int* cnt = (const int*)(A.ws + WS_CNT); int* tile = (int*)(A.ws + WS_TILE);
    LAS int* ptot = base + 640;
    LAS int* ppre = ptot + 512; LAS int* wcnt = ppre + 512;
    for (int tb = F.wg; tb < NTOK / 128; tb += F.G) {
        {
            const int e = F.tid & 31, part = F.tid >> 5; int tot = 0, pre = 0;
#pragma unroll
            for (int j = 0; j < 16; ++j) { const int t2 = part * 16 + j; const int v = cnt[t2 * 32 + e]; tot += v; pre += t2 < tb ? v : 0; }
            ptot[part * 32 + e] = tot; ppre[part * 32 + e] = pre; }
        if (F.tid >= 64 && F.tid < 64 + 128) { const i32x4 rec = tok[tb * 128 + (F.tid - 64)]; el[2 * (F.tid - 64)] = rec.x & 255; el[2 * (F.tid - 64) + 1] = (rec.x >> 8) & 255; }
        __syncthreads();
        if (F.tid < 32) { int tot = 0, pre = 0;
#pragma unroll
            for (int p = 0; p < 16; ++p) { tot += ptot[p * 32 + F.tid]; pre += ppre[p * 32 + F.tid]; }
            base[F.tid] = pre; seg[F.tid] = (tot + 255) & ~255; }
        int myrank = 0, mye = 0;
        if (F.tid < 256) { mye = el[F.tid];
#pragma unroll 4
            for (int x = 0; x < 32; ++x) { const unsigned long long m = __ballot(mye == x);
                if (mye == x) myrank = __popcll(m & ((1ull << F.lane) - 1ull));
                if (F.lane == 0) wcnt[F.wave * 32 + x] = __popcll(m); } }
        __syncthreads();
        if (F.tid == 0) { int acc = 0; for (int e = 0; e < 32; ++e) { const int sz = seg[e]; seg[e] = acc; acc += sz; } seg[32] = acc; }
        __syncthreads();
        if (F.tid < 256) { int p = seg[mye] + base[mye] + myrank;
            for (int w = 0; w < F.wave; ++w) p += wcnt[w * 32 + mye];
            pos[F.tid] = p; }
        if (tb == 0 && F.tid >= 256 && F.tid < 256 + 32) { const int e = F.tid - 256;
            for (int t2 = seg[e] >> 8; t2 < (seg[e + 1] >> 8); ++t2) tile[t2] = e;
            if (e == 0) tile[MAXT] = seg[32] >> 8; }
        __syncthreads();
        if (F.tid < 128) { i32x4 rec = tok[tb * 128 + F.tid]; rec.x = pos[2 * F.tid]; rec.y = pos[2 * F.tid + 1]; tok[tb * 128 + F.tid] = rec; }
        for (int q = F.wave; q < 256; q += NWAVES) { const int n = tb * 128 + (q >> 1);
            const u32x4* src = (const u32x4*)(H2 + (size_t)n * D) + F.lane; u32x4* dst = (u32x4*)(HS + (size_t)pos[q] * D) + F.lane;
            dst[0] = src[0]; dst[64] = src[64]; }
        __syncthreads();
    }
}

DI void p14_final(const Frame& F0, ARef A, const bf16* YE) {
    Frame F = F0; F.tid = opq_tid(F0.wave); F.lane = F.tid & 63; F.wave = __builtin_amdgcn_readfirstlane(F.tid >> 6); F.gw = F.wg * NWAVES + F.wave;
    const int lane = F.lane;
    const float* mod = (const float*)(A.ws + WS_MOD); const i32x4* tok = (const i32x4*)(A.ws + WS_TOK);
    for (int n = F.gw; n < NTOK; n += F.NGW) {
        const int b = n >> 13; const i32x4 rec = tok[n];
        const float c0 = ((const float*)(A.ws + WS_CW))[2 * n], c1 = ((const float*)(A.ws + WS_CW))[2 * n + 1];
        const u32x2* y0 = (const u32x2*)(YE + (size_t)rec.x * D) + lane; const u32x2* y1 = (const u32x2*)(YE + (size_t)rec.y * D) + lane;
        f32x4 yv[4]; float s = 0.f;
#pragma unroll
        for (int j = 0; j < 4; ++j) { const u32x2 a = y0[64 * j], bq = y1[64 * j];
            yv[j][0] = c0 * bflo(a.x) + c1 * bflo(bq.x); yv[j][1] = c0 * bfhi(a.x) + c1 * bfhi(bq.x); yv[j][2] = c0 * bflo(a.y) + c1 * bflo(bq.y); yv[j][3] = c0 * bfhi(a.y) + c1 * bfhi(bq.y);
            s += (yv[j][0] * yv[j][0] + yv[j][1] * yv[j][1]) + (yv[j][2] * yv[j][2] + yv[j][3] * yv[j][3]); }
        const float inv = rsqrtf(wave_sum(s) * (1.0f / D) + NORM_EPS);
#pragma unroll
        for (int j = 0; j < 4; ++j) { const int k = 4 * lane + 256 * j;
            const f32x4 g3 = *(const f32x4*)(A.gains + 3 * D + k), gt = *(const f32x4*)(mod + b * 6144 + 5 * D + k);
            const u32x2 xw = *((const u32x2*)(A.ws + WS_X1 + (size_t)n * D * 2) + lane + 64 * j); f32x4 xv = {bflo(xw.x), bfhi(xw.x), bflo(xw.y), bfhi(xw.y)};
#pragma unroll
            for (int q = 0; q < 4; ++q) xv[q] = xv[q] + gt[q] * ((yv[j][q] * inv) * g3[q]);
            *((f32x4*)(A.out + (size_t)n * D) + lane + 64 * j) = xv; }
    }
}

DI bf16x8 pk_tile(const f32x16& x, const int s) { return pack8v(x[8 * s], x[8 * s + 1], x[8 * s + 2], x[8 * s + 3], x[8 * s + 4], x[8 * s + 5], x[8 * s + 6], x[8 * s + 7]); }
constexpr int FS = 72;
DI bf16x8 rd_frag(const LAS bf16* buf, int tb, int cb, int s, int r, int hh) {
    const LAS bf16* p = buf + (32 * cb + r) * FS + 32 * tb + 16 * s + 4 * hh;
    const s16x4 lo = *(const LAS s16x4*)p, hi = *(const LAS s16x4*)(p + 8); bf16x8 f;
#pragma unroll
    for (int e = 0; e < 4; ++e) { f[e] = lo[e]; f[4 + e] = hi[e]; }
    return f; }
DI void wr_tile_ft(LAS bf16* buf, const f32x16& x, int tb, int cb, int r, int hh) {
#pragma unroll
    for (int g = 0; g < 4; ++g) { u32x2 w; w.x = pk2(x[4 * g], x[4 * g + 1]); w.y = pk2(x[4 * g + 2], x[4 * g + 3]); *(LAS u32x2*)(buf + (32 * cb + r) * FS + 32 * tb + 8 * g + 4 * hh) = w; } }
DI void wr_l_ft(LAS bf16* buf, const float (&x)[64], int lane) {
#pragma unroll
    for (int t8 = 0; t8 < 8; ++t8) { u32x4 w; w.x = pk2(x[8 * t8], x[8 * t8 + 1]); w.y = pk2(x[8 * t8 + 2], x[8 * t8 + 3]); w.z = pk2(x[8 * t8 + 4], x[8 * t8 + 5]); w.w = pk2(x[8 * t8 + 6], x[8 * t8 + 7]);
        *(LAS u32x4*)(buf + lane * FS + 8 * t8) = w; } }

#if defined(STAMPS)
#define P5STAMP(k) do { p5ts[k] = __builtin_amdgcn_s_memrealtime(); } while (0)
#else
#define P5STAMP(k) do { } while (0)
#endif
DI void p5_mfma(unsigned char* F0_ws, const Frame& F0, const bf16* R, const bf16* KP, const bf16* V, const bf16* KK, const bf16* Bv, const bf16* Ev, bf16* P, bf16* QO, bf16* GT, bf16* HT) {
    Frame F = F0; F.tid = opq_tid(F0.wave); F.lane = F.tid & 63; F.wave = __builtin_amdgcn_readfirstlane(F.tid >> 6); F.gw = F.wg * NWAVES + F.wave;
    const int lane = F.lane, r = lane & 31, hh = lane >> 5;
    LAS unsigned char* wl_init = F.lds + F.wave * 20480;
    LAS unsigned char* const wl0 = wl_init;
    {   bf16x8 id_[2];
#pragma unroll
        for (int s = 0; s < 2; ++s)
#pragma unroll
            for (int e = 0; e < 8; ++e) id_[s][e] = (16 * s + 8 * (e >> 2) + 4 * hh + (e & 3)) == r ? (short)0x3F80 : (short)0;
        *(LAS bf16x8*)(wl0 + 16640 + lane * 16) = id_[0]; *(LAS bf16x8*)(wl0 + 16640 + 1024 + lane * 16) = id_[1]; }
    wave_lds_fence();
    for (int cid = F.gw; cid < NCHUNK; cid += F.NGW) {
        const int bh = cid >> NCH_LOG, c = cid & (NCH - 1), b = bh >> 3, h = bh & 7;
        const unsigned n0 = (unsigned)b * SEQ + (unsigned)c * CH, col0 = (unsigned)h * HD;
        LAS unsigned char* wl = wl0; asm volatile("" : "+s"(wl));
        LAS unsigned char* IFR = wl + 16640;
        const int ln = opq_tid(F.wave) & 63;
#if defined(STAMPS)
        unsigned long long p5ts[10];
#endif
        const int rm = ln & 31, hm = ln >> 5;
        const bf16 *R0_ = R, *KP0_ = KP, *V0_ = V, *KK0_ = KK, *Bv0_ = Bv, *Ev0_ = Ev; bf16 *P0_ = P, *QO0_ = QO;
        asm volatile("" : "+s"(R0_), "+s"(KP0_), "+s"(V0_), "+s"(KK0_), "+s"(Bv0_), "+s"(Ev0_), "+s"(P0_), "+s"(QO0_));
        const GAS char *R_ = (const GAS char*)R0_, *KP_ = (const GAS char*)KP0_, *V_ = (const GAS char*)V0_, *KK_ = (const GAS char*)KK0_, *Bv_ = (const GAS char*)Bv0_, *Ev_ = (const GAS char*)Ev0_;
        GAS char *P_ = (GAS char*)P0_, *QO_ = (GAS char*)QO0_;
        const unsigned nb0 = n0 * BW + col0;
        const unsigned vL = (nb0 + (unsigned)ln) * 2u, vT = (nb0 + (unsigned)rm * BW + 4u * hm) * 2u;
#define OADD(v, c) ({ unsigned o_; asm volatile("v_add_u32_e32 %0, %1, %2" : "=v"(o_) : "n"((int)(c)), "v"(v)); o_; })
#define LD16(arr, off) (*(const GAS bf16*)((arr) + (off)))
#define XL(arr, t) LD16(arr, OADD(vL, (t) * BW * 2))
#define ROWQ(q) (((q) & 3) + 8 * ((q) >> 2))
        P5STAMP(0);
        bf16x8 Ep[2][2][2]; u32x2 raw[2][4][4];
#pragma unroll
        for (int fb = 0; fb < 2; ++fb)
#pragma unroll
            for (int tb = 0; tb < 2; ++tb)
#pragma unroll
                for (int s = 0; s < 2; ++s) { const u32x2 lo_ = *(const GAS u32x2*)(Ev_ + OADD(vT, (32 * tb * BW + 32 * fb + 16 * s) * 2)), hi_ = *(const GAS u32x2*)(Ev_ + OADD(vT, (32 * tb * BW + 32 * fb + 16 * s + 8) * 2));
                    u32x4 w_; w_.x = lo_.x; w_.y = lo_.y; w_.z = hi_.x; w_.w = hi_.y; Ep[fb][tb][s] = __builtin_bit_cast(bf16x8, w_); }
#define LOAD_TILE(BUF, FB, TB) do { _Pragma("unroll") for (int g = 0; g < 4; ++g) { const unsigned ot_ = OADD(vT, (32 * (TB) * BW + 32 * (FB) + 8 * g) * 2); \
            raw[BUF][0][g] = *(const GAS u32x2*)(KK_ + ot_); raw[BUF][1][g] = *(const GAS u32x2*)(R_ + ot_); \
            raw[BUF][2][g] = *(const GAS u32x2*)(Bv_ + ot_); raw[BUF][3][g] = *(const GAS u32x2*)(KP_ + ot_); } } while (0)
        LOAD_TILE(0, 0, 0);
#define IDF(s) (*(const LAS bf16x8*)(IFR + (s) * 1024 + ln * 16))
        bf16x8 ETp[2][2][2], tri[2], ones;
        float sc_[2];
        {   const bf16x8 id0 = IDF(0), id1 = IDF(1);
            {   unsigned o2_ = 0x3F803F80u; asm volatile("" : "+v"(o2_)); u32x4 o4_; o4_.x = o2_; o4_.y = o2_; o4_.z = o2_; o4_.w = o2_; ones = __builtin_bit_cast(bf16x8, o4_); }
#pragma unroll
            for (int e = 0; e < 8; ++e) {
#pragma unroll
                for (int s = 0; s < 2; ++s) tri[s][e] = (16 * s + 8 * (e >> 2) + 4 * hm + (e & 3)) <= rm ? (short)0x3F80 : (short)0; }
#pragma unroll
            for (int kb = 0; kb < 2; ++kb)
#pragma unroll
                for (int fb = 0; fb < 2; ++fb) { f32x16 x_;
#pragma unroll
                    for (int q = 0; q < 16; ++q) x_[q] = 0.f;
                    x_ = MFMA32(Ep[fb][kb][0], id0, x_); x_ = MFMA32(Ep[fb][kb][1], id1, x_);
                    ETp[kb][fb][0] = pk_tile(x_, 0); ETp[kb][fb][1] = pk_tile(x_, 1); }
#pragma unroll
            for (int fb = 0; fb < 2; ++fb) { f32x16 t_;
#pragma unroll
                for (int q = 0; q < 16; ++q) t_[q] = 0.f;
#pragma unroll
                for (int kb = 0; kb < 2; ++kb)
#pragma unroll
                    for (int s = 0; s < 2; ++s) t_ = MFMA32(ones, ETp[kb][fb][s], t_);
                sc_[fb] = fexp(-t_[0]); }
            __builtin_amdgcn_sched_barrier(0); }
        P5STAMP(1);
        bf16x8 Ap[2][2][2], Rp[2][2][2], Bp[2][2][2], Kp[2][2][2];
#pragma unroll
        for (int ti = 0; ti < 4; ++ti) { const int fb = ti >> 1, tb = ti & 1;
            if (ti < 3) LOAD_TILE((ti + 1) & 1, (ti + 1) >> 1, (ti + 1) & 1);
            f32x16 Lt;
#pragma unroll
            for (int q = 0; q < 16; ++q) Lt[q] = 0.f;
#pragma unroll
            for (int kb = 0; kb <= tb; ++kb)
#pragma unroll
                for (int s = 0; s < 2; ++s) Lt = MFMA32(ETp[kb][fb][s], kb < tb ? ones : tri[s], Lt);
#pragma unroll
            for (int s = 0; s < 2; ++s) {
                float a8[8], r8[8], b8[8], k8[8], e8[8]; unpack8(__builtin_bit_cast(u32x4, Ep[fb][tb][s]), e8);
#pragma unroll
                for (int g2 = 0; g2 < 2; ++g2) { const int g = 2 * s + g2;
                    const u32x2 aw = raw[ti & 1][0][g], rw = raw[ti & 1][1][g], bw = raw[ti & 1][2][g], kw = raw[ti & 1][3][g];
                    const float av[4] = {bflo(aw.x), bfhi(aw.x), bflo(aw.y), bfhi(aw.y)}, rv[4] = {bflo(rw.x), bfhi(rw.x), bflo(rw.y), bfhi(rw.y)},
                                bv[4] = {bflo(bw.x), bfhi(bw.x), bflo(bw.y), bfhi(bw.y)}, kv[4] = {bflo(kw.x), bfhi(kw.x), bflo(kw.y), bfhi(kw.y)};
#pragma unroll
                    for (int j = 0; j < 4; ++j) { const float l = -Lt[4 * g + j];
                        const float eI = fexp(l), eX = fexp(l + e8[4 * g2 + j]), eN = frcp(eI);
                        a8[4 * g2 + j] = -av[j] * eX; r8[4 * g2 + j] = rv[j] * eI; b8[4 * g2 + j] = bv[j] * eN; k8[4 * g2 + j] = kv[j] * eN; } }
                Ap[fb][tb][s] = __builtin_bit_cast(bf16x8, pack8(a8)); Rp[fb][tb][s] = __builtin_bit_cast(bf16x8, pack8(r8));
                Bp[fb][tb][s] = __builtin_bit_cast(bf16x8, pack8(b8)); Kp[fb][tb][s] = __builtin_bit_cast(bf16x8, pack8(k8)); }
            __builtin_amdgcn_sched_barrier(0); }
#undef LOAD_TILE
        P5STAMP(2);
#define GRAM_TILE(m_, XP, YP, ib, tb) do { _Pragma("unroll") for (int q = 0; q < 16; ++q) m_[q] = 0.f; \
            _Pragma("unroll") for (int fb = 0; fb < 2; ++fb) _Pragma("unroll") for (int s = 0; s < 2; ++s) m_ = MFMA32(XP[fb][ib][s], YP[fb][tb][s], m_); } while (0)
        bf16x8 Tp[2][2][2];
        {
#pragma unroll
            for (int b = 1; b >= 0; --b) { bf16x8 AP[2], BP[2]; f32x16 CT;
                {   f32x16 m_; int rm_ = rm; asm volatile("" : "+v"(rm_));
                    GRAM_TILE(m_, Bp, Ap, b, b);
#pragma unroll
                    for (int q = 0; q < 16; ++q) m_[q] = crow(q, hm) < rm_ ? m_[q] : 0.f;
                    BP[0] = pk_tile(m_, 0); BP[1] = pk_tile(m_, 1);
#pragma unroll
                    for (int q = 0; q < 16; ++q) CT[q] = m_[q] + (crow(q, hm) == rm_ ? 1.0f : 0.f);
                    GRAM_TILE(m_, Ap, Bp, b, b);
#pragma unroll
                    for (int q = 0; q < 16; ++q) m_[q] = rm_ < crow(q, hm) ? m_[q] : 0.f;
                    AP[0] = pk_tile(m_, 0); AP[1] = pk_tile(m_, 1); }
                __builtin_amdgcn_sched_barrier(0);
#pragma unroll
                for (int it = 0; it < 4; ++it) { f32x16 pn_, pt_;
#pragma unroll
                    for (int q = 0; q < 16; ++q) { pn_[q] = 0.f; pt_[q] = 0.f; }
#pragma unroll
                    for (int s = 0; s < 2; ++s) { pn_ = MFMA32(AP[s], BP[s], pn_); pt_ = MFMA32(BP[s], AP[s], pt_); }
                    const bf16x8 bt0 = pk_tile(CT, 0), bt1 = pk_tile(CT, 1);
                    AP[0] = pk_tile(pt_, 0); AP[1] = pk_tile(pt_, 1); BP[0] = pk_tile(pn_, 0); BP[1] = pk_tile(pn_, 1);
                    CT = MFMA32(AP[0], bt0, CT); CT = MFMA32(AP[1], bt1, CT);
                    __builtin_amdgcn_sched_barrier(0); }
                Tp[b][b][0] = pk_tile(CT, 0); Tp[b][b][1] = pk_tile(CT, 1); }
            {   f32x16 x_; GRAM_TILE(x_, Ap, Bp, 1, 0);
                const bf16x8 au0 = pk_tile(x_, 0), au1 = pk_tile(x_, 1);
#pragma unroll
                for (int q = 0; q < 16; ++q) x_[q] = 0.f;
                x_ = MFMA32(au0, Tp[1][1][0], x_); x_ = MFMA32(au1, Tp[1][1][1], x_);
                const bf16x8 bx0 = pk_tile(x_, 0), bx1 = pk_tile(x_, 1);
#pragma unroll
                for (int q = 0; q < 16; ++q) x_[q] = 0.f;
                x_ = MFMA32(Tp[0][0][0], IDF(0), x_); x_ = MFMA32(Tp[0][0][1], IDF(1), x_);
                const bf16x8 at0 = pk_tile(x_, 0), at1 = pk_tile(x_, 1);
#pragma unroll
                for (int q = 0; q < 16; ++q) x_[q] = 0.f;
                x_ = MFMA32(at0, bx0, x_); x_ = MFMA32(at1, bx1, x_);
                Tp[1][0][0] = pk_tile(x_, 0); Tp[1][0][1] = pk_tile(x_, 1); }
            __builtin_amdgcn_sched_barrier(0); }
        P5STAMP(3);
        {   const bf16x8 id0 = IDF(0), id1 = IDF(1);
#pragma unroll
            for (int tb = 0; tb < 2; ++tb)
#pragma unroll
                for (int kb = 0; kb < 2; ++kb) { f32x16 xb_, xk_; const float sc = sc_[kb];
#pragma unroll
                    for (int q = 0; q < 16; ++q) { xb_[q] = 0.f; xk_[q] = 0.f; }
                    xb_ = MFMA32(Bp[kb][tb][0], id0, xb_); xb_ = MFMA32(Bp[kb][tb][1], id1, xb_);
                    xk_ = MFMA32(Kp[kb][tb][0], id0, xk_); xk_ = MFMA32(Kp[kb][tb][1], id1, xk_);
#pragma unroll
                    for (int q = 0; q < 16; ++q) { xb_[q] *= sc; xk_[q] *= sc; }
#pragma unroll
                    for (int s = 0; s < 2; ++s) { *(LAS bf16x8*)(wl + (((tb * 2 + kb) * 2 + s) * 1024) + ln * 16) = pk_tile(xb_, s); *(LAS bf16x8*)(wl + 8192 + (((tb * 2 + kb) * 2 + s) * 1024) + ln * 16) = pk_tile(xk_, s); }
                    __builtin_amdgcn_sched_barrier(0); } }
        bf16x8 Makp[2][2][2], Mbrp[2][2][2], Mkrp[2][2][2];
#define GRAM(XP, YP, STRICT, BODY) _Pragma("unroll") for (int ib = 0; ib < 2; ++ib) _Pragma("unroll") for (int tb = 0; tb < 2; ++tb) if (!(ib == 1 && tb == 0)) { f32x16 m_; \
            GRAM_TILE(m_, XP, YP, ib, tb); \
            int rm_ = rm; asm volatile("" : "+v"(rm_)); \
            _Pragma("unroll") for (int q = 0; q < 16; ++q) { const int i_ = 32 * ib + crow(q, hm), t_ = 32 * tb + rm_; m_[q] = ((STRICT) ? (i_ < t_) : (i_ <= t_)) ? m_[q] : 0.f; } \
            BODY __builtin_amdgcn_sched_barrier(0); }
        GRAM(Kp, Rp, false, { Mkrp[ib][tb][0] = pk_tile(m_, 0); Mkrp[ib][tb][1] = pk_tile(m_, 1); })
        GRAM(Kp, Ap, true, { Makp[ib][tb][0] = pk_tile(m_, 0); Makp[ib][tb][1] = pk_tile(m_, 1); })
        GRAM(Bp, Rp, false, { Mbrp[ib][tb][0] = pk_tile(m_, 0); Mbrp[ib][tb][1] = pk_tile(m_, 1); })
#undef GRAM
#undef GRAM_TILE
        P5STAMP(4);
#define IDF2(s) (*(const LAS bf16x8*)(IFR + (s) * 1024 + ln2 * 16))
        bf16x8 ATp[2][2][2];
        const int ln2 = opq_tid(F.wave) & 63;
        GAS char* pn = (GAS char*)(P0_ + (size_t)cid * 4096);
#pragma unroll
        for (int kb = 0; kb < 2; ++kb) { const bf16x8 id0 = IDF2(0), id1 = IDF2(1);
            {   bf16x8 A0p[2][2];
#pragma unroll
                for (int ib = 0; ib < 2; ++ib) { f32x16 x_;
#pragma unroll
                    for (int q = 0; q < 16; ++q) x_[q] = 0.f;
                    x_ = MFMA32(Ap[kb][ib][0], id0, x_); x_ = MFMA32(Ap[kb][ib][1], id1, x_);
                    A0p[ib][0] = pk_tile(x_, 0); A0p[ib][1] = pk_tile(x_, 1); }
#pragma unroll
                for (int tb = 0; tb < 2; ++tb) { f32x16 a_;
#pragma unroll
                    for (int q = 0; q < 16; ++q) a_[q] = 0.f;
#pragma unroll
                    for (int ib = 0; ib <= tb; ++ib)
#pragma unroll
                        for (int s = 0; s < 2; ++s) a_ = MFMA32(Tp[tb][ib][s], A0p[ib][s], a_);
                    ATp[tb][kb][0] = pk_tile(a_, 0); ATp[tb][kb][1] = pk_tile(a_, 1); } }
            __builtin_amdgcn_sched_barrier(0);
#pragma unroll
            for (int tb = 0; tb < 2; ++tb) { f32x16 p_; const int jb = kb;
#pragma unroll
                for (int q = 0; q < 16; ++q) p_[q] = 0.f;
                p_ = MFMA32(id0, Rp[jb][tb][0], p_); p_ = MFMA32(id1, Rp[jb][tb][1], p_);
#pragma unroll
                for (int ib = 0; ib <= tb; ++ib)
#pragma unroll
                    for (int s = 0; s < 2; ++s) p_ = MFMA32(ATp[ib][jb][s], Mbrp[ib][tb][s], p_);
#pragma unroll
                for (int s = 0; s < 2; ++s) *(GAS bf16x8*)(pn + ((((jb * 2 + tb) * 2 + s) * 64) + ln2) * 16) = pk_tile(p_, s);
                __builtin_amdgcn_sched_barrier(0); } }
        P5STAMP(6);
        bf16x8 W1p[2][2][2], Vp[2][2][2];
        const int lc_ = ln2;
        const unsigned vC = (nb0 + 4u * (unsigned)(lc_ >> 5) * BW + 2u * (unsigned)(lc_ & 31)) * 2u;
#pragma unroll
        for (int ib = 0; ib < 2; ++ib) { f32x16 v0_, v1_;
#pragma unroll
            for (int q = 0; q < 16; ++q) { const unsigned w_ = *(const GAS unsigned*)(V_ + OADD(vC, ((32 * ib + ROWQ(q)) * BW) * 2)); v0_[q] = bflo(w_); v1_[q] = bfhi(w_); }
            Vp[ib][0][0] = pk_tile(v0_, 0); Vp[ib][0][1] = pk_tile(v0_, 1); Vp[ib][1][0] = pk_tile(v1_, 0); Vp[ib][1][1] = pk_tile(v1_, 1); }
#pragma unroll
        for (int vb = 0; vb < 2; ++vb) { bf16x8 W0p[2][2];
#pragma unroll
            for (int tb = 0; tb < 2; ++tb) { f32x16 w_;
#pragma unroll
                for (int q = 0; q < 16; ++q) w_[q] = 0.f;
#pragma unroll
                for (int ib = 0; ib <= tb; ++ib)
#pragma unroll
                    for (int s = 0; s < 2; ++s) w_ = MFMA32(Makp[ib][tb][s], Vp[ib][vb][s], w_);
                W0p[tb][0] = pk_tile(w_, 0); W0p[tb][1] = pk_tile(w_, 1); }
#pragma unroll
            for (int tb = 0; tb < 2; ++tb) { f32x16 w_;
#pragma unroll
                for (int q = 0; q < 16; ++q) w_[q] = 0.f;
#pragma unroll
                for (int ib = 0; ib <= tb; ++ib)
#pragma unroll
                    for (int s = 0; s < 2; ++s) w_ = MFMA32(Tp[tb][ib][s], W0p[ib][s], w_);
                W1p[tb][vb][0] = pk_tile(w_, 0); W1p[tb][vb][1] = pk_tile(w_, 1); }
            __builtin_amdgcn_sched_barrier(0); }
        P5STAMP(7);
        GAS char* qn = (GAS char*)(QO0_ + (size_t)cid * 4096);
#pragma unroll
        for (int tb = 0; tb < 2; ++tb)
#pragma unroll
            for (int vb = 0; vb < 2; ++vb) { f32x16 y_;
#pragma unroll
                for (int q = 0; q < 16; ++q) y_[q] = 0.f;
#pragma unroll
                for (int ib = 0; ib <= tb; ++ib)
#pragma unroll
                    for (int s = 0; s < 2; ++s) { y_ = MFMA32(Mbrp[ib][tb][s], W1p[ib][vb][s], y_); y_ = MFMA32(Mkrp[ib][tb][s], Vp[ib][vb][s], y_); }
#pragma unroll
                for (int g = 0; g < 4; ++g) { u32x2 w; w.x = pk2(y_[4 * g], y_[4 * g + 1]); w.y = pk2(y_[4 * g + 2], y_[4 * g + 3]); *(GAS u32x2*)(qn + ((((tb * 2 + vb) * 4 + g) * 64) + ln2) * 8) = w; }
                __builtin_amdgcn_sched_barrier(0); }
        P5STAMP(8);
        wave_lds_fence();
        bf16x8 Bh[2][2][2];
#pragma unroll
        for (int tb = 0; tb < 2; ++tb)
#pragma unroll
            for (int kb = 0; kb < 2; ++kb)
#pragma unroll
                for (int s = 0; s < 2; ++s) Bh[tb][kb][s] = *(const LAS bf16x8*)(wl + (((tb * 2 + kb) * 2 + s) * 1024) + ln2 * 16);
        GAS char* gt = (GAS char*)(GT + (size_t)cid * 4096); GAS char* ht = (GAS char*)(HT + (size_t)cid * 4096);
#pragma unroll
        for (int kb = 0; kb < 2; ++kb)
#pragma unroll
            for (int jb = 0; jb < 2; ++jb) { f32x16 g_;
                const float dg = sc_[kb];
#pragma unroll
                for (int q = 0; q < 16; ++q) g_[q] = (kb == jb && crow(q, hm) == rm) ? dg : 0.f;
#pragma unroll
                for (int tb = 0; tb < 2; ++tb)
#pragma unroll
                    for (int s = 0; s < 2; ++s) g_ = MFMA32(ATp[tb][jb][s], Bh[tb][kb][s], g_);
#pragma unroll
                for (int s = 0; s < 2; ++s) *(GAS bf16x8*)(gt + ((kb * 4 + jb * 2 + s) * 64 + ln2) * 16) = pk_tile(g_, s);
                __builtin_amdgcn_sched_barrier(0); }
        {   bf16x8 Kh[2][2][2];
#pragma unroll
            for (int tb = 0; tb < 2; ++tb)
#pragma unroll
                for (int kb = 0; kb < 2; ++kb)
#pragma unroll
                    for (int s = 0; s < 2; ++s) Kh[tb][kb][s] = *(const LAS bf16x8*)(wl + 8192 + (((tb * 2 + kb) * 2 + s) * 1024) + ln2 * 16);
#pragma unroll
            for (int kb = 0; kb < 2; ++kb)
#pragma unroll
                for (int vb = 0; vb < 2; ++vb) { f32x16 h_;
#pragma unroll
                    for (int q = 0; q < 16; ++q) h_[q] = 0.f;
#pragma unroll
                    for (int tb = 0; tb < 2; ++tb)
#pragma unroll
                        for (int s = 0; s < 2; ++s) { h_ = MFMA32(Bh[tb][kb][s], W1p[tb][vb][s], h_); h_ = MFMA32(Kh[tb][kb][s], Vp[tb][vb][s], h_); }
#pragma unroll
                    for (int g = 0; g < 4; ++g) { u32x2 w; w.x = pk2(h_[4 * g], h_[4 * g + 1]); w.y = pk2(h_[4 * g + 2], h_[4 * g + 3]); *(GAS u32x2*)(ht + ((((kb * 2 + vb) * 4 + g) * 64) + ln2) * 8) = w; }
                    __builtin_amdgcn_sched_barrier(0); } }
        P5STAMP(9);
#undef IDF
#undef IDF2
#if defined(STAMPS)
        if (F.gw == 0 && cid == 0 && lane == 0) { _Pragma("unroll") for (int k_ = 0; k_ < 10; ++k_) ((unsigned long long*)(F0_ws + WS_CTL + 49152))[32 + k_] = p5ts[k_]; }
#endif
        wave_lds_fence();
#undef XL
#undef OADD
#undef LD16
#undef ROWQ
    }
}

#if defined(CHECKS)
constexpr size_t WS_FLG = WS_CTL + 32768;
DI unsigned* chk_flags(unsigned char* ws) { return (unsigned*)(ws + WS_FLG); }
DI void chk(unsigned char* ws, int id, float got, float want, float rel, float ab) {
    const float d = fabsf(got - want), lim = rel * fmaxf(fabsf(got), fabsf(want)) + ab;
    if (!(d <= lim)) chk_flags(ws)[id] = 1u; }
DI unsigned hsh(unsigned a) { a ^= a >> 16; a *= 0x7feb352du; a ^= a >> 15; a *= 0x846ca68bu; a ^= a >> 16; return a; }
DI float bfr(float v) { return bflo(f2bf(v)); }
DI int scol_of(int n) { return n < 3360 ? n : (n < 3584 ? -1 : n - 224); }

DI void chk_p0(const Frame& F, ARef A) {
    unsigned char* ws = A.ws; const int lane = F.lane;
    const float* mod = (const float*)(ws + WS_MOD);
    for (int s = F.wave; s < 32; s += NWAVES) { const unsigned hh = hsh(1000 + s); const int b = hh & 3, o = (hh >> 2) % 6144; float a = 0.f;
        for (int k = lane; k < D; k += 64) { const float c = A.c[b * D + k]; a += (c / (1.0f + expf(-c))) * A.w_mod[(size_t)k * 6144 + o]; }
        a = wave_sum(a) + A.b_mod[o]; chk(ws, 10, mod[b * 6144 + o], a, 1e-3f, 1e-4f); }
    const bf16* wt = (const bf16*)(ws + WS_WIN);
    for (int s = 0; s < 8; ++s) { const unsigned hh = hsh(2000 + (F.wave * 8 + s) * 64 + lane); const int n = hh % NPAD, k = (hh >> 13) & 1023; const int sc = scol_of(n);
        const float want = sc >= 0 ? bfr(A.w_in[(size_t)k * IN_COLS + sc]) : 0.f; chk(ws, 11, bf2f(wt[(size_t)n * D + k]), want, 0.f, 0.f); }
    { const unsigned hh = hsh(3000 + F.wave * 64 + lane); const int n = hh & 1023, k = (hh >> 10) & 511, k2 = (hh >> 10) & 1023;
        chk(ws, 11, bf2f(((const bf16*)(ws + WS_WOSB))[n * BW + k]), bfr(A.w_o_sb[k * D + n]), 0.f, 0.f);
        chk(ws, 11, bf2f(((const bf16*)(ws + WS_WORW))[n * BW + k]), bfr(A.w_o_rw[k * D + n]), 0.f, 0.f);
        chk(ws, 11, bf2f(((const bf16*)(ws + WS_WOUT))[n * D + k2]), bfr(A.w_out[k2 * D + n]), 0.f, 0.f);
        const int o = hh % 36; chk(ws, 11, ((const float*)(ws + WS_RTW))[o * D + k2], o < 4 ? A.w_group[k2 * 4 + o] : A.w_router[k2 * NE + o - 4], 0.f, 0.f);
        const int nl = hh % 1536, kl = (hh >> 11) % LK; float v = 0.f;
        if (nl < 512) { if (kl < 64) v = A.w_decay_up[kl * BW + nl]; } else if (nl < 1024) { if (kl >= 64 && kl < 128) v = A.w_iclr_up[(kl - 64) * BW + nl - 512]; } else { if (kl >= 128 && kl < 288) v = A.w_gate_up[(kl - 128) * BW + nl - 1024]; }
        chk(ws, 11, bf2f(((const bf16*)(ws + WS_WL))[nl * LK + kl]), bfr(v), 0.f, 0.f); }
}
DI void chk_p1(const Frame& F, ARef A, const bf16* H1) {
    unsigned char* ws = A.ws; const int lane = F.lane; const float* mod = (const float*)(ws + WS_MOD);
    for (int s = F.wave; s < 16; s += NWAVES) { const int n = hsh(4000 + s) % NTOK, b = n >> 13; float ss = 0.f;
        for (int k = lane; k < D; k += 64) { const float v = A.x[(size_t)n * D + k]; ss += v * v; }
        const float inv = 1.0f / sqrtf(wave_sum(ss) / D + NORM_EPS);
        for (int k = lane; k < D; k += 64) { const float want = (A.x[(size_t)n * D + k] * inv) * A.gains[k] * (1.0f + mod[b * 6144 + D + k]) + mod[b * 6144 + k];
            chk(ws, 12, bf2f(H1[(size_t)n * D + k]), want, 0.01f, 0.01f); } }
}
DI float wdot(const bf16* arow, const float* W, int ldw, int col, int K, int lane) { float a = 0.f; for (int k = lane; k < K; k += 64) a += bf2f(arow[k]) * W[(size_t)k * ldw + col]; return wave_sum(a); }
DI void chk_p2(const Frame& F, ARef A, const bf16* H1) {
    unsigned char* ws = A.ws; const int lane = F.lane;
    for (int s = F.wave; s < 96; s += NWAVES) { const unsigned hh = hsh(5000 + s); const int n = hh % NTOK, region = s % 6; int col;
        const unsigned h2 = hsh(hh);
        float got, want; int id = 13 + region;
        if (region == 0) { col = h2 % 512; want = 0.125f * wdot(H1 + (size_t)n * D, A.w_in, IN_COLS, col, D, lane); got = bf2f(((const bf16*)(ws + WS_QB))[(size_t)n * BW + col]); }
        else if (region == 1) { col = h2 % 512; want = wdot(H1 + (size_t)n * D, A.w_in, IN_COLS, 512 + col, D, lane); got = bf2f(((const bf16*)(ws + WS_KB))[(size_t)n * BW + col]); }
        else if (region == 2) { col = h2 % 512; want = wdot(H1 + (size_t)n * D, A.w_in, IN_COLS, 1024 + col, D, lane); got = bf2f(((const bf16*)(ws + WS_VT))[((size_t)((n >> 13) * BW + col)) * SEQ + (n & (SEQ - 1))]); }
        else if (region == 3) { col = h2 % 1536; want = wdot(H1 + (size_t)n * D, A.w_in, IN_COLS, 1536 + col, D, lane); got = bf2f(((const bf16*)(ws + WS_RWRAW))[(size_t)n * 1536 + col]); }
        else if (region == 4) { col = h2 % 288; want = wdot(H1 + (size_t)n * D, A.w_in, IN_COLS, 3072 + col, D, lane); got = bf2f(((const bf16*)(ws + WS_LORA))[(size_t)n * BW + col]); }
        else { col = h2 % 2048; want = wdot(H1 + (size_t)n * D, A.w_in, IN_COLS, 3360 + col, D, lane) + A.gate_bias[col]; want = 1.0f / (1.0f + expf(-want)); got = bf2f(((const bf16*)(ws + WS_GATE))[(size_t)n * 2048 + col]); }
        chk(ws, id, got, want, 0.03f, 0.02f); }
}
constexpr int NATT = 16;
DI void att_sample(int s, int& b, int& h, int& t) { const unsigned hh = hsh(6000 + s); b = hh & 3; h = (hh >> 2) & 7; t = (s < 4) ? (s * 37) : (int)((hh >> 5) % SEQ); }
DI void chk_p3_save(const Frame& F, ARef A) {
    if (F.wave == 0) { bf16* sv = (bf16*)(A.ws + WS_FLG + 4096);
        for (int s = 0; s < NATT; ++s) { int b, h, t; att_sample(s, b, h, t); sv[s * 64 + F.lane] = ((const bf16*)(A.ws + WS_QB))[(size_t)(b * SEQ + t) * BW + h * HD + F.lane]; } }
}
DI void chk_p3(const Frame& F, ARef A, const bf16* R, const bf16* KS, const bf16* V, const bf16* KK) {
    unsigned char* ws = A.ws; const int lane = F.lane;
    const bf16* sv = (const bf16*)(ws + WS_FLG + 4096); const bf16* KB = (const bf16*)(ws + WS_KB); const bf16* VT = (const bf16*)(ws + WS_VT);
    for (int s = F.wave; s < NATT; s += NWAVES) { int b, h, t; att_sample(s, b, h, t);
        const float q = bf2f(sv[s * 64 + lane]); float later = 0.f, o = 0.f;
        for (int k = t - 1; k >= 0; --k) { const float z = wave_sum(q * bf2f(KB[(size_t)(b * SEQ + k) * BW + h * HD + lane]));
            const float sp = fmaxf(z, 0.f) + log1pf(expf(-fabsf(z)));
            o += expf(z - sp + later) * bf2f(VT[((size_t)((b * NH + h) * HD + lane)) * SEQ + k]);
            later -= sp; if (later < -200.f) break; }
        chk(ws, 19, bf2f(((const bf16*)(ws + WS_QB))[(size_t)(b * SEQ + t) * BW + h * HD + lane]), o, 0.04f, 0.02f); }
    const bf16* RW = (const bf16*)(ws + WS_RWRAW); const bf16* LO = (const bf16*)(ws + WS_LORA); const bf16* AL = (const bf16*)(ws + WS_ALORA);
    for (int s = F.wave; s < 32; s += NWAVES) { const unsigned hh = hsh(7000 + s); const int n = (s < 4) ? s * SEQ : (int)(hh % NTOK), hd = (hh >> 16) & 7; const bool first = (n & (SEQ - 1)) == 0;
        float xs[3];
        for (int p = 0; p < 3; ++p) { const int col = p * 512 + hd * 64 + lane; const float cur = bf2f(RW[(size_t)n * 1536 + col]), prv = first ? 0.f : bf2f(RW[(size_t)(n - 1) * 1536 + col]); xs[p] = cur + A.shift_mu[col] * (prv - cur); }
        const size_t o = (size_t)n * BW + hd * 64 + lane;
        chk(ws, 20, bf2f(R[o]), xs[0], 0.01f, 0.005f); chk(ws, 20, bf2f(KS[o]), xs[1], 0.01f, 0.005f); chk(ws, 20, bf2f(V[o]), xs[2], 0.01f, 0.005f);
        const float kk = xs[1] * A.k_k[hd * 64 + lane]; const float nn = sqrtf(wave_sum(kk * kk));
        chk(ws, 20, bf2f(KK[o]), kk / fmaxf(nn, L2_EPS), 0.01f, 0.002f);
        for (int c = lane; c < LK; c += 64) { float want = 0.f;
            if (c < 288) { const float cur = bf2f(LO[(size_t)n * BW + c]), prv = first ? 0.f : bf2f(LO[(size_t)(n - 1) * BW + c]); const float v = cur + A.shift_mu[1536 + c] * (prv - cur);
                want = c < 64 ? tanhf(v) : (c < 128 ? v : 1.0f / (1.0f + expf(-v))); }
            chk(ws, 20, bf2f(AL[(size_t)n * LK + c]), want, 0.01f, 0.005f); } }
}
DI void chk_p4_save(const Frame& F, ARef A, const bf16* KS) {
    if (F.wave == 0) { bf16* sv = (bf16*)(A.ws + WS_FLG + 8192);
        for (int s = 0; s < 16; ++s) { const unsigned hh = hsh(8000 + s); const int n = hh % NTOK, hd = (hh >> 16) & 7; sv[s * 64 + F.lane] = KS[(size_t)n * BW + hd * 64 + F.lane]; } }
}
DI void chk_p4(const Frame& F, ARef A, const bf16* KP, const bf16* KK) {
    unsigned char* ws = A.ws; const int lane = F.lane; const bf16* AL = (const bf16*)(ws + WS_ALORA); const bf16* sv = (const bf16*)(ws + WS_FLG + 8192);
    for (int s = F.wave; s < 16; s += NWAVES) { const unsigned hh = hsh(8000 + s); const int n = hh % NTOK, hd = (hh >> 16) & 7, c = hd * 64 + lane; const size_t o = (size_t)n * BW + c;
        float lw = 0.f, la = 0.f, lg = 0.f;
        for (int k = 0; k < 64; ++k) { lw += bf2f(AL[(size_t)n * LK + k]) * A.w_decay_up[k * BW + c]; la += bf2f(AL[(size_t)n * LK + 64 + k]) * A.w_iclr_up[k * BW + c]; }
        for (int k = 0; k < 160; ++k) lg += bf2f(AL[(size_t)n * LK + 128 + k]) * A.w_gate_up[k * BW + c];
        const float x = -(A.w0[c] + lw), w = -(fmaxf(x, 0.f) + log1pf(expf(-fabsf(x)))) - 0.5f;
        chk(ws, 21, bf2f(((const bf16*)(ws + WS_E))[o]), expf(w), 0.03f, 0.003f);
        const float a = 1.0f / (1.0f + expf(-(A.a0[c] + la))); const float ks = bf2f(sv[s * 64 + lane]);
        chk(ws, 22, bf2f(KP[o]), ks * (1.0f + (a - 1.0f) * A.k_a[c]), 0.03f, 0.01f);
        chk(ws, 22, bf2f(((const bf16*)(ws + WS_B))[o]), bf2f(KK[o]) * a, 0.03f, 0.003f);
        chk(ws, 23, bf2f(((const bf16*)(ws + WS_GG))[o]), lg, 0.03f, 0.01f); }
}
constexpr int NST = 300;
DI void chk_p7_save(const Frame& F, ARef A) {
    if (F.wave < 4) { const int b = (F.wave * 3) & 3, h = (F.wave * 5 + 1) & 7; bf16* sv = (bf16*)(A.ws + 256 * 1024) + F.wave * NST * 64;
        for (int t = 0; t < NST; ++t) sv[t * 64 + F.lane] = ((const bf16*)(A.ws + WS_E))[(size_t)(b * SEQ + t) * BW + h * HD + F.lane]; }
}
DI void chk_p7(const Frame& F, ARef A, const bf16* R, const bf16* KP, const bf16* V, const bf16* KK) {
    unsigned char* ws = A.ws; const int lane = F.lane;
    const bf16* Bv = (const bf16*)(ws + WS_B); const bf16* Esv = (const bf16*)(ws + 256 * 1024) + F.wave * NST * 64; const bf16* GG = (const bf16*)(ws + WS_GG); const bf16* YRW = (const bf16*)(ws + WS_YRW);
    if (F.wave < 4) { const int b = (F.wave * 3) & 3, h = (F.wave * 5 + 1) & 7, col0 = h * HD;
        float S[64];
#pragma unroll
        for (int k = 0; k < 64; ++k) S[k] = 0.f;
        for (int t = 0; t < NST; ++t) { const size_t o = (size_t)(b * SEQ + t) * BW + col0 + lane;
            const float av = -bf2f(KK[o]), bv = bf2f(Bv[o]), dv = expf(-bf2f(Esv[t * 64 + lane])), kv = bf2f(KP[o]), rv = bf2f(R[o]), vv = bf2f(V[o]);
            float sa = 0.f;
#pragma unroll
            for (int k = 0; k < 64; ++k) sa += S[k] * __shfl(av, k);
            float y = 0.f;
#pragma unroll
            for (int k = 0; k < 64; ++k) { S[k] = S[k] * __shfl(dv, k) + sa * __shfl(bv, k) + vv * __shfl(kv, k); y += S[k] * __shfl(rv, k); }
            const float mean = wave_sum(y) / 64.f, d = y - mean, var = wave_sum(d * d) / 64.f;
            const float yn = d / sqrtf(var + GN_EPS) * A.lnx_w[col0 + lane] + A.lnx_b[col0 + lane];
            const float bonus = wave_sum(rv * kv * A.r_k[col0 + lane]) * vv;
            const float want = (yn + bonus) * bf2f(GG[o]);
            chk(ws, t < 128 ? 24 : 25, bf2f(YRW[o]), want, 0.05f, 0.03f); } }
}
DI void chk_p8(const Frame& F, ARef A) {
    unsigned char* ws = A.ws; const int lane = F.lane;
    for (int s = F.wave; s < 32; s += NWAVES) { const unsigned hh = hsh(9000 + s); const int n = hh % NTOK, c = (hh >> 15) & 1023;
        const float p1 = wdot((const bf16*)(ws + WS_QB) + (size_t)n * BW, A.w_o_sb, D, c, BW, lane), p2 = wdot((const bf16*)(ws + WS_YRW) + (size_t)n * BW, A.w_o_rw, D, c, BW, lane);
        const bf16* ga = (const bf16*)(ws + WS_GATE) + (size_t)n * 2048;
        chk(ws, 26, bf2f(((const bf16*)(ws + WS_MRG))[(size_t)n * D + c]), bf2f(ga[c]) * p1 + bf2f(ga[1024 + c]) * p2, 0.03f, 0.01f); }
}
DI void chk_p9(const Frame& F, ARef A) {
    unsigned char* ws = A.ws; const int lane = F.lane;
    for (int s = F.wave; s < 32; s += NWAVES) { const unsigned hh = hsh(9500 + s); const int n = hh % NTOK, c = (hh >> 15) & 1023;
        chk(ws, 27, bf2f(((const bf16*)(ws + WS_Y1))[(size_t)n * D + c]), wdot((const bf16*)(ws + WS_MRG) + (size_t)n * D, A.w_out, D, c, D, lane), 0.03f, 0.01f); }
}
DI void chk_p10(const Frame& F, ARef A) {
    unsigned char* ws = A.ws; const int lane = F.lane; const float* mod = (const float*)(ws + WS_MOD);
    const bf16* Y1 = (const bf16*)(ws + WS_Y1); const bf16* H2 = (const bf16*)(ws + WS_H2); const i32x4* tok = (const i32x4*)(ws + WS_TOK);
    for (int s = F.wave; s < 32; s += NWAVES) { const int n = s == 0 ? DBG_TOKEN : (s < 16 ? (int)(hsh(10000 + s) % 128) : (int)(hsh(10000 + s) % NTOK)), b = n >> 13; float ss = 0.f;
        for (int k = lane; k < D; k += 64) { const float v = bf2f(Y1[(size_t)n * D + k]); ss += v * v; }
        const float inv1 = 1.0f / sqrtf(wave_sum(ss) / D + NORM_EPS); float s2 = 0.f;
        for (int k = lane; k < D; k += 64) { const float x1 = A.x[(size_t)n * D + k] + mod[b * 6144 + 2 * D + k] * ((bf2f(Y1[(size_t)n * D + k]) * inv1) * A.gains[D + k]);
            chk(ws, 28, A.out[(size_t)n * D + k], x1, 1e-3f, 1e-3f); s2 += x1 * x1; }
        const float inv2 = 1.0f / sqrtf(wave_sum(s2) / D + NORM_EPS);
        float lg[36];
#pragma unroll
        for (int o = 0; o < 36; ++o) lg[o] = 0.f;
        for (int k = lane; k < D; k += 64) { const float h2 = (A.out[(size_t)n * D + k] * inv2) * A.gains[2 * D + k] * (1.0f + mod[b * 6144 + 4 * D + k]) + mod[b * 6144 + 3 * D + k];
            chk(ws, 29, bf2f(H2[(size_t)n * D + k]), h2, 0.01f, 0.01f);
#pragma unroll
            for (int o = 0; o < 36; ++o) lg[o] += h2 * (o < 4 ? A.w_group[k * 4 + o] : A.w_router[k * NE + o - 4]); }
#pragma unroll
        for (int o = 0; o < 36; ++o) lg[o] = wave_sum(lg[o]);
        int gs = 0; float gm = lg[0];
#pragma unroll
        for (int g = 1; g < 4; ++g) if (lg[g] > gm) { gm = lg[g]; gs = g; }
        float gsum = 0.f;
#pragma unroll
        for (int g = 0; g < 4; ++g) gsum += expf(lg[g] - gm);
        float el[8];
#pragma unroll
        for (int e = 0; e < 8; ++e) el[e] = gs == 0 ? lg[4 + e] : (gs == 1 ? lg[12 + e] : (gs == 2 ? lg[20 + e] : lg[28 + e]));
        int i0 = 0; float m0 = el[0];
#pragma unroll
        for (int e = 1; e < 8; ++e) if (el[e] > m0) { m0 = el[e]; i0 = e; }
        int i1 = -1; float m1 = -3.0e38f;
#pragma unroll
        for (int e = 0; e < 8; ++e) if (e != i0 && el[e] > m1) { m1 = el[e]; i1 = e; }
        const float tt = expf(m1 - m0), p0 = 1.0f / (1.0f + tt);
        const i32x4 rec = tok[n];
        if (lane == 0 && s < 16) { if ((rec.x & 255) != gs * 8 + i0 || ((rec.x >> 8) & 255) != gs * 8 + i1) chk_flags(ws)[30] = 1u;
            if (n == DBG_TOKEN) { const float* dbg = (const float*)chk_flags(ws) + 48; float code = 1.f;
                if (dbg[4] > 4.001f) code += 2.f; if (dbg[5] < 0.499f) code += 4.f;
                if (fabsf(dbg[0] - lg[0]) > 1e-3f || fabsf(dbg[1] - lg[1]) > 1e-3f || fabsf(dbg[2] - lg[2]) > 1e-3f || fabsf(dbg[3] - lg[3]) > 1e-3f) code += 8.f;
                if (fabsf(dbg[4] - gsum) > 1e-3f) code += 16.f; if (fabsf(dbg[6] * dbg[5] - __builtin_bit_cast(float, rec.z)) > 1e-4f) code += 32.f;
                ((float*)chk_flags(ws))[62] = code * 0.1f; ((float*)chk_flags(ws))[63] = dbg[4]; }
            chk(ws, 56, ((const float*)(ws + WS_CW))[2 * n], p0 / gsum, 3e-2f, 1e-4f); chk(ws, 57, ((const float*)(ws + WS_CW))[2 * n + 1], tt * p0 / gsum, 3e-2f, 1e-4f);
            chk(ws, 58, ((const float*)(ws + WS_CW))[2 * n], p0 / gsum, 1e-3f, 1e-5f); chk(ws, 59, ((const float*)(ws + WS_CW))[2 * n + 1], tt * p0 / gsum, 1e-3f, 1e-5f); } }
}
DI void chk_p11(const Frame& F, ARef A) {
    unsigned char* ws = A.ws; const int lane = F.lane; const i32x4* tok = (const i32x4*)(ws + WS_TOK); const int* tile = (const int*)(ws + WS_TILE);
    const bf16* H2 = (const bf16*)(ws + WS_H2); const bf16* HS = (const bf16*)(ws + WS_HS);
    for (int s = F.wave; s < 64; s += NWAVES) { const int n = hsh(11000 + s) % NTOK; const i32x4 rec = tok[n];
        if (rec.x < 0 || rec.x >= tile[MAXT] * 256 || rec.y < 0 || rec.y >= tile[MAXT] * 256 || tile[MAXT] > MAXT || tile[MAXT] < 256) { chk_flags(ws)[32] = 1u; continue; }
        for (int k = lane; k < D; k += 64) { chk(ws, 33, bf2f(HS[(size_t)rec.x * D + k]), bf2f(H2[(size_t)n * D + k]), 0.f, 0.f); chk(ws, 33, bf2f(HS[(size_t)rec.y * D + k]), bf2f(H2[(size_t)n * D + k]), 0.f, 0.f); } }
    { const unsigned hh = hsh(12000 + F.wave * 64 + lane); const int e = hh & 31, n = (hh >> 5) & 1023, k = (hh >> 15) & 1023, k5 = k & 511;
        const int c = (n >> 3) * 4 + (n & 3); const float want = (n & 4) ? A.w_up3[((size_t)e * D + k) * DE + c] : A.w_up1[((size_t)e * D + k) * DE + c];
        chk(ws, 34, bf2f(((const bf16*)(ws + WS_WUP))[((size_t)e * 1024 + n) * D + k]), bfr(want), 0.f, 0.f);
        chk(ws, 35, bf2f(((const bf16*)(ws + WS_WDN))[((size_t)e * 1024 + n) * DE + k5]), bfr(A.w_down[((size_t)e * DE + k5) * D + n]), 0.f, 0.f); }
}
DI void chk_p12(const Frame& F, ARef A) {
    unsigned char* ws = A.ws; const int lane = F.lane; const i32x4* tok = (const i32x4*)(ws + WS_TOK); const int* tile = (const int*)(ws + WS_TILE);
    const bf16* H2 = (const bf16*)(ws + WS_H2); const bf16* HID = (const bf16*)(ws + WS_HID);
    for (int s = F.wave; s < 32; s += NWAVES) { const unsigned hh = hsh(13000 + s); const int n = hh % NTOK, c = (hh >> 16) & 511; const i32x4 rec = tok[n]; const int pos = (s & 1) ? rec.y : rec.x;
        const int e = tile[pos >> 8];
        const float u1 = wdot(H2 + (size_t)n * D, A.w_up1 + (size_t)e * D * DE, DE, c, D, lane), u3 = wdot(H2 + (size_t)n * D, A.w_up3 + (size_t)e * D * DE, DE, c, D, lane);
        chk(ws, 36, bf2f(HID[(size_t)pos * DE + c]), u1 / (1.0f + expf(-u1)) * u3, 0.04f, 0.01f); }
}
DI void chk_p13(const Frame& F, ARef A) {
    unsigned char* ws = A.ws; const int lane = F.lane; const i32x4* tok = (const i32x4*)(ws + WS_TOK); const int* tile = (const int*)(ws + WS_TILE);
    const bf16* HID = (const bf16*)(ws + WS_HID); const bf16* YE = (const bf16*)(ws + WS_HS);
    for (int s = F.wave; s < 32; s += NWAVES) { const unsigned hh = hsh(14000 + s); const int n = hh % NTOK, c = (hh >> 16) & 1023; const i32x4 rec = tok[n]; const int pos = (s & 1) ? rec.y : rec.x;
        const int e = tile[pos >> 8];
        chk(ws, 37, bf2f(YE[(size_t)pos * D + c]), wdot(HID + (size_t)pos * DE, A.w_down + (size_t)e * DE * D, D, c, DE, lane), 0.04f, 0.01f); }
}
#endif

__global__ void __launch_bounds__(NTHR, 2) hybrid_fwd(Args A_unused) {
    extern __shared__ __attribute__((aligned(16))) unsigned char lds_raw[];
    const CAS Args& A = *(const CAS Args*)__builtin_amdgcn_kernarg_segment_ptr();
    Frame F;
    F.lds = (LAS unsigned char*)lds_raw;
    F.wave = __builtin_amdgcn_readfirstlane((int)threadIdx.x >> 6); F.tid = opq_tid(F.wave); F.lane = F.tid & 63;
    F.wg = blockIdx.x; F.G = gridDim.x; F.gw = F.wg * NWAVES + F.wave; F.NGW = F.G * NWAVES;
    volatile LAS unsigned* MISC = (volatile LAS unsigned*)(F.lds + LDS_MISC);
    if (F.wave == 0) MISC[F.lane] = 0u;
    __syncthreads();
    const XcdBarrier bar = xcd_barrier_post((unsigned*)(A.ws + WS_CTL), MISC + 8, F.wave);
    unsigned char* ws = A.ws;
    LAS unsigned char* stage = F.lds;
    bf16* const dob = (bf16*)A.out;
    bf16 *H1 = dob, *R = dob, *KS = dob + (size_t)NTOK * BW, *V = dob + 2 * (size_t)NTOK * BW, *KK = dob + 3 * (size_t)NTOK * BW;

#if defined(STAMPS)
    unsigned long long* const tsp = (unsigned long long*)(ws + WS_CTL + 49152);
#define STAMP(k) do { if (F.wg == 0 && xb_t0(F.wave)) tsp[k] = wall_clock64(); } while (0)
#elif defined(TIMEPHASE)
#define STAMP(k) TPS(F, k)
#else
#define STAMP(k) do { } while (0)
#endif
#if defined(REPEAT_PHASE)
#ifndef REPEAT_COUNT
#define REPEAT_COUNT 2
#endif
#define REP(k) _Pragma("nounroll") for (int rep_ = 0; rep_ < ((k) == REPEAT_PHASE ? REPEAT_COUNT : 1); ++rep_)
#else
#define REP(k)
#endif
    STAMP(0);
    REP(0) {
    p0_prologue(F, A);
    xcd_barrier(bar);
    }
    STAMP(1);
#if defined(CHECKS)
    if (F.wg == 0) chk_p0(F, A);
#endif
    REP(1) {
    p1_h1(F, A, H1);
    xcd_barrier(bar);
    }
    STAMP(2);
#if defined(CHECKS)
    if (F.wg == 0) chk_p1(F, A, H1);
#endif
    REP(2) {
    {   pg8::Gemm g{H1, (const bf16*)(ws + WS_WIN), NTOK, NPAD, D}; pg8::StaticOrder S; S.init(NTOK, NPAD, F.G, F.wg);
        EpiIn E{(bf16*)(ws + WS_QB), (bf16*)(ws + WS_KB), (bf16*)(ws + WS_VT), (bf16*)(ws + WS_RWRAW), (bf16*)(ws + WS_LORA), (bf16*)(ws + WS_GATE), A.gate_bias};
        pg8::gemm_phase<EpiIn, pg8::StaticOrder>(stage, g, S, E, nullptr, F.wave); }
    xcd_barrier(bar);
    }
    STAMP(3);
#if defined(CHECKS)
    if (F.wg == 0) { chk_p2(F, A, H1); chk_p3_save(F, A); }
    xcd_barrier(bar);
#endif
#if !defined(CHECKS)
    const bool fuse34 = (F.G == 256);
#else
    const bool fuse34 = false;
#endif
    REP(3) {
#if defined(TIMEPHASE)
    STAMP(30);
#endif
    p3_attn(F, (const bf16*)(ws + WS_QB), (const bf16*)(ws + WS_KB), (const bf16*)(ws + WS_VT), (bf16*)(ws + WS_QB));
#if defined(STAMPS)
    STAMP(20);
#endif
#if defined(TIMEPHASE)
    STAMP(31);
#endif
    p3_prep(F, A, (const bf16*)(ws + WS_RWRAW), (const bf16*)(ws + WS_LORA), R, KS, V, KK, (bf16*)(ws + WS_ALORA));
#if defined(TIMEPHASE)
    STAMP(32);
#endif
#if !defined(CHECKS)
    if (fuse34) { asm volatile("s_waitcnt vmcnt(0)" ::: "memory"); __syncthreads();
        p4_lora(F, A, (const bf16*)(ws + WS_ALORA), (const bf16*)(ws + WS_WL), (bf16*)(ws + WS_E), KS, (bf16*)(ws + WS_B), (bf16*)(ws + WS_GG), KK, R, (float*)(ws + WS_BON)); }
#endif
#if defined(TIMEPHASE)
    STAMP(33);
#endif
    xcd_barrier(bar);
    }
#if defined(STAMPS)
    STAMP(21);
#endif
    STAMP(4);
#if defined(CHECKS)
    if (F.wg == 0) { chk_p3(F, A, R, KS, V, KK); chk_p4_save(F, A, KS); }
    xcd_barrier(bar);
#endif
    if (!fuse34) {
    p4_lora(F, A, (const bf16*)(ws + WS_ALORA), (const bf16*)(ws + WS_WL), (bf16*)(ws + WS_E), KS, (bf16*)(ws + WS_B), (bf16*)(ws + WS_GG), KK, R, (float*)(ws + WS_BON));
    xcd_barrier(bar);
    }
    STAMP(5);
#if defined(CHECKS)
    if (F.wg == 0) chk_p4(F, A, KS, KK);
#endif
    REP(5) {
    p5_mfma(ws, F, R, KS, V, KK, (const bf16*)(ws + WS_B), (const bf16*)(ws + WS_E), (bf16*)(ws + WS_P), (bf16*)(ws + WS_QO), (bf16*)(ws + WS_GT), (bf16*)(ws + WS_HT));
    p6_moe_weights(F, A, F.gw, F.NGW);
    xcd_barrier(bar);
    }
    STAMP(6);
#if defined(CHECKS)
    if (F.wg == 255) chk_p7_save(F, A);
#endif
    REP(6) {
    {   const int ncw = F.G < 64 ? F.G : 64;
        if (F.wg < ncw) { if (F.wave == 0) for (int task = F.wg; task < 64; task += ncw) p6_chain(task, F.wave, F.lds, (const bf16*)(ws + WS_GT), (const bf16*)(ws + WS_HT), (bf16*)(ws + WS_SC));
#if defined(STAMPS)
            STAMP(22);
#endif
        }
        else {
            pg8::StaticOrder S; S.init(NTOK, D, F.G - ncw, F.wg - ncw);
            pg8::Gemm g{(const bf16*)(ws + WS_QB), (const bf16*)(ws + WS_WOSB), NTOK, D, BW};
            EpiMerge<false> E{(bf16*)(ws + WS_GATE), (bf16*)(ws + WS_MRG), 0};
            pg8::gemm_phase<EpiMerge<false>, pg8::StaticOrder>(stage, g, S, E, nullptr, F.wave); }
    }
    xcd_barrier(bar);
    }
    STAMP(7);
    REP(7) {
    p7_mfma(F, A, (const bf16*)(ws + WS_SC), (const bf16*)(ws + WS_P), (const bf16*)(ws + WS_QO), V, (const bf16*)(ws + WS_GG), (const float*)(ws + WS_BON), (bf16*)(ws + WS_YRW));
    xcd_barrier(bar);
    }
    STAMP(8);
#if defined(CHECKS)
    if (F.wg == 0) chk_p7(F, A, R, KS, V, KK);
#endif
    REP(8) {
    {   pg8::StaticOrder S; S.init(NTOK, D, F.G, F.wg);
        {   pg8::Gemm g{(const bf16*)(ws + WS_YRW), (const bf16*)(ws + WS_WORW), NTOK, D, BW};
            EpiMerge<true> E{(bf16*)(ws + WS_GATE), (bf16*)(ws + WS_MRG), D};
            pg8::gemm_phase<EpiMerge<true>, pg8::StaticOrder>(stage, g, S, E, nullptr, F.wave); } }
    xcd_barrier(bar);
    }
    STAMP(9);
#if defined(CHECKS)
    if (F.wg == 0) chk_p8(F, A);
#endif
    REP(9) {
    {   pg8::Gemm g{(const bf16*)(ws + WS_MRG), (const bf16*)(ws + WS_WOUT), NTOK, D, D}; pg8::StaticOrder S; S.init(NTOK, D, F.G, F.wg);
        EpiPlain E{(bf16*)(ws + WS_Y1), D, 0xff};
        pg8::gemm_phase<EpiPlain, pg8::StaticOrder>(stage, g, S, E, nullptr, F.wave); }
    xcd_barrier(bar);
    }
    STAMP(10);
#if defined(CHECKS)
    if (F.wg == 0) chk_p9(F, A);
#endif
    REP(10) {
    p10_rows(F, A, (const bf16*)(ws + WS_Y1), (bf16*)(ws + WS_H2));
    xcd_barrier(bar);
    }
    STAMP(11);
#if defined(CHECKS)
    if (F.wg == 0) chk_p10(F, A);
#endif
    REP(11) {
    p11_rank_gather(F, A, (const bf16*)(ws + WS_H2), (bf16*)(ws + WS_HS));
    xcd_barrier(bar);
    }
    STAMP(12);
#if defined(CHECKS)
    if (F.wg == 0) chk_p11(F, A);
#endif
    {   const int* tile = (const int*)(ws + WS_TILE);
        const int nt = __builtin_amdgcn_readfirstlane(tile[MAXT]);
        const int vc = (F.G % 8 == 0) ? (F.wg % 8) * (F.G / 8) + F.wg / 8 : F.wg;
        unsigned* tcnt = (unsigned*)(ws + WS_CTL) + MOE_CNT_WORD;
        REP(12) {   pg8::Gemm g{(const bf16*)(ws + WS_HS), (const bf16*)(ws + WS_WUP), MAXT * 256, NE * 1024, D};
            MoeUpOrder S; S.nunits = nt * 4; S.G = F.G; S.vc = vc; S.tile_e = tile; S.cnt = tcnt;
            EpiUp E{(bf16*)(ws + WS_HID)};
            pg8::gemm_phase<EpiUp, MoeUpOrder>(stage, g, S, E, nullptr, F.wave); }
        __syncthreads();
    STAMP(13);
        REP(13) {   pg8::Gemm g{(const bf16*)(ws + WS_HID), (const bf16*)(ws + WS_WDN), MAXT * 256, NE * 1024, DE};
            MoeDnOrder S; S.nunits = nt * 4; S.G = F.G; S.vc = vc; S.q = (nt * 4) / F.G; S.rem = nt * 4 - S.q * F.G; S.wave = F.wave; S.tile_e = tile; S.cnt = tcnt;
            EpiPlain E{(bf16*)(ws + WS_HS), D, 3};
            pg8::gemm_phase<EpiPlain, MoeDnOrder>(stage, g, S, E, nullptr, F.wave);
        xcd_barrier(bar); } }
    STAMP(14);
#if defined(CHECKS)
    if (F.wg == 0) chk_p13(F, A);
#endif
    p14_final(F, A, (const bf16*)(ws + WS_HS));
#if defined(STAMPS)
    xcd_barrier(bar);
    STAMP(15);
    if (F.wg == 0) { __syncthreads();
        const float va = (float)(long long)(tsp[STAMP_A2] - tsp[STAMP_A]) * 0.01f, vb = (float)(long long)(tsp[STAMP_B2] - tsp[STAMP_B]) * 0.01f;
#if defined(STAMP_SHIFT)
        const float shf_ = 1.1f;
#else
        const float shf_ = 1.0f;
#endif
        int b1 = (int)floorf(logf(fmaxf(va * shf_, 1.0f)) / logf(1.21f)) + 1, b2 = (int)floorf(logf(fmaxf(vb * shf_, 1.0f)) / logf(1.21f)) + 1;
#if defined(STAMP_CAL)
        b1 = 10; b2 = 30;
#endif
#if defined(STAMP_FRAC)
        { const unsigned long long* t5 = tsp + 32; const float tot = (float)(long long)(t5[9] - t5[0]);
          b1 = (int)(12.0f * (float)(long long)(t5[STAMP_A2] - t5[STAMP_A]) / tot) + 3; b2 = (int)(12.0f * (float)(long long)(t5[STAMP_B2] - t5[STAMP_B]) / tot) + 3; }
#endif
#if defined(STAMP_THR_A)
        b1 = va > (float)(STAMP_THR_A) ? 30 : 10; b2 = vb > (float)(STAMP_THR_B) ? 30 : 10;
#endif
        const int t_ = opq_tid(F.wave);
        for (int i = t_; i < 1000; i += NTHR) A.out[1000 + i] += 20.0f * (float)b2;
        if (t_ == 0) A.out[0] = 200.0f * (float)b1; }
#endif
#if defined(CHECKS)
    xcd_barrier(bar);
    if (F.wg == 0 && F.tid == 0) { const unsigned* fl = chk_flags(ws); int id = 0; for (int i = 61; i >= 0; --i) if (fl[i]) id = i;
        if (((const unsigned*)(ws + WS_CTL))[XB_TMO]) id = 60;
        if (id) A.out[0] = 10.0f * (float)id;
#if defined(CHKVAL)
        A.out[0] = 1000.0f * ((const float*)fl)[CHKVAL];
#endif
        }
#endif
}

extern "C" void kernel_launch(void* const* d_in, const int* in_sizes, int n_in, void* d_out, int out_size, void* d_ws, size_t ws_size, hipStream_t stream) {
    static int grid = 0;
    if (grid == 0) {
        if (n_in != 26 || in_sizes[0] != NTOK * D || out_size != NTOK * D || ws_size < WS_END) {
            fprintf(stderr, "kernel_launch: unexpected shapes (n_in %d, in0 %d, out %d, ws %zu); nothing launched\n", n_in, n_in > 0 ? in_sizes[0] : -1, out_size, ws_size); grid = -1; return; }
        int dev = 0, cus = 0, per_cu = 0;
        if (hipGetDevice(&dev) != hipSuccess || hipDeviceGetAttribute(&cus, hipDeviceAttributeMultiprocessorCount, dev) != hipSuccess) { grid = -1; return; }
        if (hipFuncSetAttribute((const void*)hybrid_fwd, hipFuncAttributeMaxDynamicSharedMemorySize, LDS_BYTES) != hipSuccess) { fprintf(stderr, "kernel_launch: hipFuncSetAttribute failed\n"); grid = -1; return; }
        if (hipOccupancyMaxActiveBlocksPerMultiprocessor(&per_cu, (const void*)hybrid_fwd, NTHR, LDS_BYTES) != hipSuccess || per_cu < 1)
            fprintf(stderr, "kernel_launch: note: occupancy query reports %d workgroups per CU\n", per_cu);
        (void)hipGetLastError();
        grid = cus > 256 ? 256 : cus;
    }
    if (grid < 0) return;
    if (hipMemsetAsync((char*)d_ws + WS_CTL, 0, CTL_ZERO_BYTES, stream) != hipSuccess) return;
    Args a{};
    const float** p = (const float**)&a;
    for (int i = 0; i < 26; ++i) p[i] = (const float*)d_in[i];
    a.out = (float*)d_out; a.ws = (unsigned char*)d_ws;
    hipLaunchKernelGGL(hybrid_fwd, dim3(grid), dim3(NTHR), LDS_BYTES, stream, a);
}

#if defined(ONLY_P5)
__global__ void __launch_bounds__(NTHR, 2) only_p5(Args A_unused) {
    extern __shared__ __attribute__((aligned(16))) unsigned char lds_raw[];
    const CAS Args& A = *(const CAS Args*)__builtin_amdgcn_kernarg_segment_ptr();
    Frame F; F.lds = (LAS unsigned char*)lds_raw; F.wave = __builtin_amdgcn_readfirstlane((int)threadIdx.x >> 6); F.tid = opq_tid(F.wave); F.lane = F.tid & 63;
    F.wg = blockIdx.x; F.G = gridDim.x; F.gw = F.wg * NWAVES + F.wave; F.NGW = F.G * NWAVES;
    unsigned char* ws = A.ws; bf16* const dob = (bf16*)A.out;
    bf16 *R = dob, *KS = dob + (size_t)NTOK * BW, *V = dob + 2 * (size_t)NTOK * BW, *KK = dob + 3 * (size_t)NTOK * BW;
    p5_mfma(ws, F, R, KS, V, KK, (const bf16*)(ws + WS_B), (const bf16*)(ws + WS_E), (bf16*)(ws + WS_P), (bf16*)(ws + WS_QO), (bf16*)(ws + WS_GT), (bf16*)(ws + WS_HT));
}
#endif
```

```cpp
#include <hip/hip_runtime.h>
#include <cstdio>
#include <cstdint>
__device__ __forceinline__ int opq_tid(int wave) { int l; asm volatile("v_mbcnt_lo_u32_b32 %0, -1, 0\n\tv_mbcnt_hi_u32_b32 %0, -1, %0" : "=v"(l)); return wave * 64 + l; }
#ifndef PHMASK
#define PHMASK 0xffff
#endif
namespace pg8 {
#define PG8_LAS __attribute__((address_space(3)))
typedef unsigned short bf16_t;
typedef short bf16x8 __attribute__((ext_vector_type(8)));
typedef float f32x4 __attribute__((ext_vector_type(4)));
typedef unsigned u32x4 __attribute__((ext_vector_type(4)));
constexpr int BM = 256, BK = 64, HALF = 128, HTB = HALF * BK * 2  , STAGE_BYTES = 8 * HTB, NXCD = 8, WGM = 8;

__host__ __device__ __forceinline__ int lds_byte(int r, int c) { const int st = (r >> 4) * 2 + (c >> 5), rr = r & 15, cc = c & 31, ob = rr * 64 + cc * 2; return st * 1024 + (ob ^ (((ob >> 9) & 1) << 5)); }
__host__ __device__ __forceinline__ void stage_rc(int b, int& R, int& C) { const int st = b / 1024, sb = b % 1024, swz = sb ^ (((sb >> 9) & 1) << 5); R = (st >> 1) * 16 + swz / 64; C = (st & 1) * 32 + (swz % 64) / 2; }
__host__ __device__ __forceinline__ int perm32(int rho) { const int n = rho >> 4, i = rho & 15; return 8 * (i >> 2) + 4 * n + (i & 3); }

struct Unit { int pm, pn; };
struct Gemm { const bf16_t* A; const bf16_t* Bt; int M, N, K; };

struct StaticOrder {
    int nM, nN, nwg, G, c;
    __host__ __device__ void init(int M, int N, int G_, int c_) { nM = M / BM; nN = N / BM; nwg = nM * nN; G = G_; c = c_; }
    __host__ __device__ bool next(int i, Unit& u) const {
        const long L = (long)i * G + c; if (L >= nwg) return false;
        int wgid = (int)L; { const int q = nwg / NXCD, r = nwg % NXCD, xcd = wgid % NXCD, off = wgid / NXCD; wgid = (xcd < r ? xcd * (q + 1) : r * (q + 1) + (xcd - r) * q) + off; }
        const int nig = WGM * nN, gid = wgid / nig, fm = gid * WGM, gsz = (nM - fm) < WGM ? (nM - fm) : WGM;
        u.pm = fm + ((wgid % nig) % gsz); u.pn = (wgid % nig) / gsz; return true;
    }
    __device__ __forceinline__ void a_ready(const Unit&) const {}
    __device__ __forceinline__ void done(const Unit&) const {}
};

template <class Epi, class Sched, bool STAMP = false>
__device__ __forceinline__ void gemm_phase(PG8_LAS unsigned char* lds, const Gemm g, const Sched& S, const Epi& E, unsigned long long* stamps, int wave_id) {
    const int tid = opq_tid(wave_id), wid = __builtin_amdgcn_readfirstlane(tid >> 6), lane = tid & 63, wr = wid >> 2, wc = wid & 3, fr = lane & 15, fq = lane >> 4;
    const int K = g.K, nt = K / BK;
    int ts_lo = 0, ts_hi = 0, nts = 0; const unsigned long long rt_entry = STAMP ? (unsigned long long)wall_clock64() : 0ull;
#define PG8_STAMP() do { if (STAMP && wid == 0 && nts < 64) { const unsigned long long _c = (unsigned long long)clock64(); \
        ts_lo = (lane == nts) ? (int)(unsigned)_c : ts_lo; ts_hi = (lane == nts) ? (int)(unsigned)(_c >> 32) : ts_hi; ++nts; } } while (0)
    PG8_STAMP();
    unsigned voffA[2], voffB[2];
#pragma unroll
    for (int i = 0; i < 2; ++i) { int R, C; stage_rc(tid * 16 + i * 8192, R, C); const int Rb = Epi::PERM ? ((R & ~31) + perm32(R & 31)) : R;
        voffA[i] = (unsigned)(R * K + C) * 2u; voffB[i] = (unsigned)(Rb * K + C) * 2u; }
    const size_t kstep = (size_t)(BK * 2);
    const size_t hstep = (size_t)HALF * K * 2;
    const size_t tstep = 2 * hstep;
    const unsigned ldsw = (unsigned)wid * 1024u;
    const int aoff = lds_byte(wr * 64 + fr, fq * 8), boff = lds_byte(wc * 32 + fr, fq * 8);
#define PG8_SA(b, h) (((b) * 2 + (h)) * HTB)
#define PG8_SB(b, h) ((4 + (b) * 2 + (h)) * HTB)
#define PG8_STAGE(bufoff, gbase, voff) do { _Pragma("unroll") for (int _i = 0; _i < 2; ++_i) \
        __builtin_amdgcn_global_load_lds((const unsigned*)((const char*)(gbase) + (voff)[_i]), (PG8_LAS unsigned*)(lds + (bufoff) + ldsw + _i * 8192), 16, 0, 0); } while (0)
#define PG8_LDA(dst, b, h) do { _Pragma("unroll") for (int m = 0; m < 4; ++m) _Pragma("unroll") for (int k = 0; k < 2; ++k) dst[m][k] = *(const PG8_LAS bf16x8*)(lds + PG8_SA(b, h) + aoff + m * 2048 + k * 1024); } while (0)
#define PG8_LDB(dst, b, h) do { _Pragma("unroll") for (int n = 0; n < 2; ++n) _Pragma("unroll") for (int k = 0; k < 2; ++k) dst[n][k] = *(const PG8_LAS bf16x8*)(lds + PG8_SB(b, h) + boff + n * 2048 + k * 1024); } while (0)
#define PG8_MMA(ai, bj, At, Bt) do { __builtin_amdgcn_s_setprio(1); _Pragma("unroll") for (int m = 0; m < 4; ++m) _Pragma("unroll") for (int n = 0; n < 2; ++n) _Pragma("unroll") for (int k = 0; k < 2; ++k) \
        acc[ai][bj][m][n] = __builtin_amdgcn_mfma_f32_16x16x32_bf16(Bt[n][k], At[m][k], acc[ai][bj][m][n], 0, 0, 0); __builtin_amdgcn_s_setprio(0); } while (0)
#define PG8_WAIT_V(n) asm volatile("s_waitcnt vmcnt(" #n ")" ::: "memory")
#define PG8_WAIT_L(n) asm volatile("s_waitcnt lgkmcnt(" #n ")" ::: "memory")
#define PG8_BAR __builtin_amdgcn_s_barrier()
#define PG8_SCHED __builtin_amdgcn_sched_barrier(0)
    Unit cur, nxt; int ui = 0;
    if (!S.next(0, cur)) return;
    f32x4 acc[2][2][4][2];
#pragma unroll
    for (int a = 0; a < 2; ++a)
#pragma unroll
        for (int b = 0; b < 2; ++b)
#pragma unroll
            for (int m = 0; m < 4; ++m)
#pragma unroll
                for (int n = 0; n < 2; ++n) acc[a][b][m][n] = (f32x4){0.f, 0.f, 0.f, 0.f};
    bf16x8 At[4][2], B0[2][2], B1[2][2];
    const char* cA = (const char*)g.A + (size_t)cur.pm * tstep; const char* cB = (const char*)g.Bt + (size_t)cur.pn * tstep;
    S.a_ready(cur);
    PG8_STAGE(PG8_SB(0, 0), cB, voffB); PG8_STAGE(PG8_SA(0, 0), cA, voffA); PG8_STAGE(PG8_SB(0, 1), cB + hstep, voffB); PG8_STAGE(PG8_SA(0, 1), cA + hstep, voffA);
    if (wr == 1) PG8_BAR;
    PG8_WAIT_V(4); PG8_BAR;
    PG8_STAGE(PG8_SB(1, 0), cB + kstep, voffB); PG8_STAGE(PG8_SA(1, 0), cA + kstep, voffA); PG8_STAGE(PG8_SB(1, 1), cB + hstep + kstep, voffB);
    PG8_WAIT_V(6); PG8_BAR;
    PG8_STAMP();
    for (;;) {
        const bool has_next = S.next(ui + 1, nxt);
        const char* nA = has_next ? (const char*)g.A + (size_t)nxt.pm * tstep : cA; const char* nB = has_next ? (const char*)g.Bt + (size_t)nxt.pn * tstep : cB;
        for (int t = 0; t < nt; t += 2) {
            const bool last = (t == nt - 2);
            const char* a1 = cA + (size_t)(t + 1) * kstep;
            const char* a2 = last ? nA : cA + (size_t)(t + 2) * kstep; const char* b2 = last ? nB : cB + (size_t)(t + 2) * kstep;
            const char* a3 = a2 + kstep; const char* b3 = b2 + kstep;
            if (last && has_next) S.a_ready(nxt);
            PG8_LDB(B0, 0, 0); PG8_SCHED; PG8_LDA(At, 0, 0); PG8_STAGE(PG8_SA(1, 1), a1 + hstep, voffA);
            PG8_WAIT_L(8); PG8_BAR; PG8_WAIT_L(0); PG8_MMA(0, 0, At, B0); PG8_BAR; PG8_SCHED;
            PG8_LDB(B1, 0, 1); PG8_STAGE(PG8_SB(0, 0), b2, voffB);
            PG8_BAR; PG8_WAIT_L(0); PG8_MMA(0, 1, At, B1); PG8_BAR;
            PG8_LDA(At, 0, 1); PG8_STAGE(PG8_SA(0, 0), a2, voffA);
            PG8_BAR; PG8_WAIT_L(0); PG8_MMA(1, 0, At, B0); PG8_BAR; PG8_SCHED;
            PG8_STAGE(PG8_SB(0, 1), b2 + hstep, voffB);
            PG8_WAIT_V(6); PG8_BAR; PG8_MMA(1, 1, At, B1); PG8_BAR;
            PG8_LDB(B0, 1, 0); PG8_SCHED; PG8_LDA(At, 1, 0); PG8_STAGE(PG8_SA(0, 1), a2 + hstep, voffA);
            PG8_WAIT_L(8); PG8_BAR; PG8_WAIT_L(0); PG8_MMA(0, 0, At, B0); PG8_BAR; PG8_SCHED;
            PG8_LDB(B1, 1, 1); PG8_STAGE(PG8_SB(1, 0), b3, voffB);
            PG8_BAR; PG8_WAIT_L(0); PG8_MMA(0, 1, At, B1); PG8_BAR;
            PG8_LDA(At, 1, 1); PG8_STAGE(PG8_SA(1, 0), a3, voffA);
            PG8_BAR; PG8_WAIT_L(0); PG8_MMA(1, 0, At, B0); PG8_BAR; PG8_SCHED;
            PG8_STAGE(PG8_SB(1, 1), b3 + hstep, voffB);
            PG8_WAIT_V(6); PG8_BAR; PG8_MMA(1, 1, At, B1); PG8_BAR;
        }
        PG8_STAMP();
        if constexpr (!Epi::AFTER_DRAIN) { E(acc, cur, wr, wc, fr, fq); S.done(cur); }
        PG8_STAMP();
        if (!has_next) break;
#pragma unroll
        for (int a = 0; a < 2; ++a)
#pragma unroll
            for (int b = 0; b < 2; ++b)
#pragma unroll
                for (int m = 0; m < 4; ++m)
#pragma unroll
                    for (int n = 0; n < 2; ++n) acc[a][b][m][n] = (f32x4){0.f, 0.f, 0.f, 0.f};
        cur = nxt; cA = nA; cB = nB; ++ui;
    }
    PG8_WAIT_V(0);
    if (wr == 0) PG8_BAR;
    PG8_BAR;
    if constexpr (Epi::AFTER_DRAIN) { E.fused(acc, cur, wr, wc, fr, fq, lds, wid, lane); S.done(cur); }
    PG8_STAMP();
    if (STAMP && wid == 0) { stamps[lane] = lane < nts ? (((unsigned long long)(unsigned)ts_hi << 32) | (unsigned)ts_lo) : 0ull;
        if (lane == 62) stamps[62] = rt_entry; if (lane == 63) stamps[63] = (unsigned long long)wall_clock64(); }
#undef PG8_STAMP
#undef PG8_SA
#undef PG8_SB
#undef PG8_STAGE
#undef PG8_LDA
#undef PG8_LDB
#undef PG8_MMA
#undef PG8_WAIT_V
#undef PG8_WAIT_L
#undef PG8_BAR
#undef PG8_SCHED
}
}

#define XB_TMO      128
#define XB_XCNT(j)  (256  + 64 * (j))
#define XB_XSUB(j)  (1280 + 64 * (j))
#define XB_XGEN(j)  (2304 + 64 * (j))
#define XB_TOP      3328
#define XB_TOPGEN   3392
#define XCD_BAR_WORDS 3456
#define XB_SPIN_CAP (1u << 18)
#define LAS __attribute__((address_space(3)))

__device__ __forceinline__ unsigned xb_ld(unsigned* p)              { return __hip_atomic_load(p, __ATOMIC_RELAXED, __HIP_MEMORY_SCOPE_AGENT); }
__device__ __forceinline__ unsigned xb_add(unsigned* p, unsigned v) { return __hip_atomic_fetch_add(p, v, __ATOMIC_RELAXED, __HIP_MEMORY_SCOPE_AGENT); }
__device__ __forceinline__ unsigned xb_xcc_id() { return (unsigned)__builtin_amdgcn_s_getreg((3 << 11) | 20) & 0xFu; }
#define XB_SPIN(cond, bar) do { unsigned _sp = 0; while (cond) { __builtin_amdgcn_s_sleep(1); \
    if ((++_sp & 255u) == 0u) { if (xb_ld(&(bar)[XB_TMO])) break; if (_sp > XB_SPIN_CAP) { atomicAdd(&(bar)[XB_TMO], 1u); break; } } } } while (0)

struct XcdBarrier {
    unsigned* bar; unsigned x; int wave;
    volatile LAS unsigned* st;
};

__device__ __forceinline__ bool xb_lane0() { return __builtin_amdgcn_mbcnt_hi(~0u, __builtin_amdgcn_mbcnt_lo(~0u, 0u)) == 0u; }
__device__ __forceinline__ bool xb_t0(int wave) { return wave == 0 && __builtin_amdgcn_mbcnt_hi(~0u, __builtin_amdgcn_mbcnt_lo(~0u, 0u)) == 0u; }
__device__ __forceinline__ XcdBarrier xcd_barrier_post(unsigned* bar, volatile LAS unsigned* st, int wave) {
    XcdBarrier b; b.bar = bar; b.x = xb_xcc_id(); b.st = st; b.wave = wave;
    if (xb_t0(wave)) (void)xb_add(&bar[XB_XCNT(b.x)], 1u);
    return b;
}
__device__ __forceinline__ void xcd_barrier_complete(unsigned* bar, unsigned x, unsigned& nloc, unsigned& nx) {
    const unsigned G = gridDim.x * gridDim.y * gridDim.z;
    unsigned sum, cnt, mine, sp = 0u;
    for (;;) {
        sum = 0u; cnt = 0u; mine = 0u;
#pragma unroll
        for (unsigned j = 0; j < 16; ++j) { const unsigned c = xb_ld(&bar[XB_XCNT(j)]); sum += c; cnt += (c > 0u) ? 1u : 0u; mine = (j == x) ? c : mine; }
        if (sum == G) break;
        __builtin_amdgcn_s_sleep(1);
        if ((++sp & 255u) == 0u) { if (xb_ld(&bar[XB_TMO])) break; if (sp > XB_SPIN_CAP) { atomicAdd(&bar[XB_TMO], 1u); break; } }
    }
    nloc = mine > 0u ? mine : 1u; nx = cnt > 0u ? cnt : 1u;
}

__device__ __forceinline__ void xcd_barrier(const XcdBarrier& b) {
    asm volatile("s_waitcnt vmcnt(0)" ::: "memory");
    __syncthreads();
    if (xb_t0(b.wave)) {
        unsigned* bar = b.bar;
        __builtin_amdgcn_s_waitcnt(0);
        unsigned nloc = b.st[0], nx = b.st[1];
        if (nloc == 0u) { xcd_barrier_complete(bar, b.x, nloc, nx); b.st[0] = nloc; b.st[1] = nx; }
        const unsigned old = xb_add(&bar[XB_XSUB(b.x)], 1u);
        const unsigned gen = old / nloc;
        if (old + 1u == (gen + 1u) * nloc) {
            __builtin_amdgcn_fence(__ATOMIC_RELEASE, "agent");
            asm volatile("s_waitcnt vmcnt(0)" ::: "memory");
            const unsigned og = xb_add(&bar[XB_TOP], 1u);
            const unsigned tg = og / nx;
            if (og + 1u == (tg + 1u) * nx) xb_add(&bar[XB_TOPGEN], 1u);
            else XB_SPIN(xb_ld(&bar[XB_TOPGEN]) == tg, bar);
            __builtin_amdgcn_fence(__ATOMIC_ACQUIRE, "agent");
            xb_add(&bar[XB_XGEN(b.x)], 1u);
            asm volatile("s_waitcnt vmcnt(0)" ::: "memory");
        } else {
            XB_SPIN(xb_ld(&bar[XB_XGEN(b.x)]) == gen, bar);
            __builtin_amdgcn_fence(__ATOMIC_ACQUIRE, "agent");
            asm volatile("s_waitcnt vmcnt(0)" ::: "memory");
        }
    }
    __syncthreads();
}


constexpr int NB = 4, SEQ = 8192, D = 1024, NTOK = NB * SEQ;
constexpr int NH = 8, HD = 64, BW = 512;
constexpr int IN_COLS = 5408, NPAD = 5632;
constexpr int LK = 384;
constexpr int NE = 32, DE = 512;
constexpr int CH = 64, NCH = SEQ / CH, NCH_LOG = 7, NCHUNK = NB * NH * NCH;
constexpr int MAXT = 288;
constexpr float NORM_EPS = 1e-6f, GN_EPS = 64e-5f, L2_EPS = 1e-12f;
constexpr float SB_STOP = -104.5f;

constexpr size_t MiB = 1u << 20;
constexpr size_t WS_CTL = 0, CTL_ZERO_BYTES = 65536;
constexpr size_t WS_MOD = 1 * MiB;
constexpr size_t WS_RTW = WS_MOD + 128 * 1024;
constexpr size_t WS_TOK = WS_RTW + 160 * 1024;
constexpr size_t WS_CNT = WS_TOK + (size_t)NTOK * 16;
constexpr size_t WS_TILE = WS_CNT + 256 * 32 * 4;
constexpr size_t WS_WIN = 2 * MiB;
constexpr size_t WS_WOSB = 13 * MiB, WS_WORW = 14 * MiB, WS_WOUT = 15 * MiB;
constexpr size_t WS_WL = 17 * MiB;
constexpr size_t WS_BON = 18 * MiB + 256 * 1024;
constexpr size_t WS_CW = 19 * MiB + 768 * 1024;
constexpr size_t WS_QB = 20 * MiB;
constexpr size_t WS_GATE = 52 * MiB;
constexpr size_t WS_GG = 180 * MiB;
constexpr size_t WS_KB = 212 * MiB, WS_VT = 244 * MiB;
constexpr size_t WS_LORA = 276 * MiB;
constexpr size_t WS_ALORA = 308 * MiB;
constexpr size_t WS_E = 340 * MiB, WS_B = 372 * MiB;
constexpr size_t WS_RWRAW = 416 * MiB;
constexpr size_t WS_P = 212 * MiB, WS_QO = 244 * MiB;
constexpr size_t WS_GT = 276 * MiB;
constexpr size_t WS_HT = 308 * MiB;
constexpr size_t WS_SC = 340 * MiB;
constexpr size_t WS_YRW = 384 * MiB;
constexpr size_t WS_WUP = 416 * MiB, WS_WDN = 480 * MiB;
constexpr size_t WS_MRG = 212 * MiB;
constexpr size_t WS_Y1 = 276 * MiB;
constexpr size_t WS_H2 = 52 * MiB;
constexpr size_t WS_HS = 116 * MiB;
constexpr size_t WS_HID = 260 * MiB;
constexpr size_t WS_X1 = 340 * MiB;
constexpr size_t WS_END = 512 * MiB;
static_assert(WS_TILE + (MAXT + 1) * 4 <= WS_WIN && WS_WIN + (size_t)NPAD * D * 2 <= WS_WOSB && WS_WL + 1536 * LK * 2 <= WS_QB, "fixed region");
static_assert(WS_HS + (size_t)MAXT * 256 * D * 2 <= WS_HID && WS_HID + (size_t)MAXT * 256 * DE * 2 <= WS_WUP, "moe region");
static_assert(WS_ALORA + (size_t)NTOK * LK * 2 <= WS_E && WS_B + (size_t)NTOK * BW * 2 <= WS_RWRAW, "rwkv region");

constexpr int LDS_BYTES = 163840;
constexpr int LDS_MISC = LDS_BYTES - 256;
constexpr int NWAVES = 8, NTHR = 512;

typedef unsigned short bf16;
typedef short bf16x8 __attribute__((ext_vector_type(8)));
typedef short s16x4 __attribute__((ext_vector_type(4)));
typedef float f32x4 __attribute__((ext_vector_type(4)));
typedef float f32x16 __attribute__((ext_vector_type(16)));
typedef unsigned u32x4 __attribute__((ext_vector_type(4)));
typedef unsigned u32x2 __attribute__((ext_vector_type(2)));
typedef int i32x4 __attribute__((ext_vector_type(4)));
#define DI __device__ __forceinline__
#define GAS __attribute__((address_space(1)))
#define MFMA32(a, b, c) __builtin_amdgcn_mfma_f32_32x32x16_bf16((a), (b), (c), 0, 0, 0)

typedef float f32x2_t __attribute__((ext_vector_type(2))); typedef __bf16 bf16x2_t __attribute__((ext_vector_type(2)));
DI unsigned pk2(float lo, float hi) { f32x2_t v = {lo, hi}; return __builtin_bit_cast(unsigned, __builtin_convertvector(v, bf16x2_t)); }
DI unsigned f2bf(float f) { return pk2(f, 0.0f) & 0xffffu; }
DI float bflo(unsigned u) { return __builtin_bit_cast(float, u << 16); }
DI float bfhi(unsigned u) { return __builtin_bit_cast(float, u & 0xffff0000u); }
DI float bf2f(bf16 h) { return __builtin_bit_cast(float, (unsigned)h << 16); }
DI float fexp(float x) { return __expf(x); }
DI float frcp(float x) { return __builtin_amdgcn_rcpf(x); }
DI float fsigmoid(float x) { return frcp(1.0f + fexp(-x)); }
DI float fsoftplus(float x) { return fmaxf(x, 0.0f) + __logf(1.0f + fexp(-fabsf(x))); }
#define DPP_SHR(v, ctrl) __builtin_bit_cast(float, __builtin_amdgcn_update_dpp(0, __builtin_bit_cast(int, (v)), (ctrl), 0xf, 0xf, true))
DI float wave_sum(float v) {
    v += DPP_SHR(v, 0x111); v += DPP_SHR(v, 0x112); v += DPP_SHR(v, 0x114); v += DPP_SHR(v, 0x118);
    v += __builtin_bit_cast(float, __builtin_amdgcn_update_dpp(0, __builtin_bit_cast(int, v), 0x142, 0xa, 0xf, false));
    v += __builtin_bit_cast(float, __builtin_amdgcn_update_dpp(0, __builtin_bit_cast(int, v), 0x143, 0xc, 0xf, false));
    return __builtin_bit_cast(float, __builtin_amdgcn_readlane(__builtin_bit_cast(int, v), 63));
}
DI float shfl_xor_l(float v, int m, int lane) { return __builtin_bit_cast(float, __builtin_amdgcn_ds_bpermute(4 * (lane ^ m), __builtin_bit_cast(int, v))); }
DI int crow(int reg, int hh) { return (reg & 3) + 8 * (reg >> 2) + 4 * hh; }
DI void wave_lds_fence() { __builtin_amdgcn_fence(__ATOMIC_RELEASE, "wavefront"); __builtin_amdgcn_wave_barrier(); __builtin_amdgcn_fence(__ATOMIC_ACQUIRE, "wavefront"); }
DI void unpack8(const u32x4 v, float (&o)[8]) { o[0] = bflo(v.x); o[1] = bfhi(v.x); o[2] = bflo(v.y); o[3] = bfhi(v.y); o[4] = bflo(v.z); o[5] = bfhi(v.z); o[6] = bflo(v.w); o[7] = bfhi(v.w); }
DI u32x4 pack8(const float (&o)[8]) { u32x4 v; v.x = pk2(o[0], o[1]); v.y = pk2(o[2], o[3]); v.z = pk2(o[4], o[5]); v.w = pk2(o[6], o[7]); return v; }
DI bf16x8 pack8v(float a0, float a1, float a2, float a3, float a4, float a5, float a6, float a7) {
    u32x4 v; v.x = pk2(a0, a1); v.y = pk2(a2, a3); v.z = pk2(a4, a5); v.w = pk2(a6, a7); return __builtin_bit_cast(bf16x8, v); }


#if defined(CHECKS)
constexpr int DBG_TOKEN = 77;
#endif

typedef pg8::f32x4 af4;
DI void st8(bf16* p, const af4 v0, const af4 v1) { u32x4 w; w.x = pk2(v0[0], v0[1]); w.y = pk2(v0[2], v0[3]); w.z = pk2(v1[0], v1[1]); w.w = pk2(v1[2], v1[3]); *(u32x4*)p = w; }

struct EpiIn {
    static constexpr bool PERM = true, AFTER_DRAIN = false;
    bf16 *Q, *K, *Vt, *RW, *LO, *GA; const float* gate_bias;
    DI void operator()(const af4 (&acc)[2][2][4][2], const pg8::Unit& u, int wr, int wc, int fr, int fq) const {
        const int pn = u.pn, row0 = u.pm * 256 + wr * 64 + fr;
        if (pn == 4 || pn == 5) {
#pragma unroll
            for (int ai = 0; ai < 2; ++ai)
#pragma unroll
                for (int m = 0; m < 4; ++m) { const int row = row0 + ai * 128 + m * 16, b = row >> 13, s = row & (SEQ - 1);
#pragma unroll
                    for (int bj = 0; bj < 2; ++bj)
#pragma unroll
                        for (int n = 0; n < 2; ++n)
#pragma unroll
                            for (int j = 0; j < 4; ++j) { const int cv = (pn - 4) * 256 + bj * 128 + wc * 32 + 8 * fq + 4 * n + j;
                                Vt[((size_t)(b * BW + cv)) * SEQ + s] = (bf16)f2bf(acc[ai][bj][m][n][j]); } }
        } else if (pn >= 14) {
            const int col0 = (pn - 14) * 256 + wc * 32 + 8 * fq;
            af4 bv[2][2];
#pragma unroll
            for (int bj = 0; bj < 2; ++bj)
#pragma unroll
                for (int n = 0; n < 2; ++n) bv[bj][n] = *(const af4*)(gate_bias + col0 + bj * 128 + 4 * n);
#pragma unroll
            for (int ai = 0; ai < 2; ++ai)
#pragma unroll
                for (int m = 0; m < 4; ++m) { bf16* rowp = GA + (size_t)(row0 + ai * 128 + m * 16) * 2048 + col0;
#pragma unroll
                    for (int bj = 0; bj < 2; ++bj) { af4 v0 = acc[ai][bj][m][0] + bv[bj][0], v1 = acc[ai][bj][m][1] + bv[bj][1];
#pragma unroll
                        for (int j = 0; j < 4; ++j) { v0[j] = fsigmoid(v0[j]); v1[j] = fsigmoid(v1[j]); }
                        st8(rowp + bj * 128, v0, v1); } }
        } else {
            bf16* base; int ld, ct; float sc = 1.0f;
            if (pn < 2) { base = Q; ld = BW; ct = pn; sc = 0.125f; } else if (pn < 4) { base = K; ld = BW; ct = pn - 2; } else if (pn < 12) { base = RW; ld = 1536; ct = pn - 6; } else { base = LO; ld = BW; ct = pn - 12; }
            const int col0 = ct * 256 + wc * 32 + 8 * fq;
#pragma unroll
            for (int ai = 0; ai < 2; ++ai)
#pragma unroll
                for (int m = 0; m < 4; ++m) { bf16* rowp = base + (size_t)(row0 + ai * 128 + m * 16) * ld + col0;
#pragma unroll
                    for (int bj = 0; bj < 2; ++bj) st8(rowp + bj * 128, acc[ai][bj][m][0] * sc, acc[ai][bj][m][1] * sc); }
        }
    }
};

template <bool ADD> struct EpiMerge {
    static constexpr bool PERM = true, AFTER_DRAIN = false;
    bf16* GA; bf16* MRG; int gofs;
    DI void operator()(const af4 (&acc)[2][2][4][2], const pg8::Unit& u, int wr, int wc, int fr, int fq) const {
        const int row0 = u.pm * 256 + wr * 64 + fr, col0 = u.pn * 256 + wc * 32 + 8 * fq;
#pragma unroll
        for (int ai = 0; ai < 2; ++ai)
#pragma unroll
            for (int m = 0; m < 4; ++m) { const size_t row = (size_t)(row0 + ai * 128 + m * 16);
#pragma unroll
                for (int bj = 0; bj < 2; ++bj) { const int c = col0 + bj * 128;
                    float g[8]; unpack8(*(const u32x4*)(GA + row * 2048 + gofs + c), g);
                    af4 v0, v1;
#pragma unroll
                    for (int j = 0; j < 4; ++j) { v0[j] = g[j] * acc[ai][bj][m][0][j]; v1[j] = g[4 + j] * acc[ai][bj][m][1][j]; }
                    if (ADD) { float o[8]; unpack8(*(const u32x4*)(GA + row * 2048 + c), o);
#pragma unroll
                        for (int j = 0; j < 4; ++j) { v0[j] += o[j]; v1[j] += o[4 + j]; }
                        st8(MRG + row * D + c, v0, v1); }
                    else st8(GA + row * 2048 + c, v0, v1); } }
    }
};

struct EpiPlain {
    static constexpr bool PERM = true, AFTER_DRAIN = false;
    bf16* O; int ld, cmask;
    DI void operator()(const af4 (&acc)[2][2][4][2], const pg8::Unit& u, int wr, int wc, int fr, int fq) const {
        const int row0 = u.pm * 256 + wr * 64 + fr, col0 = (u.pn & cmask) * 256 + wc * 32 + 8 * fq;
#pragma unroll
        for (int ai = 0; ai < 2; ++ai)
#pragma unroll
            for (int m = 0; m < 4; ++m) { bf16* rowp = O + (size_t)(row0 + ai * 128 + m * 16) * ld + col0;
#pragma unroll
                for (int bj = 0; bj < 2; ++bj) st8(rowp + bj * 128, acc[ai][bj][m][0], acc[ai][bj][m][1]); }
    }
};

struct EpiUp {
    static constexpr bool PERM = true, AFTER_DRAIN = false;
    bf16* HID;
    DI void operator()(const af4 (&acc)[2][2][4][2], const pg8::Unit& u, int wr, int wc, int fr, int fq) const {
        const int row0 = u.pm * 256 + wr * 64 + fr, col0 = (u.pn & 3) * 128 + wc * 16 + 4 * fq;
#pragma unroll
        for (int ai = 0; ai < 2; ++ai)
#pragma unroll
            for (int m = 0; m < 4; ++m) { bf16* rowp = HID + (size_t)(row0 + ai * 128 + m * 16) * DE + col0;
#pragma unroll
                for (int bj = 0; bj < 2; ++bj) { float h[4];
#pragma unroll
                    for (int j = 0; j < 4; ++j) { const float u1 = acc[ai][bj][m][0][j]; h[j] = u1 * fsigmoid(u1) * acc[ai][bj][m][1][j]; }
                    __hip_atomic_store((GAS unsigned long long*)(rowp + bj * 64), (unsigned long long)pk2(h[0], h[1]) | ((unsigned long long)pk2(h[2], h[3]) << 32), __ATOMIC_RELAXED, __HIP_MEMORY_SCOPE_AGENT); } }
    }
};

constexpr unsigned MOE_CNT_WORD = 3584, MOE_CNT_STRIDE = 16;
struct MoeUpOrder {
    int nunits, G, vc; const int* tile_e; unsigned* cnt;
    DI bool next(int i, pg8::Unit& u) const { const long L = (long)i * G + vc; if (L >= nunits) return false; const int rt = (int)(L >> 2);
        u.pm = rt; u.pn = __builtin_amdgcn_readfirstlane(tile_e[rt]) * 4 + (int)(L & 3); return true; }
    DI void a_ready(const pg8::Unit&) const {}
    DI void done(const pg8::Unit& u) const { asm volatile("s_waitcnt vmcnt(0)" ::: "memory");
        if (__builtin_amdgcn_mbcnt_hi(~0u, __builtin_amdgcn_mbcnt_lo(~0u, 0u)) == 0u) __hip_atomic_fetch_add(cnt + MOE_CNT_STRIDE * u.pm, 1u, __ATOMIC_RELAXED, __HIP_MEMORY_SCOPE_AGENT); }
};
struct MoeDnOrder {
    int nunits, G, vc, q, rem, wave; const int* tile_e; unsigned* cnt;
    DI bool next(int i, pg8::Unit& u) const { long L;
        if (vc >= rem) { if (i > q) return false; L = (long)i * (G - rem) + (vc - rem); } else L = (long)(q + 1) * (G - rem) + (long)i * rem + vc;
        if (L >= nunits) return false; const int rt = (int)(L >> 2);
        u.pm = rt; u.pn = __builtin_amdgcn_readfirstlane(tile_e[rt]) * 4 + (int)(L & 3); return true; }
    DI void a_ready(const pg8::Unit& u) const {
        if (wave == 0) { unsigned sp = 0;
            while ((unsigned)__builtin_amdgcn_readfirstlane(__hip_atomic_load(cnt + MOE_CNT_STRIDE * u.pm, __ATOMIC_RELAXED, __HIP_MEMORY_SCOPE_AGENT)) < 32u) { __builtin_amdgcn_s_sleep(2); if (++sp > (1u << 22)) break; }
            __builtin_amdgcn_fence(__ATOMIC_ACQUIRE, "agent");
            asm volatile("s_waitcnt vmcnt(0)" ::: "memory"); }
        asm volatile("" ::: "memory"); __builtin_amdgcn_s_barrier(); asm volatile("" ::: "memory"); }
    DI void done(const pg8::Unit&) const {}
};

struct Args {
    const float *x, *c, *w_mod, *b_mod, *gains, *w_in, *gate_bias, *shift_mu, *w0, *w_decay_up, *a0, *w_iclr_up, *w_gate_up, *k_k, *k_a, *r_k, *lnx_w, *lnx_b,
                *w_o_sb, *w_o_rw, *w_out, *w_group, *w_router, *w_up1, *w_up3, *w_down;
    float* out; unsigned char* ws;
};
struct Frame { LAS unsigned char* lds; int tid, lane, wave, wg, G, gw, NGW; };
#define CAS __attribute__((address_space(4)))
#if defined(TIMEPHASE)
#ifndef TIMEPHASE_END
#define TIMEPHASE_END (TIMEPHASE + 1)
#endif
DI void tp_stamp(LAS unsigned char* lds, int wave, int k) {
    if (k == TIMEPHASE || k == TIMEPHASE_END) { volatile LAS unsigned long long* tp_ = (volatile LAS unsigned long long*)(lds + LDS_MISC + 64);
        if (xb_t0(wave)) { const unsigned long long now_ = __builtin_amdgcn_s_memrealtime();
            if (k == TIMEPHASE) *tp_ = now_; else { const unsigned long long until_ = now_ + (now_ - *tp_); while (__builtin_amdgcn_s_memrealtime() < until_) __builtin_amdgcn_s_sleep(8); } }
        if (k == TIMEPHASE_END) __syncthreads(); } }
#define TPS(F, k) tp_stamp((F).lds, (F).wave, (k))
#else
#define TPS(F, k) do { } while (0)
#endif
typedef const CAS Args& ARef;

DI void tr_item(const float* W, int ldw, int K, bf16* WT, int k0, int drow0, int scol0, LAS float* scr, int lane) {
    if (scol0 >= 0) {
        float v[32];
        const float* wp = W + (size_t)(k0 + (lane >> 5)) * ldw + scol0 + (lane & 31);
#pragma unroll
        for (int i = 0; i < 32; ++i) v[i] = wp[(size_t)(2 * i) * ldw];
#pragma unroll
        for (int i = 0; i < 32; ++i) scr[(2 * i + (lane >> 5)) * 33 + (lane & 31)] = v[i];
    } else {
#pragma unroll 8
        for (int i = 0; i < 32; ++i) { const int kk = 2 * i + (lane >> 5); scr[kk * 33 + (lane & 31)] = 0.0f; }
    }
    wave_lds_fence();
    const int c = lane & 7;
#pragma unroll
    for (int j = 0; j < 4; ++j) { const int n = (lane >> 3) + 8 * j; const LAS float* s = scr + (8 * c) * 33 + n;
        u32x4 o; o.x = pk2(s[0 * 33], s[1 * 33]); o.y = pk2(s[2 * 33], s[3 * 33]); o.z = pk2(s[4 * 33], s[5 * 33]); o.w = pk2(s[6 * 33], s[7 * 33]);
        *(u32x4*)(WT + (size_t)(drow0 + n) * K + k0 + 8 * c) = o; }
    wave_lds_fence();
}
DI void tr_item_up(const float* W1, const float* W3, bf16* WT, int e, int k0, int drow0, LAS float* scr, int lane) {
    const int l31 = lane & 31, sc = (drow0 >> 3) * 4 + (l31 >> 3) * 4 + (l31 & 3);
    const float* W = ((l31 & 4) ? W3 : W1) + (size_t)e * D * DE;
    { float v[32]; const float* wp = W + (size_t)(k0 + (lane >> 5)) * DE + sc;
#pragma unroll
        for (int i = 0; i < 32; ++i) v[i] = wp[(size_t)(2 * i) * DE];
#pragma unroll
        for (int i = 0; i < 32; ++i) scr[(2 * i + (lane >> 5)) * 33 + l31] = v[i]; }
    wave_lds_fence();
    const int c = lane & 7;
#pragma unroll
    for (int j = 0; j < 4; ++j) { const int n = (lane >> 3) + 8 * j; const LAS float* s = scr + (8 * c) * 33 + n;
        u32x4 o; o.x = pk2(s[0 * 33], s[1 * 33]); o.y = pk2(s[2 * 33], s[3 * 33]); o.z = pk2(s[4 * 33], s[5 * 33]); o.w = pk2(s[6 * 33], s[7 * 33]);
        *(u32x4*)(WT + ((size_t)e * 1024 + drow0 + n) * D + k0 + 8 * c) = o; }
    wave_lds_fence();
}

DI void p0_prologue(const Frame& F0, ARef A) {
    Frame F = F0; F.tid = opq_tid(F0.wave); F.lane = F.tid & 63; F.wave = __builtin_amdgcn_readfirstlane(F.tid >> 6); F.gw = F.wg * NWAVES + F.wave;
    unsigned char* ws = A.ws;
    TPS(F, 60);
    LAS float* sl = (LAS float*)F.lds;
    LAS float* part = (LAS float*)(F.lds + 16384);
    for (int i = F.tid; i < NB * D; i += NTHR) { const float v = A.c[i]; sl[i] = v * fsigmoid(v); }
    __syncthreads();
    float* mod = (float*)(ws + WS_MOD);
    for (int cg = F.wg; cg < 256; cg += F.G) {
        const int col = F.tid & 31, kg = F.tid >> 5;
        if (col < 24) { float a0 = 0.f, a1 = 0.f, a2 = 0.f, a3 = 0.f;
            float wv[64];
#pragma unroll
            for (int kk = 0; kk < 64; ++kk) wv[kk] = A.w_mod[(size_t)(kg * 64 + kk) * 6144 + cg * 24 + col];
#pragma unroll
            for (int kk = 0; kk < 64; ++kk) { const int k = kg * 64 + kk; const float w = wv[kk];
                a0 += sl[k] * w; a1 += sl[D + k] * w; a2 += sl[2 * D + k] * w; a3 += sl[3 * D + k] * w; }
            LAS float* p = part + (kg * 24 + col) * 4; p[0] = a0; p[1] = a1; p[2] = a2; p[3] = a3; }
        __syncthreads();
        if (F.tid < 96) { const int c = F.tid >> 2, b = F.tid & 3; float s = 0.f;
#pragma unroll
            for (int kg2 = 0; kg2 < 16; ++kg2) s += part[(kg2 * 24 + c) * 4 + b];
            mod[b * 6144 + cg * 24 + c] = s + A.b_mod[cg * 24 + c]; }
        __syncthreads();
    }
    TPS(F, 61);
    LAS float* scr = (LAS float*)(F.lds + 32768 + F.wave * 8704);
    constexpr int I_IN = (NPAD / 32) * (D / 64), I_OS = (D / 32) * (BW / 64), I_OUT = (D / 32) * (D / 64);
    for (int it = F.gw; it < I_IN + 2 * I_OS + I_OUT; it += F.NGW) {
        int r = it;
        if (r < I_IN) { const int g = r / (D / 64), kb = r % (D / 64), drow0 = 32 * g;
            const int sc = drow0 < 3360 ? drow0 : (drow0 < 3584 ? -1 : drow0 - 224);
            tr_item(A.w_in, IN_COLS, D, (bf16*)(ws + WS_WIN), 64 * kb, drow0, sc, scr, F.lane); continue; }
        r -= I_IN;
        if (r < I_OS) { const int g = r / (BW / 64), kb = r % (BW / 64); tr_item(A.w_o_sb, D, BW, (bf16*)(ws + WS_WOSB), 64 * kb, 32 * g, 32 * g, scr, F.lane); continue; }
        r -= I_OS;
        if (r < I_OS) { const int g = r / (BW / 64), kb = r % (BW / 64); tr_item(A.w_o_rw, D, BW, (bf16*)(ws + WS_WORW), 64 * kb, 32 * g, 32 * g, scr, F.lane); continue; }
        r -= I_OS;
        { const int g = r / (D / 64), kb = r % (D / 64); tr_item(A.w_out, D, D, (bf16*)(ws + WS_WOUT), 64 * kb, 32 * g, 32 * g, scr, F.lane); }
    }
    TPS(F, 62);
    const int gt = F.wg * NTHR + F.tid, NGT = F.G * NTHR;
    float* rtw = (float*)(ws + WS_RTW);
    for (int i = gt; i < 36 * D; i += NGT) { const int o = 2 * (i >> 11) + (i & 1), k = (i >> 1) & (D - 1); rtw[i] = o < 4 ? A.w_group[k * 4 + o] : A.w_router[k * NE + (o - 4)]; }
    TPS(F, 64);
    bf16* wl = (bf16*)(ws + WS_WL);
    for (int i0 = gt; i0 < 1536 * LK; i0 += 8 * NGT) { float v[8];
#pragma unroll
        for (int j = 0; j < 8; ++j) { const int i = i0 + j * NGT, n = i / LK, k = i % LK; v[j] = 0.f;
            if (i < 1536 * LK) {
                if (n < 512) { if (k < 64) v[j] = A.w_decay_up[k * BW + n]; }
                else if (n < 1024) { if (k >= 64 && k < 128) v[j] = A.w_iclr_up[(k - 64) * BW + (n - 512)]; }
                else { if (k >= 128 && k < 288) v[j] = A.w_gate_up[(k - 128) * BW + (n - 1024)]; } } }
#pragma unroll
        for (int j = 0; j < 8; ++j) { const int i = i0 + j * NGT; if (i < 1536 * LK) wl[i] = (bf16)f2bf(v[j]); } }
    TPS(F, 63);
}

DI void p1_h1(const Frame& F0, ARef A, bf16* H1) {
    Frame F = F0; F.tid = opq_tid(F0.wave); F.lane = F.tid & 63; F.wave = __builtin_amdgcn_readfirstlane(F.tid >> 6); F.gw = F.wg * NWAVES + F.wave;
    const float* mod = (const float*)(A.ws + WS_MOD);
    f32x4 g[4], sh[4], sc[4], v[4];
#pragma unroll
    for (int j = 0; j < 4; ++j) g[j] = *(const f32x4*)(A.gains + 4 * F.lane + 256 * j);
    int bcur = -1;
    if (F.gw < NTOK) {
#pragma unroll
        for (int j = 0; j < 4; ++j) v[j] = ((const f32x4*)(A.x + (size_t)F.gw * D) + F.lane)[64 * j]; }
    for (int n = F.gw; n < NTOK; n += F.NGW) {
        const int b = n >> 13, nn = n + F.NGW < NTOK ? n + F.NGW : n;
        f32x4 vn[4];
#pragma unroll
        for (int j = 0; j < 4; ++j) vn[j] = ((const f32x4*)(A.x + (size_t)nn * D) + F.lane)[64 * j];
        if (b != bcur) { bcur = b;
#pragma unroll
            for (int j = 0; j < 4; ++j) { const int k = 4 * F.lane + 256 * j; sh[j] = *(const f32x4*)(mod + b * 6144 + k); sc[j] = *(const f32x4*)(mod + b * 6144 + D + k); } }
        float s = 0.f;
#pragma unroll
        for (int j = 0; j < 4; ++j) s += (v[j][0] * v[j][0] + v[j][1] * v[j][1]) + (v[j][2] * v[j][2] + v[j][3] * v[j][3]);
        const float inv = rsqrtf(wave_sum(s) * (1.0f / D) + NORM_EPS);
        u32x2* o = (u32x2*)(H1 + (size_t)n * D) + F.lane;
#pragma unroll
        for (int j = 0; j < 4; ++j) { f32x4 h;
#pragma unroll
            for (int q = 0; q < 4; ++q) h[q] = (v[j][q] * inv) * g[j][q] * (1.0f + sc[j][q]) + sh[j][q];
            u32x2 w; w.x = pk2(h[0], h[1]); w.y = pk2(h[2], h[3]); o[64 * j] = w; }
#pragma unroll
        for (int j = 0; j < 4; ++j) v[j] = vn[j];
    }
}

DI void p3_attn(const Frame& F0, const bf16* QB, const bf16* KB, const bf16* VT, bf16* YSB) {
    Frame F = F0; F.tid = opq_tid(F0.wave); F.lane = F.tid & 63; F.wave = __builtin_amdgcn_readfirstlane(F.tid >> 6); F.gw = F.wg * NWAVES + F.wave;
    const int lane = F.lane, r = lane & 31, hh = lane >> 5;
    bf16x8 tri[2];
#pragma unroll
    for (int s = 0; s < 2; ++s)
#pragma unroll
        for (int e = 0; e < 8; ++e) tri[s][e] = (16 * s + 8 * (e >> 2) + 4 * hh + (e & 3)) > r ? (short)0x3F80 : (short)0;
    for (int u = F.gw; u < NB * NH * (SEQ / 32); u += F.NGW) {
        int qt, b, h;
        if (F.G == 256) { b = u >> 11; h = ((F.wg & 7) + 2 * b) & 7; qt = (F.wg >> 3) * 8 + F.wave; }
        else { qt = u & 255; b = u >> 11; h = ((u >> 8) + 2 * b) & 7; }
        const int bh = b * 8 + h;
        const bf16* qp = QB + (size_t)(b * SEQ + qt * 32 + r) * BW + h * HD + 8 * hh;
        bf16x8 qf[4];
#pragma unroll
        for (int ks = 0; ks < 4; ++ks) qf[ks] = *(const bf16x8*)(qp + 16 * ks);
        f32x16 o0, o1;
#pragma unroll
        for (int i = 0; i < 16; ++i) { o0[i] = 0.f; o1[i] = 0.f; }
        float L = 0.f;
        bf16x8 kf[4]; s16x4 vlo[2][2], vhi[2][2];
#define ATT_LOAD(KT, KF, VLO, VHI) do { const bf16* kp_ = KB + (size_t)(b * SEQ + (KT) * 32 + r) * BW + h * HD + 8 * hh; \
            _Pragma("unroll") for (int ks = 0; ks < 4; ++ks) KF[ks] = *(const bf16x8*)(kp_ + 16 * ks); \
            const bf16* vp_ = VT + ((size_t)(bh * HD + r)) * SEQ + (KT) * 32 + 4 * hh; \
            _Pragma("unroll") for (int mb = 0; mb < 2; ++mb) _Pragma("unroll") for (int ks = 0; ks < 2; ++ks) { VLO[mb][ks] = *(const s16x4*)(vp_ + (size_t)mb * 32 * SEQ + 16 * ks); VHI[mb][ks] = *(const s16x4*)(vp_ + (size_t)mb * 32 * SEQ + 16 * ks + 8); } } while (0)
        ATT_LOAD(qt, kf, vlo, vhi);
        for (int kt = qt; kt >= 0; --kt) {
            bf16x8 kfn[4]; s16x4 vlon[2][2], vhin[2][2];
            { const int ktn = kt > 0 ? kt - 1 : 0; ATT_LOAD(ktn, kfn, vlon, vhin); }
            f32x16 z;
#pragma unroll
            for (int i = 0; i < 16; ++i) z[i] = 0.f;
#pragma unroll
            for (int ks = 0; ks < 4; ++ks) z = MFMA32(kf[ks], qf[ks], z);
            const bool diag = (kt == qt);
            float lk[16], lo[16], tot = 0.f;
#pragma unroll
            for (int i = 0; i < 16; ++i) { const bool valid = !diag || (crow(i, hh) < r);
                const float sp = fsoftplus(z[i]); lk[i] = valid ? -sp : 0.0f; z[i] = valid ? z[i] - sp : -1.0e30f;
                tot += lk[i];
                const float hi = bflo(f2bf(lk[i])); lo[i] = lk[i] - hi; lk[i] = hi; }
            tot += shfl_xor_l(tot, 32, lane);
            f32x16 lat;
#pragma unroll
            for (int i = 0; i < 16; ++i) lat[i] = L;
#pragma unroll
            for (int s = 0; s < 2; ++s) {
                lat = MFMA32(tri[s], pack8v(lk[8 * s], lk[8 * s + 1], lk[8 * s + 2], lk[8 * s + 3], lk[8 * s + 4], lk[8 * s + 5], lk[8 * s + 6], lk[8 * s + 7]), lat);
                lat = MFMA32(tri[s], pack8v(lo[8 * s], lo[8 * s + 1], lo[8 * s + 2], lo[8 * s + 3], lo[8 * s + 4], lo[8 * s + 5], lo[8 * s + 6], lo[8 * s + 7]), lat); }
            float at[16];
#pragma unroll
            for (int i = 0; i < 16; ++i) at[i] = fexp(z[i] + lat[i]);
#pragma unroll
            for (int s = 0; s < 2; ++s) { const bf16x8 ab = pack8v(at[8 * s], at[8 * s + 1], at[8 * s + 2], at[8 * s + 3], at[8 * s + 4], at[8 * s + 5], at[8 * s + 6], at[8 * s + 7]);
                bf16x8 va, vb;
#pragma unroll
                for (int e = 0; e < 4; ++e) { va[e] = vlo[0][s][e]; va[4 + e] = vhi[0][s][e]; vb[e] = vlo[1][s][e]; vb[4 + e] = vhi[1][s][e]; }
                o0 = MFMA32(va, ab, o0); o1 = MFMA32(vb, ab, o1); }
            L += tot;
            if (__all(L < SB_STOP)) break;
#pragma unroll
            for (int ks = 0; ks < 4; ++ks) kf[ks] = kfn[ks];
#pragma unroll
            for (int mb = 0; mb < 2; ++mb)
#pragma unroll
                for (int ks = 0; ks < 2; ++ks) { vlo[mb][ks] = vlon[mb][ks]; vhi[mb][ks] = vhin[mb][ks]; }
        }
#undef ATT_LOAD
        bf16* op = YSB + (size_t)(b * SEQ + qt * 32 + r) * BW + h * HD + 4 * hh;
#pragma unroll
        for (int g = 0; g < 4; ++g) { u32x2 w0, w1; w0.x = pk2(o0[4 * g], o0[4 * g + 1]); w0.y = pk2(o0[4 * g + 2], o0[4 * g + 3]); w1.x = pk2(o1[4 * g], o1[4 * g + 1]); w1.y = pk2(o1[4 * g + 2], o1[4 * g + 3]);
            *(u32x2*)(op + 8 * g) = w0; *(u32x2*)(op + 32 + 8 * g) = w1; }
    }
}

DI void p3_prep(const Frame& F0, ARef A, const bf16* RWRAW, const bf16* LORA, bf16* R, bf16* KS, bf16* V, bf16* KK, bf16* ALORA) {
    Frame F = F0; F.tid = opq_tid(F0.wave); F.lane = F.tid & 63; F.wave = __builtin_amdgcn_readfirstlane(F.tid >> 6); F.gw = F.wg * NWAVES + F.wave;
    const int lane = F.lane;
    f32x4 mu[3][2], kkc[2], mul[2];
#pragma unroll
    for (int part = 0; part < 3; ++part) { mu[part][0] = *(const f32x4*)(A.shift_mu + part * 512 + lane * 8); mu[part][1] = *(const f32x4*)(A.shift_mu + part * 512 + lane * 8 + 4); }
    kkc[0] = *(const f32x4*)(A.k_k + lane * 8); kkc[1] = *(const f32x4*)(A.k_k + lane * 8 + 4);
    const int lcol = lane < 36 ? lane * 8 : 0;
    mul[0] = *(const f32x4*)(A.shift_mu + 1536 + lcol); mul[1] = *(const f32x4*)(A.shift_mu + 1536 + lcol + 4);
    constexpr int RUN = 16;
    for (int run = F.gw; run < NTOK / RUN; run += F.NGW) {
        const int n0 = run * RUN;
        u32x4 prv[3], prl, cur[3], cul;
        const u32x4 z4 = {0u, 0u, 0u, 0u};
        if ((n0 & (SEQ - 1)) == 0) { prv[0] = z4; prv[1] = z4; prv[2] = z4; prl = z4; }
        else {
#pragma unroll
            for (int part = 0; part < 3; ++part) prv[part] = *(const u32x4*)(RWRAW + (size_t)(n0 - 1) * 1536 + part * 512 + lane * 8);
            prl = *(const u32x4*)(LORA + (size_t)(n0 - 1) * BW + lcol); }
#pragma unroll
        for (int part = 0; part < 3; ++part) cur[part] = *(const u32x4*)(RWRAW + (size_t)n0 * 1536 + part * 512 + lane * 8);
        cul = *(const u32x4*)(LORA + (size_t)n0 * BW + lcol);
        for (int i = 0; i < RUN; ++i) {
            const int n = n0 + i, nn = i + 1 < RUN ? n + 1 : n;
            u32x4 nxt[3], nxl;
#pragma unroll
            for (int part = 0; part < 3; ++part) nxt[part] = *(const u32x4*)(RWRAW + (size_t)nn * 1536 + part * 512 + lane * 8);
            nxl = *(const u32x4*)(LORA + (size_t)nn * BW + lcol);
            float xs[3][8];
#pragma unroll
            for (int part = 0; part < 3; ++part) { float p[8], q[8]; unpack8(cur[part], p); unpack8(prv[part], q);
#pragma unroll
                for (int j = 0; j < 4; ++j) { xs[part][j] = p[j] + mu[part][0][j] * (q[j] - p[j]); xs[part][4 + j] = p[4 + j] + mu[part][1][j] * (q[4 + j] - p[4 + j]); } }
            const size_t off = (size_t)n * BW + lane * 8;
            *(u32x4*)(R + off) = pack8(xs[0]); *(u32x4*)(KS + off) = pack8(xs[1]); *(u32x4*)(V + off) = pack8(xs[2]);
            float kk[8], ss = 0.f;
#pragma unroll
            for (int j = 0; j < 4; ++j) { kk[j] = xs[1][j] * kkc[0][j]; kk[4 + j] = xs[1][4 + j] * kkc[1][j]; }
#pragma unroll
            for (int j = 0; j < 8; ++j) ss += kk[j] * kk[j];
            ss += shfl_xor_l(ss, 1, lane); ss += shfl_xor_l(ss, 2, lane); ss += shfl_xor_l(ss, 4, lane);
            const float rn = 1.0f / fmaxf(sqrtf(ss), L2_EPS);
#pragma unroll
            for (int j = 0; j < 8; ++j) kk[j] *= rn;
            *(u32x4*)(KK + off) = pack8(kk);
            if (lane < 48) { float a[8];
                if (lane < 36) { float p[8], q[8]; unpack8(cul, p); unpack8(prl, q);
#pragma unroll
                    for (int j = 0; j < 8; ++j) { const float m = j < 4 ? mul[0][j & 3] : mul[1][j & 3]; const float v = p[j] + m * (q[j] - p[j]);
                        a[j] = lane < 8 ? (1.0f - 2.0f * frcp(fexp(2.0f * v) + 1.0f)) : (lane < 16 ? v : fsigmoid(v)); }
                } else {
#pragma unroll
                    for (int j = 0; j < 8; ++j) a[j] = 0.f; }
                *(u32x4*)(ALORA + (size_t)n * LK + lane * 8) = pack8(a); }
#pragma unroll
            for (int part = 0; part < 3; ++part) { prv[part] = cur[part]; cur[part] = nxt[part]; }
            prl = cul; cul = nxl;
        }
    }
}

DI void p4_lora(const Frame& F0, ARef A, const bf16* ALORA, const bf16* WL, bf16* E, bf16* KS, bf16* Bo, bf16* GG, const bf16* KK, const bf16* R, float* BON) {
    Frame F = F0; F.tid = opq_tid(F0.wave); F.lane = F.tid & 63; F.wave = __builtin_amdgcn_readfirstlane(F.tid >> 6); F.gw = F.wg * NWAVES + F.wave;
    const int lane = F.lane, r = lane & 31, hh = lane >> 5;
    for (int u = F.gw; u < 2 * (NTOK / 32); u += F.NGW) {
        const int n0 = (u >> 1) * 32, par = u & 1;
        bf16x8 tf[18];
#pragma unroll
        for (int ks = 0; ks < 18; ++ks) tf[ks] = *(const bf16x8*)(ALORA + (size_t)(n0 + r) * LK + 16 * ks + 8 * hh);
        TPS(F, 40);
        const unsigned orow = (unsigned)(n0 + r) * BW + 4 * hh;
#define LORA_W(dst, KS0, NKS, CB) do { _Pragma("unroll") for (int ks = 0; ks < (NKS); ++ks) dst[ks] = *(const bf16x8*)(WL + (size_t)(32 * (CB) + r) * LK + 16 * ((KS0) + ks) + 8 * hh); } while (0)
#define LORA_MM(W, KS0, NKS) f32x16 acc_; do { _Pragma("unroll") for (int q = 0; q < 16; ++q) acc_[q] = 0.f; \
            _Pragma("unroll") for (int ks = 0; ks < (NKS); ++ks) acc_ = MFMA32(W[ks], tf[(KS0) + ks], acc_); } while (0)
#define LORA_CB(base, i) ((base) + 4 * ((i) >> 1) + 2 * par + ((i) & 1))
        {   bf16x8 wc[4], wn[4]; LORA_W(wc, 0, 4, LORA_CB(0, 0));
#pragma nounroll
            for (int i = 0; i < 8; ++i) { const int cb = LORA_CB(0, i), c0_ = 32 * (cb & 15); { const int in_ = i < 7 ? i + 1 : 7; LORA_W(wn, 0, 4, LORA_CB(0, in_)); }
                f32x4 w0v[4];
#pragma unroll
                for (int g = 0; g < 4; ++g) w0v[g] = *(const f32x4*)(A.w0 + c0_ + 8 * g + 4 * hh);
                LORA_MM(wc, 0, 4);
#pragma unroll
                for (int g = 0; g < 4; ++g) { float e4[4];
#pragma unroll
                    for (int j = 0; j < 4; ++j) { const float v = acc_[4 * g + j] + w0v[g][j]; e4[j] = fexp(-fsoftplus(-v) - 0.5f); }
                    u32x2 w; w.x = pk2(e4[0], e4[1]); w.y = pk2(e4[2], e4[3]); *(u32x2*)(E + orow + c0_ + 8 * g) = w; }
#pragma unroll
                for (int ks = 0; ks < 4; ++ks) wc[ks] = wn[ks]; } }
        TPS(F, 41);
        {   float bsum = 0.f; bf16x8 wc[4], wn[4]; LORA_W(wc, 4, 4, LORA_CB(16, 0));
#pragma nounroll
            for (int i = 0; i < 8; ++i) { const int cb = LORA_CB(16, i), c0_ = 32 * (cb & 15); { const int in_ = i < 7 ? i + 1 : 7; LORA_W(wn, 4, 4, LORA_CB(16, in_)); }
                f32x4 a0v[4], kav[4], rkv[4]; u32x2 kw[4], qw[4], rw[4];
#pragma unroll
                for (int g = 0; g < 4; ++g) { const unsigned o = orow + c0_ + 8 * g; kw[g] = *(const u32x2*)(KS + o); qw[g] = *(const u32x2*)(KK + o); rw[g] = *(const u32x2*)(R + o);
                    a0v[g] = *(const f32x4*)(A.a0 + c0_ + 8 * g + 4 * hh); kav[g] = *(const f32x4*)(A.k_a + c0_ + 8 * g + 4 * hh); rkv[g] = *(const f32x4*)(A.r_k + c0_ + 8 * g + 4 * hh); }
                LORA_MM(wc, 4, 4);
#pragma unroll
                for (int g = 0; g < 4; ++g) { const unsigned o = orow + c0_ + 8 * g;
                    float ksv[4], kkv[4], kp[4], bb[4]; ksv[0] = bflo(kw[g].x); ksv[1] = bfhi(kw[g].x); ksv[2] = bflo(kw[g].y); ksv[3] = bfhi(kw[g].y); kkv[0] = bflo(qw[g].x); kkv[1] = bfhi(qw[g].x); kkv[2] = bflo(qw[g].y); kkv[3] = bfhi(qw[g].y);
#pragma unroll
                    for (int j = 0; j < 4; ++j) { const float s0 = fsigmoid(acc_[4 * g + j] + a0v[g][j]); kp[j] = ksv[j] * (1.0f + (s0 - 1.0f) * kav[g][j]); bb[j] = kkv[j] * s0; }
                    bsum += (bflo(rw[g].x) * kp[0] * rkv[g][0] + bfhi(rw[g].x) * kp[1] * rkv[g][1]) + (bflo(rw[g].y) * kp[2] * rkv[g][2] + bfhi(rw[g].y) * kp[3] * rkv[g][3]);
                    u32x2 w1, w2; w1.x = pk2(kp[0], kp[1]); w1.y = pk2(kp[2], kp[3]); w2.x = pk2(bb[0], bb[1]); w2.y = pk2(bb[2], bb[3]); *(u32x2*)(KS + o) = w1; *(u32x2*)(Bo + o) = w2; }
                if (i & 1) { const float tot = bsum + shfl_xor_l(bsum, 32, lane); if (hh == 0) BON[(size_t)(n0 + r) * 8 + 2 * (i >> 1) + par] = tot; bsum = 0.f; }
#pragma unroll
                for (int ks = 0; ks < 4; ++ks) wc[ks] = wn[ks]; } }
        TPS(F, 42);
        {   bf16x8 wc[10], wn[10]; LORA_W(wc, 8, 10, LORA_CB(32, 0));
#pragma nounroll
            for (int i = 0; i < 8; ++i) { const int cb = LORA_CB(32, i), c0_ = 32 * (cb & 15); { const int in_ = i < 7 ? i + 1 : 7; LORA_W(wn, 8, 10, LORA_CB(32, in_)); }
                LORA_MM(wc, 8, 10);
#pragma unroll
                for (int g = 0; g < 4; ++g) { u32x2 w; w.x = pk2(acc_[4 * g], acc_[4 * g + 1]); w.y = pk2(acc_[4 * g + 2], acc_[4 * g + 3]); *(u32x2*)(GG + orow + c0_ + 8 * g) = w; }
#pragma unroll
                for (int ks = 0; ks < 10; ++ks) wc[ks] = wn[ks]; } }
        TPS(F, 43);
#undef LORA_W
#undef LORA_MM
#undef LORA_CB
    }
}

DI void p6_chain(int task, int wave, LAS unsigned char* ring, const bf16* GT, const bf16* HT, bf16* SC) {
    const int lane = opq_tid(wave) & 63;
    const int bh = task >> 1, nb = task & 1;
    constexpr int RD = 6, SLOT = 12288;
    f32x16 X[2];
#pragma unroll
    for (int q = 0; q < 16; ++q) { X[0][q] = 0.f; X[1][q] = 0.f; }
    const char* gsrc = (const char*)(GT + (size_t)bh * NCH * 4096) + lane * 16;
    const char* hsrc = (const char*)(HT + (size_t)bh * NCH * 4096) + nb * 2048 + lane * 16;
#define CHAIN_DMA(cc) do { LAS unsigned char* sl_ = ring + ((cc) % RD) * SLOT; const char* g_ = gsrc + (size_t)(cc) * 8192; const char* h_ = hsrc + (size_t)(cc) * 8192; \
        _Pragma("unroll") for (int f = 0; f < 8; ++f) __builtin_amdgcn_global_load_lds((const unsigned*)(g_ + f * 1024), (LAS unsigned*)(sl_ + f * 1024), 16, 0, 0); \
        _Pragma("unroll") for (int kb = 0; kb < 2; ++kb) _Pragma("unroll") for (int j = 0; j < 2; ++j) \
            __builtin_amdgcn_global_load_lds((const unsigned*)(h_ + kb * 4096 + j * 1024), (LAS unsigned*)(sl_ + 8192 + (kb * 2 + j) * 1024), 16, 0, 0); } while (0)
#define CHAIN_READ(cc, HS, GS) do { const LAS unsigned char* sl_ = ring + ((cc) % RD) * SLOT; \
        _Pragma("unroll") for (int f = 0; f < 8; ++f) GS[f] = *(const LAS bf16x8*)(sl_ + f * 1024 + lane * 16); \
        _Pragma("unroll") for (int kb = 0; kb < 2; ++kb) _Pragma("unroll") for (int g = 0; g < 4; ++g) { const u32x2 w_ = *(const LAS u32x2*)(sl_ + 8192 + kb * 2048 + (g * 64 + lane) * 8); \
            HS[kb][4 * g] = bflo(w_.x); HS[kb][4 * g + 1] = bfhi(w_.x); HS[kb][4 * g + 2] = bflo(w_.y); HS[kb][4 * g + 3] = bfhi(w_.y); } } while (0)
#define CHAIN_STORE(cc) do { bf16* sc_ = SC + ((size_t)bh * NCH + (cc)) * 4096; \
        _Pragma("unroll") for (int jb = 0; jb < 2; ++jb) _Pragma("unroll") for (int g = 0; g < 4; ++g) { u32x2 w_; w_.x = pk2(X[jb][4 * g], X[jb][4 * g + 1]); w_.y = pk2(X[jb][4 * g + 2], X[jb][4 * g + 3]); \
            *(u32x2*)(sc_ + ((((jb * 2 + nb) * 4 + g) * 64) + lane) * 4) = w_; } } while (0)
#define CHAIN_STEP(HS, GS) do { bf16x8 xb_[2][2]; \
        _Pragma("unroll") for (int jb = 0; jb < 2; ++jb) _Pragma("unroll") for (int s = 0; s < 2; ++s) \
            xb_[jb][s] = pack8v(X[jb][8 * s], X[jb][8 * s + 1], X[jb][8 * s + 2], X[jb][8 * s + 3], X[jb][8 * s + 4], X[jb][8 * s + 5], X[jb][8 * s + 6], X[jb][8 * s + 7]); \
        X[0] = HS[0]; X[1] = HS[1]; \
        _Pragma("unroll") for (int kb = 0; kb < 2; ++kb) _Pragma("unroll") for (int jb = 0; jb < 2; ++jb) _Pragma("unroll") for (int s = 0; s < 2; ++s) X[kb] = MFMA32(GS[kb * 4 + jb * 2 + s], xb_[jb][s], X[kb]); } while (0)
    for (int cc = 0; cc < RD; ++cc) CHAIN_DMA(cc);
    for (int c = 0; c < NCH - 1; ++c) {
        f32x16 Hc[2]; bf16x8 Gc[8];
        if (c + RD <= NCH - 1) asm volatile("s_waitcnt vmcnt(60)" ::: "memory"); else asm volatile("s_waitcnt vmcnt(0)" ::: "memory");
        CHAIN_READ(c, Hc, Gc);
        asm volatile("s_waitcnt lgkmcnt(0)" ::: "memory");
        if (c + RD < NCH - 1) CHAIN_DMA(c + RD);
        CHAIN_STORE(c);
        CHAIN_STEP(Hc, Gc);
    }
    CHAIN_STORE(NCH - 1);
    asm volatile("s_waitcnt vmcnt(0)" ::: "memory");
#undef CHAIN_DMA
#undef CHAIN_READ
#undef CHAIN_STORE
#undef CHAIN_STEP
}

DI void p6_moe_weights(const Frame& F0, ARef A, int wi, int NW) {
    Frame F = F0; F.tid = opq_tid(F0.wave); F.lane = F.tid & 63; F.wave = __builtin_amdgcn_readfirstlane(F.tid >> 6); F.gw = F.wg * NWAVES + F.wave;
    LAS float* scr = (LAS float*)(F.lds + F.wave * 20480);
    constexpr int I_UP = NE * 32 * 16, I_DN = NE * 32 * 8;
    for (int it = wi; it < I_UP + I_DN; it += NW) {
        if (it < I_UP) { const int e = it >> 9, g = (it >> 4) & 31, kb = it & 15; tr_item_up(A.w_up1, A.w_up3, (bf16*)(A.ws + WS_WUP), e, 64 * kb, 32 * g, scr, F.lane); }
        else { const int r = it - I_UP, e = r >> 8, g = (r >> 3) & 31, kb = r & 7;
            tr_item(A.w_down + (size_t)e * DE * D, D, DE, (bf16*)(A.ws + WS_WDN) + (size_t)e * 1024 * DE, 64 * kb, 32 * g, 32 * g, scr, F.lane); }
    }
}

DI float half_bcast_sum(float v, int hh) {
    v += DPP_SHR(v, 0x111); v += DPP_SHR(v, 0x112); v += DPP_SHR(v, 0x114); v += DPP_SHR(v, 0x118);
    v += __builtin_bit_cast(float, __builtin_amdgcn_update_dpp(0, __builtin_bit_cast(int, v), 0x142, 0xa, 0xf, false));
    const float lo = __builtin_bit_cast(float, __builtin_amdgcn_readlane(__builtin_bit_cast(int, v), 31)), hi = __builtin_bit_cast(float, __builtin_amdgcn_readlane(__builtin_bit_cast(int, v), 63));
    return hh ? hi : lo; }
DI void p7_mfma(const Frame& F0, ARef A, const bf16* SC, const bf16* Pn, const bf16* QOn, const bf16* V, const bf16* GG, const float* BON, bf16* YRW) {
    Frame F = F0; F.tid = opq_tid(F0.wave); F.lane = F.tid & 63; F.wave = __builtin_amdgcn_readfirstlane(F.tid >> 6); F.gw = F.wg * NWAVES + F.wave;
    const int lane = F.lane, r = lane & 31, hh = lane >> 5;
    for (int cid = F.gw; cid < NCHUNK; cid += F.NGW) {
        const int bh = cid >> NCH_LOG, c = cid & (NCH - 1), b = bh >> 3, h = bh & 7;
        const unsigned n0 = (unsigned)b * SEQ + (unsigned)c * CH; const int col0 = h * HD;
        const bf16* sc = SC + (size_t)cid * 4096; const bf16* pn = Pn + (size_t)cid * 4096; const bf16* qn = QOn + (size_t)cid * 4096;
        bf16x8 Sf[2][2][2], Pf[2][2][2];
#pragma unroll
        for (int jb = 0; jb < 2; ++jb)
#pragma unroll
            for (int xb = 0; xb < 2; ++xb)
#pragma unroll
                for (int s = 0; s < 2; ++s) { const s16x4 lo = *(const s16x4*)(sc + ((((jb * 2 + xb) * 4 + 2 * s) * 64) + lane) * 4), hi = *(const s16x4*)(sc + ((((jb * 2 + xb) * 4 + 2 * s + 1) * 64) + lane) * 4);
#pragma unroll
                    for (int e = 0; e < 4; ++e) { Sf[jb][xb][s][e] = lo[e]; Sf[jb][xb][s][4 + e] = hi[e]; }
                    Pf[jb][xb][s] = *(const bf16x8*)(pn + ((((jb * 2 + xb) * 2 + s) * 64) + lane) * 8); }
        f32x16 Z[2][2];
#pragma unroll
        for (int tb = 0; tb < 2; ++tb)
#pragma unroll
            for (int nb = 0; nb < 2; ++nb) {
#pragma unroll
                for (int g = 0; g < 4; ++g) { const u32x2 w = *(const u32x2*)(qn + ((((tb * 2 + nb) * 4 + g) * 64) + lane) * 4);
                    Z[tb][nb][4 * g] = bflo(w.x); Z[tb][nb][4 * g + 1] = bfhi(w.x); Z[tb][nb][4 * g + 2] = bflo(w.y); Z[tb][nb][4 * g + 3] = bfhi(w.y); }
#pragma unroll
                for (int jb = 0; jb < 2; ++jb)
#pragma unroll
                    for (int s = 0; s < 2; ++s) Z[tb][nb] = MFMA32(Pf[jb][tb][s], Sf[jb][nb][s], Z[tb][nb]); }
        typedef float f2_t __attribute__((ext_vector_type(2)));
        const f2_t lw = *(const f2_t*)(A.lnx_w + col0 + 2 * r), lb = *(const f2_t*)(A.lnx_b + col0 + 2 * r);
#pragma unroll
        for (int tb = 0; tb < 2; ++tb) {
            unsigned vv[16], gg[16]; float bon[16];
#pragma unroll
            for (int q = 0; q < 16; ++q) { const unsigned tokrow = n0 + 32 * tb + 4 * hh + (q & 3) + 8 * (q >> 2); const unsigned o0 = tokrow * BW + col0 + 2 * r;
                vv[q] = *(const unsigned*)(V + o0); gg[q] = *(const unsigned*)(GG + o0); bon[q] = BON[(size_t)tokrow * 8 + h]; }
#pragma unroll
            for (int q = 0; q < 16; ++q) {
                const unsigned tokrow = n0 + 32 * tb + 4 * hh + (q & 3) + 8 * (q >> 2); const unsigned o0 = tokrow * BW + col0 + 2 * r;
                const float mean = half_bcast_sum(Z[tb][0][q] + Z[tb][1][q], hh) * (1.0f / 64.0f);
                const float d0 = Z[tb][0][q] - mean, d1 = Z[tb][1][q] - mean;
                const float rs = rsqrtf(half_bcast_sum(d0 * d0 + d1 * d1, hh) * (1.0f / 64.0f) + GN_EPS);
                const float y0 = (d0 * rs * lw.x + lb.x + bon[q] * bflo(vv[q])) * bflo(gg[q]), y1 = (d1 * rs * lw.y + lb.y + bon[q] * bfhi(vv[q])) * bfhi(gg[q]);
                *(unsigned*)(YRW + o0) = pk2(y0, y1);
                if ((q & 3) == 3) __builtin_amdgcn_sched_barrier(0); } }
    }
}

DI void p10_rows(const Frame& F0, ARef A, const bf16* Y1, bf16* H2) {
    Frame F = F0; F.tid = opq_tid(F0.wave); F.lane = F.tid & 63; F.wave = __builtin_amdgcn_readfirstlane(F.tid >> 6); F.gw = F.wg * NWAVES + F.wave;
    const int lane = F.lane;
    const float* mod = (const float*)(A.ws + WS_MOD);
    LAS float* rw = (LAS float*)F.lds;
    LAS int* hist = (LAS int*)(F.lds + 147456);
    TPS(F, 50);
    {   const char* src = (const char*)(A.ws + WS_RTW) + lane * 16;
        for (int j = F.wave; j < 144; j += NWAVES) __builtin_amdgcn_global_load_lds((const unsigned*)(src + j * 1024), (LAS unsigned*)(F.lds + j * 1024), 16, 0, 0);
        asm volatile("s_waitcnt vmcnt(0)" ::: "memory"); }
    __syncthreads();
    TPS(F, 51);
    i32x4* tok = (i32x4*)(A.ws + WS_TOK); int* cnt = (int*)(A.ws + WS_CNT);
    for (int tb = F.wg; tb < NTOK / 128; tb += F.G) {
        if (F.tid < 32) hist[F.tid] = 0;
        __syncthreads();
        f32x4 g1v[4], gtv[4], g2v[4], shv[4], scv[4], xn[4]; u32x2 yn[4];
        {   const int b0 = (tb * 128) >> 13;
#pragma unroll
            for (int j = 0; j < 4; ++j) { const int k = 4 * lane + 256 * j; g1v[j] = *(const f32x4*)(A.gains + D + k); gtv[j] = *(const f32x4*)(mod + b0 * 6144 + 2 * D + k);
                g2v[j] = *(const f32x4*)(A.gains + 2 * D + k); shv[j] = *(const f32x4*)(mod + b0 * 6144 + 3 * D + k); scv[j] = *(const f32x4*)(mod + b0 * 6144 + 4 * D + k); }
            const int n_ = tb * 128 + F.wave;
#pragma unroll
            for (int j = 0; j < 4; ++j) { xn[j] = ((const f32x4*)(A.x + (size_t)n_ * D) + lane)[64 * j]; yn[j] = ((const u32x2*)(Y1 + (size_t)n_ * D) + lane)[64 * j]; } }
        for (int tl = F.wave; tl < 128; tl += NWAVES) {
            const int n = tb * 128 + tl;
            f32x4 xv[4], yv[4]; float s = 0.f;
#pragma unroll
            for (int j = 0; j < 4; ++j) { xv[j] = xn[j]; const u32x2 w = yn[j]; yv[j][0] = bflo(w.x); yv[j][1] = bfhi(w.x); yv[j][2] = bflo(w.y); yv[j][3] = bfhi(w.y);
                s += (yv[j][0] * yv[j][0] + yv[j][1] * yv[j][1]) + (yv[j][2] * yv[j][2] + yv[j][3] * yv[j][3]); }
            {   const int nn = tl + NWAVES < 128 ? n + NWAVES : n;
#pragma unroll
                for (int j = 0; j < 4; ++j) { xn[j] = ((const f32x4*)(A.x + (size_t)nn * D) + lane)[64 * j]; yn[j] = ((const u32x2*)(Y1 + (size_t)nn * D) + lane)[64 * j]; } }
            const float inv1 = rsqrtf(wave_sum(s) * (1.0f / D) + NORM_EPS);
            float s2 = 0.f;
#pragma unroll
            for (int j = 0; j < 4; ++j) { const f32x4 g1 = g1v[j], gt = gtv[j];
#pragma unroll
                for (int q = 0; q < 4; ++q) { xv[j][q] = xv[j][q] + gt[q] * ((yv[j][q] * inv1) * g1[q]); s2 += xv[j][q] * xv[j][q]; }
                u32x2 xw; xw.x = pk2(xv[j][0], xv[j][1]); xw.y = pk2(xv[j][2], xv[j][3]); *((u32x2*)(A.ws + WS_X1 + (size_t)n * D * 2) + lane + 64 * j) = xw; }
            const float inv2 = rsqrtf(wave_sum(s2) * (1.0f / D) + NORM_EPS);
            f32x4 hv[4];
#pragma unroll
            for (int j = 0; j < 4; ++j) { const f32x4 g2 = g2v[j], sh = shv[j], sc = scv[j];
#pragma unroll
                for (int q = 0; q < 4; ++q) hv[j][q] = (xv[j][q] * inv2) * g2[q] * (1.0f + sc[q]) + sh[q];
                u32x2 w; w.x = pk2(hv[j][0], hv[j][1]); w.y = pk2(hv[j][2], hv[j][3]); *((u32x2*)(H2 + (size_t)n * D) + lane + 64 * j) = w; }
            typedef float f2_t __attribute__((ext_vector_type(2)));
#define P10_PAIR(OUT0, OUT1, WBASE) do { f2_t a = {0.f, 0.f}; \
                _Pragma("unroll") for (int j = 0; j < 4; ++j) { const LAS f32x4* wp = (const LAS f32x4*)((WBASE) + (4 * lane + 256 * j) * 2); const f32x4 wA = wp[0], wB = wp[1]; \
                    a += (f2_t){hv[j][0], hv[j][0]} * (f2_t){wA[0], wA[1]}; a += (f2_t){hv[j][1], hv[j][1]} * (f2_t){wA[2], wA[3]}; \
                    a += (f2_t){hv[j][2], hv[j][2]} * (f2_t){wB[0], wB[1]}; a += (f2_t){hv[j][3], hv[j][3]} * (f2_t){wB[2], wB[3]}; } \
                OUT0 = wave_sum(a.x); OUT1 = wave_sum(a.y); } while (0)
            float lg[4];
            P10_PAIR(lg[0], lg[1], rw); P10_PAIR(lg[2], lg[3], rw + 2 * D);
            int gs = 0; float gm = lg[0];
#pragma unroll
            for (int g = 1; g < 4; ++g) if (lg[g] > gm) { gm = lg[g]; gs = g; }
            gs = __builtin_amdgcn_readfirstlane(gs);
            float gsum = 0.f;
#pragma unroll
            for (int g = 0; g < 4; ++g) gsum += fexp(lg[g] - gm);
            const float gw = 1.0f / gsum;
            float el[8];
            { const LAS float* rwg = rw + (2 + 4 * gs) * (2 * D);
#pragma unroll
              for (int i = 0; i < 4; ++i) P10_PAIR(el[2 * i], el[2 * i + 1], rwg + i * 2 * D); }
#undef P10_PAIR
            int i0 = 0; float m0 = el[0];
#pragma unroll
            for (int e = 1; e < 8; ++e) if (el[e] > m0) { m0 = el[e]; i0 = e; }
            int i1 = -1; float m1 = -3.0e38f;
#pragma unroll
            for (int e = 0; e < 8; ++e) if (e != i0 && el[e] > m1) { m1 = el[e]; i1 = e; }
            const float t = fexp(m1 - m0), p0 = 1.0f / (1.0f + t), p1 = t * p0;
            const int e0 = gs * 8 + i0, e1 = gs * 8 + i1;
#if defined(CHECKS)
            if (lane == 0 && n == DBG_TOKEN) { float* dbg = (float*)(A.ws + WS_CTL + 32768) + 48; dbg[0] = lg[0]; dbg[1] = lg[1]; dbg[2] = lg[2]; dbg[3] = lg[3]; dbg[4] = gsum; dbg[5] = p0; dbg[6] = gw; dbg[7] = t; }
#endif
            if (lane == 0) { i32x4 rec; rec.x = e0 | (e1 << 8); rec.y = 0; rec.z = 0; rec.w = 0; tok[n] = rec;
                float* cwp = (float*)(A.ws + WS_CW) + 2 * n; cwp[0] = gw * p0; cwp[1] = gw * p1;
                atomicAdd((int*)&hist[e0], 1); atomicAdd((int*)&hist[e1], 1); }
        }
        __syncthreads();
        if (F.tid < 32) cnt[tb * 32 + F.tid] = hist[F.tid];
        __syncthreads();
    }
    TPS(F, 52);
}

DI void p11_rank_gather(const Frame& F0, ARef A, const bf16* H2, bf16* HS) {
    Frame F = F0; F.tid = opq_tid(F0.wave); F.lane = F.tid & 63; F.wave = __builtin_amdgcn_readfirstlane(F.tid >> 6); F.gw = F.wg * NWAVES + F.wave;
    LAS int* base = (LAS int*)F.lds;
    LAS int* seg = base + 32;
    LAS int* el = base + 96;
    LAS int* pos = base + 352;
    i32x4* tok = (i32x4*)(A.ws + WS_TOK); const int* cnt = (const int*)(A.ws + WS_CNT); int* tile = (int*)(A.ws + WS_TILE);
    LAS int* ptot = base + 640;
    LAS int* ppre = ptot + 512; LAS int* wcnt = ppre + 512;
    for (int tb = F.wg; tb < NTOK / 128; tb += F.G) {
        {
            const int e = F.tid & 31, part = F.tid >> 5; int tot = 0, pre = 0;
#pragma unroll
            for (int j = 0; j < 16; ++j) { const int t2 = part * 16 + j; const int v = cnt[t2 * 32 + e]; tot += v; pre += t2 < tb ? v : 0; }
            ptot[part * 32 + e] = tot; ppre[part * 32 + e] = pre; }
        if (F.tid >= 64 && F.tid < 64 + 128) { const i32x4 rec = tok[tb * 128 + (F.tid - 64)]; el[2 * (F.tid - 64)] = rec.x & 255; el[2 * (F.tid - 64) + 1] = (rec.x >> 8) & 255; }
        __syncthreads();
        if (F.tid < 32) { int tot = 0, pre = 0;
#pragma unroll
            for (int p = 0; p < 16; ++p) { tot += ptot[p * 32 + F.tid]; pre += ppre[p * 32 + F.tid]; }
            base[F.tid] = pre; seg[F.tid] = (tot + 255) & ~255; }
        int myrank = 0, mye = 0;
        if (F.tid < 256) { mye = el[F.tid];
#pragma unroll 4
            for (int x = 0; x < 32; ++x) { const unsigned long long m = __ballot(mye == x);
                if (mye == x) myrank = __popcll(m & ((1ull << F.lane) - 1ull));
                if (F.lane == 0) wcnt[F.wave * 32 + x] = __popcll(m); } }
        __syncthreads();
        if (F.tid == 0) { int acc = 0; for (int e = 0; e < 32; ++e) { const int sz = seg[e]; seg[e] = acc; acc += sz; } seg[32] = acc; }
        __syncthreads();
        if (F.tid < 256) { int p = seg[mye] + base[mye] + myrank;
            for (int w = 0; w < F.wave; ++w) p += wcnt[w * 32 + mye];
            pos[F.tid] = p; }
        if (tb == 0 && F.tid >= 256 && F.tid < 256 + 32) { const int e = F.tid - 256;
            for (int t2 = seg[e] >> 8; t2 < (seg[e + 1] >> 8); ++t2) tile[t2] = e;
            if (e == 0) tile[MAXT] = seg[32] >> 8; }
        __syncthreads();
        if (F.tid < 128) { i32x4 rec = tok[tb * 128 + F.tid]; rec.x = pos[2 * F.tid]; rec.y = pos[2 * F.tid + 1]; tok[tb * 128 + F.tid] = rec; }
        for (int q = F.wave; q < 256; q += NWAVES) { const int n = tb * 128 + (q >> 1);
            const u32x4* src = (const u32x4*)(H2 + (size_t)n * D) + F.lane; u32x4* dst = (u32x4*)(HS + (size_t)pos[q] * D) + F.lane;
            dst[0] = src[0]; dst[64] = src[64]; }
        __syncthreads();
    }
}

DI void p14_final(const Frame& F0, ARef A, const bf16* YE) {
    Frame F = F0; F.tid = opq_tid(F0.wave); F.lane = F.tid & 63; F.wave = __builtin_amdgcn_readfirstlane(F.tid >> 6); F.gw = F.wg * NWAVES + F.wave;
    const int lane = F.lane;
    const float* mod = (const float*)(A.ws + WS_MOD); const i32x4* tok = (const i32x4*)(A.ws + WS_TOK); const float* cwp = (const float*)(A.ws + WS_CW);
    f32x4 g3[4], gt[4];
#pragma unroll
    for (int j = 0; j < 4; ++j) g3[j] = *(const f32x4*)(A.gains + 3 * D + 4 * lane + 256 * j);
    int bcur = -1;
    i32x4 rec1, rec2; float c10, c11, c20, c21;
    u32x2 ya[4], yb[4], xw[4]; float c0 = 0.f, c1 = 0.f;
#define P14_REC(n_, R, C0, C1) do { const int m_ = (n_) < NTOK ? (n_) : F.gw; R = tok[m_]; C0 = cwp[2 * m_]; C1 = cwp[2 * m_ + 1]; } while (0)
#define P14_ROWS(n_, R) do { const int m_ = (n_) < NTOK ? (n_) : F.gw; const u32x2* y0_ = (const u32x2*)(YE + (size_t)(R).x * D) + lane; const u32x2* y1_ = (const u32x2*)(YE + (size_t)(R).y * D) + lane; \
        const u32x2* x_ = (const u32x2*)(A.ws + WS_X1 + (size_t)m_ * D * 2) + lane; \
        _Pragma("unroll") for (int j = 0; j < 4; ++j) { ya[j] = y0_[64 * j]; yb[j] = y1_[64 * j]; xw[j] = x_[64 * j]; } } while (0)
    if (F.gw < NTOK) { P14_REC(F.gw, rec1, c10, c11); P14_ROWS(F.gw, rec1); c0 = c10; c1 = c11; P14_REC(F.gw + F.NGW, rec1, c10, c11); }
    for (int n = F.gw; n < NTOK; n += F.NGW) {
        const int b = n >> 13;
        f32x4 yv[4], xv[4]; float s = 0.f;
#pragma unroll
        for (int j = 0; j < 4; ++j) { const u32x2 a = ya[j], bq = yb[j];
            yv[j][0] = c0 * bflo(a.x) + c1 * bflo(bq.x); yv[j][1] = c0 * bfhi(a.x) + c1 * bfhi(bq.x); yv[j][2] = c0 * bflo(a.y) + c1 * bflo(bq.y); yv[j][3] = c0 * bfhi(a.y) + c1 * bfhi(bq.y);
            xv[j][0] = bflo(xw[j].x); xv[j][1] = bfhi(xw[j].x); xv[j][2] = bflo(xw[j].y); xv[j][3] = bfhi(xw[j].y);
            s += (yv[j][0] * yv[j][0] + yv[j][1] * yv[j][1]) + (yv[j][2] * yv[j][2] + yv[j][3] * yv[j][3]); }
        P14_ROWS(n + F.NGW, rec1); c0 = c10; c1 = c11; P14_REC(n + 2 * F.NGW, rec2, c20, c21);
        if (b != bcur) { bcur = b;
#pragma unroll
            for (int j = 0; j < 4; ++j) gt[j] = *(const f32x4*)(mod + b * 6144 + 5 * D + 4 * lane + 256 * j); }
        const float inv = rsqrtf(wave_sum(s) * (1.0f / D) + NORM_EPS);
#pragma unroll
        for (int j = 0; j < 4; ++j) {
#pragma unroll
            for (int q = 0; q < 4; ++q) xv[j][q] = xv[j][q] + gt[j][q] * ((yv[j][q] * inv) * g3[j][q]);
            *((f32x4*)(A.out + (size_t)n * D) + lane + 64 * j) = xv[j]; }
        rec1 = rec2; c10 = c20; c11 = c21;
    }
#undef P14_REC
#undef P14_ROWS
}

DI bf16x8 pk_tile(const f32x16& x, const int s) { return pack8v(x[8 * s], x[8 * s + 1], x[8 * s + 2], x[8 * s + 3], x[8 * s + 4], x[8 * s + 5], x[8 * s + 6], x[8 * s + 7]); }
constexpr int FS = 72;
DI bf16x8 rd_frag(const LAS bf16* buf, int tb, int cb, int s, int r, int hh) {
    const LAS bf16* p = buf + (32 * cb + r) * FS + 32 * tb + 16 * s + 4 * hh;
    const s16x4 lo = *(const LAS s16x4*)p, hi = *(const LAS s16x4*)(p + 8); bf16x8 f;
#pragma unroll
    for (int e = 0; e < 4; ++e) { f[e] = lo[e]; f[4 + e] = hi[e]; }
    return f; }
DI void wr_tile_ft(LAS bf16* buf, const f32x16& x, int tb, int cb, int r, int hh) {
#pragma unroll
    for (int g = 0; g < 4; ++g) { u32x2 w; w.x = pk2(x[4 * g], x[4 * g + 1]); w.y = pk2(x[4 * g + 2], x[4 * g + 3]); *(LAS u32x2*)(buf + (32 * cb + r) * FS + 32 * tb + 8 * g + 4 * hh) = w; } }
DI void wr_l_ft(LAS bf16* buf, const float (&x)[64], int lane) {
#pragma unroll
    for (int t8 = 0; t8 < 8; ++t8) { u32x4 w; w.x = pk2(x[8 * t8], x[8 * t8 + 1]); w.y = pk2(x[8 * t8 + 2], x[8 * t8 + 3]); w.z = pk2(x[8 * t8 + 4], x[8 * t8 + 5]); w.w = pk2(x[8 * t8 + 6], x[8 * t8 + 7]);
        *(LAS u32x4*)(buf + lane * FS + 8 * t8) = w; } }

#if defined(STAMPS)
#define P5STAMP(k) do { p5ts[k] = __builtin_amdgcn_s_memrealtime(); } while (0)
#else
#define P5STAMP(k) TPS(F, 70 + (k))
#endif
DI void p5_mfma(unsigned char* F0_ws, const Frame& F0, const bf16* R, const bf16* KP, const bf16* V, const bf16* KK, const bf16* Bv, const bf16* Ev, bf16* P, bf16* QO, bf16* GT, bf16* HT) {
    Frame F = F0; F.tid = opq_tid(F0.wave); F.lane = F.tid & 63; F.wave = __builtin_amdgcn_readfirstlane(F.tid >> 6); F.gw = F.wg * NWAVES + F.wave;
    const int lane = F.lane, r = lane & 31, hh = lane >> 5;
    LAS unsigned char* wl_init = F.lds + F.wave * 20480;
    LAS unsigned char* const wl0 = wl_init;
    {   bf16x8 id_[2];
#pragma unroll
        for (int s = 0; s < 2; ++s)
#pragma unroll
            for (int e = 0; e < 8; ++e) id_[s][e] = (16 * s + 8 * (e >> 2) + 4 * hh + (e & 3)) == r ? (short)0x3F80 : (short)0;
        *(LAS bf16x8*)(wl0 + 16640 + lane * 16) = id_[0]; *(LAS bf16x8*)(wl0 + 16640 + 1024 + lane * 16) = id_[1]; }
    wave_lds_fence();
    for (int cid = F.gw; cid < NCHUNK; cid += F.NGW) {
        const int bh = cid >> NCH_LOG, c = cid & (NCH - 1), b = bh >> 3, h = bh & 7;
        const unsigned n0 = (unsigned)b * SEQ + (unsigned)c * CH, col0 = (unsigned)h * HD;
        LAS unsigned char* wl = wl0; asm volatile("" : "+s"(wl));
        LAS unsigned char* IFR = wl + 16640;
        const int ln = opq_tid(F.wave) & 63;
#if defined(STAMPS)
        unsigned long long p5ts[10];
#endif
        const int rm = ln & 31, hm = ln >> 5;
        const bf16 *R0_ = R, *KP0_ = KP, *V0_ = V, *KK0_ = KK, *Bv0_ = Bv, *Ev0_ = Ev; bf16 *P0_ = P, *QO0_ = QO;
        asm volatile("" : "+s"(R0_), "+s"(KP0_), "+s"(V0_), "+s"(KK0_), "+s"(Bv0_), "+s"(Ev0_), "+s"(P0_), "+s"(QO0_));
        const GAS char *R_ = (const GAS char*)R0_, *KP_ = (const GAS char*)KP0_, *V_ = (const GAS char*)V0_, *KK_ = (const GAS char*)KK0_, *Bv_ = (const GAS char*)Bv0_, *Ev_ = (const GAS char*)Ev0_;
        GAS char *P_ = (GAS char*)P0_, *QO_ = (GAS char*)QO0_;
        const unsigned nb0 = n0 * BW + col0;
        const unsigned vL = (nb0 + (unsigned)ln) * 2u, vT = (nb0 + (unsigned)rm * BW + 4u * hm) * 2u;
#define OADD(v, c) ({ unsigned o_; asm volatile("v_add_u32_e32 %0, %1, %2" : "=v"(o_) : "n"((int)(c)), "v"(v)); o_; })
#define LD16(arr, off) (*(const GAS bf16*)((arr) + (off)))
#define XL(arr, t) LD16(arr, OADD(vL, (t) * BW * 2))
#define ROWQ(q) (((q) & 3) + 8 * ((q) >> 2))
        P5STAMP(0);
        bf16x8 Ep[2][2][2]; u32x2 raw[2][4][4];
#pragma unroll
        for (int fb = 0; fb < 2; ++fb)
#pragma unroll
            for (int tb = 0; tb < 2; ++tb)
#pragma unroll
                for (int s = 0; s < 2; ++s) { const u32x2 lo_ = *(const GAS u32x2*)(Ev_ + OADD(vT, (32 * tb * BW + 32 * fb + 16 * s) * 2)), hi_ = *(const GAS u32x2*)(Ev_ + OADD(vT, (32 * tb * BW + 32 * fb + 16 * s + 8) * 2));
                    u32x4 w_; w_.x = lo_.x; w_.y = lo_.y; w_.z = hi_.x; w_.w = hi_.y; Ep[fb][tb][s] = __builtin_bit_cast(bf16x8, w_); }
#define LOAD_TILE(BUF, FB, TB) do { _Pragma("unroll") for (int g = 0; g < 4; ++g) { const unsigned ot_ = OADD(vT, (32 * (TB) * BW + 32 * (FB) + 8 * g) * 2); \
            raw[BUF][0][g] = *(const GAS u32x2*)(KK_ + ot_); raw[BUF][1][g] = *(const GAS u32x2*)(R_ + ot_); \
            raw[BUF][2][g] = *(const GAS u32x2*)(Bv_ + ot_); raw[BUF][3][g] = *(const GAS u32x2*)(KP_ + ot_); } } while (0)
        LOAD_TILE(0, 0, 0);
#define IDF(s) (*(const LAS bf16x8*)(IFR + (s) * 1024 + ln * 16))
        bf16x8 ETp[2][2][2], tri[2], ones;
        float sc_[2];
        {   const bf16x8 id0 = IDF(0), id1 = IDF(1);
            {   unsigned o2_ = 0x3F803F80u; asm volatile("" : "+v"(o2_)); u32x4 o4_; o4_.x = o2_; o4_.y = o2_; o4_.z = o2_; o4_.w = o2_; ones = __builtin_bit_cast(bf16x8, o4_); }
#pragma unroll
            for (int e = 0; e < 8; ++e) {
#pragma unroll
                for (int s = 0; s < 2; ++s) tri[s][e] = (16 * s + 8 * (e >> 2) + 4 * hm + (e & 3)) <= rm ? (short)0x3F80 : (short)0; }
#pragma unroll
            for (int kb = 0; kb < 2; ++kb)
#pragma unroll
                for (int fb = 0; fb < 2; ++fb) { f32x16 x_;
#pragma unroll
                    for (int q = 0; q < 16; ++q) x_[q] = 0.f;
                    x_ = MFMA32(Ep[fb][kb][0], id0, x_); x_ = MFMA32(Ep[fb][kb][1], id1, x_);
                    ETp[kb][fb][0] = pk_tile(x_, 0); ETp[kb][fb][1] = pk_tile(x_, 1); }
#pragma unroll
            for (int fb = 0; fb < 2; ++fb) { f32x16 t_;
#pragma unroll
                for (int q = 0; q < 16; ++q) t_[q] = 0.f;
#pragma unroll
                for (int kb = 0; kb < 2; ++kb)
#pragma unroll
                    for (int s = 0; s < 2; ++s) t_ = MFMA32(ones, ETp[kb][fb][s], t_);
                sc_[fb] = fexp(-t_[0]); }
            __builtin_amdgcn_sched_barrier(0); }
        P5STAMP(1);
        bf16x8 Ap[2][2][2], Rp[2][2][2], Bp[2][2][2], Kp[2][2][2];
#pragma unroll
        for (int ti = 0; ti < 4; ++ti) { const int fb = ti >> 1, tb = ti & 1;
            if (ti < 3) LOAD_TILE((ti + 1) & 1, (ti + 1) >> 1, (ti + 1) & 1);
            f32x16 Lt;
#pragma unroll
            for (int q = 0; q < 16; ++q) Lt[q] = 0.f;
#pragma unroll
            for (int kb = 0; kb <= tb; ++kb)
#pragma unroll
                for (int s = 0; s < 2; ++s) Lt = MFMA32(ETp[kb][fb][s], kb < tb ? ones : tri[s], Lt);
#pragma unroll
            for (int s = 0; s < 2; ++s) {
                float a8[8], r8[8], b8[8], k8[8], e8[8]; unpack8(__builtin_bit_cast(u32x4, Ep[fb][tb][s]), e8);
#pragma unroll
                for (int g2 = 0; g2 < 2; ++g2) { const int g = 2 * s + g2;
                    const u32x2 aw = raw[ti & 1][0][g], rw = raw[ti & 1][1][g], bw = raw[ti & 1][2][g], kw = raw[ti & 1][3][g];
                    const float av[4] = {bflo(aw.x), bfhi(aw.x), bflo(aw.y), bfhi(aw.y)}, rv[4] = {bflo(rw.x), bfhi(rw.x), bflo(rw.y), bfhi(rw.y)},
                                bv[4] = {bflo(bw.x), bfhi(bw.x), bflo(bw.y), bfhi(bw.y)}, kv[4] = {bflo(kw.x), bfhi(kw.x), bflo(kw.y), bfhi(kw.y)};
#pragma unroll
                    for (int j = 0; j < 4; ++j) { const float l = -Lt[4 * g + j];
                        const float eI = fexp(l), eX = fexp(l + e8[4 * g2 + j]), eN = frcp(eI);
                        a8[4 * g2 + j] = -av[j] * eX; r8[4 * g2 + j] = rv[j] * eI; b8[4 * g2 + j] = bv[j] * eN; k8[4 * g2 + j] = kv[j] * eN; } }
                Ap[fb][tb][s] = __builtin_bit_cast(bf16x8, pack8(a8)); Rp[fb][tb][s] = __builtin_bit_cast(bf16x8, pack8(r8));
                Bp[fb][tb][s] = __builtin_bit_cast(bf16x8, pack8(b8)); Kp[fb][tb][s] = __builtin_bit_cast(bf16x8, pack8(k8)); }
            __builtin_amdgcn_sched_barrier(0); }
#undef LOAD_TILE
        P5STAMP(2);
#define GRAM_TILE(m_, XP, YP, ib, tb) do { _Pragma("unroll") for (int q = 0; q < 16; ++q) m_[q] = 0.f; \
            _Pragma("unroll") for (int fb = 0; fb < 2; ++fb) _Pragma("unroll") for (int s = 0; s < 2; ++s) m_ = MFMA32(XP[fb][ib][s], YP[fb][tb][s], m_); } while (0)
        bf16x8 Tp[2][2][2];
        {
#pragma unroll
            for (int b = 1; b >= 0; --b) { bf16x8 AP[2], BP[2]; f32x16 CT;
                {   f32x16 m_; int rm_ = rm; asm volatile("" : "+v"(rm_));
                    GRAM_TILE(m_, Bp, Ap, b, b);
#pragma unroll
                    for (int q = 0; q < 16; ++q) m_[q] = crow(q, hm) < rm_ ? m_[q] : 0.f;
                    BP[0] = pk_tile(m_, 0); BP[1] = pk_tile(m_, 1);
#pragma unroll
                    for (int q = 0; q < 16; ++q) CT[q] = m_[q] + (crow(q, hm) == rm_ ? 1.0f : 0.f);
                    GRAM_TILE(m_, Ap, Bp, b, b);
#pragma unroll
                    for (int q = 0; q < 16; ++q) m_[q] = rm_ < crow(q, hm) ? m_[q] : 0.f;
                    AP[0] = pk_tile(m_, 0); AP[1] = pk_tile(m_, 1); }
                __builtin_amdgcn_sched_barrier(0);
#pragma unroll
                for (int it = 0; it < 4; ++it) { f32x16 pn_, pt_;
#pragma unroll
                    for (int q = 0; q < 16; ++q) { pn_[q] = 0.f; pt_[q] = 0.f; }
#pragma unroll
                    for (int s = 0; s < 2; ++s) { pn_ = MFMA32(AP[s], BP[s], pn_); pt_ = MFMA32(BP[s], AP[s], pt_); }
                    const bf16x8 bt0 = pk_tile(CT, 0), bt1 = pk_tile(CT, 1);
                    AP[0] = pk_tile(pt_, 0); AP[1] = pk_tile(pt_, 1); BP[0] = pk_tile(pn_, 0); BP[1] = pk_tile(pn_, 1);
                    CT = MFMA32(AP[0], bt0, CT); CT = MFMA32(AP[1], bt1, CT);
                    __builtin_amdgcn_sched_barrier(0); }
                Tp[b][b][0] = pk_tile(CT, 0); Tp[b][b][1] = pk_tile(CT, 1); }
            {   f32x16 x_; GRAM_TILE(x_, Ap, Bp, 1, 0);
                const bf16x8 au0 = pk_tile(x_, 0), au1 = pk_tile(x_, 1);
#pragma unroll
                for (int q = 0; q < 16; ++q) x_[q] = 0.f;
                x_ = MFMA32(au0, Tp[1][1][0], x_); x_ = MFMA32(au1, Tp[1][1][1], x_);
                const bf16x8 bx0 = pk_tile(x_, 0), bx1 = pk_tile(x_, 1);
#pragma unroll
                for (int q = 0; q < 16; ++q) x_[q] = 0.f;
                x_ = MFMA32(Tp[0][0][0], IDF(0), x_); x_ = MFMA32(Tp[0][0][1], IDF(1), x_);
                const bf16x8 at0 = pk_tile(x_, 0), at1 = pk_tile(x_, 1);
#pragma unroll
                for (int q = 0; q < 16; ++q) x_[q] = 0.f;
                x_ = MFMA32(at0, bx0, x_); x_ = MFMA32(at1, bx1, x_);
                Tp[1][0][0] = pk_tile(x_, 0); Tp[1][0][1] = pk_tile(x_, 1); }
            __builtin_amdgcn_sched_barrier(0); }
        P5STAMP(3);
        {   const bf16x8 id0 = IDF(0), id1 = IDF(1);
#pragma unroll
            for (int tb = 0; tb < 2; ++tb)
#pragma unroll
                for (int kb = 0; kb < 2; ++kb) { f32x16 xb_, xk_; const float sc = sc_[kb];
#pragma unroll
                    for (int q = 0; q < 16; ++q) { xb_[q] = 0.f; xk_[q] = 0.f; }
                    xb_ = MFMA32(Bp[kb][tb][0], id0, xb_); xb_ = MFMA32(Bp[kb][tb][1], id1, xb_);
                    xk_ = MFMA32(Kp[kb][tb][0], id0, xk_); xk_ = MFMA32(Kp[kb][tb][1], id1, xk_);
#pragma unroll
                    for (int q = 0; q < 16; ++q) { xb_[q] *= sc; xk_[q] *= sc; }
#pragma unroll
                    for (int s = 0; s < 2; ++s) { *(LAS bf16x8*)(wl + (((tb * 2 + kb) * 2 + s) * 1024) + ln * 16) = pk_tile(xb_, s); *(LAS bf16x8*)(wl + 8192 + (((tb * 2 + kb) * 2 + s) * 1024) + ln * 16) = pk_tile(xk_, s); }
                    __builtin_amdgcn_sched_barrier(0); } }
        bf16x8 Makp[2][2][2], Mbrp[2][2][2], Mkrp[2][2][2];
#define GRAM(XP, YP, STRICT, BODY) _Pragma("unroll") for (int ib = 0; ib < 2; ++ib) _Pragma("unroll") for (int tb = 0; tb < 2; ++tb) if (!(ib == 1 && tb == 0)) { f32x16 m_; \
            GRAM_TILE(m_, XP, YP, ib, tb); \
            int rm_ = rm; asm volatile("" : "+v"(rm_)); \
            _Pragma("unroll") for (int q = 0; q < 16; ++q) { const int i_ = 32 * ib + crow(q, hm), t_ = 32 * tb + rm_; m_[q] = ((STRICT) ? (i_ < t_) : (i_ <= t_)) ? m_[q] : 0.f; } \
            BODY __builtin_amdgcn_sched_barrier(0); }
        GRAM(Kp, Rp, false, { Mkrp[ib][tb][0] = pk_tile(m_, 0); Mkrp[ib][tb][1] = pk_tile(m_, 1); })
        GRAM(Kp, Ap, true, { Makp[ib][tb][0] = pk_tile(m_, 0); Makp[ib][tb][1] = pk_tile(m_, 1); })
        GRAM(Bp, Rp, false, { Mbrp[ib][tb][0] = pk_tile(m_, 0); Mbrp[ib][tb][1] = pk_tile(m_, 1); })
#undef GRAM
#undef GRAM_TILE
        P5STAMP(4);
#define IDF2(s) (*(const LAS bf16x8*)(IFR + (s) * 1024 + ln2 * 16))
        bf16x8 ATp[2][2][2];
        const int ln2 = opq_tid(F.wave) & 63;
        GAS char* pn = (GAS char*)(P0_ + (size_t)cid * 4096);
#pragma unroll
        for (int kb = 0; kb < 2; ++kb) { const bf16x8 id0 = IDF2(0), id1 = IDF2(1);
            {   bf16x8 A0p[2][2];
#pragma unroll
                for (int ib = 0; ib < 2; ++ib) { f32x16 x_;
#pragma unroll
                    for (int q = 0; q < 16; ++q) x_[q] = 0.f;
                    x_ = MFMA32(Ap[kb][ib][0], id0, x_); x_ = MFMA32(Ap[kb][ib][1], id1, x_);
                    A0p[ib][0] = pk_tile(x_, 0); A0p[ib][1] = pk_tile(x_, 1); }
#pragma unroll
                for (int tb = 0; tb < 2; ++tb) { f32x16 a_;
#pragma unroll
                    for (int q = 0; q < 16; ++q) a_[q] = 0.f;
#pragma unroll
                    for (int ib = 0; ib <= tb; ++ib)
#pragma unroll
                        for (int s = 0; s < 2; ++s) a_ = MFMA32(Tp[tb][ib][s], A0p[ib][s], a_);
                    ATp[tb][kb][0] = pk_tile(a_, 0); ATp[tb][kb][1] = pk_tile(a_, 1); } }
            __builtin_amdgcn_sched_barrier(0);
#pragma unroll
            for (int tb = 0; tb < 2; ++tb) { f32x16 p_; const int jb = kb;
#pragma unroll
                for (int q = 0; q < 16; ++q) p_[q] = 0.f;
                p_ = MFMA32(id0, Rp[jb][tb][0], p_); p_ = MFMA32(id1, Rp[jb][tb][1], p_);
#pragma unroll
                for (int ib = 0; ib <= tb; ++ib)
#pragma unroll
                    for (int s = 0; s < 2; ++s) p_ = MFMA32(ATp[ib][jb][s], Mbrp[ib][tb][s], p_);
#pragma unroll
                for (int s = 0; s < 2; ++s) *(GAS bf16x8*)(pn + ((((jb * 2 + tb) * 2 + s) * 64) + ln2) * 16) = pk_tile(p_, s);
                __builtin_amdgcn_sched_barrier(0); } }
        P5STAMP(6);
        bf16x8 W1p[2][2][2], Vp[2][2][2];
        const int lc_ = ln2;
        const unsigned vC = (nb0 + 4u * (unsigned)(lc_ >> 5) * BW + 2u * (unsigned)(lc_ & 31)) * 2u;
#pragma unroll
        for (int ib = 0; ib < 2; ++ib) { f32x16 v0_, v1_;
#pragma unroll
            for (int q = 0; q < 16; ++q) { const unsigned w_ = *(const GAS unsigned*)(V_ + OADD(vC, ((32 * ib + ROWQ(q)) * BW) * 2)); v0_[q] = bflo(w_); v1_[q] = bfhi(w_); }
            Vp[ib][0][0] = pk_tile(v0_, 0); Vp[ib][0][1] = pk_tile(v0_, 1); Vp[ib][1][0] = pk_tile(v1_, 0); Vp[ib][1][1] = pk_tile(v1_, 1); }
#pragma unroll
        for (int vb = 0; vb < 2; ++vb) { bf16x8 W0p[2][2];
#pragma unroll
            for (int tb = 0; tb < 2; ++tb) { f32x16 w_;
#pragma unroll
                for (int q = 0; q < 16; ++q) w_[q] = 0.f;
#pragma unroll
                for (int ib = 0; ib <= tb; ++ib)
#pragma unroll
                    for (int s = 0; s < 2; ++s) w_ = MFMA32(Makp[ib][tb][s], Vp[ib][vb][s], w_);
                W0p[tb][0] = pk_tile(w_, 0); W0p[tb][1] = pk_tile(w_, 1); }
#pragma unroll
            for (int tb = 0; tb < 2; ++tb) { f32x16 w_;
#pragma unroll
                for (int q = 0; q < 16; ++q) w_[q] = 0.f;
#pragma unroll
                for (int ib = 0; ib <= tb; ++ib)
#pragma unroll
                    for (int s = 0; s < 2; ++s) w_ = MFMA32(Tp[tb][ib][s], W0p[ib][s], w_);
                W1p[tb][vb][0] = pk_tile(w_, 0); W1p[tb][vb][1] = pk_tile(w_, 1); }
            __builtin_amdgcn_sched_barrier(0); }
        P5STAMP(7);
        GAS char* qn = (GAS char*)(QO0_ + (size_t)cid * 4096);
#pragma unroll
        for (int tb = 0; tb < 2; ++tb)
#pragma unroll
            for (int vb = 0; vb < 2; ++vb) { f32x16 y_;
#pragma unroll
                for (int q = 0; q < 16; ++q) y_[q] = 0.f;
#pragma unroll
                for (int ib = 0; ib <= tb; ++ib)
#pragma unroll
                    for (int s = 0; s < 2; ++s) { y_ = MFMA32(Mbrp[ib][tb][s], W1p[ib][vb][s], y_); y_ = MFMA32(Mkrp[ib][tb][s], Vp[ib][vb][s], y_); }
#pragma unroll
                for (int g = 0; g < 4; ++g) { u32x2 w; w.x = pk2(y_[4 * g], y_[4 * g + 1]); w.y = pk2(y_[4 * g + 2], y_[4 * g + 3]); *(GAS u32x2*)(qn + ((((tb * 2 + vb) * 4 + g) * 64) + ln2) * 8) = w; }
                __builtin_amdgcn_sched_barrier(0); }
        P5STAMP(8);
        wave_lds_fence();
        bf16x8 Bh[2][2][2];
#pragma unroll
        for (int tb = 0; tb < 2; ++tb)
#pragma unroll
            for (int kb = 0; kb < 2; ++kb)
#pragma unroll
                for (int s = 0; s < 2; ++s) Bh[tb][kb][s] = *(const LAS bf16x8*)(wl + (((tb * 2 + kb) * 2 + s) * 1024) + ln2 * 16);
        GAS char* gt = (GAS char*)(GT + (size_t)cid * 4096); GAS char* ht = (GAS char*)(HT + (size_t)cid * 4096);
#pragma unroll
        for (int kb = 0; kb < 2; ++kb)
#pragma unroll
            for (int jb = 0; jb < 2; ++jb) { f32x16 g_;
                const float dg = sc_[kb];
#pragma unroll
                for (int q = 0; q < 16; ++q) g_[q] = (kb == jb && crow(q, hm) == rm) ? dg : 0.f;
#pragma unroll
                for (int tb = 0; tb < 2; ++tb)
#pragma unroll
                    for (int s = 0; s < 2; ++s) g_ = MFMA32(ATp[tb][jb][s], Bh[tb][kb][s], g_);
#pragma unroll
                for (int s = 0; s < 2; ++s) *(GAS bf16x8*)(gt + ((kb * 4 + jb * 2 + s) * 64 + ln2) * 16) = pk_tile(g_, s);
                __builtin_amdgcn_sched_barrier(0); }
        {   bf16x8 Kh[2][2][2];
#pragma unroll
            for (int tb = 0; tb < 2; ++tb)
#pragma unroll
                for (int kb = 0; kb < 2; ++kb)
#pragma unroll
                    for (int s = 0; s < 2; ++s) Kh[tb][kb][s] = *(const LAS bf16x8*)(wl + 8192 + (((tb * 2 + kb) * 2 + s) * 1024) + ln2 * 16);
#pragma unroll
            for (int kb = 0; kb < 2; ++kb)
#pragma unroll
                for (int vb = 0; vb < 2; ++vb) { f32x16 h_;
#pragma unroll
                    for (int q = 0; q < 16; ++q) h_[q] = 0.f;
#pragma unroll
                    for (int tb = 0; tb < 2; ++tb)
#pragma unroll
                        for (int s = 0; s < 2; ++s) { h_ = MFMA32(Bh[tb][kb][s], W1p[tb][vb][s], h_); h_ = MFMA32(Kh[tb][kb][s], Vp[tb][vb][s], h_); }
#pragma unroll
                    for (int g = 0; g < 4; ++g) { u32x2 w; w.x = pk2(h_[4 * g], h_[4 * g + 1]); w.y = pk2(h_[4 * g + 2], h_[4 * g + 3]); *(GAS u32x2*)(ht + ((((kb * 2 + vb) * 4 + g) * 64) + ln2) * 8) = w; }
                    __builtin_amdgcn_sched_barrier(0); } }
        P5STAMP(9);
#undef IDF
#undef IDF2
#if defined(STAMPS)
        if (F.gw == 0 && cid == 0 && lane == 0) { _Pragma("unroll") for (int k_ = 0; k_ < 10; ++k_) ((unsigned long long*)(F0_ws + WS_CTL + 49152))[32 + k_] = p5ts[k_]; }
#endif
        wave_lds_fence();
#undef XL
#undef OADD
#undef LD16
#undef ROWQ
    }
}

#if defined(CHECKS)
constexpr size_t WS_FLG = WS_CTL + 32768;
DI unsigned* chk_flags(unsigned char* ws) { return (unsigned*)(ws + WS_FLG); }
DI void chk(unsigned char* ws, int id, float got, float want, float rel, float ab) {
    const float d = fabsf(got - want), lim = rel * fmaxf(fabsf(got), fabsf(want)) + ab;
    if (!(d <= lim)) chk_flags(ws)[id] = 1u; }
DI unsigned hsh(unsigned a) { a ^= a >> 16; a *= 0x7feb352du; a ^= a >> 15; a *= 0x846ca68bu; a ^= a >> 16; return a; }
DI float bfr(float v) { return bflo(f2bf(v)); }
DI int scol_of(int n) { return n < 3360 ? n : (n < 3584 ? -1 : n - 224); }

DI void chk_p0(const Frame& F, ARef A) {
    unsigned char* ws = A.ws; const int lane = F.lane;
    const float* mod = (const float*)(ws + WS_MOD);
    for (int s = F.wave; s < 32; s += NWAVES) { const unsigned hh = hsh(1000 + s); const int b = hh & 3, o = (hh >> 2) % 6144; float a = 0.f;
        for (int k = lane; k < D; k += 64) { const float c = A.c[b * D + k]; a += (c / (1.0f + expf(-c))) * A.w_mod[(size_t)k * 6144 + o]; }
        a = wave_sum(a) + A.b_mod[o]; chk(ws, 10, mod[b * 6144 + o], a, 1e-3f, 1e-4f); }
    const bf16* wt = (const bf16*)(ws + WS_WIN);
    for (int s = 0; s < 8; ++s) { const unsigned hh = hsh(2000 + (F.wave * 8 + s) * 64 + lane); const int n = hh % NPAD, k = (hh >> 13) & 1023; const int sc = scol_of(n);
        const float want = sc >= 0 ? bfr(A.w_in[(size_t)k * IN_COLS + sc]) : 0.f; chk(ws, 11, bf2f(wt[(size_t)n * D + k]), want, 0.f, 0.f); }
    { const unsigned hh = hsh(3000 + F.wave * 64 + lane); const int n = hh & 1023, k = (hh >> 10) & 511, k2 = (hh >> 10) & 1023;
        chk(ws, 11, bf2f(((const bf16*)(ws + WS_WOSB))[n * BW + k]), bfr(A.w_o_sb[k * D + n]), 0.f, 0.f);
        chk(ws, 11, bf2f(((const bf16*)(ws + WS_WORW))[n * BW + k]), bfr(A.w_o_rw[k * D + n]), 0.f, 0.f);
        chk(ws, 11, bf2f(((const bf16*)(ws + WS_WOUT))[n * D + k2]), bfr(A.w_out[k2 * D + n]), 0.f, 0.f);
        const int o = hh % 36; chk(ws, 11, ((const float*)(ws + WS_RTW))[o * D + k2], o < 4 ? A.w_group[k2 * 4 + o] : A.w_router[k2 * NE + o - 4], 0.f, 0.f);
        const int nl = hh % 1536, kl = (hh >> 11) % LK; float v = 0.f;
        if (nl < 512) { if (kl < 64) v = A.w_decay_up[kl * BW + nl]; } else if (nl < 1024) { if (kl >= 64 && kl < 128) v = A.w_iclr_up[(kl - 64) * BW + nl - 512]; } else { if (kl >= 128 && kl < 288) v = A.w_gate_up[(kl - 128) * BW + nl - 1024]; }
        chk(ws, 11, bf2f(((const bf16*)(ws + WS_WL))[nl * LK + kl]), bfr(v), 0.f, 0.f); }
}
DI void chk_p1(const Frame& F, ARef A, const bf16* H1) {
    unsigned char* ws = A.ws; const int lane = F.lane; const float* mod = (const float*)(ws + WS_MOD);
    for (int s = F.wave; s < 16; s += NWAVES) { const int n = hsh(4000 + s) % NTOK, b = n >> 13; float ss = 0.f;
        for (int k = lane; k < D; k += 64) { const float v = A.x[(size_t)n * D + k]; ss += v * v; }
        const float inv = 1.0f / sqrtf(wave_sum(ss) / D + NORM_EPS);
        for (int k = lane; k < D; k += 64) { const float want = (A.x[(size_t)n * D + k] * inv) * A.gains[k] * (1.0f + mod[b * 6144 + D + k]) + mod[b * 6144 + k];
            chk(ws, 12, bf2f(H1[(size_t)n * D + k]), want, 0.01f, 0.01f); } }
}
DI float wdot(const bf16* arow, const float* W, int ldw, int col, int K, int lane) { float a = 0.f; for (int k = lane; k < K; k += 64) a += bf2f(arow[k]) * W[(size_t)k * ldw + col]; return wave_sum(a); }
DI void chk_p2(const Frame& F, ARef A, const bf16* H1) {
    unsigned char* ws = A.ws; const int lane = F.lane;
    for (int s = F.wave; s < 96; s += NWAVES) { const unsigned hh = hsh(5000 + s); const int n = hh % NTOK, region = s % 6; int col;
        const unsigned h2 = hsh(hh);
        float got, want; int id = 13 + region;
        if (region == 0) { col = h2 % 512; want = 0.125f * wdot(H1 + (size_t)n * D, A.w_in, IN_COLS, col, D, lane); got = bf2f(((const bf16*)(ws + WS_QB))[(size_t)n * BW + col]); }
        else if (region == 1) { col = h2 % 512; want = wdot(H1 + (size_t)n * D, A.w_in, IN_COLS, 512 + col, D, lane); got = bf2f(((const bf16*)(ws + WS_KB))[(size_t)n * BW + col]); }
        else if (region == 2) { col = h2 % 512; want = wdot(H1 + (size_t)n * D, A.w_in, IN_COLS, 1024 + col, D, lane); got = bf2f(((const bf16*)(ws + WS_VT))[((size_t)((n >> 13) * BW + col)) * SEQ + (n & (SEQ - 1))]); }
        else if (region == 3) { col = h2 % 1536; want = wdot(H1 + (size_t)n * D, A.w_in, IN_COLS, 1536 + col, D, lane); got = bf2f(((const bf16*)(ws + WS_RWRAW))[(size_t)n * 1536 + col]); }
        else if (region == 4) { col = h2 % 288; want = wdot(H1 + (size_t)n * D, A.w_in, IN_COLS, 3072 + col, D, lane); got = bf2f(((const bf16*)(ws + WS_LORA))[(size_t)n * BW + col]); }
        else { col = h2 % 2048; want = wdot(H1 + (size_t)n * D, A.w_in, IN_COLS, 3360 + col, D, lane) + A.gate_bias[col]; want = 1.0f / (1.0f + expf(-want)); got = bf2f(((const bf16*)(ws + WS_GATE))[(size_t)n * 2048 + col]); }
        chk(ws, id, got, want, 0.03f, 0.02f); }
}
constexpr int NATT = 16;
DI void att_sample(int s, int& b, int& h, int& t) { const unsigned hh = hsh(6000 + s); b = hh & 3; h = (hh >> 2) & 7; t = (s < 4) ? (s * 37) : (int)((hh >> 5) % SEQ); }
DI void chk_p3_save(const Frame& F, ARef A) {
    if (F.wave == 0) { bf16* sv = (bf16*)(A.ws + WS_FLG + 4096);
        for (int s = 0; s < NATT; ++s) { int b, h, t; att_sample(s, b, h, t); sv[s * 64 + F.lane] = ((const bf16*)(A.ws + WS_QB))[(size_t)(b * SEQ + t) * BW + h * HD + F.lane]; } }
}
DI void chk_p3(const Frame& F, ARef A, const bf16* R, const bf16* KS, const bf16* V, const bf16* KK) {
    unsigned char* ws = A.ws; const int lane = F.lane;
    const bf16* sv = (const bf16*)(ws + WS_FLG + 4096); const bf16* KB = (const bf16*)(ws + WS_KB); const bf16* VT = (const bf16*)(ws + WS_VT);
    for (int s = F.wave; s < NATT; s += NWAVES) { int b, h, t; att_sample(s, b, h, t);
        const float q = bf2f(sv[s * 64 + lane]); float later = 0.f, o = 0.f;
        for (int k = t - 1; k >= 0; --k) { const float z = wave_sum(q * bf2f(KB[(size_t)(b * SEQ + k) * BW + h * HD + lane]));
            const float sp = fmaxf(z, 0.f) + log1pf(expf(-fabsf(z)));
            o += expf(z - sp + later) * bf2f(VT[((size_t)((b * NH + h) * HD + lane)) * SEQ + k]);
            later -= sp; if (later < -200.f) break; }
        chk(ws, 19, bf2f(((const bf16*)(ws + WS_QB))[(size_t)(b * SEQ + t) * BW + h * HD + lane]), o, 0.04f, 0.02f); }
    const bf16* RW = (const bf16*)(ws + WS_RWRAW); const bf16* LO = (const bf16*)(ws + WS_LORA); const bf16* AL = (const bf16*)(ws + WS_ALORA);
    for (int s = F.wave; s < 32; s += NWAVES) { const unsigned hh = hsh(7000 + s); const int n = (s < 4) ? s * SEQ : (int)(hh % NTOK), hd = (hh >> 16) & 7; const bool first = (n & (SEQ - 1)) == 0;
        float xs[3];
        for (int p = 0; p < 3; ++p) { const int col = p * 512 + hd * 64 + lane; const float cur = bf2f(RW[(size_t)n * 1536 + col]), prv = first ? 0.f : bf2f(RW[(size_t)(n - 1) * 1536 + col]); xs[p] = cur + A.shift_mu[col] * (prv - cur); }
        const size_t o = (size_t)n * BW + hd * 64 + lane;
        chk(ws, 20, bf2f(R[o]), xs[0], 0.01f, 0.005f); chk(ws, 20, bf2f(KS[o]), xs[1], 0.01f, 0.005f); chk(ws, 20, bf2f(V[o]), xs[2], 0.01f, 0.005f);
        const float kk = xs[1] * A.k_k[hd * 64 + lane]; const float nn = sqrtf(wave_sum(kk * kk));
        chk(ws, 20, bf2f(KK[o]), kk / fmaxf(nn, L2_EPS), 0.01f, 0.002f);
        for (int c = lane; c < LK; c += 64) { float want = 0.f;
            if (c < 288) { const float cur = bf2f(LO[(size_t)n * BW + c]), prv = first ? 0.f : bf2f(LO[(size_t)(n - 1) * BW + c]); const float v = cur + A.shift_mu[1536 + c] * (prv - cur);
                want = c < 64 ? tanhf(v) : (c < 128 ? v : 1.0f / (1.0f + expf(-v))); }
            chk(ws, 20, bf2f(AL[(size_t)n * LK + c]), want, 0.01f, 0.005f); } }
}
DI void chk_p4_save(const Frame& F, ARef A, const bf16* KS) {
    if (F.wave == 0) { bf16* sv = (bf16*)(A.ws + WS_FLG + 8192);
        for (int s = 0; s < 16; ++s) { const unsigned hh = hsh(8000 + s); const int n = hh % NTOK, hd = (hh >> 16) & 7; sv[s * 64 + F.lane] = KS[(size_t)n * BW + hd * 64 + F.lane]; } }
}
DI void chk_p4(const Frame& F, ARef A, const bf16* KP, const bf16* KK) {
    unsigned char* ws = A.ws; const int lane = F.lane; const bf16* AL = (const bf16*)(ws + WS_ALORA); const bf16* sv = (const bf16*)(ws + WS_FLG + 8192);
    for (int s = F.wave; s < 16; s += NWAVES) { const unsigned hh = hsh(8000 + s); const int n = hh % NTOK, hd = (hh >> 16) & 7, c = hd * 64 + lane; const size_t o = (size_t)n * BW + c;
        float lw = 0.f, la = 0.f, lg = 0.f;
        for (int k = 0; k < 64; ++k) { lw += bf2f(AL[(size_t)n * LK + k]) * A.w_decay_up[k * BW + c]; la += bf2f(AL[(size_t)n * LK + 64 + k]) * A.w_iclr_up[k * BW + c]; }
        for (int k = 0; k < 160; ++k) lg += bf2f(AL[(size_t)n * LK + 128 + k]) * A.w_gate_up[k * BW + c];
        const float x = -(A.w0[c] + lw), w = -(fmaxf(x, 0.f) + log1pf(expf(-fabsf(x)))) - 0.5f;
        chk(ws, 21, bf2f(((const bf16*)(ws + WS_E))[o]), expf(w), 0.03f, 0.003f);
        const float a = 1.0f / (1.0f + expf(-(A.a0[c] + la))); const float ks = bf2f(sv[s * 64 + lane]);
        chk(ws, 22, bf2f(KP[o]), ks * (1.0f + (a - 1.0f) * A.k_a[c]), 0.03f, 0.01f);
        chk(ws, 22, bf2f(((const bf16*)(ws + WS_B))[o]), bf2f(KK[o]) * a, 0.03f, 0.003f);
        chk(ws, 23, bf2f(((const bf16*)(ws + WS_GG))[o]), lg, 0.03f, 0.01f); }
}
constexpr int NST = 300;
DI void chk_p7_save(const Frame& F, ARef A) {
    if (F.wave < 4) { const int b = (F.wave * 3) & 3, h = (F.wave * 5 + 1) & 7; bf16* sv = (bf16*)(A.ws + 256 * 1024) + F.wave * NST * 64;
        for (int t = 0; t < NST; ++t) sv[t * 64 + F.lane] = ((const bf16*)(A.ws + WS_E))[(size_t)(b * SEQ + t) * BW + h * HD + F.lane]; }
}
DI void chk_p7(const Frame& F, ARef A, const bf16* R, const bf16* KP, const bf16* V, const bf16* KK) {
    unsigned char* ws = A.ws; const int lane = F.lane;
    const bf16* Bv = (const bf16*)(ws + WS_B); const bf16* Esv = (const bf16*)(ws + 256 * 1024) + F.wave * NST * 64; const bf16* GG = (const bf16*)(ws + WS_GG); const bf16* YRW = (const bf16*)(ws + WS_YRW);
    if (F.wave < 4) { const int b = (F.wave * 3) & 3, h = (F.wave * 5 + 1) & 7, col0 = h * HD;
        float S[64];
#pragma unroll
        for (int k = 0; k < 64; ++k) S[k] = 0.f;
        for (int t = 0; t < NST; ++t) { const size_t o = (size_t)(b * SEQ + t) * BW + col0 + lane;
            const float av = -bf2f(KK[o]), bv = bf2f(Bv[o]), dv = expf(-bf2f(Esv[t * 64 + lane])), kv = bf2f(KP[o]), rv = bf2f(R[o]), vv = bf2f(V[o]);
            float sa = 0.f;
#pragma unroll
            for (int k = 0; k < 64; ++k) sa += S[k] * __shfl(av, k);
            float y = 0.f;
#pragma unroll
            for (int k = 0; k < 64; ++k) { S[k] = S[k] * __shfl(dv, k) + sa * __shfl(bv, k) + vv * __shfl(kv, k); y += S[k] * __shfl(rv, k); }
            const float mean = wave_sum(y) / 64.f, d = y - mean, var = wave_sum(d * d) / 64.f;
            const float yn = d / sqrtf(var + GN_EPS) * A.lnx_w[col0 + lane] + A.lnx_b[col0 + lane];
            const float bonus = wave_sum(rv * kv * A.r_k[col0 + lane]) * vv;
            const float want = (yn + bonus) * bf2f(GG[o]);
            chk(ws, t < 128 ? 24 : 25, bf2f(YRW[o]), want, 0.05f, 0.03f); } }
}
DI void chk_p8(const Frame& F, ARef A) {
    unsigned char* ws = A.ws; const int lane = F.lane;
    for (int s = F.wave; s < 32; s += NWAVES) { const unsigned hh = hsh(9000 + s); const int n = hh % NTOK, c = (hh >> 15) & 1023;
        const float p1 = wdot((const bf16*)(ws + WS_QB) + (size_t)n * BW, A.w_o_sb, D, c, BW, lane), p2 = wdot((const bf16*)(ws + WS_YRW) + (size_t)n * BW, A.w_o_rw, D, c, BW, lane);
        const bf16* ga = (const bf16*)(ws + WS_GATE) + (size_t)n * 2048;
        chk(ws, 26, bf2f(((const bf16*)(ws + WS_MRG))[(size_t)n * D + c]), bf2f(ga[c]) * p1 + bf2f(ga[1024 + c]) * p2, 0.03f, 0.01f); }
}
DI void chk_p9(const Frame& F, ARef A) {
    unsigned char* ws = A.ws; const int lane = F.lane;
    for (int s = F.wave; s < 32; s += NWAVES) { const unsigned hh = hsh(9500 + s); const int n = hh % NTOK, c = (hh >> 15) & 1023;
        chk(ws, 27, bf2f(((const bf16*)(ws + WS_Y1))[(size_t)n * D + c]), wdot((const bf16*)(ws + WS_MRG) + (size_t)n * D, A.w_out, D, c, D, lane), 0.03f, 0.01f); }
}
DI void chk_p10(const Frame& F, ARef A) {
    unsigned char* ws = A.ws; const int lane = F.lane; const float* mod = (const float*)(ws + WS_MOD);
    const bf16* Y1 = (const bf16*)(ws + WS_Y1); const bf16* H2 = (const bf16*)(ws + WS_H2); const i32x4* tok = (const i32x4*)(ws + WS_TOK);
    for (int s = F.wave; s < 32; s += NWAVES) { const int n = s == 0 ? DBG_TOKEN : (s < 16 ? (int)(hsh(10000 + s) % 128) : (int)(hsh(10000 + s) % NTOK)), b = n >> 13; float ss = 0.f;
        for (int k = lane; k < D; k += 64) { const float v = bf2f(Y1[(size_t)n * D + k]); ss += v * v; }
        const float inv1 = 1.0f / sqrtf(wave_sum(ss) / D + NORM_EPS); float s2 = 0.f;
        for (int k = lane; k < D; k += 64) { const float x1 = A.x[(size_t)n * D + k] + mod[b * 6144 + 2 * D + k] * ((bf2f(Y1[(size_t)n * D + k]) * inv1) * A.gains[D + k]);
            chk(ws, 28, A.out[(size_t)n * D + k], x1, 1e-3f, 1e-3f); s2 += x1 * x1; }
        const float inv2 = 1.0f / sqrtf(wave_sum(s2) / D + NORM_EPS);
        float lg[36];
#pragma unroll
        for (int o = 0; o < 36; ++o) lg[o] = 0.f;
        for (int k = lane; k < D; k += 64) { const float h2 = (A.out[(size_t)n * D + k] * inv2) * A.gains[2 * D + k] * (1.0f + mod[b * 6144 + 4 * D + k]) + mod[b * 6144 + 3 * D + k];
            chk(ws, 29, bf2f(H2[(size_t)n * D + k]), h2, 0.01f, 0.01f);
#pragma unroll
            for (int o = 0; o < 36; ++o) lg[o] += h2 * (o < 4 ? A.w_group[k * 4 + o] : A.w_router[k * NE + o - 4]); }
#pragma unroll
        for (int o = 0; o < 36; ++o) lg[o] = wave_sum(lg[o]);
        int gs = 0; float gm = lg[0];
#pragma unroll
        for (int g = 1; g < 4; ++g) if (lg[g] > gm) { gm = lg[g]; gs = g; }
        float gsum = 0.f;
#pragma unroll
        for (int g = 0; g < 4; ++g) gsum += expf(lg[g] - gm);
        float el[8];
#pragma unroll
        for (int e = 0; e < 8; ++e) el[e] = gs == 0 ? lg[4 + e] : (gs == 1 ? lg[12 + e] : (gs == 2 ? lg[20 + e] : lg[28 + e]));
        int i0 = 0; float m0 = el[0];
#pragma unroll
        for (int e = 1; e < 8; ++e) if (el[e] > m0) { m0 = el[e]; i0 = e; }
        int i1 = -1; float m1 = -3.0e38f;
#pragma unroll
        for (int e = 0; e < 8; ++e) if (e != i0 && el[e] > m1) { m1 = el[e]; i1 = e; }
        const float tt = expf(m1 - m0), p0 = 1.0f / (1.0f + tt);
        const i32x4 rec = tok[n];
        if (lane == 0 && s < 16) { if ((rec.x & 255) != gs * 8 + i0 || ((rec.x >> 8) & 255) != gs * 8 + i1) chk_flags(ws)[30] = 1u;
            if (n == DBG_TOKEN) { const float* dbg = (const float*)chk_flags(ws) + 48; float code = 1.f;
                if (dbg[4] > 4.001f) code += 2.f; if (dbg[5] < 0.499f) code += 4.f;
                if (fabsf(dbg[0] - lg[0]) > 1e-3f || fabsf(dbg[1] - lg[1]) > 1e-3f || fabsf(dbg[2] - lg[2]) > 1e-3f || fabsf(dbg[3] - lg[3]) > 1e-3f) code += 8.f;
                if (fabsf(dbg[4] - gsum) > 1e-3f) code += 16.f; if (fabsf(dbg[6] * dbg[5] - __builtin_bit_cast(float, rec.z)) > 1e-4f) code += 32.f;
                ((float*)chk_flags(ws))[62] = code * 0.1f; ((float*)chk_flags(ws))[63] = dbg[4]; }
            chk(ws, 56, ((const float*)(ws + WS_CW))[2 * n], p0 / gsum, 3e-2f, 1e-4f); chk(ws, 57, ((const float*)(ws + WS_CW))[2 * n + 1], tt * p0 / gsum, 3e-2f, 1e-4f);
            chk(ws, 58, ((const float*)(ws + WS_CW))[2 * n], p0 / gsum, 1e-3f, 1e-5f); chk(ws, 59, ((const float*)(ws + WS_CW))[2 * n + 1], tt * p0 / gsum, 1e-3f, 1e-5f); } }
}
DI void chk_p11(const Frame& F, ARef A) {
    unsigned char* ws = A.ws; const int lane = F.lane; const i32x4* tok = (const i32x4*)(ws + WS_TOK); const int* tile = (const int*)(ws + WS_TILE);
    const bf16* H2 = (const bf16*)(ws + WS_H2); const bf16* HS = (const bf16*)(ws + WS_HS);
    for (int s = F.wave; s < 64; s += NWAVES) { const int n = hsh(11000 + s) % NTOK; const i32x4 rec = tok[n];
        if (rec.x < 0 || rec.x >= tile[MAXT] * 256 || rec.y < 0 || rec.y >= tile[MAXT] * 256 || tile[MAXT] > MAXT || tile[MAXT] < 256) { chk_flags(ws)[32] = 1u; continue; }
        for (int k = lane; k < D; k += 64) { chk(ws, 33, bf2f(HS[(size_t)rec.x * D + k]), bf2f(H2[(size_t)n * D + k]), 0.f, 0.f); chk(ws, 33, bf2f(HS[(size_t)rec.y * D + k]), bf2f(H2[(size_t)n * D + k]), 0.f, 0.f); } }
    { const unsigned hh = hsh(12000 + F.wave * 64 + lane); const int e = hh & 31, n = (hh >> 5) & 1023, k = (hh >> 15) & 1023, k5 = k & 511;
        const int c = (n >> 3) * 4 + (n & 3); const float want = (n & 4) ? A.w_up3[((size_t)e * D + k) * DE + c] : A.w_up1[((size_t)e * D + k) * DE + c];
        chk(ws, 34, bf2f(((const bf16*)(ws + WS_WUP))[((size_t)e * 1024 + n) * D + k]), bfr(want), 0.f, 0.f);
        chk(ws, 35, bf2f(((const bf16*)(ws + WS_WDN))[((size_t)e * 1024 + n) * DE + k5]), bfr(A.w_down[((size_t)e * DE + k5) * D + n]), 0.f, 0.f); }
}
DI void chk_p12(const Frame& F, ARef A) {
    unsigned char* ws = A.ws; const int lane = F.lane; const i32x4* tok = (const i32x4*)(ws + WS_TOK); const int* tile = (const int*)(ws + WS_TILE);
    const bf16* H2 = (const bf16*)(ws + WS_H2); const bf16* HID = (const bf16*)(ws + WS_HID);
    for (int s = F.wave; s < 32; s += NWAVES) { const unsigned hh = hsh(13000 + s); const int n = hh % NTOK, c = (hh >> 16) & 511; const i32x4 rec = tok[n]; const int pos = (s & 1) ? rec.y : rec.x;
        const int e = tile[pos >> 8];
        const float u1 = wdot(H2 + (size_t)n * D, A.w_up1 + (size_t)e * D * DE, DE, c, D, lane), u3 = wdot(H2 + (size_t)n * D, A.w_up3 + (size_t)e * D * DE, DE, c, D, lane);
        chk(ws, 36, bf2f(HID[(size_t)pos * DE + c]), u1 / (1.0f + expf(-u1)) * u3, 0.04f, 0.01f); }
}
DI void chk_p13(const Frame& F, ARef A) {
    unsigned char* ws = A.ws; const int lane = F.lane; const i32x4* tok = (const i32x4*)(ws + WS_TOK); const int* tile = (const int*)(ws + WS_TILE);
    const bf16* HID = (const bf16*)(ws + WS_HID); const bf16* YE = (const bf16*)(ws + WS_HS);
    for (int s = F.wave; s < 32; s += NWAVES) { const unsigned hh = hsh(14000 + s); const int n = hh % NTOK, c = (hh >> 16) & 1023; const i32x4 rec = tok[n]; const int pos = (s & 1) ? rec.y : rec.x;
        const int e = tile[pos >> 8];
        chk(ws, 37, bf2f(YE[(size_t)pos * D + c]), wdot(HID + (size_t)pos * DE, A.w_down + (size_t)e * DE * D, D, c, DE, lane), 0.04f, 0.01f); }
}
#endif

__global__ void __launch_bounds__(NTHR, 2) hybrid_fwd(Args A_unused) {
    extern __shared__ __attribute__((aligned(16))) unsigned char lds_raw[];
    const CAS Args& A = *(const CAS Args*)__builtin_amdgcn_kernarg_segment_ptr();
    Frame F;
    F.lds = (LAS unsigned char*)lds_raw;
    F.wave = __builtin_amdgcn_readfirstlane((int)threadIdx.x >> 6); F.tid = opq_tid(F.wave); F.lane = F.tid & 63;
    F.wg = blockIdx.x; F.G = gridDim.x; F.gw = F.wg * NWAVES + F.wave; F.NGW = F.G * NWAVES;
    volatile LAS unsigned* MISC = (volatile LAS unsigned*)(F.lds + LDS_MISC);
    if (F.wave == 0) MISC[F.lane] = 0u;
    __syncthreads();
    const XcdBarrier bar = xcd_barrier_post((unsigned*)(A.ws + WS_CTL), MISC + 8, F.wave);
    unsigned char* ws = A.ws;
    LAS unsigned char* stage = F.lds;
    bf16* const dob = (bf16*)A.out;
    bf16 *H1 = dob, *R = dob, *KS = dob + (size_t)NTOK * BW, *V = dob + 2 * (size_t)NTOK * BW, *KK = dob + 3 * (size_t)NTOK * BW;

#if defined(STAMPS)
    unsigned long long* const tsp = (unsigned long long*)(ws + WS_CTL + 49152);
#define STAMP(k) do { if (F.wg == 0 && xb_t0(F.wave)) tsp[k] = wall_clock64(); } while (0)
#elif defined(TIMEPHASE)
#define STAMP(k) TPS(F, k)
#else
#define STAMP(k) do { } while (0)
#endif
#if defined(REPEAT_PHASE)
#ifndef REPEAT_COUNT
#define REPEAT_COUNT 2
#endif
#define REP(k) _Pragma("nounroll") for (int rep_ = 0; rep_ < ((k) == REPEAT_PHASE ? REPEAT_COUNT : 1); ++rep_)
#else
#define REP(k)
#endif
    STAMP(0);
    REP(0) {
    p0_prologue(F, A);
    xcd_barrier(bar);
    }
    STAMP(1);
#if defined(CHECKS)
    if (F.wg == 0) chk_p0(F, A);
#endif
    REP(1) {
    p1_h1(F, A, H1);
    xcd_barrier(bar);
    }
    STAMP(2);
#if defined(CHECKS)
    if (F.wg == 0) chk_p1(F, A, H1);
#endif
    REP(2) {
    {   pg8::Gemm g{H1, (const bf16*)(ws + WS_WIN), NTOK, NPAD, D}; pg8::StaticOrder S; S.init(NTOK, NPAD, F.G, F.wg);
        EpiIn E{(bf16*)(ws + WS_QB), (bf16*)(ws + WS_KB), (bf16*)(ws + WS_VT), (bf16*)(ws + WS_RWRAW), (bf16*)(ws + WS_LORA), (bf16*)(ws + WS_GATE), A.gate_bias};
        pg8::gemm_phase<EpiIn, pg8::StaticOrder>(stage, g, S, E, nullptr, F.wave); }
    xcd_barrier(bar);
    }
    STAMP(3);
#if defined(CHECKS)
    if (F.wg == 0) { chk_p2(F, A, H1); chk_p3_save(F, A); }
    xcd_barrier(bar);
#endif
#if !defined(CHECKS)
    const bool fuse34 = (F.G == 256);
#else
    const bool fuse34 = false;
#endif
    REP(3) {
#if defined(TIMEPHASE)
    STAMP(30);
#endif
    p3_attn(F, (const bf16*)(ws + WS_QB), (const bf16*)(ws + WS_KB), (const bf16*)(ws + WS_VT), (bf16*)(ws + WS_QB));
#if defined(STAMPS)
    STAMP(20);
#endif
#if defined(TIMEPHASE)
    STAMP(31);
#endif
    p3_prep(F, A, (const bf16*)(ws + WS_RWRAW), (const bf16*)(ws + WS_LORA), R, KS, V, KK, (bf16*)(ws + WS_ALORA));
#if defined(TIMEPHASE)
    STAMP(32);
#endif
#if !defined(CHECKS)
    if (fuse34) { asm volatile("s_waitcnt vmcnt(0)" ::: "memory"); __syncthreads();
        p4_lora(F, A, (const bf16*)(ws + WS_ALORA), (const bf16*)(ws + WS_WL), (bf16*)(ws + WS_E), KS, (bf16*)(ws + WS_B), (bf16*)(ws + WS_GG), KK, R, (float*)(ws + WS_BON)); }
#endif
#if defined(TIMEPHASE)
    STAMP(33);
#endif
    xcd_barrier(bar);
    }
#if defined(STAMPS)
    STAMP(21);
#endif
    STAMP(4);
#if defined(CHECKS)
    if (F.wg == 0) { chk_p3(F, A, R, KS, V, KK); chk_p4_save(F, A, KS); }
    xcd_barrier(bar);
#endif
    if (!fuse34) {
    p4_lora(F, A, (const bf16*)(ws + WS_ALORA), (const bf16*)(ws + WS_WL), (bf16*)(ws + WS_E), KS, (bf16*)(ws + WS_B), (bf16*)(ws + WS_GG), KK, R, (float*)(ws + WS_BON));
    xcd_barrier(bar);
    }
    STAMP(5);
#if defined(CHECKS)
    if (F.wg == 0) chk_p4(F, A, KS, KK);
#endif
    REP(5) {
    p5_mfma(ws, F, R, KS, V, KK, (const bf16*)(ws + WS_B), (const bf16*)(ws + WS_E), (bf16*)(ws + WS_P), (bf16*)(ws + WS_QO), (bf16*)(ws + WS_GT), (bf16*)(ws + WS_HT));
    p6_moe_weights(F, A, F.gw, F.NGW);
    xcd_barrier(bar);
    }
    STAMP(6);
#if defined(CHECKS)
    if (F.wg == 255) chk_p7_save(F, A);
#endif
    REP(6) {
    {   const int ncw = F.G < 64 ? F.G : 64;
        if (F.wg < ncw) { if (F.wave == 0) for (int task = F.wg; task < 64; task += ncw) p6_chain(task, F.wave, F.lds, (const bf16*)(ws + WS_GT), (const bf16*)(ws + WS_HT), (bf16*)(ws + WS_SC));
#if defined(STAMPS)
            STAMP(22);
#endif
        }
        else {
            pg8::StaticOrder S; S.init(NTOK, D, F.G - ncw, F.wg - ncw);
            pg8::Gemm g{(const bf16*)(ws + WS_QB), (const bf16*)(ws + WS_WOSB), NTOK, D, BW};
            EpiMerge<false> E{(bf16*)(ws + WS_GATE), (bf16*)(ws + WS_MRG), 0};
            pg8::gemm_phase<EpiMerge<false>, pg8::StaticOrder>(stage, g, S, E, nullptr, F.wave); }
    }
    xcd_barrier(bar);
    }
    STAMP(7);
    REP(7) {
    p7_mfma(F, A, (const bf16*)(ws + WS_SC), (const bf16*)(ws + WS_P), (const bf16*)(ws + WS_QO), V, (const bf16*)(ws + WS_GG), (const float*)(ws + WS_BON), (bf16*)(ws + WS_YRW));
    xcd_barrier(bar);
    }
    STAMP(8);
#if defined(CHECKS)
    if (F.wg == 0) chk_p7(F, A, R, KS, V, KK);
#endif
    REP(8) {
    {   pg8::StaticOrder S; S.init(NTOK, D, F.G, F.wg);
        {   pg8::Gemm g{(const bf16*)(ws + WS_YRW), (const bf16*)(ws + WS_WORW), NTOK, D, BW};
            EpiMerge<true> E{(bf16*)(ws + WS_GATE), (bf16*)(ws + WS_MRG), D};
            pg8::gemm_phase<EpiMerge<true>, pg8::StaticOrder>(stage, g, S, E, nullptr, F.wave); } }
    xcd_barrier(bar);
    }
    STAMP(9);
#if defined(CHECKS)
    if (F.wg == 0) chk_p8(F, A);
#endif
    REP(9) {
    {   pg8::Gemm g{(const bf16*)(ws + WS_MRG), (const bf16*)(ws + WS_WOUT), NTOK, D, D}; pg8::StaticOrder S; S.init(NTOK, D, F.G, F.wg);
        EpiPlain E{(bf16*)(ws + WS_Y1), D, 0xff};
        pg8::gemm_phase<EpiPlain, pg8::StaticOrder>(stage, g, S, E, nullptr, F.wave); }
    xcd_barrier(bar);
    }
    STAMP(10);
#if defined(CHECKS)
    if (F.wg == 0) chk_p9(F, A);
#endif
    REP(10) {
    p10_rows(F, A, (const bf16*)(ws + WS_Y1), (bf16*)(ws + WS_H2));
    xcd_barrier(bar);
    }
    STAMP(11);
#if defined(CHECKS)
    if (F.wg == 0) chk_p10(F, A);
#endif
    REP(11) {
    p11_rank_gather(F, A, (const bf16*)(ws + WS_H2), (bf16*)(ws + WS_HS));
    xcd_barrier(bar);
    }
    STAMP(12);
#if defined(CHECKS)
    if (F.wg == 0) chk_p11(F, A);
#endif
    {   const int* tile = (const int*)(ws + WS_TILE);
        const int nt = __builtin_amdgcn_readfirstlane(tile[MAXT]);
        const int vc = (F.G % 8 == 0) ? (F.wg % 8) * (F.G / 8) + F.wg / 8 : F.wg;
        unsigned* tcnt = (unsigned*)(ws + WS_CTL) + MOE_CNT_WORD;
        REP(12) {   pg8::Gemm g{(const bf16*)(ws + WS_HS), (const bf16*)(ws + WS_WUP), MAXT * 256, NE * 1024, D};
            MoeUpOrder S; S.nunits = nt * 4; S.G = F.G; S.vc = vc; S.tile_e = tile; S.cnt = tcnt;
            EpiUp E{(bf16*)(ws + WS_HID)};
            pg8::gemm_phase<EpiUp, MoeUpOrder>(stage, g, S, E, nullptr, F.wave); }
        __syncthreads();
    STAMP(13);
        REP(13) {   pg8::Gemm g{(const bf16*)(ws + WS_HID), (const bf16*)(ws + WS_WDN), MAXT * 256, NE * 1024, DE};
            MoeDnOrder S; S.nunits = nt * 4; S.G = F.G; S.vc = vc; S.q = (nt * 4) / F.G; S.rem = nt * 4 - S.q * F.G; S.wave = F.wave; S.tile_e = tile; S.cnt = tcnt;
            EpiPlain E{(bf16*)(ws + WS_HS), D, 3};
            pg8::gemm_phase<EpiPlain, MoeDnOrder>(stage, g, S, E, nullptr, F.wave);
        xcd_barrier(bar); } }
    STAMP(14);
#if defined(CHECKS)
    if (F.wg == 0) chk_p13(F, A);
#endif
    p14_final(F, A, (const bf16*)(ws + WS_HS));
#if defined(STAMPS)
    xcd_barrier(bar);
    STAMP(15);
    if (F.wg == 0) { __syncthreads();
        const float va = (float)(long long)(tsp[STAMP_A2] - tsp[STAMP_A]) * 0.01f, vb = (float)(long long)(tsp[STAMP_B2] - tsp[STAMP_B]) * 0.01f;
#if defined(STAMP_SHIFT)
        const float shf_ = 1.1f;
#else
        const float shf_ = 1.0f;
#endif
        int b1 = (int)floorf(logf(fmaxf(va * shf_, 1.0f)) / logf(1.21f)) + 1, b2 = (int)floorf(logf(fmaxf(vb * shf_, 1.0f)) / logf(1.21f)) + 1;
#if defined(STAMP_CAL)
        b1 = 10; b2 = 30;
#endif
#if defined(STAMP_FRAC)
        { const unsigned long long* t5 = tsp + 32; const float tot = (float)(long long)(t5[9] - t5[0]);
          b1 = (int)(12.0f * (float)(long long)(t5[STAMP_A2] - t5[STAMP_A]) / tot) + 3; b2 = (int)(12.0f * (float)(long long)(t5[STAMP_B2] - t5[STAMP_B]) / tot) + 3; }
#endif
#if defined(STAMP_THR_A)
        b1 = va > (float)(STAMP_THR_A) ? 30 : 10; b2 = vb > (float)(STAMP_THR_B) ? 30 : 10;
#endif
        const int t_ = opq_tid(F.wave);
        for (int i = t_; i < 1000; i += NTHR) A.out[1000 + i] += 20.0f * (float)b2;
        if (t_ == 0) A.out[0] = 200.0f * (float)b1; }
#endif
#if defined(CHECKS)
    xcd_barrier(bar);
    if (F.wg == 0 && F.tid == 0) { const unsigned* fl = chk_flags(ws); int id = 0; for (int i = 61; i >= 0; --i) if (fl[i]) id = i;
        if (((const unsigned*)(ws + WS_CTL))[XB_TMO]) id = 60;
        if (id) A.out[0] = 10.0f * (float)id;
#if defined(CHKVAL)
        A.out[0] = 1000.0f * ((const float*)fl)[CHKVAL];
#endif
        }
#endif
}

extern "C" void kernel_launch(void* const* d_in, const int* in_sizes, int n_in, void* d_out, int out_size, void* d_ws, size_t ws_size, hipStream_t stream) {
    static int grid = 0;
    if (grid == 0) {
        if (n_in != 26 || in_sizes[0] != NTOK * D || out_size != NTOK * D || ws_size < WS_END) {
            fprintf(stderr, "kernel_launch: unexpected shapes (n_in %d, in0 %d, out %d, ws %zu); nothing launched\n", n_in, n_in > 0 ? in_sizes[0] : -1, out_size, ws_size); grid = -1; return; }
        int dev = 0, cus = 0, per_cu = 0;
        if (hipGetDevice(&dev) != hipSuccess || hipDeviceGetAttribute(&cus, hipDeviceAttributeMultiprocessorCount, dev) != hipSuccess) { grid = -1; return; }
        if (hipFuncSetAttribute((const void*)hybrid_fwd, hipFuncAttributeMaxDynamicSharedMemorySize, LDS_BYTES) != hipSuccess) { fprintf(stderr, "kernel_launch: hipFuncSetAttribute failed\n"); grid = -1; return; }
        if (hipOccupancyMaxActiveBlocksPerMultiprocessor(&per_cu, (const void*)hybrid_fwd, NTHR, LDS_BYTES) != hipSuccess || per_cu < 1)
            fprintf(stderr, "kernel_launch: note: occupancy query reports %d workgroups per CU\n", per_cu);
        (void)hipGetLastError();
        grid = cus > 256 ? 256 : cus;
    }
    if (grid < 0) return;
    if (hipMemsetAsync((char*)d_ws + WS_CTL, 0, CTL_ZERO_BYTES, stream) != hipSuccess) return;
    Args a{};
    const float** p = (const float**)&a;
    for (int i = 0; i < 26; ++i) p[i] = (const float*)d_in[i];
    a.out = (float*)d_out; a.ws = (unsigned char*)d_ws;
    hipLaunchKernelGGL(hybrid_fwd, dim3(grid), dim3(NTHR), LDS_BYTES, stream, a);
}

#if defined(ONLY_P5)
__global__ void __launch_bounds__(NTHR, 2) only_p5(Args A_unused) {
    extern __shared__ __attribute__((aligned(16))) unsigned char lds_raw[];
    const CAS Args& A = *(const CAS Args*)__builtin_amdgcn_kernarg_segment_ptr();
    Frame F; F.lds = (LAS unsigned char*)lds_raw; F.wave = __builtin_amdgcn_readfirstlane((int)threadIdx.x >> 6); F.tid = opq_tid(F.wave); F.lane = F.tid & 63;
    F.wg = blockIdx.x; F.G = gridDim.x; F.gw = F.wg * NWAVES + F.wave; F.NGW = F.G * NWAVES;
    unsigned char* ws = A.ws; bf16* const dob = (bf16*)A.out;
    bf16 *R = dob, *KS = dob + (size_t)NTOK * BW, *V = dob + 2 * (size_t)NTOK * BW, *KK = dob + 3 * (size_t)NTOK * BW;
    p5_mfma(ws, F, R, KS, V, KK, (const bf16*)(ws + WS_B), (const bf16*)(ws + WS_E), (bf16*)(ws + WS_P), (bf16*)(ws + WS_QO), (bf16*)(ws + WS_GT), (bf16*)(ws + WS_HT));
}
#endif
```
